# Optimizing an MI355X kernel written in HIP

```python
import jax, jax.numpy as jnp
from jax import lax
import numpy as np

D_MODEL = 1024
BATCH = 8
SEQ = 2048
DEPTH = 2

HEAD_DIM = 64
ROPE_THETA = 10000.0
NORM_EPS = 1e-6
N_BRANCH = 4
A_WIDTH = 512
A_CONV = 3
B_WIDTH = 512
B_CONV = 31
C_HEADS = 8
C_KV_HEADS = 2
C_GROUP = C_HEADS // C_KV_HEADS
C_WIDTH = C_HEADS * HEAD_DIM
C_KV_WIDTH = C_KV_HEADS * HEAD_DIM
CMP_BLOCK = 32
CMP_STRIDE = 16
CMP_HIDDEN = 128
SLC_BLOCK = 64
SLC_TOPN = 16
SLC_QCHUNK = 32
WIN = 512
WIN_QBLOCK = 128
D_HEADS = 8
D_WIDTH = D_HEADS * HEAD_DIM
MOBA_BLOCK = 256
MOBA_TOPK = 3
MOBA_QCHUNK = 16
PEER_HEADS = 8
PEER_NKEYS = 128
PEER_EXPERTS = PEER_NKEYS * PEER_NKEYS
PEER_QDIM = 256
PEER_TOPK = 16
PEER_TCHUNK = 128

IN_SIZES = (A_WIDTH, A_WIDTH, A_WIDTH, B_WIDTH, B_WIDTH, C_WIDTH) + (C_KV_WIDTH,) * 6 + (3 * C_HEADS, D_WIDTH, D_WIDTH, D_WIDTH, N_BRANCH * D_MODEL)
IN_COLS = sum(IN_SIZES)
IN_SPLITS = [int(v) for v in np.cumsum(IN_SIZES)[:-1]]

kernel_name = 'hybrid_conv_nsa_moba_peer_block'


def rms_norm(x, g):
    xf = x.astype(jnp.float32)
    y = xf * lax.rsqrt(jnp.mean(xf * xf, axis=-1, keepdims=True) + NORM_EPS)
    return (y * g.astype(jnp.float32)).astype(x.dtype)


def layer_norm(x, g, b):
    xf = x.astype(jnp.float32)
    mu = jnp.mean(xf, axis=-1, keepdims=True)
    var = jnp.mean(jnp.square(xf - mu), axis=-1, keepdims=True)
    y = (xf - mu) * lax.rsqrt(var + NORM_EPS)
    return (y * g.astype(jnp.float32) + b.astype(jnp.float32)).astype(x.dtype)


def rope_tables(positions):
    inv = 1.0 / (ROPE_THETA ** (jnp.arange(0, HEAD_DIM, 2, dtype=jnp.float32) / HEAD_DIM))
    ang = positions.astype(jnp.float32)[..., None] * inv
    return jnp.cos(ang)[:, :, None, :], jnp.sin(ang)[:, :, None, :]


def apply_rope(x, cos, sin):
    xf = x.astype(jnp.float32)
    x1, x2 = jnp.split(xf, 2, axis=-1)
    return jnp.concatenate([x1 * cos - x2 * sin, x2 * cos + x1 * sin], axis=-1).astype(x.dtype)


def causal_dwconv(x, w):
    k, ch = w.shape
    return lax.conv_general_dilated(x, w[:, None, :].astype(x.dtype), window_strides=(1,), padding=[(k - 1, 0)], dimension_numbers=('NWC', 'WIO', 'NWC'), feature_group_count=ch)


def masked_softmax(s, mask, axis):
    s = jnp.where(mask, s.astype(jnp.float32), -jnp.inf)
    m = jnp.max(s, axis=axis, keepdims=True)
    m = jnp.where(jnp.isfinite(m), m, 0.0)
    e = jnp.where(mask, jnp.exp(s - m), 0.0)
    return e / jnp.maximum(jnp.sum(e, axis=axis, keepdims=True), 1e-30)


def short_conv_mixer(a_b, a_c, a_x, conv_w, w_out):
    return (a_b * causal_dwconv(a_c * a_x, conv_w)) @ w_out


def conformer_conv_module(b_a, b_g, conv_w, conv_b, ln_g, ln_b, w_out):
    u = b_a * jax.nn.sigmoid(b_g)
    u = causal_dwconv(u, conv_w) + conv_b
    u = jax.nn.silu(layer_norm(u, ln_g, ln_b))
    return u @ w_out


def nsa_compress(k, pos, w1, w2):
    bsz, s = k.shape[:2]
    n_cmp = (s - CMP_BLOCK) // CMP_STRIDE + 1
    idx = jnp.arange(n_cmp)[:, None] * CMP_STRIDE + jnp.arange(CMP_BLOCK)[None, :]
    blk = k[:, idx] + pos[None, None, :, None, :]
    blk = blk.transpose(0, 1, 3, 2, 4).reshape(bsz, n_cmp, C_KV_HEADS, CMP_BLOCK * HEAD_DIM)
    return jax.nn.gelu(blk @ w1, approximate=False) @ w2


def nsa_attention(q, kc, vc, ks, vs, kw, vw, gate_logits, cmp_pos, cmp_w1, cmp_w2, cos, sin, w_out):
    bsz, s = q.shape[:2]
    scale = HEAD_DIM ** -0.5
    t = jnp.arange(s)
    q = apply_rope(q.reshape(bsz, s, C_HEADS, HEAD_DIM), cos, sin).reshape(bsz, s, C_KV_HEADS, C_GROUP, HEAD_DIM)
    heads = lambda z: z.reshape(bsz, s, C_KV_HEADS, HEAD_DIM)
    kc = apply_rope(heads(kc), cos, sin)
    ks = apply_rope(heads(ks), cos, sin)
    kw = apply_rope(heads(kw), cos, sin)
    vc, vs, vw = heads(vc), heads(vs), heads(vw)

    k_cmp = nsa_compress(kc, cmp_pos[0], cmp_w1[0], cmp_w2[0])
    v_cmp = nsa_compress(vc, cmp_pos[1], cmp_w1[1], cmp_w2[1])
    n_cmp = k_cmp.shape[1]
    cmp_start = jnp.arange(n_cmp) * CMP_STRIDE
    s_cmp = jnp.einsum('bsgrd,bngd->bgrsn', q, k_cmp) * scale
    p_cmp = masked_softmax(s_cmp, (cmp_start + CMP_BLOCK - 1)[None, :] <= t[:, None], -1)
    o_cmp = jnp.einsum('bgrsn,bngd->bsgrd', p_cmp.astype(v_cmp.dtype), v_cmp)

    n_slc = s // SLC_BLOCK
    top_n = min(SLC_TOPN, n_slc)
    slc_start = jnp.arange(n_slc) * SLC_BLOCK
    overlap = ((cmp_start[:, None] < slc_start[None, :] + SLC_BLOCK) & (cmp_start[:, None] + CMP_BLOCK > slc_start[None, :])).astype(jnp.float32)
    imp = jnp.einsum('bgrsn,nj->bgsj', p_cmp, overlap)
    cur = t // SLC_BLOCK
    j = jnp.arange(n_slc)
    forced = (j[None, :] == 0) | (j[None, :] == cur[:, None]) | (j[None, :] == cur[:, None] - 1)
    imp = jnp.where(forced, jnp.inf, jnp.where(slc_start[None, :] > t[:, None], -jnp.inf, imp))
    _, sel = lax.top_k(imp, top_n)

    def to_blocks(z):
        return z.reshape(bsz, n_slc, SLC_BLOCK, C_KV_HEADS, HEAD_DIM).transpose(0, 3, 1, 2, 4).reshape(bsz, C_KV_HEADS, n_slc, SLC_BLOCK * HEAD_DIM)

    ks_blk, vs_blk = to_blocks(ks), to_blocks(vs)
    nq = s // SLC_QCHUNK
    q_ch = jnp.moveaxis(q.reshape(bsz, nq, SLC_QCHUNK, C_KV_HEADS, C_GROUP, HEAD_DIM), 1, 0)
    sel_ch = jnp.moveaxis(sel.reshape(bsz, C_KV_HEADS, nq, SLC_QCHUNK, top_n), 2, 0)
    t_ch = t.reshape(nq, SLC_QCHUNK)

    def slc_chunk(args):
        qc, ic, tc = args
        flat = ic.reshape(bsz, C_KV_HEADS, SLC_QCHUNK * top_n, 1)
        shp = (bsz, C_KV_HEADS, SLC_QCHUNK, top_n, SLC_BLOCK, HEAD_DIM)
        kg = jnp.take_along_axis(ks_blk, flat, axis=2).reshape(shp)
        vg = jnp.take_along_axis(vs_blk, flat, axis=2).reshape(shp)
        sc = jnp.einsum('bqgrd,bgqnkd->bgrqnk', qc, kg) * scale
        kpos = ic[..., None] * SLC_BLOCK + jnp.arange(SLC_BLOCK)
        mask = (kpos <= tc[:, None, None])[:, :, None]
        p = masked_softmax(sc, mask, (-2, -1))
        return jnp.einsum('bgrqnk,bgqnkd->bqgrd', p.astype(vg.dtype), vg)

    o_slc = jnp.moveaxis(lax.map(slc_chunk, (q_ch, sel_ch, t_ch)), 0, 1).reshape(bsz, s, C_KV_HEADS, C_GROUP, HEAD_DIM)

    nqb = s // WIN_QBLOCK
    nband = WIN // WIN_QBLOCK + 1

    def band(z):
        zp = jnp.pad(z, ((0, 0), (WIN, 0), (0, 0), (0, 0))).reshape(bsz, nqb + nband - 1, WIN_QBLOCK, C_KV_HEADS, HEAD_DIM)
        return jnp.concatenate([zp[:, i:i + nqb] for i in range(nband)], axis=2)

    kb, vb = band(kw), band(vw)
    qb = q.reshape(bsz, nqb, WIN_QBLOCK, C_KV_HEADS, C_GROUP, HEAD_DIM)
    sc = jnp.einsum('bnqgrd,bnkgd->bngrqk', qb, kb) * scale
    tq = t.reshape(nqb, WIN_QBLOCK)[:, :, None]
    kpos = (jnp.arange(nqb)[:, None] * WIN_QBLOCK - WIN + jnp.arange(nband * WIN_QBLOCK)[None, :])[:, None, :]
    mask = (kpos >= 0) & (kpos <= tq) & (kpos > tq - WIN)
    p = masked_softmax(sc, mask[None, :, None, None], -1)
    o_win = jnp.einsum('bngrqk,bnkgd->bnqgrd', p.astype(vb.dtype), vb).reshape(bsz, s, C_KV_HEADS, C_GROUP, HEAD_DIM)

    g = jax.nn.sigmoid(gate_logits).reshape(bsz, s, 3, C_KV_HEADS, C_GROUP, 1)
    o = g[:, :, 0] * o_cmp + g[:, :, 1] * o_slc + g[:, :, 2] * o_win
    return o.reshape(bsz, s, C_WIDTH) @ w_out


def moba_attention(q, k, v, cos, sin, w_out):
    bsz, s = q.shape[:2]
    scale = HEAD_DIM ** -0.5
    heads = lambda z: z.reshape(bsz, s, D_HEADS, HEAD_DIM)
    q = apply_rope(heads(q), cos, sin)
    k = apply_rope(heads(k), cos, sin)
    v = heads(v)
    nb = -(-s // MOBA_BLOCK)
    pad = nb * MOBA_BLOCK - s
    kp = jnp.pad(k, ((0, 0), (0, pad), (0, 0), (0, 0))).reshape(bsz, nb, MOBA_BLOCK, D_HEADS, HEAD_DIM)
    vp = jnp.pad(v, ((0, 0), (0, pad), (0, 0), (0, 0))).reshape(bsz, nb, MOBA_BLOCK, D_HEADS, HEAD_DIM)
    t = jnp.arange(s)
    own = t // MOBA_BLOCK
    kmean = jnp.mean(kp.astype(jnp.float32), axis=2).astype(q.dtype)
    gate = jnp.einsum('bshd,bnhd->bhsn', q, kmean)
    past = jnp.arange(nb)[None, :] < own[:, None]
    gate = jnp.where(past, gate.astype(jnp.float32), -jnp.inf)
    n_pick = min(MOBA_TOPK, nb)
    gval, gidx = lax.top_k(gate, n_pick)
    own_idx = jnp.broadcast_to(own[None, None, :, None], (bsz, D_HEADS, s, 1)).astype(gidx.dtype)
    idx = jnp.concatenate([gidx, own_idx], axis=-1)
    valid = jnp.concatenate([jnp.isfinite(gval), jnp.ones(own_idx.shape, dtype=bool)], axis=-1)
    n_sel = n_pick + 1
    kblk = kp.transpose(0, 3, 1, 2, 4).reshape(bsz, D_HEADS, nb, MOBA_BLOCK * HEAD_DIM)
    vblk = vp.transpose(0, 3, 1, 2, 4).reshape(bsz, D_HEADS, nb, MOBA_BLOCK * HEAD_DIM)
    nq = s // MOBA_QCHUNK
    q_ch = jnp.moveaxis(q.reshape(bsz, nq, MOBA_QCHUNK, D_HEADS, HEAD_DIM), 1, 0)
    idx_ch = jnp.moveaxis(idx.reshape(bsz, D_HEADS, nq, MOBA_QCHUNK, n_sel), 2, 0)
    val_ch = jnp.moveaxis(valid.reshape(bsz, D_HEADS, nq, MOBA_QCHUNK, n_sel), 2, 0)
    t_ch = t.reshape(nq, MOBA_QCHUNK)

    def moba_chunk(args):
        qc, ic, vc, tc = args
        flat = ic.reshape(bsz, D_HEADS, MOBA_QCHUNK * n_sel, 1)
        shp = (bsz, D_HEADS, MOBA_QCHUNK, n_sel, MOBA_BLOCK, HEAD_DIM)
        kg = jnp.take_along_axis(kblk, flat, axis=2).reshape(shp)
        vg = jnp.take_along_axis(vblk, flat, axis=2).reshape(shp)
        sc = jnp.einsum('bqhd,bhqnkd->bhqnk', qc, kg) * scale
        kpos = ic[..., None] * MOBA_BLOCK + jnp.arange(MOBA_BLOCK)
        mask = vc[..., None] & (kpos <= tc[:, None, None])
        p = masked_softmax(sc, mask, (-2, -1))
        return jnp.einsum('bhqnk,bhqnkd->bqhd', p.astype(vg.dtype), vg)

    o = jnp.moveaxis(lax.map(moba_chunk, (q_ch, idx_ch, val_ch, t_ch)), 0, 1).reshape(bsz, s, D_WIDTH)
    return o @ w_out


def peer_ffn(h, wq, subkeys, u, v):
    bsz, s, d = h.shape
    hf = h.reshape(bsz * s, d)
    q = (hf @ wq).reshape(-1, PEER_HEADS, 2, PEER_QDIM // 2)
    qf = q.astype(jnp.float32)
    q = (qf * lax.rsqrt(jnp.mean(qf * qf, axis=-1, keepdims=True) + NORM_EPS)).astype(h.dtype)
    sc = jnp.einsum('thpd,hpnd->thpn', q, subkeys).astype(jnp.float32)
    v1, i1 = lax.top_k(sc[:, :, 0], PEER_TOPK)
    v2, i2 = lax.top_k(sc[:, :, 1], PEER_TOPK)
    cand = (v1[..., :, None] + v2[..., None, :]).reshape(-1, PEER_HEADS, PEER_TOPK * PEER_TOPK)
    top, ci = lax.top_k(cand, PEER_TOPK)
    expert = jnp.take_along_axis(i1, ci // PEER_TOPK, axis=-1) * PEER_NKEYS + jnp.take_along_axis(i2, ci % PEER_TOPK, axis=-1)
    g = jax.nn.softmax(top, axis=-1)
    nch = hf.shape[0] // PEER_TCHUNK

    def peer_chunk(args):
        hc, ec, gc = args
        ue = jnp.take(u, ec, axis=0)
        act = jax.nn.gelu(jnp.einsum('td,thkd->thk', hc, ue), approximate=False)
        w = (gc * act).astype(v.dtype)
        return jnp.einsum('thk,thkd->td', w, jnp.take(v, ec, axis=0))

    out = lax.map(peer_chunk, (hf.reshape(nch, PEER_TCHUNK, d), expert.reshape(nch, PEER_TCHUNK, PEER_HEADS, PEER_TOPK), g.reshape(nch, PEER_TCHUNK, PEER_HEADS, PEER_TOPK)))
    return out.reshape(bsz, s, d)


def setup_inputs(seed: int = 0) -> dict:
    key = jax.random.key(seed)
    ks = jax.random.split(key, 32)

    def nrm(k, shape, scale):
        return scale * jax.random.normal(k, shape, jnp.float32)

    L = DEPTH
    return {
        'x': nrm(ks[0], (BATCH, SEQ, D_MODEL), 1.0),
        'c': nrm(ks[1], (BATCH, D_MODEL), 1.0),
        'positions': jax.random.randint(ks[2], (BATCH, 1), 0, 4096, dtype=jnp.int32) + jnp.arange(SEQ, dtype=jnp.int32)[None, :],
        'mod_w': nrm(ks[3], (L, D_MODEL, 6 * D_MODEL), 0.5 * D_MODEL ** -0.5),
        'mod_b': nrm(ks[4], (L, 6 * D_MODEL), 0.02),
        'norm_mix_g': 1.0 + nrm(ks[5], (L, D_MODEL), 0.05),
        'norm_ffn_g': 1.0 + nrm(ks[6], (L, D_MODEL), 0.05),
        'w_in': nrm(ks[7], (L, D_MODEL, IN_COLS), D_MODEL ** -0.5),
        'a_conv_w': nrm(ks[8], (L, A_CONV, A_WIDTH), A_CONV ** -0.5),
        'a_out': nrm(ks[9], (L, A_WIDTH, D_MODEL), A_WIDTH ** -0.5),
        'b_conv_w': nrm(ks[10], (L, B_CONV, B_WIDTH), B_CONV ** -0.5),
        'b_conv_b': nrm(ks[11], (L, B_WIDTH), 0.02),
        'b_ln_g': 1.0 + nrm(ks[12], (L, B_WIDTH), 0.05),
        'b_ln_b': nrm(ks[13], (L, B_WIDTH), 0.02),
        'b_out': nrm(ks[14], (L, B_WIDTH, D_MODEL), B_WIDTH ** -0.5),
        'c_cmp_pos': nrm(ks[15], (L, 2, CMP_BLOCK, HEAD_DIM), 0.1),
        'c_cmp_w1': nrm(ks[16], (L, 2, CMP_BLOCK * HEAD_DIM, CMP_HIDDEN), (CMP_BLOCK * HEAD_DIM) ** -0.5),
        'c_cmp_w2': nrm(ks[17], (L, 2, CMP_HIDDEN, HEAD_DIM), CMP_HIDDEN ** -0.5),
        'c_out': nrm(ks[18], (L, C_WIDTH, D_MODEL), C_WIDTH ** -0.5),
        'd_out': nrm(ks[19], (L, D_WIDTH, D_MODEL), D_WIDTH ** -0.5),
        'w_o': nrm(ks[20], (L, D_MODEL, D_MODEL), D_MODEL ** -0.5),
        'peer_wq': nrm(ks[21], (L, D_MODEL, PEER_HEADS * PEER_QDIM), D_MODEL ** -0.5),
        'peer_subkeys': nrm(ks[22], (L, PEER_HEADS, 2, PEER_NKEYS, PEER_QDIM // 2), (PEER_QDIM // 2) ** -0.5),
        'peer_u': nrm(ks[23], (L, PEER_EXPERTS, D_MODEL), D_MODEL ** -0.5),
        'peer_v': nrm(ks[24], (L, PEER_EXPERTS, D_MODEL), PEER_HEADS ** -0.5),
        'final_norm_g': 1.0 + nrm(ks[25], (D_MODEL,), 0.05),
    }


def reference(x, c, positions, mod_w, mod_b, norm_mix_g, norm_ffn_g, w_in, a_conv_w, a_out, b_conv_w, b_conv_b, b_ln_g, b_ln_b, b_out, c_cmp_pos, c_cmp_w1, c_cmp_w2, c_out, d_out, w_o, peer_wq, peer_subkeys, peer_u, peer_v, final_norm_g):
    bsz, s, d = x.shape
    cos, sin = rope_tables(positions)
    cond = jax.nn.silu(c)
    for l in range(DEPTH):
        mod = (cond @ mod_w[l] + mod_b[l])[:, None, :]
        sh1, sc1, gt1, sh2, sc2, gt2 = jnp.split(mod, 6, axis=-1)
        h = rms_norm(x, norm_mix_g[l]) * (1 + sc1) + sh1
        (a_b, a_c, a_x, b_a, b_g, c_q, c_kc, c_vc, c_ks, c_vs, c_kw, c_vw, c_gate, d_q, d_k, d_v, merge) = jnp.split(h @ w_in[l], IN_SPLITS, axis=-1)
        y_a = short_conv_mixer(a_b, a_c, a_x, a_conv_w[l], a_out[l])
        y_b = conformer_conv_module(b_a, b_g, b_conv_w[l], b_conv_b[l], b_ln_g[l], b_ln_b[l], b_out[l])
        y_c = nsa_attention(c_q, c_kc, c_vc, c_ks, c_vs, c_kw, c_vw, c_gate, c_cmp_pos[l], c_cmp_w1[l], c_cmp_w2[l], cos, sin, c_out[l])
        y_d = moba_attention(d_q, d_k, d_v, cos, sin, d_out[l])
        gates = jax.nn.sigmoid(merge).reshape(bsz, s, N_BRANCH, d)
        merged = gates[:, :, 0] * y_a + gates[:, :, 1] * y_b + gates[:, :, 2] * y_c + gates[:, :, 3] * y_d
        x = x + gt1 * (merged @ w_o[l])
        h2 = rms_norm(x, norm_ffn_g[l]) * (1 + sc2) + sh2
        x = x + gt2 * peer_ffn(h2, peer_wq[l], peer_subkeys[l], peer_u[l], peer_v[l])
    return rms_norm(x, final_norm_g)
```

```cpp
#include <hip/hip_runtime.h>
#include <hip/hip_bf16.h>
#include <cstdio>
#include <cstdint>
#include <cmath>

#ifndef MK_PER_PHASE
#define MK_PER_PHASE 1
#endif

#define GAS __attribute__((address_space(1)))
#define LAS __attribute__((address_space(3)))
typedef unsigned short bf16;
typedef unsigned v4u __attribute__((ext_vector_type(4)));
typedef unsigned v2u __attribute__((ext_vector_type(2)));
typedef float f32x4 __attribute__((ext_vector_type(4)));
typedef float f32x2 __attribute__((ext_vector_type(2)));
typedef float f32x16 __attribute__((ext_vector_type(16)));
typedef short bf16x8 __attribute__((ext_vector_type(8)));
typedef short s16x4 __attribute__((ext_vector_type(4)));
typedef __bf16 bf16x2_t __attribute__((ext_vector_type(2)));

constexpr int BATCH = 8, SEQ = 2048, DM = 1024, DEPTH = 2, TOK = BATCH * SEQ;
constexpr int NP1 = 5632;
constexpr int NGT = 4096;
constexpr int NWIN = NP1 + NGT;
constexpr int C_AB = 0, C_AC = 512, C_AX = 1024, C_BA = 1536, C_BG = 2048, C_CQ = 2560, C_KC = 3072, C_VC = 3200, C_KS = 3328, C_VS = 3456, C_KW = 3584, C_VW = 3712,
              C_DQ = 3840, C_DK = 4352, C_DV = 4864, C_CG = 5376;
constexpr float NORM_EPS = 1e-6f;
constexpr float QSCALE = 0.125f * 1.4426950408889634f;

constexpr size_t MiB = 1u << 20;
constexpr size_t WS_CTL = 0, CTL_ZERO_BYTES = 64 * 1024;
constexpr size_t WS_MOD = 1 * MiB;
constexpr size_t WS_COS = 2 * MiB, WS_SIN = 4 * MiB;
constexpr size_t WS_SMALL = 6 * MiB;
constexpr size_t SM_KMEAN = 704 * 1024;
constexpr size_t SM_KCMP = 64 * 1024;
constexpr size_t SM_VCMP = 320 * 1024;
constexpr size_t SM_PBP = 576 * 1024;
constexpr size_t SM_W2T = 640 * 1024;
constexpr size_t WS_EIDX = 8 * MiB;
constexpr size_t WS_EW = 16 * MiB;
constexpr size_t WS_WIN = 24 * MiB;
constexpr size_t WS_WOUT = 62 * MiB;
constexpr size_t WS_WO = 70 * MiB;
constexpr size_t WS_WQ = 74 * MiB;
constexpr size_t WS_W1T = 82 * MiB;
constexpr size_t WS_SUBK = 84 * MiB;
constexpr size_t WS_HN = 86 * MiB;
constexpr size_t WS_MIX = 118 * MiB;
constexpr size_t WS_BIG = 182 * MiB;
constexpr size_t WS_END = 358 * MiB;

constexpr int LDS_BYTES = 147456;
constexpr int RING_BYTES = 131072;
constexpr int MISC_OFF = LDS_BYTES - 256;

#define RLX_AGENT __ATOMIC_RELAXED, __HIP_MEMORY_SCOPE_AGENT
#define LDS_WAIT() asm volatile("s_waitcnt lgkmcnt(0)" ::: "memory")
#define VM_WAIT() asm volatile("s_waitcnt vmcnt(0)" ::: "memory")
__device__ __forceinline__ unsigned f2bf(float f) { unsigned u = __builtin_bit_cast(unsigned, f); return (u + 0x7fffu + ((u >> 16) & 1u)) >> 16; }
__device__ __forceinline__ float bf2f(unsigned h) { return __builtin_bit_cast(float, h << 16); }
__device__ __forceinline__ unsigned pk2(float lo, float hi) { f32x2 v = {lo, hi}; bf16x2_t b = __builtin_convertvector(v, bf16x2_t); return __builtin_bit_cast(unsigned, b); }
__device__ __forceinline__ float bflo(unsigned w) { return __builtin_bit_cast(float, w << 16); }
__device__ __forceinline__ float bfhi(unsigned w) { return __builtin_bit_cast(float, w & 0xffff0000u); }
__device__ __forceinline__ float sigmoidf_(float x) { return 1.0f / (1.0f + __expf(-x)); }
__device__ __forceinline__ float gelu_erf(float x) { return 0.5f * x * (1.0f + erff(x * 0.70710678118654752f)); }
__device__ __forceinline__ float shx(float v, int m, int lane) { return __builtin_bit_cast(float, __builtin_amdgcn_ds_bpermute((lane ^ m) << 2, __builtin_bit_cast(int, v))); }
__device__ __forceinline__ unsigned shxu(unsigned v, int m, int lane) { return (unsigned)__builtin_amdgcn_ds_bpermute((lane ^ m) << 2, (int)v); }
__device__ __forceinline__ void swap32(unsigned v, unsigned& r0, unsigned& r1) { unsigned b = v; asm volatile("" : "+v"(b)); auto r = __builtin_amdgcn_permlane32_swap(v, b, false, false); r0 = r[0]; r1 = r[1]; }
__device__ __forceinline__ float other32(float v, int hi) { unsigned r0, r1; swap32(__builtin_bit_cast(unsigned, v), r0, r1); return __builtin_bit_cast(float, hi ? r0 : r1); }
__device__ __forceinline__ float add32(float v) { unsigned r0, r1; swap32(__builtin_bit_cast(unsigned, v), r0, r1); return __builtin_bit_cast(float, r0) + __builtin_bit_cast(float, r1); }
__device__ __forceinline__ float max32(float v) { unsigned r0, r1; swap32(__builtin_bit_cast(unsigned, v), r0, r1); return fmaxf(__builtin_bit_cast(float, r0), __builtin_bit_cast(float, r1)); }
__device__ __forceinline__ unsigned umax32(unsigned v) { unsigned r0, r1; swap32(v, r0, r1); return r0 > r1 ? r0 : r1; }
__device__ __forceinline__ float wave_sum(float v, int lane) {
#pragma unroll
    for (int o = 1; o < 32; o <<= 1) v += shx(v, o, lane);
    return add32(v);
}
namespace pg8 {
#define PG8_LAS __attribute__((address_space(3)))
typedef unsigned short bf16_t;
typedef short bf16x8 __attribute__((ext_vector_type(8)));
typedef float f32x4 __attribute__((ext_vector_type(4)));
typedef unsigned u32x4 __attribute__((ext_vector_type(4)));
constexpr int BM = 256, BK = 64, HALF = 128, HTB = HALF * BK * 2  , STAGE_BYTES = 8 * HTB, NXCD = 8, WGM = 8;

__host__ __device__ __forceinline__ int lds_byte(int r, int c) { const int st = (r >> 4) * 2 + (c >> 5), rr = r & 15, cc = c & 31, ob = rr * 64 + cc * 2; return st * 1024 + (ob ^ (((ob >> 9) & 1) << 5)); }
__host__ __device__ __forceinline__ void stage_rc(int b, int& R, int& C) { const int st = b / 1024, sb = b % 1024, swz = sb ^ (((sb >> 9) & 1) << 5); R = (st >> 1) * 16 + swz / 64; C = (st & 1) * 32 + (swz % 64) / 2; }
__host__ __device__ __forceinline__ int perm32(int rho) { const int n = rho >> 4, i = rho & 15; return 8 * (i >> 2) + 4 * n + (i & 3); }

struct Unit { int pm, pn; };
struct Gemm { const bf16_t* A; const bf16_t* Bt; int M, N, K; };

struct StaticOrder {
    int nM, nN, nwg, G, c;
    __host__ __device__ void init(int M, int N, int G_, int c_) { nM = M / BM; nN = N / BM; nwg = nM * nN; G = G_; c = c_; }
    __host__ __device__ bool next(int i, Unit& u) const {
        const long L = (long)i * G + c; if (L >= nwg) return false;
        int wgid = (int)L; { const int q = nwg / NXCD, r = nwg % NXCD, xcd = wgid % NXCD, off = wgid / NXCD; wgid = (xcd < r ? xcd * (q + 1) : r * (q + 1) + (xcd - r) * q) + off; }
        const int nig = WGM * nN, gid = wgid / nig, fm = gid * WGM, gsz = (nM - fm) < WGM ? (nM - fm) : WGM;
        u.pm = fm + ((wgid % nig) % gsz); u.pn = (wgid % nig) / gsz; return true;
    }
    __device__ __forceinline__ void a_ready(const Unit&) const {}
    __device__ __forceinline__ void done(const Unit&) const {}
};

__device__ __forceinline__ unsigned cvt_pk_bf16(float lo, float hi) { unsigned r; asm volatile("v_cvt_pk_bf16_f32 %0, %1, %2" : "=v"(r) : "v"(lo), "v"(hi)); return r; }
typedef float f32x2 __attribute__((ext_vector_type(2)));
template <class Epi, class Sched, bool ALIGN_EPI = false, bool SP2 = false>
__device__ __forceinline__ void gemm_phase(PG8_LAS unsigned char* lds, const Gemm g, const Sched& S, const Epi& E, const int tid) {
    const int wid = __builtin_amdgcn_readfirstlane(tid >> 6), lane = tid & 63, wr = wid >> 2, wc = wid & 3, fr = lane & 15, fq = lane >> 4;
    const int K = g.K, nt = K / BK;
    unsigned voffA[2], voffB[2];
#pragma unroll
    for (int i = 0; i < 2; ++i) { int R, C; stage_rc(tid * 16 + i * 8192, R, C); const int Rb = Epi::PERM ? ((R & ~31) + perm32(R & 31)) : R;
        voffA[i] = (unsigned)(R * K + C) * 2u; voffB[i] = (unsigned)(Rb * K + C) * 2u; }
    const size_t kstep = (size_t)(BK * 2);
    const size_t hstep = (size_t)HALF * K * 2;
    const size_t tstep = 2 * hstep;
    const unsigned ldsw = (unsigned)wid * 1024u;
    const int aoff = lds_byte(wr * 64 + fr, fq * 8), boff = lds_byte(wc * 32 + fr, fq * 8);
#define PG8_SA(b, h) (((b) * 2 + (h)) * HTB)
#define PG8_SB(b, h) ((4 + (b) * 2 + (h)) * HTB)
#define PG8_STAGE(bufoff, gbase, voff) do { _Pragma("unroll") for (int _i = 0; _i < 2; ++_i) \
        __builtin_amdgcn_global_load_lds((const unsigned*)((const char*)(gbase) + (voff)[_i]), (PG8_LAS unsigned*)(lds + (bufoff) + ldsw + _i * 8192), 16, 0, 0); } while (0)
#define PG8_LDA(dst, b, h) do { _Pragma("unroll") for (int m = 0; m < 4; ++m) _Pragma("unroll") for (int k = 0; k < 2; ++k) dst[m][k] = *(const PG8_LAS bf16x8*)(lds + PG8_SA(b, h) + aoff + m * 2048 + k * 1024); } while (0)
#define PG8_LDB(dst, b, h) do { _Pragma("unroll") for (int n = 0; n < 2; ++n) _Pragma("unroll") for (int k = 0; k < 2; ++k) dst[n][k] = *(const PG8_LAS bf16x8*)(lds + PG8_SB(b, h) + boff + n * 2048 + k * 1024); } while (0)
#define PG8_MMA(ai, bj, At, Bt) do { __builtin_amdgcn_s_setprio(1); _Pragma("unroll") for (int m = 0; m < 4; ++m) _Pragma("unroll") for (int n = 0; n < 2; ++n) _Pragma("unroll") for (int k = 0; k < 2; ++k) \
        acc[ai][bj][m][n] = __builtin_amdgcn_mfma_f32_16x16x32_bf16(Bt[n][k], At[m][k], acc[ai][bj][m][n], 0, 0, 0); __builtin_amdgcn_s_setprio(0); } while (0)
#define PG8_WAIT_V(n) asm volatile("s_waitcnt vmcnt(" #n ")" ::: "memory")
#define PG8_WAIT_L(n) asm volatile("s_waitcnt lgkmcnt(" #n ")" ::: "memory")
#define PG8_BAR __builtin_amdgcn_s_barrier()
#define PG8_SCHED __builtin_amdgcn_sched_barrier(0)
    Unit cur, nxt; int ui = 0;
    if (!S.next(0, cur)) return;
    f32x4 acc[2][2][4][2];
#pragma unroll
    for (int a = 0; a < 2; ++a)
#pragma unroll
        for (int b = 0; b < 2; ++b)
#pragma unroll
            for (int m = 0; m < 4; ++m)
#pragma unroll
                for (int n = 0; n < 2; ++n) acc[a][b][m][n] = (f32x4){0.f, 0.f, 0.f, 0.f};
    bf16x8 At[4][2], B0[2][2], B1[2][2];
    const char* cA = (const char*)g.A + (size_t)cur.pm * tstep; const char* cB = (const char*)g.Bt + (size_t)cur.pn * tstep;
    S.a_ready(cur);
    if constexpr (SP2) {
        PG8_STAGE(PG8_SB(0, 0), cB, voffB); PG8_STAGE(PG8_SB(0, 1), cB + hstep, voffB); PG8_STAGE(PG8_SA(0, 0), cA, voffA); PG8_STAGE(PG8_SA(0, 1), cA + hstep, voffA);
        if (wr == 1) PG8_BAR;
        PG8_WAIT_V(2); PG8_BAR;
        PG8_STAGE(PG8_SB(1, 0), cB + kstep, voffB); PG8_STAGE(PG8_SA(1, 0), cA + kstep, voffA); PG8_STAGE(PG8_SB(1, 1), cB + hstep + kstep, voffB);
        PG8_WAIT_V(6); PG8_BAR;
    } else {
        PG8_STAGE(PG8_SB(0, 0), cB, voffB); PG8_STAGE(PG8_SA(0, 0), cA, voffA); PG8_STAGE(PG8_SB(0, 1), cB + hstep, voffB); PG8_STAGE(PG8_SA(0, 1), cA + hstep, voffA);
        if (wr == 1) PG8_BAR;
        PG8_WAIT_V(4); PG8_BAR;
        PG8_STAGE(PG8_SB(1, 0), cB + kstep, voffB); PG8_STAGE(PG8_SA(1, 0), cA + kstep, voffA); PG8_STAGE(PG8_SB(1, 1), cB + hstep + kstep, voffB);
        PG8_WAIT_V(6); PG8_BAR;
    }
    for (;;) {
        const bool has_next = S.next(ui + 1, nxt);
        const char* nA = has_next ? (const char*)g.A + (size_t)nxt.pm * tstep : cA; const char* nB = has_next ? (const char*)g.Bt + (size_t)nxt.pn * tstep : cB;
        for (int t = 0; t < nt; t += 2) {
            const bool last = (t == nt - 2);
            const char* a1 = cA + (size_t)(t + 1) * kstep;
            const char* a2 = last ? nA : cA + (size_t)(t + 2) * kstep; const char* b2 = last ? nB : cB + (size_t)(t + 2) * kstep;
            const char* a3 = a2 + kstep; const char* b3 = b2 + kstep;
            if (last && has_next) S.a_ready(nxt);
            if constexpr (SP2) {
            PG8_LDB(B0, 0, 0); PG8_LDB(B1, 0, 1); PG8_SCHED; PG8_LDA(At, 0, 0); PG8_STAGE(PG8_SA(1, 1), a1 + hstep, voffA);
            PG8_WAIT_V(8); PG8_WAIT_L(0); PG8_BAR; PG8_MMA(0, 0, At, B0); PG8_MMA(0, 1, At, B1); PG8_BAR; PG8_SCHED;
            PG8_LDA(At, 0, 1); PG8_STAGE(PG8_SB(0, 0), b2, voffB); PG8_STAGE(PG8_SB(0, 1), b2 + hstep, voffB); PG8_STAGE(PG8_SA(0, 0), a2, voffA);
            PG8_WAIT_V(8); PG8_WAIT_L(0); PG8_BAR; PG8_MMA(1, 0, At, B0); PG8_MMA(1, 1, At, B1); PG8_BAR; PG8_SCHED;
            PG8_LDB(B0, 1, 0); PG8_LDB(B1, 1, 1); PG8_SCHED; PG8_LDA(At, 1, 0); PG8_STAGE(PG8_SA(0, 1), a2 + hstep, voffA);
            PG8_WAIT_V(8); PG8_WAIT_L(0); PG8_BAR; PG8_MMA(0, 0, At, B0); PG8_MMA(0, 1, At, B1); PG8_BAR; PG8_SCHED;
            PG8_LDA(At, 1, 1); PG8_STAGE(PG8_SB(1, 0), b3, voffB); PG8_STAGE(PG8_SB(1, 1), b3 + hstep, voffB); PG8_STAGE(PG8_SA(1, 0), a3, voffA);
            PG8_WAIT_V(8); PG8_WAIT_L(0); PG8_BAR; PG8_MMA(1, 0, At, B0); PG8_MMA(1, 1, At, B1); PG8_BAR; PG8_SCHED;
            } else {
            PG8_LDB(B0, 0, 0); PG8_SCHED; PG8_LDA(At, 0, 0); PG8_STAGE(PG8_SA(1, 1), a1 + hstep, voffA);
            PG8_WAIT_L(8); PG8_BAR; PG8_WAIT_L(0); PG8_MMA(0, 0, At, B0); PG8_BAR; PG8_SCHED;
            PG8_LDB(B1, 0, 1); PG8_STAGE(PG8_SB(0, 0), b2, voffB);
            PG8_BAR; PG8_WAIT_L(0); PG8_MMA(0, 1, At, B1); PG8_BAR;
            PG8_LDA(At, 0, 1); PG8_STAGE(PG8_SA(0, 0), a2, voffA);
            PG8_BAR; PG8_WAIT_L(0); PG8_MMA(1, 0, At, B0); PG8_BAR; PG8_SCHED;
            PG8_STAGE(PG8_SB(0, 1), b2 + hstep, voffB);
            PG8_WAIT_V(6); PG8_BAR; PG8_MMA(1, 1, At, B1); PG8_BAR;
            PG8_LDB(B0, 1, 0); PG8_SCHED; PG8_LDA(At, 1, 0); PG8_STAGE(PG8_SA(0, 1), a2 + hstep, voffA);
            PG8_WAIT_L(8); PG8_BAR; PG8_WAIT_L(0); PG8_MMA(0, 0, At, B0); PG8_BAR; PG8_SCHED;
            PG8_LDB(B1, 1, 1); PG8_STAGE(PG8_SB(1, 0), b3, voffB);
            PG8_BAR; PG8_WAIT_L(0); PG8_MMA(0, 1, At, B1); PG8_BAR;
            PG8_LDA(At, 1, 1); PG8_STAGE(PG8_SA(1, 0), a3, voffA);
            PG8_BAR; PG8_WAIT_L(0); PG8_MMA(1, 0, At, B0); PG8_BAR; PG8_SCHED;
            PG8_STAGE(PG8_SB(1, 1), b3 + hstep, voffB);
            PG8_WAIT_V(6); PG8_BAR; PG8_MMA(1, 1, At, B1); PG8_BAR;
            }
        }
        if constexpr (ALIGN_EPI) { if (wr == 0) PG8_BAR; }
        if constexpr (!Epi::AFTER_DRAIN) { E(acc, cur, wr, wc, fr, fq); S.done(cur); }
        if (!has_next) break;
#pragma unroll
        for (int a = 0; a < 2; ++a)
#pragma unroll
            for (int b = 0; b < 2; ++b)
#pragma unroll
                for (int m = 0; m < 4; ++m)
#pragma unroll
                    for (int n = 0; n < 2; ++n) acc[a][b][m][n] = (f32x4){0.f, 0.f, 0.f, 0.f};
        cur = nxt; cA = nA; cB = nB; ++ui;
        if constexpr (ALIGN_EPI) { if (wr == 1) PG8_BAR; }
    }
    PG8_WAIT_V(0);
    if constexpr (!ALIGN_EPI) { if (wr == 0) PG8_BAR; }
    PG8_BAR;
    if constexpr (Epi::AFTER_DRAIN) { E.fused(acc, cur, wr, wc, fr, fq, lds, wid, lane); S.done(cur); }
#undef PG8_SA
#undef PG8_SB
#undef PG8_STAGE
#undef PG8_LDA
#undef PG8_LDB
#undef PG8_MMA
#undef PG8_WAIT_V
#undef PG8_WAIT_L
#undef PG8_BAR
#undef PG8_SCHED
}
}
#define XB_TMO      128
#define XB_XCNT(j)  (256  + 64 * (j))
#define XB_XSUB(j)  (1280 + 64 * (j))
#define XB_XGEN(j)  (2304 + 64 * (j))
#define XB_TOP      3328
#define XB_TOPGEN   3392
#define XCD_BAR_WORDS 3456
#define XB_SPIN_CAP (1u << 25)

__device__ __forceinline__ unsigned xb_ld(unsigned* p)              { return __hip_atomic_load(p, __ATOMIC_RELAXED, __HIP_MEMORY_SCOPE_AGENT); }
__device__ __forceinline__ unsigned xb_add(unsigned* p, unsigned v) { return __hip_atomic_fetch_add(p, v, __ATOMIC_RELAXED, __HIP_MEMORY_SCOPE_AGENT); }
__device__ __forceinline__ unsigned xb_xcc_id() { return (unsigned)__builtin_amdgcn_s_getreg((3 << 11) | 20) & 0xFu; }
#define XB_SPIN(cond, bar) do { unsigned _sp = 0; while (cond) { __builtin_amdgcn_s_sleep(1); \
    if ((++_sp & 255u) == 0u) { if (xb_ld(&(bar)[XB_TMO])) break; if (_sp > XB_SPIN_CAP) { atomicAdd(&(bar)[XB_TMO], 1u); break; } } } } while (0)

struct XcdBarrier {
    unsigned* bar; unsigned x;
    volatile LAS unsigned* st;
};

__device__ __forceinline__ XcdBarrier xcd_barrier_post(unsigned* bar, volatile LAS unsigned* st) {
    XcdBarrier b; b.bar = bar; b.x = xb_xcc_id(); b.st = st;
    if (threadIdx.x == 0) (void)xb_add(&bar[XB_XCNT(b.x)], 1u);
    return b;
}
__device__ __forceinline__ void xcd_barrier_complete(unsigned* bar, unsigned x, unsigned& nloc, unsigned& nx) {
    const unsigned G = gridDim.x * gridDim.y * gridDim.z;
    unsigned sum, cnt, mine, sp = 0u;
    for (;;) {
        sum = 0u; cnt = 0u; mine = 0u;
#pragma unroll
        for (unsigned j = 0; j < 16; ++j) { const unsigned c = xb_ld(&bar[XB_XCNT(j)]); sum += c; cnt += (c > 0u) ? 1u : 0u; mine = (j == x) ? c : mine; }
        if (sum == G) break;
        __builtin_amdgcn_s_sleep(1);
        if ((++sp & 255u) == 0u) { if (xb_ld(&bar[XB_TMO])) break; if (sp > XB_SPIN_CAP) { atomicAdd(&bar[XB_TMO], 1u); break; } }
    }
    nloc = mine > 0u ? mine : 1u; nx = cnt > 0u ? cnt : 1u;
}

__device__ __forceinline__ void xcd_barrier(const XcdBarrier& b) {
    asm volatile("s_waitcnt vmcnt(0)" ::: "memory");
    __syncthreads();
    if (threadIdx.x == 0) {
        unsigned* bar = b.bar;
        __builtin_amdgcn_s_waitcnt(0);
        unsigned nloc = b.st[0], nx = b.st[1];
        if (nloc == 0u) { xcd_barrier_complete(bar, b.x, nloc, nx); b.st[0] = nloc; b.st[1] = nx; }
        const unsigned old = xb_add(&bar[XB_XSUB(b.x)], 1u);
        const unsigned gen = old / nloc;
        if (old + 1u == (gen + 1u) * nloc) {
            __builtin_amdgcn_fence(__ATOMIC_RELEASE, "agent");
            asm volatile("s_waitcnt vmcnt(0)" ::: "memory");
            const unsigned og = xb_add(&bar[XB_TOP], 1u);
            const unsigned tg = og / nx;
            if (og + 1u == (tg + 1u) * nx) xb_add(&bar[XB_TOPGEN], 1u);
            else XB_SPIN(xb_ld(&bar[XB_TOPGEN]) == tg, bar);
            __builtin_amdgcn_fence(__ATOMIC_ACQUIRE, "agent");
            xb_add(&bar[XB_XGEN(b.x)], 1u);
            asm volatile("s_waitcnt vmcnt(0)" ::: "memory");
        } else {
            XB_SPIN(xb_ld(&bar[XB_XGEN(b.x)]) == gen, bar);
            __builtin_amdgcn_fence(__ATOMIC_ACQUIRE, "agent");
            asm volatile("s_waitcnt vmcnt(0)" ::: "memory");
        }
    }
    __syncthreads();
}

namespace epi {
using pg8::Unit; using pg8::BM; using pg8::HALF;
typedef const pg8::f32x4 (&AccRef)[2][2][4][2];

struct EpiProj1 {
    static constexpr bool PERM = false, AFTER_DRAIN = false;
    bf16* O; const float* cosT; const float* sinT;
    __device__ __forceinline__ void operator()(AccRef acc, const Unit& u, int wr, int wc, int fr, int fq) const {
        const int row0 = u.pm * BM + wr * 64 + fr, colw = u.pn * BM + wc * 32;
#pragma unroll
        for (int bj = 0; bj < 2; ++bj) {
            const int hb = (colw + bj * HALF) >> 6;
            const bool rope = (hb >= 40 && hb < 50) || (hb >= 52 && hb < 54) || (hb >= 56 && hb < 58) || (hb >= 60 && hb < 76);
            const bool isq = (hb >= 40 && hb < 48) || (hb >= 60 && hb < 68);
            const float qs = isq ? QSCALE : 1.0f;
            const int jw = (wc & 1) * 16 + fq * 2;
#pragma unroll
            for (int ai = 0; ai < 2; ++ai)
#pragma unroll
                for (int m = 0; m < 4; ++m) {
                    const int row = row0 + ai * HALF + m * 16;
                    bf16* rowp = O + (size_t)row * NP1 + colw + bj * HALF + 4 * fq;
#pragma unroll
                    for (int n = 0; n < 2; ++n) {
                        pg8::f32x4 v = acc[ai][bj][m][n];
                        if (rope) {
                            const f32x2 c = *(const f32x2*)(cosT + (size_t)row * 32 + jw + n * 8), s = *(const f32x2*)(sinT + (size_t)row * 32 + jw + n * 8);
                            const float y0 = v[0] * c.x - v[1] * s.x, y1 = v[1] * c.x + v[0] * s.x, y2 = v[2] * c.y - v[3] * s.y, y3 = v[3] * c.y + v[2] * s.y;
                            v[0] = y0 * qs; v[1] = y1 * qs; v[2] = y2 * qs; v[3] = y3 * qs;
                        }
                        v2u w; w.x = pk2(v[0], v[1]); w.y = pk2(v[2], v[3]);
                        *(v2u*)(rowp + n * 16) = w;
                    }
                }
        }
    }
};
template <int ACT> struct EpiStore {
    static constexpr bool PERM = false, AFTER_DRAIN = false;
    bf16* O; int ldc;
    __device__ __forceinline__ void operator()(AccRef acc, const Unit& u, int wr, int wc, int fr, int fq) const {
        const int row0 = u.pm * BM + wr * 64 + fr, col0 = u.pn * BM + wc * 32 + 4 * fq;
#pragma unroll
        for (int ai = 0; ai < 2; ++ai)
#pragma unroll
            for (int m = 0; m < 4; ++m) { bf16* rowp = O + (size_t)(row0 + ai * HALF + m * 16) * ldc + col0;
#pragma unroll
                for (int bj = 0; bj < 2; ++bj)
#pragma unroll
                    for (int n = 0; n < 2; ++n) { pg8::f32x4 v = acc[ai][bj][m][n];
                        if (ACT == 1) { v[0] = sigmoidf_(v[0]); v[1] = sigmoidf_(v[1]); v[2] = sigmoidf_(v[2]); v[3] = sigmoidf_(v[3]); }
                        v2u w; w.x = pk2(v[0], v[1]); w.y = pk2(v[2], v[3]); *(v2u*)(rowp + bj * HALF + n * 16) = w; } }
    }
};
struct EpiMerge {
    static constexpr bool PERM = false, AFTER_DRAIN = false;
    bf16* O; const bf16* G; int seg;
    __device__ __forceinline__ void operator()(AccRef acc, const Unit& u, int wr, int wc, int fr, int fq) const {
        const int row0 = u.pm * BM + wr * 64 + fr, col0 = u.pn * BM + wc * 32 + 4 * fq;
#pragma unroll
        for (int ai = 0; ai < 2; ++ai)
#pragma unroll
            for (int m = 0; m < 4; ++m) { const size_t row = (size_t)(row0 + ai * HALF + m * 16); bf16* rowp = O + row * DM + col0; const bf16* gp = G + row * NGT + seg * DM + col0;
#pragma unroll
                for (int bj = 0; bj < 2; ++bj)
#pragma unroll
                    for (int n = 0; n < 2; ++n) { pg8::f32x4 v = acc[ai][bj][m][n];
                        const v2u g = *(const v2u*)(gp + bj * HALF + n * 16);
                        v[0] *= bflo(g.x); v[1] *= bfhi(g.x); v[2] *= bflo(g.y); v[3] *= bfhi(g.y);
                        if (seg != 0) { const v2u o = *(const v2u*)(rowp + bj * HALF + n * 16); v[0] += bflo(o.x); v[1] += bfhi(o.x); v[2] += bflo(o.y); v[3] += bfhi(o.y); }
                        v2u w; w.x = pk2(v[0], v[1]); w.y = pk2(v[2], v[3]); *(v2u*)(rowp + bj * HALF + n * 16) = w; } }
    }
};
struct EpiResid {
    static constexpr bool PERM = false, AFTER_DRAIN = false;
    const float* XI; float* XO; const float* gate;
    __device__ __forceinline__ void operator()(AccRef acc, const Unit& u, int wr, int wc, int fr, int fq) const {
        const int row0 = u.pm * BM + wr * 64 + fr, col0 = u.pn * BM + wc * 32 + 4 * fq;
        const float* gb = gate + (size_t)((u.pm * BM) / SEQ) * 6144 + col0;
        pg8::f32x4 gv[2][2];
#pragma unroll
        for (int bj = 0; bj < 2; ++bj)
#pragma unroll
            for (int n = 0; n < 2; ++n) gv[bj][n] = *(const pg8::f32x4*)(gb + bj * HALF + n * 16);
#pragma unroll
        for (int ai = 0; ai < 2; ++ai)
#pragma unroll
            for (int m = 0; m < 4; ++m) { const size_t off = (size_t)(row0 + ai * HALF + m * 16) * DM + col0;
#pragma unroll
                for (int bj = 0; bj < 2; ++bj)
#pragma unroll
                    for (int n = 0; n < 2; ++n) { const pg8::f32x4 xi = *(const pg8::f32x4*)(XI + off + bj * HALF + n * 16);
                        *(pg8::f32x4*)(XO + off + bj * HALF + n * 16) = xi + gv[bj][n] * acc[ai][bj][m][n]; } }
    }
};
}

constexpr int NWAVES = 8, NTHR = 512;
struct Args { const void* in[26]; float* out; unsigned char* ws; int ph_lo, ph_hi; };
enum InIdx { I_X = 0, I_C, I_POS, I_MODW, I_MODB, I_NMG, I_NFG, I_WIN, I_ACW, I_AOUT, I_BCW, I_BCB, I_BLNG, I_BLNB, I_BOUT, I_CPOS, I_CW1, I_CW2, I_COUT, I_DOUT, I_WO, I_PWQ, I_PSUB, I_PU, I_PV, I_FNG };

struct Frame {
    LAS unsigned char* lds; unsigned char* ldsg;
    int tid, lane, wave, G, bid;
    unsigned char* ws;
};
__device__ __forceinline__ int gwave(const Frame& F) { return F.bid * NWAVES + F.wave; }
__device__ __forceinline__ int ngwave(const Frame& F) { return F.G * NWAVES; }

__device__ __forceinline__ int rope_pos_of_dim(int d) { return d < 32 ? 2 * d : 2 * (d - 32) + 1; }
__device__ __forceinline__ int rope_dim_of_pos(int p) { return (p >> 1) + 32 * (p & 1); }
__device__ __forceinline__ int win_row_of_col(int n) {
    if (n < 2560) return n;
    if (n < 3072) { const int c = n - 2560; return C_CQ + (c & ~63) + rope_pos_of_dim(c & 63); }
    if (n < 3200) { const int c = n - 3072; return C_KC + (c & ~63) + rope_pos_of_dim(c & 63); }
    if (n < 3328) return C_VC + (n - 3200);
    if (n < 3456) { const int c = n - 3328; return C_KS + (c & ~63) + rope_pos_of_dim(c & 63); }
    if (n < 3584) return C_VS + (n - 3456);
    if (n < 3712) { const int c = n - 3584; return C_KW + (c & ~63) + rope_pos_of_dim(c & 63); }
    if (n < 3840) return C_VW + (n - 3712);
    if (n < 3864) return C_CG + (n - 3840);
    if (n < 4376) { const int c = n - 3864; return C_DQ + (c & ~63) + rope_pos_of_dim(c & 63); }
    if (n < 4888) { const int c = n - 4376; return C_DK + (c & ~63) + rope_pos_of_dim(c & 63); }
    if (n < 5400) return C_DV + (n - 4888);
    return NP1 + (n - 5400);
}
template <int MODE, bool KPERM>
__device__ __forceinline__ void transpose_item(const float* W, int K, int N, bf16* WT, LAS float* scr, int item, int lane) {
    const int nblk = (N + 31) / 32, kb = item / nblk, nb = item % nblk, k0 = 64 * kb, n0 = 32 * nb;
    const int nsrc = n0 + (lane & 31); const bool nok = nsrc < N;
#pragma unroll 8
    for (int i = 0; i < 32; ++i) { const int kk = 2 * i + (lane >> 5); scr[kk * 33 + (lane & 31)] = nok ? W[(size_t)(k0 + kk) * N + nsrc] : 0.f; }
    LDS_WAIT(); asm volatile("" ::: "memory");
    const int c = lane & 7;
#pragma unroll
    for (int j = 0; j < 4; ++j) { const int n = (lane >> 3) + 8 * j;
        float s[8];
#pragma unroll
        for (int e = 0; e < 8; ++e) { const int p = 8 * c + e; const int ks = KPERM ? rope_dim_of_pos(p) : p; s[e] = scr[ks * 33 + n]; }
        v4u o; o.x = pk2(s[0], s[1]); o.y = pk2(s[2], s[3]); o.z = pk2(s[4], s[5]); o.w = pk2(s[6], s[7]);
        if (n0 + n < N) { const int row = (MODE == 1) ? win_row_of_col(n0 + n) : (n0 + n); *(v4u*)(WT + (size_t)row * K + k0 + 8 * c) = o; } }
    LDS_WAIT(); asm volatile("" ::: "memory");
}
template <int MODE, bool KPERM>
__device__ __forceinline__ void transpose_matrix(const Frame& F, const float* W, int K, int N, bf16* WT, int& base) {
    LAS float* scr = (LAS float*)(F.lds + F.wave * 16384);
    const int nitems = (K / 64) * ((N + 31) / 32), gw = gwave(F), NGW = ngwave(F);
    int first = (gw - base % NGW + NGW) % NGW;
    for (int it = first; it < nitems; it += NGW) transpose_item<MODE, KPERM>(W, K, N, WT, scr, it, F.lane);
    base += nitems;
}
__device__ __forceinline__ void convert_copy(const Frame& F, const float* src, bf16* dst, size_t n) {
    const size_t nth = (size_t)F.G * NTHR, t0 = (size_t)F.bid * NTHR + F.tid;
    for (size_t i = t0; i < n / 8; i += nth) { const f32x4 a = *(const f32x4*)(src + i * 8), b = *(const f32x4*)(src + i * 8 + 4);
        v4u o; o.x = pk2(a[0], a[1]); o.y = pk2(a[2], a[3]); o.z = pk2(b[0], b[1]); o.w = pk2(b[2], b[3]); *(v4u*)(dst + i * 8) = o; }
}

typedef __attribute__((address_space(4))) const Args* KArgsP;
__device__ __forceinline__ void phase_prologue(const Frame& F, KArgsP Ap) {
    unsigned char* ws = F.ws;
    int base = 0;
    for (int l = 0; l < DEPTH; ++l) {
        transpose_matrix<1, false>(F, (const float*)Ap->in[I_WIN] + (size_t)l * DM * 9496, DM, 9496, (bf16*)(ws + WS_WIN) + (size_t)l * NWIN * DM, base);
        transpose_matrix<0, false>(F, (const float*)Ap->in[I_AOUT] + (size_t)l * 512 * DM, 512, DM, (bf16*)(ws + WS_WOUT) + (size_t)(l * 4 + 0) * DM * 512, base);
        transpose_matrix<0, false>(F, (const float*)Ap->in[I_BOUT] + (size_t)l * 512 * DM, 512, DM, (bf16*)(ws + WS_WOUT) + (size_t)(l * 4 + 1) * DM * 512, base);
        transpose_matrix<0, false>(F, (const float*)Ap->in[I_COUT] + (size_t)l * 512 * DM, 512, DM, (bf16*)(ws + WS_WOUT) + (size_t)(l * 4 + 2) * DM * 512, base);
        transpose_matrix<0, false>(F, (const float*)Ap->in[I_DOUT] + (size_t)l * 512 * DM, 512, DM, (bf16*)(ws + WS_WOUT) + (size_t)(l * 4 + 3) * DM * 512, base);
        transpose_matrix<0, false>(F, (const float*)Ap->in[I_WO] + (size_t)l * DM * DM, DM, DM, (bf16*)(ws + WS_WO) + (size_t)l * DM * DM, base);
        transpose_matrix<0, false>(F, (const float*)Ap->in[I_PWQ] + (size_t)l * DM * 2048, DM, 2048, (bf16*)(ws + WS_WQ) + (size_t)l * 2048 * DM, base);
        transpose_matrix<0, true>(F, (const float*)Ap->in[I_CW1] + (size_t)(l * 2 + 0) * 2048 * 128, 2048, 128, (bf16*)(ws + WS_W1T) + (size_t)(l * 2 + 0) * 128 * 2048, base);
        transpose_matrix<0, false>(F, (const float*)Ap->in[I_CW1] + (size_t)(l * 2 + 1) * 2048 * 128, 2048, 128, (bf16*)(ws + WS_W1T) + (size_t)(l * 2 + 1) * 128 * 2048, base);
    }
    convert_copy(F, (const float*)Ap->in[I_PSUB], (bf16*)(ws + WS_SUBK), (size_t)DEPTH * 8 * 2 * 128 * 128);
    const int gt = F.bid * NTHR + F.tid, NGT_ = F.G * NTHR;
    { const float* w2 = (const float*)Ap->in[I_CW2]; bf16* w2t = (bf16*)(ws + WS_SMALL + SM_W2T);
      for (int i = gt; i < DEPTH * 2 * 64 * 128; i += NGT_) { const int k = i & 127, n = (i >> 7) & 63, lw = i >> 13; w2t[i] = (bf16)f2bf(w2[((size_t)lw * 128 + k) * 64 + n]); } }
    { const int* pos = (const int*)Ap->in[I_POS]; float* ct = (float*)(ws + WS_COS); float* st = (float*)(ws + WS_SIN);
      for (int i = gt; i < TOK * 32; i += NGT_) { const int t = i >> 5, j = i & 31;
          const float inv = 1.0f / powf(10000.0f, (float)(2 * j) / 64.0f); const float ang = (float)pos[t] * inv;
          ct[i] = (float)cos((double)ang); st[i] = (float)sin((double)ang); } }
    { const float* w1 = (const float*)Ap->in[I_CW1]; const float* cp = (const float*)Ap->in[I_CPOS]; float* pbp = (float*)(ws + WS_SMALL + SM_PBP);
      for (int i = gt; i < DEPTH * 2 * 16 * 128; i += NGT_) { const int n = i & 127, kc = (i >> 7) & 15, lw = i >> 11; float s = 0.f;
          for (int k = kc * 128; k < kc * 128 + 128; ++k) s += cp[(size_t)lw * 2048 + k] * w1[((size_t)lw * 2048 + k) * 128 + n];
          pbp[i] = s; } }
    __syncthreads();
    { LAS float* cond = (LAS float*)(F.lds);
      LAS float* red = (LAS float*)(F.lds + 32768);
      const float* c = (const float*)Ap->in[I_C];
      for (int i = F.tid; i < 8 * 1024; i += NTHR) { const float v = c[i]; cond[i] = v / (1.0f + __expf(-v)); }
      __syncthreads();
      for (int un = F.bid; un < DEPTH * 96; un += F.G) { const int l = un / 96, n0 = (un % 96) * 64;
          const float* mw = (const float*)Ap->in[I_MODW] + (size_t)l * DM * 6144 + n0 + F.lane;
          float acc[8];
#pragma unroll
          for (int b = 0; b < 8; ++b) acc[b] = 0.f;
#pragma unroll 4
          for (int k = F.wave * 128; k < F.wave * 128 + 128; ++k) { const float w = mw[(size_t)k * 6144];
#pragma unroll
              for (int b = 0; b < 8; ++b) acc[b] += cond[b * 1024 + k] * w; }
#pragma unroll
          for (int b = 0; b < 8; ++b) red[(F.wave * 8 + b) * 64 + F.lane] = acc[b];
          __syncthreads();
          { const int b = F.tid >> 6, n = F.tid & 63; float s = 0.f;
#pragma unroll
            for (int w = 0; w < 8; ++w) s += red[(w * 8 + b) * 64 + n];
            ((float*)(ws + WS_MOD))[((size_t)l * 8 + b) * 6144 + n0 + n] = s + ((const float*)Ap->in[I_MODB])[(size_t)l * 6144 + n0 + n]; }
          __syncthreads(); }
    }
}

__device__ __forceinline__ void phase_norm_mod(const Frame& F, const float* X, const float* g, const float* sh, const float* sc, bf16* O) {
    const int gw = gwave(F), NGW = ngwave(F);
    f32x4 gv[4];
#pragma unroll
    for (int j = 0; j < 4; ++j) gv[j] = *(const f32x4*)(g + 4 * F.lane + 256 * j);
    for (int row = gw; row < TOK; row += NGW) {
        const int b = row / SEQ; const float* xr = X + (size_t)row * DM + 4 * F.lane;
        f32x4 v[4]; float s = 0.f;
#pragma unroll
        for (int j = 0; j < 4; ++j) { v[j] = *(const f32x4*)(xr + 256 * j); s += (v[j][0] * v[j][0] + v[j][1] * v[j][1]) + (v[j][2] * v[j][2] + v[j][3] * v[j][3]); }
        const float r = 1.0f / sqrtf(wave_sum(s, F.lane) * (1.0f / DM) + NORM_EPS);
        bf16* orow = O + (size_t)row * DM + 4 * F.lane;
#pragma unroll
        for (int j = 0; j < 4; ++j) { const f32x4 scv = *(const f32x4*)(sc + (size_t)b * 6144 + 4 * F.lane + 256 * j), shv = *(const f32x4*)(sh + (size_t)b * 6144 + 4 * F.lane + 256 * j);
            const f32x4 y = v[j] * r * gv[j] * (scv + 1.0f) + shv; v2u w; w.x = pk2(y[0], y[1]); w.y = pk2(y[2], y[3]); *(v2u*)(orow + 256 * j) = w; }
    }
}
__device__ __forceinline__ void phase_final_norm(const Frame& F, const float* X, const float* g, float* O) {
    const int gw = gwave(F), NGW = ngwave(F);
    f32x4 gv[4];
#pragma unroll
    for (int j = 0; j < 4; ++j) gv[j] = *(const f32x4*)(g + 4 * F.lane + 256 * j);
    for (int row = gw; row < TOK; row += NGW) {
        const float* xr = X + (size_t)row * DM + 4 * F.lane; f32x4 v[4]; float s = 0.f;
#pragma unroll
        for (int j = 0; j < 4; ++j) { v[j] = *(const f32x4*)(xr + 256 * j); s += (v[j][0] * v[j][0] + v[j][1] * v[j][1]) + (v[j][2] * v[j][2] + v[j][3] * v[j][3]); }
        const float r = 1.0f / sqrtf(wave_sum(s, F.lane) * (1.0f / DM) + NORM_EPS);
        float* orow = O + (size_t)row * DM + 4 * F.lane;
#pragma unroll
        for (int j = 0; j < 4; ++j) *(f32x4*)(orow + 256 * j) = v[j] * r * gv[j];
    }
}

__device__ __forceinline__ void phase_mixer_a(const Frame& F, const bf16* P, const float* cw  , bf16* O  ) {
    const int nth = F.G * NTHR, gt = F.bid * NTHR + F.tid;
    for (int it = gt; it < (TOK / 32) * 64; it += nth) {
        const int cg = it & 63, tb = it >> 6, c0 = cg * 8, t0 = tb * 32, s0 = t0 % SEQ;
        float w0[8], w1[8], w2[8];
#pragma unroll
        for (int e = 0; e < 8; ++e) { w0[e] = cw[c0 + e]; w1[e] = cw[512 + c0 + e]; w2[e] = cw[1024 + c0 + e]; }
        float pm2[8], pm1[8];
#pragma unroll
        for (int e = 0; e < 8; ++e) { pm2[e] = 0.f; pm1[e] = 0.f; }
        for (int pre = 2; pre >= 1; --pre) if (s0 - pre >= 0) { const bf16* r = P + (size_t)(t0 - pre) * NP1;
            const v4u ac = *(const v4u*)(r + C_AC + c0), ax = *(const v4u*)(r + C_AX + c0);
            float pr[8]; pr[0] = bflo(ac.x) * bflo(ax.x); pr[1] = bfhi(ac.x) * bfhi(ax.x); pr[2] = bflo(ac.y) * bflo(ax.y); pr[3] = bfhi(ac.y) * bfhi(ax.y);
            pr[4] = bflo(ac.z) * bflo(ax.z); pr[5] = bfhi(ac.z) * bfhi(ax.z); pr[6] = bflo(ac.w) * bflo(ax.w); pr[7] = bfhi(ac.w) * bfhi(ax.w);
#pragma unroll
            for (int e = 0; e < 8; ++e) { if (pre == 2) pm2[e] = pr[e]; else pm1[e] = pr[e]; } }
        for (int tt = 0; tt < 32; ++tt) { const bf16* r = P + (size_t)(t0 + tt) * NP1;
            const v4u ac = *(const v4u*)(r + C_AC + c0), ax = *(const v4u*)(r + C_AX + c0), ab = *(const v4u*)(r + C_AB + c0);
            float pr[8], bb[8], y[8];
            pr[0] = bflo(ac.x) * bflo(ax.x); pr[1] = bfhi(ac.x) * bfhi(ax.x); pr[2] = bflo(ac.y) * bflo(ax.y); pr[3] = bfhi(ac.y) * bfhi(ax.y);
            pr[4] = bflo(ac.z) * bflo(ax.z); pr[5] = bfhi(ac.z) * bfhi(ax.z); pr[6] = bflo(ac.w) * bflo(ax.w); pr[7] = bfhi(ac.w) * bfhi(ax.w);
            bb[0] = bflo(ab.x); bb[1] = bfhi(ab.x); bb[2] = bflo(ab.y); bb[3] = bfhi(ab.y); bb[4] = bflo(ab.z); bb[5] = bfhi(ab.z); bb[6] = bflo(ab.w); bb[7] = bfhi(ab.w);
#pragma unroll
            for (int e = 0; e < 8; ++e) { y[e] = bb[e] * (w0[e] * pm2[e] + w1[e] * pm1[e] + w2[e] * pr[e]); pm2[e] = pm1[e]; pm1[e] = pr[e]; }
            v4u o; o.x = pk2(y[0], y[1]); o.y = pk2(y[2], y[3]); o.z = pk2(y[4], y[5]); o.w = pk2(y[6], y[7]);
            *(v4u*)(O + (size_t)(t0 + tt) * 512 + c0) = o; }
    }
}

__device__ __forceinline__ void phase_mixer_b(const Frame& F, const bf16* P, const float* cw  , const float* cb, const float* lg, const float* lb, bf16* O) {
    LAS float* U = (LAS float*)F.lds;
    for (int un = F.bid; un < TOK / 32; un += F.G) {
        const int t0 = un * 32, s0 = t0 % SEQ;
        __syncthreads();
        for (int i = F.tid; i < 62 * 64; i += NTHR) { const int r = i >> 6, cg = i & 63, c0 = cg * 8; const int srel = s0 - 30 + r;
            float u[8];
            if (srel >= 0) { const bf16* row = P + (size_t)(t0 - 30 + r) * NP1; const v4u a = *(const v4u*)(row + C_BA + c0), g = *(const v4u*)(row + C_BG + c0);
                u[0] = bflo(a.x) * sigmoidf_(bflo(g.x)); u[1] = bfhi(a.x) * sigmoidf_(bfhi(g.x)); u[2] = bflo(a.y) * sigmoidf_(bflo(g.y)); u[3] = bfhi(a.y) * sigmoidf_(bfhi(g.y));
                u[4] = bflo(a.z) * sigmoidf_(bflo(g.z)); u[5] = bfhi(a.z) * sigmoidf_(bfhi(g.z)); u[6] = bflo(a.w) * sigmoidf_(bflo(g.w)); u[7] = bfhi(a.w) * sigmoidf_(bfhi(g.w)); }
            else {
#pragma unroll
                for (int e = 0; e < 8; ++e) u[e] = 0.f; }
            *(LAS f32x4*)(U + r * 512 + c0) = (f32x4){u[0], u[1], u[2], u[3]}; *(LAS f32x4*)(U + r * 512 + c0 + 4) = (f32x4){u[4], u[5], u[6], u[7]}; }
        __syncthreads();
        const int c0 = F.lane * 8;
        float acc[4][8];
#pragma unroll
        for (int q = 0; q < 4; ++q)
#pragma unroll
            for (int e = 0; e < 8; ++e) acc[q][e] = cb[c0 + e];
        for (int k = 0; k < 31; ++k) { const f32x4 wa = *(const f32x4*)(cw + k * 512 + c0), wb = *(const f32x4*)(cw + k * 512 + c0 + 4);
#pragma unroll
            for (int q = 0; q < 4; ++q) { const int r = 4 * F.wave + q + k; const f32x4 ua = *(LAS f32x4*)(U + r * 512 + c0), ub = *(LAS f32x4*)(U + r * 512 + c0 + 4);
                acc[q][0] += wa[0] * ua[0]; acc[q][1] += wa[1] * ua[1]; acc[q][2] += wa[2] * ua[2]; acc[q][3] += wa[3] * ua[3];
                acc[q][4] += wb[0] * ub[0]; acc[q][5] += wb[1] * ub[1]; acc[q][6] += wb[2] * ub[2]; acc[q][7] += wb[3] * ub[3]; } }
        const f32x4 ga = *(const f32x4*)(lg + c0), gb = *(const f32x4*)(lg + c0 + 4), ba = *(const f32x4*)(lb + c0), bb = *(const f32x4*)(lb + c0 + 4);
#pragma unroll
        for (int q = 0; q < 4; ++q) { float s = 0.f;
#pragma unroll
            for (int e = 0; e < 8; ++e) s += acc[q][e];
            const float mu = wave_sum(s, F.lane) * (1.0f / 512.0f); float v = 0.f;
#pragma unroll
            for (int e = 0; e < 8; ++e) { acc[q][e] -= mu; v += acc[q][e] * acc[q][e]; }
            const float rs = 1.0f / sqrtf(wave_sum(v, F.lane) * (1.0f / 512.0f) + NORM_EPS);
            float y[8];
#pragma unroll
            for (int e = 0; e < 8; ++e) { const float gg = e < 4 ? ga[e] : gb[e - 4], bv = e < 4 ? ba[e] : bb[e - 4]; const float z = acc[q][e] * rs * gg + bv; y[e] = z / (1.0f + __expf(-z)); }
            v4u o; o.x = pk2(y[0], y[1]); o.y = pk2(y[2], y[3]); o.z = pk2(y[4], y[5]); o.w = pk2(y[6], y[7]);
            *(v4u*)(O + (size_t)(t0 + 4 * F.wave + q) * 512 + c0) = o; }
    }
}

__device__ __forceinline__ void phase_compress(const Frame& F, const bf16* P, const bf16* W1T  , const bf16* W2T  , const float* PBP  ,
                                               bf16* KC, bf16* VC  ) {
    LAS bf16* H1 = (LAS bf16*)(F.lds + F.wave * 8192);
    const int gw = gwave(F), NGW = ngwave(F), lane = F.lane, r16 = lane & 15, q4 = lane >> 4;
    for (int un = gw; un < 2 * 8 * 2 * 8; un += NGW) {
        const int nb = un & 7, g = (un >> 3) & 1, b = (un >> 4) & 7, which = un >> 7;
        const int n = nb * 16 + r16; const int nn = n < 127 ? n : 126;
        const int col0 = (which == 0 ? C_KC : C_VC) + g * 64;
        const bf16* arow = P + ((size_t)b * SEQ + nn * 16) * NP1 + col0;
        const bf16* w1 = W1T + (size_t)which * 128 * 2048;
        f32x4 acc[8];
#pragma unroll
        for (int j = 0; j < 8; ++j) acc[j] = (f32x4){0.f, 0.f, 0.f, 0.f};
        for (int ks = 0; ks < 64; ++ks) {
            const int k = ks * 32 + q4 * 8; const bf16x8 a = *(const bf16x8*)(arow + (size_t)(k >> 6) * NP1 + (k & 63));
#pragma unroll
            for (int j = 0; j < 8; ++j) { const bf16x8 bb = *(const bf16x8*)(w1 + (size_t)(j * 16 + r16) * 2048 + k);
                acc[j] = __builtin_amdgcn_mfma_f32_16x16x32_bf16(a, bb, acc[j], 0, 0, 0); } }
#pragma unroll
        for (int j = 0; j < 8; ++j) { float pb = 0.f;
#pragma unroll
            for (int kc = 0; kc < 16; ++kc) pb += PBP[((size_t)which * 16 + kc) * 128 + j * 16 + r16];
#pragma unroll
            for (int i = 0; i < 4; ++i) H1[(4 * q4 + i) * 136 + j * 16 + r16] = (bf16)f2bf(gelu_erf(acc[j][i] + pb)); }
        LDS_WAIT(); asm volatile("" ::: "memory");
        f32x4 o[4];
#pragma unroll
        for (int j = 0; j < 4; ++j) o[j] = (f32x4){0.f, 0.f, 0.f, 0.f};
        const bf16* w2 = W2T + (size_t)which * 64 * 128;
#pragma unroll
        for (int ks = 0; ks < 4; ++ks) { const bf16x8 a = *(LAS bf16x8*)(H1 + r16 * 136 + ks * 32 + q4 * 8);
#pragma unroll
            for (int j = 0; j < 4; ++j) { const bf16x8 bb = *(const bf16x8*)(w2 + (size_t)(j * 16 + r16) * 128 + ks * 32 + q4 * 8);
                o[j] = __builtin_amdgcn_mfma_f32_16x16x32_bf16(a, bb, o[j], 0, 0, 0); } }
        bf16* out = (which == 0 ? KC : VC) + ((size_t)(b * 2 + g) * 128) * 64;
#pragma unroll
        for (int j = 0; j < 4; ++j)
#pragma unroll
            for (int i = 0; i < 4; ++i) { const int row = nb * 16 + 4 * q4 + i; out[(size_t)row * 64 + j * 16 + r16] = row < 127 ? (bf16)f2bf(o[j][i]) : (bf16)0; }
        LDS_WAIT(); asm volatile("" ::: "memory");
    }
}
__device__ __forceinline__ void phase_kmean(const Frame& F, const bf16* P, float* KM) {
    const int gw = gwave(F), NGW = ngwave(F), lane = F.lane, rs = lane >> 3, ch = lane & 7;
    for (int un = gw; un < 8 * 8 * 8; un += NGW) { const int h = un & 7, blk = (un >> 3) & 7, b = un >> 6;
        const bf16* base = P + ((size_t)b * SEQ + blk * 256) * NP1 + C_DK + h * 64 + ch * 8;
        float s[8];
#pragma unroll
        for (int e = 0; e < 8; ++e) s[e] = 0.f;
        for (int i = 0; i < 32; ++i) { const v4u v = *(const v4u*)(base + (size_t)(i * 8 + rs) * NP1);
            s[0] += bflo(v.x); s[1] += bfhi(v.x); s[2] += bflo(v.y); s[3] += bfhi(v.y); s[4] += bflo(v.z); s[5] += bfhi(v.z); s[6] += bflo(v.w); s[7] += bfhi(v.w); }
#pragma unroll
        for (int e = 0; e < 8; ++e) { s[e] += shx(s[e], 8, lane); s[e] += shx(s[e], 16, lane); s[e] = add32(s[e]); }
        if (rs == 0) { float* o = KM + ((size_t)(b * 8 + blk) * 8 + h) * 64 + ch * 8;
            *(f32x4*)o = (f32x4){s[0], s[1], s[2], s[3]} * (1.0f / 256.0f); *(f32x4*)(o + 4) = (f32x4){s[4], s[5], s[6], s[7]} * (1.0f / 256.0f); }
    }
}

constexpr int KT_STRIDE = 144, VT_STRIDE = 192, KT_BYTES = 64 * KT_STRIDE, VT_BYTES = 64 * VT_STRIDE, KV_BUF = KT_BYTES + VT_BYTES;
__device__ __forceinline__ int crow(int r, int hi) { return (r & 3) + 8 * (r >> 2) + 4 * hi; }
struct AttnState { float m, l; f32x16 o0, o1; };
__device__ __forceinline__ void attn_reset(AttnState& st) { st.m = -1e30f; st.l = 0.f;
#pragma unroll
    for (int r = 0; r < 16; ++r) { st.o0[r] = 0.f; st.o1[r] = 0.f; } }
__device__ __forceinline__ s16x4 vtr(LAS const unsigned char* p) { return __builtin_bit_cast(s16x4, __builtin_amdgcn_ds_read_tr16_b64_v4i16((LAS s16x4*)p)); }

__device__ __forceinline__ void attn_scores(LAS const unsigned char* Kt, const bf16x8 (&qr)[4], f32x16& p0, f32x16& p1, int lane) {
    const int r32 = lane & 31, hi = lane >> 5;
#pragma unroll
    for (int r = 0; r < 16; ++r) { p0[r] = 0.f; p1[r] = 0.f; }
#pragma unroll
    for (int s = 0; s < 4; ++s) {
        const bf16x8 a0 = *(LAS const bf16x8*)(Kt + r32 * KT_STRIDE + (2 * s + hi) * 16), a1 = *(LAS const bf16x8*)(Kt + (32 + r32) * KT_STRIDE + (2 * s + hi) * 16);
        p0 = __builtin_amdgcn_mfma_f32_32x32x16_bf16(a0, qr[s], p0, 0, 0, 0);
        p1 = __builtin_amdgcn_mfma_f32_32x32x16_bf16(a1, qr[s], p1, 0, 0, 0);
    }
}
__device__ __forceinline__ void attn_pv(LAS const unsigned char* Vt, const f32x16& e0, const f32x16& e1, f32x16& o0, f32x16& o1, int lane) {
    const int hi = lane >> 5;
    LAS const unsigned char* vb = Vt + (4 * hi + ((lane & 15) >> 2)) * VT_STRIDE + (((lane >> 4) & 1) * 16 + 4 * (lane & 3)) * 2;
#pragma unroll
    for (int s = 0; s < 4; ++s) {
        v4u pw;
        if (s < 2) { pw.x = pk2(e0[8 * s + 0], e0[8 * s + 1]); pw.y = pk2(e0[8 * s + 2], e0[8 * s + 3]); pw.z = pk2(e0[8 * s + 4], e0[8 * s + 5]); pw.w = pk2(e0[8 * s + 6], e0[8 * s + 7]); }
        else { const int t = s - 2; pw.x = pk2(e1[8 * t + 0], e1[8 * t + 1]); pw.y = pk2(e1[8 * t + 2], e1[8 * t + 3]); pw.z = pk2(e1[8 * t + 4], e1[8 * t + 5]); pw.w = pk2(e1[8 * t + 6], e1[8 * t + 7]); }
        const bf16x8 pb = __builtin_bit_cast(bf16x8, pw);
#pragma unroll
        for (int db = 0; db < 2; ++db) {
            const s16x4 lo = vtr(vb + (16 * s) * VT_STRIDE + db * 64), hh = vtr(vb + (16 * s + 8) * VT_STRIDE + db * 64);
            const bf16x8 a = (bf16x8){lo[0], lo[1], lo[2], lo[3], hh[0], hh[1], hh[2], hh[3]};
            if (db == 0) o0 = __builtin_amdgcn_mfma_f32_32x32x16_bf16(a, pb, o0, 0, 0, 0); else o1 = __builtin_amdgcn_mfma_f32_32x32x16_bf16(a, pb, o1, 0, 0, 0);
        }
    }
}
__device__ __forceinline__ void attn_tile(LAS const unsigned char* Kt, LAS const unsigned char* Vt, const bf16x8 (&qr)[4], AttnState& st, int kmin, int kmax, int lane) {
    const int hi = lane >> 5;
    f32x16 p0, p1; attn_scores(Kt, qr, p0, p1, lane);
    float mx = -1e30f;
#pragma unroll
    for (int r = 0; r < 16; ++r) { const int k0 = crow(r, hi), k1 = 32 + k0;
        p0[r] = (k0 >= kmin && k0 <= kmax) ? p0[r] : -1e30f; p1[r] = (k1 >= kmin && k1 <= kmax) ? p1[r] : -1e30f;
        mx = fmaxf(mx, fmaxf(p0[r], p1[r])); }
    mx = max32(mx);
    const float mn = fmaxf(st.m, mx), alpha = __builtin_amdgcn_exp2f(st.m - mn);
    float rs = 0.f;
#pragma unroll
    for (int r = 0; r < 16; ++r) { p0[r] = p0[r] > -1e29f ? __builtin_amdgcn_exp2f(p0[r] - mn) : 0.f; p1[r] = p1[r] > -1e29f ? __builtin_amdgcn_exp2f(p1[r] - mn) : 0.f; rs += p0[r] + p1[r]; }
    st.m = mn; st.l = st.l * alpha + rs;
#pragma unroll
    for (int r = 0; r < 16; ++r) { st.o0[r] *= alpha; st.o1[r] *= alpha; }
    attn_pv(Vt, p0, p1, st.o0, st.o1, lane);
}
struct KVRegs { v4u k, v; };
__device__ __forceinline__ void kv_load(KVRegs& r, const bf16* Kg, const bf16* Vg, size_t ld, int tid) {
    const int key = tid >> 3, ch = tid & 7;
    r.k = *(const v4u*)(Kg + (size_t)key * ld + ch * 8); r.v = *(const v4u*)(Vg + (size_t)key * ld + ch * 8);
}
__device__ __forceinline__ void kv_store(const KVRegs& r, LAS unsigned char* buf, int tid) {
    const int key = tid >> 3, ch = tid & 7;
    *(LAS v4u*)(buf + key * KT_STRIDE + ch * 16) = r.k; *(LAS v4u*)(buf + KT_BYTES + key * VT_STRIDE + ch * 16) = r.v;
}

__device__ __forceinline__ float attn_inv_l(const AttnState& st) { const float l = add32(st.l); return 1.0f / fmaxf(l, 1e-30f); }

#define ATTN_STREAM(Kg, Vg, ld, j0, j1, SKIP, RANGE) do { \
    int jn_ = (j0); while (jn_ < (j1) && (SKIP(jn_))) ++jn_; \
    if (jn_ < (j1)) { KVRegs kv_; kv_load(kv_, (Kg) + (size_t)jn_ * 64 * (ld), (Vg) + (size_t)jn_ * 64 * (ld), (ld), F.tid); \
        __syncthreads(); kv_store(kv_, ring, F.tid); int cur_ = 0; \
        for (;;) { const int j_ = jn_; ++jn_; while (jn_ < (j1) && (SKIP(jn_))) ++jn_; const bool more_ = jn_ < (j1); \
            if (more_) kv_load(kv_, (Kg) + (size_t)jn_ * 64 * (ld), (Vg) + (size_t)jn_ * 64 * (ld), (ld), F.tid); \
            __syncthreads(); \
            { int kmin_, kmax_; RANGE(j_, kmin_, kmax_); \
              if (__any(kmax_ >= kmin_)) attn_tile(ring + cur_ * KV_BUF, ring + cur_ * KV_BUF + KT_BYTES, qr, st, kmin_, kmax_, F.lane); } \
            if (!more_) break; \
            kv_store(kv_, ring + (cur_ ^ 1) * KV_BUF, F.tid); cur_ ^= 1; } } } while (0)

__device__ __forceinline__ void nsa_unit(const Frame& F, const bf16* P, const bf16* KC, const bf16* VC, bf16* O  , int b, int g, int i) {
    LAS unsigned char* ring = F.lds;
    LAS float* impb = (LAS float*)(F.lds + 2 * KV_BUF);
    LAS unsigned* selm = (LAS unsigned*)(F.lds + 2 * KV_BUF + 33792);
    LAS float* stash = (LAS float*)(F.lds + 2 * KV_BUF + 33792 + 256) + F.tid;
    const int lane = F.lane, r32 = lane & 31, hi = lane >> 5, hr = F.wave & 3, th = F.wave >> 2;
    const int tl = 32 * th + r32;
    const int s = 64 * i + tl;
    const size_t row = (size_t)b * SEQ + s;
    const int head = g * 4 + hr;
    bf16x8 qr[4];
#pragma unroll
    for (int d = 0; d < 4; ++d) qr[d] = *(const bf16x8*)(P + row * NP1 + C_CQ + head * 64 + d * 16 + hi * 8);
    const float g0 = sigmoidf_(bf2f(P[row * NP1 + C_CG + head])), g1 = sigmoidf_(bf2f(P[row * NP1 + C_CG + 8 + head])), g2 = sigmoidf_(bf2f(P[row * NP1 + C_CG + 16 + head]));
    AttnState st;
    {
        const bf16* Kg = KC + (size_t)(b * 2 + g) * 128 * 64; const bf16* Vg = VC + (size_t)(b * 2 + g) * 128 * 64;
        const int nmax = (s >= 31) ? ((s - 31) >> 4) : -1;
        KVRegs kv0, kv1; kv_load(kv0, Kg, Vg, 64, F.tid); kv_load(kv1, Kg + 64 * 64, Vg + 64 * 64, 64, F.tid);
        __syncthreads();
        kv_store(kv0, ring, F.tid); kv_store(kv1, ring + KV_BUF, F.tid);
        __syncthreads();
        f32x16 a0, a1, c0, c1, out0, out1;
        attn_scores(ring, qr, a0, a1, lane); attn_scores(ring + KV_BUF, qr, c0, c1, lane);
        float mx = -1e30f;
#pragma unroll
        for (int r = 0; r < 16; ++r) { const int k0 = crow(r, hi);
            a0[r] = (k0 <= nmax) ? a0[r] : -1e30f; a1[r] = (32 + k0 <= nmax) ? a1[r] : -1e30f; c0[r] = (64 + k0 <= nmax) ? c0[r] : -1e30f; c1[r] = (96 + k0 <= nmax) ? c1[r] : -1e30f;
            mx = fmaxf(fmaxf(mx, fmaxf(a0[r], a1[r])), fmaxf(c0[r], c1[r])); }
        mx = max32(mx);
        float rs = 0.f;
#pragma unroll
        for (int r = 0; r < 16; ++r) { a0[r] = a0[r] > -1e29f ? __builtin_amdgcn_exp2f(a0[r] - mx) : 0.f; a1[r] = a1[r] > -1e29f ? __builtin_amdgcn_exp2f(a1[r] - mx) : 0.f;
            c0[r] = c0[r] > -1e29f ? __builtin_amdgcn_exp2f(c0[r] - mx) : 0.f; c1[r] = c1[r] > -1e29f ? __builtin_amdgcn_exp2f(c1[r] - mx) : 0.f; rs += (a0[r] + a1[r]) + (c0[r] + c1[r]); }
        rs = add32(rs);
        const float inv = 1.0f / fmaxf(rs, 1e-30f);
#pragma unroll
        for (int r = 0; r < 16; ++r) { out0[r] = 0.f; out1[r] = 0.f; }
        attn_pv(ring + KT_BYTES, a0, a1, out0, out1, lane); attn_pv(ring + KV_BUF + KT_BYTES, c0, c1, out0, out1, lane);
        const float sc = g0 * inv;
#pragma unroll
        for (int r = 0; r < 16; ++r) { stash[r * 512] = out0[r] * sc; stash[(16 + r) * 512] = out1[r] * sc; }
        if (i >= 16) {
            float xprev = 0.f;
#define NSA_IMP(U, ACC, GQ) do { const float G_ = ((ACC[4 * (GQ)] + ACC[4 * (GQ) + 1]) + (ACC[4 * (GQ) + 2] + ACC[4 * (GQ) + 3])) * inv, L_ = ACC[4 * (GQ) + 3] * inv; \
                const float x_ = other32(L_, hi); impb[(hr * 64 + tl) * 33 + 2 * (U) + hi] = G_ + (hi ? x_ : xprev); xprev = x_; } while (0)
            NSA_IMP(0, a0, 0); NSA_IMP(1, a0, 1); NSA_IMP(2, a0, 2); NSA_IMP(3, a0, 3); NSA_IMP(4, a1, 0); NSA_IMP(5, a1, 1); NSA_IMP(6, a1, 2); NSA_IMP(7, a1, 3);
            NSA_IMP(8, c0, 0); NSA_IMP(9, c0, 1); NSA_IMP(10, c0, 2); NSA_IMP(11, c0, 3); NSA_IMP(12, c1, 0); NSA_IMP(13, c1, 1); NSA_IMP(14, c1, 2); NSA_IMP(15, c1, 3);
#undef NSA_IMP
        }
    }
    __syncthreads();
    unsigned mymask;
    if (i < 16) mymask = (2u << i) - 1u;
    else {
        { const int tk = F.tid >> 3, js = F.tid & 7; unsigned bits = 0u;
          float v[4];
#pragma unroll
          for (int e = 0; e < 4; ++e) { const int j = js * 4 + e; v[e] = (impb[(0 * 64 + tk) * 33 + j] + impb[(1 * 64 + tk) * 33 + j]) + (impb[(2 * 64 + tk) * 33 + j] + impb[(3 * 64 + tk) * 33 + j]); }
          int rank[4] = {0, 0, 0, 0};
          for (int jj = 1; jj <= i - 2; ++jj) { const float o = (impb[(0 * 64 + tk) * 33 + jj] + impb[(1 * 64 + tk) * 33 + jj]) + (impb[(2 * 64 + tk) * 33 + jj] + impb[(3 * 64 + tk) * 33 + jj]);
#pragma unroll
              for (int e = 0; e < 4; ++e) { const int j = js * 4 + e; rank[e] += (o > v[e] || (o == v[e] && jj < j)) ? 1 : 0; } }
#pragma unroll
          for (int e = 0; e < 4; ++e) { const int j = js * 4 + e; const bool forced = (j == 0) || (j == i) || (j == i - 1); const bool cand = (j >= 1) && (j <= i - 2);
              if (forced || (cand && rank[e] < 13)) bits |= 1u << j; }
          bits |= shxu(bits, 1, F.lane); bits |= shxu(bits, 2, F.lane); bits |= shxu(bits, 4, F.lane);
          if (js == 0) selm[tk] = bits; }
        __syncthreads();
        mymask = selm[tl];
    }
    {
        attn_reset(st);
        const bf16* Kg = P + (size_t)b * SEQ * NP1 + C_KS + g * 64; const bf16* Vg = P + (size_t)b * SEQ * NP1 + C_VS + g * 64;
#define NSA_SKIP(j) (false)
#define NSA_RANGE(j, kmin, kmax) do { kmin = 0; kmax = ((mymask >> (j)) & 1u) ? ((j) == i ? tl : 63) : -1; } while (0)
        ATTN_STREAM(Kg, Vg, (size_t)NP1, 0, i + 1, NSA_SKIP, NSA_RANGE);
#undef NSA_RANGE
        const float sc = g1 * attn_inv_l(st);
#pragma unroll
        for (int r = 0; r < 16; ++r) { stash[r * 512] += st.o0[r] * sc; stash[(16 + r) * 512] += st.o1[r] * sc; }
    }
    {
        attn_reset(st);
        const bf16* Kg = P + (size_t)b * SEQ * NP1 + C_KW + g * 64; const bf16* Vg = P + (size_t)b * SEQ * NP1 + C_VW + g * 64;
        const int jlo = i >= 8 ? i - 8 : 0; f32x16 out0, out1;
#define NSA_RANGE(j, kmin, kmax) do { const int d_ = 64 * (i - (j)) + tl; kmin = d_ - 511 > 0 ? d_ - 511 : 0; kmax = d_ < 63 ? d_ : 63; } while (0)
        ATTN_STREAM(Kg, Vg, (size_t)NP1, jlo, i + 1, NSA_SKIP, NSA_RANGE);
#undef NSA_RANGE
#undef NSA_SKIP
        const float sc = g2 * attn_inv_l(st);
#pragma unroll
        for (int r = 0; r < 16; ++r) { out0[r] = stash[r * 512] + st.o0[r] * sc; out1[r] = stash[(16 + r) * 512] + st.o1[r] * sc; }
        bf16* orow = O + row * 512 + head * 64;
#pragma unroll
        for (int gq = 0; gq < 4; ++gq) {
            v2u w0; w0.x = pk2(out0[4 * gq], out0[4 * gq + 1]); w0.y = pk2(out0[4 * gq + 2], out0[4 * gq + 3]); *(v2u*)(orow + 8 * gq + 4 * hi) = w0;
            v2u w1; w1.x = pk2(out1[4 * gq], out1[4 * gq + 1]); w1.y = pk2(out1[4 * gq + 2], out1[4 * gq + 3]); *(v2u*)(orow + 32 + 8 * gq + 4 * hi) = w1; }
    }
}
__device__ __forceinline__ void phase_nsa(const Frame& F, const bf16* P, const bf16* KC, const bf16* VC, bf16* O) {
    for (int un2 = 2 * F.bid; un2 < 512; un2 += 2 * F.G)
#pragma unroll 1
        for (int k = 0; k < 2; ++k) { const int un = un2 >> 1, ip = un & 15, g = (un >> 4) & 1, b = un >> 5; nsa_unit(F, P, KC, VC, O, b, g, k == 0 ? 31 - ip : ip); }
}

__device__ __forceinline__ void moba_unit(const Frame& F, const bf16* P, const float* KM, bf16* O  , int b, int h, int qb) {
    LAS unsigned char* ring = F.lds;
    LAS float* kml = (LAS float*)(F.lds + 2 * KV_BUF);
    LAS unsigned* uni = (LAS unsigned*)(F.lds + 2 * KV_BUF + 2048);
    const int lane = F.lane, r32 = lane & 31, hi = lane >> 5;
    const int tl = 32 * F.wave + r32;
    const size_t row = (size_t)b * SEQ + 256 * qb + tl;
    bf16x8 qr[4];
#pragma unroll
    for (int d = 0; d < 4; ++d) qr[d] = *(const bf16x8*)(P + row * NP1 + C_DQ + h * 64 + d * 16 + hi * 8);
    __syncthreads();
    { const int blk = F.tid >> 6, p = F.tid & 63; kml[F.tid] = KM[((size_t)(b * 8 + blk) * 8 + h) * 64 + p]; if (F.tid == 0) uni[0] = 0u; }
    __syncthreads();
    unsigned mymask = 0u;
    if (qb > 0) {
        float gt[8];
#pragma unroll
        for (int n = 0; n < 8; ++n) { float a = 0.f;
#pragma unroll
            for (int d = 0; d < 4; ++d) { const v4u qw = __builtin_bit_cast(v4u, qr[d]); const LAS float* km = kml + n * 64 + d * 16 + hi * 8;
                a += bflo(qw.x) * km[0] + bfhi(qw.x) * km[1] + bflo(qw.y) * km[2] + bfhi(qw.y) * km[3] + bflo(qw.z) * km[4] + bfhi(qw.z) * km[5] + bflo(qw.w) * km[6] + bfhi(qw.w) * km[7]; }
            a = add32(a); gt[n] = a; }
#pragma unroll
        for (int n = 0; n < 8; ++n) { int rank = 0;
#pragma unroll
            for (int m = 0; m < 8; ++m) rank += (m < qb && m != n && (gt[m] > gt[n] || (gt[m] == gt[n] && m < n))) ? 1 : 0;
            if (n < qb && rank < 3) mymask |= 1u << n; }
        atomicOr((unsigned*)uni, mymask);
    }
    __syncthreads();
    const unsigned um = uni[0];
    AttnState st; attn_reset(st);
    const bf16* Kg = P + (size_t)b * SEQ * NP1 + C_DK + h * 64; const bf16* Vg = P + (size_t)b * SEQ * NP1 + C_DV + h * 64;
#define MOBA_SKIP(j) ((j) < 4 * qb && !((um >> ((j) >> 2)) & 1u))
#define MOBA_RANGE(j, kmin, kmax) do { kmin = 0; if ((j) < 4 * qb) kmax = ((mymask >> ((j) >> 2)) & 1u) ? 63 : -1; else { const int d_ = tl - 64 * ((j) - 4 * qb); kmax = d_ < 63 ? d_ : 63; } } while (0)
    ATTN_STREAM(Kg, Vg, (size_t)NP1, 0, 4 * qb + 4, MOBA_SKIP, MOBA_RANGE);
#undef MOBA_SKIP
#undef MOBA_RANGE
    const float sc = attn_inv_l(st);
    bf16* orow = O + row * 512 + h * 64;
#pragma unroll
    for (int gq = 0; gq < 4; ++gq) {
        v2u w0; w0.x = pk2(st.o0[4 * gq] * sc, st.o0[4 * gq + 1] * sc); w0.y = pk2(st.o0[4 * gq + 2] * sc, st.o0[4 * gq + 3] * sc); *(v2u*)(orow + 8 * gq + 4 * hi) = w0;
        v2u w1; w1.x = pk2(st.o1[4 * gq] * sc, st.o1[4 * gq + 1] * sc); w1.y = pk2(st.o1[4 * gq + 2] * sc, st.o1[4 * gq + 3] * sc); *(v2u*)(orow + 32 + 8 * gq + 4 * hi) = w1; }
}
__device__ __forceinline__ void phase_moba(const Frame& F, const bf16* P, const float* KM, bf16* O) {
    for (int un2 = 2 * F.bid; un2 < 512; un2 += 2 * F.G)
#pragma unroll 1
        for (int k = 0; k < 2; ++k) { const int un = un2 >> 1, qp = un & 3, h = (un >> 2) & 7, b = un >> 5; moba_unit(F, P, KM, O, b, h, k == 0 ? 7 - qp : qp); }
}

__device__ __forceinline__ unsigned ord_key(float x) { const unsigned u = __builtin_bit_cast(unsigned, x); return (u & 0x80000000u) ? ~u : (u | 0x80000000u); }
__device__ __forceinline__ float ord_val(unsigned k) { const unsigned u = (k & 0x80000000u) ? (k & 0x7fffffffu) : ~k; return __builtin_bit_cast(float, u); }
constexpr int SK_STRIDE = 272;
__device__ __forceinline__ void peer_route_unit(const Frame& F, const bf16* Q2, const bf16* SUBK  , int* EIDX, float* EW, int tb, int h) {
    LAS unsigned char* skl = F.lds;
    const int lane = F.lane, r32 = lane & 31, hi = lane >> 5;
    __syncthreads();
    for (int i = F.tid; i < 2 * 128 * 16; i += NTHR) { const int ch = i & 15, rowi = i >> 4;
        *(LAS v4u*)(skl + rowi * SK_STRIDE + ch * 16) = *(const v4u*)(SUBK + ((size_t)h * 256 + rowi) * 128 + ch * 8); }
    __syncthreads();
    const size_t tok = (size_t)tb * 256 + F.wave * 32 + r32;
    unsigned topk[2][16];
#pragma unroll
    for (int p = 0; p < 2; ++p) {
        bf16x8 qf[8]; float ss = 0.f;
#pragma unroll
        for (int s = 0; s < 8; ++s) { qf[s] = *(const bf16x8*)(Q2 + tok * 2048 + h * 256 + p * 128 + s * 16 + hi * 8); const v4u w = __builtin_bit_cast(v4u, qf[s]);
            const float a0 = bflo(w.x), a1 = bfhi(w.x), a2 = bflo(w.y), a3 = bfhi(w.y), a4 = bflo(w.z), a5 = bfhi(w.z), a6 = bflo(w.w), a7 = bfhi(w.w);
            ss += (a0 * a0 + a1 * a1) + (a2 * a2 + a3 * a3) + (a4 * a4 + a5 * a5) + (a6 * a6 + a7 * a7); }
        ss = add32(ss);
        const float rn = 1.0f / sqrtf(ss * (1.0f / 128.0f) + NORM_EPS);
        unsigned key[64];
#pragma unroll
        for (int nb = 0; nb < 4; ++nb) { f32x16 acc;
#pragma unroll
            for (int r = 0; r < 16; ++r) acc[r] = 0.f;
#pragma unroll
            for (int s = 0; s < 8; ++s) { const bf16x8 a = *(LAS const bf16x8*)(skl + (p * 128 + nb * 32 + r32) * SK_STRIDE + (2 * s + hi) * 16);
                acc = __builtin_amdgcn_mfma_f32_32x32x16_bf16(a, qf[s], acc, 0, 0, 0); }
#pragma unroll
            for (int r = 0; r < 16; ++r) { const int n = nb * 32 + crow(r, hi); key[nb * 16 + r] = (ord_key(acc[r] * rn) & 0xffffff80u) | (unsigned)(127 - n); } }
#pragma unroll
        for (int k = 0; k < 16; ++k) { unsigned m = key[0];
#pragma unroll
            for (int e = 1; e < 64; ++e) m = m > key[e] ? m : key[e];
            m = umax32(m);
            topk[p][k] = m;
#pragma unroll
            for (int e = 0; e < 64; ++e) key[e] = key[e] == m ? 0u : key[e]; }
    }
    float v1[16], v2[16];
#pragma unroll
    for (int k = 0; k < 16; ++k) { v1[k] = ord_val(topk[0][k] & 0xffffff80u); v2[k] = ord_val(topk[1][k] & 0xffffff80u); }
    unsigned ck[50]; { int c = 0;
#pragma unroll
        for (int a = 0; a < 16; ++a)
#pragma unroll
            for (int bq = 0; bq < 16; ++bq) if ((a + 1) * (bq + 1) <= 16) { ck[c] = (ord_key(v1[a] + v2[bq]) & 0xffffff00u) | (unsigned)(255 - (16 * a + bq)); ++c; } }
    float tv[16]; int te[16];
#pragma unroll
    for (int k = 0; k < 16; ++k) { unsigned m = ck[0];
#pragma unroll
        for (int e = 1; e < 50; ++e) m = m > ck[e] ? m : ck[e];
#pragma unroll
        for (int e = 0; e < 50; ++e) ck[e] = ck[e] == m ? 0u : ck[e];
        const int ci = 255 - (int)(m & 255u), a = ci >> 4, bq = ci & 15;
        unsigned ka = topk[0][0], kb = topk[1][0];
#pragma unroll
        for (int e = 1; e < 16; ++e) { ka = a == e ? topk[0][e] : ka; kb = bq == e ? topk[1][e] : kb; }
        te[k] = (127 - (int)(ka & 127u)) * 128 + (127 - (int)(kb & 127u));
        tv[k] = ord_val(m & 0xffffff00u); }
    { float den = 0.f; const float mx = tv[0];
#pragma unroll
      for (int k = 0; k < 16; ++k) { tv[k] = __expf(tv[k] - mx); den += tv[k]; }
      const float inv = 1.0f / den;
#pragma unroll
      for (int k = 0; k < 16; ++k) tv[k] *= inv; }
    if (hi == 0) {
#pragma unroll
        for (int k = 0; k < 16; ++k) { EIDX[(tok * 8 + h) * 16 + k] = te[k]; EW[(tok * 8 + h) * 16 + k] = tv[k]; }
    }
}

__device__ __forceinline__ void phase_peer_route(const Frame& F, const bf16* Q2, const bf16* SUBK, int* EIDX, float* EW) {
    for (int un = F.bid; un < 64 * 8; un += F.G) peer_route_unit(F, Q2, SUBK, EIDX, EW, un >> 3, un & 7);
}

__device__ __forceinline__ float dot8(v4u a, v4u b) {
    return (bflo(a.x) * bflo(b.x) + bfhi(a.x) * bfhi(b.x)) + (bflo(a.y) * bflo(b.y) + bfhi(a.y) * bfhi(b.y)) + (bflo(a.z) * bflo(b.z) + bfhi(a.z) * bfhi(b.z)) + (bflo(a.w) * bflo(b.w) + bfhi(a.w) * bfhi(b.w));
}
__device__ __forceinline__ void phase_peer_gather(const Frame& F, const bf16* H2, const bf16* UT, const bf16* VT, const int* EIDX, const float* EW, float* XB, const float* gate  ) {
    const int gw = gwave(F), NGW = ngwave(F), lane = F.lane;
    for (int tok = gw; tok < TOK; tok += NGW) {
        const v4u h0 = *(const v4u*)(H2 + (size_t)tok * DM + 8 * lane), h1 = *(const v4u*)(H2 + (size_t)tok * DM + 512 + 8 * lane);
        float o[16];
#pragma unroll
        for (int e = 0; e < 16; ++e) o[e] = 0.f;
        const int* ei = EIDX + (size_t)tok * 128; const float* ew = EW + (size_t)tok * 128;
        for (int c = 0; c < 16; ++c) {
            v4u ua[8], ub[8], va[8], vb[8]; float cf[8];
#pragma unroll
            for (int j = 0; j < 8; ++j) { const int e = __builtin_amdgcn_readfirstlane(ei[c * 8 + j]);
                ua[j] = *(const v4u*)(UT + (size_t)e * DM + 8 * lane); ub[j] = *(const v4u*)(UT + (size_t)e * DM + 512 + 8 * lane);
                va[j] = *(const v4u*)(VT + (size_t)e * DM + 8 * lane); vb[j] = *(const v4u*)(VT + (size_t)e * DM + 512 + 8 * lane); }
#pragma unroll
            for (int j = 0; j < 8; ++j) cf[j] = dot8(ua[j], h0) + dot8(ub[j], h1);
#pragma unroll
            for (int sft = 1; sft < 32; sft <<= 1)
#pragma unroll
                for (int j = 0; j < 8; ++j) cf[j] += shx(cf[j], sft, lane);
#pragma unroll
            for (int j = 0; j < 8; ++j) cf[j] = add32(cf[j]);
#pragma unroll
            for (int j = 0; j < 8; ++j) { const float w = ew[c * 8 + j] * gelu_erf(cf[j]);
                o[0] += w * bflo(va[j].x); o[1] += w * bfhi(va[j].x); o[2] += w * bflo(va[j].y); o[3] += w * bfhi(va[j].y);
                o[4] += w * bflo(va[j].z); o[5] += w * bfhi(va[j].z); o[6] += w * bflo(va[j].w); o[7] += w * bfhi(va[j].w);
                o[8] += w * bflo(vb[j].x); o[9] += w * bfhi(vb[j].x); o[10] += w * bflo(vb[j].y); o[11] += w * bfhi(vb[j].y);
                o[12] += w * bflo(vb[j].z); o[13] += w * bfhi(vb[j].z); o[14] += w * bflo(vb[j].w); o[15] += w * bfhi(vb[j].w); }
        }
        const int b = tok / SEQ; float* xr = XB + (size_t)tok * DM; const float* gr = gate + (size_t)b * 6144;
#pragma unroll
        for (int q = 0; q < 4; ++q) { const int col = (q >> 1) * 512 + 8 * lane + (q & 1) * 4;
            const f32x4 x = *(const f32x4*)(xr + col), gg = *(const f32x4*)(gr + col);
            *(f32x4*)(xr + col) = x + gg * (f32x4){o[4 * q], o[4 * q + 1], o[4 * q + 2], o[4 * q + 3]}; }
    }
}

constexpr int NPL = 12, NPHASE = 1 + DEPTH * NPL + 1;
constexpr int CW_BAR = 1024;
static_assert((CW_BAR + XCD_BAR_WORDS) * 4 <= (int)CTL_ZERO_BYTES, "barrier words inside the memset region");

__global__ void __launch_bounds__(NTHR, 2) hybrid_fwd(Args args) {
    extern __shared__ __attribute__((aligned(16))) unsigned char lds[];
    Frame F;
    F.lds = (LAS unsigned char*)lds; F.ldsg = lds;
    F.tid = threadIdx.x; F.lane = F.tid & 63; F.wave = __builtin_amdgcn_readfirstlane(F.tid >> 6);
    F.G = gridDim.x; F.bid = blockIdx.x; F.ws = args.ws;
    unsigned char* ws = args.ws;
    volatile LAS unsigned* MISC = (volatile LAS unsigned*)(F.lds + MISC_OFF);
    for (int u = F.tid; u < 64; u += NTHR) ((LAS unsigned*)(F.lds + MISC_OFF))[u] = 0u;
    __syncthreads();
    XcdBarrier bar; bar.bar = (unsigned*)(ws + WS_CTL) + CW_BAR; bar.x = 0; bar.st = nullptr;
    const int lo = args.ph_lo, hi = args.ph_hi;
    if (hi - lo > 1) bar = xcd_barrier_post((unsigned*)(ws + WS_CTL) + CW_BAR, MISC + 8);
#ifndef PHMASK
#define PHMASK 0xffffffffu
#endif
#define PM(j) ((PHMASK >> (j)) & 1u)
#define IN(k) (lo <= (k) && (k) < hi)
#define SEAM(k) do { if (IN(k) && IN((k) + 1)) xcd_barrier(bar); } while (0)

    typedef __attribute__((address_space(4))) const Args* KArgs;
    KArgs ap = (KArgs)__builtin_amdgcn_kernarg_segment_ptr();
#define FRESH() asm volatile("" : "+s"(ap), "+s"(ws)); Frame Fp = F; asm volatile("" : "+v"(Fp.tid)); Fp.lane = Fp.tid & 63; asm volatile("" : "+s"(Fp.wave), "+s"(Fp.bid), "+s"(Fp.G)); Fp.ws = ws; LAS unsigned char* ring = Fp.lds; asm volatile("" : "+s"(ring)); Fp.lds = ring
#define INP(i) ((const float*)ap->in[i])
#define WIN_ ((bf16*)(ws + WS_WIN))
#define WOUT_ ((bf16*)(ws + WS_WOUT))
#define WOT_ ((bf16*)(ws + WS_WO))
#define WQT_ ((bf16*)(ws + WS_WQ))
#define W1T_ ((bf16*)(ws + WS_W1T))
#define SUBK_ ((bf16*)(ws + WS_SUBK))
#define W2T_ ((bf16*)(ws + WS_SMALL + SM_W2T))
#define MOD_ ((float*)(ws + WS_MOD))
#define COS_ ((const float*)(ws + WS_COS))
#define SIN_ ((const float*)(ws + WS_SIN))
#define KMEAN_ ((float*)(ws + WS_SMALL + SM_KMEAN))
#define KCMP_ ((bf16*)(ws + WS_SMALL + SM_KCMP))
#define VCMP_ ((bf16*)(ws + WS_SMALL + SM_VCMP))
#define PBP_ ((float*)(ws + WS_SMALL + SM_PBP))
#define EIDX_ ((int*)(ws + WS_EIDX))
#define EW_ ((float*)(ws + WS_EW))
#define HN_ ((bf16*)(ws + WS_HN))
#define MIX_ ((bf16*)(ws + WS_MIX))
#define PROJ_ ((bf16*)(ws + WS_BIG))
#define GATES_ ((bf16*)(ws + WS_BIG))
#define UT_ ((bf16*)(ws + WS_BIG))
#define VT_ ((bf16*)(ws + WS_BIG + 32 * MiB))
#define Q2_ ((bf16*)(ws + WS_BIG + 64 * MiB))
#define XB_ ((float*)ap->out)
#define MODL_ (MOD_ + (size_t)l * 8 * 6144)
#define XIN_ ((l == 0) ? INP(I_X) : (const float*)XB_)

    if (PM(0) && IN(0)) { FRESH(); phase_prologue(Fp, ap); }
    SEAM(0);
#pragma unroll 1
    for (int l = 0; l < DEPTH; ++l) {
        const int p0 = 1 + l * NPL;
        if (PM(1) && IN(p0 + 0)) { FRESH(); phase_norm_mod(Fp, XIN_, INP(I_NMG) + l * DM, MODL_ + 0, MODL_ + 1024, HN_); }
        SEAM(p0 + 0);
        if (PM(2) && IN(p0 + 1)) { FRESH(); pg8::Gemm g{HN_, WIN_ + (size_t)l * NWIN * DM, TOK, NP1, DM}; pg8::StaticOrder S; S.init(TOK, NP1, Fp.G, Fp.bid);
            epi::EpiProj1 E{PROJ_, COS_, SIN_}; pg8::gemm_phase<epi::EpiProj1, pg8::StaticOrder, true, true>(ring, g, S, E, Fp.tid); }
        SEAM(p0 + 1);
        if (PM(3) && IN(p0 + 2)) {
            { FRESH(); phase_compress(Fp, PROJ_, W1T_ + (size_t)l * 2 * 128 * 2048, W2T_ + (size_t)l * 2 * 64 * 128, PBP_ + (size_t)l * 2 * 16 * 128, KCMP_, VCMP_); }
            { FRESH(); phase_kmean(Fp, PROJ_, KMEAN_); }
            { FRESH(); phase_mixer_a(Fp, PROJ_, INP(I_ACW) + (size_t)l * 3 * 512, MIX_); }
            __syncthreads();
            { FRESH(); phase_mixer_b(Fp, PROJ_, INP(I_BCW) + (size_t)l * 31 * 512, INP(I_BCB) + l * 512, INP(I_BLNG) + l * 512, INP(I_BLNB) + l * 512, MIX_ + (size_t)TOK * 512); }
            __syncthreads();
        }
        SEAM(p0 + 2);
        if (PM(4) && IN(p0 + 3)) { FRESH(); phase_nsa(Fp, PROJ_, KCMP_, VCMP_, MIX_ + (size_t)2 * TOK * 512); __syncthreads(); }
        SEAM(p0 + 3);
        if (PM(5) && IN(p0 + 4)) { FRESH(); phase_moba(Fp, PROJ_, KMEAN_, MIX_ + (size_t)3 * TOK * 512); __syncthreads(); }
        SEAM(p0 + 4);
        if (PM(6) && IN(p0 + 5)) { FRESH(); pg8::Gemm g{HN_, WIN_ + ((size_t)l * NWIN + NP1) * DM, TOK, NGT, DM}; pg8::StaticOrder S; S.init(TOK, NGT, Fp.G, Fp.bid);
            epi::EpiStore<1> E{GATES_, NGT}; pg8::gemm_phase<epi::EpiStore<1>, pg8::StaticOrder, true, true>(ring, g, S, E, Fp.tid); }
        SEAM(p0 + 5);
        if (PM(7) && IN(p0 + 6)) {
#pragma unroll 1
            for (int seg = 0; seg < 4; ++seg) { FRESH(); pg8::Gemm g{MIX_ + (size_t)seg * TOK * 512, WOUT_ + (size_t)(l * 4 + seg) * DM * 512, TOK, DM, 512}; pg8::StaticOrder S; S.init(TOK, DM, Fp.G, Fp.bid);
                epi::EpiMerge E{HN_, GATES_, seg}; pg8::gemm_phase<epi::EpiMerge, pg8::StaticOrder, true, true>(ring, g, S, E, Fp.tid); }
        }
        SEAM(p0 + 6);
        if (PM(8) && IN(p0 + 7)) { FRESH(); pg8::Gemm g{HN_, WOT_ + (size_t)l * DM * DM, TOK, DM, DM}; pg8::StaticOrder S; S.init(TOK, DM, Fp.G, Fp.bid);
            epi::EpiResid E{XIN_, XB_, MODL_ + 2048}; pg8::gemm_phase<epi::EpiResid, pg8::StaticOrder, true, true>(ring, g, S, E, Fp.tid); }
        SEAM(p0 + 7);
        if (PM(9) && IN(p0 + 8)) {
            { FRESH(); phase_norm_mod(Fp, XB_, INP(I_NFG) + l * DM, MODL_ + 3072, MODL_ + 4096, HN_); }
            { FRESH(); convert_copy(Fp, INP(I_PU) + (size_t)l * 16384 * DM, UT_, (size_t)16384 * DM); }
            { FRESH(); convert_copy(Fp, INP(I_PV) + (size_t)l * 16384 * DM, VT_, (size_t)16384 * DM); }
        }
        SEAM(p0 + 8);
        if (PM(10) && IN(p0 + 9)) { FRESH(); pg8::Gemm g{HN_, WQT_ + (size_t)l * 2048 * DM, TOK, 2048, DM}; pg8::StaticOrder S; S.init(TOK, 2048, Fp.G, Fp.bid);
            epi::EpiStore<0> E{Q2_, 2048}; pg8::gemm_phase<epi::EpiStore<0>, pg8::StaticOrder, true, true>(ring, g, S, E, Fp.tid); }
        SEAM(p0 + 9);
        if (PM(11) && IN(p0 + 10)) { FRESH(); phase_peer_route(Fp, Q2_, SUBK_ + (size_t)l * 8 * 2 * 128 * 128, EIDX_, EW_); __syncthreads(); }
        SEAM(p0 + 10);
        if (PM(12) && IN(p0 + 11)) { FRESH(); phase_peer_gather(Fp, HN_, UT_, VT_, EIDX_, EW_, XB_, MODL_ + 5120); }
        SEAM(p0 + 11);
    }
    if (PM(13) && IN(NPHASE - 1)) { FRESH(); phase_final_norm(Fp, XB_, INP(I_FNG), XB_); }
#ifdef DBG_STOP
    if (IN(NPHASE)) { FRESH();
        const bf16* src = (const bf16*)(ws + (size_t)DBG_OFF); const size_t n = (size_t)DBG_BYTES / 2, NO = (size_t)TOK * DM; float* o = (float*)ap->out;
        for (size_t i = (size_t)Fp.bid * NTHR + Fp.tid; i < NO; i += (size_t)Fp.G * NTHR) { float a = 0.f; for (size_t j = i; j < n; j += NO) a += bf2f(src[j]);
#ifdef DBG_OFF2
            { const float* s2 = (const float*)(ws + (size_t)DBG_OFF2); const size_t n2 = (size_t)DBG_BYTES2 / 4; for (size_t j = i; j < n2; j += NO) a += s2[j]; }
#endif
            if (!(a == a) || fabsf(a) > 1e30f) a = 12345.0f;
            o[i] = a; } }
#endif
#undef IN
#undef SEAM
}

extern "C" void kernel_launch(void* const* d_in, const int* in_sizes, int n_in, void* d_out, int out_size, void* d_ws, size_t ws_size, hipStream_t stream) {
    static int grid = 0;
    if (grid == 0) {
        if (n_in != 26 || in_sizes[0] != TOK * DM || out_size != TOK * DM || ws_size < WS_END) {
            fprintf(stderr, "kernel_launch: unexpected problem (n_in %d, in0 %d, out %d, ws %zu); nothing launched\n", n_in, n_in > 0 ? in_sizes[0] : -1, out_size, ws_size); grid = -1; return; }
        int dev = 0, cus = 0, per_cu = 0;
        if (hipGetDevice(&dev) != hipSuccess || hipDeviceGetAttribute(&cus, hipDeviceAttributeMultiprocessorCount, dev) != hipSuccess) { grid = -1; return; }
        if (hipFuncSetAttribute((const void*)hybrid_fwd, hipFuncAttributeMaxDynamicSharedMemorySize, LDS_BYTES) != hipSuccess) { fprintf(stderr, "kernel_launch: hipFuncSetAttribute failed\n"); grid = -1; return; }
        if (hipOccupancyMaxActiveBlocksPerMultiprocessor(&per_cu, (const void*)hybrid_fwd, NTHR, LDS_BYTES) != hipSuccess || per_cu < 1)
            fprintf(stderr, "kernel_launch: note: occupancy query reports %d workgroups per CU\n", per_cu);
        (void)hipGetLastError();
        grid = cus;
    }
    if (grid < 0) return;
    if (hipMemsetAsync((char*)d_ws + WS_CTL, 0, CTL_ZERO_BYTES, stream) != hipSuccess) return;
    Args a{};
    for (int i = 0; i < 26; ++i) a.in[i] = d_in[i];
    a.out = (float*)d_out; a.ws = (unsigned char*)d_ws;
#if MK_PER_PHASE
#ifdef DBG_STOP
    for (int p = 0; p <= DBG_STOP; ++p) { a.ph_lo = p; a.ph_hi = p + 1; hipLaunchKernelGGL(hybrid_fwd, dim3(grid), dim3(NTHR), LDS_BYTES, stream, a); }
    a.ph_lo = NPHASE; a.ph_hi = NPHASE + 1; hipLaunchKernelGGL(hybrid_fwd, dim3(grid), dim3(NTHR), LDS_BYTES, stream, a);
#else
    for (int p = 0; p < NPHASE; ++p) { a.ph_lo = p; a.ph_hi = p + 1; hipLaunchKernelGGL(hybrid_fwd, dim3(grid), dim3(NTHR), LDS_BYTES, stream, a); }
#endif
#else
    a.ph_lo = 0; a.ph_hi = NPHASE; hipLaunchKernelGGL(hybrid_fwd, dim3(grid), dim3(NTHR), LDS_BYTES, stream, a);
#endif
    const hipError_t le = hipPeekAtLastError();
    if (le != hipSuccess) fprintf(stderr, "kernel_launch: launch failed: %s\n", hipGetErrorName(le));
}
```

```cpp
#include <hip/hip_runtime.h>
#include <hip/hip_bf16.h>
#include <cstdio>
#include <cstdint>
#include <cmath>

#ifndef MK_PER_PHASE
#define MK_PER_PHASE 0
#endif

#define GAS __attribute__((address_space(1)))
#define LAS __attribute__((address_space(3)))
typedef unsigned short bf16;
typedef unsigned v4u __attribute__((ext_vector_type(4)));
typedef unsigned v2u __attribute__((ext_vector_type(2)));
typedef float f32x4 __attribute__((ext_vector_type(4)));
typedef float f32x2 __attribute__((ext_vector_type(2)));
typedef float f32x16 __attribute__((ext_vector_type(16)));
typedef short bf16x8 __attribute__((ext_vector_type(8)));
typedef short s16x4 __attribute__((ext_vector_type(4)));
typedef __bf16 bf16x2_t __attribute__((ext_vector_type(2)));

constexpr int BATCH = 8, SEQ = 2048, DM = 1024, DEPTH = 2, TOK = BATCH * SEQ;
constexpr int NP1 = 5632;
constexpr int NGT = 4096;
constexpr int NWIN = NP1 + NGT;
constexpr int C_AB = 0, C_AC = 512, C_AX = 1024, C_BA = 1536, C_BG = 2048, C_CQ = 2560, C_KC = 3072, C_VC = 3200, C_KS = 3328, C_VS = 3456, C_KW = 3584, C_VW = 3712,
              C_DQ = 3840, C_DK = 4352, C_DV = 4864, C_CG = 5376;
constexpr float NORM_EPS = 1e-6f;
constexpr float QSCALE = 0.125f * 1.4426950408889634f;

constexpr size_t MiB = 1u << 20;
constexpr size_t WS_CTL = 0, CTL_ZERO_BYTES = 64 * 1024;
constexpr size_t WS_MOD = 1 * MiB;
constexpr size_t WS_COS = 2 * MiB, WS_SIN = 4 * MiB;
constexpr size_t WS_SMALL = 6 * MiB;
constexpr size_t SM_KMEAN = 704 * 1024;
constexpr size_t SM_KCMP = 64 * 1024;
constexpr size_t SM_VCMP = 320 * 1024;
constexpr size_t SM_PBP = 576 * 1024;
constexpr size_t SM_W2T = 640 * 1024;
constexpr size_t WS_EIDX = 8 * MiB;
constexpr size_t WS_EW = 16 * MiB;
constexpr size_t WS_WIN = 24 * MiB;
constexpr size_t WS_WOUT = 62 * MiB;
constexpr size_t WS_WO = 70 * MiB;
constexpr size_t WS_WQ = 74 * MiB;
constexpr size_t WS_W1T = 82 * MiB;
constexpr size_t WS_SUBK = 84 * MiB;
constexpr size_t WS_HN = 86 * MiB;
constexpr size_t WS_MIX = 118 * MiB;
constexpr size_t WS_BIG = 182 * MiB;
constexpr size_t WS_END = 358 * MiB;

constexpr int LDS_BYTES = 147456;
constexpr int RING_BYTES = 131072;
constexpr int MISC_OFF = LDS_BYTES - 256;

#define RLX_AGENT __ATOMIC_RELAXED, __HIP_MEMORY_SCOPE_AGENT
#define LDS_WAIT() asm volatile("s_waitcnt lgkmcnt(0)" ::: "memory")
#define VM_WAIT() asm volatile("s_waitcnt vmcnt(0)" ::: "memory")
__device__ __forceinline__ unsigned f2bf(float f) { unsigned u = __builtin_bit_cast(unsigned, f); return (u + 0x7fffu + ((u >> 16) & 1u)) >> 16; }
__device__ __forceinline__ float bf2f(unsigned h) { return __builtin_bit_cast(float, h << 16); }
__device__ __forceinline__ unsigned pk2(float lo, float hi) { f32x2 v = {lo, hi}; bf16x2_t b = __builtin_convertvector(v, bf16x2_t); return __builtin_bit_cast(unsigned, b); }
__device__ __forceinline__ float bflo(unsigned w) { return __builtin_bit_cast(float, w << 16); }
__device__ __forceinline__ float bfhi(unsigned w) { return __builtin_bit_cast(float, w & 0xffff0000u); }
__device__ __forceinline__ float sigmoidf_(float x) { return 1.0f / (1.0f + __expf(-x)); }
__device__ __forceinline__ float gelu_erf(float x) { return 0.5f * x * (1.0f + erff(x * 0.70710678118654752f)); }
__device__ __forceinline__ float shx(float v, int m, int lane) { return __builtin_bit_cast(float, __builtin_amdgcn_ds_bpermute((lane ^ m) << 2, __builtin_bit_cast(int, v))); }
__device__ __forceinline__ unsigned shxu(unsigned v, int m, int lane) { return (unsigned)__builtin_amdgcn_ds_bpermute((lane ^ m) << 2, (int)v); }
__device__ __forceinline__ void swap32(unsigned v, unsigned& r0, unsigned& r1) { unsigned b = v; asm volatile("" : "+v"(b)); auto r = __builtin_amdgcn_permlane32_swap(v, b, false, false); r0 = r[0]; r1 = r[1]; }
__device__ __forceinline__ float other32(float v, int hi) { unsigned r0, r1; swap32(__builtin_bit_cast(unsigned, v), r0, r1); return __builtin_bit_cast(float, hi ? r0 : r1); }
__device__ __forceinline__ float add32(float v) { unsigned r0, r1; swap32(__builtin_bit_cast(unsigned, v), r0, r1); return __builtin_bit_cast(float, r0) + __builtin_bit_cast(float, r1); }
__device__ __forceinline__ float max32(float v) { unsigned r0, r1; swap32(__builtin_bit_cast(unsigned, v), r0, r1); return fmaxf(__builtin_bit_cast(float, r0), __builtin_bit_cast(float, r1)); }
__device__ __forceinline__ unsigned umax32(unsigned v) { unsigned r0, r1; swap32(v, r0, r1); return r0 > r1 ? r0 : r1; }
__device__ __forceinline__ float wave_sum(float v, int lane) {
#pragma unroll
    for (int o = 1; o < 32; o <<= 1) v += shx(v, o, lane);
    return add32(v);
}
namespace pg8 {
#define PG8_LAS __attribute__((address_space(3)))
typedef unsigned short bf16_t;
typedef short bf16x8 __attribute__((ext_vector_type(8)));
typedef float f32x4 __attribute__((ext_vector_type(4)));
typedef unsigned u32x4 __attribute__((ext_vector_type(4)));
constexpr int BM = 256, BK = 64, HALF = 128, HTB = HALF * BK * 2  , STAGE_BYTES = 8 * HTB, NXCD = 8, WGM = 8;

__host__ __device__ __forceinline__ int lds_byte(int r, int c) { const int st = (r >> 4) * 2 + (c >> 5), rr = r & 15, cc = c & 31, ob = rr * 64 + cc * 2; return st * 1024 + (ob ^ (((ob >> 9) & 1) << 5)); }
__host__ __device__ __forceinline__ void stage_rc(int b, int& R, int& C) { const int st = b / 1024, sb = b % 1024, swz = sb ^ (((sb >> 9) & 1) << 5); R = (st >> 1) * 16 + swz / 64; C = (st & 1) * 32 + (swz % 64) / 2; }
__host__ __device__ __forceinline__ int perm32(int rho) { const int n = rho >> 4, i = rho & 15; return 8 * (i >> 2) + 4 * n + (i & 3); }

struct Unit { int pm, pn; };
struct Gemm { const bf16_t* A; const bf16_t* Bt; int M, N, K; };

struct StaticOrder {
    int nM, nN, nwg, G, c;
    __host__ __device__ void init(int M, int N, int G_, int c_) { nM = M / BM; nN = N / BM; nwg = nM * nN; G = G_; c = c_; }
    __host__ __device__ bool next(int i, Unit& u) const {
        const long L = (long)i * G + c; if (L >= nwg) return false;
        int wgid = (int)L; { const int q = nwg / NXCD, r = nwg % NXCD, xcd = wgid % NXCD, off = wgid / NXCD; wgid = (xcd < r ? xcd * (q + 1) : r * (q + 1) + (xcd - r) * q) + off; }
        const int nig = WGM * nN, gid = wgid / nig, fm = gid * WGM, gsz = (nM - fm) < WGM ? (nM - fm) : WGM;
        u.pm = fm + ((wgid % nig) % gsz); u.pn = (wgid % nig) / gsz; return true;
    }
    __device__ __forceinline__ void a_ready(const Unit&) const {}
    __device__ __forceinline__ void done(const Unit&) const {}
};

__device__ __forceinline__ unsigned cvt_pk_bf16(float lo, float hi) { unsigned r; asm volatile("v_cvt_pk_bf16_f32 %0, %1, %2" : "=v"(r) : "v"(lo), "v"(hi)); return r; }
typedef float f32x2 __attribute__((ext_vector_type(2)));
template <class Epi, class Sched, bool ALIGN_EPI = false, bool SP2 = false>
__device__ __forceinline__ void gemm_phase(PG8_LAS unsigned char* lds, const Gemm g, const Sched& S, const Epi& E, const int tid) {
    const int wid = __builtin_amdgcn_readfirstlane(tid >> 6), lane = tid & 63, wr = wid >> 2, wc = wid & 3, fr = lane & 15, fq = lane >> 4;
    const int K = g.K, nt = K / BK;
    unsigned voffA[2], voffB[2];
#pragma unroll
    for (int i = 0; i < 2; ++i) { int R, C; stage_rc(tid * 16 + i * 8192, R, C); const int Rb = Epi::PERM ? ((R & ~31) + perm32(R & 31)) : R;
        voffA[i] = (unsigned)(R * K + C) * 2u; voffB[i] = (unsigned)(Rb * K + C) * 2u; }
    const size_t kstep = (size_t)(BK * 2);
    const size_t hstep = (size_t)HALF * K * 2;
    const size_t tstep = 2 * hstep;
    const unsigned ldsw = (unsigned)wid * 1024u;
    const int aoff = lds_byte(wr * 64 + fr, fq * 8), boff = lds_byte(wc * 32 + fr, fq * 8);
#define PG8_SA(b, h) (((b) * 2 + (h)) * HTB)
#define PG8_SB(b, h) ((4 + (b) * 2 + (h)) * HTB)
#define PG8_STAGE(bufoff, gbase, voff) do { _Pragma("unroll") for (int _i = 0; _i < 2; ++_i) \
        __builtin_amdgcn_global_load_lds((const unsigned*)((const char*)(gbase) + (voff)[_i]), (PG8_LAS unsigned*)(lds + (bufoff) + ldsw + _i * 8192), 16, 0, 0); } while (0)
#define PG8_LDA(dst, b, h) do { _Pragma("unroll") for (int m = 0; m < 4; ++m) _Pragma("unroll") for (int k = 0; k < 2; ++k) dst[m][k] = *(const PG8_LAS bf16x8*)(lds + PG8_SA(b, h) + aoff + m * 2048 + k * 1024); } while (0)
#define PG8_LDB(dst, b, h) do { _Pragma("unroll") for (int n = 0; n < 2; ++n) _Pragma("unroll") for (int k = 0; k < 2; ++k) dst[n][k] = *(const PG8_LAS bf16x8*)(lds + PG8_SB(b, h) + boff + n * 2048 + k * 1024); } while (0)
#define PG8_MMA(ai, bj, At, Bt) do { __builtin_amdgcn_s_setprio(1); _Pragma("unroll") for (int m = 0; m < 4; ++m) _Pragma("unroll") for (int n = 0; n < 2; ++n) _Pragma("unroll") for (int k = 0; k < 2; ++k) \
        acc[ai][bj][m][n] = __builtin_amdgcn_mfma_f32_16x16x32_bf16(Bt[n][k], At[m][k], acc[ai][bj][m][n], 0, 0, 0); __builtin_amdgcn_s_setprio(0); } while (0)
#define PG8_WAIT_V(n) asm volatile("s_waitcnt vmcnt(" #n ")" ::: "memory")
#define PG8_WAIT_L(n) asm volatile("s_waitcnt lgkmcnt(" #n ")" ::: "memory")
#define PG8_BAR __builtin_amdgcn_s_barrier()
#define PG8_SCHED __builtin_amdgcn_sched_barrier(0)
    Unit cur, nxt; int ui = 0;
    if (!S.next(0, cur)) return;
    f32x4 acc[2][2][4][2];
#pragma unroll
    for (int a = 0; a < 2; ++a)
#pragma unroll
        for (int b = 0; b < 2; ++b)
#pragma unroll
            for (int m = 0; m < 4; ++m)
#pragma unroll
                for (int n = 0; n < 2; ++n) acc[a][b][m][n] = (f32x4){0.f, 0.f, 0.f, 0.f};
    bf16x8 At[4][2], B0[2][2], B1[2][2];
    const char* cA = (const char*)g.A + (size_t)cur.pm * tstep; const char* cB = (const char*)g.Bt + (size_t)cur.pn * tstep;
    S.a_ready(cur);
    if constexpr (SP2) {
        PG8_STAGE(PG8_SB(0, 0), cB, voffB); PG8_STAGE(PG8_SB(0, 1), cB + hstep, voffB); PG8_STAGE(PG8_SA(0, 0), cA, voffA); PG8_STAGE(PG8_SA(0, 1), cA + hstep, voffA);
        if (wr == 1) PG8_BAR;
        PG8_WAIT_V(2); PG8_BAR;
        PG8_STAGE(PG8_SB(1, 0), cB + kstep, voffB); PG8_STAGE(PG8_SA(1, 0), cA + kstep, voffA); PG8_STAGE(PG8_SB(1, 1), cB + hstep + kstep, voffB);
        PG8_WAIT_V(6); PG8_BAR;
    } else {
        PG8_STAGE(PG8_SB(0, 0), cB, voffB); PG8_STAGE(PG8_SA(0, 0), cA, voffA); PG8_STAGE(PG8_SB(0, 1), cB + hstep, voffB); PG8_STAGE(PG8_SA(0, 1), cA + hstep, voffA);
        if (wr == 1) PG8_BAR;
        PG8_WAIT_V(4); PG8_BAR;
        PG8_STAGE(PG8_SB(1, 0), cB + kstep, voffB); PG8_STAGE(PG8_SA(1, 0), cA + kstep, voffA); PG8_STAGE(PG8_SB(1, 1), cB + hstep + kstep, voffB);
        PG8_WAIT_V(6); PG8_BAR;
    }
    for (;;) {
        const bool has_next = S.next(ui + 1, nxt);
        const char* nA = has_next ? (const char*)g.A + (size_t)nxt.pm * tstep : cA; const char* nB = has_next ? (const char*)g.Bt + (size_t)nxt.pn * tstep : cB;
        for (int t = 0; t < nt; t += 2) {
            const bool last = (t == nt - 2);
            const char* a1 = cA + (size_t)(t + 1) * kstep;
            const char* a2 = last ? nA : cA + (size_t)(t + 2) * kstep; const char* b2 = last ? nB : cB + (size_t)(t + 2) * kstep;
            const char* a3 = a2 + kstep; const char* b3 = b2 + kstep;
            if (last && has_next) S.a_ready(nxt);
            if constexpr (SP2) {
            PG8_LDB(B0, 0, 0); PG8_LDB(B1, 0, 1); PG8_SCHED; PG8_LDA(At, 0, 0); PG8_STAGE(PG8_SA(1, 1), a1 + hstep, voffA);
            PG8_WAIT_V(8); PG8_WAIT_L(0); PG8_BAR; PG8_MMA(0, 0, At, B0); PG8_MMA(0, 1, At, B1); PG8_BAR; PG8_SCHED;
            PG8_LDA(At, 0, 1); PG8_STAGE(PG8_SB(0, 0), b2, voffB); PG8_STAGE(PG8_SB(0, 1), b2 + hstep, voffB); PG8_STAGE(PG8_SA(0, 0), a2, voffA);
            PG8_WAIT_V(8); PG8_WAIT_L(0); PG8_BAR; PG8_MMA(1, 0, At, B0); PG8_MMA(1, 1, At, B1); PG8_BAR; PG8_SCHED;
            PG8_LDB(B0, 1, 0); PG8_LDB(B1, 1, 1); PG8_SCHED; PG8_LDA(At, 1, 0); PG8_STAGE(PG8_SA(0, 1), a2 + hstep, voffA);
            PG8_WAIT_V(8); PG8_WAIT_L(0); PG8_BAR; PG8_MMA(0, 0, At, B0); PG8_MMA(0, 1, At, B1); PG8_BAR; PG8_SCHED;
            PG8_LDA(At, 1, 1); PG8_STAGE(PG8_SB(1, 0), b3, voffB); PG8_STAGE(PG8_SB(1, 1), b3 + hstep, voffB); PG8_STAGE(PG8_SA(1, 0), a3, voffA);
            PG8_WAIT_V(8); PG8_WAIT_L(0); PG8_BAR; PG8_MMA(1, 0, At, B0); PG8_MMA(1, 1, At, B1); PG8_BAR; PG8_SCHED;
            } else {
            PG8_LDB(B0, 0, 0); PG8_SCHED; PG8_LDA(At, 0, 0); PG8_STAGE(PG8_SA(1, 1), a1 + hstep, voffA);
            PG8_WAIT_L(8); PG8_BAR; PG8_WAIT_L(0); PG8_MMA(0, 0, At, B0); PG8_BAR; PG8_SCHED;
            PG8_LDB(B1, 0, 1); PG8_STAGE(PG8_SB(0, 0), b2, voffB);
            PG8_BAR; PG8_WAIT_L(0); PG8_MMA(0, 1, At, B1); PG8_BAR;
            PG8_LDA(At, 0, 1); PG8_STAGE(PG8_SA(0, 0), a2, voffA);
            PG8_BAR; PG8_WAIT_L(0); PG8_MMA(1, 0, At, B0); PG8_BAR; PG8_SCHED;
            PG8_STAGE(PG8_SB(0, 1), b2 + hstep, voffB);
            PG8_WAIT_V(6); PG8_BAR; PG8_MMA(1, 1, At, B1); PG8_BAR;
            PG8_LDB(B0, 1, 0); PG8_SCHED; PG8_LDA(At, 1, 0); PG8_STAGE(PG8_SA(0, 1), a2 + hstep, voffA);
            PG8_WAIT_L(8); PG8_BAR; PG8_WAIT_L(0); PG8_MMA(0, 0, At, B0); PG8_BAR; PG8_SCHED;
            PG8_LDB(B1, 1, 1); PG8_STAGE(PG8_SB(1, 0), b3, voffB);
            PG8_BAR; PG8_WAIT_L(0); PG8_MMA(0, 1, At, B1); PG8_BAR;
            PG8_LDA(At, 1, 1); PG8_STAGE(PG8_SA(1, 0), a3, voffA);
            PG8_BAR; PG8_WAIT_L(0); PG8_MMA(1, 0, At, B0); PG8_BAR; PG8_SCHED;
            PG8_STAGE(PG8_SB(1, 1), b3 + hstep, voffB);
            PG8_WAIT_V(6); PG8_BAR; PG8_MMA(1, 1, At, B1); PG8_BAR;
            }
        }
        if constexpr (ALIGN_EPI) { if (wr == 0) PG8_BAR; }
        if constexpr (!Epi::AFTER_DRAIN) { E(acc, cur, wr, wc, fr, fq); S.done(cur); }
        if (!has_next) break;
#pragma unroll
        for (int a = 0; a < 2; ++a)
#pragma unroll
            for (int b = 0; b < 2; ++b)
#pragma unroll
                for (int m = 0; m < 4; ++m)
#pragma unroll
                    for (int n = 0; n < 2; ++n) acc[a][b][m][n] = (f32x4){0.f, 0.f, 0.f, 0.f};
        cur = nxt; cA = nA; cB = nB; ++ui;
        if constexpr (ALIGN_EPI) { if (wr == 1) PG8_BAR; }
    }
    PG8_WAIT_V(0);
    if constexpr (!ALIGN_EPI) { if (wr == 0) PG8_BAR; }
    PG8_BAR;
    if constexpr (Epi::AFTER_DRAIN) { E.fused(acc, cur, wr, wc, fr, fq, lds, wid, lane); S.done(cur); }
#undef PG8_SA
#undef PG8_SB
#undef PG8_STAGE
#undef PG8_LDA
#undef PG8_LDB
#undef PG8_MMA
#undef PG8_WAIT_V
#undef PG8_WAIT_L
#undef PG8_BAR
#undef PG8_SCHED
}
}
#define XB_TMO      128
#define XB_XCNT(j)  (256  + 64 * (j))
#define XB_XSUB(j)  (1280 + 64 * (j))
#define XB_XGEN(j)  (2304 + 64 * (j))
#define XB_TOP      3328
#define XB_TOPGEN   3392
#define XCD_BAR_WORDS 3456
#define XB_SPIN_CAP (1u << 25)

__device__ __forceinline__ unsigned xb_ld(unsigned* p)              { return __hip_atomic_load(p, __ATOMIC_RELAXED, __HIP_MEMORY_SCOPE_AGENT); }
__device__ __forceinline__ unsigned xb_add(unsigned* p, unsigned v) { return __hip_atomic_fetch_add(p, v, __ATOMIC_RELAXED, __HIP_MEMORY_SCOPE_AGENT); }
__device__ __forceinline__ unsigned xb_xcc_id() { return (unsigned)__builtin_amdgcn_s_getreg((3 << 11) | 20) & 0xFu; }
#define XB_SPIN(cond, bar) do { unsigned _sp = 0; while (cond) { __builtin_amdgcn_s_sleep(1); \
    if ((++_sp & 255u) == 0u) { if (xb_ld(&(bar)[XB_TMO])) break; if (_sp > XB_SPIN_CAP) { atomicAdd(&(bar)[XB_TMO], 1u); break; } } } } while (0)

struct XcdBarrier {
    unsigned* bar; unsigned x;
    volatile LAS unsigned* st;
};

__device__ __forceinline__ XcdBarrier xcd_barrier_post(unsigned* bar, volatile LAS unsigned* st) {
    XcdBarrier b; b.bar = bar; b.x = xb_xcc_id(); b.st = st;
    if (threadIdx.x == 0) (void)xb_add(&bar[XB_XCNT(b.x)], 1u);
    return b;
}
__device__ __forceinline__ void xcd_barrier_complete(unsigned* bar, unsigned x, unsigned& nloc, unsigned& nx) {
    const unsigned G = gridDim.x * gridDim.y * gridDim.z;
    unsigned sum, cnt, mine, sp = 0u;
    for (;;) {
        sum = 0u; cnt = 0u; mine = 0u;
#pragma unroll
        for (unsigned j = 0; j < 16; ++j) { const unsigned c = xb_ld(&bar[XB_XCNT(j)]); sum += c; cnt += (c > 0u) ? 1u : 0u; mine = (j == x) ? c : mine; }
        if (sum == G) break;
        __builtin_amdgcn_s_sleep(1);
        if ((++sp & 255u) == 0u) { if (xb_ld(&bar[XB_TMO])) break; if (sp > XB_SPIN_CAP) { atomicAdd(&bar[XB_TMO], 1u); break; } }
    }
    nloc = mine > 0u ? mine : 1u; nx = cnt > 0u ? cnt : 1u;
}

__device__ __forceinline__ void xcd_barrier(const XcdBarrier& b) {
    asm volatile("s_waitcnt vmcnt(0)" ::: "memory");
    __syncthreads();
    if (threadIdx.x == 0) {
        unsigned* bar = b.bar;
        __builtin_amdgcn_s_waitcnt(0);
        unsigned nloc = b.st[0], nx = b.st[1];
        if (nloc == 0u) { xcd_barrier_complete(bar, b.x, nloc, nx); b.st[0] = nloc; b.st[1] = nx; }
        const unsigned old = xb_add(&bar[XB_XSUB(b.x)], 1u);
        const unsigned gen = old / nloc;
        if (old + 1u == (gen + 1u) * nloc) {
            __builtin_amdgcn_fence(__ATOMIC_RELEASE, "agent");
            asm volatile("s_waitcnt vmcnt(0)" ::: "memory");
            const unsigned og = xb_add(&bar[XB_TOP], 1u);
            const unsigned tg = og / nx;
            if (og + 1u == (tg + 1u) * nx) xb_add(&bar[XB_TOPGEN], 1u);
            else XB_SPIN(xb_ld(&bar[XB_TOPGEN]) == tg, bar);
            __builtin_amdgcn_fence(__ATOMIC_ACQUIRE, "agent");
            xb_add(&bar[XB_XGEN(b.x)], 1u);
            asm volatile("s_waitcnt vmcnt(0)" ::: "memory");
        } else {
            XB_SPIN(xb_ld(&bar[XB_XGEN(b.x)]) == gen, bar);
            __builtin_amdgcn_fence(__ATOMIC_ACQUIRE, "agent");
            asm volatile("s_waitcnt vmcnt(0)" ::: "memory");
        }
    }
    __syncthreads();
}

namespace epi {
using pg8::Unit; using pg8::BM; using pg8::HALF;
typedef const pg8::f32x4 (&AccRef)[2][2][4][2];

struct EpiProj1 {
    static constexpr bool PERM = false, AFTER_DRAIN = false;
    bf16* O; const float* cosT; const float* sinT;
    __device__ __forceinline__ void operator()(AccRef acc, const Unit& u, int wr, int wc, int fr, int fq) const {
        const int row0 = u.pm * BM + wr * 64 + fr, colw = u.pn * BM + wc * 32;
#pragma unroll
        for (int bj = 0; bj < 2; ++bj) {
            const int hb = (colw + bj * HALF) >> 6;
            const bool rope = (hb >= 40 && hb < 50) || (hb >= 52 && hb < 54) || (hb >= 56 && hb < 58) || (hb >= 60 && hb < 76);
            const bool isq = (hb >= 40 && hb < 48) || (hb >= 60 && hb < 68);
            const float qs = isq ? QSCALE : 1.0f;
            const int jw = (wc & 1) * 16 + fq * 2;
#pragma unroll
            for (int ai = 0; ai < 2; ++ai)
#pragma unroll
                for (int m = 0; m < 4; ++m) {
                    const int row = row0 + ai * HALF + m * 16;
                    bf16* rowp = O + (size_t)row * NP1 + colw + bj * HALF + 4 * fq;
#pragma unroll
                    for (int n = 0; n < 2; ++n) {
                        pg8::f32x4 v = acc[ai][bj][m][n];
                        if (rope) {
                            const f32x2 c = *(const f32x2*)(cosT + (size_t)row * 32 + jw + n * 8), s = *(const f32x2*)(sinT + (size_t)row * 32 + jw + n * 8);
                            const float y0 = v[0] * c.x - v[1] * s.x, y1 = v[1] * c.x + v[0] * s.x, y2 = v[2] * c.y - v[3] * s.y, y3 = v[3] * c.y + v[2] * s.y;
                            v[0] = y0 * qs; v[1] = y1 * qs; v[2] = y2 * qs; v[3] = y3 * qs;
                        }
                        v2u w; w.x = pk2(v[0], v[1]); w.y = pk2(v[2], v[3]);
                        *(v2u*)(rowp + n * 16) = w;
                    }
                }
        }
    }
};
template <int ACT> struct EpiStore {
    static constexpr bool PERM = false, AFTER_DRAIN = false;
    bf16* O; int ldc;
    __device__ __forceinline__ void operator()(AccRef acc, const Unit& u, int wr, int wc, int fr, int fq) const {
        const int row0 = u.pm * BM + wr * 64 + fr, col0 = u.pn * BM + wc * 32 + 4 * fq;
#pragma unroll
        for (int ai = 0; ai < 2; ++ai)
#pragma unroll
            for (int m = 0; m < 4; ++m) { bf16* rowp = O + (size_t)(row0 + ai * HALF + m * 16) * ldc + col0;
#pragma unroll
                for (int bj = 0; bj < 2; ++bj)
#pragma unroll
                    for (int n = 0; n < 2; ++n) { pg8::f32x4 v = acc[ai][bj][m][n];
                        if (ACT == 1) { v[0] = sigmoidf_(v[0]); v[1] = sigmoidf_(v[1]); v[2] = sigmoidf_(v[2]); v[3] = sigmoidf_(v[3]); }
                        v2u w; w.x = pk2(v[0], v[1]); w.y = pk2(v[2], v[3]); *(v2u*)(rowp + bj * HALF + n * 16) = w; } }
    }
};
struct EpiMerge {
    static constexpr bool PERM = false, AFTER_DRAIN = false;
    bf16* O; const bf16* G; int seg;
    __device__ __forceinline__ void operator()(AccRef acc, const Unit& u, int wr, int wc, int fr, int fq) const {
        const int row0 = u.pm * BM + wr * 64 + fr, col0 = u.pn * BM + wc * 32 + 4 * fq;
#pragma unroll
        for (int ai = 0; ai < 2; ++ai)
#pragma unroll
            for (int m = 0; m < 4; ++m) { const size_t row = (size_t)(row0 + ai * HALF + m * 16); bf16* rowp = O + row * DM + col0; const bf16* gp = G + row * NGT + seg * DM + col0;
#pragma unroll
                for (int bj = 0; bj < 2; ++bj)
#pragma unroll
                    for (int n = 0; n < 2; ++n) { pg8::f32x4 v = acc[ai][bj][m][n];
                        const v2u g = *(const v2u*)(gp + bj * HALF + n * 16);
                        v[0] *= bflo(g.x); v[1] *= bfhi(g.x); v[2] *= bflo(g.y); v[3] *= bfhi(g.y);
                        if (seg != 0) { const v2u o = *(const v2u*)(rowp + bj * HALF + n * 16); v[0] += bflo(o.x); v[1] += bfhi(o.x); v[2] += bflo(o.y); v[3] += bfhi(o.y); }
                        v2u w; w.x = pk2(v[0], v[1]); w.y = pk2(v[2], v[3]); *(v2u*)(rowp + bj * HALF + n * 16) = w; } }
    }
};
struct EpiResid {
    static constexpr bool PERM = false, AFTER_DRAIN = false;
    const float* XI; float* XO; const float* gate;
    __device__ __forceinline__ void operator()(AccRef acc, const Unit& u, int wr, int wc, int fr, int fq) const {
        const int row0 = u.pm * BM + wr * 64 + fr, col0 = u.pn * BM + wc * 32 + 4 * fq;
        const float* gb = gate + (size_t)((u.pm * BM) / SEQ) * 6144 + col0;
        pg8::f32x4 gv[2][2];
#pragma unroll
        for (int bj = 0; bj < 2; ++bj)
#pragma unroll
            for (int n = 0; n < 2; ++n) gv[bj][n] = *(const pg8::f32x4*)(gb + bj * HALF + n * 16);
#pragma unroll
        for (int ai = 0; ai < 2; ++ai)
#pragma unroll
            for (int m = 0; m < 4; ++m) { const size_t off = (size_t)(row0 + ai * HALF + m * 16) * DM + col0;
#pragma unroll
                for (int bj = 0; bj < 2; ++bj)
#pragma unroll
                    for (int n = 0; n < 2; ++n) { const pg8::f32x4 xi = *(const pg8::f32x4*)(XI + off + bj * HALF + n * 16);
                        *(pg8::f32x4*)(XO + off + bj * HALF + n * 16) = xi + gv[bj][n] * acc[ai][bj][m][n]; } }
    }
};
}

constexpr int NWAVES = 8, NTHR = 512;
struct Args { const void* in[26]; float* out; unsigned char* ws; int ph_lo, ph_hi; };
enum InIdx { I_X = 0, I_C, I_POS, I_MODW, I_MODB, I_NMG, I_NFG, I_WIN, I_ACW, I_AOUT, I_BCW, I_BCB, I_BLNG, I_BLNB, I_BOUT, I_CPOS, I_CW1, I_CW2, I_COUT, I_DOUT, I_WO, I_PWQ, I_PSUB, I_PU, I_PV, I_FNG };

struct Frame {
    LAS unsigned char* lds; unsigned char* ldsg;
    int tid, lane, wave, G, bid;
    unsigned char* ws;
};
__device__ __forceinline__ int gwave(const Frame& F) { return F.bid * NWAVES + F.wave; }
__device__ __forceinline__ int ngwave(const Frame& F) { return F.G * NWAVES; }

__device__ __forceinline__ int rope_pos_of_dim(int d) { return d < 32 ? 2 * d : 2 * (d - 32) + 1; }
__device__ __forceinline__ int rope_dim_of_pos(int p) { return (p >> 1) + 32 * (p & 1); }
__device__ __forceinline__ int win_row_of_col(int n) {
    if (n < 2560) return n;
    if (n < 3072) { const int c = n - 2560; return C_CQ + (c & ~63) + rope_pos_of_dim(c & 63); }
    if (n < 3200) { const int c = n - 3072; return C_KC + (c & ~63) + rope_pos_of_dim(c & 63); }
    if (n < 3328) return C_VC + (n - 3200);
    if (n < 3456) { const int c = n - 3328; return C_KS + (c & ~63) + rope_pos_of_dim(c & 63); }
    if (n < 3584) return C_VS + (n - 3456);
    if (n < 3712) { const int c = n - 3584; return C_KW + (c & ~63) + rope_pos_of_dim(c & 63); }
    if (n < 3840) return C_VW + (n - 3712);
    if (n < 3864) return C_CG + (n - 3840);
    if (n < 4376) { const int c = n - 3864; return C_DQ + (c & ~63) + rope_pos_of_dim(c & 63); }
    if (n < 4888) { const int c = n - 4376; return C_DK + (c & ~63) + rope_pos_of_dim(c & 63); }
    if (n < 5400) return C_DV + (n - 4888);
    return NP1 + (n - 5400);
}
template <int MODE, bool KPERM>
__device__ __forceinline__ void transpose_item(const float* W, int K, int N, bf16* WT, LAS float* scr, int item, int lane) {
    const int nblk = (N + 31) / 32, kb = item / nblk, nb = item % nblk, k0 = 64 * kb, n0 = 32 * nb;
    const int nsrc = n0 + (lane & 31); const bool nok = nsrc < N;
#pragma unroll 8
    for (int i = 0; i < 32; ++i) { const int kk = 2 * i + (lane >> 5); scr[kk * 33 + (lane & 31)] = nok ? W[(size_t)(k0 + kk) * N + nsrc] : 0.f; }
    LDS_WAIT(); asm volatile("" ::: "memory");
    const int c = lane & 7;
#pragma unroll
    for (int j = 0; j < 4; ++j) { const int n = (lane >> 3) + 8 * j;
        float s[8];
#pragma unroll
        for (int e = 0; e < 8; ++e) { const int p = 8 * c + e; const int ks = KPERM ? rope_dim_of_pos(p) : p; s[e] = scr[ks * 33 + n]; }
        v4u o; o.x = pk2(s[0], s[1]); o.y = pk2(s[2], s[3]); o.z = pk2(s[4], s[5]); o.w = pk2(s[6], s[7]);
        if (n0 + n < N) { const int row = (MODE == 1) ? win_row_of_col(n0 + n) : (n0 + n); *(v4u*)(WT + (size_t)row * K + k0 + 8 * c) = o; } }
    LDS_WAIT(); asm volatile("" ::: "memory");
}
template <int MODE, bool KPERM>
__device__ __forceinline__ void transpose_matrix(const Frame& F, const float* W, int K, int N, bf16* WT, int& base) {
    LAS float* scr = (LAS float*)(F.lds + F.wave * 16384);
    const int nitems = (K / 64) * ((N + 31) / 32), gw = gwave(F), NGW = ngwave(F);
    int first = (gw - base % NGW + NGW) % NGW;
    for (int it = first; it < nitems; it += NGW) transpose_item<MODE, KPERM>(W, K, N, WT, scr, it, F.lane);
    base += nitems;
}
__device__ __forceinline__ void convert_copy(const Frame& F, const float* src, bf16* dst, size_t n) {
    const size_t nth = (size_t)F.G * NTHR, t0 = (size_t)F.bid * NTHR + F.tid;
    for (size_t i = t0; i < n / 8; i += nth) { const f32x4 a = *(const f32x4*)(src + i * 8), b = *(const f32x4*)(src + i * 8 + 4);
        v4u o; o.x = pk2(a[0], a[1]); o.y = pk2(a[2], a[3]); o.z = pk2(b[0], b[1]); o.w = pk2(b[2], b[3]); *(v4u*)(dst + i * 8) = o; }
}

typedef __attribute__((address_space(4))) const Args* KArgsP;
__device__ __forceinline__ void phase_prologue(const Frame& F, KArgsP Ap) {
    unsigned char* ws = F.ws;
    int base = 0;
    for (int l = 0; l < DEPTH; ++l) {
        transpose_matrix<1, false>(F, (const float*)Ap->in[I_WIN] + (size_t)l * DM * 9496, DM, 9496, (bf16*)(ws + WS_WIN) + (size_t)l * NWIN * DM, base);
        transpose_matrix<0, false>(F, (const float*)Ap->in[I_AOUT] + (size_t)l * 512 * DM, 512, DM, (bf16*)(ws + WS_WOUT) + (size_t)(l * 4 + 0) * DM * 512, base);
        transpose_matrix<0, false>(F, (const float*)Ap->in[I_BOUT] + (size_t)l * 512 * DM, 512, DM, (bf16*)(ws + WS_WOUT) + (size_t)(l * 4 + 1) * DM * 512, base);
        transpose_matrix<0, false>(F, (const float*)Ap->in[I_COUT] + (size_t)l * 512 * DM, 512, DM, (bf16*)(ws + WS_WOUT) + (size_t)(l * 4 + 2) * DM * 512, base);
        transpose_matrix<0, false>(F, (const float*)Ap->in[I_DOUT] + (size_t)l * 512 * DM, 512, DM, (bf16*)(ws + WS_WOUT) + (size_t)(l * 4 + 3) * DM * 512, base);
        transpose_matrix<0, false>(F, (const float*)Ap->in[I_WO] + (size_t)l * DM * DM, DM, DM, (bf16*)(ws + WS_WO) + (size_t)l * DM * DM, base);
        transpose_matrix<0, false>(F, (const float*)Ap->in[I_PWQ] + (size_t)l * DM * 2048, DM, 2048, (bf16*)(ws + WS_WQ) + (size_t)l * 2048 * DM, base);
        transpose_matrix<0, true>(F, (const float*)Ap->in[I_CW1] + (size_t)(l * 2 + 0) * 2048 * 128, 2048, 128, (bf16*)(ws + WS_W1T) + (size_t)(l * 2 + 0) * 128 * 2048, base);
        transpose_matrix<0, false>(F, (const float*)Ap->in[I_CW1] + (size_t)(l * 2 + 1) * 2048 * 128, 2048, 128, (bf16*)(ws + WS_W1T) + (size_t)(l * 2 + 1) * 128 * 2048, base);
    }
    convert_copy(F, (const float*)Ap->in[I_PSUB], (bf16*)(ws + WS_SUBK), (size_t)DEPTH * 8 * 2 * 128 * 128);
    const int gt = F.bid * NTHR + F.tid, NGT_ = F.G * NTHR;
    { const float* w2 = (const float*)Ap->in[I_CW2]; bf16* w2t = (bf16*)(ws + WS_SMALL + SM_W2T);
      for (int i = gt; i < DEPTH * 2 * 64 * 128; i += NGT_) { const int k = i & 127, n = (i >> 7) & 63, lw = i >> 13; w2t[i] = (bf16)f2bf(w2[((size_t)lw * 128 + k) * 64 + n]); } }
    { const int* pos = (const int*)Ap->in[I_POS]; float* ct = (float*)(ws + WS_COS); float* st = (float*)(ws + WS_SIN);
      for (int i = gt; i < TOK * 32; i += NGT_) { const int t = i >> 5, j = i & 31;
          const float inv = 1.0f / powf(10000.0f, (float)(2 * j) / 64.0f); const float ang = (float)pos[t] * inv;
          ct[i] = (float)cos((double)ang); st[i] = (float)sin((double)ang); } }
    { const float* w1 = (const float*)Ap->in[I_CW1]; const float* cp = (const float*)Ap->in[I_CPOS]; float* pbp = (float*)(ws + WS_SMALL + SM_PBP);
      for (int i = gt; i < DEPTH * 2 * 16 * 128; i += NGT_) { const int n = i & 127, kc = (i >> 7) & 15, lw = i >> 11; float s = 0.f;
          for (int k = kc * 128; k < kc * 128 + 128; ++k) s += cp[(size_t)lw * 2048 + k] * w1[((size_t)lw * 2048 + k) * 128 + n];
          pbp[i] = s; } }
    __syncthreads();
    { LAS float* cond = (LAS float*)(F.lds);
      LAS float* red = (LAS float*)(F.lds + 32768);
      const float* c = (const float*)Ap->in[I_C];
      for (int i = F.tid; i < 8 * 1024; i += NTHR) { const float v = c[i]; cond[i] = v / (1.0f + __expf(-v)); }
      __syncthreads();
      for (int un = F.bid; un < DEPTH * 96; un += F.G) { const int l = un / 96, n0 = (un % 96) * 64;
          const float* mw = (const float*)Ap->in[I_MODW] + (size_t)l * DM * 6144 + n0 + F.lane;
          float acc[8];
#pragma unroll
          for (int b = 0; b < 8; ++b) acc[b] = 0.f;
#pragma unroll 4
          for (int k = F.wave * 128; k < F.wave * 128 + 128; ++k) { const float w = mw[(size_t)k * 6144];
#pragma unroll
              for (int b = 0; b < 8; ++b) acc[b] += cond[b * 1024 + k] * w; }
#pragma unroll
          for (int b = 0; b < 8; ++b) red[(F.wave * 8 + b) * 64 + F.lane] = acc[b];
          __syncthreads();
          { const int b = F.tid >> 6, n = F.tid & 63; float s = 0.f;
#pragma unroll
            for (int w = 0; w < 8; ++w) s += red[(w * 8 + b) * 64 + n];
            ((float*)(ws + WS_MOD))[((size_t)l * 8 + b) * 6144 + n0 + n] = s + ((const float*)Ap->in[I_MODB])[(size_t)l * 6144 + n0 + n]; }
          __syncthreads(); }
    }
}

__device__ __forceinline__ void phase_norm_mod(const Frame& F, const float* X, const float* g, const float* sh, const float* sc, bf16* O) {
    const int gw = gwave(F), NGW = ngwave(F);
    f32x4 gv[4];
#pragma unroll
    for (int j = 0; j < 4; ++j) gv[j] = *(const f32x4*)(g + 4 * F.lane + 256 * j);
    for (int row = gw; row < TOK; row += NGW) {
        const int b = row / SEQ; const float* xr = X + (size_t)row * DM + 4 * F.lane;
        f32x4 v[4]; float s = 0.f;
#pragma unroll
        for (int j = 0; j < 4; ++j) { v[j] = *(const f32x4*)(xr + 256 * j); s += (v[j][0] * v[j][0] + v[j][1] * v[j][1]) + (v[j][2] * v[j][2] + v[j][3] * v[j][3]); }
        const float r = 1.0f / sqrtf(wave_sum(s, F.lane) * (1.0f / DM) + NORM_EPS);
        bf16* orow = O + (size_t)row * DM + 4 * F.lane;
#pragma unroll
        for (int j = 0; j < 4; ++j) { const f32x4 scv = *(const f32x4*)(sc + (size_t)b * 6144 + 4 * F.lane + 256 * j), shv = *(const f32x4*)(sh + (size_t)b * 6144 + 4 * F.lane + 256 * j);
            const f32x4 y = v[j] * r * gv[j] * (scv + 1.0f) + shv; v2u w; w.x = pk2(y[0], y[1]); w.y = pk2(y[2], y[3]); *(v2u*)(orow + 256 * j) = w; }
    }
}
__device__ __forceinline__ void phase_final_norm(const Frame& F, const float* X, const float* g, float* O) {
    const int gw = gwave(F), NGW = ngwave(F);
    f32x4 gv[4];
#pragma unroll
    for (int j = 0; j < 4; ++j) gv[j] = *(const f32x4*)(g + 4 * F.lane + 256 * j);
    for (int row = gw; row < TOK; row += NGW) {
        const float* xr = X + (size_t)row * DM + 4 * F.lane; f32x4 v[4]; float s = 0.f;
#pragma unroll
        for (int j = 0; j < 4; ++j) { v[j] = *(const f32x4*)(xr + 256 * j); s += (v[j][0] * v[j][0] + v[j][1] * v[j][1]) + (v[j][2] * v[j][2] + v[j][3] * v[j][3]); }
        const float r = 1.0f / sqrtf(wave_sum(s, F.lane) * (1.0f / DM) + NORM_EPS);
        float* orow = O + (size_t)row * DM + 4 * F.lane;
#pragma unroll
        for (int j = 0; j < 4; ++j) *(f32x4*)(orow + 256 * j) = v[j] * r * gv[j];
    }
}

__device__ __forceinline__ void phase_mixer_a(const Frame& F, const bf16* P, const float* cw  , bf16* O  ) {
    const int nth = F.G * NTHR, gt = F.bid * NTHR + F.tid;
    for (int it = gt; it < (TOK / 32) * 64; it += nth) {
        const int cg = it & 63, tb = it >> 6, c0 = cg * 8, t0 = tb * 32, s0 = t0 % SEQ;
        float w0[8], w1[8], w2[8];
#pragma unroll
        for (int e = 0; e < 8; ++e) { w0[e] = cw[c0 + e]; w1[e] = cw[512 + c0 + e]; w2[e] = cw[1024 + c0 + e]; }
        float pm2[8], pm1[8];
#pragma unroll
        for (int e = 0; e < 8; ++e) { pm2[e] = 0.f; pm1[e] = 0.f; }
        for (int pre = 2; pre >= 1; --pre) if (s0 - pre >= 0) { const bf16* r = P + (size_t)(t0 - pre) * NP1;
            const v4u ac = *(const v4u*)(r + C_AC + c0), ax = *(const v4u*)(r + C_AX + c0);
            float pr[8]; pr[0] = bflo(ac.x) * bflo(ax.x); pr[1] = bfhi(ac.x) * bfhi(ax.x); pr[2] = bflo(ac.y) * bflo(ax.y); pr[3] = bfhi(ac.y) * bfhi(ax.y);
            pr[4] = bflo(ac.z) * bflo(ax.z); pr[5] = bfhi(ac.z) * bfhi(ax.z); pr[6] = bflo(ac.w) * bflo(ax.w); pr[7] = bfhi(ac.w) * bfhi(ax.w);
#pragma unroll
            for (int e = 0; e < 8; ++e) { if (pre == 2) pm2[e] = pr[e]; else pm1[e] = pr[e]; } }
        for (int tt = 0; tt < 32; ++tt) { const bf16* r = P + (size_t)(t0 + tt) * NP1;
            const v4u ac = *(const v4u*)(r + C_AC + c0), ax = *(const v4u*)(r + C_AX + c0), ab = *(const v4u*)(r + C_AB + c0);
            float pr[8], bb[8], y[8];
            pr[0] = bflo(ac.x) * bflo(ax.x); pr[1] = bfhi(ac.x) * bfhi(ax.x); pr[2] = bflo(ac.y) * bflo(ax.y); pr[3] = bfhi(ac.y) * bfhi(ax.y);
            pr[4] = bflo(ac.z) * bflo(ax.z); pr[5] = bfhi(ac.z) * bfhi(ax.z); pr[6] = bflo(ac.w) * bflo(ax.w); pr[7] = bfhi(ac.w) * bfhi(ax.w);
            bb[0] = bflo(ab.x); bb[1] = bfhi(ab.x); bb[2] = bflo(ab.y); bb[3] = bfhi(ab.y); bb[4] = bflo(ab.z); bb[5] = bfhi(ab.z); bb[6] = bflo(ab.w); bb[7] = bfhi(ab.w);
#pragma unroll
            for (int e = 0; e < 8; ++e) { y[e] = bb[e] * (w0[e] * pm2[e] + w1[e] * pm1[e] + w2[e] * pr[e]); pm2[e] = pm1[e]; pm1[e] = pr[e]; }
            v4u o; o.x = pk2(y[0], y[1]); o.y = pk2(y[2], y[3]); o.z = pk2(y[4], y[5]); o.w = pk2(y[6], y[7]);
            *(v4u*)(O + (size_t)(t0 + tt) * 512 + c0) = o; }
    }
}

__device__ __forceinline__ void phase_mixer_b(const Frame& F, const bf16* P, const float* cw  , const float* cb, const float* lg, const float* lb, bf16* O) {
    LAS float* U = (LAS float*)F.lds;
    for (int un = F.bid; un < TOK / 32; un += F.G) {
        const int t0 = un * 32, s0 = t0 % SEQ;
        __syncthreads();
        for (int i = F.tid; i < 62 * 64; i += NTHR) { const int r = i >> 6, cg = i & 63, c0 = cg * 8; const int srel = s0 - 30 + r;
            float u[8];
            if (srel >= 0) { const bf16* row = P + (size_t)(t0 - 30 + r) * NP1; const v4u a = *(const v4u*)(row + C_BA + c0), g = *(const v4u*)(row + C_BG + c0);
                u[0] = bflo(a.x) * sigmoidf_(bflo(g.x)); u[1] = bfhi(a.x) * sigmoidf_(bfhi(g.x)); u[2] = bflo(a.y) * sigmoidf_(bflo(g.y)); u[3] = bfhi(a.y) * sigmoidf_(bfhi(g.y));
                u[4] = bflo(a.z) * sigmoidf_(bflo(g.z)); u[5] = bfhi(a.z) * sigmoidf_(bfhi(g.z)); u[6] = bflo(a.w) * sigmoidf_(bflo(g.w)); u[7] = bfhi(a.w) * sigmoidf_(bfhi(g.w)); }
            else {
#pragma unroll
                for (int e = 0; e < 8; ++e) u[e] = 0.f; }
            *(LAS f32x4*)(U + r * 512 + c0) = (f32x4){u[0], u[1], u[2], u[3]}; *(LAS f32x4*)(U + r * 512 + c0 + 4) = (f32x4){u[4], u[5], u[6], u[7]}; }
        __syncthreads();
        const int c0 = F.lane * 8;
        float acc[4][8];
#pragma unroll
        for (int q = 0; q < 4; ++q)
#pragma unroll
            for (int e = 0; e < 8; ++e) acc[q][e] = cb[c0 + e];
        for (int k = 0; k < 31; ++k) { const f32x4 wa = *(const f32x4*)(cw + k * 512 + c0), wb = *(const f32x4*)(cw + k * 512 + c0 + 4);
#pragma unroll
            for (int q = 0; q < 4; ++q) { const int r = 4 * F.wave + q + k; const f32x4 ua = *(LAS f32x4*)(U + r * 512 + c0), ub = *(LAS f32x4*)(U + r * 512 + c0 + 4);
                acc[q][0] += wa[0] * ua[0]; acc[q][1] += wa[1] * ua[1]; acc[q][2] += wa[2] * ua[2]; acc[q][3] += wa[3] * ua[3];
                acc[q][4] += wb[0] * ub[0]; acc[q][5] += wb[1] * ub[1]; acc[q][6] += wb[2] * ub[2]; acc[q][7] += wb[3] * ub[3]; } }
        const f32x4 ga = *(const f32x4*)(lg + c0), gb = *(const f32x4*)(lg + c0 + 4), ba = *(const f32x4*)(lb + c0), bb = *(const f32x4*)(lb + c0 + 4);
#pragma unroll
        for (int q = 0; q < 4; ++q) { float s = 0.f;
#pragma unroll
            for (int e = 0; e < 8; ++e) s += acc[q][e];
            const float mu = wave_sum(s, F.lane) * (1.0f / 512.0f); float v = 0.f;
#pragma unroll
            for (int e = 0; e < 8; ++e) { acc[q][e] -= mu; v += acc[q][e] * acc[q][e]; }
            const float rs = 1.0f / sqrtf(wave_sum(v, F.lane) * (1.0f / 512.0f) + NORM_EPS);
            float y[8];
#pragma unroll
            for (int e = 0; e < 8; ++e) { const float gg = e < 4 ? ga[e] : gb[e - 4], bv = e < 4 ? ba[e] : bb[e - 4]; const float z = acc[q][e] * rs * gg + bv; y[e] = z / (1.0f + __expf(-z)); }
            v4u o; o.x = pk2(y[0], y[1]); o.y = pk2(y[2], y[3]); o.z = pk2(y[4], y[5]); o.w = pk2(y[6], y[7]);
            *(v4u*)(O + (size_t)(t0 + 4 * F.wave + q) * 512 + c0) = o; }
    }
}

__device__ __forceinline__ void phase_compress(const Frame& F, const bf16* P, const bf16* W1T  , const bf16* W2T  , const float* PBP  ,
                                               bf16* KC, bf16* VC  ) {
    LAS bf16* H1 = (LAS bf16*)(F.lds + F.wave * 8192);
    const int gw = gwave(F), NGW = ngwave(F), lane = F.lane, r16 = lane & 15, q4 = lane >> 4;
    for (int un = gw; un < 2 * 8 * 2 * 8; un += NGW) {
        const int nb = un & 7, g = (un >> 3) & 1, b = (un >> 4) & 7, which = un >> 7;
        const int n = nb * 16 + r16; const int nn = n < 127 ? n : 126;
        const int col0 = (which == 0 ? C_KC : C_VC) + g * 64;
        const bf16* arow = P + ((size_t)b * SEQ + nn * 16) * NP1 + col0;
        const bf16* w1 = W1T + (size_t)which * 128 * 2048;
        f32x4 acc[8];
#pragma unroll
        for (int j = 0; j < 8; ++j) acc[j] = (f32x4){0.f, 0.f, 0.f, 0.f};
        for (int ks = 0; ks < 64; ++ks) {
            const int k = ks * 32 + q4 * 8; const bf16x8 a = *(const bf16x8*)(arow + (size_t)(k >> 6) * NP1 + (k & 63));
#pragma unroll
            for (int j = 0; j < 8; ++j) { const bf16x8 bb = *(const bf16x8*)(w1 + (size_t)(j * 16 + r16) * 2048 + k);
                acc[j] = __builtin_amdgcn_mfma_f32_16x16x32_bf16(a, bb, acc[j], 0, 0, 0); } }
#pragma unroll
        for (int j = 0; j < 8; ++j) { float pb = 0.f;
#pragma unroll
            for (int kc = 0; kc < 16; ++kc) pb += PBP[((size_t)which * 16 + kc) * 128 + j * 16 + r16];
#pragma unroll
            for (int i = 0; i < 4; ++i) H1[(4 * q4 + i) * 136 + j * 16 + r16] = (bf16)f2bf(gelu_erf(acc[j][i] + pb)); }
        LDS_WAIT(); asm volatile("" ::: "memory");
        f32x4 o[4];
#pragma unroll
        for (int j = 0; j < 4; ++j) o[j] = (f32x4){0.f, 0.f, 0.f, 0.f};
        const bf16* w2 = W2T + (size_t)which * 64 * 128;
#pragma unroll
        for (int ks = 0; ks < 4; ++ks) { const bf16x8 a = *(LAS bf16x8*)(H1 + r16 * 136 + ks * 32 + q4 * 8);
#pragma unroll
            for (int j = 0; j < 4; ++j) { const bf16x8 bb = *(const bf16x8*)(w2 + (size_t)(j * 16 + r16) * 128 + ks * 32 + q4 * 8);
                o[j] = __builtin_amdgcn_mfma_f32_16x16x32_bf16(a, bb, o[j], 0, 0, 0); } }
        bf16* out = (which == 0 ? KC : VC) + ((size_t)(b * 2 + g) * 128) * 64;
#pragma unroll
        for (int j = 0; j < 4; ++j)
#pragma unroll
            for (int i = 0; i < 4; ++i) { const int row = nb * 16 + 4 * q4 + i; out[(size_t)row * 64 + j * 16 + r16] = row < 127 ? (bf16)f2bf(o[j][i]) : (bf16)0; }
        LDS_WAIT(); asm volatile("" ::: "memory");
    }
}
__device__ __forceinline__ void phase_kmean(const Frame& F, const bf16* P, float* KM) {
    const int gw = gwave(F), NGW = ngwave(F), lane = F.lane, rs = lane >> 3, ch = lane & 7;
    for (int un = gw; un < 8 * 8 * 8; un += NGW) { const int h = un & 7, blk = (un >> 3) & 7, b = un >> 6;
        const bf16* base = P + ((size_t)b * SEQ + blk * 256) * NP1 + C_DK + h * 64 + ch * 8;
        float s[8];
#pragma unroll
        for (int e = 0; e < 8; ++e) s[e] = 0.f;
        for (int i = 0; i < 32; ++i) { const v4u v = *(const v4u*)(base + (size_t)(i * 8 + rs) * NP1);
            s[0] += bflo(v.x); s[1] += bfhi(v.x); s[2] += bflo(v.y); s[3] += bfhi(v.y); s[4] += bflo(v.z); s[5] += bfhi(v.z); s[6] += bflo(v.w); s[7] += bfhi(v.w); }
#pragma unroll
        for (int e = 0; e < 8; ++e) { s[e] += shx(s[e], 8, lane); s[e] += shx(s[e], 16, lane); s[e] = add32(s[e]); }
        if (rs == 0) { float* o = KM + ((size_t)(b * 8 + blk) * 8 + h) * 64 + ch * 8;
            *(f32x4*)o = (f32x4){s[0], s[1], s[2], s[3]} * (1.0f / 256.0f); *(f32x4*)(o + 4) = (f32x4){s[4], s[5], s[6], s[7]} * (1.0f / 256.0f); }
    }
}

constexpr int KT_STRIDE = 144, VT_STRIDE = 192, KT_BYTES = 64 * KT_STRIDE, VT_BYTES = 64 * VT_STRIDE, KV_BUF = KT_BYTES + VT_BYTES;
__device__ __forceinline__ int crow(int r, int hi) { return (r & 3) + 8 * (r >> 2) + 4 * hi; }
struct AttnState { float m, l; f32x16 o0, o1; };
__device__ __forceinline__ void attn_reset(AttnState& st) { st.m = -1e30f; st.l = 0.f;
#pragma unroll
    for (int r = 0; r < 16; ++r) { st.o0[r] = 0.f; st.o1[r] = 0.f; } }
__device__ __forceinline__ s16x4 vtr(LAS const unsigned char* p) { return __builtin_bit_cast(s16x4, __builtin_amdgcn_ds_read_tr16_b64_v4i16((LAS s16x4*)p)); }

__device__ __forceinline__ void attn_scores(LAS const unsigned char* Kt, const bf16x8 (&qr)[4], f32x16& p0, f32x16& p1, int lane) {
    const int r32 = lane & 31, hi = lane >> 5;
#pragma unroll
    for (int r = 0; r < 16; ++r) { p0[r] = 0.f; p1[r] = 0.f; }
#pragma unroll
    for (int s = 0; s < 4; ++s) {
        const bf16x8 a0 = *(LAS const bf16x8*)(Kt + r32 * KT_STRIDE + (2 * s + hi) * 16), a1 = *(LAS const bf16x8*)(Kt + (32 + r32) * KT_STRIDE + (2 * s + hi) * 16);
        p0 = __builtin_amdgcn_mfma_f32_32x32x16_bf16(a0, qr[s], p0, 0, 0, 0);
        p1 = __builtin_amdgcn_mfma_f32_32x32x16_bf16(a1, qr[s], p1, 0, 0, 0);
    }
}
__device__ __forceinline__ void attn_pv(LAS const unsigned char* Vt, const f32x16& e0, const f32x16& e1, f32x16& o0, f32x16& o1, int lane) {
    const int hi = lane >> 5;
    LAS const unsigned char* vb = Vt + (4 * hi + ((lane & 15) >> 2)) * VT_STRIDE + (((lane >> 4) & 1) * 16 + 4 * (lane & 3)) * 2;
#pragma unroll
    for (int s = 0; s < 4; ++s) {
        v4u pw;
        if (s < 2) { pw.x = pk2(e0[8 * s + 0], e0[8 * s + 1]); pw.y = pk2(e0[8 * s + 2], e0[8 * s + 3]); pw.z = pk2(e0[8 * s + 4], e0[8 * s + 5]); pw.w = pk2(e0[8 * s + 6], e0[8 * s + 7]); }
        else { const int t = s - 2; pw.x = pk2(e1[8 * t + 0], e1[8 * t + 1]); pw.y = pk2(e1[8 * t + 2], e1[8 * t + 3]); pw.z = pk2(e1[8 * t + 4], e1[8 * t + 5]); pw.w = pk2(e1[8 * t + 6], e1[8 * t + 7]); }
        const bf16x8 pb = __builtin_bit_cast(bf16x8, pw);
#pragma unroll
        for (int db = 0; db < 2; ++db) {
            const s16x4 lo = vtr(vb + (16 * s) * VT_STRIDE + db * 64), hh = vtr(vb + (16 * s + 8) * VT_STRIDE + db * 64);
            const bf16x8 a = (bf16x8){lo[0], lo[1], lo[2], lo[3], hh[0], hh[1], hh[2], hh[3]};
            if (db == 0) o0 = __builtin_amdgcn_mfma_f32_32x32x16_bf16(a, pb, o0, 0, 0, 0); else o1 = __builtin_amdgcn_mfma_f32_32x32x16_bf16(a, pb, o1, 0, 0, 0);
        }
    }
}
__device__ __forceinline__ void attn_tile(LAS const unsigned char* Kt, LAS const unsigned char* Vt, const bf16x8 (&qr)[4], AttnState& st, int kmin, int kmax, int lane) {
    const int hi = lane >> 5;
    f32x16 p0, p1; attn_scores(Kt, qr, p0, p1, lane);
    float mx = -1e30f;
#pragma unroll
    for (int r = 0; r < 16; ++r) { const int k0 = crow(r, hi), k1 = 32 + k0;
        p0[r] = (k0 >= kmin && k0 <= kmax) ? p0[r] : -1e30f; p1[r] = (k1 >= kmin && k1 <= kmax) ? p1[r] : -1e30f;
        mx = fmaxf(mx, fmaxf(p0[r], p1[r])); }
    mx = max32(mx);
    const float mn = fmaxf(st.m, mx), alpha = __builtin_amdgcn_exp2f(st.m - mn);
    float rs = 0.f;
#pragma unroll
    for (int r = 0; r < 16; ++r) { p0[r] = p0[r] > -1e29f ? __builtin_amdgcn_exp2f(p0[r] - mn) : 0.f; p1[r] = p1[r] > -1e29f ? __builtin_amdgcn_exp2f(p1[r] - mn) : 0.f; rs += p0[r] + p1[r]; }
    st.m = mn; st.l = st.l * alpha + rs;
#pragma unroll
    for (int r = 0; r < 16; ++r) { st.o0[r] *= alpha; st.o1[r] *= alpha; }
    attn_pv(Vt, p0, p1, st.o0, st.o1, lane);
}
struct KVRegs { v4u k, v; };
__device__ __forceinline__ void kv_load(KVRegs& r, const bf16* Kg, const bf16* Vg, size_t ld, int tid) {
    const int key = tid >> 3, ch = tid & 7;
    r.k = *(const v4u*)(Kg + (size_t)key * ld + ch * 8); r.v = *(const v4u*)(Vg + (size_t)key * ld + ch * 8);
}
__device__ __forceinline__ void kv_store(const KVRegs& r, LAS unsigned char* buf, int tid) {
    const int key = tid >> 3, ch = tid & 7;
    *(LAS v4u*)(buf + key * KT_STRIDE + ch * 16) = r.k; *(LAS v4u*)(buf + KT_BYTES + key * VT_STRIDE + ch * 16) = r.v;
}

__device__ __forceinline__ float attn_inv_l(const AttnState& st) { const float l = add32(st.l); return 1.0f / fmaxf(l, 1e-30f); }

#define ATTN_STREAM(Kg, Vg, ld, j0, j1, SKIP, RANGE) do { \
    int jn_ = (j0); while (jn_ < (j1) && (SKIP(jn_))) ++jn_; \
    if (jn_ < (j1)) { KVRegs kv_; kv_load(kv_, (Kg) + (size_t)jn_ * 64 * (ld), (Vg) + (size_t)jn_ * 64 * (ld), (ld), F.tid); \
        __syncthreads(); kv_store(kv_, ring, F.tid); int cur_ = 0; \
        for (;;) { const int j_ = jn_; ++jn_; while (jn_ < (j1) && (SKIP(jn_))) ++jn_; const bool more_ = jn_ < (j1); \
            if (more_) kv_load(kv_, (Kg) + (size_t)jn_ * 64 * (ld), (Vg) + (size_t)jn_ * 64 * (ld), (ld), F.tid); \
            __syncthreads(); \
            { int kmin_, kmax_; RANGE(j_, kmin_, kmax_); \
              if (__any(kmax_ >= kmin_)) attn_tile(ring + cur_ * KV_BUF, ring + cur_ * KV_BUF + KT_BYTES, qr, st, kmin_, kmax_, F.lane); } \
            if (!more_) break; \
            kv_store(kv_, ring + (cur_ ^ 1) * KV_BUF, F.tid); cur_ ^= 1; } } } while (0)

__device__ __forceinline__ void nsa_unit(const Frame& F, const bf16* P, const bf16* KC, const bf16* VC, bf16* O  , int b, int g, int i) {
    LAS unsigned char* ring = F.lds;
    LAS float* impb = (LAS float*)(F.lds + 2 * KV_BUF);
    LAS unsigned* selm = (LAS unsigned*)(F.lds + 2 * KV_BUF + 33792);
    LAS float* stash = (LAS float*)(F.lds + 2 * KV_BUF + 33792 + 256) + F.tid;
    const int lane = F.lane, r32 = lane & 31, hi = lane >> 5, hr = F.wave & 3, th = F.wave >> 2;
    const int tl = 32 * th + r32;
    const int s = 64 * i + tl;
    const size_t row = (size_t)b * SEQ + s;
    const int head = g * 4 + hr;
    bf16x8 qr[4];
#pragma unroll
    for (int d = 0; d < 4; ++d) qr[d] = *(const bf16x8*)(P + row * NP1 + C_CQ + head * 64 + d * 16 + hi * 8);
    const float g0 = sigmoidf_(bf2f(P[row * NP1 + C_CG + head])), g1 = sigmoidf_(bf2f(P[row * NP1 + C_CG + 8 + head])), g2 = sigmoidf_(bf2f(P[row * NP1 + C_CG + 16 + head]));
    AttnState st;
    {
        const bf16* Kg = KC + (size_t)(b * 2 + g) * 128 * 64; const bf16* Vg = VC + (size_t)(b * 2 + g) * 128 * 64;
        const int nmax = (s >= 31) ? ((s - 31) >> 4) : -1;
        KVRegs kv0, kv1; kv_load(kv0, Kg, Vg, 64, F.tid); kv_load(kv1, Kg + 64 * 64, Vg + 64 * 64, 64, F.tid);
        __syncthreads();
        kv_store(kv0, ring, F.tid); kv_store(kv1, ring + KV_BUF, F.tid);
        __syncthreads();
        f32x16 a0, a1, c0, c1, out0, out1;
        attn_scores(ring, qr, a0, a1, lane); attn_scores(ring + KV_BUF, qr, c0, c1, lane);
        float mx = -1e30f;
#pragma unroll
        for (int r = 0; r < 16; ++r) { const int k0 = crow(r, hi);
            a0[r] = (k0 <= nmax) ? a0[r] : -1e30f; a1[r] = (32 + k0 <= nmax) ? a1[r] : -1e30f; c0[r] = (64 + k0 <= nmax) ? c0[r] : -1e30f; c1[r] = (96 + k0 <= nmax) ? c1[r] : -1e30f;
            mx = fmaxf(fmaxf(mx, fmaxf(a0[r], a1[r])), fmaxf(c0[r], c1[r])); }
        mx = max32(mx);
        float rs = 0.f;
#pragma unroll
        for (int r = 0; r < 16; ++r) { a0[r] = a0[r] > -1e29f ? __builtin_amdgcn_exp2f(a0[r] - mx) : 0.f; a1[r] = a1[r] > -1e29f ? __builtin_amdgcn_exp2f(a1[r] - mx) : 0.f;
            c0[r] = c0[r] > -1e29f ? __builtin_amdgcn_exp2f(c0[r] - mx) : 0.f; c1[r] = c1[r] > -1e29f ? __builtin_amdgcn_exp2f(c1[r] - mx) : 0.f; rs += (a0[r] + a1[r]) + (c0[r] + c1[r]); }
        rs = add32(rs);
        const float inv = 1.0f / fmaxf(rs, 1e-30f);
#pragma unroll
        for (int r = 0; r < 16; ++r) { out0[r] = 0.f; out1[r] = 0.f; }
        attn_pv(ring + KT_BYTES, a0, a1, out0, out1, lane); attn_pv(ring + KV_BUF + KT_BYTES, c0, c1, out0, out1, lane);
        const float sc = g0 * inv;
#pragma unroll
        for (int r = 0; r < 16; ++r) { stash[r * 512] = out0[r] * sc; stash[(16 + r) * 512] = out1[r] * sc; }
        if (i >= 16) {
            float xprev = 0.f;
#define NSA_IMP(U, ACC, GQ) do { const float G_ = ((ACC[4 * (GQ)] + ACC[4 * (GQ) + 1]) + (ACC[4 * (GQ) + 2] + ACC[4 * (GQ) + 3])) * inv, L_ = ACC[4 * (GQ) + 3] * inv; \
                const float x_ = other32(L_, hi); impb[(hr * 64 + tl) * 33 + 2 * (U) + hi] = G_ + (hi ? x_ : xprev); xprev = x_; } while (0)
            NSA_IMP(0, a0, 0); NSA_IMP(1, a0, 1); NSA_IMP(2, a0, 2); NSA_IMP(3, a0, 3); NSA_IMP(4, a1, 0); NSA_IMP(5, a1, 1); NSA_IMP(6, a1, 2); NSA_IMP(7, a1, 3);
            NSA_IMP(8, c0, 0); NSA_IMP(9, c0, 1); NSA_IMP(10, c0, 2); NSA_IMP(11, c0, 3); NSA_IMP(12, c1, 0); NSA_IMP(13, c1, 1); NSA_IMP(14, c1, 2); NSA_IMP(15, c1, 3);
#undef NSA_IMP
        }
    }
    __syncthreads();
    unsigned mymask;
    if (i < 16) mymask = (2u << i) - 1u;
    else {
        { const int tk = F.tid >> 3, js = F.tid & 7; unsigned bits = 0u;
          float v[4];
#pragma unroll
          for (int e = 0; e < 4; ++e) { const int j = js * 4 + e; v[e] = (impb[(0 * 64 + tk) * 33 + j] + impb[(1 * 64 + tk) * 33 + j]) + (impb[(2 * 64 + tk) * 33 + j] + impb[(3 * 64 + tk) * 33 + j]); }
          int rank[4] = {0, 0, 0, 0};
          for (int jj = 1; jj <= i - 2; ++jj) { const float o = (impb[(0 * 64 + tk) * 33 + jj] + impb[(1 * 64 + tk) * 33 + jj]) + (impb[(2 * 64 + tk) * 33 + jj] + impb[(3 * 64 + tk) * 33 + jj]);
#pragma unroll
              for (int e = 0; e < 4; ++e) { const int j = js * 4 + e; rank[e] += (o > v[e] || (o == v[e] && jj < j)) ? 1 : 0; } }
#pragma unroll
          for (int e = 0; e < 4; ++e) { const int j = js * 4 + e; const bool forced = (j == 0) || (j == i) || (j == i - 1); const bool cand = (j >= 1) && (j <= i - 2);
              if (forced || (cand && rank[e] < 13)) bits |= 1u << j; }
          bits |= shxu(bits, 1, F.lane); bits |= shxu(bits, 2, F.lane); bits |= shxu(bits, 4, F.lane);
          if (js == 0) selm[tk] = bits; }
        __syncthreads();
        mymask = selm[tl];
    }
    {
        attn_reset(st);
        const bf16* Kg = P + (size_t)b * SEQ * NP1 + C_KS + g * 64; const bf16* Vg = P + (size_t)b * SEQ * NP1 + C_VS + g * 64;
#define NSA_SKIP(j) (false)
#define NSA_RANGE(j, kmin, kmax) do { kmin = 0; kmax = ((mymask >> (j)) & 1u) ? ((j) == i ? tl : 63) : -1; } while (0)
        ATTN_STREAM(Kg, Vg, (size_t)NP1, 0, i + 1, NSA_SKIP, NSA_RANGE);
#undef NSA_RANGE
        const float sc = g1 * attn_inv_l(st);
#pragma unroll
        for (int r = 0; r < 16; ++r) { stash[r * 512] += st.o0[r] * sc; stash[(16 + r) * 512] += st.o1[r] * sc; }
    }
    {
        attn_reset(st);
        const bf16* Kg = P + (size_t)b * SEQ * NP1 + C_KW + g * 64; const bf16* Vg = P + (size_t)b * SEQ * NP1 + C_VW + g * 64;
        const int jlo = i >= 8 ? i - 8 : 0; f32x16 out0, out1;
#define NSA_RANGE(j, kmin, kmax) do { const int d_ = 64 * (i - (j)) + tl; kmin = d_ - 511 > 0 ? d_ - 511 : 0; kmax = d_ < 63 ? d_ : 63; } while (0)
        ATTN_STREAM(Kg, Vg, (size_t)NP1, jlo, i + 1, NSA_SKIP, NSA_RANGE);
#undef NSA_RANGE
#undef NSA_SKIP
        const float sc = g2 * attn_inv_l(st);
#pragma unroll
        for (int r = 0; r < 16; ++r) { out0[r] = stash[r * 512] + st.o0[r] * sc; out1[r] = stash[(16 + r) * 512] + st.o1[r] * sc; }
        bf16* orow = O + row * 512 + head * 64;
#pragma unroll
        for (int gq = 0; gq < 4; ++gq) {
            v2u w0; w0.x = pk2(out0[4 * gq], out0[4 * gq + 1]); w0.y = pk2(out0[4 * gq + 2], out0[4 * gq + 3]); *(v2u*)(orow + 8 * gq + 4 * hi) = w0;
            v2u w1; w1.x = pk2(out1[4 * gq], out1[4 * gq + 1]); w1.y = pk2(out1[4 * gq + 2], out1[4 * gq + 3]); *(v2u*)(orow + 32 + 8 * gq + 4 * hi) = w1; }
    }
}
__device__ __forceinline__ void phase_nsa(const Frame& F, const bf16* P, const bf16* KC, const bf16* VC, bf16* O) {
    for (int un2 = 2 * F.bid; un2 < 512; un2 += 2 * F.G)
#pragma unroll 1
        for (int k = 0; k < 2; ++k) { const int un = un2 >> 1, ip = un & 15, g = (un >> 4) & 1, b = un >> 5; nsa_unit(F, P, KC, VC, O, b, g, k == 0 ? 31 - ip : ip); }
}

__device__ __forceinline__ void moba_unit(const Frame& F, const bf16* P, const float* KM, bf16* O  , int b, int h, int qb) {
    LAS unsigned char* ring = F.lds;
    LAS float* kml = (LAS float*)(F.lds + 2 * KV_BUF);
    LAS unsigned* uni = (LAS unsigned*)(F.lds + 2 * KV_BUF + 2048);
    const int lane = F.lane, r32 = lane & 31, hi = lane >> 5;
    const int tl = 32 * F.wave + r32;
    const size_t row = (size_t)b * SEQ + 256 * qb + tl;
    bf16x8 qr[4];
#pragma unroll
    for (int d = 0; d < 4; ++d) qr[d] = *(const bf16x8*)(P + row * NP1 + C_DQ + h * 64 + d * 16 + hi * 8);
    __syncthreads();
    { const int blk = F.tid >> 6, p = F.tid & 63; kml[F.tid] = KM[((size_t)(b * 8 + blk) * 8 + h) * 64 + p]; if (F.tid == 0) uni[0] = 0u; }
    __syncthreads();
    unsigned mymask = 0u;
    if (qb > 0) {
        float gt[8];
#pragma unroll
        for (int n = 0; n < 8; ++n) { float a = 0.f;
#pragma unroll
            for (int d = 0; d < 4; ++d) { const v4u qw = __builtin_bit_cast(v4u, qr[d]); const LAS float* km = kml + n * 64 + d * 16 + hi * 8;
                a += bflo(qw.x) * km[0] + bfhi(qw.x) * km[1] + bflo(qw.y) * km[2] + bfhi(qw.y) * km[3] + bflo(qw.z) * km[4] + bfhi(qw.z) * km[5] + bflo(qw.w) * km[6] + bfhi(qw.w) * km[7]; }
            a = add32(a); gt[n] = a; }
#pragma unroll
        for (int n = 0; n < 8; ++n) { int rank = 0;
#pragma unroll
            for (int m = 0; m < 8; ++m) rank += (m < qb && m != n && (gt[m] > gt[n] || (gt[m] == gt[n] && m < n))) ? 1 : 0;
            if (n < qb && rank < 3) mymask |= 1u << n; }
        atomicOr((unsigned*)uni, mymask);
    }
    __syncthreads();
    const unsigned um = uni[0];
    AttnState st; attn_reset(st);
    const bf16* Kg = P + (size_t)b * SEQ * NP1 + C_DK + h * 64; const bf16* Vg = P + (size_t)b * SEQ * NP1 + C_DV + h * 64;
#define MOBA_SKIP(j) ((j) < 4 * qb && !((um >> ((j) >> 2)) & 1u))
#define MOBA_RANGE(j, kmin, kmax) do { kmin = 0; if ((j) < 4 * qb) kmax = ((mymask >> ((j) >> 2)) & 1u) ? 63 : -1; else { const int d_ = tl - 64 * ((j) - 4 * qb); kmax = d_ < 63 ? d_ : 63; } } while (0)
    ATTN_STREAM(Kg, Vg, (size_t)NP1, 0, 4 * qb + 4, MOBA_SKIP, MOBA_RANGE);
#undef MOBA_SKIP
#undef MOBA_RANGE
    const float sc = attn_inv_l(st);
    bf16* orow = O + row * 512 + h * 64;
#pragma unroll
    for (int gq = 0; gq < 4; ++gq) {
        v2u w0; w0.x = pk2(st.o0[4 * gq] * sc, st.o0[4 * gq + 1] * sc); w0.y = pk2(st.o0[4 * gq + 2] * sc, st.o0[4 * gq + 3] * sc); *(v2u*)(orow + 8 * gq + 4 * hi) = w0;
        v2u w1; w1.x = pk2(st.o1[4 * gq] * sc, st.o1[4 * gq + 1] * sc); w1.y = pk2(st.o1[4 * gq + 2] * sc, st.o1[4 * gq + 3] * sc); *(v2u*)(orow + 32 + 8 * gq + 4 * hi) = w1; }
}
__device__ __forceinline__ void phase_moba(const Frame& F, const bf16* P, const float* KM, bf16* O) {
    for (int un2 = 2 * F.bid; un2 < 512; un2 += 2 * F.G)
#pragma unroll 1
        for (int k = 0; k < 2; ++k) { const int un = un2 >> 1, qp = un & 3, h = (un >> 2) & 7, b = un >> 5; moba_unit(F, P, KM, O, b, h, k == 0 ? 7 - qp : qp); }
}

__device__ __forceinline__ unsigned ord_key(float x) { const unsigned u = __builtin_bit_cast(unsigned, x); return (u & 0x80000000u) ? ~u : (u | 0x80000000u); }
__device__ __forceinline__ float ord_val(unsigned k) { const unsigned u = (k & 0x80000000u) ? (k & 0x7fffffffu) : ~k; return __builtin_bit_cast(float, u); }
constexpr int SK_STRIDE = 272;
__device__ __forceinline__ void peer_route_unit(const Frame& F, const bf16* Q2, const bf16* SUBK  , int* EIDX, float* EW, int tb, int h) {
    LAS unsigned char* skl = F.lds;
    const int lane = F.lane, r32 = lane & 31, hi = lane >> 5;
    __syncthreads();
    for (int i = F.tid; i < 2 * 128 * 16; i += NTHR) { const int ch = i & 15, rowi = i >> 4;
        *(LAS v4u*)(skl + rowi * SK_STRIDE + ch * 16) = *(const v4u*)(SUBK + ((size_t)h * 256 + rowi) * 128 + ch * 8); }
    __syncthreads();
    const size_t tok = (size_t)tb * 256 + F.wave * 32 + r32;
    unsigned topk[2][16];
#pragma unroll
    for (int p = 0; p < 2; ++p) {
        bf16x8 qf[8]; float ss = 0.f;
#pragma unroll
        for (int s = 0; s < 8; ++s) { qf[s] = *(const bf16x8*)(Q2 + tok * 2048 + h * 256 + p * 128 + s * 16 + hi * 8); const v4u w = __builtin_bit_cast(v4u, qf[s]);
            const float a0 = bflo(w.x), a1 = bfhi(w.x), a2 = bflo(w.y), a3 = bfhi(w.y), a4 = bflo(w.z), a5 = bfhi(w.z), a6 = bflo(w.w), a7 = bfhi(w.w);
            ss += (a0 * a0 + a1 * a1) + (a2 * a2 + a3 * a3) + (a4 * a4 + a5 * a5) + (a6 * a6 + a7 * a7); }
        ss = add32(ss);
        const float rn = 1.0f / sqrtf(ss * (1.0f / 128.0f) + NORM_EPS);
        unsigned key[64];
#pragma unroll
        for (int nb = 0; nb < 4; ++nb) { f32x16 acc;
#pragma unroll
            for (int r = 0; r < 16; ++r) acc[r] = 0.f;
#pragma unroll
            for (int s = 0; s < 8; ++s) { const bf16x8 a = *(LAS const bf16x8*)(skl + (p * 128 + nb * 32 + r32) * SK_STRIDE + (2 * s + hi) * 16);
                acc = __builtin_amdgcn_mfma_f32_32x32x16_bf16(a, qf[s], acc, 0, 0, 0); }
#pragma unroll
            for (int r = 0; r < 16; ++r) { const int n = nb * 32 + crow(r, hi); key[nb * 16 + r] = (ord_key(acc[r] * rn) & 0xffffff80u) | (unsigned)(127 - n); } }
#pragma unroll
        for (int k = 0; k < 16; ++k) { unsigned m = key[0];
#pragma unroll
            for (int e = 1; e < 64; ++e) m = m > key[e] ? m : key[e];
            m = umax32(m);
            topk[p][k] = m;
#pragma unroll
            for (int e = 0; e < 64; ++e) key[e] = key[e] == m ? 0u : key[e]; }
    }
    float v1[16], v2[16];
#pragma unroll
    for (int k = 0; k < 16; ++k) { v1[k] = ord_val(topk[0][k] & 0xffffff80u); v2[k] = ord_val(topk[1][k] & 0xffffff80u); }
    unsigned ck[50]; { int c = 0;
#pragma unroll
        for (int a = 0; a < 16; ++a)
#pragma unroll
            for (int bq = 0; bq < 16; ++bq) if ((a + 1) * (bq + 1) <= 16) { ck[c] = (ord_key(v1[a] + v2[bq]) & 0xffffff00u) | (unsigned)(255 - (16 * a + bq)); ++c; } }
    float tv[16]; int te[16];
#pragma unroll
    for (int k = 0; k < 16; ++k) { unsigned m = ck[0];
#pragma unroll
        for (int e = 1; e < 50; ++e) m = m > ck[e] ? m : ck[e];
#pragma unroll
        for (int e = 0; e < 50; ++e) ck[e] = ck[e] == m ? 0u : ck[e];
        const int ci = 255 - (int)(m & 255u), a = ci >> 4, bq = ci & 15;
        unsigned ka = topk[0][0], kb = topk[1][0];
#pragma unroll
        for (int e = 1; e < 16; ++e) { ka = a == e ? topk[0][e] : ka; kb = bq == e ? topk[1][e] : kb; }
        te[k] = (127 - (int)(ka & 127u)) * 128 + (127 - (int)(kb & 127u));
        tv[k] = ord_val(m & 0xffffff00u); }
    { float den = 0.f; const float mx = tv[0];
#pragma unroll
      for (int k = 0; k < 16; ++k) { tv[k] = __expf(tv[k] - mx); den += tv[k]; }
      const float inv = 1.0f / den;
#pragma unroll
      for (int k = 0; k < 16; ++k) tv[k] *= inv; }
    if (hi == 0) {
#pragma unroll
        for (int k = 0; k < 16; ++k) { EIDX[(tok * 8 + h) * 16 + k] = te[k]; EW[(tok * 8 + h) * 16 + k] = tv[k]; }
    }
}

__device__ __forceinline__ void phase_peer_route(const Frame& F, const bf16* Q2, const bf16* SUBK, int* EIDX, float* EW) {
    for (int un = F.bid; un < 64 * 8; un += F.G) peer_route_unit(F, Q2, SUBK, EIDX, EW, un >> 3, un & 7);
}

__device__ __forceinline__ float dot8(v4u a, v4u b) {
    return (bflo(a.x) * bflo(b.x) + bfhi(a.x) * bfhi(b.x)) + (bflo(a.y) * bflo(b.y) + bfhi(a.y) * bfhi(b.y)) + (bflo(a.z) * bflo(b.z) + bfhi(a.z) * bfhi(b.z)) + (bflo(a.w) * bflo(b.w) + bfhi(a.w) * bfhi(b.w));
}
__device__ __forceinline__ void phase_peer_gather(const Frame& F, const bf16* H2, const bf16* UT, const bf16* VT, const int* EIDX, const float* EW, float* XB, const float* gate  ) {
    const int gw = gwave(F), NGW = ngwave(F), lane = F.lane;
    for (int tok = gw; tok < TOK; tok += NGW) {
        const v4u h0 = *(const v4u*)(H2 + (size_t)tok * DM + 8 * lane), h1 = *(const v4u*)(H2 + (size_t)tok * DM + 512 + 8 * lane);
        float o[16];
#pragma unroll
        for (int e = 0; e < 16; ++e) o[e] = 0.f;
        const int* ei = EIDX + (size_t)tok * 128; const float* ew = EW + (size_t)tok * 128;
        for (int c = 0; c < 16; ++c) {
            v4u ua[8], ub[8], va[8], vb[8]; float cf[8];
#pragma unroll
            for (int j = 0; j < 8; ++j) { const int e = __builtin_amdgcn_readfirstlane(ei[c * 8 + j]);
                ua[j] = *(const v4u*)(UT + (size_t)e * DM + 8 * lane); ub[j] = *(const v4u*)(UT + (size_t)e * DM + 512 + 8 * lane);
                va[j] = *(const v4u*)(VT + (size_t)e * DM + 8 * lane); vb[j] = *(const v4u*)(VT + (size_t)e * DM + 512 + 8 * lane); }
#pragma unroll
            for (int j = 0; j < 8; ++j) cf[j] = dot8(ua[j], h0) + dot8(ub[j], h1);
#pragma unroll
            for (int sft = 1; sft < 32; sft <<= 1)
#pragma unroll
                for (int j = 0; j < 8; ++j) cf[j] += shx(cf[j], sft, lane);
#pragma unroll
            for (int j = 0; j < 8; ++j) cf[j] = add32(cf[j]);
#pragma unroll
            for (int j = 0; j < 8; ++j) { const float w = ew[c * 8 + j] * gelu_erf(cf[j]);
                o[0] += w * bflo(va[j].x); o[1] += w * bfhi(va[j].x); o[2] += w * bflo(va[j].y); o[3] += w * bfhi(va[j].y);
                o[4] += w * bflo(va[j].z); o[5] += w * bfhi(va[j].z); o[6] += w * bflo(va[j].w); o[7] += w * bfhi(va[j].w);
                o[8] += w * bflo(vb[j].x); o[9] += w * bfhi(vb[j].x); o[10] += w * bflo(vb[j].y); o[11] += w * bfhi(vb[j].y);
                o[12] += w * bflo(vb[j].z); o[13] += w * bfhi(vb[j].z); o[14] += w * bflo(vb[j].w); o[15] += w * bfhi(vb[j].w); }
        }
        const int b = tok / SEQ; float* xr = XB + (size_t)tok * DM; const float* gr = gate + (size_t)b * 6144;
#pragma unroll
        for (int q = 0; q < 4; ++q) { const int col = (q >> 1) * 512 + 8 * lane + (q & 1) * 4;
            const f32x4 x = *(const f32x4*)(xr + col), gg = *(const f32x4*)(gr + col);
            *(f32x4*)(xr + col) = x + gg * (f32x4){o[4 * q], o[4 * q + 1], o[4 * q + 2], o[4 * q + 3]}; }
    }
}

constexpr int NPL = 12, NPHASE = 1 + DEPTH * NPL + 1;
constexpr int CW_BAR = 1024;
static_assert((CW_BAR + XCD_BAR_WORDS) * 4 <= (int)CTL_ZERO_BYTES, "barrier words inside the memset region");

__global__ void __launch_bounds__(NTHR, 2) hybrid_fwd(Args args) {
    extern __shared__ __attribute__((aligned(16))) unsigned char lds[];
    Frame F;
    F.lds = (LAS unsigned char*)lds; F.ldsg = lds;
    F.tid = threadIdx.x; F.lane = F.tid & 63; F.wave = __builtin_amdgcn_readfirstlane(F.tid >> 6);
    F.G = gridDim.x; F.bid = blockIdx.x; F.ws = args.ws;
    unsigned char* ws = args.ws;
    volatile LAS unsigned* MISC = (volatile LAS unsigned*)(F.lds + MISC_OFF);
    for (int u = F.tid; u < 64; u += NTHR) ((LAS unsigned*)(F.lds + MISC_OFF))[u] = 0u;
    __syncthreads();
    XcdBarrier bar; bar.bar = (unsigned*)(ws + WS_CTL) + CW_BAR; bar.x = 0; bar.st = nullptr;
    const int lo = args.ph_lo, hi = args.ph_hi;
    if (hi - lo > 1) bar = xcd_barrier_post((unsigned*)(ws + WS_CTL) + CW_BAR, MISC + 8);
#ifndef PHMASK
#define PHMASK 0xffffffffu
#endif
#define PM(j) ((PHMASK >> (j)) & 1u)
#define IN(k) (lo <= (k) && (k) < hi)
#define SEAM(k) do { if (IN(k) && IN((k) + 1)) xcd_barrier(bar); } while (0)

    typedef __attribute__((address_space(4))) const Args* KArgs;
    KArgs ap = (KArgs)__builtin_amdgcn_kernarg_segment_ptr();
#define FRESH() asm volatile("" : "+s"(ap), "+s"(ws)); Frame Fp = F; asm volatile("" : "+v"(Fp.tid)); Fp.lane = Fp.tid & 63; asm volatile("" : "+s"(Fp.wave), "+s"(Fp.bid), "+s"(Fp.G)); Fp.ws = ws; LAS unsigned char* ring = Fp.lds; asm volatile("" : "+s"(ring)); Fp.lds = ring
#define INP(i) ((const float*)ap->in[i])
#define WIN_ ((bf16*)(ws + WS_WIN))
#define WOUT_ ((bf16*)(ws + WS_WOUT))
#define WOT_ ((bf16*)(ws + WS_WO))
#define WQT_ ((bf16*)(ws + WS_WQ))
#define W1T_ ((bf16*)(ws + WS_W1T))
#define SUBK_ ((bf16*)(ws + WS_SUBK))
#define W2T_ ((bf16*)(ws + WS_SMALL + SM_W2T))
#define MOD_ ((float*)(ws + WS_MOD))
#define COS_ ((const float*)(ws + WS_COS))
#define SIN_ ((const float*)(ws + WS_SIN))
#define KMEAN_ ((float*)(ws + WS_SMALL + SM_KMEAN))
#define KCMP_ ((bf16*)(ws + WS_SMALL + SM_KCMP))
#define VCMP_ ((bf16*)(ws + WS_SMALL + SM_VCMP))
#define PBP_ ((float*)(ws + WS_SMALL + SM_PBP))
#define EIDX_ ((int*)(ws + WS_EIDX))
#define EW_ ((float*)(ws + WS_EW))
#define HN_ ((bf16*)(ws + WS_HN))
#define MIX_ ((bf16*)(ws + WS_MIX))
#define PROJ_ ((bf16*)(ws + WS_BIG))
#define GATES_ ((bf16*)(ws + WS_BIG))
#define UT_ ((bf16*)(ws + WS_BIG))
#define VT_ ((bf16*)(ws + WS_BIG + 32 * MiB))
#define Q2_ ((bf16*)(ws + WS_BIG + 64 * MiB))
#define XB_ ((float*)ap->out)
#define MODL_ (MOD_ + (size_t)l * 8 * 6144)
#define XIN_ ((l == 0) ? INP(I_X) : (const float*)XB_)

    if (PM(0) && IN(0)) { FRESH(); phase_prologue(Fp, ap); }
    SEAM(0);
#pragma unroll 1
    for (int l = 0; l < DEPTH; ++l) {
        const int p0 = 1 + l * NPL;
        if (PM(1) && IN(p0 + 0)) { FRESH(); phase_norm_mod(Fp, XIN_, INP(I_NMG) + l * DM, MODL_ + 0, MODL_ + 1024, HN_); }
        SEAM(p0 + 0);
        if (PM(2) && IN(p0 + 1)) { FRESH(); pg8::Gemm g{HN_, WIN_ + (size_t)l * NWIN * DM, TOK, NP1, DM}; pg8::StaticOrder S; S.init(TOK, NP1, Fp.G, Fp.bid);
            epi::EpiProj1 E{PROJ_, COS_, SIN_}; pg8::gemm_phase<epi::EpiProj1, pg8::StaticOrder, true, true>(ring, g, S, E, Fp.tid); }
        SEAM(p0 + 1);
        if (PM(3) && IN(p0 + 2)) {
            { FRESH(); phase_compress(Fp, PROJ_, W1T_ + (size_t)l * 2 * 128 * 2048, W2T_ + (size_t)l * 2 * 64 * 128, PBP_ + (size_t)l * 2 * 16 * 128, KCMP_, VCMP_); }
            { FRESH(); phase_kmean(Fp, PROJ_, KMEAN_); }
            { FRESH(); phase_mixer_a(Fp, PROJ_, INP(I_ACW) + (size_t)l * 3 * 512, MIX_); }
            __syncthreads();
            { FRESH(); phase_mixer_b(Fp, PROJ_, INP(I_BCW) + (size_t)l * 31 * 512, INP(I_BCB) + l * 512, INP(I_BLNG) + l * 512, INP(I_BLNB) + l * 512, MIX_ + (size_t)TOK * 512); }
            __syncthreads();
        }
        SEAM(p0 + 2);
        if (PM(4) && IN(p0 + 3)) { FRESH(); phase_nsa(Fp, PROJ_, KCMP_, VCMP_, MIX_ + (size_t)2 * TOK * 512); __syncthreads(); }
        SEAM(p0 + 3);
        if (PM(5) && IN(p0 + 4)) { FRESH(); phase_moba(Fp, PROJ_, KMEAN_, MIX_ + (size_t)3 * TOK * 512); __syncthreads(); }
        SEAM(p0 + 4);
        if (PM(6) && IN(p0 + 5)) { FRESH(); pg8::Gemm g{HN_, WIN_ + ((size_t)l * NWIN + NP1) * DM, TOK, NGT, DM}; pg8::StaticOrder S; S.init(TOK, NGT, Fp.G, Fp.bid);
            epi::EpiStore<1> E{GATES_, NGT}; pg8::gemm_phase<epi::EpiStore<1>, pg8::StaticOrder, true, true>(ring, g, S, E, Fp.tid); }
        SEAM(p0 + 5);
        if (PM(7) && IN(p0 + 6)) {
#pragma unroll 1
            for (int seg = 0; seg < 4; ++seg) { FRESH(); pg8::Gemm g{MIX_ + (size_t)seg * TOK * 512, WOUT_ + (size_t)(l * 4 + seg) * DM * 512, TOK, DM, 512}; pg8::StaticOrder S; S.init(TOK, DM, Fp.G, Fp.bid);
                epi::EpiMerge E{HN_, GATES_, seg}; pg8::gemm_phase<epi::EpiMerge, pg8::StaticOrder, true, true>(ring, g, S, E, Fp.tid); }
        }
        SEAM(p0 + 6);
        if (PM(8) && IN(p0 + 7)) { FRESH(); pg8::Gemm g{HN_, WOT_ + (size_t)l * DM * DM, TOK, DM, DM}; pg8::StaticOrder S; S.init(TOK, DM, Fp.G, Fp.bid);
            epi::EpiResid E{XIN_, XB_, MODL_ + 2048}; pg8::gemm_phase<epi::EpiResid, pg8::StaticOrder, true, true>(ring, g, S, E, Fp.tid); }
        SEAM(p0 + 7);
        if (PM(9) && IN(p0 + 8)) {
            { FRESH(); phase_norm_mod(Fp, XB_, INP(I_NFG) + l * DM, MODL_ + 3072, MODL_ + 4096, HN_); }
            { FRESH(); convert_copy(Fp, INP(I_PU) + (size_t)l * 16384 * DM, UT_, (size_t)16384 * DM); }
            { FRESH(); convert_copy(Fp, INP(I_PV) + (size_t)l * 16384 * DM, VT_, (size_t)16384 * DM); }
        }
        SEAM(p0 + 8);
        if (PM(10) && IN(p0 + 9)) { FRESH(); pg8::Gemm g{HN_, WQT_ + (size_t)l * 2048 * DM, TOK, 2048, DM}; pg8::StaticOrder S; S.init(TOK, 2048, Fp.G, Fp.bid);
            epi::EpiStore<0> E{Q2_, 2048}; pg8::gemm_phase<epi::EpiStore<0>, pg8::StaticOrder, true, true>(ring, g, S, E, Fp.tid); }
        SEAM(p0 + 9);
        if (PM(11) && IN(p0 + 10)) { FRESH(); phase_peer_route(Fp, Q2_, SUBK_ + (size_t)l * 8 * 2 * 128 * 128, EIDX_, EW_); __syncthreads(); }
        SEAM(p0 + 10);
        if (PM(12) && IN(p0 + 11)) { FRESH(); phase_peer_gather(Fp, HN_, UT_, VT_, EIDX_, EW_, XB_, MODL_ + 5120); }
        SEAM(p0 + 11);
    }
    if (PM(13) && IN(NPHASE - 1)) { FRESH(); phase_final_norm(Fp, XB_, INP(I_FNG), XB_); }
#ifdef DBG_STOP
    if (IN(NPHASE)) { FRESH();
        const bf16* src = (const bf16*)(ws + (size_t)DBG_OFF); const size_t n = (size_t)DBG_BYTES / 2, NO = (size_t)TOK * DM; float* o = (float*)ap->out;
        for (size_t i = (size_t)Fp.bid * NTHR + Fp.tid; i < NO; i += (size_t)Fp.G * NTHR) { float a = 0.f; for (size_t j = i; j < n; j += NO) a += bf2f(src[j]);
#ifdef DBG_OFF2
            { const float* s2 = (const float*)(ws + (size_t)DBG_OFF2); const size_t n2 = (size_t)DBG_BYTES2 / 4; for (size_t j = i; j < n2; j += NO) a += s2[j]; }
#endif
            if (!(a == a) || fabsf(a) > 1e30f) a = 12345.0f;
            o[i] = a; } }
#endif
#undef IN
#undef SEAM
}

extern "C" void kernel_launch(void* const* d_in, const int* in_sizes, int n_in, void* d_out, int out_size, void* d_ws, size_t ws_size, hipStream_t stream) {
    static int grid = 0;
    if (grid == 0) {
        if (n_in != 26 || in_sizes[0] != TOK * DM || out_size != TOK * DM || ws_size < WS_END) {
            fprintf(stderr, "kernel_launch: unexpected problem (n_in %d, in0 %d, out %d, ws %zu); nothing launched\n", n_in, n_in > 0 ? in_sizes[0] : -1, out_size, ws_size); grid = -1; return; }
        int dev = 0, cus = 0, per_cu = 0;
        if (hipGetDevice(&dev) != hipSuccess || hipDeviceGetAttribute(&cus, hipDeviceAttributeMultiprocessorCount, dev) != hipSuccess) { grid = -1; return; }
        if (hipFuncSetAttribute((const void*)hybrid_fwd, hipFuncAttributeMaxDynamicSharedMemorySize, LDS_BYTES) != hipSuccess) { fprintf(stderr, "kernel_launch: hipFuncSetAttribute failed\n"); grid = -1; return; }
        if (hipOccupancyMaxActiveBlocksPerMultiprocessor(&per_cu, (const void*)hybrid_fwd, NTHR, LDS_BYTES) != hipSuccess || per_cu < 1)
            fprintf(stderr, "kernel_launch: note: occupancy query reports %d workgroups per CU\n", per_cu);
        (void)hipGetLastError();
        grid = cus;
    }
    if (grid < 0) return;
    if (hipMemsetAsync((char*)d_ws + WS_CTL, 0, CTL_ZERO_BYTES, stream) != hipSuccess) return;
    Args a{};
    for (int i = 0; i < 26; ++i) a.in[i] = d_in[i];
    a.out = (float*)d_out; a.ws = (unsigned char*)d_ws;
#if MK_PER_PHASE
#ifdef DBG_STOP
    for (int p = 0; p <= DBG_STOP; ++p) { a.ph_lo = p; a.ph_hi = p + 1; hipLaunchKernelGGL(hybrid_fwd, dim3(grid), dim3(NTHR), LDS_BYTES, stream, a); }
    a.ph_lo = NPHASE; a.ph_hi = NPHASE + 1; hipLaunchKernelGGL(hybrid_fwd, dim3(grid), dim3(NTHR), LDS_BYTES, stream, a);
#else
    for (int p = 0; p < NPHASE; ++p) { a.ph_lo = p; a.ph_hi = p + 1; hipLaunchKernelGGL(hybrid_fwd, dim3(grid), dim3(NTHR), LDS_BYTES, stream, a); }
#endif
#else
    a.ph_lo = 0; a.ph_hi = NPHASE; hipLaunchKernelGGL(hybrid_fwd, dim3(grid), dim3(NTHR), LDS_BYTES, stream, a);
#endif
    const hipError_t le = hipPeekAtLastError();
    if (le != hipSuccess) fprintf(stderr, "kernel_launch: launch failed: %s\n", hipGetErrorName(le));
}
```

```cpp
#include <hip/hip_runtime.h>
#include <hip/hip_bf16.h>
#include <cstdio>
#include <cstdint>
#include <cmath>

#ifndef MK_PER_PHASE
#define MK_PER_PHASE 0
#endif

#define RPMASK 0x0u
#define GAS __attribute__((address_space(1)))
#define LAS __attribute__((address_space(3)))
typedef unsigned short bf16;
typedef unsigned v4u __attribute__((ext_vector_type(4)));
typedef unsigned v2u __attribute__((ext_vector_type(2)));
typedef float f32x4 __attribute__((ext_vector_type(4)));
typedef float f32x2 __attribute__((ext_vector_type(2)));
typedef float f32x16 __attribute__((ext_vector_type(16)));
typedef short bf16x8 __attribute__((ext_vector_type(8)));
typedef short s16x4 __attribute__((ext_vector_type(4)));
typedef __bf16 bf16x2_t __attribute__((ext_vector_type(2)));

constexpr int BATCH = 8, SEQ = 2048, DM = 1024, DEPTH = 2, TOK = BATCH * SEQ;
constexpr int NP1 = 5632;
constexpr int NGT = 4096;
constexpr int NWIN = NP1 + NGT;
constexpr int C_AB = 0, C_AC = 512, C_AX = 1024, C_BA = 1536, C_BG = 2048, C_CQ = 2560, C_KC = 3072, C_VC = 3200, C_KS = 3328, C_VS = 3456, C_KW = 3584, C_VW = 3712,
              C_DQ = 3840, C_DK = 4352, C_DV = 4864, C_CG = 5376;
constexpr float NORM_EPS = 1e-6f;
constexpr float QSCALE = 0.125f * 1.4426950408889634f;

constexpr size_t MiB = 1u << 20;
constexpr size_t WS_CTL = 0, CTL_ZERO_BYTES = 64 * 1024;
constexpr size_t WS_MOD = 1 * MiB;
constexpr size_t WS_COS = 2 * MiB, WS_SIN = 4 * MiB;
constexpr size_t WS_SMALL = 6 * MiB;
constexpr size_t SM_KMEAN = 704 * 1024;
constexpr size_t SM_KCMP = 64 * 1024;
constexpr size_t SM_VCMP = 320 * 1024;
constexpr size_t SM_PBP = 576 * 1024;
constexpr size_t SM_W2T = 640 * 1024;
constexpr size_t WS_EIDX = 8 * MiB;
constexpr size_t WS_EW = 16 * MiB;
constexpr size_t WS_WIN = 24 * MiB;
constexpr size_t WS_WOUT = 62 * MiB;
constexpr size_t WS_WO = 70 * MiB;
constexpr size_t WS_WQ = 74 * MiB;
constexpr size_t WS_W1T = 82 * MiB;
constexpr size_t WS_SUBK = 84 * MiB;
constexpr size_t WS_HN = 86 * MiB;
constexpr size_t WS_MIX = 118 * MiB;
constexpr size_t WS_BIG = 182 * MiB;
constexpr size_t WS_END = 358 * MiB;

constexpr int LDS_BYTES = 147456;
constexpr int RING_BYTES = 131072;
constexpr int MISC_OFF = LDS_BYTES - 256;

#define RLX_AGENT __ATOMIC_RELAXED, __HIP_MEMORY_SCOPE_AGENT
#define LDS_WAIT() asm volatile("s_waitcnt lgkmcnt(0)" ::: "memory")
#define VM_WAIT() asm volatile("s_waitcnt vmcnt(0)" ::: "memory")
__device__ __forceinline__ unsigned f2bf(float f) { unsigned u = __builtin_bit_cast(unsigned, f); return (u + 0x7fffu + ((u >> 16) & 1u)) >> 16; }
__device__ __forceinline__ float bf2f(unsigned h) { return __builtin_bit_cast(float, h << 16); }
__device__ __forceinline__ unsigned pk2(float lo, float hi) { f32x2 v = {lo, hi}; bf16x2_t b = __builtin_convertvector(v, bf16x2_t); return __builtin_bit_cast(unsigned, b); }
__device__ __forceinline__ float bflo(unsigned w) { return __builtin_bit_cast(float, w << 16); }
__device__ __forceinline__ float bfhi(unsigned w) { return __builtin_bit_cast(float, w & 0xffff0000u); }
__device__ __forceinline__ float sigmoidf_(float x) { return 1.0f / (1.0f + __expf(-x)); }
__device__ __forceinline__ float gelu_erf(float x) { return 0.5f * x * (1.0f + erff(x * 0.70710678118654752f)); }
__device__ __forceinline__ float shx(float v, int m, int lane) { return __builtin_bit_cast(float, __builtin_amdgcn_ds_bpermute((lane ^ m) << 2, __builtin_bit_cast(int, v))); }
__device__ __forceinline__ unsigned shxu(unsigned v, int m, int lane) { return (unsigned)__builtin_amdgcn_ds_bpermute((lane ^ m) << 2, (int)v); }
__device__ __forceinline__ void swap32(unsigned v, unsigned& r0, unsigned& r1) { unsigned b = v; asm volatile("" : "+v"(b)); auto r = __builtin_amdgcn_permlane32_swap(v, b, false, false); r0 = r[0]; r1 = r[1]; }
__device__ __forceinline__ float other32(float v, int hi) { unsigned r0, r1; swap32(__builtin_bit_cast(unsigned, v), r0, r1); return __builtin_bit_cast(float, hi ? r0 : r1); }
__device__ __forceinline__ float add32(float v) { unsigned r0, r1; swap32(__builtin_bit_cast(unsigned, v), r0, r1); return __builtin_bit_cast(float, r0) + __builtin_bit_cast(float, r1); }
__device__ __forceinline__ float max32(float v) { unsigned r0, r1; swap32(__builtin_bit_cast(unsigned, v), r0, r1); return fmaxf(__builtin_bit_cast(float, r0), __builtin_bit_cast(float, r1)); }
__device__ __forceinline__ unsigned umax32(unsigned v) { unsigned r0, r1; swap32(v, r0, r1); return r0 > r1 ? r0 : r1; }
__device__ __forceinline__ float wave_sum(float v, int lane) {
#pragma unroll
    for (int o = 1; o < 32; o <<= 1) v += shx(v, o, lane);
    return add32(v);
}
namespace pg8 {
#define PG8_LAS __attribute__((address_space(3)))
typedef unsigned short bf16_t;
typedef short bf16x8 __attribute__((ext_vector_type(8)));
typedef float f32x4 __attribute__((ext_vector_type(4)));
typedef unsigned u32x4 __attribute__((ext_vector_type(4)));
constexpr int BM = 256, BK = 64, HALF = 128, HTB = HALF * BK * 2  , STAGE_BYTES = 8 * HTB, NXCD = 8, WGM = 8;

__host__ __device__ __forceinline__ int lds_byte(int r, int c) { const int st = (r >> 4) * 2 + (c >> 5), rr = r & 15, cc = c & 31, ob = rr * 64 + cc * 2; return st * 1024 + (ob ^ (((ob >> 9) & 1) << 5)); }
__host__ __device__ __forceinline__ void stage_rc(int b, int& R, int& C) { const int st = b / 1024, sb = b % 1024, swz = sb ^ (((sb >> 9) & 1) << 5); R = (st >> 1) * 16 + swz / 64; C = (st & 1) * 32 + (swz % 64) / 2; }
__host__ __device__ __forceinline__ int perm32(int rho) { const int n = rho >> 4, i = rho & 15; return 8 * (i >> 2) + 4 * n + (i & 3); }

struct Unit { int pm, pn; };
struct Gemm { const bf16_t* A; const bf16_t* Bt; int M, N, K; };

struct StaticOrder {
    int nM, nN, nwg, G, c;
    __host__ __device__ void init(int M, int N, int G_, int c_) { nM = M / BM; nN = N / BM; nwg = nM * nN; G = G_; c = c_; }
    __host__ __device__ bool next(int i, Unit& u) const {
        const long L = (long)i * G + c; if (L >= nwg) return false;
        int wgid = (int)L; { const int q = nwg / NXCD, r = nwg % NXCD, xcd = wgid % NXCD, off = wgid / NXCD; wgid = (xcd < r ? xcd * (q + 1) : r * (q + 1) + (xcd - r) * q) + off; }
        const int nig = WGM * nN, gid = wgid / nig, fm = gid * WGM, gsz = (nM - fm) < WGM ? (nM - fm) : WGM;
        u.pm = fm + ((wgid % nig) % gsz); u.pn = (wgid % nig) / gsz; return true;
    }
    __device__ __forceinline__ void a_ready(const Unit&) const {}
    __device__ __forceinline__ void done(const Unit&) const {}
};

__device__ __forceinline__ unsigned cvt_pk_bf16(float lo, float hi) { unsigned r; asm volatile("v_cvt_pk_bf16_f32 %0, %1, %2" : "=v"(r) : "v"(lo), "v"(hi)); return r; }
typedef float f32x2 __attribute__((ext_vector_type(2)));
template <class Epi, class Sched, bool ALIGN_EPI = false, bool SP2 = false>
__device__ __forceinline__ void gemm_phase(PG8_LAS unsigned char* lds, const Gemm g, const Sched& S, const Epi& E, const int tid) {
    const int wid = __builtin_amdgcn_readfirstlane(tid >> 6), lane = tid & 63, wr = wid >> 2, wc = wid & 3, fr = lane & 15, fq = lane >> 4;
    const int K = g.K, nt = K / BK;
    unsigned voffA[2], voffB[2];
#pragma unroll
    for (int i = 0; i < 2; ++i) { int R, C; stage_rc(tid * 16 + i * 8192, R, C); const int Rb = Epi::PERM ? ((R & ~31) + perm32(R & 31)) : R;
        voffA[i] = (unsigned)(R * K + C) * 2u; voffB[i] = (unsigned)(Rb * K + C) * 2u; }
    const size_t kstep = (size_t)(BK * 2);
    const size_t hstep = (size_t)HALF * K * 2;
    const size_t tstep = 2 * hstep;
    const unsigned ldsw = (unsigned)wid * 1024u;
    const int aoff = lds_byte(wr * 64 + fr, fq * 8), boff = lds_byte(wc * 32 + fr, fq * 8);
#define PG8_SA(b, h) (((b) * 2 + (h)) * HTB)
#define PG8_SB(b, h) ((4 + (b) * 2 + (h)) * HTB)
#define PG8_STAGE(bufoff, gbase, voff) do { _Pragma("unroll") for (int _i = 0; _i < 2; ++_i) \
        __builtin_amdgcn_global_load_lds((const unsigned*)((const char*)(gbase) + (voff)[_i]), (PG8_LAS unsigned*)(lds + (bufoff) + ldsw + _i * 8192), 16, 0, 0); } while (0)
#define PG8_LDA(dst, b, h) do { _Pragma("unroll") for (int m = 0; m < 4; ++m) _Pragma("unroll") for (int k = 0; k < 2; ++k) dst[m][k] = *(const PG8_LAS bf16x8*)(lds + PG8_SA(b, h) + aoff + m * 2048 + k * 1024); } while (0)
#define PG8_LDB(dst, b, h) do { _Pragma("unroll") for (int n = 0; n < 2; ++n) _Pragma("unroll") for (int k = 0; k < 2; ++k) dst[n][k] = *(const PG8_LAS bf16x8*)(lds + PG8_SB(b, h) + boff + n * 2048 + k * 1024); } while (0)
#define PG8_MMA(ai, bj, At, Bt) do { __builtin_amdgcn_s_setprio(1); _Pragma("unroll") for (int m = 0; m < 4; ++m) _Pragma("unroll") for (int n = 0; n < 2; ++n) _Pragma("unroll") for (int k = 0; k < 2; ++k) \
        acc[ai][bj][m][n] = __builtin_amdgcn_mfma_f32_16x16x32_bf16(Bt[n][k], At[m][k], acc[ai][bj][m][n], 0, 0, 0); __builtin_amdgcn_s_setprio(0); } while (0)
#define PG8_WAIT_V(n) asm volatile("s_waitcnt vmcnt(" #n ")" ::: "memory")
#define PG8_WAIT_L(n) asm volatile("s_waitcnt lgkmcnt(" #n ")" ::: "memory")
#define PG8_BAR __builtin_amdgcn_s_barrier()
#define PG8_SCHED __builtin_amdgcn_sched_barrier(0)
    Unit cur, nxt; int ui = 0;
    if (!S.next(0, cur)) return;
    f32x4 acc[2][2][4][2];
#pragma unroll
    for (int a = 0; a < 2; ++a)
#pragma unroll
        for (int b = 0; b < 2; ++b)
#pragma unroll
            for (int m = 0; m < 4; ++m)
#pragma unroll
                for (int n = 0; n < 2; ++n) acc[a][b][m][n] = (f32x4){0.f, 0.f, 0.f, 0.f};
    bf16x8 At[4][2], B0[2][2], B1[2][2];
    const char* cA = (const char*)g.A + (size_t)cur.pm * tstep; const char* cB = (const char*)g.Bt + (size_t)cur.pn * tstep;
    S.a_ready(cur);
    if constexpr (SP2) {
        PG8_STAGE(PG8_SB(0, 0), cB, voffB); PG8_STAGE(PG8_SB(0, 1), cB + hstep, voffB); PG8_STAGE(PG8_SA(0, 0), cA, voffA); PG8_STAGE(PG8_SA(0, 1), cA + hstep, voffA);
        if (wr == 1) PG8_BAR;
        PG8_WAIT_V(2); PG8_BAR;
        PG8_STAGE(PG8_SB(1, 0), cB + kstep, voffB); PG8_STAGE(PG8_SA(1, 0), cA + kstep, voffA); PG8_STAGE(PG8_SB(1, 1), cB + hstep + kstep, voffB);
        PG8_WAIT_V(6); PG8_BAR;
    } else {
        PG8_STAGE(PG8_SB(0, 0), cB, voffB); PG8_STAGE(PG8_SA(0, 0), cA, voffA); PG8_STAGE(PG8_SB(0, 1), cB + hstep, voffB); PG8_STAGE(PG8_SA(0, 1), cA + hstep, voffA);
        if (wr == 1) PG8_BAR;
        PG8_WAIT_V(4); PG8_BAR;
        PG8_STAGE(PG8_SB(1, 0), cB + kstep, voffB); PG8_STAGE(PG8_SA(1, 0), cA + kstep, voffA); PG8_STAGE(PG8_SB(1, 1), cB + hstep + kstep, voffB);
        PG8_WAIT_V(6); PG8_BAR;
    }
    for (;;) {
        const bool has_next = S.next(ui + 1, nxt);
        const char* nA = has_next ? (const char*)g.A + (size_t)nxt.pm * tstep : cA; const char* nB = has_next ? (const char*)g.Bt + (size_t)nxt.pn * tstep : cB;
        for (int t = 0; t < nt; t += 2) {
            const bool last = (t == nt - 2);
            const char* a1 = cA + (size_t)(t + 1) * kstep;
            const char* a2 = last ? nA : cA + (size_t)(t + 2) * kstep; const char* b2 = last ? nB : cB + (size_t)(t + 2) * kstep;
            const char* a3 = a2 + kstep; const char* b3 = b2 + kstep;
            if (last && has_next) S.a_ready(nxt);
            if constexpr (SP2) {
            PG8_LDB(B0, 0, 0); PG8_LDB(B1, 0, 1); PG8_SCHED; PG8_LDA(At, 0, 0); PG8_STAGE(PG8_SA(1, 1), a1 + hstep, voffA);
            PG8_WAIT_V(8); PG8_WAIT_L(0); PG8_BAR; PG8_MMA(0, 0, At, B0); PG8_MMA(0, 1, At, B1); PG8_BAR; PG8_SCHED;
            PG8_LDA(At, 0, 1); PG8_STAGE(PG8_SB(0, 0), b2, voffB); PG8_STAGE(PG8_SB(0, 1), b2 + hstep, voffB); PG8_STAGE(PG8_SA(0, 0), a2, voffA);
            PG8_WAIT_V(8); PG8_WAIT_L(0); PG8_BAR; PG8_MMA(1, 0, At, B0); PG8_MMA(1, 1, At, B1); PG8_BAR; PG8_SCHED;
            PG8_LDB(B0, 1, 0); PG8_LDB(B1, 1, 1); PG8_SCHED; PG8_LDA(At, 1, 0); PG8_STAGE(PG8_SA(0, 1), a2 + hstep, voffA);
            PG8_WAIT_V(8); PG8_WAIT_L(0); PG8_BAR; PG8_MMA(0, 0, At, B0); PG8_MMA(0, 1, At, B1); PG8_BAR; PG8_SCHED;
            PG8_LDA(At, 1, 1); PG8_STAGE(PG8_SB(1, 0), b3, voffB); PG8_STAGE(PG8_SB(1, 1), b3 + hstep, voffB); PG8_STAGE(PG8_SA(1, 0), a3, voffA);
            PG8_WAIT_V(8); PG8_WAIT_L(0); PG8_BAR; PG8_MMA(1, 0, At, B0); PG8_MMA(1, 1, At, B1); PG8_BAR; PG8_SCHED;
            } else {
            PG8_LDB(B0, 0, 0); PG8_SCHED; PG8_LDA(At, 0, 0); PG8_STAGE(PG8_SA(1, 1), a1 + hstep, voffA);
            PG8_WAIT_L(8); PG8_BAR; PG8_WAIT_L(0); PG8_MMA(0, 0, At, B0); PG8_BAR; PG8_SCHED;
            PG8_LDB(B1, 0, 1); PG8_STAGE(PG8_SB(0, 0), b2, voffB);
            PG8_BAR; PG8_WAIT_L(0); PG8_MMA(0, 1, At, B1); PG8_BAR;
            PG8_LDA(At, 0, 1); PG8_STAGE(PG8_SA(0, 0), a2, voffA);
            PG8_BAR; PG8_WAIT_L(0); PG8_MMA(1, 0, At, B0); PG8_BAR; PG8_SCHED;
            PG8_STAGE(PG8_SB(0, 1), b2 + hstep, voffB);
            PG8_WAIT_V(6); PG8_BAR; PG8_MMA(1, 1, At, B1); PG8_BAR;
            PG8_LDB(B0, 1, 0); PG8_SCHED; PG8_LDA(At, 1, 0); PG8_STAGE(PG8_SA(0, 1), a2 + hstep, voffA);
            PG8_WAIT_L(8); PG8_BAR; PG8_WAIT_L(0); PG8_MMA(0, 0, At, B0); PG8_BAR; PG8_SCHED;
            PG8_LDB(B1, 1, 1); PG8_STAGE(PG8_SB(1, 0), b3, voffB);
            PG8_BAR; PG8_WAIT_L(0); PG8_MMA(0, 1, At, B1); PG8_BAR;
            PG8_LDA(At, 1, 1); PG8_STAGE(PG8_SA(1, 0), a3, voffA);
            PG8_BAR; PG8_WAIT_L(0); PG8_MMA(1, 0, At, B0); PG8_BAR; PG8_SCHED;
            PG8_STAGE(PG8_SB(1, 1), b3 + hstep, voffB);
            PG8_WAIT_V(6); PG8_BAR; PG8_MMA(1, 1, At, B1); PG8_BAR;
            }
        }
        if constexpr (ALIGN_EPI) { if (wr == 0) PG8_BAR; }
        if constexpr (!Epi::AFTER_DRAIN) { E(acc, cur, wr, wc, fr, fq); S.done(cur); }
        if (!has_next) break;
#pragma unroll
        for (int a = 0; a < 2; ++a)
#pragma unroll
            for (int b = 0; b < 2; ++b)
#pragma unroll
                for (int m = 0; m < 4; ++m)
#pragma unroll
                    for (int n = 0; n < 2; ++n) acc[a][b][m][n] = (f32x4){0.f, 0.f, 0.f, 0.f};
        cur = nxt; cA = nA; cB = nB; ++ui;
        if constexpr (ALIGN_EPI) { if (wr == 1) PG8_BAR; }
    }
    PG8_WAIT_V(0);
    if constexpr (!ALIGN_EPI) { if (wr == 0) PG8_BAR; }
    PG8_BAR;
    if constexpr (Epi::AFTER_DRAIN) { E.fused(acc, cur, wr, wc, fr, fq, lds, wid, lane); S.done(cur); }
#undef PG8_SA
#undef PG8_SB
#undef PG8_STAGE
#undef PG8_LDA
#undef PG8_LDB
#undef PG8_MMA
#undef PG8_WAIT_V
#undef PG8_WAIT_L
#undef PG8_BAR
#undef PG8_SCHED
}
}
#define XB_TMO      128
#define XB_XCNT(j)  (256  + 64 * (j))
#define XB_XSUB(j)  (1280 + 64 * (j))
#define XB_XGEN(j)  (2304 + 64 * (j))
#define XB_TOP      3328
#define XB_TOPGEN   3392
#define XCD_BAR_WORDS 3456
#define XB_SPIN_CAP (1u << 25)

__device__ __forceinline__ unsigned xb_ld(unsigned* p)              { return __hip_atomic_load(p, __ATOMIC_RELAXED, __HIP_MEMORY_SCOPE_AGENT); }
__device__ __forceinline__ unsigned xb_add(unsigned* p, unsigned v) { return __hip_atomic_fetch_add(p, v, __ATOMIC_RELAXED, __HIP_MEMORY_SCOPE_AGENT); }
__device__ __forceinline__ unsigned xb_xcc_id() { return (unsigned)__builtin_amdgcn_s_getreg((3 << 11) | 20) & 0xFu; }
#define XB_SPIN(cond, bar) do { unsigned _sp = 0; while (cond) { __builtin_amdgcn_s_sleep(1); \
    if ((++_sp & 255u) == 0u) { if (xb_ld(&(bar)[XB_TMO])) break; if (_sp > XB_SPIN_CAP) { atomicAdd(&(bar)[XB_TMO], 1u); break; } } } } while (0)

struct XcdBarrier {
    unsigned* bar; unsigned x;
    volatile LAS unsigned* st;
};

__device__ __forceinline__ XcdBarrier xcd_barrier_post(unsigned* bar, volatile LAS unsigned* st) {
    XcdBarrier b; b.bar = bar; b.x = xb_xcc_id(); b.st = st;
    if (threadIdx.x == 0) (void)xb_add(&bar[XB_XCNT(b.x)], 1u);
    return b;
}
__device__ __forceinline__ void xcd_barrier_complete(unsigned* bar, unsigned x, unsigned& nloc, unsigned& nx) {
    const unsigned G = gridDim.x * gridDim.y * gridDim.z;
    unsigned sum, cnt, mine, sp = 0u;
    for (;;) {
        sum = 0u; cnt = 0u; mine = 0u;
#pragma unroll
        for (unsigned j = 0; j < 16; ++j) { const unsigned c = xb_ld(&bar[XB_XCNT(j)]); sum += c; cnt += (c > 0u) ? 1u : 0u; mine = (j == x) ? c : mine; }
        if (sum == G) break;
        __builtin_amdgcn_s_sleep(1);
        if ((++sp & 255u) == 0u) { if (xb_ld(&bar[XB_TMO])) break; if (sp > XB_SPIN_CAP) { atomicAdd(&bar[XB_TMO], 1u); break; } }
    }
    nloc = mine > 0u ? mine : 1u; nx = cnt > 0u ? cnt : 1u;
}

__device__ __forceinline__ void xcd_barrier(const XcdBarrier& b) {
    asm volatile("s_waitcnt vmcnt(0)" ::: "memory");
    __syncthreads();
    if (threadIdx.x == 0) {
        unsigned* bar = b.bar;
        __builtin_amdgcn_s_waitcnt(0);
        unsigned nloc = b.st[0], nx = b.st[1];
        if (nloc == 0u) { xcd_barrier_complete(bar, b.x, nloc, nx); b.st[0] = nloc; b.st[1] = nx; }
        const unsigned old = xb_add(&bar[XB_XSUB(b.x)], 1u);
        const unsigned gen = old / nloc;
        if (old + 1u == (gen + 1u) * nloc) {
            __builtin_amdgcn_fence(__ATOMIC_RELEASE, "agent");
            asm volatile("s_waitcnt vmcnt(0)" ::: "memory");
            const unsigned og = xb_add(&bar[XB_TOP], 1u);
            const unsigned tg = og / nx;
            if (og + 1u == (tg + 1u) * nx) xb_add(&bar[XB_TOPGEN], 1u);
            else XB_SPIN(xb_ld(&bar[XB_TOPGEN]) == tg, bar);
            __builtin_amdgcn_fence(__ATOMIC_ACQUIRE, "agent");
            xb_add(&bar[XB_XGEN(b.x)], 1u);
            asm volatile("s_waitcnt vmcnt(0)" ::: "memory");
        } else {
            XB_SPIN(xb_ld(&bar[XB_XGEN(b.x)]) == gen, bar);
            __builtin_amdgcn_fence(__ATOMIC_ACQUIRE, "agent");
            asm volatile("s_waitcnt vmcnt(0)" ::: "memory");
        }
    }
    __syncthreads();
}

namespace epi {
using pg8::Unit; using pg8::BM; using pg8::HALF;
typedef const pg8::f32x4 (&AccRef)[2][2][4][2];

struct EpiProj1 {
    static constexpr bool PERM = false, AFTER_DRAIN = false;
    bf16* O; const float* cosT; const float* sinT;
    __device__ __forceinline__ void operator()(AccRef acc, const Unit& u, int wr, int wc, int fr, int fq) const {
        const int row0 = u.pm * BM + wr * 64 + fr, colw = u.pn * BM + wc * 32;
#pragma unroll
        for (int bj = 0; bj < 2; ++bj) {
            const int hb = (colw + bj * HALF) >> 6;
            const bool rope = (hb >= 40 && hb < 50) || (hb >= 52 && hb < 54) || (hb >= 56 && hb < 58) || (hb >= 60 && hb < 76);
            const bool isq = (hb >= 40 && hb < 48) || (hb >= 60 && hb < 68);
            const float qs = isq ? QSCALE : 1.0f;
            const int jw = (wc & 1) * 16 + fq * 2;
#pragma unroll
            for (int ai = 0; ai < 2; ++ai)
#pragma unroll
                for (int m = 0; m < 4; ++m) {
                    const int row = row0 + ai * HALF + m * 16;
                    bf16* rowp = O + (size_t)row * NP1 + colw + bj * HALF + 4 * fq;
#pragma unroll
                    for (int n = 0; n < 2; ++n) {
                        pg8::f32x4 v = acc[ai][bj][m][n];
                        if (rope) {
                            const f32x2 c = *(const f32x2*)(cosT + (size_t)row * 32 + jw + n * 8), s = *(const f32x2*)(sinT + (size_t)row * 32 + jw + n * 8);
                            const float y0 = v[0] * c.x - v[1] * s.x, y1 = v[1] * c.x + v[0] * s.x, y2 = v[2] * c.y - v[3] * s.y, y3 = v[3] * c.y + v[2] * s.y;
                            v[0] = y0 * qs; v[1] = y1 * qs; v[2] = y2 * qs; v[3] = y3 * qs;
                        }
                        v2u w; w.x = pk2(v[0], v[1]); w.y = pk2(v[2], v[3]);
                        *(v2u*)(rowp + n * 16) = w;
                    }
                }
        }
    }
};
template <int ACT> struct EpiStore {
    static constexpr bool PERM = false, AFTER_DRAIN = false;
    bf16* O; int ldc;
    __device__ __forceinline__ void operator()(AccRef acc, const Unit& u, int wr, int wc, int fr, int fq) const {
        const int row0 = u.pm * BM + wr * 64 + fr, col0 = u.pn * BM + wc * 32 + 4 * fq;
#pragma unroll
        for (int ai = 0; ai < 2; ++ai)
#pragma unroll
            for (int m = 0; m < 4; ++m) { bf16* rowp = O + (size_t)(row0 + ai * HALF + m * 16) * ldc + col0;
#pragma unroll
                for (int bj = 0; bj < 2; ++bj)
#pragma unroll
                    for (int n = 0; n < 2; ++n) { pg8::f32x4 v = acc[ai][bj][m][n];
                        if (ACT == 1) { v[0] = sigmoidf_(v[0]); v[1] = sigmoidf_(v[1]); v[2] = sigmoidf_(v[2]); v[3] = sigmoidf_(v[3]); }
                        v2u w; w.x = pk2(v[0], v[1]); w.y = pk2(v[2], v[3]); *(v2u*)(rowp + bj * HALF + n * 16) = w; } }
    }
};
struct EpiMerge {
    static constexpr bool PERM = false, AFTER_DRAIN = false;
    bf16* O; const bf16* G; int seg;
    __device__ __forceinline__ void operator()(AccRef acc, const Unit& u, int wr, int wc, int fr, int fq) const {
        const int row0 = u.pm * BM + wr * 64 + fr, col0 = u.pn * BM + wc * 32 + 4 * fq;
#pragma unroll
        for (int ai = 0; ai < 2; ++ai)
#pragma unroll
            for (int m = 0; m < 4; ++m) { const size_t row = (size_t)(row0 + ai * HALF + m * 16); bf16* rowp = O + row * DM + col0; const bf16* gp = G + row * NGT + seg * DM + col0;
#pragma unroll
                for (int bj = 0; bj < 2; ++bj)
#pragma unroll
                    for (int n = 0; n < 2; ++n) { pg8::f32x4 v = acc[ai][bj][m][n];
                        const v2u g = *(const v2u*)(gp + bj * HALF + n * 16);
                        v[0] *= bflo(g.x); v[1] *= bfhi(g.x); v[2] *= bflo(g.y); v[3] *= bfhi(g.y);
                        if (seg != 0) { const v2u o = *(const v2u*)(rowp + bj * HALF + n * 16); v[0] += bflo(o.x); v[1] += bfhi(o.x); v[2] += bflo(o.y); v[3] += bfhi(o.y); }
                        v2u w; w.x = pk2(v[0], v[1]); w.y = pk2(v[2], v[3]); *(v2u*)(rowp + bj * HALF + n * 16) = w; } }
    }
};
struct EpiResid {
    static constexpr bool PERM = false, AFTER_DRAIN = false;
    const float* XI; float* XO; const float* gate;
    __device__ __forceinline__ void operator()(AccRef acc, const Unit& u, int wr, int wc, int fr, int fq) const {
        const int row0 = u.pm * BM + wr * 64 + fr, col0 = u.pn * BM + wc * 32 + 4 * fq;
        const float* gb = gate + (size_t)((u.pm * BM) / SEQ) * 6144 + col0;
        pg8::f32x4 gv[2][2];
#pragma unroll
        for (int bj = 0; bj < 2; ++bj)
#pragma unroll
            for (int n = 0; n < 2; ++n) gv[bj][n] = *(const pg8::f32x4*)(gb + bj * HALF + n * 16);
#pragma unroll
        for (int ai = 0; ai < 2; ++ai)
#pragma unroll
            for (int m = 0; m < 4; ++m) { const size_t off = (size_t)(row0 + ai * HALF + m * 16) * DM + col0;
#pragma unroll
                for (int bj = 0; bj < 2; ++bj)
#pragma unroll
                    for (int n = 0; n < 2; ++n) { const pg8::f32x4 xi = *(const pg8::f32x4*)(XI + off + bj * HALF + n * 16);
                        *(pg8::f32x4*)(XO + off + bj * HALF + n * 16) = xi + gv[bj][n] * acc[ai][bj][m][n]; } }
    }
};
}

constexpr int NWAVES = 8, NTHR = 512;
struct Args { const void* in[26]; float* out; unsigned char* ws; int ph_lo, ph_hi; };
enum InIdx { I_X = 0, I_C, I_POS, I_MODW, I_MODB, I_NMG, I_NFG, I_WIN, I_ACW, I_AOUT, I_BCW, I_BCB, I_BLNG, I_BLNB, I_BOUT, I_CPOS, I_CW1, I_CW2, I_COUT, I_DOUT, I_WO, I_PWQ, I_PSUB, I_PU, I_PV, I_FNG };

struct Frame {
    LAS unsigned char* lds; unsigned char* ldsg;
    int tid, lane, wave, G, bid;
    unsigned char* ws;
};
__device__ __forceinline__ int gwave(const Frame& F) { return F.bid * NWAVES + F.wave; }
__device__ __forceinline__ int ngwave(const Frame& F) { return F.G * NWAVES; }

__device__ __forceinline__ int rope_pos_of_dim(int d) { return d < 32 ? 2 * d : 2 * (d - 32) + 1; }
__device__ __forceinline__ int rope_dim_of_pos(int p) { return (p >> 1) + 32 * (p & 1); }
__device__ __forceinline__ int win_row_of_col(int n) {
    if (n < 2560) return n;
    if (n < 3072) { const int c = n - 2560; return C_CQ + (c & ~63) + rope_pos_of_dim(c & 63); }
    if (n < 3200) { const int c = n - 3072; return C_KC + (c & ~63) + rope_pos_of_dim(c & 63); }
    if (n < 3328) return C_VC + (n - 3200);
    if (n < 3456) { const int c = n - 3328; return C_KS + (c & ~63) + rope_pos_of_dim(c & 63); }
    if (n < 3584) return C_VS + (n - 3456);
    if (n < 3712) { const int c = n - 3584; return C_KW + (c & ~63) + rope_pos_of_dim(c & 63); }
    if (n < 3840) return C_VW + (n - 3712);
    if (n < 3864) return C_CG + (n - 3840);
    if (n < 4376) { const int c = n - 3864; return C_DQ + (c & ~63) + rope_pos_of_dim(c & 63); }
    if (n < 4888) { const int c = n - 4376; return C_DK + (c & ~63) + rope_pos_of_dim(c & 63); }
    if (n < 5400) return C_DV + (n - 4888);
    return NP1 + (n - 5400);
}
template <int MODE, bool KPERM>
__device__ __forceinline__ void transpose_item(const float* W, int K, int N, bf16* WT, LAS float* scr, int item, int lane) {
    const int nblk = (N + 31) / 32, kb = item / nblk, nb = item % nblk, k0 = 64 * kb, n0 = 32 * nb;
    const int nsrc = n0 + (lane & 31); const bool nok = nsrc < N;
#pragma unroll 8
    for (int i = 0; i < 32; ++i) { const int kk = 2 * i + (lane >> 5); scr[kk * 33 + (lane & 31)] = nok ? W[(size_t)(k0 + kk) * N + nsrc] : 0.f; }
    LDS_WAIT(); asm volatile("" ::: "memory");
    const int c = lane & 7;
#pragma unroll
    for (int j = 0; j < 4; ++j) { const int n = (lane >> 3) + 8 * j;
        float s[8];
#pragma unroll
        for (int e = 0; e < 8; ++e) { const int p = 8 * c + e; const int ks = KPERM ? rope_dim_of_pos(p) : p; s[e] = scr[ks * 33 + n]; }
        v4u o; o.x = pk2(s[0], s[1]); o.y = pk2(s[2], s[3]); o.z = pk2(s[4], s[5]); o.w = pk2(s[6], s[7]);
        if (n0 + n < N) { const int row = (MODE == 1) ? win_row_of_col(n0 + n) : (n0 + n); *(v4u*)(WT + (size_t)row * K + k0 + 8 * c) = o; } }
    LDS_WAIT(); asm volatile("" ::: "memory");
}
template <int MODE, bool KPERM>
__device__ __forceinline__ void transpose_matrix(const Frame& F, const float* W, int K, int N, bf16* WT, int& base) {
    LAS float* scr = (LAS float*)(F.lds + F.wave * 16384);
    const int nitems = (K / 64) * ((N + 31) / 32), gw = gwave(F), NGW = ngwave(F);
    int first = (gw - base % NGW + NGW) % NGW;
    for (int it = first; it < nitems; it += NGW) transpose_item<MODE, KPERM>(W, K, N, WT, scr, it, F.lane);
    base += nitems;
}
__device__ __forceinline__ void convert_copy(const Frame& F, const float* src, bf16* dst, size_t n) {
    const size_t nth = (size_t)F.G * NTHR, t0 = (size_t)F.bid * NTHR + F.tid;
    for (size_t i = t0; i < n / 8; i += nth) { const f32x4 a = *(const f32x4*)(src + i * 8), b = *(const f32x4*)(src + i * 8 + 4);
        v4u o; o.x = pk2(a[0], a[1]); o.y = pk2(a[2], a[3]); o.z = pk2(b[0], b[1]); o.w = pk2(b[2], b[3]); *(v4u*)(dst + i * 8) = o; }
}

typedef __attribute__((address_space(4))) const Args* KArgsP;
__device__ __forceinline__ void phase_prologue(const Frame& F, KArgsP Ap) {
    unsigned char* ws = F.ws;
    int base = 0;
    for (int l = 0; l < DEPTH; ++l) {
        transpose_matrix<1, false>(F, (const float*)Ap->in[I_WIN] + (size_t)l * DM * 9496, DM, 9496, (bf16*)(ws + WS_WIN) + (size_t)l * NWIN * DM, base);
        transpose_matrix<0, false>(F, (const float*)Ap->in[I_AOUT] + (size_t)l * 512 * DM, 512, DM, (bf16*)(ws + WS_WOUT) + (size_t)(l * 4 + 0) * DM * 512, base);
        transpose_matrix<0, false>(F, (const float*)Ap->in[I_BOUT] + (size_t)l * 512 * DM, 512, DM, (bf16*)(ws + WS_WOUT) + (size_t)(l * 4 + 1) * DM * 512, base);
        transpose_matrix<0, false>(F, (const float*)Ap->in[I_COUT] + (size_t)l * 512 * DM, 512, DM, (bf16*)(ws + WS_WOUT) + (size_t)(l * 4 + 2) * DM * 512, base);
        transpose_matrix<0, false>(F, (const float*)Ap->in[I_DOUT] + (size_t)l * 512 * DM, 512, DM, (bf16*)(ws + WS_WOUT) + (size_t)(l * 4 + 3) * DM * 512, base);
        transpose_matrix<0, false>(F, (const float*)Ap->in[I_WO] + (size_t)l * DM * DM, DM, DM, (bf16*)(ws + WS_WO) + (size_t)l * DM * DM, base);
        transpose_matrix<0, false>(F, (const float*)Ap->in[I_PWQ] + (size_t)l * DM * 2048, DM, 2048, (bf16*)(ws + WS_WQ) + (size_t)l * 2048 * DM, base);
        transpose_matrix<0, true>(F, (const float*)Ap->in[I_CW1] + (size_t)(l * 2 + 0) * 2048 * 128, 2048, 128, (bf16*)(ws + WS_W1T) + (size_t)(l * 2 + 0) * 128 * 2048, base);
        transpose_matrix<0, false>(F, (const float*)Ap->in[I_CW1] + (size_t)(l * 2 + 1) * 2048 * 128, 2048, 128, (bf16*)(ws + WS_W1T) + (size_t)(l * 2 + 1) * 128 * 2048, base);
    }
    convert_copy(F, (const float*)Ap->in[I_PSUB], (bf16*)(ws + WS_SUBK), (size_t)DEPTH * 8 * 2 * 128 * 128);
    const int gt = F.bid * NTHR + F.tid, NGT_ = F.G * NTHR;
    { const float* w2 = (const float*)Ap->in[I_CW2]; bf16* w2t = (bf16*)(ws + WS_SMALL + SM_W2T);
      for (int i = gt; i < DEPTH * 2 * 64 * 128; i += NGT_) { const int k = i & 127, n = (i >> 7) & 63, lw = i >> 13; w2t[i] = (bf16)f2bf(w2[((size_t)lw * 128 + k) * 64 + n]); } }
    { const int* pos = (const int*)Ap->in[I_POS]; float* ct = (float*)(ws + WS_COS); float* st = (float*)(ws + WS_SIN);
      for (int i = gt; i < TOK * 32; i += NGT_) { const int t = i >> 5, j = i & 31;
          const float inv = 1.0f / powf(10000.0f, (float)(2 * j) / 64.0f); const float ang = (float)pos[t] * inv;
          ct[i] = (float)cos((double)ang); st[i] = (float)sin((double)ang); } }
    { const float* w1 = (const float*)Ap->in[I_CW1]; const float* cp = (const float*)Ap->in[I_CPOS]; float* pbp = (float*)(ws + WS_SMALL + SM_PBP);
      for (int i = gt; i < DEPTH * 2 * 16 * 128; i += NGT_) { const int n = i & 127, kc = (i >> 7) & 15, lw = i >> 11; float s = 0.f;
          for (int k = kc * 128; k < kc * 128 + 128; ++k) s += cp[(size_t)lw * 2048 + k] * w1[((size_t)lw * 2048 + k) * 128 + n];
          pbp[i] = s; } }
    __syncthreads();
    { LAS float* cond = (LAS float*)(F.lds);
      LAS float* red = (LAS float*)(F.lds + 32768);
      const float* c = (const float*)Ap->in[I_C];
      for (int i = F.tid; i < 8 * 1024; i += NTHR) { const float v = c[i]; cond[i] = v / (1.0f + __expf(-v)); }
      __syncthreads();
      for (int un = F.bid; un < DEPTH * 96; un += F.G) { const int l = un / 96, n0 = (un % 96) * 64;
          const float* mw = (const float*)Ap->in[I_MODW] + (size_t)l * DM * 6144 + n0 + F.lane;
          float acc[8];
#pragma unroll
          for (int b = 0; b < 8; ++b) acc[b] = 0.f;
#pragma unroll 4
          for (int k = F.wave * 128; k < F.wave * 128 + 128; ++k) { const float w = mw[(size_t)k * 6144];
#pragma unroll
              for (int b = 0; b < 8; ++b) acc[b] += cond[b * 1024 + k] * w; }
#pragma unroll
          for (int b = 0; b < 8; ++b) red[(F.wave * 8 + b) * 64 + F.lane] = acc[b];
          __syncthreads();
          { const int b = F.tid >> 6, n = F.tid & 63; float s = 0.f;
#pragma unroll
            for (int w = 0; w < 8; ++w) s += red[(w * 8 + b) * 64 + n];
            ((float*)(ws + WS_MOD))[((size_t)l * 8 + b) * 6144 + n0 + n] = s + ((const float*)Ap->in[I_MODB])[(size_t)l * 6144 + n0 + n]; }
          __syncthreads(); }
    }
}

__device__ __forceinline__ void phase_norm_mod(const Frame& F, const float* X, const float* g, const float* sh, const float* sc, bf16* O) {
    const int gw = gwave(F), NGW = ngwave(F);
    f32x4 gv[4];
#pragma unroll
    for (int j = 0; j < 4; ++j) gv[j] = *(const f32x4*)(g + 4 * F.lane + 256 * j);
    for (int row = gw; row < TOK; row += NGW) {
        const int b = row / SEQ; const float* xr = X + (size_t)row * DM + 4 * F.lane;
        f32x4 v[4]; float s = 0.f;
#pragma unroll
        for (int j = 0; j < 4; ++j) { v[j] = *(const f32x4*)(xr + 256 * j); s += (v[j][0] * v[j][0] + v[j][1] * v[j][1]) + (v[j][2] * v[j][2] + v[j][3] * v[j][3]); }
        const float r = 1.0f / sqrtf(wave_sum(s, F.lane) * (1.0f / DM) + NORM_EPS);
        bf16* orow = O + (size_t)row * DM + 4 * F.lane;
#pragma unroll
        for (int j = 0; j < 4; ++j) { const f32x4 scv = *(const f32x4*)(sc + (size_t)b * 6144 + 4 * F.lane + 256 * j), shv = *(const f32x4*)(sh + (size_t)b * 6144 + 4 * F.lane + 256 * j);
            const f32x4 y = v[j] * r * gv[j] * (scv + 1.0f) + shv; v2u w; w.x = pk2(y[0], y[1]); w.y = pk2(y[2], y[3]); *(v2u*)(orow + 256 * j) = w; }
    }
}
__device__ __forceinline__ void phase_final_norm(const Frame& F, const float* X, const float* g, float* O) {
    const int gw = gwave(F), NGW = ngwave(F);
    f32x4 gv[4];
#pragma unroll
    for (int j = 0; j < 4; ++j) gv[j] = *(const f32x4*)(g + 4 * F.lane + 256 * j);
    for (int row = gw; row < TOK; row += NGW) {
        const float* xr = X + (size_t)row * DM + 4 * F.lane; f32x4 v[4]; float s = 0.f;
#pragma unroll
        for (int j = 0; j < 4; ++j) { v[j] = *(const f32x4*)(xr + 256 * j); s += (v[j][0] * v[j][0] + v[j][1] * v[j][1]) + (v[j][2] * v[j][2] + v[j][3] * v[j][3]); }
        const float r = 1.0f / sqrtf(wave_sum(s, F.lane) * (1.0f / DM) + NORM_EPS);
        float* orow = O + (size_t)row * DM + 4 * F.lane;
#pragma unroll
        for (int j = 0; j < 4; ++j) *(f32x4*)(orow + 256 * j) = v[j] * r * gv[j];
    }
}

__device__ __forceinline__ void phase_mixer_a(const Frame& F, const bf16* P, const float* cw  , bf16* O  ) {
    const int nth = F.G * NTHR, gt = F.bid * NTHR + F.tid;
    for (int it = gt; it < (TOK / 32) * 64; it += nth) {
        const int cg = it & 63, tb = it >> 6, c0 = cg * 8, t0 = tb * 32, s0 = t0 % SEQ;
        float w0[8], w1[8], w2[8];
#pragma unroll
        for (int e = 0; e < 8; ++e) { w0[e] = cw[c0 + e]; w1[e] = cw[512 + c0 + e]; w2[e] = cw[1024 + c0 + e]; }
        float pm2[8], pm1[8];
#pragma unroll
        for (int e = 0; e < 8; ++e) { pm2[e] = 0.f; pm1[e] = 0.f; }
        for (int pre = 2; pre >= 1; --pre) if (s0 - pre >= 0) { const bf16* r = P + (size_t)(t0 - pre) * NP1;
            const v4u ac = *(const v4u*)(r + C_AC + c0), ax = *(const v4u*)(r + C_AX + c0);
            float pr[8]; pr[0] = bflo(ac.x) * bflo(ax.x); pr[1] = bfhi(ac.x) * bfhi(ax.x); pr[2] = bflo(ac.y) * bflo(ax.y); pr[3] = bfhi(ac.y) * bfhi(ax.y);
            pr[4] = bflo(ac.z) * bflo(ax.z); pr[5] = bfhi(ac.z) * bfhi(ax.z); pr[6] = bflo(ac.w) * bflo(ax.w); pr[7] = bfhi(ac.w) * bfhi(ax.w);
#pragma unroll
            for (int e = 0; e < 8; ++e) { if (pre == 2) pm2[e] = pr[e]; else pm1[e] = pr[e]; } }
        for (int tt = 0; tt < 32; ++tt) { const bf16* r = P + (size_t)(t0 + tt) * NP1;
            const v4u ac = *(const v4u*)(r + C_AC + c0), ax = *(const v4u*)(r + C_AX + c0), ab = *(const v4u*)(r + C_AB + c0);
            float pr[8], bb[8], y[8];
            pr[0] = bflo(ac.x) * bflo(ax.x); pr[1] = bfhi(ac.x) * bfhi(ax.x); pr[2] = bflo(ac.y) * bflo(ax.y); pr[3] = bfhi(ac.y) * bfhi(ax.y);
            pr[4] = bflo(ac.z) * bflo(ax.z); pr[5] = bfhi(ac.z) * bfhi(ax.z); pr[6] = bflo(ac.w) * bflo(ax.w); pr[7] = bfhi(ac.w) * bfhi(ax.w);
            bb[0] = bflo(ab.x); bb[1] = bfhi(ab.x); bb[2] = bflo(ab.y); bb[3] = bfhi(ab.y); bb[4] = bflo(ab.z); bb[5] = bfhi(ab.z); bb[6] = bflo(ab.w); bb[7] = bfhi(ab.w);
#pragma unroll
            for (int e = 0; e < 8; ++e) { y[e] = bb[e] * (w0[e] * pm2[e] + w1[e] * pm1[e] + w2[e] * pr[e]); pm2[e] = pm1[e]; pm1[e] = pr[e]; }
            v4u o; o.x = pk2(y[0], y[1]); o.y = pk2(y[2], y[3]); o.z = pk2(y[4], y[5]); o.w = pk2(y[6], y[7]);
            *(v4u*)(O + (size_t)(t0 + tt) * 512 + c0) = o; }
    }
}

__device__ __forceinline__ void phase_mixer_b(const Frame& F, const bf16* P, const float* cw  , const float* cb, const float* lg, const float* lb, bf16* O) {
    LAS float* U = (LAS float*)F.lds;
    for (int un = F.bid; un < TOK / 32; un += F.G) {
        const int t0 = un * 32, s0 = t0 % SEQ;
        __syncthreads();
        for (int i = F.tid; i < 62 * 64; i += NTHR) { const int r = i >> 6, cg = i & 63, c0 = cg * 8; const int srel = s0 - 30 + r;
            float u[8];
            if (srel >= 0) { const bf16* row = P + (size_t)(t0 - 30 + r) * NP1; const v4u a = *(const v4u*)(row + C_BA + c0), g = *(const v4u*)(row + C_BG + c0);
                u[0] = bflo(a.x) * sigmoidf_(bflo(g.x)); u[1] = bfhi(a.x) * sigmoidf_(bfhi(g.x)); u[2] = bflo(a.y) * sigmoidf_(bflo(g.y)); u[3] = bfhi(a.y) * sigmoidf_(bfhi(g.y));
                u[4] = bflo(a.z) * sigmoidf_(bflo(g.z)); u[5] = bfhi(a.z) * sigmoidf_(bfhi(g.z)); u[6] = bflo(a.w) * sigmoidf_(bflo(g.w)); u[7] = bfhi(a.w) * sigmoidf_(bfhi(g.w)); }
            else {
#pragma unroll
                for (int e = 0; e < 8; ++e) u[e] = 0.f; }
            *(LAS f32x4*)(U + r * 512 + c0) = (f32x4){u[0], u[1], u[2], u[3]}; *(LAS f32x4*)(U + r * 512 + c0 + 4) = (f32x4){u[4], u[5], u[6], u[7]}; }
        __syncthreads();
        const int c0 = F.lane * 8;
        float acc[4][8];
#pragma unroll
        for (int q = 0; q < 4; ++q)
#pragma unroll
            for (int e = 0; e < 8; ++e) acc[q][e] = cb[c0 + e];
        for (int k = 0; k < 31; ++k) { const f32x4 wa = *(const f32x4*)(cw + k * 512 + c0), wb = *(const f32x4*)(cw + k * 512 + c0 + 4);
#pragma unroll
            for (int q = 0; q < 4; ++q) { const int r = 4 * F.wave + q + k; const f32x4 ua = *(LAS f32x4*)(U + r * 512 + c0), ub = *(LAS f32x4*)(U + r * 512 + c0 + 4);
                acc[q][0] += wa[0] * ua[0]; acc[q][1] += wa[1] * ua[1]; acc[q][2] += wa[2] * ua[2]; acc[q][3] += wa[3] * ua[3];
                acc[q][4] += wb[0] * ub[0]; acc[q][5] += wb[1] * ub[1]; acc[q][6] += wb[2] * ub[2]; acc[q][7] += wb[3] * ub[3]; } }
        const f32x4 ga = *(const f32x4*)(lg + c0), gb = *(const f32x4*)(lg + c0 + 4), ba = *(const f32x4*)(lb + c0), bb = *(const f32x4*)(lb + c0 + 4);
#pragma unroll
        for (int q = 0; q < 4; ++q) { float s = 0.f;
#pragma unroll
            for (int e = 0; e < 8; ++e) s += acc[q][e];
            const float mu = wave_sum(s, F.lane) * (1.0f / 512.0f); float v = 0.f;
#pragma unroll
            for (int e = 0; e < 8; ++e) { acc[q][e] -= mu; v += acc[q][e] * acc[q][e]; }
            const float rs = 1.0f / sqrtf(wave_sum(v, F.lane) * (1.0f / 512.0f) + NORM_EPS);
            float y[8];
#pragma unroll
            for (int e = 0; e < 8; ++e) { const float gg = e < 4 ? ga[e] : gb[e - 4], bv = e < 4 ? ba[e] : bb[e - 4]; const float z = acc[q][e] * rs * gg + bv; y[e] = z / (1.0f + __expf(-z)); }
            v4u o; o.x = pk2(y[0], y[1]); o.y = pk2(y[2], y[3]); o.z = pk2(y[4], y[5]); o.w = pk2(y[6], y[7]);
            *(v4u*)(O + (size_t)(t0 + 4 * F.wave + q) * 512 + c0) = o; }
    }
}

__device__ __forceinline__ void phase_compress(const Frame& F, const bf16* P, const bf16* W1T  , const bf16* W2T  , const float* PBP  ,
                                               bf16* KC, bf16* VC  ) {
    LAS bf16* H1 = (LAS bf16*)(F.lds + F.wave * 8192);
    const int gw = gwave(F), NGW = ngwave(F), lane = F.lane, r16 = lane & 15, q4 = lane >> 4;
    for (int un = gw; un < 2 * 8 * 2 * 8; un += NGW) {
        const int nb = un & 7, g = (un >> 3) & 1, b = (un >> 4) & 7, which = un >> 7;
        const int n = nb * 16 + r16; const int nn = n < 127 ? n : 126;
        const int col0 = (which == 0 ? C_KC : C_VC) + g * 64;
        const bf16* arow = P + ((size_t)b * SEQ + nn * 16) * NP1 + col0;
        const bf16* w1 = W1T + (size_t)which * 128 * 2048;
        f32x4 acc[8];
#pragma unroll
        for (int j = 0; j < 8; ++j) acc[j] = (f32x4){0.f, 0.f, 0.f, 0.f};
        for (int ks = 0; ks < 64; ++ks) {
            const int k = ks * 32 + q4 * 8; const bf16x8 a = *(const bf16x8*)(arow + (size_t)(k >> 6) * NP1 + (k & 63));
#pragma unroll
            for (int j = 0; j < 8; ++j) { const bf16x8 bb = *(const bf16x8*)(w1 + (size_t)(j * 16 + r16) * 2048 + k);
                acc[j] = __builtin_amdgcn_mfma_f32_16x16x32_bf16(a, bb, acc[j], 0, 0, 0); } }
#pragma unroll
        for (int j = 0; j < 8; ++j) { float pb = 0.f;
#pragma unroll
            for (int kc = 0; kc < 16; ++kc) pb += PBP[((size_t)which * 16 + kc) * 128 + j * 16 + r16];
#pragma unroll
            for (int i = 0; i < 4; ++i) H1[(4 * q4 + i) * 136 + j * 16 + r16] = (bf16)f2bf(gelu_erf(acc[j][i] + pb)); }
        LDS_WAIT(); asm volatile("" ::: "memory");
        f32x4 o[4];
#pragma unroll
        for (int j = 0; j < 4; ++j) o[j] = (f32x4){0.f, 0.f, 0.f, 0.f};
        const bf16* w2 = W2T + (size_t)which * 64 * 128;
#pragma unroll
        for (int ks = 0; ks < 4; ++ks) { const bf16x8 a = *(LAS bf16x8*)(H1 + r16 * 136 + ks * 32 + q4 * 8);
#pragma unroll
            for (int j = 0; j < 4; ++j) { const bf16x8 bb = *(const bf16x8*)(w2 + (size_t)(j * 16 + r16) * 128 + ks * 32 + q4 * 8);
                o[j] = __builtin_amdgcn_mfma_f32_16x16x32_bf16(a, bb, o[j], 0, 0, 0); } }
        bf16* out = (which == 0 ? KC : VC) + ((size_t)(b * 2 + g) * 128) * 64;
#pragma unroll
        for (int j = 0; j < 4; ++j)
#pragma unroll
            for (int i = 0; i < 4; ++i) { const int row = nb * 16 + 4 * q4 + i; out[(size_t)row * 64 + j * 16 + r16] = row < 127 ? (bf16)f2bf(o[j][i]) : (bf16)0; }
        LDS_WAIT(); asm volatile("" ::: "memory");
    }
}
__device__ __forceinline__ void phase_kmean(const Frame& F, const bf16* P, float* KM) {
    const int gw = gwave(F), NGW = ngwave(F), lane = F.lane, rs = lane >> 3, ch = lane & 7;
    for (int un = gw; un < 8 * 8 * 8; un += NGW) { const int h = un & 7, blk = (un >> 3) & 7, b = un >> 6;
        const bf16* base = P + ((size_t)b * SEQ + blk * 256) * NP1 + C_DK + h * 64 + ch * 8;
        float s[8];
#pragma unroll
        for (int e = 0; e < 8; ++e) s[e] = 0.f;
        for (int i = 0; i < 32; ++i) { const v4u v = *(const v4u*)(base + (size_t)(i * 8 + rs) * NP1);
            s[0] += bflo(v.x); s[1] += bfhi(v.x); s[2] += bflo(v.y); s[3] += bfhi(v.y); s[4] += bflo(v.z); s[5] += bfhi(v.z); s[6] += bflo(v.w); s[7] += bfhi(v.w); }
#pragma unroll
        for (int e = 0; e < 8; ++e) { s[e] += shx(s[e], 8, lane); s[e] += shx(s[e], 16, lane); s[e] = add32(s[e]); }
        if (rs == 0) { float* o = KM + ((size_t)(b * 8 + blk) * 8 + h) * 64 + ch * 8;
            *(f32x4*)o = (f32x4){s[0], s[1], s[2], s[3]} * (1.0f / 256.0f); *(f32x4*)(o + 4) = (f32x4){s[4], s[5], s[6], s[7]} * (1.0f / 256.0f); }
    }
}

constexpr int KT_STRIDE = 144, VT_STRIDE = 192, KT_BYTES = 64 * KT_STRIDE, VT_BYTES = 64 * VT_STRIDE, KV_BUF = KT_BYTES + VT_BYTES;
__device__ __forceinline__ int crow(int r, int hi) { return (r & 3) + 8 * (r >> 2) + 4 * hi; }
struct AttnState { float m, l; f32x16 o0, o1; };
__device__ __forceinline__ void attn_reset(AttnState& st) { st.m = -1e30f; st.l = 0.f;
#pragma unroll
    for (int r = 0; r < 16; ++r) { st.o0[r] = 0.f; st.o1[r] = 0.f; } }
__device__ __forceinline__ s16x4 vtr(LAS const unsigned char* p) { return __builtin_bit_cast(s16x4, __builtin_amdgcn_ds_read_tr16_b64_v4i16((LAS s16x4*)p)); }

__device__ __forceinline__ void attn_scores(LAS const unsigned char* Kt, const bf16x8 (&qr)[4], f32x16& p0, f32x16& p1, int lane) {
    const int r32 = lane & 31, hi = lane >> 5;
#pragma unroll
    for (int r = 0; r < 16; ++r) { p0[r] = 0.f; p1[r] = 0.f; }
#pragma unroll
    for (int s = 0; s < 4; ++s) {
        const bf16x8 a0 = *(LAS const bf16x8*)(Kt + r32 * KT_STRIDE + (2 * s + hi) * 16), a1 = *(LAS const bf16x8*)(Kt + (32 + r32) * KT_STRIDE + (2 * s + hi) * 16);
        p0 = __builtin_amdgcn_mfma_f32_32x32x16_bf16(a0, qr[s], p0, 0, 0, 0);
        p1 = __builtin_amdgcn_mfma_f32_32x32x16_bf16(a1, qr[s], p1, 0, 0, 0);
    }
}
__device__ __forceinline__ void attn_pv(LAS const unsigned char* Vt, const f32x16& e0, const f32x16& e1, f32x16& o0, f32x16& o1, int lane) {
    const int hi = lane >> 5;
    LAS const unsigned char* vb = Vt + (4 * hi + ((lane & 15) >> 2)) * VT_STRIDE + (((lane >> 4) & 1) * 16 + 4 * (lane & 3)) * 2;
#pragma unroll
    for (int s = 0; s < 4; ++s) {
        v4u pw;
        if (s < 2) { pw.x = pk2(e0[8 * s + 0], e0[8 * s + 1]); pw.y = pk2(e0[8 * s + 2], e0[8 * s + 3]); pw.z = pk2(e0[8 * s + 4], e0[8 * s + 5]); pw.w = pk2(e0[8 * s + 6], e0[8 * s + 7]); }
        else { const int t = s - 2; pw.x = pk2(e1[8 * t + 0], e1[8 * t + 1]); pw.y = pk2(e1[8 * t + 2], e1[8 * t + 3]); pw.z = pk2(e1[8 * t + 4], e1[8 * t + 5]); pw.w = pk2(e1[8 * t + 6], e1[8 * t + 7]); }
        const bf16x8 pb = __builtin_bit_cast(bf16x8, pw);
#pragma unroll
        for (int db = 0; db < 2; ++db) {
            const s16x4 lo = vtr(vb + (16 * s) * VT_STRIDE + db * 64), hh = vtr(vb + (16 * s + 8) * VT_STRIDE + db * 64);
            const bf16x8 a = (bf16x8){lo[0], lo[1], lo[2], lo[3], hh[0], hh[1], hh[2], hh[3]};
            if (db == 0) o0 = __builtin_amdgcn_mfma_f32_32x32x16_bf16(a, pb, o0, 0, 0, 0); else o1 = __builtin_amdgcn_mfma_f32_32x32x16_bf16(a, pb, o1, 0, 0, 0);
        }
    }
}
__device__ __forceinline__ void attn_tile(LAS const unsigned char* Kt, LAS const unsigned char* Vt, const bf16x8 (&qr)[4], AttnState& st, int kmin, int kmax, int lane) {
    const int hi = lane >> 5;
    f32x16 p0, p1; attn_scores(Kt, qr, p0, p1, lane);
    float mx = -1e30f;
#pragma unroll
    for (int r = 0; r < 16; ++r) { const int k0 = crow(r, hi), k1 = 32 + k0;
        p0[r] = (k0 >= kmin && k0 <= kmax) ? p0[r] : -1e30f; p1[r] = (k1 >= kmin && k1 <= kmax) ? p1[r] : -1e30f;
        mx = fmaxf(mx, fmaxf(p0[r], p1[r])); }
    mx = max32(mx);
    const float mn = fmaxf(st.m, mx), alpha = __builtin_amdgcn_exp2f(st.m - mn);
    float rs = 0.f;
#pragma unroll
    for (int r = 0; r < 16; ++r) { p0[r] = p0[r] > -1e29f ? __builtin_amdgcn_exp2f(p0[r] - mn) : 0.f; p1[r] = p1[r] > -1e29f ? __builtin_amdgcn_exp2f(p1[r] - mn) : 0.f; rs += p0[r] + p1[r]; }
    st.m = mn; st.l = st.l * alpha + rs;
#pragma unroll
    for (int r = 0; r < 16; ++r) { st.o0[r] *= alpha; st.o1[r] *= alpha; }
    attn_pv(Vt, p0, p1, st.o0, st.o1, lane);
}
struct KVRegs { v4u k, v; };
__device__ __forceinline__ void kv_load(KVRegs& r, const bf16* Kg, const bf16* Vg, size_t ld, int tid) {
    const int key = tid >> 3, ch = tid & 7;
    r.k = *(const v4u*)(Kg + (size_t)key * ld + ch * 8); r.v = *(const v4u*)(Vg + (size_t)key * ld + ch * 8);
}
__device__ __forceinline__ void kv_store(const KVRegs& r, LAS unsigned char* buf, int tid) {
    const int key = tid >> 3, ch = tid & 7;
    *(LAS v4u*)(buf + key * KT_STRIDE + ch * 16) = r.k; *(LAS v4u*)(buf + KT_BYTES + key * VT_STRIDE + ch * 16) = r.v;
}

__device__ __forceinline__ float attn_inv_l(const AttnState& st) { const float l = add32(st.l); return 1.0f / fmaxf(l, 1e-30f); }

#define ATTN_STREAM(Kg, Vg, ld, j0, j1, SKIP, RANGE) do { \
    int jn_ = (j0); while (jn_ < (j1) && (SKIP(jn_))) ++jn_; \
    if (jn_ < (j1)) { KVRegs kv_; kv_load(kv_, (Kg) + (size_t)jn_ * 64 * (ld), (Vg) + (size_t)jn_ * 64 * (ld), (ld), F.tid); \
        __syncthreads(); kv_store(kv_, ring, F.tid); int cur_ = 0; \
        for (;;) { const int j_ = jn_; ++jn_; while (jn_ < (j1) && (SKIP(jn_))) ++jn_; const bool more_ = jn_ < (j1); \
            if (more_) kv_load(kv_, (Kg) + (size_t)jn_ * 64 * (ld), (Vg) + (size_t)jn_ * 64 * (ld), (ld), F.tid); \
            __syncthreads(); \
            { int kmin_, kmax_; RANGE(j_, kmin_, kmax_); \
              if (__any(kmax_ >= kmin_)) attn_tile(ring + cur_ * KV_BUF, ring + cur_ * KV_BUF + KT_BYTES, qr, st, kmin_, kmax_, F.lane); } \
            if (!more_) break; \
            kv_store(kv_, ring + (cur_ ^ 1) * KV_BUF, F.tid); cur_ ^= 1; } } } while (0)

__device__ __forceinline__ void nsa_unit(const Frame& F, const bf16* P, const bf16* KC, const bf16* VC, bf16* O  , int b, int g, int i) {
    LAS unsigned char* ring = F.lds;
    LAS float* impb = (LAS float*)(F.lds + 2 * KV_BUF);
    LAS unsigned* selm = (LAS unsigned*)(F.lds + 2 * KV_BUF + 33792);
    LAS float* stash = (LAS float*)(F.lds + 2 * KV_BUF + 33792 + 256) + F.tid;
    const int lane = F.lane, r32 = lane & 31, hi = lane >> 5, hr = F.wave & 3, th = F.wave >> 2;
    const int tl = 32 * th + r32;
    const int s = 64 * i + tl;
    const size_t row = (size_t)b * SEQ + s;
    const int head = g * 4 + hr;
    bf16x8 qr[4];
#pragma unroll
    for (int d = 0; d < 4; ++d) qr[d] = *(const bf16x8*)(P + row * NP1 + C_CQ + head * 64 + d * 16 + hi * 8);
    const float g0 = sigmoidf_(bf2f(P[row * NP1 + C_CG + head])), g1 = sigmoidf_(bf2f(P[row * NP1 + C_CG + 8 + head])), g2 = sigmoidf_(bf2f(P[row * NP1 + C_CG + 16 + head]));
    AttnState st;
    {
        const bf16* Kg = KC + (size_t)(b * 2 + g) * 128 * 64; const bf16* Vg = VC + (size_t)(b * 2 + g) * 128 * 64;
        const int nmax = (s >= 31) ? ((s - 31) >> 4) : -1;
        KVRegs kv0, kv1; kv_load(kv0, Kg, Vg, 64, F.tid); kv_load(kv1, Kg + 64 * 64, Vg + 64 * 64, 64, F.tid);
        __syncthreads();
        kv_store(kv0, ring, F.tid); kv_store(kv1, ring + KV_BUF, F.tid);
        __syncthreads();
        f32x16 a0, a1, c0, c1, out0, out1;
        attn_scores(ring, qr, a0, a1, lane); attn_scores(ring + KV_BUF, qr, c0, c1, lane);
        float mx = -1e30f;
#pragma unroll
        for (int r = 0; r < 16; ++r) { const int k0 = crow(r, hi);
            a0[r] = (k0 <= nmax) ? a0[r] : -1e30f; a1[r] = (32 + k0 <= nmax) ? a1[r] : -1e30f; c0[r] = (64 + k0 <= nmax) ? c0[r] : -1e30f; c1[r] = (96 + k0 <= nmax) ? c1[r] : -1e30f;
            mx = fmaxf(fmaxf(mx, fmaxf(a0[r], a1[r])), fmaxf(c0[r], c1[r])); }
        mx = max32(mx);
        float rs = 0.f;
#pragma unroll
        for (int r = 0; r < 16; ++r) { a0[r] = a0[r] > -1e29f ? __builtin_amdgcn_exp2f(a0[r] - mx) : 0.f; a1[r] = a1[r] > -1e29f ? __builtin_amdgcn_exp2f(a1[r] - mx) : 0.f;
            c0[r] = c0[r] > -1e29f ? __builtin_amdgcn_exp2f(c0[r] - mx) : 0.f; c1[r] = c1[r] > -1e29f ? __builtin_amdgcn_exp2f(c1[r] - mx) : 0.f; rs += (a0[r] + a1[r]) + (c0[r] + c1[r]); }
        rs = add32(rs);
        const float inv = 1.0f / fmaxf(rs, 1e-30f);
#pragma unroll
        for (int r = 0; r < 16; ++r) { out0[r] = 0.f; out1[r] = 0.f; }
        attn_pv(ring + KT_BYTES, a0, a1, out0, out1, lane); attn_pv(ring + KV_BUF + KT_BYTES, c0, c1, out0, out1, lane);
        const float sc = g0 * inv;
#pragma unroll
        for (int r = 0; r < 16; ++r) { stash[r * 512] = out0[r] * sc; stash[(16 + r) * 512] = out1[r] * sc; }
        if (i >= 16) {
            float xprev = 0.f;
#define NSA_IMP(U, ACC, GQ) do { const float G_ = ((ACC[4 * (GQ)] + ACC[4 * (GQ) + 1]) + (ACC[4 * (GQ) + 2] + ACC[4 * (GQ) + 3])) * inv, L_ = ACC[4 * (GQ) + 3] * inv; \
                const float x_ = other32(L_, hi); impb[(hr * 64 + tl) * 33 + 2 * (U) + hi] = G_ + (hi ? x_ : xprev); xprev = x_; } while (0)
            NSA_IMP(0, a0, 0); NSA_IMP(1, a0, 1); NSA_IMP(2, a0, 2); NSA_IMP(3, a0, 3); NSA_IMP(4, a1, 0); NSA_IMP(5, a1, 1); NSA_IMP(6, a1, 2); NSA_IMP(7, a1, 3);
            NSA_IMP(8, c0, 0); NSA_IMP(9, c0, 1); NSA_IMP(10, c0, 2); NSA_IMP(11, c0, 3); NSA_IMP(12, c1, 0); NSA_IMP(13, c1, 1); NSA_IMP(14, c1, 2); NSA_IMP(15, c1, 3);
#undef NSA_IMP
        }
    }
    __syncthreads();
    unsigned mymask;
    if (i < 16) mymask = (2u << i) - 1u;
    else {
        { const int tk = F.tid >> 3, js = F.tid & 7; unsigned bits = 0u;
          float v[4];
#pragma unroll
          for (int e = 0; e < 4; ++e) { const int j = js * 4 + e; v[e] = (impb[(0 * 64 + tk) * 33 + j] + impb[(1 * 64 + tk) * 33 + j]) + (impb[(2 * 64 + tk) * 33 + j] + impb[(3 * 64 + tk) * 33 + j]); }
          int rank[4] = {0, 0, 0, 0};
          for (int jj = 1; jj <= i - 2; ++jj) { const float o = (impb[(0 * 64 + tk) * 33 + jj] + impb[(1 * 64 + tk) * 33 + jj]) + (impb[(2 * 64 + tk) * 33 + jj] + impb[(3 * 64 + tk) * 33 + jj]);
#pragma unroll
              for (int e = 0; e < 4; ++e) { const int j = js * 4 + e; rank[e] += (o > v[e] || (o == v[e] && jj < j)) ? 1 : 0; } }
#pragma unroll
          for (int e = 0; e < 4; ++e) { const int j = js * 4 + e; const bool forced = (j == 0) || (j == i) || (j == i - 1); const bool cand = (j >= 1) && (j <= i - 2);
              if (forced || (cand && rank[e] < 13)) bits |= 1u << j; }
          bits |= shxu(bits, 1, F.lane); bits |= shxu(bits, 2, F.lane); bits |= shxu(bits, 4, F.lane);
          if (js == 0) selm[tk] = bits; }
        __syncthreads();
        mymask = selm[tl];
    }
    {
        attn_reset(st);
        const bf16* Kg = P + (size_t)b * SEQ * NP1 + C_KS + g * 64; const bf16* Vg = P + (size_t)b * SEQ * NP1 + C_VS + g * 64;
#define NSA_SKIP(j) (false)
#define NSA_RANGE(j, kmin, kmax) do { kmin = 0; kmax = ((mymask >> (j)) & 1u) ? ((j) == i ? tl : 63) : -1; } while (0)
        ATTN_STREAM(Kg, Vg, (size_t)NP1, 0, i + 1, NSA_SKIP, NSA_RANGE);
#undef NSA_RANGE
        const float sc = g1 * attn_inv_l(st);
#pragma unroll
        for (int r = 0; r < 16; ++r) { stash[r * 512] += st.o0[r] * sc; stash[(16 + r) * 512] += st.o1[r] * sc; }
    }
    {
        attn_reset(st);
        const bf16* Kg = P + (size_t)b * SEQ * NP1 + C_KW + g * 64; const bf16* Vg = P + (size_t)b * SEQ * NP1 + C_VW + g * 64;
        const int jlo = i >= 8 ? i - 8 : 0; f32x16 out0, out1;
#define NSA_RANGE(j, kmin, kmax) do { const int d_ = 64 * (i - (j)) + tl; kmin = d_ - 511 > 0 ? d_ - 511 : 0; kmax = d_ < 63 ? d_ : 63; } while (0)
        ATTN_STREAM(Kg, Vg, (size_t)NP1, jlo, i + 1, NSA_SKIP, NSA_RANGE);
#undef NSA_RANGE
#undef NSA_SKIP
        const float sc = g2 * attn_inv_l(st);
#pragma unroll
        for (int r = 0; r < 16; ++r) { out0[r] = stash[r * 512] + st.o0[r] * sc; out1[r] = stash[(16 + r) * 512] + st.o1[r] * sc; }
        bf16* orow = O + row * 512 + head * 64;
#pragma unroll
        for (int gq = 0; gq < 4; ++gq) {
            v2u w0; w0.x = pk2(out0[4 * gq], out0[4 * gq + 1]); w0.y = pk2(out0[4 * gq + 2], out0[4 * gq + 3]); *(v2u*)(orow + 8 * gq + 4 * hi) = w0;
            v2u w1; w1.x = pk2(out1[4 * gq], out1[4 * gq + 1]); w1.y = pk2(out1[4 * gq + 2], out1[4 * gq + 3]); *(v2u*)(orow + 32 + 8 * gq + 4 * hi) = w1; }
    }
}
__device__ __forceinline__ void phase_nsa(const Frame& F, const bf16* P, const bf16* KC, const bf16* VC, bf16* O) {
    for (int un2 = 2 * F.bid; un2 < 512; un2 += 2 * F.G)
#pragma unroll 1
        for (int k = 0; k < 2; ++k) { const int un = un2 >> 1, ip = un & 15, g = (un >> 4) & 1, b = un >> 5; nsa_unit(F, P, KC, VC, O, b, g, k == 0 ? 31 - ip : ip); }
}

__device__ __forceinline__ void moba_unit(const Frame& F, const bf16* P, const float* KM, bf16* O  , int b, int h, int qb) {
    LAS unsigned char* ring = F.lds;
    LAS float* kml = (LAS float*)(F.lds + 2 * KV_BUF);
    LAS unsigned* uni = (LAS unsigned*)(F.lds + 2 * KV_BUF + 2048);
    const int lane = F.lane, r32 = lane & 31, hi = lane >> 5;
    const int tl = 32 * F.wave + r32;
    const size_t row = (size_t)b * SEQ + 256 * qb + tl;
    bf16x8 qr[4];
#pragma unroll
    for (int d = 0; d < 4; ++d) qr[d] = *(const bf16x8*)(P + row * NP1 + C_DQ + h * 64 + d * 16 + hi * 8);
    __syncthreads();
    { const int blk = F.tid >> 6, p = F.tid & 63; kml[F.tid] = KM[((size_t)(b * 8 + blk) * 8 + h) * 64 + p]; if (F.tid == 0) uni[0] = 0u; }
    __syncthreads();
    unsigned mymask = 0u;
    if (qb > 0) {
        float gt[8];
#pragma unroll
        for (int n = 0; n < 8; ++n) { float a = 0.f;
#pragma unroll
            for (int d = 0; d < 4; ++d) { const v4u qw = __builtin_bit_cast(v4u, qr[d]); const LAS float* km = kml + n * 64 + d * 16 + hi * 8;
                a += bflo(qw.x) * km[0] + bfhi(qw.x) * km[1] + bflo(qw.y) * km[2] + bfhi(qw.y) * km[3] + bflo(qw.z) * km[4] + bfhi(qw.z) * km[5] + bflo(qw.w) * km[6] + bfhi(qw.w) * km[7]; }
            a = add32(a); gt[n] = a; }
#pragma unroll
        for (int n = 0; n < 8; ++n) { int rank = 0;
#pragma unroll
            for (int m = 0; m < 8; ++m) rank += (m < qb && m != n && (gt[m] > gt[n] || (gt[m] == gt[n] && m < n))) ? 1 : 0;
            if (n < qb && rank < 3) mymask |= 1u << n; }
        atomicOr((unsigned*)uni, mymask);
    }
    __syncthreads();
    const unsigned um = uni[0];
    AttnState st; attn_reset(st);
    const bf16* Kg = P + (size_t)b * SEQ * NP1 + C_DK + h * 64; const bf16* Vg = P + (size_t)b * SEQ * NP1 + C_DV + h * 64;
#define MOBA_SKIP(j) ((j) < 4 * qb && !((um >> ((j) >> 2)) & 1u))
#define MOBA_RANGE(j, kmin, kmax) do { kmin = 0; if ((j) < 4 * qb) kmax = ((mymask >> ((j) >> 2)) & 1u) ? 63 : -1; else { const int d_ = tl - 64 * ((j) - 4 * qb); kmax = d_ < 63 ? d_ : 63; } } while (0)
    ATTN_STREAM(Kg, Vg, (size_t)NP1, 0, 4 * qb + 4, MOBA_SKIP, MOBA_RANGE);
#undef MOBA_SKIP
#undef MOBA_RANGE
    const float sc = attn_inv_l(st);
    bf16* orow = O + row * 512 + h * 64;
#pragma unroll
    for (int gq = 0; gq < 4; ++gq) {
        v2u w0; w0.x = pk2(st.o0[4 * gq] * sc, st.o0[4 * gq + 1] * sc); w0.y = pk2(st.o0[4 * gq + 2] * sc, st.o0[4 * gq + 3] * sc); *(v2u*)(orow + 8 * gq + 4 * hi) = w0;
        v2u w1; w1.x = pk2(st.o1[4 * gq] * sc, st.o1[4 * gq + 1] * sc); w1.y = pk2(st.o1[4 * gq + 2] * sc, st.o1[4 * gq + 3] * sc); *(v2u*)(orow + 32 + 8 * gq + 4 * hi) = w1; }
}
__device__ __forceinline__ void phase_moba(const Frame& F, const bf16* P, const float* KM, bf16* O) {
    for (int un2 = 2 * F.bid; un2 < 512; un2 += 2 * F.G)
#pragma unroll 1
        for (int k = 0; k < 2; ++k) { const int un = un2 >> 1, qp = un & 3, h = (un >> 2) & 7, b = un >> 5; moba_unit(F, P, KM, O, b, h, k == 0 ? 7 - qp : qp); }
}

__device__ __forceinline__ unsigned ord_key(float x) { const unsigned u = __builtin_bit_cast(unsigned, x); return (u & 0x80000000u) ? ~u : (u | 0x80000000u); }
__device__ __forceinline__ float ord_val(unsigned k) { const unsigned u = (k & 0x80000000u) ? (k & 0x7fffffffu) : ~k; return __builtin_bit_cast(float, u); }
constexpr int SK_STRIDE = 272;
__device__ __forceinline__ void peer_route_unit(const Frame& F, const bf16* Q2, const bf16* SUBK  , int* EIDX, float* EW, int tb, int h) {
    LAS unsigned char* skl = F.lds;
    const int lane = F.lane, r32 = lane & 31, hi = lane >> 5;
    __syncthreads();
    for (int i = F.tid; i < 2 * 128 * 16; i += NTHR) { const int ch = i & 15, rowi = i >> 4;
        *(LAS v4u*)(skl + rowi * SK_STRIDE + ch * 16) = *(const v4u*)(SUBK + ((size_t)h * 256 + rowi) * 128 + ch * 8); }
    __syncthreads();
    const size_t tok = (size_t)tb * 256 + F.wave * 32 + r32;
    unsigned topk[2][16];
#pragma unroll
    for (int p = 0; p < 2; ++p) {
        bf16x8 qf[8]; float ss = 0.f;
#pragma unroll
        for (int s = 0; s < 8; ++s) { qf[s] = *(const bf16x8*)(Q2 + tok * 2048 + h * 256 + p * 128 + s * 16 + hi * 8); const v4u w = __builtin_bit_cast(v4u, qf[s]);
            const float a0 = bflo(w.x), a1 = bfhi(w.x), a2 = bflo(w.y), a3 = bfhi(w.y), a4 = bflo(w.z), a5 = bfhi(w.z), a6 = bflo(w.w), a7 = bfhi(w.w);
            ss += (a0 * a0 + a1 * a1) + (a2 * a2 + a3 * a3) + (a4 * a4 + a5 * a5) + (a6 * a6 + a7 * a7); }
        ss = add32(ss);
        const float rn = 1.0f / sqrtf(ss * (1.0f / 128.0f) + NORM_EPS);
        unsigned key[64];
#pragma unroll
        for (int nb = 0; nb < 4; ++nb) { f32x16 acc;
#pragma unroll
            for (int r = 0; r < 16; ++r) acc[r] = 0.f;
#pragma unroll
            for (int s = 0; s < 8; ++s) { const bf16x8 a = *(LAS const bf16x8*)(skl + (p * 128 + nb * 32 + r32) * SK_STRIDE + (2 * s + hi) * 16);
                acc = __builtin_amdgcn_mfma_f32_32x32x16_bf16(a, qf[s], acc, 0, 0, 0); }
#pragma unroll
            for (int r = 0; r < 16; ++r) { const int n = nb * 32 + crow(r, hi); key[nb * 16 + r] = (ord_key(acc[r] * rn) & 0xffffff80u) | (unsigned)(127 - n); } }
#pragma unroll
        for (int k = 0; k < 16; ++k) { unsigned m = key[0];
#pragma unroll
            for (int e = 1; e < 64; ++e) m = m > key[e] ? m : key[e];
            m = umax32(m);
            topk[p][k] = m;
#pragma unroll
            for (int e = 0; e < 64; ++e) key[e] = key[e] == m ? 0u : key[e]; }
    }
    float v1[16], v2[16];
#pragma unroll
    for (int k = 0; k < 16; ++k) { v1[k] = ord_val(topk[0][k] & 0xffffff80u); v2[k] = ord_val(topk[1][k] & 0xffffff80u); }
    unsigned ck[50]; { int c = 0;
#pragma unroll
        for (int a = 0; a < 16; ++a)
#pragma unroll
            for (int bq = 0; bq < 16; ++bq) if ((a + 1) * (bq + 1) <= 16) { ck[c] = (ord_key(v1[a] + v2[bq]) & 0xffffff00u) | (unsigned)(255 - (16 * a + bq)); ++c; } }
    float tv[16]; int te[16];
#pragma unroll
    for (int k = 0; k < 16; ++k) { unsigned m = ck[0];
#pragma unroll
        for (int e = 1; e < 50; ++e) m = m > ck[e] ? m : ck[e];
#pragma unroll
        for (int e = 0; e < 50; ++e) ck[e] = ck[e] == m ? 0u : ck[e];
        const int ci = 255 - (int)(m & 255u), a = ci >> 4, bq = ci & 15;
        unsigned ka = topk[0][0], kb = topk[1][0];
#pragma unroll
        for (int e = 1; e < 16; ++e) { ka = a == e ? topk[0][e] : ka; kb = bq == e ? topk[1][e] : kb; }
        te[k] = (127 - (int)(ka & 127u)) * 128 + (127 - (int)(kb & 127u));
        tv[k] = ord_val(m & 0xffffff00u); }
    { float den = 0.f; const float mx = tv[0];
#pragma unroll
      for (int k = 0; k < 16; ++k) { tv[k] = __expf(tv[k] - mx); den += tv[k]; }
      const float inv = 1.0f / den;
#pragma unroll
      for (int k = 0; k < 16; ++k) tv[k] *= inv; }
    if (hi == 0) {
#pragma unroll
        for (int k = 0; k < 16; ++k) { EIDX[(tok * 8 + h) * 16 + k] = te[k]; EW[(tok * 8 + h) * 16 + k] = tv[k]; }
    }
}

__device__ __forceinline__ void phase_peer_route(const Frame& F, const bf16* Q2, const bf16* SUBK, int* EIDX, float* EW) {
    for (int un = F.bid; un < 64 * 8; un += F.G) peer_route_unit(F, Q2, SUBK, EIDX, EW, un >> 3, un & 7);
}

__device__ __forceinline__ void phase_peer_tables(const Frame& F, const float* U, const float* V, unsigned char* UT8, unsigned char* VT8, float* SU, float* SV) {
    const int gw = gwave(F), NGW = ngwave(F), lane = F.lane;
    for (int r = gw; r < 2 * 16384; r += NGW) {
        const int tab = r >> 14, e = r & 16383; const float* src = (tab ? V : U) + (size_t)e * DM + 16 * lane;
        f32x4 x[4]; float mx = 0.f;
#pragma unroll
        for (int q = 0; q < 4; ++q) { x[q] = *(const f32x4*)(src + 4 * q); mx = fmaxf(fmaxf(mx, fmaxf(fabsf(x[q][0]), fabsf(x[q][1]))), fmaxf(fabsf(x[q][2]), fabsf(x[q][3]))); }
#pragma unroll
        for (int o = 1; o < 32; o <<= 1) mx = fmaxf(mx, shx(mx, o, lane));
        mx = max32(mx);
        int ex = 0; (void)frexpf(mx, &ex);
        const int k = (mx > 0.f) ? (8 - ex) : 0;
        const float sc = __builtin_ldexpf(1.0f, k), inv = __builtin_ldexpf(1.0f, -k);
        v4u w;
#pragma unroll
        for (int q = 0; q < 4; ++q) { unsigned p = 0u; p = __builtin_amdgcn_cvt_pk_fp8_f32(x[q][0] * sc, x[q][1] * sc, p, false); p = __builtin_amdgcn_cvt_pk_fp8_f32(x[q][2] * sc, x[q][3] * sc, p, true); w[q] = p; }
        *(v4u*)((tab ? VT8 : UT8) + (size_t)e * DM + 16 * lane) = w;
        if (lane == 0) (tab ? SV : SU)[e] = inv;
    }
}
__device__ __forceinline__ void phase_peer_gather(const Frame& F, const bf16* H2, const unsigned char* UT8, const unsigned char* VT8, const float* SU, const float* SV,
                                                  const int* EIDX, const float* EW, float* XB, const float* gate  ) {
    const int gw = gwave(F), NGW = ngwave(F), lane = F.lane, b0 = lane & 1, b1 = (lane >> 1) & 1, b2 = (lane >> 2) & 1;
    for (int tok = gw; tok < TOK; tok += NGW) {
        f32x2 h[8];
        { const v4u ha = *(const v4u*)(H2 + (size_t)tok * DM + 16 * lane), hb = *(const v4u*)(H2 + (size_t)tok * DM + 16 * lane + 8);
          h[0] = (f32x2){bflo(ha.x), bfhi(ha.x)}; h[1] = (f32x2){bflo(ha.y), bfhi(ha.y)}; h[2] = (f32x2){bflo(ha.z), bfhi(ha.z)}; h[3] = (f32x2){bflo(ha.w), bfhi(ha.w)};
          h[4] = (f32x2){bflo(hb.x), bfhi(hb.x)}; h[5] = (f32x2){bflo(hb.y), bfhi(hb.y)}; h[6] = (f32x2){bflo(hb.z), bfhi(hb.z)}; h[7] = (f32x2){bflo(hb.w), bfhi(hb.w)}; }
        f32x2 o[8];
#pragma unroll
        for (int e = 0; e < 8; ++e) o[e] = (f32x2){0.f, 0.f};
        const int* ei = EIDX + (size_t)tok * 128; const float* ew = EW + (size_t)tok * 128;
        for (int c = 0; c < 16; ++c) {
            v4u ua[8], va[8]; float a[8]; float wsc[8];
#pragma unroll
            for (int j = 0; j < 8; ++j) { const int e = __builtin_amdgcn_readfirstlane(ei[c * 8 + j]);
                ua[j] = *(const v4u*)(UT8 + (size_t)e * DM + 16 * lane); va[j] = *(const v4u*)(VT8 + (size_t)e * DM + 16 * lane);
                wsc[j] = ew[c * 8 + j] * SV[e]; a[j] = SU[e]; }
#pragma unroll
            for (int j = 0; j < 8; ++j) { f32x2 acc = (f32x2){0.f, 0.f};
#pragma unroll
                for (int q = 0; q < 4; ++q) { acc = __builtin_elementwise_fma(__builtin_amdgcn_cvt_pk_f32_fp8(ua[j][q], false), h[2 * q], acc); acc = __builtin_elementwise_fma(__builtin_amdgcn_cvt_pk_f32_fp8(ua[j][q], true), h[2 * q + 1], acc); }
                a[j] *= (acc.x + acc.y); }
            float b[4], cc[2], d;
#pragma unroll
            for (int p = 0; p < 4; ++p) { const float keep = b0 ? a[2 * p + 1] : a[2 * p], send = b0 ? a[2 * p] : a[2 * p + 1]; b[p] = keep + shx(send, 1, lane); }
#pragma unroll
            for (int q = 0; q < 2; ++q) { const float keep = b1 ? b[2 * q + 1] : b[2 * q], send = b1 ? b[2 * q] : b[2 * q + 1]; cc[q] = keep + shx(send, 2, lane); }
            { const float keep = b2 ? cc[1] : cc[0], send = b2 ? cc[0] : cc[1]; d = keep + shx(send, 4, lane); }
            d += shx(d, 8, lane); d += shx(d, 16, lane); d = add32(d);
            float wj = wsc[0];
#pragma unroll
            for (int j = 1; j < 8; ++j) wj = ((lane & 7) == j) ? wsc[j] : wj;
            const float coef = wj * gelu_erf(d);
#pragma unroll
            for (int j = 0; j < 8; ++j) { const float w = __builtin_bit_cast(float, __builtin_amdgcn_readlane(__builtin_bit_cast(int, coef), j)); const f32x2 w2 = (f32x2){w, w};
#pragma unroll
                for (int q = 0; q < 4; ++q) { o[2 * q] = __builtin_elementwise_fma(__builtin_amdgcn_cvt_pk_f32_fp8(va[j][q], false), w2, o[2 * q]); o[2 * q + 1] = __builtin_elementwise_fma(__builtin_amdgcn_cvt_pk_f32_fp8(va[j][q], true), w2, o[2 * q + 1]); } }
        }
        const int bb = tok / SEQ; float* xr = XB + (size_t)tok * DM + 16 * lane; const float* gr = gate + (size_t)bb * 6144 + 16 * lane;
#pragma unroll
        for (int q = 0; q < 4; ++q) { const f32x4 x = *(const f32x4*)(xr + 4 * q), gg = *(const f32x4*)(gr + 4 * q);
            *(f32x4*)(xr + 4 * q) = x + gg * (f32x4){o[2 * q].x, o[2 * q].y, o[2 * q + 1].x, o[2 * q + 1].y}; }
    }
}

constexpr int NPL = 12, NPHASE = 1 + DEPTH * NPL + 1;
constexpr int CW_BAR = 1024;
static_assert((CW_BAR + XCD_BAR_WORDS) * 4 <= (int)CTL_ZERO_BYTES, "barrier words inside the memset region");

__global__ void __launch_bounds__(NTHR, 2) hybrid_fwd(Args args) {
    extern __shared__ __attribute__((aligned(16))) unsigned char lds[];
    Frame F;
    F.lds = (LAS unsigned char*)lds; F.ldsg = lds;
    F.tid = threadIdx.x; F.lane = F.tid & 63; F.wave = __builtin_amdgcn_readfirstlane(F.tid >> 6);
    F.G = gridDim.x; F.bid = blockIdx.x; F.ws = args.ws;
    unsigned char* ws = args.ws;
    volatile LAS unsigned* MISC = (volatile LAS unsigned*)(F.lds + MISC_OFF);
    for (int u = F.tid; u < 64; u += NTHR) ((LAS unsigned*)(F.lds + MISC_OFF))[u] = 0u;
    __syncthreads();
    XcdBarrier bar; bar.bar = (unsigned*)(ws + WS_CTL) + CW_BAR; bar.x = 0; bar.st = nullptr;
    const int lo = args.ph_lo, hi = args.ph_hi;
    if (hi - lo > 1) bar = xcd_barrier_post((unsigned*)(ws + WS_CTL) + CW_BAR, MISC + 8);
#ifndef PHMASK
#define PHMASK 0xffffffffu
#endif
#define PM(j) ((PHMASK >> (j)) & 1u)
#ifndef RPMASK
#define RPMASK 0u
#endif
#define RP(j) for (int rp_ = 0; rp_ < 1 + (int)((RPMASK >> (j)) & 1u); ++rp_)
#define LASTRP(j) (rp_ == (int)((RPMASK >> (j)) & 1u))
#define IN(k) (lo <= (k) && (k) < hi)
#define SEAM(k) do { if (IN(k) && IN((k) + 1)) xcd_barrier(bar); } while (0)

    typedef __attribute__((address_space(4))) const Args* KArgs;
    KArgs ap = (KArgs)__builtin_amdgcn_kernarg_segment_ptr();
#define FRESH() asm volatile("" : "+s"(ap), "+s"(ws)); Frame Fp = F; asm volatile("" : "+v"(Fp.tid)); Fp.lane = Fp.tid & 63; asm volatile("" : "+s"(Fp.wave), "+s"(Fp.bid), "+s"(Fp.G)); Fp.ws = ws; LAS unsigned char* ring = Fp.lds; asm volatile("" : "+s"(ring)); Fp.lds = ring
#define INP(i) ((const float*)ap->in[i])
#define WIN_ ((bf16*)(ws + WS_WIN))
#define WOUT_ ((bf16*)(ws + WS_WOUT))
#define WOT_ ((bf16*)(ws + WS_WO))
#define WQT_ ((bf16*)(ws + WS_WQ))
#define W1T_ ((bf16*)(ws + WS_W1T))
#define SUBK_ ((bf16*)(ws + WS_SUBK))
#define W2T_ ((bf16*)(ws + WS_SMALL + SM_W2T))
#define MOD_ ((float*)(ws + WS_MOD))
#define COS_ ((const float*)(ws + WS_COS))
#define SIN_ ((const float*)(ws + WS_SIN))
#define KMEAN_ ((float*)(ws + WS_SMALL + SM_KMEAN))
#define KCMP_ ((bf16*)(ws + WS_SMALL + SM_KCMP))
#define VCMP_ ((bf16*)(ws + WS_SMALL + SM_VCMP))
#define PBP_ ((float*)(ws + WS_SMALL + SM_PBP))
#define EIDX_ ((int*)(ws + WS_EIDX))
#define EW_ ((float*)(ws + WS_EW))
#define HN_ ((bf16*)(ws + WS_HN))
#define MIX_ ((bf16*)(ws + WS_MIX))
#define PROJ_ ((bf16*)(ws + WS_BIG))
#define GATES_ ((bf16*)(ws + WS_BIG))
#define UT_ ((unsigned char*)(ws + WS_BIG))
#define VT_ ((unsigned char*)(ws + WS_BIG + 16 * MiB))
#define SU_ ((float*)(ws + WS_BIG + 32 * MiB))
#define SV_ ((float*)(ws + WS_BIG + 32 * MiB + 65536))
#define Q2_ ((bf16*)(ws + WS_BIG + 64 * MiB))
#define XB_ ((float*)ap->out)
#define MODL_ (MOD_ + (size_t)l * 8 * 6144)
#define XIN_ ((l == 0) ? INP(I_X) : (const float*)XB_)

    if (PM(0) && IN(0)) RP(0) { FRESH(); phase_prologue(Fp, ap); }
    SEAM(0);
#pragma unroll 1
    for (int l = 0; l < DEPTH; ++l) {
        const int p0 = 1 + l * NPL;
        if (PM(1) && IN(p0 + 0)) RP(1) { FRESH(); phase_norm_mod(Fp, XIN_, INP(I_NMG) + l * DM, MODL_ + 0, MODL_ + 1024, HN_); }
        SEAM(p0 + 0);
        if (PM(2) && IN(p0 + 1)) RP(2) { FRESH(); pg8::Gemm g{HN_, WIN_ + (size_t)l * NWIN * DM, TOK, NP1, DM}; pg8::StaticOrder S; S.init(TOK, NP1, Fp.G, Fp.bid);
            epi::EpiProj1 E{PROJ_, COS_, SIN_}; pg8::gemm_phase<epi::EpiProj1, pg8::StaticOrder, true, true>(ring, g, S, E, Fp.tid); }
        SEAM(p0 + 1);
        if (PM(3) && IN(p0 + 2)) RP(3) {
            { FRESH(); phase_compress(Fp, PROJ_, W1T_ + (size_t)l * 2 * 128 * 2048, W2T_ + (size_t)l * 2 * 64 * 128, PBP_ + (size_t)l * 2 * 16 * 128, KCMP_, VCMP_); }
            { FRESH(); phase_kmean(Fp, PROJ_, KMEAN_); }
            { FRESH(); phase_mixer_a(Fp, PROJ_, INP(I_ACW) + (size_t)l * 3 * 512, MIX_); }
            __syncthreads();
            { FRESH(); phase_mixer_b(Fp, PROJ_, INP(I_BCW) + (size_t)l * 31 * 512, INP(I_BCB) + l * 512, INP(I_BLNG) + l * 512, INP(I_BLNB) + l * 512, MIX_ + (size_t)TOK * 512); }
            __syncthreads();
        }
        SEAM(p0 + 2);
        if (PM(4) && IN(p0 + 3)) RP(4) { FRESH(); phase_nsa(Fp, PROJ_, KCMP_, VCMP_, MIX_ + (size_t)2 * TOK * 512); __syncthreads(); }
        SEAM(p0 + 3);
        if (PM(5) && IN(p0 + 4)) RP(5) { FRESH(); phase_moba(Fp, PROJ_, KMEAN_, MIX_ + (size_t)3 * TOK * 512); __syncthreads(); }
        SEAM(p0 + 4);
        if (PM(6) && IN(p0 + 5)) RP(6) { FRESH(); pg8::Gemm g{HN_, WIN_ + ((size_t)l * NWIN + NP1) * DM, TOK, NGT, DM}; pg8::StaticOrder S; S.init(TOK, NGT, Fp.G, Fp.bid);
            epi::EpiStore<1> E{GATES_, NGT}; pg8::gemm_phase<epi::EpiStore<1>, pg8::StaticOrder, true, true>(ring, g, S, E, Fp.tid); }
        SEAM(p0 + 5);
        if (PM(7) && IN(p0 + 6)) RP(7) {
#pragma unroll 1
            for (int seg = 0; seg < 4; ++seg) { FRESH(); pg8::Gemm g{MIX_ + (size_t)seg * TOK * 512, WOUT_ + (size_t)(l * 4 + seg) * DM * 512, TOK, DM, 512}; pg8::StaticOrder S; S.init(TOK, DM, Fp.G, Fp.bid);
                epi::EpiMerge E{HN_, GATES_, seg}; pg8::gemm_phase<epi::EpiMerge, pg8::StaticOrder, true, true>(ring, g, S, E, Fp.tid); }
        }
        SEAM(p0 + 6);
        if (PM(8) && IN(p0 + 7)) RP(8) { FRESH(); pg8::Gemm g{HN_, WOT_ + (size_t)l * DM * DM, TOK, DM, DM}; pg8::StaticOrder S; S.init(TOK, DM, Fp.G, Fp.bid);
            epi::EpiResid E{XIN_, LASTRP(8) ? XB_ : (float*)MIX_, MODL_ + 2048}; pg8::gemm_phase<epi::EpiResid, pg8::StaticOrder, true, true>(ring, g, S, E, Fp.tid); }
        SEAM(p0 + 7);
        if (PM(9) && IN(p0 + 8)) RP(9) {
            { FRESH(); phase_norm_mod(Fp, XB_, INP(I_NFG) + l * DM, MODL_ + 3072, MODL_ + 4096, HN_); }
            { FRESH(); phase_peer_tables(Fp, INP(I_PU) + (size_t)l * 16384 * DM, INP(I_PV) + (size_t)l * 16384 * DM, UT_, VT_, SU_, SV_); }
        }
        SEAM(p0 + 8);
        if (PM(10) && IN(p0 + 9)) RP(10) { FRESH(); pg8::Gemm g{HN_, WQT_ + (size_t)l * 2048 * DM, TOK, 2048, DM}; pg8::StaticOrder S; S.init(TOK, 2048, Fp.G, Fp.bid);
            epi::EpiStore<0> E{Q2_, 2048}; pg8::gemm_phase<epi::EpiStore<0>, pg8::StaticOrder, true, true>(ring, g, S, E, Fp.tid); }
        SEAM(p0 + 9);
        if (PM(11) && IN(p0 + 10)) RP(11) { FRESH(); phase_peer_route(Fp, Q2_, SUBK_ + (size_t)l * 8 * 2 * 128 * 128, EIDX_, EW_); __syncthreads(); }
        SEAM(p0 + 10);
        if (PM(12) && IN(p0 + 11)) RP(12) { FRESH(); phase_peer_gather(Fp, HN_, UT_, VT_, SU_, SV_, EIDX_, EW_, LASTRP(12) ? XB_ : (float*)MIX_, MODL_ + 5120); }
        SEAM(p0 + 11);
    }
    if (PM(13) && IN(NPHASE - 1)) { FRESH(); phase_final_norm(Fp, XB_, INP(I_FNG), XB_); }
#ifdef DBG_STOP
    if (IN(NPHASE)) { FRESH();
        const bf16* src = (const bf16*)(ws + (size_t)DBG_OFF); const size_t n = (size_t)DBG_BYTES / 2, NO = (size_t)TOK * DM; float* o = (float*)ap->out;
        for (size_t i = (size_t)Fp.bid * NTHR + Fp.tid; i < NO; i += (size_t)Fp.G * NTHR) { float a = 0.f; for (size_t j = i; j < n; j += NO) a += bf2f(src[j]);
#ifdef DBG_OFF2
            { const float* s2 = (const float*)(ws + (size_t)DBG_OFF2); const size_t n2 = (size_t)DBG_BYTES2 / 4; for (size_t j = i; j < n2; j += NO) a += s2[j]; }
#endif
            if (!(a == a) || fabsf(a) > 1e30f) a = 12345.0f;
            o[i] = a; } }
#endif
#undef IN
#undef SEAM
}

extern "C" void kernel_launch(void* const* d_in, const int* in_sizes, int n_in, void* d_out, int out_size, void* d_ws, size_t ws_size, hipStream_t stream) {
    static int grid = 0;
    if (grid == 0) {
        if (n_in != 26 || in_sizes[0] != TOK * DM || out_size != TOK * DM || ws_size < WS_END) {
            fprintf(stderr, "kernel_launch: unexpected problem (n_in %d, in0 %d, out %d, ws %zu); nothing launched\n", n_in, n_in > 0 ? in_sizes[0] : -1, out_size, ws_size); grid = -1; return; }
        int dev = 0, cus = 0, per_cu = 0;
        if (hipGetDevice(&dev) != hipSuccess || hipDeviceGetAttribute(&cus, hipDeviceAttributeMultiprocessorCount, dev) != hipSuccess) { grid = -1; return; }
        if (hipFuncSetAttribute((const void*)hybrid_fwd, hipFuncAttributeMaxDynamicSharedMemorySize, LDS_BYTES) != hipSuccess) { fprintf(stderr, "kernel_launch: hipFuncSetAttribute failed\n"); grid = -1; return; }
        if (hipOccupancyMaxActiveBlocksPerMultiprocessor(&per_cu, (const void*)hybrid_fwd, NTHR, LDS_BYTES) != hipSuccess || per_cu < 1)
            fprintf(stderr, "kernel_launch: note: occupancy query reports %d workgroups per CU\n", per_cu);
        (void)hipGetLastError();
        grid = cus;
    }
    if (grid < 0) return;
    if (hipMemsetAsync((char*)d_ws + WS_CTL, 0, CTL_ZERO_BYTES, stream) != hipSuccess) return;
    Args a{};
    for (int i = 0; i < 26; ++i) a.in[i] = d_in[i];
    a.out = (float*)d_out; a.ws = (unsigned char*)d_ws;
#if MK_PER_PHASE
#ifdef DBG_STOP
    for (int p = 0; p <= DBG_STOP; ++p) { a.ph_lo = p; a.ph_hi = p + 1; hipLaunchKernelGGL(hybrid_fwd, dim3(grid), dim3(NTHR), LDS_BYTES, stream, a); }
    a.ph_lo = NPHASE; a.ph_hi = NPHASE + 1; hipLaunchKernelGGL(hybrid_fwd, dim3(grid), dim3(NTHR), LDS_BYTES, stream, a);
#else
    for (int p = 0; p < NPHASE; ++p) { a.ph_lo = p; a.ph_hi = p + 1; hipLaunchKernelGGL(hybrid_fwd, dim3(grid), dim3(NTHR), LDS_BYTES, stream, a); }
#endif
#else
    a.ph_lo = 0; a.ph_hi = NPHASE; hipLaunchKernelGGL(hybrid_fwd, dim3(grid), dim3(NTHR), LDS_BYTES, stream, a);
#endif
    const hipError_t le = hipPeekAtLastError();
    if (le != hipSuccess) fprintf(stderr, "kernel_launch: launch failed: %s\n", hipGetErrorName(le));
}
```

```cpp
#include <hip/hip_runtime.h>
#include <hip/hip_bf16.h>
#include <cstdio>
#include <cstdint>
#include <cmath>

#ifndef MK_PER_PHASE
#define MK_PER_PHASE 0
#endif

#define DUMMY_EMASK 0x3fffu
#define RPMASK 0x0u
#define GAS __attribute__((address_space(1)))
#define LAS __attribute__((address_space(3)))
typedef unsigned short bf16;
typedef unsigned v4u __attribute__((ext_vector_type(4)));
typedef unsigned v2u __attribute__((ext_vector_type(2)));
typedef float f32x4 __attribute__((ext_vector_type(4)));
typedef float f32x2 __attribute__((ext_vector_type(2)));
typedef float f32x16 __attribute__((ext_vector_type(16)));
typedef short bf16x8 __attribute__((ext_vector_type(8)));
typedef short s16x4 __attribute__((ext_vector_type(4)));
typedef __bf16 bf16x2_t __attribute__((ext_vector_type(2)));

constexpr int BATCH = 8, SEQ = 2048, DM = 1024, DEPTH = 2, TOK = BATCH * SEQ;
constexpr int NP1 = 5632;
constexpr int NGT = 4096;
constexpr int NWIN = NP1 + NGT;
constexpr int C_AB = 0, C_AC = 512, C_AX = 1024, C_BA = 1536, C_BG = 2048, C_CQ = 2560, C_KC = 3072, C_VC = 3200, C_KS = 3328, C_VS = 3456, C_KW = 3584, C_VW = 3712,
              C_DQ = 3840, C_DK = 4352, C_DV = 4864, C_CG = 5376;
constexpr float NORM_EPS = 1e-6f;
constexpr float QSCALE = 0.125f * 1.4426950408889634f;

constexpr size_t MiB = 1u << 20;
constexpr size_t WS_CTL = 0, CTL_ZERO_BYTES = 64 * 1024;
constexpr size_t WS_MOD = 1 * MiB;
constexpr size_t WS_COS = 2 * MiB, WS_SIN = 4 * MiB;
constexpr size_t WS_SMALL = 6 * MiB;
constexpr size_t SM_KMEAN = 704 * 1024;
constexpr size_t SM_KCMP = 64 * 1024;
constexpr size_t SM_VCMP = 320 * 1024;
constexpr size_t SM_PBP = 576 * 1024;
constexpr size_t SM_W2T = 640 * 1024;
constexpr size_t WS_EIDX = 8 * MiB;
constexpr size_t WS_EW = 16 * MiB;
constexpr size_t WS_WIN = 24 * MiB;
constexpr size_t WS_WOUT = 62 * MiB;
constexpr size_t WS_WO = 70 * MiB;
constexpr size_t WS_WQ = 74 * MiB;
constexpr size_t WS_W1T = 82 * MiB;
constexpr size_t WS_SUBK = 84 * MiB;
constexpr size_t WS_HN = 86 * MiB;
constexpr size_t WS_MIX = 118 * MiB;
constexpr size_t WS_BIG = 182 * MiB;
constexpr size_t WS_END = 358 * MiB;

constexpr int LDS_BYTES = 147456;
constexpr int RING_BYTES = 131072;
constexpr int MISC_OFF = LDS_BYTES - 256;

#define RLX_AGENT __ATOMIC_RELAXED, __HIP_MEMORY_SCOPE_AGENT
#define LDS_WAIT() asm volatile("s_waitcnt lgkmcnt(0)" ::: "memory")
#define VM_WAIT() asm volatile("s_waitcnt vmcnt(0)" ::: "memory")
__device__ __forceinline__ unsigned f2bf(float f) { unsigned u = __builtin_bit_cast(unsigned, f); return (u + 0x7fffu + ((u >> 16) & 1u)) >> 16; }
__device__ __forceinline__ float bf2f(unsigned h) { return __builtin_bit_cast(float, h << 16); }
__device__ __forceinline__ unsigned pk2(float lo, float hi) { f32x2 v = {lo, hi}; bf16x2_t b = __builtin_convertvector(v, bf16x2_t); return __builtin_bit_cast(unsigned, b); }
__device__ __forceinline__ float bflo(unsigned w) { return __builtin_bit_cast(float, w << 16); }
__device__ __forceinline__ float bfhi(unsigned w) { return __builtin_bit_cast(float, w & 0xffff0000u); }
__device__ __forceinline__ float sigmoidf_(float x) { return 1.0f / (1.0f + __expf(-x)); }
__device__ __forceinline__ float gelu_erf(float x) { return 0.5f * x * (1.0f + erff(x * 0.70710678118654752f)); }
__device__ __forceinline__ float shx(float v, int m, int lane) { return __builtin_bit_cast(float, __builtin_amdgcn_ds_bpermute((lane ^ m) << 2, __builtin_bit_cast(int, v))); }
__device__ __forceinline__ unsigned shxu(unsigned v, int m, int lane) { return (unsigned)__builtin_amdgcn_ds_bpermute((lane ^ m) << 2, (int)v); }
__device__ __forceinline__ void swap32(unsigned v, unsigned& r0, unsigned& r1) { unsigned b = v; asm volatile("" : "+v"(b)); auto r = __builtin_amdgcn_permlane32_swap(v, b, false, false); r0 = r[0]; r1 = r[1]; }
__device__ __forceinline__ float other32(float v, int hi) { unsigned r0, r1; swap32(__builtin_bit_cast(unsigned, v), r0, r1); return __builtin_bit_cast(float, hi ? r0 : r1); }
__device__ __forceinline__ float add32(float v) { unsigned r0, r1; swap32(__builtin_bit_cast(unsigned, v), r0, r1); return __builtin_bit_cast(float, r0) + __builtin_bit_cast(float, r1); }
__device__ __forceinline__ float max32(float v) { unsigned r0, r1; swap32(__builtin_bit_cast(unsigned, v), r0, r1); return fmaxf(__builtin_bit_cast(float, r0), __builtin_bit_cast(float, r1)); }
__device__ __forceinline__ unsigned umax32(unsigned v) { unsigned r0, r1; swap32(v, r0, r1); return r0 > r1 ? r0 : r1; }
__device__ __forceinline__ float wave_sum(float v, int lane) {
#pragma unroll
    for (int o = 1; o < 32; o <<= 1) v += shx(v, o, lane);
    return add32(v);
}
namespace pg8 {
#define PG8_LAS __attribute__((address_space(3)))
typedef unsigned short bf16_t;
typedef short bf16x8 __attribute__((ext_vector_type(8)));
typedef float f32x4 __attribute__((ext_vector_type(4)));
typedef unsigned u32x4 __attribute__((ext_vector_type(4)));
constexpr int BM = 256, BK = 64, HALF = 128, HTB = HALF * BK * 2  , STAGE_BYTES = 8 * HTB, NXCD = 8, WGM = 8;

__host__ __device__ __forceinline__ int lds_byte(int r, int c) { const int st = (r >> 4) * 2 + (c >> 5), rr = r & 15, cc = c & 31, ob = rr * 64 + cc * 2; return st * 1024 + (ob ^ (((ob >> 9) & 1) << 5)); }
__host__ __device__ __forceinline__ void stage_rc(int b, int& R, int& C) { const int st = b / 1024, sb = b % 1024, swz = sb ^ (((sb >> 9) & 1) << 5); R = (st >> 1) * 16 + swz / 64; C = (st & 1) * 32 + (swz % 64) / 2; }
__host__ __device__ __forceinline__ int perm32(int rho) { const int n = rho >> 4, i = rho & 15; return 8 * (i >> 2) + 4 * n + (i & 3); }

struct Unit { int pm, pn; };
struct Gemm { const bf16_t* A; const bf16_t* Bt; int M, N, K; };

struct StaticOrder {
    int nM, nN, nwg, G, c;
    __host__ __device__ void init(int M, int N, int G_, int c_) { nM = M / BM; nN = N / BM; nwg = nM * nN; G = G_; c = c_; }
    __host__ __device__ bool next(int i, Unit& u) const {
        const long L = (long)i * G + c; if (L >= nwg) return false;
        int wgid = (int)L; { const int q = nwg / NXCD, r = nwg % NXCD, xcd = wgid % NXCD, off = wgid / NXCD; wgid = (xcd < r ? xcd * (q + 1) : r * (q + 1) + (xcd - r) * q) + off; }
        const int nig = WGM * nN, gid = wgid / nig, fm = gid * WGM, gsz = (nM - fm) < WGM ? (nM - fm) : WGM;
        u.pm = fm + ((wgid % nig) % gsz); u.pn = (wgid % nig) / gsz; return true;
    }
    __device__ __forceinline__ void a_ready(const Unit&) const {}
    __device__ __forceinline__ void done(const Unit&) const {}
};

__device__ __forceinline__ unsigned cvt_pk_bf16(float lo, float hi) { unsigned r; asm volatile("v_cvt_pk_bf16_f32 %0, %1, %2" : "=v"(r) : "v"(lo), "v"(hi)); return r; }
typedef float f32x2 __attribute__((ext_vector_type(2)));
template <class Epi, class Sched, bool ALIGN_EPI = false, bool SP2 = false>
__device__ __forceinline__ void gemm_phase(PG8_LAS unsigned char* lds, const Gemm g, const Sched& S, const Epi& E, const int tid) {
    const int wid = __builtin_amdgcn_readfirstlane(tid >> 6), lane = tid & 63, wr = wid >> 2, wc = wid & 3, fr = lane & 15, fq = lane >> 4;
    const int K = g.K, nt = K / BK;
    unsigned voffA[2], voffB[2];
#pragma unroll
    for (int i = 0; i < 2; ++i) { int R, C; stage_rc(tid * 16 + i * 8192, R, C); const int Rb = Epi::PERM ? ((R & ~31) + perm32(R & 31)) : R;
        voffA[i] = (unsigned)(R * K + C) * 2u; voffB[i] = (unsigned)(Rb * K + C) * 2u; }
    const size_t kstep = (size_t)(BK * 2);
    const size_t hstep = (size_t)HALF * K * 2;
    const size_t tstep = 2 * hstep;
    const unsigned ldsw = (unsigned)wid * 1024u;
    const int aoff = lds_byte(wr * 64 + fr, fq * 8), boff = lds_byte(wc * 32 + fr, fq * 8);
#define PG8_SA(b, h) (((b) * 2 + (h)) * HTB)
#define PG8_SB(b, h) ((4 + (b) * 2 + (h)) * HTB)
#define PG8_STAGE(bufoff, gbase, voff) do { _Pragma("unroll") for (int _i = 0; _i < 2; ++_i) \
        __builtin_amdgcn_global_load_lds((const unsigned*)((const char*)(gbase) + (voff)[_i]), (PG8_LAS unsigned*)(lds + (bufoff) + ldsw + _i * 8192), 16, 0, 0); } while (0)
#define PG8_LDA(dst, b, h) do { _Pragma("unroll") for (int m = 0; m < 4; ++m) _Pragma("unroll") for (int k = 0; k < 2; ++k) dst[m][k] = *(const PG8_LAS bf16x8*)(lds + PG8_SA(b, h) + aoff + m * 2048 + k * 1024); } while (0)
#define PG8_LDB(dst, b, h) do { _Pragma("unroll") for (int n = 0; n < 2; ++n) _Pragma("unroll") for (int k = 0; k < 2; ++k) dst[n][k] = *(const PG8_LAS bf16x8*)(lds + PG8_SB(b, h) + boff + n * 2048 + k * 1024); } while (0)
#define PG8_MMA(ai, bj, At, Bt) do { __builtin_amdgcn_s_setprio(1); _Pragma("unroll") for (int m = 0; m < 4; ++m) _Pragma("unroll") for (int n = 0; n < 2; ++n) _Pragma("unroll") for (int k = 0; k < 2; ++k) \
        acc[ai][bj][m][n] = __builtin_amdgcn_mfma_f32_16x16x32_bf16(Bt[n][k], At[m][k], acc[ai][bj][m][n], 0, 0, 0); __builtin_amdgcn_s_setprio(0); } while (0)
#define PG8_WAIT_V(n) asm volatile("s_waitcnt vmcnt(" #n ")" ::: "memory")
#define PG8_WAIT_L(n) asm volatile("s_waitcnt lgkmcnt(" #n ")" ::: "memory")
#define PG8_BAR __builtin_amdgcn_s_barrier()
#define PG8_SCHED __builtin_amdgcn_sched_barrier(0)
    Unit cur, nxt; int ui = 0;
    if (!S.next(0, cur)) return;
    f32x4 acc[2][2][4][2];
#pragma unroll
    for (int a = 0; a < 2; ++a)
#pragma unroll
        for (int b = 0; b < 2; ++b)
#pragma unroll
            for (int m = 0; m < 4; ++m)
#pragma unroll
                for (int n = 0; n < 2; ++n) acc[a][b][m][n] = (f32x4){0.f, 0.f, 0.f, 0.f};
    bf16x8 At[4][2], B0[2][2], B1[2][2];
    const char* cA = (const char*)g.A + (size_t)cur.pm * tstep; const char* cB = (const char*)g.Bt + (size_t)cur.pn * tstep;
    S.a_ready(cur);
    if constexpr (SP2) {
        PG8_STAGE(PG8_SB(0, 0), cB, voffB); PG8_STAGE(PG8_SB(0, 1), cB + hstep, voffB); PG8_STAGE(PG8_SA(0, 0), cA, voffA); PG8_STAGE(PG8_SA(0, 1), cA + hstep, voffA);
        if (wr == 1) PG8_BAR;
        PG8_WAIT_V(2); PG8_BAR;
        PG8_STAGE(PG8_SB(1, 0), cB + kstep, voffB); PG8_STAGE(PG8_SA(1, 0), cA + kstep, voffA); PG8_STAGE(PG8_SB(1, 1), cB + hstep + kstep, voffB);
        PG8_WAIT_V(6); PG8_BAR;
    } else {
        PG8_STAGE(PG8_SB(0, 0), cB, voffB); PG8_STAGE(PG8_SA(0, 0), cA, voffA); PG8_STAGE(PG8_SB(0, 1), cB + hstep, voffB); PG8_STAGE(PG8_SA(0, 1), cA + hstep, voffA);
        if (wr == 1) PG8_BAR;
        PG8_WAIT_V(4); PG8_BAR;
        PG8_STAGE(PG8_SB(1, 0), cB + kstep, voffB); PG8_STAGE(PG8_SA(1, 0), cA + kstep, voffA); PG8_STAGE(PG8_SB(1, 1), cB + hstep + kstep, voffB);
        PG8_WAIT_V(6); PG8_BAR;
    }
    for (;;) {
        const bool has_next = S.next(ui + 1, nxt);
        const char* nA = has_next ? (const char*)g.A + (size_t)nxt.pm * tstep : cA; const char* nB = has_next ? (const char*)g.Bt + (size_t)nxt.pn * tstep : cB;
        for (int t = 0; t < nt; t += 2) {
            const bool last = (t == nt - 2);
            const char* a1 = cA + (size_t)(t + 1) * kstep;
            const char* a2 = last ? nA : cA + (size_t)(t + 2) * kstep; const char* b2 = last ? nB : cB + (size_t)(t + 2) * kstep;
            const char* a3 = a2 + kstep; const char* b3 = b2 + kstep;
            if (last && has_next) S.a_ready(nxt);
            if constexpr (SP2) {
            PG8_LDB(B0, 0, 0); PG8_LDB(B1, 0, 1); PG8_SCHED; PG8_LDA(At, 0, 0); PG8_STAGE(PG8_SA(1, 1), a1 + hstep, voffA);
            PG8_WAIT_V(8); PG8_WAIT_L(0); PG8_BAR; PG8_MMA(0, 0, At, B0); PG8_MMA(0, 1, At, B1); PG8_BAR; PG8_SCHED;
            PG8_LDA(At, 0, 1); PG8_STAGE(PG8_SB(0, 0), b2, voffB); PG8_STAGE(PG8_SB(0, 1), b2 + hstep, voffB); PG8_STAGE(PG8_SA(0, 0), a2, voffA);
            PG8_WAIT_V(8); PG8_WAIT_L(0); PG8_BAR; PG8_MMA(1, 0, At, B0); PG8_MMA(1, 1, At, B1); PG8_BAR; PG8_SCHED;
            PG8_LDB(B0, 1, 0); PG8_LDB(B1, 1, 1); PG8_SCHED; PG8_LDA(At, 1, 0); PG8_STAGE(PG8_SA(0, 1), a2 + hstep, voffA);
            PG8_WAIT_V(8); PG8_WAIT_L(0); PG8_BAR; PG8_MMA(0, 0, At, B0); PG8_MMA(0, 1, At, B1); PG8_BAR; PG8_SCHED;
            PG8_LDA(At, 1, 1); PG8_STAGE(PG8_SB(1, 0), b3, voffB); PG8_STAGE(PG8_SB(1, 1), b3 + hstep, voffB); PG8_STAGE(PG8_SA(1, 0), a3, voffA);
            PG8_WAIT_V(8); PG8_WAIT_L(0); PG8_BAR; PG8_MMA(1, 0, At, B0); PG8_MMA(1, 1, At, B1); PG8_BAR; PG8_SCHED;
            } else {
            PG8_LDB(B0, 0, 0); PG8_SCHED; PG8_LDA(At, 0, 0); PG8_STAGE(PG8_SA(1, 1), a1 + hstep, voffA);
            PG8_WAIT_L(8); PG8_BAR; PG8_WAIT_L(0); PG8_MMA(0, 0, At, B0); PG8_BAR; PG8_SCHED;
            PG8_LDB(B1, 0, 1); PG8_STAGE(PG8_SB(0, 0), b2, voffB);
            PG8_BAR; PG8_WAIT_L(0); PG8_MMA(0, 1, At, B1); PG8_BAR;
            PG8_LDA(At, 0, 1); PG8_STAGE(PG8_SA(0, 0), a2, voffA);
            PG8_BAR; PG8_WAIT_L(0); PG8_MMA(1, 0, At, B0); PG8_BAR; PG8_SCHED;
            PG8_STAGE(PG8_SB(0, 1), b2 + hstep, voffB);
            PG8_WAIT_V(6); PG8_BAR; PG8_MMA(1, 1, At, B1); PG8_BAR;
            PG8_LDB(B0, 1, 0); PG8_SCHED; PG8_LDA(At, 1, 0); PG8_STAGE(PG8_SA(0, 1), a2 + hstep, voffA);
            PG8_WAIT_L(8); PG8_BAR; PG8_WAIT_L(0); PG8_MMA(0, 0, At, B0); PG8_BAR; PG8_SCHED;
            PG8_LDB(B1, 1, 1); PG8_STAGE(PG8_SB(1, 0), b3, voffB);
            PG8_BAR; PG8_WAIT_L(0); PG8_MMA(0, 1, At, B1); PG8_BAR;
            PG8_LDA(At, 1, 1); PG8_STAGE(PG8_SA(1, 0), a3, voffA);
            PG8_BAR; PG8_WAIT_L(0); PG8_MMA(1, 0, At, B0); PG8_BAR; PG8_SCHED;
            PG8_STAGE(PG8_SB(1, 1), b3 + hstep, voffB);
            PG8_WAIT_V(6); PG8_BAR; PG8_MMA(1, 1, At, B1); PG8_BAR;
            }
        }
        if constexpr (ALIGN_EPI) { if (wr == 0) PG8_BAR; }
        if constexpr (!Epi::AFTER_DRAIN) { E(acc, cur, wr, wc, fr, fq); S.done(cur); }
        if (!has_next) break;
#pragma unroll
        for (int a = 0; a < 2; ++a)
#pragma unroll
            for (int b = 0; b < 2; ++b)
#pragma unroll
                for (int m = 0; m < 4; ++m)
#pragma unroll
                    for (int n = 0; n < 2; ++n) acc[a][b][m][n] = (f32x4){0.f, 0.f, 0.f, 0.f};
        cur = nxt; cA = nA; cB = nB; ++ui;
        if constexpr (ALIGN_EPI) { if (wr == 1) PG8_BAR; }
    }
    PG8_WAIT_V(0);
    if constexpr (!ALIGN_EPI) { if (wr == 0) PG8_BAR; }
    PG8_BAR;
    if constexpr (Epi::AFTER_DRAIN) { E.fused(acc, cur, wr, wc, fr, fq, lds, wid, lane); S.done(cur); }
#undef PG8_SA
#undef PG8_SB
#undef PG8_STAGE
#undef PG8_LDA
#undef PG8_LDB
#undef PG8_MMA
#undef PG8_WAIT_V
#undef PG8_WAIT_L
#undef PG8_BAR
#undef PG8_SCHED
}
}
#define XB_TMO      128
#define XB_XCNT(j)  (256  + 64 * (j))
#define XB_XSUB(j)  (1280 + 64 * (j))
#define XB_XGEN(j)  (2304 + 64 * (j))
#define XB_TOP      3328
#define XB_TOPGEN   3392
#define XCD_BAR_WORDS 3456
#define XB_SPIN_CAP (1u << 25)

__device__ __forceinline__ unsigned xb_ld(unsigned* p)              { return __hip_atomic_load(p, __ATOMIC_RELAXED, __HIP_MEMORY_SCOPE_AGENT); }
__device__ __forceinline__ unsigned xb_add(unsigned* p, unsigned v) { return __hip_atomic_fetch_add(p, v, __ATOMIC_RELAXED, __HIP_MEMORY_SCOPE_AGENT); }
__device__ __forceinline__ unsigned xb_xcc_id() { return (unsigned)__builtin_amdgcn_s_getreg((3 << 11) | 20) & 0xFu; }
#define XB_SPIN(cond, bar) do { unsigned _sp = 0; while (cond) { __builtin_amdgcn_s_sleep(1); \
    if ((++_sp & 255u) == 0u) { if (xb_ld(&(bar)[XB_TMO])) break; if (_sp > XB_SPIN_CAP) { atomicAdd(&(bar)[XB_TMO], 1u); break; } } } } while (0)

struct XcdBarrier {
    unsigned* bar; unsigned x;
    volatile LAS unsigned* st;
};

__device__ __forceinline__ XcdBarrier xcd_barrier_post(unsigned* bar, volatile LAS unsigned* st) {
    XcdBarrier b; b.bar = bar; b.x = xb_xcc_id(); b.st = st;
    if (threadIdx.x == 0) (void)xb_add(&bar[XB_XCNT(b.x)], 1u);
    return b;
}
__device__ __forceinline__ void xcd_barrier_complete(unsigned* bar, unsigned x, unsigned& nloc, unsigned& nx) {
    const unsigned G = gridDim.x * gridDim.y * gridDim.z;
    unsigned sum, cnt, mine, sp = 0u;
    for (;;) {
        sum = 0u; cnt = 0u; mine = 0u;
#pragma unroll
        for (unsigned j = 0; j < 16; ++j) { const unsigned c = xb_ld(&bar[XB_XCNT(j)]); sum += c; cnt += (c > 0u) ? 1u : 0u; mine = (j == x) ? c : mine; }
        if (sum == G) break;
        __builtin_amdgcn_s_sleep(1);
        if ((++sp & 255u) == 0u) { if (xb_ld(&bar[XB_TMO])) break; if (sp > XB_SPIN_CAP) { atomicAdd(&bar[XB_TMO], 1u); break; } }
    }
    nloc = mine > 0u ? mine : 1u; nx = cnt > 0u ? cnt : 1u;
}

__device__ __forceinline__ void xcd_barrier(const XcdBarrier& b) {
    asm volatile("s_waitcnt vmcnt(0)" ::: "memory");
    __syncthreads();
    if (threadIdx.x == 0) {
        unsigned* bar = b.bar;
        __builtin_amdgcn_s_waitcnt(0);
        unsigned nloc = b.st[0], nx = b.st[1];
        if (nloc == 0u) { xcd_barrier_complete(bar, b.x, nloc, nx); b.st[0] = nloc; b.st[1] = nx; }
        const unsigned old = xb_add(&bar[XB_XSUB(b.x)], 1u);
        const unsigned gen = old / nloc;
        if (old + 1u == (gen + 1u) * nloc) {
            __builtin_amdgcn_fence(__ATOMIC_RELEASE, "agent");
            asm volatile("s_waitcnt vmcnt(0)" ::: "memory");
            const unsigned og = xb_add(&bar[XB_TOP], 1u);
            const unsigned tg = og / nx;
            if (og + 1u == (tg + 1u) * nx) xb_add(&bar[XB_TOPGEN], 1u);
            else XB_SPIN(xb_ld(&bar[XB_TOPGEN]) == tg, bar);
            __builtin_amdgcn_fence(__ATOMIC_ACQUIRE, "agent");
            xb_add(&bar[XB_XGEN(b.x)], 1u);
            asm volatile("s_waitcnt vmcnt(0)" ::: "memory");
        } else {
            XB_SPIN(xb_ld(&bar[XB_XGEN(b.x)]) == gen, bar);
            __builtin_amdgcn_fence(__ATOMIC_ACQUIRE, "agent");
            asm volatile("s_waitcnt vmcnt(0)" ::: "memory");
        }
    }
    __syncthreads();
}

namespace epi {
using pg8::Unit; using pg8::BM; using pg8::HALF;
typedef const pg8::f32x4 (&AccRef)[2][2][4][2];

struct EpiProj1 {
    static constexpr bool PERM = false, AFTER_DRAIN = false;
    bf16* O; const float* cosT; const float* sinT;
    __device__ __forceinline__ void operator()(AccRef acc, const Unit& u, int wr, int wc, int fr, int fq) const {
        const int row0 = u.pm * BM + wr * 64 + fr, colw = u.pn * BM + wc * 32;
#pragma unroll
        for (int bj = 0; bj < 2; ++bj) {
            const int hb = (colw + bj * HALF) >> 6;
            const bool rope = (hb >= 40 && hb < 50) || (hb >= 52 && hb < 54) || (hb >= 56 && hb < 58) || (hb >= 60 && hb < 76);
            const bool isq = (hb >= 40 && hb < 48) || (hb >= 60 && hb < 68);
            const float qs = isq ? QSCALE : 1.0f;
            const int jw = (wc & 1) * 16 + fq * 2;
#pragma unroll
            for (int ai = 0; ai < 2; ++ai)
#pragma unroll
                for (int m = 0; m < 4; ++m) {
                    const int row = row0 + ai * HALF + m * 16;
                    bf16* rowp = O + (size_t)row * NP1 + colw + bj * HALF + 4 * fq;
#pragma unroll
                    for (int n = 0; n < 2; ++n) {
                        pg8::f32x4 v = acc[ai][bj][m][n];
                        if (rope) {
                            const f32x2 c = *(const f32x2*)(cosT + (size_t)row * 32 + jw + n * 8), s = *(const f32x2*)(sinT + (size_t)row * 32 + jw + n * 8);
                            const float y0 = v[0] * c.x - v[1] * s.x, y1 = v[1] * c.x + v[0] * s.x, y2 = v[2] * c.y - v[3] * s.y, y3 = v[3] * c.y + v[2] * s.y;
                            v[0] = y0 * qs; v[1] = y1 * qs; v[2] = y2 * qs; v[3] = y3 * qs;
                        }
                        v2u w; w.x = pk2(v[0], v[1]); w.y = pk2(v[2], v[3]);
                        *(v2u*)(rowp + n * 16) = w;
                    }
                }
        }
    }
};
template <int ACT> struct EpiStore {
    static constexpr bool PERM = false, AFTER_DRAIN = false;
    bf16* O; int ldc;
    __device__ __forceinline__ void operator()(AccRef acc, const Unit& u, int wr, int wc, int fr, int fq) const {
        const int row0 = u.pm * BM + wr * 64 + fr, col0 = u.pn * BM + wc * 32 + 4 * fq;
#pragma unroll
        for (int ai = 0; ai < 2; ++ai)
#pragma unroll
            for (int m = 0; m < 4; ++m) { bf16* rowp = O + (size_t)(row0 + ai * HALF + m * 16) * ldc + col0;
#pragma unroll
                for (int bj = 0; bj < 2; ++bj)
#pragma unroll
                    for (int n = 0; n < 2; ++n) { pg8::f32x4 v = acc[ai][bj][m][n];
                        if (ACT == 1) { v[0] = sigmoidf_(v[0]); v[1] = sigmoidf_(v[1]); v[2] = sigmoidf_(v[2]); v[3] = sigmoidf_(v[3]); }
                        v2u w; w.x = pk2(v[0], v[1]); w.y = pk2(v[2], v[3]); *(v2u*)(rowp + bj * HALF + n * 16) = w; } }
    }
};
struct EpiMerge {
    static constexpr bool PERM = false, AFTER_DRAIN = false;
    bf16* O; const bf16* G; int seg;
    __device__ __forceinline__ void operator()(AccRef acc, const Unit& u, int wr, int wc, int fr, int fq) const {
        const int row0 = u.pm * BM + wr * 64 + fr, col0 = u.pn * BM + wc * 32 + 4 * fq;
#pragma unroll
        for (int ai = 0; ai < 2; ++ai)
#pragma unroll
            for (int m = 0; m < 4; ++m) { const size_t row = (size_t)(row0 + ai * HALF + m * 16); bf16* rowp = O + row * DM + col0; const bf16* gp = G + row * NGT + seg * DM + col0;
#pragma unroll
                for (int bj = 0; bj < 2; ++bj)
#pragma unroll
                    for (int n = 0; n < 2; ++n) { pg8::f32x4 v = acc[ai][bj][m][n];
                        const v2u g = *(const v2u*)(gp + bj * HALF + n * 16);
                        v[0] *= bflo(g.x); v[1] *= bfhi(g.x); v[2] *= bflo(g.y); v[3] *= bfhi(g.y);
                        if (seg != 0) { const v2u o = *(const v2u*)(rowp + bj * HALF + n * 16); v[0] += bflo(o.x); v[1] += bfhi(o.x); v[2] += bflo(o.y); v[3] += bfhi(o.y); }
                        v2u w; w.x = pk2(v[0], v[1]); w.y = pk2(v[2], v[3]); *(v2u*)(rowp + bj * HALF + n * 16) = w; } }
    }
};
struct EpiResid {
    static constexpr bool PERM = false, AFTER_DRAIN = false;
    const float* XI; float* XO; const float* gate;
    __device__ __forceinline__ void operator()(AccRef acc, const Unit& u, int wr, int wc, int fr, int fq) const {
        const int row0 = u.pm * BM + wr * 64 + fr, col0 = u.pn * BM + wc * 32 + 4 * fq;
        const float* gb = gate + (size_t)((u.pm * BM) / SEQ) * 6144 + col0;
        pg8::f32x4 gv[2][2];
#pragma unroll
        for (int bj = 0; bj < 2; ++bj)
#pragma unroll
            for (int n = 0; n < 2; ++n) gv[bj][n] = *(const pg8::f32x4*)(gb + bj * HALF + n * 16);
#pragma unroll
        for (int ai = 0; ai < 2; ++ai)
#pragma unroll
            for (int m = 0; m < 4; ++m) { const size_t off = (size_t)(row0 + ai * HALF + m * 16) * DM + col0;
#pragma unroll
                for (int bj = 0; bj < 2; ++bj)
#pragma unroll
                    for (int n = 0; n < 2; ++n) { const pg8::f32x4 xi = *(const pg8::f32x4*)(XI + off + bj * HALF + n * 16);
                        *(pg8::f32x4*)(XO + off + bj * HALF + n * 16) = xi + gv[bj][n] * acc[ai][bj][m][n]; } }
    }
};
}

constexpr int NWAVES = 8, NTHR = 512;
struct Args { const void* in[26]; float* out; unsigned char* ws; int ph_lo, ph_hi; };
enum InIdx { I_X = 0, I_C, I_POS, I_MODW, I_MODB, I_NMG, I_NFG, I_WIN, I_ACW, I_AOUT, I_BCW, I_BCB, I_BLNG, I_BLNB, I_BOUT, I_CPOS, I_CW1, I_CW2, I_COUT, I_DOUT, I_WO, I_PWQ, I_PSUB, I_PU, I_PV, I_FNG };

struct Frame {
    LAS unsigned char* lds; unsigned char* ldsg;
    int tid, lane, wave, G, bid;
    unsigned char* ws;
};
__device__ __forceinline__ int gwave(const Frame& F) { return F.bid * NWAVES + F.wave; }
__device__ __forceinline__ int ngwave(const Frame& F) { return F.G * NWAVES; }

__device__ __forceinline__ int rope_pos_of_dim(int d) { return d < 32 ? 2 * d : 2 * (d - 32) + 1; }
__device__ __forceinline__ int rope_dim_of_pos(int p) { return (p >> 1) + 32 * (p & 1); }
__device__ __forceinline__ int win_row_of_col(int n) {
    if (n < 2560) return n;
    if (n < 3072) { const int c = n - 2560; return C_CQ + (c & ~63) + rope_pos_of_dim(c & 63); }
    if (n < 3200) { const int c = n - 3072; return C_KC + (c & ~63) + rope_pos_of_dim(c & 63); }
    if (n < 3328) return C_VC + (n - 3200);
    if (n < 3456) { const int c = n - 3328; return C_KS + (c & ~63) + rope_pos_of_dim(c & 63); }
    if (n < 3584) return C_VS + (n - 3456);
    if (n < 3712) { const int c = n - 3584; return C_KW + (c & ~63) + rope_pos_of_dim(c & 63); }
    if (n < 3840) return C_VW + (n - 3712);
    if (n < 3864) return C_CG + (n - 3840);
    if (n < 4376) { const int c = n - 3864; return C_DQ + (c & ~63) + rope_pos_of_dim(c & 63); }
    if (n < 4888) { const int c = n - 4376; return C_DK + (c & ~63) + rope_pos_of_dim(c & 63); }
    if (n < 5400) return C_DV + (n - 4888);
    return NP1 + (n - 5400);
}
template <int MODE, bool KPERM>
__device__ __forceinline__ void transpose_item(const float* W, int K, int N, bf16* WT, LAS float* scr, int item, int lane) {
    const int nblk = (N + 31) / 32, kb = item / nblk, nb = item % nblk, k0 = 64 * kb, n0 = 32 * nb;
    const int nsrc = n0 + (lane & 31); const bool nok = nsrc < N;
#pragma unroll 8
    for (int i = 0; i < 32; ++i) { const int kk = 2 * i + (lane >> 5); scr[kk * 33 + (lane & 31)] = nok ? W[(size_t)(k0 + kk) * N + nsrc] : 0.f; }
    LDS_WAIT(); asm volatile("" ::: "memory");
    const int c = lane & 7;
#pragma unroll
    for (int j = 0; j < 4; ++j) { const int n = (lane >> 3) + 8 * j;
        float s[8];
#pragma unroll
        for (int e = 0; e < 8; ++e) { const int p = 8 * c + e; const int ks = KPERM ? rope_dim_of_pos(p) : p; s[e] = scr[ks * 33 + n]; }
        v4u o; o.x = pk2(s[0], s[1]); o.y = pk2(s[2], s[3]); o.z = pk2(s[4], s[5]); o.w = pk2(s[6], s[7]);
        if (n0 + n < N) { const int row = (MODE == 1) ? win_row_of_col(n0 + n) : (n0 + n); *(v4u*)(WT + (size_t)row * K + k0 + 8 * c) = o; } }
    LDS_WAIT(); asm volatile("" ::: "memory");
}
template <int MODE, bool KPERM>
__device__ __forceinline__ void transpose_matrix(const Frame& F, const float* W, int K, int N, bf16* WT, int& base) {
    LAS float* scr = (LAS float*)(F.lds + F.wave * 16384);
    const int nitems = (K / 64) * ((N + 31) / 32), gw = gwave(F), NGW = ngwave(F);
    int first = (gw - base % NGW + NGW) % NGW;
    for (int it = first; it < nitems; it += NGW) transpose_item<MODE, KPERM>(W, K, N, WT, scr, it, F.lane);
    base += nitems;
}
__device__ __forceinline__ void convert_copy(const Frame& F, const float* src, bf16* dst, size_t n) {
    const size_t nth = (size_t)F.G * NTHR, t0 = (size_t)F.bid * NTHR + F.tid;
    for (size_t i = t0; i < n / 8; i += nth) { const f32x4 a = *(const f32x4*)(src + i * 8), b = *(const f32x4*)(src + i * 8 + 4);
        v4u o; o.x = pk2(a[0], a[1]); o.y = pk2(a[2], a[3]); o.z = pk2(b[0], b[1]); o.w = pk2(b[2], b[3]); *(v4u*)(dst + i * 8) = o; }
}

typedef __attribute__((address_space(4))) const Args* KArgsP;
__device__ __forceinline__ void phase_prologue(const Frame& F, KArgsP Ap) {
    unsigned char* ws = F.ws;
    int base = 0;
    for (int l = 0; l < DEPTH; ++l) {
        transpose_matrix<1, false>(F, (const float*)(GAS const void*)Ap->in[I_WIN] + (size_t)l * DM * 9496, DM, 9496, (bf16*)(ws + WS_WIN) + (size_t)l * NWIN * DM, base);
        transpose_matrix<0, false>(F, (const float*)(GAS const void*)Ap->in[I_AOUT] + (size_t)l * 512 * DM, 512, DM, (bf16*)(ws + WS_WOUT) + (size_t)(l * 4 + 0) * DM * 512, base);
        transpose_matrix<0, false>(F, (const float*)(GAS const void*)Ap->in[I_BOUT] + (size_t)l * 512 * DM, 512, DM, (bf16*)(ws + WS_WOUT) + (size_t)(l * 4 + 1) * DM * 512, base);
        transpose_matrix<0, false>(F, (const float*)(GAS const void*)Ap->in[I_COUT] + (size_t)l * 512 * DM, 512, DM, (bf16*)(ws + WS_WOUT) + (size_t)(l * 4 + 2) * DM * 512, base);
        transpose_matrix<0, false>(F, (const float*)(GAS const void*)Ap->in[I_DOUT] + (size_t)l * 512 * DM, 512, DM, (bf16*)(ws + WS_WOUT) + (size_t)(l * 4 + 3) * DM * 512, base);
        transpose_matrix<0, false>(F, (const float*)(GAS const void*)Ap->in[I_WO] + (size_t)l * DM * DM, DM, DM, (bf16*)(ws + WS_WO) + (size_t)l * DM * DM, base);
        transpose_matrix<0, false>(F, (const float*)(GAS const void*)Ap->in[I_PWQ] + (size_t)l * DM * 2048, DM, 2048, (bf16*)(ws + WS_WQ) + (size_t)l * 2048 * DM, base);
        transpose_matrix<0, true>(F, (const float*)(GAS const void*)Ap->in[I_CW1] + (size_t)(l * 2 + 0) * 2048 * 128, 2048, 128, (bf16*)(ws + WS_W1T) + (size_t)(l * 2 + 0) * 128 * 2048, base);
        transpose_matrix<0, false>(F, (const float*)(GAS const void*)Ap->in[I_CW1] + (size_t)(l * 2 + 1) * 2048 * 128, 2048, 128, (bf16*)(ws + WS_W1T) + (size_t)(l * 2 + 1) * 128 * 2048, base);
    }
    convert_copy(F, (const float*)(GAS const void*)Ap->in[I_PSUB], (bf16*)(ws + WS_SUBK), (size_t)DEPTH * 8 * 2 * 128 * 128);
    const int gt = F.bid * NTHR + F.tid, NGT_ = F.G * NTHR;
    { const float* w2 = (const float*)(GAS const void*)Ap->in[I_CW2]; bf16* w2t = (bf16*)(ws + WS_SMALL + SM_W2T);
      for (int i = gt; i < DEPTH * 2 * 64 * 128; i += NGT_) { const int k = i & 127, n = (i >> 7) & 63, lw = i >> 13; w2t[i] = (bf16)f2bf(w2[((size_t)lw * 128 + k) * 64 + n]); } }
    { const int* pos = (const int*)(GAS const void*)Ap->in[I_POS]; float* ct = (float*)(ws + WS_COS); float* st = (float*)(ws + WS_SIN);
      for (int i = gt; i < TOK * 32; i += NGT_) { const int t = i >> 5, j = i & 31;
          const float inv = 1.0f / powf(10000.0f, (float)(2 * j) / 64.0f); const float ang = (float)pos[t] * inv;
          ct[i] = (float)cos((double)ang); st[i] = (float)sin((double)ang); } }
    { const float* w1 = (const float*)(GAS const void*)Ap->in[I_CW1]; const float* cp = (const float*)(GAS const void*)Ap->in[I_CPOS]; float* pbp = (float*)(ws + WS_SMALL + SM_PBP);
      for (int i = gt; i < DEPTH * 2 * 16 * 128; i += NGT_) { const int n = i & 127, kc = (i >> 7) & 15, lw = i >> 11; float s = 0.f;
          for (int k = kc * 128; k < kc * 128 + 128; ++k) s += cp[(size_t)lw * 2048 + k] * w1[((size_t)lw * 2048 + k) * 128 + n];
          pbp[i] = s; } }
    __syncthreads();
    { LAS float* cond = (LAS float*)(F.lds);
      LAS float* red = (LAS float*)(F.lds + 32768);
      const float* c = (const float*)(GAS const void*)Ap->in[I_C];
      for (int i = F.tid; i < 8 * 1024; i += NTHR) { const float v = c[i]; cond[i] = v / (1.0f + __expf(-v)); }
      __syncthreads();
      for (int un = F.bid; un < DEPTH * 96; un += F.G) { const int l = un / 96, n0 = (un % 96) * 64;
          const float* mw = (const float*)(GAS const void*)Ap->in[I_MODW] + (size_t)l * DM * 6144 + n0 + F.lane;
          float acc[8];
#pragma unroll
          for (int b = 0; b < 8; ++b) acc[b] = 0.f;
#pragma unroll 4
          for (int k = F.wave * 128; k < F.wave * 128 + 128; ++k) { const float w = mw[(size_t)k * 6144];
#pragma unroll
              for (int b = 0; b < 8; ++b) acc[b] += cond[b * 1024 + k] * w; }
#pragma unroll
          for (int b = 0; b < 8; ++b) red[(F.wave * 8 + b) * 64 + F.lane] = acc[b];
          __syncthreads();
          { const int b = F.tid >> 6, n = F.tid & 63; float s = 0.f;
#pragma unroll
            for (int w = 0; w < 8; ++w) s += red[(w * 8 + b) * 64 + n];
            ((float*)(ws + WS_MOD))[((size_t)l * 8 + b) * 6144 + n0 + n] = s + ((const float*)(GAS const void*)Ap->in[I_MODB])[(size_t)l * 6144 + n0 + n]; }
          __syncthreads(); }
    }
}

__device__ __forceinline__ void phase_norm_mod(const Frame& F, const float* X, const float* g, const float* sh, const float* sc, bf16* O, unsigned char* O8 = nullptr, float* OS = nullptr) {
    const int gw = gwave(F), NGW = ngwave(F);
    f32x4 gv[4];
#pragma unroll
    for (int j = 0; j < 4; ++j) gv[j] = *(const f32x4*)(g + 4 * F.lane + 256 * j);
    for (int row = gw; row < TOK; row += NGW) {
        const int b = row / SEQ; const float* xr = X + (size_t)row * DM + 4 * F.lane;
        f32x4 v[4]; float s = 0.f;
#pragma unroll
        for (int j = 0; j < 4; ++j) { v[j] = *(const f32x4*)(xr + 256 * j); s += (v[j][0] * v[j][0] + v[j][1] * v[j][1]) + (v[j][2] * v[j][2] + v[j][3] * v[j][3]); }
        const float r = 1.0f / sqrtf(wave_sum(s, F.lane) * (1.0f / DM) + NORM_EPS);
        bf16* orow = O + (size_t)row * DM + 4 * F.lane;
#pragma unroll
        for (int j = 0; j < 4; ++j) { const f32x4 scv = *(const f32x4*)(sc + (size_t)b * 6144 + 4 * F.lane + 256 * j), shv = *(const f32x4*)(sh + (size_t)b * 6144 + 4 * F.lane + 256 * j);
            const f32x4 y = v[j] * r * gv[j] * (scv + 1.0f) + shv; v2u w; w.x = pk2(y[0], y[1]); w.y = pk2(y[2], y[3]); *(v2u*)(orow + 256 * j) = w; v[j] = y; }
        if (O8) {
            float mx = 0.f;
#pragma unroll
            for (int j = 0; j < 4; ++j) mx = fmaxf(fmaxf(mx, fmaxf(fabsf(v[j][0]), fabsf(v[j][1]))), fmaxf(fabsf(v[j][2]), fabsf(v[j][3])));
#pragma unroll
            for (int o = 1; o < 32; o <<= 1) mx = fmaxf(mx, shx(mx, o, F.lane));
            mx = max32(mx);
            int ex = 0; (void)frexpf(mx, &ex); const int k = (mx > 0.f) ? (8 - ex) : 0;
            const float s8 = __builtin_ldexpf(1.0f, k);
#pragma unroll
            for (int j = 0; j < 4; ++j) { unsigned p = 0u; p = __builtin_amdgcn_cvt_pk_fp8_f32(v[j][0] * s8, v[j][1] * s8, p, false); p = __builtin_amdgcn_cvt_pk_fp8_f32(v[j][2] * s8, v[j][3] * s8, p, true);
                *(unsigned*)(O8 + (size_t)row * DM + 4 * F.lane + 256 * j) = p; }
            if (F.lane == 0) OS[row] = __builtin_ldexpf(1.0f, -k);
        }
    }
}
__device__ __forceinline__ void phase_final_norm(const Frame& F, const float* X, const float* g, float* O) {
    const int gw = gwave(F), NGW = ngwave(F);
    f32x4 gv[4];
#pragma unroll
    for (int j = 0; j < 4; ++j) gv[j] = *(const f32x4*)(g + 4 * F.lane + 256 * j);
    for (int row = gw; row < TOK; row += NGW) {
        const float* xr = X + (size_t)row * DM + 4 * F.lane; f32x4 v[4]; float s = 0.f;
#pragma unroll
        for (int j = 0; j < 4; ++j) { v[j] = *(const f32x4*)(xr + 256 * j); s += (v[j][0] * v[j][0] + v[j][1] * v[j][1]) + (v[j][2] * v[j][2] + v[j][3] * v[j][3]); }
        const float r = 1.0f / sqrtf(wave_sum(s, F.lane) * (1.0f / DM) + NORM_EPS);
        float* orow = O + (size_t)row * DM + 4 * F.lane;
#pragma unroll
        for (int j = 0; j < 4; ++j) *(f32x4*)(orow + 256 * j) = v[j] * r * gv[j];
    }
}

__device__ __forceinline__ void phase_mixer_a(const Frame& F, const bf16* P, const float* cw  , bf16* O  ) {
    const int nth = F.G * NTHR, gt = F.bid * NTHR + F.tid;
    for (int it = gt; it < (TOK / 8) * 64; it += nth) {
        const int cg = it & 63, tb = it >> 6, c0 = cg * 8, t0 = tb * 8, s0 = t0 % SEQ;
        float w0[8], w1[8], w2[8];
#pragma unroll
        for (int e = 0; e < 8; ++e) { w0[e] = cw[c0 + e]; w1[e] = cw[512 + c0 + e]; w2[e] = cw[1024 + c0 + e]; }
        float pm2[8], pm1[8];
#pragma unroll
        for (int e = 0; e < 8; ++e) { pm2[e] = 0.f; pm1[e] = 0.f; }
        for (int pre = 2; pre >= 1; --pre) if (s0 - pre >= 0) { const bf16* r = P + (size_t)(t0 - pre) * NP1;
            const v4u ac = *(const v4u*)(r + C_AC + c0), ax = *(const v4u*)(r + C_AX + c0);
            float pr[8]; pr[0] = bflo(ac.x) * bflo(ax.x); pr[1] = bfhi(ac.x) * bfhi(ax.x); pr[2] = bflo(ac.y) * bflo(ax.y); pr[3] = bfhi(ac.y) * bfhi(ax.y);
            pr[4] = bflo(ac.z) * bflo(ax.z); pr[5] = bfhi(ac.z) * bfhi(ax.z); pr[6] = bflo(ac.w) * bflo(ax.w); pr[7] = bfhi(ac.w) * bfhi(ax.w);
#pragma unroll
            for (int e = 0; e < 8; ++e) { if (pre == 2) pm2[e] = pr[e]; else pm1[e] = pr[e]; } }
#pragma unroll
        for (int tt = 0; tt < 8; ++tt) { const bf16* r = P + (size_t)(t0 + tt) * NP1;
            const v4u ac = *(const v4u*)(r + C_AC + c0), ax = *(const v4u*)(r + C_AX + c0), ab = *(const v4u*)(r + C_AB + c0);
            float pr[8], bb[8], y[8];
            pr[0] = bflo(ac.x) * bflo(ax.x); pr[1] = bfhi(ac.x) * bfhi(ax.x); pr[2] = bflo(ac.y) * bflo(ax.y); pr[3] = bfhi(ac.y) * bfhi(ax.y);
            pr[4] = bflo(ac.z) * bflo(ax.z); pr[5] = bfhi(ac.z) * bfhi(ax.z); pr[6] = bflo(ac.w) * bflo(ax.w); pr[7] = bfhi(ac.w) * bfhi(ax.w);
            bb[0] = bflo(ab.x); bb[1] = bfhi(ab.x); bb[2] = bflo(ab.y); bb[3] = bfhi(ab.y); bb[4] = bflo(ab.z); bb[5] = bfhi(ab.z); bb[6] = bflo(ab.w); bb[7] = bfhi(ab.w);
#pragma unroll
            for (int e = 0; e < 8; ++e) { y[e] = bb[e] * (w0[e] * pm2[e] + w1[e] * pm1[e] + w2[e] * pr[e]); pm2[e] = pm1[e]; pm1[e] = pr[e]; }
            v4u o; o.x = pk2(y[0], y[1]); o.y = pk2(y[2], y[3]); o.z = pk2(y[4], y[5]); o.w = pk2(y[6], y[7]);
            *(v4u*)(O + (size_t)(t0 + tt) * 512 + c0) = o; }
    }
}

__device__ __forceinline__ void phase_mixer_b(const Frame& F, const bf16* P, const float* cw  , const float* cb, const float* lg, const float* lb, bf16* O) {
    LAS float* U = (LAS float*)F.lds;
    for (int un = F.bid; un < TOK / 32; un += F.G) {
        const int t0 = un * 32, s0 = t0 % SEQ;
        __syncthreads();
        for (int i = F.tid; i < 62 * 64; i += NTHR) { const int r = i >> 6, cg = i & 63, c0 = cg * 8; const int srel = s0 - 30 + r;
            float u[8];
            if (srel >= 0) { const bf16* row = P + (size_t)(t0 - 30 + r) * NP1; const v4u a = *(const v4u*)(row + C_BA + c0), g = *(const v4u*)(row + C_BG + c0);
                u[0] = bflo(a.x) * sigmoidf_(bflo(g.x)); u[1] = bfhi(a.x) * sigmoidf_(bfhi(g.x)); u[2] = bflo(a.y) * sigmoidf_(bflo(g.y)); u[3] = bfhi(a.y) * sigmoidf_(bfhi(g.y));
                u[4] = bflo(a.z) * sigmoidf_(bflo(g.z)); u[5] = bfhi(a.z) * sigmoidf_(bfhi(g.z)); u[6] = bflo(a.w) * sigmoidf_(bflo(g.w)); u[7] = bfhi(a.w) * sigmoidf_(bfhi(g.w)); }
            else {
#pragma unroll
                for (int e = 0; e < 8; ++e) u[e] = 0.f; }
            *(LAS f32x4*)(U + r * 512 + c0) = (f32x4){u[0], u[1], u[2], u[3]}; *(LAS f32x4*)(U + r * 512 + c0 + 4) = (f32x4){u[4], u[5], u[6], u[7]}; }
        __syncthreads();
        const int c0 = F.lane * 8;
        float acc[4][8];
#pragma unroll
        for (int q = 0; q < 4; ++q)
#pragma unroll
            for (int e = 0; e < 8; ++e) acc[q][e] = cb[c0 + e];
        for (int k = 0; k < 31; ++k) { const f32x4 wa = *(const f32x4*)(cw + k * 512 + c0), wb = *(const f32x4*)(cw + k * 512 + c0 + 4);
#pragma unroll
            for (int q = 0; q < 4; ++q) { const int r = 4 * F.wave + q + k; const f32x4 ua = *(LAS f32x4*)(U + r * 512 + c0), ub = *(LAS f32x4*)(U + r * 512 + c0 + 4);
                acc[q][0] += wa[0] * ua[0]; acc[q][1] += wa[1] * ua[1]; acc[q][2] += wa[2] * ua[2]; acc[q][3] += wa[3] * ua[3];
                acc[q][4] += wb[0] * ub[0]; acc[q][5] += wb[1] * ub[1]; acc[q][6] += wb[2] * ub[2]; acc[q][7] += wb[3] * ub[3]; } }
        const f32x4 ga = *(const f32x4*)(lg + c0), gb = *(const f32x4*)(lg + c0 + 4), ba = *(const f32x4*)(lb + c0), bb = *(const f32x4*)(lb + c0 + 4);
#pragma unroll
        for (int q = 0; q < 4; ++q) { float s = 0.f;
#pragma unroll
            for (int e = 0; e < 8; ++e) s += acc[q][e];
            const float mu = wave_sum(s, F.lane) * (1.0f / 512.0f); float v = 0.f;
#pragma unroll
            for (int e = 0; e < 8; ++e) { acc[q][e] -= mu; v += acc[q][e] * acc[q][e]; }
            const float rs = 1.0f / sqrtf(wave_sum(v, F.lane) * (1.0f / 512.0f) + NORM_EPS);
            float y[8];
#pragma unroll
            for (int e = 0; e < 8; ++e) { const float gg = e < 4 ? ga[e] : gb[e - 4], bv = e < 4 ? ba[e] : bb[e - 4]; const float z = acc[q][e] * rs * gg + bv; y[e] = z / (1.0f + __expf(-z)); }
            v4u o; o.x = pk2(y[0], y[1]); o.y = pk2(y[2], y[3]); o.z = pk2(y[4], y[5]); o.w = pk2(y[6], y[7]);
            *(v4u*)(O + (size_t)(t0 + 4 * F.wave + q) * 512 + c0) = o; }
    }
}

__device__ __forceinline__ void phase_compress(const Frame& F, const bf16* P, const bf16* W1T  , const bf16* W2T  , const float* PBP  ,
                                               bf16* KC, bf16* VC  ) {
    LAS float* PART = (LAS float*)F.lds;
    LAS bf16* H1 = (LAS bf16*)(F.lds + 69632);
    const int lane = F.lane, r16 = lane & 15, q4 = lane >> 4, w = F.wave;
    for (int un = F.bid; un < 2 * 8 * 2 * 8; un += F.G) {
        const int nb = un & 7, g = (un >> 3) & 1, b = (un >> 4) & 7, which = un >> 7;
        const int n = nb * 16 + r16; const int nn = n < 127 ? n : 126;
        const int col0 = (which == 0 ? C_KC : C_VC) + g * 64;
        const bf16* arow = P + ((size_t)b * SEQ + nn * 16) * NP1 + col0;
        const bf16* w1 = W1T + (size_t)which * 128 * 2048;
        f32x4 acc[8];
#pragma unroll
        for (int j = 0; j < 8; ++j) acc[j] = (f32x4){0.f, 0.f, 0.f, 0.f};
#pragma unroll
        for (int half = 0; half < 2; ++half) {
            bf16x8 a[4], bb[4][8];
#pragma unroll
            for (int s4 = 0; s4 < 4; ++s4) { const int k = w * 256 + (half * 4 + s4) * 32 + q4 * 8;
                a[s4] = *(const bf16x8*)(arow + (size_t)(k >> 6) * NP1 + (k & 63));
#pragma unroll
                for (int j = 0; j < 8; ++j) bb[s4][j] = *(const bf16x8*)(w1 + (size_t)(j * 16 + r16) * 2048 + k); }
#pragma unroll
            for (int s4 = 0; s4 < 4; ++s4)
#pragma unroll
                for (int j = 0; j < 8; ++j) acc[j] = __builtin_amdgcn_mfma_f32_16x16x32_bf16(a[s4], bb[s4][j], acc[j], 0, 0, 0);
        }
        __syncthreads();
#pragma unroll
        for (int j = 0; j < 8; ++j)
#pragma unroll
            for (int i = 0; i < 4; ++i) PART[(w * 16 + 4 * q4 + i) * 132 + j * 16 + r16] = acc[j][i];
        __syncthreads();
        {
            const int row = F.tid >> 5, c4 = (F.tid & 31) * 4;
            f32x4 sacc = (f32x4){0.f, 0.f, 0.f, 0.f};
#pragma unroll
            for (int ww = 0; ww < 8; ++ww) sacc += *(LAS f32x4*)(PART + (ww * 16 + row) * 132 + c4);
#pragma unroll
            for (int kc = 0; kc < 16; ++kc) sacc += *(const f32x4*)(PBP + ((size_t)which * 16 + kc) * 128 + c4);
            v2u o; o.x = pk2(gelu_erf(sacc[0]), gelu_erf(sacc[1])); o.y = pk2(gelu_erf(sacc[2]), gelu_erf(sacc[3]));
            *(LAS v2u*)(H1 + row * 136 + c4) = o;
        }
        __syncthreads();
        if (w < 4) {
            f32x4 o = (f32x4){0.f, 0.f, 0.f, 0.f};
            const bf16* w2 = W2T + (size_t)which * 64 * 128;
#pragma unroll
            for (int ks = 0; ks < 4; ++ks) { const bf16x8 a = *(LAS bf16x8*)(H1 + r16 * 136 + ks * 32 + q4 * 8);
                const bf16x8 bb = *(const bf16x8*)(w2 + (size_t)(w * 16 + r16) * 128 + ks * 32 + q4 * 8);
                o = __builtin_amdgcn_mfma_f32_16x16x32_bf16(a, bb, o, 0, 0, 0); }
            bf16* out = (which == 0 ? KC : VC) + ((size_t)(b * 2 + g) * 128) * 64;
#pragma unroll
            for (int i = 0; i < 4; ++i) { const int row = nb * 16 + 4 * q4 + i; out[(size_t)row * 64 + w * 16 + r16] = row < 127 ? (bf16)f2bf(o[i]) : (bf16)0; }
        }
    }
    __syncthreads();
}
__device__ __forceinline__ void phase_kmean(const Frame& F, const bf16* P, float* KM) {
    const int gw = gwave(F), NGW = ngwave(F), lane = F.lane, rs = lane >> 3, ch = lane & 7;
    for (int un = gw; un < 8 * 8 * 8; un += NGW) { const int h = un & 7, blk = (un >> 3) & 7, b = un >> 6;
        const bf16* base = P + ((size_t)b * SEQ + blk * 256) * NP1 + C_DK + h * 64 + ch * 8;
        float s[8];
#pragma unroll
        for (int e = 0; e < 8; ++e) s[e] = 0.f;
#pragma unroll 8
        for (int i = 0; i < 32; ++i) { const v4u v = *(const v4u*)(base + (size_t)(i * 8 + rs) * NP1);
            s[0] += bflo(v.x); s[1] += bfhi(v.x); s[2] += bflo(v.y); s[3] += bfhi(v.y); s[4] += bflo(v.z); s[5] += bfhi(v.z); s[6] += bflo(v.w); s[7] += bfhi(v.w); }
#pragma unroll
        for (int e = 0; e < 8; ++e) { s[e] += shx(s[e], 8, lane); s[e] += shx(s[e], 16, lane); s[e] = add32(s[e]); }
        if (rs == 0) { float* o = KM + ((size_t)(b * 8 + blk) * 8 + h) * 64 + ch * 8;
            *(f32x4*)o = (f32x4){s[0], s[1], s[2], s[3]} * (1.0f / 256.0f); *(f32x4*)(o + 4) = (f32x4){s[4], s[5], s[6], s[7]} * (1.0f / 256.0f); }
    }
}

constexpr int KT_STRIDE = 144, VT_STRIDE = 192, KT_BYTES = 64 * KT_STRIDE, VT_BYTES = 64 * VT_STRIDE, KV_BUF = KT_BYTES + VT_BYTES;
__device__ __forceinline__ int crow(int r, int hi) { return (r & 3) + 8 * (r >> 2) + 4 * hi; }
struct AttnState { float m, l; f32x16 o0, o1; };
__device__ __forceinline__ void attn_reset(AttnState& st) { st.m = -1e30f; st.l = 0.f;
#pragma unroll
    for (int r = 0; r < 16; ++r) { st.o0[r] = 0.f; st.o1[r] = 0.f; } }
__device__ __forceinline__ s16x4 vtr(LAS const unsigned char* p) { return __builtin_bit_cast(s16x4, __builtin_amdgcn_ds_read_tr16_b64_v4i16((LAS s16x4*)p)); }

__device__ __forceinline__ void attn_scores(LAS const unsigned char* Kt, const bf16x8 (&qr)[4], f32x16& p0, f32x16& p1, int lane) {
    const int r32 = lane & 31, hi = lane >> 5;
#pragma unroll
    for (int r = 0; r < 16; ++r) { p0[r] = 0.f; p1[r] = 0.f; }
#pragma unroll
    for (int s = 0; s < 4; ++s) {
        const bf16x8 a0 = *(LAS const bf16x8*)(Kt + r32 * KT_STRIDE + (2 * s + hi) * 16), a1 = *(LAS const bf16x8*)(Kt + (32 + r32) * KT_STRIDE + (2 * s + hi) * 16);
        p0 = __builtin_amdgcn_mfma_f32_32x32x16_bf16(a0, qr[s], p0, 0, 0, 0);
        p1 = __builtin_amdgcn_mfma_f32_32x32x16_bf16(a1, qr[s], p1, 0, 0, 0);
    }
}
__device__ __forceinline__ void attn_pv(LAS const unsigned char* Vt, const f32x16& e0, const f32x16& e1, f32x16& o0, f32x16& o1, int lane) {
    const int hi = lane >> 5;
    LAS const unsigned char* vb = Vt + (4 * hi + ((lane & 15) >> 2)) * VT_STRIDE + (((lane >> 4) & 1) * 16 + 4 * (lane & 3)) * 2;
#pragma unroll
    for (int s = 0; s < 4; ++s) {
        v4u pw;
        if (s < 2) { pw.x = pk2(e0[8 * s + 0], e0[8 * s + 1]); pw.y = pk2(e0[8 * s + 2], e0[8 * s + 3]); pw.z = pk2(e0[8 * s + 4], e0[8 * s + 5]); pw.w = pk2(e0[8 * s + 6], e0[8 * s + 7]); }
        else { const int t = s - 2; pw.x = pk2(e1[8 * t + 0], e1[8 * t + 1]); pw.y = pk2(e1[8 * t + 2], e1[8 * t + 3]); pw.z = pk2(e1[8 * t + 4], e1[8 * t + 5]); pw.w = pk2(e1[8 * t + 6], e1[8 * t + 7]); }
        const bf16x8 pb = __builtin_bit_cast(bf16x8, pw);
#pragma unroll
        for (int db = 0; db < 2; ++db) {
            const s16x4 lo = vtr(vb + (16 * s) * VT_STRIDE + db * 64), hh = vtr(vb + (16 * s + 8) * VT_STRIDE + db * 64);
            const bf16x8 a = (bf16x8){lo[0], lo[1], lo[2], lo[3], hh[0], hh[1], hh[2], hh[3]};
            if (db == 0) o0 = __builtin_amdgcn_mfma_f32_32x32x16_bf16(a, pb, o0, 0, 0, 0); else o1 = __builtin_amdgcn_mfma_f32_32x32x16_bf16(a, pb, o1, 0, 0, 0);
        }
    }
}
__device__ __forceinline__ float mask_score(float v, int a, int b, int c) {
    const unsigned sg = (unsigned)(((a + c) | (b - c)) >> 31);
    return __builtin_bit_cast(float, (__builtin_bit_cast(unsigned, v) & ~sg) | (0xf149f2cau & sg));
}
__device__ __forceinline__ void attn_tile(LAS const unsigned char* Kt, LAS const unsigned char* Vt, const bf16x8 (&qr)[4], AttnState& st, int kmin, int kmax, int lane) {
    const int hi = lane >> 5;
    f32x16 p0, p1; attn_scores(Kt, qr, p0, p1, lane);
    if (!__all(kmin <= 0 && kmax >= 63)) {
        const int a = 4 * hi - kmin, b = kmax - 4 * hi;
#pragma unroll
        for (int r = 0; r < 16; ++r) { const int c = (r & 3) + 8 * (r >> 2); p0[r] = mask_score(p0[r], a, b, c); p1[r] = mask_score(p1[r], a, b, c + 32); }
    }
    float mx = fmaxf(p0[0], p1[0]);
#pragma unroll
    for (int r = 1; r < 16; ++r) mx = fmaxf(mx, fmaxf(p0[r], p1[r]));
    mx = max32(mx);
    const float mn = fmaxf(st.m, mx), me = fmaxf(mn, -1e29f), alpha = __builtin_amdgcn_exp2f(st.m - me);
    float rs = 0.f;
#pragma unroll
    for (int r = 0; r < 16; ++r) { p0[r] = __builtin_amdgcn_exp2f(p0[r] - me); p1[r] = __builtin_amdgcn_exp2f(p1[r] - me); rs += p0[r] + p1[r]; }
    st.m = mn; st.l = st.l * alpha + rs;
    if (__any(alpha < 1.0f)) {
#pragma unroll
        for (int r = 0; r < 16; ++r) { st.o0[r] *= alpha; st.o1[r] *= alpha; }
    }
    attn_pv(Vt, p0, p1, st.o0, st.o1, lane);
}
struct KVRegs { v4u k, v; };
__device__ __forceinline__ void kv_load(KVRegs& r, const bf16* Kg, const bf16* Vg, size_t ld, int tid) {
    const int key = tid >> 3, ch = tid & 7;
    r.k = *(const v4u*)(Kg + (size_t)key * ld + ch * 8); r.v = *(const v4u*)(Vg + (size_t)key * ld + ch * 8);
}
__device__ __forceinline__ void kv_store(const KVRegs& r, LAS unsigned char* buf, int tid) {
    const int key = tid >> 3, ch = tid & 7;
    *(LAS v4u*)(buf + key * KT_STRIDE + ch * 16) = r.k; *(LAS v4u*)(buf + KT_BYTES + key * VT_STRIDE + ch * 16) = r.v;
}

__device__ __forceinline__ float attn_inv_l(const AttnState& st) { const float l = add32(st.l); return 1.0f / fmaxf(l, 1e-30f); }

#define ATTN_STREAM(Kg, Vg, ld, j0, j1, SKIP, RANGE) do { \
    int jn_ = (j0); while (jn_ < (j1) && (SKIP(jn_))) ++jn_; \
    if (jn_ < (j1)) { KVRegs kv_; kv_load(kv_, (Kg) + (size_t)jn_ * 64 * (ld), (Vg) + (size_t)jn_ * 64 * (ld), (ld), F.tid); \
        __syncthreads(); kv_store(kv_, ring, F.tid); int cur_ = 0; \
        for (;;) { const int j_ = jn_; ++jn_; while (jn_ < (j1) && (SKIP(jn_))) ++jn_; const bool more_ = jn_ < (j1); \
            if (more_) kv_load(kv_, (Kg) + (size_t)jn_ * 64 * (ld), (Vg) + (size_t)jn_ * 64 * (ld), (ld), F.tid); \
            __syncthreads(); \
            { int kmin_, kmax_; RANGE(j_, kmin_, kmax_); \
              if (__any(kmax_ >= kmin_)) attn_tile(ring + cur_ * KV_BUF, ring + cur_ * KV_BUF + KT_BYTES, qr, st, kmin_, kmax_, F.lane); } \
            if (!more_) break; \
            kv_store(kv_, ring + (cur_ ^ 1) * KV_BUF, F.tid); cur_ ^= 1; } } } while (0)

__device__ __forceinline__ void nsa_unit(const Frame& F, const bf16* P, const bf16* KC, const bf16* VC, bf16* O  , int b, int g, int i) {
    LAS unsigned char* ring = F.lds;
    LAS float* impb = (LAS float*)(F.lds + 2 * KV_BUF);
    LAS unsigned* selm = (LAS unsigned*)(F.lds + 2 * KV_BUF + 33792);
    LAS float* stash = (LAS float*)(F.lds + 2 * KV_BUF + 33792 + 256) + F.tid;
    const int lane = F.lane, r32 = lane & 31, hi = lane >> 5, hr = F.wave & 3, th = F.wave >> 2;
    const int tl = 32 * th + r32;
    const int s = 64 * i + tl;
    const size_t row = (size_t)b * SEQ + s;
    const int head = g * 4 + hr;
    bf16x8 qr[4];
#pragma unroll
    for (int d = 0; d < 4; ++d) qr[d] = *(const bf16x8*)(P + row * NP1 + C_CQ + head * 64 + d * 16 + hi * 8);
    const float g0 = sigmoidf_(bf2f(P[row * NP1 + C_CG + head])), g1 = sigmoidf_(bf2f(P[row * NP1 + C_CG + 8 + head])), g2 = sigmoidf_(bf2f(P[row * NP1 + C_CG + 16 + head]));
    AttnState st;
    {
        const bf16* Kg = KC + (size_t)(b * 2 + g) * 128 * 64; const bf16* Vg = VC + (size_t)(b * 2 + g) * 128 * 64;
        const int nmax = (s >= 31) ? ((s - 31) >> 4) : -1;
        { KVRegs kv0, kv1; kv_load(kv0, Kg, Vg, 64, F.tid); kv_load(kv1, Kg + 64 * 64, Vg + 64 * 64, 64, F.tid);
          __syncthreads();
          kv_store(kv0, ring, F.tid); kv_store(kv1, ring + KV_BUF, F.tid); }
        __syncthreads();
        attn_reset(st);
        attn_tile(ring, ring + KT_BYTES, qr, st, 0, nmax < 63 ? nmax : 63, lane);
        attn_tile(ring + KV_BUF, ring + KV_BUF + KT_BYTES, qr, st, 0, nmax - 64 < 63 ? nmax - 64 : 63, lane);
        const float inv = attn_inv_l(st);
        { const float sc = g0 * inv;
#pragma unroll
          for (int r = 0; r < 16; ++r) { stash[r * 512] = st.o0[r] * sc; stash[(16 + r) * 512] = st.o1[r] * sc; } }
        if (i >= 16) {
            float xprev = 0.f; const float mfin = st.m;
#define NSA_IMP(U, ACC, GQ) do { const float G_ = ((ACC[4 * (GQ)] + ACC[4 * (GQ) + 1]) + (ACC[4 * (GQ) + 2] + ACC[4 * (GQ) + 3])), L_ = ACC[4 * (GQ) + 3]; \
                const float x_ = other32(L_, hi); impb[(hr * 64 + tl) * 33 + 2 * (U) + hi] = G_ + (hi ? x_ : xprev); xprev = x_; } while (0)
#pragma unroll
            for (int tile = 0; tile < 2; ++tile) {
                f32x16 a0, a1; attn_scores(ring + tile * KV_BUF, qr, a0, a1, lane);
#pragma unroll
                for (int r = 0; r < 16; ++r) { const int c = (r & 3) + 8 * (r >> 2);
                    a0[r] = __builtin_amdgcn_exp2f(mask_score(a0[r], 4 * hi, nmax - 64 * tile - 4 * hi, c) - mfin) * inv; a1[r] = __builtin_amdgcn_exp2f(mask_score(a1[r], 4 * hi, nmax - 64 * tile - 4 * hi, c + 32) - mfin) * inv; }
                NSA_IMP(8 * tile + 0, a0, 0); NSA_IMP(8 * tile + 1, a0, 1); NSA_IMP(8 * tile + 2, a0, 2); NSA_IMP(8 * tile + 3, a0, 3);
                NSA_IMP(8 * tile + 4, a1, 0); NSA_IMP(8 * tile + 5, a1, 1); NSA_IMP(8 * tile + 6, a1, 2); NSA_IMP(8 * tile + 7, a1, 3);
            }
#undef NSA_IMP
        }
    }
    __syncthreads();
    unsigned mymask;
    if (i < 16) mymask = (2u << i) - 1u;
    else {
        { const int tk = F.tid >> 3, js = F.tid & 7; unsigned bits = 0u;
          float v[4];
#pragma unroll
          for (int e = 0; e < 4; ++e) { const int j = js * 4 + e; v[e] = (impb[(0 * 64 + tk) * 33 + j] + impb[(1 * 64 + tk) * 33 + j]) + (impb[(2 * 64 + tk) * 33 + j] + impb[(3 * 64 + tk) * 33 + j]); }
          int rank[4] = {0, 0, 0, 0};
          for (int jj = 1; jj <= i - 2; ++jj) { const float o = (impb[(0 * 64 + tk) * 33 + jj] + impb[(1 * 64 + tk) * 33 + jj]) + (impb[(2 * 64 + tk) * 33 + jj] + impb[(3 * 64 + tk) * 33 + jj]);
#pragma unroll
              for (int e = 0; e < 4; ++e) { const int j = js * 4 + e; rank[e] += (o > v[e] || (o == v[e] && jj < j)) ? 1 : 0; } }
#pragma unroll
          for (int e = 0; e < 4; ++e) { const int j = js * 4 + e; const bool forced = (j == 0) || (j == i) || (j == i - 1); const bool cand = (j >= 1) && (j <= i - 2);
              if (forced || (cand && rank[e] < 13)) bits |= 1u << j; }
          bits |= shxu(bits, 1, F.lane); bits |= shxu(bits, 2, F.lane); bits |= shxu(bits, 4, F.lane);
          if (js == 0) selm[tk] = bits; }
        __syncthreads();
        mymask = selm[tl];
    }
    {
        attn_reset(st);
        const bf16* Kg = P + (size_t)b * SEQ * NP1 + C_KS + g * 64; const bf16* Vg = P + (size_t)b * SEQ * NP1 + C_VS + g * 64;
#define NSA_SKIP(j) (false)
#define NSA_RANGE(j, kmin, kmax) do { kmin = 0; kmax = ((mymask >> (j)) & 1u) ? ((j) == i ? tl : 63) : -1; } while (0)
        ATTN_STREAM(Kg, Vg, (size_t)NP1, 0, i + 1, NSA_SKIP, NSA_RANGE);
#undef NSA_RANGE
        const float sc = g1 * attn_inv_l(st);
#pragma unroll
        for (int r = 0; r < 16; ++r) { stash[r * 512] += st.o0[r] * sc; stash[(16 + r) * 512] += st.o1[r] * sc; }
    }
    {
        attn_reset(st);
        const bf16* Kg = P + (size_t)b * SEQ * NP1 + C_KW + g * 64; const bf16* Vg = P + (size_t)b * SEQ * NP1 + C_VW + g * 64;
        const int jlo = i >= 8 ? i - 8 : 0; f32x16 out0, out1;
#define NSA_RANGE(j, kmin, kmax) do { const int d_ = 64 * (i - (j)) + tl; kmin = d_ - 511 > 0 ? d_ - 511 : 0; kmax = d_ < 63 ? d_ : 63; } while (0)
        ATTN_STREAM(Kg, Vg, (size_t)NP1, jlo, i + 1, NSA_SKIP, NSA_RANGE);
#undef NSA_RANGE
#undef NSA_SKIP
        const float sc = g2 * attn_inv_l(st);
#pragma unroll
        for (int r = 0; r < 16; ++r) { out0[r] = stash[r * 512] + st.o0[r] * sc; out1[r] = stash[(16 + r) * 512] + st.o1[r] * sc; }
        bf16* orow = O + row * 512 + head * 64;
#pragma unroll
        for (int gq = 0; gq < 4; ++gq) {
            v2u w0; w0.x = pk2(out0[4 * gq], out0[4 * gq + 1]); w0.y = pk2(out0[4 * gq + 2], out0[4 * gq + 3]); *(v2u*)(orow + 8 * gq + 4 * hi) = w0;
            v2u w1; w1.x = pk2(out1[4 * gq], out1[4 * gq + 1]); w1.y = pk2(out1[4 * gq + 2], out1[4 * gq + 3]); *(v2u*)(orow + 32 + 8 * gq + 4 * hi) = w1; }
    }
}
__device__ __forceinline__ void phase_nsa(const Frame& F, const bf16* P, const bf16* KC, const bf16* VC, bf16* O) {
    for (int un2 = 2 * F.bid; un2 < 512; un2 += 2 * F.G)
#pragma unroll 1
        for (int k = 0; k < 2; ++k) { const int un = un2 >> 1, ip = un & 15, g = (un >> 4) & 1, b = un >> 5; nsa_unit(F, P, KC, VC, O, b, g, k == 0 ? 31 - ip : ip); }
}

__device__ __forceinline__ void moba_unit(const Frame& F, const bf16* P, const float* KM, bf16* O  , int b, int h, int qb) {
    LAS unsigned char* ring = F.lds;
    LAS float* kml = (LAS float*)(F.lds + 2 * KV_BUF);
    LAS unsigned* uni = (LAS unsigned*)(F.lds + 2 * KV_BUF + 2048);
    const int lane = F.lane, r32 = lane & 31, hi = lane >> 5;
    const int tl = 32 * F.wave + r32;
    const size_t row = (size_t)b * SEQ + 256 * qb + tl;
    bf16x8 qr[4];
#pragma unroll
    for (int d = 0; d < 4; ++d) qr[d] = *(const bf16x8*)(P + row * NP1 + C_DQ + h * 64 + d * 16 + hi * 8);
    __syncthreads();
    { const int blk = F.tid >> 6, p = F.tid & 63; kml[F.tid] = KM[((size_t)(b * 8 + blk) * 8 + h) * 64 + p]; if (F.tid == 0) uni[0] = 0u; }
    __syncthreads();
    unsigned mymask = 0u;
    if (qb > 0) {
        float gt[8];
#pragma unroll
        for (int n = 0; n < 8; ++n) { float a = 0.f;
#pragma unroll
            for (int d = 0; d < 4; ++d) { const v4u qw = __builtin_bit_cast(v4u, qr[d]); const LAS float* km = kml + n * 64 + d * 16 + hi * 8;
                a += bflo(qw.x) * km[0] + bfhi(qw.x) * km[1] + bflo(qw.y) * km[2] + bfhi(qw.y) * km[3] + bflo(qw.z) * km[4] + bfhi(qw.z) * km[5] + bflo(qw.w) * km[6] + bfhi(qw.w) * km[7]; }
            a = add32(a); gt[n] = a; }
#pragma unroll
        for (int n = 0; n < 8; ++n) { int rank = 0;
#pragma unroll
            for (int m = 0; m < 8; ++m) rank += (m < qb && m != n && (gt[m] > gt[n] || (gt[m] == gt[n] && m < n))) ? 1 : 0;
            if (n < qb && rank < 3) mymask |= 1u << n; }
        atomicOr((unsigned*)uni, mymask);
    }
    __syncthreads();
    const unsigned um = uni[0];
    AttnState st; attn_reset(st);
    const bf16* Kg = P + (size_t)b * SEQ * NP1 + C_DK + h * 64; const bf16* Vg = P + (size_t)b * SEQ * NP1 + C_DV + h * 64;
#define MOBA_SKIP(j) ((j) < 4 * qb && !((um >> ((j) >> 2)) & 1u))
#define MOBA_RANGE(j, kmin, kmax) do { kmin = 0; if ((j) < 4 * qb) kmax = ((mymask >> ((j) >> 2)) & 1u) ? 63 : -1; else { const int d_ = tl - 64 * ((j) - 4 * qb); kmax = d_ < 63 ? d_ : 63; } } while (0)
    ATTN_STREAM(Kg, Vg, (size_t)NP1, 0, 4 * qb + 4, MOBA_SKIP, MOBA_RANGE);
#undef MOBA_SKIP
#undef MOBA_RANGE
    const float sc = attn_inv_l(st);
    bf16* orow = O + row * 512 + h * 64;
#pragma unroll
    for (int gq = 0; gq < 4; ++gq) {
        v2u w0; w0.x = pk2(st.o0[4 * gq] * sc, st.o0[4 * gq + 1] * sc); w0.y = pk2(st.o0[4 * gq + 2] * sc, st.o0[4 * gq + 3] * sc); *(v2u*)(orow + 8 * gq + 4 * hi) = w0;
        v2u w1; w1.x = pk2(st.o1[4 * gq] * sc, st.o1[4 * gq + 1] * sc); w1.y = pk2(st.o1[4 * gq + 2] * sc, st.o1[4 * gq + 3] * sc); *(v2u*)(orow + 32 + 8 * gq + 4 * hi) = w1; }
}
__device__ __forceinline__ void phase_moba(const Frame& F, const bf16* P, const float* KM, bf16* O) {
    for (int un2 = 2 * F.bid; un2 < 512; un2 += 2 * F.G)
#pragma unroll 1
        for (int k = 0; k < 2; ++k) { const int un = un2 >> 1, qp = un & 3, h = (un >> 2) & 7, b = un >> 5; moba_unit(F, P, KM, O, b, h, k == 0 ? 7 - qp : qp); }
}

__device__ __forceinline__ unsigned ord_key(float x) { const unsigned u = __builtin_bit_cast(unsigned, x); return (u & 0x80000000u) ? ~u : (u | 0x80000000u); }
__device__ __forceinline__ float ord_val(unsigned k) { const unsigned u = (k & 0x80000000u) ? (k & 0x7fffffffu) : ~k; return __builtin_bit_cast(float, u); }
constexpr int SK_STRIDE = 272;
__device__ __forceinline__ void peer_route_unit(const Frame& F, const bf16* Q2, const bf16* SUBK  , int* EIDX, float* EW, int tb, int h) {
    LAS unsigned char* skl = F.lds;
    LAS unsigned* slot = (LAS unsigned*)(F.lds + 36864) + F.tid;
    const int lane = F.lane, r32 = lane & 31, hi = lane >> 5;
    const size_t tok = (size_t)tb * 256 + F.wave * 32 + r32;
#pragma unroll 1
    for (int p = 0; p < 2; ++p) {
        __syncthreads();
        for (int i = F.tid; i < 128 * 16; i += NTHR) { const int ch = i & 15, rowi = i >> 4;
            *(LAS v4u*)(skl + rowi * SK_STRIDE + ch * 16) = *(const v4u*)(SUBK + ((size_t)h * 256 + p * 128 + rowi) * 128 + ch * 8); }
        __syncthreads();
        bf16x8 qf[8]; float ss = 0.f;
#pragma unroll
        for (int s = 0; s < 8; ++s) { qf[s] = *(const bf16x8*)(Q2 + tok * 2048 + h * 256 + p * 128 + s * 16 + hi * 8); const v4u w = __builtin_bit_cast(v4u, qf[s]);
            const float a0 = bflo(w.x), a1 = bfhi(w.x), a2 = bflo(w.y), a3 = bfhi(w.y), a4 = bflo(w.z), a5 = bfhi(w.z), a6 = bflo(w.w), a7 = bfhi(w.w);
            ss += (a0 * a0 + a1 * a1) + (a2 * a2 + a3 * a3) + (a4 * a4 + a5 * a5) + (a6 * a6 + a7 * a7); }
        ss = add32(ss);
        const float rn = 1.0f / sqrtf(ss * (1.0f / 128.0f) + NORM_EPS);
        unsigned key[64];
#pragma unroll
        for (int nb = 0; nb < 4; ++nb) { f32x16 acc;
#pragma unroll
            for (int r = 0; r < 16; ++r) acc[r] = 0.f;
#pragma unroll
            for (int s = 0; s < 8; ++s) { const bf16x8 a = *(LAS const bf16x8*)(skl + (nb * 32 + r32) * SK_STRIDE + (2 * s + hi) * 16);
                acc = __builtin_amdgcn_mfma_f32_32x32x16_bf16(a, qf[s], acc, 0, 0, 0); }
#pragma unroll
            for (int r = 0; r < 16; ++r) { const int n = nb * 32 + crow(r, hi); key[nb * 16 + r] = (ord_key(acc[r] * rn) & 0xffffff80u) | (unsigned)(127 - n); } }
#pragma unroll 1
        for (int k = 0; k < 16; ++k) { unsigned m = key[0];
#pragma unroll
            for (int e = 1; e < 64; ++e) m = m > key[e] ? m : key[e];
            m = umax32(m);
            slot[(p * 16 + k) * 512] = m;
#pragma unroll
            for (int e = 0; e < 64; ++e) key[e] = key[e] == m ? 0u : key[e]; }
    }
    LDS_WAIT(); asm volatile("" ::: "memory");
    unsigned ck[50];
    { float v1[16], v2[16];
#pragma unroll
      for (int k = 0; k < 16; ++k) { v1[k] = ord_val(slot[k * 512] & 0xffffff80u); v2[k] = ord_val(slot[(16 + k) * 512] & 0xffffff80u); }
      int c = 0;
#pragma unroll
      for (int a = 0; a < 16; ++a)
#pragma unroll
          for (int bq = 0; bq < 16; ++bq) if ((a + 1) * (bq + 1) <= 16) { ck[c] = (ord_key(v1[a] + v2[bq]) & 0xffffff00u) | (unsigned)(255 - (16 * a + bq)); ++c; } }
    float den = 0.f, mx = 0.f;
#pragma unroll 1
    for (int k = 0; k < 16; ++k) { unsigned m = ck[0];
#pragma unroll
        for (int e = 1; e < 50; ++e) m = m > ck[e] ? m : ck[e];
#pragma unroll
        for (int e = 0; e < 50; ++e) ck[e] = ck[e] == m ? 0u : ck[e];
        const int ci = 255 - (int)(m & 255u), a = ci >> 4, bq = ci & 15;
        const unsigned ka = slot[a * 512], kb = slot[(16 + bq) * 512];
        const int te = (127 - (int)(ka & 127u)) * 128 + (127 - (int)(kb & 127u));
        const float tvk = ord_val(m & 0xffffff00u);
        if (k == 0) mx = tvk;
        const float ek = __expf(tvk - mx); den += ek;
        slot[(32 + k) * 512] = __builtin_bit_cast(unsigned, ek);
        if (hi == 0) EIDX[(tok * 8 + h) * 16 + k] = te; }
    LDS_WAIT(); asm volatile("" ::: "memory");
    if (hi == 0) { const float inv = 1.0f / den; float* ewp = EW + (tok * 8 + h) * 16;
#pragma unroll
        for (int q = 0; q < 4; ++q) *(f32x4*)(ewp + 4 * q) = (f32x4){__builtin_bit_cast(float, slot[(32 + 4 * q) * 512]), __builtin_bit_cast(float, slot[(33 + 4 * q) * 512]),
                                                                      __builtin_bit_cast(float, slot[(34 + 4 * q) * 512]), __builtin_bit_cast(float, slot[(35 + 4 * q) * 512])} * inv; }
}

__device__ __forceinline__ void phase_peer_route(const Frame& F, const bf16* Q2, const bf16* SUBK, int* EIDX, float* EW) {
    for (int un = F.bid; un < 64 * 8; un += F.G) peer_route_unit(F, Q2, SUBK, EIDX, EW, un >> 3, un & 7);
}

__device__ __forceinline__ void phase_peer_tables(const Frame& F, const float* U, const float* V, unsigned char* UT8, unsigned char* VT8, float* SU, float* SV) {
    const int gw = gwave(F), NGW = ngwave(F), lane = F.lane;
    for (int r = gw; r < 2 * 16384; r += NGW) {
        const int tab = r >> 14, e = r & 16383; const float* src = (tab ? V : U) + (size_t)e * DM + 16 * lane;
        f32x4 x[4]; float mx = 0.f;
#pragma unroll
        for (int q = 0; q < 4; ++q) { x[q] = *(const f32x4*)(src + 4 * q); mx = fmaxf(fmaxf(mx, fmaxf(fabsf(x[q][0]), fabsf(x[q][1]))), fmaxf(fabsf(x[q][2]), fabsf(x[q][3]))); }
#pragma unroll
        for (int o = 1; o < 32; o <<= 1) mx = fmaxf(mx, shx(mx, o, lane));
        mx = max32(mx);
        int ex = 0; (void)frexpf(mx, &ex);
        const int k = (mx > 0.f) ? (8 - ex) : 0;
        const float sc = __builtin_ldexpf(1.0f, k), inv = __builtin_ldexpf(1.0f, -k);
        v4u w;
#pragma unroll
        for (int q = 0; q < 4; ++q) { unsigned p = 0u; p = __builtin_amdgcn_cvt_pk_fp8_f32(x[q][0] * sc, x[q][1] * sc, p, false); p = __builtin_amdgcn_cvt_pk_fp8_f32(x[q][2] * sc, x[q][3] * sc, p, true); w[q] = p; }
        *(v4u*)((tab ? VT8 : UT8) + ((size_t)(lane >> 3) * 16384 + e) * 128 + (lane & 7) * 16) = w;
        if (lane == 0) (tab ? SV : SU)[e] = inv;
    }
}
typedef _Float16 h16x2 __attribute__((ext_vector_type(2)));
typedef __fp16 fp16x2_t __attribute__((ext_vector_type(2)));
__device__ __forceinline__ void phase_peer_u(const Frame& F, const bf16* H2, const unsigned char* UT8, const float* SU, const int* EIDX, float* PART, unsigned emask = 0x3fffu) {
    const int lane = F.lane, g = lane >> 3, sub = lane & 7, b0 = lane & 1, b1 = (lane >> 1) & 1, b2 = (lane >> 2) & 1;
    const int s = F.bid >> 5, wgq = F.bid & 31, nq = F.G >> 3;
    LAS int* il = (LAS int*)(F.lds + F.wave * 8192);
    LAS float* pcl = (LAS float*)(F.lds + F.wave * 8192 + 4096);
    const unsigned char* ub = UT8 + (size_t)s * 16384 * 128 + sub * 16;
    for (int batch = wgq * 8 + F.wave; batch < TOK / 8; batch += nq * 8) {
        const int t0 = batch * 8, t = t0 + g;
        { const v4u* src = (const v4u*)(EIDX + (size_t)t0 * 128 + lane * 16);
          const v4u i0 = src[0], i1 = src[1], i2 = src[2], i3 = src[3];
          LAS v4u* dst = (LAS v4u*)(il + lane * 16); dst[0] = i0 & emask; dst[1] = i1 & emask; dst[2] = i2 & emask; dst[3] = i3 & emask; }
        h16x2 h[8];
        { const v4u ha = *(const v4u*)(H2 + (size_t)t * DM + s * 128 + sub * 16), hb = *(const v4u*)(H2 + (size_t)t * DM + s * 128 + sub * 16 + 8);
          h[0] = (h16x2){(_Float16)bflo(ha.x), (_Float16)bfhi(ha.x)}; h[1] = (h16x2){(_Float16)bflo(ha.y), (_Float16)bfhi(ha.y)}; h[2] = (h16x2){(_Float16)bflo(ha.z), (_Float16)bfhi(ha.z)}; h[3] = (h16x2){(_Float16)bflo(ha.w), (_Float16)bfhi(ha.w)};
          h[4] = (h16x2){(_Float16)bflo(hb.x), (_Float16)bfhi(hb.x)}; h[5] = (h16x2){(_Float16)bflo(hb.y), (_Float16)bfhi(hb.y)}; h[6] = (h16x2){(_Float16)bflo(hb.z), (_Float16)bfhi(hb.z)}; h[7] = (h16x2){(_Float16)bflo(hb.w), (_Float16)bfhi(hb.w)}; }
        LDS_WAIT(); asm volatile("" ::: "memory");
#define PU_LOAD(c, ua, su_) do { const v4u ia = *(LAS v4u*)(il + g * 128 + (c) * 8), ib = *(LAS v4u*)(il + g * 128 + (c) * 8 + 4); \
            ua[0] = *(const v4u*)(ub + (size_t)ia.x * 128); ua[1] = *(const v4u*)(ub + (size_t)ia.y * 128); ua[2] = *(const v4u*)(ub + (size_t)ia.z * 128); ua[3] = *(const v4u*)(ub + (size_t)ia.w * 128); \
            ua[4] = *(const v4u*)(ub + (size_t)ib.x * 128); ua[5] = *(const v4u*)(ub + (size_t)ib.y * 128); ua[6] = *(const v4u*)(ub + (size_t)ib.z * 128); ua[7] = *(const v4u*)(ub + (size_t)ib.w * 128); \
            su_ = SU[il[g * 128 + (c) * 8 + sub]]; } while (0)
#define PU_COMP(c, ua, su_) do { float a[8]; \
            _Pragma("unroll") for (int j = 0; j < 8; ++j) { float acc = 0.f; \
                _Pragma("unroll") for (int q = 0; q < 4; ++q) { acc = __builtin_amdgcn_fdot2(__builtin_bit_cast(h16x2, __builtin_amdgcn_cvt_scalef32_pk_f16_fp8(ua[j][q], 1.0f, false)), h[2 * q], acc, false); \
                    acc = __builtin_amdgcn_fdot2(__builtin_bit_cast(h16x2, __builtin_amdgcn_cvt_scalef32_pk_f16_fp8(ua[j][q], 1.0f, true)), h[2 * q + 1], acc, false); } \
                a[j] = acc; } \
            float bq[4], cc[2]; \
            _Pragma("unroll") for (int p = 0; p < 4; ++p) { const float keep = b0 ? a[2 * p + 1] : a[2 * p], send = b0 ? a[2 * p] : a[2 * p + 1]; bq[p] = keep + shx(send, 1, lane); } \
            _Pragma("unroll") for (int q = 0; q < 2; ++q) { const float keep = b1 ? bq[2 * q + 1] : bq[2 * q], send = b1 ? bq[2 * q] : bq[2 * q + 1]; cc[q] = keep + shx(send, 2, lane); } \
            { const float keep = b2 ? cc[1] : cc[0], send = b2 ? cc[0] : cc[1]; pcl[(c) * 64 + lane] = (keep + shx(send, 4, lane)) * su_; } } while (0)
        { v4u uA[8], uB[8]; float sA, sB;
          PU_LOAD(0, uA, sA);
#pragma unroll 1
          for (int c = 0; c < 16; c += 2) {
              PU_LOAD(c + 1, uB, sB);
              PU_COMP(c, uA, sA);
              if (c + 2 < 16) PU_LOAD(c + 2, uA, sA);
              PU_COMP(c + 1, uB, sB);
          } }
#undef PU_LOAD
#undef PU_COMP
        LDS_WAIT(); asm volatile("" ::: "memory");
        float* dst = PART + ((size_t)s * TOK + t) * 128 + sub;
#pragma unroll
        for (int c = 0; c < 16; ++c) dst[8 * c] = pcl[c * 64 + lane];
        LDS_WAIT(); asm volatile("" ::: "memory");
    }
}
__device__ __forceinline__ float gelu_as(float v) {
    const float av = fabsf(v), t = __builtin_amdgcn_rcpf(av * 0.2316418882f + 1.0f);
    float q = t * 0.5307027145f + (-0.7265760135f); q = q * t + 0.7107068705f; q = q * t + (-0.142248368f); q = q * t + 0.127414796f; q = q * t;
    const float m = v * (q * __builtin_amdgcn_exp2f((v * v) * (-0.72134752044f)));
    return v < 0.f ? m : v - m;
}
__device__ __forceinline__ void phase_peer_w(const Frame& F, const float* SV, const int* EIDX, const float* EW, const float* PART, v2u* COEF) {
    const int nth = F.G * NTHR;
    for (int i = F.bid * NTHR + F.tid; i < TOK * 128; i += nth) {
        float act = 0.f;
#pragma unroll
        for (int sp = 0; sp < 8; ++sp) act += PART[(size_t)sp * TOK * 128 + i];
        const int e = EIDX[i]; const float c = EW[i] * gelu_as(act) * SV[e];
        COEF[i] = (v2u){(unsigned)e, __builtin_bit_cast(unsigned, c)};
    }
}
__device__ __forceinline__ void phase_peer_v(const Frame& F, const unsigned char* VT8, const v2u* COEF, float* XB, const float* gate, unsigned emask = 0x3fffu) {
    const int lane = F.lane, g = lane >> 3, sub = lane & 7;
    const int s = F.bid >> 5, wgq = F.bid & 31, nq = F.G >> 3;
    LAS v2u* wl = (LAS v2u*)(F.lds + F.wave * 8192);
    const unsigned char* vb = VT8 + (size_t)s * 16384 * 128 + sub * 16;
    for (int batch = wgq * 8 + F.wave; batch < TOK / 8; batch += nq * 8) {
        const int t0 = batch * 8, t = t0 + g;
        { const v4u* src = (const v4u*)(COEF + (size_t)t0 * 128) + lane * 8;
          v4u c[8];
#pragma unroll
          for (int q = 0; q < 8; ++q) c[q] = src[q];
          LAS v4u* dst = (LAS v4u*)wl + lane * 8;
#pragma unroll
          for (int q = 0; q < 8; ++q) { v4u x = c[q]; x.x &= emask; x.z &= emask; dst[q] = x; } }
        LDS_WAIT(); asm volatile("" ::: "memory");
        h16x2 o[8];
#pragma unroll
        for (int q = 0; q < 8; ++q) o[q] = (h16x2){(_Float16)0.f, (_Float16)0.f};
#define PV_LOAD(c, pr, va) do { \
            _Pragma("unroll") for (int q = 0; q < 4; ++q) pr[q] = *(LAS v4u*)(wl + g * 128 + (c) * 8 + 2 * q); \
            _Pragma("unroll") for (int q = 0; q < 4; ++q) { va[2 * q] = *(const v4u*)(vb + (size_t)pr[q].x * 128); va[2 * q + 1] = *(const v4u*)(vb + (size_t)pr[q].z * 128); } } while (0)
#define PV_COMP(pr, va) do { \
            _Pragma("unroll") for (int j = 0; j < 8; ++j) { const unsigned cb = (j & 1) ? pr[j >> 1].w : pr[j >> 1].y; \
                const float s2 = __builtin_bit_cast(float, cb & 0x7f800000u); const _Float16 mh = (_Float16)__builtin_bit_cast(float, (cb & 0x807fffffu) | 0x3f800000u); const h16x2 m2 = (h16x2){mh, mh}; \
                _Pragma("unroll") for (int q = 0; q < 4; ++q) { o[2 * q] = __builtin_elementwise_fma(__builtin_bit_cast(h16x2, __builtin_amdgcn_cvt_scalef32_pk_f16_fp8(va[j][q], s2, false)), m2, o[2 * q]); \
                    o[2 * q + 1] = __builtin_elementwise_fma(__builtin_bit_cast(h16x2, __builtin_amdgcn_cvt_scalef32_pk_f16_fp8(va[j][q], s2, true)), m2, o[2 * q + 1]); } } } while (0)
        { v4u pA[4], pB[4], vA[8], vB[8];
          PV_LOAD(0, pA, vA);
#pragma unroll 1
          for (int c = 0; c < 16; c += 2) {
              PV_LOAD(c + 1, pB, vB);
              PV_COMP(pA, vA);
              if (c + 2 < 16) PV_LOAD(c + 2, pA, vA);
              PV_COMP(pB, vB);
          } }
#undef PV_LOAD
#undef PV_COMP
        const int bb = t / SEQ; float* xr = XB + (size_t)t * DM + s * 128 + sub * 16; const float* gr = gate + (size_t)bb * 6144 + s * 128 + sub * 16;
#pragma unroll
        for (int q = 0; q < 4; ++q) { const f32x4 x = *(const f32x4*)(xr + 4 * q), gg = *(const f32x4*)(gr + 4 * q);
            *(f32x4*)(xr + 4 * q) = x + gg * (f32x4){(float)o[2 * q].x, (float)o[2 * q].y, (float)o[2 * q + 1].x, (float)o[2 * q + 1].y}; }
        LDS_WAIT(); asm volatile("" ::: "memory");
    }
}

constexpr int NPL = 14, NPHASE = 1 + DEPTH * NPL + 1;
constexpr int CW_BAR = 1024;
static_assert((CW_BAR + XCD_BAR_WORDS) * 4 <= (int)CTL_ZERO_BYTES, "barrier words inside the memset region");

__global__ void __launch_bounds__(NTHR, 2) hybrid_fwd(Args args) {
    extern __shared__ __attribute__((aligned(16))) unsigned char lds[];
    Frame F;
    F.lds = (LAS unsigned char*)lds; F.ldsg = lds;
    F.tid = threadIdx.x; F.lane = F.tid & 63; F.wave = __builtin_amdgcn_readfirstlane(F.tid >> 6);
    F.G = gridDim.x; F.bid = blockIdx.x; F.ws = args.ws;
    GAS unsigned char* wsg = (GAS unsigned char*)args.ws;
#define WSP ((unsigned char*)wsg)
    volatile LAS unsigned* MISC = (volatile LAS unsigned*)(F.lds + MISC_OFF);
    for (int u = F.tid; u < 64; u += NTHR) ((LAS unsigned*)(F.lds + MISC_OFF))[u] = 0u;
    __syncthreads();
    XcdBarrier bar; bar.bar = (unsigned*)(WSP + WS_CTL) + CW_BAR; bar.x = 0; bar.st = nullptr;
    const int lo = args.ph_lo, hi = args.ph_hi;
    if (hi - lo > 1) bar = xcd_barrier_post((unsigned*)(WSP + WS_CTL) + CW_BAR, MISC + 8);
#ifndef PHMASK
#define PHMASK 0xffffffffu
#endif
#define PM(j) ((PHMASK >> (j)) & 1u)
#ifndef DUMMY_EMASK
#define DUMMY_EMASK 0x3fffu
#endif
#ifndef RPMASK
#define RPMASK 0u
#endif
#define RP(j) for (int rp_ = 0; rp_ < 1 + (int)((RPMASK >> (j)) & 1u); ++rp_)
#define LASTRP(j) (rp_ == (int)((RPMASK >> (j)) & 1u))
#define IN(k) (lo <= (k) && (k) < hi)
#define SEAM(k) do { if (IN(k) && IN((k) + 1)) { xcd_barrier(bar); if ((RPMASK >> 30) & 1u) xcd_barrier(bar); } } while (0)

    typedef __attribute__((address_space(4))) const Args* KArgs;
    KArgs ap = (KArgs)__builtin_amdgcn_kernarg_segment_ptr();
#define FRESH() asm volatile("" : "+s"(ap), "+s"(wsg)); Frame Fp = F; asm volatile("" : "+v"(Fp.tid)); Fp.lane = Fp.tid & 63; asm volatile("" : "+s"(Fp.wave), "+s"(Fp.bid), "+s"(Fp.G)); Fp.ws = WSP; LAS unsigned char* ring = Fp.lds; asm volatile("" : "+s"(ring)); Fp.lds = ring
#define INP(i) ((const float*)(GAS const float*)ap->in[i])
#define WIN_ ((bf16*)(WSP + WS_WIN))
#define WOUT_ ((bf16*)(WSP + WS_WOUT))
#define WOT_ ((bf16*)(WSP + WS_WO))
#define WQT_ ((bf16*)(WSP + WS_WQ))
#define W1T_ ((bf16*)(WSP + WS_W1T))
#define SUBK_ ((bf16*)(WSP + WS_SUBK))
#define W2T_ ((bf16*)(WSP + WS_SMALL + SM_W2T))
#define MOD_ ((float*)(WSP + WS_MOD))
#define COS_ ((const float*)(WSP + WS_COS))
#define SIN_ ((const float*)(WSP + WS_SIN))
#define KMEAN_ ((float*)(WSP + WS_SMALL + SM_KMEAN))
#define KCMP_ ((bf16*)(WSP + WS_SMALL + SM_KCMP))
#define VCMP_ ((bf16*)(WSP + WS_SMALL + SM_VCMP))
#define PBP_ ((float*)(WSP + WS_SMALL + SM_PBP))
#define EIDX_ ((int*)(WSP + WS_EIDX))
#define EW_ ((float*)(WSP + WS_EW))
#define HN_ ((bf16*)(WSP + WS_HN))
#define MIX_ ((bf16*)(WSP + WS_MIX))
#define PROJ_ ((bf16*)(WSP + WS_BIG))
#define GATES_ ((bf16*)(WSP + WS_BIG))
#define UT_ ((unsigned char*)(WSP + WS_BIG))
#define VT_ ((unsigned char*)(WSP + WS_BIG + 16 * MiB))
#define SU_ ((float*)(WSP + WS_BIG + 32 * MiB))
#define SV_ ((float*)(WSP + WS_BIG + 32 * MiB + 65536))
#define COEF_ ((v2u*)(WSP + WS_BIG + 33 * MiB))
#define Q2_ ((bf16*)(WSP + WS_BIG + 64 * MiB))
#define PART_ ((float*)(WSP + WS_BIG + 64 * MiB))
#define XB_ ((float*)(GAS float*)ap->out)
#define MODL_ (MOD_ + (size_t)l * 8 * 6144)
#define XIN_ ((l == 0) ? INP(I_X) : (const float*)XB_)

    if (PM(0) && IN(0)) RP(0) { FRESH(); phase_prologue(Fp, ap); }
    SEAM(0);
#pragma unroll 1
    for (int l = 0; l < DEPTH; ++l) {
        const int p0 = 1 + l * NPL;
        if (PM(1) && IN(p0 + 0)) RP(1) { FRESH(); phase_norm_mod(Fp, XIN_, INP(I_NMG) + l * DM, MODL_ + 0, MODL_ + 1024, HN_); }
        SEAM(p0 + 0);
        if (PM(2) && IN(p0 + 1)) RP(2) { FRESH(); pg8::Gemm g{HN_, WIN_ + (size_t)l * NWIN * DM, TOK, NP1, DM}; pg8::StaticOrder S; S.init(TOK, NP1, Fp.G, Fp.bid);
            epi::EpiProj1 E{PROJ_, COS_, SIN_}; pg8::gemm_phase<epi::EpiProj1, pg8::StaticOrder, true, true>(ring, g, S, E, Fp.tid); }
        SEAM(p0 + 1);
        if (PM(3) && IN(p0 + 2)) RP(3) {
            { FRESH(); phase_compress(Fp, PROJ_, W1T_ + (size_t)l * 2 * 128 * 2048, W2T_ + (size_t)l * 2 * 64 * 128, PBP_ + (size_t)l * 2 * 16 * 128, KCMP_, VCMP_); }
            { FRESH(); phase_kmean(Fp, PROJ_, KMEAN_); }
            { FRESH(); phase_mixer_a(Fp, PROJ_, INP(I_ACW) + (size_t)l * 3 * 512, MIX_); }
            __syncthreads();
            { FRESH(); phase_mixer_b(Fp, PROJ_, INP(I_BCW) + (size_t)l * 31 * 512, INP(I_BCB) + l * 512, INP(I_BLNG) + l * 512, INP(I_BLNB) + l * 512, MIX_ + (size_t)TOK * 512); }
            __syncthreads();
        }
        SEAM(p0 + 2);
        if (PM(4) && IN(p0 + 3)) RP(4) { FRESH(); phase_nsa(Fp, PROJ_, KCMP_, VCMP_, MIX_ + (size_t)2 * TOK * 512); __syncthreads(); }
        SEAM(p0 + 3);
        if (PM(5) && IN(p0 + 4)) RP(5) { FRESH(); phase_moba(Fp, PROJ_, KMEAN_, MIX_ + (size_t)3 * TOK * 512); __syncthreads(); }
        SEAM(p0 + 4);
        if (PM(6) && IN(p0 + 5)) RP(6) { FRESH(); pg8::Gemm g{HN_, WIN_ + ((size_t)l * NWIN + NP1) * DM, TOK, NGT, DM}; pg8::StaticOrder S; S.init(TOK, NGT, Fp.G, Fp.bid);
            epi::EpiStore<1> E{GATES_, NGT}; pg8::gemm_phase<epi::EpiStore<1>, pg8::StaticOrder, true, true>(ring, g, S, E, Fp.tid); }
        SEAM(p0 + 5);
        if (PM(7) && IN(p0 + 6)) RP(7) {
#pragma unroll 1
            for (int seg = 0; seg < 4; ++seg) { FRESH(); pg8::Gemm g{MIX_ + (size_t)seg * TOK * 512, WOUT_ + (size_t)(l * 4 + seg) * DM * 512, TOK, DM, 512}; pg8::StaticOrder S; S.init(TOK, DM, Fp.G, Fp.bid);
                epi::EpiMerge E{HN_, GATES_, seg}; pg8::gemm_phase<epi::EpiMerge, pg8::StaticOrder, true, true>(ring, g, S, E, Fp.tid); }
        }
        SEAM(p0 + 6);
        if (PM(8) && IN(p0 + 7)) RP(8) { FRESH(); pg8::Gemm g{HN_, WOT_ + (size_t)l * DM * DM, TOK, DM, DM}; pg8::StaticOrder S; S.init(TOK, DM, Fp.G, Fp.bid);
            epi::EpiResid E{XIN_, LASTRP(8) ? XB_ : (float*)MIX_, MODL_ + 2048}; pg8::gemm_phase<epi::EpiResid, pg8::StaticOrder, true, true>(ring, g, S, E, Fp.tid); }
        SEAM(p0 + 7);
        if (PM(9) && IN(p0 + 8)) RP(9) {
            { FRESH(); phase_norm_mod(Fp, XB_, INP(I_NFG) + l * DM, MODL_ + 3072, MODL_ + 4096, HN_); }
            { FRESH(); phase_peer_tables(Fp, INP(I_PU) + (size_t)l * 16384 * DM, INP(I_PV) + (size_t)l * 16384 * DM, UT_, VT_, SU_, SV_); }
        }
        SEAM(p0 + 8);
        if (PM(10) && IN(p0 + 9)) RP(10) { FRESH(); pg8::Gemm g{HN_, WQT_ + (size_t)l * 2048 * DM, TOK, 2048, DM}; pg8::StaticOrder S; S.init(TOK, 2048, Fp.G, Fp.bid);
            epi::EpiStore<0> E{Q2_, 2048}; pg8::gemm_phase<epi::EpiStore<0>, pg8::StaticOrder, true, true>(ring, g, S, E, Fp.tid); }
        SEAM(p0 + 9);
        if (PM(11) && IN(p0 + 10)) RP(11) { FRESH(); phase_peer_route(Fp, Q2_, SUBK_ + (size_t)l * 8 * 2 * 128 * 128, EIDX_, EW_); __syncthreads(); }
        SEAM(p0 + 10);
        if (PM(12) && IN(p0 + 11)) RP(12) { FRESH(); phase_peer_u(Fp, HN_, UT_, SU_, EIDX_, LASTRP(12) ? PART_ : (float*)MIX_, LASTRP(12) ? 0x3fffu : DUMMY_EMASK); }
        SEAM(p0 + 11);
        if (PM(12) && IN(p0 + 12)) { FRESH(); phase_peer_w(Fp, SV_, EIDX_, EW_, PART_, COEF_); }
        SEAM(p0 + 12);
        if (PM(12) && IN(p0 + 13)) RP(14) { FRESH(); phase_peer_v(Fp, VT_, COEF_, LASTRP(14) ? XB_ : (float*)MIX_, MODL_ + 5120, LASTRP(14) ? 0x3fffu : DUMMY_EMASK); }
        SEAM(p0 + 13);
    }
    if (PM(13) && IN(NPHASE - 1)) { FRESH(); phase_final_norm(Fp, XB_, INP(I_FNG), XB_); }
#ifdef DBG_STOP
    if (IN(NPHASE)) { FRESH();
        const bf16* src = (const bf16*)(WSP + (size_t)DBG_OFF); const size_t n = (size_t)DBG_BYTES / 2, NO = (size_t)TOK * DM; float* o = (float*)ap->out;
        for (size_t i = (size_t)Fp.bid * NTHR + Fp.tid; i < NO; i += (size_t)Fp.G * NTHR) { float a = 0.f; for (size_t j = i; j < n; j += NO) a += bf2f(src[j]);
#ifdef DBG_OFF2
            { const float* s2 = (const float*)(WSP + (size_t)DBG_OFF2); const size_t n2 = (size_t)DBG_BYTES2 / 4; for (size_t j = i; j < n2; j += NO) a += s2[j]; }
#endif
            if (!(a == a) || fabsf(a) > 1e30f) a = 12345.0f;
            o[i] = a; } }
#endif
#undef IN
#undef SEAM
#undef WSP
}

extern "C" void kernel_launch(void* const* d_in, const int* in_sizes, int n_in, void* d_out, int out_size, void* d_ws, size_t ws_size, hipStream_t stream) {
    static int grid = 0;
    if (grid == 0) {
        if (n_in != 26 || in_sizes[0] != TOK * DM || out_size != TOK * DM || ws_size < WS_END) {
            fprintf(stderr, "kernel_launch: unexpected problem (n_in %d, in0 %d, out %d, WSP %zu); nothing launched\n", n_in, n_in > 0 ? in_sizes[0] : -1, out_size, ws_size); grid = -1; return; }
        int dev = 0, cus = 0, per_cu = 0;
        if (hipGetDevice(&dev) != hipSuccess || hipDeviceGetAttribute(&cus, hipDeviceAttributeMultiprocessorCount, dev) != hipSuccess) { grid = -1; return; }
        if (hipFuncSetAttribute((const void*)hybrid_fwd, hipFuncAttributeMaxDynamicSharedMemorySize, LDS_BYTES) != hipSuccess) { fprintf(stderr, "kernel_launch: hipFuncSetAttribute failed\n"); grid = -1; return; }
        if (hipOccupancyMaxActiveBlocksPerMultiprocessor(&per_cu, (const void*)hybrid_fwd, NTHR, LDS_BYTES) != hipSuccess || per_cu < 1)
            fprintf(stderr, "kernel_launch: note: occupancy query reports %d workgroups per CU\n", per_cu);
        (void)hipGetLastError();
        grid = cus;
    }
    if (grid < 0) return;
    if (hipMemsetAsync((char*)d_ws + WS_CTL, 0, CTL_ZERO_BYTES, stream) != hipSuccess) return;
    Args a{};
    for (int i = 0; i < 26; ++i) a.in[i] = d_in[i];
    a.out = (float*)d_out; a.ws = (unsigned char*)d_ws;
#if MK_PER_PHASE
#ifdef DBG_STOP
    for (int p = 0; p <= DBG_STOP; ++p) { a.ph_lo = p; a.ph_hi = p + 1; hipLaunchKernelGGL(hybrid_fwd, dim3(grid), dim3(NTHR), LDS_BYTES, stream, a); }
    a.ph_lo = NPHASE; a.ph_hi = NPHASE + 1; hipLaunchKernelGGL(hybrid_fwd, dim3(grid), dim3(NTHR), LDS_BYTES, stream, a);
#else
    for (int p = 0; p < NPHASE; ++p) { a.ph_lo = p; a.ph_hi = p + 1; hipLaunchKernelGGL(hybrid_fwd, dim3(grid), dim3(NTHR), LDS_BYTES, stream, a); }
#endif
#else
    a.ph_lo = 0; a.ph_hi = NPHASE; hipLaunchKernelGGL(hybrid_fwd, dim3(grid), dim3(NTHR), LDS_BYTES, stream, a);
#endif
    const hipError_t le = hipPeekAtLastError();
    if (le != hipSuccess) fprintf(stderr, "kernel_launch: launch failed: %s\n", hipGetErrorName(le));
}
```

```cpp
#include <hip/hip_runtime.h>
#include <hip/hip_bf16.h>
#include <cstdio>
#include <cstdint>
#include <cmath>

#ifndef MK_PER_PHASE
#define MK_PER_PHASE 0
#endif

#define DUMMY_EMASK 0x3fffu
#define RPMASK 0x0u
#define GAS __attribute__((address_space(1)))
#define LAS __attribute__((address_space(3)))
typedef unsigned short bf16;
typedef unsigned v4u __attribute__((ext_vector_type(4)));
typedef unsigned v2u __attribute__((ext_vector_type(2)));
typedef float f32x4 __attribute__((ext_vector_type(4)));
typedef float f32x2 __attribute__((ext_vector_type(2)));
typedef float f32x16 __attribute__((ext_vector_type(16)));
typedef short bf16x8 __attribute__((ext_vector_type(8)));
typedef short s16x4 __attribute__((ext_vector_type(4)));
typedef __bf16 bf16x2_t __attribute__((ext_vector_type(2)));

constexpr int BATCH = 8, SEQ = 2048, DM = 1024, DEPTH = 2, TOK = BATCH * SEQ;
constexpr int NP1 = 5632;
constexpr int NGT = 4096;
constexpr int NWIN = NP1 + NGT;
constexpr int C_AB = 0, C_AC = 512, C_AX = 1024, C_BA = 1536, C_BG = 2048, C_CQ = 2560, C_KC = 3072, C_VC = 3200, C_KS = 3328, C_VS = 3456, C_KW = 3584, C_VW = 3712,
              C_DQ = 3840, C_DK = 4352, C_DV = 4864, C_CG = 5376;
constexpr float NORM_EPS = 1e-6f;
constexpr float QSCALE = 0.125f * 1.4426950408889634f;

constexpr size_t MiB = 1u << 20;
constexpr size_t WS_CTL = 0, CTL_ZERO_BYTES = 64 * 1024;
constexpr size_t WS_MOD = 1 * MiB;
constexpr size_t WS_COS = 2 * MiB, WS_SIN = 4 * MiB;
constexpr size_t WS_SMALL = 6 * MiB;
constexpr size_t SM_KMEAN = 704 * 1024;
constexpr size_t SM_KCMP = 64 * 1024;
constexpr size_t SM_VCMP = 320 * 1024;
constexpr size_t SM_PBP = 576 * 1024;
constexpr size_t SM_W2T = 640 * 1024;
constexpr size_t WS_EIDX = 8 * MiB;
constexpr size_t WS_EW = 16 * MiB;
constexpr size_t WS_WIN = 24 * MiB;
constexpr size_t WS_WOUT = 62 * MiB;
constexpr size_t WS_WO = 70 * MiB;
constexpr size_t WS_WQ = 74 * MiB;
constexpr size_t WS_W1T = 82 * MiB;
constexpr size_t WS_SUBK = 84 * MiB;
constexpr size_t WS_HN = 86 * MiB;
constexpr size_t WS_MIX = 118 * MiB;
constexpr size_t WS_BIG = 182 * MiB;
constexpr size_t WS_END = 358 * MiB;

constexpr int LDS_BYTES = 147456;
constexpr int RING_BYTES = 131072;
constexpr int MISC_OFF = LDS_BYTES - 256;

#define RLX_AGENT __ATOMIC_RELAXED, __HIP_MEMORY_SCOPE_AGENT
#define LDS_WAIT() asm volatile("s_waitcnt lgkmcnt(0)" ::: "memory")
#define VM_WAIT() asm volatile("s_waitcnt vmcnt(0)" ::: "memory")
__device__ __forceinline__ unsigned f2bf(float f) { unsigned u = __builtin_bit_cast(unsigned, f); return (u + 0x7fffu + ((u >> 16) & 1u)) >> 16; }
__device__ __forceinline__ float bf2f(unsigned h) { return __builtin_bit_cast(float, h << 16); }
__device__ __forceinline__ unsigned pk2(float lo, float hi) { f32x2 v = {lo, hi}; bf16x2_t b = __builtin_convertvector(v, bf16x2_t); return __builtin_bit_cast(unsigned, b); }
__device__ __forceinline__ float bflo(unsigned w) { return __builtin_bit_cast(float, w << 16); }
__device__ __forceinline__ float bfhi(unsigned w) { return __builtin_bit_cast(float, w & 0xffff0000u); }
__device__ __forceinline__ float sigmoidf_(float x) { return 1.0f / (1.0f + __expf(-x)); }
__device__ __forceinline__ float gelu_erf(float x) { return 0.5f * x * (1.0f + erff(x * 0.70710678118654752f)); }
__device__ __forceinline__ float shx(float v, int m, int lane) { return __builtin_bit_cast(float, __builtin_amdgcn_ds_bpermute((lane ^ m) << 2, __builtin_bit_cast(int, v))); }
__device__ __forceinline__ unsigned shxu(unsigned v, int m, int lane) { return (unsigned)__builtin_amdgcn_ds_bpermute((lane ^ m) << 2, (int)v); }
__device__ __forceinline__ void swap32(unsigned v, unsigned& r0, unsigned& r1) { unsigned b = v; asm volatile("" : "+v"(b)); auto r = __builtin_amdgcn_permlane32_swap(v, b, false, false); r0 = r[0]; r1 = r[1]; }
__device__ __forceinline__ float other32(float v, int hi) { unsigned r0, r1; swap32(__builtin_bit_cast(unsigned, v), r0, r1); return __builtin_bit_cast(float, hi ? r0 : r1); }
__device__ __forceinline__ float add32(float v) { unsigned r0, r1; swap32(__builtin_bit_cast(unsigned, v), r0, r1); return __builtin_bit_cast(float, r0) + __builtin_bit_cast(float, r1); }
__device__ __forceinline__ float max32(float v) { unsigned r0, r1; swap32(__builtin_bit_cast(unsigned, v), r0, r1); return fmaxf(__builtin_bit_cast(float, r0), __builtin_bit_cast(float, r1)); }
__device__ __forceinline__ unsigned umax32(unsigned v) { unsigned r0, r1; swap32(v, r0, r1); return r0 > r1 ? r0 : r1; }
__device__ __forceinline__ float wave_sum(float v, int lane) {
#pragma unroll
    for (int o = 1; o < 32; o <<= 1) v += shx(v, o, lane);
    return add32(v);
}
namespace pg8 {
#define PG8_LAS __attribute__((address_space(3)))
typedef unsigned short bf16_t;
typedef short bf16x8 __attribute__((ext_vector_type(8)));
typedef float f32x4 __attribute__((ext_vector_type(4)));
typedef unsigned u32x4 __attribute__((ext_vector_type(4)));
constexpr int BM = 256, BK = 64, HALF = 128, HTB = HALF * BK * 2  , STAGE_BYTES = 8 * HTB, NXCD = 8, WGM = 8;

__host__ __device__ __forceinline__ int lds_byte(int r, int c) { const int st = (r >> 4) * 2 + (c >> 5), rr = r & 15, cc = c & 31, ob = rr * 64 + cc * 2; return st * 1024 + (ob ^ (((ob >> 9) & 1) << 5)); }
__host__ __device__ __forceinline__ void stage_rc(int b, int& R, int& C) { const int st = b / 1024, sb = b % 1024, swz = sb ^ (((sb >> 9) & 1) << 5); R = (st >> 1) * 16 + swz / 64; C = (st & 1) * 32 + (swz % 64) / 2; }
__host__ __device__ __forceinline__ int perm32(int rho) { const int n = rho >> 4, i = rho & 15; return 8 * (i >> 2) + 4 * n + (i & 3); }

struct Unit { int pm, pn; };
struct Gemm { const bf16_t* A; const bf16_t* Bt; int M, N, K; };

struct StaticOrder {
    int nM, nN, nwg, G, c;
    __host__ __device__ void init(int M, int N, int G_, int c_) { nM = M / BM; nN = N / BM; nwg = nM * nN; G = G_; c = c_; }
    __host__ __device__ bool next(int i, Unit& u) const {
        const long L = (long)i * G + c; if (L >= nwg) return false;
        int wgid = (int)L; { const int q = nwg / NXCD, r = nwg % NXCD, xcd = wgid % NXCD, off = wgid / NXCD; wgid = (xcd < r ? xcd * (q + 1) : r * (q + 1) + (xcd - r) * q) + off; }
        const int nig = WGM * nN, gid = wgid / nig, fm = gid * WGM, gsz = (nM - fm) < WGM ? (nM - fm) : WGM;
        u.pm = fm + ((wgid % nig) % gsz); u.pn = (wgid % nig) / gsz; return true;
    }
    __device__ __forceinline__ void a_ready(const Unit&) const {}
    __device__ __forceinline__ void done(const Unit&) const {}
};

__device__ __forceinline__ unsigned cvt_pk_bf16(float lo, float hi) { unsigned r; asm volatile("v_cvt_pk_bf16_f32 %0, %1, %2" : "=v"(r) : "v"(lo), "v"(hi)); return r; }
typedef float f32x2 __attribute__((ext_vector_type(2)));
template <class Epi, class Sched, bool ALIGN_EPI = false, bool SP2 = false>
__device__ __forceinline__ void gemm_phase(PG8_LAS unsigned char* lds, const Gemm g, const Sched& S, const Epi& E, const int tid) {
    const int wid = __builtin_amdgcn_readfirstlane(tid >> 6), lane = tid & 63, wr = wid >> 2, wc = wid & 3, fr = lane & 15, fq = lane >> 4;
    const int K = g.K, nt = K / BK;
    unsigned voffA[2], voffB[2];
#pragma unroll
    for (int i = 0; i < 2; ++i) { int R, C; stage_rc(tid * 16 + i * 8192, R, C); const int Rb = Epi::PERM ? ((R & ~31) + perm32(R & 31)) : R;
        voffA[i] = (unsigned)(R * K + C) * 2u; voffB[i] = (unsigned)(Rb * K + C) * 2u; }
    const size_t kstep = (size_t)(BK * 2);
    const size_t hstep = (size_t)HALF * K * 2;
    const size_t tstep = 2 * hstep;
    const unsigned ldsw = (unsigned)wid * 1024u;
    const int aoff = lds_byte(wr * 64 + fr, fq * 8), boff = lds_byte(wc * 32 + fr, fq * 8);
#define PG8_SA(b, h) (((b) * 2 + (h)) * HTB)
#define PG8_SB(b, h) ((4 + (b) * 2 + (h)) * HTB)
#define PG8_STAGE(bufoff, gbase, voff) do { _Pragma("unroll") for (int _i = 0; _i < 2; ++_i) \
        __builtin_amdgcn_global_load_lds((const unsigned*)((const char*)(gbase) + (voff)[_i]), (PG8_LAS unsigned*)(lds + (bufoff) + ldsw + _i * 8192), 16, 0, 0); } while (0)
#define PG8_LDA(dst, b, h) do { _Pragma("unroll") for (int m = 0; m < 4; ++m) _Pragma("unroll") for (int k = 0; k < 2; ++k) dst[m][k] = *(const PG8_LAS bf16x8*)(lds + PG8_SA(b, h) + aoff + m * 2048 + k * 1024); } while (0)
#define PG8_LDB(dst, b, h) do { _Pragma("unroll") for (int n = 0; n < 2; ++n) _Pragma("unroll") for (int k = 0; k < 2; ++k) dst[n][k] = *(const PG8_LAS bf16x8*)(lds + PG8_SB(b, h) + boff + n * 2048 + k * 1024); } while (0)
#define PG8_MMA(ai, bj, At, Bt) do { __builtin_amdgcn_s_setprio(1); _Pragma("unroll") for (int m = 0; m < 4; ++m) _Pragma("unroll") for (int n = 0; n < 2; ++n) _Pragma("unroll") for (int k = 0; k < 2; ++k) \
        acc[ai][bj][m][n] = __builtin_amdgcn_mfma_f32_16x16x32_bf16(Bt[n][k], At[m][k], acc[ai][bj][m][n], 0, 0, 0); __builtin_amdgcn_s_setprio(0); } while (0)
#define PG8_WAIT_V(n) asm volatile("s_waitcnt vmcnt(" #n ")" ::: "memory")
#define PG8_WAIT_L(n) asm volatile("s_waitcnt lgkmcnt(" #n ")" ::: "memory")
#define PG8_BAR __builtin_amdgcn_s_barrier()
#define PG8_SCHED __builtin_amdgcn_sched_barrier(0)
    Unit cur, nxt; int ui = 0;
    if (!S.next(0, cur)) return;
    f32x4 acc[2][2][4][2];
#pragma unroll
    for (int a = 0; a < 2; ++a)
#pragma unroll
        for (int b = 0; b < 2; ++b)
#pragma unroll
            for (int m = 0; m < 4; ++m)
#pragma unroll
                for (int n = 0; n < 2; ++n) acc[a][b][m][n] = (f32x4){0.f, 0.f, 0.f, 0.f};
    bf16x8 At[4][2], B0[2][2], B1[2][2];
    const char* cA = (const char*)g.A + (size_t)cur.pm * tstep; const char* cB = (const char*)g.Bt + (size_t)cur.pn * tstep;
    S.a_ready(cur);
    if constexpr (SP2) {
        PG8_STAGE(PG8_SB(0, 0), cB, voffB); PG8_STAGE(PG8_SB(0, 1), cB + hstep, voffB); PG8_STAGE(PG8_SA(0, 0), cA, voffA); PG8_STAGE(PG8_SA(0, 1), cA + hstep, voffA);
        if (wr == 1) PG8_BAR;
        PG8_WAIT_V(2); PG8_BAR;
        PG8_STAGE(PG8_SB(1, 0), cB + kstep, voffB); PG8_STAGE(PG8_SA(1, 0), cA + kstep, voffA); PG8_STAGE(PG8_SB(1, 1), cB + hstep + kstep, voffB);
        PG8_WAIT_V(6); PG8_BAR;
    } else {
        PG8_STAGE(PG8_SB(0, 0), cB, voffB); PG8_STAGE(PG8_SA(0, 0), cA, voffA); PG8_STAGE(PG8_SB(0, 1), cB + hstep, voffB); PG8_STAGE(PG8_SA(0, 1), cA + hstep, voffA);
        if (wr == 1) PG8_BAR;
        PG8_WAIT_V(4); PG8_BAR;
        PG8_STAGE(PG8_SB(1, 0), cB + kstep, voffB); PG8_STAGE(PG8_SA(1, 0), cA + kstep, voffA); PG8_STAGE(PG8_SB(1, 1), cB + hstep + kstep, voffB);
        PG8_WAIT_V(6); PG8_BAR;
    }
    for (;;) {
        const bool has_next = S.next(ui + 1, nxt);
        const char* nA = has_next ? (const char*)g.A + (size_t)nxt.pm * tstep : cA; const char* nB = has_next ? (const char*)g.Bt + (size_t)nxt.pn * tstep : cB;
        for (int t = 0; t < nt; t += 2) {
            const bool last = (t == nt - 2);
            const char* a1 = cA + (size_t)(t + 1) * kstep;
            const char* a2 = last ? nA : cA + (size_t)(t + 2) * kstep; const char* b2 = last ? nB : cB + (size_t)(t + 2) * kstep;
            const char* a3 = a2 + kstep; const char* b3 = b2 + kstep;
            if (last && has_next) S.a_ready(nxt);
            if constexpr (SP2) {
            PG8_LDB(B0, 0, 0); PG8_LDB(B1, 0, 1); PG8_SCHED; PG8_LDA(At, 0, 0); PG8_STAGE(PG8_SA(1, 1), a1 + hstep, voffA);
            PG8_WAIT_V(8); PG8_WAIT_L(0); PG8_BAR; PG8_MMA(0, 0, At, B0); PG8_MMA(0, 1, At, B1); PG8_BAR; PG8_SCHED;
            PG8_LDA(At, 0, 1); PG8_STAGE(PG8_SB(0, 0), b2, voffB); PG8_STAGE(PG8_SB(0, 1), b2 + hstep, voffB); PG8_STAGE(PG8_SA(0, 0), a2, voffA);
            PG8_WAIT_V(8); PG8_WAIT_L(0); PG8_BAR; PG8_MMA(1, 0, At, B0); PG8_MMA(1, 1, At, B1); PG8_BAR; PG8_SCHED;
            PG8_LDB(B0, 1, 0); PG8_LDB(B1, 1, 1); PG8_SCHED; PG8_LDA(At, 1, 0); PG8_STAGE(PG8_SA(0, 1), a2 + hstep, voffA);
            PG8_WAIT_V(8); PG8_WAIT_L(0); PG8_BAR; PG8_MMA(0, 0, At, B0); PG8_MMA(0, 1, At, B1); PG8_BAR; PG8_SCHED;
            PG8_LDA(At, 1, 1); PG8_STAGE(PG8_SB(1, 0), b3, voffB); PG8_STAGE(PG8_SB(1, 1), b3 + hstep, voffB); PG8_STAGE(PG8_SA(1, 0), a3, voffA);
            PG8_WAIT_V(8); PG8_WAIT_L(0); PG8_BAR; PG8_MMA(1, 0, At, B0); PG8_MMA(1, 1, At, B1); PG8_BAR; PG8_SCHED;
            } else {
            PG8_LDB(B0, 0, 0); PG8_SCHED; PG8_LDA(At, 0, 0); PG8_STAGE(PG8_SA(1, 1), a1 + hstep, voffA);
            PG8_WAIT_L(8); PG8_BAR; PG8_WAIT_L(0); PG8_MMA(0, 0, At, B0); PG8_BAR; PG8_SCHED;
            PG8_LDB(B1, 0, 1); PG8_STAGE(PG8_SB(0, 0), b2, voffB);
            PG8_BAR; PG8_WAIT_L(0); PG8_MMA(0, 1, At, B1); PG8_BAR;
            PG8_LDA(At, 0, 1); PG8_STAGE(PG8_SA(0, 0), a2, voffA);
            PG8_BAR; PG8_WAIT_L(0); PG8_MMA(1, 0, At, B0); PG8_BAR; PG8_SCHED;
            PG8_STAGE(PG8_SB(0, 1), b2 + hstep, voffB);
            PG8_WAIT_V(6); PG8_BAR; PG8_MMA(1, 1, At, B1); PG8_BAR;
            PG8_LDB(B0, 1, 0); PG8_SCHED; PG8_LDA(At, 1, 0); PG8_STAGE(PG8_SA(0, 1), a2 + hstep, voffA);
            PG8_WAIT_L(8); PG8_BAR; PG8_WAIT_L(0); PG8_MMA(0, 0, At, B0); PG8_BAR; PG8_SCHED;
            PG8_LDB(B1, 1, 1); PG8_STAGE(PG8_SB(1, 0), b3, voffB);
            PG8_BAR; PG8_WAIT_L(0); PG8_MMA(0, 1, At, B1); PG8_BAR;
            PG8_LDA(At, 1, 1); PG8_STAGE(PG8_SA(1, 0), a3, voffA);
            PG8_BAR; PG8_WAIT_L(0); PG8_MMA(1, 0, At, B0); PG8_BAR; PG8_SCHED;
            PG8_STAGE(PG8_SB(1, 1), b3 + hstep, voffB);
            PG8_WAIT_V(6); PG8_BAR; PG8_MMA(1, 1, At, B1); PG8_BAR;
            }
        }
        if constexpr (ALIGN_EPI) { if (wr == 0) PG8_BAR; }
        if constexpr (!Epi::AFTER_DRAIN) { E(acc, cur, wr, wc, fr, fq); S.done(cur); }
        if (!has_next) break;
#pragma unroll
        for (int a = 0; a < 2; ++a)
#pragma unroll
            for (int b = 0; b < 2; ++b)
#pragma unroll
                for (int m = 0; m < 4; ++m)
#pragma unroll
                    for (int n = 0; n < 2; ++n) acc[a][b][m][n] = (f32x4){0.f, 0.f, 0.f, 0.f};
        cur = nxt; cA = nA; cB = nB; ++ui;
        if constexpr (ALIGN_EPI) { if (wr == 1) PG8_BAR; }
    }
    PG8_WAIT_V(0);
    if constexpr (!ALIGN_EPI) { if (wr == 0) PG8_BAR; }
    PG8_BAR;
    if constexpr (Epi::AFTER_DRAIN) { E.fused(acc, cur, wr, wc, fr, fq, lds, wid, lane); S.done(cur); }
#undef PG8_SA
#undef PG8_SB
#undef PG8_STAGE
#undef PG8_LDA
#undef PG8_LDB
#undef PG8_MMA
#undef PG8_WAIT_V
#undef PG8_WAIT_L
#undef PG8_BAR
#undef PG8_SCHED
}
}
#define XB_TMO      128
#define XB_XCNT(j)  (256  + 64 * (j))
#define XB_XSUB(j)  (1280 + 64 * (j))
#define XB_XGEN(j)  (2304 + 64 * (j))
#define XB_TOP      3328
#define XB_TOPGEN   3392
#define XCD_BAR_WORDS 3456
#define XB_SPIN_CAP (1u << 25)

__device__ __forceinline__ unsigned xb_ld(unsigned* p)              { return __hip_atomic_load(p, __ATOMIC_RELAXED, __HIP_MEMORY_SCOPE_AGENT); }
__device__ __forceinline__ unsigned xb_add(unsigned* p, unsigned v) { return __hip_atomic_fetch_add(p, v, __ATOMIC_RELAXED, __HIP_MEMORY_SCOPE_AGENT); }
__device__ __forceinline__ unsigned xb_xcc_id() { return (unsigned)__builtin_amdgcn_s_getreg((3 << 11) | 20) & 0xFu; }
#define XB_SPIN(cond, bar) do { unsigned _sp = 0; while (cond) { __builtin_amdgcn_s_sleep(1); \
    if ((++_sp & 255u) == 0u) { if (xb_ld(&(bar)[XB_TMO])) break; if (_sp > XB_SPIN_CAP) { atomicAdd(&(bar)[XB_TMO], 1u); break; } } } } while (0)

struct XcdBarrier {
    unsigned* bar; unsigned x;
    volatile LAS unsigned* st;
};

__device__ __forceinline__ XcdBarrier xcd_barrier_post(unsigned* bar, volatile LAS unsigned* st) {
    XcdBarrier b; b.bar = bar; b.x = xb_xcc_id(); b.st = st;
    if (threadIdx.x == 0) (void)xb_add(&bar[XB_XCNT(b.x)], 1u);
    return b;
}
__device__ __forceinline__ void xcd_barrier_complete(unsigned* bar, unsigned x, unsigned& nloc, unsigned& nx) {
    const unsigned G = gridDim.x * gridDim.y * gridDim.z;
    unsigned sum, cnt, mine, sp = 0u;
    for (;;) {
        sum = 0u; cnt = 0u; mine = 0u;
#pragma unroll
        for (unsigned j = 0; j < 16; ++j) { const unsigned c = xb_ld(&bar[XB_XCNT(j)]); sum += c; cnt += (c > 0u) ? 1u : 0u; mine = (j == x) ? c : mine; }
        if (sum == G) break;
        __builtin_amdgcn_s_sleep(1);
        if ((++sp & 255u) == 0u) { if (xb_ld(&bar[XB_TMO])) break; if (sp > XB_SPIN_CAP) { atomicAdd(&bar[XB_TMO], 1u); break; } }
    }
    nloc = mine > 0u ? mine : 1u; nx = cnt > 0u ? cnt : 1u;
}

__device__ __forceinline__ void xcd_barrier(const XcdBarrier& b) {
    asm volatile("s_waitcnt vmcnt(0)" ::: "memory");
    __syncthreads();
    if (threadIdx.x == 0) {
        unsigned* bar = b.bar;
        __builtin_amdgcn_s_waitcnt(0);
        unsigned nloc = b.st[0], nx = b.st[1];
        if (nloc == 0u) { xcd_barrier_complete(bar, b.x, nloc, nx); b.st[0] = nloc; b.st[1] = nx; }
        const unsigned old = xb_add(&bar[XB_XSUB(b.x)], 1u);
        const unsigned gen = old / nloc;
        if (old + 1u == (gen + 1u) * nloc) {
            __builtin_amdgcn_fence(__ATOMIC_RELEASE, "agent");
            asm volatile("s_waitcnt vmcnt(0)" ::: "memory");
            const unsigned og = xb_add(&bar[XB_TOP], 1u);
            const unsigned tg = og / nx;
            if (og + 1u == (tg + 1u) * nx) xb_add(&bar[XB_TOPGEN], 1u);
            else XB_SPIN(xb_ld(&bar[XB_TOPGEN]) == tg, bar);
            __builtin_amdgcn_fence(__ATOMIC_ACQUIRE, "agent");
            xb_add(&bar[XB_XGEN(b.x)], 1u);
            asm volatile("s_waitcnt vmcnt(0)" ::: "memory");
        } else {
            XB_SPIN(xb_ld(&bar[XB_XGEN(b.x)]) == gen, bar);
            __builtin_amdgcn_fence(__ATOMIC_ACQUIRE, "agent");
            asm volatile("s_waitcnt vmcnt(0)" ::: "memory");
        }
    }
    __syncthreads();
}

namespace epi {
using pg8::Unit; using pg8::BM; using pg8::HALF;
typedef const pg8::f32x4 (&AccRef)[2][2][4][2];

struct EpiProj1 {
    static constexpr bool PERM = false, AFTER_DRAIN = false;
    bf16* O; const float* cosT; const float* sinT;
    __device__ __forceinline__ void operator()(AccRef acc, const Unit& u, int wr, int wc, int fr, int fq) const {
        const int row0 = u.pm * BM + wr * 64 + fr, colw = u.pn * BM + wc * 32;
#pragma unroll
        for (int bj = 0; bj < 2; ++bj) {
            const int hb = (colw + bj * HALF) >> 6;
            const bool rope = (hb >= 40 && hb < 50) || (hb >= 52 && hb < 54) || (hb >= 56 && hb < 58) || (hb >= 60 && hb < 76);
            const bool isq = (hb >= 40 && hb < 48) || (hb >= 60 && hb < 68);
            const float qs = isq ? QSCALE : 1.0f;
            const int jw = (wc & 1) * 16 + fq * 2;
#pragma unroll
            for (int ai = 0; ai < 2; ++ai)
#pragma unroll
                for (int m = 0; m < 4; ++m) {
                    const int row = row0 + ai * HALF + m * 16;
                    bf16* rowp = O + (size_t)row * NP1 + colw + bj * HALF + 4 * fq;
#pragma unroll
                    for (int n = 0; n < 2; ++n) {
                        pg8::f32x4 v = acc[ai][bj][m][n];
                        if (rope) {
                            const f32x2 c = *(const f32x2*)(cosT + (size_t)row * 32 + jw + n * 8), s = *(const f32x2*)(sinT + (size_t)row * 32 + jw + n * 8);
                            const float y0 = v[0] * c.x - v[1] * s.x, y1 = v[1] * c.x + v[0] * s.x, y2 = v[2] * c.y - v[3] * s.y, y3 = v[3] * c.y + v[2] * s.y;
                            v[0] = y0 * qs; v[1] = y1 * qs; v[2] = y2 * qs; v[3] = y3 * qs;
                        }
                        v2u w; w.x = pk2(v[0], v[1]); w.y = pk2(v[2], v[3]);
                        *(v2u*)(rowp + n * 16) = w;
                    }
                }
        }
    }
};
template <int ACT> struct EpiStore {
    static constexpr bool PERM = false, AFTER_DRAIN = false;
    bf16* O; int ldc;
    __device__ __forceinline__ void operator()(AccRef acc, const Unit& u, int wr, int wc, int fr, int fq) const {
        const int row0 = u.pm * BM + wr * 64 + fr, col0 = u.pn * BM + wc * 32 + 4 * fq;
#pragma unroll
        for (int ai = 0; ai < 2; ++ai)
#pragma unroll
            for (int m = 0; m < 4; ++m) { bf16* rowp = O + (size_t)(row0 + ai * HALF + m * 16) * ldc + col0;
#pragma unroll
                for (int bj = 0; bj < 2; ++bj)
#pragma unroll
                    for (int n = 0; n < 2; ++n) { pg8::f32x4 v = acc[ai][bj][m][n];
                        if (ACT == 1) { v[0] = sigmoidf_(v[0]); v[1] = sigmoidf_(v[1]); v[2] = sigmoidf_(v[2]); v[3] = sigmoidf_(v[3]); }
                        v2u w; w.x = pk2(v[0], v[1]); w.y = pk2(v[2], v[3]); *(v2u*)(rowp + bj * HALF + n * 16) = w; } }
    }
};
struct EpiMerge {
    static constexpr bool PERM = false, AFTER_DRAIN = false;
    bf16* O; const bf16* G; int seg;
    __device__ __forceinline__ void operator()(AccRef acc, const Unit& u, int wr, int wc, int fr, int fq) const {
        const int row0 = u.pm * BM + wr * 64 + fr, col0 = u.pn * BM + wc * 32 + 4 * fq;
#pragma unroll
        for (int ai = 0; ai < 2; ++ai)
#pragma unroll
            for (int m = 0; m < 4; ++m) { const size_t row = (size_t)(row0 + ai * HALF + m * 16); bf16* rowp = O + row * DM + col0; const bf16* gp = G + row * NGT + seg * DM + col0;
#pragma unroll
                for (int bj = 0; bj < 2; ++bj)
#pragma unroll
                    for (int n = 0; n < 2; ++n) { pg8::f32x4 v = acc[ai][bj][m][n];
                        const v2u g = *(const v2u*)(gp + bj * HALF + n * 16);
                        v[0] *= bflo(g.x); v[1] *= bfhi(g.x); v[2] *= bflo(g.y); v[3] *= bfhi(g.y);
                        if (seg != 0) { const v2u o = *(const v2u*)(rowp + bj * HALF + n * 16); v[0] += bflo(o.x); v[1] += bfhi(o.x); v[2] += bflo(o.y); v[3] += bfhi(o.y); }
                        v2u w; w.x = pk2(v[0], v[1]); w.y = pk2(v[2], v[3]); *(v2u*)(rowp + bj * HALF + n * 16) = w; } }
    }
};
struct EpiResid {
    static constexpr bool PERM = false, AFTER_DRAIN = false;
    const float* XI; float* XO; const float* gate;
    __device__ __forceinline__ void operator()(AccRef acc, const Unit& u, int wr, int wc, int fr, int fq) const {
        const int row0 = u.pm * BM + wr * 64 + fr, col0 = u.pn * BM + wc * 32 + 4 * fq;
        const float* gb = gate + (size_t)((u.pm * BM) / SEQ) * 6144 + col0;
        pg8::f32x4 gv[2][2];
#pragma unroll
        for (int bj = 0; bj < 2; ++bj)
#pragma unroll
            for (int n = 0; n < 2; ++n) gv[bj][n] = *(const pg8::f32x4*)(gb + bj * HALF + n * 16);
#pragma unroll
        for (int ai = 0; ai < 2; ++ai)
#pragma unroll
            for (int m = 0; m < 4; ++m) { const size_t off = (size_t)(row0 + ai * HALF + m * 16) * DM + col0;
#pragma unroll
                for (int bj = 0; bj < 2; ++bj)
#pragma unroll
                    for (int n = 0; n < 2; ++n) { const pg8::f32x4 xi = *(const pg8::f32x4*)(XI + off + bj * HALF + n * 16);
                        *(pg8::f32x4*)(XO + off + bj * HALF + n * 16) = xi + gv[bj][n] * acc[ai][bj][m][n]; } }
    }
};
}

constexpr int NWAVES = 8, NTHR = 512;
struct Args { const void* in[26]; float* out; unsigned char* ws; int ph_lo, ph_hi; };
enum InIdx { I_X = 0, I_C, I_POS, I_MODW, I_MODB, I_NMG, I_NFG, I_WIN, I_ACW, I_AOUT, I_BCW, I_BCB, I_BLNG, I_BLNB, I_BOUT, I_CPOS, I_CW1, I_CW2, I_COUT, I_DOUT, I_WO, I_PWQ, I_PSUB, I_PU, I_PV, I_FNG };

struct Frame {
    LAS unsigned char* lds; unsigned char* ldsg;
    int tid, lane, wave, G, bid;
    unsigned char* ws;
};
__device__ __forceinline__ int gwave(const Frame& F) { return F.bid * NWAVES + F.wave; }
__device__ __forceinline__ int ngwave(const Frame& F) { return F.G * NWAVES; }

__device__ __forceinline__ int rope_pos_of_dim(int d) { return d < 32 ? 2 * d : 2 * (d - 32) + 1; }
__device__ __forceinline__ int rope_dim_of_pos(int p) { return (p >> 1) + 32 * (p & 1); }
__device__ __forceinline__ int win_row_of_col(int n) {
    if (n < 2560) return n;
    if (n < 3072) { const int c = n - 2560; return C_CQ + (c & ~63) + rope_pos_of_dim(c & 63); }
    if (n < 3200) { const int c = n - 3072; return C_KC + (c & ~63) + rope_pos_of_dim(c & 63); }
    if (n < 3328) return C_VC + (n - 3200);
    if (n < 3456) { const int c = n - 3328; return C_KS + (c & ~63) + rope_pos_of_dim(c & 63); }
    if (n < 3584) return C_VS + (n - 3456);
    if (n < 3712) { const int c = n - 3584; return C_KW + (c & ~63) + rope_pos_of_dim(c & 63); }
    if (n < 3840) return C_VW + (n - 3712);
    if (n < 3864) return C_CG + (n - 3840);
    if (n < 4376) { const int c = n - 3864; return C_DQ + (c & ~63) + rope_pos_of_dim(c & 63); }
    if (n < 4888) { const int c = n - 4376; return C_DK + (c & ~63) + rope_pos_of_dim(c & 63); }
    if (n < 5400) return C_DV + (n - 4888);
    return NP1 + (n - 5400);
}
template <int MODE, bool KPERM>
__device__ __forceinline__ void transpose_item(const float* W, int K, int N, bf16* WT, LAS float* scr, int item, int lane) {
    const int nblk = (N + 31) / 32, kb = item / nblk, nb = item % nblk, k0 = 64 * kb, n0 = 32 * nb;
    const int nsrc = n0 + (lane & 31); const bool nok = nsrc < N;
#pragma unroll 8
    for (int i = 0; i < 32; ++i) { const int kk = 2 * i + (lane >> 5); scr[kk * 33 + (lane & 31)] = nok ? W[(size_t)(k0 + kk) * N + nsrc] : 0.f; }
    LDS_WAIT(); asm volatile("" ::: "memory");
    const int c = lane & 7;
#pragma unroll
    for (int j = 0; j < 4; ++j) { const int n = (lane >> 3) + 8 * j;
        float s[8];
#pragma unroll
        for (int e = 0; e < 8; ++e) { const int p = 8 * c + e; const int ks = KPERM ? rope_dim_of_pos(p) : p; s[e] = scr[ks * 33 + n]; }
        v4u o; o.x = pk2(s[0], s[1]); o.y = pk2(s[2], s[3]); o.z = pk2(s[4], s[5]); o.w = pk2(s[6], s[7]);
        if (n0 + n < N) { const int row = (MODE == 1) ? win_row_of_col(n0 + n) : (n0 + n); *(v4u*)(WT + (size_t)row * K + k0 + 8 * c) = o; } }
    LDS_WAIT(); asm volatile("" ::: "memory");
}
template <int MODE, bool KPERM>
__device__ __forceinline__ void transpose_matrix(const Frame& F, const float* W, int K, int N, bf16* WT, int& base) {
    LAS float* scr = (LAS float*)(F.lds + F.wave * 16384);
    const int nitems = (K / 64) * ((N + 31) / 32), gw = gwave(F), NGW = ngwave(F);
    int first = (gw - base % NGW + NGW) % NGW;
    for (int it = first; it < nitems; it += NGW) transpose_item<MODE, KPERM>(W, K, N, WT, scr, it, F.lane);
    base += nitems;
}
__device__ __forceinline__ void convert_copy(const Frame& F, const float* src, bf16* dst, size_t n) {
    const size_t nth = (size_t)F.G * NTHR, t0 = (size_t)F.bid * NTHR + F.tid;
    for (size_t i = t0; i < n / 8; i += nth) { const f32x4 a = *(const f32x4*)(src + i * 8), b = *(const f32x4*)(src + i * 8 + 4);
        v4u o; o.x = pk2(a[0], a[1]); o.y = pk2(a[2], a[3]); o.z = pk2(b[0], b[1]); o.w = pk2(b[2], b[3]); *(v4u*)(dst + i * 8) = o; }
}

typedef __attribute__((address_space(4))) const Args* KArgsP;
__device__ __forceinline__ void phase_prologue(const Frame& F, KArgsP Ap) {
    unsigned char* ws = F.ws;
    int base = 0;
    for (int l = 0; l < DEPTH; ++l) {
        transpose_matrix<1, false>(F, (const float*)(GAS const void*)Ap->in[I_WIN] + (size_t)l * DM * 9496, DM, 9496, (bf16*)(ws + WS_WIN) + (size_t)l * NWIN * DM, base);
        transpose_matrix<0, false>(F, (const float*)(GAS const void*)Ap->in[I_AOUT] + (size_t)l * 512 * DM, 512, DM, (bf16*)(ws + WS_WOUT) + (size_t)(l * 4 + 0) * DM * 512, base);
        transpose_matrix<0, false>(F, (const float*)(GAS const void*)Ap->in[I_BOUT] + (size_t)l * 512 * DM, 512, DM, (bf16*)(ws + WS_WOUT) + (size_t)(l * 4 + 1) * DM * 512, base);
        transpose_matrix<0, false>(F, (const float*)(GAS const void*)Ap->in[I_COUT] + (size_t)l * 512 * DM, 512, DM, (bf16*)(ws + WS_WOUT) + (size_t)(l * 4 + 2) * DM * 512, base);
        transpose_matrix<0, false>(F, (const float*)(GAS const void*)Ap->in[I_DOUT] + (size_t)l * 512 * DM, 512, DM, (bf16*)(ws + WS_WOUT) + (size_t)(l * 4 + 3) * DM * 512, base);
        transpose_matrix<0, false>(F, (const float*)(GAS const void*)Ap->in[I_WO] + (size_t)l * DM * DM, DM, DM, (bf16*)(ws + WS_WO) + (size_t)l * DM * DM, base);
        transpose_matrix<0, false>(F, (const float*)(GAS const void*)Ap->in[I_PWQ] + (size_t)l * DM * 2048, DM, 2048, (bf16*)(ws + WS_WQ) + (size_t)l * 2048 * DM, base);
        transpose_matrix<0, true>(F, (const float*)(GAS const void*)Ap->in[I_CW1] + (size_t)(l * 2 + 0) * 2048 * 128, 2048, 128, (bf16*)(ws + WS_W1T) + (size_t)(l * 2 + 0) * 128 * 2048, base);
        transpose_matrix<0, false>(F, (const float*)(GAS const void*)Ap->in[I_CW1] + (size_t)(l * 2 + 1) * 2048 * 128, 2048, 128, (bf16*)(ws + WS_W1T) + (size_t)(l * 2 + 1) * 128 * 2048, base);
    }
    convert_copy(F, (const float*)(GAS const void*)Ap->in[I_PSUB], (bf16*)(ws + WS_SUBK), (size_t)DEPTH * 8 * 2 * 128 * 128);
    const int gt = F.bid * NTHR + F.tid, NGT_ = F.G * NTHR;
    { const float* w2 = (const float*)(GAS const void*)Ap->in[I_CW2]; bf16* w2t = (bf16*)(ws + WS_SMALL + SM_W2T);
      for (int i = gt; i < DEPTH * 2 * 64 * 128; i += NGT_) { const int k = i & 127, n = (i >> 7) & 63, lw = i >> 13; w2t[i] = (bf16)f2bf(w2[((size_t)lw * 128 + k) * 64 + n]); } }
    { const int* pos = (const int*)(GAS const void*)Ap->in[I_POS]; float* ct = (float*)(ws + WS_COS); float* st = (float*)(ws + WS_SIN);
      for (int i = gt; i < TOK * 32; i += NGT_) { const int t = i >> 5, j = i & 31;
          const float inv = 1.0f / powf(10000.0f, (float)(2 * j) / 64.0f); const float ang = (float)pos[t] * inv;
          ct[i] = (float)cos((double)ang); st[i] = (float)sin((double)ang); } }
    { const float* w1 = (const float*)(GAS const void*)Ap->in[I_CW1]; const float* cp = (const float*)(GAS const void*)Ap->in[I_CPOS]; float* pbp = (float*)(ws + WS_SMALL + SM_PBP);
      for (int i = gt; i < DEPTH * 2 * 16 * 128; i += NGT_) { const int n = i & 127, kc = (i >> 7) & 15, lw = i >> 11; float s = 0.f;
          for (int k = kc * 128; k < kc * 128 + 128; ++k) s += cp[(size_t)lw * 2048 + k] * w1[((size_t)lw * 2048 + k) * 128 + n];
          pbp[i] = s; } }
    __syncthreads();
    { LAS float* cond = (LAS float*)(F.lds);
      LAS float* red = (LAS float*)(F.lds + 32768);
      const float* c = (const float*)(GAS const void*)Ap->in[I_C];
      for (int i = F.tid; i < 8 * 1024; i += NTHR) { const float v = c[i]; cond[i] = v / (1.0f + __expf(-v)); }
      __syncthreads();
      for (int un = F.bid; un < DEPTH * 96; un += F.G) { const int l = un / 96, n0 = (un % 96) * 64;
          const float* mw = (const float*)(GAS const void*)Ap->in[I_MODW] + (size_t)l * DM * 6144 + n0 + F.lane;
          float acc[8];
#pragma unroll
          for (int b = 0; b < 8; ++b) acc[b] = 0.f;
#pragma unroll 4
          for (int k = F.wave * 128; k < F.wave * 128 + 128; ++k) { const float w = mw[(size_t)k * 6144];
#pragma unroll
              for (int b = 0; b < 8; ++b) acc[b] += cond[b * 1024 + k] * w; }
#pragma unroll
          for (int b = 0; b < 8; ++b) red[(F.wave * 8 + b) * 64 + F.lane] = acc[b];
          __syncthreads();
          { const int b = F.tid >> 6, n = F.tid & 63; float s = 0.f;
#pragma unroll
            for (int w = 0; w < 8; ++w) s += red[(w * 8 + b) * 64 + n];
            ((float*)(ws + WS_MOD))[((size_t)l * 8 + b) * 6144 + n0 + n] = s + ((const float*)(GAS const void*)Ap->in[I_MODB])[(size_t)l * 6144 + n0 + n]; }
          __syncthreads(); }
    }
}

__device__ __forceinline__ void phase_norm_mod(const Frame& F, const float* X, const float* g, const float* sh, const float* sc, bf16* O, unsigned char* O8 = nullptr, float* OS = nullptr) {
    const int gw = gwave(F), NGW = ngwave(F);
    f32x4 gv[4];
#pragma unroll
    for (int j = 0; j < 4; ++j) gv[j] = *(const f32x4*)(g + 4 * F.lane + 256 * j);
    for (int row = gw; row < TOK; row += NGW) {
        const int b = row / SEQ; const float* xr = X + (size_t)row * DM + 4 * F.lane;
        f32x4 v[4]; float s = 0.f;
#pragma unroll
        for (int j = 0; j < 4; ++j) { v[j] = *(const f32x4*)(xr + 256 * j); s += (v[j][0] * v[j][0] + v[j][1] * v[j][1]) + (v[j][2] * v[j][2] + v[j][3] * v[j][3]); }
        const float r = 1.0f / sqrtf(wave_sum(s, F.lane) * (1.0f / DM) + NORM_EPS);
        bf16* orow = O + (size_t)row * DM + 4 * F.lane;
#pragma unroll
        for (int j = 0; j < 4; ++j) { const f32x4 scv = *(const f32x4*)(sc + (size_t)b * 6144 + 4 * F.lane + 256 * j), shv = *(const f32x4*)(sh + (size_t)b * 6144 + 4 * F.lane + 256 * j);
            const f32x4 y = v[j] * r * gv[j] * (scv + 1.0f) + shv; v2u w; w.x = pk2(y[0], y[1]); w.y = pk2(y[2], y[3]); *(v2u*)(orow + 256 * j) = w; v[j] = y; }
        if (O8) {
            float mx = 0.f;
#pragma unroll
            for (int j = 0; j < 4; ++j) mx = fmaxf(fmaxf(mx, fmaxf(fabsf(v[j][0]), fabsf(v[j][1]))), fmaxf(fabsf(v[j][2]), fabsf(v[j][3])));
#pragma unroll
            for (int o = 1; o < 32; o <<= 1) mx = fmaxf(mx, shx(mx, o, F.lane));
            mx = max32(mx);
            int ex = 0; (void)frexpf(mx, &ex); const int k = (mx > 0.f) ? (8 - ex) : 0;
            const float s8 = __builtin_ldexpf(1.0f, k);
#pragma unroll
            for (int j = 0; j < 4; ++j) { unsigned p = 0u; p = __builtin_amdgcn_cvt_pk_fp8_f32(v[j][0] * s8, v[j][1] * s8, p, false); p = __builtin_amdgcn_cvt_pk_fp8_f32(v[j][2] * s8, v[j][3] * s8, p, true);
                *(unsigned*)(O8 + (size_t)row * DM + 4 * F.lane + 256 * j) = p; }
            if (F.lane == 0) OS[row] = __builtin_ldexpf(1.0f, -k);
        }
    }
}
__device__ __forceinline__ void phase_final_norm(const Frame& F, const float* X, const float* g, float* O) {
    const int gw = gwave(F), NGW = ngwave(F);
    f32x4 gv[4];
#pragma unroll
    for (int j = 0; j < 4; ++j) gv[j] = *(const f32x4*)(g + 4 * F.lane + 256 * j);
    for (int row = gw; row < TOK; row += NGW) {
        const float* xr = X + (size_t)row * DM + 4 * F.lane; f32x4 v[4]; float s = 0.f;
#pragma unroll
        for (int j = 0; j < 4; ++j) { v[j] = *(const f32x4*)(xr + 256 * j); s += (v[j][0] * v[j][0] + v[j][1] * v[j][1]) + (v[j][2] * v[j][2] + v[j][3] * v[j][3]); }
        const float r = 1.0f / sqrtf(wave_sum(s, F.lane) * (1.0f / DM) + NORM_EPS);
        float* orow = O + (size_t)row * DM + 4 * F.lane;
#pragma unroll
        for (int j = 0; j < 4; ++j) *(f32x4*)(orow + 256 * j) = v[j] * r * gv[j];
    }
}

__device__ __forceinline__ void phase_mixer_a(const Frame& F, const bf16* P, const float* cw  , bf16* O  ) {
    const int nth = F.G * NTHR, gt = F.bid * NTHR + F.tid;
    for (int it = gt; it < (TOK / 8) * 64; it += nth) {
        const int cg = it & 63, tb = it >> 6, c0 = cg * 8, t0 = tb * 8, s0 = t0 % SEQ;
        float w0[8], w1[8], w2[8];
#pragma unroll
        for (int e = 0; e < 8; ++e) { w0[e] = cw[c0 + e]; w1[e] = cw[512 + c0 + e]; w2[e] = cw[1024 + c0 + e]; }
        float pm2[8], pm1[8];
#pragma unroll
        for (int e = 0; e < 8; ++e) { pm2[e] = 0.f; pm1[e] = 0.f; }
        for (int pre = 2; pre >= 1; --pre) if (s0 - pre >= 0) { const bf16* r = P + (size_t)(t0 - pre) * NP1;
            const v4u ac = *(const v4u*)(r + C_AC + c0), ax = *(const v4u*)(r + C_AX + c0);
            float pr[8]; pr[0] = bflo(ac.x) * bflo(ax.x); pr[1] = bfhi(ac.x) * bfhi(ax.x); pr[2] = bflo(ac.y) * bflo(ax.y); pr[3] = bfhi(ac.y) * bfhi(ax.y);
            pr[4] = bflo(ac.z) * bflo(ax.z); pr[5] = bfhi(ac.z) * bfhi(ax.z); pr[6] = bflo(ac.w) * bflo(ax.w); pr[7] = bfhi(ac.w) * bfhi(ax.w);
#pragma unroll
            for (int e = 0; e < 8; ++e) { if (pre == 2) pm2[e] = pr[e]; else pm1[e] = pr[e]; } }
#pragma unroll
        for (int tt = 0; tt < 8; ++tt) { const bf16* r = P + (size_t)(t0 + tt) * NP1;
            const v4u ac = *(const v4u*)(r + C_AC + c0), ax = *(const v4u*)(r + C_AX + c0), ab = *(const v4u*)(r + C_AB + c0);
            float pr[8], bb[8], y[8];
            pr[0] = bflo(ac.x) * bflo(ax.x); pr[1] = bfhi(ac.x) * bfhi(ax.x); pr[2] = bflo(ac.y) * bflo(ax.y); pr[3] = bfhi(ac.y) * bfhi(ax.y);
            pr[4] = bflo(ac.z) * bflo(ax.z); pr[5] = bfhi(ac.z) * bfhi(ax.z); pr[6] = bflo(ac.w) * bflo(ax.w); pr[7] = bfhi(ac.w) * bfhi(ax.w);
            bb[0] = bflo(ab.x); bb[1] = bfhi(ab.x); bb[2] = bflo(ab.y); bb[3] = bfhi(ab.y); bb[4] = bflo(ab.z); bb[5] = bfhi(ab.z); bb[6] = bflo(ab.w); bb[7] = bfhi(ab.w);
#pragma unroll
            for (int e = 0; e < 8; ++e) { y[e] = bb[e] * (w0[e] * pm2[e] + w1[e] * pm1[e] + w2[e] * pr[e]); pm2[e] = pm1[e]; pm1[e] = pr[e]; }
            v4u o; o.x = pk2(y[0], y[1]); o.y = pk2(y[2], y[3]); o.z = pk2(y[4], y[5]); o.w = pk2(y[6], y[7]);
            *(v4u*)(O + (size_t)(t0 + tt) * 512 + c0) = o; }
    }
}

__device__ __forceinline__ void phase_mixer_b(const Frame& F, const bf16* P, const float* cw  , const float* cb, const float* lg, const float* lb, bf16* O) {
    LAS float* U = (LAS float*)F.lds;
    for (int un = F.bid; un < TOK / 32; un += F.G) {
        const int t0 = un * 32, s0 = t0 % SEQ;
        __syncthreads();
        for (int i = F.tid; i < 62 * 64; i += NTHR) { const int r = i >> 6, cg = i & 63, c0 = cg * 8; const int srel = s0 - 30 + r;
            float u[8];
            if (srel >= 0) { const bf16* row = P + (size_t)(t0 - 30 + r) * NP1; const v4u a = *(const v4u*)(row + C_BA + c0), g = *(const v4u*)(row + C_BG + c0);
                u[0] = bflo(a.x) * sigmoidf_(bflo(g.x)); u[1] = bfhi(a.x) * sigmoidf_(bfhi(g.x)); u[2] = bflo(a.y) * sigmoidf_(bflo(g.y)); u[3] = bfhi(a.y) * sigmoidf_(bfhi(g.y));
                u[4] = bflo(a.z) * sigmoidf_(bflo(g.z)); u[5] = bfhi(a.z) * sigmoidf_(bfhi(g.z)); u[6] = bflo(a.w) * sigmoidf_(bflo(g.w)); u[7] = bfhi(a.w) * sigmoidf_(bfhi(g.w)); }
            else {
#pragma unroll
                for (int e = 0; e < 8; ++e) u[e] = 0.f; }
            *(LAS f32x4*)(U + r * 512 + c0) = (f32x4){u[0], u[1], u[2], u[3]}; *(LAS f32x4*)(U + r * 512 + c0 + 4) = (f32x4){u[4], u[5], u[6], u[7]}; }
        __syncthreads();
        const int c0 = F.lane * 8;
        float acc[4][8];
#pragma unroll
        for (int q = 0; q < 4; ++q)
#pragma unroll
            for (int e = 0; e < 8; ++e) acc[q][e] = cb[c0 + e];
        for (int k = 0; k < 31; ++k) { const f32x4 wa = *(const f32x4*)(cw + k * 512 + c0), wb = *(const f32x4*)(cw + k * 512 + c0 + 4);
#pragma unroll
            for (int q = 0; q < 4; ++q) { const int r = 4 * F.wave + q + k; const f32x4 ua = *(LAS f32x4*)(U + r * 512 + c0), ub = *(LAS f32x4*)(U + r * 512 + c0 + 4);
                acc[q][0] += wa[0] * ua[0]; acc[q][1] += wa[1] * ua[1]; acc[q][2] += wa[2] * ua[2]; acc[q][3] += wa[3] * ua[3];
                acc[q][4] += wb[0] * ub[0]; acc[q][5] += wb[1] * ub[1]; acc[q][6] += wb[2] * ub[2]; acc[q][7] += wb[3] * ub[3]; } }
        const f32x4 ga = *(const f32x4*)(lg + c0), gb = *(const f32x4*)(lg + c0 + 4), ba = *(const f32x4*)(lb + c0), bb = *(const f32x4*)(lb + c0 + 4);
#pragma unroll
        for (int q = 0; q < 4; ++q) { float s = 0.f;
#pragma unroll
            for (int e = 0; e < 8; ++e) s += acc[q][e];
            const float mu = wave_sum(s, F.lane) * (1.0f / 512.0f); float v = 0.f;
#pragma unroll
            for (int e = 0; e < 8; ++e) { acc[q][e] -= mu; v += acc[q][e] * acc[q][e]; }
            const float rs = 1.0f / sqrtf(wave_sum(v, F.lane) * (1.0f / 512.0f) + NORM_EPS);
            float y[8];
#pragma unroll
            for (int e = 0; e < 8; ++e) { const float gg = e < 4 ? ga[e] : gb[e - 4], bv = e < 4 ? ba[e] : bb[e - 4]; const float z = acc[q][e] * rs * gg + bv; y[e] = z / (1.0f + __expf(-z)); }
            v4u o; o.x = pk2(y[0], y[1]); o.y = pk2(y[2], y[3]); o.z = pk2(y[4], y[5]); o.w = pk2(y[6], y[7]);
            *(v4u*)(O + (size_t)(t0 + 4 * F.wave + q) * 512 + c0) = o; }
    }
}

__device__ __forceinline__ void phase_compress(const Frame& F, const bf16* P, const bf16* W1T  , const bf16* W2T  , const float* PBP  ,
                                               bf16* KC, bf16* VC  ) {
    LAS float* PART = (LAS float*)F.lds;
    LAS bf16* H1 = (LAS bf16*)(F.lds + 69632);
    const int lane = F.lane, r16 = lane & 15, q4 = lane >> 4, w = F.wave;
    for (int un = F.bid; un < 2 * 8 * 2 * 8; un += F.G) {
        const int nb = un & 7, g = (un >> 3) & 1, b = (un >> 4) & 7, which = un >> 7;
        const int n = nb * 16 + r16; const int nn = n < 127 ? n : 126;
        const int col0 = (which == 0 ? C_KC : C_VC) + g * 64;
        const bf16* arow = P + ((size_t)b * SEQ + nn * 16) * NP1 + col0;
        const bf16* w1 = W1T + (size_t)which * 128 * 2048;
        f32x4 acc[8];
#pragma unroll
        for (int j = 0; j < 8; ++j) acc[j] = (f32x4){0.f, 0.f, 0.f, 0.f};
#pragma unroll
        for (int half = 0; half < 2; ++half) {
            bf16x8 a[4], bb[4][8];
#pragma unroll
            for (int s4 = 0; s4 < 4; ++s4) { const int k = w * 256 + (half * 4 + s4) * 32 + q4 * 8;
                a[s4] = *(const bf16x8*)(arow + (size_t)(k >> 6) * NP1 + (k & 63));
#pragma unroll
                for (int j = 0; j < 8; ++j) bb[s4][j] = *(const bf16x8*)(w1 + (size_t)(j * 16 + r16) * 2048 + k); }
#pragma unroll
            for (int s4 = 0; s4 < 4; ++s4)
#pragma unroll
                for (int j = 0; j < 8; ++j) acc[j] = __builtin_amdgcn_mfma_f32_16x16x32_bf16(a[s4], bb[s4][j], acc[j], 0, 0, 0);
        }
        __syncthreads();
#pragma unroll
        for (int j = 0; j < 8; ++j)
#pragma unroll
            for (int i = 0; i < 4; ++i) PART[(w * 16 + 4 * q4 + i) * 132 + j * 16 + r16] = acc[j][i];
        __syncthreads();
        {
            const int row = F.tid >> 5, c4 = (F.tid & 31) * 4;
            f32x4 sacc = (f32x4){0.f, 0.f, 0.f, 0.f};
#pragma unroll
            for (int ww = 0; ww < 8; ++ww) sacc += *(LAS f32x4*)(PART + (ww * 16 + row) * 132 + c4);
#pragma unroll
            for (int kc = 0; kc < 16; ++kc) sacc += *(const f32x4*)(PBP + ((size_t)which * 16 + kc) * 128 + c4);
            v2u o; o.x = pk2(gelu_erf(sacc[0]), gelu_erf(sacc[1])); o.y = pk2(gelu_erf(sacc[2]), gelu_erf(sacc[3]));
            *(LAS v2u*)(H1 + row * 136 + c4) = o;
        }
        __syncthreads();
        if (w < 4) {
            f32x4 o = (f32x4){0.f, 0.f, 0.f, 0.f};
            const bf16* w2 = W2T + (size_t)which * 64 * 128;
#pragma unroll
            for (int ks = 0; ks < 4; ++ks) { const bf16x8 a = *(LAS bf16x8*)(H1 + r16 * 136 + ks * 32 + q4 * 8);
                const bf16x8 bb = *(const bf16x8*)(w2 + (size_t)(w * 16 + r16) * 128 + ks * 32 + q4 * 8);
                o = __builtin_amdgcn_mfma_f32_16x16x32_bf16(a, bb, o, 0, 0, 0); }
            bf16* out = (which == 0 ? KC : VC) + ((size_t)(b * 2 + g) * 128) * 64;
#pragma unroll
            for (int i = 0; i < 4; ++i) { const int row = nb * 16 + 4 * q4 + i; out[(size_t)row * 64 + w * 16 + r16] = row < 127 ? (bf16)f2bf(o[i]) : (bf16)0; }
        }
    }
    __syncthreads();
}
__device__ __forceinline__ void phase_kmean(const Frame& F, const bf16* P, float* KM) {
    const int gw = gwave(F), NGW = ngwave(F), lane = F.lane, rs = lane >> 3, ch = lane & 7;
    for (int un = gw; un < 8 * 8 * 8; un += NGW) { const int h = un & 7, blk = (un >> 3) & 7, b = un >> 6;
        const bf16* base = P + ((size_t)b * SEQ + blk * 256) * NP1 + C_DK + h * 64 + ch * 8;
        float s[8];
#pragma unroll
        for (int e = 0; e < 8; ++e) s[e] = 0.f;
#pragma unroll 8
        for (int i = 0; i < 32; ++i) { const v4u v = *(const v4u*)(base + (size_t)(i * 8 + rs) * NP1);
            s[0] += bflo(v.x); s[1] += bfhi(v.x); s[2] += bflo(v.y); s[3] += bfhi(v.y); s[4] += bflo(v.z); s[5] += bfhi(v.z); s[6] += bflo(v.w); s[7] += bfhi(v.w); }
#pragma unroll
        for (int e = 0; e < 8; ++e) { s[e] += shx(s[e], 8, lane); s[e] += shx(s[e], 16, lane); s[e] = add32(s[e]); }
        if (rs == 0) { float* o = KM + ((size_t)(b * 8 + blk) * 8 + h) * 64 + ch * 8;
            *(f32x4*)o = (f32x4){s[0], s[1], s[2], s[3]} * (1.0f / 256.0f); *(f32x4*)(o + 4) = (f32x4){s[4], s[5], s[6], s[7]} * (1.0f / 256.0f); }
    }
}

constexpr int KT_STRIDE = 144, VT_STRIDE = 192, KT_BYTES = 64 * KT_STRIDE, VT_BYTES = 64 * VT_STRIDE, KV_BUF = KT_BYTES + VT_BYTES;
__device__ __forceinline__ int crow(int r, int hi) { return (r & 3) + 8 * (r >> 2) + 4 * hi; }
struct AttnState { float m, l; f32x16 o0, o1; };
__device__ __forceinline__ void attn_reset(AttnState& st) { st.m = -1e30f; st.l = 0.f;
#pragma unroll
    for (int r = 0; r < 16; ++r) { st.o0[r] = 0.f; st.o1[r] = 0.f; } }
__device__ __forceinline__ s16x4 vtr(LAS const unsigned char* p) { return __builtin_bit_cast(s16x4, __builtin_amdgcn_ds_read_tr16_b64_v4i16((LAS s16x4*)p)); }

__device__ __forceinline__ void attn_scores(LAS const unsigned char* Kt, const bf16x8 (&qr)[4], f32x16& p0, f32x16& p1, int lane) {
    const int r32 = lane & 31, hi = lane >> 5;
#pragma unroll
    for (int r = 0; r < 16; ++r) { p0[r] = 0.f; p1[r] = 0.f; }
#pragma unroll
    for (int s = 0; s < 4; ++s) {
        const bf16x8 a0 = *(LAS const bf16x8*)(Kt + r32 * KT_STRIDE + (2 * s + hi) * 16), a1 = *(LAS const bf16x8*)(Kt + (32 + r32) * KT_STRIDE + (2 * s + hi) * 16);
        p0 = __builtin_amdgcn_mfma_f32_32x32x16_bf16(a0, qr[s], p0, 0, 0, 0);
        p1 = __builtin_amdgcn_mfma_f32_32x32x16_bf16(a1, qr[s], p1, 0, 0, 0);
    }
}
__device__ __forceinline__ void attn_pv(LAS const unsigned char* Vt, const f32x16& e0, const f32x16& e1, f32x16& o0, f32x16& o1, int lane) {
    const int hi = lane >> 5;
    LAS const unsigned char* vb = Vt + (4 * hi + ((lane & 15) >> 2)) * VT_STRIDE + (((lane >> 4) & 1) * 16 + 4 * (lane & 3)) * 2;
#pragma unroll
    for (int s = 0; s < 4; ++s) {
        v4u pw;
        if (s < 2) { pw.x = pk2(e0[8 * s + 0], e0[8 * s + 1]); pw.y = pk2(e0[8 * s + 2], e0[8 * s + 3]); pw.z = pk2(e0[8 * s + 4], e0[8 * s + 5]); pw.w = pk2(e0[8 * s + 6], e0[8 * s + 7]); }
        else { const int t = s - 2; pw.x = pk2(e1[8 * t + 0], e1[8 * t + 1]); pw.y = pk2(e1[8 * t + 2], e1[8 * t + 3]); pw.z = pk2(e1[8 * t + 4], e1[8 * t + 5]); pw.w = pk2(e1[8 * t + 6], e1[8 * t + 7]); }
        const bf16x8 pb = __builtin_bit_cast(bf16x8, pw);
#pragma unroll
        for (int db = 0; db < 2; ++db) {
            const s16x4 lo = vtr(vb + (16 * s) * VT_STRIDE + db * 64), hh = vtr(vb + (16 * s + 8) * VT_STRIDE + db * 64);
            const bf16x8 a = (bf16x8){lo[0], lo[1], lo[2], lo[3], hh[0], hh[1], hh[2], hh[3]};
            if (db == 0) o0 = __builtin_amdgcn_mfma_f32_32x32x16_bf16(a, pb, o0, 0, 0, 0); else o1 = __builtin_amdgcn_mfma_f32_32x32x16_bf16(a, pb, o1, 0, 0, 0);
        }
    }
}
__device__ __forceinline__ float mask_score(float v, int a, int b, int c) {
    const unsigned sg = (unsigned)(((a + c) | (b - c)) >> 31);
    return __builtin_bit_cast(float, (__builtin_bit_cast(unsigned, v) & ~sg) | (0xf149f2cau & sg));
}
__device__ __forceinline__ void attn_tile(LAS const unsigned char* Kt, LAS const unsigned char* Vt, const bf16x8 (&qr)[4], AttnState& st, int kmin, int kmax, int lane) {
    const int hi = lane >> 5;
    f32x16 p0, p1; attn_scores(Kt, qr, p0, p1, lane);
    if (!__all(kmin <= 0 && kmax >= 63)) {
        const int a = 4 * hi - kmin, b = kmax - 4 * hi;
#pragma unroll
        for (int r = 0; r < 16; ++r) { const int c = (r & 3) + 8 * (r >> 2); p0[r] = mask_score(p0[r], a, b, c); p1[r] = mask_score(p1[r], a, b, c + 32); }
    }
    float mx = fmaxf(p0[0], p1[0]);
#pragma unroll
    for (int r = 1; r < 16; ++r) mx = fmaxf(mx, fmaxf(p0[r], p1[r]));
    mx = max32(mx);
    const float mn = fmaxf(st.m, mx), me = fmaxf(mn, -1e29f), alpha = __builtin_amdgcn_exp2f(st.m - me);
    float rs = 0.f;
#pragma unroll
    for (int r = 0; r < 16; ++r) { p0[r] = __builtin_amdgcn_exp2f(p0[r] - me); p1[r] = __builtin_amdgcn_exp2f(p1[r] - me); rs += p0[r] + p1[r]; }
    st.m = mn; st.l = st.l * alpha + rs;
    if (__any(alpha < 1.0f)) {
#pragma unroll
        for (int r = 0; r < 16; ++r) { st.o0[r] *= alpha; st.o1[r] *= alpha; }
    }
    attn_pv(Vt, p0, p1, st.o0, st.o1, lane);
}
struct KVRegs { v4u k, v; };
__device__ __forceinline__ void kv_load(KVRegs& r, const bf16* Kg, const bf16* Vg, size_t ld, int tid) {
    const int key = tid >> 3, ch = tid & 7;
    r.k = *(const v4u*)(Kg + (size_t)key * ld + ch * 8); r.v = *(const v4u*)(Vg + (size_t)key * ld + ch * 8);
}
__device__ __forceinline__ void kv_store(const KVRegs& r, LAS unsigned char* buf, int tid) {
    const int key = tid >> 3, ch = tid & 7;
    *(LAS v4u*)(buf + key * KT_STRIDE + ch * 16) = r.k; *(LAS v4u*)(buf + KT_BYTES + key * VT_STRIDE + ch * 16) = r.v;
}

__device__ __forceinline__ float attn_inv_l(const AttnState& st) { const float l = add32(st.l); return 1.0f / fmaxf(l, 1e-30f); }

#define ATTN_STREAM(Kg, Vg, ld, j0, j1, SKIP, RANGE) do { \
    int jn_ = (j0); while (jn_ < (j1) && (SKIP(jn_))) ++jn_; \
    if (jn_ < (j1)) { KVRegs kv_; kv_load(kv_, (Kg) + (size_t)jn_ * 64 * (ld), (Vg) + (size_t)jn_ * 64 * (ld), (ld), F.tid); \
        __syncthreads(); kv_store(kv_, ring, F.tid); int cur_ = 0; \
        for (;;) { const int j_ = jn_; ++jn_; while (jn_ < (j1) && (SKIP(jn_))) ++jn_; const bool more_ = jn_ < (j1); \
            if (more_) kv_load(kv_, (Kg) + (size_t)jn_ * 64 * (ld), (Vg) + (size_t)jn_ * 64 * (ld), (ld), F.tid); \
            __syncthreads(); \
            { int kmin_, kmax_; RANGE(j_, kmin_, kmax_); \
              if (__any(kmax_ >= kmin_)) attn_tile(ring + cur_ * KV_BUF, ring + cur_ * KV_BUF + KT_BYTES, qr, st, kmin_, kmax_, F.lane); } \
            if (!more_) break; \
            kv_store(kv_, ring + (cur_ ^ 1) * KV_BUF, F.tid); cur_ ^= 1; } } } while (0)

__device__ __forceinline__ void nsa_unit(const Frame& F, const bf16* P, const bf16* KC, const bf16* VC, bf16* O  , int b, int g, int i) {
    LAS unsigned char* ring = F.lds;
    LAS float* impb = (LAS float*)(F.lds + 2 * KV_BUF);
    LAS unsigned* selm = (LAS unsigned*)(F.lds + 2 * KV_BUF + 33792);
    LAS float* stash = (LAS float*)(F.lds + 2 * KV_BUF + 33792 + 256) + F.tid;
    const int lane = F.lane, r32 = lane & 31, hi = lane >> 5, hr = F.wave & 3, th = F.wave >> 2;
    const int tl = 32 * th + r32;
    const int s = 64 * i + tl;
    const size_t row = (size_t)b * SEQ + s;
    const int head = g * 4 + hr;
    bf16x8 qr[4];
#pragma unroll
    for (int d = 0; d < 4; ++d) qr[d] = *(const bf16x8*)(P + row * NP1 + C_CQ + head * 64 + d * 16 + hi * 8);
    const float g0 = sigmoidf_(bf2f(P[row * NP1 + C_CG + head])), g1 = sigmoidf_(bf2f(P[row * NP1 + C_CG + 8 + head])), g2 = sigmoidf_(bf2f(P[row * NP1 + C_CG + 16 + head]));
    AttnState st;
    {
        const bf16* Kg = KC + (size_t)(b * 2 + g) * 128 * 64; const bf16* Vg = VC + (size_t)(b * 2 + g) * 128 * 64;
        const int nmax = (s >= 31) ? ((s - 31) >> 4) : -1;
        { KVRegs kv0, kv1; kv_load(kv0, Kg, Vg, 64, F.tid); kv_load(kv1, Kg + 64 * 64, Vg + 64 * 64, 64, F.tid);
          __syncthreads();
          kv_store(kv0, ring, F.tid); kv_store(kv1, ring + KV_BUF, F.tid); }
        __syncthreads();
        attn_reset(st);
        attn_tile(ring, ring + KT_BYTES, qr, st, 0, nmax < 63 ? nmax : 63, lane);
        attn_tile(ring + KV_BUF, ring + KV_BUF + KT_BYTES, qr, st, 0, nmax - 64 < 63 ? nmax - 64 : 63, lane);
        const float inv = attn_inv_l(st);
        { const float sc = g0 * inv;
#pragma unroll
          for (int r = 0; r < 16; ++r) { stash[r * 512] = st.o0[r] * sc; stash[(16 + r) * 512] = st.o1[r] * sc; } }
        if (i >= 16) {
            float xprev = 0.f; const float mfin = st.m;
#define NSA_IMP(U, ACC, GQ) do { const float G_ = ((ACC[4 * (GQ)] + ACC[4 * (GQ) + 1]) + (ACC[4 * (GQ) + 2] + ACC[4 * (GQ) + 3])), L_ = ACC[4 * (GQ) + 3]; \
                const float x_ = other32(L_, hi); impb[(hr * 64 + tl) * 33 + 2 * (U) + hi] = G_ + (hi ? x_ : xprev); xprev = x_; } while (0)
#pragma unroll
            for (int tile = 0; tile < 2; ++tile) {
                f32x16 a0, a1; attn_scores(ring + tile * KV_BUF, qr, a0, a1, lane);
#pragma unroll
                for (int r = 0; r < 16; ++r) { const int c = (r & 3) + 8 * (r >> 2);
                    a0[r] = __builtin_amdgcn_exp2f(mask_score(a0[r], 4 * hi, nmax - 64 * tile - 4 * hi, c) - mfin) * inv; a1[r] = __builtin_amdgcn_exp2f(mask_score(a1[r], 4 * hi, nmax - 64 * tile - 4 * hi, c + 32) - mfin) * inv; }
                NSA_IMP(8 * tile + 0, a0, 0); NSA_IMP(8 * tile + 1, a0, 1); NSA_IMP(8 * tile + 2, a0, 2); NSA_IMP(8 * tile + 3, a0, 3);
                NSA_IMP(8 * tile + 4, a1, 0); NSA_IMP(8 * tile + 5, a1, 1); NSA_IMP(8 * tile + 6, a1, 2); NSA_IMP(8 * tile + 7, a1, 3);
            }
#undef NSA_IMP
        }
    }
    __syncthreads();
    unsigned mymask;
    if (i < 16) mymask = (2u << i) - 1u;
    else {
        { const int tk = F.tid >> 3, js = F.tid & 7; unsigned bits = 0u;
          float v[4];
#pragma unroll
          for (int e = 0; e < 4; ++e) { const int j = js * 4 + e; v[e] = (impb[(0 * 64 + tk) * 33 + j] + impb[(1 * 64 + tk) * 33 + j]) + (impb[(2 * 64 + tk) * 33 + j] + impb[(3 * 64 + tk) * 33 + j]); }
          int rank[4] = {0, 0, 0, 0};
          for (int jj = 1; jj <= i - 2; ++jj) { const float o = (impb[(0 * 64 + tk) * 33 + jj] + impb[(1 * 64 + tk) * 33 + jj]) + (impb[(2 * 64 + tk) * 33 + jj] + impb[(3 * 64 + tk) * 33 + jj]);
#pragma unroll
              for (int e = 0; e < 4; ++e) { const int j = js * 4 + e; rank[e] += (o > v[e] || (o == v[e] && jj < j)) ? 1 : 0; } }
#pragma unroll
          for (int e = 0; e < 4; ++e) { const int j = js * 4 + e; const bool forced = (j == 0) || (j == i) || (j == i - 1); const bool cand = (j >= 1) && (j <= i - 2);
              if (forced || (cand && rank[e] < 13)) bits |= 1u << j; }
          bits |= shxu(bits, 1, F.lane); bits |= shxu(bits, 2, F.lane); bits |= shxu(bits, 4, F.lane);
          if (js == 0) selm[tk] = bits; }
        __syncthreads();
        mymask = selm[tl];
    }
    {
        attn_reset(st);
        const bf16* Kg = P + (size_t)b * SEQ * NP1 + C_KS + g * 64; const bf16* Vg = P + (size_t)b * SEQ * NP1 + C_VS + g * 64;
#define NSA_SKIP(j) (false)
#define NSA_RANGE(j, kmin, kmax) do { kmin = 0; kmax = ((mymask >> (j)) & 1u) ? ((j) == i ? tl : 63) : -1; } while (0)
        ATTN_STREAM(Kg, Vg, (size_t)NP1, 0, i + 1, NSA_SKIP, NSA_RANGE);
#undef NSA_RANGE
        const float sc = g1 * attn_inv_l(st);
#pragma unroll
        for (int r = 0; r < 16; ++r) { stash[r * 512] += st.o0[r] * sc; stash[(16 + r) * 512] += st.o1[r] * sc; }
    }
    {
        attn_reset(st);
        const bf16* Kg = P + (size_t)b * SEQ * NP1 + C_KW + g * 64; const bf16* Vg = P + (size_t)b * SEQ * NP1 + C_VW + g * 64;
        const int jlo = i >= 8 ? i - 8 : 0; f32x16 out0, out1;
#define NSA_RANGE(j, kmin, kmax) do { const int d_ = 64 * (i - (j)) + tl; kmin = d_ - 511 > 0 ? d_ - 511 : 0; kmax = d_ < 63 ? d_ : 63; } while (0)
        ATTN_STREAM(Kg, Vg, (size_t)NP1, jlo, i + 1, NSA_SKIP, NSA_RANGE);
#undef NSA_RANGE
#undef NSA_SKIP
        const float sc = g2 * attn_inv_l(st);
#pragma unroll
        for (int r = 0; r < 16; ++r) { out0[r] = stash[r * 512] + st.o0[r] * sc; out1[r] = stash[(16 + r) * 512] + st.o1[r] * sc; }
        bf16* orow = O + row * 512 + head * 64;
#pragma unroll
        for (int gq = 0; gq < 4; ++gq) {
            v2u w0; w0.x = pk2(out0[4 * gq], out0[4 * gq + 1]); w0.y = pk2(out0[4 * gq + 2], out0[4 * gq + 3]); *(v2u*)(orow + 8 * gq + 4 * hi) = w0;
            v2u w1; w1.x = pk2(out1[4 * gq], out1[4 * gq + 1]); w1.y = pk2(out1[4 * gq + 2], out1[4 * gq + 3]); *(v2u*)(orow + 32 + 8 * gq + 4 * hi) = w1; }
    }
}
__device__ __forceinline__ void phase_nsa(const Frame& F, const bf16* P, const bf16* KC, const bf16* VC, bf16* O) {
    for (int un2 = 2 * F.bid; un2 < 512; un2 += 2 * F.G)
#pragma unroll 1
        for (int k = 0; k < 2; ++k) { const int un = un2 >> 1, ip = un & 15, g = (un >> 4) & 1, b = un >> 5; nsa_unit(F, P, KC, VC, O, b, g, k == 0 ? 31 - ip : ip); }
}

__device__ __forceinline__ void moba_unit(const Frame& F, const bf16* P, const float* KM, bf16* O  , int b, int h, int qb) {
    LAS unsigned char* ring = F.lds;
    LAS float* kml = (LAS float*)(F.lds + 2 * KV_BUF);
    LAS unsigned* uni = (LAS unsigned*)(F.lds + 2 * KV_BUF + 2048);
    const int lane = F.lane, r32 = lane & 31, hi = lane >> 5;
    const int tl = 32 * F.wave + r32;
    const size_t row = (size_t)b * SEQ + 256 * qb + tl;
    bf16x8 qr[4];
#pragma unroll
    for (int d = 0; d < 4; ++d) qr[d] = *(const bf16x8*)(P + row * NP1 + C_DQ + h * 64 + d * 16 + hi * 8);
    __syncthreads();
    { const int blk = F.tid >> 6, p = F.tid & 63; kml[F.tid] = KM[((size_t)(b * 8 + blk) * 8 + h) * 64 + p]; if (F.tid == 0) uni[0] = 0u; }
    __syncthreads();
    unsigned mymask = 0u;
    if (qb > 0) {
        float gt[8];
#pragma unroll
        for (int n = 0; n < 8; ++n) { float a = 0.f;
#pragma unroll
            for (int d = 0; d < 4; ++d) { const v4u qw = __builtin_bit_cast(v4u, qr[d]); const LAS float* km = kml + n * 64 + d * 16 + hi * 8;
                a += bflo(qw.x) * km[0] + bfhi(qw.x) * km[1] + bflo(qw.y) * km[2] + bfhi(qw.y) * km[3] + bflo(qw.z) * km[4] + bfhi(qw.z) * km[5] + bflo(qw.w) * km[6] + bfhi(qw.w) * km[7]; }
            a = add32(a); gt[n] = a; }
#pragma unroll
        for (int n = 0; n < 8; ++n) { int rank = 0;
#pragma unroll
            for (int m = 0; m < 8; ++m) rank += (m < qb && m != n && (gt[m] > gt[n] || (gt[m] == gt[n] && m < n))) ? 1 : 0;
            if (n < qb && rank < 3) mymask |= 1u << n; }
        atomicOr((unsigned*)uni, mymask);
    }
    __syncthreads();
    const unsigned um = uni[0];
    AttnState st; attn_reset(st);
    const bf16* Kg = P + (size_t)b * SEQ * NP1 + C_DK + h * 64; const bf16* Vg = P + (size_t)b * SEQ * NP1 + C_DV + h * 64;
#define MOBA_SKIP(j) ((j) < 4 * qb && !((um >> ((j) >> 2)) & 1u))
#define MOBA_RANGE(j, kmin, kmax) do { kmin = 0; if ((j) < 4 * qb) kmax = ((mymask >> ((j) >> 2)) & 1u) ? 63 : -1; else { const int d_ = tl - 64 * ((j) - 4 * qb); kmax = d_ < 63 ? d_ : 63; } } while (0)
    ATTN_STREAM(Kg, Vg, (size_t)NP1, 0, 4 * qb + 4, MOBA_SKIP, MOBA_RANGE);
#undef MOBA_SKIP
#undef MOBA_RANGE
    const float sc = attn_inv_l(st);
    bf16* orow = O + row * 512 + h * 64;
#pragma unroll
    for (int gq = 0; gq < 4; ++gq) {
        v2u w0; w0.x = pk2(st.o0[4 * gq] * sc, st.o0[4 * gq + 1] * sc); w0.y = pk2(st.o0[4 * gq + 2] * sc, st.o0[4 * gq + 3] * sc); *(v2u*)(orow + 8 * gq + 4 * hi) = w0;
        v2u w1; w1.x = pk2(st.o1[4 * gq] * sc, st.o1[4 * gq + 1] * sc); w1.y = pk2(st.o1[4 * gq + 2] * sc, st.o1[4 * gq + 3] * sc); *(v2u*)(orow + 32 + 8 * gq + 4 * hi) = w1; }
}
__device__ __forceinline__ void phase_moba(const Frame& F, const bf16* P, const float* KM, bf16* O) {
    for (int un2 = 2 * F.bid; un2 < 512; un2 += 2 * F.G)
#pragma unroll 1
        for (int k = 0; k < 2; ++k) { const int un = un2 >> 1, qp = un & 3, h = (un >> 2) & 7, b = un >> 5; moba_unit(F, P, KM, O, b, h, k == 0 ? 7 - qp : qp); }
}

__device__ __forceinline__ unsigned ord_key(float x) { const unsigned u = __builtin_bit_cast(unsigned, x); return (u & 0x80000000u) ? ~u : (u | 0x80000000u); }
__device__ __forceinline__ float ord_val(unsigned k) { const unsigned u = (k & 0x80000000u) ? (k & 0x7fffffffu) : ~k; return __builtin_bit_cast(float, u); }
constexpr int SK_STRIDE = 272;
__device__ __forceinline__ void peer_route_unit(const Frame& F, const bf16* Q2, const bf16* SUBK  , int* EIDX, float* EW, int tb, int h) {
    LAS unsigned char* skl = F.lds;
    LAS unsigned* slot = (LAS unsigned*)(F.lds + 36864) + F.tid;
    const int lane = F.lane, r32 = lane & 31, hi = lane >> 5;
    const size_t tok = (size_t)tb * 256 + F.wave * 32 + r32;
#pragma unroll 1
    for (int p = 0; p < 2; ++p) {
        __syncthreads();
        for (int i = F.tid; i < 128 * 16; i += NTHR) { const int ch = i & 15, rowi = i >> 4;
            *(LAS v4u*)(skl + rowi * SK_STRIDE + ch * 16) = *(const v4u*)(SUBK + ((size_t)h * 256 + p * 128 + rowi) * 128 + ch * 8); }
        __syncthreads();
        bf16x8 qf[8]; float ss = 0.f;
#pragma unroll
        for (int s = 0; s < 8; ++s) { qf[s] = *(const bf16x8*)(Q2 + tok * 2048 + h * 256 + p * 128 + s * 16 + hi * 8); const v4u w = __builtin_bit_cast(v4u, qf[s]);
            const float a0 = bflo(w.x), a1 = bfhi(w.x), a2 = bflo(w.y), a3 = bfhi(w.y), a4 = bflo(w.z), a5 = bfhi(w.z), a6 = bflo(w.w), a7 = bfhi(w.w);
            ss += (a0 * a0 + a1 * a1) + (a2 * a2 + a3 * a3) + (a4 * a4 + a5 * a5) + (a6 * a6 + a7 * a7); }
        ss = add32(ss);
        const float rn = 1.0f / sqrtf(ss * (1.0f / 128.0f) + NORM_EPS);
        unsigned key[64];
#pragma unroll
        for (int nb = 0; nb < 4; ++nb) { f32x16 acc;
#pragma unroll
            for (int r = 0; r < 16; ++r) acc[r] = 0.f;
#pragma unroll
            for (int s = 0; s < 8; ++s) { const bf16x8 a = *(LAS const bf16x8*)(skl + (nb * 32 + r32) * SK_STRIDE + (2 * s + hi) * 16);
                acc = __builtin_amdgcn_mfma_f32_32x32x16_bf16(a, qf[s], acc, 0, 0, 0); }
#pragma unroll
            for (int r = 0; r < 16; ++r) { const int n = nb * 32 + crow(r, hi); key[nb * 16 + r] = (ord_key(acc[r] * rn) & 0xffffff80u) | (unsigned)(127 - n); } }
#pragma unroll 1
        for (int k = 0; k < 16; ++k) { unsigned m = key[0];
#pragma unroll
            for (int e = 1; e < 64; ++e) m = m > key[e] ? m : key[e];
            m = umax32(m);
            slot[(p * 16 + k) * 512] = m;
#pragma unroll
            for (int e = 0; e < 64; ++e) key[e] = key[e] == m ? 0u : key[e]; }
    }
    LDS_WAIT(); asm volatile("" ::: "memory");
    unsigned ck[50];
    { float v1[16], v2[16];
#pragma unroll
      for (int k = 0; k < 16; ++k) { v1[k] = ord_val(slot[k * 512] & 0xffffff80u); v2[k] = ord_val(slot[(16 + k) * 512] & 0xffffff80u); }
      int c = 0;
#pragma unroll
      for (int a = 0; a < 16; ++a)
#pragma unroll
          for (int bq = 0; bq < 16; ++bq) if ((a + 1) * (bq + 1) <= 16) { ck[c] = (ord_key(v1[a] + v2[bq]) & 0xffffff00u) | (unsigned)(255 - (16 * a + bq)); ++c; } }
    float den = 0.f, mx = 0.f;
#pragma unroll 1
    for (int k = 0; k < 16; ++k) { unsigned m = ck[0];
#pragma unroll
        for (int e = 1; e < 50; ++e) m = m > ck[e] ? m : ck[e];
#pragma unroll
        for (int e = 0; e < 50; ++e) ck[e] = ck[e] == m ? 0u : ck[e];
        const int ci = 255 - (int)(m & 255u), a = ci >> 4, bq = ci & 15;
        const unsigned ka = slot[a * 512], kb = slot[(16 + bq) * 512];
        const int te = (127 - (int)(ka & 127u)) * 128 + (127 - (int)(kb & 127u));
        const float tvk = ord_val(m & 0xffffff00u);
        if (k == 0) mx = tvk;
        const float ek = __expf(tvk - mx); den += ek;
        slot[(32 + k) * 512] = __builtin_bit_cast(unsigned, ek);
        if (hi == 0) EIDX[(tok * 8 + h) * 16 + k] = te; }
    LDS_WAIT(); asm volatile("" ::: "memory");
    if (hi == 0) { const float inv = 1.0f / den; float* ewp = EW + (tok * 8 + h) * 16;
#pragma unroll
        for (int q = 0; q < 4; ++q) *(f32x4*)(ewp + 4 * q) = (f32x4){__builtin_bit_cast(float, slot[(32 + 4 * q) * 512]), __builtin_bit_cast(float, slot[(33 + 4 * q) * 512]),
                                                                      __builtin_bit_cast(float, slot[(34 + 4 * q) * 512]), __builtin_bit_cast(float, slot[(35 + 4 * q) * 512])} * inv; }
}

__device__ __forceinline__ void phase_peer_route(const Frame& F, const bf16* Q2, const bf16* SUBK, int* EIDX, float* EW) {
    for (int un = F.bid; un < 64 * 8; un += F.G) peer_route_unit(F, Q2, SUBK, EIDX, EW, un >> 3, un & 7);
}

__device__ __forceinline__ void phase_peer_tables(const Frame& F, const float* U, const float* V, unsigned char* UT8, unsigned char* VT8, float* SU, float* SV) {
    const int gw = gwave(F), NGW = ngwave(F), lane = F.lane;
    for (int r = gw; r < 2 * 16384; r += NGW) {
        const int tab = r >> 14, e = r & 16383; const float* src = (tab ? V : U) + (size_t)e * DM + 16 * lane;
        f32x4 x[4]; float mx = 0.f;
#pragma unroll
        for (int q = 0; q < 4; ++q) { x[q] = *(const f32x4*)(src + 4 * q); mx = fmaxf(fmaxf(mx, fmaxf(fabsf(x[q][0]), fabsf(x[q][1]))), fmaxf(fabsf(x[q][2]), fabsf(x[q][3]))); }
#pragma unroll
        for (int o = 1; o < 32; o <<= 1) mx = fmaxf(mx, shx(mx, o, lane));
        mx = max32(mx);
        int ex = 0; (void)frexpf(mx, &ex);
        const int k = (mx > 0.f) ? (8 - ex) : 0;
        const float sc = __builtin_ldexpf(1.0f, k), inv = __builtin_ldexpf(1.0f, -k);
        v4u w;
#pragma unroll
        for (int q = 0; q < 4; ++q) { unsigned p = 0u; p = __builtin_amdgcn_cvt_pk_fp8_f32(x[q][0] * sc, x[q][1] * sc, p, false); p = __builtin_amdgcn_cvt_pk_fp8_f32(x[q][2] * sc, x[q][3] * sc, p, true); w[q] = p; }
        *(v4u*)((tab ? VT8 : UT8) + ((size_t)(lane >> 3) * 16384 + e) * 128 + (lane & 7) * 16) = w;
        if (lane == 0) (tab ? SV : SU)[e] = inv;
    }
}
typedef _Float16 h16x2 __attribute__((ext_vector_type(2)));
typedef __fp16 fp16x2_t __attribute__((ext_vector_type(2)));
__device__ __forceinline__ void phase_peer_u(const Frame& F, const bf16* H2, const unsigned char* UT8, const float* SU, const int* EIDX, float* PART, unsigned emask = 0x3fffu) {
    const int lane = F.lane, g = lane >> 3, sub = lane & 7, b0 = lane & 1, b1 = (lane >> 1) & 1, b2 = (lane >> 2) & 1;
    const int s = F.bid & 7, wgq = F.bid >> 3, nq = F.G >> 3;
    LAS int* il = (LAS int*)(F.lds + F.wave * 8192);
    LAS float* pcl = (LAS float*)(F.lds + F.wave * 8192 + 4096);
    const unsigned char* ub = UT8 + (size_t)s * 16384 * 128 + sub * 16;
    for (int batch = wgq * 8 + F.wave; batch < TOK / 8; batch += nq * 8) {
        const int t0 = batch * 8, t = t0 + g;
        { const v4u* src = (const v4u*)(EIDX + (size_t)t0 * 128 + lane * 16);
          const v4u i0 = src[0], i1 = src[1], i2 = src[2], i3 = src[3];
          LAS v4u* dst = (LAS v4u*)(il + lane * 16); dst[0] = i0 & emask; dst[1] = i1 & emask; dst[2] = i2 & emask; dst[3] = i3 & emask; }
        h16x2 h[8];
        { const v4u ha = *(const v4u*)(H2 + (size_t)t * DM + s * 128 + sub * 16), hb = *(const v4u*)(H2 + (size_t)t * DM + s * 128 + sub * 16 + 8);
          h[0] = (h16x2){(_Float16)bflo(ha.x), (_Float16)bfhi(ha.x)}; h[1] = (h16x2){(_Float16)bflo(ha.y), (_Float16)bfhi(ha.y)}; h[2] = (h16x2){(_Float16)bflo(ha.z), (_Float16)bfhi(ha.z)}; h[3] = (h16x2){(_Float16)bflo(ha.w), (_Float16)bfhi(ha.w)};
          h[4] = (h16x2){(_Float16)bflo(hb.x), (_Float16)bfhi(hb.x)}; h[5] = (h16x2){(_Float16)bflo(hb.y), (_Float16)bfhi(hb.y)}; h[6] = (h16x2){(_Float16)bflo(hb.z), (_Float16)bfhi(hb.z)}; h[7] = (h16x2){(_Float16)bflo(hb.w), (_Float16)bfhi(hb.w)}; }
        LDS_WAIT(); asm volatile("" ::: "memory");
#define PU_LOAD(c, ua, su_) do { const v4u ia = *(LAS v4u*)(il + g * 128 + (c) * 8), ib = *(LAS v4u*)(il + g * 128 + (c) * 8 + 4); \
            ua[0] = *(const v4u*)(ub + (size_t)ia.x * 128); ua[1] = *(const v4u*)(ub + (size_t)ia.y * 128); ua[2] = *(const v4u*)(ub + (size_t)ia.z * 128); ua[3] = *(const v4u*)(ub + (size_t)ia.w * 128); \
            ua[4] = *(const v4u*)(ub + (size_t)ib.x * 128); ua[5] = *(const v4u*)(ub + (size_t)ib.y * 128); ua[6] = *(const v4u*)(ub + (size_t)ib.z * 128); ua[7] = *(const v4u*)(ub + (size_t)ib.w * 128); \
            su_ = SU[il[g * 128 + (c) * 8 + sub]]; } while (0)
#define PU_COMP(c, ua, su_) do { float a[8]; \
            _Pragma("unroll") for (int j = 0; j < 8; ++j) { float acc = 0.f; \
                _Pragma("unroll") for (int q = 0; q < 4; ++q) { acc = __builtin_amdgcn_fdot2(__builtin_bit_cast(h16x2, __builtin_amdgcn_cvt_scalef32_pk_f16_fp8(ua[j][q], 1.0f, false)), h[2 * q], acc, false); \
                    acc = __builtin_amdgcn_fdot2(__builtin_bit_cast(h16x2, __builtin_amdgcn_cvt_scalef32_pk_f16_fp8(ua[j][q], 1.0f, true)), h[2 * q + 1], acc, false); } \
                a[j] = acc; } \
            float bq[4], cc[2]; \
            _Pragma("unroll") for (int p = 0; p < 4; ++p) { const float keep = b0 ? a[2 * p + 1] : a[2 * p], send = b0 ? a[2 * p] : a[2 * p + 1]; bq[p] = keep + shx(send, 1, lane); } \
            _Pragma("unroll") for (int q = 0; q < 2; ++q) { const float keep = b1 ? bq[2 * q + 1] : bq[2 * q], send = b1 ? bq[2 * q] : bq[2 * q + 1]; cc[q] = keep + shx(send, 2, lane); } \
            { const float keep = b2 ? cc[1] : cc[0], send = b2 ? cc[0] : cc[1]; pcl[(c) * 64 + lane] = (keep + shx(send, 4, lane)) * su_; } } while (0)
        { v4u uA[8], uB[8]; float sA, sB;
          PU_LOAD(0, uA, sA);
#pragma unroll 1
          for (int c = 0; c < 16; c += 2) {
              PU_LOAD(c + 1, uB, sB);
              PU_COMP(c, uA, sA);
              if (c + 2 < 16) PU_LOAD(c + 2, uA, sA);
              PU_COMP(c + 1, uB, sB);
          } }
#undef PU_LOAD
#undef PU_COMP
        LDS_WAIT(); asm volatile("" ::: "memory");
        float* dst = PART + ((size_t)s * TOK + t) * 128 + sub;
#pragma unroll
        for (int c = 0; c < 16; ++c) dst[8 * c] = pcl[c * 64 + lane];
        LDS_WAIT(); asm volatile("" ::: "memory");
    }
}
__device__ __forceinline__ float gelu_as(float v) {
    const float av = fabsf(v), t = __builtin_amdgcn_rcpf(av * 0.2316418882f + 1.0f);
    float q = t * 0.5307027145f + (-0.7265760135f); q = q * t + 0.7107068705f; q = q * t + (-0.142248368f); q = q * t + 0.127414796f; q = q * t;
    const float m = v * (q * __builtin_amdgcn_exp2f((v * v) * (-0.72134752044f)));
    return v < 0.f ? m : v - m;
}
__device__ __forceinline__ void phase_peer_w(const Frame& F, const float* SV, const int* EIDX, const float* EW, const float* PART, v2u* COEF) {
    const int nth = F.G * NTHR;
    for (int i = F.bid * NTHR + F.tid; i < TOK * 128; i += nth) {
        float act = 0.f;
#pragma unroll
        for (int sp = 0; sp < 8; ++sp) act += PART[(size_t)sp * TOK * 128 + i];
        const int e = EIDX[i]; const float c = EW[i] * gelu_as(act) * SV[e];
        COEF[i] = (v2u){(unsigned)e, __builtin_bit_cast(unsigned, c)};
    }
}
__device__ __forceinline__ void phase_peer_v(const Frame& F, const unsigned char* VT8, const v2u* COEF, float* XB, const float* gate, unsigned emask = 0x3fffu) {
    const int lane = F.lane, g = lane >> 3, sub = lane & 7;
    const int s = F.bid & 7, wgq = F.bid >> 3, nq = F.G >> 3;
    LAS v2u* wl = (LAS v2u*)(F.lds + F.wave * 8192);
    const unsigned char* vb = VT8 + (size_t)s * 16384 * 128 + sub * 16;
    for (int batch = wgq * 8 + F.wave; batch < TOK / 8; batch += nq * 8) {
        const int t0 = batch * 8, t = t0 + g;
        { const v4u* src = (const v4u*)(COEF + (size_t)t0 * 128) + lane * 8;
          v4u c[8];
#pragma unroll
          for (int q = 0; q < 8; ++q) c[q] = src[q];
          LAS v4u* dst = (LAS v4u*)wl + lane * 8;
#pragma unroll
          for (int q = 0; q < 8; ++q) { v4u x = c[q]; x.x &= emask; x.z &= emask; dst[q] = x; } }
        LDS_WAIT(); asm volatile("" ::: "memory");
        h16x2 o[8];
#pragma unroll
        for (int q = 0; q < 8; ++q) o[q] = (h16x2){(_Float16)0.f, (_Float16)0.f};
#define PV_LOAD(c, pr, va) do { \
            _Pragma("unroll") for (int q = 0; q < 4; ++q) pr[q] = *(LAS v4u*)(wl + g * 128 + (c) * 8 + 2 * q); \
            _Pragma("unroll") for (int q = 0; q < 4; ++q) { va[2 * q] = *(const v4u*)(vb + (size_t)pr[q].x * 128); va[2 * q + 1] = *(const v4u*)(vb + (size_t)pr[q].z * 128); } } while (0)
#define PV_COMP(pr, va) do { \
            _Pragma("unroll") for (int j = 0; j < 8; ++j) { const unsigned cb = (j & 1) ? pr[j >> 1].w : pr[j >> 1].y; \
                const float s2 = __builtin_bit_cast(float, cb & 0x7f800000u); const _Float16 mh = (_Float16)__builtin_bit_cast(float, (cb & 0x807fffffu) | 0x3f800000u); const h16x2 m2 = (h16x2){mh, mh}; \
                _Pragma("unroll") for (int q = 0; q < 4; ++q) { o[2 * q] = __builtin_elementwise_fma(__builtin_bit_cast(h16x2, __builtin_amdgcn_cvt_scalef32_pk_f16_fp8(va[j][q], s2, false)), m2, o[2 * q]); \
                    o[2 * q + 1] = __builtin_elementwise_fma(__builtin_bit_cast(h16x2, __builtin_amdgcn_cvt_scalef32_pk_f16_fp8(va[j][q], s2, true)), m2, o[2 * q + 1]); } } } while (0)
        { v4u pA[4], pB[4], vA[8], vB[8];
          PV_LOAD(0, pA, vA);
#pragma unroll 1
          for (int c = 0; c < 16; c += 2) {
              PV_LOAD(c + 1, pB, vB);
              PV_COMP(pA, vA);
              if (c + 2 < 16) PV_LOAD(c + 2, pA, vA);
              PV_COMP(pB, vB);
          } }
#undef PV_LOAD
#undef PV_COMP
        const int bb = t / SEQ; float* xr = XB + (size_t)t * DM + s * 128 + sub * 16; const float* gr = gate + (size_t)bb * 6144 + s * 128 + sub * 16;
#pragma unroll
        for (int q = 0; q < 4; ++q) { const f32x4 x = *(const f32x4*)(xr + 4 * q), gg = *(const f32x4*)(gr + 4 * q);
            *(f32x4*)(xr + 4 * q) = x + gg * (f32x4){(float)o[2 * q].x, (float)o[2 * q].y, (float)o[2 * q + 1].x, (float)o[2 * q + 1].y}; }
        LDS_WAIT(); asm volatile("" ::: "memory");
    }
}

constexpr int NPL = 14, NPHASE = 1 + DEPTH * NPL + 1;
constexpr int CW_BAR = 1024;
static_assert((CW_BAR + XCD_BAR_WORDS) * 4 <= (int)CTL_ZERO_BYTES, "barrier words inside the memset region");

__global__ void __launch_bounds__(NTHR, 2) hybrid_fwd(Args args) {
    extern __shared__ __attribute__((aligned(16))) unsigned char lds[];
    Frame F;
    F.lds = (LAS unsigned char*)lds; F.ldsg = lds;
    F.tid = threadIdx.x; F.lane = F.tid & 63; F.wave = __builtin_amdgcn_readfirstlane(F.tid >> 6);
    F.G = gridDim.x; F.bid = blockIdx.x; F.ws = args.ws;
    GAS unsigned char* wsg = (GAS unsigned char*)args.ws;
#define WSP ((unsigned char*)wsg)
    volatile LAS unsigned* MISC = (volatile LAS unsigned*)(F.lds + MISC_OFF);
    for (int u = F.tid; u < 64; u += NTHR) ((LAS unsigned*)(F.lds + MISC_OFF))[u] = 0u;
    __syncthreads();
    XcdBarrier bar; bar.bar = (unsigned*)(WSP + WS_CTL) + CW_BAR; bar.x = 0; bar.st = nullptr;
    const int lo = args.ph_lo, hi = args.ph_hi;
    if (hi - lo > 1) bar = xcd_barrier_post((unsigned*)(WSP + WS_CTL) + CW_BAR, MISC + 8);
#ifndef PHMASK
#define PHMASK 0xffffffffu
#endif
#define PM(j) ((PHMASK >> (j)) & 1u)
#ifndef DUMMY_EMASK
#define DUMMY_EMASK 0x3fffu
#endif
#ifndef RPMASK
#define RPMASK 0u
#endif
#define RP(j) for (int rp_ = 0; rp_ < 1 + (int)((RPMASK >> (j)) & 1u); ++rp_)
#define LASTRP(j) (rp_ == (int)((RPMASK >> (j)) & 1u))
#define IN(k) (lo <= (k) && (k) < hi)
#define SEAM(k) do { if (IN(k) && IN((k) + 1)) { xcd_barrier(bar); if ((RPMASK >> 30) & 1u) xcd_barrier(bar); } } while (0)

    typedef __attribute__((address_space(4))) const Args* KArgs;
    KArgs ap = (KArgs)__builtin_amdgcn_kernarg_segment_ptr();
#define FRESH() asm volatile("" : "+s"(ap), "+s"(wsg)); Frame Fp = F; asm volatile("" : "+v"(Fp.tid)); Fp.lane = Fp.tid & 63; asm volatile("" : "+s"(Fp.wave), "+s"(Fp.bid), "+s"(Fp.G)); Fp.ws = WSP; LAS unsigned char* ring = Fp.lds; asm volatile("" : "+s"(ring)); Fp.lds = ring
#define INP(i) ((const float*)(GAS const float*)ap->in[i])
#define WIN_ ((bf16*)(WSP + WS_WIN))
#define WOUT_ ((bf16*)(WSP + WS_WOUT))
#define WOT_ ((bf16*)(WSP + WS_WO))
#define WQT_ ((bf16*)(WSP + WS_WQ))
#define W1T_ ((bf16*)(WSP + WS_W1T))
#define SUBK_ ((bf16*)(WSP + WS_SUBK))
#define W2T_ ((bf16*)(WSP + WS_SMALL + SM_W2T))
#define MOD_ ((float*)(WSP + WS_MOD))
#define COS_ ((const float*)(WSP + WS_COS))
#define SIN_ ((const float*)(WSP + WS_SIN))
#define KMEAN_ ((float*)(WSP + WS_SMALL + SM_KMEAN))
#define KCMP_ ((bf16*)(WSP + WS_SMALL + SM_KCMP))
#define VCMP_ ((bf16*)(WSP + WS_SMALL + SM_VCMP))
#define PBP_ ((float*)(WSP + WS_SMALL + SM_PBP))
#define EIDX_ ((int*)(WSP + WS_EIDX))
#define EW_ ((float*)(WSP + WS_EW))
#define HN_ ((bf16*)(WSP + WS_HN))
#define MIX_ ((bf16*)(WSP + WS_MIX))
#define PROJ_ ((bf16*)(WSP + WS_BIG))
#define GATES_ ((bf16*)(WSP + WS_BIG))
#define UT_ ((unsigned char*)(WSP + WS_BIG))
#define VT_ ((unsigned char*)(WSP + WS_BIG + 16 * MiB))
#define SU_ ((float*)(WSP + WS_BIG + 32 * MiB))
#define SV_ ((float*)(WSP + WS_BIG + 32 * MiB + 65536))
#define COEF_ ((v2u*)(WSP + WS_BIG + 33 * MiB))
#define Q2_ ((bf16*)(WSP + WS_BIG + 64 * MiB))
#define PART_ ((float*)(WSP + WS_BIG + 64 * MiB))
#define XB_ ((float*)(GAS float*)ap->out)
#define MODL_ (MOD_ + (size_t)l * 8 * 6144)
#define XIN_ ((l == 0) ? INP(I_X) : (const float*)XB_)

    if (PM(0) && IN(0)) RP(0) { FRESH(); phase_prologue(Fp, ap); }
    SEAM(0);
#pragma unroll 1
    for (int l = 0; l < DEPTH; ++l) {
        const int p0 = 1 + l * NPL;
        if (PM(1) && IN(p0 + 0)) RP(1) { FRESH(); phase_norm_mod(Fp, XIN_, INP(I_NMG) + l * DM, MODL_ + 0, MODL_ + 1024, HN_); }
        SEAM(p0 + 0);
        if (PM(2) && IN(p0 + 1)) RP(2) { FRESH(); pg8::Gemm g{HN_, WIN_ + (size_t)l * NWIN * DM, TOK, NP1, DM}; pg8::StaticOrder S; S.init(TOK, NP1, Fp.G, Fp.bid);
            epi::EpiProj1 E{PROJ_, COS_, SIN_}; pg8::gemm_phase<epi::EpiProj1, pg8::StaticOrder, true, true>(ring, g, S, E, Fp.tid); }
        SEAM(p0 + 1);
        if (PM(3) && IN(p0 + 2)) RP(3) {
            { FRESH(); phase_compress(Fp, PROJ_, W1T_ + (size_t)l * 2 * 128 * 2048, W2T_ + (size_t)l * 2 * 64 * 128, PBP_ + (size_t)l * 2 * 16 * 128, KCMP_, VCMP_); }
            { FRESH(); phase_kmean(Fp, PROJ_, KMEAN_); }
            { FRESH(); phase_mixer_a(Fp, PROJ_, INP(I_ACW) + (size_t)l * 3 * 512, MIX_); }
            __syncthreads();
            { FRESH(); phase_mixer_b(Fp, PROJ_, INP(I_BCW) + (size_t)l * 31 * 512, INP(I_BCB) + l * 512, INP(I_BLNG) + l * 512, INP(I_BLNB) + l * 512, MIX_ + (size_t)TOK * 512); }
            __syncthreads();
        }
        SEAM(p0 + 2);
        if (PM(4) && IN(p0 + 3)) RP(4) { FRESH(); phase_nsa(Fp, PROJ_, KCMP_, VCMP_, MIX_ + (size_t)2 * TOK * 512); __syncthreads(); }
        SEAM(p0 + 3);
        if (PM(5) && IN(p0 + 4)) RP(5) { FRESH(); phase_moba(Fp, PROJ_, KMEAN_, MIX_ + (size_t)3 * TOK * 512); __syncthreads(); }
        SEAM(p0 + 4);
        if (PM(6) && IN(p0 + 5)) RP(6) { FRESH(); pg8::Gemm g{HN_, WIN_ + ((size_t)l * NWIN + NP1) * DM, TOK, NGT, DM}; pg8::StaticOrder S; S.init(TOK, NGT, Fp.G, Fp.bid);
            epi::EpiStore<1> E{GATES_, NGT}; pg8::gemm_phase<epi::EpiStore<1>, pg8::StaticOrder, true, true>(ring, g, S, E, Fp.tid); }
        SEAM(p0 + 5);
        if (PM(7) && IN(p0 + 6)) RP(7) {
#pragma unroll 1
            for (int seg = 0; seg < 4; ++seg) { FRESH(); pg8::Gemm g{MIX_ + (size_t)seg * TOK * 512, WOUT_ + (size_t)(l * 4 + seg) * DM * 512, TOK, DM, 512}; pg8::StaticOrder S; S.init(TOK, DM, Fp.G, Fp.bid);
                epi::EpiMerge E{HN_, GATES_, seg}; pg8::gemm_phase<epi::EpiMerge, pg8::StaticOrder, true, true>(ring, g, S, E, Fp.tid); }
        }
        SEAM(p0 + 6);
        if (PM(8) && IN(p0 + 7)) RP(8) { FRESH(); pg8::Gemm g{HN_, WOT_ + (size_t)l * DM * DM, TOK, DM, DM}; pg8::StaticOrder S; S.init(TOK, DM, Fp.G, Fp.bid);
            epi::EpiResid E{XIN_, LASTRP(8) ? XB_ : (float*)MIX_, MODL_ + 2048}; pg8::gemm_phase<epi::EpiResid, pg8::StaticOrder, true, true>(ring, g, S, E, Fp.tid); }
        SEAM(p0 + 7);
        if (PM(9) && IN(p0 + 8)) RP(9) {
            { FRESH(); phase_norm_mod(Fp, XB_, INP(I_NFG) + l * DM, MODL_ + 3072, MODL_ + 4096, HN_); }
            { FRESH(); phase_peer_tables(Fp, INP(I_PU) + (size_t)l * 16384 * DM, INP(I_PV) + (size_t)l * 16384 * DM, UT_, VT_, SU_, SV_); }
        }
        SEAM(p0 + 8);
        if (PM(10) && IN(p0 + 9)) RP(10) { FRESH(); pg8::Gemm g{HN_, WQT_ + (size_t)l * 2048 * DM, TOK, 2048, DM}; pg8::StaticOrder S; S.init(TOK, 2048, Fp.G, Fp.bid);
            epi::EpiStore<0> E{Q2_, 2048}; pg8::gemm_phase<epi::EpiStore<0>, pg8::StaticOrder, true, true>(ring, g, S, E, Fp.tid); }
        SEAM(p0 + 9);
        if (PM(11) && IN(p0 + 10)) RP(11) { FRESH(); phase_peer_route(Fp, Q2_, SUBK_ + (size_t)l * 8 * 2 * 128 * 128, EIDX_, EW_); __syncthreads(); }
        SEAM(p0 + 10);
        if (PM(12) && IN(p0 + 11)) RP(12) { FRESH(); phase_peer_u(Fp, HN_, UT_, SU_, EIDX_, LASTRP(12) ? PART_ : (float*)MIX_, LASTRP(12) ? 0x3fffu : DUMMY_EMASK); }
        SEAM(p0 + 11);
        if (PM(12) && IN(p0 + 12)) { FRESH(); phase_peer_w(Fp, SV_, EIDX_, EW_, PART_, COEF_); }
        SEAM(p0 + 12);
        if (PM(12) && IN(p0 + 13)) RP(14) { FRESH(); phase_peer_v(Fp, VT_, COEF_, LASTRP(14) ? XB_ : (float*)MIX_, MODL_ + 5120, LASTRP(14) ? 0x3fffu : DUMMY_EMASK); }
        SEAM(p0 + 13);
    }
    if (PM(13) && IN(NPHASE - 1)) { FRESH(); phase_final_norm(Fp, XB_, INP(I_FNG), XB_); }
#ifdef DBG_STOP
    if (IN(NPHASE)) { FRESH();
        const bf16* src = (const bf16*)(WSP + (size_t)DBG_OFF); const size_t n = (size_t)DBG_BYTES / 2, NO = (size_t)TOK * DM; float* o = (float*)ap->out;
        for (size_t i = (size_t)Fp.bid * NTHR + Fp.tid; i < NO; i += (size_t)Fp.G * NTHR) { float a = 0.f; for (size_t j = i; j < n; j += NO) a += bf2f(src[j]);
#ifdef DBG_OFF2
            { const float* s2 = (const float*)(WSP + (size_t)DBG_OFF2); const size_t n2 = (size_t)DBG_BYTES2 / 4; for (size_t j = i; j < n2; j += NO) a += s2[j]; }
#endif
            if (!(a == a) || fabsf(a) > 1e30f) a = 12345.0f;
            o[i] = a; } }
#endif
#undef IN
#undef SEAM
#undef WSP
}

extern "C" void kernel_launch(void* const* d_in, const int* in_sizes, int n_in, void* d_out, int out_size, void* d_ws, size_t ws_size, hipStream_t stream) {
    static int grid = 0;
    if (grid == 0) {
        if (n_in != 26 || in_sizes[0] != TOK * DM || out_size != TOK * DM || ws_size < WS_END) {
            fprintf(stderr, "kernel_launch: unexpected problem (n_in %d, in0 %d, out %d, WSP %zu); nothing launched\n", n_in, n_in > 0 ? in_sizes[0] : -1, out_size, ws_size); grid = -1; return; }
        int dev = 0, cus = 0, per_cu = 0;
        if (hipGetDevice(&dev) != hipSuccess || hipDeviceGetAttribute(&cus, hipDeviceAttributeMultiprocessorCount, dev) != hipSuccess) { grid = -1; return; }
        if (hipFuncSetAttribute((const void*)hybrid_fwd, hipFuncAttributeMaxDynamicSharedMemorySize, LDS_BYTES) != hipSuccess) { fprintf(stderr, "kernel_launch: hipFuncSetAttribute failed\n"); grid = -1; return; }
        if (hipOccupancyMaxActiveBlocksPerMultiprocessor(&per_cu, (const void*)hybrid_fwd, NTHR, LDS_BYTES) != hipSuccess || per_cu < 1)
            fprintf(stderr, "kernel_launch: note: occupancy query reports %d workgroups per CU\n", per_cu);
        (void)hipGetLastError();
        grid = cus;
    }
    if (grid < 0) return;
    if (hipMemsetAsync((char*)d_ws + WS_CTL, 0, CTL_ZERO_BYTES, stream) != hipSuccess) return;
    Args a{};
    for (int i = 0; i < 26; ++i) a.in[i] = d_in[i];
    a.out = (float*)d_out; a.ws = (unsigned char*)d_ws;
#if MK_PER_PHASE
#ifdef DBG_STOP
    for (int p = 0; p <= DBG_STOP; ++p) { a.ph_lo = p; a.ph_hi = p + 1; hipLaunchKernelGGL(hybrid_fwd, dim3(grid), dim3(NTHR), LDS_BYTES, stream, a); }
    a.ph_lo = NPHASE; a.ph_hi = NPHASE + 1; hipLaunchKernelGGL(hybrid_fwd, dim3(grid), dim3(NTHR), LDS_BYTES, stream, a);
#else
    for (int p = 0; p < NPHASE; ++p) { a.ph_lo = p; a.ph_hi = p + 1; hipLaunchKernelGGL(hybrid_fwd, dim3(grid), dim3(NTHR), LDS_BYTES, stream, a); }
#endif
#else
    a.ph_lo = 0; a.ph_hi = NPHASE; hipLaunchKernelGGL(hybrid_fwd, dim3(grid), dim3(NTHR), LDS_BYTES, stream, a);
#endif
    const hipError_t le = hipPeekAtLastError();
    if (le != hipSuccess) fprintf(stderr, "kernel_launch: launch failed: %s\n", hipGetErrorName(le));
}
```

```cpp
#include <hip/hip_runtime.h>
#include <hip/hip_bf16.h>
#include <cstdio>
#include <cstdint>
#include <cmath>

#ifndef MK_PER_PHASE
#define MK_PER_PHASE 0
#endif

#define DUMMY_EMASK 0x3fffu
#define RPMASK 0x0u
#define GAS __attribute__((address_space(1)))
#define LAS __attribute__((address_space(3)))
typedef unsigned short bf16;
typedef unsigned v4u __attribute__((ext_vector_type(4)));
typedef unsigned v2u __attribute__((ext_vector_type(2)));
typedef float f32x4 __attribute__((ext_vector_type(4)));
typedef float f32x2 __attribute__((ext_vector_type(2)));
typedef float f32x16 __attribute__((ext_vector_type(16)));
typedef short bf16x8 __attribute__((ext_vector_type(8)));
typedef short s16x4 __attribute__((ext_vector_type(4)));
typedef __bf16 bf16x2_t __attribute__((ext_vector_type(2)));

constexpr int BATCH = 8, SEQ = 2048, DM = 1024, DEPTH = 2, TOK = BATCH * SEQ;
constexpr int NP1 = 5632;
constexpr int NGT = 4096;
constexpr int NWIN = NP1 + NGT;
constexpr int C_AB = 0, C_AC = 512, C_AX = 1024, C_BA = 1536, C_BG = 2048, C_CQ = 2560, C_KC = 3072, C_VC = 3200, C_KS = 3328, C_VS = 3456, C_KW = 3584, C_VW = 3712,
              C_DQ = 3840, C_DK = 4352, C_DV = 4864, C_CG = 5376;
constexpr float NORM_EPS = 1e-6f;
constexpr float QSCALE = 0.125f * 1.4426950408889634f;

constexpr size_t MiB = 1u << 20;
constexpr size_t WS_CTL = 0, CTL_ZERO_BYTES = 64 * 1024;
constexpr size_t WS_MOD = 1 * MiB;
constexpr size_t WS_COS = 2 * MiB, WS_SIN = 4 * MiB;
constexpr size_t WS_SMALL = 6 * MiB;
constexpr size_t SM_KMEAN = 704 * 1024;
constexpr size_t SM_KCMP = 64 * 1024;
constexpr size_t SM_VCMP = 320 * 1024;
constexpr size_t SM_PBP = 576 * 1024;
constexpr size_t SM_W2T = 640 * 1024;
constexpr size_t WS_EIDX = 8 * MiB;
constexpr size_t WS_EW = 16 * MiB;
constexpr size_t WS_WIN = 24 * MiB;
constexpr size_t WS_WOUT = 62 * MiB;
constexpr size_t WS_WO = 70 * MiB;
constexpr size_t WS_WQ = 74 * MiB;
constexpr size_t WS_W1T = 82 * MiB;
constexpr size_t WS_SUBK = 84 * MiB;
constexpr size_t WS_HN = 86 * MiB;
constexpr size_t WS_MIX = 118 * MiB;
constexpr size_t WS_BIG = 182 * MiB;
constexpr size_t WS_GATES = 358 * MiB;
constexpr size_t WS_END = 486 * MiB;

constexpr int LDS_BYTES = 147456;
constexpr int RING_BYTES = 131072;
constexpr int MISC_OFF = LDS_BYTES - 256;

#define RLX_AGENT __ATOMIC_RELAXED, __HIP_MEMORY_SCOPE_AGENT
#define LDS_WAIT() asm volatile("s_waitcnt lgkmcnt(0)" ::: "memory")
#define VM_WAIT() asm volatile("s_waitcnt vmcnt(0)" ::: "memory")
__device__ __forceinline__ unsigned f2bf(float f) { unsigned u = __builtin_bit_cast(unsigned, f); return (u + 0x7fffu + ((u >> 16) & 1u)) >> 16; }
__device__ __forceinline__ float bf2f(unsigned h) { return __builtin_bit_cast(float, h << 16); }
__device__ __forceinline__ unsigned pk2(float lo, float hi) { f32x2 v = {lo, hi}; bf16x2_t b = __builtin_convertvector(v, bf16x2_t); return __builtin_bit_cast(unsigned, b); }
__device__ __forceinline__ float bflo(unsigned w) { return __builtin_bit_cast(float, w << 16); }
__device__ __forceinline__ float bfhi(unsigned w) { return __builtin_bit_cast(float, w & 0xffff0000u); }
__device__ __forceinline__ float sigmoidf_(float x) { return 1.0f / (1.0f + __expf(-x)); }
__device__ __forceinline__ float gelu_erf(float x) { return 0.5f * x * (1.0f + erff(x * 0.70710678118654752f)); }
__device__ __forceinline__ float shx(float v, int m, int lane) { return __builtin_bit_cast(float, __builtin_amdgcn_ds_bpermute((lane ^ m) << 2, __builtin_bit_cast(int, v))); }
__device__ __forceinline__ unsigned shxu(unsigned v, int m, int lane) { return (unsigned)__builtin_amdgcn_ds_bpermute((lane ^ m) << 2, (int)v); }
__device__ __forceinline__ void swap32(unsigned v, unsigned& r0, unsigned& r1) { unsigned b = v; asm volatile("" : "+v"(b)); auto r = __builtin_amdgcn_permlane32_swap(v, b, false, false); r0 = r[0]; r1 = r[1]; }
__device__ __forceinline__ float other32(float v, int hi) { unsigned r0, r1; swap32(__builtin_bit_cast(unsigned, v), r0, r1); return __builtin_bit_cast(float, hi ? r0 : r1); }
__device__ __forceinline__ float add32(float v) { unsigned r0, r1; swap32(__builtin_bit_cast(unsigned, v), r0, r1); return __builtin_bit_cast(float, r0) + __builtin_bit_cast(float, r1); }
__device__ __forceinline__ float max32(float v) { unsigned r0, r1; swap32(__builtin_bit_cast(unsigned, v), r0, r1); return fmaxf(__builtin_bit_cast(float, r0), __builtin_bit_cast(float, r1)); }
__device__ __forceinline__ unsigned umax32(unsigned v) { unsigned r0, r1; swap32(v, r0, r1); return r0 > r1 ? r0 : r1; }
__device__ __forceinline__ float wave_sum(float v, int lane) {
#pragma unroll
    for (int o = 1; o < 32; o <<= 1) v += shx(v, o, lane);
    return add32(v);
}
namespace pg8 {
#define PG8_LAS __attribute__((address_space(3)))
typedef unsigned short bf16_t;
typedef short bf16x8 __attribute__((ext_vector_type(8)));
typedef float f32x4 __attribute__((ext_vector_type(4)));
typedef unsigned u32x4 __attribute__((ext_vector_type(4)));
constexpr int BM = 256, BK = 64, HALF = 128, HTB = HALF * BK * 2  , STAGE_BYTES = 8 * HTB, NXCD = 8, WGM = 8;

__host__ __device__ __forceinline__ int lds_byte(int r, int c) { const int st = (r >> 4) * 2 + (c >> 5), rr = r & 15, cc = c & 31, ob = rr * 64 + cc * 2; return st * 1024 + (ob ^ (((ob >> 9) & 1) << 5)); }
__host__ __device__ __forceinline__ void stage_rc(int b, int& R, int& C) { const int st = b / 1024, sb = b % 1024, swz = sb ^ (((sb >> 9) & 1) << 5); R = (st >> 1) * 16 + swz / 64; C = (st & 1) * 32 + (swz % 64) / 2; }
__host__ __device__ __forceinline__ int perm32(int rho) { const int n = rho >> 4, i = rho & 15; return 8 * (i >> 2) + 4 * n + (i & 3); }

struct Unit { int pm, pn; };
struct Gemm { const bf16_t* A; const bf16_t* Bt; int M, N, K; };

struct StaticOrder {
    int nM, nN, nwg, G, c;
    __host__ __device__ void init(int M, int N, int G_, int c_) { nM = M / BM; nN = N / BM; nwg = nM * nN; G = G_; c = c_; }
    __host__ __device__ bool next(int i, Unit& u) const {
        const long L = (long)i * G + c; if (L >= nwg) return false;
        int wgid = (int)L; { const int q = nwg / NXCD, r = nwg % NXCD, xcd = wgid % NXCD, off = wgid / NXCD; wgid = (xcd < r ? xcd * (q + 1) : r * (q + 1) + (xcd - r) * q) + off; }
        const int nig = WGM * nN, gid = wgid / nig, fm = gid * WGM, gsz = (nM - fm) < WGM ? (nM - fm) : WGM;
        u.pm = fm + ((wgid % nig) % gsz); u.pn = (wgid % nig) / gsz; return true;
    }
    __device__ __forceinline__ void a_ready(const Unit&) const {}
    __device__ __forceinline__ void done(const Unit&) const {}
};

__device__ __forceinline__ unsigned cvt_pk_bf16(float lo, float hi) { unsigned r; asm volatile("v_cvt_pk_bf16_f32 %0, %1, %2" : "=v"(r) : "v"(lo), "v"(hi)); return r; }
typedef float f32x2 __attribute__((ext_vector_type(2)));
template <class Epi, class Sched, bool ALIGN_EPI = false, bool SP2 = false>
__device__ __forceinline__ void gemm_phase(PG8_LAS unsigned char* lds, const Gemm g, const Sched& S, const Epi& E, const int tid) {
    const int wid = __builtin_amdgcn_readfirstlane(tid >> 6), lane = tid & 63, wr = wid >> 2, wc = wid & 3, fr = lane & 15, fq = lane >> 4;
    const int K = g.K, nt = K / BK;
    unsigned voffA[2], voffB[2];
#pragma unroll
    for (int i = 0; i < 2; ++i) { int R, C; stage_rc(tid * 16 + i * 8192, R, C); const int Rb = Epi::PERM ? ((R & ~31) + perm32(R & 31)) : R;
        voffA[i] = (unsigned)(R * K + C) * 2u; voffB[i] = (unsigned)(Rb * K + C) * 2u; }
    const size_t kstep = (size_t)(BK * 2);
    const size_t hstep = (size_t)HALF * K * 2;
    const size_t tstep = 2 * hstep;
    const unsigned ldsw = (unsigned)wid * 1024u;
    const int aoff = lds_byte(wr * 64 + fr, fq * 8), boff = lds_byte(wc * 32 + fr, fq * 8);
#define PG8_SA(b, h) (((b) * 2 + (h)) * HTB)
#define PG8_SB(b, h) ((4 + (b) * 2 + (h)) * HTB)
#define PG8_STAGE(bufoff, gbase, voff) do { _Pragma("unroll") for (int _i = 0; _i < 2; ++_i) \
        __builtin_amdgcn_global_load_lds((const unsigned*)((const char*)(gbase) + (voff)[_i]), (PG8_LAS unsigned*)(lds + (bufoff) + ldsw + _i * 8192), 16, 0, 0); } while (0)
#define PG8_LDA(dst, b, h) do { _Pragma("unroll") for (int m = 0; m < 4; ++m) _Pragma("unroll") for (int k = 0; k < 2; ++k) dst[m][k] = *(const PG8_LAS bf16x8*)(lds + PG8_SA(b, h) + aoff + m * 2048 + k * 1024); } while (0)
#define PG8_LDB(dst, b, h) do { _Pragma("unroll") for (int n = 0; n < 2; ++n) _Pragma("unroll") for (int k = 0; k < 2; ++k) dst[n][k] = *(const PG8_LAS bf16x8*)(lds + PG8_SB(b, h) + boff + n * 2048 + k * 1024); } while (0)
#define PG8_MMA(ai, bj, At, Bt) do { __builtin_amdgcn_s_setprio(1); _Pragma("unroll") for (int m = 0; m < 4; ++m) _Pragma("unroll") for (int n = 0; n < 2; ++n) _Pragma("unroll") for (int k = 0; k < 2; ++k) \
        acc[ai][bj][m][n] = __builtin_amdgcn_mfma_f32_16x16x32_bf16(Bt[n][k], At[m][k], acc[ai][bj][m][n], 0, 0, 0); __builtin_amdgcn_s_setprio(0); } while (0)
#define PG8_WAIT_V(n) asm volatile("s_waitcnt vmcnt(" #n ")" ::: "memory")
#define PG8_WAIT_L(n) asm volatile("s_waitcnt lgkmcnt(" #n ")" ::: "memory")
#define PG8_BAR __builtin_amdgcn_s_barrier()
#define PG8_SCHED __builtin_amdgcn_sched_barrier(0)
    Unit cur, nxt; int ui = 0;
    if (!S.next(0, cur)) return;
    f32x4 acc[2][2][4][2];
#pragma unroll
    for (int a = 0; a < 2; ++a)
#pragma unroll
        for (int b = 0; b < 2; ++b)
#pragma unroll
            for (int m = 0; m < 4; ++m)
#pragma unroll
                for (int n = 0; n < 2; ++n) acc[a][b][m][n] = (f32x4){0.f, 0.f, 0.f, 0.f};
    bf16x8 At[4][2], B0[2][2], B1[2][2];
    const char* cA = (const char*)g.A + (size_t)cur.pm * tstep; const char* cB = (const char*)g.Bt + (size_t)cur.pn * tstep;
    S.a_ready(cur);
    if constexpr (SP2) {
        PG8_STAGE(PG8_SB(0, 0), cB, voffB); PG8_STAGE(PG8_SB(0, 1), cB + hstep, voffB); PG8_STAGE(PG8_SA(0, 0), cA, voffA); PG8_STAGE(PG8_SA(0, 1), cA + hstep, voffA);
        if (wr == 1) PG8_BAR;
        PG8_WAIT_V(2); PG8_BAR;
        PG8_STAGE(PG8_SB(1, 0), cB + kstep, voffB); PG8_STAGE(PG8_SA(1, 0), cA + kstep, voffA); PG8_STAGE(PG8_SB(1, 1), cB + hstep + kstep, voffB);
        PG8_WAIT_V(6); PG8_BAR;
    } else {
        PG8_STAGE(PG8_SB(0, 0), cB, voffB); PG8_STAGE(PG8_SA(0, 0), cA, voffA); PG8_STAGE(PG8_SB(0, 1), cB + hstep, voffB); PG8_STAGE(PG8_SA(0, 1), cA + hstep, voffA);
        if (wr == 1) PG8_BAR;
        PG8_WAIT_V(4); PG8_BAR;
        PG8_STAGE(PG8_SB(1, 0), cB + kstep, voffB); PG8_STAGE(PG8_SA(1, 0), cA + kstep, voffA); PG8_STAGE(PG8_SB(1, 1), cB + hstep + kstep, voffB);
        PG8_WAIT_V(6); PG8_BAR;
    }
    for (;;) {
        const bool has_next = S.next(ui + 1, nxt);
        const char* nA = has_next ? (const char*)g.A + (size_t)nxt.pm * tstep : cA; const char* nB = has_next ? (const char*)g.Bt + (size_t)nxt.pn * tstep : cB;
        for (int t = 0; t < nt; t += 2) {
            const bool last = (t == nt - 2);
            const char* a1 = cA + (size_t)(t + 1) * kstep;
            const char* a2 = last ? nA : cA + (size_t)(t + 2) * kstep; const char* b2 = last ? nB : cB + (size_t)(t + 2) * kstep;
            const char* a3 = a2 + kstep; const char* b3 = b2 + kstep;
            if (last && has_next) S.a_ready(nxt);
            if constexpr (SP2) {
            PG8_LDB(B0, 0, 0); PG8_LDB(B1, 0, 1); PG8_SCHED; PG8_LDA(At, 0, 0); PG8_STAGE(PG8_SA(1, 1), a1 + hstep, voffA);
            PG8_WAIT_V(8); PG8_WAIT_L(0); PG8_BAR; PG8_MMA(0, 0, At, B0); PG8_MMA(0, 1, At, B1); PG8_BAR; PG8_SCHED;
            PG8_LDA(At, 0, 1); PG8_STAGE(PG8_SB(0, 0), b2, voffB); PG8_STAGE(PG8_SB(0, 1), b2 + hstep, voffB); PG8_STAGE(PG8_SA(0, 0), a2, voffA);
            PG8_WAIT_V(8); PG8_WAIT_L(0); PG8_BAR; PG8_MMA(1, 0, At, B0); PG8_MMA(1, 1, At, B1); PG8_BAR; PG8_SCHED;
            PG8_LDB(B0, 1, 0); PG8_LDB(B1, 1, 1); PG8_SCHED; PG8_LDA(At, 1, 0); PG8_STAGE(PG8_SA(0, 1), a2 + hstep, voffA);
            PG8_WAIT_V(8); PG8_WAIT_L(0); PG8_BAR; PG8_MMA(0, 0, At, B0); PG8_MMA(0, 1, At, B1); PG8_BAR; PG8_SCHED;
            PG8_LDA(At, 1, 1); PG8_STAGE(PG8_SB(1, 0), b3, voffB); PG8_STAGE(PG8_SB(1, 1), b3 + hstep, voffB); PG8_STAGE(PG8_SA(1, 0), a3, voffA);
            PG8_WAIT_V(8); PG8_WAIT_L(0); PG8_BAR; PG8_MMA(1, 0, At, B0); PG8_MMA(1, 1, At, B1); PG8_BAR; PG8_SCHED;
            } else {
            PG8_LDB(B0, 0, 0); PG8_SCHED; PG8_LDA(At, 0, 0); PG8_STAGE(PG8_SA(1, 1), a1 + hstep, voffA);
            PG8_WAIT_L(8); PG8_BAR; PG8_WAIT_L(0); PG8_MMA(0, 0, At, B0); PG8_BAR; PG8_SCHED;
            PG8_LDB(B1, 0, 1); PG8_STAGE(PG8_SB(0, 0), b2, voffB);
            PG8_BAR; PG8_WAIT_L(0); PG8_MMA(0, 1, At, B1); PG8_BAR;
            PG8_LDA(At, 0, 1); PG8_STAGE(PG8_SA(0, 0), a2, voffA);
            PG8_BAR; PG8_WAIT_L(0); PG8_MMA(1, 0, At, B0); PG8_BAR; PG8_SCHED;
            PG8_STAGE(PG8_SB(0, 1), b2 + hstep, voffB);
            PG8_WAIT_V(6); PG8_BAR; PG8_MMA(1, 1, At, B1); PG8_BAR;
            PG8_LDB(B0, 1, 0); PG8_SCHED; PG8_LDA(At, 1, 0); PG8_STAGE(PG8_SA(0, 1), a2 + hstep, voffA);
            PG8_WAIT_L(8); PG8_BAR; PG8_WAIT_L(0); PG8_MMA(0, 0, At, B0); PG8_BAR; PG8_SCHED;
            PG8_LDB(B1, 1, 1); PG8_STAGE(PG8_SB(1, 0), b3, voffB);
            PG8_BAR; PG8_WAIT_L(0); PG8_MMA(0, 1, At, B1); PG8_BAR;
            PG8_LDA(At, 1, 1); PG8_STAGE(PG8_SA(1, 0), a3, voffA);
            PG8_BAR; PG8_WAIT_L(0); PG8_MMA(1, 0, At, B0); PG8_BAR; PG8_SCHED;
            PG8_STAGE(PG8_SB(1, 1), b3 + hstep, voffB);
            PG8_WAIT_V(6); PG8_BAR; PG8_MMA(1, 1, At, B1); PG8_BAR;
            }
        }
        if constexpr (ALIGN_EPI) { if (wr == 0) PG8_BAR; }
        if constexpr (!Epi::AFTER_DRAIN) { E(acc, cur, wr, wc, fr, fq); S.done(cur); }
        if (!has_next) break;
#pragma unroll
        for (int a = 0; a < 2; ++a)
#pragma unroll
            for (int b = 0; b < 2; ++b)
#pragma unroll
                for (int m = 0; m < 4; ++m)
#pragma unroll
                    for (int n = 0; n < 2; ++n) acc[a][b][m][n] = (f32x4){0.f, 0.f, 0.f, 0.f};
        cur = nxt; cA = nA; cB = nB; ++ui;
        if constexpr (ALIGN_EPI) { if (wr == 1) PG8_BAR; }
    }
    PG8_WAIT_V(0);
    if constexpr (!ALIGN_EPI) { if (wr == 0) PG8_BAR; }
    PG8_BAR;
    if constexpr (Epi::AFTER_DRAIN) { E.fused(acc, cur, wr, wc, fr, fq, lds, wid, lane); S.done(cur); }
#undef PG8_SA
#undef PG8_SB
#undef PG8_STAGE
#undef PG8_LDA
#undef PG8_LDB
#undef PG8_MMA
#undef PG8_WAIT_V
#undef PG8_WAIT_L
#undef PG8_BAR
#undef PG8_SCHED
}
}
#define XB_TMO      128
#define XB_XCNT(j)  (256  + 64 * (j))
#define XB_XSUB(j)  (1280 + 64 * (j))
#define XB_XGEN(j)  (2304 + 64 * (j))
#define XB_TOP      3328
#define XB_TOPGEN   3392
#define XCD_BAR_WORDS 3456
#define XB_SPIN_CAP (1u << 25)

__device__ __forceinline__ unsigned xb_ld(unsigned* p)              { return __hip_atomic_load(p, __ATOMIC_RELAXED, __HIP_MEMORY_SCOPE_AGENT); }
__device__ __forceinline__ unsigned xb_add(unsigned* p, unsigned v) { return __hip_atomic_fetch_add(p, v, __ATOMIC_RELAXED, __HIP_MEMORY_SCOPE_AGENT); }
__device__ __forceinline__ unsigned xb_xcc_id() { return (unsigned)__builtin_amdgcn_s_getreg((3 << 11) | 20) & 0xFu; }
#define XB_SPIN(cond, bar) do { unsigned _sp = 0; while (cond) { __builtin_amdgcn_s_sleep(1); \
    if ((++_sp & 255u) == 0u) { if (xb_ld(&(bar)[XB_TMO])) break; if (_sp > XB_SPIN_CAP) { atomicAdd(&(bar)[XB_TMO], 1u); break; } } } } while (0)

struct XcdBarrier {
    unsigned* bar; unsigned x;
    volatile LAS unsigned* st;
};

__device__ __forceinline__ XcdBarrier xcd_barrier_post(unsigned* bar, volatile LAS unsigned* st) {
    XcdBarrier b; b.bar = bar; b.x = xb_xcc_id(); b.st = st;
    if (threadIdx.x == 0) (void)xb_add(&bar[XB_XCNT(b.x)], 1u);
    return b;
}
__device__ __forceinline__ void xcd_barrier_complete(unsigned* bar, unsigned x, unsigned& nloc, unsigned& nx) {
    const unsigned G = gridDim.x * gridDim.y * gridDim.z;
    unsigned sum, cnt, mine, sp = 0u;
    for (;;) {
        sum = 0u; cnt = 0u; mine = 0u;
#pragma unroll
        for (unsigned j = 0; j < 16; ++j) { const unsigned c = xb_ld(&bar[XB_XCNT(j)]); sum += c; cnt += (c > 0u) ? 1u : 0u; mine = (j == x) ? c : mine; }
        if (sum == G) break;
        __builtin_amdgcn_s_sleep(1);
        if ((++sp & 255u) == 0u) { if (xb_ld(&bar[XB_TMO])) break; if (sp > XB_SPIN_CAP) { atomicAdd(&bar[XB_TMO], 1u); break; } }
    }
    nloc = mine > 0u ? mine : 1u; nx = cnt > 0u ? cnt : 1u;
}

__device__ __forceinline__ void xcd_barrier(const XcdBarrier& b) {
    asm volatile("s_waitcnt vmcnt(0)" ::: "memory");
    __syncthreads();
    if (threadIdx.x == 0) {
        unsigned* bar = b.bar;
        __builtin_amdgcn_s_waitcnt(0);
        unsigned nloc = b.st[0], nx = b.st[1];
        if (nloc == 0u) { xcd_barrier_complete(bar, b.x, nloc, nx); b.st[0] = nloc; b.st[1] = nx; }
        const unsigned old = xb_add(&bar[XB_XSUB(b.x)], 1u);
        const unsigned gen = old / nloc;
        if (old + 1u == (gen + 1u) * nloc) {
            __builtin_amdgcn_fence(__ATOMIC_RELEASE, "agent");
            asm volatile("s_waitcnt vmcnt(0)" ::: "memory");
            const unsigned og = xb_add(&bar[XB_TOP], 1u);
            const unsigned tg = og / nx;
            if (og + 1u == (tg + 1u) * nx) xb_add(&bar[XB_TOPGEN], 1u);
            else XB_SPIN(xb_ld(&bar[XB_TOPGEN]) == tg, bar);
            __builtin_amdgcn_fence(__ATOMIC_ACQUIRE, "agent");
            xb_add(&bar[XB_XGEN(b.x)], 1u);
            asm volatile("s_waitcnt vmcnt(0)" ::: "memory");
        } else {
            XB_SPIN(xb_ld(&bar[XB_XGEN(b.x)]) == gen, bar);
            __builtin_amdgcn_fence(__ATOMIC_ACQUIRE, "agent");
            asm volatile("s_waitcnt vmcnt(0)" ::: "memory");
        }
    }
    __syncthreads();
}

namespace epi {
using pg8::Unit; using pg8::BM; using pg8::HALF;
typedef const pg8::f32x4 (&AccRef)[2][2][4][2];

struct EpiProj1 {
    static constexpr bool PERM = true, AFTER_DRAIN = false;
    bf16* O; const float* cosT; const float* sinT;
    __device__ __forceinline__ void operator()(AccRef acc, const Unit& u, int wr, int wc, int fr, int fq) const {
        const int row0 = u.pm * BM + wr * 64 + fr, colw = u.pn * BM + wc * 32;
#pragma unroll
        for (int bj = 0; bj < 2; ++bj) {
            const int hb = (colw + bj * HALF) >> 6;
            const bool rope = (hb >= 40 && hb < 50) || (hb >= 52 && hb < 54) || (hb >= 56 && hb < 58) || (hb >= 60 && hb < 76);
            const bool isq = (hb >= 40 && hb < 48) || (hb >= 60 && hb < 68);
            const float qs = isq ? QSCALE : 1.0f;
            const int jw = (wc & 1) * 16 + fq * 4;
#pragma unroll
            for (int ai = 0; ai < 2; ++ai)
#pragma unroll
                for (int m = 0; m < 4; ++m) {
                    const int row = row0 + ai * HALF + m * 16;
                    pg8::f32x4 v0 = acc[ai][bj][m][0], v1 = acc[ai][bj][m][1];
                    if (rope) {
                        const pg8::f32x4 c = *(const pg8::f32x4*)(cosT + (size_t)row * 32 + jw), s = *(const pg8::f32x4*)(sinT + (size_t)row * 32 + jw);
                        const float a0 = v0[0] * c[0] - v0[1] * s[0], a1 = v0[1] * c[0] + v0[0] * s[0], a2 = v0[2] * c[1] - v0[3] * s[1], a3 = v0[3] * c[1] + v0[2] * s[1];
                        const float b0 = v1[0] * c[2] - v1[1] * s[2], b1 = v1[1] * c[2] + v1[0] * s[2], b2 = v1[2] * c[3] - v1[3] * s[3], b3 = v1[3] * c[3] + v1[2] * s[3];
                        v0 = (pg8::f32x4){a0, a1, a2, a3} * qs; v1 = (pg8::f32x4){b0, b1, b2, b3} * qs;
                    }
                    v4u w; w.x = pk2(v0[0], v0[1]); w.y = pk2(v0[2], v0[3]); w.z = pk2(v1[0], v1[1]); w.w = pk2(v1[2], v1[3]);
                    *(v4u*)(O + (size_t)row * NP1 + colw + bj * HALF + 8 * fq) = w;
                }
        }
    }
};
struct EpiStoreBf {
    static constexpr bool PERM = true, AFTER_DRAIN = false;
    bf16* O; int ldc;
    __device__ __forceinline__ void operator()(AccRef acc, const Unit& u, int wr, int wc, int fr, int fq) const {
        const int row0 = u.pm * BM + wr * 64 + fr, col0 = u.pn * BM + wc * 32 + 8 * fq;
#pragma unroll
        for (int ai = 0; ai < 2; ++ai)
#pragma unroll
            for (int m = 0; m < 4; ++m) { bf16* rowp = O + (size_t)(row0 + ai * HALF + m * 16) * ldc + col0;
#pragma unroll
                for (int bj = 0; bj < 2; ++bj) { const pg8::f32x4 v0 = acc[ai][bj][m][0], v1 = acc[ai][bj][m][1];
                    v4u w; w.x = pk2(v0[0], v0[1]); w.y = pk2(v0[2], v0[3]); w.z = pk2(v1[0], v1[1]); w.w = pk2(v1[2], v1[3]); *(v4u*)(rowp + bj * HALF) = w; } }
    }
};
__device__ __forceinline__ float gate_enc(float x) { return 2.0f * sigmoidf_(x) - 1.0f; }
struct EpiGates {
    static constexpr bool PERM = true, AFTER_DRAIN = false;
    unsigned char* O;
    __device__ __forceinline__ void operator()(AccRef acc, const Unit& u, int wr, int wc, int fr, int fq) const {
        const int row0 = u.pm * BM + wr * 64 + fr, col0 = u.pn * BM + wc * 32 + 8 * fq;
#pragma unroll
        for (int ai = 0; ai < 2; ++ai)
#pragma unroll
            for (int m = 0; m < 4; ++m) { unsigned char* rowp = O + (size_t)(row0 + ai * HALF + m * 16) * NGT + col0;
#pragma unroll
                for (int bj = 0; bj < 2; ++bj) { const pg8::f32x4 v0 = acc[ai][bj][m][0], v1 = acc[ai][bj][m][1];
                    v2u w; unsigned p = 0u; p = __builtin_amdgcn_cvt_pk_fp8_f32(gate_enc(v0[0]), gate_enc(v0[1]), p, false); p = __builtin_amdgcn_cvt_pk_fp8_f32(gate_enc(v0[2]), gate_enc(v0[3]), p, true); w.x = p;
                    p = 0u; p = __builtin_amdgcn_cvt_pk_fp8_f32(gate_enc(v1[0]), gate_enc(v1[1]), p, false); p = __builtin_amdgcn_cvt_pk_fp8_f32(gate_enc(v1[2]), gate_enc(v1[3]), p, true); w.y = p;
                    *(v2u*)(rowp + bj * HALF) = w; } }
    }
};
struct EpiMerge {
    static constexpr bool PERM = true, AFTER_DRAIN = false;
    bf16* O; const unsigned char* G; int seg;
    __device__ __forceinline__ void operator()(AccRef acc, const Unit& u, int wr, int wc, int fr, int fq) const {
        const int row0 = u.pm * BM + wr * 64 + fr, col0 = u.pn * BM + wc * 32 + 8 * fq;
#pragma unroll
        for (int ai = 0; ai < 2; ++ai)
#pragma unroll
            for (int m = 0; m < 4; ++m) { const size_t row = (size_t)(row0 + ai * HALF + m * 16); bf16* rowp = O + row * DM + col0; const unsigned char* gp = G + row * NGT + seg * DM + col0;
#pragma unroll
                for (int bj = 0; bj < 2; ++bj) { pg8::f32x4 v0 = acc[ai][bj][m][0], v1 = acc[ai][bj][m][1];
                    const v2u g = *(const v2u*)(gp + bj * HALF);
                    const f32x2 g0 = __builtin_amdgcn_cvt_pk_f32_fp8(g.x, false), g1 = __builtin_amdgcn_cvt_pk_f32_fp8(g.x, true), g2 = __builtin_amdgcn_cvt_pk_f32_fp8(g.y, false), g3 = __builtin_amdgcn_cvt_pk_f32_fp8(g.y, true);
                    v0[0] *= 0.5f * g0.x + 0.5f; v0[1] *= 0.5f * g0.y + 0.5f; v0[2] *= 0.5f * g1.x + 0.5f; v0[3] *= 0.5f * g1.y + 0.5f;
                    v1[0] *= 0.5f * g2.x + 0.5f; v1[1] *= 0.5f * g2.y + 0.5f; v1[2] *= 0.5f * g3.x + 0.5f; v1[3] *= 0.5f * g3.y + 0.5f;
                    if (seg != 0) { const v4u o = *(const v4u*)(rowp + bj * HALF); v0[0] += bflo(o.x); v0[1] += bfhi(o.x); v0[2] += bflo(o.y); v0[3] += bfhi(o.y); v1[0] += bflo(o.z); v1[1] += bfhi(o.z); v1[2] += bflo(o.w); v1[3] += bfhi(o.w); }
                    v4u w; w.x = pk2(v0[0], v0[1]); w.y = pk2(v0[2], v0[3]); w.z = pk2(v1[0], v1[1]); w.w = pk2(v1[2], v1[3]); *(v4u*)(rowp + bj * HALF) = w; } }
    }
};
struct EpiResid {
    static constexpr bool PERM = false, AFTER_DRAIN = false;
    const float* XI; float* XO; const float* gate;
    __device__ __forceinline__ void operator()(AccRef acc, const Unit& u, int wr, int wc, int fr, int fq) const {
        const int row0 = u.pm * BM + wr * 64 + fr, col0 = u.pn * BM + wc * 32 + 4 * fq;
        const float* gb = gate + (size_t)((u.pm * BM) / SEQ) * 6144 + col0;
        pg8::f32x4 gv[2][2];
#pragma unroll
        for (int bj = 0; bj < 2; ++bj)
#pragma unroll
            for (int n = 0; n < 2; ++n) gv[bj][n] = *(const pg8::f32x4*)(gb + bj * HALF + n * 16);
#pragma unroll
        for (int ai = 0; ai < 2; ++ai)
#pragma unroll
            for (int m = 0; m < 4; ++m) { const size_t off = (size_t)(row0 + ai * HALF + m * 16) * DM + col0;
#pragma unroll
                for (int bj = 0; bj < 2; ++bj)
#pragma unroll
                    for (int n = 0; n < 2; ++n) { const pg8::f32x4 xi = *(const pg8::f32x4*)(XI + off + bj * HALF + n * 16);
                        *(pg8::f32x4*)(XO + off + bj * HALF + n * 16) = xi + gv[bj][n] * acc[ai][bj][m][n]; } }
    }
};

struct EpiProjAll {
    static constexpr bool PERM = true, AFTER_DRAIN = false;
    static_assert(true, ""); EpiProj1 P; EpiGates G;
    __device__ __forceinline__ void operator()(AccRef acc, const Unit& u, int wr, int wc, int fr, int fq) const {
        if (u.pn < NP1 / BM) P(acc, u, wr, wc, fr, fq);
        else { Unit v = u; v.pn -= NP1 / BM; G(acc, v, wr, wc, fr, fq); }
    }
};
struct EpiMergeAll {
    static constexpr bool PERM = true, AFTER_DRAIN = false;
    bf16* O; const unsigned char* G;
    __device__ __forceinline__ void operator()(AccRef acc, const Unit& u, int wr, int wc, int fr, int fq) const {
        const int seg = u.pm >> 6; Unit v; v.pm = u.pm & 63; v.pn = u.pn & 3;
        EpiMerge E{O, G, seg}; E(acc, v, wr, wc, fr, fq);
    }
};
struct MergeOrder {
    pg8::StaticOrder S;
    __device__ void init(int G_, int c_) { S.init(TOK, DM, G_, c_); }
    __device__ bool next(int i, Unit& u) const { Unit b; if (!S.next(i >> 2, b)) return false; const int seg = i & 3; u.pm = seg * 64 + b.pm; u.pn = seg * 4 + b.pn; return true; }
    __device__ __forceinline__ void a_ready(const Unit&) const {}
    __device__ __forceinline__ void done(const Unit&) const {}
};
}

constexpr int NWAVES = 8, NTHR = 512;
struct Args { const void* in[26]; float* out; unsigned char* ws; int ph_lo, ph_hi; };
enum InIdx { I_X = 0, I_C, I_POS, I_MODW, I_MODB, I_NMG, I_NFG, I_WIN, I_ACW, I_AOUT, I_BCW, I_BCB, I_BLNG, I_BLNB, I_BOUT, I_CPOS, I_CW1, I_CW2, I_COUT, I_DOUT, I_WO, I_PWQ, I_PSUB, I_PU, I_PV, I_FNG };

struct Frame {
    LAS unsigned char* lds; unsigned char* ldsg;
    int tid, lane, wave, G, bid;
    unsigned char* ws;
};
__device__ __forceinline__ int gwave(const Frame& F) { return F.bid * NWAVES + F.wave; }
__device__ __forceinline__ int ngwave(const Frame& F) { return F.G * NWAVES; }

__device__ __forceinline__ int rope_pos_of_dim(int d) { return d < 32 ? 2 * d : 2 * (d - 32) + 1; }
__device__ __forceinline__ int rope_dim_of_pos(int p) { return (p >> 1) + 32 * (p & 1); }
__device__ __forceinline__ int win_row_of_col(int n) {
    if (n < 2560) return n;
    if (n < 3072) { const int c = n - 2560; return C_CQ + (c & ~63) + rope_pos_of_dim(c & 63); }
    if (n < 3200) { const int c = n - 3072; return C_KC + (c & ~63) + rope_pos_of_dim(c & 63); }
    if (n < 3328) return C_VC + (n - 3200);
    if (n < 3456) { const int c = n - 3328; return C_KS + (c & ~63) + rope_pos_of_dim(c & 63); }
    if (n < 3584) return C_VS + (n - 3456);
    if (n < 3712) { const int c = n - 3584; return C_KW + (c & ~63) + rope_pos_of_dim(c & 63); }
    if (n < 3840) return C_VW + (n - 3712);
    if (n < 3864) return C_CG + (n - 3840);
    if (n < 4376) { const int c = n - 3864; return C_DQ + (c & ~63) + rope_pos_of_dim(c & 63); }
    if (n < 4888) { const int c = n - 4376; return C_DK + (c & ~63) + rope_pos_of_dim(c & 63); }
    if (n < 5400) return C_DV + (n - 4888);
    return NP1 + (n - 5400);
}
template <int MODE, bool KPERM>
__device__ __forceinline__ void transpose_item(const float* W, int K, int N, bf16* WT, LAS float* scr, int item, int lane) {
    const int nblk = (N + 31) / 32, kb = item / nblk, nb = item % nblk, k0 = 64 * kb, n0 = 32 * nb;
    const int nsrc = n0 + (lane & 31); const bool nok = nsrc < N;
#pragma unroll 8
    for (int i = 0; i < 32; ++i) { const int kk = 2 * i + (lane >> 5); scr[kk * 33 + (lane & 31)] = nok ? W[(size_t)(k0 + kk) * N + nsrc] : 0.f; }
    LDS_WAIT(); asm volatile("" ::: "memory");
    const int c = lane & 7;
#pragma unroll
    for (int j = 0; j < 4; ++j) { const int n = (lane >> 3) + 8 * j;
        float s[8];
#pragma unroll
        for (int e = 0; e < 8; ++e) { const int p = 8 * c + e; const int ks = KPERM ? rope_dim_of_pos(p) : p; s[e] = scr[ks * 33 + n]; }
        v4u o; o.x = pk2(s[0], s[1]); o.y = pk2(s[2], s[3]); o.z = pk2(s[4], s[5]); o.w = pk2(s[6], s[7]);
        if (n0 + n < N) { const int row = (MODE == 1) ? win_row_of_col(n0 + n) : (n0 + n); *(v4u*)(WT + (size_t)row * K + k0 + 8 * c) = o; } }
    LDS_WAIT(); asm volatile("" ::: "memory");
}
template <int MODE, bool KPERM>
__device__ __forceinline__ void transpose_matrix(const Frame& F, const float* W, int K, int N, bf16* WT, int& base) {
    LAS float* scr = (LAS float*)(F.lds + F.wave * 16384);
    const int nitems = (K / 64) * ((N + 31) / 32), gw = gwave(F), NGW = ngwave(F);
    int first = (gw - base % NGW + NGW) % NGW;
    for (int it = first; it < nitems; it += NGW) transpose_item<MODE, KPERM>(W, K, N, WT, scr, it, F.lane);
    base += nitems;
}
__device__ __forceinline__ void convert_copy(const Frame& F, const float* src, bf16* dst, size_t n) {
    const size_t nth = (size_t)F.G * NTHR, t0 = (size_t)F.bid * NTHR + F.tid;
    for (size_t i = t0; i < n / 8; i += nth) { const f32x4 a = *(const f32x4*)(src + i * 8), b = *(const f32x4*)(src + i * 8 + 4);
        v4u o; o.x = pk2(a[0], a[1]); o.y = pk2(a[2], a[3]); o.z = pk2(b[0], b[1]); o.w = pk2(b[2], b[3]); *(v4u*)(dst + i * 8) = o; }
}

typedef __attribute__((address_space(4))) const Args* KArgsP;
__device__ __forceinline__ void phase_prologue(const Frame& F, KArgsP Ap) {
    unsigned char* ws = F.ws;
    int base = 0;
    for (int l = 0; l < DEPTH; ++l) {
        transpose_matrix<1, false>(F, (const float*)(GAS const void*)Ap->in[I_WIN] + (size_t)l * DM * 9496, DM, 9496, (bf16*)(ws + WS_WIN) + (size_t)l * NWIN * DM, base);
        transpose_matrix<0, false>(F, (const float*)(GAS const void*)Ap->in[I_AOUT] + (size_t)l * 512 * DM, 512, DM, (bf16*)(ws + WS_WOUT) + (size_t)(l * 4 + 0) * DM * 512, base);
        transpose_matrix<0, false>(F, (const float*)(GAS const void*)Ap->in[I_BOUT] + (size_t)l * 512 * DM, 512, DM, (bf16*)(ws + WS_WOUT) + (size_t)(l * 4 + 1) * DM * 512, base);
        transpose_matrix<0, false>(F, (const float*)(GAS const void*)Ap->in[I_COUT] + (size_t)l * 512 * DM, 512, DM, (bf16*)(ws + WS_WOUT) + (size_t)(l * 4 + 2) * DM * 512, base);
        transpose_matrix<0, false>(F, (const float*)(GAS const void*)Ap->in[I_DOUT] + (size_t)l * 512 * DM, 512, DM, (bf16*)(ws + WS_WOUT) + (size_t)(l * 4 + 3) * DM * 512, base);
        transpose_matrix<0, false>(F, (const float*)(GAS const void*)Ap->in[I_WO] + (size_t)l * DM * DM, DM, DM, (bf16*)(ws + WS_WO) + (size_t)l * DM * DM, base);
        transpose_matrix<0, false>(F, (const float*)(GAS const void*)Ap->in[I_PWQ] + (size_t)l * DM * 2048, DM, 2048, (bf16*)(ws + WS_WQ) + (size_t)l * 2048 * DM, base);
        transpose_matrix<0, true>(F, (const float*)(GAS const void*)Ap->in[I_CW1] + (size_t)(l * 2 + 0) * 2048 * 128, 2048, 128, (bf16*)(ws + WS_W1T) + (size_t)(l * 2 + 0) * 128 * 2048, base);
        transpose_matrix<0, false>(F, (const float*)(GAS const void*)Ap->in[I_CW1] + (size_t)(l * 2 + 1) * 2048 * 128, 2048, 128, (bf16*)(ws + WS_W1T) + (size_t)(l * 2 + 1) * 128 * 2048, base);
    }
    convert_copy(F, (const float*)(GAS const void*)Ap->in[I_PSUB], (bf16*)(ws + WS_SUBK), (size_t)DEPTH * 8 * 2 * 128 * 128);
    const int gt = F.bid * NTHR + F.tid, NGT_ = F.G * NTHR;
    { const float* w2 = (const float*)(GAS const void*)Ap->in[I_CW2]; bf16* w2t = (bf16*)(ws + WS_SMALL + SM_W2T);
      for (int i = gt; i < DEPTH * 2 * 64 * 128; i += NGT_) { const int k = i & 127, n = (i >> 7) & 63, lw = i >> 13; w2t[i] = (bf16)f2bf(w2[((size_t)lw * 128 + k) * 64 + n]); } }
    { const int* pos = (const int*)(GAS const void*)Ap->in[I_POS]; float* ct = (float*)(ws + WS_COS); float* st = (float*)(ws + WS_SIN);
      for (int i = gt; i < TOK * 32; i += NGT_) { const int t = i >> 5, j = i & 31;
          const float inv = 1.0f / powf(10000.0f, (float)(2 * j) / 64.0f); const float ang = (float)pos[t] * inv;
          ct[i] = (float)cos((double)ang); st[i] = (float)sin((double)ang); } }
    { const float* w1 = (const float*)(GAS const void*)Ap->in[I_CW1]; const float* cp = (const float*)(GAS const void*)Ap->in[I_CPOS]; float* pbp = (float*)(ws + WS_SMALL + SM_PBP);
      for (int i = gt; i < DEPTH * 2 * 16 * 128; i += NGT_) { const int n = i & 127, kc = (i >> 7) & 15, lw = i >> 11; float s = 0.f;
          for (int k = kc * 128; k < kc * 128 + 128; ++k) s += cp[(size_t)lw * 2048 + k] * w1[((size_t)lw * 2048 + k) * 128 + n];
          pbp[i] = s; } }
    __syncthreads();
    { LAS float* cond = (LAS float*)(F.lds);
      LAS float* red = (LAS float*)(F.lds + 32768);
      const float* c = (const float*)(GAS const void*)Ap->in[I_C];
      for (int i = F.tid; i < 8 * 1024; i += NTHR) { const float v = c[i]; cond[i] = v / (1.0f + __expf(-v)); }
      __syncthreads();
      for (int un = F.bid; un < DEPTH * 96; un += F.G) { const int l = un / 96, n0 = (un % 96) * 64;
          const float* mw = (const float*)(GAS const void*)Ap->in[I_MODW] + (size_t)l * DM * 6144 + n0 + F.lane;
          float acc[8];
#pragma unroll
          for (int b = 0; b < 8; ++b) acc[b] = 0.f;
#pragma unroll 4
          for (int k = F.wave * 128; k < F.wave * 128 + 128; ++k) { const float w = mw[(size_t)k * 6144];
#pragma unroll
              for (int b = 0; b < 8; ++b) acc[b] += cond[b * 1024 + k] * w; }
#pragma unroll
          for (int b = 0; b < 8; ++b) red[(F.wave * 8 + b) * 64 + F.lane] = acc[b];
          __syncthreads();
          { const int b = F.tid >> 6, n = F.tid & 63; float s = 0.f;
#pragma unroll
            for (int w = 0; w < 8; ++w) s += red[(w * 8 + b) * 64 + n];
            ((float*)(ws + WS_MOD))[((size_t)l * 8 + b) * 6144 + n0 + n] = s + ((const float*)(GAS const void*)Ap->in[I_MODB])[(size_t)l * 6144 + n0 + n]; }
          __syncthreads(); }
    }
}

__device__ __forceinline__ void phase_norm_mod(const Frame& F, const float* X, const float* g, const float* sh, const float* sc, bf16* O, unsigned char* O8 = nullptr, float* OS = nullptr) {
    const int gw = gwave(F), NGW = ngwave(F);
    f32x4 gv[4];
#pragma unroll
    for (int j = 0; j < 4; ++j) gv[j] = *(const f32x4*)(g + 4 * F.lane + 256 * j);
    for (int row = gw; row < TOK; row += NGW) {
        const int b = row / SEQ; const float* xr = X + (size_t)row * DM + 4 * F.lane;
        f32x4 v[4]; float s = 0.f;
#pragma unroll
        for (int j = 0; j < 4; ++j) { v[j] = *(const f32x4*)(xr + 256 * j); s += (v[j][0] * v[j][0] + v[j][1] * v[j][1]) + (v[j][2] * v[j][2] + v[j][3] * v[j][3]); }
        const float r = 1.0f / sqrtf(wave_sum(s, F.lane) * (1.0f / DM) + NORM_EPS);
        bf16* orow = O + (size_t)row * DM + 4 * F.lane;
#pragma unroll
        for (int j = 0; j < 4; ++j) { const f32x4 scv = *(const f32x4*)(sc + (size_t)b * 6144 + 4 * F.lane + 256 * j), shv = *(const f32x4*)(sh + (size_t)b * 6144 + 4 * F.lane + 256 * j);
            const f32x4 y = v[j] * r * gv[j] * (scv + 1.0f) + shv; v2u w; w.x = pk2(y[0], y[1]); w.y = pk2(y[2], y[3]); *(v2u*)(orow + 256 * j) = w; v[j] = y; }
        if (O8) {
            float mx = 0.f;
#pragma unroll
            for (int j = 0; j < 4; ++j) mx = fmaxf(fmaxf(mx, fmaxf(fabsf(v[j][0]), fabsf(v[j][1]))), fmaxf(fabsf(v[j][2]), fabsf(v[j][3])));
#pragma unroll
            for (int o = 1; o < 32; o <<= 1) mx = fmaxf(mx, shx(mx, o, F.lane));
            mx = max32(mx);
            int ex = 0; (void)frexpf(mx, &ex); const int k = (mx > 0.f) ? (8 - ex) : 0;
            const float s8 = __builtin_ldexpf(1.0f, k);
#pragma unroll
            for (int j = 0; j < 4; ++j) { unsigned p = 0u; p = __builtin_amdgcn_cvt_pk_fp8_f32(v[j][0] * s8, v[j][1] * s8, p, false); p = __builtin_amdgcn_cvt_pk_fp8_f32(v[j][2] * s8, v[j][3] * s8, p, true);
                *(unsigned*)(O8 + (size_t)row * DM + 4 * F.lane + 256 * j) = p; }
            if (F.lane == 0) OS[row] = __builtin_ldexpf(1.0f, -k);
        }
    }
}
__device__ __forceinline__ void phase_final_norm(const Frame& F, const float* X, const float* g, float* O) {
    const int gw = gwave(F), NGW = ngwave(F);
    f32x4 gv[4];
#pragma unroll
    for (int j = 0; j < 4; ++j) gv[j] = *(const f32x4*)(g + 4 * F.lane + 256 * j);
    for (int row = gw; row < TOK; row += NGW) {
        const float* xr = X + (size_t)row * DM + 4 * F.lane; f32x4 v[4]; float s = 0.f;
#pragma unroll
        for (int j = 0; j < 4; ++j) { v[j] = *(const f32x4*)(xr + 256 * j); s += (v[j][0] * v[j][0] + v[j][1] * v[j][1]) + (v[j][2] * v[j][2] + v[j][3] * v[j][3]); }
        const float r = 1.0f / sqrtf(wave_sum(s, F.lane) * (1.0f / DM) + NORM_EPS);
        float* orow = O + (size_t)row * DM + 4 * F.lane;
#pragma unroll
        for (int j = 0; j < 4; ++j) *(f32x4*)(orow + 256 * j) = v[j] * r * gv[j];
    }
}

__device__ __forceinline__ void phase_mixer_a(const Frame& F, const bf16* P, const float* cw  , bf16* O  ) {
    const int nth = F.G * NTHR, gt = F.bid * NTHR + F.tid;
    for (int it = gt; it < (TOK / 8) * 64; it += nth) {
        const int cg = it & 63, tb = it >> 6, c0 = cg * 8, t0 = tb * 8, s0 = t0 % SEQ;
        float w0[8], w1[8], w2[8];
#pragma unroll
        for (int e = 0; e < 8; ++e) { w0[e] = cw[c0 + e]; w1[e] = cw[512 + c0 + e]; w2[e] = cw[1024 + c0 + e]; }
        float pm2[8], pm1[8];
#pragma unroll
        for (int e = 0; e < 8; ++e) { pm2[e] = 0.f; pm1[e] = 0.f; }
        for (int pre = 2; pre >= 1; --pre) if (s0 - pre >= 0) { const bf16* r = P + (size_t)(t0 - pre) * NP1;
            const v4u ac = *(const v4u*)(r + C_AC + c0), ax = *(const v4u*)(r + C_AX + c0);
            float pr[8]; pr[0] = bflo(ac.x) * bflo(ax.x); pr[1] = bfhi(ac.x) * bfhi(ax.x); pr[2] = bflo(ac.y) * bflo(ax.y); pr[3] = bfhi(ac.y) * bfhi(ax.y);
            pr[4] = bflo(ac.z) * bflo(ax.z); pr[5] = bfhi(ac.z) * bfhi(ax.z); pr[6] = bflo(ac.w) * bflo(ax.w); pr[7] = bfhi(ac.w) * bfhi(ax.w);
#pragma unroll
            for (int e = 0; e < 8; ++e) { if (pre == 2) pm2[e] = pr[e]; else pm1[e] = pr[e]; } }
#pragma unroll
        for (int tt = 0; tt < 8; ++tt) { const bf16* r = P + (size_t)(t0 + tt) * NP1;
            const v4u ac = *(const v4u*)(r + C_AC + c0), ax = *(const v4u*)(r + C_AX + c0), ab = *(const v4u*)(r + C_AB + c0);
            float pr[8], bb[8], y[8];
            pr[0] = bflo(ac.x) * bflo(ax.x); pr[1] = bfhi(ac.x) * bfhi(ax.x); pr[2] = bflo(ac.y) * bflo(ax.y); pr[3] = bfhi(ac.y) * bfhi(ax.y);
            pr[4] = bflo(ac.z) * bflo(ax.z); pr[5] = bfhi(ac.z) * bfhi(ax.z); pr[6] = bflo(ac.w) * bflo(ax.w); pr[7] = bfhi(ac.w) * bfhi(ax.w);
            bb[0] = bflo(ab.x); bb[1] = bfhi(ab.x); bb[2] = bflo(ab.y); bb[3] = bfhi(ab.y); bb[4] = bflo(ab.z); bb[5] = bfhi(ab.z); bb[6] = bflo(ab.w); bb[7] = bfhi(ab.w);
#pragma unroll
            for (int e = 0; e < 8; ++e) { y[e] = bb[e] * (w0[e] * pm2[e] + w1[e] * pm1[e] + w2[e] * pr[e]); pm2[e] = pm1[e]; pm1[e] = pr[e]; }
            v4u o; o.x = pk2(y[0], y[1]); o.y = pk2(y[2], y[3]); o.z = pk2(y[4], y[5]); o.w = pk2(y[6], y[7]);
            *(v4u*)(O + (size_t)(t0 + tt) * 512 + c0) = o; }
    }
}

__device__ __forceinline__ void phase_mixer_b(const Frame& F, const bf16* P, const float* cw  , const float* cb, const float* lg, const float* lb, bf16* O) {
    LAS float* U = (LAS float*)F.lds;
    for (int un = F.bid; un < TOK / 32; un += F.G) {
        const int t0 = un * 32, s0 = t0 % SEQ;
        __syncthreads();
        for (int i = F.tid; i < 62 * 64; i += NTHR) { const int r = i >> 6, cg = i & 63, c0 = cg * 8; const int srel = s0 - 30 + r;
            float u[8];
            if (srel >= 0) { const bf16* row = P + (size_t)(t0 - 30 + r) * NP1; const v4u a = *(const v4u*)(row + C_BA + c0), g = *(const v4u*)(row + C_BG + c0);
                u[0] = bflo(a.x) * sigmoidf_(bflo(g.x)); u[1] = bfhi(a.x) * sigmoidf_(bfhi(g.x)); u[2] = bflo(a.y) * sigmoidf_(bflo(g.y)); u[3] = bfhi(a.y) * sigmoidf_(bfhi(g.y));
                u[4] = bflo(a.z) * sigmoidf_(bflo(g.z)); u[5] = bfhi(a.z) * sigmoidf_(bfhi(g.z)); u[6] = bflo(a.w) * sigmoidf_(bflo(g.w)); u[7] = bfhi(a.w) * sigmoidf_(bfhi(g.w)); }
            else {
#pragma unroll
                for (int e = 0; e < 8; ++e) u[e] = 0.f; }
            *(LAS f32x4*)(U + r * 512 + c0) = (f32x4){u[0], u[1], u[2], u[3]}; *(LAS f32x4*)(U + r * 512 + c0 + 4) = (f32x4){u[4], u[5], u[6], u[7]}; }
        __syncthreads();
        const int c0 = F.lane * 8;
        float acc[4][8];
#pragma unroll
        for (int q = 0; q < 4; ++q)
#pragma unroll
            for (int e = 0; e < 8; ++e) acc[q][e] = cb[c0 + e];
        for (int k = 0; k < 31; ++k) { const f32x4 wa = *(const f32x4*)(cw + k * 512 + c0), wb = *(const f32x4*)(cw + k * 512 + c0 + 4);
#pragma unroll
            for (int q = 0; q < 4; ++q) { const int r = 4 * F.wave + q + k; const f32x4 ua = *(LAS f32x4*)(U + r * 512 + c0), ub = *(LAS f32x4*)(U + r * 512 + c0 + 4);
                acc[q][0] += wa[0] * ua[0]; acc[q][1] += wa[1] * ua[1]; acc[q][2] += wa[2] * ua[2]; acc[q][3] += wa[3] * ua[3];
                acc[q][4] += wb[0] * ub[0]; acc[q][5] += wb[1] * ub[1]; acc[q][6] += wb[2] * ub[2]; acc[q][7] += wb[3] * ub[3]; } }
        const f32x4 ga = *(const f32x4*)(lg + c0), gb = *(const f32x4*)(lg + c0 + 4), ba = *(const f32x4*)(lb + c0), bb = *(const f32x4*)(lb + c0 + 4);
#pragma unroll
        for (int q = 0; q < 4; ++q) { float s = 0.f;
#pragma unroll
            for (int e = 0; e < 8; ++e) s += acc[q][e];
            const float mu = wave_sum(s, F.lane) * (1.0f / 512.0f); float v = 0.f;
#pragma unroll
            for (int e = 0; e < 8; ++e) { acc[q][e] -= mu; v += acc[q][e] * acc[q][e]; }
            const float rs = 1.0f / sqrtf(wave_sum(v, F.lane) * (1.0f / 512.0f) + NORM_EPS);
            float y[8];
#pragma unroll
            for (int e = 0; e < 8; ++e) { const float gg = e < 4 ? ga[e] : gb[e - 4], bv = e < 4 ? ba[e] : bb[e - 4]; const float z = acc[q][e] * rs * gg + bv; y[e] = z / (1.0f + __expf(-z)); }
            v4u o; o.x = pk2(y[0], y[1]); o.y = pk2(y[2], y[3]); o.z = pk2(y[4], y[5]); o.w = pk2(y[6], y[7]);
            *(v4u*)(O + (size_t)(t0 + 4 * F.wave + q) * 512 + c0) = o; }
    }
}

__device__ __forceinline__ void phase_compress(const Frame& F, const bf16* P, const bf16* W1T  , const bf16* W2T  , const float* PBP  ,
                                               bf16* KC, bf16* VC  ) {
    LAS float* PART = (LAS float*)F.lds;
    LAS bf16* H1 = (LAS bf16*)(F.lds + 69632);
    const int lane = F.lane, r16 = lane & 15, q4 = lane >> 4, w = F.wave;
    for (int un = F.bid; un < 2 * 8 * 2 * 8; un += F.G) {
        const int nb = un & 7, g = (un >> 3) & 1, b = (un >> 4) & 7, which = un >> 7;
        const int n = nb * 16 + r16; const int nn = n < 127 ? n : 126;
        const int col0 = (which == 0 ? C_KC : C_VC) + g * 64;
        const bf16* arow = P + ((size_t)b * SEQ + nn * 16) * NP1 + col0;
        const bf16* w1 = W1T + (size_t)which * 128 * 2048;
        f32x4 acc[8];
#pragma unroll
        for (int j = 0; j < 8; ++j) acc[j] = (f32x4){0.f, 0.f, 0.f, 0.f};
#pragma unroll
        for (int half = 0; half < 2; ++half) {
            bf16x8 a[4], bb[4][8];
#pragma unroll
            for (int s4 = 0; s4 < 4; ++s4) { const int k = w * 256 + (half * 4 + s4) * 32 + q4 * 8;
                a[s4] = *(const bf16x8*)(arow + (size_t)(k >> 6) * NP1 + (k & 63));
#pragma unroll
                for (int j = 0; j < 8; ++j) bb[s4][j] = *(const bf16x8*)(w1 + (size_t)(j * 16 + r16) * 2048 + k); }
#pragma unroll
            for (int s4 = 0; s4 < 4; ++s4)
#pragma unroll
                for (int j = 0; j < 8; ++j) acc[j] = __builtin_amdgcn_mfma_f32_16x16x32_bf16(a[s4], bb[s4][j], acc[j], 0, 0, 0);
        }
        __syncthreads();
#pragma unroll
        for (int j = 0; j < 8; ++j)
#pragma unroll
            for (int i = 0; i < 4; ++i) PART[(w * 16 + 4 * q4 + i) * 132 + j * 16 + r16] = acc[j][i];
        __syncthreads();
        {
            const int row = F.tid >> 5, c4 = (F.tid & 31) * 4;
            f32x4 sacc = (f32x4){0.f, 0.f, 0.f, 0.f};
#pragma unroll
            for (int ww = 0; ww < 8; ++ww) sacc += *(LAS f32x4*)(PART + (ww * 16 + row) * 132 + c4);
#pragma unroll
            for (int kc = 0; kc < 16; ++kc) sacc += *(const f32x4*)(PBP + ((size_t)which * 16 + kc) * 128 + c4);
            v2u o; o.x = pk2(gelu_erf(sacc[0]), gelu_erf(sacc[1])); o.y = pk2(gelu_erf(sacc[2]), gelu_erf(sacc[3]));
            *(LAS v2u*)(H1 + row * 136 + c4) = o;
        }
        __syncthreads();
        if (w < 4) {
            f32x4 o = (f32x4){0.f, 0.f, 0.f, 0.f};
            const bf16* w2 = W2T + (size_t)which * 64 * 128;
#pragma unroll
            for (int ks = 0; ks < 4; ++ks) { const bf16x8 a = *(LAS bf16x8*)(H1 + r16 * 136 + ks * 32 + q4 * 8);
                const bf16x8 bb = *(const bf16x8*)(w2 + (size_t)(w * 16 + r16) * 128 + ks * 32 + q4 * 8);
                o = __builtin_amdgcn_mfma_f32_16x16x32_bf16(a, bb, o, 0, 0, 0); }
            bf16* out = (which == 0 ? KC : VC) + ((size_t)(b * 2 + g) * 128) * 64;
#pragma unroll
            for (int i = 0; i < 4; ++i) { const int row = nb * 16 + 4 * q4 + i; out[(size_t)row * 64 + w * 16 + r16] = row < 127 ? (bf16)f2bf(o[i]) : (bf16)0; }
        }
    }
    __syncthreads();
}
__device__ __forceinline__ void phase_kmean(const Frame& F, const bf16* P, float* KM) {
    const int gw = gwave(F), NGW = ngwave(F), lane = F.lane, rs = lane >> 3, ch = lane & 7;
    for (int un = gw; un < 8 * 8 * 8; un += NGW) { const int h = un & 7, blk = (un >> 3) & 7, b = un >> 6;
        const bf16* base = P + ((size_t)b * SEQ + blk * 256) * NP1 + C_DK + h * 64 + ch * 8;
        float s[8];
#pragma unroll
        for (int e = 0; e < 8; ++e) s[e] = 0.f;
#pragma unroll 8
        for (int i = 0; i < 32; ++i) { const v4u v = *(const v4u*)(base + (size_t)(i * 8 + rs) * NP1);
            s[0] += bflo(v.x); s[1] += bfhi(v.x); s[2] += bflo(v.y); s[3] += bfhi(v.y); s[4] += bflo(v.z); s[5] += bfhi(v.z); s[6] += bflo(v.w); s[7] += bfhi(v.w); }
#pragma unroll
        for (int e = 0; e < 8; ++e) { s[e] += shx(s[e], 8, lane); s[e] += shx(s[e], 16, lane); s[e] = add32(s[e]); }
        if (rs == 0) { float* o = KM + ((size_t)(b * 8 + blk) * 8 + h) * 64 + ch * 8;
            *(f32x4*)o = (f32x4){s[0], s[1], s[2], s[3]} * (1.0f / 256.0f); *(f32x4*)(o + 4) = (f32x4){s[4], s[5], s[6], s[7]} * (1.0f / 256.0f); }
    }
}

constexpr int KT_STRIDE = 144, VT_STRIDE = 192, KT_BYTES = 64 * KT_STRIDE, VT_BYTES = 64 * VT_STRIDE, KV_BUF = KT_BYTES + VT_BYTES;
__device__ __forceinline__ int crow(int r, int hi) { return (r & 3) + 8 * (r >> 2) + 4 * hi; }
struct AttnState { float m, l; f32x16 o0, o1; };
__device__ __forceinline__ void attn_reset(AttnState& st) { st.m = -1e30f; st.l = 0.f;
#pragma unroll
    for (int r = 0; r < 16; ++r) { st.o0[r] = 0.f; st.o1[r] = 0.f; } }
__device__ __forceinline__ s16x4 vtr(LAS const unsigned char* p) { return __builtin_bit_cast(s16x4, __builtin_amdgcn_ds_read_tr16_b64_v4i16((LAS s16x4*)p)); }

__device__ __forceinline__ void attn_scores(LAS const unsigned char* Kt, const bf16x8 (&qr)[4], f32x16& p0, f32x16& p1, int lane) {
    const int r32 = lane & 31, hi = lane >> 5;
#pragma unroll
    for (int r = 0; r < 16; ++r) { p0[r] = 0.f; p1[r] = 0.f; }
#pragma unroll
    for (int s = 0; s < 4; ++s) {
        const bf16x8 a0 = *(LAS const bf16x8*)(Kt + r32 * KT_STRIDE + (2 * s + hi) * 16), a1 = *(LAS const bf16x8*)(Kt + (32 + r32) * KT_STRIDE + (2 * s + hi) * 16);
        p0 = __builtin_amdgcn_mfma_f32_32x32x16_bf16(a0, qr[s], p0, 0, 0, 0);
        p1 = __builtin_amdgcn_mfma_f32_32x32x16_bf16(a1, qr[s], p1, 0, 0, 0);
    }
}
__device__ __forceinline__ void attn_pv(LAS const unsigned char* Vt, const f32x16& e0, const f32x16& e1, f32x16& o0, f32x16& o1, int lane) {
    const int hi = lane >> 5;
    LAS const unsigned char* vb = Vt + (4 * hi + ((lane & 15) >> 2)) * VT_STRIDE + (((lane >> 4) & 1) * 16 + 4 * (lane & 3)) * 2;
#pragma unroll
    for (int s = 0; s < 4; ++s) {
        v4u pw;
        if (s < 2) { pw.x = pk2(e0[8 * s + 0], e0[8 * s + 1]); pw.y = pk2(e0[8 * s + 2], e0[8 * s + 3]); pw.z = pk2(e0[8 * s + 4], e0[8 * s + 5]); pw.w = pk2(e0[8 * s + 6], e0[8 * s + 7]); }
        else { const int t = s - 2; pw.x = pk2(e1[8 * t + 0], e1[8 * t + 1]); pw.y = pk2(e1[8 * t + 2], e1[8 * t + 3]); pw.z = pk2(e1[8 * t + 4], e1[8 * t + 5]); pw.w = pk2(e1[8 * t + 6], e1[8 * t + 7]); }
        const bf16x8 pb = __builtin_bit_cast(bf16x8, pw);
#pragma unroll
        for (int db = 0; db < 2; ++db) {
            const s16x4 lo = vtr(vb + (16 * s) * VT_STRIDE + db * 64), hh = vtr(vb + (16 * s + 8) * VT_STRIDE + db * 64);
            const bf16x8 a = (bf16x8){lo[0], lo[1], lo[2], lo[3], hh[0], hh[1], hh[2], hh[3]};
            if (db == 0) o0 = __builtin_amdgcn_mfma_f32_32x32x16_bf16(a, pb, o0, 0, 0, 0); else o1 = __builtin_amdgcn_mfma_f32_32x32x16_bf16(a, pb, o1, 0, 0, 0);
        }
    }
}
__device__ __forceinline__ float mask_score(float v, int a, int b, int c) {
    const unsigned sg = (unsigned)(((a + c) | (b - c)) >> 31);
    return __builtin_bit_cast(float, (__builtin_bit_cast(unsigned, v) & ~sg) | (0xf149f2cau & sg));
}
__device__ __forceinline__ void attn_tile(LAS const unsigned char* Kt, LAS const unsigned char* Vt, const bf16x8 (&qr)[4], AttnState& st, int kmin, int kmax, int lane) {
    const int hi = lane >> 5;
    f32x16 p0, p1; attn_scores(Kt, qr, p0, p1, lane);
    if (!__all(kmin <= 0 && kmax >= 63)) {
        const int a = 4 * hi - kmin, b = kmax - 4 * hi;
#pragma unroll
        for (int r = 0; r < 16; ++r) { const int c = (r & 3) + 8 * (r >> 2); p0[r] = mask_score(p0[r], a, b, c); p1[r] = mask_score(p1[r], a, b, c + 32); }
    }
    float mx = fmaxf(p0[0], p1[0]);
#pragma unroll
    for (int r = 1; r < 16; ++r) mx = fmaxf(mx, fmaxf(p0[r], p1[r]));
    mx = max32(mx);
    const float mn = fmaxf(st.m, mx), me = fmaxf(mn, -1e29f), alpha = __builtin_amdgcn_exp2f(st.m - me);
    float rs = 0.f;
#pragma unroll
    for (int r = 0; r < 16; ++r) { p0[r] = __builtin_amdgcn_exp2f(p0[r] - me); p1[r] = __builtin_amdgcn_exp2f(p1[r] - me); rs += p0[r] + p1[r]; }
    st.m = mn; st.l = st.l * alpha + rs;
    if (__any(alpha < 1.0f)) {
#pragma unroll
        for (int r = 0; r < 16; ++r) { st.o0[r] *= alpha; st.o1[r] *= alpha; }
    }
    attn_pv(Vt, p0, p1, st.o0, st.o1, lane);
}
struct KVRegs { v4u k, v; };
__device__ __forceinline__ void kv_load(KVRegs& r, const bf16* Kg, const bf16* Vg, size_t ld, int tid) {
    const int key = tid >> 3, ch = tid & 7;
    r.k = *(const v4u*)(Kg + (size_t)key * ld + ch * 8); r.v = *(const v4u*)(Vg + (size_t)key * ld + ch * 8);
}
__device__ __forceinline__ void kv_store(const KVRegs& r, LAS unsigned char* buf, int tid) {
    const int key = tid >> 3, ch = tid & 7;
    *(LAS v4u*)(buf + key * KT_STRIDE + ch * 16) = r.k; *(LAS v4u*)(buf + KT_BYTES + key * VT_STRIDE + ch * 16) = r.v;
}

__device__ __forceinline__ float attn_inv_l(const AttnState& st) { const float l = add32(st.l); return 1.0f / fmaxf(l, 1e-30f); }

#define ATTN_STREAM(Kg, Vg, ld, j0, j1, SKIP, RANGE) do { \
    int jn_ = (j0); while (jn_ < (j1) && (SKIP(jn_))) ++jn_; \
    if (jn_ < (j1)) { KVRegs kv_; kv_load(kv_, (Kg) + (size_t)jn_ * 64 * (ld), (Vg) + (size_t)jn_ * 64 * (ld), (ld), F.tid); \
        __syncthreads(); kv_store(kv_, ring, F.tid); int cur_ = 0; \
        for (;;) { const int j_ = jn_; ++jn_; while (jn_ < (j1) && (SKIP(jn_))) ++jn_; const bool more_ = jn_ < (j1); \
            if (more_) kv_load(kv_, (Kg) + (size_t)jn_ * 64 * (ld), (Vg) + (size_t)jn_ * 64 * (ld), (ld), F.tid); \
            __syncthreads(); \
            { int kmin_, kmax_; RANGE(j_, kmin_, kmax_); \
              if (__any(kmax_ >= kmin_)) attn_tile(ring + cur_ * KV_BUF, ring + cur_ * KV_BUF + KT_BYTES, qr, st, kmin_, kmax_, F.lane); } \
            if (!more_) break; \
            kv_store(kv_, ring + (cur_ ^ 1) * KV_BUF, F.tid); cur_ ^= 1; } } } while (0)

__device__ __forceinline__ void nsa_unit(const Frame& F, const bf16* P, const bf16* KC, const bf16* VC, bf16* O  , int b, int g, int i) {
    LAS unsigned char* ring = F.lds;
    LAS float* impb = (LAS float*)(F.lds + 2 * KV_BUF);
    LAS unsigned* selm = (LAS unsigned*)(F.lds + 2 * KV_BUF + 33792);
    LAS float* stash = (LAS float*)(F.lds + 2 * KV_BUF + 33792 + 256) + F.tid;
    const int lane = F.lane, r32 = lane & 31, hi = lane >> 5, hr = F.wave & 3, th = F.wave >> 2;
    const int tl = 32 * th + r32;
    const int s = 64 * i + tl;
    const size_t row = (size_t)b * SEQ + s;
    const int head = g * 4 + hr;
    bf16x8 qr[4];
#pragma unroll
    for (int d = 0; d < 4; ++d) qr[d] = *(const bf16x8*)(P + row * NP1 + C_CQ + head * 64 + d * 16 + hi * 8);
    const float g0 = sigmoidf_(bf2f(P[row * NP1 + C_CG + head])), g1 = sigmoidf_(bf2f(P[row * NP1 + C_CG + 8 + head])), g2 = sigmoidf_(bf2f(P[row * NP1 + C_CG + 16 + head]));
    AttnState st;
    {
        const bf16* Kg = KC + (size_t)(b * 2 + g) * 128 * 64; const bf16* Vg = VC + (size_t)(b * 2 + g) * 128 * 64;
        const int nmax = (s >= 31) ? ((s - 31) >> 4) : -1;
        { KVRegs kv0, kv1; kv_load(kv0, Kg, Vg, 64, F.tid); kv_load(kv1, Kg + 64 * 64, Vg + 64 * 64, 64, F.tid);
          __syncthreads();
          kv_store(kv0, ring, F.tid); kv_store(kv1, ring + KV_BUF, F.tid); }
        __syncthreads();
        attn_reset(st);
        attn_tile(ring, ring + KT_BYTES, qr, st, 0, nmax < 63 ? nmax : 63, lane);
        attn_tile(ring + KV_BUF, ring + KV_BUF + KT_BYTES, qr, st, 0, nmax - 64 < 63 ? nmax - 64 : 63, lane);
        const float inv = attn_inv_l(st);
        { const float sc = g0 * inv;
#pragma unroll
          for (int r = 0; r < 16; ++r) { stash[r * 512] = st.o0[r] * sc; stash[(16 + r) * 512] = st.o1[r] * sc; } }
        if (i >= 16) {
            float xprev = 0.f; const float mfin = st.m;
#define NSA_IMP(U, ACC, GQ) do { const float G_ = ((ACC[4 * (GQ)] + ACC[4 * (GQ) + 1]) + (ACC[4 * (GQ) + 2] + ACC[4 * (GQ) + 3])), L_ = ACC[4 * (GQ) + 3]; \
                const float x_ = other32(L_, hi); impb[(hr * 64 + tl) * 33 + 2 * (U) + hi] = G_ + (hi ? x_ : xprev); xprev = x_; } while (0)
#pragma unroll
            for (int tile = 0; tile < 2; ++tile) {
                f32x16 a0, a1; attn_scores(ring + tile * KV_BUF, qr, a0, a1, lane);
#pragma unroll
                for (int r = 0; r < 16; ++r) { const int c = (r & 3) + 8 * (r >> 2);
                    a0[r] = __builtin_amdgcn_exp2f(mask_score(a0[r], 4 * hi, nmax - 64 * tile - 4 * hi, c) - mfin) * inv; a1[r] = __builtin_amdgcn_exp2f(mask_score(a1[r], 4 * hi, nmax - 64 * tile - 4 * hi, c + 32) - mfin) * inv; }
                NSA_IMP(8 * tile + 0, a0, 0); NSA_IMP(8 * tile + 1, a0, 1); NSA_IMP(8 * tile + 2, a0, 2); NSA_IMP(8 * tile + 3, a0, 3);
                NSA_IMP(8 * tile + 4, a1, 0); NSA_IMP(8 * tile + 5, a1, 1); NSA_IMP(8 * tile + 6, a1, 2); NSA_IMP(8 * tile + 7, a1, 3);
            }
#undef NSA_IMP
        }
    }
    __syncthreads();
    unsigned mymask;
    if (i < 16) mymask = (2u << i) - 1u;
    else {
        { const int tk = F.tid >> 3, js = F.tid & 7; unsigned bits = 0u;
          float v[4];
#pragma unroll
          for (int e = 0; e < 4; ++e) { const int j = js * 4 + e; v[e] = (impb[(0 * 64 + tk) * 33 + j] + impb[(1 * 64 + tk) * 33 + j]) + (impb[(2 * 64 + tk) * 33 + j] + impb[(3 * 64 + tk) * 33 + j]); }
          int rank[4] = {0, 0, 0, 0};
          for (int jj = 1; jj <= i - 2; ++jj) { const float o = (impb[(0 * 64 + tk) * 33 + jj] + impb[(1 * 64 + tk) * 33 + jj]) + (impb[(2 * 64 + tk) * 33 + jj] + impb[(3 * 64 + tk) * 33 + jj]);
#pragma unroll
              for (int e = 0; e < 4; ++e) { const int j = js * 4 + e; rank[e] += (o > v[e] || (o == v[e] && jj < j)) ? 1 : 0; } }
#pragma unroll
          for (int e = 0; e < 4; ++e) { const int j = js * 4 + e; const bool forced = (j == 0) || (j == i) || (j == i - 1); const bool cand = (j >= 1) && (j <= i - 2);
              if (forced || (cand && rank[e] < 13)) bits |= 1u << j; }
          bits |= shxu(bits, 1, F.lane); bits |= shxu(bits, 2, F.lane); bits |= shxu(bits, 4, F.lane);
          if (js == 0) selm[tk] = bits; }
        __syncthreads();
        mymask = selm[tl];
    }
    {
        attn_reset(st);
        const bf16* Kg = P + (size_t)b * SEQ * NP1 + C_KS + g * 64; const bf16* Vg = P + (size_t)b * SEQ * NP1 + C_VS + g * 64;
#define NSA_SKIP(j) (false)
#define NSA_RANGE(j, kmin, kmax) do { kmin = 0; kmax = ((mymask >> (j)) & 1u) ? ((j) == i ? tl : 63) : -1; } while (0)
        ATTN_STREAM(Kg, Vg, (size_t)NP1, 0, i + 1, NSA_SKIP, NSA_RANGE);
#undef NSA_RANGE
        const float sc = g1 * attn_inv_l(st);
#pragma unroll
        for (int r = 0; r < 16; ++r) { stash[r * 512] += st.o0[r] * sc; stash[(16 + r) * 512] += st.o1[r] * sc; }
    }
    {
        attn_reset(st);
        const bf16* Kg = P + (size_t)b * SEQ * NP1 + C_KW + g * 64; const bf16* Vg = P + (size_t)b * SEQ * NP1 + C_VW + g * 64;
        const int jlo = i >= 8 ? i - 8 : 0; f32x16 out0, out1;
#define NSA_RANGE(j, kmin, kmax) do { const int d_ = 64 * (i - (j)) + tl; kmin = d_ - 511 > 0 ? d_ - 511 : 0; kmax = d_ < 63 ? d_ : 63; } while (0)
        ATTN_STREAM(Kg, Vg, (size_t)NP1, jlo, i + 1, NSA_SKIP, NSA_RANGE);
#undef NSA_RANGE
#undef NSA_SKIP
        const float sc = g2 * attn_inv_l(st);
#pragma unroll
        for (int r = 0; r < 16; ++r) { out0[r] = stash[r * 512] + st.o0[r] * sc; out1[r] = stash[(16 + r) * 512] + st.o1[r] * sc; }
        bf16* orow = O + row * 512 + head * 64;
#pragma unroll
        for (int gq = 0; gq < 4; ++gq) {
            v2u w0; w0.x = pk2(out0[4 * gq], out0[4 * gq + 1]); w0.y = pk2(out0[4 * gq + 2], out0[4 * gq + 3]); *(v2u*)(orow + 8 * gq + 4 * hi) = w0;
            v2u w1; w1.x = pk2(out1[4 * gq], out1[4 * gq + 1]); w1.y = pk2(out1[4 * gq + 2], out1[4 * gq + 3]); *(v2u*)(orow + 32 + 8 * gq + 4 * hi) = w1; }
    }
}
__device__ __forceinline__ void phase_nsa(const Frame& F, const bf16* P, const bf16* KC, const bf16* VC, bf16* O) {
    for (int un2 = 2 * F.bid; un2 < 512; un2 += 2 * F.G)
#pragma unroll 1
        for (int k = 0; k < 2; ++k) { const int un = un2 >> 1, ip = un & 15, g = (un >> 4) & 1, b = un >> 5; nsa_unit(F, P, KC, VC, O, b, g, k == 0 ? 31 - ip : ip); }
}

__device__ __forceinline__ void moba_unit(const Frame& F, const bf16* P, const float* KM, bf16* O  , int b, int h, int qb) {
    LAS unsigned char* ring = F.lds;
    LAS float* kml = (LAS float*)(F.lds + 2 * KV_BUF);
    LAS unsigned* uni = (LAS unsigned*)(F.lds + 2 * KV_BUF + 2048);
    const int lane = F.lane, r32 = lane & 31, hi = lane >> 5;
    const int tl = 32 * F.wave + r32;
    const size_t row = (size_t)b * SEQ + 256 * qb + tl;
    bf16x8 qr[4];
#pragma unroll
    for (int d = 0; d < 4; ++d) qr[d] = *(const bf16x8*)(P + row * NP1 + C_DQ + h * 64 + d * 16 + hi * 8);
    __syncthreads();
    { const int blk = F.tid >> 6, p = F.tid & 63; kml[F.tid] = KM[((size_t)(b * 8 + blk) * 8 + h) * 64 + p]; if (F.tid == 0) uni[0] = 0u; }
    __syncthreads();
    unsigned mymask = 0u;
    if (qb > 0) {
        float gt[8];
#pragma unroll
        for (int n = 0; n < 8; ++n) { float a = 0.f;
#pragma unroll
            for (int d = 0; d < 4; ++d) { const v4u qw = __builtin_bit_cast(v4u, qr[d]); const LAS float* km = kml + n * 64 + d * 16 + hi * 8;
                a += bflo(qw.x) * km[0] + bfhi(qw.x) * km[1] + bflo(qw.y) * km[2] + bfhi(qw.y) * km[3] + bflo(qw.z) * km[4] + bfhi(qw.z) * km[5] + bflo(qw.w) * km[6] + bfhi(qw.w) * km[7]; }
            a = add32(a); gt[n] = a; }
#pragma unroll
        for (int n = 0; n < 8; ++n) { int rank = 0;
#pragma unroll
            for (int m = 0; m < 8; ++m) rank += (m < qb && m != n && (gt[m] > gt[n] || (gt[m] == gt[n] && m < n))) ? 1 : 0;
            if (n < qb && rank < 3) mymask |= 1u << n; }
        atomicOr((unsigned*)uni, mymask);
    }
    __syncthreads();
    const unsigned um = uni[0];
    AttnState st; attn_reset(st);
    const bf16* Kg = P + (size_t)b * SEQ * NP1 + C_DK + h * 64; const bf16* Vg = P + (size_t)b * SEQ * NP1 + C_DV + h * 64;
#define MOBA_SKIP(j) ((j) < 4 * qb && !((um >> ((j) >> 2)) & 1u))
#define MOBA_RANGE(j, kmin, kmax) do { kmin = 0; if ((j) < 4 * qb) kmax = ((mymask >> ((j) >> 2)) & 1u) ? 63 : -1; else { const int d_ = tl - 64 * ((j) - 4 * qb); kmax = d_ < 63 ? d_ : 63; } } while (0)
    ATTN_STREAM(Kg, Vg, (size_t)NP1, 0, 4 * qb + 4, MOBA_SKIP, MOBA_RANGE);
#undef MOBA_SKIP
#undef MOBA_RANGE
    const float sc = attn_inv_l(st);
    bf16* orow = O + row * 512 + h * 64;
#pragma unroll
    for (int gq = 0; gq < 4; ++gq) {
        v2u w0; w0.x = pk2(st.o0[4 * gq] * sc, st.o0[4 * gq + 1] * sc); w0.y = pk2(st.o0[4 * gq + 2] * sc, st.o0[4 * gq + 3] * sc); *(v2u*)(orow + 8 * gq + 4 * hi) = w0;
        v2u w1; w1.x = pk2(st.o1[4 * gq] * sc, st.o1[4 * gq + 1] * sc); w1.y = pk2(st.o1[4 * gq + 2] * sc, st.o1[4 * gq + 3] * sc); *(v2u*)(orow + 32 + 8 * gq + 4 * hi) = w1; }
}
__device__ __forceinline__ void phase_moba(const Frame& F, const bf16* P, const float* KM, bf16* O) {
    for (int un2 = 2 * F.bid; un2 < 512; un2 += 2 * F.G)
#pragma unroll 1
        for (int k = 0; k < 2; ++k) { const int un = un2 >> 1, qp = un & 3, h = (un >> 2) & 7, b = un >> 5; moba_unit(F, P, KM, O, b, h, k == 0 ? 7 - qp : qp); }
}

__device__ __forceinline__ unsigned ord_key(float x) { const unsigned u = __builtin_bit_cast(unsigned, x); return (u & 0x80000000u) ? ~u : (u | 0x80000000u); }
__device__ __forceinline__ float ord_val(unsigned k) { const unsigned u = (k & 0x80000000u) ? (k & 0x7fffffffu) : ~k; return __builtin_bit_cast(float, u); }
constexpr int SK_STRIDE = 272;
__device__ __forceinline__ void peer_route_unit(const Frame& F, const bf16* Q2, const bf16* SUBK  , int* EIDX, float* EW, int tb, int h) {
    LAS unsigned char* skl = F.lds;
    LAS unsigned* slot = (LAS unsigned*)(F.lds + 36864) + F.tid;
    const int lane = F.lane, r32 = lane & 31, hi = lane >> 5;
    const size_t tok = (size_t)tb * 256 + F.wave * 32 + r32;
#pragma unroll 1
    for (int p = 0; p < 2; ++p) {
        __syncthreads();
        for (int i = F.tid; i < 128 * 16; i += NTHR) { const int ch = i & 15, rowi = i >> 4;
            *(LAS v4u*)(skl + rowi * SK_STRIDE + ch * 16) = *(const v4u*)(SUBK + ((size_t)h * 256 + p * 128 + rowi) * 128 + ch * 8); }
        __syncthreads();
        bf16x8 qf[8]; float ss = 0.f;
#pragma unroll
        for (int s = 0; s < 8; ++s) { qf[s] = *(const bf16x8*)(Q2 + tok * 2048 + h * 256 + p * 128 + s * 16 + hi * 8); const v4u w = __builtin_bit_cast(v4u, qf[s]);
            const float a0 = bflo(w.x), a1 = bfhi(w.x), a2 = bflo(w.y), a3 = bfhi(w.y), a4 = bflo(w.z), a5 = bfhi(w.z), a6 = bflo(w.w), a7 = bfhi(w.w);
            ss += (a0 * a0 + a1 * a1) + (a2 * a2 + a3 * a3) + (a4 * a4 + a5 * a5) + (a6 * a6 + a7 * a7); }
        ss = add32(ss);
        const float rn = 1.0f / sqrtf(ss * (1.0f / 128.0f) + NORM_EPS);
        unsigned key[64];
#pragma unroll
        for (int nb = 0; nb < 4; ++nb) { f32x16 acc;
#pragma unroll
            for (int r = 0; r < 16; ++r) acc[r] = 0.f;
#pragma unroll
            for (int s = 0; s < 8; ++s) { const bf16x8 a = *(LAS const bf16x8*)(skl + (nb * 32 + r32) * SK_STRIDE + (2 * s + hi) * 16);
                acc = __builtin_amdgcn_mfma_f32_32x32x16_bf16(a, qf[s], acc, 0, 0, 0); }
#pragma unroll
            for (int r = 0; r < 16; ++r) { const int n = nb * 32 + crow(r, hi); key[nb * 16 + r] = (ord_key(acc[r] * rn) & 0xffffff80u) | (unsigned)(127 - n); } }
#pragma unroll 1
        for (int k = 0; k < 16; ++k) { unsigned m = key[0];
#pragma unroll
            for (int e = 1; e < 64; ++e) m = m > key[e] ? m : key[e];
            m = umax32(m);
            slot[(p * 16 + k) * 512] = m;
#pragma unroll
            for (int e = 0; e < 64; ++e) key[e] = key[e] == m ? 0u : key[e]; }
    }
    LDS_WAIT(); asm volatile("" ::: "memory");
    unsigned ck[50];
    { float v1[16], v2[16];
#pragma unroll
      for (int k = 0; k < 16; ++k) { v1[k] = ord_val(slot[k * 512] & 0xffffff80u); v2[k] = ord_val(slot[(16 + k) * 512] & 0xffffff80u); }
      int c = 0;
#pragma unroll
      for (int a = 0; a < 16; ++a)
#pragma unroll
          for (int bq = 0; bq < 16; ++bq) if ((a + 1) * (bq + 1) <= 16) { ck[c] = (ord_key(v1[a] + v2[bq]) & 0xffffff00u) | (unsigned)(255 - (16 * a + bq)); ++c; } }
    float den = 0.f, mx = 0.f;
#pragma unroll 1
    for (int k = 0; k < 16; ++k) { unsigned m = ck[0];
#pragma unroll
        for (int e = 1; e < 50; ++e) m = m > ck[e] ? m : ck[e];
#pragma unroll
        for (int e = 0; e < 50; ++e) ck[e] = ck[e] == m ? 0u : ck[e];
        const int ci = 255 - (int)(m & 255u), a = ci >> 4, bq = ci & 15;
        const unsigned ka = slot[a * 512], kb = slot[(16 + bq) * 512];
        const int te = (127 - (int)(ka & 127u)) * 128 + (127 - (int)(kb & 127u));
        const float tvk = ord_val(m & 0xffffff00u);
        if (k == 0) mx = tvk;
        const float ek = __expf(tvk - mx); den += ek;
        slot[(32 + k) * 512] = __builtin_bit_cast(unsigned, ek);
        if (hi == 0) EIDX[(tok * 8 + h) * 16 + k] = te; }
    LDS_WAIT(); asm volatile("" ::: "memory");
    if (hi == 0) { const float inv = 1.0f / den; float* ewp = EW + (tok * 8 + h) * 16;
#pragma unroll
        for (int q = 0; q < 4; ++q) *(f32x4*)(ewp + 4 * q) = (f32x4){__builtin_bit_cast(float, slot[(32 + 4 * q) * 512]), __builtin_bit_cast(float, slot[(33 + 4 * q) * 512]),
                                                                      __builtin_bit_cast(float, slot[(34 + 4 * q) * 512]), __builtin_bit_cast(float, slot[(35 + 4 * q) * 512])} * inv; }
}

__device__ __forceinline__ void phase_peer_route(const Frame& F, const bf16* Q2, const bf16* SUBK, int* EIDX, float* EW) {
    for (int un = F.bid; un < 64 * 8; un += F.G) peer_route_unit(F, Q2, SUBK, EIDX, EW, un >> 3, un & 7);
}

__device__ __forceinline__ void phase_peer_tables(const Frame& F, const float* U, const float* V, unsigned char* UT8, unsigned char* VT8, float* SU, float* SV) {
    const int gw = gwave(F), NGW = ngwave(F), lane = F.lane;
    for (int r = gw; r < 2 * 16384; r += NGW) {
        const int tab = r >> 14, e = r & 16383; const float* src = (tab ? V : U) + (size_t)e * DM + 16 * lane;
        f32x4 x[4]; float mx = 0.f;
#pragma unroll
        for (int q = 0; q < 4; ++q) { x[q] = *(const f32x4*)(src + 4 * q); mx = fmaxf(fmaxf(mx, fmaxf(fabsf(x[q][0]), fabsf(x[q][1]))), fmaxf(fabsf(x[q][2]), fabsf(x[q][3]))); }
#pragma unroll
        for (int o = 1; o < 32; o <<= 1) mx = fmaxf(mx, shx(mx, o, lane));
        mx = max32(mx);
        int ex = 0; (void)frexpf(mx, &ex);
        const int k = (mx > 0.f) ? (8 - ex) : 0;
        const float sc = __builtin_ldexpf(1.0f, k), inv = __builtin_ldexpf(1.0f, -k);
        v4u w;
#pragma unroll
        for (int q = 0; q < 4; ++q) { unsigned p = 0u; p = __builtin_amdgcn_cvt_pk_fp8_f32(x[q][0] * sc, x[q][1] * sc, p, false); p = __builtin_amdgcn_cvt_pk_fp8_f32(x[q][2] * sc, x[q][3] * sc, p, true); w[q] = p; }
        *(v4u*)((tab ? VT8 : UT8) + ((size_t)(lane >> 3) * 16384 + e) * 128 + (lane & 7) * 16) = w;
        if (lane == 0) (tab ? SV : SU)[e] = inv;
    }
}
typedef _Float16 h16x2 __attribute__((ext_vector_type(2)));
typedef __fp16 fp16x2_t __attribute__((ext_vector_type(2)));
__device__ __forceinline__ void phase_peer_u(const Frame& F, const bf16* H2, const unsigned char* UT8, const float* SU, const int* EIDX, float* PART, unsigned emask = 0x3fffu) {
    const int lane = F.lane, g = lane >> 3, sub = lane & 7, b0 = lane & 1, b1 = (lane >> 1) & 1, b2 = (lane >> 2) & 1;
    const int s = F.bid & 7, wgq = F.bid >> 3, nq = F.G >> 3;
    LAS int* il = (LAS int*)(F.lds + F.wave * 8192);
    LAS float* pcl = (LAS float*)(F.lds + F.wave * 8192 + 4096);
    const unsigned char* ub = UT8 + (size_t)s * 16384 * 128 + sub * 16;
    for (int batch = wgq * 8 + F.wave; batch < TOK / 8; batch += nq * 8) {
        const int t0 = batch * 8, t = t0 + g;
        { const v4u* src = (const v4u*)(EIDX + (size_t)t0 * 128 + lane * 16);
          const v4u i0 = src[0], i1 = src[1], i2 = src[2], i3 = src[3];
          LAS v4u* dst = (LAS v4u*)(il + lane * 16); dst[0] = i0 & emask; dst[1] = i1 & emask; dst[2] = i2 & emask; dst[3] = i3 & emask; }
        h16x2 h[8];
        { const v4u ha = *(const v4u*)(H2 + (size_t)t * DM + s * 128 + sub * 16), hb = *(const v4u*)(H2 + (size_t)t * DM + s * 128 + sub * 16 + 8);
          h[0] = (h16x2){(_Float16)bflo(ha.x), (_Float16)bfhi(ha.x)}; h[1] = (h16x2){(_Float16)bflo(ha.y), (_Float16)bfhi(ha.y)}; h[2] = (h16x2){(_Float16)bflo(ha.z), (_Float16)bfhi(ha.z)}; h[3] = (h16x2){(_Float16)bflo(ha.w), (_Float16)bfhi(ha.w)};
          h[4] = (h16x2){(_Float16)bflo(hb.x), (_Float16)bfhi(hb.x)}; h[5] = (h16x2){(_Float16)bflo(hb.y), (_Float16)bfhi(hb.y)}; h[6] = (h16x2){(_Float16)bflo(hb.z), (_Float16)bfhi(hb.z)}; h[7] = (h16x2){(_Float16)bflo(hb.w), (_Float16)bfhi(hb.w)}; }
        LDS_WAIT(); asm volatile("" ::: "memory");
#define PU_LOAD(c, ua, su_) do { const v4u ia = *(LAS v4u*)(il + g * 128 + (c) * 8), ib = *(LAS v4u*)(il + g * 128 + (c) * 8 + 4); \
            ua[0] = *(const v4u*)(ub + (size_t)ia.x * 128); ua[1] = *(const v4u*)(ub + (size_t)ia.y * 128); ua[2] = *(const v4u*)(ub + (size_t)ia.z * 128); ua[3] = *(const v4u*)(ub + (size_t)ia.w * 128); \
            ua[4] = *(const v4u*)(ub + (size_t)ib.x * 128); ua[5] = *(const v4u*)(ub + (size_t)ib.y * 128); ua[6] = *(const v4u*)(ub + (size_t)ib.z * 128); ua[7] = *(const v4u*)(ub + (size_t)ib.w * 128); \
            su_ = SU[il[g * 128 + (c) * 8 + sub]]; } while (0)
#define PU_COMP(c, ua, su_) do { float a[8]; \
            _Pragma("unroll") for (int j = 0; j < 8; ++j) { float acc = 0.f; \
                _Pragma("unroll") for (int q = 0; q < 4; ++q) { acc = __builtin_amdgcn_fdot2(__builtin_bit_cast(h16x2, __builtin_amdgcn_cvt_scalef32_pk_f16_fp8(ua[j][q], 1.0f, false)), h[2 * q], acc, false); \
                    acc = __builtin_amdgcn_fdot2(__builtin_bit_cast(h16x2, __builtin_amdgcn_cvt_scalef32_pk_f16_fp8(ua[j][q], 1.0f, true)), h[2 * q + 1], acc, false); } \
                a[j] = acc; } \
            float bq[4], cc[2]; \
            _Pragma("unroll") for (int p = 0; p < 4; ++p) { const float keep = b0 ? a[2 * p + 1] : a[2 * p], send = b0 ? a[2 * p] : a[2 * p + 1]; bq[p] = keep + shx(send, 1, lane); } \
            _Pragma("unroll") for (int q = 0; q < 2; ++q) { const float keep = b1 ? bq[2 * q + 1] : bq[2 * q], send = b1 ? bq[2 * q] : bq[2 * q + 1]; cc[q] = keep + shx(send, 2, lane); } \
            { const float keep = b2 ? cc[1] : cc[0], send = b2 ? cc[0] : cc[1]; pcl[(c) * 64 + lane] = (keep + shx(send, 4, lane)) * su_; } } while (0)
        { v4u uA[8], uB[8]; float sA, sB;
          PU_LOAD(0, uA, sA);
#pragma unroll 1
          for (int c = 0; c < 16; c += 2) {
              PU_LOAD(c + 1, uB, sB);
              PU_COMP(c, uA, sA);
              if (c + 2 < 16) PU_LOAD(c + 2, uA, sA);
              PU_COMP(c + 1, uB, sB);
          } }
#undef PU_LOAD
#undef PU_COMP
        LDS_WAIT(); asm volatile("" ::: "memory");
        float* dst = PART + ((size_t)s * TOK + t) * 128 + sub;
#pragma unroll
        for (int c = 0; c < 16; ++c) dst[8 * c] = pcl[c * 64 + lane];
        LDS_WAIT(); asm volatile("" ::: "memory");
    }
}
__device__ __forceinline__ float gelu_as(float v) {
    const float av = fabsf(v), t = __builtin_amdgcn_rcpf(av * 0.2316418882f + 1.0f);
    float q = t * 0.5307027145f + (-0.7265760135f); q = q * t + 0.7107068705f; q = q * t + (-0.142248368f); q = q * t + 0.127414796f; q = q * t;
    const float m = v * (q * __builtin_amdgcn_exp2f((v * v) * (-0.72134752044f)));
    return v < 0.f ? m : v - m;
}
__device__ __forceinline__ void phase_peer_w(const Frame& F, const float* SV, const int* EIDX, const float* EW, const float* PART, v2u* COEF) {
    const int nth = F.G * NTHR;
    for (int i = F.bid * NTHR + F.tid; i < TOK * 128; i += nth) {
        float act = 0.f;
#pragma unroll
        for (int sp = 0; sp < 8; ++sp) act += PART[(size_t)sp * TOK * 128 + i];
        const int e = EIDX[i]; const float c = EW[i] * gelu_as(act) * SV[e];
        COEF[i] = (v2u){(unsigned)e, __builtin_bit_cast(unsigned, c)};
    }
}
__device__ __forceinline__ void phase_peer_v(const Frame& F, const unsigned char* VT8, const v2u* COEF, float* XB, const float* gate, unsigned emask = 0x3fffu) {
    const int lane = F.lane, g = lane >> 3, sub = lane & 7;
    const int s = F.bid & 7, wgq = F.bid >> 3, nq = F.G >> 3;
    LAS v2u* wl = (LAS v2u*)(F.lds + F.wave * 8192);
    const unsigned char* vb = VT8 + (size_t)s * 16384 * 128 + sub * 16;
    for (int batch = wgq * 8 + F.wave; batch < TOK / 8; batch += nq * 8) {
        const int t0 = batch * 8, t = t0 + g;
        { const v4u* src = (const v4u*)(COEF + (size_t)t0 * 128) + lane * 8;
          v4u c[8];
#pragma unroll
          for (int q = 0; q < 8; ++q) c[q] = src[q];
          LAS v4u* dst = (LAS v4u*)wl + lane * 8;
#pragma unroll
          for (int q = 0; q < 8; ++q) { v4u x = c[q]; x.x &= emask; x.z &= emask; dst[q] = x; } }
        LDS_WAIT(); asm volatile("" ::: "memory");
        h16x2 o[8];
#pragma unroll
        for (int q = 0; q < 8; ++q) o[q] = (h16x2){(_Float16)0.f, (_Float16)0.f};
#define PV_LOAD(c, pr, va) do { \
            _Pragma("unroll") for (int q = 0; q < 4; ++q) pr[q] = *(LAS v4u*)(wl + g * 128 + (c) * 8 + 2 * q); \
            _Pragma("unroll") for (int q = 0; q < 4; ++q) { va[2 * q] = *(const v4u*)(vb + (size_t)pr[q].x * 128); va[2 * q + 1] = *(const v4u*)(vb + (size_t)pr[q].z * 128); } } while (0)
#define PV_COMP(pr, va) do { \
            _Pragma("unroll") for (int j = 0; j < 8; ++j) { const unsigned cb = (j & 1) ? pr[j >> 1].w : pr[j >> 1].y; \
                const float s2 = __builtin_bit_cast(float, cb & 0x7f800000u); const _Float16 mh = (_Float16)__builtin_bit_cast(float, (cb & 0x807fffffu) | 0x3f800000u); const h16x2 m2 = (h16x2){mh, mh}; \
                _Pragma("unroll") for (int q = 0; q < 4; ++q) { o[2 * q] = __builtin_elementwise_fma(__builtin_bit_cast(h16x2, __builtin_amdgcn_cvt_scalef32_pk_f16_fp8(va[j][q], s2, false)), m2, o[2 * q]); \
                    o[2 * q + 1] = __builtin_elementwise_fma(__builtin_bit_cast(h16x2, __builtin_amdgcn_cvt_scalef32_pk_f16_fp8(va[j][q], s2, true)), m2, o[2 * q + 1]); } } } while (0)
        { v4u pA[4], pB[4], vA[8], vB[8];
          PV_LOAD(0, pA, vA);
#pragma unroll 1
          for (int c = 0; c < 16; c += 2) {
              PV_LOAD(c + 1, pB, vB);
              PV_COMP(pA, vA);
              if (c + 2 < 16) PV_LOAD(c + 2, pA, vA);
              PV_COMP(pB, vB);
          } }
#undef PV_LOAD
#undef PV_COMP
        const int bb = t / SEQ; float* xr = XB + (size_t)t * DM + s * 128 + sub * 16; const float* gr = gate + (size_t)bb * 6144 + s * 128 + sub * 16;
#pragma unroll
        for (int q = 0; q < 4; ++q) { const f32x4 x = *(const f32x4*)(xr + 4 * q), gg = *(const f32x4*)(gr + 4 * q);
            *(f32x4*)(xr + 4 * q) = x + gg * (f32x4){(float)o[2 * q].x, (float)o[2 * q].y, (float)o[2 * q + 1].x, (float)o[2 * q + 1].y}; }
        LDS_WAIT(); asm volatile("" ::: "memory");
    }
}

constexpr int NPL = 12, NPHASE = 1 + DEPTH * NPL + 1;
constexpr int CW_BAR = 1024;
static_assert((CW_BAR + XCD_BAR_WORDS) * 4 <= (int)CTL_ZERO_BYTES, "barrier words inside the memset region");

__global__ void __launch_bounds__(NTHR, 2) hybrid_fwd(Args args) {
    extern __shared__ __attribute__((aligned(16))) unsigned char lds[];
    Frame F;
    F.lds = (LAS unsigned char*)lds; F.ldsg = lds;
    F.tid = threadIdx.x; F.lane = F.tid & 63; F.wave = __builtin_amdgcn_readfirstlane(F.tid >> 6);
    F.G = gridDim.x; F.bid = blockIdx.x; F.ws = args.ws;
    GAS unsigned char* wsg = (GAS unsigned char*)args.ws;
#define WSP ((unsigned char*)wsg)
    volatile LAS unsigned* MISC = (volatile LAS unsigned*)(F.lds + MISC_OFF);
    for (int u = F.tid; u < 64; u += NTHR) ((LAS unsigned*)(F.lds + MISC_OFF))[u] = 0u;
    __syncthreads();
    XcdBarrier bar; bar.bar = (unsigned*)(WSP + WS_CTL) + CW_BAR; bar.x = 0; bar.st = nullptr;
    const int lo = args.ph_lo, hi = args.ph_hi;
    if (hi - lo > 1) bar = xcd_barrier_post((unsigned*)(WSP + WS_CTL) + CW_BAR, MISC + 8);
#ifndef PHMASK
#define PHMASK 0xffffffffu
#endif
#define PM(j) ((PHMASK >> (j)) & 1u)
#ifndef DUMMY_EMASK
#define DUMMY_EMASK 0x3fffu
#endif
#ifndef RPMASK
#define RPMASK 0u
#endif
#define RP(j) for (int rp_ = 0; rp_ < 1 + (int)((RPMASK >> (j)) & 1u); ++rp_)
#define LASTRP(j) (rp_ == (int)((RPMASK >> (j)) & 1u))
#define IN(k) (lo <= (k) && (k) < hi)
#define SEAM(k) do { if (IN(k) && IN((k) + 1)) { xcd_barrier(bar); if ((RPMASK >> 30) & 1u) xcd_barrier(bar); } } while (0)

    typedef __attribute__((address_space(4))) const Args* KArgs;
    KArgs ap = (KArgs)__builtin_amdgcn_kernarg_segment_ptr();
#define FRESH() asm volatile("" : "+s"(ap), "+s"(wsg)); Frame Fp = F; asm volatile("" : "+v"(Fp.tid)); Fp.lane = Fp.tid & 63; asm volatile("" : "+s"(Fp.wave), "+s"(Fp.bid), "+s"(Fp.G)); Fp.ws = WSP; LAS unsigned char* ring = Fp.lds; asm volatile("" : "+s"(ring)); Fp.lds = ring
#define INP(i) ((const float*)(GAS const float*)ap->in[i])
#define WIN_ ((bf16*)(WSP + WS_WIN))
#define WOUT_ ((bf16*)(WSP + WS_WOUT))
#define WOT_ ((bf16*)(WSP + WS_WO))
#define WQT_ ((bf16*)(WSP + WS_WQ))
#define W1T_ ((bf16*)(WSP + WS_W1T))
#define SUBK_ ((bf16*)(WSP + WS_SUBK))
#define W2T_ ((bf16*)(WSP + WS_SMALL + SM_W2T))
#define MOD_ ((float*)(WSP + WS_MOD))
#define COS_ ((const float*)(WSP + WS_COS))
#define SIN_ ((const float*)(WSP + WS_SIN))
#define KMEAN_ ((float*)(WSP + WS_SMALL + SM_KMEAN))
#define KCMP_ ((bf16*)(WSP + WS_SMALL + SM_KCMP))
#define VCMP_ ((bf16*)(WSP + WS_SMALL + SM_VCMP))
#define PBP_ ((float*)(WSP + WS_SMALL + SM_PBP))
#define EIDX_ ((int*)(WSP + WS_EIDX))
#define EW_ ((float*)(WSP + WS_EW))
#define HN_ ((bf16*)(WSP + WS_HN))
#define MIX_ ((bf16*)(WSP + WS_MIX))
#define PROJ_ ((bf16*)(WSP + WS_BIG))
#define GATES_ ((unsigned char*)(WSP + WS_GATES))
#define UT_ ((unsigned char*)(WSP + WS_BIG))
#define VT_ ((unsigned char*)(WSP + WS_BIG + 16 * MiB))
#define SU_ ((float*)(WSP + WS_BIG + 32 * MiB))
#define SV_ ((float*)(WSP + WS_BIG + 32 * MiB + 65536))
#define COEF_ ((v2u*)(WSP + WS_BIG + 33 * MiB))
#define Q2_ ((bf16*)(WSP + WS_BIG + 64 * MiB))
#define PART_ ((float*)(WSP + WS_BIG + 64 * MiB))
#define XB_ ((float*)(GAS float*)ap->out)
#define MODL_ (MOD_ + (size_t)l * 8 * 6144)
#define XIN_ ((l == 0) ? INP(I_X) : (const float*)XB_)

    if (PM(0) && IN(0)) RP(0) { FRESH(); phase_prologue(Fp, ap); }
    SEAM(0);
#pragma unroll 1
    for (int l = 0; l < DEPTH; ++l) {
        const int p0 = 1 + l * NPL;
        if (PM(1) && IN(p0 + 0)) RP(1) { FRESH(); phase_norm_mod(Fp, XIN_, INP(I_NMG) + l * DM, MODL_ + 0, MODL_ + 1024, HN_); }
        SEAM(p0 + 0);
        if (PM(2) && IN(p0 + 1)) RP(2) { FRESH(); pg8::Gemm g{HN_, WIN_ + (size_t)l * NWIN * DM, TOK, NWIN, DM}; pg8::StaticOrder S; S.init(TOK, NWIN, Fp.G, Fp.bid);
            epi::EpiProjAll E{{PROJ_, COS_, SIN_}, {GATES_}}; pg8::gemm_phase<epi::EpiProjAll, pg8::StaticOrder, true, true>(ring, g, S, E, Fp.tid); }
        SEAM(p0 + 1);
        if (PM(3) && IN(p0 + 2)) RP(3) {
            { FRESH(); phase_compress(Fp, PROJ_, W1T_ + (size_t)l * 2 * 128 * 2048, W2T_ + (size_t)l * 2 * 64 * 128, PBP_ + (size_t)l * 2 * 16 * 128, KCMP_, VCMP_); }
            { FRESH(); phase_kmean(Fp, PROJ_, KMEAN_); }
            { FRESH(); phase_mixer_a(Fp, PROJ_, INP(I_ACW) + (size_t)l * 3 * 512, MIX_); }
            __syncthreads();
            { FRESH(); phase_mixer_b(Fp, PROJ_, INP(I_BCW) + (size_t)l * 31 * 512, INP(I_BCB) + l * 512, INP(I_BLNG) + l * 512, INP(I_BLNB) + l * 512, MIX_ + (size_t)TOK * 512); }
            __syncthreads();
        }
        SEAM(p0 + 2);
        if (PM(4) && IN(p0 + 3)) RP(4) { { FRESH(); phase_nsa(Fp, PROJ_, KCMP_, VCMP_, MIX_ + (size_t)2 * TOK * 512); __syncthreads(); }
                                         { FRESH(); phase_moba(Fp, PROJ_, KMEAN_, MIX_ + (size_t)3 * TOK * 512); __syncthreads(); } }
        SEAM(p0 + 3);
        if (PM(7) && IN(p0 + 4)) RP(7) { FRESH(); pg8::Gemm g{MIX_, WOUT_ + (size_t)(l * 4) * DM * 512, 4 * TOK, 4 * DM, 512}; epi::MergeOrder S; S.init(Fp.G, Fp.bid);
            epi::EpiMergeAll E{HN_, GATES_}; pg8::gemm_phase<epi::EpiMergeAll, epi::MergeOrder, true, true>(ring, g, S, E, Fp.tid); }
        SEAM(p0 + 4);
        if (PM(8) && IN(p0 + 5)) RP(8) { FRESH(); pg8::Gemm g{HN_, WOT_ + (size_t)l * DM * DM, TOK, DM, DM}; pg8::StaticOrder S; S.init(TOK, DM, Fp.G, Fp.bid);
            epi::EpiResid E{XIN_, LASTRP(8) ? XB_ : (float*)MIX_, MODL_ + 2048}; pg8::gemm_phase<epi::EpiResid, pg8::StaticOrder, true, true>(ring, g, S, E, Fp.tid); }
        SEAM(p0 + 5);
        if (PM(9) && IN(p0 + 6)) RP(9) {
            { FRESH(); phase_norm_mod(Fp, XB_, INP(I_NFG) + l * DM, MODL_ + 3072, MODL_ + 4096, HN_); }
            { FRESH(); phase_peer_tables(Fp, INP(I_PU) + (size_t)l * 16384 * DM, INP(I_PV) + (size_t)l * 16384 * DM, UT_, VT_, SU_, SV_); }
        }
        SEAM(p0 + 6);
        if (PM(10) && IN(p0 + 7)) RP(10) { FRESH(); pg8::Gemm g{HN_, WQT_ + (size_t)l * 2048 * DM, TOK, 2048, DM}; pg8::StaticOrder S; S.init(TOK, 2048, Fp.G, Fp.bid);
            epi::EpiStoreBf E{Q2_, 2048}; pg8::gemm_phase<epi::EpiStoreBf, pg8::StaticOrder, true, true>(ring, g, S, E, Fp.tid); }
        SEAM(p0 + 7);
        if (PM(11) && IN(p0 + 8)) RP(11) { FRESH(); phase_peer_route(Fp, Q2_, SUBK_ + (size_t)l * 8 * 2 * 128 * 128, EIDX_, EW_); __syncthreads(); }
        SEAM(p0 + 8);
        if (PM(12) && IN(p0 + 9)) RP(12) { FRESH(); phase_peer_u(Fp, HN_, UT_, SU_, EIDX_, LASTRP(12) ? PART_ : (float*)MIX_, LASTRP(12) ? 0x3fffu : DUMMY_EMASK); }
        SEAM(p0 + 9);
        if (PM(12) && IN(p0 + 10)) { FRESH(); phase_peer_w(Fp, SV_, EIDX_, EW_, PART_, COEF_); }
        SEAM(p0 + 10);
        if (PM(12) && IN(p0 + 11)) RP(14) { FRESH(); phase_peer_v(Fp, VT_, COEF_, LASTRP(14) ? XB_ : (float*)MIX_, MODL_ + 5120, LASTRP(14) ? 0x3fffu : DUMMY_EMASK); }
        SEAM(p0 + 11);
    }
    if (PM(13) && IN(NPHASE - 1)) { FRESH(); phase_final_norm(Fp, XB_, INP(I_FNG), XB_); }
#ifdef DBG_STOP
    if (IN(NPHASE)) { FRESH();
        const bf16* src = (const bf16*)(WSP + (size_t)DBG_OFF); const size_t n = (size_t)DBG_BYTES / 2, NO = (size_t)TOK * DM; float* o = (float*)ap->out;
        for (size_t i = (size_t)Fp.bid * NTHR + Fp.tid; i < NO; i += (size_t)Fp.G * NTHR) { float a = 0.f; for (size_t j = i; j < n; j += NO) a += bf2f(src[j]);
#ifdef DBG_OFF2
            { const float* s2 = (const float*)(WSP + (size_t)DBG_OFF2); const size_t n2 = (size_t)DBG_BYTES2 / 4; for (size_t j = i; j < n2; j += NO) a += s2[j]; }
#endif
            if (!(a == a) || fabsf(a) > 1e30f) a = 12345.0f;
            o[i] = a; } }
#endif
#undef IN
#undef SEAM
#undef WSP
}

extern "C" void kernel_launch(void* const* d_in, const int* in_sizes, int n_in, void* d_out, int out_size, void* d_ws, size_t ws_size, hipStream_t stream) {
    static int grid = 0;
    if (grid == 0) {
        if (n_in != 26 || in_sizes[0] != TOK * DM || out_size != TOK * DM || ws_size < WS_END) {
            fprintf(stderr, "kernel_launch: unexpected problem (n_in %d, in0 %d, out %d, WSP %zu); nothing launched\n", n_in, n_in > 0 ? in_sizes[0] : -1, out_size, ws_size); grid = -1; return; }
        int dev = 0, cus = 0, per_cu = 0;
        if (hipGetDevice(&dev) != hipSuccess || hipDeviceGetAttribute(&cus, hipDeviceAttributeMultiprocessorCount, dev) != hipSuccess) { grid = -1; return; }
        if (hipFuncSetAttribute((const void*)hybrid_fwd, hipFuncAttributeMaxDynamicSharedMemorySize, LDS_BYTES) != hipSuccess) { fprintf(stderr, "kernel_launch: hipFuncSetAttribute failed\n"); grid = -1; return; }
        if (hipOccupancyMaxActiveBlocksPerMultiprocessor(&per_cu, (const void*)hybrid_fwd, NTHR, LDS_BYTES) != hipSuccess || per_cu < 1)
            fprintf(stderr, "kernel_launch: note: occupancy query reports %d workgroups per CU\n", per_cu);
        (void)hipGetLastError();
        grid = cus;
    }
    if (grid < 0) return;
    if (hipMemsetAsync((char*)d_ws + WS_CTL, 0, CTL_ZERO_BYTES, stream) != hipSuccess) return;
    Args a{};
    for (int i = 0; i < 26; ++i) a.in[i] = d_in[i];
    a.out = (float*)d_out; a.ws = (unsigned char*)d_ws;
#if MK_PER_PHASE
#ifdef DBG_STOP
    for (int p = 0; p <= DBG_STOP; ++p) { a.ph_lo = p; a.ph_hi = p + 1; hipLaunchKernelGGL(hybrid_fwd, dim3(grid), dim3(NTHR), LDS_BYTES, stream, a); }
    a.ph_lo = NPHASE; a.ph_hi = NPHASE + 1; hipLaunchKernelGGL(hybrid_fwd, dim3(grid), dim3(NTHR), LDS_BYTES, stream, a);
#else
    for (int p = 0; p < NPHASE; ++p) { a.ph_lo = p; a.ph_hi = p + 1; hipLaunchKernelGGL(hybrid_fwd, dim3(grid), dim3(NTHR), LDS_BYTES, stream, a); }
#endif
#else
    a.ph_lo = 0; a.ph_hi = NPHASE; hipLaunchKernelGGL(hybrid_fwd, dim3(grid), dim3(NTHR), LDS_BYTES, stream, a);
#endif
    const hipError_t le = hipPeekAtLastError();
    if (le != hipSuccess) fprintf(stderr, "kernel_launch: launch failed: %s\n", hipGetErrorName(le));
}
```

```cpp
#include <hip/hip_runtime.h>
#include <hip/hip_bf16.h>
#include <cstdio>
#include <cstdint>
#include <cmath>

#ifndef MK_PER_PHASE
#define MK_PER_PHASE 0
#endif

#define DUMMY_EMASK 0x3fffu
#define RPMASK 0x0u
#define GAS __attribute__((address_space(1)))
#define LAS __attribute__((address_space(3)))
typedef unsigned short bf16;
typedef unsigned v4u __attribute__((ext_vector_type(4)));
typedef unsigned v2u __attribute__((ext_vector_type(2)));
typedef float f32x4 __attribute__((ext_vector_type(4)));
typedef float f32x2 __attribute__((ext_vector_type(2)));
typedef float f32x16 __attribute__((ext_vector_type(16)));
typedef short bf16x8 __attribute__((ext_vector_type(8)));
typedef short s16x4 __attribute__((ext_vector_type(4)));
typedef __bf16 bf16x2_t __attribute__((ext_vector_type(2)));

constexpr int BATCH = 8, SEQ = 2048, DM = 1024, DEPTH = 2, TOK = BATCH * SEQ;
constexpr int NP1 = 5632;
constexpr int NGT = 4096;
constexpr int NWIN = NP1 + NGT;
constexpr int C_AB = 0, C_AC = 512, C_AX = 1024, C_BA = 1536, C_BG = 2048, C_CQ = 2560, C_KC = 3072, C_VC = 3200, C_KS = 3328, C_VS = 3456, C_KW = 3584, C_VW = 3712,
              C_DQ = 3840, C_DK = 4352, C_DV = 4864, C_CG = 5376;
constexpr float NORM_EPS = 1e-6f;
constexpr float QSCALE = 0.125f * 1.4426950408889634f;

constexpr size_t MiB = 1u << 20;
constexpr size_t WS_CTL = 0, CTL_ZERO_BYTES = 64 * 1024;
constexpr size_t WS_MOD = 1 * MiB;
constexpr size_t WS_COS = 2 * MiB, WS_SIN = 4 * MiB;
constexpr size_t WS_SMALL = 6 * MiB;
constexpr size_t SM_KMEAN = 704 * 1024;
constexpr size_t SM_KCMP = 64 * 1024;
constexpr size_t SM_VCMP = 320 * 1024;
constexpr size_t SM_PBP = 576 * 1024;
constexpr size_t SM_W2T = 640 * 1024;
constexpr size_t WS_EIDX = 8 * MiB;
constexpr size_t WS_EW = 16 * MiB;
constexpr size_t WS_WIN = 24 * MiB;
constexpr size_t WS_WOUT = 62 * MiB;
constexpr size_t WS_WO = 70 * MiB;
constexpr size_t WS_WQ = 74 * MiB;
constexpr size_t WS_W1T = 82 * MiB;
constexpr size_t WS_SUBK = 84 * MiB;
constexpr size_t WS_HN = 86 * MiB;
constexpr size_t WS_MIX = 118 * MiB;
constexpr size_t WS_BIG = 182 * MiB;
constexpr size_t WS_GATES = 358 * MiB;
constexpr size_t WS_END = 486 * MiB;

constexpr int LDS_BYTES = 147456;
constexpr int RING_BYTES = 131072;
constexpr int MISC_OFF = LDS_BYTES - 256;

#define RLX_AGENT __ATOMIC_RELAXED, __HIP_MEMORY_SCOPE_AGENT
#define LDS_WAIT() asm volatile("s_waitcnt lgkmcnt(0)" ::: "memory")
#define VM_WAIT() asm volatile("s_waitcnt vmcnt(0)" ::: "memory")
__device__ __forceinline__ unsigned f2bf(float f) { unsigned u = __builtin_bit_cast(unsigned, f); return (u + 0x7fffu + ((u >> 16) & 1u)) >> 16; }
__device__ __forceinline__ float bf2f(unsigned h) { return __builtin_bit_cast(float, h << 16); }
__device__ __forceinline__ unsigned pk2(float lo, float hi) { f32x2 v = {lo, hi}; bf16x2_t b = __builtin_convertvector(v, bf16x2_t); return __builtin_bit_cast(unsigned, b); }
__device__ __forceinline__ float bflo(unsigned w) { return __builtin_bit_cast(float, w << 16); }
__device__ __forceinline__ float bfhi(unsigned w) { return __builtin_bit_cast(float, w & 0xffff0000u); }
__device__ __forceinline__ float sigmoidf_(float x) { return 1.0f / (1.0f + __expf(-x)); }
__device__ __forceinline__ float gelu_erf(float x) { return 0.5f * x * (1.0f + erff(x * 0.70710678118654752f)); }
__device__ __forceinline__ float shx(float v, int m, int lane) { return __builtin_bit_cast(float, __builtin_amdgcn_ds_bpermute((lane ^ m) << 2, __builtin_bit_cast(int, v))); }
__device__ __forceinline__ unsigned shxu(unsigned v, int m, int lane) { return (unsigned)__builtin_amdgcn_ds_bpermute((lane ^ m) << 2, (int)v); }
__device__ __forceinline__ void swap32(unsigned v, unsigned& r0, unsigned& r1) { unsigned b = v; asm volatile("" : "+v"(b)); auto r = __builtin_amdgcn_permlane32_swap(v, b, false, false); r0 = r[0]; r1 = r[1]; }
__device__ __forceinline__ float other32(float v, int hi) { unsigned r0, r1; swap32(__builtin_bit_cast(unsigned, v), r0, r1); return __builtin_bit_cast(float, hi ? r0 : r1); }
__device__ __forceinline__ float add32(float v) { unsigned r0, r1; swap32(__builtin_bit_cast(unsigned, v), r0, r1); return __builtin_bit_cast(float, r0) + __builtin_bit_cast(float, r1); }
__device__ __forceinline__ float max32(float v) { unsigned r0, r1; swap32(__builtin_bit_cast(unsigned, v), r0, r1); return fmaxf(__builtin_bit_cast(float, r0), __builtin_bit_cast(float, r1)); }
__device__ __forceinline__ unsigned umax32(unsigned v) { unsigned r0, r1; swap32(v, r0, r1); return r0 > r1 ? r0 : r1; }
__device__ __forceinline__ float wave_sum(float v, int lane) {
#pragma unroll
    for (int o = 1; o < 32; o <<= 1) v += shx(v, o, lane);
    return add32(v);
}
namespace pg8 {
#define PG8_LAS __attribute__((address_space(3)))
typedef unsigned short bf16_t;
typedef short bf16x8 __attribute__((ext_vector_type(8)));
typedef float f32x4 __attribute__((ext_vector_type(4)));
typedef unsigned u32x4 __attribute__((ext_vector_type(4)));
constexpr int BM = 256, BK = 64, HALF = 128, HTB = HALF * BK * 2  , STAGE_BYTES = 8 * HTB, NXCD = 8, WGM = 8;

__host__ __device__ __forceinline__ int lds_byte(int r, int c) { const int st = (r >> 4) * 2 + (c >> 5), rr = r & 15, cc = c & 31, ob = rr * 64 + cc * 2; return st * 1024 + (ob ^ (((ob >> 9) & 1) << 5)); }
__host__ __device__ __forceinline__ void stage_rc(int b, int& R, int& C) { const int st = b / 1024, sb = b % 1024, swz = sb ^ (((sb >> 9) & 1) << 5); R = (st >> 1) * 16 + swz / 64; C = (st & 1) * 32 + (swz % 64) / 2; }
__host__ __device__ __forceinline__ int perm32(int rho) { const int n = rho >> 4, i = rho & 15; return 8 * (i >> 2) + 4 * n + (i & 3); }

struct Unit { int pm, pn; };
struct Gemm { const bf16_t* A; const bf16_t* Bt; int M, N, K; };

struct StaticOrder {
    int nM, nN, nwg, G, c;
    __host__ __device__ void init(int M, int N, int G_, int c_) { nM = M / BM; nN = N / BM; nwg = nM * nN; G = G_; c = c_; }
    __host__ __device__ bool next(int i, Unit& u) const {
        const long L = (long)i * G + c; if (L >= nwg) return false;
        int wgid = (int)L; { const int q = nwg / NXCD, r = nwg % NXCD, xcd = wgid % NXCD, off = wgid / NXCD; wgid = (xcd < r ? xcd * (q + 1) : r * (q + 1) + (xcd - r) * q) + off; }
        const int nig = WGM * nN, gid = wgid / nig, fm = gid * WGM, gsz = (nM - fm) < WGM ? (nM - fm) : WGM;
        u.pm = fm + ((wgid % nig) % gsz); u.pn = (wgid % nig) / gsz; return true;
    }
    __device__ __forceinline__ void a_ready(const Unit&) const {}
    __device__ __forceinline__ void done(const Unit&) const {}
};

__device__ __forceinline__ unsigned cvt_pk_bf16(float lo, float hi) { unsigned r; asm volatile("v_cvt_pk_bf16_f32 %0, %1, %2" : "=v"(r) : "v"(lo), "v"(hi)); return r; }
typedef float f32x2 __attribute__((ext_vector_type(2)));
template <class Epi, class Sched, bool ALIGN_EPI = false, bool SP2 = false>
__device__ __forceinline__ void gemm_phase(PG8_LAS unsigned char* lds, const Gemm g, const Sched& S, const Epi& E, const int tid) {
    const int wid = __builtin_amdgcn_readfirstlane(tid >> 6), lane = tid & 63, wr = wid >> 2, wc = wid & 3, fr = lane & 15, fq = lane >> 4;
    const int K = g.K, nt = K / BK;
    unsigned voffA[2], voffB[2];
#pragma unroll
    for (int i = 0; i < 2; ++i) { int R, C; stage_rc(tid * 16 + i * 8192, R, C); const int Rb = Epi::PERM ? ((R & ~31) + perm32(R & 31)) : R;
        voffA[i] = (unsigned)(R * K + C) * 2u; voffB[i] = (unsigned)(Rb * K + C) * 2u; }
    const size_t kstep = (size_t)(BK * 2);
    const size_t hstep = (size_t)HALF * K * 2;
    const size_t tstep = 2 * hstep;
    const unsigned ldsw = (unsigned)wid * 1024u;
    const int aoff = lds_byte(wr * 64 + fr, fq * 8), boff = lds_byte(wc * 32 + fr, fq * 8);
#define PG8_SA(b, h) (((b) * 2 + (h)) * HTB)
#define PG8_SB(b, h) ((4 + (b) * 2 + (h)) * HTB)
#define PG8_STAGE(bufoff, gbase, voff) do { _Pragma("unroll") for (int _i = 0; _i < 2; ++_i) \
        __builtin_amdgcn_global_load_lds((const unsigned*)((const char*)(gbase) + (voff)[_i]), (PG8_LAS unsigned*)(lds + (bufoff) + ldsw + _i * 8192), 16, 0, 0); } while (0)
#define PG8_LDA(dst, b, h) do { _Pragma("unroll") for (int m = 0; m < 4; ++m) _Pragma("unroll") for (int k = 0; k < 2; ++k) dst[m][k] = *(const PG8_LAS bf16x8*)(lds + PG8_SA(b, h) + aoff + m * 2048 + k * 1024); } while (0)
#define PG8_LDB(dst, b, h) do { _Pragma("unroll") for (int n = 0; n < 2; ++n) _Pragma("unroll") for (int k = 0; k < 2; ++k) dst[n][k] = *(const PG8_LAS bf16x8*)(lds + PG8_SB(b, h) + boff + n * 2048 + k * 1024); } while (0)
#define PG8_MMA(ai, bj, At, Bt) do { __builtin_amdgcn_s_setprio(1); _Pragma("unroll") for (int m = 0; m < 4; ++m) _Pragma("unroll") for (int n = 0; n < 2; ++n) _Pragma("unroll") for (int k = 0; k < 2; ++k) \
        acc[ai][bj][m][n] = __builtin_amdgcn_mfma_f32_16x16x32_bf16(Bt[n][k], At[m][k], acc[ai][bj][m][n], 0, 0, 0); __builtin_amdgcn_s_setprio(0); } while (0)
#define PG8_WAIT_V(n) asm volatile("s_waitcnt vmcnt(" #n ")" ::: "memory")
#define PG8_WAIT_L(n) asm volatile("s_waitcnt lgkmcnt(" #n ")" ::: "memory")
#define PG8_BAR __builtin_amdgcn_s_barrier()
#define PG8_SCHED __builtin_amdgcn_sched_barrier(0)
    Unit cur, nxt; int ui = 0;
    if (!S.next(0, cur)) return;
    f32x4 acc[2][2][4][2];
#pragma unroll
    for (int a = 0; a < 2; ++a)
#pragma unroll
        for (int b = 0; b < 2; ++b)
#pragma unroll
            for (int m = 0; m < 4; ++m)
#pragma unroll
                for (int n = 0; n < 2; ++n) acc[a][b][m][n] = (f32x4){0.f, 0.f, 0.f, 0.f};
    bf16x8 At[4][2], B0[2][2], B1[2][2];
    const char* cA = (const char*)g.A + (size_t)cur.pm * tstep; const char* cB = (const char*)g.Bt + (size_t)cur.pn * tstep;
    S.a_ready(cur);
    if constexpr (SP2) {
        PG8_STAGE(PG8_SB(0, 0), cB, voffB); PG8_STAGE(PG8_SB(0, 1), cB + hstep, voffB); PG8_STAGE(PG8_SA(0, 0), cA, voffA); PG8_STAGE(PG8_SA(0, 1), cA + hstep, voffA);
        if (wr == 1) PG8_BAR;
        PG8_WAIT_V(2); PG8_BAR;
        PG8_STAGE(PG8_SB(1, 0), cB + kstep, voffB); PG8_STAGE(PG8_SA(1, 0), cA + kstep, voffA); PG8_STAGE(PG8_SB(1, 1), cB + hstep + kstep, voffB);
        PG8_WAIT_V(6); PG8_BAR;
    } else {
        PG8_STAGE(PG8_SB(0, 0), cB, voffB); PG8_STAGE(PG8_SA(0, 0), cA, voffA); PG8_STAGE(PG8_SB(0, 1), cB + hstep, voffB); PG8_STAGE(PG8_SA(0, 1), cA + hstep, voffA);
        if (wr == 1) PG8_BAR;
        PG8_WAIT_V(4); PG8_BAR;
        PG8_STAGE(PG8_SB(1, 0), cB + kstep, voffB); PG8_STAGE(PG8_SA(1, 0), cA + kstep, voffA); PG8_STAGE(PG8_SB(1, 1), cB + hstep + kstep, voffB);
        PG8_WAIT_V(6); PG8_BAR;
    }
    for (;;) {
        const bool has_next = S.next(ui + 1, nxt);
        const char* nA = has_next ? (const char*)g.A + (size_t)nxt.pm * tstep : cA; const char* nB = has_next ? (const char*)g.Bt + (size_t)nxt.pn * tstep : cB;
        for (int t = 0; t < nt; t += 2) {
            const bool last = (t == nt - 2);
            const char* a1 = cA + (size_t)(t + 1) * kstep;
            const char* a2 = last ? nA : cA + (size_t)(t + 2) * kstep; const char* b2 = last ? nB : cB + (size_t)(t + 2) * kstep;
            const char* a3 = a2 + kstep; const char* b3 = b2 + kstep;
            if (last && has_next) S.a_ready(nxt);
            if constexpr (SP2) {
            PG8_LDB(B0, 0, 0); PG8_LDB(B1, 0, 1); PG8_SCHED; PG8_LDA(At, 0, 0); PG8_STAGE(PG8_SA(1, 1), a1 + hstep, voffA);
            PG8_WAIT_V(8); PG8_WAIT_L(0); PG8_BAR; PG8_MMA(0, 0, At, B0); PG8_MMA(0, 1, At, B1); PG8_BAR; PG8_SCHED;
            PG8_LDA(At, 0, 1); PG8_STAGE(PG8_SB(0, 0), b2, voffB); PG8_STAGE(PG8_SB(0, 1), b2 + hstep, voffB); PG8_STAGE(PG8_SA(0, 0), a2, voffA);
            PG8_WAIT_V(8); PG8_WAIT_L(0); PG8_BAR; PG8_MMA(1, 0, At, B0); PG8_MMA(1, 1, At, B1); PG8_BAR; PG8_SCHED;
            PG8_LDB(B0, 1, 0); PG8_LDB(B1, 1, 1); PG8_SCHED; PG8_LDA(At, 1, 0); PG8_STAGE(PG8_SA(0, 1), a2 + hstep, voffA);
            PG8_WAIT_V(8); PG8_WAIT_L(0); PG8_BAR; PG8_MMA(0, 0, At, B0); PG8_MMA(0, 1, At, B1); PG8_BAR; PG8_SCHED;
            PG8_LDA(At, 1, 1); PG8_STAGE(PG8_SB(1, 0), b3, voffB); PG8_STAGE(PG8_SB(1, 1), b3 + hstep, voffB); PG8_STAGE(PG8_SA(1, 0), a3, voffA);
            PG8_WAIT_V(8); PG8_WAIT_L(0); PG8_BAR; PG8_MMA(1, 0, At, B0); PG8_MMA(1, 1, At, B1); PG8_BAR; PG8_SCHED;
            } else {
            PG8_LDB(B0, 0, 0); PG8_SCHED; PG8_LDA(At, 0, 0); PG8_STAGE(PG8_SA(1, 1), a1 + hstep, voffA);
            PG8_WAIT_L(8); PG8_BAR; PG8_WAIT_L(0); PG8_MMA(0, 0, At, B0); PG8_BAR; PG8_SCHED;
            PG8_LDB(B1, 0, 1); PG8_STAGE(PG8_SB(0, 0), b2, voffB);
            PG8_BAR; PG8_WAIT_L(0); PG8_MMA(0, 1, At, B1); PG8_BAR;
            PG8_LDA(At, 0, 1); PG8_STAGE(PG8_SA(0, 0), a2, voffA);
            PG8_BAR; PG8_WAIT_L(0); PG8_MMA(1, 0, At, B0); PG8_BAR; PG8_SCHED;
            PG8_STAGE(PG8_SB(0, 1), b2 + hstep, voffB);
            PG8_WAIT_V(6); PG8_BAR; PG8_MMA(1, 1, At, B1); PG8_BAR;
            PG8_LDB(B0, 1, 0); PG8_SCHED; PG8_LDA(At, 1, 0); PG8_STAGE(PG8_SA(0, 1), a2 + hstep, voffA);
            PG8_WAIT_L(8); PG8_BAR; PG8_WAIT_L(0); PG8_MMA(0, 0, At, B0); PG8_BAR; PG8_SCHED;
            PG8_LDB(B1, 1, 1); PG8_STAGE(PG8_SB(1, 0), b3, voffB);
            PG8_BAR; PG8_WAIT_L(0); PG8_MMA(0, 1, At, B1); PG8_BAR;
            PG8_LDA(At, 1, 1); PG8_STAGE(PG8_SA(1, 0), a3, voffA);
            PG8_BAR; PG8_WAIT_L(0); PG8_MMA(1, 0, At, B0); PG8_BAR; PG8_SCHED;
            PG8_STAGE(PG8_SB(1, 1), b3 + hstep, voffB);
            PG8_WAIT_V(6); PG8_BAR; PG8_MMA(1, 1, At, B1); PG8_BAR;
            }
        }
        if constexpr (ALIGN_EPI) { if (wr == 0) PG8_BAR; }
        if constexpr (Epi::KEEP_ACC) { E.inplace(acc, cur, wr, wc, fr, fq); S.done(cur); }
        else if constexpr (!Epi::AFTER_DRAIN) { E(acc, cur, wr, wc, fr, fq); S.done(cur); }
        if (!has_next) break;
        if constexpr (!Epi::KEEP_ACC)
#pragma unroll
        for (int a = 0; a < 2; ++a)
#pragma unroll
            for (int b = 0; b < 2; ++b)
#pragma unroll
                for (int m = 0; m < 4; ++m)
#pragma unroll
                    for (int n = 0; n < 2; ++n) acc[a][b][m][n] = (f32x4){0.f, 0.f, 0.f, 0.f};
        cur = nxt; cA = nA; cB = nB; ++ui;
        if constexpr (ALIGN_EPI) { if (wr == 1) PG8_BAR; }
    }
    PG8_WAIT_V(0);
    if constexpr (!ALIGN_EPI) { if (wr == 0) PG8_BAR; }
    PG8_BAR;
    if constexpr (Epi::AFTER_DRAIN) { E.fused(acc, cur, wr, wc, fr, fq, lds, wid, lane); S.done(cur); }
#undef PG8_SA
#undef PG8_SB
#undef PG8_STAGE
#undef PG8_LDA
#undef PG8_LDB
#undef PG8_MMA
#undef PG8_WAIT_V
#undef PG8_WAIT_L
#undef PG8_BAR
#undef PG8_SCHED
}
}
#define XB_TMO      128
#define XB_XCNT(j)  (256  + 64 * (j))
#define XB_XSUB(j)  (1280 + 64 * (j))
#define XB_XGEN(j)  (2304 + 64 * (j))
#define XB_TOP      3328
#define XB_TOPGEN   3392
#define XCD_BAR_WORDS 3456
#define XB_SPIN_CAP (1u << 25)

__device__ __forceinline__ unsigned xb_ld(unsigned* p)              { return __hip_atomic_load(p, __ATOMIC_RELAXED, __HIP_MEMORY_SCOPE_AGENT); }
__device__ __forceinline__ unsigned xb_add(unsigned* p, unsigned v) { return __hip_atomic_fetch_add(p, v, __ATOMIC_RELAXED, __HIP_MEMORY_SCOPE_AGENT); }
__device__ __forceinline__ unsigned xb_xcc_id() { return (unsigned)__builtin_amdgcn_s_getreg((3 << 11) | 20) & 0xFu; }
#define XB_SPIN(cond, bar) do { unsigned _sp = 0; while (cond) { __builtin_amdgcn_s_sleep(1); \
    if ((++_sp & 255u) == 0u) { if (xb_ld(&(bar)[XB_TMO])) break; if (_sp > XB_SPIN_CAP) { atomicAdd(&(bar)[XB_TMO], 1u); break; } } } } while (0)

struct XcdBarrier {
    unsigned* bar; unsigned x;
    volatile LAS unsigned* st;
};

__device__ __forceinline__ XcdBarrier xcd_barrier_post(unsigned* bar, volatile LAS unsigned* st) {
    XcdBarrier b; b.bar = bar; b.x = xb_xcc_id(); b.st = st;
    if (threadIdx.x == 0) (void)xb_add(&bar[XB_XCNT(b.x)], 1u);
    return b;
}
__device__ __forceinline__ void xcd_barrier_complete(unsigned* bar, unsigned x, unsigned& nloc, unsigned& nx) {
    const unsigned G = gridDim.x * gridDim.y * gridDim.z;
    unsigned sum, cnt, mine, sp = 0u;
    for (;;) {
        sum = 0u; cnt = 0u; mine = 0u;
#pragma unroll
        for (unsigned j = 0; j < 16; ++j) { const unsigned c = xb_ld(&bar[XB_XCNT(j)]); sum += c; cnt += (c > 0u) ? 1u : 0u; mine = (j == x) ? c : mine; }
        if (sum == G) break;
        __builtin_amdgcn_s_sleep(1);
        if ((++sp & 255u) == 0u) { if (xb_ld(&bar[XB_TMO])) break; if (sp > XB_SPIN_CAP) { atomicAdd(&bar[XB_TMO], 1u); break; } }
    }
    nloc = mine > 0u ? mine : 1u; nx = cnt > 0u ? cnt : 1u;
}

__device__ __forceinline__ void xcd_barrier(const XcdBarrier& b) {
    asm volatile("s_waitcnt vmcnt(0)" ::: "memory");
    __syncthreads();
    if (threadIdx.x == 0) {
        unsigned* bar = b.bar;
        __builtin_amdgcn_s_waitcnt(0);
        unsigned nloc = b.st[0], nx = b.st[1];
        if (nloc == 0u) { xcd_barrier_complete(bar, b.x, nloc, nx); b.st[0] = nloc; b.st[1] = nx; }
        const unsigned old = xb_add(&bar[XB_XSUB(b.x)], 1u);
        const unsigned gen = old / nloc;
        if (old + 1u == (gen + 1u) * nloc) {
            __builtin_amdgcn_fence(__ATOMIC_RELEASE, "agent");
            asm volatile("s_waitcnt vmcnt(0)" ::: "memory");
            const unsigned og = xb_add(&bar[XB_TOP], 1u);
            const unsigned tg = og / nx;
            if (og + 1u == (tg + 1u) * nx) xb_add(&bar[XB_TOPGEN], 1u);
            else XB_SPIN(xb_ld(&bar[XB_TOPGEN]) == tg, bar);
            __builtin_amdgcn_fence(__ATOMIC_ACQUIRE, "agent");
            xb_add(&bar[XB_XGEN(b.x)], 1u);
            asm volatile("s_waitcnt vmcnt(0)" ::: "memory");
        } else {
            XB_SPIN(xb_ld(&bar[XB_XGEN(b.x)]) == gen, bar);
            __builtin_amdgcn_fence(__ATOMIC_ACQUIRE, "agent");
            asm volatile("s_waitcnt vmcnt(0)" ::: "memory");
        }
    }
    __syncthreads();
}

namespace epi {
using pg8::Unit; using pg8::BM; using pg8::HALF;
typedef const pg8::f32x4 (&AccRef)[2][2][4][2];

struct EpiProj1 {
    static constexpr bool PERM = true, AFTER_DRAIN = false, KEEP_ACC = false;
    bf16* O; const float* cosT; const float* sinT;
    __device__ __forceinline__ void operator()(AccRef acc, const Unit& u, int wr, int wc, int fr, int fq) const {
        const int row0 = u.pm * BM + wr * 64 + fr, colw = u.pn * BM + wc * 32;
#pragma unroll
        for (int bj = 0; bj < 2; ++bj) {
            const int hb = (colw + bj * HALF) >> 6;
            const bool rope = (hb >= 40 && hb < 50) || (hb >= 52 && hb < 54) || (hb >= 56 && hb < 58) || (hb >= 60 && hb < 76);
            const bool isq = (hb >= 40 && hb < 48) || (hb >= 60 && hb < 68);
            const float qs = isq ? QSCALE : 1.0f;
            const int jw = (wc & 1) * 16 + fq * 4;
#pragma unroll
            for (int ai = 0; ai < 2; ++ai)
#pragma unroll
                for (int m = 0; m < 4; ++m) {
                    const int row = row0 + ai * HALF + m * 16;
                    pg8::f32x4 v0 = acc[ai][bj][m][0], v1 = acc[ai][bj][m][1];
                    if (rope) {
                        const pg8::f32x4 c = *(const pg8::f32x4*)(cosT + (size_t)row * 32 + jw), s = *(const pg8::f32x4*)(sinT + (size_t)row * 32 + jw);
                        const float a0 = v0[0] * c[0] - v0[1] * s[0], a1 = v0[1] * c[0] + v0[0] * s[0], a2 = v0[2] * c[1] - v0[3] * s[1], a3 = v0[3] * c[1] + v0[2] * s[1];
                        const float b0 = v1[0] * c[2] - v1[1] * s[2], b1 = v1[1] * c[2] + v1[0] * s[2], b2 = v1[2] * c[3] - v1[3] * s[3], b3 = v1[3] * c[3] + v1[2] * s[3];
                        v0 = (pg8::f32x4){a0, a1, a2, a3} * qs; v1 = (pg8::f32x4){b0, b1, b2, b3} * qs;
                    }
                    v4u w; w.x = pk2(v0[0], v0[1]); w.y = pk2(v0[2], v0[3]); w.z = pk2(v1[0], v1[1]); w.w = pk2(v1[2], v1[3]);
                    *(v4u*)(O + (size_t)row * NP1 + colw + bj * HALF + 8 * fq) = w;
                }
        }
    }
};
struct EpiStoreBf {
    static constexpr bool PERM = true, AFTER_DRAIN = false, KEEP_ACC = false;
    bf16* O; int ldc;
    __device__ __forceinline__ void operator()(AccRef acc, const Unit& u, int wr, int wc, int fr, int fq) const {
        const int row0 = u.pm * BM + wr * 64 + fr, col0 = u.pn * BM + wc * 32 + 8 * fq;
#pragma unroll
        for (int ai = 0; ai < 2; ++ai)
#pragma unroll
            for (int m = 0; m < 4; ++m) { bf16* rowp = O + (size_t)(row0 + ai * HALF + m * 16) * ldc + col0;
#pragma unroll
                for (int bj = 0; bj < 2; ++bj) { const pg8::f32x4 v0 = acc[ai][bj][m][0], v1 = acc[ai][bj][m][1];
                    v4u w; w.x = pk2(v0[0], v0[1]); w.y = pk2(v0[2], v0[3]); w.z = pk2(v1[0], v1[1]); w.w = pk2(v1[2], v1[3]); *(v4u*)(rowp + bj * HALF) = w; } }
    }
};
__device__ __forceinline__ float gate_enc(float x) { return 2.0f * sigmoidf_(x) - 1.0f; }
struct EpiGates {
    static constexpr bool PERM = true, AFTER_DRAIN = false, KEEP_ACC = false;
    unsigned char* O;
    __device__ __forceinline__ void operator()(AccRef acc, const Unit& u, int wr, int wc, int fr, int fq) const {
        const int row0 = u.pm * BM + wr * 64 + fr, col0 = u.pn * BM + wc * 32 + 8 * fq;
#pragma unroll
        for (int ai = 0; ai < 2; ++ai)
#pragma unroll
            for (int m = 0; m < 4; ++m) { unsigned char* rowp = O + (size_t)(row0 + ai * HALF + m * 16) * NGT + col0;
#pragma unroll
                for (int bj = 0; bj < 2; ++bj) { const pg8::f32x4 v0 = acc[ai][bj][m][0], v1 = acc[ai][bj][m][1];
                    v2u w; unsigned p = 0u; p = __builtin_amdgcn_cvt_pk_fp8_f32(gate_enc(v0[0]), gate_enc(v0[1]), p, false); p = __builtin_amdgcn_cvt_pk_fp8_f32(gate_enc(v0[2]), gate_enc(v0[3]), p, true); w.x = p;
                    p = 0u; p = __builtin_amdgcn_cvt_pk_fp8_f32(gate_enc(v1[0]), gate_enc(v1[1]), p, false); p = __builtin_amdgcn_cvt_pk_fp8_f32(gate_enc(v1[2]), gate_enc(v1[3]), p, true); w.y = p;
                    *(v2u*)(rowp + bj * HALF) = w; } }
    }
};
struct EpiMerge {
    static constexpr bool PERM = true, AFTER_DRAIN = false, KEEP_ACC = false;
    bf16* O; const unsigned char* G; int seg;
    __device__ __forceinline__ void operator()(AccRef acc, const Unit& u, int wr, int wc, int fr, int fq) const {
        const int row0 = u.pm * BM + wr * 64 + fr, col0 = u.pn * BM + wc * 32 + 8 * fq;
#pragma unroll
        for (int ai = 0; ai < 2; ++ai)
#pragma unroll
            for (int m = 0; m < 4; ++m) { const size_t row = (size_t)(row0 + ai * HALF + m * 16); bf16* rowp = O + row * DM + col0; const unsigned char* gp = G + row * NGT + seg * DM + col0;
#pragma unroll
                for (int bj = 0; bj < 2; ++bj) { pg8::f32x4 v0 = acc[ai][bj][m][0], v1 = acc[ai][bj][m][1];
                    const v2u g = *(const v2u*)(gp + bj * HALF);
                    const f32x2 g0 = __builtin_amdgcn_cvt_pk_f32_fp8(g.x, false), g1 = __builtin_amdgcn_cvt_pk_f32_fp8(g.x, true), g2 = __builtin_amdgcn_cvt_pk_f32_fp8(g.y, false), g3 = __builtin_amdgcn_cvt_pk_f32_fp8(g.y, true);
                    v0[0] *= 0.5f * g0.x + 0.5f; v0[1] *= 0.5f * g0.y + 0.5f; v0[2] *= 0.5f * g1.x + 0.5f; v0[3] *= 0.5f * g1.y + 0.5f;
                    v1[0] *= 0.5f * g2.x + 0.5f; v1[1] *= 0.5f * g2.y + 0.5f; v1[2] *= 0.5f * g3.x + 0.5f; v1[3] *= 0.5f * g3.y + 0.5f;
                    if (seg != 0) { const v4u o = *(const v4u*)(rowp + bj * HALF); v0[0] += bflo(o.x); v0[1] += bfhi(o.x); v0[2] += bflo(o.y); v0[3] += bfhi(o.y); v1[0] += bflo(o.z); v1[1] += bfhi(o.z); v1[2] += bflo(o.w); v1[3] += bfhi(o.w); }
                    v4u w; w.x = pk2(v0[0], v0[1]); w.y = pk2(v0[2], v0[3]); w.z = pk2(v1[0], v1[1]); w.w = pk2(v1[2], v1[3]); *(v4u*)(rowp + bj * HALF) = w; } }
    }
};
struct EpiResid {
    static constexpr bool PERM = false, AFTER_DRAIN = false, KEEP_ACC = false;
    const float* XI; float* XO; const float* gate;
    __device__ __forceinline__ void operator()(AccRef acc, const Unit& u, int wr, int wc, int fr, int fq) const {
        const int row0 = u.pm * BM + wr * 64 + fr, col0 = u.pn * BM + wc * 32 + 4 * fq;
        const float* gb = gate + (size_t)((u.pm * BM) / SEQ) * 6144 + col0;
        pg8::f32x4 gv[2][2];
#pragma unroll
        for (int bj = 0; bj < 2; ++bj)
#pragma unroll
            for (int n = 0; n < 2; ++n) gv[bj][n] = *(const pg8::f32x4*)(gb + bj * HALF + n * 16);
#pragma unroll
        for (int ai = 0; ai < 2; ++ai)
#pragma unroll
            for (int m = 0; m < 4; ++m) { const size_t off = (size_t)(row0 + ai * HALF + m * 16) * DM + col0;
#pragma unroll
                for (int bj = 0; bj < 2; ++bj)
#pragma unroll
                    for (int n = 0; n < 2; ++n) { const pg8::f32x4 xi = *(const pg8::f32x4*)(XI + off + bj * HALF + n * 16);
                        *(pg8::f32x4*)(XO + off + bj * HALF + n * 16) = xi + gv[bj][n] * acc[ai][bj][m][n]; } }
    }
};

struct EpiProjAll {
    static constexpr bool PERM = true, AFTER_DRAIN = false, KEEP_ACC = false;
    static_assert(true, ""); EpiProj1 P; EpiGates G;
    __device__ __forceinline__ void operator()(AccRef acc, const Unit& u, int wr, int wc, int fr, int fq) const {
        if (u.pn < NP1 / BM) P(acc, u, wr, wc, fr, fq);
        else { Unit v = u; v.pn -= NP1 / BM; G(acc, v, wr, wc, fr, fq); }
    }
};
__device__ __forceinline__ void gates8(const unsigned char* p, float (&g)[8]) {
    const v2u w = *(const v2u*)p;
    const f32x2 a = __builtin_amdgcn_cvt_pk_f32_fp8(w.x, false), b = __builtin_amdgcn_cvt_pk_f32_fp8(w.x, true), c = __builtin_amdgcn_cvt_pk_f32_fp8(w.y, false), d = __builtin_amdgcn_cvt_pk_f32_fp8(w.y, true);
    g[0] = fmaxf(0.5f * a.x + 0.5f, 0x1p-10f); g[1] = fmaxf(0.5f * a.y + 0.5f, 0x1p-10f); g[2] = fmaxf(0.5f * b.x + 0.5f, 0x1p-10f); g[3] = fmaxf(0.5f * b.y + 0.5f, 0x1p-10f);
    g[4] = fmaxf(0.5f * c.x + 0.5f, 0x1p-10f); g[5] = fmaxf(0.5f * c.y + 0.5f, 0x1p-10f); g[6] = fmaxf(0.5f * d.x + 0.5f, 0x1p-10f); g[7] = fmaxf(0.5f * d.y + 0.5f, 0x1p-10f);
}
struct EpiMergeAll {
    static constexpr bool PERM = true, AFTER_DRAIN = false, KEEP_ACC = true;
    bf16* O; const unsigned char* G;
    __device__ __forceinline__ void operator()(AccRef, const Unit&, int, int, int, int) const {}
    __device__ __forceinline__ void inplace(pg8::f32x4 (&acc)[2][2][4][2], const Unit& u, int wr, int wc, int fr, int fq) const {
        const int seg = u.pm >> 6, pm = u.pm & 63, pn = u.pn & 3;
        const int row0 = pm * BM + wr * 64 + fr, col0 = pn * BM + wc * 32 + 8 * fq;
#pragma unroll
        for (int ai = 0; ai < 2; ++ai)
#pragma unroll
            for (int m = 0; m < 4; ++m) { const size_t row = (size_t)(row0 + ai * HALF + m * 16); const unsigned char* gp = G + row * NGT + seg * DM + col0;
#pragma unroll
                for (int bj = 0; bj < 2; ++bj) { float gc[8]; gates8(gp + bj * HALF, gc);
                    pg8::f32x4& v0 = acc[ai][bj][m][0]; pg8::f32x4& v1 = acc[ai][bj][m][1];
                    if (seg < 3) { float gn[8]; gates8(gp + DM + bj * HALF, gn);
#pragma unroll
                        for (int e = 0; e < 4; ++e) { v0[e] *= gc[e] * __builtin_amdgcn_rcpf(gn[e]); v1[e] *= gc[4 + e] * __builtin_amdgcn_rcpf(gn[4 + e]); } }
                    else {
#pragma unroll
                        for (int e = 0; e < 4; ++e) { v0[e] *= gc[e]; v1[e] *= gc[4 + e]; }
                        v4u w; w.x = pk2(v0[0], v0[1]); w.y = pk2(v0[2], v0[3]); w.z = pk2(v1[0], v1[1]); w.w = pk2(v1[2], v1[3]); *(v4u*)(O + row * DM + col0 + bj * HALF) = w;
                        v0 = (pg8::f32x4){0.f, 0.f, 0.f, 0.f}; v1 = (pg8::f32x4){0.f, 0.f, 0.f, 0.f}; } } }
    }
};
struct MergeOrder {
    pg8::StaticOrder S;
    __device__ void init(int G_, int c_) { S.init(TOK, DM, G_, c_); }
    __device__ bool next(int i, Unit& u) const { Unit b; if (!S.next(i >> 2, b)) return false; const int seg = i & 3; u.pm = seg * 64 + b.pm; u.pn = seg * 4 + b.pn; return true; }
    __device__ __forceinline__ void a_ready(const Unit&) const {}
    __device__ __forceinline__ void done(const Unit&) const {}
};
}

constexpr int NWAVES = 8, NTHR = 512;
struct Args { const void* in[26]; float* out; unsigned char* ws; int ph_lo, ph_hi; };
enum InIdx { I_X = 0, I_C, I_POS, I_MODW, I_MODB, I_NMG, I_NFG, I_WIN, I_ACW, I_AOUT, I_BCW, I_BCB, I_BLNG, I_BLNB, I_BOUT, I_CPOS, I_CW1, I_CW2, I_COUT, I_DOUT, I_WO, I_PWQ, I_PSUB, I_PU, I_PV, I_FNG };

struct Frame {
    LAS unsigned char* lds; unsigned char* ldsg;
    int tid, lane, wave, G, bid;
    unsigned char* ws;
};
__device__ __forceinline__ int gwave(const Frame& F) { return F.bid * NWAVES + F.wave; }
__device__ __forceinline__ int ngwave(const Frame& F) { return F.G * NWAVES; }

__device__ __forceinline__ int rope_pos_of_dim(int d) { return d < 32 ? 2 * d : 2 * (d - 32) + 1; }
__device__ __forceinline__ int rope_dim_of_pos(int p) { return (p >> 1) + 32 * (p & 1); }
__device__ __forceinline__ int win_row_of_col(int n) {
    if (n < 2560) return n;
    if (n < 3072) { const int c = n - 2560; return C_CQ + (c & ~63) + rope_pos_of_dim(c & 63); }
    if (n < 3200) { const int c = n - 3072; return C_KC + (c & ~63) + rope_pos_of_dim(c & 63); }
    if (n < 3328) return C_VC + (n - 3200);
    if (n < 3456) { const int c = n - 3328; return C_KS + (c & ~63) + rope_pos_of_dim(c & 63); }
    if (n < 3584) return C_VS + (n - 3456);
    if (n < 3712) { const int c = n - 3584; return C_KW + (c & ~63) + rope_pos_of_dim(c & 63); }
    if (n < 3840) return C_VW + (n - 3712);
    if (n < 3864) return C_CG + (n - 3840);
    if (n < 4376) { const int c = n - 3864; return C_DQ + (c & ~63) + rope_pos_of_dim(c & 63); }
    if (n < 4888) { const int c = n - 4376; return C_DK + (c & ~63) + rope_pos_of_dim(c & 63); }
    if (n < 5400) return C_DV + (n - 4888);
    return NP1 + (n - 5400);
}
template <int MODE, bool KPERM>
__device__ __forceinline__ void transpose_item(const float* W, int K, int N, bf16* WT, LAS float* scr, int item, int lane) {
    const int nblk = (N + 31) / 32, kb = item / nblk, nb = item % nblk, k0 = 64 * kb, n0 = 32 * nb;
    const int nsrc = n0 + (lane & 31); const bool nok = nsrc < N;
#pragma unroll 8
    for (int i = 0; i < 32; ++i) { const int kk = 2 * i + (lane >> 5); scr[kk * 33 + (lane & 31)] = nok ? W[(size_t)(k0 + kk) * N + nsrc] : 0.f; }
    LDS_WAIT(); asm volatile("" ::: "memory");
    const int c = lane & 7;
#pragma unroll
    for (int j = 0; j < 4; ++j) { const int n = (lane >> 3) + 8 * j;
        float s[8];
#pragma unroll
        for (int e = 0; e < 8; ++e) { const int p = 8 * c + e; const int ks = KPERM ? rope_dim_of_pos(p) : p; s[e] = scr[ks * 33 + n]; }
        v4u o; o.x = pk2(s[0], s[1]); o.y = pk2(s[2], s[3]); o.z = pk2(s[4], s[5]); o.w = pk2(s[6], s[7]);
        if (n0 + n < N) { const int row = (MODE == 1) ? win_row_of_col(n0 + n) : (n0 + n); *(v4u*)(WT + (size_t)row * K + k0 + 8 * c) = o; } }
    LDS_WAIT(); asm volatile("" ::: "memory");
}
template <int MODE, bool KPERM>
__device__ __forceinline__ void transpose_matrix(const Frame& F, const float* W, int K, int N, bf16* WT, int& base) {
    LAS float* scr = (LAS float*)(F.lds + F.wave * 16384);
    const int nitems = (K / 64) * ((N + 31) / 32), gw = gwave(F), NGW = ngwave(F);
    int first = (gw - base % NGW + NGW) % NGW;
    for (int it = first; it < nitems; it += NGW) transpose_item<MODE, KPERM>(W, K, N, WT, scr, it, F.lane);
    base += nitems;
}
__device__ __forceinline__ void convert_copy(const Frame& F, const float* src, bf16* dst, size_t n) {
    const size_t nth = (size_t)F.G * NTHR, t0 = (size_t)F.bid * NTHR + F.tid;
    for (size_t i = t0; i < n / 8; i += nth) { const f32x4 a = *(const f32x4*)(src + i * 8), b = *(const f32x4*)(src + i * 8 + 4);
        v4u o; o.x = pk2(a[0], a[1]); o.y = pk2(a[2], a[3]); o.z = pk2(b[0], b[1]); o.w = pk2(b[2], b[3]); *(v4u*)(dst + i * 8) = o; }
}

typedef __attribute__((address_space(4))) const Args* KArgsP;
__device__ __forceinline__ void phase_prologue(const Frame& F, KArgsP Ap) {
    unsigned char* ws = F.ws;
    int base = 0;
    for (int l = 0; l < DEPTH; ++l) {
        transpose_matrix<1, false>(F, (const float*)(GAS const void*)Ap->in[I_WIN] + (size_t)l * DM * 9496, DM, 9496, (bf16*)(ws + WS_WIN) + (size_t)l * NWIN * DM, base);
        transpose_matrix<0, false>(F, (const float*)(GAS const void*)Ap->in[I_AOUT] + (size_t)l * 512 * DM, 512, DM, (bf16*)(ws + WS_WOUT) + (size_t)(l * 4 + 0) * DM * 512, base);
        transpose_matrix<0, false>(F, (const float*)(GAS const void*)Ap->in[I_BOUT] + (size_t)l * 512 * DM, 512, DM, (bf16*)(ws + WS_WOUT) + (size_t)(l * 4 + 1) * DM * 512, base);
        transpose_matrix<0, false>(F, (const float*)(GAS const void*)Ap->in[I_COUT] + (size_t)l * 512 * DM, 512, DM, (bf16*)(ws + WS_WOUT) + (size_t)(l * 4 + 2) * DM * 512, base);
        transpose_matrix<0, false>(F, (const float*)(GAS const void*)Ap->in[I_DOUT] + (size_t)l * 512 * DM, 512, DM, (bf16*)(ws + WS_WOUT) + (size_t)(l * 4 + 3) * DM * 512, base);
        transpose_matrix<0, false>(F, (const float*)(GAS const void*)Ap->in[I_WO] + (size_t)l * DM * DM, DM, DM, (bf16*)(ws + WS_WO) + (size_t)l * DM * DM, base);
        transpose_matrix<0, false>(F, (const float*)(GAS const void*)Ap->in[I_PWQ] + (size_t)l * DM * 2048, DM, 2048, (bf16*)(ws + WS_WQ) + (size_t)l * 2048 * DM, base);
        transpose_matrix<0, true>(F, (const float*)(GAS const void*)Ap->in[I_CW1] + (size_t)(l * 2 + 0) * 2048 * 128, 2048, 128, (bf16*)(ws + WS_W1T) + (size_t)(l * 2 + 0) * 128 * 2048, base);
        transpose_matrix<0, false>(F, (const float*)(GAS const void*)Ap->in[I_CW1] + (size_t)(l * 2 + 1) * 2048 * 128, 2048, 128, (bf16*)(ws + WS_W1T) + (size_t)(l * 2 + 1) * 128 * 2048, base);
    }
    convert_copy(F, (const float*)(GAS const void*)Ap->in[I_PSUB], (bf16*)(ws + WS_SUBK), (size_t)DEPTH * 8 * 2 * 128 * 128);
    const int gt = F.bid * NTHR + F.tid, NGT_ = F.G * NTHR;
    { const float* w2 = (const float*)(GAS const void*)Ap->in[I_CW2]; bf16* w2t = (bf16*)(ws + WS_SMALL + SM_W2T);
      for (int i = gt; i < DEPTH * 2 * 64 * 128; i += NGT_) { const int k = i & 127, n = (i >> 7) & 63, lw = i >> 13; w2t[i] = (bf16)f2bf(w2[((size_t)lw * 128 + k) * 64 + n]); } }
    { const int* pos = (const int*)(GAS const void*)Ap->in[I_POS]; float* ct = (float*)(ws + WS_COS); float* st = (float*)(ws + WS_SIN);
      for (int i = gt; i < TOK * 32; i += NGT_) { const int t = i >> 5, j = i & 31;
          const float inv = 1.0f / powf(10000.0f, (float)(2 * j) / 64.0f); const float ang = (float)pos[t] * inv;
          ct[i] = (float)cos((double)ang); st[i] = (float)sin((double)ang); } }
    { const float* w1 = (const float*)(GAS const void*)Ap->in[I_CW1]; const float* cp = (const float*)(GAS const void*)Ap->in[I_CPOS]; float* pbp = (float*)(ws + WS_SMALL + SM_PBP);
      for (int i = gt; i < DEPTH * 2 * 16 * 128; i += NGT_) { const int n = i & 127, kc = (i >> 7) & 15, lw = i >> 11; float s = 0.f;
          for (int k = kc * 128; k < kc * 128 + 128; ++k) s += cp[(size_t)lw * 2048 + k] * w1[((size_t)lw * 2048 + k) * 128 + n];
          pbp[i] = s; } }
    __syncthreads();
    { LAS float* cond = (LAS float*)(F.lds);
      LAS float* red = (LAS float*)(F.lds + 32768);
      const float* c = (const float*)(GAS const void*)Ap->in[I_C];
      for (int i = F.tid; i < 8 * 1024; i += NTHR) { const float v = c[i]; cond[i] = v / (1.0f + __expf(-v)); }
      __syncthreads();
      for (int un = F.bid; un < DEPTH * 96; un += F.G) { const int l = un / 96, n0 = (un % 96) * 64;
          const float* mw = (const float*)(GAS const void*)Ap->in[I_MODW] + (size_t)l * DM * 6144 + n0 + F.lane;
          float acc[8];
#pragma unroll
          for (int b = 0; b < 8; ++b) acc[b] = 0.f;
#pragma unroll 4
          for (int k = F.wave * 128; k < F.wave * 128 + 128; ++k) { const float w = mw[(size_t)k * 6144];
#pragma unroll
              for (int b = 0; b < 8; ++b) acc[b] += cond[b * 1024 + k] * w; }
#pragma unroll
          for (int b = 0; b < 8; ++b) red[(F.wave * 8 + b) * 64 + F.lane] = acc[b];
          __syncthreads();
          { const int b = F.tid >> 6, n = F.tid & 63; float s = 0.f;
#pragma unroll
            for (int w = 0; w < 8; ++w) s += red[(w * 8 + b) * 64 + n];
            ((float*)(ws + WS_MOD))[((size_t)l * 8 + b) * 6144 + n0 + n] = s + ((const float*)(GAS const void*)Ap->in[I_MODB])[(size_t)l * 6144 + n0 + n]; }
          __syncthreads(); }
    }
}

__device__ __forceinline__ void phase_norm_mod(const Frame& F, const float* X, const float* g, const float* sh, const float* sc, bf16* O, unsigned char* O8 = nullptr, float* OS = nullptr) {
    const int gw = gwave(F), NGW = ngwave(F);
    f32x4 gv[4];
#pragma unroll
    for (int j = 0; j < 4; ++j) gv[j] = *(const f32x4*)(g + 4 * F.lane + 256 * j);
    for (int row = gw; row < TOK; row += NGW) {
        const int b = row / SEQ; const float* xr = X + (size_t)row * DM + 4 * F.lane;
        f32x4 v[4]; float s = 0.f;
#pragma unroll
        for (int j = 0; j < 4; ++j) { v[j] = *(const f32x4*)(xr + 256 * j); s += (v[j][0] * v[j][0] + v[j][1] * v[j][1]) + (v[j][2] * v[j][2] + v[j][3] * v[j][3]); }
        const float r = 1.0f / sqrtf(wave_sum(s, F.lane) * (1.0f / DM) + NORM_EPS);
        bf16* orow = O + (size_t)row * DM + 4 * F.lane;
#pragma unroll
        for (int j = 0; j < 4; ++j) { const f32x4 scv = *(const f32x4*)(sc + (size_t)b * 6144 + 4 * F.lane + 256 * j), shv = *(const f32x4*)(sh + (size_t)b * 6144 + 4 * F.lane + 256 * j);
            const f32x4 y = v[j] * r * gv[j] * (scv + 1.0f) + shv; v2u w; w.x = pk2(y[0], y[1]); w.y = pk2(y[2], y[3]); *(v2u*)(orow + 256 * j) = w; v[j] = y; }
        if (O8) {
            float mx = 0.f;
#pragma unroll
            for (int j = 0; j < 4; ++j) mx = fmaxf(fmaxf(mx, fmaxf(fabsf(v[j][0]), fabsf(v[j][1]))), fmaxf(fabsf(v[j][2]), fabsf(v[j][3])));
#pragma unroll
            for (int o = 1; o < 32; o <<= 1) mx = fmaxf(mx, shx(mx, o, F.lane));
            mx = max32(mx);
            int ex = 0; (void)frexpf(mx, &ex); const int k = (mx > 0.f) ? (8 - ex) : 0;
            const float s8 = __builtin_ldexpf(1.0f, k);
#pragma unroll
            for (int j = 0; j < 4; ++j) { unsigned p = 0u; p = __builtin_amdgcn_cvt_pk_fp8_f32(v[j][0] * s8, v[j][1] * s8, p, false); p = __builtin_amdgcn_cvt_pk_fp8_f32(v[j][2] * s8, v[j][3] * s8, p, true);
                *(unsigned*)(O8 + (size_t)row * DM + 4 * F.lane + 256 * j) = p; }
            if (F.lane == 0) OS[row] = __builtin_ldexpf(1.0f, -k);
        }
    }
}
__device__ __forceinline__ void phase_final_norm(const Frame& F, const float* X, const float* g, float* O) {
    const int gw = gwave(F), NGW = ngwave(F);
    f32x4 gv[4];
#pragma unroll
    for (int j = 0; j < 4; ++j) gv[j] = *(const f32x4*)(g + 4 * F.lane + 256 * j);
    for (int row = gw; row < TOK; row += NGW) {
        const float* xr = X + (size_t)row * DM + 4 * F.lane; f32x4 v[4]; float s = 0.f;
#pragma unroll
        for (int j = 0; j < 4; ++j) { v[j] = *(const f32x4*)(xr + 256 * j); s += (v[j][0] * v[j][0] + v[j][1] * v[j][1]) + (v[j][2] * v[j][2] + v[j][3] * v[j][3]); }
        const float r = 1.0f / sqrtf(wave_sum(s, F.lane) * (1.0f / DM) + NORM_EPS);
        float* orow = O + (size_t)row * DM + 4 * F.lane;
#pragma unroll
        for (int j = 0; j < 4; ++j) *(f32x4*)(orow + 256 * j) = v[j] * r * gv[j];
    }
}

__device__ __forceinline__ void phase_mixer_a(const Frame& F, const bf16* P, const float* cw  , bf16* O  ) {
    const int nth = F.G * NTHR, gt = F.bid * NTHR + F.tid;
    for (int it = gt; it < (TOK / 8) * 64; it += nth) {
        const int cg = it & 63, tb = it >> 6, c0 = cg * 8, t0 = tb * 8, s0 = t0 % SEQ;
        float w0[8], w1[8], w2[8];
#pragma unroll
        for (int e = 0; e < 8; ++e) { w0[e] = cw[c0 + e]; w1[e] = cw[512 + c0 + e]; w2[e] = cw[1024 + c0 + e]; }
        float pm2[8], pm1[8];
#pragma unroll
        for (int e = 0; e < 8; ++e) { pm2[e] = 0.f; pm1[e] = 0.f; }
        for (int pre = 2; pre >= 1; --pre) if (s0 - pre >= 0) { const bf16* r = P + (size_t)(t0 - pre) * NP1;
            const v4u ac = *(const v4u*)(r + C_AC + c0), ax = *(const v4u*)(r + C_AX + c0);
            float pr[8]; pr[0] = bflo(ac.x) * bflo(ax.x); pr[1] = bfhi(ac.x) * bfhi(ax.x); pr[2] = bflo(ac.y) * bflo(ax.y); pr[3] = bfhi(ac.y) * bfhi(ax.y);
            pr[4] = bflo(ac.z) * bflo(ax.z); pr[5] = bfhi(ac.z) * bfhi(ax.z); pr[6] = bflo(ac.w) * bflo(ax.w); pr[7] = bfhi(ac.w) * bfhi(ax.w);
#pragma unroll
            for (int e = 0; e < 8; ++e) { if (pre == 2) pm2[e] = pr[e]; else pm1[e] = pr[e]; } }
#pragma unroll
        for (int tt = 0; tt < 8; ++tt) { const bf16* r = P + (size_t)(t0 + tt) * NP1;
            const v4u ac = *(const v4u*)(r + C_AC + c0), ax = *(const v4u*)(r + C_AX + c0), ab = *(const v4u*)(r + C_AB + c0);
            float pr[8], bb[8], y[8];
            pr[0] = bflo(ac.x) * bflo(ax.x); pr[1] = bfhi(ac.x) * bfhi(ax.x); pr[2] = bflo(ac.y) * bflo(ax.y); pr[3] = bfhi(ac.y) * bfhi(ax.y);
            pr[4] = bflo(ac.z) * bflo(ax.z); pr[5] = bfhi(ac.z) * bfhi(ax.z); pr[6] = bflo(ac.w) * bflo(ax.w); pr[7] = bfhi(ac.w) * bfhi(ax.w);
            bb[0] = bflo(ab.x); bb[1] = bfhi(ab.x); bb[2] = bflo(ab.y); bb[3] = bfhi(ab.y); bb[4] = bflo(ab.z); bb[5] = bfhi(ab.z); bb[6] = bflo(ab.w); bb[7] = bfhi(ab.w);
#pragma unroll
            for (int e = 0; e < 8; ++e) { y[e] = bb[e] * (w0[e] * pm2[e] + w1[e] * pm1[e] + w2[e] * pr[e]); pm2[e] = pm1[e]; pm1[e] = pr[e]; }
            v4u o; o.x = pk2(y[0], y[1]); o.y = pk2(y[2], y[3]); o.z = pk2(y[4], y[5]); o.w = pk2(y[6], y[7]);
            *(v4u*)(O + (size_t)(t0 + tt) * 512 + c0) = o; }
    }
}

__device__ __forceinline__ void phase_mixer_b(const Frame& F, const bf16* P, const float* cw  , const float* cb, const float* lg, const float* lb, bf16* O) {
    LAS float* U = (LAS float*)F.lds;
    for (int un = F.bid; un < TOK / 32; un += F.G) {
        const int t0 = un * 32, s0 = t0 % SEQ;
        __syncthreads();
        for (int i = F.tid; i < 62 * 64; i += NTHR) { const int r = i >> 6, cg = i & 63, c0 = cg * 8; const int srel = s0 - 30 + r;
            float u[8];
            if (srel >= 0) { const bf16* row = P + (size_t)(t0 - 30 + r) * NP1; const v4u a = *(const v4u*)(row + C_BA + c0), g = *(const v4u*)(row + C_BG + c0);
                u[0] = bflo(a.x) * sigmoidf_(bflo(g.x)); u[1] = bfhi(a.x) * sigmoidf_(bfhi(g.x)); u[2] = bflo(a.y) * sigmoidf_(bflo(g.y)); u[3] = bfhi(a.y) * sigmoidf_(bfhi(g.y));
                u[4] = bflo(a.z) * sigmoidf_(bflo(g.z)); u[5] = bfhi(a.z) * sigmoidf_(bfhi(g.z)); u[6] = bflo(a.w) * sigmoidf_(bflo(g.w)); u[7] = bfhi(a.w) * sigmoidf_(bfhi(g.w)); }
            else {
#pragma unroll
                for (int e = 0; e < 8; ++e) u[e] = 0.f; }
            *(LAS f32x4*)(U + r * 512 + c0) = (f32x4){u[0], u[1], u[2], u[3]}; *(LAS f32x4*)(U + r * 512 + c0 + 4) = (f32x4){u[4], u[5], u[6], u[7]}; }
        __syncthreads();
        const int c0 = F.lane * 8;
        float acc[4][8];
#pragma unroll
        for (int q = 0; q < 4; ++q)
#pragma unroll
            for (int e = 0; e < 8; ++e) acc[q][e] = cb[c0 + e];
        for (int k = 0; k < 31; ++k) { const f32x4 wa = *(const f32x4*)(cw + k * 512 + c0), wb = *(const f32x4*)(cw + k * 512 + c0 + 4);
#pragma unroll
            for (int q = 0; q < 4; ++q) { const int r = 4 * F.wave + q + k; const f32x4 ua = *(LAS f32x4*)(U + r * 512 + c0), ub = *(LAS f32x4*)(U + r * 512 + c0 + 4);
                acc[q][0] += wa[0] * ua[0]; acc[q][1] += wa[1] * ua[1]; acc[q][2] += wa[2] * ua[2]; acc[q][3] += wa[3] * ua[3];
                acc[q][4] += wb[0] * ub[0]; acc[q][5] += wb[1] * ub[1]; acc[q][6] += wb[2] * ub[2]; acc[q][7] += wb[3] * ub[3]; } }
        const f32x4 ga = *(const f32x4*)(lg + c0), gb = *(const f32x4*)(lg + c0 + 4), ba = *(const f32x4*)(lb + c0), bb = *(const f32x4*)(lb + c0 + 4);
#pragma unroll
        for (int q = 0; q < 4; ++q) { float s = 0.f;
#pragma unroll
            for (int e = 0; e < 8; ++e) s += acc[q][e];
            const float mu = wave_sum(s, F.lane) * (1.0f / 512.0f); float v = 0.f;
#pragma unroll
            for (int e = 0; e < 8; ++e) { acc[q][e] -= mu; v += acc[q][e] * acc[q][e]; }
            const float rs = 1.0f / sqrtf(wave_sum(v, F.lane) * (1.0f / 512.0f) + NORM_EPS);
            float y[8];
#pragma unroll
            for (int e = 0; e < 8; ++e) { const float gg = e < 4 ? ga[e] : gb[e - 4], bv = e < 4 ? ba[e] : bb[e - 4]; const float z = acc[q][e] * rs * gg + bv; y[e] = z / (1.0f + __expf(-z)); }
            v4u o; o.x = pk2(y[0], y[1]); o.y = pk2(y[2], y[3]); o.z = pk2(y[4], y[5]); o.w = pk2(y[6], y[7]);
            *(v4u*)(O + (size_t)(t0 + 4 * F.wave + q) * 512 + c0) = o; }
    }
}

__device__ __forceinline__ void phase_compress(const Frame& F, const bf16* P, const bf16* W1T  , const bf16* W2T  , const float* PBP  ,
                                               bf16* KC, bf16* VC  ) {
    LAS float* PART = (LAS float*)F.lds;
    LAS bf16* H1 = (LAS bf16*)(F.lds + 69632);
    const int lane = F.lane, r16 = lane & 15, q4 = lane >> 4, w = F.wave;
    for (int un = F.bid; un < 2 * 8 * 2 * 8; un += F.G) {
        const int nb = un & 7, g = (un >> 3) & 1, b = (un >> 4) & 7, which = un >> 7;
        const int n = nb * 16 + r16; const int nn = n < 127 ? n : 126;
        const int col0 = (which == 0 ? C_KC : C_VC) + g * 64;
        const bf16* arow = P + ((size_t)b * SEQ + nn * 16) * NP1 + col0;
        const bf16* w1 = W1T + (size_t)which * 128 * 2048;
        f32x4 acc[8];
#pragma unroll
        for (int j = 0; j < 8; ++j) acc[j] = (f32x4){0.f, 0.f, 0.f, 0.f};
#pragma unroll
        for (int half = 0; half < 2; ++half) {
            bf16x8 a[4], bb[4][8];
#pragma unroll
            for (int s4 = 0; s4 < 4; ++s4) { const int k = w * 256 + (half * 4 + s4) * 32 + q4 * 8;
                a[s4] = *(const bf16x8*)(arow + (size_t)(k >> 6) * NP1 + (k & 63));
#pragma unroll
                for (int j = 0; j < 8; ++j) bb[s4][j] = *(const bf16x8*)(w1 + (size_t)(j * 16 + r16) * 2048 + k); }
#pragma unroll
            for (int s4 = 0; s4 < 4; ++s4)
#pragma unroll
                for (int j = 0; j < 8; ++j) acc[j] = __builtin_amdgcn_mfma_f32_16x16x32_bf16(a[s4], bb[s4][j], acc[j], 0, 0, 0);
        }
        __syncthreads();
#pragma unroll
        for (int j = 0; j < 8; ++j)
#pragma unroll
            for (int i = 0; i < 4; ++i) PART[(w * 16 + 4 * q4 + i) * 132 + j * 16 + r16] = acc[j][i];
        __syncthreads();
        {
            const int row = F.tid >> 5, c4 = (F.tid & 31) * 4;
            f32x4 sacc = (f32x4){0.f, 0.f, 0.f, 0.f};
#pragma unroll
            for (int ww = 0; ww < 8; ++ww) sacc += *(LAS f32x4*)(PART + (ww * 16 + row) * 132 + c4);
#pragma unroll
            for (int kc = 0; kc < 16; ++kc) sacc += *(const f32x4*)(PBP + ((size_t)which * 16 + kc) * 128 + c4);
            v2u o; o.x = pk2(gelu_erf(sacc[0]), gelu_erf(sacc[1])); o.y = pk2(gelu_erf(sacc[2]), gelu_erf(sacc[3]));
            *(LAS v2u*)(H1 + row * 136 + c4) = o;
        }
        __syncthreads();
        if (w < 4) {
            f32x4 o = (f32x4){0.f, 0.f, 0.f, 0.f};
            const bf16* w2 = W2T + (size_t)which * 64 * 128;
#pragma unroll
            for (int ks = 0; ks < 4; ++ks) { const bf16x8 a = *(LAS bf16x8*)(H1 + r16 * 136 + ks * 32 + q4 * 8);
                const bf16x8 bb = *(const bf16x8*)(w2 + (size_t)(w * 16 + r16) * 128 + ks * 32 + q4 * 8);
                o = __builtin_amdgcn_mfma_f32_16x16x32_bf16(a, bb, o, 0, 0, 0); }
            bf16* out = (which == 0 ? KC : VC) + ((size_t)(b * 2 + g) * 128) * 64;
#pragma unroll
            for (int i = 0; i < 4; ++i) { const int row = nb * 16 + 4 * q4 + i; out[(size_t)row * 64 + w * 16 + r16] = row < 127 ? (bf16)f2bf(o[i]) : (bf16)0; }
        }
    }
    __syncthreads();
}
__device__ __forceinline__ void phase_kmean(const Frame& F, const bf16* P, float* KM) {
    const int gw = gwave(F), NGW = ngwave(F), lane = F.lane, rs = lane >> 3, ch = lane & 7;
    for (int un = gw; un < 8 * 8 * 8; un += NGW) { const int h = un & 7, blk = (un >> 3) & 7, b = un >> 6;
        const bf16* base = P + ((size_t)b * SEQ + blk * 256) * NP1 + C_DK + h * 64 + ch * 8;
        float s[8];
#pragma unroll
        for (int e = 0; e < 8; ++e) s[e] = 0.f;
#pragma unroll 8
        for (int i = 0; i < 32; ++i) { const v4u v = *(const v4u*)(base + (size_t)(i * 8 + rs) * NP1);
            s[0] += bflo(v.x); s[1] += bfhi(v.x); s[2] += bflo(v.y); s[3] += bfhi(v.y); s[4] += bflo(v.z); s[5] += bfhi(v.z); s[6] += bflo(v.w); s[7] += bfhi(v.w); }
#pragma unroll
        for (int e = 0; e < 8; ++e) { s[e] += shx(s[e], 8, lane); s[e] += shx(s[e], 16, lane); s[e] = add32(s[e]); }
        if (rs == 0) { float* o = KM + ((size_t)(b * 8 + blk) * 8 + h) * 64 + ch * 8;
            *(f32x4*)o = (f32x4){s[0], s[1], s[2], s[3]} * (1.0f / 256.0f); *(f32x4*)(o + 4) = (f32x4){s[4], s[5], s[6], s[7]} * (1.0f / 256.0f); }
    }
}

constexpr int KT_STRIDE = 144, VT_STRIDE = 192, KT_BYTES = 64 * KT_STRIDE, VT_BYTES = 64 * VT_STRIDE, KV_BUF = KT_BYTES + VT_BYTES;
__device__ __forceinline__ int crow(int r, int hi) { return (r & 3) + 8 * (r >> 2) + 4 * hi; }
struct AttnState { float m, l; f32x16 o0, o1; };
__device__ __forceinline__ void attn_reset(AttnState& st) { st.m = -1e30f; st.l = 0.f;
#pragma unroll
    for (int r = 0; r < 16; ++r) { st.o0[r] = 0.f; st.o1[r] = 0.f; } }
__device__ __forceinline__ s16x4 vtr(LAS const unsigned char* p) { return __builtin_bit_cast(s16x4, __builtin_amdgcn_ds_read_tr16_b64_v4i16((LAS s16x4*)p)); }

__device__ __forceinline__ void attn_scores(LAS const unsigned char* Kt, const bf16x8 (&qr)[4], f32x16& p0, f32x16& p1, int lane) {
    const int r32 = lane & 31, hi = lane >> 5;
#pragma unroll
    for (int r = 0; r < 16; ++r) { p0[r] = 0.f; p1[r] = 0.f; }
#pragma unroll
    for (int s = 0; s < 4; ++s) {
        const bf16x8 a0 = *(LAS const bf16x8*)(Kt + r32 * KT_STRIDE + (2 * s + hi) * 16), a1 = *(LAS const bf16x8*)(Kt + (32 + r32) * KT_STRIDE + (2 * s + hi) * 16);
        p0 = __builtin_amdgcn_mfma_f32_32x32x16_bf16(a0, qr[s], p0, 0, 0, 0);
        p1 = __builtin_amdgcn_mfma_f32_32x32x16_bf16(a1, qr[s], p1, 0, 0, 0);
    }
}
__device__ __forceinline__ void attn_pv(LAS const unsigned char* Vt, const f32x16& e0, const f32x16& e1, f32x16& o0, f32x16& o1, int lane) {
    const int hi = lane >> 5;
    LAS const unsigned char* vb = Vt + (4 * hi + ((lane & 15) >> 2)) * VT_STRIDE + (((lane >> 4) & 1) * 16 + 4 * (lane & 3)) * 2;
#pragma unroll
    for (int s = 0; s < 4; ++s) {
        v4u pw;
        if (s < 2) { pw.x = pk2(e0[8 * s + 0], e0[8 * s + 1]); pw.y = pk2(e0[8 * s + 2], e0[8 * s + 3]); pw.z = pk2(e0[8 * s + 4], e0[8 * s + 5]); pw.w = pk2(e0[8 * s + 6], e0[8 * s + 7]); }
        else { const int t = s - 2; pw.x = pk2(e1[8 * t + 0], e1[8 * t + 1]); pw.y = pk2(e1[8 * t + 2], e1[8 * t + 3]); pw.z = pk2(e1[8 * t + 4], e1[8 * t + 5]); pw.w = pk2(e1[8 * t + 6], e1[8 * t + 7]); }
        const bf16x8 pb = __builtin_bit_cast(bf16x8, pw);
#pragma unroll
        for (int db = 0; db < 2; ++db) {
            const s16x4 lo = vtr(vb + (16 * s) * VT_STRIDE + db * 64), hh = vtr(vb + (16 * s + 8) * VT_STRIDE + db * 64);
            const bf16x8 a = (bf16x8){lo[0], lo[1], lo[2], lo[3], hh[0], hh[1], hh[2], hh[3]};
            if (db == 0) o0 = __builtin_amdgcn_mfma_f32_32x32x16_bf16(a, pb, o0, 0, 0, 0); else o1 = __builtin_amdgcn_mfma_f32_32x32x16_bf16(a, pb, o1, 0, 0, 0);
        }
    }
}
__device__ __forceinline__ float max3f(float a, float b, float c) { float r; asm("v_max3_f32 %0, %1, %2, %3" : "=v"(r) : "v"(a), "v"(b), "v"(c)); return r; }
__device__ __forceinline__ float mask_score(float v, int a, int b, int c) {
    const unsigned sg = (unsigned)(((a + c) | (b - c)) >> 31);
    return __builtin_bit_cast(float, (__builtin_bit_cast(unsigned, v) & ~sg) | (0xf149f2cau & sg));
}
__device__ __forceinline__ void attn_tile(LAS const unsigned char* Kt, LAS const unsigned char* Vt, const bf16x8 (&qr)[4], AttnState& st, int kmin, int kmax, int lane) {
    const int hi = lane >> 5;
    f32x16 p0, p1; attn_scores(Kt, qr, p0, p1, lane);
    if (!__all(kmin <= 0 && kmax >= 63)) {
        const int a = 4 * hi - kmin, b = kmax - 4 * hi;
#pragma unroll
        for (int r = 0; r < 16; ++r) { const int c = (r & 3) + 8 * (r >> 2); p0[r] = mask_score(p0[r], a, b, c); p1[r] = mask_score(p1[r], a, b, c + 32); }
    }
    asm volatile("s_nop 15\n\ts_nop 7" : "+v"(p0), "+v"(p1));
    float mx = max3f(p0[0], p0[1], p1[0]), mx2 = max3f(p0[2], p0[3], p1[1]);
    mx = max3f(mx, p1[2], p1[3]);
#pragma unroll
    for (int r = 4; r < 16; r += 4) { mx = max3f(mx, p0[r], p0[r + 1]); mx2 = max3f(mx2, p0[r + 2], p0[r + 3]); mx = max3f(mx, p1[r], p1[r + 1]); mx2 = max3f(mx2, p1[r + 2], p1[r + 3]); }
    mx = max3f(mx, mx2, mx2);
    mx = max32(mx);
    const float mn = fmaxf(st.m, mx), me = fmaxf(mn, -1e29f), alpha = __builtin_amdgcn_exp2f(st.m - me);
    float rs = 0.f;
#pragma unroll
    for (int r = 0; r < 16; ++r) { p0[r] = __builtin_amdgcn_exp2f(p0[r] - me); p1[r] = __builtin_amdgcn_exp2f(p1[r] - me); rs += p0[r] + p1[r]; }
    st.m = mn; st.l = st.l * alpha + rs;
    if (__any(alpha < 1.0f)) {
#pragma unroll
        for (int r = 0; r < 16; ++r) { st.o0[r] *= alpha; st.o1[r] *= alpha; }
    }
    attn_pv(Vt, p0, p1, st.o0, st.o1, lane);
}
struct KVRegs { v4u k, v; };
__device__ __forceinline__ void kv_load(KVRegs& r, const bf16* Kg, const bf16* Vg, size_t ld, int tid) {
    const int key = tid >> 3, ch = tid & 7;
    r.k = *(const v4u*)(Kg + (size_t)key * ld + ch * 8); r.v = *(const v4u*)(Vg + (size_t)key * ld + ch * 8);
}
__device__ __forceinline__ void kv_store(const KVRegs& r, LAS unsigned char* buf, int tid) {
    const int key = tid >> 3, ch = tid & 7;
    *(LAS v4u*)(buf + key * KT_STRIDE + ch * 16) = r.k; *(LAS v4u*)(buf + KT_BYTES + key * VT_STRIDE + ch * 16) = r.v;
}

__device__ __forceinline__ float attn_inv_l(const AttnState& st) { const float l = add32(st.l); return 1.0f / fmaxf(l, 1e-30f); }

#define ATTN_STREAM(Kg, Vg, ld, j0, j1, SKIP, RANGE) do { \
    int jn_ = (j0); while (jn_ < (j1) && (SKIP(jn_))) ++jn_; \
    if (jn_ < (j1)) { KVRegs kv_; kv_load(kv_, (Kg) + (size_t)jn_ * 64 * (ld), (Vg) + (size_t)jn_ * 64 * (ld), (ld), F.tid); \
        __syncthreads(); kv_store(kv_, ring, F.tid); int cur_ = 0; \
        for (;;) { const int j_ = jn_; ++jn_; while (jn_ < (j1) && (SKIP(jn_))) ++jn_; const bool more_ = jn_ < (j1); \
            if (more_) kv_load(kv_, (Kg) + (size_t)jn_ * 64 * (ld), (Vg) + (size_t)jn_ * 64 * (ld), (ld), F.tid); \
            __syncthreads(); \
            { int kmin_, kmax_; RANGE(j_, kmin_, kmax_); \
              if (__any(kmax_ >= kmin_)) attn_tile(ring + cur_ * KV_BUF, ring + cur_ * KV_BUF + KT_BYTES, qr, st, kmin_, kmax_, F.lane); } \
            if (!more_) break; \
            kv_store(kv_, ring + (cur_ ^ 1) * KV_BUF, F.tid); cur_ ^= 1; } } } while (0)

__device__ __forceinline__ void nsa_unit(const Frame& F, const bf16* P, const bf16* KC, const bf16* VC, bf16* O  , int b, int g, int i) {
    LAS unsigned char* ring = F.lds;
    LAS float* impb = (LAS float*)(F.lds + 2 * KV_BUF);
    LAS unsigned* selm = (LAS unsigned*)(F.lds + 2 * KV_BUF + 33792);
    LAS float* stash = (LAS float*)(F.lds + 2 * KV_BUF + 33792 + 256) + F.tid;
    const int lane = F.lane, r32 = lane & 31, hi = lane >> 5, hr = F.wave & 3, th = F.wave >> 2;
    const int tl = 32 * th + r32;
    const int s = 64 * i + tl;
    const size_t row = (size_t)b * SEQ + s;
    const int head = g * 4 + hr;
    bf16x8 qr[4];
#pragma unroll
    for (int d = 0; d < 4; ++d) qr[d] = *(const bf16x8*)(P + row * NP1 + C_CQ + head * 64 + d * 16 + hi * 8);
    const float g0 = sigmoidf_(bf2f(P[row * NP1 + C_CG + head])), g1 = sigmoidf_(bf2f(P[row * NP1 + C_CG + 8 + head])), g2 = sigmoidf_(bf2f(P[row * NP1 + C_CG + 16 + head]));
    AttnState st;
    {
        const bf16* Kg = KC + (size_t)(b * 2 + g) * 128 * 64; const bf16* Vg = VC + (size_t)(b * 2 + g) * 128 * 64;
        const int nmax = (s >= 31) ? ((s - 31) >> 4) : -1;
        { KVRegs kv0, kv1; kv_load(kv0, Kg, Vg, 64, F.tid); kv_load(kv1, Kg + 64 * 64, Vg + 64 * 64, 64, F.tid);
          __syncthreads();
          kv_store(kv0, ring, F.tid); kv_store(kv1, ring + KV_BUF, F.tid); }
        __syncthreads();
        attn_reset(st);
        attn_tile(ring, ring + KT_BYTES, qr, st, 0, nmax < 63 ? nmax : 63, lane);
        attn_tile(ring + KV_BUF, ring + KV_BUF + KT_BYTES, qr, st, 0, nmax - 64 < 63 ? nmax - 64 : 63, lane);
        const float inv = attn_inv_l(st);
        { const float sc = g0 * inv;
#pragma unroll
          for (int r = 0; r < 16; ++r) { stash[r * 512] = st.o0[r] * sc; stash[(16 + r) * 512] = st.o1[r] * sc; } }
        if (i >= 16) {
            float xprev = 0.f; const float mfin = st.m;
#define NSA_IMP(U, ACC, GQ) do { const float G_ = ((ACC[4 * (GQ)] + ACC[4 * (GQ) + 1]) + (ACC[4 * (GQ) + 2] + ACC[4 * (GQ) + 3])), L_ = ACC[4 * (GQ) + 3]; \
                const float x_ = other32(L_, hi); impb[(hr * 64 + tl) * 33 + 2 * (U) + hi] = G_ + (hi ? x_ : xprev); xprev = x_; } while (0)
#pragma unroll
            for (int tile = 0; tile < 2; ++tile) {
                f32x16 a0, a1; attn_scores(ring + tile * KV_BUF, qr, a0, a1, lane);
#pragma unroll
                for (int r = 0; r < 16; ++r) { const int c = (r & 3) + 8 * (r >> 2);
                    a0[r] = __builtin_amdgcn_exp2f(mask_score(a0[r], 4 * hi, nmax - 64 * tile - 4 * hi, c) - mfin) * inv; a1[r] = __builtin_amdgcn_exp2f(mask_score(a1[r], 4 * hi, nmax - 64 * tile - 4 * hi, c + 32) - mfin) * inv; }
                NSA_IMP(8 * tile + 0, a0, 0); NSA_IMP(8 * tile + 1, a0, 1); NSA_IMP(8 * tile + 2, a0, 2); NSA_IMP(8 * tile + 3, a0, 3);
                NSA_IMP(8 * tile + 4, a1, 0); NSA_IMP(8 * tile + 5, a1, 1); NSA_IMP(8 * tile + 6, a1, 2); NSA_IMP(8 * tile + 7, a1, 3);
            }
#undef NSA_IMP
        }
    }
    __syncthreads();
    unsigned mymask;
    if (i < 16) mymask = (2u << i) - 1u;
    else {
        { const int tk = F.tid >> 3, js = F.tid & 7; unsigned bits = 0u;
          float v[4];
#pragma unroll
          for (int e = 0; e < 4; ++e) { const int j = js * 4 + e; v[e] = (impb[(0 * 64 + tk) * 33 + j] + impb[(1 * 64 + tk) * 33 + j]) + (impb[(2 * 64 + tk) * 33 + j] + impb[(3 * 64 + tk) * 33 + j]); }
          int rank[4] = {0, 0, 0, 0};
          for (int jj = 1; jj <= i - 2; ++jj) { const float o = (impb[(0 * 64 + tk) * 33 + jj] + impb[(1 * 64 + tk) * 33 + jj]) + (impb[(2 * 64 + tk) * 33 + jj] + impb[(3 * 64 + tk) * 33 + jj]);
#pragma unroll
              for (int e = 0; e < 4; ++e) { const int j = js * 4 + e; rank[e] += (o > v[e] || (o == v[e] && jj < j)) ? 1 : 0; } }
#pragma unroll
          for (int e = 0; e < 4; ++e) { const int j = js * 4 + e; const bool forced = (j == 0) || (j == i) || (j == i - 1); const bool cand = (j >= 1) && (j <= i - 2);
              if (forced || (cand && rank[e] < 13)) bits |= 1u << j; }
          bits |= shxu(bits, 1, F.lane); bits |= shxu(bits, 2, F.lane); bits |= shxu(bits, 4, F.lane);
          if (js == 0) selm[tk] = bits; }
        __syncthreads();
        mymask = selm[tl];
    }
    {
        attn_reset(st);
        const bf16* Kg = P + (size_t)b * SEQ * NP1 + C_KS + g * 64; const bf16* Vg = P + (size_t)b * SEQ * NP1 + C_VS + g * 64;
#define NSA_SKIP(j) (false)
#define NSA_RANGE(j, kmin, kmax) do { kmin = 0; kmax = ((mymask >> (j)) & 1u) ? ((j) == i ? tl : 63) : -1; } while (0)
        ATTN_STREAM(Kg, Vg, (size_t)NP1, 0, i + 1, NSA_SKIP, NSA_RANGE);
#undef NSA_RANGE
        const float sc = g1 * attn_inv_l(st);
#pragma unroll
        for (int r = 0; r < 16; ++r) { stash[r * 512] += st.o0[r] * sc; stash[(16 + r) * 512] += st.o1[r] * sc; }
    }
    {
        attn_reset(st);
        const bf16* Kg = P + (size_t)b * SEQ * NP1 + C_KW + g * 64; const bf16* Vg = P + (size_t)b * SEQ * NP1 + C_VW + g * 64;
        const int jlo = i >= 8 ? i - 8 : 0; f32x16 out0, out1;
#define NSA_RANGE(j, kmin, kmax) do { const int d_ = 64 * (i - (j)) + tl; kmin = d_ - 511 > 0 ? d_ - 511 : 0; kmax = d_ < 63 ? d_ : 63; } while (0)
        ATTN_STREAM(Kg, Vg, (size_t)NP1, jlo, i + 1, NSA_SKIP, NSA_RANGE);
#undef NSA_RANGE
#undef NSA_SKIP
        const float sc = g2 * attn_inv_l(st);
#pragma unroll
        for (int r = 0; r < 16; ++r) { out0[r] = stash[r * 512] + st.o0[r] * sc; out1[r] = stash[(16 + r) * 512] + st.o1[r] * sc; }
        bf16* orow = O + row * 512 + head * 64;
#pragma unroll
        for (int gq = 0; gq < 4; ++gq) {
            v2u w0; w0.x = pk2(out0[4 * gq], out0[4 * gq + 1]); w0.y = pk2(out0[4 * gq + 2], out0[4 * gq + 3]); *(v2u*)(orow + 8 * gq + 4 * hi) = w0;
            v2u w1; w1.x = pk2(out1[4 * gq], out1[4 * gq + 1]); w1.y = pk2(out1[4 * gq + 2], out1[4 * gq + 3]); *(v2u*)(orow + 32 + 8 * gq + 4 * hi) = w1; }
    }
}
__device__ __forceinline__ void phase_nsa(const Frame& F, const bf16* P, const bf16* KC, const bf16* VC, bf16* O) {
    for (int un2 = 2 * F.bid; un2 < 512; un2 += 2 * F.G)
#pragma unroll 1
        for (int k = 0; k < 2; ++k) { const int un = un2 >> 1, ip = un & 15, g = (un >> 4) & 1, b = un >> 5; nsa_unit(F, P, KC, VC, O, b, g, k == 0 ? 31 - ip : ip); }
}

__device__ __forceinline__ void moba_unit(const Frame& F, const bf16* P, const float* KM, bf16* O  , int b, int h, int qb) {
    LAS unsigned char* ring = F.lds;
    LAS float* kml = (LAS float*)(F.lds + 2 * KV_BUF);
    LAS unsigned* uni = (LAS unsigned*)(F.lds + 2 * KV_BUF + 2048);
    const int lane = F.lane, r32 = lane & 31, hi = lane >> 5;
    const int tl = 32 * F.wave + r32;
    const size_t row = (size_t)b * SEQ + 256 * qb + tl;
    bf16x8 qr[4];
#pragma unroll
    for (int d = 0; d < 4; ++d) qr[d] = *(const bf16x8*)(P + row * NP1 + C_DQ + h * 64 + d * 16 + hi * 8);
    __syncthreads();
    { const int blk = F.tid >> 6, p = F.tid & 63; kml[F.tid] = KM[((size_t)(b * 8 + blk) * 8 + h) * 64 + p]; if (F.tid == 0) uni[0] = 0u; }
    __syncthreads();
    unsigned mymask = 0u;
    if (qb > 0) {
        float gt[8];
#pragma unroll
        for (int n = 0; n < 8; ++n) { float a = 0.f;
#pragma unroll
            for (int d = 0; d < 4; ++d) { const v4u qw = __builtin_bit_cast(v4u, qr[d]); const LAS float* km = kml + n * 64 + d * 16 + hi * 8;
                a += bflo(qw.x) * km[0] + bfhi(qw.x) * km[1] + bflo(qw.y) * km[2] + bfhi(qw.y) * km[3] + bflo(qw.z) * km[4] + bfhi(qw.z) * km[5] + bflo(qw.w) * km[6] + bfhi(qw.w) * km[7]; }
            a = add32(a); gt[n] = a; }
#pragma unroll
        for (int n = 0; n < 8; ++n) { int rank = 0;
#pragma unroll
            for (int m = 0; m < 8; ++m) rank += (m < qb && m != n && (gt[m] > gt[n] || (gt[m] == gt[n] && m < n))) ? 1 : 0;
            if (n < qb && rank < 3) mymask |= 1u << n; }
        atomicOr((unsigned*)uni, mymask);
    }
    __syncthreads();
    const unsigned um = uni[0];
    AttnState st; attn_reset(st);
    const bf16* Kg = P + (size_t)b * SEQ * NP1 + C_DK + h * 64; const bf16* Vg = P + (size_t)b * SEQ * NP1 + C_DV + h * 64;
#define MOBA_SKIP(j) ((j) < 4 * qb && !((um >> ((j) >> 2)) & 1u))
#define MOBA_RANGE(j, kmin, kmax) do { kmin = 0; if ((j) < 4 * qb) kmax = ((mymask >> ((j) >> 2)) & 1u) ? 63 : -1; else { const int d_ = tl - 64 * ((j) - 4 * qb); kmax = d_ < 63 ? d_ : 63; } } while (0)
    ATTN_STREAM(Kg, Vg, (size_t)NP1, 0, 4 * qb + 4, MOBA_SKIP, MOBA_RANGE);
#undef MOBA_SKIP
#undef MOBA_RANGE
    const float sc = attn_inv_l(st);
    bf16* orow = O + row * 512 + h * 64;
#pragma unroll
    for (int gq = 0; gq < 4; ++gq) {
        v2u w0; w0.x = pk2(st.o0[4 * gq] * sc, st.o0[4 * gq + 1] * sc); w0.y = pk2(st.o0[4 * gq + 2] * sc, st.o0[4 * gq + 3] * sc); *(v2u*)(orow + 8 * gq + 4 * hi) = w0;
        v2u w1; w1.x = pk2(st.o1[4 * gq] * sc, st.o1[4 * gq + 1] * sc); w1.y = pk2(st.o1[4 * gq + 2] * sc, st.o1[4 * gq + 3] * sc); *(v2u*)(orow + 32 + 8 * gq + 4 * hi) = w1; }
}
__device__ __forceinline__ void phase_moba(const Frame& F, const bf16* P, const float* KM, bf16* O) {
    for (int un2 = 2 * F.bid; un2 < 512; un2 += 2 * F.G)
#pragma unroll 1
        for (int k = 0; k < 2; ++k) { const int un = un2 >> 1, qp = un & 3, h = (un >> 2) & 7, b = un >> 5; moba_unit(F, P, KM, O, b, h, k == 0 ? 7 - qp : qp); }
}

__device__ __forceinline__ unsigned ord_key(float x) { const unsigned u = __builtin_bit_cast(unsigned, x); return (u & 0x80000000u) ? ~u : (u | 0x80000000u); }
__device__ __forceinline__ float ord_val(unsigned k) { const unsigned u = (k & 0x80000000u) ? (k & 0x7fffffffu) : ~k; return __builtin_bit_cast(float, u); }
__device__ __forceinline__ void ce_desc(unsigned& a, unsigned& b) { const unsigned hi_ = a > b ? a : b, lo_ = a > b ? b : a; a = hi_; b = lo_; }
__device__ __forceinline__ void bitonic_merge16_desc(unsigned* a) {
#pragma unroll
    for (int j = 8; j > 0; j >>= 1)
#pragma unroll
        for (int i = 0; i < 16; ++i) if ((i & j) == 0) ce_desc(a[i], a[i | j]);
}
__device__ __forceinline__ void bitonic_sort16_desc(unsigned* a) {
#pragma unroll
    for (int k = 2; k <= 16; k <<= 1)
#pragma unroll
        for (int j = k >> 1; j > 0; j >>= 1)
#pragma unroll
            for (int i = 0; i < 16; ++i) { const int l = i ^ j; if (l > i) { if ((i & k) == 0) ce_desc(a[i], a[l]); else ce_desc(a[l], a[i]); } }
}
__device__ __forceinline__ void merge_top16(unsigned* a, const unsigned* b) {
#pragma unroll
    for (int i = 0; i < 16; ++i) a[i] = a[i] > b[15 - i] ? a[i] : b[15 - i];
    bitonic_merge16_desc(a);
}
constexpr int SK_STRIDE = 272;
__device__ __forceinline__ void peer_route_unit(const Frame& F, const bf16* Q2, const bf16* SUBK  , int* EIDX, float* EW, int tb, int h) {
    LAS unsigned char* skl = F.lds;
    LAS unsigned* slot = (LAS unsigned*)(F.lds + 36864) + F.tid;
    const int lane = F.lane, r32 = lane & 31, hi = lane >> 5;
    const size_t tok = (size_t)tb * 256 + F.wave * 32 + r32;
#pragma unroll 1
    for (int p = 0; p < 2; ++p) {
        __syncthreads();
        for (int i = F.tid; i < 128 * 16; i += NTHR) { const int ch = i & 15, rowi = i >> 4;
            *(LAS v4u*)(skl + rowi * SK_STRIDE + ch * 16) = *(const v4u*)(SUBK + ((size_t)h * 256 + p * 128 + rowi) * 128 + ch * 8); }
        __syncthreads();
        bf16x8 qf[8]; float ss = 0.f;
#pragma unroll
        for (int s = 0; s < 8; ++s) { qf[s] = *(const bf16x8*)(Q2 + tok * 2048 + h * 256 + p * 128 + s * 16 + hi * 8); const v4u w = __builtin_bit_cast(v4u, qf[s]);
            const float a0 = bflo(w.x), a1 = bfhi(w.x), a2 = bflo(w.y), a3 = bfhi(w.y), a4 = bflo(w.z), a5 = bfhi(w.z), a6 = bflo(w.w), a7 = bfhi(w.w);
            ss += (a0 * a0 + a1 * a1) + (a2 * a2 + a3 * a3) + (a4 * a4 + a5 * a5) + (a6 * a6 + a7 * a7); }
        ss = add32(ss);
        const float rn = 1.0f / sqrtf(ss * (1.0f / 128.0f) + NORM_EPS);
        unsigned key[64];
#pragma unroll
        for (int nb = 0; nb < 4; ++nb) { f32x16 acc;
#pragma unroll
            for (int r = 0; r < 16; ++r) acc[r] = 0.f;
#pragma unroll
            for (int s = 0; s < 8; ++s) { const bf16x8 a = *(LAS const bf16x8*)(skl + (nb * 32 + r32) * SK_STRIDE + (2 * s + hi) * 16);
                acc = __builtin_amdgcn_mfma_f32_32x32x16_bf16(a, qf[s], acc, 0, 0, 0); }
#pragma unroll
            for (int r = 0; r < 16; ++r) { const int n = nb * 32 + crow(r, hi); key[nb * 16 + r] = (ord_key(acc[r] * rn) & 0xffffff80u) | (unsigned)(127 - n); } }
#pragma unroll
        for (int blk = 0; blk < 4; ++blk) bitonic_sort16_desc(key + 16 * blk);
        merge_top16(key, key + 16); merge_top16(key + 32, key + 48); merge_top16(key, key + 32);
        { unsigned oth[16];
#pragma unroll
          for (int i = 0; i < 16; ++i) { unsigned r0, r1; swap32(key[i], r0, r1); oth[i] = hi ? r0 : r1; }
          merge_top16(key, oth); }
#pragma unroll
        for (int k = 0; k < 16; ++k) slot[(p * 16 + k) * 512] = key[k];
    }
    LDS_WAIT(); asm volatile("" ::: "memory");
    unsigned ck[64];
    { float v1[16], v2[16];
#pragma unroll
      for (int k = 0; k < 16; ++k) { v1[k] = ord_val(slot[k * 512] & 0xffffff80u); v2[k] = ord_val(slot[(16 + k) * 512] & 0xffffff80u); }
      int c = 0;
#pragma unroll
      for (int a = 0; a < 16; ++a)
#pragma unroll
          for (int bq = 0; bq < 16; ++bq) if ((a + 1) * (bq + 1) <= 16) { ck[c] = (ord_key(v1[a] + v2[bq]) & 0xffffff00u) | (unsigned)(255 - (16 * a + bq)); ++c; }
#pragma unroll
      for (int q = 50; q < 64; ++q) ck[q] = 0u; }
#pragma unroll
    for (int blk = 0; blk < 4; ++blk) bitonic_sort16_desc(ck + 16 * blk);
    merge_top16(ck, ck + 16); merge_top16(ck + 32, ck + 48); merge_top16(ck, ck + 32);
    float den = 0.f; const float mx = ord_val(ck[0] & 0xffffff00u);
#pragma unroll
    for (int k = 0; k < 16; ++k) { const unsigned m = ck[k];
        const int ci = 255 - (int)(m & 255u), a = ci >> 4, bq = ci & 15;
        const unsigned ka = slot[a * 512], kb = slot[(16 + bq) * 512];
        const int te = (127 - (int)(ka & 127u)) * 128 + (127 - (int)(kb & 127u));
        const float ek = __expf(ord_val(m & 0xffffff00u) - mx); den += ek;
        slot[(32 + k) * 512] = __builtin_bit_cast(unsigned, ek);
        if (hi == 0) EIDX[(tok * 8 + h) * 16 + k] = te; }
    LDS_WAIT(); asm volatile("" ::: "memory");
    if (hi == 0) { const float inv = 1.0f / den; float* ewp = EW + (tok * 8 + h) * 16;
#pragma unroll
        for (int q = 0; q < 4; ++q) *(f32x4*)(ewp + 4 * q) = (f32x4){__builtin_bit_cast(float, slot[(32 + 4 * q) * 512]), __builtin_bit_cast(float, slot[(33 + 4 * q) * 512]),
                                                                      __builtin_bit_cast(float, slot[(34 + 4 * q) * 512]), __builtin_bit_cast(float, slot[(35 + 4 * q) * 512])} * inv; }
}

__device__ __forceinline__ void phase_peer_route(const Frame& F, const bf16* Q2, const bf16* SUBK, int* EIDX, float* EW) {
    for (int un = F.bid; un < 64 * 8; un += F.G) peer_route_unit(F, Q2, SUBK, EIDX, EW, un >> 3, un & 7);
}

__device__ __forceinline__ void phase_peer_tables(const Frame& F, const float* U, const float* V, unsigned char* UT8, unsigned char* VT8, float* SU, float* SV) {
    const int gw = gwave(F), NGW = ngwave(F), lane = F.lane;
    for (int r = gw; r < 2 * 16384; r += NGW) {
        const int tab = r >> 14, e = r & 16383; const float* src = (tab ? V : U) + (size_t)e * DM + 16 * lane;
        f32x4 x[4]; float mx = 0.f;
#pragma unroll
        for (int q = 0; q < 4; ++q) { x[q] = *(const f32x4*)(src + 4 * q); mx = fmaxf(fmaxf(mx, fmaxf(fabsf(x[q][0]), fabsf(x[q][1]))), fmaxf(fabsf(x[q][2]), fabsf(x[q][3]))); }
#pragma unroll
        for (int o = 1; o < 32; o <<= 1) mx = fmaxf(mx, shx(mx, o, lane));
        mx = max32(mx);
        int ex = 0; (void)frexpf(mx, &ex);
        const int k = (mx > 0.f) ? (8 - ex) : 0;
        const float sc = __builtin_ldexpf(1.0f, k), inv = __builtin_ldexpf(1.0f, -k);
        v4u w;
#pragma unroll
        for (int q = 0; q < 4; ++q) { unsigned p = 0u; p = __builtin_amdgcn_cvt_pk_fp8_f32(x[q][0] * sc, x[q][1] * sc, p, false); p = __builtin_amdgcn_cvt_pk_fp8_f32(x[q][2] * sc, x[q][3] * sc, p, true); w[q] = p; }
        *(v4u*)((tab ? VT8 : UT8) + ((size_t)(lane >> 3) * 16384 + e) * 128 + (lane & 7) * 16) = w;
        if (lane == 0) (tab ? SV : SU)[e] = inv;
    }
}
typedef _Float16 h16x2 __attribute__((ext_vector_type(2)));
typedef __fp16 fp16x2_t __attribute__((ext_vector_type(2)));
__device__ __forceinline__ void phase_peer_u(const Frame& F, const bf16* H2, const unsigned char* UT8, const float* SU, const int* EIDX, float* PART, unsigned emask = 0x3fffu) {
    const int lane = F.lane, g = lane >> 3, sub = lane & 7, b0 = lane & 1, b1 = (lane >> 1) & 1, b2 = (lane >> 2) & 1;
    const int s = F.bid & 7, wgq = F.bid >> 3, nq = F.G >> 3;
    LAS int* il = (LAS int*)(F.lds + F.wave * 8192);
    LAS float* pcl = (LAS float*)(F.lds + F.wave * 8192 + 4096);
    const unsigned char* ub = UT8 + (size_t)s * 16384 * 128 + sub * 16;
    for (int batch = wgq * 8 + F.wave; batch < TOK / 8; batch += nq * 8) {
        const int t0 = batch * 8, t = t0 + g;
        { const v4u* src = (const v4u*)(EIDX + (size_t)t0 * 128 + lane * 16);
          const v4u i0 = src[0], i1 = src[1], i2 = src[2], i3 = src[3];
          LAS v4u* dst = (LAS v4u*)(il + lane * 16); dst[0] = i0 & emask; dst[1] = i1 & emask; dst[2] = i2 & emask; dst[3] = i3 & emask; }
        h16x2 h[8];
        { const v4u ha = *(const v4u*)(H2 + (size_t)t * DM + s * 128 + sub * 16), hb = *(const v4u*)(H2 + (size_t)t * DM + s * 128 + sub * 16 + 8);
          h[0] = (h16x2){(_Float16)bflo(ha.x), (_Float16)bfhi(ha.x)}; h[1] = (h16x2){(_Float16)bflo(ha.y), (_Float16)bfhi(ha.y)}; h[2] = (h16x2){(_Float16)bflo(ha.z), (_Float16)bfhi(ha.z)}; h[3] = (h16x2){(_Float16)bflo(ha.w), (_Float16)bfhi(ha.w)};
          h[4] = (h16x2){(_Float16)bflo(hb.x), (_Float16)bfhi(hb.x)}; h[5] = (h16x2){(_Float16)bflo(hb.y), (_Float16)bfhi(hb.y)}; h[6] = (h16x2){(_Float16)bflo(hb.z), (_Float16)bfhi(hb.z)}; h[7] = (h16x2){(_Float16)bflo(hb.w), (_Float16)bfhi(hb.w)}; }
        LDS_WAIT(); asm volatile("" ::: "memory");
#define PU_LOAD(c, ua, su_) do { const v4u ia = *(LAS v4u*)(il + g * 128 + (c) * 8), ib = *(LAS v4u*)(il + g * 128 + (c) * 8 + 4); \
            ua[0] = *(const v4u*)(ub + (size_t)ia.x * 128); ua[1] = *(const v4u*)(ub + (size_t)ia.y * 128); ua[2] = *(const v4u*)(ub + (size_t)ia.z * 128); ua[3] = *(const v4u*)(ub + (size_t)ia.w * 128); \
            ua[4] = *(const v4u*)(ub + (size_t)ib.x * 128); ua[5] = *(const v4u*)(ub + (size_t)ib.y * 128); ua[6] = *(const v4u*)(ub + (size_t)ib.z * 128); ua[7] = *(const v4u*)(ub + (size_t)ib.w * 128); \
            su_ = SU[il[g * 128 + (c) * 8 + sub]]; } while (0)
#define PU_COMP(c, ua, su_) do { float a[8]; \
            _Pragma("unroll") for (int j = 0; j < 8; ++j) { float acc = 0.f; \
                _Pragma("unroll") for (int q = 0; q < 4; ++q) { acc = __builtin_amdgcn_fdot2(__builtin_bit_cast(h16x2, __builtin_amdgcn_cvt_scalef32_pk_f16_fp8(ua[j][q], 1.0f, false)), h[2 * q], acc, false); \
                    acc = __builtin_amdgcn_fdot2(__builtin_bit_cast(h16x2, __builtin_amdgcn_cvt_scalef32_pk_f16_fp8(ua[j][q], 1.0f, true)), h[2 * q + 1], acc, false); } \
                a[j] = acc; } \
            float bq[4], cc[2]; \
            _Pragma("unroll") for (int p = 0; p < 4; ++p) { const float keep = b0 ? a[2 * p + 1] : a[2 * p], send = b0 ? a[2 * p] : a[2 * p + 1]; bq[p] = keep + shx(send, 1, lane); } \
            _Pragma("unroll") for (int q = 0; q < 2; ++q) { const float keep = b1 ? bq[2 * q + 1] : bq[2 * q], send = b1 ? bq[2 * q] : bq[2 * q + 1]; cc[q] = keep + shx(send, 2, lane); } \
            { const float keep = b2 ? cc[1] : cc[0], send = b2 ? cc[0] : cc[1]; pcl[(c) * 64 + lane] = (keep + shx(send, 4, lane)) * su_; } } while (0)
        { v4u uA[8], uB[8]; float sA, sB;
          PU_LOAD(0, uA, sA);
#pragma unroll 1
          for (int c = 0; c < 16; c += 2) {
              PU_LOAD(c + 1, uB, sB);
              PU_COMP(c, uA, sA);
              if (c + 2 < 16) PU_LOAD(c + 2, uA, sA);
              PU_COMP(c + 1, uB, sB);
          } }
#undef PU_LOAD
#undef PU_COMP
        LDS_WAIT(); asm volatile("" ::: "memory");
        float* dst = PART + ((size_t)s * TOK + t) * 128 + sub;
#pragma unroll
        for (int c = 0; c < 16; ++c) dst[8 * c] = pcl[c * 64 + lane];
        LDS_WAIT(); asm volatile("" ::: "memory");
    }
}
__device__ __forceinline__ float gelu_as(float v) {
    const float av = fabsf(v), t = __builtin_amdgcn_rcpf(av * 0.2316418882f + 1.0f);
    float q = t * 0.5307027145f + (-0.7265760135f); q = q * t + 0.7107068705f; q = q * t + (-0.142248368f); q = q * t + 0.127414796f; q = q * t;
    const float m = v * (q * __builtin_amdgcn_exp2f((v * v) * (-0.72134752044f)));
    return v < 0.f ? m : v - m;
}
__device__ __forceinline__ void phase_peer_w(const Frame& F, const float* SV, const int* EIDX, const float* EW, const float* PART, v2u* COEF) {
    const int nth = F.G * NTHR;
    for (int i = F.bid * NTHR + F.tid; i < TOK * 128; i += nth) {
        float act = 0.f;
#pragma unroll
        for (int sp = 0; sp < 8; ++sp) act += PART[(size_t)sp * TOK * 128 + i];
        const int e = EIDX[i]; const float c = EW[i] * gelu_as(act) * SV[e];
        COEF[i] = (v2u){(unsigned)e, __builtin_bit_cast(unsigned, c)};
    }
}
__device__ __forceinline__ void phase_peer_v(const Frame& F, const unsigned char* VT8, const v2u* COEF, float* XB, const float* gate, unsigned emask = 0x3fffu) {
    const int lane = F.lane, g = lane >> 3, sub = lane & 7;
    const int s = F.bid & 7, wgq = F.bid >> 3, nq = F.G >> 3;
    LAS v2u* wl = (LAS v2u*)(F.lds + F.wave * 8192);
    const unsigned char* vb = VT8 + (size_t)s * 16384 * 128 + sub * 16;
    for (int batch = wgq * 8 + F.wave; batch < TOK / 8; batch += nq * 8) {
        const int t0 = batch * 8, t = t0 + g;
        { const v4u* src = (const v4u*)(COEF + (size_t)t0 * 128) + lane * 8;
          v4u c[8];
#pragma unroll
          for (int q = 0; q < 8; ++q) c[q] = src[q];
          LAS v4u* dst = (LAS v4u*)wl + lane * 8;
#pragma unroll
          for (int q = 0; q < 8; ++q) { v4u x = c[q]; x.x &= emask; x.z &= emask; dst[q] = x; } }
        LDS_WAIT(); asm volatile("" ::: "memory");
        h16x2 o[8];
#pragma unroll
        for (int q = 0; q < 8; ++q) o[q] = (h16x2){(_Float16)0.f, (_Float16)0.f};
#define PV_LOAD(c, pr, va) do { \
            _Pragma("unroll") for (int q = 0; q < 4; ++q) pr[q] = *(LAS v4u*)(wl + g * 128 + (c) * 8 + 2 * q); \
            _Pragma("unroll") for (int q = 0; q < 4; ++q) { va[2 * q] = *(const v4u*)(vb + (size_t)pr[q].x * 128); va[2 * q + 1] = *(const v4u*)(vb + (size_t)pr[q].z * 128); } } while (0)
#define PV_COMP(pr, va) do { \
            _Pragma("unroll") for (int j = 0; j < 8; ++j) { const unsigned cb = (j & 1) ? pr[j >> 1].w : pr[j >> 1].y; \
                const float s2 = __builtin_bit_cast(float, cb & 0x7f800000u); const _Float16 mh = (_Float16)__builtin_bit_cast(float, (cb & 0x807fffffu) | 0x3f800000u); const h16x2 m2 = (h16x2){mh, mh}; \
                _Pragma("unroll") for (int q = 0; q < 4; ++q) { o[2 * q] = __builtin_elementwise_fma(__builtin_bit_cast(h16x2, __builtin_amdgcn_cvt_scalef32_pk_f16_fp8(va[j][q], s2, false)), m2, o[2 * q]); \
                    o[2 * q + 1] = __builtin_elementwise_fma(__builtin_bit_cast(h16x2, __builtin_amdgcn_cvt_scalef32_pk_f16_fp8(va[j][q], s2, true)), m2, o[2 * q + 1]); } } } while (0)
        { v4u pA[4], pB[4], vA[8], vB[8];
          PV_LOAD(0, pA, vA);
#pragma unroll 1
          for (int c = 0; c < 16; c += 2) {
              PV_LOAD(c + 1, pB, vB);
              PV_COMP(pA, vA);
              if (c + 2 < 16) PV_LOAD(c + 2, pA, vA);
              PV_COMP(pB, vB);
          } }
#undef PV_LOAD
#undef PV_COMP
        const int bb = t / SEQ; float* xr = XB + (size_t)t * DM + s * 128 + sub * 16; const float* gr = gate + (size_t)bb * 6144 + s * 128 + sub * 16;
#pragma unroll
        for (int q = 0; q < 4; ++q) { const f32x4 x = *(const f32x4*)(xr + 4 * q), gg = *(const f32x4*)(gr + 4 * q);
            *(f32x4*)(xr + 4 * q) = x + gg * (f32x4){(float)o[2 * q].x, (float)o[2 * q].y, (float)o[2 * q + 1].x, (float)o[2 * q + 1].y}; }
        LDS_WAIT(); asm volatile("" ::: "memory");
    }
}

constexpr int NPL = 12, NPHASE = 1 + DEPTH * NPL + 1;
constexpr int CW_BAR = 1024;
static_assert((CW_BAR + XCD_BAR_WORDS) * 4 <= (int)CTL_ZERO_BYTES, "barrier words inside the memset region");

__global__ void __launch_bounds__(NTHR, 2) hybrid_fwd(Args args) {
    extern __shared__ __attribute__((aligned(16))) unsigned char lds[];
    Frame F;
    F.lds = (LAS unsigned char*)lds; F.ldsg = lds;
    F.tid = threadIdx.x; F.lane = F.tid & 63; F.wave = __builtin_amdgcn_readfirstlane(F.tid >> 6);
    F.G = gridDim.x; F.bid = blockIdx.x; F.ws = args.ws;
    GAS unsigned char* wsg = (GAS unsigned char*)args.ws;
#define WSP ((unsigned char*)wsg)
    volatile LAS unsigned* MISC = (volatile LAS unsigned*)(F.lds + MISC_OFF);
    for (int u = F.tid; u < 64; u += NTHR) ((LAS unsigned*)(F.lds + MISC_OFF))[u] = 0u;
    __syncthreads();
    XcdBarrier bar; bar.bar = (unsigned*)(WSP + WS_CTL) + CW_BAR; bar.x = 0; bar.st = nullptr;
    const int lo = args.ph_lo, hi = args.ph_hi;
    if (hi - lo > 1) bar = xcd_barrier_post((unsigned*)(WSP + WS_CTL) + CW_BAR, MISC + 8);
#ifndef PHMASK
#define PHMASK 0xffffffffu
#endif
#define PM(j) ((PHMASK >> (j)) & 1u)
#ifndef DUMMY_EMASK
#define DUMMY_EMASK 0x3fffu
#endif
#ifndef RPMASK
#define RPMASK 0u
#endif
#define RP(j) for (int rp_ = 0; rp_ < 1 + (int)((RPMASK >> (j)) & 1u); ++rp_)
#define LASTRP(j) (rp_ == (int)((RPMASK >> (j)) & 1u))
#define IN(k) (lo <= (k) && (k) < hi)
#define SEAM(k) do { if (IN(k) && IN((k) + 1)) { xcd_barrier(bar); if ((RPMASK >> 30) & 1u) xcd_barrier(bar); } } while (0)

    typedef __attribute__((address_space(4))) const Args* KArgs;
    KArgs ap = (KArgs)__builtin_amdgcn_kernarg_segment_ptr();
#define FRESH() asm volatile("" : "+s"(ap), "+s"(wsg)); Frame Fp = F; asm volatile("" : "+v"(Fp.tid)); Fp.lane = Fp.tid & 63; asm volatile("" : "+s"(Fp.wave), "+s"(Fp.bid), "+s"(Fp.G)); Fp.ws = WSP; LAS unsigned char* ring = Fp.lds; asm volatile("" : "+s"(ring)); Fp.lds = ring
#define INP(i) ((const float*)(GAS const float*)ap->in[i])
#define WIN_ ((bf16*)(WSP + WS_WIN))
#define WOUT_ ((bf16*)(WSP + WS_WOUT))
#define WOT_ ((bf16*)(WSP + WS_WO))
#define WQT_ ((bf16*)(WSP + WS_WQ))
#define W1T_ ((bf16*)(WSP + WS_W1T))
#define SUBK_ ((bf16*)(WSP + WS_SUBK))
#define W2T_ ((bf16*)(WSP + WS_SMALL + SM_W2T))
#define MOD_ ((float*)(WSP + WS_MOD))
#define COS_ ((const float*)(WSP + WS_COS))
#define SIN_ ((const float*)(WSP + WS_SIN))
#define KMEAN_ ((float*)(WSP + WS_SMALL + SM_KMEAN))
#define KCMP_ ((bf16*)(WSP + WS_SMALL + SM_KCMP))
#define VCMP_ ((bf16*)(WSP + WS_SMALL + SM_VCMP))
#define PBP_ ((float*)(WSP + WS_SMALL + SM_PBP))
#define EIDX_ ((int*)(WSP + WS_EIDX))
#define EW_ ((float*)(WSP + WS_EW))
#define HN_ ((bf16*)(WSP + WS_HN))
#define MIX_ ((bf16*)(WSP + WS_MIX))
#define PROJ_ ((bf16*)(WSP + WS_BIG))
#define GATES_ ((unsigned char*)(WSP + WS_GATES))
#define UT_ ((unsigned char*)(WSP + WS_BIG))
#define VT_ ((unsigned char*)(WSP + WS_BIG + 16 * MiB))
#define SU_ ((float*)(WSP + WS_BIG + 32 * MiB))
#define SV_ ((float*)(WSP + WS_BIG + 32 * MiB + 65536))
#define COEF_ ((v2u*)(WSP + WS_BIG + 33 * MiB))
#define Q2_ ((bf16*)(WSP + WS_BIG + 64 * MiB))
#define PART_ ((float*)(WSP + WS_BIG + 64 * MiB))
#define XB_ ((float*)(GAS float*)ap->out)
#define MODL_ (MOD_ + (size_t)l * 8 * 6144)
#define XIN_ ((l == 0) ? INP(I_X) : (const float*)XB_)

    if (PM(0) && IN(0)) RP(0) { FRESH(); phase_prologue(Fp, ap); }
    SEAM(0);
#pragma unroll 1
    for (int l = 0; l < DEPTH; ++l) {
        const int p0 = 1 + l * NPL;
        if (PM(1) && IN(p0 + 0)) RP(1) { FRESH(); phase_norm_mod(Fp, XIN_, INP(I_NMG) + l * DM, MODL_ + 0, MODL_ + 1024, HN_); }
        SEAM(p0 + 0);
        if (PM(2) && IN(p0 + 1)) RP(2) { FRESH(); pg8::Gemm g{HN_, WIN_ + (size_t)l * NWIN * DM, TOK, NWIN, DM}; pg8::StaticOrder S; S.init(TOK, NWIN, Fp.G, Fp.bid);
            epi::EpiProjAll E{{PROJ_, COS_, SIN_}, {GATES_}}; pg8::gemm_phase<epi::EpiProjAll, pg8::StaticOrder, true, true>(ring, g, S, E, Fp.tid); }
        SEAM(p0 + 1);
        if (PM(3) && IN(p0 + 2)) RP(3) {
            { FRESH(); phase_compress(Fp, PROJ_, W1T_ + (size_t)l * 2 * 128 * 2048, W2T_ + (size_t)l * 2 * 64 * 128, PBP_ + (size_t)l * 2 * 16 * 128, KCMP_, VCMP_); }
            { FRESH(); phase_kmean(Fp, PROJ_, KMEAN_); }
            { FRESH(); phase_mixer_a(Fp, PROJ_, INP(I_ACW) + (size_t)l * 3 * 512, MIX_); }
            __syncthreads();
            { FRESH(); phase_mixer_b(Fp, PROJ_, INP(I_BCW) + (size_t)l * 31 * 512, INP(I_BCB) + l * 512, INP(I_BLNG) + l * 512, INP(I_BLNB) + l * 512, MIX_ + (size_t)TOK * 512); }
            __syncthreads();
        }
        SEAM(p0 + 2);
        if (PM(4) && IN(p0 + 3)) RP(4) { { FRESH(); phase_nsa(Fp, PROJ_, KCMP_, VCMP_, MIX_ + (size_t)2 * TOK * 512); __syncthreads(); }
                                         { FRESH(); phase_moba(Fp, PROJ_, KMEAN_, MIX_ + (size_t)3 * TOK * 512); __syncthreads(); } }
        SEAM(p0 + 3);
        if (PM(7) && IN(p0 + 4)) RP(7) { FRESH(); pg8::Gemm g{MIX_, WOUT_ + (size_t)(l * 4) * DM * 512, 4 * TOK, 4 * DM, 512}; epi::MergeOrder S; S.init(Fp.G, Fp.bid);
            epi::EpiMergeAll E{HN_, GATES_}; pg8::gemm_phase<epi::EpiMergeAll, epi::MergeOrder, true, true>(ring, g, S, E, Fp.tid); }
        SEAM(p0 + 4);
        if (PM(8) && IN(p0 + 5)) RP(8) { FRESH(); pg8::Gemm g{HN_, WOT_ + (size_t)l * DM * DM, TOK, DM, DM}; pg8::StaticOrder S; S.init(TOK, DM, Fp.G, Fp.bid);
            epi::EpiResid E{XIN_, LASTRP(8) ? XB_ : (float*)MIX_, MODL_ + 2048}; pg8::gemm_phase<epi::EpiResid, pg8::StaticOrder, true, true>(ring, g, S, E, Fp.tid); }
        SEAM(p0 + 5);
        if (PM(9) && IN(p0 + 6)) RP(9) {
            { FRESH(); phase_norm_mod(Fp, XB_, INP(I_NFG) + l * DM, MODL_ + 3072, MODL_ + 4096, HN_); }
            { FRESH(); phase_peer_tables(Fp, INP(I_PU) + (size_t)l * 16384 * DM, INP(I_PV) + (size_t)l * 16384 * DM, UT_, VT_, SU_, SV_); }
        }
        SEAM(p0 + 6);
        if (PM(10) && IN(p0 + 7)) RP(10) { FRESH(); pg8::Gemm g{HN_, WQT_ + (size_t)l * 2048 * DM, TOK, 2048, DM}; pg8::StaticOrder S; S.init(TOK, 2048, Fp.G, Fp.bid);
            epi::EpiStoreBf E{Q2_, 2048}; pg8::gemm_phase<epi::EpiStoreBf, pg8::StaticOrder, true, true>(ring, g, S, E, Fp.tid); }
        SEAM(p0 + 7);
        if (PM(11) && IN(p0 + 8)) RP(11) { FRESH(); phase_peer_route(Fp, Q2_, SUBK_ + (size_t)l * 8 * 2 * 128 * 128, EIDX_, EW_); __syncthreads(); }
        SEAM(p0 + 8);
        if (PM(12) && IN(p0 + 9)) RP(12) { FRESH(); phase_peer_u(Fp, HN_, UT_, SU_, EIDX_, LASTRP(12) ? PART_ : (float*)MIX_, LASTRP(12) ? 0x3fffu : DUMMY_EMASK); }
        SEAM(p0 + 9);
        if (PM(12) && IN(p0 + 10)) { FRESH(); phase_peer_w(Fp, SV_, EIDX_, EW_, PART_, COEF_); }
        SEAM(p0 + 10);
        if (PM(12) && IN(p0 + 11)) RP(14) { FRESH(); phase_peer_v(Fp, VT_, COEF_, LASTRP(14) ? XB_ : (float*)MIX_, MODL_ + 5120, LASTRP(14) ? 0x3fffu : DUMMY_EMASK); }
        SEAM(p0 + 11);
    }
    if (PM(13) && IN(NPHASE - 1)) { FRESH(); phase_final_norm(Fp, XB_, INP(I_FNG), XB_); }
#ifdef DBG_STOP
    if (IN(NPHASE)) { FRESH();
        const bf16* src = (const bf16*)(WSP + (size_t)DBG_OFF); const size_t n = (size_t)DBG_BYTES / 2, NO = (size_t)TOK * DM; float* o = (float*)ap->out;
        for (size_t i = (size_t)Fp.bid * NTHR + Fp.tid; i < NO; i += (size_t)Fp.G * NTHR) { float a = 0.f; for (size_t j = i; j < n; j += NO) a += bf2f(src[j]);
#ifdef DBG_OFF2
            { const float* s2 = (const float*)(WSP + (size_t)DBG_OFF2); const size_t n2 = (size_t)DBG_BYTES2 / 4; for (size_t j = i; j < n2; j += NO) a += s2[j]; }
#endif
            if (!(a == a) || fabsf(a) > 1e30f) a = 12345.0f;
            o[i] = a; } }
#endif
#undef IN
#undef SEAM
#undef WSP
}

extern "C" void kernel_launch(void* const* d_in, const int* in_sizes, int n_in, void* d_out, int out_size, void* d_ws, size_t ws_size, hipStream_t stream) {
    static int grid = 0;
    if (grid == 0) {
        if (n_in != 26 || in_sizes[0] != TOK * DM || out_size != TOK * DM || ws_size < WS_END) {
            fprintf(stderr, "kernel_launch: unexpected problem (n_in %d, in0 %d, out %d, WSP %zu); nothing launched\n", n_in, n_in > 0 ? in_sizes[0] : -1, out_size, ws_size); grid = -1; return; }
        int dev = 0, cus = 0, per_cu = 0;
        if (hipGetDevice(&dev) != hipSuccess || hipDeviceGetAttribute(&cus, hipDeviceAttributeMultiprocessorCount, dev) != hipSuccess) { grid = -1; return; }
        if (hipFuncSetAttribute((const void*)hybrid_fwd, hipFuncAttributeMaxDynamicSharedMemorySize, LDS_BYTES) != hipSuccess) { fprintf(stderr, "kernel_launch: hipFuncSetAttribute failed\n"); grid = -1; return; }
        if (hipOccupancyMaxActiveBlocksPerMultiprocessor(&per_cu, (const void*)hybrid_fwd, NTHR, LDS_BYTES) != hipSuccess || per_cu < 1)
            fprintf(stderr, "kernel_launch: note: occupancy query reports %d workgroups per CU\n", per_cu);
        (void)hipGetLastError();
        grid = cus;
    }
    if (grid < 0) return;
    if (hipMemsetAsync((char*)d_ws + WS_CTL, 0, CTL_ZERO_BYTES, stream) != hipSuccess) return;
    Args a{};
    for (int i = 0; i < 26; ++i) a.in[i] = d_in[i];
    a.out = (float*)d_out; a.ws = (unsigned char*)d_ws;
#if MK_PER_PHASE
#ifdef DBG_STOP
    for (int p = 0; p <= DBG_STOP; ++p) { a.ph_lo = p; a.ph_hi = p + 1; hipLaunchKernelGGL(hybrid_fwd, dim3(grid), dim3(NTHR), LDS_BYTES, stream, a); }
    a.ph_lo = NPHASE; a.ph_hi = NPHASE + 1; hipLaunchKernelGGL(hybrid_fwd, dim3(grid), dim3(NTHR), LDS_BYTES, stream, a);
#else
    for (int p = 0; p < NPHASE; ++p) { a.ph_lo = p; a.ph_hi = p + 1; hipLaunchKernelGGL(hybrid_fwd, dim3(grid), dim3(NTHR), LDS_BYTES, stream, a); }
#endif
#else
    a.ph_lo = 0; a.ph_hi = NPHASE; hipLaunchKernelGGL(hybrid_fwd, dim3(grid), dim3(NTHR), LDS_BYTES, stream, a);
#endif
    const hipError_t le = hipPeekAtLastError();
    if (le != hipSuccess) fprintf(stderr, "kernel_launch: launch failed: %s\n", hipGetErrorName(le));
}
```

```cpp
#include <hip/hip_runtime.h>
#include <hip/hip_bf16.h>
#include <cstdio>
#include <cstdint>
#include <cmath>

#ifndef MK_PER_PHASE
#define MK_PER_PHASE 0
#endif

#define DUMMY_EMASK 0x3fffu
#define ATT_DBG 0
#define RPMASK 0x0u
#define GAS __attribute__((address_space(1)))
#define LAS __attribute__((address_space(3)))
typedef unsigned short bf16;
typedef unsigned v4u __attribute__((ext_vector_type(4)));
typedef unsigned v2u __attribute__((ext_vector_type(2)));
typedef float f32x4 __attribute__((ext_vector_type(4)));
typedef float f32x2 __attribute__((ext_vector_type(2)));
typedef float f32x16 __attribute__((ext_vector_type(16)));
typedef short bf16x8 __attribute__((ext_vector_type(8)));
typedef short s16x4 __attribute__((ext_vector_type(4)));
typedef __bf16 bf16x2_t __attribute__((ext_vector_type(2)));

constexpr int BATCH = 8, SEQ = 2048, DM = 1024, DEPTH = 2, TOK = BATCH * SEQ;
constexpr int NP1 = 5632;
constexpr int NGT = 4096;
constexpr int NWIN = NP1 + NGT;
constexpr int C_AB = 0, C_AC = 512, C_AX = 1024, C_BA = 1536, C_BG = 2048, C_CQ = 2560, C_KC = 3072, C_VC = 3200, C_KS = 3328, C_VS = 3456, C_KW = 3584, C_VW = 3712,
              C_DQ = 3840, C_DK = 4352, C_DV = 4864, C_CG = 5376;
constexpr float NORM_EPS = 1e-6f;
constexpr float QSCALE = 0.125f * 1.4426950408889634f;

constexpr size_t MiB = 1u << 20;
constexpr size_t WS_CTL = 0, CTL_ZERO_BYTES = 64 * 1024;
constexpr size_t WS_MOD = 1 * MiB;
constexpr size_t WS_COS = 2 * MiB, WS_SIN = 4 * MiB;
constexpr size_t WS_SMALL = 6 * MiB;
constexpr size_t SM_KMEAN = 704 * 1024;
constexpr size_t SM_KCMP = 64 * 1024;
constexpr size_t SM_VCMP = 320 * 1024;
constexpr size_t SM_PBP = 576 * 1024;
constexpr size_t SM_W2T = 640 * 1024;
constexpr size_t WS_EIDX = 8 * MiB;
constexpr size_t WS_EW = 16 * MiB;
constexpr size_t WS_WIN = 24 * MiB;
constexpr size_t WS_WOUT = 62 * MiB;
constexpr size_t WS_WO = 70 * MiB;
constexpr size_t WS_WQ = 74 * MiB;
constexpr size_t WS_W1T = 82 * MiB;
constexpr size_t WS_SUBK = 84 * MiB;
constexpr size_t WS_HN = 86 * MiB;
constexpr size_t WS_MIX = 118 * MiB;
constexpr size_t WS_BIG = 182 * MiB;
constexpr size_t WS_GATES = 358 * MiB;
constexpr size_t WS_END = 486 * MiB;

constexpr int LDS_BYTES = 147456;
constexpr int RING_BYTES = 131072;
constexpr int MISC_OFF = LDS_BYTES - 256;

#define RLX_AGENT __ATOMIC_RELAXED, __HIP_MEMORY_SCOPE_AGENT
#define LDS_WAIT() asm volatile("s_waitcnt lgkmcnt(0)" ::: "memory")
#define VM_WAIT() asm volatile("s_waitcnt vmcnt(0)" ::: "memory")
__device__ __forceinline__ unsigned f2bf(float f) { unsigned u = __builtin_bit_cast(unsigned, f); return (u + 0x7fffu + ((u >> 16) & 1u)) >> 16; }
__device__ __forceinline__ float bf2f(unsigned h) { return __builtin_bit_cast(float, h << 16); }
__device__ __forceinline__ unsigned pk2(float lo, float hi) { f32x2 v = {lo, hi}; bf16x2_t b = __builtin_convertvector(v, bf16x2_t); return __builtin_bit_cast(unsigned, b); }
__device__ __forceinline__ float bflo(unsigned w) { return __builtin_bit_cast(float, w << 16); }
__device__ __forceinline__ float bfhi(unsigned w) { return __builtin_bit_cast(float, w & 0xffff0000u); }
__device__ __forceinline__ float sigmoidf_(float x) { return __builtin_amdgcn_rcpf(1.0f + __builtin_amdgcn_exp2f(x * -1.4426950408889634f)); }
__device__ __forceinline__ float gelu_erf(float x) { return 0.5f * x * (1.0f + erff(x * 0.70710678118654752f)); }
__device__ __forceinline__ float shx(float v, int m, int lane) { return __builtin_bit_cast(float, __builtin_amdgcn_ds_bpermute((lane ^ m) << 2, __builtin_bit_cast(int, v))); }
__device__ __forceinline__ unsigned shxu(unsigned v, int m, int lane) { return (unsigned)__builtin_amdgcn_ds_bpermute((lane ^ m) << 2, (int)v); }
__device__ __forceinline__ void swap32(unsigned v, unsigned& r0, unsigned& r1) { unsigned b = v; asm volatile("" : "+v"(b)); auto r = __builtin_amdgcn_permlane32_swap(v, b, false, false); r0 = r[0]; r1 = r[1]; }
__device__ __forceinline__ float other32(float v, int hi) { unsigned r0, r1; swap32(__builtin_bit_cast(unsigned, v), r0, r1); return __builtin_bit_cast(float, hi ? r0 : r1); }
__device__ __forceinline__ float add32(float v) { unsigned r0, r1; swap32(__builtin_bit_cast(unsigned, v), r0, r1); return __builtin_bit_cast(float, r0) + __builtin_bit_cast(float, r1); }
__device__ __forceinline__ float max32(float v) { unsigned r0, r1; swap32(__builtin_bit_cast(unsigned, v), r0, r1); return fmaxf(__builtin_bit_cast(float, r0), __builtin_bit_cast(float, r1)); }
__device__ __forceinline__ unsigned umax32(unsigned v) { unsigned r0, r1; swap32(v, r0, r1); return r0 > r1 ? r0 : r1; }
__device__ __forceinline__ float wave_sum(float v, int lane) {
#pragma unroll
    for (int o = 1; o < 32; o <<= 1) v += shx(v, o, lane);
    return add32(v);
}
namespace pg8 {
#define PG8_LAS __attribute__((address_space(3)))
typedef unsigned short bf16_t;
typedef short bf16x8 __attribute__((ext_vector_type(8)));
typedef float f32x4 __attribute__((ext_vector_type(4)));
typedef unsigned u32x4 __attribute__((ext_vector_type(4)));
constexpr int BM = 256, BK = 64, HALF = 128, HTB = HALF * BK * 2  , STAGE_BYTES = 8 * HTB, NXCD = 8, WGM = 8;

__host__ __device__ __forceinline__ int lds_byte(int r, int c) { const int st = (r >> 4) * 2 + (c >> 5), rr = r & 15, cc = c & 31, ob = rr * 64 + cc * 2; return st * 1024 + (ob ^ (((ob >> 9) & 1) << 5)); }
__host__ __device__ __forceinline__ void stage_rc(int b, int& R, int& C) { const int st = b / 1024, sb = b % 1024, swz = sb ^ (((sb >> 9) & 1) << 5); R = (st >> 1) * 16 + swz / 64; C = (st & 1) * 32 + (swz % 64) / 2; }
__host__ __device__ __forceinline__ int perm32(int rho) { const int n = rho >> 4, i = rho & 15; return 8 * (i >> 2) + 4 * n + (i & 3); }

struct Unit { int pm, pn; };
struct Gemm { const bf16_t* A; const bf16_t* Bt; int M, N, K; };

struct StaticOrder {
    int nM, nN, nwg, G, c;
    __host__ __device__ void init(int M, int N, int G_, int c_) { nM = M / BM; nN = N / BM; nwg = nM * nN; G = G_; c = c_; }
    __host__ __device__ bool next(int i, Unit& u) const {
        const long L = (long)i * G + c; if (L >= nwg) return false;
        int wgid = (int)L; { const int q = nwg / NXCD, r = nwg % NXCD, xcd = wgid % NXCD, off = wgid / NXCD; wgid = (xcd < r ? xcd * (q + 1) : r * (q + 1) + (xcd - r) * q) + off; }
        const int nig = WGM * nN, gid = wgid / nig, fm = gid * WGM, gsz = (nM - fm) < WGM ? (nM - fm) : WGM;
        u.pm = fm + ((wgid % nig) % gsz); u.pn = (wgid % nig) / gsz; return true;
    }
    __device__ __forceinline__ void a_ready(const Unit&) const {}
    __device__ __forceinline__ void done(const Unit&) const {}
};

__device__ __forceinline__ unsigned cvt_pk_bf16(float lo, float hi) { unsigned r; asm volatile("v_cvt_pk_bf16_f32 %0, %1, %2" : "=v"(r) : "v"(lo), "v"(hi)); return r; }
typedef float f32x2 __attribute__((ext_vector_type(2)));
template <class Epi, class Sched, bool ALIGN_EPI = false, bool SP2 = false>
__device__ __forceinline__ void gemm_phase(PG8_LAS unsigned char* lds, const Gemm g, const Sched& S, const Epi& E, const int tid) {
    const int wid = __builtin_amdgcn_readfirstlane(tid >> 6), lane = tid & 63, wr = wid >> 2, wc = wid & 3, fr = lane & 15, fq = lane >> 4;
    const int K = g.K, nt = K / BK;
    unsigned voffA[2], voffB[2];
#pragma unroll
    for (int i = 0; i < 2; ++i) { int R, C; stage_rc(tid * 16 + i * 8192, R, C); const int Rb = Epi::PERM ? ((R & ~31) + perm32(R & 31)) : R;
        voffA[i] = (unsigned)(R * K + C) * 2u; voffB[i] = (unsigned)(Rb * K + C) * 2u; }
    const size_t kstep = (size_t)(BK * 2);
    const size_t hstep = (size_t)HALF * K * 2;
    const size_t tstep = 2 * hstep;
    const unsigned ldsw = (unsigned)wid * 1024u;
    const int aoff = lds_byte(wr * 64 + fr, fq * 8), boff = lds_byte(wc * 32 + fr, fq * 8);
#define PG8_SA(b, h) (((b) * 2 + (h)) * HTB)
#define PG8_SB(b, h) ((4 + (b) * 2 + (h)) * HTB)
#define PG8_STAGE(bufoff, gbase, voff) do { _Pragma("unroll") for (int _i = 0; _i < 2; ++_i) \
        __builtin_amdgcn_global_load_lds((const unsigned*)((const char*)(gbase) + (voff)[_i]), (PG8_LAS unsigned*)(lds + (bufoff) + ldsw + _i * 8192), 16, 0, 0); } while (0)
#define PG8_LDA(dst, b, h) do { _Pragma("unroll") for (int m = 0; m < 4; ++m) _Pragma("unroll") for (int k = 0; k < 2; ++k) dst[m][k] = *(const PG8_LAS bf16x8*)(lds + PG8_SA(b, h) + aoff + m * 2048 + k * 1024); } while (0)
#define PG8_LDB(dst, b, h) do { _Pragma("unroll") for (int n = 0; n < 2; ++n) _Pragma("unroll") for (int k = 0; k < 2; ++k) dst[n][k] = *(const PG8_LAS bf16x8*)(lds + PG8_SB(b, h) + boff + n * 2048 + k * 1024); } while (0)
#define PG8_MMA(ai, bj, At, Bt) do { __builtin_amdgcn_s_setprio(1); _Pragma("unroll") for (int m = 0; m < 4; ++m) _Pragma("unroll") for (int n = 0; n < 2; ++n) _Pragma("unroll") for (int k = 0; k < 2; ++k) \
        acc[ai][bj][m][n] = __builtin_amdgcn_mfma_f32_16x16x32_bf16(Bt[n][k], At[m][k], acc[ai][bj][m][n], 0, 0, 0); __builtin_amdgcn_s_setprio(0); } while (0)
#define PG8_WAIT_V(n) asm volatile("s_waitcnt vmcnt(" #n ")" ::: "memory")
#define PG8_WAIT_L(n) asm volatile("s_waitcnt lgkmcnt(" #n ")" ::: "memory")
#define PG8_BAR __builtin_amdgcn_s_barrier()
#define PG8_SCHED __builtin_amdgcn_sched_barrier(0)
    Unit cur, nxt; int ui = 0;
    if (!S.next(0, cur)) return;
    f32x4 acc[2][2][4][2];
#pragma unroll
    for (int a = 0; a < 2; ++a)
#pragma unroll
        for (int b = 0; b < 2; ++b)
#pragma unroll
            for (int m = 0; m < 4; ++m)
#pragma unroll
                for (int n = 0; n < 2; ++n) acc[a][b][m][n] = (f32x4){0.f, 0.f, 0.f, 0.f};
    bf16x8 At[4][2], B0[2][2], B1[2][2];
    const char* cA = (const char*)g.A + (size_t)cur.pm * tstep; const char* cB = (const char*)g.Bt + (size_t)cur.pn * tstep;
    S.a_ready(cur);
    if constexpr (SP2) {
        PG8_STAGE(PG8_SB(0, 0), cB, voffB); PG8_STAGE(PG8_SB(0, 1), cB + hstep, voffB); PG8_STAGE(PG8_SA(0, 0), cA, voffA); PG8_STAGE(PG8_SA(0, 1), cA + hstep, voffA);
        if (wr == 1) PG8_BAR;
        PG8_WAIT_V(2); PG8_BAR;
        PG8_STAGE(PG8_SB(1, 0), cB + kstep, voffB); PG8_STAGE(PG8_SA(1, 0), cA + kstep, voffA); PG8_STAGE(PG8_SB(1, 1), cB + hstep + kstep, voffB);
        PG8_WAIT_V(6); PG8_BAR;
    } else {
        PG8_STAGE(PG8_SB(0, 0), cB, voffB); PG8_STAGE(PG8_SA(0, 0), cA, voffA); PG8_STAGE(PG8_SB(0, 1), cB + hstep, voffB); PG8_STAGE(PG8_SA(0, 1), cA + hstep, voffA);
        if (wr == 1) PG8_BAR;
        PG8_WAIT_V(4); PG8_BAR;
        PG8_STAGE(PG8_SB(1, 0), cB + kstep, voffB); PG8_STAGE(PG8_SA(1, 0), cA + kstep, voffA); PG8_STAGE(PG8_SB(1, 1), cB + hstep + kstep, voffB);
        PG8_WAIT_V(6); PG8_BAR;
    }
    for (;;) {
        const bool has_next = S.next(ui + 1, nxt);
        const char* nA = has_next ? (const char*)g.A + (size_t)nxt.pm * tstep : cA; const char* nB = has_next ? (const char*)g.Bt + (size_t)nxt.pn * tstep : cB;
        for (int t = 0; t < nt; t += 2) {
            const bool last = (t == nt - 2);
            const char* a1 = cA + (size_t)(t + 1) * kstep;
            const char* a2 = last ? nA : cA + (size_t)(t + 2) * kstep; const char* b2 = last ? nB : cB + (size_t)(t + 2) * kstep;
            const char* a3 = a2 + kstep; const char* b3 = b2 + kstep;
            if (last && has_next) S.a_ready(nxt);
            if constexpr (SP2) {
            PG8_LDB(B0, 0, 0); PG8_LDB(B1, 0, 1); PG8_SCHED; PG8_LDA(At, 0, 0); PG8_STAGE(PG8_SA(1, 1), a1 + hstep, voffA);
            PG8_WAIT_V(8); PG8_WAIT_L(0); PG8_BAR; PG8_MMA(0, 0, At, B0); PG8_MMA(0, 1, At, B1); PG8_BAR; PG8_SCHED;
            PG8_LDA(At, 0, 1); PG8_STAGE(PG8_SB(0, 0), b2, voffB); PG8_STAGE(PG8_SB(0, 1), b2 + hstep, voffB); PG8_STAGE(PG8_SA(0, 0), a2, voffA);
            PG8_WAIT_V(8); PG8_WAIT_L(0); PG8_BAR; PG8_MMA(1, 0, At, B0); PG8_MMA(1, 1, At, B1); PG8_BAR; PG8_SCHED;
            PG8_LDB(B0, 1, 0); PG8_LDB(B1, 1, 1); PG8_SCHED; PG8_LDA(At, 1, 0); PG8_STAGE(PG8_SA(0, 1), a2 + hstep, voffA);
            PG8_WAIT_V(8); PG8_WAIT_L(0); PG8_BAR; PG8_MMA(0, 0, At, B0); PG8_MMA(0, 1, At, B1); PG8_BAR; PG8_SCHED;
            PG8_LDA(At, 1, 1); PG8_STAGE(PG8_SB(1, 0), b3, voffB); PG8_STAGE(PG8_SB(1, 1), b3 + hstep, voffB); PG8_STAGE(PG8_SA(1, 0), a3, voffA);
            PG8_WAIT_V(8); PG8_WAIT_L(0); PG8_BAR; PG8_MMA(1, 0, At, B0); PG8_MMA(1, 1, At, B1); PG8_BAR; PG8_SCHED;
            } else {
            PG8_LDB(B0, 0, 0); PG8_SCHED; PG8_LDA(At, 0, 0); PG8_STAGE(PG8_SA(1, 1), a1 + hstep, voffA);
            PG8_WAIT_L(8); PG8_BAR; PG8_WAIT_L(0); PG8_MMA(0, 0, At, B0); PG8_BAR; PG8_SCHED;
            PG8_LDB(B1, 0, 1); PG8_STAGE(PG8_SB(0, 0), b2, voffB);
            PG8_BAR; PG8_WAIT_L(0); PG8_MMA(0, 1, At, B1); PG8_BAR;
            PG8_LDA(At, 0, 1); PG8_STAGE(PG8_SA(0, 0), a2, voffA);
            PG8_BAR; PG8_WAIT_L(0); PG8_MMA(1, 0, At, B0); PG8_BAR; PG8_SCHED;
            PG8_STAGE(PG8_SB(0, 1), b2 + hstep, voffB);
            PG8_WAIT_V(6); PG8_BAR; PG8_MMA(1, 1, At, B1); PG8_BAR;
            PG8_LDB(B0, 1, 0); PG8_SCHED; PG8_LDA(At, 1, 0); PG8_STAGE(PG8_SA(0, 1), a2 + hstep, voffA);
            PG8_WAIT_L(8); PG8_BAR; PG8_WAIT_L(0); PG8_MMA(0, 0, At, B0); PG8_BAR; PG8_SCHED;
            PG8_LDB(B1, 1, 1); PG8_STAGE(PG8_SB(1, 0), b3, voffB);
            PG8_BAR; PG8_WAIT_L(0); PG8_MMA(0, 1, At, B1); PG8_BAR;
            PG8_LDA(At, 1, 1); PG8_STAGE(PG8_SA(1, 0), a3, voffA);
            PG8_BAR; PG8_WAIT_L(0); PG8_MMA(1, 0, At, B0); PG8_BAR; PG8_SCHED;
            PG8_STAGE(PG8_SB(1, 1), b3 + hstep, voffB);
            PG8_WAIT_V(6); PG8_BAR; PG8_MMA(1, 1, At, B1); PG8_BAR;
            }
        }
        if constexpr (ALIGN_EPI) { if (wr == 0) PG8_BAR; }
        if constexpr (Epi::KEEP_ACC) { E.inplace(acc, cur, wr, wc, fr, fq); S.done(cur); }
        else if constexpr (!Epi::AFTER_DRAIN) { E(acc, cur, wr, wc, fr, fq); S.done(cur); }
        if (!has_next) break;
        if constexpr (!Epi::KEEP_ACC)
#pragma unroll
        for (int a = 0; a < 2; ++a)
#pragma unroll
            for (int b = 0; b < 2; ++b)
#pragma unroll
                for (int m = 0; m < 4; ++m)
#pragma unroll
                    for (int n = 0; n < 2; ++n) acc[a][b][m][n] = (f32x4){0.f, 0.f, 0.f, 0.f};
        cur = nxt; cA = nA; cB = nB; ++ui;
        if constexpr (ALIGN_EPI) { if (wr == 1) PG8_BAR; }
    }
    PG8_WAIT_V(0);
    if constexpr (!ALIGN_EPI) { if (wr == 0) PG8_BAR; }
    PG8_BAR;
    if constexpr (Epi::AFTER_DRAIN) { E.fused(acc, cur, wr, wc, fr, fq, lds, wid, lane); S.done(cur); }
#undef PG8_SA
#undef PG8_SB
#undef PG8_STAGE
#undef PG8_LDA
#undef PG8_LDB
#undef PG8_MMA
#undef PG8_WAIT_V
#undef PG8_WAIT_L
#undef PG8_BAR
#undef PG8_SCHED
}
}
#define XB_TMO      128
#define XB_XCNT(j)  (256  + 64 * (j))
#define XB_XSUB(j)  (1280 + 64 * (j))
#define XB_XGEN(j)  (2304 + 64 * (j))
#define XB_TOP      3328
#define XB_TOPGEN   3392
#define XCD_BAR_WORDS 3456
#define XB_SPIN_CAP (1u << 25)

__device__ __forceinline__ unsigned xb_ld(unsigned* p)              { return __hip_atomic_load(p, __ATOMIC_RELAXED, __HIP_MEMORY_SCOPE_AGENT); }
__device__ __forceinline__ unsigned xb_add(unsigned* p, unsigned v) { return __hip_atomic_fetch_add(p, v, __ATOMIC_RELAXED, __HIP_MEMORY_SCOPE_AGENT); }
__device__ __forceinline__ unsigned xb_xcc_id() { return (unsigned)__builtin_amdgcn_s_getreg((3 << 11) | 20) & 0xFu; }
#define XB_SPIN(cond, bar) do { unsigned _sp = 0; while (cond) { __builtin_amdgcn_s_sleep(1); \
    if ((++_sp & 255u) == 0u) { if (xb_ld(&(bar)[XB_TMO])) break; if (_sp > XB_SPIN_CAP) { atomicAdd(&(bar)[XB_TMO], 1u); break; } } } } while (0)

struct XcdBarrier {
    unsigned* bar; unsigned x;
    volatile LAS unsigned* st;
};

__device__ __forceinline__ XcdBarrier xcd_barrier_post(unsigned* bar, volatile LAS unsigned* st) {
    XcdBarrier b; b.bar = bar; b.x = xb_xcc_id(); b.st = st;
    if (threadIdx.x == 0) (void)xb_add(&bar[XB_XCNT(b.x)], 1u);
    return b;
}
__device__ __forceinline__ void xcd_barrier_complete(unsigned* bar, unsigned x, unsigned& nloc, unsigned& nx) {
    const unsigned G = gridDim.x * gridDim.y * gridDim.z;
    unsigned sum, cnt, mine, sp = 0u;
    for (;;) {
        sum = 0u; cnt = 0u; mine = 0u;
#pragma unroll
        for (unsigned j = 0; j < 16; ++j) { const unsigned c = xb_ld(&bar[XB_XCNT(j)]); sum += c; cnt += (c > 0u) ? 1u : 0u; mine = (j == x) ? c : mine; }
        if (sum == G) break;
        __builtin_amdgcn_s_sleep(1);
        if ((++sp & 255u) == 0u) { if (xb_ld(&bar[XB_TMO])) break; if (sp > XB_SPIN_CAP) { atomicAdd(&bar[XB_TMO], 1u); break; } }
    }
    nloc = mine > 0u ? mine : 1u; nx = cnt > 0u ? cnt : 1u;
}

__device__ __forceinline__ void xcd_barrier(const XcdBarrier& b) {
    asm volatile("s_waitcnt vmcnt(0)" ::: "memory");
    __syncthreads();
    if (threadIdx.x == 0) {
        unsigned* bar = b.bar;
        __builtin_amdgcn_s_waitcnt(0);
        unsigned nloc = b.st[0], nx = b.st[1];
        if (nloc == 0u) { xcd_barrier_complete(bar, b.x, nloc, nx); b.st[0] = nloc; b.st[1] = nx; }
        const unsigned old = xb_add(&bar[XB_XSUB(b.x)], 1u);
        const unsigned gen = old / nloc;
        if (old + 1u == (gen + 1u) * nloc) {
            __builtin_amdgcn_fence(__ATOMIC_RELEASE, "agent");
            asm volatile("s_waitcnt vmcnt(0)" ::: "memory");
            const unsigned og = xb_add(&bar[XB_TOP], 1u);
            const unsigned tg = og / nx;
            if (og + 1u == (tg + 1u) * nx) xb_add(&bar[XB_TOPGEN], 1u);
            else XB_SPIN(xb_ld(&bar[XB_TOPGEN]) == tg, bar);
            __builtin_amdgcn_fence(__ATOMIC_ACQUIRE, "agent");
            xb_add(&bar[XB_XGEN(b.x)], 1u);
            asm volatile("s_waitcnt vmcnt(0)" ::: "memory");
        } else {
            XB_SPIN(xb_ld(&bar[XB_XGEN(b.x)]) == gen, bar);
            __builtin_amdgcn_fence(__ATOMIC_ACQUIRE, "agent");
            asm volatile("s_waitcnt vmcnt(0)" ::: "memory");
        }
    }
    __syncthreads();
}

namespace epi {
using pg8::Unit; using pg8::BM; using pg8::HALF;
typedef const pg8::f32x4 (&AccRef)[2][2][4][2];

struct EpiProj1 {
    static constexpr bool PERM = true, AFTER_DRAIN = false, KEEP_ACC = false;
    bf16* O; const float* cosT; const float* sinT;
    __device__ __forceinline__ void operator()(AccRef acc, const Unit& u, int wr, int wc, int fr, int fq) const {
        const int row0 = u.pm * BM + wr * 64 + fr, colw = u.pn * BM + wc * 32;
#pragma unroll
        for (int bj = 0; bj < 2; ++bj) {
            const int hb = (colw + bj * HALF) >> 6;
            const bool rope = (hb >= 40 && hb < 50) || (hb >= 52 && hb < 54) || (hb >= 56 && hb < 58) || (hb >= 60 && hb < 76);
            const bool isq = (hb >= 40 && hb < 48) || (hb >= 60 && hb < 68);
            const float qs = isq ? QSCALE : 1.0f;
            const int jw = (wc & 1) * 16 + fq * 4;
#pragma unroll
            for (int ai = 0; ai < 2; ++ai)
#pragma unroll
                for (int m = 0; m < 4; ++m) {
                    const int row = row0 + ai * HALF + m * 16;
                    pg8::f32x4 v0 = acc[ai][bj][m][0], v1 = acc[ai][bj][m][1];
                    if (rope) {
                        const pg8::f32x4 c = *(const pg8::f32x4*)(cosT + (size_t)row * 32 + jw), s = *(const pg8::f32x4*)(sinT + (size_t)row * 32 + jw);
                        const float a0 = v0[0] * c[0] - v0[1] * s[0], a1 = v0[1] * c[0] + v0[0] * s[0], a2 = v0[2] * c[1] - v0[3] * s[1], a3 = v0[3] * c[1] + v0[2] * s[1];
                        const float b0 = v1[0] * c[2] - v1[1] * s[2], b1 = v1[1] * c[2] + v1[0] * s[2], b2 = v1[2] * c[3] - v1[3] * s[3], b3 = v1[3] * c[3] + v1[2] * s[3];
                        v0 = (pg8::f32x4){a0, a1, a2, a3} * qs; v1 = (pg8::f32x4){b0, b1, b2, b3} * qs;
                    }
                    v4u w; w.x = pk2(v0[0], v0[1]); w.y = pk2(v0[2], v0[3]); w.z = pk2(v1[0], v1[1]); w.w = pk2(v1[2], v1[3]);
                    *(v4u*)(O + (size_t)row * NP1 + colw + bj * HALF + 8 * fq) = w;
                }
        }
    }
};
struct EpiStoreBf {
    static constexpr bool PERM = true, AFTER_DRAIN = false, KEEP_ACC = false;
    bf16* O; int ldc;
    __device__ __forceinline__ void operator()(AccRef acc, const Unit& u, int wr, int wc, int fr, int fq) const {
        const int row0 = u.pm * BM + wr * 64 + fr, col0 = u.pn * BM + wc * 32 + 8 * fq;
#pragma unroll
        for (int ai = 0; ai < 2; ++ai)
#pragma unroll
            for (int m = 0; m < 4; ++m) { bf16* rowp = O + (size_t)(row0 + ai * HALF + m * 16) * ldc + col0;
#pragma unroll
                for (int bj = 0; bj < 2; ++bj) { const pg8::f32x4 v0 = acc[ai][bj][m][0], v1 = acc[ai][bj][m][1];
                    v4u w; w.x = pk2(v0[0], v0[1]); w.y = pk2(v0[2], v0[3]); w.z = pk2(v1[0], v1[1]); w.w = pk2(v1[2], v1[3]); *(v4u*)(rowp + bj * HALF) = w; } }
    }
};
__device__ __forceinline__ float gate_enc(float x) { const float e = __builtin_amdgcn_exp2f(__builtin_amdgcn_fmed3f(x, -30.0f, 30.0f) * -1.4426950408889634f); return (1.0f - e) * __builtin_amdgcn_rcpf(1.0f + e); }

struct EpiGates {
    static constexpr bool PERM = true, AFTER_DRAIN = false, KEEP_ACC = false;
    unsigned char* O;
    __device__ __forceinline__ void operator()(AccRef acc, const Unit& u, int wr, int wc, int fr, int fq) const {
        const int row0 = u.pm * BM + wr * 64 + fr, col0 = u.pn * BM + wc * 32 + 8 * fq;
#pragma unroll
        for (int ai = 0; ai < 2; ++ai)
#pragma unroll
            for (int m = 0; m < 4; ++m) { unsigned char* rowp = O + (size_t)(row0 + ai * HALF + m * 16) * NGT + col0;
#pragma unroll
                for (int bj = 0; bj < 2; ++bj) { const pg8::f32x4 v0 = acc[ai][bj][m][0], v1 = acc[ai][bj][m][1];
                    v2u w; unsigned p = 0u; p = __builtin_amdgcn_cvt_pk_fp8_f32(gate_enc(v0[0]), gate_enc(v0[1]), p, false); p = __builtin_amdgcn_cvt_pk_fp8_f32(gate_enc(v0[2]), gate_enc(v0[3]), p, true); w.x = p;
                    p = 0u; p = __builtin_amdgcn_cvt_pk_fp8_f32(gate_enc(v1[0]), gate_enc(v1[1]), p, false); p = __builtin_amdgcn_cvt_pk_fp8_f32(gate_enc(v1[2]), gate_enc(v1[3]), p, true); w.y = p;
                    *(v2u*)(rowp + bj * HALF) = w; } }
    }
};
struct EpiMerge {
    static constexpr bool PERM = true, AFTER_DRAIN = false, KEEP_ACC = false;
    bf16* O; const unsigned char* G; int seg;
    __device__ __forceinline__ void operator()(AccRef acc, const Unit& u, int wr, int wc, int fr, int fq) const {
        const int row0 = u.pm * BM + wr * 64 + fr, col0 = u.pn * BM + wc * 32 + 8 * fq;
#pragma unroll
        for (int ai = 0; ai < 2; ++ai)
#pragma unroll
            for (int m = 0; m < 4; ++m) { const size_t row = (size_t)(row0 + ai * HALF + m * 16); bf16* rowp = O + row * DM + col0; const unsigned char* gp = G + row * NGT + seg * DM + col0;
#pragma unroll
                for (int bj = 0; bj < 2; ++bj) { pg8::f32x4 v0 = acc[ai][bj][m][0], v1 = acc[ai][bj][m][1];
                    const v2u g = *(const v2u*)(gp + bj * HALF);
                    const f32x2 g0 = __builtin_amdgcn_cvt_pk_f32_fp8(g.x, false), g1 = __builtin_amdgcn_cvt_pk_f32_fp8(g.x, true), g2 = __builtin_amdgcn_cvt_pk_f32_fp8(g.y, false), g3 = __builtin_amdgcn_cvt_pk_f32_fp8(g.y, true);
                    v0[0] *= 0.5f * g0.x + 0.5f; v0[1] *= 0.5f * g0.y + 0.5f; v0[2] *= 0.5f * g1.x + 0.5f; v0[3] *= 0.5f * g1.y + 0.5f;
                    v1[0] *= 0.5f * g2.x + 0.5f; v1[1] *= 0.5f * g2.y + 0.5f; v1[2] *= 0.5f * g3.x + 0.5f; v1[3] *= 0.5f * g3.y + 0.5f;
                    if (seg != 0) { const v4u o = *(const v4u*)(rowp + bj * HALF); v0[0] += bflo(o.x); v0[1] += bfhi(o.x); v0[2] += bflo(o.y); v0[3] += bfhi(o.y); v1[0] += bflo(o.z); v1[1] += bfhi(o.z); v1[2] += bflo(o.w); v1[3] += bfhi(o.w); }
                    v4u w; w.x = pk2(v0[0], v0[1]); w.y = pk2(v0[2], v0[3]); w.z = pk2(v1[0], v1[1]); w.w = pk2(v1[2], v1[3]); *(v4u*)(rowp + bj * HALF) = w; } }
    }
};
struct EpiResid {
    static constexpr bool PERM = false, AFTER_DRAIN = false, KEEP_ACC = false;
    const float* XI; float* XO; const float* gate;
    __device__ __forceinline__ void operator()(AccRef acc, const Unit& u, int wr, int wc, int fr, int fq) const {
        const int row0 = u.pm * BM + wr * 64 + fr, col0 = u.pn * BM + wc * 32 + 4 * fq;
        const float* gb = gate + (size_t)((u.pm * BM) / SEQ) * 6144 + col0;
        pg8::f32x4 gv[2][2];
#pragma unroll
        for (int bj = 0; bj < 2; ++bj)
#pragma unroll
            for (int n = 0; n < 2; ++n) gv[bj][n] = *(const pg8::f32x4*)(gb + bj * HALF + n * 16);
#pragma unroll
        for (int ai = 0; ai < 2; ++ai)
#pragma unroll
            for (int m = 0; m < 4; ++m) { const size_t off = (size_t)(row0 + ai * HALF + m * 16) * DM + col0;
#pragma unroll
                for (int bj = 0; bj < 2; ++bj)
#pragma unroll
                    for (int n = 0; n < 2; ++n) { const pg8::f32x4 xi = *(const pg8::f32x4*)(XI + off + bj * HALF + n * 16);
                        *(pg8::f32x4*)(XO + off + bj * HALF + n * 16) = xi + gv[bj][n] * acc[ai][bj][m][n]; } }
    }
};

struct EpiProjAll {
    static constexpr bool PERM = true, AFTER_DRAIN = false, KEEP_ACC = false;
    static_assert(true, ""); EpiProj1 P; EpiGates G;
    __device__ __forceinline__ void operator()(AccRef acc, const Unit& u, int wr, int wc, int fr, int fq) const {
        if (u.pn < NP1 / BM) P(acc, u, wr, wc, fr, fq);
        else { Unit v = u; v.pn -= NP1 / BM; G(acc, v, wr, wc, fr, fq); }
    }
};
__device__ __forceinline__ void gates8(const unsigned char* p, float (&g)[8]) {
    const v2u w = *(const v2u*)p;
    const f32x2 a = __builtin_amdgcn_cvt_pk_f32_fp8(w.x, false), b = __builtin_amdgcn_cvt_pk_f32_fp8(w.x, true), c = __builtin_amdgcn_cvt_pk_f32_fp8(w.y, false), d = __builtin_amdgcn_cvt_pk_f32_fp8(w.y, true);
    g[0] = fmaxf(0.5f * a.x + 0.5f, 0x1p-10f); g[1] = fmaxf(0.5f * a.y + 0.5f, 0x1p-10f); g[2] = fmaxf(0.5f * b.x + 0.5f, 0x1p-10f); g[3] = fmaxf(0.5f * b.y + 0.5f, 0x1p-10f);
    g[4] = fmaxf(0.5f * c.x + 0.5f, 0x1p-10f); g[5] = fmaxf(0.5f * c.y + 0.5f, 0x1p-10f); g[6] = fmaxf(0.5f * d.x + 0.5f, 0x1p-10f); g[7] = fmaxf(0.5f * d.y + 0.5f, 0x1p-10f);
}
struct EpiMergeAll {
    static constexpr bool PERM = true, AFTER_DRAIN = false, KEEP_ACC = true;
    bf16* O; const unsigned char* G;
    __device__ __forceinline__ void operator()(AccRef, const Unit&, int, int, int, int) const {}
    __device__ __forceinline__ void inplace(pg8::f32x4 (&acc)[2][2][4][2], const Unit& u, int wr, int wc, int fr, int fq) const {
        const int seg = u.pm >> 6, pm = u.pm & 63, pn = u.pn & 3;
        const int row0 = pm * BM + wr * 64 + fr, col0 = pn * BM + wc * 32 + 8 * fq;
#pragma unroll
        for (int ai = 0; ai < 2; ++ai)
#pragma unroll
            for (int m = 0; m < 4; ++m) { const size_t row = (size_t)(row0 + ai * HALF + m * 16); const unsigned char* gp = G + row * NGT + seg * DM + col0;
#pragma unroll
                for (int bj = 0; bj < 2; ++bj) { float gc[8]; gates8(gp + bj * HALF, gc);
                    pg8::f32x4& v0 = acc[ai][bj][m][0]; pg8::f32x4& v1 = acc[ai][bj][m][1];
                    if (seg < 3) { float gn[8]; gates8(gp + DM + bj * HALF, gn);
#pragma unroll
                        for (int e = 0; e < 4; ++e) { v0[e] *= gc[e] * __builtin_amdgcn_rcpf(gn[e]); v1[e] *= gc[4 + e] * __builtin_amdgcn_rcpf(gn[4 + e]); } }
                    else {
#pragma unroll
                        for (int e = 0; e < 4; ++e) { v0[e] *= gc[e]; v1[e] *= gc[4 + e]; }
                        v4u w; w.x = pk2(v0[0], v0[1]); w.y = pk2(v0[2], v0[3]); w.z = pk2(v1[0], v1[1]); w.w = pk2(v1[2], v1[3]); *(v4u*)(O + row * DM + col0 + bj * HALF) = w;
                        v0 = (pg8::f32x4){0.f, 0.f, 0.f, 0.f}; v1 = (pg8::f32x4){0.f, 0.f, 0.f, 0.f}; } } }
    }
};
struct MergeOrder {
    pg8::StaticOrder S;
    __device__ void init(int G_, int c_) { S.init(TOK, DM, G_, c_); }
    __device__ bool next(int i, Unit& u) const { Unit b; if (!S.next(i >> 2, b)) return false; const int seg = i & 3; u.pm = seg * 64 + b.pm; u.pn = seg * 4 + b.pn; return true; }
    __device__ __forceinline__ void a_ready(const Unit&) const {}
    __device__ __forceinline__ void done(const Unit&) const {}
};
}

constexpr int NWAVES = 8, NTHR = 512;
struct Args { const void* in[26]; float* out; unsigned char* ws; int ph_lo, ph_hi; };
enum InIdx { I_X = 0, I_C, I_POS, I_MODW, I_MODB, I_NMG, I_NFG, I_WIN, I_ACW, I_AOUT, I_BCW, I_BCB, I_BLNG, I_BLNB, I_BOUT, I_CPOS, I_CW1, I_CW2, I_COUT, I_DOUT, I_WO, I_PWQ, I_PSUB, I_PU, I_PV, I_FNG };

struct Frame {
    LAS unsigned char* lds; unsigned char* ldsg;
    int tid, lane, wave, G, bid;
    unsigned char* ws;
};
__device__ __forceinline__ int gwave(const Frame& F) { return F.bid * NWAVES + F.wave; }
__device__ __forceinline__ int ngwave(const Frame& F) { return F.G * NWAVES; }

__device__ __forceinline__ int rope_pos_of_dim(int d) { return d < 32 ? 2 * d : 2 * (d - 32) + 1; }
__device__ __forceinline__ int rope_dim_of_pos(int p) { return (p >> 1) + 32 * (p & 1); }
__device__ __forceinline__ int win_row_of_col(int n) {
    if (n < 2560) return n;
    if (n < 3072) { const int c = n - 2560; return C_CQ + (c & ~63) + rope_pos_of_dim(c & 63); }
    if (n < 3200) { const int c = n - 3072; return C_KC + (c & ~63) + rope_pos_of_dim(c & 63); }
    if (n < 3328) return C_VC + (n - 3200);
    if (n < 3456) { const int c = n - 3328; return C_KS + (c & ~63) + rope_pos_of_dim(c & 63); }
    if (n < 3584) return C_VS + (n - 3456);
    if (n < 3712) { const int c = n - 3584; return C_KW + (c & ~63) + rope_pos_of_dim(c & 63); }
    if (n < 3840) return C_VW + (n - 3712);
    if (n < 3864) return C_CG + (n - 3840);
    if (n < 4376) { const int c = n - 3864; return C_DQ + (c & ~63) + rope_pos_of_dim(c & 63); }
    if (n < 4888) { const int c = n - 4376; return C_DK + (c & ~63) + rope_pos_of_dim(c & 63); }
    if (n < 5400) return C_DV + (n - 4888);
    return NP1 + (n - 5400);
}
constexpr int TR_SCR = 17408;
template <int MODE, bool KPERM>
__device__ __forceinline__ void transpose_item(const float* W, int K, int N, bf16* WT, LAS float* scr, int item, int lane) {
    const int nblk = (N + 63) / 64, kb = item / nblk, nb = item % nblk, k0 = 64 * kb, n0 = 64 * nb;
    const int nq = (lane & 15) * 4; const bool nok = n0 + nq < N;
#pragma unroll 4
    for (int i = 0; i < 16; ++i) { const int kk = 4 * i + (lane >> 4); const f32x4 v = nok ? *(const f32x4*)(W + (size_t)(k0 + kk) * N + n0 + nq) : (f32x4){0.f, 0.f, 0.f, 0.f};
        LAS float* d = scr + kk * 65 + nq; d[0] = v[0]; d[1] = v[1]; d[2] = v[2]; d[3] = v[3]; }
    LDS_WAIT(); asm volatile("" ::: "memory");
    const int c = lane & 7;
#pragma unroll
    for (int j = 0; j < 8; ++j) { const int n = (lane >> 3) + 8 * j;
        float s[8];
#pragma unroll
        for (int e = 0; e < 8; ++e) { const int p = 8 * c + e; const int ks = KPERM ? rope_dim_of_pos(p) : p; s[e] = scr[ks * 65 + n]; }
        v4u o; o.x = pk2(s[0], s[1]); o.y = pk2(s[2], s[3]); o.z = pk2(s[4], s[5]); o.w = pk2(s[6], s[7]);
        if (n0 + n < N) { const int row = (MODE == 1) ? win_row_of_col(n0 + n) : (n0 + n); *(v4u*)(WT + (size_t)row * K + k0 + 8 * c) = o; } }
    LDS_WAIT(); asm volatile("" ::: "memory");
}
template <int MODE, bool KPERM>
__device__ __forceinline__ void transpose_matrix(const Frame& F, const float* W, int K, int N, bf16* WT, int& base) {
    LAS float* scr = (LAS float*)(F.lds + F.wave * TR_SCR);
    const int nitems = (K / 64) * ((N + 63) / 64), gw = gwave(F), NGW = ngwave(F);
    int first = (gw - base % NGW + NGW) % NGW;
    for (int it = first; it < nitems; it += NGW) transpose_item<MODE, KPERM>(W, K, N, WT, scr, it, F.lane);
    base += nitems;
}
__device__ __forceinline__ void convert_copy(const Frame& F, const float* src, bf16* dst, size_t n) {
    const size_t nth = (size_t)F.G * NTHR, t0 = (size_t)F.bid * NTHR + F.tid;
    for (size_t i = t0; i < n / 8; i += nth) { const f32x4 a = *(const f32x4*)(src + i * 8), b = *(const f32x4*)(src + i * 8 + 4);
        v4u o; o.x = pk2(a[0], a[1]); o.y = pk2(a[2], a[3]); o.z = pk2(b[0], b[1]); o.w = pk2(b[2], b[3]); *(v4u*)(dst + i * 8) = o; }
}

typedef __attribute__((address_space(4))) const Args* KArgsP;
__device__ __forceinline__ void phase_prologue(const Frame& F, KArgsP Ap) {
    unsigned char* ws = F.ws;
    int base = 0;
    for (int l = 0; l < DEPTH; ++l) {
        transpose_matrix<1, false>(F, (const float*)(GAS const void*)Ap->in[I_WIN] + (size_t)l * DM * 9496, DM, 9496, (bf16*)(ws + WS_WIN) + (size_t)l * NWIN * DM, base);
        transpose_matrix<0, false>(F, (const float*)(GAS const void*)Ap->in[I_AOUT] + (size_t)l * 512 * DM, 512, DM, (bf16*)(ws + WS_WOUT) + (size_t)(l * 4 + 0) * DM * 512, base);
        transpose_matrix<0, false>(F, (const float*)(GAS const void*)Ap->in[I_BOUT] + (size_t)l * 512 * DM, 512, DM, (bf16*)(ws + WS_WOUT) + (size_t)(l * 4 + 1) * DM * 512, base);
        transpose_matrix<0, false>(F, (const float*)(GAS const void*)Ap->in[I_COUT] + (size_t)l * 512 * DM, 512, DM, (bf16*)(ws + WS_WOUT) + (size_t)(l * 4 + 2) * DM * 512, base);
        transpose_matrix<0, false>(F, (const float*)(GAS const void*)Ap->in[I_DOUT] + (size_t)l * 512 * DM, 512, DM, (bf16*)(ws + WS_WOUT) + (size_t)(l * 4 + 3) * DM * 512, base);
        transpose_matrix<0, false>(F, (const float*)(GAS const void*)Ap->in[I_WO] + (size_t)l * DM * DM, DM, DM, (bf16*)(ws + WS_WO) + (size_t)l * DM * DM, base);
        transpose_matrix<0, false>(F, (const float*)(GAS const void*)Ap->in[I_PWQ] + (size_t)l * DM * 2048, DM, 2048, (bf16*)(ws + WS_WQ) + (size_t)l * 2048 * DM, base);
        transpose_matrix<0, true>(F, (const float*)(GAS const void*)Ap->in[I_CW1] + (size_t)(l * 2 + 0) * 2048 * 128, 2048, 128, (bf16*)(ws + WS_W1T) + (size_t)(l * 2 + 0) * 128 * 2048, base);
        transpose_matrix<0, false>(F, (const float*)(GAS const void*)Ap->in[I_CW1] + (size_t)(l * 2 + 1) * 2048 * 128, 2048, 128, (bf16*)(ws + WS_W1T) + (size_t)(l * 2 + 1) * 128 * 2048, base);
    }
    convert_copy(F, (const float*)(GAS const void*)Ap->in[I_PSUB], (bf16*)(ws + WS_SUBK), (size_t)DEPTH * 8 * 2 * 128 * 128);
    const int gt = F.bid * NTHR + F.tid, NGT_ = F.G * NTHR;
    { const float* w2 = (const float*)(GAS const void*)Ap->in[I_CW2]; bf16* w2t = (bf16*)(ws + WS_SMALL + SM_W2T);
      for (int i = gt; i < DEPTH * 2 * 64 * 128; i += NGT_) { const int k = i & 127, n = (i >> 7) & 63, lw = i >> 13; w2t[i] = (bf16)f2bf(w2[((size_t)lw * 128 + k) * 64 + n]); } }
    { const int* pos = (const int*)(GAS const void*)Ap->in[I_POS]; float* ct = (float*)(ws + WS_COS); float* st = (float*)(ws + WS_SIN);
      for (int i = gt; i < TOK * 32; i += NGT_) { const int t = i >> 5, j = i & 31;
          const float inv = 1.0f / powf(10000.0f, (float)(2 * j) / 64.0f); const float ang = (float)pos[t] * inv;
          ct[i] = (float)cos((double)ang); st[i] = (float)sin((double)ang); } }
    { const float* w1 = (const float*)(GAS const void*)Ap->in[I_CW1]; const float* cp = (const float*)(GAS const void*)Ap->in[I_CPOS]; float* pbp = (float*)(ws + WS_SMALL + SM_PBP);
      for (int i = gt; i < DEPTH * 2 * 16 * 128; i += NGT_) { const int n = i & 127, kc = (i >> 7) & 15, lw = i >> 11; float s = 0.f;
          for (int k = kc * 128; k < kc * 128 + 128; ++k) s += cp[(size_t)lw * 2048 + k] * w1[((size_t)lw * 2048 + k) * 128 + n];
          pbp[i] = s; } }
    __syncthreads();
    { LAS float* cond = (LAS float*)(F.lds);
      LAS float* red = (LAS float*)(F.lds + 32768);
      const float* c = (const float*)(GAS const void*)Ap->in[I_C];
      for (int i = F.tid; i < 8 * 1024; i += NTHR) { const float v = c[i]; cond[i] = v / (1.0f + __expf(-v)); }
      __syncthreads();
      for (int un = F.bid; un < DEPTH * 96; un += F.G) { const int l = un / 96, n0 = (un % 96) * 64;
          const float* mw = (const float*)(GAS const void*)Ap->in[I_MODW] + (size_t)l * DM * 6144 + n0 + F.lane;
          float acc[8];
#pragma unroll
          for (int b = 0; b < 8; ++b) acc[b] = 0.f;
#pragma unroll 4
          for (int k = F.wave * 128; k < F.wave * 128 + 128; ++k) { const float w = mw[(size_t)k * 6144];
#pragma unroll
              for (int b = 0; b < 8; ++b) acc[b] += cond[b * 1024 + k] * w; }
#pragma unroll
          for (int b = 0; b < 8; ++b) red[(F.wave * 8 + b) * 64 + F.lane] = acc[b];
          __syncthreads();
          { const int b = F.tid >> 6, n = F.tid & 63; float s = 0.f;
#pragma unroll
            for (int w = 0; w < 8; ++w) s += red[(w * 8 + b) * 64 + n];
            ((float*)(ws + WS_MOD))[((size_t)l * 8 + b) * 6144 + n0 + n] = s + ((const float*)(GAS const void*)Ap->in[I_MODB])[(size_t)l * 6144 + n0 + n]; }
          __syncthreads(); }
    }
}

__device__ __forceinline__ void phase_norm_mod(const Frame& F, const float* X, const float* g, const float* sh, const float* sc, bf16* O, unsigned char* O8 = nullptr, float* OS = nullptr) {
    const int gw = gwave(F), NGW = ngwave(F);
    f32x4 gv[4];
#pragma unroll
    for (int j = 0; j < 4; ++j) gv[j] = *(const f32x4*)(g + 4 * F.lane + 256 * j);
    for (int row = gw; row < TOK; row += NGW) {
        const int b = row / SEQ; const float* xr = X + (size_t)row * DM + 4 * F.lane;
        f32x4 v[4]; float s = 0.f;
#pragma unroll
        for (int j = 0; j < 4; ++j) { v[j] = *(const f32x4*)(xr + 256 * j); s += (v[j][0] * v[j][0] + v[j][1] * v[j][1]) + (v[j][2] * v[j][2] + v[j][3] * v[j][3]); }
        const float r = 1.0f / sqrtf(wave_sum(s, F.lane) * (1.0f / DM) + NORM_EPS);
        bf16* orow = O + (size_t)row * DM + 4 * F.lane;
#pragma unroll
        for (int j = 0; j < 4; ++j) { const f32x4 scv = *(const f32x4*)(sc + (size_t)b * 6144 + 4 * F.lane + 256 * j), shv = *(const f32x4*)(sh + (size_t)b * 6144 + 4 * F.lane + 256 * j);
            const f32x4 y = v[j] * r * gv[j] * (scv + 1.0f) + shv; v2u w; w.x = pk2(y[0], y[1]); w.y = pk2(y[2], y[3]); *(v2u*)(orow + 256 * j) = w; v[j] = y; }
        if (O8) {
            float mx = 0.f;
#pragma unroll
            for (int j = 0; j < 4; ++j) mx = fmaxf(fmaxf(mx, fmaxf(fabsf(v[j][0]), fabsf(v[j][1]))), fmaxf(fabsf(v[j][2]), fabsf(v[j][3])));
#pragma unroll
            for (int o = 1; o < 32; o <<= 1) mx = fmaxf(mx, shx(mx, o, F.lane));
            mx = max32(mx);
            int ex = 0; (void)frexpf(mx, &ex); const int k = (mx > 0.f) ? (8 - ex) : 0;
            const float s8 = __builtin_ldexpf(1.0f, k);
#pragma unroll
            for (int j = 0; j < 4; ++j) { unsigned p = 0u; p = __builtin_amdgcn_cvt_pk_fp8_f32(v[j][0] * s8, v[j][1] * s8, p, false); p = __builtin_amdgcn_cvt_pk_fp8_f32(v[j][2] * s8, v[j][3] * s8, p, true);
                *(unsigned*)(O8 + (size_t)row * DM + 4 * F.lane + 256 * j) = p; }
            if (F.lane == 0) OS[row] = __builtin_ldexpf(1.0f, -k);
        }
    }
}
__device__ __forceinline__ void phase_final_norm(const Frame& F, const float* X, const float* g, float* O) {
    const int gw = gwave(F), NGW = ngwave(F);
    f32x4 gv[4];
#pragma unroll
    for (int j = 0; j < 4; ++j) gv[j] = *(const f32x4*)(g + 4 * F.lane + 256 * j);
    for (int row = gw; row < TOK; row += NGW) {
        const float* xr = X + (size_t)row * DM + 4 * F.lane; f32x4 v[4]; float s = 0.f;
#pragma unroll
        for (int j = 0; j < 4; ++j) { v[j] = *(const f32x4*)(xr + 256 * j); s += (v[j][0] * v[j][0] + v[j][1] * v[j][1]) + (v[j][2] * v[j][2] + v[j][3] * v[j][3]); }
        const float r = 1.0f / sqrtf(wave_sum(s, F.lane) * (1.0f / DM) + NORM_EPS);
        float* orow = O + (size_t)row * DM + 4 * F.lane;
#pragma unroll
        for (int j = 0; j < 4; ++j) *(f32x4*)(orow + 256 * j) = v[j] * r * gv[j];
    }
}

__device__ __forceinline__ void phase_mixer_a(const Frame& F, const bf16* P, const float* cw  , bf16* O  ) {
    const int nth = F.G * NTHR, gt = F.bid * NTHR + F.tid;
    for (int it = gt; it < (TOK / 8) * 64; it += nth) {
        const int cg = it & 63, tb = it >> 6, c0 = cg * 8, t0 = tb * 8, s0 = t0 % SEQ;
        float w0[8], w1[8], w2[8];
#pragma unroll
        for (int e = 0; e < 8; ++e) { w0[e] = cw[c0 + e]; w1[e] = cw[512 + c0 + e]; w2[e] = cw[1024 + c0 + e]; }
        float pm2[8], pm1[8];
#pragma unroll
        for (int e = 0; e < 8; ++e) { pm2[e] = 0.f; pm1[e] = 0.f; }
        for (int pre = 2; pre >= 1; --pre) if (s0 - pre >= 0) { const bf16* r = P + (size_t)(t0 - pre) * NP1;
            const v4u ac = *(const v4u*)(r + C_AC + c0), ax = *(const v4u*)(r + C_AX + c0);
            float pr[8]; pr[0] = bflo(ac.x) * bflo(ax.x); pr[1] = bfhi(ac.x) * bfhi(ax.x); pr[2] = bflo(ac.y) * bflo(ax.y); pr[3] = bfhi(ac.y) * bfhi(ax.y);
            pr[4] = bflo(ac.z) * bflo(ax.z); pr[5] = bfhi(ac.z) * bfhi(ax.z); pr[6] = bflo(ac.w) * bflo(ax.w); pr[7] = bfhi(ac.w) * bfhi(ax.w);
#pragma unroll
            for (int e = 0; e < 8; ++e) { if (pre == 2) pm2[e] = pr[e]; else pm1[e] = pr[e]; } }
#pragma unroll
        for (int tt = 0; tt < 8; ++tt) { const bf16* r = P + (size_t)(t0 + tt) * NP1;
            const v4u ac = *(const v4u*)(r + C_AC + c0), ax = *(const v4u*)(r + C_AX + c0), ab = *(const v4u*)(r + C_AB + c0);
            float pr[8], bb[8], y[8];
            pr[0] = bflo(ac.x) * bflo(ax.x); pr[1] = bfhi(ac.x) * bfhi(ax.x); pr[2] = bflo(ac.y) * bflo(ax.y); pr[3] = bfhi(ac.y) * bfhi(ax.y);
            pr[4] = bflo(ac.z) * bflo(ax.z); pr[5] = bfhi(ac.z) * bfhi(ax.z); pr[6] = bflo(ac.w) * bflo(ax.w); pr[7] = bfhi(ac.w) * bfhi(ax.w);
            bb[0] = bflo(ab.x); bb[1] = bfhi(ab.x); bb[2] = bflo(ab.y); bb[3] = bfhi(ab.y); bb[4] = bflo(ab.z); bb[5] = bfhi(ab.z); bb[6] = bflo(ab.w); bb[7] = bfhi(ab.w);
#pragma unroll
            for (int e = 0; e < 8; ++e) { y[e] = bb[e] * (w0[e] * pm2[e] + w1[e] * pm1[e] + w2[e] * pr[e]); pm2[e] = pm1[e]; pm1[e] = pr[e]; }
            v4u o; o.x = pk2(y[0], y[1]); o.y = pk2(y[2], y[3]); o.z = pk2(y[4], y[5]); o.w = pk2(y[6], y[7]);
            *(v4u*)(O + (size_t)(t0 + tt) * 512 + c0) = o; }
    }
}

__device__ __forceinline__ void phase_mixer_b(const Frame& F, const bf16* P, const float* cw  , const float* cb, const float* lg, const float* lb, bf16* O) {
    LAS float* U = (LAS float*)F.lds;
    for (int un = F.bid; un < TOK / 32; un += F.G) {
        const int t0 = un * 32, s0 = t0 % SEQ;
        __syncthreads();
        for (int i = F.tid; i < 62 * 64; i += NTHR) { const int r = i >> 6, cg = i & 63, c0 = cg * 8; const int srel = s0 - 30 + r;
            float u[8];
            if (srel >= 0) { const bf16* row = P + (size_t)(t0 - 30 + r) * NP1; const v4u a = *(const v4u*)(row + C_BA + c0), g = *(const v4u*)(row + C_BG + c0);
                u[0] = bflo(a.x) * sigmoidf_(bflo(g.x)); u[1] = bfhi(a.x) * sigmoidf_(bfhi(g.x)); u[2] = bflo(a.y) * sigmoidf_(bflo(g.y)); u[3] = bfhi(a.y) * sigmoidf_(bfhi(g.y));
                u[4] = bflo(a.z) * sigmoidf_(bflo(g.z)); u[5] = bfhi(a.z) * sigmoidf_(bfhi(g.z)); u[6] = bflo(a.w) * sigmoidf_(bflo(g.w)); u[7] = bfhi(a.w) * sigmoidf_(bfhi(g.w)); }
            else {
#pragma unroll
                for (int e = 0; e < 8; ++e) u[e] = 0.f; }
            *(LAS f32x4*)(U + r * 512 + c0) = (f32x4){u[0], u[1], u[2], u[3]}; *(LAS f32x4*)(U + r * 512 + c0 + 4) = (f32x4){u[4], u[5], u[6], u[7]}; }
        __syncthreads();
        const int c0 = F.lane * 8;
        float acc[4][8];
#pragma unroll
        for (int q = 0; q < 4; ++q)
#pragma unroll
            for (int e = 0; e < 8; ++e) acc[q][e] = cb[c0 + e];
        for (int k = 0; k < 31; ++k) { const f32x4 wa = *(const f32x4*)(cw + k * 512 + c0), wb = *(const f32x4*)(cw + k * 512 + c0 + 4);
#pragma unroll
            for (int q = 0; q < 4; ++q) { const int r = 4 * F.wave + q + k; const f32x4 ua = *(LAS f32x4*)(U + r * 512 + c0), ub = *(LAS f32x4*)(U + r * 512 + c0 + 4);
                acc[q][0] += wa[0] * ua[0]; acc[q][1] += wa[1] * ua[1]; acc[q][2] += wa[2] * ua[2]; acc[q][3] += wa[3] * ua[3];
                acc[q][4] += wb[0] * ub[0]; acc[q][5] += wb[1] * ub[1]; acc[q][6] += wb[2] * ub[2]; acc[q][7] += wb[3] * ub[3]; } }
        const f32x4 ga = *(const f32x4*)(lg + c0), gb = *(const f32x4*)(lg + c0 + 4), ba = *(const f32x4*)(lb + c0), bb = *(const f32x4*)(lb + c0 + 4);
#pragma unroll
        for (int q = 0; q < 4; ++q) { float s = 0.f;
#pragma unroll
            for (int e = 0; e < 8; ++e) s += acc[q][e];
            const float mu = wave_sum(s, F.lane) * (1.0f / 512.0f); float v = 0.f;
#pragma unroll
            for (int e = 0; e < 8; ++e) { acc[q][e] -= mu; v += acc[q][e] * acc[q][e]; }
            const float rs = 1.0f / sqrtf(wave_sum(v, F.lane) * (1.0f / 512.0f) + NORM_EPS);
            float y[8];
#pragma unroll
            for (int e = 0; e < 8; ++e) { const float gg = e < 4 ? ga[e] : gb[e - 4], bv = e < 4 ? ba[e] : bb[e - 4]; const float z = acc[q][e] * rs * gg + bv; y[e] = z / (1.0f + __expf(-z)); }
            v4u o; o.x = pk2(y[0], y[1]); o.y = pk2(y[2], y[3]); o.z = pk2(y[4], y[5]); o.w = pk2(y[6], y[7]);
            *(v4u*)(O + (size_t)(t0 + 4 * F.wave + q) * 512 + c0) = o; }
    }
}

__device__ __forceinline__ void phase_compress(const Frame& F, const bf16* P, const bf16* W1T  , const bf16* W2T  , const float* PBP  ,
                                               bf16* KC, bf16* VC  ) {
    LAS float* PART = (LAS float*)F.lds;
    LAS bf16* H1 = (LAS bf16*)(F.lds + 69632);
    const int lane = F.lane, r16 = lane & 15, q4 = lane >> 4, w = F.wave;
    for (int un = F.bid; un < 2 * 8 * 2 * 8; un += F.G) {
        const int nb = un & 7, g = (un >> 3) & 1, b = (un >> 4) & 7, which = un >> 7;
        const int n = nb * 16 + r16; const int nn = n < 127 ? n : 126;
        const int col0 = (which == 0 ? C_KC : C_VC) + g * 64;
        const bf16* arow = P + ((size_t)b * SEQ + nn * 16) * NP1 + col0;
        const bf16* w1 = W1T + (size_t)which * 128 * 2048;
        f32x4 acc[8];
#pragma unroll
        for (int j = 0; j < 8; ++j) acc[j] = (f32x4){0.f, 0.f, 0.f, 0.f};
#pragma unroll
        for (int half = 0; half < 2; ++half) {
            bf16x8 a[4], bb[4][8];
#pragma unroll
            for (int s4 = 0; s4 < 4; ++s4) { const int k = w * 256 + (half * 4 + s4) * 32 + q4 * 8;
                a[s4] = *(const bf16x8*)(arow + (size_t)(k >> 6) * NP1 + (k & 63));
#pragma unroll
                for (int j = 0; j < 8; ++j) bb[s4][j] = *(const bf16x8*)(w1 + (size_t)(j * 16 + r16) * 2048 + k); }
#pragma unroll
            for (int s4 = 0; s4 < 4; ++s4)
#pragma unroll
                for (int j = 0; j < 8; ++j) acc[j] = __builtin_amdgcn_mfma_f32_16x16x32_bf16(a[s4], bb[s4][j], acc[j], 0, 0, 0);
        }
        __syncthreads();
#pragma unroll
        for (int j = 0; j < 8; ++j)
#pragma unroll
            for (int i = 0; i < 4; ++i) PART[(w * 16 + 4 * q4 + i) * 132 + j * 16 + r16] = acc[j][i];
        __syncthreads();
        {
            const int row = F.tid >> 5, c4 = (F.tid & 31) * 4;
            f32x4 sacc = (f32x4){0.f, 0.f, 0.f, 0.f};
#pragma unroll
            for (int ww = 0; ww < 8; ++ww) sacc += *(LAS f32x4*)(PART + (ww * 16 + row) * 132 + c4);
#pragma unroll
            for (int kc = 0; kc < 16; ++kc) sacc += *(const f32x4*)(PBP + ((size_t)which * 16 + kc) * 128 + c4);
            v2u o; o.x = pk2(gelu_erf(sacc[0]), gelu_erf(sacc[1])); o.y = pk2(gelu_erf(sacc[2]), gelu_erf(sacc[3]));
            *(LAS v2u*)(H1 + row * 136 + c4) = o;
        }
        __syncthreads();
        if (w < 4) {
            f32x4 o = (f32x4){0.f, 0.f, 0.f, 0.f};
            const bf16* w2 = W2T + (size_t)which * 64 * 128;
#pragma unroll
            for (int ks = 0; ks < 4; ++ks) { const bf16x8 a = *(LAS bf16x8*)(H1 + r16 * 136 + ks * 32 + q4 * 8);
                const bf16x8 bb = *(const bf16x8*)(w2 + (size_t)(w * 16 + r16) * 128 + ks * 32 + q4 * 8);
                o = __builtin_amdgcn_mfma_f32_16x16x32_bf16(a, bb, o, 0, 0, 0); }
            bf16* out = (which == 0 ? KC : VC) + ((size_t)(b * 2 + g) * 128) * 64;
#pragma unroll
            for (int i = 0; i < 4; ++i) { const int row = nb * 16 + 4 * q4 + i; out[(size_t)row * 64 + w * 16 + r16] = row < 127 ? (bf16)f2bf(o[i]) : (bf16)0; }
        }
    }
    __syncthreads();
}
__device__ __forceinline__ void phase_kmean(const Frame& F, const bf16* P, float* KM) {
    const int gw = gwave(F), NGW = ngwave(F), lane = F.lane, rs = lane >> 3, ch = lane & 7;
    for (int un = gw; un < 8 * 8 * 8; un += NGW) { const int h = un & 7, blk = (un >> 3) & 7, b = un >> 6;
        const bf16* base = P + ((size_t)b * SEQ + blk * 256) * NP1 + C_DK + h * 64 + ch * 8;
        float s[8];
#pragma unroll
        for (int e = 0; e < 8; ++e) s[e] = 0.f;
#pragma unroll 8
        for (int i = 0; i < 32; ++i) { const v4u v = *(const v4u*)(base + (size_t)(i * 8 + rs) * NP1);
            s[0] += bflo(v.x); s[1] += bfhi(v.x); s[2] += bflo(v.y); s[3] += bfhi(v.y); s[4] += bflo(v.z); s[5] += bfhi(v.z); s[6] += bflo(v.w); s[7] += bfhi(v.w); }
#pragma unroll
        for (int e = 0; e < 8; ++e) { s[e] += shx(s[e], 8, lane); s[e] += shx(s[e], 16, lane); s[e] = add32(s[e]); }
        if (rs == 0) { float* o = KM + ((size_t)(b * 8 + blk) * 8 + h) * 64 + ch * 8;
            *(f32x4*)o = (f32x4){s[0], s[1], s[2], s[3]} * (1.0f / 256.0f); *(f32x4*)(o + 4) = (f32x4){s[4], s[5], s[6], s[7]} * (1.0f / 256.0f); }
    }
}

constexpr int KT_STRIDE = 144, VT_STRIDE = 192, KT_BYTES = 64 * KT_STRIDE, VT_BYTES = 64 * VT_STRIDE, KV_BUF = KT_BYTES + VT_BYTES;
__device__ __forceinline__ int crow(int r, int hi) { return (r & 3) + 8 * (r >> 2) + 4 * hi; }
struct AttnState { float m, l; f32x16 o0, o1; };
__device__ __forceinline__ void attn_reset(AttnState& st) { st.m = -1e30f; st.l = 0.f;
#pragma unroll
    for (int r = 0; r < 16; ++r) { st.o0[r] = 0.f; st.o1[r] = 0.f; } }
__device__ __forceinline__ s16x4 vtr(LAS const unsigned char* p) { return __builtin_bit_cast(s16x4, __builtin_amdgcn_ds_read_tr16_b64_v4i16((LAS s16x4*)p)); }

__device__ __forceinline__ void attn_scores(LAS const unsigned char* Kt, const bf16x8 (&qr)[4], f32x16& p0, f32x16& p1, int lane) {
    const int r32 = lane & 31, hi = lane >> 5;
#pragma unroll
    for (int r = 0; r < 16; ++r) { p0[r] = 0.f; p1[r] = 0.f; }
#pragma unroll
    for (int s = 0; s < 4; ++s) {
        const bf16x8 a0 = *(LAS const bf16x8*)(Kt + r32 * KT_STRIDE + (2 * s + hi) * 16), a1 = *(LAS const bf16x8*)(Kt + (32 + r32) * KT_STRIDE + (2 * s + hi) * 16);
        p0 = __builtin_amdgcn_mfma_f32_32x32x16_bf16(a0, qr[s], p0, 0, 0, 0);
        p1 = __builtin_amdgcn_mfma_f32_32x32x16_bf16(a1, qr[s], p1, 0, 0, 0);
    }
}
__device__ __forceinline__ void attn_pv(LAS const unsigned char* Vt, const f32x16& e0, const f32x16& e1, f32x16& o0, f32x16& o1, int lane) {
    const int hi = lane >> 5;
    LAS const unsigned char* vb = Vt + (4 * hi + ((lane & 15) >> 2)) * VT_STRIDE + (((lane >> 4) & 1) * 16 + 4 * (lane & 3)) * 2;
#pragma unroll
    for (int s = 0; s < 4; ++s) {
        v4u pw;
        if (s < 2) { pw.x = pk2(e0[8 * s + 0], e0[8 * s + 1]); pw.y = pk2(e0[8 * s + 2], e0[8 * s + 3]); pw.z = pk2(e0[8 * s + 4], e0[8 * s + 5]); pw.w = pk2(e0[8 * s + 6], e0[8 * s + 7]); }
        else { const int t = s - 2; pw.x = pk2(e1[8 * t + 0], e1[8 * t + 1]); pw.y = pk2(e1[8 * t + 2], e1[8 * t + 3]); pw.z = pk2(e1[8 * t + 4], e1[8 * t + 5]); pw.w = pk2(e1[8 * t + 6], e1[8 * t + 7]); }
        const bf16x8 pb = __builtin_bit_cast(bf16x8, pw);
#pragma unroll
        for (int db = 0; db < 2; ++db) {
            const s16x4 lo = vtr(vb + (16 * s) * VT_STRIDE + db * 64), hh = vtr(vb + (16 * s + 8) * VT_STRIDE + db * 64);
            const bf16x8 a = (bf16x8){lo[0], lo[1], lo[2], lo[3], hh[0], hh[1], hh[2], hh[3]};
            if (db == 0) o0 = __builtin_amdgcn_mfma_f32_32x32x16_bf16(a, pb, o0, 0, 0, 0); else o1 = __builtin_amdgcn_mfma_f32_32x32x16_bf16(a, pb, o1, 0, 0, 0);
        }
    }
}
__device__ __forceinline__ float max3f(float a, float b, float c) { float r; asm("v_max3_f32 %0, %1, %2, %3" : "=v"(r) : "v"(a), "v"(b), "v"(c)); return r; }
__device__ __forceinline__ float mask_score(float v, int a, int b, int c) {
    const unsigned sg = (unsigned)(((a + c) | (b - c)) >> 31);
    return __builtin_bit_cast(float, (__builtin_bit_cast(unsigned, v) & ~sg) | (0xf149f2cau & sg));
}
#ifndef ATT_DBG
#define ATT_DBG 0
#endif
__device__ __forceinline__ void attn_tile(LAS const unsigned char* Kt, LAS const unsigned char* Vt, const bf16x8 (&qr)[4], AttnState& st, int kmin, int kmax, int lane, bool dbg = false) {
    const int hi = lane >> 5;
    if (ATT_DBG == 3 && dbg) return;
    if (ATT_DBG == 1 && dbg) { f32x16 p0, p1; attn_scores(Kt, qr, p0, p1, lane); attn_pv(Vt, p0, p1, st.o0, st.o1, lane); return; }
    if (ATT_DBG == 2 && dbg) { f32x16 p0, p1; attn_scores(Kt, qr, p0, p1, lane);
#pragma unroll
        for (int r = 0; r < 16; ++r) { st.o0[r] += p0[r]; st.o1[r] += p1[r]; } return; }
    f32x16 p0, p1; attn_scores(Kt, qr, p0, p1, lane);
    if (!__all(kmin <= 0 && kmax >= 63)) {
        const int a = 4 * hi - kmin, b = kmax - 4 * hi;
#pragma unroll
        for (int r = 0; r < 16; ++r) { const int c = (r & 3) + 8 * (r >> 2); p0[r] = mask_score(p0[r], a, b, c); p1[r] = mask_score(p1[r], a, b, c + 32); }
    }
    asm volatile("s_nop 15\n\ts_nop 7" : "+v"(p0), "+v"(p1));
    float mx = max3f(p0[0], p0[1], p1[0]), mx2 = max3f(p0[2], p0[3], p1[1]);
    mx = max3f(mx, p1[2], p1[3]);
#pragma unroll
    for (int r = 4; r < 16; r += 4) { mx = max3f(mx, p0[r], p0[r + 1]); mx2 = max3f(mx2, p0[r + 2], p0[r + 3]); mx = max3f(mx, p1[r], p1[r + 1]); mx2 = max3f(mx2, p1[r + 2], p1[r + 3]); }
    mx = max3f(mx, mx2, mx2);
    mx = max32(mx);
    const float mn = fmaxf(st.m, mx), me = fmaxf(mn, -1e29f), alpha = __builtin_amdgcn_exp2f(st.m - me);
    float rs = 0.f;
#pragma unroll
    for (int r = 0; r < 16; ++r) { p0[r] = __builtin_amdgcn_exp2f(p0[r] - me); p1[r] = __builtin_amdgcn_exp2f(p1[r] - me); rs += p0[r] + p1[r]; }
    st.m = mn; st.l = st.l * alpha + rs;
    if (__any(alpha < 1.0f)) {
#pragma unroll
        for (int r = 0; r < 16; ++r) { st.o0[r] *= alpha; st.o1[r] *= alpha; }
    }
    attn_pv(Vt, p0, p1, st.o0, st.o1, lane);
}
struct KVRegs { v4u k, v; };
__device__ __forceinline__ void kv_load(KVRegs& r, const bf16* Kg, const bf16* Vg, size_t ld, int tid) {
    const int key = tid >> 3, ch = tid & 7;
    r.k = *(const v4u*)(Kg + (size_t)key * ld + ch * 8); r.v = *(const v4u*)(Vg + (size_t)key * ld + ch * 8);
}
__device__ __forceinline__ void kv_store(const KVRegs& r, LAS unsigned char* buf, int tid) {
    const int key = tid >> 3, ch = tid & 7;
    *(LAS v4u*)(buf + key * KT_STRIDE + ch * 16) = r.k; *(LAS v4u*)(buf + KT_BYTES + key * VT_STRIDE + ch * 16) = r.v;
}

__device__ __forceinline__ float attn_inv_l(const AttnState& st) { const float l = add32(st.l); return 1.0f / fmaxf(l, 1e-30f); }

#define ATTN_STREAM(Kg, Vg, ld, j0, j1, SKIP, RANGE) do { \
    int jn_ = (j0); while (jn_ < (j1) && (SKIP(jn_))) ++jn_; \
    if (jn_ < (j1)) { KVRegs kv_; kv_load(kv_, (Kg) + (size_t)jn_ * 64 * (ld), (Vg) + (size_t)jn_ * 64 * (ld), (ld), F.tid); \
        __syncthreads(); kv_store(kv_, ring, F.tid); int cur_ = 0; \
        for (;;) { const int j_ = jn_; ++jn_; while (jn_ < (j1) && (SKIP(jn_))) ++jn_; const bool more_ = jn_ < (j1); \
            if (more_) kv_load(kv_, (Kg) + (size_t)jn_ * 64 * (ld), (Vg) + (size_t)jn_ * 64 * (ld), (ld), F.tid); \
            __syncthreads(); \
            { int kmin_, kmax_; RANGE(j_, kmin_, kmax_); \
              if (__any(kmax_ >= kmin_)) attn_tile(ring + cur_ * KV_BUF, ring + cur_ * KV_BUF + KT_BYTES, qr, st, kmin_, kmax_, F.lane, dbgflag); } \
            if (!more_) break; \
            kv_store(kv_, ring + (cur_ ^ 1) * KV_BUF, F.tid); cur_ ^= 1; } } } while (0)

__device__ __forceinline__ void nsa_unit(const Frame& F, const bf16* P, const bf16* KC, const bf16* VC, bf16* O  , int b, int g, int i) {
    const bool dbgflag = false;
    LAS unsigned char* ring = F.lds;
    LAS float* impb = (LAS float*)(F.lds + 2 * KV_BUF);
    LAS unsigned* selm = (LAS unsigned*)(F.lds + 2 * KV_BUF + 33792);
    LAS float* stash = (LAS float*)(F.lds + 2 * KV_BUF + 33792 + 256) + F.tid;
    const int lane = F.lane, r32 = lane & 31, hi = lane >> 5, hr = F.wave & 3, th = F.wave >> 2;
    const int tl = 32 * th + r32;
    const int s = 64 * i + tl;
    const size_t row = (size_t)b * SEQ + s;
    const int head = g * 4 + hr;
    bf16x8 qr[4];
#pragma unroll
    for (int d = 0; d < 4; ++d) qr[d] = *(const bf16x8*)(P + row * NP1 + C_CQ + head * 64 + d * 16 + hi * 8);
    const float g0 = sigmoidf_(bf2f(P[row * NP1 + C_CG + head])), g1 = sigmoidf_(bf2f(P[row * NP1 + C_CG + 8 + head])), g2 = sigmoidf_(bf2f(P[row * NP1 + C_CG + 16 + head]));
    AttnState st;
    {
        const bf16* Kg = KC + (size_t)(b * 2 + g) * 128 * 64; const bf16* Vg = VC + (size_t)(b * 2 + g) * 128 * 64;
        const int nmax = (s >= 31) ? ((s - 31) >> 4) : -1;
        { KVRegs kv0, kv1; kv_load(kv0, Kg, Vg, 64, F.tid); kv_load(kv1, Kg + 64 * 64, Vg + 64 * 64, 64, F.tid);
          __syncthreads();
          kv_store(kv0, ring, F.tid); kv_store(kv1, ring + KV_BUF, F.tid); }
        __syncthreads();
        attn_reset(st);
        attn_tile(ring, ring + KT_BYTES, qr, st, 0, nmax < 63 ? nmax : 63, lane);
        attn_tile(ring + KV_BUF, ring + KV_BUF + KT_BYTES, qr, st, 0, nmax - 64 < 63 ? nmax - 64 : 63, lane);
        const float inv = attn_inv_l(st);
        { const float sc = g0 * inv;
#pragma unroll
          for (int r = 0; r < 16; ++r) { stash[r * 512] = st.o0[r] * sc; stash[(16 + r) * 512] = st.o1[r] * sc; } }
        if (i >= 16) {
            float xprev = 0.f; const float mfin = st.m;
#define NSA_IMP(U, ACC, GQ) do { const float G_ = ((ACC[4 * (GQ)] + ACC[4 * (GQ) + 1]) + (ACC[4 * (GQ) + 2] + ACC[4 * (GQ) + 3])), L_ = ACC[4 * (GQ) + 3]; \
                const float x_ = other32(L_, hi); impb[(hr * 64 + tl) * 33 + 2 * (U) + hi] = G_ + (hi ? x_ : xprev); xprev = x_; } while (0)
#pragma unroll
            for (int tile = 0; tile < 2; ++tile) {
                f32x16 a0, a1; attn_scores(ring + tile * KV_BUF, qr, a0, a1, lane);
#pragma unroll
                for (int r = 0; r < 16; ++r) { const int c = (r & 3) + 8 * (r >> 2);
                    a0[r] = __builtin_amdgcn_exp2f(mask_score(a0[r], 4 * hi, nmax - 64 * tile - 4 * hi, c) - mfin) * inv; a1[r] = __builtin_amdgcn_exp2f(mask_score(a1[r], 4 * hi, nmax - 64 * tile - 4 * hi, c + 32) - mfin) * inv; }
                NSA_IMP(8 * tile + 0, a0, 0); NSA_IMP(8 * tile + 1, a0, 1); NSA_IMP(8 * tile + 2, a0, 2); NSA_IMP(8 * tile + 3, a0, 3);
                NSA_IMP(8 * tile + 4, a1, 0); NSA_IMP(8 * tile + 5, a1, 1); NSA_IMP(8 * tile + 6, a1, 2); NSA_IMP(8 * tile + 7, a1, 3);
            }
#undef NSA_IMP
        }
    }
    __syncthreads();
    unsigned mymask;
    if (i < 16) mymask = (2u << i) - 1u;
    else {
        { const int tk = F.tid >> 3, js = F.tid & 7; unsigned bits = 0u;
          float v[4];
#pragma unroll
          for (int e = 0; e < 4; ++e) { const int j = js * 4 + e; v[e] = (impb[(0 * 64 + tk) * 33 + j] + impb[(1 * 64 + tk) * 33 + j]) + (impb[(2 * 64 + tk) * 33 + j] + impb[(3 * 64 + tk) * 33 + j]); }
          int rank[4] = {0, 0, 0, 0};
          for (int jj = 1; jj <= i - 2; ++jj) { const float o = (impb[(0 * 64 + tk) * 33 + jj] + impb[(1 * 64 + tk) * 33 + jj]) + (impb[(2 * 64 + tk) * 33 + jj] + impb[(3 * 64 + tk) * 33 + jj]);
#pragma unroll
              for (int e = 0; e < 4; ++e) { const int j = js * 4 + e; rank[e] += (o > v[e] || (o == v[e] && jj < j)) ? 1 : 0; } }
#pragma unroll
          for (int e = 0; e < 4; ++e) { const int j = js * 4 + e; const bool forced = (j == 0) || (j == i) || (j == i - 1); const bool cand = (j >= 1) && (j <= i - 2);
              if (forced || (cand && rank[e] < 13)) bits |= 1u << j; }
          bits |= shxu(bits, 1, F.lane); bits |= shxu(bits, 2, F.lane); bits |= shxu(bits, 4, F.lane);
          if (js == 0) selm[tk] = bits; }
        __syncthreads();
        mymask = selm[tl];
    }
    {
        attn_reset(st);
        const bf16* Kg = P + (size_t)b * SEQ * NP1 + C_KS + g * 64; const bf16* Vg = P + (size_t)b * SEQ * NP1 + C_VS + g * 64;
#define NSA_SKIP(j) (false)
#define NSA_RANGE(j, kmin, kmax) do { kmin = 0; kmax = ((mymask >> (j)) & 1u) ? ((j) == i ? tl : 63) : -1; } while (0)
        ATTN_STREAM(Kg, Vg, (size_t)NP1, 0, i + 1, NSA_SKIP, NSA_RANGE);
#undef NSA_RANGE
        const float sc = g1 * attn_inv_l(st);
#pragma unroll
        for (int r = 0; r < 16; ++r) { stash[r * 512] += st.o0[r] * sc; stash[(16 + r) * 512] += st.o1[r] * sc; }
    }
    {
        attn_reset(st);
        const bf16* Kg = P + (size_t)b * SEQ * NP1 + C_KW + g * 64; const bf16* Vg = P + (size_t)b * SEQ * NP1 + C_VW + g * 64;
        const int jlo = i >= 8 ? i - 8 : 0; f32x16 out0, out1;
#define NSA_RANGE(j, kmin, kmax) do { const int d_ = 64 * (i - (j)) + tl; kmin = d_ - 511 > 0 ? d_ - 511 : 0; kmax = d_ < 63 ? d_ : 63; } while (0)
        ATTN_STREAM(Kg, Vg, (size_t)NP1, jlo, i + 1, NSA_SKIP, NSA_RANGE);
#undef NSA_RANGE
#undef NSA_SKIP
        const float sc = g2 * attn_inv_l(st);
#pragma unroll
        for (int r = 0; r < 16; ++r) { out0[r] = stash[r * 512] + st.o0[r] * sc; out1[r] = stash[(16 + r) * 512] + st.o1[r] * sc; }
        bf16* orow = O + row * 512 + head * 64;
#pragma unroll
        for (int gq = 0; gq < 4; ++gq) {
            v2u w0; w0.x = pk2(out0[4 * gq], out0[4 * gq + 1]); w0.y = pk2(out0[4 * gq + 2], out0[4 * gq + 3]); *(v2u*)(orow + 8 * gq + 4 * hi) = w0;
            v2u w1; w1.x = pk2(out1[4 * gq], out1[4 * gq + 1]); w1.y = pk2(out1[4 * gq + 2], out1[4 * gq + 3]); *(v2u*)(orow + 32 + 8 * gq + 4 * hi) = w1; }
    }
}
__device__ __forceinline__ void phase_nsa(const Frame& F, const bf16* P, const bf16* KC, const bf16* VC, bf16* O) {
    for (int un2 = 2 * F.bid; un2 < 512; un2 += 2 * F.G)
#pragma unroll 1
        for (int k = 0; k < 2; ++k) { const int un = un2 >> 1, ip = un & 15, g = (un >> 4) & 1, b = un >> 5; nsa_unit(F, P, KC, VC, O, b, g, k == 0 ? 31 - ip : ip); }
}

__device__ __forceinline__ void moba_unit(const Frame& F, const bf16* P, const float* KM, bf16* O  , int b, int h, int qb, bool dbgflag = false) {
    LAS unsigned char* ring = F.lds;
    LAS float* kml = (LAS float*)(F.lds + 2 * KV_BUF);
    LAS unsigned* uni = (LAS unsigned*)(F.lds + 2 * KV_BUF + 2048);
    const int lane = F.lane, r32 = lane & 31, hi = lane >> 5;
    const int tl = 32 * F.wave + r32;
    const size_t row = (size_t)b * SEQ + 256 * qb + tl;
    bf16x8 qr[4];
#pragma unroll
    for (int d = 0; d < 4; ++d) qr[d] = *(const bf16x8*)(P + row * NP1 + C_DQ + h * 64 + d * 16 + hi * 8);
    __syncthreads();
    { const int blk = F.tid >> 6, p = F.tid & 63; kml[F.tid] = KM[((size_t)(b * 8 + blk) * 8 + h) * 64 + p]; if (F.tid == 0) uni[0] = 0u; }
    __syncthreads();
    unsigned mymask = 0u;
    if (qb > 0) {
        float gt[8];
#pragma unroll
        for (int n = 0; n < 8; ++n) { float a = 0.f;
#pragma unroll
            for (int d = 0; d < 4; ++d) { const v4u qw = __builtin_bit_cast(v4u, qr[d]); const LAS float* km = kml + n * 64 + d * 16 + hi * 8;
                a += bflo(qw.x) * km[0] + bfhi(qw.x) * km[1] + bflo(qw.y) * km[2] + bfhi(qw.y) * km[3] + bflo(qw.z) * km[4] + bfhi(qw.z) * km[5] + bflo(qw.w) * km[6] + bfhi(qw.w) * km[7]; }
            a = add32(a); gt[n] = a; }
#pragma unroll
        for (int n = 0; n < 8; ++n) { int rank = 0;
#pragma unroll
            for (int m = 0; m < 8; ++m) rank += (m < qb && m != n && (gt[m] > gt[n] || (gt[m] == gt[n] && m < n))) ? 1 : 0;
            if (n < qb && rank < 3) mymask |= 1u << n; }
        atomicOr((unsigned*)uni, mymask);
    }
    __syncthreads();
    const unsigned um = uni[0];
    AttnState st; attn_reset(st);
    const bf16* Kg = P + (size_t)b * SEQ * NP1 + C_DK + h * 64; const bf16* Vg = P + (size_t)b * SEQ * NP1 + C_DV + h * 64;
#define MOBA_SKIP(j) ((j) < 4 * qb && !((um >> ((j) >> 2)) & 1u))
#define MOBA_RANGE(j, kmin, kmax) do { kmin = 0; if ((j) < 4 * qb) kmax = ((mymask >> ((j) >> 2)) & 1u) ? 63 : -1; else { const int d_ = tl - 64 * ((j) - 4 * qb); kmax = d_ < 63 ? d_ : 63; } } while (0)
    ATTN_STREAM(Kg, Vg, (size_t)NP1, 0, 4 * qb + 4, MOBA_SKIP, MOBA_RANGE);
#undef MOBA_SKIP
#undef MOBA_RANGE
    const float sc = attn_inv_l(st);
    bf16* orow = O + row * 512 + h * 64;
#pragma unroll
    for (int gq = 0; gq < 4; ++gq) {
        v2u w0; w0.x = pk2(st.o0[4 * gq] * sc, st.o0[4 * gq + 1] * sc); w0.y = pk2(st.o0[4 * gq + 2] * sc, st.o0[4 * gq + 3] * sc); *(v2u*)(orow + 8 * gq + 4 * hi) = w0;
        v2u w1; w1.x = pk2(st.o1[4 * gq] * sc, st.o1[4 * gq + 1] * sc); w1.y = pk2(st.o1[4 * gq + 2] * sc, st.o1[4 * gq + 3] * sc); *(v2u*)(orow + 32 + 8 * gq + 4 * hi) = w1; }
}
__device__ __forceinline__ void phase_moba(const Frame& F, const bf16* P, const float* KM, bf16* O, bool dbgflag = false) {
    for (int un2 = 2 * F.bid; un2 < 512; un2 += 2 * F.G)
#pragma unroll 1
        for (int k = 0; k < 2; ++k) { const int un = un2 >> 1, qp = un & 3, h = (un >> 2) & 7, b = un >> 5; moba_unit(F, P, KM, O, b, h, k == 0 ? 7 - qp : qp, dbgflag); }
}

__device__ __forceinline__ unsigned ord_key(float x) { const unsigned u = __builtin_bit_cast(unsigned, x); return (u & 0x80000000u) ? ~u : (u | 0x80000000u); }
__device__ __forceinline__ float ord_val(unsigned k) { const unsigned u = (k & 0x80000000u) ? (k & 0x7fffffffu) : ~k; return __builtin_bit_cast(float, u); }
__device__ __forceinline__ void ce_desc(unsigned& a, unsigned& b) { const unsigned hi_ = a > b ? a : b, lo_ = a > b ? b : a; a = hi_; b = lo_; }
__device__ __forceinline__ void bitonic_merge16_desc(unsigned* a) {
#pragma unroll
    for (int j = 8; j > 0; j >>= 1)
#pragma unroll
        for (int i = 0; i < 16; ++i) if ((i & j) == 0) ce_desc(a[i], a[i | j]);
}
__device__ __forceinline__ void bitonic_sort16_desc(unsigned* a) {
#pragma unroll
    for (int k = 2; k <= 16; k <<= 1)
#pragma unroll
        for (int j = k >> 1; j > 0; j >>= 1)
#pragma unroll
            for (int i = 0; i < 16; ++i) { const int l = i ^ j; if (l > i) { if ((i & k) == 0) ce_desc(a[i], a[l]); else ce_desc(a[l], a[i]); } }
}
__device__ __forceinline__ void merge_top16(unsigned* a, const unsigned* b) {
#pragma unroll
    for (int i = 0; i < 16; ++i) a[i] = a[i] > b[15 - i] ? a[i] : b[15 - i];
    bitonic_merge16_desc(a);
}
constexpr int SK_STRIDE = 272;
__device__ __forceinline__ void peer_route_unit(const Frame& F, const bf16* Q2, const bf16* SUBK  , int* EIDX, float* EW, int tb, int h) {
    LAS unsigned char* skl = F.lds;
    LAS unsigned* slot = (LAS unsigned*)(F.lds + 36864) + F.tid;
    const int lane = F.lane, r32 = lane & 31, hi = lane >> 5;
    const size_t tok = (size_t)tb * 256 + F.wave * 32 + r32;
#pragma unroll 1
    for (int p = 0; p < 2; ++p) {
        __syncthreads();
        for (int i = F.tid; i < 128 * 16; i += NTHR) { const int ch = i & 15, rowi = i >> 4;
            *(LAS v4u*)(skl + rowi * SK_STRIDE + ch * 16) = *(const v4u*)(SUBK + ((size_t)h * 256 + p * 128 + rowi) * 128 + ch * 8); }
        __syncthreads();
        bf16x8 qf[8]; float ss = 0.f;
#pragma unroll
        for (int s = 0; s < 8; ++s) { qf[s] = *(const bf16x8*)(Q2 + tok * 2048 + h * 256 + p * 128 + s * 16 + hi * 8); const v4u w = __builtin_bit_cast(v4u, qf[s]);
            const float a0 = bflo(w.x), a1 = bfhi(w.x), a2 = bflo(w.y), a3 = bfhi(w.y), a4 = bflo(w.z), a5 = bfhi(w.z), a6 = bflo(w.w), a7 = bfhi(w.w);
            ss += (a0 * a0 + a1 * a1) + (a2 * a2 + a3 * a3) + (a4 * a4 + a5 * a5) + (a6 * a6 + a7 * a7); }
        ss = add32(ss);
        const float rn = 1.0f / sqrtf(ss * (1.0f / 128.0f) + NORM_EPS);
        unsigned key[64];
#pragma unroll
        for (int nb = 0; nb < 4; ++nb) { f32x16 acc;
#pragma unroll
            for (int r = 0; r < 16; ++r) acc[r] = 0.f;
#pragma unroll
            for (int s = 0; s < 8; ++s) { const bf16x8 a = *(LAS const bf16x8*)(skl + (nb * 32 + r32) * SK_STRIDE + (2 * s + hi) * 16);
                acc = __builtin_amdgcn_mfma_f32_32x32x16_bf16(a, qf[s], acc, 0, 0, 0); }
#pragma unroll
            for (int r = 0; r < 16; ++r) { const int n = nb * 32 + crow(r, hi); key[nb * 16 + r] = (ord_key(acc[r] * rn) & 0xffffff80u) | (unsigned)(127 - n); } }
#pragma unroll
        for (int blk = 0; blk < 4; ++blk) bitonic_sort16_desc(key + 16 * blk);
        merge_top16(key, key + 16); merge_top16(key + 32, key + 48); merge_top16(key, key + 32);
        { unsigned oth[16];
#pragma unroll
          for (int i = 0; i < 16; ++i) { unsigned r0, r1; swap32(key[i], r0, r1); oth[i] = hi ? r0 : r1; }
          merge_top16(key, oth); }
#pragma unroll
        for (int k = 0; k < 16; ++k) slot[(p * 16 + k) * 512] = key[k];
    }
    LDS_WAIT(); asm volatile("" ::: "memory");
    unsigned ck[64];
    { float v1[16], v2[16];
#pragma unroll
      for (int k = 0; k < 16; ++k) { v1[k] = ord_val(slot[k * 512] & 0xffffff80u); v2[k] = ord_val(slot[(16 + k) * 512] & 0xffffff80u); }
      int c = 0;
#pragma unroll
      for (int a = 0; a < 16; ++a)
#pragma unroll
          for (int bq = 0; bq < 16; ++bq) if ((a + 1) * (bq + 1) <= 16) { ck[c] = (ord_key(v1[a] + v2[bq]) & 0xffffff00u) | (unsigned)(255 - (16 * a + bq)); ++c; }
#pragma unroll
      for (int q = 50; q < 64; ++q) ck[q] = 0u; }
#pragma unroll
    for (int blk = 0; blk < 4; ++blk) bitonic_sort16_desc(ck + 16 * blk);
    merge_top16(ck, ck + 16); merge_top16(ck + 32, ck + 48); merge_top16(ck, ck + 32);
    float den = 0.f; const float mx = ord_val(ck[0] & 0xffffff00u);
#pragma unroll
    for (int k = 0; k < 16; ++k) { const unsigned m = ck[k];
        const int ci = 255 - (int)(m & 255u), a = ci >> 4, bq = ci & 15;
        const unsigned ka = slot[a * 512], kb = slot[(16 + bq) * 512];
        const int te = (127 - (int)(ka & 127u)) * 128 + (127 - (int)(kb & 127u));
        const float ek = __expf(ord_val(m & 0xffffff00u) - mx); den += ek;
        slot[(32 + k) * 512] = __builtin_bit_cast(unsigned, ek);
        if (hi == 0) EIDX[(tok * 8 + h) * 16 + k] = te; }
    LDS_WAIT(); asm volatile("" ::: "memory");
    if (hi == 0) { const float inv = 1.0f / den; float* ewp = EW + (tok * 8 + h) * 16;
#pragma unroll
        for (int q = 0; q < 4; ++q) *(f32x4*)(ewp + 4 * q) = (f32x4){__builtin_bit_cast(float, slot[(32 + 4 * q) * 512]), __builtin_bit_cast(float, slot[(33 + 4 * q) * 512]),
                                                                      __builtin_bit_cast(float, slot[(34 + 4 * q) * 512]), __builtin_bit_cast(float, slot[(35 + 4 * q) * 512])} * inv; }
}

__device__ __forceinline__ void phase_peer_route(const Frame& F, const bf16* Q2, const bf16* SUBK, int* EIDX, float* EW) {
    for (int un = F.bid; un < 64 * 8; un += F.G) peer_route_unit(F, Q2, SUBK, EIDX, EW, un >> 3, un & 7);
}

__device__ __forceinline__ void phase_peer_tables(const Frame& F, const float* U, const float* V, unsigned char* UT8, unsigned char* VT8, float* SU, float* SV) {
    const int gw = gwave(F), NGW = ngwave(F), lane = F.lane;
    for (int r = gw; r < 2 * 16384; r += NGW) {
        const int tab = r >> 14, e = r & 16383; const float* src = (tab ? V : U) + (size_t)e * DM + 16 * lane;
        f32x4 x[4]; float mx = 0.f;
#pragma unroll
        for (int q = 0; q < 4; ++q) { x[q] = *(const f32x4*)(src + 4 * q); mx = fmaxf(fmaxf(mx, fmaxf(fabsf(x[q][0]), fabsf(x[q][1]))), fmaxf(fabsf(x[q][2]), fabsf(x[q][3]))); }
#pragma unroll
        for (int o = 1; o < 32; o <<= 1) mx = fmaxf(mx, shx(mx, o, lane));
        mx = max32(mx);
        int ex = 0; (void)frexpf(mx, &ex);
        const int k = (mx > 0.f) ? (8 - ex) : 0;
        const float sc = __builtin_ldexpf(1.0f, k), inv = __builtin_ldexpf(1.0f, -k);
        v4u w;
#pragma unroll
        for (int q = 0; q < 4; ++q) { unsigned p = 0u; p = __builtin_amdgcn_cvt_pk_fp8_f32(x[q][0] * sc, x[q][1] * sc, p, false); p = __builtin_amdgcn_cvt_pk_fp8_f32(x[q][2] * sc, x[q][3] * sc, p, true); w[q] = p; }
        *(v4u*)((tab ? VT8 : UT8) + ((size_t)(lane >> 3) * 16384 + e) * 128 + (lane & 7) * 16) = w;
        if (lane == 0) (tab ? SV : SU)[e] = inv;
    }
}
typedef _Float16 h16x2 __attribute__((ext_vector_type(2)));
typedef __fp16 fp16x2_t __attribute__((ext_vector_type(2)));
__device__ __forceinline__ void phase_peer_u(const Frame& F, const bf16* H2, const unsigned char* UT8, const float* SU, const int* EIDX, float* PART, unsigned emask = 0x3fffu) {
    const int lane = F.lane, g = lane >> 3, sub = lane & 7, b0 = lane & 1, b1 = (lane >> 1) & 1, b2 = (lane >> 2) & 1;
    const int s = F.bid & 7, wgq = F.bid >> 3, nq = F.G >> 3;
    LAS int* il = (LAS int*)(F.lds + F.wave * 8192);
    LAS float* pcl = (LAS float*)(F.lds + F.wave * 8192 + 4096);
    const unsigned char* ub = UT8 + (size_t)s * 16384 * 128 + sub * 16;
    for (int batch = wgq * 8 + F.wave; batch < TOK / 8; batch += nq * 8) {
        const int t0 = batch * 8, t = t0 + g;
        { const v4u* src = (const v4u*)(EIDX + (size_t)t0 * 128 + lane * 16);
          const v4u i0 = src[0], i1 = src[1], i2 = src[2], i3 = src[3];
          LAS v4u* dst = (LAS v4u*)(il + lane * 16); dst[0] = i0 & emask; dst[1] = i1 & emask; dst[2] = i2 & emask; dst[3] = i3 & emask; }
        h16x2 h[8];
        { const v4u ha = *(const v4u*)(H2 + (size_t)t * DM + s * 128 + sub * 16), hb = *(const v4u*)(H2 + (size_t)t * DM + s * 128 + sub * 16 + 8);
          h[0] = (h16x2){(_Float16)bflo(ha.x), (_Float16)bfhi(ha.x)}; h[1] = (h16x2){(_Float16)bflo(ha.y), (_Float16)bfhi(ha.y)}; h[2] = (h16x2){(_Float16)bflo(ha.z), (_Float16)bfhi(ha.z)}; h[3] = (h16x2){(_Float16)bflo(ha.w), (_Float16)bfhi(ha.w)};
          h[4] = (h16x2){(_Float16)bflo(hb.x), (_Float16)bfhi(hb.x)}; h[5] = (h16x2){(_Float16)bflo(hb.y), (_Float16)bfhi(hb.y)}; h[6] = (h16x2){(_Float16)bflo(hb.z), (_Float16)bfhi(hb.z)}; h[7] = (h16x2){(_Float16)bflo(hb.w), (_Float16)bfhi(hb.w)}; }
        LDS_WAIT(); asm volatile("" ::: "memory");
#define PU_LOAD(c, ua, su_) do { const v4u ia = *(LAS v4u*)(il + g * 128 + (c) * 8), ib = *(LAS v4u*)(il + g * 128 + (c) * 8 + 4); \
            ua[0] = *(const v4u*)(ub + (size_t)ia.x * 128); ua[1] = *(const v4u*)(ub + (size_t)ia.y * 128); ua[2] = *(const v4u*)(ub + (size_t)ia.z * 128); ua[3] = *(const v4u*)(ub + (size_t)ia.w * 128); \
            ua[4] = *(const v4u*)(ub + (size_t)ib.x * 128); ua[5] = *(const v4u*)(ub + (size_t)ib.y * 128); ua[6] = *(const v4u*)(ub + (size_t)ib.z * 128); ua[7] = *(const v4u*)(ub + (size_t)ib.w * 128); \
            su_ = SU[il[g * 128 + (c) * 8 + sub]]; } while (0)
#define PU_COMP(c, ua, su_) do { float a[8]; \
            _Pragma("unroll") for (int j = 0; j < 8; ++j) { float acc = 0.f; \
                _Pragma("unroll") for (int q = 0; q < 4; ++q) { acc = __builtin_amdgcn_fdot2(__builtin_bit_cast(h16x2, __builtin_amdgcn_cvt_scalef32_pk_f16_fp8(ua[j][q], 1.0f, false)), h[2 * q], acc, false); \
                    acc = __builtin_amdgcn_fdot2(__builtin_bit_cast(h16x2, __builtin_amdgcn_cvt_scalef32_pk_f16_fp8(ua[j][q], 1.0f, true)), h[2 * q + 1], acc, false); } \
                a[j] = acc; } \
            float bq[4], cc[2]; \
            _Pragma("unroll") for (int p = 0; p < 4; ++p) { const float keep = b0 ? a[2 * p + 1] : a[2 * p], send = b0 ? a[2 * p] : a[2 * p + 1]; bq[p] = keep + shx(send, 1, lane); } \
            _Pragma("unroll") for (int q = 0; q < 2; ++q) { const float keep = b1 ? bq[2 * q + 1] : bq[2 * q], send = b1 ? bq[2 * q] : bq[2 * q + 1]; cc[q] = keep + shx(send, 2, lane); } \
            { const float keep = b2 ? cc[1] : cc[0], send = b2 ? cc[0] : cc[1]; pcl[(c) * 64 + lane] = (keep + shx(send, 4, lane)) * su_; } } while (0)
        { v4u uA[8], uB[8]; float sA, sB;
          PU_LOAD(0, uA, sA);
#pragma unroll 1
          for (int c = 0; c < 16; c += 2) {
              PU_LOAD(c + 1, uB, sB);
              PU_COMP(c, uA, sA);
              if (c + 2 < 16) PU_LOAD(c + 2, uA, sA);
              PU_COMP(c + 1, uB, sB);
          } }
#undef PU_LOAD
#undef PU_COMP
        LDS_WAIT(); asm volatile("" ::: "memory");
        float* dst = PART + ((size_t)s * TOK + t) * 128 + sub;
#pragma unroll
        for (int c = 0; c < 16; ++c) dst[8 * c] = pcl[c * 64 + lane];
        LDS_WAIT(); asm volatile("" ::: "memory");
    }
}
__device__ __forceinline__ float gelu_as(float v) {
    const float av = fabsf(v), t = __builtin_amdgcn_rcpf(av * 0.2316418882f + 1.0f);
    float q = t * 0.5307027145f + (-0.7265760135f); q = q * t + 0.7107068705f; q = q * t + (-0.142248368f); q = q * t + 0.127414796f; q = q * t;
    const float m = v * (q * __builtin_amdgcn_exp2f((v * v) * (-0.72134752044f)));
    return v < 0.f ? m : v - m;
}
__device__ __forceinline__ void phase_peer_w(const Frame& F, const float* SV, const int* EIDX, const float* EW, const float* PART, v2u* COEF) {
    const int nth = F.G * NTHR;
    for (int i = F.bid * NTHR + F.tid; i < TOK * 128; i += nth) {
        float act = 0.f;
#pragma unroll
        for (int sp = 0; sp < 8; ++sp) act += PART[(size_t)sp * TOK * 128 + i];
        const int e = EIDX[i]; const float c = EW[i] * gelu_as(act) * SV[e];
        COEF[i] = (v2u){(unsigned)e, __builtin_bit_cast(unsigned, c)};
    }
}
__device__ __forceinline__ void phase_peer_v(const Frame& F, const unsigned char* VT8, const v2u* COEF, float* XB, const float* gate, unsigned emask = 0x3fffu) {
    const int lane = F.lane, g = lane >> 3, sub = lane & 7;
    const int s = F.bid & 7, wgq = F.bid >> 3, nq = F.G >> 3;
    LAS v2u* wl = (LAS v2u*)(F.lds + F.wave * 8192);
    const unsigned char* vb = VT8 + (size_t)s * 16384 * 128 + sub * 16;
    for (int batch = wgq * 8 + F.wave; batch < TOK / 8; batch += nq * 8) {
        const int t0 = batch * 8, t = t0 + g;
        { const v4u* src = (const v4u*)(COEF + (size_t)t0 * 128) + lane * 8;
          v4u c[8];
#pragma unroll
          for (int q = 0; q < 8; ++q) c[q] = src[q];
          LAS v4u* dst = (LAS v4u*)wl + lane * 8;
#pragma unroll
          for (int q = 0; q < 8; ++q) { v4u x = c[q]; x.x &= emask; x.z &= emask; dst[q] = x; } }
        LDS_WAIT(); asm volatile("" ::: "memory");
        h16x2 o[8];
#pragma unroll
        for (int q = 0; q < 8; ++q) o[q] = (h16x2){(_Float16)0.f, (_Float16)0.f};
#define PV_LOAD(c, pr, va) do { \
            _Pragma("unroll") for (int q = 0; q < 4; ++q) pr[q] = *(LAS v4u*)(wl + g * 128 + (c) * 8 + 2 * q); \
            _Pragma("unroll") for (int q = 0; q < 4; ++q) { va[2 * q] = *(const v4u*)(vb + (size_t)pr[q].x * 128); va[2 * q + 1] = *(const v4u*)(vb + (size_t)pr[q].z * 128); } } while (0)
#define PV_COMP(pr, va) do { \
            _Pragma("unroll") for (int j = 0; j < 8; ++j) { const unsigned cb = (j & 1) ? pr[j >> 1].w : pr[j >> 1].y; \
                const float s2 = __builtin_bit_cast(float, cb & 0x7f800000u); const _Float16 mh = (_Float16)__builtin_bit_cast(float, (cb & 0x807fffffu) | 0x3f800000u); const h16x2 m2 = (h16x2){mh, mh}; \
                _Pragma("unroll") for (int q = 0; q < 4; ++q) { o[2 * q] = __builtin_elementwise_fma(__builtin_bit_cast(h16x2, __builtin_amdgcn_cvt_scalef32_pk_f16_fp8(va[j][q], s2, false)), m2, o[2 * q]); \
                    o[2 * q + 1] = __builtin_elementwise_fma(__builtin_bit_cast(h16x2, __builtin_amdgcn_cvt_scalef32_pk_f16_fp8(va[j][q], s2, true)), m2, o[2 * q + 1]); } } } while (0)
        { v4u pA[4], pB[4], vA[8], vB[8];
          PV_LOAD(0, pA, vA);
#pragma unroll 1
          for (int c = 0; c < 16; c += 2) {
              PV_LOAD(c + 1, pB, vB);
              PV_COMP(pA, vA);
              if (c + 2 < 16) PV_LOAD(c + 2, pA, vA);
              PV_COMP(pB, vB);
          } }
#undef PV_LOAD
#undef PV_COMP
        const int bb = t / SEQ; float* xr = XB + (size_t)t * DM + s * 128 + sub * 16; const float* gr = gate + (size_t)bb * 6144 + s * 128 + sub * 16;
#pragma unroll
        for (int q = 0; q < 4; ++q) { const f32x4 x = *(const f32x4*)(xr + 4 * q), gg = *(const f32x4*)(gr + 4 * q);
            *(f32x4*)(xr + 4 * q) = x + gg * (f32x4){(float)o[2 * q].x, (float)o[2 * q].y, (float)o[2 * q + 1].x, (float)o[2 * q + 1].y}; }
        LDS_WAIT(); asm volatile("" ::: "memory");
    }
}

constexpr int NPL = 12, NPHASE = 1 + DEPTH * NPL + 1;
constexpr int CW_BAR = 1024;
static_assert((CW_BAR + XCD_BAR_WORDS) * 4 <= (int)CTL_ZERO_BYTES, "barrier words inside the memset region");

__global__ void __launch_bounds__(NTHR, 2) hybrid_fwd(Args args) {
    extern __shared__ __attribute__((aligned(16))) unsigned char lds[];
    Frame F;
    F.lds = (LAS unsigned char*)lds; F.ldsg = lds;
    F.tid = threadIdx.x; F.lane = F.tid & 63; F.wave = __builtin_amdgcn_readfirstlane(F.tid >> 6);
    F.G = gridDim.x; F.bid = blockIdx.x; F.ws = args.ws;
    GAS unsigned char* wsg = (GAS unsigned char*)args.ws;
#define WSP ((unsigned char*)wsg)
    volatile LAS unsigned* MISC = (volatile LAS unsigned*)(F.lds + MISC_OFF);
    for (int u = F.tid; u < 64; u += NTHR) ((LAS unsigned*)(F.lds + MISC_OFF))[u] = 0u;
    __syncthreads();
    XcdBarrier bar; bar.bar = (unsigned*)(WSP + WS_CTL) + CW_BAR; bar.x = 0; bar.st = nullptr;
    const int lo = args.ph_lo, hi = args.ph_hi;
    if (hi - lo > 1) bar = xcd_barrier_post((unsigned*)(WSP + WS_CTL) + CW_BAR, MISC + 8);
#ifndef PHMASK
#define PHMASK 0xffffffffu
#endif
#define PM(j) ((PHMASK >> (j)) & 1u)
#ifndef DUMMY_EMASK
#define DUMMY_EMASK 0x3fffu
#endif
#ifndef RPMASK
#define RPMASK 0u
#endif
#define RP(j) for (int rp_ = 0; rp_ < 1 + (int)((RPMASK >> (j)) & 1u); ++rp_)
#define LASTRP(j) (rp_ == (int)((RPMASK >> (j)) & 1u))
#define IN(k) (lo <= (k) && (k) < hi)
#define SEAM(k) do { if (IN(k) && IN((k) + 1)) { xcd_barrier(bar); if ((RPMASK >> 30) & 1u) xcd_barrier(bar); } } while (0)

    typedef __attribute__((address_space(4))) const Args* KArgs;
    KArgs ap = (KArgs)__builtin_amdgcn_kernarg_segment_ptr();
#define FRESH() asm volatile("" : "+s"(ap), "+s"(wsg)); Frame Fp = F; asm volatile("" : "+v"(Fp.tid)); Fp.lane = Fp.tid & 63; asm volatile("" : "+s"(Fp.wave), "+s"(Fp.bid), "+s"(Fp.G)); Fp.ws = WSP; LAS unsigned char* ring = Fp.lds; asm volatile("" : "+s"(ring)); Fp.lds = ring
#define INP(i) ((const float*)(GAS const float*)ap->in[i])
#define WIN_ ((bf16*)(WSP + WS_WIN))
#define WOUT_ ((bf16*)(WSP + WS_WOUT))
#define WOT_ ((bf16*)(WSP + WS_WO))
#define WQT_ ((bf16*)(WSP + WS_WQ))
#define W1T_ ((bf16*)(WSP + WS_W1T))
#define SUBK_ ((bf16*)(WSP + WS_SUBK))
#define W2T_ ((bf16*)(WSP + WS_SMALL + SM_W2T))
#define MOD_ ((float*)(WSP + WS_MOD))
#define COS_ ((const float*)(WSP + WS_COS))
#define SIN_ ((const float*)(WSP + WS_SIN))
#define KMEAN_ ((float*)(WSP + WS_SMALL + SM_KMEAN))
#define KCMP_ ((bf16*)(WSP + WS_SMALL + SM_KCMP))
#define VCMP_ ((bf16*)(WSP + WS_SMALL + SM_VCMP))
#define PBP_ ((float*)(WSP + WS_SMALL + SM_PBP))
#define EIDX_ ((int*)(WSP + WS_EIDX))
#define EW_ ((float*)(WSP + WS_EW))
#define HN_ ((bf16*)(WSP + WS_HN))
#define MIX_ ((bf16*)(WSP + WS_MIX))
#define PROJ_ ((bf16*)(WSP + WS_BIG))
#define GATES_ ((unsigned char*)(WSP + WS_GATES))
#define UT_ ((unsigned char*)(WSP + WS_BIG))
#define VT_ ((unsigned char*)(WSP + WS_BIG + 16 * MiB))
#define SU_ ((float*)(WSP + WS_BIG + 32 * MiB))
#define SV_ ((float*)(WSP + WS_BIG + 32 * MiB + 65536))
#define COEF_ ((v2u*)(WSP + WS_BIG + 33 * MiB))
#define Q2_ ((bf16*)(WSP + WS_BIG + 64 * MiB))
#define PART_ ((float*)(WSP + WS_BIG + 64 * MiB))
#define XB_ ((float*)(GAS float*)ap->out)
#define MODL_ (MOD_ + (size_t)l * 8 * 6144)
#define XIN_ ((l == 0) ? INP(I_X) : (const float*)XB_)

    if (PM(0) && IN(0)) RP(0) { FRESH(); phase_prologue(Fp, ap); }
    SEAM(0);
#pragma unroll 1
    for (int l = 0; l < DEPTH; ++l) {
        const int p0 = 1 + l * NPL;
        if (PM(1) && IN(p0 + 0)) RP(1) { FRESH(); phase_norm_mod(Fp, XIN_, INP(I_NMG) + l * DM, MODL_ + 0, MODL_ + 1024, HN_); }
        SEAM(p0 + 0);
        if (PM(2) && IN(p0 + 1)) RP(2) { FRESH(); pg8::Gemm g{HN_, WIN_ + (size_t)l * NWIN * DM, TOK, NWIN, DM}; pg8::StaticOrder S; S.init(TOK, NWIN, Fp.G, Fp.bid);
            epi::EpiProjAll E{{PROJ_, COS_, SIN_}, {GATES_}}; pg8::gemm_phase<epi::EpiProjAll, pg8::StaticOrder, true, true>(ring, g, S, E, Fp.tid); }
        SEAM(p0 + 1);
        if (PM(3) && IN(p0 + 2)) RP(3) {
            { FRESH(); phase_compress(Fp, PROJ_, W1T_ + (size_t)l * 2 * 128 * 2048, W2T_ + (size_t)l * 2 * 64 * 128, PBP_ + (size_t)l * 2 * 16 * 128, KCMP_, VCMP_); }
            { FRESH(); phase_kmean(Fp, PROJ_, KMEAN_); }
            { FRESH(); phase_mixer_a(Fp, PROJ_, INP(I_ACW) + (size_t)l * 3 * 512, MIX_); }
            __syncthreads();
            { FRESH(); phase_mixer_b(Fp, PROJ_, INP(I_BCW) + (size_t)l * 31 * 512, INP(I_BCB) + l * 512, INP(I_BLNG) + l * 512, INP(I_BLNB) + l * 512, MIX_ + (size_t)TOK * 512); }
            __syncthreads();
        }
        SEAM(p0 + 2);
        if (PM(4) && IN(p0 + 3)) { RP(4) { FRESH(); phase_nsa(Fp, PROJ_, KCMP_, VCMP_, MIX_ + (size_t)2 * TOK * 512); __syncthreads(); }
                                   RP(5) { FRESH(); phase_moba(Fp, PROJ_, KMEAN_, MIX_ + (size_t)3 * TOK * 512, !LASTRP(5)); __syncthreads(); } }
        SEAM(p0 + 3);
        if (PM(7) && IN(p0 + 4)) RP(7) { FRESH(); pg8::Gemm g{MIX_, WOUT_ + (size_t)(l * 4) * DM * 512, 4 * TOK, 4 * DM, 512}; epi::MergeOrder S; S.init(Fp.G, Fp.bid);
            epi::EpiMergeAll E{HN_, GATES_}; pg8::gemm_phase<epi::EpiMergeAll, epi::MergeOrder, true, true>(ring, g, S, E, Fp.tid); }
        SEAM(p0 + 4);
        if (PM(8) && IN(p0 + 5)) RP(8) { FRESH(); pg8::Gemm g{HN_, WOT_ + (size_t)l * DM * DM, TOK, DM, DM}; pg8::StaticOrder S; S.init(TOK, DM, Fp.G, Fp.bid);
            epi::EpiResid E{XIN_, LASTRP(8) ? XB_ : (float*)MIX_, MODL_ + 2048}; pg8::gemm_phase<epi::EpiResid, pg8::StaticOrder, true, true>(ring, g, S, E, Fp.tid); }
        SEAM(p0 + 5);
        if (PM(9) && IN(p0 + 6)) RP(9) {
            { FRESH(); phase_norm_mod(Fp, XB_, INP(I_NFG) + l * DM, MODL_ + 3072, MODL_ + 4096, HN_); }
            { FRESH(); phase_peer_tables(Fp, INP(I_PU) + (size_t)l * 16384 * DM, INP(I_PV) + (size_t)l * 16384 * DM, UT_, VT_, SU_, SV_); }
        }
        SEAM(p0 + 6);
        if (PM(10) && IN(p0 + 7)) RP(10) { FRESH(); pg8::Gemm g{HN_, WQT_ + (size_t)l * 2048 * DM, TOK, 2048, DM}; pg8::StaticOrder S; S.init(TOK, 2048, Fp.G, Fp.bid);
            epi::EpiStoreBf E{Q2_, 2048}; pg8::gemm_phase<epi::EpiStoreBf, pg8::StaticOrder, true, true>(ring, g, S, E, Fp.tid); }
        SEAM(p0 + 7);
        if (PM(11) && IN(p0 + 8)) RP(11) { FRESH(); phase_peer_route(Fp, Q2_, SUBK_ + (size_t)l * 8 * 2 * 128 * 128, EIDX_, EW_); __syncthreads(); }
        SEAM(p0 + 8);
        if (PM(12) && IN(p0 + 9)) RP(12) { FRESH(); phase_peer_u(Fp, HN_, UT_, SU_, EIDX_, LASTRP(12) ? PART_ : (float*)MIX_, LASTRP(12) ? 0x3fffu : DUMMY_EMASK); }
        SEAM(p0 + 9);
        if (PM(12) && IN(p0 + 10)) { FRESH(); phase_peer_w(Fp, SV_, EIDX_, EW_, PART_, COEF_); }
        SEAM(p0 + 10);
        if (PM(12) && IN(p0 + 11)) RP(14) { FRESH(); phase_peer_v(Fp, VT_, COEF_, LASTRP(14) ? XB_ : (float*)MIX_, MODL_ + 5120, LASTRP(14) ? 0x3fffu : DUMMY_EMASK); }
        SEAM(p0 + 11);
    }
    if (PM(13) && IN(NPHASE - 1)) { FRESH(); phase_final_norm(Fp, XB_, INP(I_FNG), XB_); }
#ifdef DBG_STOP
    if (IN(NPHASE)) { FRESH();
        const bf16* src = (const bf16*)(WSP + (size_t)DBG_OFF); const size_t n = (size_t)DBG_BYTES / 2, NO = (size_t)TOK * DM; float* o = (float*)ap->out;
        for (size_t i = (size_t)Fp.bid * NTHR + Fp.tid; i < NO; i += (size_t)Fp.G * NTHR) { float a = 0.f; for (size_t j = i; j < n; j += NO) a += bf2f(src[j]);
#ifdef DBG_OFF2
            { const float* s2 = (const float*)(WSP + (size_t)DBG_OFF2); const size_t n2 = (size_t)DBG_BYTES2 / 4; for (size_t j = i; j < n2; j += NO) a += s2[j]; }
#endif
            if (!(a == a) || fabsf(a) > 1e30f) a = 12345.0f;
            o[i] = a; } }
#endif
#undef IN
#undef SEAM
#undef WSP
}

extern "C" void kernel_launch(void* const* d_in, const int* in_sizes, int n_in, void* d_out, int out_size, void* d_ws, size_t ws_size, hipStream_t stream) {
    static int grid = 0;
    if (grid == 0) {
        if (n_in != 26 || in_sizes[0] != TOK * DM || out_size != TOK * DM || ws_size < WS_END) {
            fprintf(stderr, "kernel_launch: unexpected problem (n_in %d, in0 %d, out %d, WSP %zu); nothing launched\n", n_in, n_in > 0 ? in_sizes[0] : -1, out_size, ws_size); grid = -1; return; }
        int dev = 0, cus = 0, per_cu = 0;
        if (hipGetDevice(&dev) != hipSuccess || hipDeviceGetAttribute(&cus, hipDeviceAttributeMultiprocessorCount, dev) != hipSuccess) { grid = -1; return; }
        if (hipFuncSetAttribute((const void*)hybrid_fwd, hipFuncAttributeMaxDynamicSharedMemorySize, LDS_BYTES) != hipSuccess) { fprintf(stderr, "kernel_launch: hipFuncSetAttribute failed\n"); grid = -1; return; }
        if (hipOccupancyMaxActiveBlocksPerMultiprocessor(&per_cu, (const void*)hybrid_fwd, NTHR, LDS_BYTES) != hipSuccess || per_cu < 1)
            fprintf(stderr, "kernel_launch: note: occupancy query reports %d workgroups per CU\n", per_cu);
        (void)hipGetLastError();
        grid = cus;
    }
    if (grid < 0) return;
    if (hipMemsetAsync((char*)d_ws + WS_CTL, 0, CTL_ZERO_BYTES, stream) != hipSuccess) return;
    Args a{};
    for (int i = 0; i < 26; ++i) a.in[i] = d_in[i];
    a.out = (float*)d_out; a.ws = (unsigned char*)d_ws;
#if MK_PER_PHASE
#ifdef DBG_STOP
    for (int p = 0; p <= DBG_STOP; ++p) { a.ph_lo = p; a.ph_hi = p + 1; hipLaunchKernelGGL(hybrid_fwd, dim3(grid), dim3(NTHR), LDS_BYTES, stream, a); }
    a.ph_lo = NPHASE; a.ph_hi = NPHASE + 1; hipLaunchKernelGGL(hybrid_fwd, dim3(grid), dim3(NTHR), LDS_BYTES, stream, a);
#else
    for (int p = 0; p < NPHASE; ++p) { a.ph_lo = p; a.ph_hi = p + 1; hipLaunchKernelGGL(hybrid_fwd, dim3(grid), dim3(NTHR), LDS_BYTES, stream, a); }
#endif
#else
    a.ph_lo = 0; a.ph_hi = NPHASE; hipLaunchKernelGGL(hybrid_fwd, dim3(grid), dim3(NTHR), LDS_BYTES, stream, a);
#endif
    const hipError_t le = hipPeekAtLastError();
    if (le != hipSuccess) fprintf(stderr, "kernel_launch: launch failed: %s\n", hipGetErrorName(le));
}
```

```cpp
#include <hip/hip_runtime.h>
#include <hip/hip_bf16.h>
#include <cstdio>
#include <cstdint>
#include <cmath>

#ifndef MK_PER_PHASE
#define MK_PER_PHASE 0
#endif

#define DUMMY_EMASK 0x3fffu
#define ATT_DBG 0
#define RPMASK 0x0u
#define GAS __attribute__((address_space(1)))
#define LAS __attribute__((address_space(3)))
typedef unsigned short bf16;
typedef unsigned v4u __attribute__((ext_vector_type(4)));
typedef unsigned v2u __attribute__((ext_vector_type(2)));
typedef float f32x4 __attribute__((ext_vector_type(4)));
typedef float f32x2 __attribute__((ext_vector_type(2)));
typedef float f32x16 __attribute__((ext_vector_type(16)));
typedef short bf16x8 __attribute__((ext_vector_type(8)));
typedef short s16x4 __attribute__((ext_vector_type(4)));
typedef __bf16 bf16x2_t __attribute__((ext_vector_type(2)));

constexpr int BATCH = 8, SEQ = 2048, DM = 1024, DEPTH = 2, TOK = BATCH * SEQ;
constexpr int NP1 = 5632;
constexpr int NGT = 4096;
constexpr int NWIN = NP1 + NGT;
constexpr int C_AB = 0, C_AC = 512, C_AX = 1024, C_BA = 1536, C_BG = 2048, C_CQ = 2560, C_KC = 3072, C_VC = 3200, C_KS = 3328, C_VS = 3456, C_KW = 3584, C_VW = 3712,
              C_DQ = 3840, C_DK = 4352, C_DV = 4864, C_CG = 5376;
constexpr float NORM_EPS = 1e-6f;
constexpr float QSCALE = 0.125f * 1.4426950408889634f;

constexpr size_t MiB = 1u << 20;
constexpr size_t WS_CTL = 0, CTL_ZERO_BYTES = 64 * 1024;
constexpr size_t WS_MOD = 1 * MiB;
constexpr size_t WS_COS = 2 * MiB, WS_SIN = 4 * MiB;
constexpr size_t WS_SMALL = 6 * MiB;
constexpr size_t SM_KMEAN = 704 * 1024;
constexpr size_t SM_KCMP = 64 * 1024;
constexpr size_t SM_VCMP = 320 * 1024;
constexpr size_t SM_PBP = 576 * 1024;
constexpr size_t SM_W2T = 640 * 1024;
constexpr size_t WS_EIDX = 8 * MiB;
constexpr size_t WS_EW = 16 * MiB;
constexpr size_t WS_WIN = 24 * MiB;
constexpr size_t WS_WOUT = 62 * MiB;
constexpr size_t WS_WO = 70 * MiB;
constexpr size_t WS_WQ = 74 * MiB;
constexpr size_t WS_W1T = 82 * MiB;
constexpr size_t WS_SUBK = 84 * MiB;
constexpr size_t WS_HN = 86 * MiB;
constexpr size_t WS_MIX = 118 * MiB;
constexpr size_t WS_BIG = 182 * MiB;
constexpr size_t WS_GATES = 358 * MiB;
constexpr size_t WS_END = 486 * MiB;

constexpr int LDS_BYTES = 147456;
constexpr int RING_BYTES = 131072;
constexpr int MISC_OFF = LDS_BYTES - 256;

#define RLX_AGENT __ATOMIC_RELAXED, __HIP_MEMORY_SCOPE_AGENT
#define LDS_WAIT() asm volatile("s_waitcnt lgkmcnt(0)" ::: "memory")
#define VM_WAIT() asm volatile("s_waitcnt vmcnt(0)" ::: "memory")
__device__ __forceinline__ unsigned f2bf(float f) { unsigned u = __builtin_bit_cast(unsigned, f); return (u + 0x7fffu + ((u >> 16) & 1u)) >> 16; }
__device__ __forceinline__ float bf2f(unsigned h) { return __builtin_bit_cast(float, h << 16); }
__device__ __forceinline__ unsigned pk2(float lo, float hi) { f32x2 v = {lo, hi}; bf16x2_t b = __builtin_convertvector(v, bf16x2_t); return __builtin_bit_cast(unsigned, b); }
__device__ __forceinline__ float bflo(unsigned w) { return __builtin_bit_cast(float, w << 16); }
__device__ __forceinline__ float bfhi(unsigned w) { return __builtin_bit_cast(float, w & 0xffff0000u); }
__device__ __forceinline__ float sigmoidf_(float x) { return __builtin_amdgcn_rcpf(1.0f + __builtin_amdgcn_exp2f(x * -1.4426950408889634f)); }
__device__ __forceinline__ float gelu_erf(float x) { return 0.5f * x * (1.0f + erff(x * 0.70710678118654752f)); }
__device__ __forceinline__ float shx(float v, int m, int lane) { return __builtin_bit_cast(float, __builtin_amdgcn_ds_bpermute((lane ^ m) << 2, __builtin_bit_cast(int, v))); }
__device__ __forceinline__ unsigned shxu(unsigned v, int m, int lane) { return (unsigned)__builtin_amdgcn_ds_bpermute((lane ^ m) << 2, (int)v); }
__device__ __forceinline__ void swap32(unsigned v, unsigned& r0, unsigned& r1) { unsigned b = v; asm volatile("" : "+v"(b)); auto r = __builtin_amdgcn_permlane32_swap(v, b, false, false); r0 = r[0]; r1 = r[1]; }
__device__ __forceinline__ float other32(float v, int hi) { unsigned r0, r1; swap32(__builtin_bit_cast(unsigned, v), r0, r1); return __builtin_bit_cast(float, hi ? r0 : r1); }
__device__ __forceinline__ float add32(float v) { unsigned r0, r1; swap32(__builtin_bit_cast(unsigned, v), r0, r1); return __builtin_bit_cast(float, r0) + __builtin_bit_cast(float, r1); }
__device__ __forceinline__ float max32(float v) { unsigned r0, r1; swap32(__builtin_bit_cast(unsigned, v), r0, r1); return fmaxf(__builtin_bit_cast(float, r0), __builtin_bit_cast(float, r1)); }
__device__ __forceinline__ unsigned umax32(unsigned v) { unsigned r0, r1; swap32(v, r0, r1); return r0 > r1 ? r0 : r1; }
__device__ __forceinline__ float wave_sum(float v, int lane) {
#pragma unroll
    for (int o = 1; o < 32; o <<= 1) v += shx(v, o, lane);
    return add32(v);
}
namespace pg8 {
#define PG8_LAS __attribute__((address_space(3)))
typedef unsigned short bf16_t;
typedef short bf16x8 __attribute__((ext_vector_type(8)));
typedef float f32x4 __attribute__((ext_vector_type(4)));
typedef unsigned u32x4 __attribute__((ext_vector_type(4)));
constexpr int BM = 256, BK = 64, HALF = 128, HTB = HALF * BK * 2  , STAGE_BYTES = 8 * HTB, NXCD = 8, WGM = 8;

__host__ __device__ __forceinline__ int lds_byte(int r, int c) { const int st = (r >> 4) * 2 + (c >> 5), rr = r & 15, cc = c & 31, ob = rr * 64 + cc * 2; return st * 1024 + (ob ^ (((ob >> 9) & 1) << 5)); }
__host__ __device__ __forceinline__ void stage_rc(int b, int& R, int& C) { const int st = b / 1024, sb = b % 1024, swz = sb ^ (((sb >> 9) & 1) << 5); R = (st >> 1) * 16 + swz / 64; C = (st & 1) * 32 + (swz % 64) / 2; }
__host__ __device__ __forceinline__ int perm32(int rho) { const int n = rho >> 4, i = rho & 15; return 8 * (i >> 2) + 4 * n + (i & 3); }

struct Unit { int pm, pn; };
struct Gemm { const bf16_t* A; const bf16_t* Bt; int M, N, K; };

struct StaticOrder {
    int nM, nN, nwg, G, c;
    __host__ __device__ void init(int M, int N, int G_, int c_) { nM = M / BM; nN = N / BM; nwg = nM * nN; G = G_; c = c_; }
    __host__ __device__ bool next(int i, Unit& u) const {
        const long L = (long)i * G + c; if (L >= nwg) return false;
        int wgid = (int)L; { const int q = nwg / NXCD, r = nwg % NXCD, xcd = wgid % NXCD, off = wgid / NXCD; wgid = (xcd < r ? xcd * (q + 1) : r * (q + 1) + (xcd - r) * q) + off; }
        const int nig = WGM * nN, gid = wgid / nig, fm = gid * WGM, gsz = (nM - fm) < WGM ? (nM - fm) : WGM;
        u.pm = fm + ((wgid % nig) % gsz); u.pn = (wgid % nig) / gsz; return true;
    }
    __device__ __forceinline__ void a_ready(const Unit&) const {}
    __device__ __forceinline__ void done(const Unit&) const {}
};

__device__ __forceinline__ unsigned cvt_pk_bf16(float lo, float hi) { unsigned r; asm volatile("v_cvt_pk_bf16_f32 %0, %1, %2" : "=v"(r) : "v"(lo), "v"(hi)); return r; }
typedef float f32x2 __attribute__((ext_vector_type(2)));
template <class Epi, class Sched, bool ALIGN_EPI = false, bool SP2 = false>
__device__ __forceinline__ void gemm_phase(PG8_LAS unsigned char* lds, const Gemm g, const Sched& S, const Epi& E, const int tid) {
    const int wid = __builtin_amdgcn_readfirstlane(tid >> 6), lane = tid & 63, wr = wid >> 2, wc = wid & 3, fr = lane & 15, fq = lane >> 4;
    const int K = g.K, nt = K / BK;
    unsigned voffA[2], voffB[2];
#pragma unroll
    for (int i = 0; i < 2; ++i) { int R, C; stage_rc(tid * 16 + i * 8192, R, C); const int Rb = Epi::PERM ? ((R & ~31) + perm32(R & 31)) : R;
        voffA[i] = (unsigned)(R * K + C) * 2u; voffB[i] = (unsigned)(Rb * K + C) * 2u; }
    const size_t kstep = (size_t)(BK * 2);
    const size_t hstep = (size_t)HALF * K * 2;
    const size_t tstep = 2 * hstep;
    const unsigned ldsw = (unsigned)wid * 1024u;
    const int aoff = lds_byte(wr * 64 + fr, fq * 8), boff = lds_byte(wc * 32 + fr, fq * 8);
#define PG8_SA(b, h) (((b) * 2 + (h)) * HTB)
#define PG8_SB(b, h) ((4 + (b) * 2 + (h)) * HTB)
#define PG8_STAGE(bufoff, gbase, voff) do { _Pragma("unroll") for (int _i = 0; _i < 2; ++_i) \
        __builtin_amdgcn_global_load_lds((const unsigned*)((const char*)(gbase) + (voff)[_i]), (PG8_LAS unsigned*)(lds + (bufoff) + ldsw + _i * 8192), 16, 0, 0); } while (0)
#define PG8_LDA(dst, b, h) do { _Pragma("unroll") for (int m = 0; m < 4; ++m) _Pragma("unroll") for (int k = 0; k < 2; ++k) dst[m][k] = *(const PG8_LAS bf16x8*)(lds + PG8_SA(b, h) + aoff + m * 2048 + k * 1024); } while (0)
#define PG8_LDB(dst, b, h) do { _Pragma("unroll") for (int n = 0; n < 2; ++n) _Pragma("unroll") for (int k = 0; k < 2; ++k) dst[n][k] = *(const PG8_LAS bf16x8*)(lds + PG8_SB(b, h) + boff + n * 2048 + k * 1024); } while (0)
#define PG8_MMA(ai, bj, At, Bt) do { __builtin_amdgcn_s_setprio(1); _Pragma("unroll") for (int m = 0; m < 4; ++m) _Pragma("unroll") for (int n = 0; n < 2; ++n) _Pragma("unroll") for (int k = 0; k < 2; ++k) \
        acc[ai][bj][m][n] = __builtin_amdgcn_mfma_f32_16x16x32_bf16(Bt[n][k], At[m][k], acc[ai][bj][m][n], 0, 0, 0); __builtin_amdgcn_s_setprio(0); } while (0)
#define PG8_WAIT_V(n) asm volatile("s_waitcnt vmcnt(" #n ")" ::: "memory")
#define PG8_WAIT_L(n) asm volatile("s_waitcnt lgkmcnt(" #n ")" ::: "memory")
#define PG8_BAR __builtin_amdgcn_s_barrier()
#define PG8_SCHED __builtin_amdgcn_sched_barrier(0)
    Unit cur, nxt; int ui = 0;
    if (!S.next(0, cur)) return;
    f32x4 acc[2][2][4][2];
#pragma unroll
    for (int a = 0; a < 2; ++a)
#pragma unroll
        for (int b = 0; b < 2; ++b)
#pragma unroll
            for (int m = 0; m < 4; ++m)
#pragma unroll
                for (int n = 0; n < 2; ++n) acc[a][b][m][n] = (f32x4){0.f, 0.f, 0.f, 0.f};
    bf16x8 At[4][2], B0[2][2], B1[2][2];
    const char* cA = (const char*)g.A + (size_t)cur.pm * tstep; const char* cB = (const char*)g.Bt + (size_t)cur.pn * tstep;
    S.a_ready(cur);
    if constexpr (SP2) {
        PG8_STAGE(PG8_SB(0, 0), cB, voffB); PG8_STAGE(PG8_SB(0, 1), cB + hstep, voffB); PG8_STAGE(PG8_SA(0, 0), cA, voffA); PG8_STAGE(PG8_SA(0, 1), cA + hstep, voffA);
        if (wr == 1) PG8_BAR;
        PG8_WAIT_V(2); PG8_BAR;
        PG8_STAGE(PG8_SB(1, 0), cB + kstep, voffB); PG8_STAGE(PG8_SA(1, 0), cA + kstep, voffA); PG8_STAGE(PG8_SB(1, 1), cB + hstep + kstep, voffB);
        PG8_WAIT_V(6); PG8_BAR;
    } else {
        PG8_STAGE(PG8_SB(0, 0), cB, voffB); PG8_STAGE(PG8_SA(0, 0), cA, voffA); PG8_STAGE(PG8_SB(0, 1), cB + hstep, voffB); PG8_STAGE(PG8_SA(0, 1), cA + hstep, voffA);
        if (wr == 1) PG8_BAR;
        PG8_WAIT_V(4); PG8_BAR;
        PG8_STAGE(PG8_SB(1, 0), cB + kstep, voffB); PG8_STAGE(PG8_SA(1, 0), cA + kstep, voffA); PG8_STAGE(PG8_SB(1, 1), cB + hstep + kstep, voffB);
        PG8_WAIT_V(6); PG8_BAR;
    }
    for (;;) {
        const bool has_next = S.next(ui + 1, nxt);
        const char* nA = has_next ? (const char*)g.A + (size_t)nxt.pm * tstep : cA; const char* nB = has_next ? (const char*)g.Bt + (size_t)nxt.pn * tstep : cB;
        for (int t = 0; t < nt; t += 2) {
            const bool last = (t == nt - 2);
            const char* a1 = cA + (size_t)(t + 1) * kstep;
            const char* a2 = last ? nA : cA + (size_t)(t + 2) * kstep; const char* b2 = last ? nB : cB + (size_t)(t + 2) * kstep;
            const char* a3 = a2 + kstep; const char* b3 = b2 + kstep;
            if (last && has_next) S.a_ready(nxt);
            if constexpr (SP2) {
            PG8_LDB(B0, 0, 0); PG8_LDB(B1, 0, 1); PG8_SCHED; PG8_LDA(At, 0, 0); PG8_STAGE(PG8_SA(1, 1), a1 + hstep, voffA);
            PG8_WAIT_V(8); PG8_WAIT_L(0); PG8_BAR; PG8_MMA(0, 0, At, B0); PG8_MMA(0, 1, At, B1); PG8_BAR; PG8_SCHED;
            PG8_LDA(At, 0, 1); PG8_STAGE(PG8_SB(0, 0), b2, voffB); PG8_STAGE(PG8_SB(0, 1), b2 + hstep, voffB); PG8_STAGE(PG8_SA(0, 0), a2, voffA);
            PG8_WAIT_V(8); PG8_WAIT_L(0); PG8_BAR; PG8_MMA(1, 0, At, B0); PG8_MMA(1, 1, At, B1); PG8_BAR; PG8_SCHED;
            PG8_LDB(B0, 1, 0); PG8_LDB(B1, 1, 1); PG8_SCHED; PG8_LDA(At, 1, 0); PG8_STAGE(PG8_SA(0, 1), a2 + hstep, voffA);
            PG8_WAIT_V(8); PG8_WAIT_L(0); PG8_BAR; PG8_MMA(0, 0, At, B0); PG8_MMA(0, 1, At, B1); PG8_BAR; PG8_SCHED;
            PG8_LDA(At, 1, 1); PG8_STAGE(PG8_SB(1, 0), b3, voffB); PG8_STAGE(PG8_SB(1, 1), b3 + hstep, voffB); PG8_STAGE(PG8_SA(1, 0), a3, voffA);
            PG8_WAIT_V(8); PG8_WAIT_L(0); PG8_BAR; PG8_MMA(1, 0, At, B0); PG8_MMA(1, 1, At, B1); PG8_BAR; PG8_SCHED;
            } else {
            PG8_LDB(B0, 0, 0); PG8_SCHED; PG8_LDA(At, 0, 0); PG8_STAGE(PG8_SA(1, 1), a1 + hstep, voffA);
            PG8_WAIT_L(8); PG8_BAR; PG8_WAIT_L(0); PG8_MMA(0, 0, At, B0); PG8_BAR; PG8_SCHED;
            PG8_LDB(B1, 0, 1); PG8_STAGE(PG8_SB(0, 0), b2, voffB);
            PG8_BAR; PG8_WAIT_L(0); PG8_MMA(0, 1, At, B1); PG8_BAR;
            PG8_LDA(At, 0, 1); PG8_STAGE(PG8_SA(0, 0), a2, voffA);
            PG8_BAR; PG8_WAIT_L(0); PG8_MMA(1, 0, At, B0); PG8_BAR; PG8_SCHED;
            PG8_STAGE(PG8_SB(0, 1), b2 + hstep, voffB);
            PG8_WAIT_V(6); PG8_BAR; PG8_MMA(1, 1, At, B1); PG8_BAR;
            PG8_LDB(B0, 1, 0); PG8_SCHED; PG8_LDA(At, 1, 0); PG8_STAGE(PG8_SA(0, 1), a2 + hstep, voffA);
            PG8_WAIT_L(8); PG8_BAR; PG8_WAIT_L(0); PG8_MMA(0, 0, At, B0); PG8_BAR; PG8_SCHED;
            PG8_LDB(B1, 1, 1); PG8_STAGE(PG8_SB(1, 0), b3, voffB);
            PG8_BAR; PG8_WAIT_L(0); PG8_MMA(0, 1, At, B1); PG8_BAR;
            PG8_LDA(At, 1, 1); PG8_STAGE(PG8_SA(1, 0), a3, voffA);
            PG8_BAR; PG8_WAIT_L(0); PG8_MMA(1, 0, At, B0); PG8_BAR; PG8_SCHED;
            PG8_STAGE(PG8_SB(1, 1), b3 + hstep, voffB);
            PG8_WAIT_V(6); PG8_BAR; PG8_MMA(1, 1, At, B1); PG8_BAR;
            }
        }
        if constexpr (ALIGN_EPI) { if (wr == 0) PG8_BAR; }
        if constexpr (Epi::KEEP_ACC) { E.inplace(acc, cur, wr, wc, fr, fq); S.done(cur); }
        else if constexpr (!Epi::AFTER_DRAIN) { E(acc, cur, wr, wc, fr, fq); S.done(cur); }
        if (!has_next) break;
        if constexpr (!Epi::KEEP_ACC)
#pragma unroll
        for (int a = 0; a < 2; ++a)
#pragma unroll
            for (int b = 0; b < 2; ++b)
#pragma unroll
                for (int m = 0; m < 4; ++m)
#pragma unroll
                    for (int n = 0; n < 2; ++n) acc[a][b][m][n] = (f32x4){0.f, 0.f, 0.f, 0.f};
        cur = nxt; cA = nA; cB = nB; ++ui;
        if constexpr (ALIGN_EPI) { if (wr == 1) PG8_BAR; }
    }
    PG8_WAIT_V(0);
    if constexpr (!ALIGN_EPI) { if (wr == 0) PG8_BAR; }
    PG8_BAR;
    if constexpr (Epi::AFTER_DRAIN) { E.fused(acc, cur, wr, wc, fr, fq, lds, wid, lane); S.done(cur); }
#undef PG8_SA
#undef PG8_SB
#undef PG8_STAGE
#undef PG8_LDA
#undef PG8_LDB
#undef PG8_MMA
#undef PG8_WAIT_V
#undef PG8_WAIT_L
#undef PG8_BAR
#undef PG8_SCHED
}
}
#define XB_TMO      128
#define XB_XCNT(j)  (256  + 64 * (j))
#define XB_XSUB(j)  (1280 + 64 * (j))
#define XB_XGEN(j)  (2304 + 64 * (j))
#define XB_TOP      3328
#define XB_TOPGEN   3392
#define XCD_BAR_WORDS 3456
#define XB_SPIN_CAP (1u << 25)

__device__ __forceinline__ unsigned xb_ld(unsigned* p)              { return __hip_atomic_load(p, __ATOMIC_RELAXED, __HIP_MEMORY_SCOPE_AGENT); }
__device__ __forceinline__ unsigned xb_add(unsigned* p, unsigned v) { return __hip_atomic_fetch_add(p, v, __ATOMIC_RELAXED, __HIP_MEMORY_SCOPE_AGENT); }
__device__ __forceinline__ unsigned xb_xcc_id() { return (unsigned)__builtin_amdgcn_s_getreg((3 << 11) | 20) & 0xFu; }
#define XB_SPIN(cond, bar) do { unsigned _sp = 0; while (cond) { __builtin_amdgcn_s_sleep(1); \
    if ((++_sp & 255u) == 0u) { if (xb_ld(&(bar)[XB_TMO])) break; if (_sp > XB_SPIN_CAP) { atomicAdd(&(bar)[XB_TMO], 1u); break; } } } } while (0)

struct XcdBarrier {
    unsigned* bar; unsigned x;
    volatile LAS unsigned* st;
};

__device__ __forceinline__ XcdBarrier xcd_barrier_post(unsigned* bar, volatile LAS unsigned* st) {
    XcdBarrier b; b.bar = bar; b.x = xb_xcc_id(); b.st = st;
    if (threadIdx.x == 0) (void)xb_add(&bar[XB_XCNT(b.x)], 1u);
    return b;
}
__device__ __forceinline__ void xcd_barrier_complete(unsigned* bar, unsigned x, unsigned& nloc, unsigned& nx) {
    const unsigned G = gridDim.x * gridDim.y * gridDim.z;
    unsigned sum, cnt, mine, sp = 0u;
    for (;;) {
        sum = 0u; cnt = 0u; mine = 0u;
#pragma unroll
        for (unsigned j = 0; j < 16; ++j) { const unsigned c = xb_ld(&bar[XB_XCNT(j)]); sum += c; cnt += (c > 0u) ? 1u : 0u; mine = (j == x) ? c : mine; }
        if (sum == G) break;
        __builtin_amdgcn_s_sleep(1);
        if ((++sp & 255u) == 0u) { if (xb_ld(&bar[XB_TMO])) break; if (sp > XB_SPIN_CAP) { atomicAdd(&bar[XB_TMO], 1u); break; } }
    }
    nloc = mine > 0u ? mine : 1u; nx = cnt > 0u ? cnt : 1u;
}

__device__ __forceinline__ void xcd_barrier(const XcdBarrier& b) {
    asm volatile("s_waitcnt vmcnt(0)" ::: "memory");
    __syncthreads();
    if (threadIdx.x == 0) {
        unsigned* bar = b.bar;
        __builtin_amdgcn_s_waitcnt(0);
        unsigned nloc = b.st[0], nx = b.st[1];
        if (nloc == 0u) { xcd_barrier_complete(bar, b.x, nloc, nx); b.st[0] = nloc; b.st[1] = nx; }
        const unsigned old = xb_add(&bar[XB_XSUB(b.x)], 1u);
        const unsigned gen = old / nloc;
        if (old + 1u == (gen + 1u) * nloc) {
            __builtin_amdgcn_fence(__ATOMIC_RELEASE, "agent");
            asm volatile("s_waitcnt vmcnt(0)" ::: "memory");
            const unsigned og = xb_add(&bar[XB_TOP], 1u);
            const unsigned tg = og / nx;
            if (og + 1u == (tg + 1u) * nx) xb_add(&bar[XB_TOPGEN], 1u);
            else XB_SPIN(xb_ld(&bar[XB_TOPGEN]) == tg, bar);
            __builtin_amdgcn_fence(__ATOMIC_ACQUIRE, "agent");
            xb_add(&bar[XB_XGEN(b.x)], 1u);
            asm volatile("s_waitcnt vmcnt(0)" ::: "memory");
        } else {
            XB_SPIN(xb_ld(&bar[XB_XGEN(b.x)]) == gen, bar);
            __builtin_amdgcn_fence(__ATOMIC_ACQUIRE, "agent");
            asm volatile("s_waitcnt vmcnt(0)" ::: "memory");
        }
    }
    __syncthreads();
}

namespace epi {
using pg8::Unit; using pg8::BM; using pg8::HALF;
typedef const pg8::f32x4 (&AccRef)[2][2][4][2];

struct EpiProj1 {
    static constexpr bool PERM = true, AFTER_DRAIN = false, KEEP_ACC = false;
    bf16* O; const float* cosT; const float* sinT;
    __device__ __forceinline__ void operator()(AccRef acc, const Unit& u, int wr, int wc, int fr, int fq) const {
        const int row0 = u.pm * BM + wr * 64 + fr, colw = u.pn * BM + wc * 32;
#pragma unroll
        for (int bj = 0; bj < 2; ++bj) {
            const int hb = (colw + bj * HALF) >> 6;
            const bool rope = (hb >= 40 && hb < 50) || (hb >= 52 && hb < 54) || (hb >= 56 && hb < 58) || (hb >= 60 && hb < 76);
            const bool isq = (hb >= 40 && hb < 48) || (hb >= 60 && hb < 68);
            const float qs = isq ? QSCALE : 1.0f;
            const int jw = (wc & 1) * 16 + fq * 4;
#pragma unroll
            for (int ai = 0; ai < 2; ++ai)
#pragma unroll
                for (int m = 0; m < 4; ++m) {
                    const int row = row0 + ai * HALF + m * 16;
                    pg8::f32x4 v0 = acc[ai][bj][m][0], v1 = acc[ai][bj][m][1];
                    if (rope) {
                        const pg8::f32x4 c = *(const pg8::f32x4*)(cosT + (size_t)row * 32 + jw), s = *(const pg8::f32x4*)(sinT + (size_t)row * 32 + jw);
                        const float a0 = v0[0] * c[0] - v0[1] * s[0], a1 = v0[1] * c[0] + v0[0] * s[0], a2 = v0[2] * c[1] - v0[3] * s[1], a3 = v0[3] * c[1] + v0[2] * s[1];
                        const float b0 = v1[0] * c[2] - v1[1] * s[2], b1 = v1[1] * c[2] + v1[0] * s[2], b2 = v1[2] * c[3] - v1[3] * s[3], b3 = v1[3] * c[3] + v1[2] * s[3];
                        v0 = (pg8::f32x4){a0, a1, a2, a3} * qs; v1 = (pg8::f32x4){b0, b1, b2, b3} * qs;
                    }
                    v4u w; w.x = pk2(v0[0], v0[1]); w.y = pk2(v0[2], v0[3]); w.z = pk2(v1[0], v1[1]); w.w = pk2(v1[2], v1[3]);
                    *(v4u*)(O + (size_t)row * NP1 + colw + bj * HALF + 8 * fq) = w;
                }
        }
    }
};
struct EpiStoreBf {
    static constexpr bool PERM = true, AFTER_DRAIN = false, KEEP_ACC = false;
    bf16* O; int ldc;
    __device__ __forceinline__ void operator()(AccRef acc, const Unit& u, int wr, int wc, int fr, int fq) const {
        const int row0 = u.pm * BM + wr * 64 + fr, col0 = u.pn * BM + wc * 32 + 8 * fq;
#pragma unroll
        for (int ai = 0; ai < 2; ++ai)
#pragma unroll
            for (int m = 0; m < 4; ++m) { bf16* rowp = O + (size_t)(row0 + ai * HALF + m * 16) * ldc + col0;
#pragma unroll
                for (int bj = 0; bj < 2; ++bj) { const pg8::f32x4 v0 = acc[ai][bj][m][0], v1 = acc[ai][bj][m][1];
                    v4u w; w.x = pk2(v0[0], v0[1]); w.y = pk2(v0[2], v0[3]); w.z = pk2(v1[0], v1[1]); w.w = pk2(v1[2], v1[3]); *(v4u*)(rowp + bj * HALF) = w; } }
    }
};
__device__ __forceinline__ float gate_enc(float x) { const float e = __builtin_amdgcn_exp2f(__builtin_amdgcn_fmed3f(x, -30.0f, 30.0f) * -1.4426950408889634f); return (1.0f - e) * __builtin_amdgcn_rcpf(1.0f + e); }

struct EpiGates {
    static constexpr bool PERM = true, AFTER_DRAIN = false, KEEP_ACC = false;
    unsigned char* O;
    __device__ __forceinline__ void operator()(AccRef acc, const Unit& u, int wr, int wc, int fr, int fq) const {
        const int row0 = u.pm * BM + wr * 64 + fr, col0 = u.pn * BM + wc * 32 + 8 * fq;
#pragma unroll
        for (int ai = 0; ai < 2; ++ai)
#pragma unroll
            for (int m = 0; m < 4; ++m) { unsigned char* rowp = O + (size_t)(row0 + ai * HALF + m * 16) * NGT + col0;
#pragma unroll
                for (int bj = 0; bj < 2; ++bj) { const pg8::f32x4 v0 = acc[ai][bj][m][0], v1 = acc[ai][bj][m][1];
                    v2u w; unsigned p = 0u; p = __builtin_amdgcn_cvt_pk_fp8_f32(gate_enc(v0[0]), gate_enc(v0[1]), p, false); p = __builtin_amdgcn_cvt_pk_fp8_f32(gate_enc(v0[2]), gate_enc(v0[3]), p, true); w.x = p;
                    p = 0u; p = __builtin_amdgcn_cvt_pk_fp8_f32(gate_enc(v1[0]), gate_enc(v1[1]), p, false); p = __builtin_amdgcn_cvt_pk_fp8_f32(gate_enc(v1[2]), gate_enc(v1[3]), p, true); w.y = p;
                    *(v2u*)(rowp + bj * HALF) = w; } }
    }
};
struct EpiMerge {
    static constexpr bool PERM = true, AFTER_DRAIN = false, KEEP_ACC = false;
    bf16* O; const unsigned char* G; int seg;
    __device__ __forceinline__ void operator()(AccRef acc, const Unit& u, int wr, int wc, int fr, int fq) const {
        const int row0 = u.pm * BM + wr * 64 + fr, col0 = u.pn * BM + wc * 32 + 8 * fq;
#pragma unroll
        for (int ai = 0; ai < 2; ++ai)
#pragma unroll
            for (int m = 0; m < 4; ++m) { const size_t row = (size_t)(row0 + ai * HALF + m * 16); bf16* rowp = O + row * DM + col0; const unsigned char* gp = G + row * NGT + seg * DM + col0;
#pragma unroll
                for (int bj = 0; bj < 2; ++bj) { pg8::f32x4 v0 = acc[ai][bj][m][0], v1 = acc[ai][bj][m][1];
                    const v2u g = *(const v2u*)(gp + bj * HALF);
                    const f32x2 g0 = __builtin_amdgcn_cvt_pk_f32_fp8(g.x, false), g1 = __builtin_amdgcn_cvt_pk_f32_fp8(g.x, true), g2 = __builtin_amdgcn_cvt_pk_f32_fp8(g.y, false), g3 = __builtin_amdgcn_cvt_pk_f32_fp8(g.y, true);
                    v0[0] *= 0.5f * g0.x + 0.5f; v0[1] *= 0.5f * g0.y + 0.5f; v0[2] *= 0.5f * g1.x + 0.5f; v0[3] *= 0.5f * g1.y + 0.5f;
                    v1[0] *= 0.5f * g2.x + 0.5f; v1[1] *= 0.5f * g2.y + 0.5f; v1[2] *= 0.5f * g3.x + 0.5f; v1[3] *= 0.5f * g3.y + 0.5f;
                    if (seg != 0) { const v4u o = *(const v4u*)(rowp + bj * HALF); v0[0] += bflo(o.x); v0[1] += bfhi(o.x); v0[2] += bflo(o.y); v0[3] += bfhi(o.y); v1[0] += bflo(o.z); v1[1] += bfhi(o.z); v1[2] += bflo(o.w); v1[3] += bfhi(o.w); }
                    v4u w; w.x = pk2(v0[0], v0[1]); w.y = pk2(v0[2], v0[3]); w.z = pk2(v1[0], v1[1]); w.w = pk2(v1[2], v1[3]); *(v4u*)(rowp + bj * HALF) = w; } }
    }
};
struct EpiResid {
    static constexpr bool PERM = false, AFTER_DRAIN = false, KEEP_ACC = false;
    const float* XI; float* XO; const float* gate;
    __device__ __forceinline__ void operator()(AccRef acc, const Unit& u, int wr, int wc, int fr, int fq) const {
        const int row0 = u.pm * BM + wr * 64 + fr, col0 = u.pn * BM + wc * 32 + 4 * fq;
        const float* gb = gate + (size_t)((u.pm * BM) / SEQ) * 6144 + col0;
        pg8::f32x4 gv[2][2];
#pragma unroll
        for (int bj = 0; bj < 2; ++bj)
#pragma unroll
            for (int n = 0; n < 2; ++n) gv[bj][n] = *(const pg8::f32x4*)(gb + bj * HALF + n * 16);
#pragma unroll
        for (int ai = 0; ai < 2; ++ai)
#pragma unroll
            for (int m = 0; m < 4; ++m) { const size_t off = (size_t)(row0 + ai * HALF + m * 16) * DM + col0;
#pragma unroll
                for (int bj = 0; bj < 2; ++bj)
#pragma unroll
                    for (int n = 0; n < 2; ++n) { const pg8::f32x4 xi = *(const pg8::f32x4*)(XI + off + bj * HALF + n * 16);
                        *(pg8::f32x4*)(XO + off + bj * HALF + n * 16) = xi + gv[bj][n] * acc[ai][bj][m][n]; } }
    }
};

struct EpiProjAll {
    static constexpr bool PERM = true, AFTER_DRAIN = false, KEEP_ACC = false;
    static_assert(true, ""); EpiProj1 P; EpiGates G;
    __device__ __forceinline__ void operator()(AccRef acc, const Unit& u, int wr, int wc, int fr, int fq) const {
        if (u.pn < NP1 / BM) P(acc, u, wr, wc, fr, fq);
        else { Unit v = u; v.pn -= NP1 / BM; G(acc, v, wr, wc, fr, fq); }
    }
};
__device__ __forceinline__ void gates8(const unsigned char* p, float (&g)[8]) {
    const v2u w = *(const v2u*)p;
    const f32x2 a = __builtin_amdgcn_cvt_pk_f32_fp8(w.x, false), b = __builtin_amdgcn_cvt_pk_f32_fp8(w.x, true), c = __builtin_amdgcn_cvt_pk_f32_fp8(w.y, false), d = __builtin_amdgcn_cvt_pk_f32_fp8(w.y, true);
    g[0] = fmaxf(0.5f * a.x + 0.5f, 0x1p-10f); g[1] = fmaxf(0.5f * a.y + 0.5f, 0x1p-10f); g[2] = fmaxf(0.5f * b.x + 0.5f, 0x1p-10f); g[3] = fmaxf(0.5f * b.y + 0.5f, 0x1p-10f);
    g[4] = fmaxf(0.5f * c.x + 0.5f, 0x1p-10f); g[5] = fmaxf(0.5f * c.y + 0.5f, 0x1p-10f); g[6] = fmaxf(0.5f * d.x + 0.5f, 0x1p-10f); g[7] = fmaxf(0.5f * d.y + 0.5f, 0x1p-10f);
}
struct EpiMergeAll {
    static constexpr bool PERM = true, AFTER_DRAIN = false, KEEP_ACC = true;
    bf16* O; const unsigned char* G;
    __device__ __forceinline__ void operator()(AccRef, const Unit&, int, int, int, int) const {}
    __device__ __forceinline__ void inplace(pg8::f32x4 (&acc)[2][2][4][2], const Unit& u, int wr, int wc, int fr, int fq) const {
        const int seg = u.pm >> 6, pm = u.pm & 63, pn = u.pn & 3;
        const int row0 = pm * BM + wr * 64 + fr, col0 = pn * BM + wc * 32 + 8 * fq;
#pragma unroll
        for (int ai = 0; ai < 2; ++ai)
#pragma unroll
            for (int m = 0; m < 4; ++m) { const size_t row = (size_t)(row0 + ai * HALF + m * 16); const unsigned char* gp = G + row * NGT + seg * DM + col0;
#pragma unroll
                for (int bj = 0; bj < 2; ++bj) { float gc[8]; gates8(gp + bj * HALF, gc);
                    pg8::f32x4& v0 = acc[ai][bj][m][0]; pg8::f32x4& v1 = acc[ai][bj][m][1];
                    if (seg < 3) { float gn[8]; gates8(gp + DM + bj * HALF, gn);
#pragma unroll
                        for (int e = 0; e < 4; ++e) { v0[e] *= gc[e] * __builtin_amdgcn_rcpf(gn[e]); v1[e] *= gc[4 + e] * __builtin_amdgcn_rcpf(gn[4 + e]); } }
                    else {
#pragma unroll
                        for (int e = 0; e < 4; ++e) { v0[e] *= gc[e]; v1[e] *= gc[4 + e]; }
                        v4u w; w.x = pk2(v0[0], v0[1]); w.y = pk2(v0[2], v0[3]); w.z = pk2(v1[0], v1[1]); w.w = pk2(v1[2], v1[3]); *(v4u*)(O + row * DM + col0 + bj * HALF) = w;
                        v0 = (pg8::f32x4){0.f, 0.f, 0.f, 0.f}; v1 = (pg8::f32x4){0.f, 0.f, 0.f, 0.f}; } } }
    }
};
struct MergeOrder {
    pg8::StaticOrder S;
    __device__ void init(int G_, int c_) { S.init(TOK, DM, G_, c_); }
    __device__ bool next(int i, Unit& u) const { Unit b; if (!S.next(i >> 2, b)) return false; const int seg = i & 3; u.pm = seg * 64 + b.pm; u.pn = seg * 4 + b.pn; return true; }
    __device__ __forceinline__ void a_ready(const Unit&) const {}
    __device__ __forceinline__ void done(const Unit&) const {}
};
}

constexpr int NWAVES = 8, NTHR = 512;
struct Args { const void* in[26]; float* out; unsigned char* ws; int ph_lo, ph_hi; };
enum InIdx { I_X = 0, I_C, I_POS, I_MODW, I_MODB, I_NMG, I_NFG, I_WIN, I_ACW, I_AOUT, I_BCW, I_BCB, I_BLNG, I_BLNB, I_BOUT, I_CPOS, I_CW1, I_CW2, I_COUT, I_DOUT, I_WO, I_PWQ, I_PSUB, I_PU, I_PV, I_FNG };

struct Frame {
    LAS unsigned char* lds; unsigned char* ldsg;
    int tid, lane, wave, G, bid;
    unsigned char* ws;
};
__device__ __forceinline__ int gwave(const Frame& F) { return F.bid * NWAVES + F.wave; }
__device__ __forceinline__ int ngwave(const Frame& F) { return F.G * NWAVES; }

__device__ __forceinline__ int rope_pos_of_dim(int d) { return d < 32 ? 2 * d : 2 * (d - 32) + 1; }
__device__ __forceinline__ int rope_dim_of_pos(int p) { return (p >> 1) + 32 * (p & 1); }
__device__ __forceinline__ int win_row_of_col(int n) {
    if (n < 2560) return n;
    if (n < 3072) { const int c = n - 2560; return C_CQ + (c & ~63) + rope_pos_of_dim(c & 63); }
    if (n < 3200) { const int c = n - 3072; return C_KC + (c & ~63) + rope_pos_of_dim(c & 63); }
    if (n < 3328) return C_VC + (n - 3200);
    if (n < 3456) { const int c = n - 3328; return C_KS + (c & ~63) + rope_pos_of_dim(c & 63); }
    if (n < 3584) return C_VS + (n - 3456);
    if (n < 3712) { const int c = n - 3584; return C_KW + (c & ~63) + rope_pos_of_dim(c & 63); }
    if (n < 3840) return C_VW + (n - 3712);
    if (n < 3864) return C_CG + (n - 3840);
    if (n < 4376) { const int c = n - 3864; return C_DQ + (c & ~63) + rope_pos_of_dim(c & 63); }
    if (n < 4888) { const int c = n - 4376; return C_DK + (c & ~63) + rope_pos_of_dim(c & 63); }
    if (n < 5400) return C_DV + (n - 4888);
    return NP1 + (n - 5400);
}
constexpr int TR_SCR = 17408;
template <int MODE, bool KPERM>
__device__ __forceinline__ void transpose_item(const float* W, int K, int N, bf16* WT, LAS float* scr, int item, int lane) {
    const int nblk = (N + 63) / 64, kb = item / nblk, nb = item % nblk, k0 = 64 * kb, n0 = 64 * nb;
    const int nq = (lane & 15) * 4; const bool nok = n0 + nq < N;
#pragma unroll 4
    for (int i = 0; i < 16; ++i) { const int kk = 4 * i + (lane >> 4); const f32x4 v = nok ? *(const f32x4*)(W + (size_t)(k0 + kk) * N + n0 + nq) : (f32x4){0.f, 0.f, 0.f, 0.f};
        LAS float* d = scr + kk * 65 + nq; d[0] = v[0]; d[1] = v[1]; d[2] = v[2]; d[3] = v[3]; }
    LDS_WAIT(); asm volatile("" ::: "memory");
    const int c = lane & 7;
#pragma unroll
    for (int j = 0; j < 8; ++j) { const int n = (lane >> 3) + 8 * j;
        float s[8];
#pragma unroll
        for (int e = 0; e < 8; ++e) { const int p = 8 * c + e; const int ks = KPERM ? rope_dim_of_pos(p) : p; s[e] = scr[ks * 65 + n]; }
        v4u o; o.x = pk2(s[0], s[1]); o.y = pk2(s[2], s[3]); o.z = pk2(s[4], s[5]); o.w = pk2(s[6], s[7]);
        if (n0 + n < N) { const int row = (MODE == 1) ? win_row_of_col(n0 + n) : (n0 + n); *(v4u*)(WT + (size_t)row * K + k0 + 8 * c) = o; } }
    LDS_WAIT(); asm volatile("" ::: "memory");
}
template <int MODE, bool KPERM>
__device__ __forceinline__ void transpose_matrix(const Frame& F, const float* W, int K, int N, bf16* WT, int& base) {
    LAS float* scr = (LAS float*)(F.lds + F.wave * TR_SCR);
    const int nitems = (K / 64) * ((N + 63) / 64), gw = gwave(F), NGW = ngwave(F);
    int first = (gw - base % NGW + NGW) % NGW;
    for (int it = first; it < nitems; it += NGW) transpose_item<MODE, KPERM>(W, K, N, WT, scr, it, F.lane);
    base += nitems;
}
__device__ __forceinline__ void convert_copy(const Frame& F, const float* src, bf16* dst, size_t n) {
    const size_t nth = (size_t)F.G * NTHR, t0 = (size_t)F.bid * NTHR + F.tid;
    for (size_t i = t0; i < n / 8; i += nth) { const f32x4 a = *(const f32x4*)(src + i * 8), b = *(const f32x4*)(src + i * 8 + 4);
        v4u o; o.x = pk2(a[0], a[1]); o.y = pk2(a[2], a[3]); o.z = pk2(b[0], b[1]); o.w = pk2(b[2], b[3]); *(v4u*)(dst + i * 8) = o; }
}

typedef __attribute__((address_space(4))) const Args* KArgsP;
__device__ __forceinline__ void phase_prologue(const Frame& F, KArgsP Ap) {
    unsigned char* ws = F.ws;
    int base = 0;
    for (int l = 0; l < DEPTH; ++l) {
        transpose_matrix<1, false>(F, (const float*)(GAS const void*)Ap->in[I_WIN] + (size_t)l * DM * 9496, DM, 9496, (bf16*)(ws + WS_WIN) + (size_t)l * NWIN * DM, base);
        transpose_matrix<0, false>(F, (const float*)(GAS const void*)Ap->in[I_AOUT] + (size_t)l * 512 * DM, 512, DM, (bf16*)(ws + WS_WOUT) + (size_t)(l * 4 + 0) * DM * 512, base);
        transpose_matrix<0, false>(F, (const float*)(GAS const void*)Ap->in[I_BOUT] + (size_t)l * 512 * DM, 512, DM, (bf16*)(ws + WS_WOUT) + (size_t)(l * 4 + 1) * DM * 512, base);
        transpose_matrix<0, false>(F, (const float*)(GAS const void*)Ap->in[I_COUT] + (size_t)l * 512 * DM, 512, DM, (bf16*)(ws + WS_WOUT) + (size_t)(l * 4 + 2) * DM * 512, base);
        transpose_matrix<0, false>(F, (const float*)(GAS const void*)Ap->in[I_DOUT] + (size_t)l * 512 * DM, 512, DM, (bf16*)(ws + WS_WOUT) + (size_t)(l * 4 + 3) * DM * 512, base);
        transpose_matrix<0, false>(F, (const float*)(GAS const void*)Ap->in[I_WO] + (size_t)l * DM * DM, DM, DM, (bf16*)(ws + WS_WO) + (size_t)l * DM * DM, base);
        transpose_matrix<0, false>(F, (const float*)(GAS const void*)Ap->in[I_PWQ] + (size_t)l * DM * 2048, DM, 2048, (bf16*)(ws + WS_WQ) + (size_t)l * 2048 * DM, base);
        transpose_matrix<0, true>(F, (const float*)(GAS const void*)Ap->in[I_CW1] + (size_t)(l * 2 + 0) * 2048 * 128, 2048, 128, (bf16*)(ws + WS_W1T) + (size_t)(l * 2 + 0) * 128 * 2048, base);
        transpose_matrix<0, false>(F, (const float*)(GAS const void*)Ap->in[I_CW1] + (size_t)(l * 2 + 1) * 2048 * 128, 2048, 128, (bf16*)(ws + WS_W1T) + (size_t)(l * 2 + 1) * 128 * 2048, base);
    }
    convert_copy(F, (const float*)(GAS const void*)Ap->in[I_PSUB], (bf16*)(ws + WS_SUBK), (size_t)DEPTH * 8 * 2 * 128 * 128);
    const int gt = F.bid * NTHR + F.tid, NGT_ = F.G * NTHR;
    { const float* w2 = (const float*)(GAS const void*)Ap->in[I_CW2]; bf16* w2t = (bf16*)(ws + WS_SMALL + SM_W2T);
      for (int i = gt; i < DEPTH * 2 * 64 * 128; i += NGT_) { const int k = i & 127, n = (i >> 7) & 63, lw = i >> 13; w2t[i] = (bf16)f2bf(w2[((size_t)lw * 128 + k) * 64 + n]); } }
    { const int* pos = (const int*)(GAS const void*)Ap->in[I_POS]; float* ct = (float*)(ws + WS_COS); float* st = (float*)(ws + WS_SIN);
      for (int i = gt; i < TOK * 32; i += NGT_) { const int t = i >> 5, j = i & 31;
          const float inv = 1.0f / powf(10000.0f, (float)(2 * j) / 64.0f); const float ang = (float)pos[t] * inv;
          ct[i] = (float)cos((double)ang); st[i] = (float)sin((double)ang); } }
    { const float* w1 = (const float*)(GAS const void*)Ap->in[I_CW1]; const float* cp = (const float*)(GAS const void*)Ap->in[I_CPOS]; float* pbp = (float*)(ws + WS_SMALL + SM_PBP);
      for (int i = gt; i < DEPTH * 2 * 16 * 128; i += NGT_) { const int n = i & 127, kc = (i >> 7) & 15, lw = i >> 11; float s = 0.f;
          for (int k = kc * 128; k < kc * 128 + 128; ++k) s += cp[(size_t)lw * 2048 + k] * w1[((size_t)lw * 2048 + k) * 128 + n];
          pbp[i] = s; } }
    __syncthreads();
    { LAS float* cond = (LAS float*)(F.lds);
      LAS float* red = (LAS float*)(F.lds + 32768);
      const float* c = (const float*)(GAS const void*)Ap->in[I_C];
      for (int i = F.tid; i < 8 * 1024; i += NTHR) { const float v = c[i]; cond[i] = v / (1.0f + __expf(-v)); }
      __syncthreads();
      for (int un = F.bid; un < DEPTH * 96; un += F.G) { const int l = un / 96, n0 = (un % 96) * 64;
          const float* mw = (const float*)(GAS const void*)Ap->in[I_MODW] + (size_t)l * DM * 6144 + n0 + F.lane;
          float acc[8];
#pragma unroll
          for (int b = 0; b < 8; ++b) acc[b] = 0.f;
#pragma unroll 4
          for (int k = F.wave * 128; k < F.wave * 128 + 128; ++k) { const float w = mw[(size_t)k * 6144];
#pragma unroll
              for (int b = 0; b < 8; ++b) acc[b] += cond[b * 1024 + k] * w; }
#pragma unroll
          for (int b = 0; b < 8; ++b) red[(F.wave * 8 + b) * 64 + F.lane] = acc[b];
          __syncthreads();
          { const int b = F.tid >> 6, n = F.tid & 63; float s = 0.f;
#pragma unroll
            for (int w = 0; w < 8; ++w) s += red[(w * 8 + b) * 64 + n];
            ((float*)(ws + WS_MOD))[((size_t)l * 8 + b) * 6144 + n0 + n] = s + ((const float*)(GAS const void*)Ap->in[I_MODB])[(size_t)l * 6144 + n0 + n]; }
          __syncthreads(); }
    }
}

__device__ __forceinline__ void phase_norm_mod(const Frame& F, const float* X, const float* g, const float* sh, const float* sc, bf16* O, unsigned char* O8 = nullptr, float* OS = nullptr) {
    const int gw = gwave(F), NGW = ngwave(F);
    f32x4 gv[4];
#pragma unroll
    for (int j = 0; j < 4; ++j) gv[j] = *(const f32x4*)(g + 4 * F.lane + 256 * j);
    for (int row = gw; row < TOK; row += NGW) {
        const int b = row / SEQ; const float* xr = X + (size_t)row * DM + 4 * F.lane;
        f32x4 v[4]; float s = 0.f;
#pragma unroll
        for (int j = 0; j < 4; ++j) { v[j] = *(const f32x4*)(xr + 256 * j); s += (v[j][0] * v[j][0] + v[j][1] * v[j][1]) + (v[j][2] * v[j][2] + v[j][3] * v[j][3]); }
        const float r = 1.0f / sqrtf(wave_sum(s, F.lane) * (1.0f / DM) + NORM_EPS);
        bf16* orow = O + (size_t)row * DM + 4 * F.lane;
#pragma unroll
        for (int j = 0; j < 4; ++j) { const f32x4 scv = *(const f32x4*)(sc + (size_t)b * 6144 + 4 * F.lane + 256 * j), shv = *(const f32x4*)(sh + (size_t)b * 6144 + 4 * F.lane + 256 * j);
            const f32x4 y = v[j] * r * gv[j] * (scv + 1.0f) + shv; v2u w; w.x = pk2(y[0], y[1]); w.y = pk2(y[2], y[3]); *(v2u*)(orow + 256 * j) = w; v[j] = y; }
        if (O8) {
            float mx = 0.f;
#pragma unroll
            for (int j = 0; j < 4; ++j) mx = fmaxf(fmaxf(mx, fmaxf(fabsf(v[j][0]), fabsf(v[j][1]))), fmaxf(fabsf(v[j][2]), fabsf(v[j][3])));
#pragma unroll
            for (int o = 1; o < 32; o <<= 1) mx = fmaxf(mx, shx(mx, o, F.lane));
            mx = max32(mx);
            const float qs = mx > 0.f ? 127.0f / mx : 0.f;
#pragma unroll
            for (int j = 0; j < 4; ++j) *(unsigned*)(O8 + (size_t)row * DM + 4 * F.lane + 256 * j) =
                ((unsigned)(int)rintf(v[j][0] * qs) & 0xffu) | (((unsigned)(int)rintf(v[j][1] * qs) & 0xffu) << 8) | (((unsigned)(int)rintf(v[j][2] * qs) & 0xffu) << 16) | (((unsigned)(int)rintf(v[j][3] * qs) & 0xffu) << 24);
            if (F.lane == 0) OS[row] = mx * (1.0f / 127.0f);
        }
    }
}
__device__ __forceinline__ void phase_final_norm(const Frame& F, const float* X, const float* g, float* O) {
    const int gw = gwave(F), NGW = ngwave(F);
    f32x4 gv[4];
#pragma unroll
    for (int j = 0; j < 4; ++j) gv[j] = *(const f32x4*)(g + 4 * F.lane + 256 * j);
    for (int row = gw; row < TOK; row += NGW) {
        const float* xr = X + (size_t)row * DM + 4 * F.lane; f32x4 v[4]; float s = 0.f;
#pragma unroll
        for (int j = 0; j < 4; ++j) { v[j] = *(const f32x4*)(xr + 256 * j); s += (v[j][0] * v[j][0] + v[j][1] * v[j][1]) + (v[j][2] * v[j][2] + v[j][3] * v[j][3]); }
        const float r = 1.0f / sqrtf(wave_sum(s, F.lane) * (1.0f / DM) + NORM_EPS);
        float* orow = O + (size_t)row * DM + 4 * F.lane;
#pragma unroll
        for (int j = 0; j < 4; ++j) *(f32x4*)(orow + 256 * j) = v[j] * r * gv[j];
    }
}

__device__ __forceinline__ void phase_mixer_a(const Frame& F, const bf16* P, const float* cw  , bf16* O  ) {
    const int nth = F.G * NTHR, gt = F.bid * NTHR + F.tid;
    for (int it = gt; it < (TOK / 8) * 64; it += nth) {
        const int cg = it & 63, tb = it >> 6, c0 = cg * 8, t0 = tb * 8, s0 = t0 % SEQ;
        float w0[8], w1[8], w2[8];
#pragma unroll
        for (int e = 0; e < 8; ++e) { w0[e] = cw[c0 + e]; w1[e] = cw[512 + c0 + e]; w2[e] = cw[1024 + c0 + e]; }
        float pm2[8], pm1[8];
#pragma unroll
        for (int e = 0; e < 8; ++e) { pm2[e] = 0.f; pm1[e] = 0.f; }
        for (int pre = 2; pre >= 1; --pre) if (s0 - pre >= 0) { const bf16* r = P + (size_t)(t0 - pre) * NP1;
            const v4u ac = *(const v4u*)(r + C_AC + c0), ax = *(const v4u*)(r + C_AX + c0);
            float pr[8]; pr[0] = bflo(ac.x) * bflo(ax.x); pr[1] = bfhi(ac.x) * bfhi(ax.x); pr[2] = bflo(ac.y) * bflo(ax.y); pr[3] = bfhi(ac.y) * bfhi(ax.y);
            pr[4] = bflo(ac.z) * bflo(ax.z); pr[5] = bfhi(ac.z) * bfhi(ax.z); pr[6] = bflo(ac.w) * bflo(ax.w); pr[7] = bfhi(ac.w) * bfhi(ax.w);
#pragma unroll
            for (int e = 0; e < 8; ++e) { if (pre == 2) pm2[e] = pr[e]; else pm1[e] = pr[e]; } }
#pragma unroll
        for (int tt = 0; tt < 8; ++tt) { const bf16* r = P + (size_t)(t0 + tt) * NP1;
            const v4u ac = *(const v4u*)(r + C_AC + c0), ax = *(const v4u*)(r + C_AX + c0), ab = *(const v4u*)(r + C_AB + c0);
            float pr[8], bb[8], y[8];
            pr[0] = bflo(ac.x) * bflo(ax.x); pr[1] = bfhi(ac.x) * bfhi(ax.x); pr[2] = bflo(ac.y) * bflo(ax.y); pr[3] = bfhi(ac.y) * bfhi(ax.y);
            pr[4] = bflo(ac.z) * bflo(ax.z); pr[5] = bfhi(ac.z) * bfhi(ax.z); pr[6] = bflo(ac.w) * bflo(ax.w); pr[7] = bfhi(ac.w) * bfhi(ax.w);
            bb[0] = bflo(ab.x); bb[1] = bfhi(ab.x); bb[2] = bflo(ab.y); bb[3] = bfhi(ab.y); bb[4] = bflo(ab.z); bb[5] = bfhi(ab.z); bb[6] = bflo(ab.w); bb[7] = bfhi(ab.w);
#pragma unroll
            for (int e = 0; e < 8; ++e) { y[e] = bb[e] * (w0[e] * pm2[e] + w1[e] * pm1[e] + w2[e] * pr[e]); pm2[e] = pm1[e]; pm1[e] = pr[e]; }
            v4u o; o.x = pk2(y[0], y[1]); o.y = pk2(y[2], y[3]); o.z = pk2(y[4], y[5]); o.w = pk2(y[6], y[7]);
            *(v4u*)(O + (size_t)(t0 + tt) * 512 + c0) = o; }
    }
}

__device__ __forceinline__ void phase_mixer_b(const Frame& F, const bf16* P, const float* cw  , const float* cb, const float* lg, const float* lb, bf16* O) {
    LAS float* U = (LAS float*)F.lds;
    for (int un = F.bid; un < TOK / 32; un += F.G) {
        const int t0 = un * 32, s0 = t0 % SEQ;
        __syncthreads();
        for (int i = F.tid; i < 62 * 64; i += NTHR) { const int r = i >> 6, cg = i & 63, c0 = cg * 8; const int srel = s0 - 30 + r;
            float u[8];
            if (srel >= 0) { const bf16* row = P + (size_t)(t0 - 30 + r) * NP1; const v4u a = *(const v4u*)(row + C_BA + c0), g = *(const v4u*)(row + C_BG + c0);
                u[0] = bflo(a.x) * sigmoidf_(bflo(g.x)); u[1] = bfhi(a.x) * sigmoidf_(bfhi(g.x)); u[2] = bflo(a.y) * sigmoidf_(bflo(g.y)); u[3] = bfhi(a.y) * sigmoidf_(bfhi(g.y));
                u[4] = bflo(a.z) * sigmoidf_(bflo(g.z)); u[5] = bfhi(a.z) * sigmoidf_(bfhi(g.z)); u[6] = bflo(a.w) * sigmoidf_(bflo(g.w)); u[7] = bfhi(a.w) * sigmoidf_(bfhi(g.w)); }
            else {
#pragma unroll
                for (int e = 0; e < 8; ++e) u[e] = 0.f; }
            *(LAS f32x4*)(U + r * 512 + c0) = (f32x4){u[0], u[1], u[2], u[3]}; *(LAS f32x4*)(U + r * 512 + c0 + 4) = (f32x4){u[4], u[5], u[6], u[7]}; }
        __syncthreads();
        const int c0 = F.lane * 8;
        float acc[4][8];
#pragma unroll
        for (int q = 0; q < 4; ++q)
#pragma unroll
            for (int e = 0; e < 8; ++e) acc[q][e] = cb[c0 + e];
        for (int k = 0; k < 31; ++k) { const f32x4 wa = *(const f32x4*)(cw + k * 512 + c0), wb = *(const f32x4*)(cw + k * 512 + c0 + 4);
#pragma unroll
            for (int q = 0; q < 4; ++q) { const int r = 4 * F.wave + q + k; const f32x4 ua = *(LAS f32x4*)(U + r * 512 + c0), ub = *(LAS f32x4*)(U + r * 512 + c0 + 4);
                acc[q][0] += wa[0] * ua[0]; acc[q][1] += wa[1] * ua[1]; acc[q][2] += wa[2] * ua[2]; acc[q][3] += wa[3] * ua[3];
                acc[q][4] += wb[0] * ub[0]; acc[q][5] += wb[1] * ub[1]; acc[q][6] += wb[2] * ub[2]; acc[q][7] += wb[3] * ub[3]; } }
        const f32x4 ga = *(const f32x4*)(lg + c0), gb = *(const f32x4*)(lg + c0 + 4), ba = *(const f32x4*)(lb + c0), bb = *(const f32x4*)(lb + c0 + 4);
#pragma unroll
        for (int q = 0; q < 4; ++q) { float s = 0.f;
#pragma unroll
            for (int e = 0; e < 8; ++e) s += acc[q][e];
            const float mu = wave_sum(s, F.lane) * (1.0f / 512.0f); float v = 0.f;
#pragma unroll
            for (int e = 0; e < 8; ++e) { acc[q][e] -= mu; v += acc[q][e] * acc[q][e]; }
            const float rs = 1.0f / sqrtf(wave_sum(v, F.lane) * (1.0f / 512.0f) + NORM_EPS);
            float y[8];
#pragma unroll
            for (int e = 0; e < 8; ++e) { const float gg = e < 4 ? ga[e] : gb[e - 4], bv = e < 4 ? ba[e] : bb[e - 4]; const float z = acc[q][e] * rs * gg + bv; y[e] = z / (1.0f + __expf(-z)); }
            v4u o; o.x = pk2(y[0], y[1]); o.y = pk2(y[2], y[3]); o.z = pk2(y[4], y[5]); o.w = pk2(y[6], y[7]);
            *(v4u*)(O + (size_t)(t0 + 4 * F.wave + q) * 512 + c0) = o; }
    }
}

__device__ __forceinline__ void phase_compress(const Frame& F, const bf16* P, const bf16* W1T  , const bf16* W2T  , const float* PBP  ,
                                               bf16* KC, bf16* VC  ) {
    LAS float* PART = (LAS float*)F.lds;
    LAS bf16* H1 = (LAS bf16*)(F.lds + 69632);
    const int lane = F.lane, r16 = lane & 15, q4 = lane >> 4, w = F.wave;
    for (int un = F.bid; un < 2 * 8 * 2 * 8; un += F.G) {
        const int nb = un & 7, g = (un >> 3) & 1, b = (un >> 4) & 7, which = un >> 7;
        const int n = nb * 16 + r16; const int nn = n < 127 ? n : 126;
        const int col0 = (which == 0 ? C_KC : C_VC) + g * 64;
        const bf16* arow = P + ((size_t)b * SEQ + nn * 16) * NP1 + col0;
        const bf16* w1 = W1T + (size_t)which * 128 * 2048;
        f32x4 acc[8];
#pragma unroll
        for (int j = 0; j < 8; ++j) acc[j] = (f32x4){0.f, 0.f, 0.f, 0.f};
#pragma unroll
        for (int half = 0; half < 2; ++half) {
            bf16x8 a[4], bb[4][8];
#pragma unroll
            for (int s4 = 0; s4 < 4; ++s4) { const int k = w * 256 + (half * 4 + s4) * 32 + q4 * 8;
                a[s4] = *(const bf16x8*)(arow + (size_t)(k >> 6) * NP1 + (k & 63));
#pragma unroll
                for (int j = 0; j < 8; ++j) bb[s4][j] = *(const bf16x8*)(w1 + (size_t)(j * 16 + r16) * 2048 + k); }
#pragma unroll
            for (int s4 = 0; s4 < 4; ++s4)
#pragma unroll
                for (int j = 0; j < 8; ++j) acc[j] = __builtin_amdgcn_mfma_f32_16x16x32_bf16(a[s4], bb[s4][j], acc[j], 0, 0, 0);
        }
        __syncthreads();
#pragma unroll
        for (int j = 0; j < 8; ++j)
#pragma unroll
            for (int i = 0; i < 4; ++i) PART[(w * 16 + 4 * q4 + i) * 132 + j * 16 + r16] = acc[j][i];
        __syncthreads();
        {
            const int row = F.tid >> 5, c4 = (F.tid & 31) * 4;
            f32x4 sacc = (f32x4){0.f, 0.f, 0.f, 0.f};
#pragma unroll
            for (int ww = 0; ww < 8; ++ww) sacc += *(LAS f32x4*)(PART + (ww * 16 + row) * 132 + c4);
#pragma unroll
            for (int kc = 0; kc < 16; ++kc) sacc += *(const f32x4*)(PBP + ((size_t)which * 16 + kc) * 128 + c4);
            v2u o; o.x = pk2(gelu_erf(sacc[0]), gelu_erf(sacc[1])); o.y = pk2(gelu_erf(sacc[2]), gelu_erf(sacc[3]));
            *(LAS v2u*)(H1 + row * 136 + c4) = o;
        }
        __syncthreads();
        if (w < 4) {
            f32x4 o = (f32x4){0.f, 0.f, 0.f, 0.f};
            const bf16* w2 = W2T + (size_t)which * 64 * 128;
#pragma unroll
            for (int ks = 0; ks < 4; ++ks) { const bf16x8 a = *(LAS bf16x8*)(H1 + r16 * 136 + ks * 32 + q4 * 8);
                const bf16x8 bb = *(const bf16x8*)(w2 + (size_t)(w * 16 + r16) * 128 + ks * 32 + q4 * 8);
                o = __builtin_amdgcn_mfma_f32_16x16x32_bf16(a, bb, o, 0, 0, 0); }
            bf16* out = (which == 0 ? KC : VC) + ((size_t)(b * 2 + g) * 128) * 64;
#pragma unroll
            for (int i = 0; i < 4; ++i) { const int row = nb * 16 + 4 * q4 + i; out[(size_t)row * 64 + w * 16 + r16] = row < 127 ? (bf16)f2bf(o[i]) : (bf16)0; }
        }
    }
    __syncthreads();
}
__device__ __forceinline__ void phase_kmean(const Frame& F, const bf16* P, float* KM) {
    const int gw = gwave(F), NGW = ngwave(F), lane = F.lane, rs = lane >> 3, ch = lane & 7;
    for (int un = gw; un < 8 * 8 * 8; un += NGW) { const int h = un & 7, blk = (un >> 3) & 7, b = un >> 6;
        const bf16* base = P + ((size_t)b * SEQ + blk * 256) * NP1 + C_DK + h * 64 + ch * 8;
        float s[8];
#pragma unroll
        for (int e = 0; e < 8; ++e) s[e] = 0.f;
#pragma unroll 8
        for (int i = 0; i < 32; ++i) { const v4u v = *(const v4u*)(base + (size_t)(i * 8 + rs) * NP1);
            s[0] += bflo(v.x); s[1] += bfhi(v.x); s[2] += bflo(v.y); s[3] += bfhi(v.y); s[4] += bflo(v.z); s[5] += bfhi(v.z); s[6] += bflo(v.w); s[7] += bfhi(v.w); }
#pragma unroll
        for (int e = 0; e < 8; ++e) { s[e] += shx(s[e], 8, lane); s[e] += shx(s[e], 16, lane); s[e] = add32(s[e]); }
        if (rs == 0) { float* o = KM + ((size_t)(b * 8 + blk) * 8 + h) * 64 + ch * 8;
            *(f32x4*)o = (f32x4){s[0], s[1], s[2], s[3]} * (1.0f / 256.0f); *(f32x4*)(o + 4) = (f32x4){s[4], s[5], s[6], s[7]} * (1.0f / 256.0f); }
    }
}

constexpr int KT_STRIDE = 144, VT_STRIDE = 192, KT_BYTES = 64 * KT_STRIDE, VT_BYTES = 64 * VT_STRIDE, KV_BUF = KT_BYTES + VT_BYTES;
__device__ __forceinline__ int crow(int r, int hi) { return (r & 3) + 8 * (r >> 2) + 4 * hi; }
struct AttnState { float m, l; f32x16 o0, o1; };
__device__ __forceinline__ void attn_reset(AttnState& st) { st.m = -1e30f; st.l = 0.f;
#pragma unroll
    for (int r = 0; r < 16; ++r) { st.o0[r] = 0.f; st.o1[r] = 0.f; } }
__device__ __forceinline__ s16x4 vtr(LAS const unsigned char* p) { return __builtin_bit_cast(s16x4, __builtin_amdgcn_ds_read_tr16_b64_v4i16((LAS s16x4*)p)); }

__device__ __forceinline__ void attn_scores(LAS const unsigned char* Kt, const bf16x8 (&qr)[4], f32x16& p0, f32x16& p1, int lane) {
    const int r32 = lane & 31, hi = lane >> 5;
#pragma unroll
    for (int r = 0; r < 16; ++r) { p0[r] = 0.f; p1[r] = 0.f; }
#pragma unroll
    for (int s = 0; s < 4; ++s) {
        const bf16x8 a0 = *(LAS const bf16x8*)(Kt + r32 * KT_STRIDE + (2 * s + hi) * 16), a1 = *(LAS const bf16x8*)(Kt + (32 + r32) * KT_STRIDE + (2 * s + hi) * 16);
        p0 = __builtin_amdgcn_mfma_f32_32x32x16_bf16(a0, qr[s], p0, 0, 0, 0);
        p1 = __builtin_amdgcn_mfma_f32_32x32x16_bf16(a1, qr[s], p1, 0, 0, 0);
    }
}
__device__ __forceinline__ void attn_pv(LAS const unsigned char* Vt, const f32x16& e0, const f32x16& e1, f32x16& o0, f32x16& o1, int lane) {
    const int hi = lane >> 5;
    LAS const unsigned char* vb = Vt + (4 * hi + ((lane & 15) >> 2)) * VT_STRIDE + (((lane >> 4) & 1) * 16 + 4 * (lane & 3)) * 2;
#pragma unroll
    for (int s = 0; s < 4; ++s) {
        v4u pw;
        if (s < 2) { pw.x = pk2(e0[8 * s + 0], e0[8 * s + 1]); pw.y = pk2(e0[8 * s + 2], e0[8 * s + 3]); pw.z = pk2(e0[8 * s + 4], e0[8 * s + 5]); pw.w = pk2(e0[8 * s + 6], e0[8 * s + 7]); }
        else { const int t = s - 2; pw.x = pk2(e1[8 * t + 0], e1[8 * t + 1]); pw.y = pk2(e1[8 * t + 2], e1[8 * t + 3]); pw.z = pk2(e1[8 * t + 4], e1[8 * t + 5]); pw.w = pk2(e1[8 * t + 6], e1[8 * t + 7]); }
        const bf16x8 pb = __builtin_bit_cast(bf16x8, pw);
#pragma unroll
        for (int db = 0; db < 2; ++db) {
            const s16x4 lo = vtr(vb + (16 * s) * VT_STRIDE + db * 64), hh = vtr(vb + (16 * s + 8) * VT_STRIDE + db * 64);
            const bf16x8 a = (bf16x8){lo[0], lo[1], lo[2], lo[3], hh[0], hh[1], hh[2], hh[3]};
            if (db == 0) o0 = __builtin_amdgcn_mfma_f32_32x32x16_bf16(a, pb, o0, 0, 0, 0); else o1 = __builtin_amdgcn_mfma_f32_32x32x16_bf16(a, pb, o1, 0, 0, 0);
        }
    }
}
__device__ __forceinline__ float max3f(float a, float b, float c) { float r; asm("v_max3_f32 %0, %1, %2, %3" : "=v"(r) : "v"(a), "v"(b), "v"(c)); return r; }
__device__ __forceinline__ float mask_score(float v, int a, int b, int c) {
    const unsigned sg = (unsigned)(((a + c) | (b - c)) >> 31);
    return __builtin_bit_cast(float, (__builtin_bit_cast(unsigned, v) & ~sg) | (0xf149f2cau & sg));
}
#ifndef ATT_DBG
#define ATT_DBG 0
#endif
__device__ __forceinline__ void attn_tile(LAS const unsigned char* Kt, LAS const unsigned char* Vt, const bf16x8 (&qr)[4], AttnState& st, int kmin, int kmax, int lane, bool dbg = false) {
    const int hi = lane >> 5;
    if (ATT_DBG == 3 && dbg) return;
    if (ATT_DBG == 1 && dbg) { f32x16 p0, p1; attn_scores(Kt, qr, p0, p1, lane); attn_pv(Vt, p0, p1, st.o0, st.o1, lane); return; }
    if (ATT_DBG == 2 && dbg) { f32x16 p0, p1; attn_scores(Kt, qr, p0, p1, lane);
#pragma unroll
        for (int r = 0; r < 16; ++r) { st.o0[r] += p0[r]; st.o1[r] += p1[r]; } return; }
    f32x16 p0, p1; attn_scores(Kt, qr, p0, p1, lane);
    if (!__all(kmin <= 0 && kmax >= 63)) {
        const int a = 4 * hi - kmin, b = kmax - 4 * hi;
#pragma unroll
        for (int r = 0; r < 16; ++r) { const int c = (r & 3) + 8 * (r >> 2); p0[r] = mask_score(p0[r], a, b, c); p1[r] = mask_score(p1[r], a, b, c + 32); }
    }
    asm volatile("s_nop 15\n\ts_nop 7" : "+v"(p0), "+v"(p1));
    float mx = max3f(p0[0], p0[1], p1[0]), mx2 = max3f(p0[2], p0[3], p1[1]);
    mx = max3f(mx, p1[2], p1[3]);
#pragma unroll
    for (int r = 4; r < 16; r += 4) { mx = max3f(mx, p0[r], p0[r + 1]); mx2 = max3f(mx2, p0[r + 2], p0[r + 3]); mx = max3f(mx, p1[r], p1[r + 1]); mx2 = max3f(mx2, p1[r + 2], p1[r + 3]); }
    mx = max3f(mx, mx2, mx2);
    mx = max32(mx);
    const float mn = fmaxf(st.m, mx), me = fmaxf(mn, -1e29f), alpha = __builtin_amdgcn_exp2f(st.m - me);
    float rs = 0.f;
#pragma unroll
    for (int r = 0; r < 16; ++r) { p0[r] = __builtin_amdgcn_exp2f(p0[r] - me); p1[r] = __builtin_amdgcn_exp2f(p1[r] - me); rs += p0[r] + p1[r]; }
    st.m = mn; st.l = st.l * alpha + rs;
    if (__any(alpha < 1.0f)) {
#pragma unroll
        for (int r = 0; r < 16; ++r) { st.o0[r] *= alpha; st.o1[r] *= alpha; }
    }
    attn_pv(Vt, p0, p1, st.o0, st.o1, lane);
}
struct KVRegs { v4u k, v; };
__device__ __forceinline__ void kv_load(KVRegs& r, const bf16* Kg, const bf16* Vg, size_t ld, int tid) {
    const int key = tid >> 3, ch = tid & 7;
    r.k = *(const v4u*)(Kg + (size_t)key * ld + ch * 8); r.v = *(const v4u*)(Vg + (size_t)key * ld + ch * 8);
}
__device__ __forceinline__ void kv_store(const KVRegs& r, LAS unsigned char* buf, int tid) {
    const int key = tid >> 3, ch = tid & 7;
    *(LAS v4u*)(buf + key * KT_STRIDE + ch * 16) = r.k; *(LAS v4u*)(buf + KT_BYTES + key * VT_STRIDE + ch * 16) = r.v;
}

__device__ __forceinline__ float attn_inv_l(const AttnState& st) { const float l = add32(st.l); return 1.0f / fmaxf(l, 1e-30f); }

#define ATTN_STREAM(Kg, Vg, ld, j0, j1, SKIP, RANGE) do { \
    int jn_ = (j0); while (jn_ < (j1) && (SKIP(jn_))) ++jn_; \
    if (jn_ < (j1)) { KVRegs kv_; kv_load(kv_, (Kg) + (size_t)jn_ * 64 * (ld), (Vg) + (size_t)jn_ * 64 * (ld), (ld), F.tid); \
        __syncthreads(); kv_store(kv_, ring, F.tid); int cur_ = 0; \
        for (;;) { const int j_ = jn_; ++jn_; while (jn_ < (j1) && (SKIP(jn_))) ++jn_; const bool more_ = jn_ < (j1); \
            if (more_) kv_load(kv_, (Kg) + (size_t)jn_ * 64 * (ld), (Vg) + (size_t)jn_ * 64 * (ld), (ld), F.tid); \
            __syncthreads(); \
            { int kmin_, kmax_; RANGE(j_, kmin_, kmax_); \
              if (__any(kmax_ >= kmin_)) attn_tile(ring + cur_ * KV_BUF, ring + cur_ * KV_BUF + KT_BYTES, qr, st, kmin_, kmax_, F.lane, dbgflag); } \
            if (!more_) break; \
            kv_store(kv_, ring + (cur_ ^ 1) * KV_BUF, F.tid); cur_ ^= 1; } } } while (0)

__device__ __forceinline__ void nsa_unit(const Frame& F, const bf16* P, const bf16* KC, const bf16* VC, bf16* O  , int b, int g, int i) {
    const bool dbgflag = false;
    LAS unsigned char* ring = F.lds;
    LAS float* impb = (LAS float*)(F.lds + 2 * KV_BUF);
    LAS unsigned* selm = (LAS unsigned*)(F.lds + 2 * KV_BUF + 33792);
    LAS float* stash = (LAS float*)(F.lds + 2 * KV_BUF + 33792 + 256) + F.tid;
    const int lane = F.lane, r32 = lane & 31, hi = lane >> 5, hr = F.wave & 3, th = F.wave >> 2;
    const int tl = 32 * th + r32;
    const int s = 64 * i + tl;
    const size_t row = (size_t)b * SEQ + s;
    const int head = g * 4 + hr;
    bf16x8 qr[4];
#pragma unroll
    for (int d = 0; d < 4; ++d) qr[d] = *(const bf16x8*)(P + row * NP1 + C_CQ + head * 64 + d * 16 + hi * 8);
    const float g0 = sigmoidf_(bf2f(P[row * NP1 + C_CG + head])), g1 = sigmoidf_(bf2f(P[row * NP1 + C_CG + 8 + head])), g2 = sigmoidf_(bf2f(P[row * NP1 + C_CG + 16 + head]));
    AttnState st;
    {
        const bf16* Kg = KC + (size_t)(b * 2 + g) * 128 * 64; const bf16* Vg = VC + (size_t)(b * 2 + g) * 128 * 64;
        const int nmax = (s >= 31) ? ((s - 31) >> 4) : -1;
        { KVRegs kv0, kv1; kv_load(kv0, Kg, Vg, 64, F.tid); kv_load(kv1, Kg + 64 * 64, Vg + 64 * 64, 64, F.tid);
          __syncthreads();
          kv_store(kv0, ring, F.tid); kv_store(kv1, ring + KV_BUF, F.tid); }
        __syncthreads();
        attn_reset(st);
        attn_tile(ring, ring + KT_BYTES, qr, st, 0, nmax < 63 ? nmax : 63, lane);
        attn_tile(ring + KV_BUF, ring + KV_BUF + KT_BYTES, qr, st, 0, nmax - 64 < 63 ? nmax - 64 : 63, lane);
        const float inv = attn_inv_l(st);
        { const float sc = g0 * inv;
#pragma unroll
          for (int r = 0; r < 16; ++r) { stash[r * 512] = st.o0[r] * sc; stash[(16 + r) * 512] = st.o1[r] * sc; } }
        if (i >= 16) {
            float xprev = 0.f; const float mfin = st.m;
#define NSA_IMP(U, ACC, GQ) do { const float G_ = ((ACC[4 * (GQ)] + ACC[4 * (GQ) + 1]) + (ACC[4 * (GQ) + 2] + ACC[4 * (GQ) + 3])), L_ = ACC[4 * (GQ) + 3]; \
                const float x_ = other32(L_, hi); impb[(hr * 64 + tl) * 33 + 2 * (U) + hi] = G_ + (hi ? x_ : xprev); xprev = x_; } while (0)
#pragma unroll
            for (int tile = 0; tile < 2; ++tile) {
                f32x16 a0, a1; attn_scores(ring + tile * KV_BUF, qr, a0, a1, lane);
#pragma unroll
                for (int r = 0; r < 16; ++r) { const int c = (r & 3) + 8 * (r >> 2);
                    a0[r] = __builtin_amdgcn_exp2f(mask_score(a0[r], 4 * hi, nmax - 64 * tile - 4 * hi, c) - mfin) * inv; a1[r] = __builtin_amdgcn_exp2f(mask_score(a1[r], 4 * hi, nmax - 64 * tile - 4 * hi, c + 32) - mfin) * inv; }
                NSA_IMP(8 * tile + 0, a0, 0); NSA_IMP(8 * tile + 1, a0, 1); NSA_IMP(8 * tile + 2, a0, 2); NSA_IMP(8 * tile + 3, a0, 3);
                NSA_IMP(8 * tile + 4, a1, 0); NSA_IMP(8 * tile + 5, a1, 1); NSA_IMP(8 * tile + 6, a1, 2); NSA_IMP(8 * tile + 7, a1, 3);
            }
#undef NSA_IMP
        }
    }
    __syncthreads();
    unsigned mymask;
    if (i < 16) mymask = (2u << i) - 1u;
    else {
        { const int tk = F.tid >> 3, js = F.tid & 7; unsigned bits = 0u;
          float v[4];
#pragma unroll
          for (int e = 0; e < 4; ++e) { const int j = js * 4 + e; v[e] = (impb[(0 * 64 + tk) * 33 + j] + impb[(1 * 64 + tk) * 33 + j]) + (impb[(2 * 64 + tk) * 33 + j] + impb[(3 * 64 + tk) * 33 + j]); }
          int rank[4] = {0, 0, 0, 0};
          for (int jj = 1; jj <= i - 2; ++jj) { const float o = (impb[(0 * 64 + tk) * 33 + jj] + impb[(1 * 64 + tk) * 33 + jj]) + (impb[(2 * 64 + tk) * 33 + jj] + impb[(3 * 64 + tk) * 33 + jj]);
#pragma unroll
              for (int e = 0; e < 4; ++e) { const int j = js * 4 + e; rank[e] += (o > v[e] || (o == v[e] && jj < j)) ? 1 : 0; } }
#pragma unroll
          for (int e = 0; e < 4; ++e) { const int j = js * 4 + e; const bool forced = (j == 0) || (j == i) || (j == i - 1); const bool cand = (j >= 1) && (j <= i - 2);
              if (forced || (cand && rank[e] < 13)) bits |= 1u << j; }
          bits |= shxu(bits, 1, F.lane); bits |= shxu(bits, 2, F.lane); bits |= shxu(bits, 4, F.lane);
          if (js == 0) selm[tk] = bits; }
        __syncthreads();
        mymask = selm[tl];
    }
    {
        attn_reset(st);
        const bf16* Kg = P + (size_t)b * SEQ * NP1 + C_KS + g * 64; const bf16* Vg = P + (size_t)b * SEQ * NP1 + C_VS + g * 64;
#define NSA_SKIP(j) (false)
#define NSA_RANGE(j, kmin, kmax) do { kmin = 0; kmax = ((mymask >> (j)) & 1u) ? ((j) == i ? tl : 63) : -1; } while (0)
        ATTN_STREAM(Kg, Vg, (size_t)NP1, 0, i + 1, NSA_SKIP, NSA_RANGE);
#undef NSA_RANGE
        const float sc = g1 * attn_inv_l(st);
#pragma unroll
        for (int r = 0; r < 16; ++r) { stash[r * 512] += st.o0[r] * sc; stash[(16 + r) * 512] += st.o1[r] * sc; }
    }
    {
        attn_reset(st);
        const bf16* Kg = P + (size_t)b * SEQ * NP1 + C_KW + g * 64; const bf16* Vg = P + (size_t)b * SEQ * NP1 + C_VW + g * 64;
        const int jlo = i >= 8 ? i - 8 : 0; f32x16 out0, out1;
#define NSA_RANGE(j, kmin, kmax) do { const int d_ = 64 * (i - (j)) + tl; kmin = d_ - 511 > 0 ? d_ - 511 : 0; kmax = d_ < 63 ? d_ : 63; } while (0)
        ATTN_STREAM(Kg, Vg, (size_t)NP1, jlo, i + 1, NSA_SKIP, NSA_RANGE);
#undef NSA_RANGE
#undef NSA_SKIP
        const float sc = g2 * attn_inv_l(st);
#pragma unroll
        for (int r = 0; r < 16; ++r) { out0[r] = stash[r * 512] + st.o0[r] * sc; out1[r] = stash[(16 + r) * 512] + st.o1[r] * sc; }
        bf16* orow = O + row * 512 + head * 64;
#pragma unroll
        for (int gq = 0; gq < 4; ++gq) {
            v2u w0; w0.x = pk2(out0[4 * gq], out0[4 * gq + 1]); w0.y = pk2(out0[4 * gq + 2], out0[4 * gq + 3]); *(v2u*)(orow + 8 * gq + 4 * hi) = w0;
            v2u w1; w1.x = pk2(out1[4 * gq], out1[4 * gq + 1]); w1.y = pk2(out1[4 * gq + 2], out1[4 * gq + 3]); *(v2u*)(orow + 32 + 8 * gq + 4 * hi) = w1; }
    }
}
__device__ __forceinline__ void phase_nsa(const Frame& F, const bf16* P, const bf16* KC, const bf16* VC, bf16* O) {
    for (int un2 = 2 * F.bid; un2 < 512; un2 += 2 * F.G)
#pragma unroll 1
        for (int k = 0; k < 2; ++k) { const int un = un2 >> 1, ip = un & 15, g = (un >> 4) & 1, b = un >> 5; nsa_unit(F, P, KC, VC, O, b, g, k == 0 ? 31 - ip : ip); }
}

__device__ __forceinline__ void moba_unit(const Frame& F, const bf16* P, const float* KM, bf16* O  , int b, int h, int qb, bool dbgflag = false) {
    LAS unsigned char* ring = F.lds;
    LAS float* kml = (LAS float*)(F.lds + 2 * KV_BUF);
    LAS unsigned* uni = (LAS unsigned*)(F.lds + 2 * KV_BUF + 2048);
    const int lane = F.lane, r32 = lane & 31, hi = lane >> 5;
    const int tl = 32 * F.wave + r32;
    const size_t row = (size_t)b * SEQ + 256 * qb + tl;
    bf16x8 qr[4];
#pragma unroll
    for (int d = 0; d < 4; ++d) qr[d] = *(const bf16x8*)(P + row * NP1 + C_DQ + h * 64 + d * 16 + hi * 8);
    __syncthreads();
    { const int blk = F.tid >> 6, p = F.tid & 63; kml[F.tid] = KM[((size_t)(b * 8 + blk) * 8 + h) * 64 + p]; if (F.tid == 0) uni[0] = 0u; }
    __syncthreads();
    unsigned mymask = 0u;
    if (qb > 0) {
        float gt[8];
#pragma unroll
        for (int n = 0; n < 8; ++n) { float a = 0.f;
#pragma unroll
            for (int d = 0; d < 4; ++d) { const v4u qw = __builtin_bit_cast(v4u, qr[d]); const LAS float* km = kml + n * 64 + d * 16 + hi * 8;
                a += bflo(qw.x) * km[0] + bfhi(qw.x) * km[1] + bflo(qw.y) * km[2] + bfhi(qw.y) * km[3] + bflo(qw.z) * km[4] + bfhi(qw.z) * km[5] + bflo(qw.w) * km[6] + bfhi(qw.w) * km[7]; }
            a = add32(a); gt[n] = a; }
#pragma unroll
        for (int n = 0; n < 8; ++n) { int rank = 0;
#pragma unroll
            for (int m = 0; m < 8; ++m) rank += (m < qb && m != n && (gt[m] > gt[n] || (gt[m] == gt[n] && m < n))) ? 1 : 0;
            if (n < qb && rank < 3) mymask |= 1u << n; }
        atomicOr((unsigned*)uni, mymask);
    }
    __syncthreads();
    const unsigned um = uni[0];
    AttnState st; attn_reset(st);
    const bf16* Kg = P + (size_t)b * SEQ * NP1 + C_DK + h * 64; const bf16* Vg = P + (size_t)b * SEQ * NP1 + C_DV + h * 64;
#define MOBA_SKIP(j) ((j) < 4 * qb && !((um >> ((j) >> 2)) & 1u))
#define MOBA_RANGE(j, kmin, kmax) do { kmin = 0; if ((j) < 4 * qb) kmax = ((mymask >> ((j) >> 2)) & 1u) ? 63 : -1; else { const int d_ = tl - 64 * ((j) - 4 * qb); kmax = d_ < 63 ? d_ : 63; } } while (0)
    ATTN_STREAM(Kg, Vg, (size_t)NP1, 0, 4 * qb + 4, MOBA_SKIP, MOBA_RANGE);
#undef MOBA_SKIP
#undef MOBA_RANGE
    const float sc = attn_inv_l(st);
    bf16* orow = O + row * 512 + h * 64;
#pragma unroll
    for (int gq = 0; gq < 4; ++gq) {
        v2u w0; w0.x = pk2(st.o0[4 * gq] * sc, st.o0[4 * gq + 1] * sc); w0.y = pk2(st.o0[4 * gq + 2] * sc, st.o0[4 * gq + 3] * sc); *(v2u*)(orow + 8 * gq + 4 * hi) = w0;
        v2u w1; w1.x = pk2(st.o1[4 * gq] * sc, st.o1[4 * gq + 1] * sc); w1.y = pk2(st.o1[4 * gq + 2] * sc, st.o1[4 * gq + 3] * sc); *(v2u*)(orow + 32 + 8 * gq + 4 * hi) = w1; }
}
__device__ __forceinline__ void phase_moba(const Frame& F, const bf16* P, const float* KM, bf16* O, bool dbgflag = false) {
    for (int un2 = 2 * F.bid; un2 < 512; un2 += 2 * F.G)
#pragma unroll 1
        for (int k = 0; k < 2; ++k) { const int un = un2 >> 1, qp = un & 3, h = (un >> 2) & 7, b = un >> 5; moba_unit(F, P, KM, O, b, h, k == 0 ? 7 - qp : qp, dbgflag); }
}

__device__ __forceinline__ unsigned ord_key(float x) { const unsigned u = __builtin_bit_cast(unsigned, x); return (u & 0x80000000u) ? ~u : (u | 0x80000000u); }
__device__ __forceinline__ float ord_val(unsigned k) { const unsigned u = (k & 0x80000000u) ? (k & 0x7fffffffu) : ~k; return __builtin_bit_cast(float, u); }
__device__ __forceinline__ void ce_desc(unsigned& a, unsigned& b) { const unsigned hi_ = a > b ? a : b, lo_ = a > b ? b : a; a = hi_; b = lo_; }
__device__ __forceinline__ void bitonic_merge16_desc(unsigned* a) {
#pragma unroll
    for (int j = 8; j > 0; j >>= 1)
#pragma unroll
        for (int i = 0; i < 16; ++i) if ((i & j) == 0) ce_desc(a[i], a[i | j]);
}
__device__ __forceinline__ void bitonic_sort16_desc(unsigned* a) {
#pragma unroll
    for (int k = 2; k <= 16; k <<= 1)
#pragma unroll
        for (int j = k >> 1; j > 0; j >>= 1)
#pragma unroll
            for (int i = 0; i < 16; ++i) { const int l = i ^ j; if (l > i) { if ((i & k) == 0) ce_desc(a[i], a[l]); else ce_desc(a[l], a[i]); } }
}
__device__ __forceinline__ void merge_top16(unsigned* a, const unsigned* b) {
#pragma unroll
    for (int i = 0; i < 16; ++i) a[i] = a[i] > b[15 - i] ? a[i] : b[15 - i];
    bitonic_merge16_desc(a);
}
constexpr int SK_STRIDE = 272;
__device__ __forceinline__ void peer_route_unit(const Frame& F, const bf16* Q2, const bf16* SUBK  , int* EIDX, float* EW, int tb, int h) {
    LAS unsigned char* skl = F.lds;
    LAS unsigned* slot = (LAS unsigned*)(F.lds + 36864) + F.tid;
    const int lane = F.lane, r32 = lane & 31, hi = lane >> 5;
    const size_t tok = (size_t)tb * 256 + F.wave * 32 + r32;
#pragma unroll 1
    for (int p = 0; p < 2; ++p) {
        __syncthreads();
        for (int i = F.tid; i < 128 * 16; i += NTHR) { const int ch = i & 15, rowi = i >> 4;
            *(LAS v4u*)(skl + rowi * SK_STRIDE + ch * 16) = *(const v4u*)(SUBK + ((size_t)h * 256 + p * 128 + rowi) * 128 + ch * 8); }
        __syncthreads();
        bf16x8 qf[8]; float ss = 0.f;
#pragma unroll
        for (int s = 0; s < 8; ++s) { qf[s] = *(const bf16x8*)(Q2 + tok * 2048 + h * 256 + p * 128 + s * 16 + hi * 8); const v4u w = __builtin_bit_cast(v4u, qf[s]);
            const float a0 = bflo(w.x), a1 = bfhi(w.x), a2 = bflo(w.y), a3 = bfhi(w.y), a4 = bflo(w.z), a5 = bfhi(w.z), a6 = bflo(w.w), a7 = bfhi(w.w);
            ss += (a0 * a0 + a1 * a1) + (a2 * a2 + a3 * a3) + (a4 * a4 + a5 * a5) + (a6 * a6 + a7 * a7); }
        ss = add32(ss);
        const float rn = 1.0f / sqrtf(ss * (1.0f / 128.0f) + NORM_EPS);
        unsigned key[64];
#pragma unroll
        for (int nb = 0; nb < 4; ++nb) { f32x16 acc;
#pragma unroll
            for (int r = 0; r < 16; ++r) acc[r] = 0.f;
#pragma unroll
            for (int s = 0; s < 8; ++s) { const bf16x8 a = *(LAS const bf16x8*)(skl + (nb * 32 + r32) * SK_STRIDE + (2 * s + hi) * 16);
                acc = __builtin_amdgcn_mfma_f32_32x32x16_bf16(a, qf[s], acc, 0, 0, 0); }
#pragma unroll
            for (int r = 0; r < 16; ++r) { const int n = nb * 32 + crow(r, hi); key[nb * 16 + r] = (ord_key(acc[r] * rn) & 0xffffff80u) | (unsigned)(127 - n); } }
#pragma unroll
        for (int blk = 0; blk < 4; ++blk) bitonic_sort16_desc(key + 16 * blk);
        merge_top16(key, key + 16); merge_top16(key + 32, key + 48); merge_top16(key, key + 32);
        { unsigned oth[16];
#pragma unroll
          for (int i = 0; i < 16; ++i) { unsigned r0, r1; swap32(key[i], r0, r1); oth[i] = hi ? r0 : r1; }
          merge_top16(key, oth); }
#pragma unroll
        for (int k = 0; k < 16; ++k) slot[(p * 16 + k) * 512] = key[k];
    }
    LDS_WAIT(); asm volatile("" ::: "memory");
    unsigned ck[64];
    { float v1[16], v2[16];
#pragma unroll
      for (int k = 0; k < 16; ++k) { v1[k] = ord_val(slot[k * 512] & 0xffffff80u); v2[k] = ord_val(slot[(16 + k) * 512] & 0xffffff80u); }
      int c = 0;
#pragma unroll
      for (int a = 0; a < 16; ++a)
#pragma unroll
          for (int bq = 0; bq < 16; ++bq) if ((a + 1) * (bq + 1) <= 16) { ck[c] = (ord_key(v1[a] + v2[bq]) & 0xffffff00u) | (unsigned)(255 - (16 * a + bq)); ++c; }
#pragma unroll
      for (int q = 50; q < 64; ++q) ck[q] = 0u; }
#pragma unroll
    for (int blk = 0; blk < 4; ++blk) bitonic_sort16_desc(ck + 16 * blk);
    merge_top16(ck, ck + 16); merge_top16(ck + 32, ck + 48); merge_top16(ck, ck + 32);
    float den = 0.f; const float mx = ord_val(ck[0] & 0xffffff00u);
#pragma unroll
    for (int k = 0; k < 16; ++k) { const unsigned m = ck[k];
        const int ci = 255 - (int)(m & 255u), a = ci >> 4, bq = ci & 15;
        const unsigned ka = slot[a * 512], kb = slot[(16 + bq) * 512];
        const int te = (127 - (int)(ka & 127u)) * 128 + (127 - (int)(kb & 127u));
        const float ek = __expf(ord_val(m & 0xffffff00u) - mx); den += ek;
        slot[(32 + k) * 512] = __builtin_bit_cast(unsigned, ek);
        if (hi == 0) EIDX[(tok * 8 + h) * 16 + k] = te; }
    LDS_WAIT(); asm volatile("" ::: "memory");
    if (hi == 0) { const float inv = 1.0f / den; float* ewp = EW + (tok * 8 + h) * 16;
#pragma unroll
        for (int q = 0; q < 4; ++q) *(f32x4*)(ewp + 4 * q) = (f32x4){__builtin_bit_cast(float, slot[(32 + 4 * q) * 512]), __builtin_bit_cast(float, slot[(33 + 4 * q) * 512]),
                                                                      __builtin_bit_cast(float, slot[(34 + 4 * q) * 512]), __builtin_bit_cast(float, slot[(35 + 4 * q) * 512])} * inv; }
}

__device__ __forceinline__ void phase_peer_route(const Frame& F, const bf16* Q2, const bf16* SUBK, int* EIDX, float* EW) {
    for (int un = F.bid; un < 64 * 8; un += F.G) peer_route_unit(F, Q2, SUBK, EIDX, EW, un >> 3, un & 7);
}

__device__ __forceinline__ void phase_peer_tables(const Frame& F, const float* U, const float* V, unsigned char* UT8, unsigned char* VT8, float* SU, float* SV) {
    const int gw = gwave(F), NGW = ngwave(F), lane = F.lane;
    for (int r = gw; r < 2 * 16384; r += NGW) {
        const int tab = r >> 14, e = r & 16383; const float* src = (tab ? V : U) + (size_t)e * DM + 16 * lane;
        f32x4 x[4]; float mx = 0.f;
#pragma unroll
        for (int q = 0; q < 4; ++q) { x[q] = *(const f32x4*)(src + 4 * q); mx = fmaxf(fmaxf(mx, fmaxf(fabsf(x[q][0]), fabsf(x[q][1]))), fmaxf(fabsf(x[q][2]), fabsf(x[q][3]))); }
#pragma unroll
        for (int o = 1; o < 32; o <<= 1) mx = fmaxf(mx, shx(mx, o, lane));
        mx = max32(mx);
        int ex = 0; (void)frexpf(mx, &ex);
        const int k = (mx > 0.f) ? (8 - ex) : 0;
        const float sc = __builtin_ldexpf(1.0f, k), inv = __builtin_ldexpf(1.0f, -k);
        v4u w; float rowscale = inv;
        if (tab) {
#pragma unroll
            for (int q = 0; q < 4; ++q) { unsigned p = 0u; p = __builtin_amdgcn_cvt_pk_fp8_f32(x[q][0] * sc, x[q][1] * sc, p, false); p = __builtin_amdgcn_cvt_pk_fp8_f32(x[q][2] * sc, x[q][3] * sc, p, true); w[q] = p; }
        } else {
            const float qs = mx > 0.f ? 127.0f / mx : 0.f; rowscale = mx > 0.f ? mx * (1.0f / 127.0f) : 0.f;
#pragma unroll
            for (int q = 0; q < 4; ++q) w[q] = ((unsigned)(int)rintf(x[q][0] * qs) & 0xffu) | (((unsigned)(int)rintf(x[q][1] * qs) & 0xffu) << 8) | (((unsigned)(int)rintf(x[q][2] * qs) & 0xffu) << 16) | (((unsigned)(int)rintf(x[q][3] * qs) & 0xffu) << 24);
        }
        *(v4u*)((tab ? VT8 : UT8) + ((size_t)(lane >> 3) * 16384 + e) * 128 + (lane & 7) * 16) = w;
        if (lane == 0) (tab ? SV : SU)[e] = rowscale;
    }
}
typedef _Float16 h16x2 __attribute__((ext_vector_type(2)));
typedef __fp16 fp16x2_t __attribute__((ext_vector_type(2)));
__device__ __forceinline__ void phase_peer_u(const Frame& F, const unsigned char* H8, const float* HS, const unsigned char* UT8, const float* SU, const int* EIDX, float* PART, unsigned emask = 0x3fffu) {
    const int lane = F.lane, g = lane >> 3, sub = lane & 7, b0 = lane & 1, b1 = (lane >> 1) & 1, b2 = (lane >> 2) & 1;
    const int s = F.bid & 7, wgq = F.bid >> 3, nq = F.G >> 3;
    LAS int* il = (LAS int*)(F.lds + F.wave * 8192);
    LAS float* pcl = (LAS float*)(F.lds + F.wave * 8192 + 4096);
    const unsigned char* ub = UT8 + (size_t)s * 16384 * 128 + sub * 16;
    for (int batch = wgq * 8 + F.wave; batch < TOK / 8; batch += nq * 8) {
        const int t0 = batch * 8, t = t0 + g;
        { const v4u* src = (const v4u*)(EIDX + (size_t)t0 * 128 + lane * 16);
          const v4u i0 = src[0], i1 = src[1], i2 = src[2], i3 = src[3];
          LAS v4u* dst = (LAS v4u*)(il + lane * 16); dst[0] = i0 & emask; dst[1] = i1 & emask; dst[2] = i2 & emask; dst[3] = i3 & emask; }
        const v4u h = *(const v4u*)(H8 + (size_t)t * DM + s * 128 + sub * 16);
        const float hs = HS[t];
        LDS_WAIT(); asm volatile("" ::: "memory");
#define PU_LOAD(c, ua, su_) do { const v4u ia = *(LAS v4u*)(il + g * 128 + (c) * 8), ib = *(LAS v4u*)(il + g * 128 + (c) * 8 + 4); \
            ua[0] = *(const v4u*)(ub + (size_t)ia.x * 128); ua[1] = *(const v4u*)(ub + (size_t)ia.y * 128); ua[2] = *(const v4u*)(ub + (size_t)ia.z * 128); ua[3] = *(const v4u*)(ub + (size_t)ia.w * 128); \
            ua[4] = *(const v4u*)(ub + (size_t)ib.x * 128); ua[5] = *(const v4u*)(ub + (size_t)ib.y * 128); ua[6] = *(const v4u*)(ub + (size_t)ib.z * 128); ua[7] = *(const v4u*)(ub + (size_t)ib.w * 128); \
            su_ = SU[il[g * 128 + (c) * 8 + sub]] * hs; } while (0)
#define PU_COMP(c, ua, su_) do { float a[8]; \
            _Pragma("unroll") for (int j = 0; j < 8; ++j) { int acc = __builtin_amdgcn_sdot4((int)ua[j].x, (int)h.x, 0, false); acc = __builtin_amdgcn_sdot4((int)ua[j].y, (int)h.y, acc, false); \
                acc = __builtin_amdgcn_sdot4((int)ua[j].z, (int)h.z, acc, false); acc = __builtin_amdgcn_sdot4((int)ua[j].w, (int)h.w, acc, false); a[j] = (float)acc; } \
            float bq[4], cc[2]; \
            _Pragma("unroll") for (int p = 0; p < 4; ++p) { const float keep = b0 ? a[2 * p + 1] : a[2 * p], send = b0 ? a[2 * p] : a[2 * p + 1]; bq[p] = keep + shx(send, 1, lane); } \
            _Pragma("unroll") for (int q = 0; q < 2; ++q) { const float keep = b1 ? bq[2 * q + 1] : bq[2 * q], send = b1 ? bq[2 * q] : bq[2 * q + 1]; cc[q] = keep + shx(send, 2, lane); } \
            { const float keep = b2 ? cc[1] : cc[0], send = b2 ? cc[0] : cc[1]; pcl[(c) * 64 + lane] = (keep + shx(send, 4, lane)) * su_; } } while (0)
        { v4u uA[8], uB[8]; float sA, sB;
          PU_LOAD(0, uA, sA);
#pragma unroll 1
          for (int c = 0; c < 16; c += 2) {
              PU_LOAD(c + 1, uB, sB);
              PU_COMP(c, uA, sA);
              if (c + 2 < 16) PU_LOAD(c + 2, uA, sA);
              PU_COMP(c + 1, uB, sB);
          } }
#undef PU_LOAD
#undef PU_COMP
        LDS_WAIT(); asm volatile("" ::: "memory");
        float* dst = PART + ((size_t)s * TOK + t) * 128 + sub;
#pragma unroll
        for (int c = 0; c < 16; ++c) dst[8 * c] = pcl[c * 64 + lane];
        LDS_WAIT(); asm volatile("" ::: "memory");
    }
}
__device__ __forceinline__ float gelu_as(float v) {
    const float av = fabsf(v), t = __builtin_amdgcn_rcpf(av * 0.2316418882f + 1.0f);
    float q = t * 0.5307027145f + (-0.7265760135f); q = q * t + 0.7107068705f; q = q * t + (-0.142248368f); q = q * t + 0.127414796f; q = q * t;
    const float m = v * (q * __builtin_amdgcn_exp2f((v * v) * (-0.72134752044f)));
    return v < 0.f ? m : v - m;
}
__device__ __forceinline__ void phase_peer_w(const Frame& F, const float* SV, const int* EIDX, const float* EW, const float* PART, v2u* COEF) {
    const int nth = F.G * NTHR;
    for (int i = F.bid * NTHR + F.tid; i < TOK * 128; i += nth) {
        float act = 0.f;
#pragma unroll
        for (int sp = 0; sp < 8; ++sp) act += PART[(size_t)sp * TOK * 128 + i];
        const int e = EIDX[i]; const float c = EW[i] * gelu_as(act) * SV[e];
        COEF[i] = (v2u){(unsigned)e, __builtin_bit_cast(unsigned, c)};
    }
}
__device__ __forceinline__ void phase_peer_v(const Frame& F, const unsigned char* VT8, const v2u* COEF, float* XB, const float* gate, unsigned emask = 0x3fffu) {
    const int lane = F.lane, g = lane >> 3, sub = lane & 7;
    const int s = F.bid & 7, wgq = F.bid >> 3, nq = F.G >> 3;
    LAS v2u* wl = (LAS v2u*)(F.lds + F.wave * 8192);
    const unsigned char* vb = VT8 + (size_t)s * 16384 * 128 + sub * 16;
    for (int batch = wgq * 8 + F.wave; batch < TOK / 8; batch += nq * 8) {
        const int t0 = batch * 8, t = t0 + g;
        { const v4u* src = (const v4u*)(COEF + (size_t)t0 * 128) + lane * 8;
          v4u c[8];
#pragma unroll
          for (int q = 0; q < 8; ++q) c[q] = src[q];
          LAS v4u* dst = (LAS v4u*)wl + lane * 8;
#pragma unroll
          for (int q = 0; q < 8; ++q) { v4u x = c[q]; x.x &= emask; x.z &= emask; dst[q] = x; } }
        LDS_WAIT(); asm volatile("" ::: "memory");
        h16x2 o[8];
#pragma unroll
        for (int q = 0; q < 8; ++q) o[q] = (h16x2){(_Float16)0.f, (_Float16)0.f};
#define PV_LOAD(c, pr, va) do { \
            _Pragma("unroll") for (int q = 0; q < 4; ++q) pr[q] = *(LAS v4u*)(wl + g * 128 + (c) * 8 + 2 * q); \
            _Pragma("unroll") for (int q = 0; q < 4; ++q) { va[2 * q] = *(const v4u*)(vb + (size_t)pr[q].x * 128); va[2 * q + 1] = *(const v4u*)(vb + (size_t)pr[q].z * 128); } } while (0)
#define PV_COMP(pr, va) do { \
            _Pragma("unroll") for (int j = 0; j < 8; ++j) { const unsigned cb = (j & 1) ? pr[j >> 1].w : pr[j >> 1].y; \
                const float s2 = __builtin_bit_cast(float, cb & 0x7f800000u); const _Float16 mh = (_Float16)__builtin_bit_cast(float, (cb & 0x807fffffu) | 0x3f800000u); const h16x2 m2 = (h16x2){mh, mh}; \
                _Pragma("unroll") for (int q = 0; q < 4; ++q) { o[2 * q] = __builtin_elementwise_fma(__builtin_bit_cast(h16x2, __builtin_amdgcn_cvt_scalef32_pk_f16_fp8(va[j][q], s2, false)), m2, o[2 * q]); \
                    o[2 * q + 1] = __builtin_elementwise_fma(__builtin_bit_cast(h16x2, __builtin_amdgcn_cvt_scalef32_pk_f16_fp8(va[j][q], s2, true)), m2, o[2 * q + 1]); } } } while (0)
        { v4u pA[4], pB[4], vA[8], vB[8];
          PV_LOAD(0, pA, vA);
#pragma unroll 1
          for (int c = 0; c < 16; c += 2) {
              PV_LOAD(c + 1, pB, vB);
              PV_COMP(pA, vA);
              if (c + 2 < 16) PV_LOAD(c + 2, pA, vA);
              PV_COMP(pB, vB);
          } }
#undef PV_LOAD
#undef PV_COMP
        const int bb = t / SEQ; float* xr = XB + (size_t)t * DM + s * 128 + sub * 16; const float* gr = gate + (size_t)bb * 6144 + s * 128 + sub * 16;
#pragma unroll
        for (int q = 0; q < 4; ++q) { const f32x4 x = *(const f32x4*)(xr + 4 * q), gg = *(const f32x4*)(gr + 4 * q);
            *(f32x4*)(xr + 4 * q) = x + gg * (f32x4){(float)o[2 * q].x, (float)o[2 * q].y, (float)o[2 * q + 1].x, (float)o[2 * q + 1].y}; }
        LDS_WAIT(); asm volatile("" ::: "memory");
    }
}

constexpr int NPL = 12, NPHASE = 1 + DEPTH * NPL + 1;
constexpr int CW_BAR = 1024;
static_assert((CW_BAR + XCD_BAR_WORDS) * 4 <= (int)CTL_ZERO_BYTES, "barrier words inside the memset region");

__global__ void __launch_bounds__(NTHR, 2) hybrid_fwd(Args args) {
    extern __shared__ __attribute__((aligned(16))) unsigned char lds[];
    Frame F;
    F.lds = (LAS unsigned char*)lds; F.ldsg = lds;
    F.tid = threadIdx.x; F.lane = F.tid & 63; F.wave = __builtin_amdgcn_readfirstlane(F.tid >> 6);
    F.G = gridDim.x; F.bid = blockIdx.x; F.ws = args.ws;
    GAS unsigned char* wsg = (GAS unsigned char*)args.ws;
#define WSP ((unsigned char*)wsg)
    volatile LAS unsigned* MISC = (volatile LAS unsigned*)(F.lds + MISC_OFF);
    for (int u = F.tid; u < 64; u += NTHR) ((LAS unsigned*)(F.lds + MISC_OFF))[u] = 0u;
    __syncthreads();
    XcdBarrier bar; bar.bar = (unsigned*)(WSP + WS_CTL) + CW_BAR; bar.x = 0; bar.st = nullptr;
    const int lo = args.ph_lo, hi = args.ph_hi;
    if (hi - lo > 1) bar = xcd_barrier_post((unsigned*)(WSP + WS_CTL) + CW_BAR, MISC + 8);
#ifndef PHMASK
#define PHMASK 0xffffffffu
#endif
#define PM(j) ((PHMASK >> (j)) & 1u)
#ifndef DUMMY_EMASK
#define DUMMY_EMASK 0x3fffu
#endif
#ifndef RPMASK
#define RPMASK 0u
#endif
#define RP(j) for (int rp_ = 0; rp_ < 1 + (int)((RPMASK >> (j)) & 1u); ++rp_)
#define LASTRP(j) (rp_ == (int)((RPMASK >> (j)) & 1u))
#define IN(k) (lo <= (k) && (k) < hi)
#define SEAM(k) do { if (IN(k) && IN((k) + 1)) { xcd_barrier(bar); if ((RPMASK >> 30) & 1u) xcd_barrier(bar); } } while (0)

    typedef __attribute__((address_space(4))) const Args* KArgs;
    KArgs ap = (KArgs)__builtin_amdgcn_kernarg_segment_ptr();
#define FRESH() asm volatile("" : "+s"(ap), "+s"(wsg)); Frame Fp = F; asm volatile("" : "+v"(Fp.tid)); Fp.lane = Fp.tid & 63; asm volatile("" : "+s"(Fp.wave), "+s"(Fp.bid), "+s"(Fp.G)); Fp.ws = WSP; LAS unsigned char* ring = Fp.lds; asm volatile("" : "+s"(ring)); Fp.lds = ring
#define INP(i) ((const float*)(GAS const float*)ap->in[i])
#define WIN_ ((bf16*)(WSP + WS_WIN))
#define WOUT_ ((bf16*)(WSP + WS_WOUT))
#define WOT_ ((bf16*)(WSP + WS_WO))
#define WQT_ ((bf16*)(WSP + WS_WQ))
#define W1T_ ((bf16*)(WSP + WS_W1T))
#define SUBK_ ((bf16*)(WSP + WS_SUBK))
#define W2T_ ((bf16*)(WSP + WS_SMALL + SM_W2T))
#define MOD_ ((float*)(WSP + WS_MOD))
#define COS_ ((const float*)(WSP + WS_COS))
#define SIN_ ((const float*)(WSP + WS_SIN))
#define KMEAN_ ((float*)(WSP + WS_SMALL + SM_KMEAN))
#define KCMP_ ((bf16*)(WSP + WS_SMALL + SM_KCMP))
#define VCMP_ ((bf16*)(WSP + WS_SMALL + SM_VCMP))
#define PBP_ ((float*)(WSP + WS_SMALL + SM_PBP))
#define EIDX_ ((int*)(WSP + WS_EIDX))
#define EW_ ((float*)(WSP + WS_EW))
#define HN_ ((bf16*)(WSP + WS_HN))
#define MIX_ ((bf16*)(WSP + WS_MIX))
#define PROJ_ ((bf16*)(WSP + WS_BIG))
#define GATES_ ((unsigned char*)(WSP + WS_GATES))
#define UT_ ((unsigned char*)(WSP + WS_BIG))
#define VT_ ((unsigned char*)(WSP + WS_BIG + 16 * MiB))
#define SU_ ((float*)(WSP + WS_BIG + 32 * MiB))
#define SV_ ((float*)(WSP + WS_BIG + 32 * MiB + 65536))
#define COEF_ ((v2u*)(WSP + WS_BIG + 33 * MiB))
#define H8_ ((unsigned char*)(WSP + WS_BIG + 128 * MiB))
#define HS_ ((float*)(WSP + WS_BIG + 144 * MiB))
#define Q2_ ((bf16*)(WSP + WS_BIG + 64 * MiB))
#define PART_ ((float*)(WSP + WS_BIG + 64 * MiB))
#define XB_ ((float*)(GAS float*)ap->out)
#define MODL_ (MOD_ + (size_t)l * 8 * 6144)
#define XIN_ ((l == 0) ? INP(I_X) : (const float*)XB_)

    if (PM(0) && IN(0)) RP(0) { FRESH(); phase_prologue(Fp, ap); }
    SEAM(0);
#pragma unroll 1
    for (int l = 0; l < DEPTH; ++l) {
        const int p0 = 1 + l * NPL;
        if (PM(1) && IN(p0 + 0)) RP(1) { FRESH(); phase_norm_mod(Fp, XIN_, INP(I_NMG) + l * DM, MODL_ + 0, MODL_ + 1024, HN_); }
        SEAM(p0 + 0);
        if (PM(2) && IN(p0 + 1)) RP(2) { FRESH(); pg8::Gemm g{HN_, WIN_ + (size_t)l * NWIN * DM, TOK, NWIN, DM}; pg8::StaticOrder S; S.init(TOK, NWIN, Fp.G, Fp.bid);
            epi::EpiProjAll E{{PROJ_, COS_, SIN_}, {GATES_}}; pg8::gemm_phase<epi::EpiProjAll, pg8::StaticOrder, true, true>(ring, g, S, E, Fp.tid); }
        SEAM(p0 + 1);
        if (PM(3) && IN(p0 + 2)) RP(3) {
            { FRESH(); phase_compress(Fp, PROJ_, W1T_ + (size_t)l * 2 * 128 * 2048, W2T_ + (size_t)l * 2 * 64 * 128, PBP_ + (size_t)l * 2 * 16 * 128, KCMP_, VCMP_); }
            { FRESH(); phase_kmean(Fp, PROJ_, KMEAN_); }
            { FRESH(); phase_mixer_a(Fp, PROJ_, INP(I_ACW) + (size_t)l * 3 * 512, MIX_); }
            __syncthreads();
            { FRESH(); phase_mixer_b(Fp, PROJ_, INP(I_BCW) + (size_t)l * 31 * 512, INP(I_BCB) + l * 512, INP(I_BLNG) + l * 512, INP(I_BLNB) + l * 512, MIX_ + (size_t)TOK * 512); }
            __syncthreads();
        }
        SEAM(p0 + 2);
        if (PM(4) && IN(p0 + 3)) { RP(4) { FRESH(); phase_nsa(Fp, PROJ_, KCMP_, VCMP_, MIX_ + (size_t)2 * TOK * 512); __syncthreads(); }
                                   RP(5) { FRESH(); phase_moba(Fp, PROJ_, KMEAN_, MIX_ + (size_t)3 * TOK * 512, !LASTRP(5)); __syncthreads(); } }
        SEAM(p0 + 3);
        if (PM(7) && IN(p0 + 4)) RP(7) { FRESH(); pg8::Gemm g{MIX_, WOUT_ + (size_t)(l * 4) * DM * 512, 4 * TOK, 4 * DM, 512}; epi::MergeOrder S; S.init(Fp.G, Fp.bid);
            epi::EpiMergeAll E{HN_, GATES_}; pg8::gemm_phase<epi::EpiMergeAll, epi::MergeOrder, true, true>(ring, g, S, E, Fp.tid); }
        SEAM(p0 + 4);
        if (PM(8) && IN(p0 + 5)) RP(8) { FRESH(); pg8::Gemm g{HN_, WOT_ + (size_t)l * DM * DM, TOK, DM, DM}; pg8::StaticOrder S; S.init(TOK, DM, Fp.G, Fp.bid);
            epi::EpiResid E{XIN_, LASTRP(8) ? XB_ : (float*)MIX_, MODL_ + 2048}; pg8::gemm_phase<epi::EpiResid, pg8::StaticOrder, true, true>(ring, g, S, E, Fp.tid); }
        SEAM(p0 + 5);
        if (PM(9) && IN(p0 + 6)) RP(9) {
            { FRESH(); phase_norm_mod(Fp, XB_, INP(I_NFG) + l * DM, MODL_ + 3072, MODL_ + 4096, HN_, H8_, HS_); }
            { FRESH(); phase_peer_tables(Fp, INP(I_PU) + (size_t)l * 16384 * DM, INP(I_PV) + (size_t)l * 16384 * DM, UT_, VT_, SU_, SV_); }
        }
        SEAM(p0 + 6);
        if (PM(10) && IN(p0 + 7)) RP(10) { FRESH(); pg8::Gemm g{HN_, WQT_ + (size_t)l * 2048 * DM, TOK, 2048, DM}; pg8::StaticOrder S; S.init(TOK, 2048, Fp.G, Fp.bid);
            epi::EpiStoreBf E{Q2_, 2048}; pg8::gemm_phase<epi::EpiStoreBf, pg8::StaticOrder, true, true>(ring, g, S, E, Fp.tid); }
        SEAM(p0 + 7);
        if (PM(11) && IN(p0 + 8)) RP(11) { FRESH(); phase_peer_route(Fp, Q2_, SUBK_ + (size_t)l * 8 * 2 * 128 * 128, EIDX_, EW_); __syncthreads(); }
        SEAM(p0 + 8);
        if (PM(12) && IN(p0 + 9)) RP(12) { FRESH(); phase_peer_u(Fp, H8_, HS_, UT_, SU_, EIDX_, LASTRP(12) ? PART_ : (float*)MIX_, LASTRP(12) ? 0x3fffu : DUMMY_EMASK); }
        SEAM(p0 + 9);
        if (PM(12) && IN(p0 + 10)) { FRESH(); phase_peer_w(Fp, SV_, EIDX_, EW_, PART_, COEF_); }
        SEAM(p0 + 10);
        if (PM(12) && IN(p0 + 11)) RP(14) { FRESH(); phase_peer_v(Fp, VT_, COEF_, LASTRP(14) ? XB_ : (float*)MIX_, MODL_ + 5120, LASTRP(14) ? 0x3fffu : DUMMY_EMASK); }
        SEAM(p0 + 11);
    }
    if (PM(13) && IN(NPHASE - 1)) { FRESH(); phase_final_norm(Fp, XB_, INP(I_FNG), XB_); }
#ifdef DBG_STOP
    if (IN(NPHASE)) { FRESH();
        const bf16* src = (const bf16*)(WSP + (size_t)DBG_OFF); const size_t n = (size_t)DBG_BYTES / 2, NO = (size_t)TOK * DM; float* o = (float*)ap->out;
        for (size_t i = (size_t)Fp.bid * NTHR + Fp.tid; i < NO; i += (size_t)Fp.G * NTHR) { float a = 0.f; for (size_t j = i; j < n; j += NO) a += bf2f(src[j]);
#ifdef DBG_OFF2
            { const float* s2 = (const float*)(WSP + (size_t)DBG_OFF2); const size_t n2 = (size_t)DBG_BYTES2 / 4; for (size_t j = i; j < n2; j += NO) a += s2[j]; }
#endif
            if (!(a == a) || fabsf(a) > 1e30f) a = 12345.0f;
            o[i] = a; } }
#endif
#undef IN
#undef SEAM
#undef WSP
}

extern "C" void kernel_launch(void* const* d_in, const int* in_sizes, int n_in, void* d_out, int out_size, void* d_ws, size_t ws_size, hipStream_t stream) {
    static int grid = 0;
    if (grid == 0) {
        if (n_in != 26 || in_sizes[0] != TOK * DM || out_size != TOK * DM || ws_size < WS_END) {
            fprintf(stderr, "kernel_launch: unexpected problem (n_in %d, in0 %d, out %d, WSP %zu); nothing launched\n", n_in, n_in > 0 ? in_sizes[0] : -1, out_size, ws_size); grid = -1; return; }
        int dev = 0, cus = 0, per_cu = 0;
        if (hipGetDevice(&dev) != hipSuccess || hipDeviceGetAttribute(&cus, hipDeviceAttributeMultiprocessorCount, dev) != hipSuccess) { grid = -1; return; }
        if (hipFuncSetAttribute((const void*)hybrid_fwd, hipFuncAttributeMaxDynamicSharedMemorySize, LDS_BYTES) != hipSuccess) { fprintf(stderr, "kernel_launch: hipFuncSetAttribute failed\n"); grid = -1; return; }
        if (hipOccupancyMaxActiveBlocksPerMultiprocessor(&per_cu, (const void*)hybrid_fwd, NTHR, LDS_BYTES) != hipSuccess || per_cu < 1)
            fprintf(stderr, "kernel_launch: note: occupancy query reports %d workgroups per CU\n", per_cu);
        (void)hipGetLastError();
        grid = cus;
    }
    if (grid < 0) return;
    if (hipMemsetAsync((char*)d_ws + WS_CTL, 0, CTL_ZERO_BYTES, stream) != hipSuccess) return;
    Args a{};
    for (int i = 0; i < 26; ++i) a.in[i] = d_in[i];
    a.out = (float*)d_out; a.ws = (unsigned char*)d_ws;
#if MK_PER_PHASE
#ifdef DBG_STOP
    for (int p = 0; p <= DBG_STOP; ++p) { a.ph_lo = p; a.ph_hi = p + 1; hipLaunchKernelGGL(hybrid_fwd, dim3(grid), dim3(NTHR), LDS_BYTES, stream, a); }
    a.ph_lo = NPHASE; a.ph_hi = NPHASE + 1; hipLaunchKernelGGL(hybrid_fwd, dim3(grid), dim3(NTHR), LDS_BYTES, stream, a);
#else
    for (int p = 0; p < NPHASE; ++p) { a.ph_lo = p; a.ph_hi = p + 1; hipLaunchKernelGGL(hybrid_fwd, dim3(grid), dim3(NTHR), LDS_BYTES, stream, a); }
#endif
#else
    a.ph_lo = 0; a.ph_hi = NPHASE; hipLaunchKernelGGL(hybrid_fwd, dim3(grid), dim3(NTHR), LDS_BYTES, stream, a);
#endif
    const hipError_t le = hipPeekAtLastError();
    if (le != hipSuccess) fprintf(stderr, "kernel_launch: launch failed: %s\n", hipGetErrorName(le));
}
```

```cpp
#include <hip/hip_runtime.h>
#include <hip/hip_bf16.h>
#include <cstdio>
#include <cstdint>
#include <cmath>

#ifndef MK_PER_PHASE
#define MK_PER_PHASE 0
#endif

#define GAS __attribute__((address_space(1)))
#define LAS __attribute__((address_space(3)))
typedef unsigned short bf16;
typedef unsigned v4u __attribute__((ext_vector_type(4)));
typedef unsigned v2u __attribute__((ext_vector_type(2)));
typedef float f32x4 __attribute__((ext_vector_type(4)));
typedef float f32x2 __attribute__((ext_vector_type(2)));
typedef float f32x16 __attribute__((ext_vector_type(16)));
typedef short bf16x8 __attribute__((ext_vector_type(8)));
typedef short s16x4 __attribute__((ext_vector_type(4)));
typedef __bf16 bf16x2_t __attribute__((ext_vector_type(2)));

constexpr int BATCH = 8, SEQ = 2048, DM = 1024, DEPTH = 2, TOK = BATCH * SEQ;
constexpr int NP1 = 5632;
constexpr int NGT = 4096;
constexpr int NWIN = NP1 + NGT;
constexpr int C_AB = 0, C_AC = 512, C_AX = 1024, C_BA = 1536, C_BG = 2048, C_CQ = 2560, C_KC = 3072, C_VC = 3200, C_KS = 3328, C_VS = 3456, C_KW = 3584, C_VW = 3712,
              C_DQ = 3840, C_DK = 4352, C_DV = 4864, C_CG = 5376;
constexpr float NORM_EPS = 1e-6f;
constexpr float QSCALE = 0.125f * 1.4426950408889634f;

constexpr size_t MiB = 1u << 20;
constexpr size_t WS_CTL = 0, CTL_ZERO_BYTES = 64 * 1024;
constexpr size_t WS_MOD = 1 * MiB;
constexpr size_t WS_COS = 2 * MiB, WS_SIN = 4 * MiB;
constexpr size_t WS_SMALL = 6 * MiB;
constexpr size_t SM_KMEAN = 704 * 1024;
constexpr size_t SM_KCMP = 64 * 1024;
constexpr size_t SM_VCMP = 320 * 1024;
constexpr size_t SM_PBP = 576 * 1024;
constexpr size_t SM_W2T = 640 * 1024;
constexpr size_t WS_EIDX = 8 * MiB;
constexpr size_t WS_EW = 16 * MiB;
constexpr size_t WS_WIN = 24 * MiB;
constexpr size_t WS_WOUT = 62 * MiB;
constexpr size_t WS_WO = 70 * MiB;
constexpr size_t WS_WQ = 74 * MiB;
constexpr size_t WS_W1T = 82 * MiB;
constexpr size_t WS_SUBK = 84 * MiB;
constexpr size_t WS_HN = 86 * MiB;
constexpr size_t WS_MIX = 118 * MiB;
constexpr size_t WS_BIG = 182 * MiB;
constexpr size_t WS_GATES = 358 * MiB;
constexpr size_t WS_END = 486 * MiB;

constexpr int LDS_BYTES = 147456;
constexpr int RING_BYTES = 131072;
constexpr int MISC_OFF = LDS_BYTES - 256;

#define RLX_AGENT __ATOMIC_RELAXED, __HIP_MEMORY_SCOPE_AGENT
#define LDS_WAIT() asm volatile("s_waitcnt lgkmcnt(0)" ::: "memory")
#define VM_WAIT() asm volatile("s_waitcnt vmcnt(0)" ::: "memory")
__device__ __forceinline__ unsigned f2bf(float f) { unsigned u = __builtin_bit_cast(unsigned, f); return (u + 0x7fffu + ((u >> 16) & 1u)) >> 16; }
__device__ __forceinline__ float bf2f(unsigned h) { return __builtin_bit_cast(float, h << 16); }
__device__ __forceinline__ unsigned pk2(float lo, float hi) { f32x2 v = {lo, hi}; bf16x2_t b = __builtin_convertvector(v, bf16x2_t); return __builtin_bit_cast(unsigned, b); }
__device__ __forceinline__ float bflo(unsigned w) { return __builtin_bit_cast(float, w << 16); }
__device__ __forceinline__ float bfhi(unsigned w) { return __builtin_bit_cast(float, w & 0xffff0000u); }
__device__ __forceinline__ float sigmoidf_(float x) { return __builtin_amdgcn_rcpf(1.0f + __builtin_amdgcn_exp2f(x * -1.4426950408889634f)); }
__device__ __forceinline__ float gelu_erf(float x) { return 0.5f * x * (1.0f + erff(x * 0.70710678118654752f)); }
__device__ __forceinline__ float shx(float v, int m, int lane) { return __builtin_bit_cast(float, __builtin_amdgcn_ds_bpermute((lane ^ m) << 2, __builtin_bit_cast(int, v))); }
__device__ __forceinline__ unsigned shxu(unsigned v, int m, int lane) { return (unsigned)__builtin_amdgcn_ds_bpermute((lane ^ m) << 2, (int)v); }
__device__ __forceinline__ void swap32(unsigned v, unsigned& r0, unsigned& r1) { unsigned b = v; asm volatile("" : "+v"(b)); auto r = __builtin_amdgcn_permlane32_swap(v, b, false, false); r0 = r[0]; r1 = r[1]; }
__device__ __forceinline__ float other32(float v, int hi) { unsigned r0, r1; swap32(__builtin_bit_cast(unsigned, v), r0, r1); return __builtin_bit_cast(float, hi ? r0 : r1); }
__device__ __forceinline__ float add32(float v) { unsigned r0, r1; swap32(__builtin_bit_cast(unsigned, v), r0, r1); return __builtin_bit_cast(float, r0) + __builtin_bit_cast(float, r1); }
__device__ __forceinline__ float max32(float v) { unsigned r0, r1; swap32(__builtin_bit_cast(unsigned, v), r0, r1); return fmaxf(__builtin_bit_cast(float, r0), __builtin_bit_cast(float, r1)); }
__device__ __forceinline__ unsigned umax32(unsigned v) { unsigned r0, r1; swap32(v, r0, r1); return r0 > r1 ? r0 : r1; }
__device__ __forceinline__ float wave_sum(float v, int lane) {
#pragma unroll
    for (int o = 1; o < 32; o <<= 1) v += shx(v, o, lane);
    return add32(v);
}
namespace pg8 {
#define PG8_LAS __attribute__((address_space(3)))
typedef unsigned short bf16_t;
typedef short bf16x8 __attribute__((ext_vector_type(8)));
typedef float f32x4 __attribute__((ext_vector_type(4)));
typedef unsigned u32x4 __attribute__((ext_vector_type(4)));
constexpr int BM = 256, BK = 64, HALF = 128, HTB = HALF * BK * 2  , STAGE_BYTES = 8 * HTB, NXCD = 8, WGM = 8;

__host__ __device__ __forceinline__ int lds_byte(int r, int c) { const int st = (r >> 4) * 2 + (c >> 5), rr = r & 15, cc = c & 31, ob = rr * 64 + cc * 2; return st * 1024 + (ob ^ (((ob >> 9) & 1) << 5)); }
__host__ __device__ __forceinline__ void stage_rc(int b, int& R, int& C) { const int st = b / 1024, sb = b % 1024, swz = sb ^ (((sb >> 9) & 1) << 5); R = (st >> 1) * 16 + swz / 64; C = (st & 1) * 32 + (swz % 64) / 2; }
__host__ __device__ __forceinline__ int perm32(int rho) { const int n = rho >> 4, i = rho & 15; return 8 * (i >> 2) + 4 * n + (i & 3); }

struct Unit { int pm, pn; };
struct Gemm { const bf16_t* A; const bf16_t* Bt; int M, N, K; };

struct StaticOrder {
    int nM, nN, nwg, G, c;
    __host__ __device__ void init(int M, int N, int G_, int c_) { nM = M / BM; nN = N / BM; nwg = nM * nN; G = G_; c = c_; }
    __host__ __device__ bool next(int i, Unit& u) const {
        const long L = (long)i * G + c; if (L >= nwg) return false;
        int wgid = (int)L; { const int q = nwg / NXCD, r = nwg % NXCD, xcd = wgid % NXCD, off = wgid / NXCD; wgid = (xcd < r ? xcd * (q + 1) : r * (q + 1) + (xcd - r) * q) + off; }
        const int nig = WGM * nN, gid = wgid / nig, fm = gid * WGM, gsz = (nM - fm) < WGM ? (nM - fm) : WGM;
        u.pm = fm + ((wgid % nig) % gsz); u.pn = (wgid % nig) / gsz; return true;
    }
    __device__ __forceinline__ void a_ready(const Unit&) const {}
    __device__ __forceinline__ void done(const Unit&) const {}
};

__device__ __forceinline__ unsigned cvt_pk_bf16(float lo, float hi) { unsigned r; asm volatile("v_cvt_pk_bf16_f32 %0, %1, %2" : "=v"(r) : "v"(lo), "v"(hi)); return r; }
typedef float f32x2 __attribute__((ext_vector_type(2)));
template <class Epi, class Sched, bool ALIGN_EPI = false, bool SP2 = false>
__device__ __forceinline__ void gemm_phase(PG8_LAS unsigned char* lds, const Gemm g, const Sched& S, const Epi& E, const int tid) {
    const int wid = __builtin_amdgcn_readfirstlane(tid >> 6), lane = tid & 63, wr = wid >> 2, wc = wid & 3, fr = lane & 15, fq = lane >> 4;
    const int K = g.K, nt = K / BK;
    unsigned voffA[2], voffB[2];
#pragma unroll
    for (int i = 0; i < 2; ++i) { int R, C; stage_rc(tid * 16 + i * 8192, R, C); const int Rb = Epi::PERM ? ((R & ~31) + perm32(R & 31)) : R;
        voffA[i] = (unsigned)(R * K + C) * 2u; voffB[i] = (unsigned)(Rb * K + C) * 2u; }
    const size_t kstep = (size_t)(BK * 2);
    const size_t hstep = (size_t)HALF * K * 2;
    const size_t tstep = 2 * hstep;
    const unsigned ldsw = (unsigned)wid * 1024u;
    const int aoff = lds_byte(wr * 64 + fr, fq * 8), boff = lds_byte(wc * 32 + fr, fq * 8);
#define PG8_SA(b, h) (((b) * 2 + (h)) * HTB)
#define PG8_SB(b, h) ((4 + (b) * 2 + (h)) * HTB)
#define PG8_STAGE(bufoff, gbase, voff) do { _Pragma("unroll") for (int _i = 0; _i < 2; ++_i) \
        __builtin_amdgcn_global_load_lds((const unsigned*)((const char*)(gbase) + (voff)[_i]), (PG8_LAS unsigned*)(lds + (bufoff) + ldsw + _i * 8192), 16, 0, 0); } while (0)
#define PG8_LDA(dst, b, h) do { _Pragma("unroll") for (int m = 0; m < 4; ++m) _Pragma("unroll") for (int k = 0; k < 2; ++k) dst[m][k] = *(const PG8_LAS bf16x8*)(lds + PG8_SA(b, h) + aoff + m * 2048 + k * 1024); } while (0)
#define PG8_LDB(dst, b, h) do { _Pragma("unroll") for (int n = 0; n < 2; ++n) _Pragma("unroll") for (int k = 0; k < 2; ++k) dst[n][k] = *(const PG8_LAS bf16x8*)(lds + PG8_SB(b, h) + boff + n * 2048 + k * 1024); } while (0)
#define PG8_MMA(ai, bj, At, Bt) do { __builtin_amdgcn_s_setprio(1); _Pragma("unroll") for (int m = 0; m < 4; ++m) _Pragma("unroll") for (int n = 0; n < 2; ++n) _Pragma("unroll") for (int k = 0; k < 2; ++k) \
        acc[ai][bj][m][n] = __builtin_amdgcn_mfma_f32_16x16x32_bf16(Bt[n][k], At[m][k], acc[ai][bj][m][n], 0, 0, 0); __builtin_amdgcn_s_setprio(0); } while (0)
#define PG8_WAIT_V(n) asm volatile("s_waitcnt vmcnt(" #n ")" ::: "memory")
#define PG8_WAIT_L(n) asm volatile("s_waitcnt lgkmcnt(" #n ")" ::: "memory")
#define PG8_BAR __builtin_amdgcn_s_barrier()
#define PG8_SCHED __builtin_amdgcn_sched_barrier(0)
    Unit cur, nxt; int ui = 0;
    if (!S.next(0, cur)) return;
    f32x4 acc[2][2][4][2];
#pragma unroll
    for (int a = 0; a < 2; ++a)
#pragma unroll
        for (int b = 0; b < 2; ++b)
#pragma unroll
            for (int m = 0; m < 4; ++m)
#pragma unroll
                for (int n = 0; n < 2; ++n) acc[a][b][m][n] = (f32x4){0.f, 0.f, 0.f, 0.f};
    bf16x8 At[4][2], B0[2][2], B1[2][2];
    const char* cA = (const char*)g.A + (size_t)cur.pm * tstep; const char* cB = (const char*)g.Bt + (size_t)cur.pn * tstep;
    S.a_ready(cur);
    if constexpr (SP2) {
        PG8_STAGE(PG8_SB(0, 0), cB, voffB); PG8_STAGE(PG8_SB(0, 1), cB + hstep, voffB); PG8_STAGE(PG8_SA(0, 0), cA, voffA); PG8_STAGE(PG8_SA(0, 1), cA + hstep, voffA);
        if (wr == 1) PG8_BAR;
        PG8_WAIT_V(2); PG8_BAR;
        PG8_STAGE(PG8_SB(1, 0), cB + kstep, voffB); PG8_STAGE(PG8_SA(1, 0), cA + kstep, voffA); PG8_STAGE(PG8_SB(1, 1), cB + hstep + kstep, voffB);
        PG8_WAIT_V(6); PG8_BAR;
    } else {
        PG8_STAGE(PG8_SB(0, 0), cB, voffB); PG8_STAGE(PG8_SA(0, 0), cA, voffA); PG8_STAGE(PG8_SB(0, 1), cB + hstep, voffB); PG8_STAGE(PG8_SA(0, 1), cA + hstep, voffA);
        if (wr == 1) PG8_BAR;
        PG8_WAIT_V(4); PG8_BAR;
        PG8_STAGE(PG8_SB(1, 0), cB + kstep, voffB); PG8_STAGE(PG8_SA(1, 0), cA + kstep, voffA); PG8_STAGE(PG8_SB(1, 1), cB + hstep + kstep, voffB);
        PG8_WAIT_V(6); PG8_BAR;
    }
    for (;;) {
        const bool has_next = S.next(ui + 1, nxt);
        const char* nA = has_next ? (const char*)g.A + (size_t)nxt.pm * tstep : cA; const char* nB = has_next ? (const char*)g.Bt + (size_t)nxt.pn * tstep : cB;
        for (int t = 0; t < nt; t += 2) {
            const bool last = (t == nt - 2);
            const char* a1 = cA + (size_t)(t + 1) * kstep;
            const char* a2 = last ? nA : cA + (size_t)(t + 2) * kstep; const char* b2 = last ? nB : cB + (size_t)(t + 2) * kstep;
            const char* a3 = a2 + kstep; const char* b3 = b2 + kstep;
            if (last && has_next) S.a_ready(nxt);
            if constexpr (SP2) {
            PG8_LDB(B0, 0, 0); PG8_LDB(B1, 0, 1); PG8_SCHED; PG8_LDA(At, 0, 0); PG8_STAGE(PG8_SA(1, 1), a1 + hstep, voffA);
            PG8_WAIT_V(8); PG8_WAIT_L(0); PG8_BAR; PG8_MMA(0, 0, At, B0); PG8_MMA(0, 1, At, B1); PG8_BAR; PG8_SCHED;
            PG8_LDA(At, 0, 1); PG8_STAGE(PG8_SB(0, 0), b2, voffB); PG8_STAGE(PG8_SB(0, 1), b2 + hstep, voffB); PG8_STAGE(PG8_SA(0, 0), a2, voffA);
            PG8_WAIT_V(8); PG8_WAIT_L(0); PG8_BAR; PG8_MMA(1, 0, At, B0); PG8_MMA(1, 1, At, B1); PG8_BAR; PG8_SCHED;
            PG8_LDB(B0, 1, 0); PG8_LDB(B1, 1, 1); PG8_SCHED; PG8_LDA(At, 1, 0); PG8_STAGE(PG8_SA(0, 1), a2 + hstep, voffA);
            PG8_WAIT_V(8); PG8_WAIT_L(0); PG8_BAR; PG8_MMA(0, 0, At, B0); PG8_MMA(0, 1, At, B1); PG8_BAR; PG8_SCHED;
            PG8_LDA(At, 1, 1); PG8_STAGE(PG8_SB(1, 0), b3, voffB); PG8_STAGE(PG8_SB(1, 1), b3 + hstep, voffB); PG8_STAGE(PG8_SA(1, 0), a3, voffA);
            PG8_WAIT_V(8); PG8_WAIT_L(0); PG8_BAR; PG8_MMA(1, 0, At, B0); PG8_MMA(1, 1, At, B1); PG8_BAR; PG8_SCHED;
            } else {
            PG8_LDB(B0, 0, 0); PG8_SCHED; PG8_LDA(At, 0, 0); PG8_STAGE(PG8_SA(1, 1), a1 + hstep, voffA);
            PG8_WAIT_L(8); PG8_BAR; PG8_WAIT_L(0); PG8_MMA(0, 0, At, B0); PG8_BAR; PG8_SCHED;
            PG8_LDB(B1, 0, 1); PG8_STAGE(PG8_SB(0, 0), b2, voffB);
            PG8_BAR; PG8_WAIT_L(0); PG8_MMA(0, 1, At, B1); PG8_BAR;
            PG8_LDA(At, 0, 1); PG8_STAGE(PG8_SA(0, 0), a2, voffA);
            PG8_BAR; PG8_WAIT_L(0); PG8_MMA(1, 0, At, B0); PG8_BAR; PG8_SCHED;
            PG8_STAGE(PG8_SB(0, 1), b2 + hstep, voffB);
            PG8_WAIT_V(6); PG8_BAR; PG8_MMA(1, 1, At, B1); PG8_BAR;
            PG8_LDB(B0, 1, 0); PG8_SCHED; PG8_LDA(At, 1, 0); PG8_STAGE(PG8_SA(0, 1), a2 + hstep, voffA);
            PG8_WAIT_L(8); PG8_BAR; PG8_WAIT_L(0); PG8_MMA(0, 0, At, B0); PG8_BAR; PG8_SCHED;
            PG8_LDB(B1, 1, 1); PG8_STAGE(PG8_SB(1, 0), b3, voffB);
            PG8_BAR; PG8_WAIT_L(0); PG8_MMA(0, 1, At, B1); PG8_BAR;
            PG8_LDA(At, 1, 1); PG8_STAGE(PG8_SA(1, 0), a3, voffA);
            PG8_BAR; PG8_WAIT_L(0); PG8_MMA(1, 0, At, B0); PG8_BAR; PG8_SCHED;
            PG8_STAGE(PG8_SB(1, 1), b3 + hstep, voffB);
            PG8_WAIT_V(6); PG8_BAR; PG8_MMA(1, 1, At, B1); PG8_BAR;
            }
        }
        if constexpr (ALIGN_EPI) { if (wr == 0) PG8_BAR; }
        if constexpr (Epi::KEEP_ACC) { E.inplace(acc, cur, wr, wc, fr, fq); S.done(cur); }
        else if constexpr (!Epi::AFTER_DRAIN) { E(acc, cur, wr, wc, fr, fq); S.done(cur); }
        if (!has_next) break;
        if constexpr (!Epi::KEEP_ACC)
#pragma unroll
        for (int a = 0; a < 2; ++a)
#pragma unroll
            for (int b = 0; b < 2; ++b)
#pragma unroll
                for (int m = 0; m < 4; ++m)
#pragma unroll
                    for (int n = 0; n < 2; ++n) acc[a][b][m][n] = (f32x4){0.f, 0.f, 0.f, 0.f};
        cur = nxt; cA = nA; cB = nB; ++ui;
        if constexpr (ALIGN_EPI) { if (wr == 1) PG8_BAR; }
    }
    PG8_WAIT_V(0);
    if constexpr (!ALIGN_EPI) { if (wr == 0) PG8_BAR; }
    PG8_BAR;
    if constexpr (Epi::AFTER_DRAIN) { E.fused(acc, cur, wr, wc, fr, fq, lds, wid, lane); S.done(cur); }
#undef PG8_SA
#undef PG8_SB
#undef PG8_STAGE
#undef PG8_LDA
#undef PG8_LDB
#undef PG8_MMA
#undef PG8_WAIT_V
#undef PG8_WAIT_L
#undef PG8_BAR
#undef PG8_SCHED
}
}
#define XB_TMO      128
#define XB_XCNT(j)  (256  + 64 * (j))
#define XB_XSUB(j)  (1280 + 64 * (j))
#define XB_XGEN(j)  (2304 + 64 * (j))
#define XB_TOP      3328
#define XB_TOPGEN   3392
#define XCD_BAR_WORDS 3456
#define XB_SPIN_CAP (1u << 25)

__device__ __forceinline__ unsigned xb_ld(unsigned* p)              { return __hip_atomic_load(p, __ATOMIC_RELAXED, __HIP_MEMORY_SCOPE_AGENT); }
__device__ __forceinline__ unsigned xb_add(unsigned* p, unsigned v) { return __hip_atomic_fetch_add(p, v, __ATOMIC_RELAXED, __HIP_MEMORY_SCOPE_AGENT); }
__device__ __forceinline__ unsigned xb_xcc_id() { return (unsigned)__builtin_amdgcn_s_getreg((3 << 11) | 20) & 0xFu; }
#define XB_SPIN(cond, bar) do { unsigned _sp = 0; while (cond) { __builtin_amdgcn_s_sleep(1); \
    if ((++_sp & 255u) == 0u) { if (xb_ld(&(bar)[XB_TMO])) break; if (_sp > XB_SPIN_CAP) { atomicAdd(&(bar)[XB_TMO], 1u); break; } } } } while (0)

struct XcdBarrier {
    unsigned* bar; unsigned x;
    volatile LAS unsigned* st;
};

__device__ __forceinline__ XcdBarrier xcd_barrier_post(unsigned* bar, volatile LAS unsigned* st) {
    XcdBarrier b; b.bar = bar; b.x = xb_xcc_id(); b.st = st;
    if (threadIdx.x == 0) (void)xb_add(&bar[XB_XCNT(b.x)], 1u);
    return b;
}
__device__ __forceinline__ void xcd_barrier_complete(unsigned* bar, unsigned x, unsigned& nloc, unsigned& nx) {
    const unsigned G = gridDim.x * gridDim.y * gridDim.z;
    unsigned sum, cnt, mine, sp = 0u;
    for (;;) {
        sum = 0u; cnt = 0u; mine = 0u;
#pragma unroll
        for (unsigned j = 0; j < 16; ++j) { const unsigned c = xb_ld(&bar[XB_XCNT(j)]); sum += c; cnt += (c > 0u) ? 1u : 0u; mine = (j == x) ? c : mine; }
        if (sum == G) break;
        __builtin_amdgcn_s_sleep(1);
        if ((++sp & 255u) == 0u) { if (xb_ld(&bar[XB_TMO])) break; if (sp > XB_SPIN_CAP) { atomicAdd(&bar[XB_TMO], 1u); break; } }
    }
    nloc = mine > 0u ? mine : 1u; nx = cnt > 0u ? cnt : 1u;
}

__device__ __forceinline__ void xcd_barrier(const XcdBarrier& b) {
    asm volatile("s_waitcnt vmcnt(0)" ::: "memory");
    __syncthreads();
    if (threadIdx.x == 0) {
        unsigned* bar = b.bar;
        __builtin_amdgcn_s_waitcnt(0);
        unsigned nloc = b.st[0], nx = b.st[1];
        if (nloc == 0u) { xcd_barrier_complete(bar, b.x, nloc, nx); b.st[0] = nloc; b.st[1] = nx; }
        const unsigned old = xb_add(&bar[XB_XSUB(b.x)], 1u);
        const unsigned gen = old / nloc;
        if (old + 1u == (gen + 1u) * nloc) {
            __builtin_amdgcn_fence(__ATOMIC_RELEASE, "agent");
            asm volatile("s_waitcnt vmcnt(0)" ::: "memory");
            const unsigned og = xb_add(&bar[XB_TOP], 1u);
            const unsigned tg = og / nx;
            if (og + 1u == (tg + 1u) * nx) xb_add(&bar[XB_TOPGEN], 1u);
            else XB_SPIN(xb_ld(&bar[XB_TOPGEN]) == tg, bar);
            __builtin_amdgcn_fence(__ATOMIC_ACQUIRE, "agent");
            xb_add(&bar[XB_XGEN(b.x)], 1u);
            asm volatile("s_waitcnt vmcnt(0)" ::: "memory");
        } else {
            XB_SPIN(xb_ld(&bar[XB_XGEN(b.x)]) == gen, bar);
            __builtin_amdgcn_fence(__ATOMIC_ACQUIRE, "agent");
            asm volatile("s_waitcnt vmcnt(0)" ::: "memory");
        }
    }
    __syncthreads();
}

namespace epi {
using pg8::Unit; using pg8::BM; using pg8::HALF;
typedef const pg8::f32x4 (&AccRef)[2][2][4][2];

struct EpiProj1 {
    static constexpr bool PERM = true, AFTER_DRAIN = false, KEEP_ACC = false;
    bf16* O; const float* cosT; const float* sinT;
    __device__ __forceinline__ void operator()(AccRef acc, const Unit& u, int wr, int wc, int fr, int fq) const {
        const int row0 = u.pm * BM + wr * 64 + fr, colw = u.pn * BM + wc * 32;
#pragma unroll
        for (int bj = 0; bj < 2; ++bj) {
            const int hb = (colw + bj * HALF) >> 6;
            const bool rope = (hb >= 40 && hb < 50) || (hb >= 52 && hb < 54) || (hb >= 56 && hb < 58) || (hb >= 60 && hb < 76);
            const bool isq = (hb >= 40 && hb < 48) || (hb >= 60 && hb < 68);
            const float qs = isq ? QSCALE : 1.0f;
            const int jw = (wc & 1) * 16 + fq * 4;
#pragma unroll
            for (int ai = 0; ai < 2; ++ai)
#pragma unroll
                for (int m = 0; m < 4; ++m) {
                    const int row = row0 + ai * HALF + m * 16;
                    pg8::f32x4 v0 = acc[ai][bj][m][0], v1 = acc[ai][bj][m][1];
                    if (rope) {
                        const pg8::f32x4 c = *(const pg8::f32x4*)(cosT + (size_t)row * 32 + jw), s = *(const pg8::f32x4*)(sinT + (size_t)row * 32 + jw);
                        const float a0 = v0[0] * c[0] - v0[1] * s[0], a1 = v0[1] * c[0] + v0[0] * s[0], a2 = v0[2] * c[1] - v0[3] * s[1], a3 = v0[3] * c[1] + v0[2] * s[1];
                        const float b0 = v1[0] * c[2] - v1[1] * s[2], b1 = v1[1] * c[2] + v1[0] * s[2], b2 = v1[2] * c[3] - v1[3] * s[3], b3 = v1[3] * c[3] + v1[2] * s[3];
                        v0 = (pg8::f32x4){a0, a1, a2, a3} * qs; v1 = (pg8::f32x4){b0, b1, b2, b3} * qs;
                    }
                    v4u w; w.x = pk2(v0[0], v0[1]); w.y = pk2(v0[2], v0[3]); w.z = pk2(v1[0], v1[1]); w.w = pk2(v1[2], v1[3]);
                    *(v4u*)(O + (size_t)row * NP1 + colw + bj * HALF + 8 * fq) = w;
                }
        }
    }
};
struct EpiStoreBf {
    static constexpr bool PERM = true, AFTER_DRAIN = false, KEEP_ACC = false;
    bf16* O; int ldc;
    __device__ __forceinline__ void operator()(AccRef acc, const Unit& u, int wr, int wc, int fr, int fq) const {
        const int row0 = u.pm * BM + wr * 64 + fr, col0 = u.pn * BM + wc * 32 + 8 * fq;
#pragma unroll
        for (int ai = 0; ai < 2; ++ai)
#pragma unroll
            for (int m = 0; m < 4; ++m) { bf16* rowp = O + (size_t)(row0 + ai * HALF + m * 16) * ldc + col0;
#pragma unroll
                for (int bj = 0; bj < 2; ++bj) { const pg8::f32x4 v0 = acc[ai][bj][m][0], v1 = acc[ai][bj][m][1];
                    v4u w; w.x = pk2(v0[0], v0[1]); w.y = pk2(v0[2], v0[3]); w.z = pk2(v1[0], v1[1]); w.w = pk2(v1[2], v1[3]); *(v4u*)(rowp + bj * HALF) = w; } }
    }
};
__device__ __forceinline__ float gate_enc(float x) { const float e = __builtin_amdgcn_exp2f(__builtin_amdgcn_fmed3f(x, -30.0f, 30.0f) * -1.4426950408889634f); return (1.0f - e) * __builtin_amdgcn_rcpf(1.0f + e); }

struct EpiGates {
    static constexpr bool PERM = true, AFTER_DRAIN = false, KEEP_ACC = false;
    unsigned char* O;
    __device__ __forceinline__ void operator()(AccRef acc, const Unit& u, int wr, int wc, int fr, int fq) const {
        const int row0 = u.pm * BM + wr * 64 + fr, col0 = u.pn * BM + wc * 32 + 8 * fq;
#pragma unroll
        for (int ai = 0; ai < 2; ++ai)
#pragma unroll
            for (int m = 0; m < 4; ++m) { unsigned char* rowp = O + (size_t)(row0 + ai * HALF + m * 16) * NGT + col0;
#pragma unroll
                for (int bj = 0; bj < 2; ++bj) { const pg8::f32x4 v0 = acc[ai][bj][m][0], v1 = acc[ai][bj][m][1];
                    v2u w; unsigned p = 0u; p = __builtin_amdgcn_cvt_pk_fp8_f32(gate_enc(v0[0]), gate_enc(v0[1]), p, false); p = __builtin_amdgcn_cvt_pk_fp8_f32(gate_enc(v0[2]), gate_enc(v0[3]), p, true); w.x = p;
                    p = 0u; p = __builtin_amdgcn_cvt_pk_fp8_f32(gate_enc(v1[0]), gate_enc(v1[1]), p, false); p = __builtin_amdgcn_cvt_pk_fp8_f32(gate_enc(v1[2]), gate_enc(v1[3]), p, true); w.y = p;
                    *(v2u*)(rowp + bj * HALF) = w; } }
    }
};
struct EpiMerge {
    static constexpr bool PERM = true, AFTER_DRAIN = false, KEEP_ACC = false;
    bf16* O; const unsigned char* G; int seg;
    __device__ __forceinline__ void operator()(AccRef acc, const Unit& u, int wr, int wc, int fr, int fq) const {
        const int row0 = u.pm * BM + wr * 64 + fr, col0 = u.pn * BM + wc * 32 + 8 * fq;
#pragma unroll
        for (int ai = 0; ai < 2; ++ai)
#pragma unroll
            for (int m = 0; m < 4; ++m) { const size_t row = (size_t)(row0 + ai * HALF + m * 16); bf16* rowp = O + row * DM + col0; const unsigned char* gp = G + row * NGT + seg * DM + col0;
#pragma unroll
                for (int bj = 0; bj < 2; ++bj) { pg8::f32x4 v0 = acc[ai][bj][m][0], v1 = acc[ai][bj][m][1];
                    const v2u g = *(const v2u*)(gp + bj * HALF);
                    const f32x2 g0 = __builtin_amdgcn_cvt_pk_f32_fp8(g.x, false), g1 = __builtin_amdgcn_cvt_pk_f32_fp8(g.x, true), g2 = __builtin_amdgcn_cvt_pk_f32_fp8(g.y, false), g3 = __builtin_amdgcn_cvt_pk_f32_fp8(g.y, true);
                    v0[0] *= 0.5f * g0.x + 0.5f; v0[1] *= 0.5f * g0.y + 0.5f; v0[2] *= 0.5f * g1.x + 0.5f; v0[3] *= 0.5f * g1.y + 0.5f;
                    v1[0] *= 0.5f * g2.x + 0.5f; v1[1] *= 0.5f * g2.y + 0.5f; v1[2] *= 0.5f * g3.x + 0.5f; v1[3] *= 0.5f * g3.y + 0.5f;
                    if (seg != 0) { const v4u o = *(const v4u*)(rowp + bj * HALF); v0[0] += bflo(o.x); v0[1] += bfhi(o.x); v0[2] += bflo(o.y); v0[3] += bfhi(o.y); v1[0] += bflo(o.z); v1[1] += bfhi(o.z); v1[2] += bflo(o.w); v1[3] += bfhi(o.w); }
                    v4u w; w.x = pk2(v0[0], v0[1]); w.y = pk2(v0[2], v0[3]); w.z = pk2(v1[0], v1[1]); w.w = pk2(v1[2], v1[3]); *(v4u*)(rowp + bj * HALF) = w; } }
    }
};
struct EpiResid {
    static constexpr bool PERM = false, AFTER_DRAIN = false, KEEP_ACC = false;
    const float* XI; float* XO; const float* gate;
    __device__ __forceinline__ void operator()(AccRef acc, const Unit& u, int wr, int wc, int fr, int fq) const {
        const int row0 = u.pm * BM + wr * 64 + fr, col0 = u.pn * BM + wc * 32 + 4 * fq;
        const float* gb = gate + (size_t)((u.pm * BM) / SEQ) * 6144 + col0;
        pg8::f32x4 gv[2][2];
#pragma unroll
        for (int bj = 0; bj < 2; ++bj)
#pragma unroll
            for (int n = 0; n < 2; ++n) gv[bj][n] = *(const pg8::f32x4*)(gb + bj * HALF + n * 16);
#pragma unroll
        for (int ai = 0; ai < 2; ++ai)
#pragma unroll
            for (int m = 0; m < 4; ++m) { const size_t off = (size_t)(row0 + ai * HALF + m * 16) * DM + col0;
#pragma unroll
                for (int bj = 0; bj < 2; ++bj)
#pragma unroll
                    for (int n = 0; n < 2; ++n) { const pg8::f32x4 xi = *(const pg8::f32x4*)(XI + off + bj * HALF + n * 16);
                        *(pg8::f32x4*)(XO + off + bj * HALF + n * 16) = xi + gv[bj][n] * acc[ai][bj][m][n]; } }
    }
};

struct EpiProjAll {
    static constexpr bool PERM = true, AFTER_DRAIN = false, KEEP_ACC = false;
    static_assert(true, ""); EpiProj1 P; EpiGates G;
    __device__ __forceinline__ void operator()(AccRef acc, const Unit& u, int wr, int wc, int fr, int fq) const {
        if (u.pn < NP1 / BM) P(acc, u, wr, wc, fr, fq);
        else { Unit v = u; v.pn -= NP1 / BM; G(acc, v, wr, wc, fr, fq); }
    }
};
__device__ __forceinline__ void gates8(const unsigned char* p, float (&g)[8]) {
    const v2u w = *(const v2u*)p;
    const f32x2 a = __builtin_amdgcn_cvt_pk_f32_fp8(w.x, false), b = __builtin_amdgcn_cvt_pk_f32_fp8(w.x, true), c = __builtin_amdgcn_cvt_pk_f32_fp8(w.y, false), d = __builtin_amdgcn_cvt_pk_f32_fp8(w.y, true);
    g[0] = fmaxf(0.5f * a.x + 0.5f, 0x1p-10f); g[1] = fmaxf(0.5f * a.y + 0.5f, 0x1p-10f); g[2] = fmaxf(0.5f * b.x + 0.5f, 0x1p-10f); g[3] = fmaxf(0.5f * b.y + 0.5f, 0x1p-10f);
    g[4] = fmaxf(0.5f * c.x + 0.5f, 0x1p-10f); g[5] = fmaxf(0.5f * c.y + 0.5f, 0x1p-10f); g[6] = fmaxf(0.5f * d.x + 0.5f, 0x1p-10f); g[7] = fmaxf(0.5f * d.y + 0.5f, 0x1p-10f);
}
struct EpiMergeAll {
    static constexpr bool PERM = true, AFTER_DRAIN = false, KEEP_ACC = true;
    bf16* O; const unsigned char* G;
    __device__ __forceinline__ void operator()(AccRef, const Unit&, int, int, int, int) const {}
    __device__ __forceinline__ void inplace(pg8::f32x4 (&acc)[2][2][4][2], const Unit& u, int wr, int wc, int fr, int fq) const {
        const int seg = u.pm >> 6, pm = u.pm & 63, pn = u.pn & 3;
        const int row0 = pm * BM + wr * 64 + fr, col0 = pn * BM + wc * 32 + 8 * fq;
#pragma unroll
        for (int ai = 0; ai < 2; ++ai)
#pragma unroll
            for (int m = 0; m < 4; ++m) { const size_t row = (size_t)(row0 + ai * HALF + m * 16); const unsigned char* gp = G + row * NGT + seg * DM + col0;
#pragma unroll
                for (int bj = 0; bj < 2; ++bj) { float gc[8]; gates8(gp + bj * HALF, gc);
                    pg8::f32x4& v0 = acc[ai][bj][m][0]; pg8::f32x4& v1 = acc[ai][bj][m][1];
                    if (seg < 3) { float gn[8]; gates8(gp + DM + bj * HALF, gn);
#pragma unroll
                        for (int e = 0; e < 4; ++e) { v0[e] *= gc[e] * __builtin_amdgcn_rcpf(gn[e]); v1[e] *= gc[4 + e] * __builtin_amdgcn_rcpf(gn[4 + e]); } }
                    else {
#pragma unroll
                        for (int e = 0; e < 4; ++e) { v0[e] *= gc[e]; v1[e] *= gc[4 + e]; }
                        v4u w; w.x = pk2(v0[0], v0[1]); w.y = pk2(v0[2], v0[3]); w.z = pk2(v1[0], v1[1]); w.w = pk2(v1[2], v1[3]); *(v4u*)(O + row * DM + col0 + bj * HALF) = w;
                        v0 = (pg8::f32x4){0.f, 0.f, 0.f, 0.f}; v1 = (pg8::f32x4){0.f, 0.f, 0.f, 0.f}; } } }
    }
};
struct MergeOrder {
    pg8::StaticOrder S;
    __device__ void init(int G_, int c_) { S.init(TOK, DM, G_, c_); }
    __device__ bool next(int i, Unit& u) const { Unit b; if (!S.next(i >> 2, b)) return false; const int seg = i & 3; u.pm = seg * 64 + b.pm; u.pn = seg * 4 + b.pn; return true; }
    __device__ __forceinline__ void a_ready(const Unit&) const {}
    __device__ __forceinline__ void done(const Unit&) const {}
};
}

constexpr int NWAVES = 8, NTHR = 512;
struct Args { const void* in[26]; float* out; unsigned char* ws; int ph_lo, ph_hi; };
enum InIdx { I_X = 0, I_C, I_POS, I_MODW, I_MODB, I_NMG, I_NFG, I_WIN, I_ACW, I_AOUT, I_BCW, I_BCB, I_BLNG, I_BLNB, I_BOUT, I_CPOS, I_CW1, I_CW2, I_COUT, I_DOUT, I_WO, I_PWQ, I_PSUB, I_PU, I_PV, I_FNG };

struct Frame {
    LAS unsigned char* lds; unsigned char* ldsg;
    int tid, lane, wave, G, bid;
    unsigned char* ws;
};
__device__ __forceinline__ int gwave(const Frame& F) { return F.bid * NWAVES + F.wave; }
__device__ __forceinline__ int ngwave(const Frame& F) { return F.G * NWAVES; }

__device__ __forceinline__ int rope_pos_of_dim(int d) { return d < 32 ? 2 * d : 2 * (d - 32) + 1; }
__device__ __forceinline__ int rope_dim_of_pos(int p) { return (p >> 1) + 32 * (p & 1); }
__device__ __forceinline__ int win_row_of_col(int n) {
    if (n < 2560) return n;
    if (n < 3072) { const int c = n - 2560; return C_CQ + (c & ~63) + rope_pos_of_dim(c & 63); }
    if (n < 3200) { const int c = n - 3072; return C_KC + (c & ~63) + rope_pos_of_dim(c & 63); }
    if (n < 3328) return C_VC + (n - 3200);
    if (n < 3456) { const int c = n - 3328; return C_KS + (c & ~63) + rope_pos_of_dim(c & 63); }
    if (n < 3584) return C_VS + (n - 3456);
    if (n < 3712) { const int c = n - 3584; return C_KW + (c & ~63) + rope_pos_of_dim(c & 63); }
    if (n < 3840) return C_VW + (n - 3712);
    if (n < 3864) return C_CG + (n - 3840);
    if (n < 4376) { const int c = n - 3864; return C_DQ + (c & ~63) + rope_pos_of_dim(c & 63); }
    if (n < 4888) { const int c = n - 4376; return C_DK + (c & ~63) + rope_pos_of_dim(c & 63); }
    if (n < 5400) return C_DV + (n - 4888);
    return NP1 + (n - 5400);
}
constexpr int TR_SCR = 17408;
template <int MODE, bool KPERM>
__device__ __forceinline__ void transpose_item(const float* W, int K, int N, bf16* WT, LAS float* scr, int item, int lane) {
    const int nblk = (N + 63) / 64, kb = item / nblk, nb = item % nblk, k0 = 64 * kb, n0 = 64 * nb;
    const int nq = (lane & 15) * 4; const bool nok = n0 + nq < N;
#pragma unroll 4
    for (int i = 0; i < 16; ++i) { const int kk = 4 * i + (lane >> 4); const f32x4 v = nok ? *(const f32x4*)(W + (size_t)(k0 + kk) * N + n0 + nq) : (f32x4){0.f, 0.f, 0.f, 0.f};
        LAS float* d = scr + kk * 65 + nq; d[0] = v[0]; d[1] = v[1]; d[2] = v[2]; d[3] = v[3]; }
    LDS_WAIT(); asm volatile("" ::: "memory");
    const int c = lane & 7;
#pragma unroll
    for (int j = 0; j < 8; ++j) { const int n = (lane >> 3) + 8 * j;
        float s[8];
#pragma unroll
        for (int e = 0; e < 8; ++e) { const int p = 8 * c + e; const int ks = KPERM ? rope_dim_of_pos(p) : p; s[e] = scr[ks * 65 + n]; }
        v4u o; o.x = pk2(s[0], s[1]); o.y = pk2(s[2], s[3]); o.z = pk2(s[4], s[5]); o.w = pk2(s[6], s[7]);
        if (n0 + n < N) { const int row = (MODE == 1) ? win_row_of_col(n0 + n) : (n0 + n); *(v4u*)(WT + (size_t)row * K + k0 + 8 * c) = o; } }
    LDS_WAIT(); asm volatile("" ::: "memory");
}
template <int MODE, bool KPERM>
__device__ __forceinline__ void transpose_matrix(const Frame& F, const float* W, int K, int N, bf16* WT, int& base) {
    LAS float* scr = (LAS float*)(F.lds + F.wave * TR_SCR);
    const int nitems = (K / 64) * ((N + 63) / 64), gw = gwave(F), NGW = ngwave(F);
    int first = (gw - base % NGW + NGW) % NGW;
    for (int it = first; it < nitems; it += NGW) transpose_item<MODE, KPERM>(W, K, N, WT, scr, it, F.lane);
    base += nitems;
}
__device__ __forceinline__ void convert_copy(const Frame& F, const float* src, bf16* dst, size_t n) {
    const size_t nth = (size_t)F.G * NTHR, t0 = (size_t)F.bid * NTHR + F.tid;
    for (size_t i = t0; i < n / 8; i += nth) { const f32x4 a = *(const f32x4*)(src + i * 8), b = *(const f32x4*)(src + i * 8 + 4);
        v4u o; o.x = pk2(a[0], a[1]); o.y = pk2(a[2], a[3]); o.z = pk2(b[0], b[1]); o.w = pk2(b[2], b[3]); *(v4u*)(dst + i * 8) = o; }
}

typedef __attribute__((address_space(4))) const Args* KArgsP;
__device__ __forceinline__ void phase_prologue(const Frame& F, KArgsP Ap) {
    unsigned char* ws = F.ws;
    int base = 0;
    for (int l = 0; l < DEPTH; ++l) {
        transpose_matrix<1, false>(F, (const float*)(GAS const void*)Ap->in[I_WIN] + (size_t)l * DM * 9496, DM, 9496, (bf16*)(ws + WS_WIN) + (size_t)l * NWIN * DM, base);
        transpose_matrix<0, false>(F, (const float*)(GAS const void*)Ap->in[I_AOUT] + (size_t)l * 512 * DM, 512, DM, (bf16*)(ws + WS_WOUT) + (size_t)(l * 4 + 0) * DM * 512, base);
        transpose_matrix<0, false>(F, (const float*)(GAS const void*)Ap->in[I_BOUT] + (size_t)l * 512 * DM, 512, DM, (bf16*)(ws + WS_WOUT) + (size_t)(l * 4 + 1) * DM * 512, base);
        transpose_matrix<0, false>(F, (const float*)(GAS const void*)Ap->in[I_COUT] + (size_t)l * 512 * DM, 512, DM, (bf16*)(ws + WS_WOUT) + (size_t)(l * 4 + 2) * DM * 512, base);
        transpose_matrix<0, false>(F, (const float*)(GAS const void*)Ap->in[I_DOUT] + (size_t)l * 512 * DM, 512, DM, (bf16*)(ws + WS_WOUT) + (size_t)(l * 4 + 3) * DM * 512, base);
        transpose_matrix<0, false>(F, (const float*)(GAS const void*)Ap->in[I_WO] + (size_t)l * DM * DM, DM, DM, (bf16*)(ws + WS_WO) + (size_t)l * DM * DM, base);
        transpose_matrix<0, false>(F, (const float*)(GAS const void*)Ap->in[I_PWQ] + (size_t)l * DM * 2048, DM, 2048, (bf16*)(ws + WS_WQ) + (size_t)l * 2048 * DM, base);
        transpose_matrix<0, true>(F, (const float*)(GAS const void*)Ap->in[I_CW1] + (size_t)(l * 2 + 0) * 2048 * 128, 2048, 128, (bf16*)(ws + WS_W1T) + (size_t)(l * 2 + 0) * 128 * 2048, base);
        transpose_matrix<0, false>(F, (const float*)(GAS const void*)Ap->in[I_CW1] + (size_t)(l * 2 + 1) * 2048 * 128, 2048, 128, (bf16*)(ws + WS_W1T) + (size_t)(l * 2 + 1) * 128 * 2048, base);
    }
    convert_copy(F, (const float*)(GAS const void*)Ap->in[I_PSUB], (bf16*)(ws + WS_SUBK), (size_t)DEPTH * 8 * 2 * 128 * 128);
    const int gt = F.bid * NTHR + F.tid, NGT_ = F.G * NTHR;
    { const float* w2 = (const float*)(GAS const void*)Ap->in[I_CW2]; bf16* w2t = (bf16*)(ws + WS_SMALL + SM_W2T);
      for (int i = gt; i < DEPTH * 2 * 64 * 128; i += NGT_) { const int k = i & 127, n = (i >> 7) & 63, lw = i >> 13; w2t[i] = (bf16)f2bf(w2[((size_t)lw * 128 + k) * 64 + n]); } }
    { const int* pos = (const int*)(GAS const void*)Ap->in[I_POS]; float* ct = (float*)(ws + WS_COS); float* st = (float*)(ws + WS_SIN);
      for (int i = gt; i < TOK * 32; i += NGT_) { const int t = i >> 5, j = i & 31;
          const float inv = 1.0f / powf(10000.0f, (float)(2 * j) / 64.0f); const float ang = (float)pos[t] * inv;
          ct[i] = (float)cos((double)ang); st[i] = (float)sin((double)ang); } }
    { const float* w1 = (const float*)(GAS const void*)Ap->in[I_CW1]; const float* cp = (const float*)(GAS const void*)Ap->in[I_CPOS]; float* pbp = (float*)(ws + WS_SMALL + SM_PBP);
      for (int i = gt; i < DEPTH * 2 * 16 * 128; i += NGT_) { const int n = i & 127, kc = (i >> 7) & 15, lw = i >> 11; float s = 0.f;
          for (int k = kc * 128; k < kc * 128 + 128; ++k) s += cp[(size_t)lw * 2048 + k] * w1[((size_t)lw * 2048 + k) * 128 + n];
          pbp[i] = s; } }
    __syncthreads();
    { LAS float* cond = (LAS float*)(F.lds);
      LAS float* red = (LAS float*)(F.lds + 32768);
      const float* c = (const float*)(GAS const void*)Ap->in[I_C];
      for (int i = F.tid; i < 8 * 1024; i += NTHR) { const float v = c[i]; cond[i] = v / (1.0f + __expf(-v)); }
      __syncthreads();
      for (int un = F.bid; un < DEPTH * 96; un += F.G) { const int l = un / 96, n0 = (un % 96) * 64;
          const float* mw = (const float*)(GAS const void*)Ap->in[I_MODW] + (size_t)l * DM * 6144 + n0 + F.lane;
          float acc[8];
#pragma unroll
          for (int b = 0; b < 8; ++b) acc[b] = 0.f;
#pragma unroll 4
          for (int k = F.wave * 128; k < F.wave * 128 + 128; ++k) { const float w = mw[(size_t)k * 6144];
#pragma unroll
              for (int b = 0; b < 8; ++b) acc[b] += cond[b * 1024 + k] * w; }
#pragma unroll
          for (int b = 0; b < 8; ++b) red[(F.wave * 8 + b) * 64 + F.lane] = acc[b];
          __syncthreads();
          { const int b = F.tid >> 6, n = F.tid & 63; float s = 0.f;
#pragma unroll
            for (int w = 0; w < 8; ++w) s += red[(w * 8 + b) * 64 + n];
            ((float*)(ws + WS_MOD))[((size_t)l * 8 + b) * 6144 + n0 + n] = s + ((const float*)(GAS const void*)Ap->in[I_MODB])[(size_t)l * 6144 + n0 + n]; }
          __syncthreads(); }
    }
}

__device__ __forceinline__ void phase_norm_mod(const Frame& F, const float* X, const float* g, const float* sh, const float* sc, bf16* O, unsigned char* O8 = nullptr, float* OS = nullptr) {
    const int gw = gwave(F), NGW = ngwave(F);
    f32x4 gv[4];
#pragma unroll
    for (int j = 0; j < 4; ++j) gv[j] = *(const f32x4*)(g + 4 * F.lane + 256 * j);
    for (int row = gw; row < TOK; row += NGW) {
        const int b = row / SEQ; const float* xr = X + (size_t)row * DM + 4 * F.lane;
        f32x4 v[4]; float s = 0.f;
#pragma unroll
        for (int j = 0; j < 4; ++j) { v[j] = *(const f32x4*)(xr + 256 * j); s += (v[j][0] * v[j][0] + v[j][1] * v[j][1]) + (v[j][2] * v[j][2] + v[j][3] * v[j][3]); }
        const float r = 1.0f / sqrtf(wave_sum(s, F.lane) * (1.0f / DM) + NORM_EPS);
        bf16* orow = O + (size_t)row * DM + 4 * F.lane;
#pragma unroll
        for (int j = 0; j < 4; ++j) { const f32x4 scv = *(const f32x4*)(sc + (size_t)b * 6144 + 4 * F.lane + 256 * j), shv = *(const f32x4*)(sh + (size_t)b * 6144 + 4 * F.lane + 256 * j);
            const f32x4 y = v[j] * r * gv[j] * (scv + 1.0f) + shv; v2u w; w.x = pk2(y[0], y[1]); w.y = pk2(y[2], y[3]); *(v2u*)(orow + 256 * j) = w; v[j] = y; }
        if (O8) {
            float mx = 0.f;
#pragma unroll
            for (int j = 0; j < 4; ++j) mx = fmaxf(fmaxf(mx, fmaxf(fabsf(v[j][0]), fabsf(v[j][1]))), fmaxf(fabsf(v[j][2]), fabsf(v[j][3])));
#pragma unroll
            for (int o = 1; o < 32; o <<= 1) mx = fmaxf(mx, shx(mx, o, F.lane));
            mx = max32(mx);
            const float qs = mx > 0.f ? 127.0f / mx : 0.f;
#pragma unroll
            for (int j = 0; j < 4; ++j) *(unsigned*)(O8 + (size_t)row * DM + 4 * F.lane + 256 * j) =
                ((unsigned)(int)rintf(v[j][0] * qs) & 0xffu) | (((unsigned)(int)rintf(v[j][1] * qs) & 0xffu) << 8) | (((unsigned)(int)rintf(v[j][2] * qs) & 0xffu) << 16) | (((unsigned)(int)rintf(v[j][3] * qs) & 0xffu) << 24);
            if (F.lane == 0) OS[row] = mx * (1.0f / 127.0f);
        }
    }
}
__device__ __forceinline__ void phase_final_norm(const Frame& F, const float* X, const float* g, float* O) {
    const int gw = gwave(F), NGW = ngwave(F);
    f32x4 gv[4];
#pragma unroll
    for (int j = 0; j < 4; ++j) gv[j] = *(const f32x4*)(g + 4 * F.lane + 256 * j);
    for (int row = gw; row < TOK; row += NGW) {
        const float* xr = X + (size_t)row * DM + 4 * F.lane; f32x4 v[4]; float s = 0.f;
#pragma unroll
        for (int j = 0; j < 4; ++j) { v[j] = *(const f32x4*)(xr + 256 * j); s += (v[j][0] * v[j][0] + v[j][1] * v[j][1]) + (v[j][2] * v[j][2] + v[j][3] * v[j][3]); }
        const float r = 1.0f / sqrtf(wave_sum(s, F.lane) * (1.0f / DM) + NORM_EPS);
        float* orow = O + (size_t)row * DM + 4 * F.lane;
#pragma unroll
        for (int j = 0; j < 4; ++j) *(f32x4*)(orow + 256 * j) = v[j] * r * gv[j];
    }
}

__device__ __forceinline__ void phase_mixer_a(const Frame& F, const bf16* P, const float* cw  , bf16* O  ) {
    const int nth = F.G * NTHR, gt = F.bid * NTHR + F.tid;
    for (int it = gt; it < (TOK / 8) * 64; it += nth) {
        const int cg = it & 63, tb = it >> 6, c0 = cg * 8, t0 = tb * 8, s0 = t0 % SEQ;
        float w0[8], w1[8], w2[8];
#pragma unroll
        for (int e = 0; e < 8; ++e) { w0[e] = cw[c0 + e]; w1[e] = cw[512 + c0 + e]; w2[e] = cw[1024 + c0 + e]; }
        float pm2[8], pm1[8];
#pragma unroll
        for (int e = 0; e < 8; ++e) { pm2[e] = 0.f; pm1[e] = 0.f; }
        for (int pre = 2; pre >= 1; --pre) if (s0 - pre >= 0) { const bf16* r = P + (size_t)(t0 - pre) * NP1;
            const v4u ac = *(const v4u*)(r + C_AC + c0), ax = *(const v4u*)(r + C_AX + c0);
            float pr[8]; pr[0] = bflo(ac.x) * bflo(ax.x); pr[1] = bfhi(ac.x) * bfhi(ax.x); pr[2] = bflo(ac.y) * bflo(ax.y); pr[3] = bfhi(ac.y) * bfhi(ax.y);
            pr[4] = bflo(ac.z) * bflo(ax.z); pr[5] = bfhi(ac.z) * bfhi(ax.z); pr[6] = bflo(ac.w) * bflo(ax.w); pr[7] = bfhi(ac.w) * bfhi(ax.w);
#pragma unroll
            for (int e = 0; e < 8; ++e) { if (pre == 2) pm2[e] = pr[e]; else pm1[e] = pr[e]; } }
#pragma unroll
        for (int tt = 0; tt < 8; ++tt) { const bf16* r = P + (size_t)(t0 + tt) * NP1;
            const v4u ac = *(const v4u*)(r + C_AC + c0), ax = *(const v4u*)(r + C_AX + c0), ab = *(const v4u*)(r + C_AB + c0);
            float pr[8], bb[8], y[8];
            pr[0] = bflo(ac.x) * bflo(ax.x); pr[1] = bfhi(ac.x) * bfhi(ax.x); pr[2] = bflo(ac.y) * bflo(ax.y); pr[3] = bfhi(ac.y) * bfhi(ax.y);
            pr[4] = bflo(ac.z) * bflo(ax.z); pr[5] = bfhi(ac.z) * bfhi(ax.z); pr[6] = bflo(ac.w) * bflo(ax.w); pr[7] = bfhi(ac.w) * bfhi(ax.w);
            bb[0] = bflo(ab.x); bb[1] = bfhi(ab.x); bb[2] = bflo(ab.y); bb[3] = bfhi(ab.y); bb[4] = bflo(ab.z); bb[5] = bfhi(ab.z); bb[6] = bflo(ab.w); bb[7] = bfhi(ab.w);
#pragma unroll
            for (int e = 0; e < 8; ++e) { y[e] = bb[e] * (w0[e] * pm2[e] + w1[e] * pm1[e] + w2[e] * pr[e]); pm2[e] = pm1[e]; pm1[e] = pr[e]; }
            v4u o; o.x = pk2(y[0], y[1]); o.y = pk2(y[2], y[3]); o.z = pk2(y[4], y[5]); o.w = pk2(y[6], y[7]);
            *(v4u*)(O + (size_t)(t0 + tt) * 512 + c0) = o; }
    }
}

__device__ __forceinline__ void phase_mixer_b(const Frame& F, const bf16* P, const float* cw  , const float* cb, const float* lg, const float* lb, bf16* O) {
    LAS float* U = (LAS float*)F.lds;
    for (int un = F.bid; un < TOK / 32; un += F.G) {
        const int t0 = un * 32, s0 = t0 % SEQ;
        __syncthreads();
        for (int i = F.tid; i < 62 * 64; i += NTHR) { const int r = i >> 6, cg = i & 63, c0 = cg * 8; const int srel = s0 - 30 + r;
            float u[8];
            if (srel >= 0) { const bf16* row = P + (size_t)(t0 - 30 + r) * NP1; const v4u a = *(const v4u*)(row + C_BA + c0), g = *(const v4u*)(row + C_BG + c0);
                u[0] = bflo(a.x) * sigmoidf_(bflo(g.x)); u[1] = bfhi(a.x) * sigmoidf_(bfhi(g.x)); u[2] = bflo(a.y) * sigmoidf_(bflo(g.y)); u[3] = bfhi(a.y) * sigmoidf_(bfhi(g.y));
                u[4] = bflo(a.z) * sigmoidf_(bflo(g.z)); u[5] = bfhi(a.z) * sigmoidf_(bfhi(g.z)); u[6] = bflo(a.w) * sigmoidf_(bflo(g.w)); u[7] = bfhi(a.w) * sigmoidf_(bfhi(g.w)); }
            else {
#pragma unroll
                for (int e = 0; e < 8; ++e) u[e] = 0.f; }
            *(LAS f32x4*)(U + r * 512 + c0) = (f32x4){u[0], u[1], u[2], u[3]}; *(LAS f32x4*)(U + r * 512 + c0 + 4) = (f32x4){u[4], u[5], u[6], u[7]}; }
        __syncthreads();
        const int c0 = F.lane * 8;
        float acc[4][8];
#pragma unroll
        for (int q = 0; q < 4; ++q)
#pragma unroll
            for (int e = 0; e < 8; ++e) acc[q][e] = cb[c0 + e];
        for (int k = 0; k < 31; ++k) { const f32x4 wa = *(const f32x4*)(cw + k * 512 + c0), wb = *(const f32x4*)(cw + k * 512 + c0 + 4);
#pragma unroll
            for (int q = 0; q < 4; ++q) { const int r = 4 * F.wave + q + k; const f32x4 ua = *(LAS f32x4*)(U + r * 512 + c0), ub = *(LAS f32x4*)(U + r * 512 + c0 + 4);
                acc[q][0] += wa[0] * ua[0]; acc[q][1] += wa[1] * ua[1]; acc[q][2] += wa[2] * ua[2]; acc[q][3] += wa[3] * ua[3];
                acc[q][4] += wb[0] * ub[0]; acc[q][5] += wb[1] * ub[1]; acc[q][6] += wb[2] * ub[2]; acc[q][7] += wb[3] * ub[3]; } }
        const f32x4 ga = *(const f32x4*)(lg + c0), gb = *(const f32x4*)(lg + c0 + 4), ba = *(const f32x4*)(lb + c0), bb = *(const f32x4*)(lb + c0 + 4);
#pragma unroll
        for (int q = 0; q < 4; ++q) { float s = 0.f;
#pragma unroll
            for (int e = 0; e < 8; ++e) s += acc[q][e];
            const float mu = wave_sum(s, F.lane) * (1.0f / 512.0f); float v = 0.f;
#pragma unroll
            for (int e = 0; e < 8; ++e) { acc[q][e] -= mu; v += acc[q][e] * acc[q][e]; }
            const float rs = 1.0f / sqrtf(wave_sum(v, F.lane) * (1.0f / 512.0f) + NORM_EPS);
            float y[8];
#pragma unroll
            for (int e = 0; e < 8; ++e) { const float gg = e < 4 ? ga[e] : gb[e - 4], bv = e < 4 ? ba[e] : bb[e - 4]; const float z = acc[q][e] * rs * gg + bv; y[e] = z / (1.0f + __expf(-z)); }
            v4u o; o.x = pk2(y[0], y[1]); o.y = pk2(y[2], y[3]); o.z = pk2(y[4], y[5]); o.w = pk2(y[6], y[7]);
            *(v4u*)(O + (size_t)(t0 + 4 * F.wave + q) * 512 + c0) = o; }
    }
}

__device__ __forceinline__ void phase_compress(const Frame& F, const bf16* P, const bf16* W1T  , const bf16* W2T  , const float* PBP  ,
                                               bf16* KC, bf16* VC  ) {
    LAS float* PART = (LAS float*)F.lds;
    LAS bf16* H1 = (LAS bf16*)(F.lds + 69632);
    const int lane = F.lane, r16 = lane & 15, q4 = lane >> 4, w = F.wave;
    for (int un = F.bid; un < 2 * 8 * 2 * 8; un += F.G) {
        const int nb = un & 7, g = (un >> 3) & 1, b = (un >> 4) & 7, which = un >> 7;
        const int n = nb * 16 + r16; const int nn = n < 127 ? n : 126;
        const int col0 = (which == 0 ? C_KC : C_VC) + g * 64;
        const bf16* arow = P + ((size_t)b * SEQ + nn * 16) * NP1 + col0;
        const bf16* w1 = W1T + (size_t)which * 128 * 2048;
        f32x4 acc[8];
#pragma unroll
        for (int j = 0; j < 8; ++j) acc[j] = (f32x4){0.f, 0.f, 0.f, 0.f};
#pragma unroll
        for (int half = 0; half < 2; ++half) {
            bf16x8 a[4], bb[4][8];
#pragma unroll
            for (int s4 = 0; s4 < 4; ++s4) { const int k = w * 256 + (half * 4 + s4) * 32 + q4 * 8;
                a[s4] = *(const bf16x8*)(arow + (size_t)(k >> 6) * NP1 + (k & 63));
#pragma unroll
                for (int j = 0; j < 8; ++j) bb[s4][j] = *(const bf16x8*)(w1 + (size_t)(j * 16 + r16) * 2048 + k); }
#pragma unroll
            for (int s4 = 0; s4 < 4; ++s4)
#pragma unroll
                for (int j = 0; j < 8; ++j) acc[j] = __builtin_amdgcn_mfma_f32_16x16x32_bf16(a[s4], bb[s4][j], acc[j], 0, 0, 0);
        }
        __syncthreads();
#pragma unroll
        for (int j = 0; j < 8; ++j)
#pragma unroll
            for (int i = 0; i < 4; ++i) PART[(w * 16 + 4 * q4 + i) * 132 + j * 16 + r16] = acc[j][i];
        __syncthreads();
        {
            const int row = F.tid >> 5, c4 = (F.tid & 31) * 4;
            f32x4 sacc = (f32x4){0.f, 0.f, 0.f, 0.f};
#pragma unroll
            for (int ww = 0; ww < 8; ++ww) sacc += *(LAS f32x4*)(PART + (ww * 16 + row) * 132 + c4);
#pragma unroll
            for (int kc = 0; kc < 16; ++kc) sacc += *(const f32x4*)(PBP + ((size_t)which * 16 + kc) * 128 + c4);
            v2u o; o.x = pk2(gelu_erf(sacc[0]), gelu_erf(sacc[1])); o.y = pk2(gelu_erf(sacc[2]), gelu_erf(sacc[3]));
            *(LAS v2u*)(H1 + row * 136 + c4) = o;
        }
        __syncthreads();
        if (w < 4) {
            f32x4 o = (f32x4){0.f, 0.f, 0.f, 0.f};
            const bf16* w2 = W2T + (size_t)which * 64 * 128;
#pragma unroll
            for (int ks = 0; ks < 4; ++ks) { const bf16x8 a = *(LAS bf16x8*)(H1 + r16 * 136 + ks * 32 + q4 * 8);
                const bf16x8 bb = *(const bf16x8*)(w2 + (size_t)(w * 16 + r16) * 128 + ks * 32 + q4 * 8);
                o = __builtin_amdgcn_mfma_f32_16x16x32_bf16(a, bb, o, 0, 0, 0); }
            bf16* out = (which == 0 ? KC : VC) + ((size_t)(b * 2 + g) * 128) * 64;
#pragma unroll
            for (int i = 0; i < 4; ++i) { const int row = nb * 16 + 4 * q4 + i; out[(size_t)row * 64 + w * 16 + r16] = row < 127 ? (bf16)f2bf(o[i]) : (bf16)0; }
        }
    }
    __syncthreads();
}
__device__ __forceinline__ void phase_kmean(const Frame& F, const bf16* P, float* KM) {
    const int gw = gwave(F), NGW = ngwave(F), lane = F.lane, rs = lane >> 3, ch = lane & 7;
    for (int un = gw; un < 8 * 8 * 8; un += NGW) { const int h = un & 7, blk = (un >> 3) & 7, b = un >> 6;
        const bf16* base = P + ((size_t)b * SEQ + blk * 256) * NP1 + C_DK + h * 64 + ch * 8;
        float s[8];
#pragma unroll
        for (int e = 0; e < 8; ++e) s[e] = 0.f;
#pragma unroll 8
        for (int i = 0; i < 32; ++i) { const v4u v = *(const v4u*)(base + (size_t)(i * 8 + rs) * NP1);
            s[0] += bflo(v.x); s[1] += bfhi(v.x); s[2] += bflo(v.y); s[3] += bfhi(v.y); s[4] += bflo(v.z); s[5] += bfhi(v.z); s[6] += bflo(v.w); s[7] += bfhi(v.w); }
#pragma unroll
        for (int e = 0; e < 8; ++e) { s[e] += shx(s[e], 8, lane); s[e] += shx(s[e], 16, lane); s[e] = add32(s[e]); }
        if (rs == 0) { float* o = KM + ((size_t)(b * 8 + blk) * 8 + h) * 64 + ch * 8;
            *(f32x4*)o = (f32x4){s[0], s[1], s[2], s[3]} * (1.0f / 256.0f); *(f32x4*)(o + 4) = (f32x4){s[4], s[5], s[6], s[7]} * (1.0f / 256.0f); }
    }
}

constexpr int KT_STRIDE = 144, VT_STRIDE = 192, KT_BYTES = 64 * KT_STRIDE, VT_BYTES = 64 * VT_STRIDE, KV_BUF = KT_BYTES + VT_BYTES;
__device__ __forceinline__ int crow(int r, int hi) { return (r & 3) + 8 * (r >> 2) + 4 * hi; }
struct AttnState { float m, l; f32x16 o0, o1; };
__device__ __forceinline__ void attn_reset(AttnState& st) { st.m = -1e30f; st.l = 0.f;
#pragma unroll
    for (int r = 0; r < 16; ++r) { st.o0[r] = 0.f; st.o1[r] = 0.f; } }
__device__ __forceinline__ s16x4 vtr(LAS const unsigned char* p) { return __builtin_bit_cast(s16x4, __builtin_amdgcn_ds_read_tr16_b64_v4i16((LAS s16x4*)p)); }

__device__ __forceinline__ void attn_scores(LAS const unsigned char* Kt, const bf16x8 (&qr)[4], f32x16& p0, f32x16& p1, int lane) {
    const int r32 = lane & 31, hi = lane >> 5;
#pragma unroll
    for (int r = 0; r < 16; ++r) { p0[r] = 0.f; p1[r] = 0.f; }
#pragma unroll
    for (int s = 0; s < 4; ++s) {
        const bf16x8 a0 = *(LAS const bf16x8*)(Kt + r32 * KT_STRIDE + (2 * s + hi) * 16), a1 = *(LAS const bf16x8*)(Kt + (32 + r32) * KT_STRIDE + (2 * s + hi) * 16);
        p0 = __builtin_amdgcn_mfma_f32_32x32x16_bf16(a0, qr[s], p0, 0, 0, 0);
        p1 = __builtin_amdgcn_mfma_f32_32x32x16_bf16(a1, qr[s], p1, 0, 0, 0);
    }
}
__device__ __forceinline__ void attn_pv(LAS const unsigned char* Vt, const f32x16& e0, const f32x16& e1, f32x16& o0, f32x16& o1, int lane) {
    const int hi = lane >> 5;
    LAS const unsigned char* vb = Vt + (4 * hi + ((lane & 15) >> 2)) * VT_STRIDE + (((lane >> 4) & 1) * 16 + 4 * (lane & 3)) * 2;
#pragma unroll
    for (int s = 0; s < 4; ++s) {
        v4u pw;
        if (s < 2) { pw.x = pk2(e0[8 * s + 0], e0[8 * s + 1]); pw.y = pk2(e0[8 * s + 2], e0[8 * s + 3]); pw.z = pk2(e0[8 * s + 4], e0[8 * s + 5]); pw.w = pk2(e0[8 * s + 6], e0[8 * s + 7]); }
        else { const int t = s - 2; pw.x = pk2(e1[8 * t + 0], e1[8 * t + 1]); pw.y = pk2(e1[8 * t + 2], e1[8 * t + 3]); pw.z = pk2(e1[8 * t + 4], e1[8 * t + 5]); pw.w = pk2(e1[8 * t + 6], e1[8 * t + 7]); }
        const bf16x8 pb = __builtin_bit_cast(bf16x8, pw);
#pragma unroll
        for (int db = 0; db < 2; ++db) {
            const s16x4 lo = vtr(vb + (16 * s) * VT_STRIDE + db * 64), hh = vtr(vb + (16 * s + 8) * VT_STRIDE + db * 64);
            const bf16x8 a = (bf16x8){lo[0], lo[1], lo[2], lo[3], hh[0], hh[1], hh[2], hh[3]};
            if (db == 0) o0 = __builtin_amdgcn_mfma_f32_32x32x16_bf16(a, pb, o0, 0, 0, 0); else o1 = __builtin_amdgcn_mfma_f32_32x32x16_bf16(a, pb, o1, 0, 0, 0);
        }
    }
}
__device__ __forceinline__ float max3f(float a, float b, float c) { float r; asm("v_max3_f32 %0, %1, %2, %3" : "=v"(r) : "v"(a), "v"(b), "v"(c)); return r; }
__device__ __forceinline__ float mask_score(float v, int a, int b, int c) {
    const unsigned sg = (unsigned)(((a + c) | (b - c)) >> 31);
    return __builtin_bit_cast(float, (__builtin_bit_cast(unsigned, v) & ~sg) | (0xf149f2cau & sg));
}
__device__ __forceinline__ void attn_tile(LAS const unsigned char* Kt, LAS const unsigned char* Vt, const bf16x8 (&qr)[4], AttnState& st, int kmin, int kmax, int lane) {
    const int hi = lane >> 5;
    f32x16 p0, p1; attn_scores(Kt, qr, p0, p1, lane);
    if (!__all(kmin <= 0 && kmax >= 63)) {
        const int a = 4 * hi - kmin, b = kmax - 4 * hi;
#pragma unroll
        for (int r = 0; r < 16; ++r) { const int c = (r & 3) + 8 * (r >> 2); p0[r] = mask_score(p0[r], a, b, c); p1[r] = mask_score(p1[r], a, b, c + 32); }
    }
    asm volatile("s_nop 15\n\ts_nop 7" : "+v"(p0), "+v"(p1));
    float mx = max3f(p0[0], p0[1], p1[0]), mx2 = max3f(p0[2], p0[3], p1[1]);
    mx = max3f(mx, p1[2], p1[3]);
#pragma unroll
    for (int r = 4; r < 16; r += 4) { mx = max3f(mx, p0[r], p0[r + 1]); mx2 = max3f(mx2, p0[r + 2], p0[r + 3]); mx = max3f(mx, p1[r], p1[r + 1]); mx2 = max3f(mx2, p1[r + 2], p1[r + 3]); }
    mx = max3f(mx, mx2, mx2);
    mx = max32(mx);
    const float mn = fmaxf(st.m, mx), me = fmaxf(mn, -1e29f), alpha = __builtin_amdgcn_exp2f(st.m - me);
    float rs = 0.f;
#pragma unroll
    for (int r = 0; r < 16; ++r) { p0[r] = __builtin_amdgcn_exp2f(p0[r] - me); p1[r] = __builtin_amdgcn_exp2f(p1[r] - me); rs += p0[r] + p1[r]; }
    st.m = mn; st.l = st.l * alpha + rs;
    if (__any(alpha < 1.0f)) {
#pragma unroll
        for (int r = 0; r < 16; ++r) { st.o0[r] *= alpha; st.o1[r] *= alpha; }
    }
    attn_pv(Vt, p0, p1, st.o0, st.o1, lane);
}
struct KVRegs { v4u k, v; };
__device__ __forceinline__ void kv_load(KVRegs& r, const bf16* Kg, const bf16* Vg, size_t ld, int tid) {
    const int key = tid >> 3, ch = tid & 7;
    r.k = *(const v4u*)(Kg + (size_t)key * ld + ch * 8); r.v = *(const v4u*)(Vg + (size_t)key * ld + ch * 8);
}
__device__ __forceinline__ void kv_store(const KVRegs& r, LAS unsigned char* buf, int tid) {
    const int key = tid >> 3, ch = tid & 7;
    *(LAS v4u*)(buf + key * KT_STRIDE + ch * 16) = r.k; *(LAS v4u*)(buf + KT_BYTES + key * VT_STRIDE + ch * 16) = r.v;
}

__device__ __forceinline__ float attn_inv_l(const AttnState& st) { const float l = add32(st.l); return 1.0f / fmaxf(l, 1e-30f); }

#define ATTN_STREAM(Kg, Vg, ld, j0, j1, SKIP, RANGE) do { \
    int jn_ = (j0); while (jn_ < (j1) && (SKIP(jn_))) ++jn_; \
    if (jn_ < (j1)) { KVRegs kv_; kv_load(kv_, (Kg) + (size_t)jn_ * 64 * (ld), (Vg) + (size_t)jn_ * 64 * (ld), (ld), F.tid); \
        __syncthreads(); kv_store(kv_, ring, F.tid); int cur_ = 0; \
        for (;;) { const int j_ = jn_; ++jn_; while (jn_ < (j1) && (SKIP(jn_))) ++jn_; const bool more_ = jn_ < (j1); \
            if (more_) kv_load(kv_, (Kg) + (size_t)jn_ * 64 * (ld), (Vg) + (size_t)jn_ * 64 * (ld), (ld), F.tid); \
            __syncthreads(); \
            { int kmin_, kmax_; RANGE(j_, kmin_, kmax_); \
              if (__any(kmax_ >= kmin_)) attn_tile(ring + cur_ * KV_BUF, ring + cur_ * KV_BUF + KT_BYTES, qr, st, kmin_, kmax_, F.lane); } \
            if (!more_) break; \
            kv_store(kv_, ring + (cur_ ^ 1) * KV_BUF, F.tid); cur_ ^= 1; } } } while (0)

__device__ __forceinline__ void nsa_unit(const Frame& F, const bf16* P, const bf16* KC, const bf16* VC, bf16* O  , int b, int g, int i) {
    LAS unsigned char* ring = F.lds;
    LAS float* impb = (LAS float*)(F.lds + 2 * KV_BUF);
    LAS unsigned* selm = (LAS unsigned*)(F.lds + 2 * KV_BUF + 33792);
    LAS float* stash = (LAS float*)(F.lds + 2 * KV_BUF + 33792 + 256) + F.tid;
    const int lane = F.lane, r32 = lane & 31, hi = lane >> 5, hr = F.wave & 3, th = F.wave >> 2;
    const int tl = 32 * th + r32;
    const int s = 64 * i + tl;
    const size_t row = (size_t)b * SEQ + s;
    const int head = g * 4 + hr;
    bf16x8 qr[4];
#pragma unroll
    for (int d = 0; d < 4; ++d) qr[d] = *(const bf16x8*)(P + row * NP1 + C_CQ + head * 64 + d * 16 + hi * 8);
    const float g0 = sigmoidf_(bf2f(P[row * NP1 + C_CG + head])), g1 = sigmoidf_(bf2f(P[row * NP1 + C_CG + 8 + head])), g2 = sigmoidf_(bf2f(P[row * NP1 + C_CG + 16 + head]));
    AttnState st;
    {
        const bf16* Kg = KC + (size_t)(b * 2 + g) * 128 * 64; const bf16* Vg = VC + (size_t)(b * 2 + g) * 128 * 64;
        const int nmax = (s >= 31) ? ((s - 31) >> 4) : -1;
        { KVRegs kv0, kv1; kv_load(kv0, Kg, Vg, 64, F.tid); kv_load(kv1, Kg + 64 * 64, Vg + 64 * 64, 64, F.tid);
          __syncthreads();
          kv_store(kv0, ring, F.tid); kv_store(kv1, ring + KV_BUF, F.tid); }
        __syncthreads();
        attn_reset(st);
        attn_tile(ring, ring + KT_BYTES, qr, st, 0, nmax < 63 ? nmax : 63, lane);
        attn_tile(ring + KV_BUF, ring + KV_BUF + KT_BYTES, qr, st, 0, nmax - 64 < 63 ? nmax - 64 : 63, lane);
        const float inv = attn_inv_l(st);
        { const float sc = g0 * inv;
#pragma unroll
          for (int r = 0; r < 16; ++r) { stash[r * 512] = st.o0[r] * sc; stash[(16 + r) * 512] = st.o1[r] * sc; } }
        if (i >= 16) {
            float xprev = 0.f; const float mfin = st.m;
#define NSA_IMP(U, ACC, GQ) do { const float G_ = ((ACC[4 * (GQ)] + ACC[4 * (GQ) + 1]) + (ACC[4 * (GQ) + 2] + ACC[4 * (GQ) + 3])), L_ = ACC[4 * (GQ) + 3]; \
                const float x_ = other32(L_, hi); impb[(hr * 64 + tl) * 33 + 2 * (U) + hi] = G_ + (hi ? x_ : xprev); xprev = x_; } while (0)
#pragma unroll
            for (int tile = 0; tile < 2; ++tile) {
                f32x16 a0, a1; attn_scores(ring + tile * KV_BUF, qr, a0, a1, lane);
#pragma unroll
                for (int r = 0; r < 16; ++r) { const int c = (r & 3) + 8 * (r >> 2);
                    a0[r] = __builtin_amdgcn_exp2f(mask_score(a0[r], 4 * hi, nmax - 64 * tile - 4 * hi, c) - mfin) * inv; a1[r] = __builtin_amdgcn_exp2f(mask_score(a1[r], 4 * hi, nmax - 64 * tile - 4 * hi, c + 32) - mfin) * inv; }
                NSA_IMP(8 * tile + 0, a0, 0); NSA_IMP(8 * tile + 1, a0, 1); NSA_IMP(8 * tile + 2, a0, 2); NSA_IMP(8 * tile + 3, a0, 3);
                NSA_IMP(8 * tile + 4, a1, 0); NSA_IMP(8 * tile + 5, a1, 1); NSA_IMP(8 * tile + 6, a1, 2); NSA_IMP(8 * tile + 7, a1, 3);
            }
#undef NSA_IMP
        }
    }
    __syncthreads();
    unsigned mymask;
    if (i < 16) mymask = (2u << i) - 1u;
    else {
        { const int tk = F.tid >> 3, js = F.tid & 7; unsigned bits = 0u;
          float v[4];
#pragma unroll
          for (int e = 0; e < 4; ++e) { const int j = js * 4 + e; v[e] = (impb[(0 * 64 + tk) * 33 + j] + impb[(1 * 64 + tk) * 33 + j]) + (impb[(2 * 64 + tk) * 33 + j] + impb[(3 * 64 + tk) * 33 + j]); }
          int rank[4] = {0, 0, 0, 0};
          for (int jj = 1; jj <= i - 2; ++jj) { const float o = (impb[(0 * 64 + tk) * 33 + jj] + impb[(1 * 64 + tk) * 33 + jj]) + (impb[(2 * 64 + tk) * 33 + jj] + impb[(3 * 64 + tk) * 33 + jj]);
#pragma unroll
              for (int e = 0; e < 4; ++e) { const int j = js * 4 + e; rank[e] += (o > v[e] || (o == v[e] && jj < j)) ? 1 : 0; } }
#pragma unroll
          for (int e = 0; e < 4; ++e) { const int j = js * 4 + e; const bool forced = (j == 0) || (j == i) || (j == i - 1); const bool cand = (j >= 1) && (j <= i - 2);
              if (forced || (cand && rank[e] < 13)) bits |= 1u << j; }
          bits |= shxu(bits, 1, F.lane); bits |= shxu(bits, 2, F.lane); bits |= shxu(bits, 4, F.lane);
          if (js == 0) selm[tk] = bits; }
        __syncthreads();
        mymask = selm[tl];
    }
    {
        attn_reset(st);
        const bf16* Kg = P + (size_t)b * SEQ * NP1 + C_KS + g * 64; const bf16* Vg = P + (size_t)b * SEQ * NP1 + C_VS + g * 64;
#define NSA_SKIP(j) (false)
#define NSA_RANGE(j, kmin, kmax) do { kmin = 0; kmax = ((mymask >> (j)) & 1u) ? ((j) == i ? tl : 63) : -1; } while (0)
        ATTN_STREAM(Kg, Vg, (size_t)NP1, 0, i + 1, NSA_SKIP, NSA_RANGE);
#undef NSA_RANGE
        const float sc = g1 * attn_inv_l(st);
#pragma unroll
        for (int r = 0; r < 16; ++r) { stash[r * 512] += st.o0[r] * sc; stash[(16 + r) * 512] += st.o1[r] * sc; }
    }
    {
        attn_reset(st);
        const bf16* Kg = P + (size_t)b * SEQ * NP1 + C_KW + g * 64; const bf16* Vg = P + (size_t)b * SEQ * NP1 + C_VW + g * 64;
        const int jlo = i >= 8 ? i - 8 : 0; f32x16 out0, out1;
#define NSA_RANGE(j, kmin, kmax) do { const int d_ = 64 * (i - (j)) + tl; kmin = d_ - 511 > 0 ? d_ - 511 : 0; kmax = d_ < 63 ? d_ : 63; } while (0)
        ATTN_STREAM(Kg, Vg, (size_t)NP1, jlo, i + 1, NSA_SKIP, NSA_RANGE);
#undef NSA_RANGE
#undef NSA_SKIP
        const float sc = g2 * attn_inv_l(st);
#pragma unroll
        for (int r = 0; r < 16; ++r) { out0[r] = stash[r * 512] + st.o0[r] * sc; out1[r] = stash[(16 + r) * 512] + st.o1[r] * sc; }
        bf16* orow = O + row * 512 + head * 64;
#pragma unroll
        for (int gq = 0; gq < 4; ++gq) {
            v2u w0; w0.x = pk2(out0[4 * gq], out0[4 * gq + 1]); w0.y = pk2(out0[4 * gq + 2], out0[4 * gq + 3]); *(v2u*)(orow + 8 * gq + 4 * hi) = w0;
            v2u w1; w1.x = pk2(out1[4 * gq], out1[4 * gq + 1]); w1.y = pk2(out1[4 * gq + 2], out1[4 * gq + 3]); *(v2u*)(orow + 32 + 8 * gq + 4 * hi) = w1; }
    }
}
__device__ __forceinline__ void phase_nsa(const Frame& F, const bf16* P, const bf16* KC, const bf16* VC, bf16* O) {
    for (int un2 = 2 * F.bid; un2 < 512; un2 += 2 * F.G)
#pragma unroll 1
        for (int k = 0; k < 2; ++k) { const int un = un2 >> 1, ip = un & 15, g = (un >> 4) & 1, b = un >> 5; nsa_unit(F, P, KC, VC, O, b, g, k == 0 ? 31 - ip : ip); }
}

__device__ __forceinline__ void moba_unit(const Frame& F, const bf16* P, const float* KM, bf16* O  , int b, int h, int qb) {
    LAS unsigned char* ring = F.lds;
    LAS float* kml = (LAS float*)(F.lds + 2 * KV_BUF);
    LAS unsigned* uni = (LAS unsigned*)(F.lds + 2 * KV_BUF + 2048);
    const int lane = F.lane, r32 = lane & 31, hi = lane >> 5;
    const int tl = 32 * F.wave + r32;
    const size_t row = (size_t)b * SEQ + 256 * qb + tl;
    bf16x8 qr[4];
#pragma unroll
    for (int d = 0; d < 4; ++d) qr[d] = *(const bf16x8*)(P + row * NP1 + C_DQ + h * 64 + d * 16 + hi * 8);
    __syncthreads();
    { const int blk = F.tid >> 6, p = F.tid & 63; kml[F.tid] = KM[((size_t)(b * 8 + blk) * 8 + h) * 64 + p]; if (F.tid == 0) uni[0] = 0u; }
    __syncthreads();
    unsigned mymask = 0u;
    if (qb > 0) {
        float gt[8];
#pragma unroll
        for (int n = 0; n < 8; ++n) { float a = 0.f;
#pragma unroll
            for (int d = 0; d < 4; ++d) { const v4u qw = __builtin_bit_cast(v4u, qr[d]); const LAS float* km = kml + n * 64 + d * 16 + hi * 8;
                a += bflo(qw.x) * km[0] + bfhi(qw.x) * km[1] + bflo(qw.y) * km[2] + bfhi(qw.y) * km[3] + bflo(qw.z) * km[4] + bfhi(qw.z) * km[5] + bflo(qw.w) * km[6] + bfhi(qw.w) * km[7]; }
            a = add32(a); gt[n] = a; }
#pragma unroll
        for (int n = 0; n < 8; ++n) { int rank = 0;
#pragma unroll
            for (int m = 0; m < 8; ++m) rank += (m < qb && m != n && (gt[m] > gt[n] || (gt[m] == gt[n] && m < n))) ? 1 : 0;
            if (n < qb && rank < 3) mymask |= 1u << n; }
        atomicOr((unsigned*)uni, mymask);
    }
    __syncthreads();
    const unsigned um = uni[0];
    AttnState st; attn_reset(st);
    const bf16* Kg = P + (size_t)b * SEQ * NP1 + C_DK + h * 64; const bf16* Vg = P + (size_t)b * SEQ * NP1 + C_DV + h * 64;
#define MOBA_SKIP(j) ((j) < 4 * qb && !((um >> ((j) >> 2)) & 1u))
#define MOBA_RANGE(j, kmin, kmax) do { kmin = 0; if ((j) < 4 * qb) kmax = ((mymask >> ((j) >> 2)) & 1u) ? 63 : -1; else { const int d_ = tl - 64 * ((j) - 4 * qb); kmax = d_ < 63 ? d_ : 63; } } while (0)
    ATTN_STREAM(Kg, Vg, (size_t)NP1, 0, 4 * qb + 4, MOBA_SKIP, MOBA_RANGE);
#undef MOBA_SKIP
#undef MOBA_RANGE
    const float sc = attn_inv_l(st);
    bf16* orow = O + row * 512 + h * 64;
#pragma unroll
    for (int gq = 0; gq < 4; ++gq) {
        v2u w0; w0.x = pk2(st.o0[4 * gq] * sc, st.o0[4 * gq + 1] * sc); w0.y = pk2(st.o0[4 * gq + 2] * sc, st.o0[4 * gq + 3] * sc); *(v2u*)(orow + 8 * gq + 4 * hi) = w0;
        v2u w1; w1.x = pk2(st.o1[4 * gq] * sc, st.o1[4 * gq + 1] * sc); w1.y = pk2(st.o1[4 * gq + 2] * sc, st.o1[4 * gq + 3] * sc); *(v2u*)(orow + 32 + 8 * gq + 4 * hi) = w1; }
}
__device__ __forceinline__ void phase_moba(const Frame& F, const bf16* P, const float* KM, bf16* O) {
    for (int un2 = 2 * F.bid; un2 < 512; un2 += 2 * F.G)
#pragma unroll 1
        for (int k = 0; k < 2; ++k) { const int un = un2 >> 1, qp = un & 3, h = (un >> 2) & 7, b = un >> 5; moba_unit(F, P, KM, O, b, h, k == 0 ? 7 - qp : qp); }
}

__device__ __forceinline__ unsigned ord_key(float x) { const unsigned u = __builtin_bit_cast(unsigned, x); return (u & 0x80000000u) ? ~u : (u | 0x80000000u); }
__device__ __forceinline__ float ord_val(unsigned k) { const unsigned u = (k & 0x80000000u) ? (k & 0x7fffffffu) : ~k; return __builtin_bit_cast(float, u); }
__device__ __forceinline__ void ce_desc(unsigned& a, unsigned& b) { const unsigned hi_ = a > b ? a : b, lo_ = a > b ? b : a; a = hi_; b = lo_; }
__device__ __forceinline__ void bitonic_merge16_desc(unsigned* a) {
#pragma unroll
    for (int j = 8; j > 0; j >>= 1)
#pragma unroll
        for (int i = 0; i < 16; ++i) if ((i & j) == 0) ce_desc(a[i], a[i | j]);
}
__device__ __forceinline__ void bitonic_sort16_desc(unsigned* a) {
#pragma unroll
    for (int k = 2; k <= 16; k <<= 1)
#pragma unroll
        for (int j = k >> 1; j > 0; j >>= 1)
#pragma unroll
            for (int i = 0; i < 16; ++i) { const int l = i ^ j; if (l > i) { if ((i & k) == 0) ce_desc(a[i], a[l]); else ce_desc(a[l], a[i]); } }
}
__device__ __forceinline__ void merge_top16(unsigned* a, const unsigned* b) {
#pragma unroll
    for (int i = 0; i < 16; ++i) a[i] = a[i] > b[15 - i] ? a[i] : b[15 - i];
    bitonic_merge16_desc(a);
}
constexpr int SK_STRIDE = 272;
__device__ __forceinline__ void peer_route_unit(const Frame& F, const bf16* Q2, const bf16* SUBK  , int* EIDX, float* EW, int tb, int h) {
    LAS unsigned char* skl = F.lds;
    LAS unsigned* slot = (LAS unsigned*)(F.lds + 36864) + F.tid;
    const int lane = F.lane, r32 = lane & 31, hi = lane >> 5;
    const size_t tok = (size_t)tb * 256 + F.wave * 32 + r32;
#pragma unroll 1
    for (int p = 0; p < 2; ++p) {
        __syncthreads();
        for (int i = F.tid; i < 128 * 16; i += NTHR) { const int ch = i & 15, rowi = i >> 4;
            *(LAS v4u*)(skl + rowi * SK_STRIDE + ch * 16) = *(const v4u*)(SUBK + ((size_t)h * 256 + p * 128 + rowi) * 128 + ch * 8); }
        __syncthreads();
        bf16x8 qf[8]; float ss = 0.f;
#pragma unroll
        for (int s = 0; s < 8; ++s) { qf[s] = *(const bf16x8*)(Q2 + tok * 2048 + h * 256 + p * 128 + s * 16 + hi * 8); const v4u w = __builtin_bit_cast(v4u, qf[s]);
            const float a0 = bflo(w.x), a1 = bfhi(w.x), a2 = bflo(w.y), a3 = bfhi(w.y), a4 = bflo(w.z), a5 = bfhi(w.z), a6 = bflo(w.w), a7 = bfhi(w.w);
            ss += (a0 * a0 + a1 * a1) + (a2 * a2 + a3 * a3) + (a4 * a4 + a5 * a5) + (a6 * a6 + a7 * a7); }
        ss = add32(ss);
        const float rn = 1.0f / sqrtf(ss * (1.0f / 128.0f) + NORM_EPS);
        unsigned key[64];
#pragma unroll
        for (int nb = 0; nb < 4; ++nb) { f32x16 acc;
#pragma unroll
            for (int r = 0; r < 16; ++r) acc[r] = 0.f;
#pragma unroll
            for (int s = 0; s < 8; ++s) { const bf16x8 a = *(LAS const bf16x8*)(skl + (nb * 32 + r32) * SK_STRIDE + (2 * s + hi) * 16);
                acc = __builtin_amdgcn_mfma_f32_32x32x16_bf16(a, qf[s], acc, 0, 0, 0); }
#pragma unroll
            for (int r = 0; r < 16; ++r) { const int n = nb * 32 + crow(r, hi); key[nb * 16 + r] = (ord_key(acc[r] * rn) & 0xffffff80u) | (unsigned)(127 - n); } }
#pragma unroll
        for (int blk = 0; blk < 4; ++blk) bitonic_sort16_desc(key + 16 * blk);
        merge_top16(key, key + 16); merge_top16(key + 32, key + 48); merge_top16(key, key + 32);
        { unsigned oth[16];
#pragma unroll
          for (int i = 0; i < 16; ++i) { unsigned r0, r1; swap32(key[i], r0, r1); oth[i] = hi ? r0 : r1; }
          merge_top16(key, oth); }
#pragma unroll
        for (int k = 0; k < 16; ++k) slot[(p * 16 + k) * 512] = key[k];
    }
    LDS_WAIT(); asm volatile("" ::: "memory");
    unsigned ck[64];
    { float v1[16], v2[16];
#pragma unroll
      for (int k = 0; k < 16; ++k) { v1[k] = ord_val(slot[k * 512] & 0xffffff80u); v2[k] = ord_val(slot[(16 + k) * 512] & 0xffffff80u); }
      int c = 0;
#pragma unroll
      for (int a = 0; a < 16; ++a)
#pragma unroll
          for (int bq = 0; bq < 16; ++bq) if ((a + 1) * (bq + 1) <= 16) { ck[c] = (ord_key(v1[a] + v2[bq]) & 0xffffff00u) | (unsigned)(255 - (16 * a + bq)); ++c; }
#pragma unroll
      for (int q = 50; q < 64; ++q) ck[q] = 0u; }
#pragma unroll
    for (int blk = 0; blk < 4; ++blk) bitonic_sort16_desc(ck + 16 * blk);
    merge_top16(ck, ck + 16); merge_top16(ck + 32, ck + 48); merge_top16(ck, ck + 32);
    float den = 0.f; const float mx = ord_val(ck[0] & 0xffffff00u);
#pragma unroll
    for (int k = 0; k < 16; ++k) { const unsigned m = ck[k];
        const int ci = 255 - (int)(m & 255u), a = ci >> 4, bq = ci & 15;
        const unsigned ka = slot[a * 512], kb = slot[(16 + bq) * 512];
        const int te = (127 - (int)(ka & 127u)) * 128 + (127 - (int)(kb & 127u));
        const float ek = __expf(ord_val(m & 0xffffff00u) - mx); den += ek;
        slot[(32 + k) * 512] = __builtin_bit_cast(unsigned, ek);
        if (hi == 0) EIDX[(tok * 8 + h) * 16 + k] = te; }
    LDS_WAIT(); asm volatile("" ::: "memory");
    if (hi == 0) { const float inv = 1.0f / den; float* ewp = EW + (tok * 8 + h) * 16;
#pragma unroll
        for (int q = 0; q < 4; ++q) *(f32x4*)(ewp + 4 * q) = (f32x4){__builtin_bit_cast(float, slot[(32 + 4 * q) * 512]), __builtin_bit_cast(float, slot[(33 + 4 * q) * 512]),
                                                                      __builtin_bit_cast(float, slot[(34 + 4 * q) * 512]), __builtin_bit_cast(float, slot[(35 + 4 * q) * 512])} * inv; }
}

__device__ __forceinline__ void phase_peer_route(const Frame& F, const bf16* Q2, const bf16* SUBK, int* EIDX, float* EW) {
    for (int un = F.bid; un < 64 * 8; un += F.G) peer_route_unit(F, Q2, SUBK, EIDX, EW, un >> 3, un & 7);
}

__device__ __forceinline__ void phase_peer_tables(const Frame& F, const float* U, const float* V, unsigned char* UT8, unsigned char* VT8, float* SU, float* SV) {
    const int gw = gwave(F), NGW = ngwave(F), lane = F.lane;
    for (int r = gw; r < 2 * 16384; r += NGW) {
        const int tab = r >> 14, e = r & 16383; const float* src = (tab ? V : U) + (size_t)e * DM + 16 * lane;
        f32x4 x[4]; float mx = 0.f;
#pragma unroll
        for (int q = 0; q < 4; ++q) { x[q] = *(const f32x4*)(src + 4 * q); mx = fmaxf(fmaxf(mx, fmaxf(fabsf(x[q][0]), fabsf(x[q][1]))), fmaxf(fabsf(x[q][2]), fabsf(x[q][3]))); }
#pragma unroll
        for (int o = 1; o < 32; o <<= 1) mx = fmaxf(mx, shx(mx, o, lane));
        mx = max32(mx);
        int ex = 0; (void)frexpf(mx, &ex);
        const int k = (mx > 0.f) ? (8 - ex) : 0;
        const float sc = __builtin_ldexpf(1.0f, k), inv = __builtin_ldexpf(1.0f, -k);
        v4u w; float rowscale = inv;
        if (tab) {
#pragma unroll
            for (int q = 0; q < 4; ++q) { unsigned p = 0u; p = __builtin_amdgcn_cvt_pk_fp8_f32(x[q][0] * sc, x[q][1] * sc, p, false); p = __builtin_amdgcn_cvt_pk_fp8_f32(x[q][2] * sc, x[q][3] * sc, p, true); w[q] = p; }
        } else {
            const float qs = mx > 0.f ? 127.0f / mx : 0.f; rowscale = mx > 0.f ? mx * (1.0f / 127.0f) : 0.f;
#pragma unroll
            for (int q = 0; q < 4; ++q) w[q] = ((unsigned)(int)rintf(x[q][0] * qs) & 0xffu) | (((unsigned)(int)rintf(x[q][1] * qs) & 0xffu) << 8) | (((unsigned)(int)rintf(x[q][2] * qs) & 0xffu) << 16) | (((unsigned)(int)rintf(x[q][3] * qs) & 0xffu) << 24);
        }
        *(v4u*)((tab ? VT8 : UT8) + ((size_t)(lane >> 3) * 16384 + e) * 128 + (lane & 7) * 16) = w;
        if (lane == 0) (tab ? SV : SU)[e] = rowscale;
    }
}
typedef _Float16 h16x2 __attribute__((ext_vector_type(2)));
typedef __fp16 fp16x2_t __attribute__((ext_vector_type(2)));
__device__ __forceinline__ void phase_peer_u(const Frame& F, const unsigned char* H8, const float* HS, const unsigned char* UT8, const float* SU, const int* EIDX, float* PART) {
    const int lane = F.lane, g = lane >> 3, sub = lane & 7, b0 = lane & 1, b1 = (lane >> 1) & 1, b2 = (lane >> 2) & 1;
    const int s = F.bid & 7, wgq = F.bid >> 3, nq = F.G >> 3;
    LAS int* il = (LAS int*)(F.lds + F.wave * 8192);
    LAS float* pcl = (LAS float*)(F.lds + F.wave * 8192 + 4096);
    const unsigned char* ub = UT8 + (size_t)s * 16384 * 128 + sub * 16;
    for (int batch = wgq * 8 + F.wave; batch < TOK / 8; batch += nq * 8) {
        const int t0 = batch * 8, t = t0 + g;
        { const v4u* src = (const v4u*)(EIDX + (size_t)t0 * 128 + lane * 16);
          const v4u i0 = src[0], i1 = src[1], i2 = src[2], i3 = src[3];
          LAS v4u* dst = (LAS v4u*)(il + lane * 16); dst[0] = i0; dst[1] = i1; dst[2] = i2; dst[3] = i3; }
        const v4u h = *(const v4u*)(H8 + (size_t)t * DM + s * 128 + sub * 16);
        const float hs = HS[t];
        LDS_WAIT(); asm volatile("" ::: "memory");
#define PU_LOAD(c, ua, su_) do { const v4u ia = *(LAS v4u*)(il + g * 128 + (c) * 8), ib = *(LAS v4u*)(il + g * 128 + (c) * 8 + 4); \
            ua[0] = *(const v4u*)(ub + (size_t)ia.x * 128); ua[1] = *(const v4u*)(ub + (size_t)ia.y * 128); ua[2] = *(const v4u*)(ub + (size_t)ia.z * 128); ua[3] = *(const v4u*)(ub + (size_t)ia.w * 128); \
            ua[4] = *(const v4u*)(ub + (size_t)ib.x * 128); ua[5] = *(const v4u*)(ub + (size_t)ib.y * 128); ua[6] = *(const v4u*)(ub + (size_t)ib.z * 128); ua[7] = *(const v4u*)(ub + (size_t)ib.w * 128); \
            su_ = SU[il[g * 128 + (c) * 8 + sub]] * hs; } while (0)
#define PU_COMP(c, ua, su_) do { float a[8]; \
            _Pragma("unroll") for (int j = 0; j < 8; ++j) { int acc = __builtin_amdgcn_sdot4((int)ua[j].x, (int)h.x, 0, false); acc = __builtin_amdgcn_sdot4((int)ua[j].y, (int)h.y, acc, false); \
                acc = __builtin_amdgcn_sdot4((int)ua[j].z, (int)h.z, acc, false); acc = __builtin_amdgcn_sdot4((int)ua[j].w, (int)h.w, acc, false); a[j] = (float)acc; } \
            float bq[4], cc[2]; \
            _Pragma("unroll") for (int p = 0; p < 4; ++p) { const float keep = b0 ? a[2 * p + 1] : a[2 * p], send = b0 ? a[2 * p] : a[2 * p + 1]; bq[p] = keep + shx(send, 1, lane); } \
            _Pragma("unroll") for (int q = 0; q < 2; ++q) { const float keep = b1 ? bq[2 * q + 1] : bq[2 * q], send = b1 ? bq[2 * q] : bq[2 * q + 1]; cc[q] = keep + shx(send, 2, lane); } \
            { const float keep = b2 ? cc[1] : cc[0], send = b2 ? cc[0] : cc[1]; pcl[(c) * 64 + lane] = (keep + shx(send, 4, lane)) * su_; } } while (0)
        { v4u uA[8], uB[8]; float sA, sB;
          PU_LOAD(0, uA, sA);
#pragma unroll 1
          for (int c = 0; c < 16; c += 2) {
              PU_LOAD(c + 1, uB, sB);
              PU_COMP(c, uA, sA);
              if (c + 2 < 16) PU_LOAD(c + 2, uA, sA);
              PU_COMP(c + 1, uB, sB);
          } }
#undef PU_LOAD
#undef PU_COMP
        LDS_WAIT(); asm volatile("" ::: "memory");
        float* dst = PART + ((size_t)s * TOK + t) * 128 + sub;
#pragma unroll
        for (int c = 0; c < 16; ++c) dst[8 * c] = pcl[c * 64 + lane];
        LDS_WAIT(); asm volatile("" ::: "memory");
    }
}
__device__ __forceinline__ float gelu_as(float v) {
    const float av = fabsf(v), t = __builtin_amdgcn_rcpf(av * 0.2316418882f + 1.0f);
    float q = t * 0.5307027145f + (-0.7265760135f); q = q * t + 0.7107068705f; q = q * t + (-0.142248368f); q = q * t + 0.127414796f; q = q * t;
    const float m = v * (q * __builtin_amdgcn_exp2f((v * v) * (-0.72134752044f)));
    return v < 0.f ? m : v - m;
}
__device__ __forceinline__ void phase_peer_w(const Frame& F, const float* SV, const int* EIDX, const float* EW, const float* PART, v2u* COEF) {
    const int nth = F.G * NTHR;
    for (int i = F.bid * NTHR + F.tid; i < TOK * 128; i += nth) {
        float act = 0.f;
#pragma unroll
        for (int sp = 0; sp < 8; ++sp) act += PART[(size_t)sp * TOK * 128 + i];
        const int e = EIDX[i]; const float c = EW[i] * gelu_as(act) * SV[e];
        COEF[i] = (v2u){(unsigned)e, __builtin_bit_cast(unsigned, c)};
    }
}
__device__ __forceinline__ void phase_peer_v(const Frame& F, const unsigned char* VT8, const v2u* COEF, float* XB, const float* gate) {
    const int lane = F.lane, g = lane >> 3, sub = lane & 7;
    const int s = F.bid & 7, wgq = F.bid >> 3, nq = F.G >> 3;
    LAS v2u* wl = (LAS v2u*)(F.lds + F.wave * 8192);
    const unsigned char* vb = VT8 + (size_t)s * 16384 * 128 + sub * 16;
    for (int batch = wgq * 8 + F.wave; batch < TOK / 8; batch += nq * 8) {
        const int t0 = batch * 8, t = t0 + g;
        { const v4u* src = (const v4u*)(COEF + (size_t)t0 * 128) + lane * 8;
          v4u c[8];
#pragma unroll
          for (int q = 0; q < 8; ++q) c[q] = src[q];
          LAS v4u* dst = (LAS v4u*)wl + lane * 8;
#pragma unroll
          for (int q = 0; q < 8; ++q) dst[q] = c[q]; }
        LDS_WAIT(); asm volatile("" ::: "memory");
        h16x2 o[8];
#pragma unroll
        for (int q = 0; q < 8; ++q) o[q] = (h16x2){(_Float16)0.f, (_Float16)0.f};
#define PV_LOAD(c, pr, va) do { \
            _Pragma("unroll") for (int q = 0; q < 4; ++q) pr[q] = *(LAS v4u*)(wl + g * 128 + (c) * 8 + 2 * q); \
            _Pragma("unroll") for (int q = 0; q < 4; ++q) { va[2 * q] = *(const v4u*)(vb + (size_t)pr[q].x * 128); va[2 * q + 1] = *(const v4u*)(vb + (size_t)pr[q].z * 128); } } while (0)
#define PV_COMP(pr, va) do { \
            _Pragma("unroll") for (int j = 0; j < 8; ++j) { const unsigned cb = (j & 1) ? pr[j >> 1].w : pr[j >> 1].y; \
                const float s2 = __builtin_bit_cast(float, cb & 0x7f800000u); const _Float16 mh = (_Float16)__builtin_bit_cast(float, (cb & 0x807fffffu) | 0x3f800000u); const h16x2 m2 = (h16x2){mh, mh}; \
                _Pragma("unroll") for (int q = 0; q < 4; ++q) { o[2 * q] = __builtin_elementwise_fma(__builtin_bit_cast(h16x2, __builtin_amdgcn_cvt_scalef32_pk_f16_fp8(va[j][q], s2, false)), m2, o[2 * q]); \
                    o[2 * q + 1] = __builtin_elementwise_fma(__builtin_bit_cast(h16x2, __builtin_amdgcn_cvt_scalef32_pk_f16_fp8(va[j][q], s2, true)), m2, o[2 * q + 1]); } } } while (0)
        { v4u pA[4], pB[4], vA[8], vB[8];
          PV_LOAD(0, pA, vA);
#pragma unroll 1
          for (int c = 0; c < 16; c += 2) {
              PV_LOAD(c + 1, pB, vB);
              PV_COMP(pA, vA);
              if (c + 2 < 16) PV_LOAD(c + 2, pA, vA);
              PV_COMP(pB, vB);
          } }
#undef PV_LOAD
#undef PV_COMP
        const int bb = t / SEQ; float* xr = XB + (size_t)t * DM + s * 128 + sub * 16; const float* gr = gate + (size_t)bb * 6144 + s * 128 + sub * 16;
#pragma unroll
        for (int q = 0; q < 4; ++q) { const f32x4 x = *(const f32x4*)(xr + 4 * q), gg = *(const f32x4*)(gr + 4 * q);
            *(f32x4*)(xr + 4 * q) = x + gg * (f32x4){(float)o[2 * q].x, (float)o[2 * q].y, (float)o[2 * q + 1].x, (float)o[2 * q + 1].y}; }
        LDS_WAIT(); asm volatile("" ::: "memory");
    }
}

constexpr int NPL = 12, NPHASE = 1 + DEPTH * NPL + 1;
constexpr int CW_BAR = 1024;
static_assert((CW_BAR + XCD_BAR_WORDS) * 4 <= (int)CTL_ZERO_BYTES, "barrier words inside the memset region");

__global__ void __launch_bounds__(NTHR, 2) hybrid_fwd(Args args) {
    extern __shared__ __attribute__((aligned(16))) unsigned char lds[];
    Frame F;
    F.lds = (LAS unsigned char*)lds; F.ldsg = lds;
    F.tid = threadIdx.x; F.lane = F.tid & 63; F.wave = __builtin_amdgcn_readfirstlane(F.tid >> 6);
    F.G = gridDim.x; F.bid = blockIdx.x; F.ws = args.ws;
    GAS unsigned char* wsg = (GAS unsigned char*)args.ws;
#define WSP ((unsigned char*)wsg)
    volatile LAS unsigned* MISC = (volatile LAS unsigned*)(F.lds + MISC_OFF);
    for (int u = F.tid; u < 64; u += NTHR) ((LAS unsigned*)(F.lds + MISC_OFF))[u] = 0u;
    __syncthreads();
    XcdBarrier bar; bar.bar = (unsigned*)(WSP + WS_CTL) + CW_BAR; bar.x = 0; bar.st = nullptr;
    const int lo = args.ph_lo, hi = args.ph_hi;
    if (hi - lo > 1) bar = xcd_barrier_post((unsigned*)(WSP + WS_CTL) + CW_BAR, MISC + 8);
#define IN(k) (lo <= (k) && (k) < hi)
#define SEAM(k) do { if (IN(k) && IN((k) + 1)) xcd_barrier(bar); } while (0)

    typedef __attribute__((address_space(4))) const Args* KArgs;
    KArgs ap = (KArgs)__builtin_amdgcn_kernarg_segment_ptr();
#define FRESH() asm volatile("" : "+s"(ap), "+s"(wsg)); Frame Fp = F; asm volatile("" : "+v"(Fp.tid)); Fp.lane = Fp.tid & 63; asm volatile("" : "+s"(Fp.wave), "+s"(Fp.bid), "+s"(Fp.G)); Fp.ws = WSP; LAS unsigned char* ring = Fp.lds; asm volatile("" : "+s"(ring)); Fp.lds = ring
#define INP(i) ((const float*)(GAS const float*)ap->in[i])
#define WIN_ ((bf16*)(WSP + WS_WIN))
#define WOUT_ ((bf16*)(WSP + WS_WOUT))
#define WOT_ ((bf16*)(WSP + WS_WO))
#define WQT_ ((bf16*)(WSP + WS_WQ))
#define W1T_ ((bf16*)(WSP + WS_W1T))
#define SUBK_ ((bf16*)(WSP + WS_SUBK))
#define W2T_ ((bf16*)(WSP + WS_SMALL + SM_W2T))
#define MOD_ ((float*)(WSP + WS_MOD))
#define COS_ ((const float*)(WSP + WS_COS))
#define SIN_ ((const float*)(WSP + WS_SIN))
#define KMEAN_ ((float*)(WSP + WS_SMALL + SM_KMEAN))
#define KCMP_ ((bf16*)(WSP + WS_SMALL + SM_KCMP))
#define VCMP_ ((bf16*)(WSP + WS_SMALL + SM_VCMP))
#define PBP_ ((float*)(WSP + WS_SMALL + SM_PBP))
#define EIDX_ ((int*)(WSP + WS_EIDX))
#define EW_ ((float*)(WSP + WS_EW))
#define HN_ ((bf16*)(WSP + WS_HN))
#define MIX_ ((bf16*)(WSP + WS_MIX))
#define PROJ_ ((bf16*)(WSP + WS_BIG))
#define GATES_ ((unsigned char*)(WSP + WS_GATES))
#define UT_ ((unsigned char*)(WSP + WS_BIG))
#define VT_ ((unsigned char*)(WSP + WS_BIG + 16 * MiB))
#define SU_ ((float*)(WSP + WS_BIG + 32 * MiB))
#define SV_ ((float*)(WSP + WS_BIG + 32 * MiB + 65536))
#define COEF_ ((v2u*)(WSP + WS_BIG + 33 * MiB))
#define H8_ ((unsigned char*)(WSP + WS_BIG + 128 * MiB))
#define HS_ ((float*)(WSP + WS_BIG + 144 * MiB))
#define Q2_ ((bf16*)(WSP + WS_BIG + 64 * MiB))
#define PART_ ((float*)(WSP + WS_BIG + 64 * MiB))
#define XB_ ((float*)(GAS float*)ap->out)
#define MODL_ (MOD_ + (size_t)l * 8 * 6144)
#define XIN_ ((l == 0) ? INP(I_X) : (const float*)XB_)

    if (IN(0)) { FRESH(); phase_prologue(Fp, ap); }
    SEAM(0);
#pragma unroll 1
    for (int l = 0; l < DEPTH; ++l) {
        const int p0 = 1 + l * NPL;
        if (IN(p0 + 0)) { FRESH(); phase_norm_mod(Fp, XIN_, INP(I_NMG) + l * DM, MODL_ + 0, MODL_ + 1024, HN_); }
        SEAM(p0 + 0);
        if (IN(p0 + 1)) { FRESH(); pg8::Gemm g{HN_, WIN_ + (size_t)l * NWIN * DM, TOK, NWIN, DM}; pg8::StaticOrder S; S.init(TOK, NWIN, Fp.G, Fp.bid);
            epi::EpiProjAll E{{PROJ_, COS_, SIN_}, {GATES_}}; pg8::gemm_phase<epi::EpiProjAll, pg8::StaticOrder, true, true>(ring, g, S, E, Fp.tid); }
        SEAM(p0 + 1);
        if (IN(p0 + 2)) {
            { FRESH(); phase_compress(Fp, PROJ_, W1T_ + (size_t)l * 2 * 128 * 2048, W2T_ + (size_t)l * 2 * 64 * 128, PBP_ + (size_t)l * 2 * 16 * 128, KCMP_, VCMP_); }
            { FRESH(); phase_kmean(Fp, PROJ_, KMEAN_); }
            { FRESH(); phase_mixer_a(Fp, PROJ_, INP(I_ACW) + (size_t)l * 3 * 512, MIX_); }
            __syncthreads();
            { FRESH(); phase_mixer_b(Fp, PROJ_, INP(I_BCW) + (size_t)l * 31 * 512, INP(I_BCB) + l * 512, INP(I_BLNG) + l * 512, INP(I_BLNB) + l * 512, MIX_ + (size_t)TOK * 512); }
            __syncthreads();
        }
        SEAM(p0 + 2);
        if (IN(p0 + 3)) { { FRESH(); phase_nsa(Fp, PROJ_, KCMP_, VCMP_, MIX_ + (size_t)2 * TOK * 512); __syncthreads(); }
                                   { FRESH(); phase_moba(Fp, PROJ_, KMEAN_, MIX_ + (size_t)3 * TOK * 512); __syncthreads(); } }
        SEAM(p0 + 3);
        if (IN(p0 + 4)) { FRESH(); pg8::Gemm g{MIX_, WOUT_ + (size_t)(l * 4) * DM * 512, 4 * TOK, 4 * DM, 512}; epi::MergeOrder S; S.init(Fp.G, Fp.bid);
            epi::EpiMergeAll E{HN_, GATES_}; pg8::gemm_phase<epi::EpiMergeAll, epi::MergeOrder, true, true>(ring, g, S, E, Fp.tid); }
        SEAM(p0 + 4);
        if (IN(p0 + 5)) { FRESH(); pg8::Gemm g{HN_, WOT_ + (size_t)l * DM * DM, TOK, DM, DM}; pg8::StaticOrder S; S.init(TOK, DM, Fp.G, Fp.bid);
            epi::EpiResid E{XIN_, XB_, MODL_ + 2048}; pg8::gemm_phase<epi::EpiResid, pg8::StaticOrder, true, true>(ring, g, S, E, Fp.tid); }
        SEAM(p0 + 5);
        if (IN(p0 + 6)) {
            { FRESH(); phase_norm_mod(Fp, XB_, INP(I_NFG) + l * DM, MODL_ + 3072, MODL_ + 4096, HN_, H8_, HS_); }
            { FRESH(); phase_peer_tables(Fp, INP(I_PU) + (size_t)l * 16384 * DM, INP(I_PV) + (size_t)l * 16384 * DM, UT_, VT_, SU_, SV_); }
        }
        SEAM(p0 + 6);
        if (IN(p0 + 7)) { FRESH(); pg8::Gemm g{HN_, WQT_ + (size_t)l * 2048 * DM, TOK, 2048, DM}; pg8::StaticOrder S; S.init(TOK, 2048, Fp.G, Fp.bid);
            epi::EpiStoreBf E{Q2_, 2048}; pg8::gemm_phase<epi::EpiStoreBf, pg8::StaticOrder, true, true>(ring, g, S, E, Fp.tid); }
        SEAM(p0 + 7);
        if (IN(p0 + 8)) { FRESH(); phase_peer_route(Fp, Q2_, SUBK_ + (size_t)l * 8 * 2 * 128 * 128, EIDX_, EW_); __syncthreads(); }
        SEAM(p0 + 8);
        if (IN(p0 + 9)) { FRESH(); phase_peer_u(Fp, H8_, HS_, UT_, SU_, EIDX_, PART_); }
        SEAM(p0 + 9);
        if (IN(p0 + 10)) { FRESH(); phase_peer_w(Fp, SV_, EIDX_, EW_, PART_, COEF_); }
        SEAM(p0 + 10);
        if (IN(p0 + 11)) { FRESH(); phase_peer_v(Fp, VT_, COEF_, XB_, MODL_ + 5120); }
        SEAM(p0 + 11);
    }
    if (IN(NPHASE - 1)) { FRESH(); phase_final_norm(Fp, XB_, INP(I_FNG), XB_); }
#undef IN
#undef SEAM
#undef WSP
}

extern "C" void kernel_launch(void* const* d_in, const int* in_sizes, int n_in, void* d_out, int out_size, void* d_ws, size_t ws_size, hipStream_t stream) {
    static int grid = 0;
    if (grid == 0) {
        if (n_in != 26 || in_sizes[0] != TOK * DM || out_size != TOK * DM || ws_size < WS_END) {
            fprintf(stderr, "kernel_launch: unexpected problem (n_in %d, in0 %d, out %d, WSP %zu); nothing launched\n", n_in, n_in > 0 ? in_sizes[0] : -1, out_size, ws_size); grid = -1; return; }
        int dev = 0, cus = 0, per_cu = 0;
        if (hipGetDevice(&dev) != hipSuccess || hipDeviceGetAttribute(&cus, hipDeviceAttributeMultiprocessorCount, dev) != hipSuccess) { grid = -1; return; }
        if (hipFuncSetAttribute((const void*)hybrid_fwd, hipFuncAttributeMaxDynamicSharedMemorySize, LDS_BYTES) != hipSuccess) { fprintf(stderr, "kernel_launch: hipFuncSetAttribute failed\n"); grid = -1; return; }
        if (hipOccupancyMaxActiveBlocksPerMultiprocessor(&per_cu, (const void*)hybrid_fwd, NTHR, LDS_BYTES) != hipSuccess || per_cu < 1)
            fprintf(stderr, "kernel_launch: note: occupancy query reports %d workgroups per CU\n", per_cu);
        (void)hipGetLastError();
        grid = cus;
    }
    if (grid < 0) return;
    if (hipMemsetAsync((char*)d_ws + WS_CTL, 0, CTL_ZERO_BYTES, stream) != hipSuccess) return;
    Args a{};
    for (int i = 0; i < 26; ++i) a.in[i] = d_in[i];
    a.out = (float*)d_out; a.ws = (unsigned char*)d_ws;
#if MK_PER_PHASE
    for (int p = 0; p < NPHASE; ++p) { a.ph_lo = p; a.ph_hi = p + 1; hipLaunchKernelGGL(hybrid_fwd, dim3(grid), dim3(NTHR), LDS_BYTES, stream, a); }
#else
    a.ph_lo = 0; a.ph_hi = NPHASE; hipLaunchKernelGGL(hybrid_fwd, dim3(grid), dim3(NTHR), LDS_BYTES, stream, a);
#endif
    const hipError_t le = hipPeekAtLastError();
    if (le != hipSuccess) fprintf(stderr, "kernel_launch: launch failed: %s\n", hipGetErrorName(le));
}
```

```cpp
#include <hip/hip_runtime.h>
#include <hip/hip_bf16.h>
#include <cstdio>
#include <cstdint>
#include <cmath>

#ifndef MK_PER_PHASE
#define MK_PER_PHASE 0
#endif

#define GAS __attribute__((address_space(1)))
#define LAS __attribute__((address_space(3)))
typedef unsigned short bf16;
typedef unsigned v4u __attribute__((ext_vector_type(4)));
typedef unsigned v2u __attribute__((ext_vector_type(2)));
typedef float f32x4 __attribute__((ext_vector_type(4)));
typedef float f32x2 __attribute__((ext_vector_type(2)));
typedef float f32x16 __attribute__((ext_vector_type(16)));
typedef short bf16x8 __attribute__((ext_vector_type(8)));
typedef short s16x4 __attribute__((ext_vector_type(4)));
typedef __bf16 bf16x2_t __attribute__((ext_vector_type(2)));

constexpr int BATCH = 8, SEQ = 2048, DM = 1024, DEPTH = 2, TOK = BATCH * SEQ;
constexpr int NP1 = 5632;
constexpr int NGT = 4096;
constexpr int NWIN = NP1 + NGT;
constexpr int C_AB = 0, C_AC = 512, C_AX = 1024, C_BA = 1536, C_BG = 2048, C_CQ = 2560, C_KC = 3072, C_VC = 3200, C_KS = 3328, C_VS = 3456, C_KW = 3584, C_VW = 3712,
              C_DQ = 3840, C_DK = 4352, C_DV = 4864, C_CG = 5376;
constexpr float NORM_EPS = 1e-6f;
constexpr float QSCALE = 0.125f * 1.4426950408889634f;

constexpr size_t MiB = 1u << 20;
constexpr size_t WS_CTL = 0, CTL_ZERO_BYTES = 64 * 1024;
constexpr size_t WS_MOD = 1 * MiB;
constexpr size_t WS_COS = 2 * MiB, WS_SIN = 4 * MiB;
constexpr size_t WS_SMALL = 6 * MiB;
constexpr size_t SM_KMEAN = 704 * 1024;
constexpr size_t SM_KCMP = 64 * 1024;
constexpr size_t SM_VCMP = 320 * 1024;
constexpr size_t SM_PBP = 576 * 1024;
constexpr size_t SM_W2T = 640 * 1024;
constexpr size_t WS_EIDX = 8 * MiB;
constexpr size_t WS_EW = 16 * MiB;
constexpr size_t WS_WIN = 24 * MiB;
constexpr size_t WS_WOUT = 62 * MiB;
constexpr size_t WS_WO = 70 * MiB;
constexpr size_t WS_WQ = 74 * MiB;
constexpr size_t WS_W1T = 82 * MiB;
constexpr size_t WS_SUBK = 84 * MiB;
constexpr size_t WS_HN = 86 * MiB;
constexpr size_t WS_MIX = 118 * MiB;
constexpr size_t WS_BIG = 182 * MiB;
constexpr size_t WS_GATES = 358 * MiB;
constexpr size_t WS_END = 486 * MiB;

constexpr int LDS_BYTES = 147456;
constexpr int RING_BYTES = 131072;
constexpr int MISC_OFF = LDS_BYTES - 256;

#define RLX_AGENT __ATOMIC_RELAXED, __HIP_MEMORY_SCOPE_AGENT
#define LDS_WAIT() asm volatile("s_waitcnt lgkmcnt(0)" ::: "memory")
#define VM_WAIT() asm volatile("s_waitcnt vmcnt(0)" ::: "memory")
__device__ __forceinline__ unsigned f2bf(float f) { unsigned u = __builtin_bit_cast(unsigned, f); return (u + 0x7fffu + ((u >> 16) & 1u)) >> 16; }
__device__ __forceinline__ float bf2f(unsigned h) { return __builtin_bit_cast(float, h << 16); }
__device__ __forceinline__ unsigned pk2(float lo, float hi) { f32x2 v = {lo, hi}; bf16x2_t b = __builtin_convertvector(v, bf16x2_t); return __builtin_bit_cast(unsigned, b); }
__device__ __forceinline__ float bflo(unsigned w) { return __builtin_bit_cast(float, w << 16); }
__device__ __forceinline__ float bfhi(unsigned w) { return __builtin_bit_cast(float, w & 0xffff0000u); }
__device__ __forceinline__ float sigmoidf_(float x) { return __builtin_amdgcn_rcpf(1.0f + __builtin_amdgcn_exp2f(x * -1.4426950408889634f)); }
__device__ __forceinline__ float gelu_erf(float x) { return 0.5f * x * (1.0f + erff(x * 0.70710678118654752f)); }
__device__ __forceinline__ float shx(float v, int m, int lane) { return __builtin_bit_cast(float, __builtin_amdgcn_ds_bpermute((lane ^ m) << 2, __builtin_bit_cast(int, v))); }
__device__ __forceinline__ unsigned shxu(unsigned v, int m, int lane) { return (unsigned)__builtin_amdgcn_ds_bpermute((lane ^ m) << 2, (int)v); }
__device__ __forceinline__ void swap32(unsigned v, unsigned& r0, unsigned& r1) { unsigned b = v; asm volatile("" : "+v"(b)); auto r = __builtin_amdgcn_permlane32_swap(v, b, false, false); r0 = r[0]; r1 = r[1]; }
__device__ __forceinline__ float other32(float v, int hi) { unsigned r0, r1; swap32(__builtin_bit_cast(unsigned, v), r0, r1); return __builtin_bit_cast(float, hi ? r0 : r1); }
__device__ __forceinline__ float add32(float v) { unsigned r0, r1; swap32(__builtin_bit_cast(unsigned, v), r0, r1); return __builtin_bit_cast(float, r0) + __builtin_bit_cast(float, r1); }
__device__ __forceinline__ float max32(float v) { unsigned r0, r1; swap32(__builtin_bit_cast(unsigned, v), r0, r1); return fmaxf(__builtin_bit_cast(float, r0), __builtin_bit_cast(float, r1)); }
__device__ __forceinline__ unsigned umax32(unsigned v) { unsigned r0, r1; swap32(v, r0, r1); return r0 > r1 ? r0 : r1; }
__device__ __forceinline__ float wave_sum(float v, int lane) {
#pragma unroll
    for (int o = 1; o < 32; o <<= 1) v += shx(v, o, lane);
    return add32(v);
}
namespace pg8 {
#define PG8_LAS __attribute__((address_space(3)))
typedef unsigned short bf16_t;
typedef short bf16x8 __attribute__((ext_vector_type(8)));
typedef float f32x4 __attribute__((ext_vector_type(4)));
typedef unsigned u32x4 __attribute__((ext_vector_type(4)));
constexpr int BM = 256, BK = 64, HALF = 128, HTB = HALF * BK * 2  , STAGE_BYTES = 8 * HTB, NXCD = 8, WGM = 8;

__host__ __device__ __forceinline__ int lds_byte(int r, int c) { const int st = (r >> 4) * 2 + (c >> 5), rr = r & 15, cc = c & 31, ob = rr * 64 + cc * 2; return st * 1024 + (ob ^ (((ob >> 9) & 1) << 5)); }
__host__ __device__ __forceinline__ void stage_rc(int b, int& R, int& C) { const int st = b / 1024, sb = b % 1024, swz = sb ^ (((sb >> 9) & 1) << 5); R = (st >> 1) * 16 + swz / 64; C = (st & 1) * 32 + (swz % 64) / 2; }
__host__ __device__ __forceinline__ int perm32(int rho) { const int n = rho >> 4, i = rho & 15; return 8 * (i >> 2) + 4 * n + (i & 3); }

struct Unit { int pm, pn; };
struct Gemm { const bf16_t* A; const bf16_t* Bt; int M, N, K; };

struct StaticOrder {
    int nM, nN, nwg, G, c;
    __host__ __device__ void init(int M, int N, int G_, int c_) { nM = M / BM; nN = N / BM; nwg = nM * nN; G = G_; c = c_; }
    __host__ __device__ bool next(int i, Unit& u) const {
        const long L = (long)i * G + c; if (L >= nwg) return false;
        int wgid = (int)L; { const int q = nwg / NXCD, r = nwg % NXCD, xcd = wgid % NXCD, off = wgid / NXCD; wgid = (xcd < r ? xcd * (q + 1) : r * (q + 1) + (xcd - r) * q) + off; }
        const int nig = WGM * nN, gid = wgid / nig, fm = gid * WGM, gsz = (nM - fm) < WGM ? (nM - fm) : WGM;
        u.pm = fm + ((wgid % nig) % gsz); u.pn = (wgid % nig) / gsz; return true;
    }
    __device__ __forceinline__ void a_ready(const Unit&) const {}
    __device__ __forceinline__ void done(const Unit&) const {}
};

__device__ __forceinline__ unsigned cvt_pk_bf16(float lo, float hi) { unsigned r; asm volatile("v_cvt_pk_bf16_f32 %0, %1, %2" : "=v"(r) : "v"(lo), "v"(hi)); return r; }
typedef float f32x2 __attribute__((ext_vector_type(2)));
template <class Epi, class Sched, bool ALIGN_EPI = false, bool SP2 = false>
__device__ __forceinline__ void gemm_phase(PG8_LAS unsigned char* lds, const Gemm g, const Sched& S, const Epi& E, const int tid) {
    const int wid = __builtin_amdgcn_readfirstlane(tid >> 6), lane = tid & 63, wr = wid >> 2, wc = wid & 3, fr = lane & 15, fq = lane >> 4;
    const int K = g.K, nt = K / BK;
    unsigned voffA[2], voffB[2];
#pragma unroll
    for (int i = 0; i < 2; ++i) { int R, C; stage_rc(tid * 16 + i * 8192, R, C); const int Rb = Epi::PERM ? ((R & ~31) + perm32(R & 31)) : R;
        voffA[i] = (unsigned)(R * K + C) * 2u; voffB[i] = (unsigned)(Rb * K + C) * 2u; }
    const size_t kstep = (size_t)(BK * 2);
    const size_t hstep = (size_t)HALF * K * 2;
    const size_t tstep = 2 * hstep;
    const unsigned ldsw = (unsigned)wid * 1024u;
    const int aoff = lds_byte(wr * 64 + fr, fq * 8), boff = lds_byte(wc * 32 + fr, fq * 8);
#define PG8_SA(b, h) (((b) * 2 + (h)) * HTB)
#define PG8_SB(b, h) ((4 + (b) * 2 + (h)) * HTB)
#define PG8_STAGE(bufoff, gbase, voff) do { _Pragma("unroll") for (int _i = 0; _i < 2; ++_i) \
        __builtin_amdgcn_global_load_lds((const unsigned*)((const char*)(gbase) + (voff)[_i]), (PG8_LAS unsigned*)(lds + (bufoff) + ldsw + _i * 8192), 16, 0, 0); } while (0)
#define PG8_LDA(dst, b, h) do { _Pragma("unroll") for (int m = 0; m < 4; ++m) _Pragma("unroll") for (int k = 0; k < 2; ++k) dst[m][k] = *(const PG8_LAS bf16x8*)(lds + PG8_SA(b, h) + aoff + m * 2048 + k * 1024); } while (0)
#define PG8_LDB(dst, b, h) do { _Pragma("unroll") for (int n = 0; n < 2; ++n) _Pragma("unroll") for (int k = 0; k < 2; ++k) dst[n][k] = *(const PG8_LAS bf16x8*)(lds + PG8_SB(b, h) + boff + n * 2048 + k * 1024); } while (0)
#define PG8_MMA(ai, bj, At, Bt) do { __builtin_amdgcn_s_setprio(1); _Pragma("unroll") for (int m = 0; m < 4; ++m) _Pragma("unroll") for (int n = 0; n < 2; ++n) _Pragma("unroll") for (int k = 0; k < 2; ++k) \
        acc[ai][bj][m][n] = __builtin_amdgcn_mfma_f32_16x16x32_bf16(Bt[n][k], At[m][k], acc[ai][bj][m][n], 0, 0, 0); __builtin_amdgcn_s_setprio(0); } while (0)
#define PG8_WAIT_V(n) asm volatile("s_waitcnt vmcnt(" #n ")" ::: "memory")
#define PG8_WAIT_L(n) asm volatile("s_waitcnt lgkmcnt(" #n ")" ::: "memory")
#define PG8_BAR __builtin_amdgcn_s_barrier()
#define PG8_SCHED __builtin_amdgcn_sched_barrier(0)
    Unit cur, nxt; int ui = 0;
    if (!S.next(0, cur)) return;
    f32x4 acc[2][2][4][2];
#pragma unroll
    for (int a = 0; a < 2; ++a)
#pragma unroll
        for (int b = 0; b < 2; ++b)
#pragma unroll
            for (int m = 0; m < 4; ++m)
#pragma unroll
                for (int n = 0; n < 2; ++n) acc[a][b][m][n] = (f32x4){0.f, 0.f, 0.f, 0.f};
    bf16x8 At[4][2], B0[2][2], B1[2][2];
    const char* cA = (const char*)g.A + (size_t)cur.pm * tstep; const char* cB = (const char*)g.Bt + (size_t)cur.pn * tstep;
    S.a_ready(cur);
    if constexpr (SP2) {
        PG8_STAGE(PG8_SB(0, 0), cB, voffB); PG8_STAGE(PG8_SB(0, 1), cB + hstep, voffB); PG8_STAGE(PG8_SA(0, 0), cA, voffA); PG8_STAGE(PG8_SA(0, 1), cA + hstep, voffA);
        if (wr == 1) PG8_BAR;
        PG8_WAIT_V(2); PG8_BAR;
        PG8_STAGE(PG8_SB(1, 0), cB + kstep, voffB); PG8_STAGE(PG8_SA(1, 0), cA + kstep, voffA); PG8_STAGE(PG8_SB(1, 1), cB + hstep + kstep, voffB);
        PG8_WAIT_V(6); PG8_BAR;
    } else {
        PG8_STAGE(PG8_SB(0, 0), cB, voffB); PG8_STAGE(PG8_SA(0, 0), cA, voffA); PG8_STAGE(PG8_SB(0, 1), cB + hstep, voffB); PG8_STAGE(PG8_SA(0, 1), cA + hstep, voffA);
        if (wr == 1) PG8_BAR;
        PG8_WAIT_V(4); PG8_BAR;
        PG8_STAGE(PG8_SB(1, 0), cB + kstep, voffB); PG8_STAGE(PG8_SA(1, 0), cA + kstep, voffA); PG8_STAGE(PG8_SB(1, 1), cB + hstep + kstep, voffB);
        PG8_WAIT_V(6); PG8_BAR;
    }
    for (;;) {
        const bool has_next = S.next(ui + 1, nxt);
        const char* nA = has_next ? (const char*)g.A + (size_t)nxt.pm * tstep : cA; const char* nB = has_next ? (const char*)g.Bt + (size_t)nxt.pn * tstep : cB;
        for (int t = 0; t < nt; t += 2) {
            const bool last = (t == nt - 2);
            const char* a1 = cA + (size_t)(t + 1) * kstep;
            const char* a2 = last ? nA : cA + (size_t)(t + 2) * kstep; const char* b2 = last ? nB : cB + (size_t)(t + 2) * kstep;
            const char* a3 = a2 + kstep; const char* b3 = b2 + kstep;
            if (last && has_next) S.a_ready(nxt);
            if constexpr (SP2) {
            PG8_LDB(B0, 0, 0); PG8_LDB(B1, 0, 1); PG8_SCHED; PG8_LDA(At, 0, 0); PG8_STAGE(PG8_SA(1, 1), a1 + hstep, voffA);
            PG8_WAIT_V(8); PG8_WAIT_L(0); PG8_BAR; PG8_MMA(0, 0, At, B0); PG8_MMA(0, 1, At, B1); PG8_BAR; PG8_SCHED;
            PG8_LDA(At, 0, 1); PG8_STAGE(PG8_SB(0, 0), b2, voffB); PG8_STAGE(PG8_SB(0, 1), b2 + hstep, voffB); PG8_STAGE(PG8_SA(0, 0), a2, voffA);
            PG8_WAIT_V(8); PG8_WAIT_L(0); PG8_BAR; PG8_MMA(1, 0, At, B0); PG8_MMA(1, 1, At, B1); PG8_BAR; PG8_SCHED;
            PG8_LDB(B0, 1, 0); PG8_LDB(B1, 1, 1); PG8_SCHED; PG8_LDA(At, 1, 0); PG8_STAGE(PG8_SA(0, 1), a2 + hstep, voffA);
            PG8_WAIT_V(8); PG8_WAIT_L(0); PG8_BAR; PG8_MMA(0, 0, At, B0); PG8_MMA(0, 1, At, B1); PG8_BAR; PG8_SCHED;
            PG8_LDA(At, 1, 1); PG8_STAGE(PG8_SB(1, 0), b3, voffB); PG8_STAGE(PG8_SB(1, 1), b3 + hstep, voffB); PG8_STAGE(PG8_SA(1, 0), a3, voffA);
            PG8_WAIT_V(8); PG8_WAIT_L(0); PG8_BAR; PG8_MMA(1, 0, At, B0); PG8_MMA(1, 1, At, B1); PG8_BAR; PG8_SCHED;
            } else {
            PG8_LDB(B0, 0, 0); PG8_SCHED; PG8_LDA(At, 0, 0); PG8_STAGE(PG8_SA(1, 1), a1 + hstep, voffA);
            PG8_WAIT_L(8); PG8_BAR; PG8_WAIT_L(0); PG8_MMA(0, 0, At, B0); PG8_BAR; PG8_SCHED;
            PG8_LDB(B1, 0, 1); PG8_STAGE(PG8_SB(0, 0), b2, voffB);
            PG8_BAR; PG8_WAIT_L(0); PG8_MMA(0, 1, At, B1); PG8_BAR;
            PG8_LDA(At, 0, 1); PG8_STAGE(PG8_SA(0, 0), a2, voffA);
            PG8_BAR; PG8_WAIT_L(0); PG8_MMA(1, 0, At, B0); PG8_BAR; PG8_SCHED;
            PG8_STAGE(PG8_SB(0, 1), b2 + hstep, voffB);
            PG8_WAIT_V(6); PG8_BAR; PG8_MMA(1, 1, At, B1); PG8_BAR;
            PG8_LDB(B0, 1, 0); PG8_SCHED; PG8_LDA(At, 1, 0); PG8_STAGE(PG8_SA(0, 1), a2 + hstep, voffA);
            PG8_WAIT_L(8); PG8_BAR; PG8_WAIT_L(0); PG8_MMA(0, 0, At, B0); PG8_BAR; PG8_SCHED;
            PG8_LDB(B1, 1, 1); PG8_STAGE(PG8_SB(1, 0), b3, voffB);
            PG8_BAR; PG8_WAIT_L(0); PG8_MMA(0, 1, At, B1); PG8_BAR;
            PG8_LDA(At, 1, 1); PG8_STAGE(PG8_SA(1, 0), a3, voffA);
            PG8_BAR; PG8_WAIT_L(0); PG8_MMA(1, 0, At, B0); PG8_BAR; PG8_SCHED;
            PG8_STAGE(PG8_SB(1, 1), b3 + hstep, voffB);
            PG8_WAIT_V(6); PG8_BAR; PG8_MMA(1, 1, At, B1); PG8_BAR;
            }
        }
        if constexpr (ALIGN_EPI) { if (wr == 0) PG8_BAR; }
        if constexpr (Epi::KEEP_ACC) { E.inplace(acc, cur, wr, wc, fr, fq); S.done(cur); }
        else if constexpr (!Epi::AFTER_DRAIN) { E(acc, cur, wr, wc, fr, fq); S.done(cur); }
        if (!has_next) break;
        if constexpr (!Epi::KEEP_ACC)
#pragma unroll
        for (int a = 0; a < 2; ++a)
#pragma unroll
            for (int b = 0; b < 2; ++b)
#pragma unroll
                for (int m = 0; m < 4; ++m)
#pragma unroll
                    for (int n = 0; n < 2; ++n) acc[a][b][m][n] = (f32x4){0.f, 0.f, 0.f, 0.f};
        cur = nxt; cA = nA; cB = nB; ++ui;
        if constexpr (ALIGN_EPI) { if (wr == 1) PG8_BAR; }
    }
    PG8_WAIT_V(0);
    if constexpr (!ALIGN_EPI) { if (wr == 0) PG8_BAR; }
    PG8_BAR;
    if constexpr (Epi::AFTER_DRAIN) { E.fused(acc, cur, wr, wc, fr, fq, lds, wid, lane); S.done(cur); }
#undef PG8_SA
#undef PG8_SB
#undef PG8_STAGE
#undef PG8_LDA
#undef PG8_LDB
#undef PG8_MMA
#undef PG8_WAIT_V
#undef PG8_WAIT_L
#undef PG8_BAR
#undef PG8_SCHED
}
}
#define XB_TMO      128
#define XB_XCNT(j)  (256  + 64 * (j))
#define XB_XSUB(j)  (1280 + 64 * (j))
#define XB_XGEN(j)  (2304 + 64 * (j))
#define XB_TOP      3328
#define XB_TOPGEN   3392
#define XB_FLAG     3408
#define XCD_BAR_WORDS 3456
#define XB_SPIN_CAP (1u << 25)

__device__ __forceinline__ unsigned xb_ld(unsigned* p)              { return __hip_atomic_load(p, __ATOMIC_RELAXED, __HIP_MEMORY_SCOPE_AGENT); }
__device__ __forceinline__ unsigned xb_add(unsigned* p, unsigned v) { return __hip_atomic_fetch_add(p, v, __ATOMIC_RELAXED, __HIP_MEMORY_SCOPE_AGENT); }
__device__ __forceinline__ unsigned xb_xcc_id() { return (unsigned)__builtin_amdgcn_s_getreg((3 << 11) | 20) & 0xFu; }
#define XB_SPIN(cond, bar) do { unsigned _sp = 0; while (cond) { __builtin_amdgcn_s_sleep(1); \
    if ((++_sp & 255u) == 0u) { if (xb_ld(&(bar)[XB_TMO])) break; if (_sp > XB_SPIN_CAP) { atomicAdd(&(bar)[XB_TMO], 1u); break; } } } } while (0)

struct XcdBarrier {
    unsigned* bar; unsigned x;
    volatile LAS unsigned* st;
};

__device__ __forceinline__ XcdBarrier xcd_barrier_post(unsigned* bar, volatile LAS unsigned* st) {
    XcdBarrier b; b.bar = bar; b.x = xb_xcc_id(); b.st = st;
    if (threadIdx.x == 0) (void)xb_add(&bar[XB_XCNT(b.x)], 1u);
    return b;
}
__device__ __forceinline__ void xcd_barrier_complete(unsigned* bar, unsigned x, unsigned& nloc, unsigned& nx, unsigned& xmask) {
    const unsigned G = gridDim.x * gridDim.y * gridDim.z;
    unsigned sum, cnt, mine, sp = 0u;
    for (;;) {
        sum = 0u; cnt = 0u; mine = 0u; xmask = 0u;
        unsigned cv[16];
        { unsigned* p0 = &bar[XB_XCNT(0)]; unsigned* p1 = &bar[XB_XCNT(8)];
          asm volatile("global_load_dword %0, %8, off sc1\n\tglobal_load_dword %1, %8, off offset:256 sc1\n\tglobal_load_dword %2, %8, off offset:512 sc1\n\tglobal_load_dword %3, %8, off offset:768 sc1\n\t"
                       "global_load_dword %4, %8, off offset:1024 sc1\n\tglobal_load_dword %5, %8, off offset:1280 sc1\n\tglobal_load_dword %6, %8, off offset:1536 sc1\n\tglobal_load_dword %7, %8, off offset:1792 sc1"
                       : "=&v"(cv[0]), "=&v"(cv[1]), "=&v"(cv[2]), "=&v"(cv[3]), "=&v"(cv[4]), "=&v"(cv[5]), "=&v"(cv[6]), "=&v"(cv[7]) : "v"(p0) : "memory");
          asm volatile("global_load_dword %0, %8, off sc1\n\tglobal_load_dword %1, %8, off offset:256 sc1\n\tglobal_load_dword %2, %8, off offset:512 sc1\n\tglobal_load_dword %3, %8, off offset:768 sc1\n\t"
                       "global_load_dword %4, %8, off offset:1024 sc1\n\tglobal_load_dword %5, %8, off offset:1280 sc1\n\tglobal_load_dword %6, %8, off offset:1536 sc1\n\tglobal_load_dword %7, %8, off offset:1792 sc1\n\ts_waitcnt vmcnt(0)"
                       : "=&v"(cv[8]), "=&v"(cv[9]), "=&v"(cv[10]), "=&v"(cv[11]), "=&v"(cv[12]), "=&v"(cv[13]), "=&v"(cv[14]), "=&v"(cv[15]) : "v"(p1) : "memory");
          asm volatile("" : "+v"(cv[0]), "+v"(cv[1]), "+v"(cv[2]), "+v"(cv[3]), "+v"(cv[4]), "+v"(cv[5]), "+v"(cv[6]), "+v"(cv[7])); }
#pragma unroll
        for (unsigned j = 0; j < 16; ++j) { const unsigned c = cv[j]; sum += c; cnt += (c > 0u) ? 1u : 0u; xmask |= (c > 0u) ? (1u << j) : 0u; mine = (j == x) ? c : mine; }
        if (sum == G) break;
        __builtin_amdgcn_s_sleep(1);
        if ((++sp & 255u) == 0u) { if (xb_ld(&bar[XB_TMO])) break; if (sp > XB_SPIN_CAP) { atomicAdd(&bar[XB_TMO], 1u); break; } }
    }
    nloc = mine > 0u ? mine : 1u; nx = cnt > 0u ? cnt : 1u;
}

__device__ __forceinline__ bool xb_flags_pending(unsigned* bar, unsigned xmask, unsigned target) {
    typedef unsigned xb_v4 __attribute__((ext_vector_type(4)));
    xb_v4 f0, f1, f2, f3; unsigned* p = &bar[XB_FLAG];
    asm volatile("global_load_dwordx4 %0, %4, off sc1\n\tglobal_load_dwordx4 %1, %4, off offset:16 sc1\n\tglobal_load_dwordx4 %2, %4, off offset:32 sc1\n\tglobal_load_dwordx4 %3, %4, off offset:48 sc1\n\ts_waitcnt vmcnt(0)"
                 : "=&v"(f0), "=&v"(f1), "=&v"(f2), "=&v"(f3) : "v"(p) : "memory");
    asm volatile("" : "+v"(f0), "+v"(f1), "+v"(f2), "+v"(f3));
    unsigned pend = 0u;
#pragma unroll
    for (int e = 0; e < 4; ++e) { pend |= (f0[e] < target) ? (1u << e) : 0u; pend |= (f1[e] < target) ? (16u << e) : 0u; pend |= (f2[e] < target) ? (256u << e) : 0u; pend |= (f3[e] < target) ? (4096u << e) : 0u; }
    return (pend & xmask) != 0u;
}
__device__ __forceinline__ void xcd_barrier(const XcdBarrier& b) {
    asm volatile("s_waitcnt vmcnt(0)" ::: "memory");
    __syncthreads();
    if (threadIdx.x == 0) {
        unsigned* bar = b.bar;
        __builtin_amdgcn_s_waitcnt(0);
        unsigned nloc = b.st[0], nx = b.st[1], xmask = b.st[3];
        if (nloc == 0u) { xcd_barrier_complete(bar, b.x, nloc, nx, xmask); b.st[0] = nloc; b.st[1] = nx; b.st[3] = xmask; }
        const unsigned round = b.st[2];
        const unsigned old = xb_add(&bar[XB_XSUB(b.x)], 1u);
        const unsigned gen = old / nloc;
        if (old + 1u == (gen + 1u) * nloc) {
            __builtin_amdgcn_fence(__ATOMIC_RELEASE, "agent");
            asm volatile("s_waitcnt vmcnt(0)" ::: "memory");
            __hip_atomic_store(&bar[XB_FLAG + b.x], round + 1u, __ATOMIC_RELAXED, __HIP_MEMORY_SCOPE_AGENT);
        }
        XB_SPIN(xb_flags_pending(bar, xmask, round + 1u), bar);
        __builtin_amdgcn_fence(__ATOMIC_ACQUIRE, "agent");
        asm volatile("s_waitcnt vmcnt(0)" ::: "memory");
        b.st[2] = round + 1u;
    }
    __syncthreads();
}

namespace epi {
using pg8::Unit; using pg8::BM; using pg8::HALF;
typedef const pg8::f32x4 (&AccRef)[2][2][4][2];

struct EpiProj1 {
    static constexpr bool PERM = true, AFTER_DRAIN = false, KEEP_ACC = false;
    bf16* O; const float* cosT; const float* sinT;
    __device__ __forceinline__ void operator()(AccRef acc, const Unit& u, int wr, int wc, int fr, int fq) const {
        const int row0 = u.pm * BM + wr * 64 + fr, colw = u.pn * BM + wc * 32;
#pragma unroll
        for (int bj = 0; bj < 2; ++bj) {
            const int hb = (colw + bj * HALF) >> 6;
            const bool rope = (hb >= 40 && hb < 50) || (hb >= 52 && hb < 54) || (hb >= 56 && hb < 58) || (hb >= 60 && hb < 76);
            const bool isq = (hb >= 40 && hb < 48) || (hb >= 60 && hb < 68);
            const float qs = isq ? QSCALE : 1.0f;
            const int jw = (wc & 1) * 16 + fq * 4;
#pragma unroll
            for (int ai = 0; ai < 2; ++ai)
#pragma unroll
                for (int m = 0; m < 4; ++m) {
                    const int row = row0 + ai * HALF + m * 16;
                    pg8::f32x4 v0 = acc[ai][bj][m][0], v1 = acc[ai][bj][m][1];
                    if (rope) {
                        const pg8::f32x4 c = *(const pg8::f32x4*)(cosT + (size_t)row * 32 + jw), s = *(const pg8::f32x4*)(sinT + (size_t)row * 32 + jw);
                        const float a0 = v0[0] * c[0] - v0[1] * s[0], a1 = v0[1] * c[0] + v0[0] * s[0], a2 = v0[2] * c[1] - v0[3] * s[1], a3 = v0[3] * c[1] + v0[2] * s[1];
                        const float b0 = v1[0] * c[2] - v1[1] * s[2], b1 = v1[1] * c[2] + v1[0] * s[2], b2 = v1[2] * c[3] - v1[3] * s[3], b3 = v1[3] * c[3] + v1[2] * s[3];
                        v0 = (pg8::f32x4){a0, a1, a2, a3} * qs; v1 = (pg8::f32x4){b0, b1, b2, b3} * qs;
                    }
                    v4u w; w.x = pk2(v0[0], v0[1]); w.y = pk2(v0[2], v0[3]); w.z = pk2(v1[0], v1[1]); w.w = pk2(v1[2], v1[3]);
                    *(v4u*)(O + (size_t)row * NP1 + colw + bj * HALF + 8 * fq) = w;
                }
        }
    }
};
struct EpiStoreBf {
    static constexpr bool PERM = true, AFTER_DRAIN = false, KEEP_ACC = false;
    bf16* O; int ldc;
    __device__ __forceinline__ void operator()(AccRef acc, const Unit& u, int wr, int wc, int fr, int fq) const {
        const int row0 = u.pm * BM + wr * 64 + fr, col0 = u.pn * BM + wc * 32 + 8 * fq;
#pragma unroll
        for (int ai = 0; ai < 2; ++ai)
#pragma unroll
            for (int m = 0; m < 4; ++m) { bf16* rowp = O + (size_t)(row0 + ai * HALF + m * 16) * ldc + col0;
#pragma unroll
                for (int bj = 0; bj < 2; ++bj) { const pg8::f32x4 v0 = acc[ai][bj][m][0], v1 = acc[ai][bj][m][1];
                    v4u w; w.x = pk2(v0[0], v0[1]); w.y = pk2(v0[2], v0[3]); w.z = pk2(v1[0], v1[1]); w.w = pk2(v1[2], v1[3]); *(v4u*)(rowp + bj * HALF) = w; } }
    }
};
__device__ __forceinline__ float gate_enc(float a) { return __builtin_fmaf(-2.0f, __builtin_amdgcn_rcpf(1.0f + __builtin_amdgcn_exp2f(a)), 1.0f); }

struct EpiGates {
    static constexpr bool PERM = true, AFTER_DRAIN = false, KEEP_ACC = false;
    unsigned char* O;
    __device__ __forceinline__ void operator()(AccRef acc, const Unit& u, int wr, int wc, int fr, int fq) const {
        const int row0 = u.pm * BM + wr * 64 + fr, col0 = u.pn * BM + wc * 32 + 8 * fq;
#pragma unroll
        for (int ai = 0; ai < 2; ++ai)
#pragma unroll
            for (int m = 0; m < 4; ++m) { unsigned char* rowp = O + (size_t)(row0 + ai * HALF + m * 16) * NGT + col0;
#pragma unroll
                for (int bj = 0; bj < 2; ++bj) { const pg8::f32x4 v0 = acc[ai][bj][m][0], v1 = acc[ai][bj][m][1];
                    v2u w; unsigned p = 0u; p = __builtin_amdgcn_cvt_pk_fp8_f32(gate_enc(v0[0]), gate_enc(v0[1]), p, false); p = __builtin_amdgcn_cvt_pk_fp8_f32(gate_enc(v0[2]), gate_enc(v0[3]), p, true); w.x = p;
                    p = 0u; p = __builtin_amdgcn_cvt_pk_fp8_f32(gate_enc(v1[0]), gate_enc(v1[1]), p, false); p = __builtin_amdgcn_cvt_pk_fp8_f32(gate_enc(v1[2]), gate_enc(v1[3]), p, true); w.y = p;
                    *(v2u*)(rowp + bj * HALF) = w; } }
    }
};
struct EpiMerge {
    static constexpr bool PERM = true, AFTER_DRAIN = false, KEEP_ACC = false;
    bf16* O; const unsigned char* G; int seg;
    __device__ __forceinline__ void operator()(AccRef acc, const Unit& u, int wr, int wc, int fr, int fq) const {
        const int row0 = u.pm * BM + wr * 64 + fr, col0 = u.pn * BM + wc * 32 + 8 * fq;
#pragma unroll
        for (int ai = 0; ai < 2; ++ai)
#pragma unroll
            for (int m = 0; m < 4; ++m) { const size_t row = (size_t)(row0 + ai * HALF + m * 16); bf16* rowp = O + row * DM + col0; const unsigned char* gp = G + row * NGT + seg * DM + col0;
#pragma unroll
                for (int bj = 0; bj < 2; ++bj) { pg8::f32x4 v0 = acc[ai][bj][m][0], v1 = acc[ai][bj][m][1];
                    const v2u g = *(const v2u*)(gp + bj * HALF);
                    const f32x2 g0 = __builtin_amdgcn_cvt_pk_f32_fp8(g.x, false), g1 = __builtin_amdgcn_cvt_pk_f32_fp8(g.x, true), g2 = __builtin_amdgcn_cvt_pk_f32_fp8(g.y, false), g3 = __builtin_amdgcn_cvt_pk_f32_fp8(g.y, true);
                    v0[0] *= 0.5f * g0.x + 0.5f; v0[1] *= 0.5f * g0.y + 0.5f; v0[2] *= 0.5f * g1.x + 0.5f; v0[3] *= 0.5f * g1.y + 0.5f;
                    v1[0] *= 0.5f * g2.x + 0.5f; v1[1] *= 0.5f * g2.y + 0.5f; v1[2] *= 0.5f * g3.x + 0.5f; v1[3] *= 0.5f * g3.y + 0.5f;
                    if (seg != 0) { const v4u o = *(const v4u*)(rowp + bj * HALF); v0[0] += bflo(o.x); v0[1] += bfhi(o.x); v0[2] += bflo(o.y); v0[3] += bfhi(o.y); v1[0] += bflo(o.z); v1[1] += bfhi(o.z); v1[2] += bflo(o.w); v1[3] += bfhi(o.w); }
                    v4u w; w.x = pk2(v0[0], v0[1]); w.y = pk2(v0[2], v0[3]); w.z = pk2(v1[0], v1[1]); w.w = pk2(v1[2], v1[3]); *(v4u*)(rowp + bj * HALF) = w; } }
    }
};
struct EpiResid {
    static constexpr bool PERM = false, AFTER_DRAIN = false, KEEP_ACC = false;
    const float* XI; float* XO; const float* gate;
    __device__ __forceinline__ void operator()(AccRef acc, const Unit& u, int wr, int wc, int fr, int fq) const {
        const int row0 = u.pm * BM + wr * 64 + fr, col0 = u.pn * BM + wc * 32 + 4 * fq;
        const float* gb = gate + (size_t)((u.pm * BM) / SEQ) * 6144 + col0;
        pg8::f32x4 gv[2][2];
#pragma unroll
        for (int bj = 0; bj < 2; ++bj)
#pragma unroll
            for (int n = 0; n < 2; ++n) gv[bj][n] = *(const pg8::f32x4*)(gb + bj * HALF + n * 16);
#pragma unroll
        for (int ai = 0; ai < 2; ++ai) { pg8::f32x4 xi[4][2][2];
#pragma unroll
            for (int m = 0; m < 4; ++m) { const size_t off = (size_t)(row0 + ai * HALF + m * 16) * DM + col0;
#pragma unroll
                for (int bj = 0; bj < 2; ++bj)
#pragma unroll
                    for (int n = 0; n < 2; ++n) xi[m][bj][n] = *(const pg8::f32x4*)(XI + off + bj * HALF + n * 16); }
            __builtin_amdgcn_sched_barrier(0);
#pragma unroll
            for (int m = 0; m < 4; ++m) { const size_t off = (size_t)(row0 + ai * HALF + m * 16) * DM + col0;
#pragma unroll
                for (int bj = 0; bj < 2; ++bj)
#pragma unroll
                    for (int n = 0; n < 2; ++n) *(pg8::f32x4*)(XO + off + bj * HALF + n * 16) = xi[m][bj][n] + gv[bj][n] * acc[ai][bj][m][n]; } }
    }
};

struct EpiProjAll {
    static constexpr bool PERM = true, AFTER_DRAIN = false, KEEP_ACC = false;
    static_assert(true, ""); EpiProj1 P; EpiGates G;
    __device__ __forceinline__ void operator()(AccRef acc, const Unit& u, int wr, int wc, int fr, int fq) const {
        if (u.pn < NP1 / BM) P(acc, u, wr, wc, fr, fq);
        else { Unit v = u; v.pn -= NP1 / BM; G(acc, v, wr, wc, fr, fq); }
    }
};
__device__ __forceinline__ void gates8w(const v2u w, float (&g)[8]) {
    const f32x2 a = __builtin_amdgcn_cvt_pk_f32_fp8(w.x, false), b = __builtin_amdgcn_cvt_pk_f32_fp8(w.x, true), c = __builtin_amdgcn_cvt_pk_f32_fp8(w.y, false), d = __builtin_amdgcn_cvt_pk_f32_fp8(w.y, true);
    g[0] = fmaxf(0.5f * a.x + 0.5f, 0x1p-10f); g[1] = fmaxf(0.5f * a.y + 0.5f, 0x1p-10f); g[2] = fmaxf(0.5f * b.x + 0.5f, 0x1p-10f); g[3] = fmaxf(0.5f * b.y + 0.5f, 0x1p-10f);
    g[4] = fmaxf(0.5f * c.x + 0.5f, 0x1p-10f); g[5] = fmaxf(0.5f * c.y + 0.5f, 0x1p-10f); g[6] = fmaxf(0.5f * d.x + 0.5f, 0x1p-10f); g[7] = fmaxf(0.5f * d.y + 0.5f, 0x1p-10f);
}
__device__ __forceinline__ void gates8(const unsigned char* p, float (&g)[8]) { gates8w(*(const v2u*)p, g); }
struct EpiMergeAll {
    static constexpr bool PERM = true, AFTER_DRAIN = false, KEEP_ACC = true;
    bf16* O; const unsigned char* G;
    __device__ __forceinline__ void operator()(AccRef, const Unit&, int, int, int, int) const {}
    __device__ __forceinline__ void inplace(pg8::f32x4 (&acc)[2][2][4][2], const Unit& u, int wr, int wc, int fr, int fq) const {
        const int seg = u.pm >> 6, pm = u.pm & 63, pn = u.pn & 3;
        const int row0 = pm * BM + wr * 64 + fr, col0 = pn * BM + wc * 32 + 8 * fq;
#pragma unroll
        for (int ai = 0; ai < 2; ++ai) {
            v2u gcw[4][2], gnw[4][2];
#pragma unroll
            for (int m = 0; m < 4; ++m) { const unsigned char* gp = G + (size_t)(row0 + ai * HALF + m * 16) * NGT + seg * DM + col0;
#pragma unroll
                for (int bj = 0; bj < 2; ++bj) { gcw[m][bj] = *(const v2u*)(gp + bj * HALF); gnw[m][bj] = seg < 3 ? *(const v2u*)(gp + DM + bj * HALF) : (v2u){0u, 0u}; } }
            __builtin_amdgcn_sched_barrier(0);
#pragma unroll
            for (int m = 0; m < 4; ++m) { const size_t row = (size_t)(row0 + ai * HALF + m * 16);
#pragma unroll
                for (int bj = 0; bj < 2; ++bj) { float gc[8]; gates8w(gcw[m][bj], gc);
                    pg8::f32x4& v0 = acc[ai][bj][m][0]; pg8::f32x4& v1 = acc[ai][bj][m][1];
                    if (seg < 3) { float gn[8]; gates8w(gnw[m][bj], gn);
#pragma unroll
                        for (int e = 0; e < 4; ++e) { v0[e] *= gc[e] * __builtin_amdgcn_rcpf(gn[e]); v1[e] *= gc[4 + e] * __builtin_amdgcn_rcpf(gn[4 + e]); } }
                    else {
#pragma unroll
                        for (int e = 0; e < 4; ++e) { v0[e] *= gc[e]; v1[e] *= gc[4 + e]; }
                        v4u w; w.x = pk2(v0[0], v0[1]); w.y = pk2(v0[2], v0[3]); w.z = pk2(v1[0], v1[1]); w.w = pk2(v1[2], v1[3]); *(v4u*)(O + row * DM + col0 + bj * HALF) = w;
                        v0 = (pg8::f32x4){0.f, 0.f, 0.f, 0.f}; v1 = (pg8::f32x4){0.f, 0.f, 0.f, 0.f}; } } } }
    }
};
struct MergeOrder {
    pg8::StaticOrder S;
    __device__ void init(int G_, int c_) { S.init(TOK, DM, G_, c_); }
    __device__ bool next(int i, Unit& u) const { Unit b; if (!S.next(i >> 2, b)) return false; const int seg = i & 3; u.pm = seg * 64 + b.pm; u.pn = seg * 4 + b.pn; return true; }
    __device__ __forceinline__ void a_ready(const Unit&) const {}
    __device__ __forceinline__ void done(const Unit&) const {}
};
}

#ifndef SBAR
#define SBAR() __builtin_amdgcn_sched_barrier(0)
#endif
constexpr int NWAVES = 8, NTHR = 512;
struct Args { const void* in[26]; float* out; unsigned char* ws; int ph_lo, ph_hi; };
enum InIdx { I_X = 0, I_C, I_POS, I_MODW, I_MODB, I_NMG, I_NFG, I_WIN, I_ACW, I_AOUT, I_BCW, I_BCB, I_BLNG, I_BLNB, I_BOUT, I_CPOS, I_CW1, I_CW2, I_COUT, I_DOUT, I_WO, I_PWQ, I_PSUB, I_PU, I_PV, I_FNG };

struct Frame {
    LAS unsigned char* lds; unsigned char* ldsg;
    int tid, lane, wave, G, bid;
    unsigned char* ws;
};
__device__ __forceinline__ int gwave(const Frame& F) { return F.bid * NWAVES + F.wave; }
__device__ __forceinline__ int ngwave(const Frame& F) { return F.G * NWAVES; }

__device__ __forceinline__ int rope_pos_of_dim(int d) { return d < 32 ? 2 * d : 2 * (d - 32) + 1; }
__device__ __forceinline__ int rope_dim_of_pos(int p) { return (p >> 1) + 32 * (p & 1); }
__device__ __forceinline__ int win_row_of_col(int n) {
    if (n < 2560) return n;
    if (n < 3072) { const int c = n - 2560; return C_CQ + (c & ~63) + rope_pos_of_dim(c & 63); }
    if (n < 3200) { const int c = n - 3072; return C_KC + (c & ~63) + rope_pos_of_dim(c & 63); }
    if (n < 3328) return C_VC + (n - 3200);
    if (n < 3456) { const int c = n - 3328; return C_KS + (c & ~63) + rope_pos_of_dim(c & 63); }
    if (n < 3584) return C_VS + (n - 3456);
    if (n < 3712) { const int c = n - 3584; return C_KW + (c & ~63) + rope_pos_of_dim(c & 63); }
    if (n < 3840) return C_VW + (n - 3712);
    if (n < 3864) return C_CG + (n - 3840);
    if (n < 4376) { const int c = n - 3864; return C_DQ + (c & ~63) + rope_pos_of_dim(c & 63); }
    if (n < 4888) { const int c = n - 4376; return C_DK + (c & ~63) + rope_pos_of_dim(c & 63); }
    if (n < 5400) return C_DV + (n - 4888);
    return NP1 + (n - 5400);
}
constexpr int TR_SCR = 17408;
template <int MODE, bool KPERM>
__device__ __forceinline__ void transpose_item(const float* W, int K, int N, bf16* WT, LAS float* scr, int item, int lane) {
    const int nblk = (N + 63) / 64, kb = item / nblk, nb = item % nblk, k0 = 64 * kb, n0 = 64 * nb;
    const int nq = (lane & 15) * 4; const bool nok = n0 + nq < N;
    f32x4 tv[16];
#pragma unroll
    for (int i = 0; i < 16; ++i) { const int kk = 4 * i + (lane >> 4); tv[i] = nok ? *(const f32x4*)(W + (size_t)(k0 + kk) * N + n0 + nq) : (f32x4){0.f, 0.f, 0.f, 0.f}; }
    SBAR();
#pragma unroll
    for (int i = 0; i < 16; ++i) { const int kk = 4 * i + (lane >> 4); const f32x4 v = tv[i];
        LAS float* d = scr + kk * 65 + nq; d[0] = v[0]; d[1] = v[1]; d[2] = v[2]; d[3] = v[3]; }
    LDS_WAIT(); asm volatile("" ::: "memory");
    const int c = lane & 7;
#pragma unroll
    for (int j = 0; j < 8; ++j) { const int n = (lane >> 3) + 8 * j;
        const int row = (MODE == 1) ? win_row_of_col(n0 + n < N ? n0 + n : 0) : (n0 + n);
        const float wsc = (MODE == 1 && row >= NP1) ? 1.4426950408889634f : 1.0f;
        float s[8];
#pragma unroll
        for (int e = 0; e < 8; ++e) { const int p = 8 * c + e; const int ks = KPERM ? rope_dim_of_pos(p) : p; s[e] = scr[ks * 65 + n] * wsc; }
        v4u o; o.x = pk2(s[0], s[1]); o.y = pk2(s[2], s[3]); o.z = pk2(s[4], s[5]); o.w = pk2(s[6], s[7]);
        if (n0 + n < N) *(v4u*)(WT + (size_t)row * K + k0 + 8 * c) = o; }
    LDS_WAIT(); asm volatile("" ::: "memory");
}
template <int MODE, bool KPERM>
__device__ __forceinline__ void transpose_matrix(const Frame& F, const float* W, int K, int N, bf16* WT, int& base) {
    LAS float* scr = (LAS float*)(F.lds + F.wave * TR_SCR);
    const int nitems = (K / 64) * ((N + 63) / 64), gw = gwave(F), NGW = ngwave(F);
    int first = (gw - base % NGW + NGW) % NGW;
    for (int it = first; it < nitems; it += NGW) transpose_item<MODE, KPERM>(W, K, N, WT, scr, it, F.lane);
    base += nitems;
}
__device__ __forceinline__ void convert_copy(const Frame& F, const float* src, bf16* dst, size_t n) {
    const size_t nth = (size_t)F.G * NTHR, t0 = (size_t)F.bid * NTHR + F.tid;
    for (size_t i = t0; i < n / 8; i += nth) { const f32x4 a = *(const f32x4*)(src + i * 8), b = *(const f32x4*)(src + i * 8 + 4);
        v4u o; o.x = pk2(a[0], a[1]); o.y = pk2(a[2], a[3]); o.z = pk2(b[0], b[1]); o.w = pk2(b[2], b[3]); *(v4u*)(dst + i * 8) = o; }
}

typedef __attribute__((address_space(4))) const Args* KArgsP;
__device__ __forceinline__ void phase_prologue(const Frame& F, KArgsP Ap) {
    unsigned char* ws = F.ws;
    int base = 0;
    for (int l = 0; l < DEPTH; ++l) {
        transpose_matrix<1, false>(F, (const float*)(GAS const void*)Ap->in[I_WIN] + (size_t)l * DM * 9496, DM, 9496, (bf16*)(ws + WS_WIN) + (size_t)l * NWIN * DM, base);
        transpose_matrix<0, false>(F, (const float*)(GAS const void*)Ap->in[I_AOUT] + (size_t)l * 512 * DM, 512, DM, (bf16*)(ws + WS_WOUT) + (size_t)(l * 4 + 0) * DM * 512, base);
        transpose_matrix<0, false>(F, (const float*)(GAS const void*)Ap->in[I_BOUT] + (size_t)l * 512 * DM, 512, DM, (bf16*)(ws + WS_WOUT) + (size_t)(l * 4 + 1) * DM * 512, base);
        transpose_matrix<0, false>(F, (const float*)(GAS const void*)Ap->in[I_COUT] + (size_t)l * 512 * DM, 512, DM, (bf16*)(ws + WS_WOUT) + (size_t)(l * 4 + 2) * DM * 512, base);
        transpose_matrix<0, false>(F, (const float*)(GAS const void*)Ap->in[I_DOUT] + (size_t)l * 512 * DM, 512, DM, (bf16*)(ws + WS_WOUT) + (size_t)(l * 4 + 3) * DM * 512, base);
        transpose_matrix<0, false>(F, (const float*)(GAS const void*)Ap->in[I_WO] + (size_t)l * DM * DM, DM, DM, (bf16*)(ws + WS_WO) + (size_t)l * DM * DM, base);
        transpose_matrix<0, false>(F, (const float*)(GAS const void*)Ap->in[I_PWQ] + (size_t)l * DM * 2048, DM, 2048, (bf16*)(ws + WS_WQ) + (size_t)l * 2048 * DM, base);
        transpose_matrix<0, true>(F, (const float*)(GAS const void*)Ap->in[I_CW1] + (size_t)(l * 2 + 0) * 2048 * 128, 2048, 128, (bf16*)(ws + WS_W1T) + (size_t)(l * 2 + 0) * 128 * 2048, base);
        transpose_matrix<0, false>(F, (const float*)(GAS const void*)Ap->in[I_CW1] + (size_t)(l * 2 + 1) * 2048 * 128, 2048, 128, (bf16*)(ws + WS_W1T) + (size_t)(l * 2 + 1) * 128 * 2048, base);
    }
    convert_copy(F, (const float*)(GAS const void*)Ap->in[I_PSUB], (bf16*)(ws + WS_SUBK), (size_t)DEPTH * 8 * 2 * 128 * 128);
    const int gt = F.bid * NTHR + F.tid, NGT_ = F.G * NTHR;
    { const float* w2 = (const float*)(GAS const void*)Ap->in[I_CW2]; bf16* w2t = (bf16*)(ws + WS_SMALL + SM_W2T);
      for (int i = gt; i < DEPTH * 2 * 64 * 128; i += NGT_) { const int k = i & 127, n = (i >> 7) & 63, lw = i >> 13; w2t[i] = (bf16)f2bf(w2[((size_t)lw * 128 + k) * 64 + n]); } }
    { const int* pos = (const int*)(GAS const void*)Ap->in[I_POS]; float* ct = (float*)(ws + WS_COS); float* st = (float*)(ws + WS_SIN);
      for (int i = gt; i < TOK * 32; i += NGT_) { const int t = i >> 5, j = i & 31;
          const float inv = 1.0f / powf(10000.0f, (float)(2 * j) / 64.0f); const float ang = (float)pos[t] * inv;
          ct[i] = (float)cos((double)ang); st[i] = (float)sin((double)ang); } }
    { const float* w1 = (const float*)(GAS const void*)Ap->in[I_CW1]; const float* cp = (const float*)(GAS const void*)Ap->in[I_CPOS]; float* pbp = (float*)(ws + WS_SMALL + SM_PBP);
      for (int i = gt; i < DEPTH * 2 * 16 * 128; i += NGT_) { const int n = i & 127, kc = (i >> 7) & 15, lw = i >> 11; float s = 0.f;
#pragma unroll 32
          for (int k = kc * 128; k < kc * 128 + 128; ++k) s += cp[(size_t)lw * 2048 + k] * w1[((size_t)lw * 2048 + k) * 128 + n];
          pbp[i] = s; } }
    __syncthreads();
    { LAS float* cond = (LAS float*)(F.lds);
      LAS float* red = (LAS float*)(F.lds + 32768);
      const float* c = (const float*)(GAS const void*)Ap->in[I_C];
      for (int i = F.tid; i < 8 * 1024; i += NTHR) { const float v = c[i]; cond[i] = v / (1.0f + __expf(-v)); }
      __syncthreads();
      for (int un = F.bid; un < DEPTH * 96; un += F.G) { const int l = un / 96, n0 = (un % 96) * 64;
          const float* mw = (const float*)(GAS const void*)Ap->in[I_MODW] + (size_t)l * DM * 6144 + n0 + F.lane;
          float acc[8];
#pragma unroll
          for (int b = 0; b < 8; ++b) acc[b] = 0.f;
#pragma unroll 32
          for (int k = F.wave * 128; k < F.wave * 128 + 128; ++k) { const float w = mw[(size_t)k * 6144];
#pragma unroll
              for (int b = 0; b < 8; ++b) acc[b] += cond[b * 1024 + k] * w; }
#pragma unroll
          for (int b = 0; b < 8; ++b) red[(F.wave * 8 + b) * 64 + F.lane] = acc[b];
          __syncthreads();
          { const int b = F.tid >> 6, n = F.tid & 63; float s = 0.f;
#pragma unroll
            for (int w = 0; w < 8; ++w) s += red[(w * 8 + b) * 64 + n];
            ((float*)(ws + WS_MOD))[((size_t)l * 8 + b) * 6144 + n0 + n] = s + ((const float*)(GAS const void*)Ap->in[I_MODB])[(size_t)l * 6144 + n0 + n]; }
          __syncthreads(); }
    }
}

__device__ __forceinline__ void phase_norm_mod(const Frame& F, const float* X, const float* g, const float* sh, const float* sc, bf16* O, unsigned char* O8 = nullptr, float* OS = nullptr) {
    const int gw = gwave(F), NGW = ngwave(F);
    f32x4 gv[4];
#pragma unroll
    for (int j = 0; j < 4; ++j) gv[j] = *(const f32x4*)(g + 4 * F.lane + 256 * j);
    for (int row0 = gw; row0 < TOK; row0 += 2 * NGW) {
        f32x4 v[2][4], scv[2][4], shv[2][4]; float s[2];
#pragma unroll
        for (int u = 0; u < 2; ++u) { const int row = row0 + u * NGW, b = row / SEQ; const float* xr = X + (size_t)row * DM + 4 * F.lane;
#pragma unroll
            for (int j = 0; j < 4; ++j) { v[u][j] = *(const f32x4*)(xr + 256 * j); scv[u][j] = *(const f32x4*)(sc + (size_t)b * 6144 + 4 * F.lane + 256 * j); shv[u][j] = *(const f32x4*)(sh + (size_t)b * 6144 + 4 * F.lane + 256 * j); } }
#pragma unroll
        for (int u = 0; u < 2; ++u) { s[u] = 0.f;
#pragma unroll
            for (int j = 0; j < 4; ++j) s[u] += (v[u][j][0] * v[u][j][0] + v[u][j][1] * v[u][j][1]) + (v[u][j][2] * v[u][j][2] + v[u][j][3] * v[u][j][3]); }
        float r[2];
#pragma unroll
        for (int u = 0; u < 2; ++u) r[u] = 1.0f / sqrtf(wave_sum(s[u], F.lane) * (1.0f / DM) + NORM_EPS);
        float mx[2] = {0.f, 0.f};
#pragma unroll
        for (int u = 0; u < 2; ++u) { const int row = row0 + u * NGW; bf16* orow = O + (size_t)row * DM + 4 * F.lane;
#pragma unroll
            for (int j = 0; j < 4; ++j) { const f32x4 y = v[u][j] * r[u] * gv[j] * (scv[u][j] + 1.0f) + shv[u][j]; v2u w; w.x = pk2(y[0], y[1]); w.y = pk2(y[2], y[3]); *(v2u*)(orow + 256 * j) = w; v[u][j] = y;
                mx[u] = fmaxf(fmaxf(mx[u], fmaxf(fabsf(y[0]), fabsf(y[1]))), fmaxf(fabsf(y[2]), fabsf(y[3]))); } }
        if (O8) {
#pragma unroll
            for (int o = 1; o < 32; o <<= 1) { mx[0] = fmaxf(mx[0], shx(mx[0], o, F.lane)); mx[1] = fmaxf(mx[1], shx(mx[1], o, F.lane)); }
#pragma unroll
            for (int u = 0; u < 2; ++u) { const int row = row0 + u * NGW; const float m = max32(mx[u]);
                const float qs = m > 0.f ? 127.0f / m : 0.f;
#pragma unroll
                for (int j = 0; j < 4; ++j) *(unsigned*)(O8 + (size_t)row * DM + 4 * F.lane + 256 * j) =
                    ((unsigned)(int)rintf(v[u][j][0] * qs) & 0xffu) | (((unsigned)(int)rintf(v[u][j][1] * qs) & 0xffu) << 8) | (((unsigned)(int)rintf(v[u][j][2] * qs) & 0xffu) << 16) | (((unsigned)(int)rintf(v[u][j][3] * qs) & 0xffu) << 24);
                if (F.lane == 0) OS[row] = m * (1.0f / 127.0f); }
        }
    }
}
__device__ __forceinline__ void phase_final_norm(const Frame& F, const float* X, const float* g, float* O) {
    const int gw = gwave(F), NGW = ngwave(F);
    f32x4 gv[4];
#pragma unroll
    for (int j = 0; j < 4; ++j) gv[j] = *(const f32x4*)(g + 4 * F.lane + 256 * j);
    for (int row0 = gw; row0 < TOK; row0 += 2 * NGW) {
        f32x4 v[2][4]; float s[2];
#pragma unroll
        for (int u = 0; u < 2; ++u) { const float* xr = X + (size_t)(row0 + u * NGW) * DM + 4 * F.lane;
#pragma unroll
            for (int j = 0; j < 4; ++j) v[u][j] = *(const f32x4*)(xr + 256 * j); }
#pragma unroll
        for (int u = 0; u < 2; ++u) { s[u] = 0.f;
#pragma unroll
            for (int j = 0; j < 4; ++j) s[u] += (v[u][j][0] * v[u][j][0] + v[u][j][1] * v[u][j][1]) + (v[u][j][2] * v[u][j][2] + v[u][j][3] * v[u][j][3]); }
#pragma unroll
        for (int u = 0; u < 2; ++u) { const float r = 1.0f / sqrtf(wave_sum(s[u], F.lane) * (1.0f / DM) + NORM_EPS);
            float* orow = O + (size_t)(row0 + u * NGW) * DM + 4 * F.lane;
#pragma unroll
            for (int j = 0; j < 4; ++j) *(f32x4*)(orow + 256 * j) = v[u][j] * r * gv[j]; }
    }
}

__device__ __forceinline__ void phase_mixer_a(const Frame& F, const bf16* P, const float* cw  , bf16* O  ) {
    const int nth = F.G * NTHR, gt = F.bid * NTHR + F.tid;
    for (int it = gt; it < (TOK / 8) * 64; it += nth) {
        const int cg = it & 63, tb = it >> 6, c0 = cg * 8, t0 = tb * 8, s0 = t0 % SEQ;
        v4u acv[10], axv[10], abv[8];
#pragma unroll
        for (int j = 0; j < 10; ++j) { const int tr = t0 - 2 + j; const bf16* r = P + (size_t)(tr > 0 ? tr : 0) * NP1; acv[j] = *(const v4u*)(r + C_AC + c0); axv[j] = *(const v4u*)(r + C_AX + c0); }
#pragma unroll
        for (int j = 0; j < 8; ++j) abv[j] = *(const v4u*)(P + (size_t)(t0 + j) * NP1 + C_AB + c0);
        float w0[8], w1[8], w2[8];
#pragma unroll
        for (int e = 0; e < 8; ++e) { w0[e] = cw[c0 + e]; w1[e] = cw[512 + c0 + e]; w2[e] = cw[1024 + c0 + e]; }
        float pm2[8], pm1[8];
#pragma unroll
        for (int j = 0; j < 2; ++j) { const v4u ac = acv[j], ax = axv[j]; const float z = (s0 - 2 + j >= 0) ? 1.0f : 0.0f;
            float pr[8]; pr[0] = bflo(ac.x) * bflo(ax.x); pr[1] = bfhi(ac.x) * bfhi(ax.x); pr[2] = bflo(ac.y) * bflo(ax.y); pr[3] = bfhi(ac.y) * bfhi(ax.y);
            pr[4] = bflo(ac.z) * bflo(ax.z); pr[5] = bfhi(ac.z) * bfhi(ax.z); pr[6] = bflo(ac.w) * bflo(ax.w); pr[7] = bfhi(ac.w) * bfhi(ax.w);
#pragma unroll
            for (int e = 0; e < 8; ++e) { if (j == 0) pm2[e] = pr[e] * z; else pm1[e] = pr[e] * z; } }
#pragma unroll
        for (int tt = 0; tt < 8; ++tt) {
            const v4u ac = acv[tt + 2], ax = axv[tt + 2], ab = abv[tt];
            float pr[8], bb[8], y[8];
            pr[0] = bflo(ac.x) * bflo(ax.x); pr[1] = bfhi(ac.x) * bfhi(ax.x); pr[2] = bflo(ac.y) * bflo(ax.y); pr[3] = bfhi(ac.y) * bfhi(ax.y);
            pr[4] = bflo(ac.z) * bflo(ax.z); pr[5] = bfhi(ac.z) * bfhi(ax.z); pr[6] = bflo(ac.w) * bflo(ax.w); pr[7] = bfhi(ac.w) * bfhi(ax.w);
            bb[0] = bflo(ab.x); bb[1] = bfhi(ab.x); bb[2] = bflo(ab.y); bb[3] = bfhi(ab.y); bb[4] = bflo(ab.z); bb[5] = bfhi(ab.z); bb[6] = bflo(ab.w); bb[7] = bfhi(ab.w);
#pragma unroll
            for (int e = 0; e < 8; ++e) { y[e] = bb[e] * (w0[e] * pm2[e] + w1[e] * pm1[e] + w2[e] * pr[e]); pm2[e] = pm1[e]; pm1[e] = pr[e]; }
            v4u o; o.x = pk2(y[0], y[1]); o.y = pk2(y[2], y[3]); o.z = pk2(y[4], y[5]); o.w = pk2(y[6], y[7]);
            *(v4u*)(O + (size_t)(t0 + tt) * 512 + c0) = o; }
    }
}

__device__ __forceinline__ void phase_mixer_b(const Frame& F, const bf16* P, const float* cw  , const float* cb, const float* lg, const float* lb, bf16* O) {
    LAS float* U = (LAS float*)F.lds;
    for (int un = F.bid; un < TOK / 32; un += F.G) {
        const int t0 = un * 32, s0 = t0 % SEQ;
        __syncthreads();
        { v4u av[8], gv[8];
#pragma unroll
          for (int j = 0; j < 8; ++j) { const int i = F.tid + j * NTHR, r = (i >> 6) < 61 ? (i >> 6) : 61, c0 = (i & 63) * 8; const int tr = t0 - 30 + r;
              const bf16* row = P + (size_t)(tr > 0 ? tr : 0) * NP1; av[j] = *(const v4u*)(row + C_BA + c0); gv[j] = *(const v4u*)(row + C_BG + c0); }
#pragma unroll
          for (int j = 0; j < 8; ++j) { const int i = F.tid + j * NTHR, r = i >> 6, c0 = (i & 63) * 8;
              if (i < 62 * 64) { const v4u a = av[j], g = gv[j]; const float z = (s0 - 30 + r >= 0) ? 1.0f : 0.0f; float u[8];
                  u[0] = bflo(a.x) * sigmoidf_(bflo(g.x)); u[1] = bfhi(a.x) * sigmoidf_(bfhi(g.x)); u[2] = bflo(a.y) * sigmoidf_(bflo(g.y)); u[3] = bfhi(a.y) * sigmoidf_(bfhi(g.y));
                  u[4] = bflo(a.z) * sigmoidf_(bflo(g.z)); u[5] = bfhi(a.z) * sigmoidf_(bfhi(g.z)); u[6] = bflo(a.w) * sigmoidf_(bflo(g.w)); u[7] = bfhi(a.w) * sigmoidf_(bfhi(g.w));
                  *(LAS f32x4*)(U + r * 512 + c0) = (f32x4){u[0], u[1], u[2], u[3]} * z; *(LAS f32x4*)(U + r * 512 + c0 + 4) = (f32x4){u[4], u[5], u[6], u[7]} * z; } } }
        __syncthreads();
        const int c0 = F.lane * 8;
        float acc[4][8];
#pragma unroll
        for (int q = 0; q < 4; ++q)
#pragma unroll
            for (int e = 0; e < 8; ++e) acc[q][e] = cb[c0 + e];
        LAS const float* Uw = U + (4 * F.wave) * 512 + c0;
        f32x4 wina[4], winb[4];
#pragma unroll
        for (int j = 0; j < 3; ++j) { wina[j] = *(LAS const f32x4*)(Uw + j * 512); winb[j] = *(LAS const f32x4*)(Uw + j * 512 + 4); }
        struct WG4 { f32x4 a[4], b[4]; };
#define MIXB_LOADW(W, kg) do { _Pragma("unroll") for (int j = 0; j < 4; ++j) { const int k_ = 4 * (kg) + j, kc_ = k_ < 31 ? k_ : 30; const float zz_ = k_ < 31 ? 1.0f : 0.0f; \
            W.a[j] = *(const f32x4*)(cw + kc_ * 512 + c0) * zz_; W.b[j] = *(const f32x4*)(cw + kc_ * 512 + c0 + 4) * zz_; } } while (0)
#define MIXB_GROUP(W, kg) do { _Pragma("unroll") for (int j = 0; j < 4; ++j) { const int k_ = 4 * (kg) + j; const int rn_ = (4 * F.wave + k_ + 3) < 62 ? (k_ + 3) : (61 - 4 * F.wave); \
            wina[(j + 3) & 3] = *(LAS const f32x4*)(Uw + rn_ * 512); winb[(j + 3) & 3] = *(LAS const f32x4*)(Uw + rn_ * 512 + 4); \
            _Pragma("unroll") for (int q = 0; q < 4; ++q) { const f32x4 ua = wina[(j + q) & 3], ub = winb[(j + q) & 3]; \
                acc[q][0] += W.a[j][0] * ua[0]; acc[q][1] += W.a[j][1] * ua[1]; acc[q][2] += W.a[j][2] * ua[2]; acc[q][3] += W.a[j][3] * ua[3]; \
                acc[q][4] += W.b[j][0] * ub[0]; acc[q][5] += W.b[j][1] * ub[1]; acc[q][6] += W.b[j][2] * ub[2]; acc[q][7] += W.b[j][3] * ub[3]; } } } while (0)
        { WG4 wA, wB; MIXB_LOADW(wA, 0);
#pragma unroll 1
          for (int kg = 0; kg < 8; kg += 2) {
              MIXB_LOADW(wB, kg + 1);
              MIXB_GROUP(wA, kg);
              if (kg + 2 < 8) MIXB_LOADW(wA, kg + 2);
              MIXB_GROUP(wB, kg + 1);
          } }
#undef MIXB_LOADW
#undef MIXB_GROUP
        const f32x4 ga = *(const f32x4*)(lg + c0), gb = *(const f32x4*)(lg + c0 + 4), ba = *(const f32x4*)(lb + c0), bb = *(const f32x4*)(lb + c0 + 4);
        float s4[4], v4[4];
#pragma unroll
        for (int q = 0; q < 4; ++q) { float s = 0.f;
#pragma unroll
            for (int e = 0; e < 8; ++e) s += acc[q][e];
            s4[q] = s; }
#pragma unroll
        for (int o = 1; o < 32; o <<= 1) { float t[4];
#pragma unroll
            for (int q = 0; q < 4; ++q) t[q] = shx(s4[q], o, F.lane);
#pragma unroll
            for (int q = 0; q < 4; ++q) s4[q] += t[q]; }
#pragma unroll
        for (int q = 0; q < 4; ++q) { const float mu = add32(s4[q]) * (1.0f / 512.0f); float v = 0.f;
#pragma unroll
            for (int e = 0; e < 8; ++e) { acc[q][e] -= mu; v += acc[q][e] * acc[q][e]; }
            v4[q] = v; }
#pragma unroll
        for (int o = 1; o < 32; o <<= 1) { float t[4];
#pragma unroll
            for (int q = 0; q < 4; ++q) t[q] = shx(v4[q], o, F.lane);
#pragma unroll
            for (int q = 0; q < 4; ++q) v4[q] += t[q]; }
#pragma unroll
        for (int q = 0; q < 4; ++q) {
            const float rs = 1.0f / sqrtf(add32(v4[q]) * (1.0f / 512.0f) + NORM_EPS);
            float y[8];
#pragma unroll
            for (int e = 0; e < 8; ++e) { const float gg = e < 4 ? ga[e] : gb[e - 4], bv = e < 4 ? ba[e] : bb[e - 4]; const float z = acc[q][e] * rs * gg + bv; y[e] = z * sigmoidf_(z); }
            v4u o; o.x = pk2(y[0], y[1]); o.y = pk2(y[2], y[3]); o.z = pk2(y[4], y[5]); o.w = pk2(y[6], y[7]);
            *(v4u*)(O + (size_t)(t0 + 4 * F.wave + q) * 512 + c0) = o; }
    }
}

__device__ __forceinline__ void phase_compress(const Frame& F, const bf16* P, const bf16* W1T  , const bf16* W2T  , const float* PBP  ,
                                               bf16* KC, bf16* VC  ) {
    LAS float* PART = (LAS float*)F.lds;
    LAS bf16* H1 = (LAS bf16*)(F.lds + 69632);
    const int lane = F.lane, r16 = lane & 15, q4 = lane >> 4, w = F.wave;
    for (int un = F.bid; un < 2 * 8 * 2 * 8; un += F.G) {
        const int nb = un & 7, g = (un >> 3) & 1, b = (un >> 4) & 7, which = un >> 7;
        const int n = nb * 16 + r16; const int nn = n < 127 ? n : 126;
        const int col0 = (which == 0 ? C_KC : C_VC) + g * 64;
        const bf16* arow = P + ((size_t)b * SEQ + nn * 16) * NP1 + col0;
        const bf16* w1 = W1T + (size_t)which * 128 * 2048;
        f32x4 acc[8];
#pragma unroll
        for (int j = 0; j < 8; ++j) acc[j] = (f32x4){0.f, 0.f, 0.f, 0.f};
#pragma unroll
        for (int half = 0; half < 2; ++half) {
            bf16x8 a[4], bb[4][8];
#pragma unroll
            for (int s4 = 0; s4 < 4; ++s4) { const int k = w * 256 + (half * 4 + s4) * 32 + q4 * 8;
                a[s4] = *(const bf16x8*)(arow + (size_t)(k >> 6) * NP1 + (k & 63));
#pragma unroll
                for (int j = 0; j < 8; ++j) bb[s4][j] = *(const bf16x8*)(w1 + (size_t)(j * 16 + r16) * 2048 + k); }
            SBAR();
#pragma unroll
            for (int s4 = 0; s4 < 4; ++s4)
#pragma unroll
                for (int j = 0; j < 8; ++j) acc[j] = __builtin_amdgcn_mfma_f32_16x16x32_bf16(a[s4], bb[s4][j], acc[j], 0, 0, 0);
        }
        __syncthreads();
#pragma unroll
        for (int j = 0; j < 8; ++j)
#pragma unroll
            for (int i = 0; i < 4; ++i) PART[(w * 16 + 4 * q4 + i) * 132 + j * 16 + r16] = acc[j][i];
        __syncthreads();
        {
            const int row = F.tid >> 5, c4 = (F.tid & 31) * 4;
            f32x4 sacc = (f32x4){0.f, 0.f, 0.f, 0.f};
#pragma unroll
            for (int ww = 0; ww < 8; ++ww) sacc += *(LAS f32x4*)(PART + (ww * 16 + row) * 132 + c4);
#pragma unroll
            for (int kc = 0; kc < 16; ++kc) sacc += *(const f32x4*)(PBP + ((size_t)which * 16 + kc) * 128 + c4);
            v2u o; o.x = pk2(gelu_erf(sacc[0]), gelu_erf(sacc[1])); o.y = pk2(gelu_erf(sacc[2]), gelu_erf(sacc[3]));
            *(LAS v2u*)(H1 + row * 136 + c4) = o;
        }
        __syncthreads();
        if (w < 4) {
            f32x4 o = (f32x4){0.f, 0.f, 0.f, 0.f};
            const bf16* w2 = W2T + (size_t)which * 64 * 128;
#pragma unroll
            for (int ks = 0; ks < 4; ++ks) { const bf16x8 a = *(LAS bf16x8*)(H1 + r16 * 136 + ks * 32 + q4 * 8);
                const bf16x8 bb = *(const bf16x8*)(w2 + (size_t)(w * 16 + r16) * 128 + ks * 32 + q4 * 8);
                o = __builtin_amdgcn_mfma_f32_16x16x32_bf16(a, bb, o, 0, 0, 0); }
            bf16* out = (which == 0 ? KC : VC) + ((size_t)(b * 2 + g) * 128) * 64;
#pragma unroll
            for (int i = 0; i < 4; ++i) { const int row = nb * 16 + 4 * q4 + i; out[(size_t)row * 64 + w * 16 + r16] = row < 127 ? (bf16)f2bf(o[i]) : (bf16)0; }
        }
    }
    __syncthreads();
}
__device__ __forceinline__ void phase_kmean(const Frame& F, const bf16* P, float* KM) {
    const int gw = gwave(F), NGW = ngwave(F), lane = F.lane, rs = lane >> 3, ch = lane & 7;
    for (int un = gw; un < 8 * 8 * 8; un += NGW) { const int h = un & 7, blk = (un >> 3) & 7, b = un >> 6;
        const bf16* base = P + ((size_t)b * SEQ + blk * 256) * NP1 + C_DK + h * 64 + ch * 8;
        float s[8];
#pragma unroll
        for (int e = 0; e < 8; ++e) s[e] = 0.f;
#pragma unroll
        for (int hb = 0; hb < 2; ++hb) { v4u vv[16];
#pragma unroll
            for (int i = 0; i < 16; ++i) vv[i] = *(const v4u*)(base + (size_t)((hb * 16 + i) * 8 + rs) * NP1);
            SBAR();
#pragma unroll
            for (int i = 0; i < 16; ++i) { const v4u v = vv[i];
                s[0] += bflo(v.x); s[1] += bfhi(v.x); s[2] += bflo(v.y); s[3] += bfhi(v.y); s[4] += bflo(v.z); s[5] += bfhi(v.z); s[6] += bflo(v.w); s[7] += bfhi(v.w); } }
#pragma unroll
        for (int e = 0; e < 8; ++e) { s[e] += shx(s[e], 8, lane); s[e] += shx(s[e], 16, lane); s[e] = add32(s[e]); }
        if (rs == 0) { float* o = KM + ((size_t)(b * 8 + blk) * 8 + h) * 64 + ch * 8;
            *(f32x4*)o = (f32x4){s[0], s[1], s[2], s[3]} * (1.0f / 256.0f); *(f32x4*)(o + 4) = (f32x4){s[4], s[5], s[6], s[7]} * (1.0f / 256.0f); }
    }
}

constexpr int KT_STRIDE = 144, VT_STRIDE = 192, KT_BYTES = 64 * KT_STRIDE, VT_BYTES = 64 * VT_STRIDE, KV_BUF = KT_BYTES + VT_BYTES;
__device__ __forceinline__ int crow(int r, int hi) { return (r & 3) + 8 * (r >> 2) + 4 * hi; }
struct AttnState { float m, l; f32x16 o0, o1; };
__device__ __forceinline__ void attn_reset(AttnState& st) { st.m = -1e30f; st.l = 0.f;
#pragma unroll
    for (int r = 0; r < 16; ++r) { st.o0[r] = 0.f; st.o1[r] = 0.f; } }
__device__ __forceinline__ s16x4 vtr(LAS const unsigned char* p) { return __builtin_bit_cast(s16x4, __builtin_amdgcn_ds_read_tr16_b64_v4i16((LAS s16x4*)p)); }

__device__ __forceinline__ void attn_scores(LAS const unsigned char* Kt, const bf16x8 (&qr)[4], f32x16& p0, f32x16& p1, int lane) {
    const int r32 = lane & 31, hi = lane >> 5;
#pragma unroll
    for (int r = 0; r < 16; ++r) { p0[r] = 0.f; p1[r] = 0.f; }
    bf16x8 ka[8];
#pragma unroll
    for (int s = 0; s < 4; ++s) { ka[2 * s] = *(LAS const bf16x8*)(Kt + r32 * KT_STRIDE + (2 * s + hi) * 16); ka[2 * s + 1] = *(LAS const bf16x8*)(Kt + (32 + r32) * KT_STRIDE + (2 * s + hi) * 16); }
    SBAR();
#pragma unroll
    for (int s = 0; s < 4; ++s) {
        p0 = __builtin_amdgcn_mfma_f32_32x32x16_bf16(ka[2 * s], qr[s], p0, 0, 0, 0);
        p1 = __builtin_amdgcn_mfma_f32_32x32x16_bf16(ka[2 * s + 1], qr[s], p1, 0, 0, 0);
    }
    SBAR();
}
struct VFrags { s16x4 lo[8], hh[8]; };
__device__ __forceinline__ void attn_vread(LAS const unsigned char* Vt, VFrags& vf, int lane) {
    const int hi = lane >> 5;
    LAS const unsigned char* vb = Vt + (4 * hi + ((lane & 15) >> 2)) * VT_STRIDE + (((lane >> 4) & 1) * 16 + 4 * (lane & 3)) * 2;
#pragma unroll
    for (int s = 0; s < 4; ++s)
#pragma unroll
        for (int db = 0; db < 2; ++db) { vf.lo[2 * s + db] = vtr(vb + (16 * s) * VT_STRIDE + db * 64); vf.hh[2 * s + db] = vtr(vb + (16 * s + 8) * VT_STRIDE + db * 64); }
    SBAR();
}
__device__ __forceinline__ void attn_pv(const VFrags& vf, const f32x16& e0, const f32x16& e1, f32x16& o0, f32x16& o1) {
    SBAR();
#pragma unroll
    for (int s = 0; s < 4; ++s) {
        v4u pw;
        if (s < 2) { pw.x = pk2(e0[8 * s + 0], e0[8 * s + 1]); pw.y = pk2(e0[8 * s + 2], e0[8 * s + 3]); pw.z = pk2(e0[8 * s + 4], e0[8 * s + 5]); pw.w = pk2(e0[8 * s + 6], e0[8 * s + 7]); }
        else { const int t = s - 2; pw.x = pk2(e1[8 * t + 0], e1[8 * t + 1]); pw.y = pk2(e1[8 * t + 2], e1[8 * t + 3]); pw.z = pk2(e1[8 * t + 4], e1[8 * t + 5]); pw.w = pk2(e1[8 * t + 6], e1[8 * t + 7]); }
        const bf16x8 pb = __builtin_bit_cast(bf16x8, pw);
#pragma unroll
        for (int db = 0; db < 2; ++db) {
            const s16x4 lo = vf.lo[2 * s + db], hh = vf.hh[2 * s + db];
            const bf16x8 a = (bf16x8){lo[0], lo[1], lo[2], lo[3], hh[0], hh[1], hh[2], hh[3]};
            if (db == 0) o0 = __builtin_amdgcn_mfma_f32_32x32x16_bf16(a, pb, o0, 0, 0, 0); else o1 = __builtin_amdgcn_mfma_f32_32x32x16_bf16(a, pb, o1, 0, 0, 0);
        }
    }
}
__device__ __forceinline__ float max3f(float a, float b, float c) { float r; asm("v_max3_f32 %0, %1, %2, %3" : "=v"(r) : "v"(a), "v"(b), "v"(c)); return r; }
__device__ __forceinline__ float mask_score(float v, int a, int b, int c) {
    const unsigned sg = (unsigned)(((a + c) | (b - c)) >> 31);
    return __builtin_bit_cast(float, (__builtin_bit_cast(unsigned, v) & ~sg) | (0xf149f2cau & sg));
}
__device__ __forceinline__ void attn_tile(LAS const unsigned char* Kt, LAS const unsigned char* Vt, const bf16x8 (&qr)[4], AttnState& st, int kmin, int kmax, int lane) {
    const int hi = lane >> 5;
    f32x16 p0, p1; attn_scores(Kt, qr, p0, p1, lane);
    VFrags vf; attn_vread(Vt, vf, lane);
    const bool none = kmax < kmin;
    if (!__all((kmin <= 0 && kmax >= 63) || none)) {
        const int a = 4 * hi - kmin, b = kmax - 4 * hi;
#pragma unroll
        for (int r = 0; r < 16; ++r) { const int c = (r & 3) + 8 * (r >> 2); p0[r] = mask_score(p0[r], a, b, c); p1[r] = mask_score(p1[r], a, b, c + 32); }
    }
    asm volatile("s_nop 15\n\ts_nop 7" : "+v"(p0), "+v"(p1));
    float mx = max3f(p0[0], p0[1], p1[0]), mx2 = max3f(p0[2], p0[3], p1[1]);
    mx = max3f(mx, p1[2], p1[3]);
#pragma unroll
    for (int r = 4; r < 16; r += 4) { mx = max3f(mx, p0[r], p0[r + 1]); mx2 = max3f(mx2, p0[r + 2], p0[r + 3]); mx = max3f(mx, p1[r], p1[r + 1]); mx2 = max3f(mx2, p1[r + 2], p1[r + 3]); }
    mx = max3f(mx, mx2, mx2);
    mx = max32(mx);
    mx = none ? -1e30f : mx;
    const bool up = mx > st.m + 8.0f;
    { const float mn = up ? mx : st.m, alpha = __builtin_amdgcn_exp2f(st.m - fmaxf(mn, -1e29f));
        st.m = mn; st.l *= alpha;
        const unsigned long long upm = __ballot(up);
#define RESC16(O) asm volatile("s_cmp_eq_u64 %[c], 0\n\ts_cbranch_scc1 .Lrs%=\n\t" \
            "v_mul_f32 %0, %0, %[a]\n\tv_mul_f32 %1, %1, %[a]\n\tv_mul_f32 %2, %2, %[a]\n\tv_mul_f32 %3, %3, %[a]\n\tv_mul_f32 %4, %4, %[a]\n\tv_mul_f32 %5, %5, %[a]\n\tv_mul_f32 %6, %6, %[a]\n\tv_mul_f32 %7, %7, %[a]\n\t" \
            "v_mul_f32 %8, %8, %[a]\n\tv_mul_f32 %9, %9, %[a]\n\tv_mul_f32 %10, %10, %[a]\n\tv_mul_f32 %11, %11, %[a]\n\tv_mul_f32 %12, %12, %[a]\n\tv_mul_f32 %13, %13, %[a]\n\tv_mul_f32 %14, %14, %[a]\n\tv_mul_f32 %15, %15, %[a]\n" \
            ".Lrs%=:" : "+v"(O[0]), "+v"(O[1]), "+v"(O[2]), "+v"(O[3]), "+v"(O[4]), "+v"(O[5]), "+v"(O[6]), "+v"(O[7]), "+v"(O[8]), "+v"(O[9]), "+v"(O[10]), "+v"(O[11]), "+v"(O[12]), "+v"(O[13]), "+v"(O[14]), "+v"(O[15]) \
            : [a] "v"(alpha), [c] "s"(upm) : "scc")
        RESC16(st.o0); RESC16(st.o1);
#undef RESC16
    }
    const float me = none ? 1e30f : fmaxf(st.m, -1e29f);
    float rs = 0.f;
#pragma unroll
    for (int r = 0; r < 16; ++r) { p0[r] = __builtin_amdgcn_exp2f(p0[r] - me); p1[r] = __builtin_amdgcn_exp2f(p1[r] - me); }
#pragma unroll
    for (int r = 0; r < 16; ++r) { rs += p0[r]; rs += p1[r]; }
    st.l += rs;
    attn_pv(vf, p0, p1, st.o0, st.o1);
}
struct KVRegs { v4u k, v; };
__device__ __forceinline__ void kv_load(KVRegs& r, const bf16* Kg, const bf16* Vg, size_t ld, int tid) {
    const int key = tid >> 3, ch = tid & 7;
    r.k = *(const v4u*)(Kg + (size_t)key * ld + ch * 8); r.v = *(const v4u*)(Vg + (size_t)key * ld + ch * 8);
}
__device__ __forceinline__ void kv_store(const KVRegs& r, LAS unsigned char* buf, int tid) {
    const int key = tid >> 3, ch = tid & 7;
    *(LAS v4u*)(buf + key * KT_STRIDE + ch * 16) = r.k; *(LAS v4u*)(buf + KT_BYTES + key * VT_STRIDE + ch * 16) = r.v;
}

__device__ __forceinline__ float attn_inv_l(const AttnState& st) { const float l = add32(st.l); return 1.0f / fmaxf(l, 1e-30f); }

#define ATTN_STREAM(Kg, Vg, ld, j0, j1, SKIP, RANGE) do { \
    int jn_ = (j0); while (jn_ < (j1) && (SKIP(jn_))) ++jn_; \
    if (jn_ < (j1)) { KVRegs kv_; kv_load(kv_, (Kg) + (size_t)jn_ * 64 * (ld), (Vg) + (size_t)jn_ * 64 * (ld), (ld), F.tid); \
        __syncthreads(); kv_store(kv_, ring, F.tid); int cur_ = 0; \
        for (;;) { const int j_ = jn_; ++jn_; while (jn_ < (j1) && (SKIP(jn_))) ++jn_; const bool more_ = jn_ < (j1); \
            if (more_) kv_load(kv_, (Kg) + (size_t)jn_ * 64 * (ld), (Vg) + (size_t)jn_ * 64 * (ld), (ld), F.tid); \
            __syncthreads(); \
            { int kmin_, kmax_; RANGE(j_, kmin_, kmax_); \
              if (__any(kmax_ >= kmin_)) attn_tile(ring + cur_ * KV_BUF, ring + cur_ * KV_BUF + KT_BYTES, qr, st, kmin_, kmax_, F.lane); } \
            if (!more_) break; \
            kv_store(kv_, ring + (cur_ ^ 1) * KV_BUF, F.tid); cur_ ^= 1; } } } while (0)

__device__ __forceinline__ void nsa_unit(const Frame& F, const bf16* P, const bf16* KC, const bf16* VC, bf16* O  , int b, int g, int i) {
    LAS unsigned char* ring = F.lds;
    LAS float* impb = (LAS float*)(F.lds + 2 * KV_BUF);
    LAS unsigned* selm = (LAS unsigned*)(F.lds + 2 * KV_BUF + 33792);
    LAS float* stash = (LAS float*)(F.lds + 2 * KV_BUF + 33792 + 256) + F.tid;
    const int lane = F.lane, r32 = lane & 31, hi = lane >> 5, hr = F.wave & 3, th = F.wave >> 2;
    const int tl = 32 * th + r32;
    const int s = 64 * i + tl;
    const size_t row = (size_t)b * SEQ + s;
    const int head = g * 4 + hr;
    bf16x8 qr[4];
#pragma unroll
    for (int d = 0; d < 4; ++d) qr[d] = *(const bf16x8*)(P + row * NP1 + C_CQ + head * 64 + d * 16 + hi * 8);
    const float g0 = sigmoidf_(bf2f(P[row * NP1 + C_CG + head])), g1 = sigmoidf_(bf2f(P[row * NP1 + C_CG + 8 + head])), g2 = sigmoidf_(bf2f(P[row * NP1 + C_CG + 16 + head]));
    AttnState st;
    {
        const bf16* Kg = KC + (size_t)(b * 2 + g) * 128 * 64; const bf16* Vg = VC + (size_t)(b * 2 + g) * 128 * 64;
        const int nmax = (s >= 31) ? ((s - 31) >> 4) : -1;
        { KVRegs kv0, kv1; kv_load(kv0, Kg, Vg, 64, F.tid); kv_load(kv1, Kg + 64 * 64, Vg + 64 * 64, 64, F.tid);
          __syncthreads();
          kv_store(kv0, ring, F.tid); kv_store(kv1, ring + KV_BUF, F.tid); }
        __syncthreads();
        attn_reset(st);
        attn_tile(ring, ring + KT_BYTES, qr, st, 0, nmax < 63 ? nmax : 63, lane);
        attn_tile(ring + KV_BUF, ring + KV_BUF + KT_BYTES, qr, st, 0, nmax - 64 < 63 ? nmax - 64 : 63, lane);
        const float inv = attn_inv_l(st);
        { const float sc = g0 * inv;
#pragma unroll
          for (int r = 0; r < 16; ++r) { stash[r * 512] = st.o0[r] * sc; stash[(16 + r) * 512] = st.o1[r] * sc; } }
        if (i >= 16) {
            float xprev = 0.f; const float mfin = st.m;
#define NSA_IMP(U, ACC, GQ) do { const float G_ = ((ACC[4 * (GQ)] + ACC[4 * (GQ) + 1]) + (ACC[4 * (GQ) + 2] + ACC[4 * (GQ) + 3])), L_ = ACC[4 * (GQ) + 3]; \
                const float x_ = other32(L_, hi); impb[(hr * 64 + tl) * 33 + 2 * (U) + hi] = G_ + (hi ? x_ : xprev); xprev = x_; } while (0)
#pragma unroll
            for (int tile = 0; tile < 2; ++tile) {
                f32x16 a0, a1; attn_scores(ring + tile * KV_BUF, qr, a0, a1, lane);
#pragma unroll
                for (int r = 0; r < 16; ++r) { const int c = (r & 3) + 8 * (r >> 2);
                    a0[r] = __builtin_amdgcn_exp2f(mask_score(a0[r], 4 * hi, nmax - 64 * tile - 4 * hi, c) - mfin) * inv; a1[r] = __builtin_amdgcn_exp2f(mask_score(a1[r], 4 * hi, nmax - 64 * tile - 4 * hi, c + 32) - mfin) * inv; }
                NSA_IMP(8 * tile + 0, a0, 0); NSA_IMP(8 * tile + 1, a0, 1); NSA_IMP(8 * tile + 2, a0, 2); NSA_IMP(8 * tile + 3, a0, 3);
                NSA_IMP(8 * tile + 4, a1, 0); NSA_IMP(8 * tile + 5, a1, 1); NSA_IMP(8 * tile + 6, a1, 2); NSA_IMP(8 * tile + 7, a1, 3);
            }
#undef NSA_IMP
        }
    }
    __syncthreads();
    unsigned mymask;
    if (i < 16) mymask = (2u << i) - 1u;
    else {
        { const int tk = F.tid >> 3, js = F.tid & 7; unsigned bits = 0u;
          float v[4];
#pragma unroll
          for (int e = 0; e < 4; ++e) { const int j = js * 4 + e; v[e] = (impb[(0 * 64 + tk) * 33 + j] + impb[(1 * 64 + tk) * 33 + j]) + (impb[(2 * 64 + tk) * 33 + j] + impb[(3 * 64 + tk) * 33 + j]); }
          int rank[4] = {0, 0, 0, 0};
          for (int jj = 1; jj <= i - 2; ++jj) { const float o = (impb[(0 * 64 + tk) * 33 + jj] + impb[(1 * 64 + tk) * 33 + jj]) + (impb[(2 * 64 + tk) * 33 + jj] + impb[(3 * 64 + tk) * 33 + jj]);
#pragma unroll
              for (int e = 0; e < 4; ++e) { const int j = js * 4 + e; rank[e] += (o > v[e] || (o == v[e] && jj < j)) ? 1 : 0; } }
#pragma unroll
          for (int e = 0; e < 4; ++e) { const int j = js * 4 + e; const bool forced = (j == 0) || (j == i) || (j == i - 1); const bool cand = (j >= 1) && (j <= i - 2);
              if (forced || (cand && rank[e] < 13)) bits |= 1u << j; }
          bits |= shxu(bits, 1, F.lane); bits |= shxu(bits, 2, F.lane); bits |= shxu(bits, 4, F.lane);
          if (js == 0) selm[tk] = bits; }
        __syncthreads();
        mymask = selm[tl];
    }
    {
        attn_reset(st);
        const bf16* Kg = P + (size_t)b * SEQ * NP1 + C_KS + g * 64; const bf16* Vg = P + (size_t)b * SEQ * NP1 + C_VS + g * 64;
#define NSA_SKIP(j) (false)
#define NSA_RANGE(j, kmin, kmax) do { kmin = 0; kmax = ((mymask >> (j)) & 1u) ? ((j) == i ? tl : 63) : -1; } while (0)
        ATTN_STREAM(Kg, Vg, (size_t)NP1, 0, i + 1, NSA_SKIP, NSA_RANGE);
#undef NSA_RANGE
        const float sc = g1 * attn_inv_l(st);
#pragma unroll
        for (int r = 0; r < 16; ++r) { stash[r * 512] += st.o0[r] * sc; stash[(16 + r) * 512] += st.o1[r] * sc; }
    }
    {
        attn_reset(st);
        const bf16* Kg = P + (size_t)b * SEQ * NP1 + C_KW + g * 64; const bf16* Vg = P + (size_t)b * SEQ * NP1 + C_VW + g * 64;
        const int jlo = i >= 8 ? i - 8 : 0; f32x16 out0, out1;
#define NSA_RANGE(j, kmin, kmax) do { const int d_ = 64 * (i - (j)) + tl; kmin = d_ - 511 > 0 ? d_ - 511 : 0; kmax = d_ < 63 ? d_ : 63; } while (0)
        ATTN_STREAM(Kg, Vg, (size_t)NP1, jlo, i + 1, NSA_SKIP, NSA_RANGE);
#undef NSA_RANGE
#undef NSA_SKIP
        const float sc = g2 * attn_inv_l(st);
#pragma unroll
        for (int r = 0; r < 16; ++r) { out0[r] = stash[r * 512] + st.o0[r] * sc; out1[r] = stash[(16 + r) * 512] + st.o1[r] * sc; }
        bf16* orow = O + row * 512 + head * 64;
#pragma unroll
        for (int gq = 0; gq < 4; ++gq) {
            v2u w0; w0.x = pk2(out0[4 * gq], out0[4 * gq + 1]); w0.y = pk2(out0[4 * gq + 2], out0[4 * gq + 3]); *(v2u*)(orow + 8 * gq + 4 * hi) = w0;
            v2u w1; w1.x = pk2(out1[4 * gq], out1[4 * gq + 1]); w1.y = pk2(out1[4 * gq + 2], out1[4 * gq + 3]); *(v2u*)(orow + 32 + 8 * gq + 4 * hi) = w1; }
    }
}
__device__ __forceinline__ void phase_nsa(const Frame& F, const bf16* P, const bf16* KC, const bf16* VC, bf16* O) {
    for (int un2 = 2 * F.bid; un2 < 512; un2 += 2 * F.G)
#pragma unroll 1
        for (int k = 0; k < 2; ++k) { const int un = un2 >> 1, ip = un & 15, g = (un >> 4) & 1, b = un >> 5; nsa_unit(F, P, KC, VC, O, b, g, k == 0 ? 31 - ip : ip); }
}

constexpr int MB_SLOTB = 8192, MB_K = 0, MB_V = 3 * MB_SLOTB, MB_WS = 6 * MB_SLOTB, MB_OST = MB_WS + 8 * 256, MB_END = MB_OST + 8 * 4096;
__device__ __forceinline__ void mb_glds16(const void* sbase, unsigned voff, unsigned lds_dst) { unsigned keep;
    asm volatile("s_mov_b32 %0, m0\n\ts_mov_b32 m0, %3\n\ts_nop 0\n\tglobal_load_lds_dwordx4 %1, %2\n\ts_mov_b32 m0, %0" : "=&s"(keep) : "v"(voff), "s"(sbase), "s"(lds_dst) : "memory"); }
__device__ __forceinline__ void mb_kload2(bf16x8* kf, LAS const unsigned char* kp, int j) { kf[2 * j] = *(LAS const bf16x8*)(kp + j * 2048); kf[2 * j + 1] = *(LAS const bf16x8*)(kp + j * 2048 + 512); }
__device__ __forceinline__ void mb_cmask(f32x16& p0, f32x16& p1, int jb, int qrel, int hi) {
    const int kb = 64 * jb + 4 * hi;
#pragma unroll
    for (int r = 0; r < 16; ++r) { const int kv = kb + (r & 3) + 8 * (r >> 2); if (kv > qrel) p0[r] = -INFINITY; if (kv + 32 > qrel) p1[r] = -INFINITY; }
}
__device__ __forceinline__ void mb_pv(f32x16* o, int vb, bf16x8 pa0, bf16x8 pa1, bf16x8 pa2, bf16x8 pa3) {
#pragma unroll
    for (int d0 = 0; d0 < 2; ++d0) { s16x4 lo[4], hh[4];
#pragma unroll
        for (int ks = 0; ks < 4; ++ks) {
            asm volatile("ds_read_b64_tr_b16 %0, %1 offset:%c2" : "=&v"(lo[ks]) : "v"(vb), "i"(d0 * 4096 + ks * 1024) : "memory");
            asm volatile("ds_read_b64_tr_b16 %0, %1 offset:%c2" : "=&v"(hh[ks]) : "v"(vb), "i"(d0 * 4096 + ks * 1024 + 512) : "memory"); }
        asm volatile("s_waitcnt lgkmcnt(0)" ::: "memory"); SBAR();
#define MB_PK(k) (bf16x8){lo[k][0], lo[k][1], lo[k][2], lo[k][3], hh[k][0], hh[k][1], hh[k][2], hh[k][3]}
        o[d0] = __builtin_amdgcn_mfma_f32_32x32x16_bf16(pa0, MB_PK(0), o[d0], 0, 0, 0);
        o[d0] = __builtin_amdgcn_mfma_f32_32x32x16_bf16(pa1, MB_PK(1), o[d0], 0, 0, 0);
        o[d0] = __builtin_amdgcn_mfma_f32_32x32x16_bf16(pa2, MB_PK(2), o[d0], 0, 0, 0);
        o[d0] = __builtin_amdgcn_mfma_f32_32x32x16_bf16(pa3, MB_PK(3), o[d0], 0, 0, 0);
#undef MB_PK
    }
}
#define MB_WAIT_BAR(N) asm volatile("s_waitcnt vmcnt(" #N ") lgkmcnt(0)\n\ts_barrier" ::: "memory")
__device__ __forceinline__ void moba_tiles(const Frame& F, const bf16* P, bf16* O, int b, int h, int qb, const bf16x8 (&qr)[4], const unsigned mymask, const unsigned um) {
    const int lane = F.lane, r32 = lane & 31, hi = lane >> 5, wid = F.wave;
    LAS unsigned char* shm = F.lds;
    const unsigned lds0 = (unsigned)(size_t)shm;
    LAS float* wsf = (LAS float*)(shm + MB_WS) + wid * 64;
    const size_t rowbase = (size_t)b * SEQ; const int q0 = qb * 256;
    const bf16* Kh = P + rowbase * NP1 + C_DK + h * 64; const bf16* Vh = P + rowbase * NP1 + C_DV + h * 64;
    const bf16* ksrc = Kh + wid * 8; const unsigned koff = (unsigned)lane * (NP1 * 2);
    const bf16* vsrc = Vh + (size_t)(16 * (wid & 3)) * NP1 + (wid >> 2) * 32; const unsigned voff = (unsigned)(lane >> 2) * (NP1 * 2) + (lane & 3) * 16;
    const unsigned kdst = lds0 + MB_K + wid * 1024, vdst = lds0 + MB_V + wid * 1024;
    const int np = __builtin_popcount(um); unsigned bl = 0u;
    { int k = 0;
#pragma unroll
      for (int n = 0; n < 8; ++n) if ((um >> n) & 1u) { bl |= (unsigned)n << (4 * k); ++k; } }
    const int NT = 4 * np + 4;
#define MB_BLK(t) ((bl >> (4 * (((t) - 1) >> 2))) & 15u)
#define MB_TJ(t) ((t) == 0 ? 4 * qb : ((t) <= 4 * np ? 4 * (int)MB_BLK(t) + (((t) - 1) & 3) : 4 * qb + (t) - 4 * np))
#define MB_SEL(t) (((t) == 0 || (t) > 4 * np) ? 0xffffffffu : (0u - ((mymask >> MB_BLK(t)) & 1u)))
#define DMA_K(t, slot) mb_glds16(ksrc + (size_t)MB_TJ(t) * 64 * NP1, koff, (unsigned)__builtin_amdgcn_readfirstlane(kdst + (slot)))
#define DMA_V(t, slot) mb_glds16(vsrc + (size_t)MB_TJ(t) * 64 * NP1, voff, (unsigned)__builtin_amdgcn_readfirstlane(vdst + (slot)))
    bf16x8 kf[8];
    LAS const unsigned char* kp0 = shm + MB_K + hi * 1024 + r32 * 16;
    LAS const unsigned char* vp0 = shm + MB_V + ((lane >> 4) & 1) * 32 + (lane & 3) * 8 + (4 * hi + ((lane & 15) >> 2)) * 64;
    DMA_K(0, 0); DMA_V(0, 0); DMA_K(1, MB_SLOTB);
    float mhat = 0.f, l_reg = 0.f; f32x16 o[2]; o[0] = f32x16{}; o[1] = f32x16{}; const f32x16 negm = f32x16{};
#define qrel (wid * 32 + (F.lane & 31))
    bool resc = false; unsigned sp = 0xffffffffu;
#define RESC() do { if (resc) { asm volatile("s_waitcnt lgkmcnt(0)" ::: "memory"); \
        _Pragma("unroll") for (int d_ = 0; d_ < 2; ++d_) _Pragma("unroll") for (int r = 0; r < 16; ++r) o[d_][r] *= wsf[crow(r, hi)]; } } while (0)
    f32x16 pA0, pA1, pB0, pB1;
    int sl_prev = 0, sl_cur = 0, sl_next = MB_SLOTB;
#define ROT() do { sl_prev = sl_cur; sl_cur = sl_next; sl_next = (sl_next == 2 * MB_SLOTB) ? 0 : sl_next + MB_SLOTB; } while (0)
    DMA_K(2, 2 * MB_SLOTB);
    MB_WAIT_BAR(3);
    { mb_kload2(kf, kp0, 0); mb_kload2(kf, kp0, 1); mb_kload2(kf, kp0, 2); mb_kload2(kf, kp0, 3);
      pA0 = __builtin_amdgcn_mfma_f32_32x32x16_bf16(kf[0], qr[0], negm, 0, 0, 0); pA1 = __builtin_amdgcn_mfma_f32_32x32x16_bf16(kf[1], qr[0], negm, 0, 0, 0);
#pragma unroll
      for (int d0 = 1; d0 < 4; ++d0) { pA0 = __builtin_amdgcn_mfma_f32_32x32x16_bf16(kf[2 * d0], qr[d0], pA0, 0, 0, 0); pA1 = __builtin_amdgcn_mfma_f32_32x32x16_bf16(kf[2 * d0 + 1], qr[d0], pA1, 0, 0, 0); } }
    mb_cmask(pA0, pA1, 0, qrel, hi);
    { float a = fmaxf(fmaxf(pA0[0], pA0[1]), pA1[0]);
#pragma unroll
      for (int r = 1; r < 16; ++r) a = fmaxf(a, r == 1 ? pA1[1] : fmaxf(pA0[r], pA1[r]));
      const float rm = max32(a); mhat = rm;
#pragma unroll
      for (int r = 0; r < 16; ++r) { pA0[r] = __builtin_amdgcn_exp2f(pA0[r] - rm); pA1[r] = __builtin_amdgcn_exp2f(pA1[r] - rm); }
    }
    MB_WAIT_BAR(0);
    DMA_K(3, 0); DMA_V(1, MB_SLOTB);
    ROT();
    mb_kload2(kf, kp0 + sl_cur, 0); mb_kload2(kf, kp0 + sl_cur, 1); mb_kload2(kf, kp0 + sl_cur, 2); mb_kload2(kf, kp0 + sl_cur, 3);
    MB_WAIT_BAR(2);
    s16x4 vlo[8], vhi[8]; v4u pw0, pw1, pw2, pw3;
#define PKW(P_, B_) (pk2(P_[B_], P_[B_ + 1]) & sp)
#define PAF(k) __builtin_bit_cast(bf16x8, pw##k)
#define VFR(i) (bf16x8){vlo[i][0], vlo[i][1], vlo[i][2], vlo[i][3], vhi[i][0], vhi[i][1], vhi[i][2], vhi[i][3]}
#define PIN(x) asm volatile("" : "+v"(x))
#define MX3(a_, b_, c_) __builtin_fmaxf(__builtin_fmaxf((a_), (b_)), (c_))
#define GAPA(MF, A0, A1, A2, A3, W0, W1, PW) do { MF; sacc += A0; sacc += A1; sacc += A2; sacc += A3; PIN(sacc); W0; W1; PIN(PW); SBAR(); } while (0)
#define EX(v_) __builtin_amdgcn_exp2f((v_) - mhat)
#define GAPB(MF, X, B_) do { MF; X[B_] = EX(X[B_]); X[B_ + 1] = EX(X[B_ + 1]); X[B_ + 2] = EX(X[B_ + 2]); X[B_ + 3] = EX(X[B_ + 3]); PIN(X); SBAR(); } while (0)
#define VRD(i) do { vlo[i] = vtr(vp_ + (((i) >> 2) * 4096 + ((i) & 3) * 1024)); vhi[i] = vtr(vp_ + (((i) >> 2) * 4096 + ((i) & 3) * 1024 + 512)); } while (0)
#define KRD(G, j) do { if (G) { mb_kload2(kf, kp0 + sl_next, j); SBAR(); } } while (0)
#define MFM(a_, b_, c_) __builtin_amdgcn_mfma_f32_32x32x16_bf16(a_, b_, c_, 0, 0, 0)
#define STEP(C0, C1, P0, P1, t, GK, GV, GL, MASK) do { SBAR(); \
    LAS const unsigned char* vp_ = vp0 + sl_prev; \
    VRD(0); SBAR(); float sacc = (P0[0] + P0[1]); \
    GAPA(C0 = MFM(kf[0], qr[0], negm), P0[2], P0[3], P0[4], P0[5],     pw0[0] = PKW(P0, 0),  pw0[1] = PKW(P0, 2),  pw0); \
    VRD(4); SBAR(); GAPA(C1 = MFM(kf[1], qr[0], negm), P0[6], P0[7], P0[8], P0[9],     pw0[2] = PKW(P0, 4),  pw0[3] = PKW(P0, 6),  pw0); \
    VRD(1); SBAR(); GAPA(C0 = MFM(kf[2], qr[1], C0),   P0[10], P0[11], P0[12], P0[13], pw1[0] = PKW(P0, 8),  pw1[1] = PKW(P0, 10), pw1); \
    VRD(5); SBAR(); GAPA(C1 = MFM(kf[3], qr[1], C1),   P0[14], P0[15], P1[0], P1[1],   pw1[2] = PKW(P0, 12), pw1[3] = PKW(P0, 14), pw1); \
    VRD(2); SBAR(); GAPA(C0 = MFM(kf[4], qr[2], C0),   P1[2], P1[3], P1[4], P1[5],     pw2[0] = PKW(P1, 0),  pw2[1] = PKW(P1, 2),  pw2); \
    VRD(6); SBAR(); GAPA(C1 = MFM(kf[5], qr[2], C1),   P1[6], P1[7], P1[8], P1[9],     pw2[2] = PKW(P1, 4),  pw2[3] = PKW(P1, 6),  pw2); \
    VRD(3); SBAR(); GAPA(C0 = MFM(kf[6], qr[3], C0),   P1[10], P1[11], P1[12], P1[13], pw3[0] = PKW(P1, 8),  pw3[1] = PKW(P1, 10), pw3); \
    VRD(7); SBAR(); GAPA(C1 = MFM(kf[7], qr[3], C1),   P1[14], P1[15], 0.f, 0.f,       pw3[2] = PKW(P1, 12), pw3[3] = PKW(P1, 14), pw3); \
    l_reg += __builtin_bit_cast(float, __builtin_bit_cast(unsigned, sacc) & sp); \
    if (GK) { DMA_K((t) + 3, sl_cur); } if (GV) { DMA_V((t) + 1, sl_next); } \
    if (MASK) { if ((t) >= NT - 3) mb_cmask(C0, C1, (t) - (NT - 4), qrel, hi); } \
    const unsigned sc_ = MB_SEL(t); \
    { float a = MX3(C0[0], C0[1], C1[0]), b_ = MX3(C0[2], C0[3], C1[1]); a = MX3(a, C1[2], C1[3]); \
      _Pragma("unroll") for (int r = 4; r < 16; r += 4) { a = MX3(a, C0[r], C0[r + 1]); b_ = MX3(b_, C0[r + 2], C0[r + 3]); a = MX3(a, C1[r], C1[r + 1]); b_ = MX3(b_, C1[r + 2], C1[r + 3]); } \
      float rm = max32(__builtin_fmaxf(a, b_)) - mhat; rm = sc_ ? rm : -INFINITY;        \
      resc = false; \
      if (__builtin_expect(__any(rm > 8.0f), 0)) { const float dl = __builtin_fmaxf(rm, 0.f); mhat += dl; \
        const float f = __builtin_amdgcn_exp2f(-dl); l_reg *= f; if (hi == 0) wsf[r32] = f; resc = true; } } \
    SBAR(); sp = sc_; \
    GAPB(o[0] = MFM(PAF(0), VFR(0), o[0]), C0, 0); \
    GAPB(o[1] = MFM(PAF(0), VFR(4), o[1]), C0, 4); \
    KRD(GL, 0); GAPB(o[0] = MFM(PAF(1), VFR(1), o[0]), C0, 8); \
    KRD(GL, 1); GAPB(o[1] = MFM(PAF(1), VFR(5), o[1]), C0, 12); \
    KRD(GL, 2); GAPB(o[0] = MFM(PAF(2), VFR(2), o[0]), C1, 0); \
    KRD(GL, 3); GAPB(o[1] = MFM(PAF(2), VFR(6), o[1]), C1, 4); \
    GAPB(o[0] = MFM(PAF(3), VFR(3), o[0]), C1, 8); \
    GAPB(o[1] = MFM(PAF(3), VFR(7), o[1]), C1, 12); \
    } while (0)
    int t = 1;
    for (; t + 5 < NT; t += 2) {
        STEP(pB0, pB1, pA0, pA1, t, true, true, true, false);     MB_WAIT_BAR(2); RESC(); ROT();
        STEP(pA0, pA1, pB0, pB1, t + 1, true, true, true, false); MB_WAIT_BAR(2); RESC(); ROT();
    }
#define ENDW(tt) do { if ((tt) + 3 < NT) { MB_WAIT_BAR(2); } else if ((tt) + 2 < NT) { MB_WAIT_BAR(1); } else { MB_WAIT_BAR(0); } } while (0)
    for (; t + 1 < NT; t += 2) {
        STEP(pB0, pB1, pA0, pA1, t, (t + 3 < NT), (t + 1 < NT), (t + 1 < NT), true);         ENDW(t);     RESC(); ROT();
        STEP(pA0, pA1, pB0, pB1, t + 1, (t + 4 < NT), (t + 2 < NT), (t + 2 < NT), true);     ENDW(t + 1); RESC(); ROT();
    }
    STEP(pB0, pB1, pA0, pA1, NT - 1, false, false, false, true); RESC();
    { float sacc = pB0[0] + pB0[1];
#pragma unroll
      for (int r = 2; r < 16; ++r) sacc += pB0[r];
#pragma unroll
      for (int r = 0; r < 16; ++r) sacc += pB1[r];
      l_reg += __builtin_bit_cast(float, __builtin_bit_cast(unsigned, sacc) & sp);
      pw0 = (v4u){PKW(pB0, 0), PKW(pB0, 2), PKW(pB0, 4), PKW(pB0, 6)}; pw1 = (v4u){PKW(pB0, 8), PKW(pB0, 10), PKW(pB0, 12), PKW(pB0, 14)};
      pw2 = (v4u){PKW(pB1, 0), PKW(pB1, 2), PKW(pB1, 4), PKW(pB1, 6)}; pw3 = (v4u){PKW(pB1, 8), PKW(pB1, 10), PKW(pB1, 12), PKW(pB1, 14)};
      SBAR(); mb_pv(o, (int)(unsigned)(size_t)vp0 + sl_cur, PAF(0), PAF(1), PAF(2), PAF(3)); }
    l_reg = add32(l_reg);
    if (hi == 0) wsf[32 + r32] = l_reg; asm volatile("s_waitcnt lgkmcnt(0)" ::: "memory");
    float rli[16];
#pragma unroll
    for (int r = 0; r < 16; ++r) rli[r] = __builtin_amdgcn_rcpf(wsf[32 + crow(r, hi)]);
    bf16* Ow = O + (rowbase + q0 + wid * 32) * 512 + h * 64; LAS bf16* stg = (LAS bf16*)(shm + MB_OST) + wid * 2048;
#pragma unroll
    for (int r = 0; r < 16; ++r) { const int orow = crow(r, hi);
#pragma unroll
        for (int d0 = 0; d0 < 2; ++d0) stg[orow * 64 + d0 * 32 + r32] = (bf16)f2bf(o[d0][r] * rli[r]); }
    asm volatile("s_waitcnt lgkmcnt(0)" ::: "memory");
#pragma unroll
    for (int i = 0; i < 4; ++i) { const int row = i * 8 + (lane >> 3), ch = lane & 7; *(v4u*)(Ow + (size_t)row * 512 + ch * 8) = *(LAS const v4u*)(stg + row * 64 + ch * 8); }
    asm volatile("s_waitcnt lgkmcnt(0)\n\ts_barrier" ::: "memory");
#undef qrel
#undef MB_BLK
#undef MB_TJ
#undef MB_SEL
#undef DMA_K
#undef DMA_V
#undef RESC
#undef ROT
#undef PKW
#undef PAF
#undef VFR
#undef PIN
#undef MX3
#undef GAPA
#undef EX
#undef GAPB
#undef VRD
#undef KRD
#undef MFM
#undef STEP
#undef ENDW
}
__device__ __forceinline__ void moba_unit(const Frame& F, const bf16* P, const float* KM, bf16* O  , int b, int h, int qb) {
    LAS float* kml = (LAS float*)(F.lds + 86016);
    LAS unsigned* uni = (LAS unsigned*)(F.lds + 86016 + 2048);
    const int lane = F.lane, r32 = lane & 31, hi = lane >> 5;
    const int tl = 32 * F.wave + r32;
    const size_t row = (size_t)b * SEQ + 256 * qb + tl;
    bf16x8 qr[4];
#pragma unroll
    for (int d = 0; d < 4; ++d) qr[d] = *(const bf16x8*)(P + row * NP1 + C_DQ + h * 64 + d * 16 + hi * 8);
    __syncthreads();
    { const int blk = F.tid >> 6, p = F.tid & 63; kml[F.tid] = KM[((size_t)(b * 8 + blk) * 8 + h) * 64 + p]; if (F.tid == 0) uni[0] = 0u; }
    __syncthreads();
    unsigned mymask = 0u;
    if (qb > 0) {
        float gt[8];
        float qf[32];
#pragma unroll
        for (int d = 0; d < 4; ++d) { const v4u qw = __builtin_bit_cast(v4u, qr[d]);
            qf[8 * d + 0] = bflo(qw.x); qf[8 * d + 1] = bfhi(qw.x); qf[8 * d + 2] = bflo(qw.y); qf[8 * d + 3] = bfhi(qw.y); qf[8 * d + 4] = bflo(qw.z); qf[8 * d + 5] = bfhi(qw.z); qf[8 * d + 6] = bflo(qw.w); qf[8 * d + 7] = bfhi(qw.w); }
#pragma unroll
        for (int n = 0; n < 8; ++n) {
            f32x4 kv[8];
#pragma unroll
            for (int d = 0; d < 4; ++d) { const LAS f32x4* km = (const LAS f32x4*)(kml + n * 64 + d * 16 + hi * 8); kv[2 * d] = km[0]; kv[2 * d + 1] = km[1]; }
            SBAR();
            float a = 0.f;
#pragma unroll
            for (int d = 0; d < 4; ++d) a += qf[8 * d + 0] * kv[2 * d][0] + qf[8 * d + 1] * kv[2 * d][1] + qf[8 * d + 2] * kv[2 * d][2] + qf[8 * d + 3] * kv[2 * d][3]
                                           + qf[8 * d + 4] * kv[2 * d + 1][0] + qf[8 * d + 5] * kv[2 * d + 1][1] + qf[8 * d + 6] * kv[2 * d + 1][2] + qf[8 * d + 7] * kv[2 * d + 1][3];
            a = add32(a); gt[n] = a; }
#pragma unroll
        for (int n = 0; n < 8; ++n) { int rank = 0;
#pragma unroll
            for (int m = 0; m < 8; ++m) if (m != n) { const bool ahead = (m < n) ? (gt[m] >= gt[n]) : (gt[m] > gt[n]); rank += ((m < qb) & ahead) ? 1 : 0; }
            mymask |= ((n < qb) & (rank < 3)) ? (1u << n) : 0u; }
        atomicOr((unsigned*)uni, mymask);
    }
    __syncthreads();
    const unsigned um = (unsigned)__builtin_amdgcn_readfirstlane((int)uni[0]);
    VM_WAIT();
    moba_tiles(F, P, O, b, h, qb, qr, mymask, um);
}
__device__ __forceinline__ void phase_moba(const Frame& F, const bf16* P, const float* KM, bf16* O) {
    for (int un2 = 2 * F.bid; un2 < 512; un2 += 2 * F.G)
#pragma unroll 1
        for (int k = 0; k < 2; ++k) { const int un = un2 >> 1, qp = un & 3, h = (un >> 2) & 7, b = un >> 5; moba_unit(F, P, KM, O, b, h, k == 0 ? 7 - qp : qp); }
}

__device__ __forceinline__ unsigned ord_key(float x) { const unsigned u = __builtin_bit_cast(unsigned, x); return (u & 0x80000000u) ? ~u : (u | 0x80000000u); }
__device__ __forceinline__ float ord_val(unsigned k) { const unsigned u = (k & 0x80000000u) ? (k & 0x7fffffffu) : ~k; return __builtin_bit_cast(float, u); }
__device__ __forceinline__ void ce_desc(unsigned& a, unsigned& b) { const unsigned hi_ = a > b ? a : b, lo_ = a > b ? b : a; a = hi_; b = lo_; }
__device__ __forceinline__ void bitonic_merge16_desc(unsigned* a) {
#pragma unroll
    for (int j = 8; j > 0; j >>= 1)
#pragma unroll
        for (int i = 0; i < 16; ++i) if ((i & j) == 0) ce_desc(a[i], a[i | j]);
}
__device__ __forceinline__ void bitonic_sort16_desc(unsigned* a) {
    ce_desc(a[0], a[1]); ce_desc(a[2], a[3]); ce_desc(a[0], a[2]); ce_desc(a[1], a[3]); ce_desc(a[1], a[2]); ce_desc(a[4], a[5]); ce_desc(a[6], a[7]); ce_desc(a[4], a[6]); ce_desc(a[5], a[7]); ce_desc(a[5], a[6]); ce_desc(a[0], a[4]); ce_desc(a[2], a[6]); ce_desc(a[2], a[4]); ce_desc(a[1], a[5]); ce_desc(a[3], a[7]); ce_desc(a[3], a[5]); ce_desc(a[1], a[2]); ce_desc(a[3], a[4]); ce_desc(a[5], a[6]); ce_desc(a[8], a[9]); ce_desc(a[10], a[11]); ce_desc(a[8], a[10]); ce_desc(a[9], a[11]); ce_desc(a[9], a[10]); ce_desc(a[12], a[13]); ce_desc(a[14], a[15]); ce_desc(a[12], a[14]); ce_desc(a[13], a[15]); ce_desc(a[13], a[14]); ce_desc(a[8], a[12]); ce_desc(a[10], a[14]); ce_desc(a[10], a[12]); ce_desc(a[9], a[13]); ce_desc(a[11], a[15]); ce_desc(a[11], a[13]); ce_desc(a[9], a[10]); ce_desc(a[11], a[12]); ce_desc(a[13], a[14]); ce_desc(a[0], a[8]); ce_desc(a[4], a[12]); ce_desc(a[4], a[8]); ce_desc(a[2], a[10]); ce_desc(a[6], a[14]); ce_desc(a[6], a[10]); ce_desc(a[2], a[4]); ce_desc(a[6], a[8]); ce_desc(a[10], a[12]); ce_desc(a[1], a[9]); ce_desc(a[5], a[13]); ce_desc(a[5], a[9]); ce_desc(a[3], a[11]); ce_desc(a[7], a[15]); ce_desc(a[7], a[11]); ce_desc(a[3], a[5]); ce_desc(a[7], a[9]); ce_desc(a[11], a[13]); ce_desc(a[1], a[2]); ce_desc(a[3], a[4]); ce_desc(a[5], a[6]); ce_desc(a[7], a[8]); ce_desc(a[9], a[10]); ce_desc(a[11], a[12]); ce_desc(a[13], a[14]);
}
__device__ __forceinline__ void merge_top16(unsigned* a, const unsigned* b) {
#pragma unroll
    for (int i = 0; i < 16; ++i) a[i] = a[i] > b[15 - i] ? a[i] : b[15 - i];
    bitonic_merge16_desc(a);
}
constexpr int SK_STRIDE = 272;
__device__ __forceinline__ void peer_route_unit(const Frame& F, const bf16* Q2, const bf16* SUBK  , int* EIDX, float* EW, int tb, int h) {
    LAS unsigned char* skl = F.lds;
    LAS unsigned* slot = (LAS unsigned*)(F.lds + 36864) + F.tid;
    const int lane = F.lane, r32 = lane & 31, hi = lane >> 5;
    const size_t tok = (size_t)tb * 256 + F.wave * 32 + r32;
#pragma unroll 1
    for (int p = 0; p < 2; ++p) {
        __syncthreads();
        { v4u sk[4];
#pragma unroll
          for (int j = 0; j < 4; ++j) { const int i = F.tid + j * NTHR, ch = i & 15, rowi = i >> 4; sk[j] = *(const v4u*)(SUBK + ((size_t)h * 256 + p * 128 + rowi) * 128 + ch * 8); }
#pragma unroll
          for (int j = 0; j < 4; ++j) { const int i = F.tid + j * NTHR, ch = i & 15, rowi = i >> 4; *(LAS v4u*)(skl + rowi * SK_STRIDE + ch * 16) = sk[j]; } }
        __syncthreads();
        bf16x8 qf[8]; float ss = 0.f;
#pragma unroll
        for (int s = 0; s < 8; ++s) { qf[s] = *(const bf16x8*)(Q2 + tok * 2048 + h * 256 + p * 128 + s * 16 + hi * 8); const v4u w = __builtin_bit_cast(v4u, qf[s]);
            const float a0 = bflo(w.x), a1 = bfhi(w.x), a2 = bflo(w.y), a3 = bfhi(w.y), a4 = bflo(w.z), a5 = bfhi(w.z), a6 = bflo(w.w), a7 = bfhi(w.w);
            ss += (a0 * a0 + a1 * a1) + (a2 * a2 + a3 * a3) + (a4 * a4 + a5 * a5) + (a6 * a6 + a7 * a7); }
        ss = add32(ss);
        const float rn = 1.0f / sqrtf(ss * (1.0f / 128.0f) + NORM_EPS);
        unsigned key[64];
#pragma unroll
        for (int nb = 0; nb < 4; ++nb) { f32x16 acc;
#pragma unroll
            for (int r = 0; r < 16; ++r) acc[r] = 0.f;
#pragma unroll
            for (int sh = 0; sh < 2; ++sh) { bf16x8 sa[4];
#pragma unroll
                for (int s = 0; s < 4; ++s) sa[s] = *(LAS const bf16x8*)(skl + (nb * 32 + r32) * SK_STRIDE + (2 * (4 * sh + s) + hi) * 16);
                __builtin_amdgcn_sched_barrier(0);
#pragma unroll
                for (int s = 0; s < 4; ++s) acc = __builtin_amdgcn_mfma_f32_32x32x16_bf16(sa[s], qf[4 * sh + s], acc, 0, 0, 0); }
#pragma unroll
            for (int r = 0; r < 16; ++r) { const int n = nb * 32 + crow(r, hi); key[nb * 16 + r] = (ord_key(acc[r] * rn) & 0xffffff80u) | (unsigned)(127 - n); } }
#pragma unroll
        for (int blk = 0; blk < 4; ++blk) bitonic_sort16_desc(key + 16 * blk);
        merge_top16(key, key + 16); merge_top16(key + 32, key + 48); merge_top16(key, key + 32);
        { unsigned oth[16];
#pragma unroll
          for (int i = 0; i < 16; ++i) { unsigned r0, r1; swap32(key[i], r0, r1); oth[i] = hi ? r0 : r1; }
          merge_top16(key, oth); }
#pragma unroll
        for (int k = 0; k < 16; ++k) slot[(p * 16 + k) * 512] = key[k];
    }
    LDS_WAIT(); asm volatile("" ::: "memory");
    unsigned ck[64];
    { float v1[16], v2[16];
#pragma unroll
      for (int k = 0; k < 16; ++k) { v1[k] = ord_val(slot[k * 512] & 0xffffff80u); v2[k] = ord_val(slot[(16 + k) * 512] & 0xffffff80u); }
      int c = 0;
#pragma unroll
      for (int a = 0; a < 16; ++a)
#pragma unroll
          for (int bq = 0; bq < 16; ++bq) if ((a + 1) * (bq + 1) <= 16) { ck[c] = (ord_key(v1[a] + v2[bq]) & 0xffffff00u) | (unsigned)(255 - (16 * a + bq)); ++c; }
#pragma unroll
      for (int q = 50; q < 64; ++q) ck[q] = 0u; }
#pragma unroll
    for (int blk = 0; blk < 4; ++blk) bitonic_sort16_desc(ck + 16 * blk);
    merge_top16(ck, ck + 16); merge_top16(ck + 32, ck + 48); merge_top16(ck, ck + 32);
    float den = 0.f; const float mx = ord_val(ck[0] & 0xffffff00u);
#pragma unroll
    for (int k = 0; k < 16; ++k) { const unsigned m = ck[k];
        const int ci = 255 - (int)(m & 255u), a = ci >> 4, bq = ci & 15;
        const unsigned ka = slot[a * 512], kb = slot[(16 + bq) * 512];
        const int te = (127 - (int)(ka & 127u)) * 128 + (127 - (int)(kb & 127u));
        const float ek = __expf(ord_val(m & 0xffffff00u) - mx); den += ek;
        slot[(32 + k) * 512] = __builtin_bit_cast(unsigned, ek);
        if (hi == 0) EIDX[(tok * 8 + h) * 16 + k] = te; }
    LDS_WAIT(); asm volatile("" ::: "memory");
    if (hi == 0) { const float inv = 1.0f / den; float* ewp = EW + (tok * 8 + h) * 16;
#pragma unroll
        for (int q = 0; q < 4; ++q) *(f32x4*)(ewp + 4 * q) = (f32x4){__builtin_bit_cast(float, slot[(32 + 4 * q) * 512]), __builtin_bit_cast(float, slot[(33 + 4 * q) * 512]),
                                                                      __builtin_bit_cast(float, slot[(34 + 4 * q) * 512]), __builtin_bit_cast(float, slot[(35 + 4 * q) * 512])} * inv; }
}

__device__ __forceinline__ void phase_peer_route(const Frame& F, const bf16* Q2, const bf16* SUBK, int* EIDX, float* EW) {
    for (int un = F.bid; un < 64 * 8; un += F.G) peer_route_unit(F, Q2, SUBK, EIDX, EW, un >> 3, un & 7);
}

__device__ __forceinline__ void phase_peer_tables(const Frame& F, const float* U, const float* V, unsigned char* UT8, unsigned char* VT8, float* SU, float* SV) {
    const int gw = gwave(F), NGW = ngwave(F), lane = F.lane;
    for (int r = gw; r < 2 * 16384; r += NGW) {
        const int tab = r >> 14, e = r & 16383; const float* src = (tab ? V : U) + (size_t)e * DM + 16 * lane;
        f32x4 x[4]; float mx = 0.f;
#pragma unroll
        for (int q = 0; q < 4; ++q) { x[q] = *(const f32x4*)(src + 4 * q); mx = fmaxf(fmaxf(mx, fmaxf(fabsf(x[q][0]), fabsf(x[q][1]))), fmaxf(fabsf(x[q][2]), fabsf(x[q][3]))); }
#pragma unroll
        for (int o = 1; o < 32; o <<= 1) mx = fmaxf(mx, shx(mx, o, lane));
        mx = max32(mx);
        int ex = 0; (void)frexpf(mx, &ex);
        const int k = (mx > 0.f) ? (8 - ex) : 0;
        const float sc = __builtin_ldexpf(1.0f, k), inv = __builtin_ldexpf(1.0f, -k);
        v4u w; float rowscale = inv;
        if (tab) {
#pragma unroll
            for (int q = 0; q < 4; ++q) { unsigned p = 0u; p = __builtin_amdgcn_cvt_pk_fp8_f32(x[q][0] * sc, x[q][1] * sc, p, false); p = __builtin_amdgcn_cvt_pk_fp8_f32(x[q][2] * sc, x[q][3] * sc, p, true); w[q] = p; }
        } else {
            const float qs = mx > 0.f ? 127.0f / mx : 0.f; rowscale = mx > 0.f ? mx * (1.0f / 127.0f) : 0.f;
#pragma unroll
            for (int q = 0; q < 4; ++q) w[q] = ((unsigned)(int)rintf(x[q][0] * qs) & 0xffu) | (((unsigned)(int)rintf(x[q][1] * qs) & 0xffu) << 8) | (((unsigned)(int)rintf(x[q][2] * qs) & 0xffu) << 16) | (((unsigned)(int)rintf(x[q][3] * qs) & 0xffu) << 24);
        }
        *(v4u*)((tab ? VT8 : UT8) + ((size_t)(lane >> 3) * 16384 + e) * 128 + (lane & 7) * 16) = w;
        if (lane == 0) (tab ? SV : SU)[e] = rowscale;
    }
}
typedef _Float16 h16x2 __attribute__((ext_vector_type(2)));
typedef __fp16 fp16x2_t __attribute__((ext_vector_type(2)));
__device__ __forceinline__ void phase_peer_u(const Frame& F, const unsigned char* H8, const float* HS, const unsigned char* UT8, const float* SU, const int* EIDX, float* PART) {
    const int lane = F.lane, g = lane >> 3, sub = lane & 7, b0 = lane & 1, b1 = (lane >> 1) & 1, b2 = (lane >> 2) & 1;
    const int s = F.bid & 7, wgq = F.bid >> 3, nq = F.G >> 3;
    LAS int* il = (LAS int*)(F.lds + F.wave * 8192);
    LAS float* pcl = (LAS float*)(F.lds + F.wave * 8192 + 4096);
    const unsigned char* ub = UT8 + (size_t)s * 16384 * 128 + sub * 16;
    v4u ni0, ni1, ni2, ni3, nh;
#define PU_META(bt) do { const int t0_ = (bt) * 8; const v4u* src = (const v4u*)(EIDX + (size_t)t0_ * 128) + lane; ni0 = src[0]; ni1 = src[64]; ni2 = src[128]; ni3 = src[192];     \
        nh = *(const v4u*)(H8 + (size_t)(t0_ + g) * DM + s * 128 + sub * 16); } while (0)
    { const int b0_ = wgq * 8 + F.wave; if (b0_ < TOK / 8) PU_META(b0_); }
    for (int batch = wgq * 8 + F.wave; batch < TOK / 8; batch += nq * 8) {
        const int t0 = batch * 8, t = t0 + g;
        { LAS v4u* dst = (LAS v4u*)il + lane; dst[0] = ni0; dst[64] = ni1; dst[128] = ni2; dst[192] = ni3; }
        const v4u h = nh;
        if (batch + nq * 8 < TOK / 8) PU_META(batch + nq * 8);
        LDS_WAIT(); asm volatile("" ::: "memory");
#define PU_LOAD(c, ua, su_) do { const v4u ia = *(LAS v4u*)(il + g * 128 + (c) * 8), ib = *(LAS v4u*)(il + g * 128 + (c) * 8 + 4); \
            ua[0] = *(const v4u*)(ub + (size_t)ia.x * 128); ua[1] = *(const v4u*)(ub + (size_t)ia.y * 128); ua[2] = *(const v4u*)(ub + (size_t)ia.z * 128); ua[3] = *(const v4u*)(ub + (size_t)ia.w * 128); \
            ua[4] = *(const v4u*)(ub + (size_t)ib.x * 128); ua[5] = *(const v4u*)(ub + (size_t)ib.y * 128); ua[6] = *(const v4u*)(ub + (size_t)ib.z * 128); ua[7] = *(const v4u*)(ub + (size_t)ib.w * 128); \
            su_ = 1.0f; } while (0)
#define PU_COMP(c, ua, su_) do { float a[8]; \
            _Pragma("unroll") for (int j = 0; j < 8; ++j) { int acc = __builtin_amdgcn_sdot4((int)ua[j].x, (int)h.x, 0, false); acc = __builtin_amdgcn_sdot4((int)ua[j].y, (int)h.y, acc, false); \
                acc = __builtin_amdgcn_sdot4((int)ua[j].z, (int)h.z, acc, false); acc = __builtin_amdgcn_sdot4((int)ua[j].w, (int)h.w, acc, false); a[j] = (float)acc; } \
            float bq[4], cc[2]; \
            _Pragma("unroll") for (int p = 0; p < 4; ++p) { const float keep = b0 ? a[2 * p + 1] : a[2 * p], send = b0 ? a[2 * p] : a[2 * p + 1]; bq[p] = keep + shx(send, 1, lane); } \
            _Pragma("unroll") for (int q = 0; q < 2; ++q) { const float keep = b1 ? bq[2 * q + 1] : bq[2 * q], send = b1 ? bq[2 * q] : bq[2 * q + 1]; cc[q] = keep + shx(send, 2, lane); } \
            { const float keep = b2 ? cc[1] : cc[0], send = b2 ? cc[0] : cc[1]; pcl[(c) * 64 + lane] = (keep + shx(send, 4, lane)) * su_; } } while (0)
        { v4u uA[8], uB[8]; float sA, sB;
          PU_LOAD(0, uA, sA);
#pragma unroll 1
          for (int c = 0; c < 16; c += 2) {
              PU_LOAD(c + 1, uB, sB);
              PU_COMP(c, uA, sA);
              if (c + 2 < 16) PU_LOAD(c + 2, uA, sA);
              PU_COMP(c + 1, uB, sB);
          } }
#undef PU_LOAD
#undef PU_COMP
        LDS_WAIT(); asm volatile("" ::: "memory");
        float* dst = PART + ((size_t)s * TOK + t) * 128 + sub;
#pragma unroll
        for (int c = 0; c < 16; ++c) dst[8 * c] = pcl[c * 64 + lane];
        LDS_WAIT(); asm volatile("" ::: "memory");
    }
#undef PU_META
}
__device__ __forceinline__ float gelu_as(float v) {
    const float av = fabsf(v), t = __builtin_amdgcn_rcpf(av * 0.2316418882f + 1.0f);
    float q = t * 0.5307027145f + (-0.7265760135f); q = q * t + 0.7107068705f; q = q * t + (-0.142248368f); q = q * t + 0.127414796f; q = q * t;
    const float m = v * (q * __builtin_amdgcn_exp2f((v * v) * (-0.72134752044f)));
    return v < 0.f ? m : v - m;
}
__device__ __forceinline__ void phase_peer_w(const Frame& F, const float* SV, const float* SU, const float* HS, const int* EIDX, const float* EW, const float* PART, v2u* COEF) {
    const int nth = F.G * NTHR;
    for (int i0 = F.bid * NTHR + F.tid; i0 < TOK * 128; i0 += 4 * nth) {
        float pv[4][8], ew[4]; int e[4];
#pragma unroll
        for (int u = 0; u < 4; ++u) { const int i = i0 + u * nth < TOK * 128 ? i0 + u * nth : i0;
#pragma unroll
            for (int sp = 0; sp < 8; ++sp) pv[u][sp] = PART[(size_t)sp * TOK * 128 + i];
            e[u] = EIDX[i]; ew[u] = EW[i]; }
        float sv[4], su[4], hs[4];
#pragma unroll
        for (int u = 0; u < 4; ++u) { const int i = i0 + u * nth < TOK * 128 ? i0 + u * nth : i0; sv[u] = SV[e[u]]; su[u] = SU[e[u]]; hs[u] = HS[i >> 7]; }
#pragma unroll
        for (int u = 0; u < 4; ++u) { const int i = i0 + u * nth; float act = 0.f;
#pragma unroll
            for (int sp = 0; sp < 8; ++sp) act += pv[u][sp];
            const float c = ew[u] * gelu_as(act * (su[u] * hs[u])) * sv[u];
            if (i < TOK * 128) COEF[i] = (v2u){(unsigned)e[u], __builtin_bit_cast(unsigned, c)}; }
    }
}
__device__ __forceinline__ void phase_peer_v(const Frame& F, const unsigned char* VT8, const v2u* COEF, float* XB, const float* gate) {
    const int lane = F.lane, g = lane >> 3, sub = lane & 7;
    const int s = F.bid & 7, wgq = F.bid >> 3, nq = F.G >> 3;
    LAS v2u* wl = (LAS v2u*)(F.lds + F.wave * 8192);
    const unsigned char* vb = VT8 + (size_t)s * 16384 * 128 + sub * 16;
    v4u nc[8];
#define PV_META(bt) do { const v4u* src = (const v4u*)(COEF + (size_t)(bt) * 8 * 128) + lane; _Pragma("unroll") for (int q = 0; q < 8; ++q) nc[q] = src[64 * q]; } while (0)
    { const int b0_ = wgq * 8 + F.wave; if (b0_ < TOK / 8) PV_META(b0_); }
    for (int batch = wgq * 8 + F.wave; batch < TOK / 8; batch += nq * 8) {
        const int t0 = batch * 8, t = t0 + g;
        { LAS v4u* dst = (LAS v4u*)wl + lane;
#pragma unroll
          for (int q = 0; q < 8; ++q) dst[64 * q] = nc[q]; }
        if (batch + nq * 8 < TOK / 8) PV_META(batch + nq * 8);
        const int bb = t / SEQ; float* xr = XB + (size_t)t * DM + s * 128 + sub * 16; const float* gr = gate + (size_t)bb * 6144 + s * 128 + sub * 16;
        f32x4 xv[4], gv4[4];
#pragma unroll
        for (int q = 0; q < 4; ++q) { xv[q] = *(const f32x4*)(xr + 4 * q); gv4[q] = *(const f32x4*)(gr + 4 * q); }
        LDS_WAIT(); asm volatile("" ::: "memory");
        h16x2 o[8];
#pragma unroll
        for (int q = 0; q < 8; ++q) o[q] = (h16x2){(_Float16)0.f, (_Float16)0.f};
#define PV_LOAD(c, pr, va) do { \
            _Pragma("unroll") for (int q = 0; q < 4; ++q) pr[q] = *(LAS v4u*)(wl + g * 128 + (c) * 8 + 2 * q); \
            _Pragma("unroll") for (int q = 0; q < 4; ++q) { va[2 * q] = *(const v4u*)(vb + (size_t)pr[q].x * 128); va[2 * q + 1] = *(const v4u*)(vb + (size_t)pr[q].z * 128); } } while (0)
#define PV_COMP(pr, va) do { \
            _Pragma("unroll") for (int j = 0; j < 8; ++j) { const unsigned cb = (j & 1) ? pr[j >> 1].w : pr[j >> 1].y; \
                const float s2 = __builtin_bit_cast(float, cb & 0x7f800000u); const _Float16 mh = (_Float16)__builtin_bit_cast(float, (cb & 0x807fffffu) | 0x3f800000u); const h16x2 m2 = (h16x2){mh, mh}; \
                _Pragma("unroll") for (int q = 0; q < 4; ++q) { o[2 * q] = __builtin_elementwise_fma(__builtin_bit_cast(h16x2, __builtin_amdgcn_cvt_scalef32_pk_f16_fp8(va[j][q], s2, false)), m2, o[2 * q]); \
                    o[2 * q + 1] = __builtin_elementwise_fma(__builtin_bit_cast(h16x2, __builtin_amdgcn_cvt_scalef32_pk_f16_fp8(va[j][q], s2, true)), m2, o[2 * q + 1]); } } } while (0)
        { v4u pA[4], pB[4], vA[8], vB[8];
          PV_LOAD(0, pA, vA);
#pragma unroll 1
          for (int c = 0; c < 16; c += 2) {
              PV_LOAD(c + 1, pB, vB);
              PV_COMP(pA, vA);
              if (c + 2 < 16) PV_LOAD(c + 2, pA, vA);
              PV_COMP(pB, vB);
          } }
#undef PV_LOAD
#undef PV_COMP
#pragma unroll
        for (int q = 0; q < 4; ++q) *(f32x4*)(xr + 4 * q) = xv[q] + gv4[q] * (f32x4){(float)o[2 * q].x, (float)o[2 * q].y, (float)o[2 * q + 1].x, (float)o[2 * q + 1].y};
        LDS_WAIT(); asm volatile("" ::: "memory");
    }
#undef PV_META
}

constexpr int NPL = 12, NPHASE = 1 + DEPTH * NPL + 1;
constexpr int CW_BAR = 1024;
static_assert((CW_BAR + XCD_BAR_WORDS) * 4 <= (int)CTL_ZERO_BYTES, "barrier words inside the memset region");

__global__ void __launch_bounds__(NTHR, 2) hybrid_fwd(Args args) {
    extern __shared__ __attribute__((aligned(16))) unsigned char lds[];
    Frame F;
    F.lds = (LAS unsigned char*)lds; F.ldsg = lds;
    F.tid = threadIdx.x; F.lane = F.tid & 63; F.wave = __builtin_amdgcn_readfirstlane(F.tid >> 6);
    F.G = gridDim.x; F.bid = blockIdx.x; F.ws = args.ws;
    GAS unsigned char* wsg = (GAS unsigned char*)args.ws;
#define WSP ((unsigned char*)wsg)
    volatile LAS unsigned* MISC = (volatile LAS unsigned*)(F.lds + MISC_OFF);
    for (int u = F.tid; u < 64; u += NTHR) ((LAS unsigned*)(F.lds + MISC_OFF))[u] = 0u;
    __syncthreads();
    XcdBarrier bar; bar.bar = (unsigned*)(WSP + WS_CTL) + CW_BAR; bar.x = 0; bar.st = nullptr;
    const int lo = args.ph_lo, hi = args.ph_hi;
    if (hi - lo > 1) bar = xcd_barrier_post((unsigned*)(WSP + WS_CTL) + CW_BAR, MISC + 8);
#define IN(k) (lo <= (k) && (k) < hi)
#define SEAM(k) do { if (IN(k) && IN((k) + 1)) xcd_barrier(bar); } while (0)

    typedef __attribute__((address_space(4))) const Args* KArgs;
    KArgs ap = (KArgs)__builtin_amdgcn_kernarg_segment_ptr();
#define FRESH() asm volatile("" : "+s"(ap), "+s"(wsg)); Frame Fp = F; asm volatile("" : "+v"(Fp.tid)); Fp.lane = Fp.tid & 63; asm volatile("" : "+s"(Fp.wave), "+s"(Fp.bid), "+s"(Fp.G)); Fp.ws = WSP; LAS unsigned char* ring = Fp.lds; asm volatile("" : "+s"(ring)); Fp.lds = ring
#define INP(i) ((const float*)(GAS const float*)ap->in[i])
#define WIN_ ((bf16*)(WSP + WS_WIN))
#define WOUT_ ((bf16*)(WSP + WS_WOUT))
#define WOT_ ((bf16*)(WSP + WS_WO))
#define WQT_ ((bf16*)(WSP + WS_WQ))
#define W1T_ ((bf16*)(WSP + WS_W1T))
#define SUBK_ ((bf16*)(WSP + WS_SUBK))
#define W2T_ ((bf16*)(WSP + WS_SMALL + SM_W2T))
#define MOD_ ((float*)(WSP + WS_MOD))
#define COS_ ((const float*)(WSP + WS_COS))
#define SIN_ ((const float*)(WSP + WS_SIN))
#define KMEAN_ ((float*)(WSP + WS_SMALL + SM_KMEAN))
#define KCMP_ ((bf16*)(WSP + WS_SMALL + SM_KCMP))
#define VCMP_ ((bf16*)(WSP + WS_SMALL + SM_VCMP))
#define PBP_ ((float*)(WSP + WS_SMALL + SM_PBP))
#define EIDX_ ((int*)(WSP + WS_EIDX))
#define EW_ ((float*)(WSP + WS_EW))
#define HN_ ((bf16*)(WSP + WS_HN))
#define MIX_ ((bf16*)(WSP + WS_MIX))
#define PROJ_ ((bf16*)(WSP + WS_BIG))
#define GATES_ ((unsigned char*)(WSP + WS_GATES))
#define UT_ ((unsigned char*)(WSP + WS_BIG))
#define VT_ ((unsigned char*)(WSP + WS_BIG + 16 * MiB))
#define SU_ ((float*)(WSP + WS_BIG + 32 * MiB))
#define SV_ ((float*)(WSP + WS_BIG + 32 * MiB + 65536))
#define COEF_ ((v2u*)(WSP + WS_BIG + 33 * MiB))
#define H8_ ((unsigned char*)(WSP + WS_BIG + 128 * MiB))
#define HS_ ((float*)(WSP + WS_BIG + 144 * MiB))
#define Q2_ ((bf16*)(WSP + WS_BIG + 64 * MiB))
#define PART_ ((float*)(WSP + WS_BIG + 64 * MiB))
#define XB_ ((float*)(GAS float*)ap->out)
#define MODL_ (MOD_ + (size_t)l * 8 * 6144)
#define XIN_ ((l == 0) ? INP(I_X) : (const float*)XB_)

    if (IN(0)) { FRESH(); phase_prologue(Fp, ap); }
    SEAM(0);
#pragma unroll 1
    for (int l = 0; l < DEPTH; ++l) {
        const int p0 = 1 + l * NPL;
        if (IN(p0 + 0)) { FRESH(); phase_norm_mod(Fp, XIN_, INP(I_NMG) + l * DM, MODL_ + 0, MODL_ + 1024, HN_); }
        SEAM(p0 + 0);
        if (IN(p0 + 1)) { FRESH(); pg8::Gemm g{HN_, WIN_ + (size_t)l * NWIN * DM, TOK, NWIN, DM}; pg8::StaticOrder S; S.init(TOK, NWIN, Fp.G, Fp.bid);
            epi::EpiProjAll E{{PROJ_, COS_, SIN_}, {GATES_}}; pg8::gemm_phase<epi::EpiProjAll, pg8::StaticOrder, true, true>(ring, g, S, E, Fp.tid); }
        SEAM(p0 + 1);
        if (IN(p0 + 2)) {
            { FRESH(); phase_compress(Fp, PROJ_, W1T_ + (size_t)l * 2 * 128 * 2048, W2T_ + (size_t)l * 2 * 64 * 128, PBP_ + (size_t)l * 2 * 16 * 128, KCMP_, VCMP_); }
            { FRESH(); phase_kmean(Fp, PROJ_, KMEAN_); }
            { FRESH(); phase_mixer_a(Fp, PROJ_, INP(I_ACW) + (size_t)l * 3 * 512, MIX_); }
            __syncthreads();
            { FRESH(); phase_mixer_b(Fp, PROJ_, INP(I_BCW) + (size_t)l * 31 * 512, INP(I_BCB) + l * 512, INP(I_BLNG) + l * 512, INP(I_BLNB) + l * 512, MIX_ + (size_t)TOK * 512); }
            __syncthreads();
        }
        SEAM(p0 + 2);
        if (IN(p0 + 3)) { { FRESH(); phase_nsa(Fp, PROJ_, KCMP_, VCMP_, MIX_ + (size_t)2 * TOK * 512); __syncthreads(); }
                                   { FRESH(); phase_moba(Fp, PROJ_, KMEAN_, MIX_ + (size_t)3 * TOK * 512); __syncthreads(); } }
        SEAM(p0 + 3);
        if (IN(p0 + 4)) { FRESH(); pg8::Gemm g{MIX_, WOUT_ + (size_t)(l * 4) * DM * 512, 4 * TOK, 4 * DM, 512}; epi::MergeOrder S; S.init(Fp.G, Fp.bid);
            epi::EpiMergeAll E{HN_, GATES_}; pg8::gemm_phase<epi::EpiMergeAll, epi::MergeOrder, true, true>(ring, g, S, E, Fp.tid); }
        SEAM(p0 + 4);
        if (IN(p0 + 5)) { FRESH(); pg8::Gemm g{HN_, WOT_ + (size_t)l * DM * DM, TOK, DM, DM}; pg8::StaticOrder S; S.init(TOK, DM, Fp.G, Fp.bid);
            epi::EpiResid E{XIN_, XB_, MODL_ + 2048}; pg8::gemm_phase<epi::EpiResid, pg8::StaticOrder, true, true>(ring, g, S, E, Fp.tid); }
        SEAM(p0 + 5);
        if (IN(p0 + 6)) {
            { FRESH(); phase_norm_mod(Fp, XB_, INP(I_NFG) + l * DM, MODL_ + 3072, MODL_ + 4096, HN_, H8_, HS_); }
            { FRESH(); phase_peer_tables(Fp, INP(I_PU) + (size_t)l * 16384 * DM, INP(I_PV) + (size_t)l * 16384 * DM, UT_, VT_, SU_, SV_); }
        }
        SEAM(p0 + 6);
        if (IN(p0 + 7)) { FRESH(); pg8::Gemm g{HN_, WQT_ + (size_t)l * 2048 * DM, TOK, 2048, DM}; pg8::StaticOrder S; S.init(TOK, 2048, Fp.G, Fp.bid);
            epi::EpiStoreBf E{Q2_, 2048}; pg8::gemm_phase<epi::EpiStoreBf, pg8::StaticOrder, true, true>(ring, g, S, E, Fp.tid); }
        SEAM(p0 + 7);
        if (IN(p0 + 8)) { FRESH(); phase_peer_route(Fp, Q2_, SUBK_ + (size_t)l * 8 * 2 * 128 * 128, EIDX_, EW_); __syncthreads(); }
        SEAM(p0 + 8);
        if (IN(p0 + 9)) { FRESH(); phase_peer_u(Fp, H8_, HS_, UT_, SU_, EIDX_, PART_); }
        SEAM(p0 + 9);
        if (IN(p0 + 10)) { FRESH(); phase_peer_w(Fp, SV_, SU_, HS_, EIDX_, EW_, PART_, COEF_); }
        SEAM(p0 + 10);
        if (IN(p0 + 11)) { FRESH(); phase_peer_v(Fp, VT_, COEF_, XB_, MODL_ + 5120); }
        SEAM(p0 + 11);
    }
    if (IN(NPHASE - 1)) { FRESH(); phase_final_norm(Fp, XB_, INP(I_FNG), XB_); }
#undef IN
#undef SEAM
#undef WSP
}

extern "C" void kernel_launch(void* const* d_in, const int* in_sizes, int n_in, void* d_out, int out_size, void* d_ws, size_t ws_size, hipStream_t stream) {
    static int grid = 0;
    if (grid == 0) {
        if (n_in != 26 || in_sizes[0] != TOK * DM || out_size != TOK * DM || ws_size < WS_END) {
            fprintf(stderr, "kernel_launch: unexpected problem (n_in %d, in0 %d, out %d, WSP %zu); nothing launched\n", n_in, n_in > 0 ? in_sizes[0] : -1, out_size, ws_size); grid = -1; return; }
        int dev = 0, cus = 0, per_cu = 0;
        if (hipGetDevice(&dev) != hipSuccess || hipDeviceGetAttribute(&cus, hipDeviceAttributeMultiprocessorCount, dev) != hipSuccess) { grid = -1; return; }
        if (hipFuncSetAttribute((const void*)hybrid_fwd, hipFuncAttributeMaxDynamicSharedMemorySize, LDS_BYTES) != hipSuccess) { fprintf(stderr, "kernel_launch: hipFuncSetAttribute failed\n"); grid = -1; return; }
        if (hipOccupancyMaxActiveBlocksPerMultiprocessor(&per_cu, (const void*)hybrid_fwd, NTHR, LDS_BYTES) != hipSuccess || per_cu < 1)
            fprintf(stderr, "kernel_launch: note: occupancy query reports %d workgroups per CU\n", per_cu);
        (void)hipGetLastError();
        grid = cus;
    }
    if (grid < 0) return;
    if (hipMemsetAsync((char*)d_ws + WS_CTL, 0, CTL_ZERO_BYTES, stream) != hipSuccess) return;
    Args a{};
    for (int i = 0; i < 26; ++i) a.in[i] = d_in[i];
    a.out = (float*)d_out; a.ws = (unsigned char*)d_ws;
#if MK_PER_PHASE
    for (int p = 0; p < NPHASE; ++p) { a.ph_lo = p; a.ph_hi = p + 1; hipLaunchKernelGGL(hybrid_fwd, dim3(grid), dim3(NTHR), LDS_BYTES, stream, a); }
#else
    a.ph_lo = 0; a.ph_hi = NPHASE; hipLaunchKernelGGL(hybrid_fwd, dim3(grid), dim3(NTHR), LDS_BYTES, stream, a);
#endif
    const hipError_t le = hipPeekAtLastError();
    if (le != hipSuccess) fprintf(stderr, "kernel_launch: launch failed: %s\n", hipGetErrorName(le));
}
```

```cpp
#include <hip/hip_runtime.h>
#include <hip/hip_bf16.h>
#include <cstdio>
#include <cstdint>
#include <cmath>

#ifndef MK_PER_PHASE
#define MK_PER_PHASE 0
#endif

#define GAS __attribute__((address_space(1)))
#define LAS __attribute__((address_space(3)))
typedef unsigned short bf16;
typedef unsigned v4u __attribute__((ext_vector_type(4)));
typedef unsigned v2u __attribute__((ext_vector_type(2)));
typedef float f32x4 __attribute__((ext_vector_type(4)));
typedef float f32x2 __attribute__((ext_vector_type(2)));
typedef float f32x16 __attribute__((ext_vector_type(16)));
typedef short bf16x8 __attribute__((ext_vector_type(8)));
typedef short s16x4 __attribute__((ext_vector_type(4)));
typedef __bf16 bf16x2_t __attribute__((ext_vector_type(2)));

constexpr int BATCH = 8, SEQ = 2048, DM = 1024, DEPTH = 2, TOK = BATCH * SEQ;
constexpr int NP1 = 5632;
constexpr int NGT = 4096;
constexpr int NWIN = NP1 + NGT;
constexpr int C_AB = 0, C_AC = 512, C_AX = 1024, C_BA = 1536, C_BG = 2048, C_CQ = 2560, C_KC = 3072, C_VC = 3200, C_KS = 3328, C_VS = 3456, C_KW = 3584, C_VW = 3712,
              C_DQ = 3840, C_DK = 4352, C_DV = 4864, C_CG = 5376;
constexpr float NORM_EPS = 1e-6f;
constexpr float QSCALE = 0.125f * 1.4426950408889634f;

constexpr size_t MiB = 1u << 20;
constexpr size_t WS_CTL = 0, CTL_ZERO_BYTES = 64 * 1024;
constexpr size_t WS_MOD = 1 * MiB;
constexpr size_t WS_COS = 2 * MiB, WS_SIN = 4 * MiB;
constexpr size_t WS_SMALL = 6 * MiB;
constexpr size_t SM_KMEAN = 704 * 1024;
constexpr size_t SM_KCMP = 64 * 1024;
constexpr size_t SM_VCMP = 320 * 1024;
constexpr size_t SM_PBP = 576 * 1024;
constexpr size_t SM_W2T = 640 * 1024;
constexpr size_t WS_EIDX = 8 * MiB;
constexpr size_t WS_EW = 16 * MiB;
constexpr size_t WS_WIN = 24 * MiB;
constexpr size_t WS_WOUT = 62 * MiB;
constexpr size_t WS_WO = 70 * MiB;
constexpr size_t WS_WQ = 74 * MiB;
constexpr size_t WS_W1T = 82 * MiB;
constexpr size_t WS_SUBK = 84 * MiB;
constexpr size_t WS_HN = 86 * MiB;
constexpr size_t WS_MIX = 118 * MiB;
constexpr size_t WS_BIG = 182 * MiB;
constexpr size_t WS_GATES = 358 * MiB;
constexpr size_t WS_END = 486 * MiB;

constexpr int LDS_BYTES = 147456;
constexpr int RING_BYTES = 131072;
constexpr int MISC_OFF = LDS_BYTES - 256;

#define RLX_AGENT __ATOMIC_RELAXED, __HIP_MEMORY_SCOPE_AGENT
#define LDS_WAIT() asm volatile("s_waitcnt lgkmcnt(0)" ::: "memory")
#define VM_WAIT() asm volatile("s_waitcnt vmcnt(0)" ::: "memory")
__device__ __forceinline__ unsigned f2bf(float f) { unsigned u = __builtin_bit_cast(unsigned, f); return (u + 0x7fffu + ((u >> 16) & 1u)) >> 16; }
__device__ __forceinline__ float bf2f(unsigned h) { return __builtin_bit_cast(float, h << 16); }
__device__ __forceinline__ unsigned pk2(float lo, float hi) { f32x2 v = {lo, hi}; bf16x2_t b = __builtin_convertvector(v, bf16x2_t); return __builtin_bit_cast(unsigned, b); }
__device__ __forceinline__ float bflo(unsigned w) { return __builtin_bit_cast(float, w << 16); }
__device__ __forceinline__ float bfhi(unsigned w) { return __builtin_bit_cast(float, w & 0xffff0000u); }
__device__ __forceinline__ float sigmoidf_(float x) { return __builtin_amdgcn_rcpf(1.0f + __builtin_amdgcn_exp2f(x * -1.4426950408889634f)); }
__device__ __forceinline__ float gelu_erf(float x) { return 0.5f * x * (1.0f + erff(x * 0.70710678118654752f)); }
__device__ __forceinline__ float shx(float v, int m, int lane) { return __builtin_bit_cast(float, __builtin_amdgcn_ds_bpermute((lane ^ m) << 2, __builtin_bit_cast(int, v))); }
__device__ __forceinline__ unsigned shxu(unsigned v, int m, int lane) { return (unsigned)__builtin_amdgcn_ds_bpermute((lane ^ m) << 2, (int)v); }
__device__ __forceinline__ void swap32(unsigned v, unsigned& r0, unsigned& r1) { unsigned b = v; asm volatile("" : "+v"(b)); auto r = __builtin_amdgcn_permlane32_swap(v, b, false, false); r0 = r[0]; r1 = r[1]; }
__device__ __forceinline__ float other32(float v, int hi) { unsigned r0, r1; swap32(__builtin_bit_cast(unsigned, v), r0, r1); return __builtin_bit_cast(float, hi ? r0 : r1); }
__device__ __forceinline__ float add32(float v) { unsigned r0, r1; swap32(__builtin_bit_cast(unsigned, v), r0, r1); return __builtin_bit_cast(float, r0) + __builtin_bit_cast(float, r1); }
__device__ __forceinline__ float max32(float v) { unsigned r0, r1; swap32(__builtin_bit_cast(unsigned, v), r0, r1); return fmaxf(__builtin_bit_cast(float, r0), __builtin_bit_cast(float, r1)); }
__device__ __forceinline__ unsigned umax32(unsigned v) { unsigned r0, r1; swap32(v, r0, r1); return r0 > r1 ? r0 : r1; }
__device__ __forceinline__ float wave_sum(float v, int lane) {
#pragma unroll
    for (int o = 1; o < 32; o <<= 1) v += shx(v, o, lane);
    return add32(v);
}
namespace pg8 {
#define PG8_LAS __attribute__((address_space(3)))
typedef unsigned short bf16_t;
typedef short bf16x8 __attribute__((ext_vector_type(8)));
typedef float f32x4 __attribute__((ext_vector_type(4)));
typedef unsigned u32x4 __attribute__((ext_vector_type(4)));
constexpr int BM = 256, BK = 64, HALF = 128, HTB = HALF * BK * 2  , STAGE_BYTES = 8 * HTB, NXCD = 8, WGM = 8;

__host__ __device__ __forceinline__ int lds_byte(int r, int c) { const int st = (r >> 4) * 2 + (c >> 5), rr = r & 15, cc = c & 31, ob = rr * 64 + cc * 2; return st * 1024 + (ob ^ (((ob >> 9) & 1) << 5)); }
__host__ __device__ __forceinline__ void stage_rc(int b, int& R, int& C) { const int st = b / 1024, sb = b % 1024, swz = sb ^ (((sb >> 9) & 1) << 5); R = (st >> 1) * 16 + swz / 64; C = (st & 1) * 32 + (swz % 64) / 2; }
__host__ __device__ __forceinline__ int perm32(int rho) { const int n = rho >> 4, i = rho & 15; return 8 * (i >> 2) + 4 * n + (i & 3); }

struct Unit { int pm, pn; };
struct Gemm { const bf16_t* A; const bf16_t* Bt; int M, N, K; };

struct StaticOrder {
    int nM, nN, nwg, G, c;
    __host__ __device__ void init(int M, int N, int G_, int c_) { nM = M / BM; nN = N / BM; nwg = nM * nN; G = G_; c = c_; }
    __host__ __device__ bool next(int i, Unit& u) const {
        const long L = (long)i * G + c; if (L >= nwg) return false;
        int wgid = (int)L; { const int q = nwg / NXCD, r = nwg % NXCD, xcd = wgid % NXCD, off = wgid / NXCD; wgid = (xcd < r ? xcd * (q + 1) : r * (q + 1) + (xcd - r) * q) + off; }
        const int nig = WGM * nN, gid = wgid / nig, fm = gid * WGM, gsz = (nM - fm) < WGM ? (nM - fm) : WGM;
        u.pm = fm + ((wgid % nig) % gsz); u.pn = (wgid % nig) / gsz; return true;
    }
    __device__ __forceinline__ void a_ready(const Unit&) const {}
    __device__ __forceinline__ void done(const Unit&) const {}
};

__device__ __forceinline__ unsigned cvt_pk_bf16(float lo, float hi) { unsigned r; asm volatile("v_cvt_pk_bf16_f32 %0, %1, %2" : "=v"(r) : "v"(lo), "v"(hi)); return r; }
typedef float f32x2 __attribute__((ext_vector_type(2)));
template <class Epi, class Sched, bool ALIGN_EPI = false, bool SP2 = false>
__device__ __forceinline__ void gemm_phase(PG8_LAS unsigned char* lds, const Gemm g, const Sched& S, const Epi& E, const int tid) {
    const int wid = __builtin_amdgcn_readfirstlane(tid >> 6), lane = tid & 63, wr = wid >> 2, wc = wid & 3, fr = lane & 15, fq = lane >> 4;
    const int K = g.K, nt = K / BK;
    unsigned voffA[2], voffB[2];
#pragma unroll
    for (int i = 0; i < 2; ++i) { int R, C; stage_rc(tid * 16 + i * 8192, R, C); const int Rb = Epi::PERM ? ((R & ~31) + perm32(R & 31)) : R;
        voffA[i] = (unsigned)(R * K + C) * 2u; voffB[i] = (unsigned)(Rb * K + C) * 2u; }
    const size_t kstep = (size_t)(BK * 2);
    const size_t hstep = (size_t)HALF * K * 2;
    const size_t tstep = 2 * hstep;
    const unsigned ldsw = (unsigned)wid * 1024u;
    const int aoff = lds_byte(wr * 64 + fr, fq * 8), boff = lds_byte(wc * 32 + fr, fq * 8);
#define PG8_SA(b, h) (((b) * 2 + (h)) * HTB)
#define PG8_SB(b, h) ((4 + (b) * 2 + (h)) * HTB)
#define PG8_STAGE(bufoff, gbase, voff) do { _Pragma("unroll") for (int _i = 0; _i < 2; ++_i) \
        __builtin_amdgcn_global_load_lds((const unsigned*)((const char*)(gbase) + (voff)[_i]), (PG8_LAS unsigned*)(lds + (bufoff) + ldsw + _i * 8192), 16, 0, 0); } while (0)
#define PG8_LDA(dst, b, h) do { _Pragma("unroll") for (int m = 0; m < 4; ++m) _Pragma("unroll") for (int k = 0; k < 2; ++k) dst[m][k] = *(const PG8_LAS bf16x8*)(lds + PG8_SA(b, h) + aoff + m * 2048 + k * 1024); } while (0)
#define PG8_LDB(dst, b, h) do { _Pragma("unroll") for (int n = 0; n < 2; ++n) _Pragma("unroll") for (int k = 0; k < 2; ++k) dst[n][k] = *(const PG8_LAS bf16x8*)(lds + PG8_SB(b, h) + boff + n * 2048 + k * 1024); } while (0)
#define PG8_MMA(ai, bj, At, Bt) do { __builtin_amdgcn_s_setprio(1); _Pragma("unroll") for (int m = 0; m < 4; ++m) _Pragma("unroll") for (int n = 0; n < 2; ++n) _Pragma("unroll") for (int k = 0; k < 2; ++k) \
        acc[ai][bj][m][n] = __builtin_amdgcn_mfma_f32_16x16x32_bf16(Bt[n][k], At[m][k], acc[ai][bj][m][n], 0, 0, 0); __builtin_amdgcn_s_setprio(0); } while (0)
#define PG8_WAIT_V(n) asm volatile("s_waitcnt vmcnt(" #n ")" ::: "memory")
#define PG8_WAIT_L(n) asm volatile("s_waitcnt lgkmcnt(" #n ")" ::: "memory")
#define PG8_BAR __builtin_amdgcn_s_barrier()
#define PG8_SCHED __builtin_amdgcn_sched_barrier(0)
    Unit cur, nxt; int ui = 0;
    if (!S.next(0, cur)) return;
    f32x4 acc[2][2][4][2];
#pragma unroll
    for (int a = 0; a < 2; ++a)
#pragma unroll
        for (int b = 0; b < 2; ++b)
#pragma unroll
            for (int m = 0; m < 4; ++m)
#pragma unroll
                for (int n = 0; n < 2; ++n) acc[a][b][m][n] = (f32x4){0.f, 0.f, 0.f, 0.f};
    bf16x8 At[4][2], B0[2][2], B1[2][2];
    const char* cA = (const char*)g.A + (size_t)cur.pm * tstep; const char* cB = (const char*)g.Bt + (size_t)cur.pn * tstep;
    S.a_ready(cur);
    if constexpr (SP2) {
        PG8_STAGE(PG8_SB(0, 0), cB, voffB); PG8_STAGE(PG8_SB(0, 1), cB + hstep, voffB); PG8_STAGE(PG8_SA(0, 0), cA, voffA); PG8_STAGE(PG8_SA(0, 1), cA + hstep, voffA);
        if (wr == 1) PG8_BAR;
        PG8_WAIT_V(2); PG8_BAR;
        PG8_STAGE(PG8_SB(1, 0), cB + kstep, voffB); PG8_STAGE(PG8_SA(1, 0), cA + kstep, voffA); PG8_STAGE(PG8_SB(1, 1), cB + hstep + kstep, voffB);
        PG8_WAIT_V(6); PG8_BAR;
    } else {
        PG8_STAGE(PG8_SB(0, 0), cB, voffB); PG8_STAGE(PG8_SA(0, 0), cA, voffA); PG8_STAGE(PG8_SB(0, 1), cB + hstep, voffB); PG8_STAGE(PG8_SA(0, 1), cA + hstep, voffA);
        if (wr == 1) PG8_BAR;
        PG8_WAIT_V(4); PG8_BAR;
        PG8_STAGE(PG8_SB(1, 0), cB + kstep, voffB); PG8_STAGE(PG8_SA(1, 0), cA + kstep, voffA); PG8_STAGE(PG8_SB(1, 1), cB + hstep + kstep, voffB);
        PG8_WAIT_V(6); PG8_BAR;
    }
    for (;;) {
        const bool has_next = S.next(ui + 1, nxt);
        const char* nA = has_next ? (const char*)g.A + (size_t)nxt.pm * tstep : cA; const char* nB = has_next ? (const char*)g.Bt + (size_t)nxt.pn * tstep : cB;
        for (int t = 0; t < nt; t += 2) {
            const bool last = (t == nt - 2);
            const char* a1 = cA + (size_t)(t + 1) * kstep;
            const char* a2 = last ? nA : cA + (size_t)(t + 2) * kstep; const char* b2 = last ? nB : cB + (size_t)(t + 2) * kstep;
            const char* a3 = a2 + kstep; const char* b3 = b2 + kstep;
            if (last && has_next) S.a_ready(nxt);
            if constexpr (SP2) {
            PG8_LDB(B0, 0, 0); PG8_LDB(B1, 0, 1); PG8_SCHED; PG8_LDA(At, 0, 0); PG8_STAGE(PG8_SA(1, 1), a1 + hstep, voffA);
            PG8_WAIT_V(8); PG8_WAIT_L(0); PG8_BAR; PG8_MMA(0, 0, At, B0); PG8_MMA(0, 1, At, B1); PG8_BAR; PG8_SCHED;
            PG8_LDA(At, 0, 1); PG8_STAGE(PG8_SB(0, 0), b2, voffB); PG8_STAGE(PG8_SB(0, 1), b2 + hstep, voffB); PG8_STAGE(PG8_SA(0, 0), a2, voffA);
            PG8_WAIT_V(8); PG8_WAIT_L(0); PG8_BAR; PG8_MMA(1, 0, At, B0); PG8_MMA(1, 1, At, B1); PG8_BAR; PG8_SCHED;
            PG8_LDB(B0, 1, 0); PG8_LDB(B1, 1, 1); PG8_SCHED; PG8_LDA(At, 1, 0); PG8_STAGE(PG8_SA(0, 1), a2 + hstep, voffA);
            PG8_WAIT_V(8); PG8_WAIT_L(0); PG8_BAR; PG8_MMA(0, 0, At, B0); PG8_MMA(0, 1, At, B1); PG8_BAR; PG8_SCHED;
            PG8_LDA(At, 1, 1); PG8_STAGE(PG8_SB(1, 0), b3, voffB); PG8_STAGE(PG8_SB(1, 1), b3 + hstep, voffB); PG8_STAGE(PG8_SA(1, 0), a3, voffA);
            PG8_WAIT_V(8); PG8_WAIT_L(0); PG8_BAR; PG8_MMA(1, 0, At, B0); PG8_MMA(1, 1, At, B1); PG8_BAR; PG8_SCHED;
            } else {
            PG8_LDB(B0, 0, 0); PG8_SCHED; PG8_LDA(At, 0, 0); PG8_STAGE(PG8_SA(1, 1), a1 + hstep, voffA);
            PG8_WAIT_L(8); PG8_BAR; PG8_WAIT_L(0); PG8_MMA(0, 0, At, B0); PG8_BAR; PG8_SCHED;
            PG8_LDB(B1, 0, 1); PG8_STAGE(PG8_SB(0, 0), b2, voffB);
            PG8_BAR; PG8_WAIT_L(0); PG8_MMA(0, 1, At, B1); PG8_BAR;
            PG8_LDA(At, 0, 1); PG8_STAGE(PG8_SA(0, 0), a2, voffA);
            PG8_BAR; PG8_WAIT_L(0); PG8_MMA(1, 0, At, B0); PG8_BAR; PG8_SCHED;
            PG8_STAGE(PG8_SB(0, 1), b2 + hstep, voffB);
            PG8_WAIT_V(6); PG8_BAR; PG8_MMA(1, 1, At, B1); PG8_BAR;
            PG8_LDB(B0, 1, 0); PG8_SCHED; PG8_LDA(At, 1, 0); PG8_STAGE(PG8_SA(0, 1), a2 + hstep, voffA);
            PG8_WAIT_L(8); PG8_BAR; PG8_WAIT_L(0); PG8_MMA(0, 0, At, B0); PG8_BAR; PG8_SCHED;
            PG8_LDB(B1, 1, 1); PG8_STAGE(PG8_SB(1, 0), b3, voffB);
            PG8_BAR; PG8_WAIT_L(0); PG8_MMA(0, 1, At, B1); PG8_BAR;
            PG8_LDA(At, 1, 1); PG8_STAGE(PG8_SA(1, 0), a3, voffA);
            PG8_BAR; PG8_WAIT_L(0); PG8_MMA(1, 0, At, B0); PG8_BAR; PG8_SCHED;
            PG8_STAGE(PG8_SB(1, 1), b3 + hstep, voffB);
            PG8_WAIT_V(6); PG8_BAR; PG8_MMA(1, 1, At, B1); PG8_BAR;
            }
        }
        if constexpr (ALIGN_EPI) { if (wr == 0) PG8_BAR; }
        if constexpr (Epi::KEEP_ACC) { E.inplace(acc, cur, wr, wc, fr, fq); S.done(cur); }
        else if constexpr (!Epi::AFTER_DRAIN) { E(acc, cur, wr, wc, fr, fq); S.done(cur); }
        if (!has_next) break;
        if constexpr (!Epi::KEEP_ACC)
#pragma unroll
        for (int a = 0; a < 2; ++a)
#pragma unroll
            for (int b = 0; b < 2; ++b)
#pragma unroll
                for (int m = 0; m < 4; ++m)
#pragma unroll
                    for (int n = 0; n < 2; ++n) acc[a][b][m][n] = (f32x4){0.f, 0.f, 0.f, 0.f};
        cur = nxt; cA = nA; cB = nB; ++ui;
        if constexpr (ALIGN_EPI) { if (wr == 1) PG8_BAR; }
    }
    PG8_WAIT_V(0);
    if constexpr (!ALIGN_EPI) { if (wr == 0) PG8_BAR; }
    PG8_BAR;
    if constexpr (Epi::AFTER_DRAIN) { E.fused(acc, cur, wr, wc, fr, fq, lds, wid, lane); S.done(cur); }
#undef PG8_SA
#undef PG8_SB
#undef PG8_STAGE
#undef PG8_LDA
#undef PG8_LDB
#undef PG8_MMA
#undef PG8_WAIT_V
#undef PG8_WAIT_L
#undef PG8_BAR
#undef PG8_SCHED
}
}
#define XB_TMO      128
#define XB_XCNT(j)  (256  + 64 * (j))
#define XB_XSUB(j)  (1280 + 64 * (j))
#define XB_XGEN(j)  (2304 + 64 * (j))
#define XB_TOP      3328
#define XB_TOPGEN   3392
#define XB_FLAG     3408
#define XCD_BAR_WORDS 3456
#define XB_SPIN_CAP (1u << 25)

__device__ __forceinline__ unsigned xb_ld(unsigned* p)              { return __hip_atomic_load(p, __ATOMIC_RELAXED, __HIP_MEMORY_SCOPE_AGENT); }
__device__ __forceinline__ unsigned xb_add(unsigned* p, unsigned v) { return __hip_atomic_fetch_add(p, v, __ATOMIC_RELAXED, __HIP_MEMORY_SCOPE_AGENT); }
__device__ __forceinline__ unsigned xb_xcc_id() { return (unsigned)__builtin_amdgcn_s_getreg((3 << 11) | 20) & 0xFu; }
#define XB_SPIN(cond, bar) do { unsigned _sp = 0; while (cond) { __builtin_amdgcn_s_sleep(1); \
    if ((++_sp & 255u) == 0u) { if (xb_ld(&(bar)[XB_TMO])) break; if (_sp > XB_SPIN_CAP) { atomicAdd(&(bar)[XB_TMO], 1u); break; } } } } while (0)

struct XcdBarrier {
    unsigned* bar; unsigned x;
    volatile LAS unsigned* st;
};

__device__ __forceinline__ XcdBarrier xcd_barrier_post(unsigned* bar, volatile LAS unsigned* st) {
    XcdBarrier b; b.bar = bar; b.x = xb_xcc_id(); b.st = st;
    if (threadIdx.x == 0) (void)xb_add(&bar[XB_XCNT(b.x)], 1u);
    return b;
}
__device__ __forceinline__ void xcd_barrier_complete(unsigned* bar, unsigned x, unsigned& nloc, unsigned& nx, unsigned& xmask) {
    const unsigned G = gridDim.x * gridDim.y * gridDim.z;
    unsigned sum, cnt, mine, sp = 0u;
    for (;;) {
        sum = 0u; cnt = 0u; mine = 0u; xmask = 0u;
        unsigned cv[16];
        { unsigned* p0 = &bar[XB_XCNT(0)]; unsigned* p1 = &bar[XB_XCNT(8)];
          asm volatile("global_load_dword %0, %8, off sc1\n\tglobal_load_dword %1, %8, off offset:256 sc1\n\tglobal_load_dword %2, %8, off offset:512 sc1\n\tglobal_load_dword %3, %8, off offset:768 sc1\n\t"
                       "global_load_dword %4, %8, off offset:1024 sc1\n\tglobal_load_dword %5, %8, off offset:1280 sc1\n\tglobal_load_dword %6, %8, off offset:1536 sc1\n\tglobal_load_dword %7, %8, off offset:1792 sc1"
                       : "=&v"(cv[0]), "=&v"(cv[1]), "=&v"(cv[2]), "=&v"(cv[3]), "=&v"(cv[4]), "=&v"(cv[5]), "=&v"(cv[6]), "=&v"(cv[7]) : "v"(p0) : "memory");
          asm volatile("global_load_dword %0, %8, off sc1\n\tglobal_load_dword %1, %8, off offset:256 sc1\n\tglobal_load_dword %2, %8, off offset:512 sc1\n\tglobal_load_dword %3, %8, off offset:768 sc1\n\t"
                       "global_load_dword %4, %8, off offset:1024 sc1\n\tglobal_load_dword %5, %8, off offset:1280 sc1\n\tglobal_load_dword %6, %8, off offset:1536 sc1\n\tglobal_load_dword %7, %8, off offset:1792 sc1\n\ts_waitcnt vmcnt(0)"
                       : "=&v"(cv[8]), "=&v"(cv[9]), "=&v"(cv[10]), "=&v"(cv[11]), "=&v"(cv[12]), "=&v"(cv[13]), "=&v"(cv[14]), "=&v"(cv[15]) : "v"(p1) : "memory");
          asm volatile("" : "+v"(cv[0]), "+v"(cv[1]), "+v"(cv[2]), "+v"(cv[3]), "+v"(cv[4]), "+v"(cv[5]), "+v"(cv[6]), "+v"(cv[7])); }
#pragma unroll
        for (unsigned j = 0; j < 16; ++j) { const unsigned c = cv[j]; sum += c; cnt += (c > 0u) ? 1u : 0u; xmask |= (c > 0u) ? (1u << j) : 0u; mine = (j == x) ? c : mine; }
        if (sum == G) break;
        __builtin_amdgcn_s_sleep(1);
        if ((++sp & 255u) == 0u) { if (xb_ld(&bar[XB_TMO])) break; if (sp > XB_SPIN_CAP) { atomicAdd(&bar[XB_TMO], 1u); break; } }
    }
    nloc = mine > 0u ? mine : 1u; nx = cnt > 0u ? cnt : 1u;
}

__device__ __forceinline__ bool xb_flags_pending(unsigned* bar, unsigned xmask, unsigned target) {
    typedef unsigned xb_v4 __attribute__((ext_vector_type(4)));
    xb_v4 f0, f1, f2, f3; unsigned* p = &bar[XB_FLAG];
    asm volatile("global_load_dwordx4 %0, %4, off sc1\n\tglobal_load_dwordx4 %1, %4, off offset:16 sc1\n\tglobal_load_dwordx4 %2, %4, off offset:32 sc1\n\tglobal_load_dwordx4 %3, %4, off offset:48 sc1\n\ts_waitcnt vmcnt(0)"
                 : "=&v"(f0), "=&v"(f1), "=&v"(f2), "=&v"(f3) : "v"(p) : "memory");
    asm volatile("" : "+v"(f0), "+v"(f1), "+v"(f2), "+v"(f3));
    unsigned pend = 0u;
#pragma unroll
    for (int e = 0; e < 4; ++e) { pend |= (f0[e] < target) ? (1u << e) : 0u; pend |= (f1[e] < target) ? (16u << e) : 0u; pend |= (f2[e] < target) ? (256u << e) : 0u; pend |= (f3[e] < target) ? (4096u << e) : 0u; }
    return (pend & xmask) != 0u;
}
__device__ __forceinline__ void xcd_barrier(const XcdBarrier& b) {
    asm volatile("s_waitcnt vmcnt(0)" ::: "memory");
    __syncthreads();
    if (threadIdx.x == 0) {
        unsigned* bar = b.bar;
        __builtin_amdgcn_s_waitcnt(0);
        unsigned nloc = b.st[0], nx = b.st[1], xmask = b.st[3];
        if (nloc == 0u) { xcd_barrier_complete(bar, b.x, nloc, nx, xmask); b.st[0] = nloc; b.st[1] = nx; b.st[3] = xmask; }
        const unsigned round = b.st[2];
        const unsigned old = xb_add(&bar[XB_XSUB(b.x)], 1u);
        const unsigned gen = old / nloc;
        if (old + 1u == (gen + 1u) * nloc) {
            __builtin_amdgcn_fence(__ATOMIC_RELEASE, "agent");
            asm volatile("s_waitcnt vmcnt(0)" ::: "memory");
            __hip_atomic_store(&bar[XB_FLAG + b.x], round + 1u, __ATOMIC_RELAXED, __HIP_MEMORY_SCOPE_AGENT);
        }
        XB_SPIN(xb_flags_pending(bar, xmask, round + 1u), bar);
        __builtin_amdgcn_fence(__ATOMIC_ACQUIRE, "agent");
        asm volatile("s_waitcnt vmcnt(0)" ::: "memory");
        b.st[2] = round + 1u;
    }
    __syncthreads();
}

namespace epi {
using pg8::Unit; using pg8::BM; using pg8::HALF;
typedef const pg8::f32x4 (&AccRef)[2][2][4][2];

struct EpiProj1 {
    static constexpr bool PERM = true, AFTER_DRAIN = false, KEEP_ACC = false;
    bf16* O; const float* cosT; const float* sinT;
    __device__ __forceinline__ void operator()(AccRef acc, const Unit& u, int wr, int wc, int fr, int fq) const {
        const int row0 = u.pm * BM + wr * 64 + fr, colw = u.pn * BM + wc * 32;
#pragma unroll
        for (int bj = 0; bj < 2; ++bj) {
            const int hb = (colw + bj * HALF) >> 6;
            const bool rope = (hb >= 40 && hb < 50) || (hb >= 52 && hb < 54) || (hb >= 56 && hb < 58) || (hb >= 60 && hb < 76);
            const bool isq = (hb >= 40 && hb < 48) || (hb >= 60 && hb < 68);
            const float qs = isq ? QSCALE : 1.0f;
            const int jw = (wc & 1) * 16 + fq * 4;
#pragma unroll
            for (int ai = 0; ai < 2; ++ai)
#pragma unroll
                for (int m = 0; m < 4; ++m) {
                    const int row = row0 + ai * HALF + m * 16;
                    pg8::f32x4 v0 = acc[ai][bj][m][0], v1 = acc[ai][bj][m][1];
                    if (rope) {
                        const pg8::f32x4 c = *(const pg8::f32x4*)(cosT + (size_t)row * 32 + jw), s = *(const pg8::f32x4*)(sinT + (size_t)row * 32 + jw);
                        const float a0 = v0[0] * c[0] - v0[1] * s[0], a1 = v0[1] * c[0] + v0[0] * s[0], a2 = v0[2] * c[1] - v0[3] * s[1], a3 = v0[3] * c[1] + v0[2] * s[1];
                        const float b0 = v1[0] * c[2] - v1[1] * s[2], b1 = v1[1] * c[2] + v1[0] * s[2], b2 = v1[2] * c[3] - v1[3] * s[3], b3 = v1[3] * c[3] + v1[2] * s[3];
                        v0 = (pg8::f32x4){a0, a1, a2, a3} * qs; v1 = (pg8::f32x4){b0, b1, b2, b3} * qs;
                    }
                    v4u w; w.x = pk2(v0[0], v0[1]); w.y = pk2(v0[2], v0[3]); w.z = pk2(v1[0], v1[1]); w.w = pk2(v1[2], v1[3]);
                    *(v4u*)(O + (size_t)row * NP1 + colw + bj * HALF + 8 * fq) = w;
                }
        }
    }
};
struct EpiStoreBf {
    static constexpr bool PERM = true, AFTER_DRAIN = false, KEEP_ACC = false;
    bf16* O; int ldc;
    __device__ __forceinline__ void operator()(AccRef acc, const Unit& u, int wr, int wc, int fr, int fq) const {
        const int row0 = u.pm * BM + wr * 64 + fr, col0 = u.pn * BM + wc * 32 + 8 * fq;
#pragma unroll
        for (int ai = 0; ai < 2; ++ai)
#pragma unroll
            for (int m = 0; m < 4; ++m) { bf16* rowp = O + (size_t)(row0 + ai * HALF + m * 16) * ldc + col0;
#pragma unroll
                for (int bj = 0; bj < 2; ++bj) { const pg8::f32x4 v0 = acc[ai][bj][m][0], v1 = acc[ai][bj][m][1];
                    v4u w; w.x = pk2(v0[0], v0[1]); w.y = pk2(v0[2], v0[3]); w.z = pk2(v1[0], v1[1]); w.w = pk2(v1[2], v1[3]); *(v4u*)(rowp + bj * HALF) = w; } }
    }
};
__device__ __forceinline__ float gate_enc(float a) { return __builtin_fmaf(-2.0f, __builtin_amdgcn_rcpf(1.0f + __builtin_amdgcn_exp2f(a)), 1.0f); }

struct EpiGates {
    static constexpr bool PERM = true, AFTER_DRAIN = false, KEEP_ACC = false;
    unsigned char* O;
    __device__ __forceinline__ void operator()(AccRef acc, const Unit& u, int wr, int wc, int fr, int fq) const {
        const int row0 = u.pm * BM + wr * 64 + fr, col0 = u.pn * BM + wc * 32 + 8 * fq;
#pragma unroll
        for (int ai = 0; ai < 2; ++ai)
#pragma unroll
            for (int m = 0; m < 4; ++m) { unsigned char* rowp = O + (size_t)(row0 + ai * HALF + m * 16) * NGT + col0;
#pragma unroll
                for (int bj = 0; bj < 2; ++bj) { const pg8::f32x4 v0 = acc[ai][bj][m][0], v1 = acc[ai][bj][m][1];
                    v2u w; unsigned p = 0u; p = __builtin_amdgcn_cvt_pk_fp8_f32(gate_enc(v0[0]), gate_enc(v0[1]), p, false); p = __builtin_amdgcn_cvt_pk_fp8_f32(gate_enc(v0[2]), gate_enc(v0[3]), p, true); w.x = p;
                    p = 0u; p = __builtin_amdgcn_cvt_pk_fp8_f32(gate_enc(v1[0]), gate_enc(v1[1]), p, false); p = __builtin_amdgcn_cvt_pk_fp8_f32(gate_enc(v1[2]), gate_enc(v1[3]), p, true); w.y = p;
                    *(v2u*)(rowp + bj * HALF) = w; } }
    }
};
struct EpiMerge {
    static constexpr bool PERM = true, AFTER_DRAIN = false, KEEP_ACC = false;
    bf16* O; const unsigned char* G; int seg;
    __device__ __forceinline__ void operator()(AccRef acc, const Unit& u, int wr, int wc, int fr, int fq) const {
        const int row0 = u.pm * BM + wr * 64 + fr, col0 = u.pn * BM + wc * 32 + 8 * fq;
#pragma unroll
        for (int ai = 0; ai < 2; ++ai)
#pragma unroll
            for (int m = 0; m < 4; ++m) { const size_t row = (size_t)(row0 + ai * HALF + m * 16); bf16* rowp = O + row * DM + col0; const unsigned char* gp = G + row * NGT + seg * DM + col0;
#pragma unroll
                for (int bj = 0; bj < 2; ++bj) { pg8::f32x4 v0 = acc[ai][bj][m][0], v1 = acc[ai][bj][m][1];
                    const v2u g = *(const v2u*)(gp + bj * HALF);
                    const f32x2 g0 = __builtin_amdgcn_cvt_pk_f32_fp8(g.x, false), g1 = __builtin_amdgcn_cvt_pk_f32_fp8(g.x, true), g2 = __builtin_amdgcn_cvt_pk_f32_fp8(g.y, false), g3 = __builtin_amdgcn_cvt_pk_f32_fp8(g.y, true);
                    v0[0] *= 0.5f * g0.x + 0.5f; v0[1] *= 0.5f * g0.y + 0.5f; v0[2] *= 0.5f * g1.x + 0.5f; v0[3] *= 0.5f * g1.y + 0.5f;
                    v1[0] *= 0.5f * g2.x + 0.5f; v1[1] *= 0.5f * g2.y + 0.5f; v1[2] *= 0.5f * g3.x + 0.5f; v1[3] *= 0.5f * g3.y + 0.5f;
                    if (seg != 0) { const v4u o = *(const v4u*)(rowp + bj * HALF); v0[0] += bflo(o.x); v0[1] += bfhi(o.x); v0[2] += bflo(o.y); v0[3] += bfhi(o.y); v1[0] += bflo(o.z); v1[1] += bfhi(o.z); v1[2] += bflo(o.w); v1[3] += bfhi(o.w); }
                    v4u w; w.x = pk2(v0[0], v0[1]); w.y = pk2(v0[2], v0[3]); w.z = pk2(v1[0], v1[1]); w.w = pk2(v1[2], v1[3]); *(v4u*)(rowp + bj * HALF) = w; } }
    }
};
struct EpiResid {
    static constexpr bool PERM = false, AFTER_DRAIN = false, KEEP_ACC = false;
    const float* XI; float* XO; const float* gate;
    __device__ __forceinline__ void operator()(AccRef acc, const Unit& u, int wr, int wc, int fr, int fq) const {
        const int row0 = u.pm * BM + wr * 64 + fr, col0 = u.pn * BM + wc * 32 + 4 * fq;
        const float* gb = gate + (size_t)((u.pm * BM) / SEQ) * 6144 + col0;
        pg8::f32x4 gv[2][2];
#pragma unroll
        for (int bj = 0; bj < 2; ++bj)
#pragma unroll
            for (int n = 0; n < 2; ++n) gv[bj][n] = *(const pg8::f32x4*)(gb + bj * HALF + n * 16);
#pragma unroll
        for (int ai = 0; ai < 2; ++ai) { pg8::f32x4 xi[4][2][2];
#pragma unroll
            for (int m = 0; m < 4; ++m) { const size_t off = (size_t)(row0 + ai * HALF + m * 16) * DM + col0;
#pragma unroll
                for (int bj = 0; bj < 2; ++bj)
#pragma unroll
                    for (int n = 0; n < 2; ++n) xi[m][bj][n] = *(const pg8::f32x4*)(XI + off + bj * HALF + n * 16); }
            __builtin_amdgcn_sched_barrier(0);
#pragma unroll
            for (int m = 0; m < 4; ++m) { const size_t off = (size_t)(row0 + ai * HALF + m * 16) * DM + col0;
#pragma unroll
                for (int bj = 0; bj < 2; ++bj)
#pragma unroll
                    for (int n = 0; n < 2; ++n) *(pg8::f32x4*)(XO + off + bj * HALF + n * 16) = xi[m][bj][n] + gv[bj][n] * acc[ai][bj][m][n]; } }
    }
};

struct EpiProjAll {
    static constexpr bool PERM = true, AFTER_DRAIN = false, KEEP_ACC = false;
    static_assert(true, ""); EpiProj1 P; EpiGates G;
    __device__ __forceinline__ void operator()(AccRef acc, const Unit& u, int wr, int wc, int fr, int fq) const {
        if (u.pn < NP1 / BM) P(acc, u, wr, wc, fr, fq);
        else { Unit v = u; v.pn -= NP1 / BM; G(acc, v, wr, wc, fr, fq); }
    }
};
__device__ __forceinline__ void gates8w(const v2u w, float (&g)[8]) {
    const f32x2 a = __builtin_amdgcn_cvt_pk_f32_fp8(w.x, false), b = __builtin_amdgcn_cvt_pk_f32_fp8(w.x, true), c = __builtin_amdgcn_cvt_pk_f32_fp8(w.y, false), d = __builtin_amdgcn_cvt_pk_f32_fp8(w.y, true);
    g[0] = fmaxf(0.5f * a.x + 0.5f, 0x1p-10f); g[1] = fmaxf(0.5f * a.y + 0.5f, 0x1p-10f); g[2] = fmaxf(0.5f * b.x + 0.5f, 0x1p-10f); g[3] = fmaxf(0.5f * b.y + 0.5f, 0x1p-10f);
    g[4] = fmaxf(0.5f * c.x + 0.5f, 0x1p-10f); g[5] = fmaxf(0.5f * c.y + 0.5f, 0x1p-10f); g[6] = fmaxf(0.5f * d.x + 0.5f, 0x1p-10f); g[7] = fmaxf(0.5f * d.y + 0.5f, 0x1p-10f);
}
__device__ __forceinline__ void gates8(const unsigned char* p, float (&g)[8]) { gates8w(*(const v2u*)p, g); }
struct EpiMergeAll {
    static constexpr bool PERM = true, AFTER_DRAIN = false, KEEP_ACC = true;
    bf16* O; const unsigned char* G;
    __device__ __forceinline__ void operator()(AccRef, const Unit&, int, int, int, int) const {}
    __device__ __forceinline__ void inplace(pg8::f32x4 (&acc)[2][2][4][2], const Unit& u, int wr, int wc, int fr, int fq) const {
        const int seg = u.pm >> 6, pm = u.pm & 63, pn = u.pn & 3;
        const int row0 = pm * BM + wr * 64 + fr, col0 = pn * BM + wc * 32 + 8 * fq;
#pragma unroll
        for (int ai = 0; ai < 2; ++ai) {
            v2u gcw[4][2], gnw[4][2];
#pragma unroll
            for (int m = 0; m < 4; ++m) { const unsigned char* gp = G + (size_t)(row0 + ai * HALF + m * 16) * NGT + seg * DM + col0;
#pragma unroll
                for (int bj = 0; bj < 2; ++bj) { gcw[m][bj] = *(const v2u*)(gp + bj * HALF); gnw[m][bj] = seg < 3 ? *(const v2u*)(gp + DM + bj * HALF) : (v2u){0u, 0u}; } }
            __builtin_amdgcn_sched_barrier(0);
#pragma unroll
            for (int m = 0; m < 4; ++m) { const size_t row = (size_t)(row0 + ai * HALF + m * 16);
#pragma unroll
                for (int bj = 0; bj < 2; ++bj) { float gc[8]; gates8w(gcw[m][bj], gc);
                    pg8::f32x4& v0 = acc[ai][bj][m][0]; pg8::f32x4& v1 = acc[ai][bj][m][1];
                    if (seg < 3) { float gn[8]; gates8w(gnw[m][bj], gn);
#pragma unroll
                        for (int e = 0; e < 4; ++e) { v0[e] *= gc[e] * __builtin_amdgcn_rcpf(gn[e]); v1[e] *= gc[4 + e] * __builtin_amdgcn_rcpf(gn[4 + e]); } }
                    else {
#pragma unroll
                        for (int e = 0; e < 4; ++e) { v0[e] *= gc[e]; v1[e] *= gc[4 + e]; }
                        v4u w; w.x = pk2(v0[0], v0[1]); w.y = pk2(v0[2], v0[3]); w.z = pk2(v1[0], v1[1]); w.w = pk2(v1[2], v1[3]); *(v4u*)(O + row * DM + col0 + bj * HALF) = w;
                        v0 = (pg8::f32x4){0.f, 0.f, 0.f, 0.f}; v1 = (pg8::f32x4){0.f, 0.f, 0.f, 0.f}; } } } }
    }
};
struct MergeOrder {
    pg8::StaticOrder S;
    __device__ void init(int G_, int c_) { S.init(TOK, DM, G_, c_); }
    __device__ bool next(int i, Unit& u) const { Unit b; if (!S.next(i >> 2, b)) return false; const int seg = i & 3; u.pm = seg * 64 + b.pm; u.pn = seg * 4 + b.pn; return true; }
    __device__ __forceinline__ void a_ready(const Unit&) const {}
    __device__ __forceinline__ void done(const Unit&) const {}
};
}

#ifndef SBAR
#define SBAR() __builtin_amdgcn_sched_barrier(0)
#endif
constexpr int NWAVES = 8, NTHR = 512;
struct Args { const void* in[26]; float* out; unsigned char* ws; int ph_lo, ph_hi; };
enum InIdx { I_X = 0, I_C, I_POS, I_MODW, I_MODB, I_NMG, I_NFG, I_WIN, I_ACW, I_AOUT, I_BCW, I_BCB, I_BLNG, I_BLNB, I_BOUT, I_CPOS, I_CW1, I_CW2, I_COUT, I_DOUT, I_WO, I_PWQ, I_PSUB, I_PU, I_PV, I_FNG };

struct Frame {
    LAS unsigned char* lds; unsigned char* ldsg;
    int tid, lane, wave, G, bid;
    unsigned char* ws;
};
__device__ __forceinline__ int gwave(const Frame& F) { return F.bid * NWAVES + F.wave; }
__device__ __forceinline__ int ngwave(const Frame& F) { return F.G * NWAVES; }

__device__ __forceinline__ int rope_pos_of_dim(int d) { return d < 32 ? 2 * d : 2 * (d - 32) + 1; }
__device__ __forceinline__ int rope_dim_of_pos(int p) { return (p >> 1) + 32 * (p & 1); }
__device__ __forceinline__ int win_row_of_col(int n) {
    if (n < 2560) return n;
    if (n < 3072) { const int c = n - 2560; return C_CQ + (c & ~63) + rope_pos_of_dim(c & 63); }
    if (n < 3200) { const int c = n - 3072; return C_KC + (c & ~63) + rope_pos_of_dim(c & 63); }
    if (n < 3328) return C_VC + (n - 3200);
    if (n < 3456) { const int c = n - 3328; return C_KS + (c & ~63) + rope_pos_of_dim(c & 63); }
    if (n < 3584) return C_VS + (n - 3456);
    if (n < 3712) { const int c = n - 3584; return C_KW + (c & ~63) + rope_pos_of_dim(c & 63); }
    if (n < 3840) return C_VW + (n - 3712);
    if (n < 3864) return C_CG + (n - 3840);
    if (n < 4376) { const int c = n - 3864; return C_DQ + (c & ~63) + rope_pos_of_dim(c & 63); }
    if (n < 4888) { const int c = n - 4376; return C_DK + (c & ~63) + rope_pos_of_dim(c & 63); }
    if (n < 5400) return C_DV + (n - 4888);
    return NP1 + (n - 5400);
}
constexpr int TR_SCR = 17408;
template <int MODE, bool KPERM>
__device__ __forceinline__ void transpose_item(const float* W, int K, int N, bf16* WT, LAS float* scr, int item, int lane) {
    const int nblk = (N + 63) / 64, kb = item / nblk, nb = item % nblk, k0 = 64 * kb, n0 = 64 * nb;
    const int nq = (lane & 15) * 4; const bool nok = n0 + nq < N;
    f32x4 tv[16];
#pragma unroll
    for (int i = 0; i < 16; ++i) { const int kk = 4 * i + (lane >> 4); tv[i] = nok ? *(const f32x4*)(W + (size_t)(k0 + kk) * N + n0 + nq) : (f32x4){0.f, 0.f, 0.f, 0.f}; }
    SBAR();
#pragma unroll
    for (int i = 0; i < 16; ++i) { const int kk = 4 * i + (lane >> 4); const f32x4 v = tv[i];
        LAS float* d = scr + kk * 65 + nq; d[0] = v[0]; d[1] = v[1]; d[2] = v[2]; d[3] = v[3]; }
    LDS_WAIT(); asm volatile("" ::: "memory");
    const int c = lane & 7;
#pragma unroll
    for (int j = 0; j < 8; ++j) { const int n = (lane >> 3) + 8 * j;
        const int row = (MODE == 1) ? win_row_of_col(n0 + n < N ? n0 + n : 0) : (n0 + n);
        const float wsc = (MODE == 1 && row >= NP1) ? 1.4426950408889634f : 1.0f;
        float s[8];
#pragma unroll
        for (int e = 0; e < 8; ++e) { const int p = 8 * c + e; const int ks = KPERM ? rope_dim_of_pos(p) : p; s[e] = scr[ks * 65 + n] * wsc; }
        v4u o; o.x = pk2(s[0], s[1]); o.y = pk2(s[2], s[3]); o.z = pk2(s[4], s[5]); o.w = pk2(s[6], s[7]);
        if (n0 + n < N) *(v4u*)(WT + (size_t)row * K + k0 + 8 * c) = o; }
    LDS_WAIT(); asm volatile("" ::: "memory");
}
template <int MODE, bool KPERM>
__device__ __forceinline__ void transpose_matrix(const Frame& F, const float* W, int K, int N, bf16* WT, int& base) {
    LAS float* scr = (LAS float*)(F.lds + F.wave * TR_SCR);
    const int nitems = (K / 64) * ((N + 63) / 64), gw = gwave(F), NGW = ngwave(F);
    int first = (gw - base % NGW + NGW) % NGW;
    for (int it = first; it < nitems; it += NGW) transpose_item<MODE, KPERM>(W, K, N, WT, scr, it, F.lane);
    base += nitems;
}
__device__ __forceinline__ void convert_copy(const Frame& F, const float* src, bf16* dst, size_t n) {
    const size_t nth = (size_t)F.G * NTHR, t0 = (size_t)F.bid * NTHR + F.tid;
    for (size_t i = t0; i < n / 8; i += nth) { const f32x4 a = *(const f32x4*)(src + i * 8), b = *(const f32x4*)(src + i * 8 + 4);
        v4u o; o.x = pk2(a[0], a[1]); o.y = pk2(a[2], a[3]); o.z = pk2(b[0], b[1]); o.w = pk2(b[2], b[3]); *(v4u*)(dst + i * 8) = o; }
}

typedef __attribute__((address_space(4))) const Args* KArgsP;
__device__ __forceinline__ void phase_prologue(const Frame& F, KArgsP Ap) {
    unsigned char* ws = F.ws;
    int base = 0;
    for (int l = 0; l < DEPTH; ++l) {
        transpose_matrix<1, false>(F, (const float*)(GAS const void*)Ap->in[I_WIN] + (size_t)l * DM * 9496, DM, 9496, (bf16*)(ws + WS_WIN) + (size_t)l * NWIN * DM, base);
        transpose_matrix<0, false>(F, (const float*)(GAS const void*)Ap->in[I_AOUT] + (size_t)l * 512 * DM, 512, DM, (bf16*)(ws + WS_WOUT) + (size_t)(l * 4 + 0) * DM * 512, base);
        transpose_matrix<0, false>(F, (const float*)(GAS const void*)Ap->in[I_BOUT] + (size_t)l * 512 * DM, 512, DM, (bf16*)(ws + WS_WOUT) + (size_t)(l * 4 + 1) * DM * 512, base);
        transpose_matrix<0, false>(F, (const float*)(GAS const void*)Ap->in[I_COUT] + (size_t)l * 512 * DM, 512, DM, (bf16*)(ws + WS_WOUT) + (size_t)(l * 4 + 2) * DM * 512, base);
        transpose_matrix<0, false>(F, (const float*)(GAS const void*)Ap->in[I_DOUT] + (size_t)l * 512 * DM, 512, DM, (bf16*)(ws + WS_WOUT) + (size_t)(l * 4 + 3) * DM * 512, base);
        transpose_matrix<0, false>(F, (const float*)(GAS const void*)Ap->in[I_WO] + (size_t)l * DM * DM, DM, DM, (bf16*)(ws + WS_WO) + (size_t)l * DM * DM, base);
        transpose_matrix<0, false>(F, (const float*)(GAS const void*)Ap->in[I_PWQ] + (size_t)l * DM * 2048, DM, 2048, (bf16*)(ws + WS_WQ) + (size_t)l * 2048 * DM, base);
        transpose_matrix<0, true>(F, (const float*)(GAS const void*)Ap->in[I_CW1] + (size_t)(l * 2 + 0) * 2048 * 128, 2048, 128, (bf16*)(ws + WS_W1T) + (size_t)(l * 2 + 0) * 128 * 2048, base);
        transpose_matrix<0, false>(F, (const float*)(GAS const void*)Ap->in[I_CW1] + (size_t)(l * 2 + 1) * 2048 * 128, 2048, 128, (bf16*)(ws + WS_W1T) + (size_t)(l * 2 + 1) * 128 * 2048, base);
    }
    convert_copy(F, (const float*)(GAS const void*)Ap->in[I_PSUB], (bf16*)(ws + WS_SUBK), (size_t)DEPTH * 8 * 2 * 128 * 128);
    const int gt = F.bid * NTHR + F.tid, NGT_ = F.G * NTHR;
    { const float* w2 = (const float*)(GAS const void*)Ap->in[I_CW2]; bf16* w2t = (bf16*)(ws + WS_SMALL + SM_W2T);
      for (int i = gt; i < DEPTH * 2 * 64 * 128; i += NGT_) { const int k = i & 127, n = (i >> 7) & 63, lw = i >> 13; w2t[i] = (bf16)f2bf(w2[((size_t)lw * 128 + k) * 64 + n]); } }
    { const int* pos = (const int*)(GAS const void*)Ap->in[I_POS]; float* ct = (float*)(ws + WS_COS); float* st = (float*)(ws + WS_SIN);
      for (int i = gt; i < TOK * 32; i += NGT_) { const int t = i >> 5, j = i & 31;
          const float inv = 1.0f / powf(10000.0f, (float)(2 * j) / 64.0f); const float ang = (float)pos[t] * inv;
          ct[i] = (float)cos((double)ang); st[i] = (float)sin((double)ang); } }
    { const float* w1 = (const float*)(GAS const void*)Ap->in[I_CW1]; const float* cp = (const float*)(GAS const void*)Ap->in[I_CPOS]; float* pbp = (float*)(ws + WS_SMALL + SM_PBP);
      for (int i = gt; i < DEPTH * 2 * 16 * 128; i += NGT_) { const int n = i & 127, kc = (i >> 7) & 15, lw = i >> 11; float s = 0.f;
#pragma unroll 32
          for (int k = kc * 128; k < kc * 128 + 128; ++k) s += cp[(size_t)lw * 2048 + k] * w1[((size_t)lw * 2048 + k) * 128 + n];
          pbp[i] = s; } }
    __syncthreads();
    { LAS float* cond = (LAS float*)(F.lds);
      LAS float* red = (LAS float*)(F.lds + 32768);
      const float* c = (const float*)(GAS const void*)Ap->in[I_C];
      for (int i = F.tid; i < 8 * 1024; i += NTHR) { const float v = c[i]; cond[i] = v / (1.0f + __expf(-v)); }
      __syncthreads();
      for (int un = F.bid; un < DEPTH * 96; un += F.G) { const int l = un / 96, n0 = (un % 96) * 64;
          const float* mw = (const float*)(GAS const void*)Ap->in[I_MODW] + (size_t)l * DM * 6144 + n0 + F.lane;
          float acc[8];
#pragma unroll
          for (int b = 0; b < 8; ++b) acc[b] = 0.f;
#pragma unroll 32
          for (int k = F.wave * 128; k < F.wave * 128 + 128; ++k) { const float w = mw[(size_t)k * 6144];
#pragma unroll
              for (int b = 0; b < 8; ++b) acc[b] += cond[b * 1024 + k] * w; }
#pragma unroll
          for (int b = 0; b < 8; ++b) red[(F.wave * 8 + b) * 64 + F.lane] = acc[b];
          __syncthreads();
          { const int b = F.tid >> 6, n = F.tid & 63; float s = 0.f;
#pragma unroll
            for (int w = 0; w < 8; ++w) s += red[(w * 8 + b) * 64 + n];
            ((float*)(ws + WS_MOD))[((size_t)l * 8 + b) * 6144 + n0 + n] = s + ((const float*)(GAS const void*)Ap->in[I_MODB])[(size_t)l * 6144 + n0 + n]; }
          __syncthreads(); }
    }
}

__device__ __forceinline__ void phase_norm_mod(const Frame& F, const float* X, const float* g, const float* sh, const float* sc, bf16* O, unsigned char* O8 = nullptr, float* OS = nullptr) {
    const int gw = gwave(F), NGW = ngwave(F);
    f32x4 gv[4];
#pragma unroll
    for (int j = 0; j < 4; ++j) gv[j] = *(const f32x4*)(g + 4 * F.lane + 256 * j);
    for (int row0 = gw; row0 < TOK; row0 += 2 * NGW) {
        f32x4 v[2][4], scv[2][4], shv[2][4]; float s[2];
#pragma unroll
        for (int u = 0; u < 2; ++u) { const int row = row0 + u * NGW, b = row / SEQ; const float* xr = X + (size_t)row * DM + 4 * F.lane;
#pragma unroll
            for (int j = 0; j < 4; ++j) { v[u][j] = *(const f32x4*)(xr + 256 * j); scv[u][j] = *(const f32x4*)(sc + (size_t)b * 6144 + 4 * F.lane + 256 * j); shv[u][j] = *(const f32x4*)(sh + (size_t)b * 6144 + 4 * F.lane + 256 * j); } }
#pragma unroll
        for (int u = 0; u < 2; ++u) { s[u] = 0.f;
#pragma unroll
            for (int j = 0; j < 4; ++j) s[u] += (v[u][j][0] * v[u][j][0] + v[u][j][1] * v[u][j][1]) + (v[u][j][2] * v[u][j][2] + v[u][j][3] * v[u][j][3]); }
        float r[2];
#pragma unroll
        for (int u = 0; u < 2; ++u) r[u] = 1.0f / sqrtf(wave_sum(s[u], F.lane) * (1.0f / DM) + NORM_EPS);
        float mx[2] = {0.f, 0.f};
#pragma unroll
        for (int u = 0; u < 2; ++u) { const int row = row0 + u * NGW; bf16* orow = O + (size_t)row * DM + 4 * F.lane;
#pragma unroll
            for (int j = 0; j < 4; ++j) { const f32x4 y = v[u][j] * r[u] * gv[j] * (scv[u][j] + 1.0f) + shv[u][j]; v2u w; w.x = pk2(y[0], y[1]); w.y = pk2(y[2], y[3]); *(v2u*)(orow + 256 * j) = w; v[u][j] = y;
                mx[u] = fmaxf(fmaxf(mx[u], fmaxf(fabsf(y[0]), fabsf(y[1]))), fmaxf(fabsf(y[2]), fabsf(y[3]))); } }
        if (O8) {
#pragma unroll
            for (int o = 1; o < 32; o <<= 1) { mx[0] = fmaxf(mx[0], shx(mx[0], o, F.lane)); mx[1] = fmaxf(mx[1], shx(mx[1], o, F.lane)); }
#pragma unroll
            for (int u = 0; u < 2; ++u) { const int row = row0 + u * NGW; const float m = max32(mx[u]);
                const float qs = m > 0.f ? 127.0f / m : 0.f;
#pragma unroll
                for (int j = 0; j < 4; ++j) *(unsigned*)(O8 + (size_t)row * DM + 4 * F.lane + 256 * j) =
                    ((unsigned)(int)rintf(v[u][j][0] * qs) & 0xffu) | (((unsigned)(int)rintf(v[u][j][1] * qs) & 0xffu) << 8) | (((unsigned)(int)rintf(v[u][j][2] * qs) & 0xffu) << 16) | (((unsigned)(int)rintf(v[u][j][3] * qs) & 0xffu) << 24);
                if (F.lane == 0) OS[row] = m * (1.0f / 127.0f); }
        }
    }
}
__device__ __forceinline__ void phase_final_norm(const Frame& F, const float* X, const float* g, float* O) {
    const int gw = gwave(F), NGW = ngwave(F);
    f32x4 gv[4];
#pragma unroll
    for (int j = 0; j < 4; ++j) gv[j] = *(const f32x4*)(g + 4 * F.lane + 256 * j);
    for (int row0 = gw; row0 < TOK; row0 += 2 * NGW) {
        f32x4 v[2][4]; float s[2];
#pragma unroll
        for (int u = 0; u < 2; ++u) { const float* xr = X + (size_t)(row0 + u * NGW) * DM + 4 * F.lane;
#pragma unroll
            for (int j = 0; j < 4; ++j) v[u][j] = *(const f32x4*)(xr + 256 * j); }
#pragma unroll
        for (int u = 0; u < 2; ++u) { s[u] = 0.f;
#pragma unroll
            for (int j = 0; j < 4; ++j) s[u] += (v[u][j][0] * v[u][j][0] + v[u][j][1] * v[u][j][1]) + (v[u][j][2] * v[u][j][2] + v[u][j][3] * v[u][j][3]); }
#pragma unroll
        for (int u = 0; u < 2; ++u) { const float r = 1.0f / sqrtf(wave_sum(s[u], F.lane) * (1.0f / DM) + NORM_EPS);
            float* orow = O + (size_t)(row0 + u * NGW) * DM + 4 * F.lane;
#pragma unroll
            for (int j = 0; j < 4; ++j) *(f32x4*)(orow + 256 * j) = v[u][j] * r * gv[j]; }
    }
}

__device__ __forceinline__ void phase_mixer_a(const Frame& F, const bf16* P, const float* cw  , bf16* O  ) {
    const int nth = F.G * NTHR, gt = F.bid * NTHR + F.tid;
    for (int it = gt; it < (TOK / 8) * 64; it += nth) {
        const int cg = it & 63, tb = it >> 6, c0 = cg * 8, t0 = tb * 8, s0 = t0 % SEQ;
        v4u acv[10], axv[10], abv[8];
#pragma unroll
        for (int j = 0; j < 10; ++j) { const int tr = t0 - 2 + j; const bf16* r = P + (size_t)(tr > 0 ? tr : 0) * NP1; acv[j] = *(const v4u*)(r + C_AC + c0); axv[j] = *(const v4u*)(r + C_AX + c0); }
#pragma unroll
        for (int j = 0; j < 8; ++j) abv[j] = *(const v4u*)(P + (size_t)(t0 + j) * NP1 + C_AB + c0);
        float w0[8], w1[8], w2[8];
#pragma unroll
        for (int e = 0; e < 8; ++e) { w0[e] = cw[c0 + e]; w1[e] = cw[512 + c0 + e]; w2[e] = cw[1024 + c0 + e]; }
        float pm2[8], pm1[8];
#pragma unroll
        for (int j = 0; j < 2; ++j) { const v4u ac = acv[j], ax = axv[j]; const float z = (s0 - 2 + j >= 0) ? 1.0f : 0.0f;
            float pr[8]; pr[0] = bflo(ac.x) * bflo(ax.x); pr[1] = bfhi(ac.x) * bfhi(ax.x); pr[2] = bflo(ac.y) * bflo(ax.y); pr[3] = bfhi(ac.y) * bfhi(ax.y);
            pr[4] = bflo(ac.z) * bflo(ax.z); pr[5] = bfhi(ac.z) * bfhi(ax.z); pr[6] = bflo(ac.w) * bflo(ax.w); pr[7] = bfhi(ac.w) * bfhi(ax.w);
#pragma unroll
            for (int e = 0; e < 8; ++e) { if (j == 0) pm2[e] = pr[e] * z; else pm1[e] = pr[e] * z; } }
#pragma unroll
        for (int tt = 0; tt < 8; ++tt) {
            const v4u ac = acv[tt + 2], ax = axv[tt + 2], ab = abv[tt];
            float pr[8], bb[8], y[8];
            pr[0] = bflo(ac.x) * bflo(ax.x); pr[1] = bfhi(ac.x) * bfhi(ax.x); pr[2] = bflo(ac.y) * bflo(ax.y); pr[3] = bfhi(ac.y) * bfhi(ax.y);
            pr[4] = bflo(ac.z) * bflo(ax.z); pr[5] = bfhi(ac.z) * bfhi(ax.z); pr[6] = bflo(ac.w) * bflo(ax.w); pr[7] = bfhi(ac.w) * bfhi(ax.w);
            bb[0] = bflo(ab.x); bb[1] = bfhi(ab.x); bb[2] = bflo(ab.y); bb[3] = bfhi(ab.y); bb[4] = bflo(ab.z); bb[5] = bfhi(ab.z); bb[6] = bflo(ab.w); bb[7] = bfhi(ab.w);
#pragma unroll
            for (int e = 0; e < 8; ++e) { y[e] = bb[e] * (w0[e] * pm2[e] + w1[e] * pm1[e] + w2[e] * pr[e]); pm2[e] = pm1[e]; pm1[e] = pr[e]; }
            v4u o; o.x = pk2(y[0], y[1]); o.y = pk2(y[2], y[3]); o.z = pk2(y[4], y[5]); o.w = pk2(y[6], y[7]);
            *(v4u*)(O + (size_t)(t0 + tt) * 512 + c0) = o; }
    }
}

__device__ __forceinline__ void phase_mixer_b(const Frame& F, const bf16* P, const float* cw  , const float* cb, const float* lg, const float* lb, bf16* O) {
    LAS float* U = (LAS float*)F.lds;
    for (int un = F.bid; un < TOK / 32; un += F.G) {
        const int t0 = un * 32, s0 = t0 % SEQ;
        __syncthreads();
        { v4u av[8], gv[8];
#pragma unroll
          for (int j = 0; j < 8; ++j) { const int i = F.tid + j * NTHR, r = (i >> 6) < 61 ? (i >> 6) : 61, c0 = (i & 63) * 8; const int tr = t0 - 30 + r;
              const bf16* row = P + (size_t)(tr > 0 ? tr : 0) * NP1; av[j] = *(const v4u*)(row + C_BA + c0); gv[j] = *(const v4u*)(row + C_BG + c0); }
#pragma unroll
          for (int j = 0; j < 8; ++j) { const int i = F.tid + j * NTHR, r = i >> 6, c0 = (i & 63) * 8;
              if (i < 62 * 64) { const v4u a = av[j], g = gv[j]; const float z = (s0 - 30 + r >= 0) ? 1.0f : 0.0f; float u[8];
                  u[0] = bflo(a.x) * sigmoidf_(bflo(g.x)); u[1] = bfhi(a.x) * sigmoidf_(bfhi(g.x)); u[2] = bflo(a.y) * sigmoidf_(bflo(g.y)); u[3] = bfhi(a.y) * sigmoidf_(bfhi(g.y));
                  u[4] = bflo(a.z) * sigmoidf_(bflo(g.z)); u[5] = bfhi(a.z) * sigmoidf_(bfhi(g.z)); u[6] = bflo(a.w) * sigmoidf_(bflo(g.w)); u[7] = bfhi(a.w) * sigmoidf_(bfhi(g.w));
                  *(LAS f32x4*)(U + r * 512 + c0) = (f32x4){u[0], u[1], u[2], u[3]} * z; *(LAS f32x4*)(U + r * 512 + c0 + 4) = (f32x4){u[4], u[5], u[6], u[7]} * z; } } }
        __syncthreads();
        const int c0 = F.lane * 8;
        float acc[4][8];
#pragma unroll
        for (int q = 0; q < 4; ++q)
#pragma unroll
            for (int e = 0; e < 8; ++e) acc[q][e] = cb[c0 + e];
        LAS const float* Uw = U + (4 * F.wave) * 512 + c0;
        f32x4 wina[4], winb[4];
#pragma unroll
        for (int j = 0; j < 3; ++j) { wina[j] = *(LAS const f32x4*)(Uw + j * 512); winb[j] = *(LAS const f32x4*)(Uw + j * 512 + 4); }
        struct WG4 { f32x4 a[4], b[4]; };
#define MIXB_LOADW(W, kg) do { _Pragma("unroll") for (int j = 0; j < 4; ++j) { const int k_ = 4 * (kg) + j, kc_ = k_ < 31 ? k_ : 30; const float zz_ = k_ < 31 ? 1.0f : 0.0f; \
            W.a[j] = *(const f32x4*)(cw + kc_ * 512 + c0) * zz_; W.b[j] = *(const f32x4*)(cw + kc_ * 512 + c0 + 4) * zz_; } } while (0)
#define MIXB_GROUP(W, kg) do { _Pragma("unroll") for (int j = 0; j < 4; ++j) { const int k_ = 4 * (kg) + j; const int rn_ = (4 * F.wave + k_ + 3) < 62 ? (k_ + 3) : (61 - 4 * F.wave); \
            wina[(j + 3) & 3] = *(LAS const f32x4*)(Uw + rn_ * 512); winb[(j + 3) & 3] = *(LAS const f32x4*)(Uw + rn_ * 512 + 4); \
            _Pragma("unroll") for (int q = 0; q < 4; ++q) { const f32x4 ua = wina[(j + q) & 3], ub = winb[(j + q) & 3]; \
                acc[q][0] += W.a[j][0] * ua[0]; acc[q][1] += W.a[j][1] * ua[1]; acc[q][2] += W.a[j][2] * ua[2]; acc[q][3] += W.a[j][3] * ua[3]; \
                acc[q][4] += W.b[j][0] * ub[0]; acc[q][5] += W.b[j][1] * ub[1]; acc[q][6] += W.b[j][2] * ub[2]; acc[q][7] += W.b[j][3] * ub[3]; } } } while (0)
        { WG4 wA, wB; MIXB_LOADW(wA, 0);
#pragma unroll 1
          for (int kg = 0; kg < 8; kg += 2) {
              MIXB_LOADW(wB, kg + 1);
              MIXB_GROUP(wA, kg);
              if (kg + 2 < 8) MIXB_LOADW(wA, kg + 2);
              MIXB_GROUP(wB, kg + 1);
          } }
#undef MIXB_LOADW
#undef MIXB_GROUP
        const f32x4 ga = *(const f32x4*)(lg + c0), gb = *(const f32x4*)(lg + c0 + 4), ba = *(const f32x4*)(lb + c0), bb = *(const f32x4*)(lb + c0 + 4);
        float s4[4], v4[4];
#pragma unroll
        for (int q = 0; q < 4; ++q) { float s = 0.f;
#pragma unroll
            for (int e = 0; e < 8; ++e) s += acc[q][e];
            s4[q] = s; }
#pragma unroll
        for (int o = 1; o < 32; o <<= 1) { float t[4];
#pragma unroll
            for (int q = 0; q < 4; ++q) t[q] = shx(s4[q], o, F.lane);
#pragma unroll
            for (int q = 0; q < 4; ++q) s4[q] += t[q]; }
#pragma unroll
        for (int q = 0; q < 4; ++q) { const float mu = add32(s4[q]) * (1.0f / 512.0f); float v = 0.f;
#pragma unroll
            for (int e = 0; e < 8; ++e) { acc[q][e] -= mu; v += acc[q][e] * acc[q][e]; }
            v4[q] = v; }
#pragma unroll
        for (int o = 1; o < 32; o <<= 1) { float t[4];
#pragma unroll
            for (int q = 0; q < 4; ++q) t[q] = shx(v4[q], o, F.lane);
#pragma unroll
            for (int q = 0; q < 4; ++q) v4[q] += t[q]; }
#pragma unroll
        for (int q = 0; q < 4; ++q) {
            const float rs = 1.0f / sqrtf(add32(v4[q]) * (1.0f / 512.0f) + NORM_EPS);
            float y[8];
#pragma unroll
            for (int e = 0; e < 8; ++e) { const float gg = e < 4 ? ga[e] : gb[e - 4], bv = e < 4 ? ba[e] : bb[e - 4]; const float z = acc[q][e] * rs * gg + bv; y[e] = z * sigmoidf_(z); }
            v4u o; o.x = pk2(y[0], y[1]); o.y = pk2(y[2], y[3]); o.z = pk2(y[4], y[5]); o.w = pk2(y[6], y[7]);
            *(v4u*)(O + (size_t)(t0 + 4 * F.wave + q) * 512 + c0) = o; }
    }
}

__device__ __forceinline__ void phase_compress(const Frame& F, const bf16* P, const bf16* W1T  , const bf16* W2T  , const float* PBP  ,
                                               bf16* KC, bf16* VC  ) {
    LAS float* PART = (LAS float*)F.lds;
    LAS bf16* H1 = (LAS bf16*)(F.lds + 69632);
    const int lane = F.lane, r16 = lane & 15, q4 = lane >> 4, w = F.wave;
    for (int un = F.bid; un < 2 * 8 * 2 * 8; un += F.G) {
        const int nb = un & 7, g = (un >> 3) & 1, b = (un >> 4) & 7, which = un >> 7;
        const int n = nb * 16 + r16; const int nn = n < 127 ? n : 126;
        const int col0 = (which == 0 ? C_KC : C_VC) + g * 64;
        const bf16* arow = P + ((size_t)b * SEQ + nn * 16) * NP1 + col0;
        const bf16* w1 = W1T + (size_t)which * 128 * 2048;
        f32x4 acc[8];
#pragma unroll
        for (int j = 0; j < 8; ++j) acc[j] = (f32x4){0.f, 0.f, 0.f, 0.f};
#pragma unroll
        for (int half = 0; half < 2; ++half) {
            bf16x8 a[4], bb[4][8];
#pragma unroll
            for (int s4 = 0; s4 < 4; ++s4) { const int k = w * 256 + (half * 4 + s4) * 32 + q4 * 8;
                a[s4] = *(const bf16x8*)(arow + (size_t)(k >> 6) * NP1 + (k & 63));
#pragma unroll
                for (int j = 0; j < 8; ++j) bb[s4][j] = *(const bf16x8*)(w1 + (size_t)(j * 16 + r16) * 2048 + k); }
            SBAR();
#pragma unroll
            for (int s4 = 0; s4 < 4; ++s4)
#pragma unroll
                for (int j = 0; j < 8; ++j) acc[j] = __builtin_amdgcn_mfma_f32_16x16x32_bf16(a[s4], bb[s4][j], acc[j], 0, 0, 0);
        }
        __syncthreads();
#pragma unroll
        for (int j = 0; j < 8; ++j)
#pragma unroll
            for (int i = 0; i < 4; ++i) PART[(w * 16 + 4 * q4 + i) * 132 + j * 16 + r16] = acc[j][i];
        __syncthreads();
        {
            const int row = F.tid >> 5, c4 = (F.tid & 31) * 4;
            f32x4 sacc = (f32x4){0.f, 0.f, 0.f, 0.f};
#pragma unroll
            for (int ww = 0; ww < 8; ++ww) sacc += *(LAS f32x4*)(PART + (ww * 16 + row) * 132 + c4);
#pragma unroll
            for (int kc = 0; kc < 16; ++kc) sacc += *(const f32x4*)(PBP + ((size_t)which * 16 + kc) * 128 + c4);
            v2u o; o.x = pk2(gelu_erf(sacc[0]), gelu_erf(sacc[1])); o.y = pk2(gelu_erf(sacc[2]), gelu_erf(sacc[3]));
            *(LAS v2u*)(H1 + row * 136 + c4) = o;
        }
        __syncthreads();
        if (w < 4) {
            f32x4 o = (f32x4){0.f, 0.f, 0.f, 0.f};
            const bf16* w2 = W2T + (size_t)which * 64 * 128;
#pragma unroll
            for (int ks = 0; ks < 4; ++ks) { const bf16x8 a = *(LAS bf16x8*)(H1 + r16 * 136 + ks * 32 + q4 * 8);
                const bf16x8 bb = *(const bf16x8*)(w2 + (size_t)(w * 16 + r16) * 128 + ks * 32 + q4 * 8);
                o = __builtin_amdgcn_mfma_f32_16x16x32_bf16(a, bb, o, 0, 0, 0); }
            bf16* out = (which == 0 ? KC : VC) + ((size_t)(b * 2 + g) * 128) * 64;
#pragma unroll
            for (int i = 0; i < 4; ++i) { const int row = nb * 16 + 4 * q4 + i; out[(size_t)row * 64 + w * 16 + r16] = row < 127 ? (bf16)f2bf(o[i]) : (bf16)0; }
        }
    }
    __syncthreads();
}
__device__ __forceinline__ void phase_kmean(const Frame& F, const bf16* P, float* KM) {
    const int gw = gwave(F), NGW = ngwave(F), lane = F.lane, rs = lane >> 3, ch = lane & 7;
    for (int un = gw; un < 8 * 8 * 8; un += NGW) { const int h = un & 7, blk = (un >> 3) & 7, b = un >> 6;
        const bf16* base = P + ((size_t)b * SEQ + blk * 256) * NP1 + C_DK + h * 64 + ch * 8;
        float s[8];
#pragma unroll
        for (int e = 0; e < 8; ++e) s[e] = 0.f;
#pragma unroll
        for (int hb = 0; hb < 2; ++hb) { v4u vv[16];
#pragma unroll
            for (int i = 0; i < 16; ++i) vv[i] = *(const v4u*)(base + (size_t)((hb * 16 + i) * 8 + rs) * NP1);
            SBAR();
#pragma unroll
            for (int i = 0; i < 16; ++i) { const v4u v = vv[i];
                s[0] += bflo(v.x); s[1] += bfhi(v.x); s[2] += bflo(v.y); s[3] += bfhi(v.y); s[4] += bflo(v.z); s[5] += bfhi(v.z); s[6] += bflo(v.w); s[7] += bfhi(v.w); } }
#pragma unroll
        for (int e = 0; e < 8; ++e) { s[e] += shx(s[e], 8, lane); s[e] += shx(s[e], 16, lane); s[e] = add32(s[e]); }
        if (rs == 0) { float* o = KM + ((size_t)(b * 8 + blk) * 8 + h) * 64 + ch * 8;
            *(f32x4*)o = (f32x4){s[0], s[1], s[2], s[3]} * (1.0f / 256.0f); *(f32x4*)(o + 4) = (f32x4){s[4], s[5], s[6], s[7]} * (1.0f / 256.0f); }
    }
}

constexpr int KT_STRIDE = 144, VT_STRIDE = 192, KT_BYTES = 64 * KT_STRIDE, VT_BYTES = 64 * VT_STRIDE, KV_BUF = KT_BYTES + VT_BYTES;
__device__ __forceinline__ int crow(int r, int hi) { return (r & 3) + 8 * (r >> 2) + 4 * hi; }
struct AttnState { float m, l; f32x16 o0, o1; };
__device__ __forceinline__ void attn_reset(AttnState& st) { st.m = -1e30f; st.l = 0.f;
#pragma unroll
    for (int r = 0; r < 16; ++r) { st.o0[r] = 0.f; st.o1[r] = 0.f; } }
__device__ __forceinline__ s16x4 vtr(LAS const unsigned char* p) { return __builtin_bit_cast(s16x4, __builtin_amdgcn_ds_read_tr16_b64_v4i16((LAS s16x4*)p)); }

__device__ __forceinline__ void attn_scores(LAS const unsigned char* Kt, const bf16x8 (&qr)[4], f32x16& p0, f32x16& p1, int lane) {
    const int r32 = lane & 31, hi = lane >> 5;
#pragma unroll
    for (int r = 0; r < 16; ++r) { p0[r] = 0.f; p1[r] = 0.f; }
    bf16x8 ka[8];
#pragma unroll
    for (int s = 0; s < 4; ++s) { ka[2 * s] = *(LAS const bf16x8*)(Kt + r32 * KT_STRIDE + (2 * s + hi) * 16); ka[2 * s + 1] = *(LAS const bf16x8*)(Kt + (32 + r32) * KT_STRIDE + (2 * s + hi) * 16); }
    SBAR();
#pragma unroll
    for (int s = 0; s < 4; ++s) {
        p0 = __builtin_amdgcn_mfma_f32_32x32x16_bf16(ka[2 * s], qr[s], p0, 0, 0, 0);
        p1 = __builtin_amdgcn_mfma_f32_32x32x16_bf16(ka[2 * s + 1], qr[s], p1, 0, 0, 0);
    }
    SBAR();
}
struct VFrags { s16x4 lo[8], hh[8]; };
__device__ __forceinline__ void attn_vread(LAS const unsigned char* Vt, VFrags& vf, int lane) {
    const int hi = lane >> 5;
    LAS const unsigned char* vb = Vt + (4 * hi + ((lane & 15) >> 2)) * VT_STRIDE + (((lane >> 4) & 1) * 16 + 4 * (lane & 3)) * 2;
#pragma unroll
    for (int s = 0; s < 4; ++s)
#pragma unroll
        for (int db = 0; db < 2; ++db) { vf.lo[2 * s + db] = vtr(vb + (16 * s) * VT_STRIDE + db * 64); vf.hh[2 * s + db] = vtr(vb + (16 * s + 8) * VT_STRIDE + db * 64); }
    SBAR();
}
__device__ __forceinline__ void attn_pv(const VFrags& vf, const f32x16& e0, const f32x16& e1, f32x16& o0, f32x16& o1) {
    SBAR();
#pragma unroll
    for (int s = 0; s < 4; ++s) {
        v4u pw;
        if (s < 2) { pw.x = pk2(e0[8 * s + 0], e0[8 * s + 1]); pw.y = pk2(e0[8 * s + 2], e0[8 * s + 3]); pw.z = pk2(e0[8 * s + 4], e0[8 * s + 5]); pw.w = pk2(e0[8 * s + 6], e0[8 * s + 7]); }
        else { const int t = s - 2; pw.x = pk2(e1[8 * t + 0], e1[8 * t + 1]); pw.y = pk2(e1[8 * t + 2], e1[8 * t + 3]); pw.z = pk2(e1[8 * t + 4], e1[8 * t + 5]); pw.w = pk2(e1[8 * t + 6], e1[8 * t + 7]); }
        const bf16x8 pb = __builtin_bit_cast(bf16x8, pw);
#pragma unroll
        for (int db = 0; db < 2; ++db) {
            const s16x4 lo = vf.lo[2 * s + db], hh = vf.hh[2 * s + db];
            const bf16x8 a = (bf16x8){lo[0], lo[1], lo[2], lo[3], hh[0], hh[1], hh[2], hh[3]};
            if (db == 0) o0 = __builtin_amdgcn_mfma_f32_32x32x16_bf16(a, pb, o0, 0, 0, 0); else o1 = __builtin_amdgcn_mfma_f32_32x32x16_bf16(a, pb, o1, 0, 0, 0);
        }
    }
}
__device__ __forceinline__ float max3f(float a, float b, float c) { float r; asm("v_max3_f32 %0, %1, %2, %3" : "=v"(r) : "v"(a), "v"(b), "v"(c)); return r; }
__device__ __forceinline__ float mask_score(float v, int a, int b, int c) {
    const unsigned sg = (unsigned)(((a + c) | (b - c)) >> 31);
    return __builtin_bit_cast(float, (__builtin_bit_cast(unsigned, v) & ~sg) | (0xf149f2cau & sg));
}
__device__ __forceinline__ void attn_tile(LAS const unsigned char* Kt, LAS const unsigned char* Vt, const bf16x8 (&qr)[4], AttnState& st, int kmin, int kmax, int lane) {
    const int hi = lane >> 5;
    f32x16 p0, p1; attn_scores(Kt, qr, p0, p1, lane);
    VFrags vf; attn_vread(Vt, vf, lane);
    const bool none = kmax < kmin;
    if (!__all((kmin <= 0 && kmax >= 63) || none)) {
        const int a = 4 * hi - kmin, b = kmax - 4 * hi;
#pragma unroll
        for (int r = 0; r < 16; ++r) { const int c = (r & 3) + 8 * (r >> 2); p0[r] = mask_score(p0[r], a, b, c); p1[r] = mask_score(p1[r], a, b, c + 32); }
    }
    asm volatile("s_nop 15\n\ts_nop 7" : "+v"(p0), "+v"(p1));
    float mx = max3f(p0[0], p0[1], p1[0]), mx2 = max3f(p0[2], p0[3], p1[1]);
    mx = max3f(mx, p1[2], p1[3]);
#pragma unroll
    for (int r = 4; r < 16; r += 4) { mx = max3f(mx, p0[r], p0[r + 1]); mx2 = max3f(mx2, p0[r + 2], p0[r + 3]); mx = max3f(mx, p1[r], p1[r + 1]); mx2 = max3f(mx2, p1[r + 2], p1[r + 3]); }
    mx = max3f(mx, mx2, mx2);
    mx = max32(mx);
    mx = none ? -1e30f : mx;
    const bool up = mx > st.m + 8.0f;
    { const float mn = up ? mx : st.m, alpha = __builtin_amdgcn_exp2f(st.m - fmaxf(mn, -1e29f));
        st.m = mn; st.l *= alpha;
        const unsigned long long upm = __ballot(up);
#define RESC16(O) asm volatile("s_cmp_eq_u64 %[c], 0\n\ts_cbranch_scc1 .Lrs%=\n\t" \
            "v_mul_f32 %0, %0, %[a]\n\tv_mul_f32 %1, %1, %[a]\n\tv_mul_f32 %2, %2, %[a]\n\tv_mul_f32 %3, %3, %[a]\n\tv_mul_f32 %4, %4, %[a]\n\tv_mul_f32 %5, %5, %[a]\n\tv_mul_f32 %6, %6, %[a]\n\tv_mul_f32 %7, %7, %[a]\n\t" \
            "v_mul_f32 %8, %8, %[a]\n\tv_mul_f32 %9, %9, %[a]\n\tv_mul_f32 %10, %10, %[a]\n\tv_mul_f32 %11, %11, %[a]\n\tv_mul_f32 %12, %12, %[a]\n\tv_mul_f32 %13, %13, %[a]\n\tv_mul_f32 %14, %14, %[a]\n\tv_mul_f32 %15, %15, %[a]\n" \
            ".Lrs%=:" : "+v"(O[0]), "+v"(O[1]), "+v"(O[2]), "+v"(O[3]), "+v"(O[4]), "+v"(O[5]), "+v"(O[6]), "+v"(O[7]), "+v"(O[8]), "+v"(O[9]), "+v"(O[10]), "+v"(O[11]), "+v"(O[12]), "+v"(O[13]), "+v"(O[14]), "+v"(O[15]) \
            : [a] "v"(alpha), [c] "s"(upm) : "scc")
        RESC16(st.o0); RESC16(st.o1);
#undef RESC16
    }
    const float me = none ? 1e30f : fmaxf(st.m, -1e29f);
    float rs = 0.f;
#pragma unroll
    for (int r = 0; r < 16; ++r) { p0[r] = __builtin_amdgcn_exp2f(p0[r] - me); p1[r] = __builtin_amdgcn_exp2f(p1[r] - me); }
#pragma unroll
    for (int r = 0; r < 16; ++r) { rs += p0[r]; rs += p1[r]; }
    st.l += rs;
    attn_pv(vf, p0, p1, st.o0, st.o1);
}
struct KVRegs { v4u k, v; };
__device__ __forceinline__ void kv_load(KVRegs& r, const bf16* Kg, const bf16* Vg, size_t ld, int tid) {
    const int key = tid >> 3, ch = tid & 7;
    r.k = *(const v4u*)(Kg + (size_t)key * ld + ch * 8); r.v = *(const v4u*)(Vg + (size_t)key * ld + ch * 8);
}
__device__ __forceinline__ void kv_store(const KVRegs& r, LAS unsigned char* buf, int tid) {
    const int key = tid >> 3, ch = tid & 7;
    *(LAS v4u*)(buf + key * KT_STRIDE + ch * 16) = r.k; *(LAS v4u*)(buf + KT_BYTES + key * VT_STRIDE + ch * 16) = r.v;
}

__device__ __forceinline__ float attn_inv_l(const AttnState& st) { const float l = add32(st.l); return 1.0f / fmaxf(l, 1e-30f); }

#define ATTN_STREAM(Kg, Vg, ld, j0, j1, SKIP, RANGE) do { \
    int jn_ = (j0); while (jn_ < (j1) && (SKIP(jn_))) ++jn_; \
    if (jn_ < (j1)) { KVRegs kv_; kv_load(kv_, (Kg) + (size_t)jn_ * 64 * (ld), (Vg) + (size_t)jn_ * 64 * (ld), (ld), F.tid); \
        __syncthreads(); kv_store(kv_, ring, F.tid); int cur_ = 0; \
        for (;;) { const int j_ = jn_; ++jn_; while (jn_ < (j1) && (SKIP(jn_))) ++jn_; const bool more_ = jn_ < (j1); \
            if (more_) kv_load(kv_, (Kg) + (size_t)jn_ * 64 * (ld), (Vg) + (size_t)jn_ * 64 * (ld), (ld), F.tid); \
            __syncthreads(); \
            { int kmin_, kmax_; RANGE(j_, kmin_, kmax_); \
              if (__any(kmax_ >= kmin_)) attn_tile(ring + cur_ * KV_BUF, ring + cur_ * KV_BUF + KT_BYTES, qr, st, kmin_, kmax_, F.lane); } \
            if (!more_) break; \
            kv_store(kv_, ring + (cur_ ^ 1) * KV_BUF, F.tid); cur_ ^= 1; } } } while (0)

__device__ __forceinline__ void nsa_unit(const Frame& F, const bf16* P, const bf16* KC, const bf16* VC, bf16* O  , int b, int g, int i) {
    LAS unsigned char* ring = F.lds;
    LAS float* impb = (LAS float*)(F.lds + 2 * KV_BUF);
    LAS unsigned* selm = (LAS unsigned*)(F.lds + 2 * KV_BUF + 33792);
    LAS float* stash = (LAS float*)(F.lds + 2 * KV_BUF + 33792 + 256) + F.tid;
    const int lane = F.lane, r32 = lane & 31, hi = lane >> 5, hr = F.wave & 3, th = F.wave >> 2;
    const int tl = 32 * th + r32;
    const int s = 64 * i + tl;
    const size_t row = (size_t)b * SEQ + s;
    const int head = g * 4 + hr;
    bf16x8 qr[4];
#pragma unroll
    for (int d = 0; d < 4; ++d) qr[d] = *(const bf16x8*)(P + row * NP1 + C_CQ + head * 64 + d * 16 + hi * 8);
    const float g0 = sigmoidf_(bf2f(P[row * NP1 + C_CG + head])), g1 = sigmoidf_(bf2f(P[row * NP1 + C_CG + 8 + head])), g2 = sigmoidf_(bf2f(P[row * NP1 + C_CG + 16 + head]));
    AttnState st;
    {
        const bf16* Kg = KC + (size_t)(b * 2 + g) * 128 * 64; const bf16* Vg = VC + (size_t)(b * 2 + g) * 128 * 64;
        const int nmax = (s >= 31) ? ((s - 31) >> 4) : -1;
        { KVRegs kv0, kv1; kv_load(kv0, Kg, Vg, 64, F.tid); kv_load(kv1, Kg + 64 * 64, Vg + 64 * 64, 64, F.tid);
          __syncthreads();
          kv_store(kv0, ring, F.tid); kv_store(kv1, ring + KV_BUF, F.tid); }
        __syncthreads();
        attn_reset(st);
        attn_tile(ring, ring + KT_BYTES, qr, st, 0, nmax < 63 ? nmax : 63, lane);
        attn_tile(ring + KV_BUF, ring + KV_BUF + KT_BYTES, qr, st, 0, nmax - 64 < 63 ? nmax - 64 : 63, lane);
        const float inv = attn_inv_l(st);
        { const float sc = g0 * inv;
#pragma unroll
          for (int r = 0; r < 16; ++r) { stash[r * 512] = st.o0[r] * sc; stash[(16 + r) * 512] = st.o1[r] * sc; } }
        if (i >= 16) {
            float xprev = 0.f; const float mfin = st.m;
#define NSA_IMP(U, ACC, GQ) do { const float G_ = ((ACC[4 * (GQ)] + ACC[4 * (GQ) + 1]) + (ACC[4 * (GQ) + 2] + ACC[4 * (GQ) + 3])), L_ = ACC[4 * (GQ) + 3]; \
                const float x_ = other32(L_, hi); impb[(hr * 64 + tl) * 33 + 2 * (U) + hi] = G_ + (hi ? x_ : xprev); xprev = x_; } while (0)
#pragma unroll
            for (int tile = 0; tile < 2; ++tile) {
                f32x16 a0, a1; attn_scores(ring + tile * KV_BUF, qr, a0, a1, lane);
#pragma unroll
                for (int r = 0; r < 16; ++r) { const int c = (r & 3) + 8 * (r >> 2);
                    a0[r] = __builtin_amdgcn_exp2f(mask_score(a0[r], 4 * hi, nmax - 64 * tile - 4 * hi, c) - mfin) * inv; a1[r] = __builtin_amdgcn_exp2f(mask_score(a1[r], 4 * hi, nmax - 64 * tile - 4 * hi, c + 32) - mfin) * inv; }
                NSA_IMP(8 * tile + 0, a0, 0); NSA_IMP(8 * tile + 1, a0, 1); NSA_IMP(8 * tile + 2, a0, 2); NSA_IMP(8 * tile + 3, a0, 3);
                NSA_IMP(8 * tile + 4, a1, 0); NSA_IMP(8 * tile + 5, a1, 1); NSA_IMP(8 * tile + 6, a1, 2); NSA_IMP(8 * tile + 7, a1, 3);
            }
#undef NSA_IMP
        }
    }
    __syncthreads();
    unsigned mymask;
    if (i < 16) mymask = (2u << i) - 1u;
    else {
        { const int tk = F.tid >> 3, js = F.tid & 7; unsigned bits = 0u;
          float v[4];
#pragma unroll
          for (int e = 0; e < 4; ++e) { const int j = js * 4 + e; v[e] = (impb[(0 * 64 + tk) * 33 + j] + impb[(1 * 64 + tk) * 33 + j]) + (impb[(2 * 64 + tk) * 33 + j] + impb[(3 * 64 + tk) * 33 + j]); }
          int rank[4] = {0, 0, 0, 0};
          for (int jj = 1; jj <= i - 2; ++jj) { const float o = (impb[(0 * 64 + tk) * 33 + jj] + impb[(1 * 64 + tk) * 33 + jj]) + (impb[(2 * 64 + tk) * 33 + jj] + impb[(3 * 64 + tk) * 33 + jj]);
#pragma unroll
              for (int e = 0; e < 4; ++e) { const int j = js * 4 + e; rank[e] += (o > v[e] || (o == v[e] && jj < j)) ? 1 : 0; } }
#pragma unroll
          for (int e = 0; e < 4; ++e) { const int j = js * 4 + e; const bool forced = (j == 0) || (j == i) || (j == i - 1); const bool cand = (j >= 1) && (j <= i - 2);
              if (forced || (cand && rank[e] < 13)) bits |= 1u << j; }
          bits |= shxu(bits, 1, F.lane); bits |= shxu(bits, 2, F.lane); bits |= shxu(bits, 4, F.lane);
          if (js == 0) selm[tk] = bits; }
        __syncthreads();
        mymask = selm[tl];
    }
    {
        attn_reset(st);
        const bf16* Kg = P + (size_t)b * SEQ * NP1 + C_KS + g * 64; const bf16* Vg = P + (size_t)b * SEQ * NP1 + C_VS + g * 64;
#define NSA_SKIP(j) (false)
#define NSA_RANGE(j, kmin, kmax) do { kmin = 0; kmax = ((mymask >> (j)) & 1u) ? ((j) == i ? tl : 63) : -1; } while (0)
        ATTN_STREAM(Kg, Vg, (size_t)NP1, 0, i + 1, NSA_SKIP, NSA_RANGE);
#undef NSA_RANGE
        const float sc = g1 * attn_inv_l(st);
#pragma unroll
        for (int r = 0; r < 16; ++r) { stash[r * 512] += st.o0[r] * sc; stash[(16 + r) * 512] += st.o1[r] * sc; }
    }
    {
        attn_reset(st);
        const bf16* Kg = P + (size_t)b * SEQ * NP1 + C_KW + g * 64; const bf16* Vg = P + (size_t)b * SEQ * NP1 + C_VW + g * 64;
        const int jlo = i >= 8 ? i - 8 : 0; f32x16 out0, out1;
#define NSA_RANGE(j, kmin, kmax) do { const int d_ = 64 * (i - (j)) + tl; kmin = d_ - 511 > 0 ? d_ - 511 : 0; kmax = d_ < 63 ? d_ : 63; } while (0)
        ATTN_STREAM(Kg, Vg, (size_t)NP1, jlo, i + 1, NSA_SKIP, NSA_RANGE);
#undef NSA_RANGE
#undef NSA_SKIP
        const float sc = g2 * attn_inv_l(st);
#pragma unroll
        for (int r = 0; r < 16; ++r) { out0[r] = stash[r * 512] + st.o0[r] * sc; out1[r] = stash[(16 + r) * 512] + st.o1[r] * sc; }
        bf16* orow = O + row * 512 + head * 64;
#pragma unroll
        for (int gq = 0; gq < 4; ++gq) {
            v2u w0; w0.x = pk2(out0[4 * gq], out0[4 * gq + 1]); w0.y = pk2(out0[4 * gq + 2], out0[4 * gq + 3]); *(v2u*)(orow + 8 * gq + 4 * hi) = w0;
            v2u w1; w1.x = pk2(out1[4 * gq], out1[4 * gq + 1]); w1.y = pk2(out1[4 * gq + 2], out1[4 * gq + 3]); *(v2u*)(orow + 32 + 8 * gq + 4 * hi) = w1; }
    }
}
__device__ __forceinline__ void phase_nsa(const Frame& F, const bf16* P, const bf16* KC, const bf16* VC, bf16* O) {
    for (int un2 = 2 * F.bid; un2 < 512; un2 += 2 * F.G)
#pragma unroll 1
        for (int k = 0; k < 2; ++k) { const int un = un2 >> 1, ip = un & 15, g = (un >> 4) & 1, b = un >> 5; nsa_unit(F, P, KC, VC, O, b, g, k == 0 ? 31 - ip : ip); }
}

constexpr int MB_SLOTB = 8192, MB_K = 0, MB_V = 3 * MB_SLOTB, MB_WS = 6 * MB_SLOTB, MB_OST = MB_WS + 8 * 256, MB_END = MB_OST + 8 * 4096;
__device__ __forceinline__ void mb_glds16(const void* sbase, unsigned voff, unsigned lds_dst) { unsigned keep;
    asm volatile("s_mov_b32 %0, m0\n\ts_mov_b32 m0, %3\n\ts_nop 0\n\tglobal_load_lds_dwordx4 %1, %2\n\ts_mov_b32 m0, %0" : "=&s"(keep) : "v"(voff), "s"(sbase), "s"(lds_dst) : "memory"); }
__device__ __forceinline__ void mb_kload2(bf16x8* kf, LAS const unsigned char* kp, int j) { kf[2 * j] = *(LAS const bf16x8*)(kp + j * 2048); kf[2 * j + 1] = *(LAS const bf16x8*)(kp + j * 2048 + 512); }
__device__ __forceinline__ void mb_cmask(f32x16& p0, f32x16& p1, int jb, int qrel, int hi) {
    const int kb = 64 * jb + 4 * hi;
#pragma unroll
    for (int r = 0; r < 16; ++r) { const int kv = kb + (r & 3) + 8 * (r >> 2); if (kv > qrel) p0[r] = -INFINITY; if (kv + 32 > qrel) p1[r] = -INFINITY; }
}
__device__ __forceinline__ void mb_pv(f32x16* o, int vb, bf16x8 pa0, bf16x8 pa1, bf16x8 pa2, bf16x8 pa3) {
#pragma unroll
    for (int d0 = 0; d0 < 2; ++d0) { s16x4 lo[4], hh[4];
#pragma unroll
        for (int ks = 0; ks < 4; ++ks) {
            asm volatile("ds_read_b64_tr_b16 %0, %1 offset:%c2" : "=&v"(lo[ks]) : "v"(vb), "i"(d0 * 4096 + ks * 1024) : "memory");
            asm volatile("ds_read_b64_tr_b16 %0, %1 offset:%c2" : "=&v"(hh[ks]) : "v"(vb), "i"(d0 * 4096 + ks * 1024 + 512) : "memory"); }
        asm volatile("s_waitcnt lgkmcnt(0)" ::: "memory"); SBAR();
#define MB_PK(k) (bf16x8){lo[k][0], lo[k][1], lo[k][2], lo[k][3], hh[k][0], hh[k][1], hh[k][2], hh[k][3]}
        o[d0] = __builtin_amdgcn_mfma_f32_32x32x16_bf16(pa0, MB_PK(0), o[d0], 0, 0, 0);
        o[d0] = __builtin_amdgcn_mfma_f32_32x32x16_bf16(pa1, MB_PK(1), o[d0], 0, 0, 0);
        o[d0] = __builtin_amdgcn_mfma_f32_32x32x16_bf16(pa2, MB_PK(2), o[d0], 0, 0, 0);
        o[d0] = __builtin_amdgcn_mfma_f32_32x32x16_bf16(pa3, MB_PK(3), o[d0], 0, 0, 0);
#undef MB_PK
    }
}
#define MB_WAIT_BAR(N) asm volatile("s_waitcnt vmcnt(" #N ") lgkmcnt(0)\n\ts_barrier" ::: "memory")
__device__ __forceinline__ void moba_tiles(const Frame& F, const bf16* P, bf16* O, int b, int h, int qb, const bf16x8 (&qr)[4], const unsigned mymask, const unsigned um) {
    const int lane = F.lane, r32 = lane & 31, hi = lane >> 5, wid = F.wave;
    LAS unsigned char* shm = F.lds;
    const unsigned lds0 = (unsigned)(size_t)shm;
    LAS float* wsf = (LAS float*)(shm + MB_WS) + wid * 64;
    const size_t rowbase = (size_t)b * SEQ; const int q0 = qb * 256;
    const bf16* Kh = P + rowbase * NP1 + C_DK + h * 64; const bf16* Vh = P + rowbase * NP1 + C_DV + h * 64;
    const bf16* ksrc = Kh + wid * 8; const unsigned koff = (unsigned)lane * (NP1 * 2);
    const bf16* vsrc = Vh + (size_t)(16 * (wid & 3)) * NP1 + (wid >> 2) * 32; const unsigned voff = (unsigned)(lane >> 2) * (NP1 * 2) + (lane & 3) * 16;
    const unsigned kdst = lds0 + MB_K + wid * 1024, vdst = lds0 + MB_V + wid * 1024;
    const int np = __builtin_popcount(um); unsigned bl = 0u;
    { int k = 0;
#pragma unroll
      for (int n = 0; n < 8; ++n) if ((um >> n) & 1u) { bl |= (unsigned)n << (4 * k); ++k; } }
    const int NT = 4 * np + 4;
#define MB_BLK(t) ((bl >> (4 * (((t) - 1) >> 2))) & 15u)
#define MB_TJ(t) ((t) == 0 ? 4 * qb : ((t) <= 4 * np ? 4 * (int)MB_BLK(t) + (((t) - 1) & 3) : 4 * qb + (t) - 4 * np))
#define MB_SEL(t) (((t) == 0 || (t) > 4 * np) ? 0xffffffffu : (0u - ((mymask >> MB_BLK(t)) & 1u)))
#define DMA_K(t, slot) mb_glds16(ksrc + (size_t)MB_TJ(t) * 64 * NP1, koff, (unsigned)__builtin_amdgcn_readfirstlane(kdst + (slot)))
#define DMA_V(t, slot) mb_glds16(vsrc + (size_t)MB_TJ(t) * 64 * NP1, voff, (unsigned)__builtin_amdgcn_readfirstlane(vdst + (slot)))
    bf16x8 kf[8];
    LAS const unsigned char* kp0 = shm + MB_K + hi * 1024 + r32 * 16;
    LAS const unsigned char* vp0 = shm + MB_V + ((lane >> 4) & 1) * 32 + (lane & 3) * 8 + (4 * hi + ((lane & 15) >> 2)) * 64;
    DMA_K(0, 0); DMA_V(0, 0); DMA_K(1, MB_SLOTB);
    float mhat = 0.f, l_reg = 0.f; f32x16 o[2]; o[0] = f32x16{}; o[1] = f32x16{}; const f32x16 negm = f32x16{};
#define qrel (wid * 32 + (F.lane & 31))
    bool resc = false; unsigned sp = 0xffffffffu;
#define RESC() do { if (resc) { asm volatile("s_waitcnt lgkmcnt(0)" ::: "memory"); \
        _Pragma("unroll") for (int d_ = 0; d_ < 2; ++d_) _Pragma("unroll") for (int r = 0; r < 16; ++r) o[d_][r] *= wsf[crow(r, hi)]; } } while (0)
    f32x16 pA0, pA1, pB0, pB1;
    int sl_prev = 0, sl_cur = 0, sl_next = MB_SLOTB;
#define ROT() do { sl_prev = sl_cur; sl_cur = sl_next; sl_next = (sl_next == 2 * MB_SLOTB) ? 0 : sl_next + MB_SLOTB; } while (0)
    DMA_K(2, 2 * MB_SLOTB);
    MB_WAIT_BAR(3);
    { mb_kload2(kf, kp0, 0); mb_kload2(kf, kp0, 1); mb_kload2(kf, kp0, 2); mb_kload2(kf, kp0, 3);
      pA0 = __builtin_amdgcn_mfma_f32_32x32x16_bf16(kf[0], qr[0], negm, 0, 0, 0); pA1 = __builtin_amdgcn_mfma_f32_32x32x16_bf16(kf[1], qr[0], negm, 0, 0, 0);
#pragma unroll
      for (int d0 = 1; d0 < 4; ++d0) { pA0 = __builtin_amdgcn_mfma_f32_32x32x16_bf16(kf[2 * d0], qr[d0], pA0, 0, 0, 0); pA1 = __builtin_amdgcn_mfma_f32_32x32x16_bf16(kf[2 * d0 + 1], qr[d0], pA1, 0, 0, 0); } }
    mb_cmask(pA0, pA1, 0, qrel, hi);
    { float a = fmaxf(fmaxf(pA0[0], pA0[1]), pA1[0]);
#pragma unroll
      for (int r = 1; r < 16; ++r) a = fmaxf(a, r == 1 ? pA1[1] : fmaxf(pA0[r], pA1[r]));
      const float rm = max32(a); mhat = rm;
#pragma unroll
      for (int r = 0; r < 16; ++r) { pA0[r] = __builtin_amdgcn_exp2f(pA0[r] - rm); pA1[r] = __builtin_amdgcn_exp2f(pA1[r] - rm); }
    }
    MB_WAIT_BAR(0);
    DMA_K(3, 0); DMA_V(1, MB_SLOTB);
    ROT();
    mb_kload2(kf, kp0 + sl_cur, 0); mb_kload2(kf, kp0 + sl_cur, 1); mb_kload2(kf, kp0 + sl_cur, 2); mb_kload2(kf, kp0 + sl_cur, 3);
    MB_WAIT_BAR(2);
    s16x4 vlo[8], vhi[8]; v4u pw0, pw1, pw2, pw3;
#define PKW(P_, B_) (pk2(P_[B_], P_[B_ + 1]) & sp)
#define PAF(k) __builtin_bit_cast(bf16x8, pw##k)
#define VFR(i) (bf16x8){vlo[i][0], vlo[i][1], vlo[i][2], vlo[i][3], vhi[i][0], vhi[i][1], vhi[i][2], vhi[i][3]}
#define PIN(x) asm volatile("" : "+v"(x))
#define MX3(a_, b_, c_) __builtin_fmaxf(__builtin_fmaxf((a_), (b_)), (c_))
#define GAPA(MF, A0, A1, A2, A3, W0, W1, PW) do { MF; sacc += A0; sacc += A1; sacc += A2; sacc += A3; PIN(sacc); W0; W1; PIN(PW); SBAR(); } while (0)
#define EX(v_) __builtin_amdgcn_exp2f((v_) - mhat)
#define GAPB(MF, X, B_) do { MF; X[B_] = EX(X[B_]); X[B_ + 1] = EX(X[B_ + 1]); X[B_ + 2] = EX(X[B_ + 2]); X[B_ + 3] = EX(X[B_ + 3]); PIN(X); SBAR(); } while (0)
#define VRD(i) do { vlo[i] = vtr(vp_ + (((i) >> 2) * 4096 + ((i) & 3) * 1024)); vhi[i] = vtr(vp_ + (((i) >> 2) * 4096 + ((i) & 3) * 1024 + 512)); } while (0)
#define KRD(G, j) do { if (G) { mb_kload2(kf, kp0 + sl_next, j); SBAR(); } } while (0)
#define MFM(a_, b_, c_) __builtin_amdgcn_mfma_f32_32x32x16_bf16(a_, b_, c_, 0, 0, 0)
#define STEP(C0, C1, P0, P1, t, GK, GV, GL, MASK) do { SBAR(); \
    LAS const unsigned char* vp_ = vp0 + sl_prev; \
    VRD(0); SBAR(); float sacc = (P0[0] + P0[1]); \
    GAPA(C0 = MFM(kf[0], qr[0], negm), P0[2], P0[3], P0[4], P0[5],     pw0[0] = PKW(P0, 0),  pw0[1] = PKW(P0, 2),  pw0); \
    VRD(4); SBAR(); GAPA(C1 = MFM(kf[1], qr[0], negm), P0[6], P0[7], P0[8], P0[9],     pw0[2] = PKW(P0, 4),  pw0[3] = PKW(P0, 6),  pw0); \
    VRD(1); SBAR(); GAPA(C0 = MFM(kf[2], qr[1], C0),   P0[10], P0[11], P0[12], P0[13], pw1[0] = PKW(P0, 8),  pw1[1] = PKW(P0, 10), pw1); \
    VRD(5); SBAR(); GAPA(C1 = MFM(kf[3], qr[1], C1),   P0[14], P0[15], P1[0], P1[1],   pw1[2] = PKW(P0, 12), pw1[3] = PKW(P0, 14), pw1); \
    VRD(2); SBAR(); GAPA(C0 = MFM(kf[4], qr[2], C0),   P1[2], P1[3], P1[4], P1[5],     pw2[0] = PKW(P1, 0),  pw2[1] = PKW(P1, 2),  pw2); \
    VRD(6); SBAR(); GAPA(C1 = MFM(kf[5], qr[2], C1),   P1[6], P1[7], P1[8], P1[9],     pw2[2] = PKW(P1, 4),  pw2[3] = PKW(P1, 6),  pw2); \
    VRD(3); SBAR(); GAPA(C0 = MFM(kf[6], qr[3], C0),   P1[10], P1[11], P1[12], P1[13], pw3[0] = PKW(P1, 8),  pw3[1] = PKW(P1, 10), pw3); \
    VRD(7); SBAR(); GAPA(C1 = MFM(kf[7], qr[3], C1),   P1[14], P1[15], 0.f, 0.f,       pw3[2] = PKW(P1, 12), pw3[3] = PKW(P1, 14), pw3); \
    l_reg += __builtin_bit_cast(float, __builtin_bit_cast(unsigned, sacc) & sp); \
    if (GK) { DMA_K((t) + 3, sl_cur); } if (GV) { DMA_V((t) + 1, sl_next); } \
    if (MASK) { if ((t) >= NT - 3) mb_cmask(C0, C1, (t) - (NT - 4), qrel, hi); } \
    const unsigned sc_ = MB_SEL(t); \
    { float a = MX3(C0[0], C0[1], C1[0]), b_ = MX3(C0[2], C0[3], C1[1]); a = MX3(a, C1[2], C1[3]); \
      _Pragma("unroll") for (int r = 4; r < 16; r += 4) { a = MX3(a, C0[r], C0[r + 1]); b_ = MX3(b_, C0[r + 2], C0[r + 3]); a = MX3(a, C1[r], C1[r + 1]); b_ = MX3(b_, C1[r + 2], C1[r + 3]); } \
      float rm = max32(__builtin_fmaxf(a, b_)) - mhat; rm = sc_ ? rm : -INFINITY;        \
      resc = false; \
      if (__builtin_expect(__any(rm > 8.0f), 0)) { const float dl = __builtin_fmaxf(rm, 0.f); mhat += dl; \
        const float f = __builtin_amdgcn_exp2f(-dl); l_reg *= f; if (hi == 0) wsf[r32] = f; resc = true; } } \
    SBAR(); sp = sc_; \
    GAPB(o[0] = MFM(PAF(0), VFR(0), o[0]), C0, 0); \
    GAPB(o[1] = MFM(PAF(0), VFR(4), o[1]), C0, 4); \
    KRD(GL, 0); GAPB(o[0] = MFM(PAF(1), VFR(1), o[0]), C0, 8); \
    KRD(GL, 1); GAPB(o[1] = MFM(PAF(1), VFR(5), o[1]), C0, 12); \
    KRD(GL, 2); GAPB(o[0] = MFM(PAF(2), VFR(2), o[0]), C1, 0); \
    KRD(GL, 3); GAPB(o[1] = MFM(PAF(2), VFR(6), o[1]), C1, 4); \
    GAPB(o[0] = MFM(PAF(3), VFR(3), o[0]), C1, 8); \
    GAPB(o[1] = MFM(PAF(3), VFR(7), o[1]), C1, 12); \
    } while (0)
    int t = 1;
    for (; t + 5 < NT; t += 2) {
        STEP(pB0, pB1, pA0, pA1, t, true, true, true, false);     MB_WAIT_BAR(2); RESC(); ROT();
        STEP(pA0, pA1, pB0, pB1, t + 1, true, true, true, false); MB_WAIT_BAR(2); RESC(); ROT();
    }
#define ENDW(tt) do { if ((tt) + 3 < NT) { MB_WAIT_BAR(2); } else if ((tt) + 2 < NT) { MB_WAIT_BAR(1); } else { MB_WAIT_BAR(0); } } while (0)
    for (; t + 1 < NT; t += 2) {
        STEP(pB0, pB1, pA0, pA1, t, (t + 3 < NT), (t + 1 < NT), (t + 1 < NT), true);         ENDW(t);     RESC(); ROT();
        STEP(pA0, pA1, pB0, pB1, t + 1, (t + 4 < NT), (t + 2 < NT), (t + 2 < NT), true);     ENDW(t + 1); RESC(); ROT();
    }
    STEP(pB0, pB1, pA0, pA1, NT - 1, false, false, false, true); RESC();
    { float sacc = pB0[0] + pB0[1];
#pragma unroll
      for (int r = 2; r < 16; ++r) sacc += pB0[r];
#pragma unroll
      for (int r = 0; r < 16; ++r) sacc += pB1[r];
      l_reg += __builtin_bit_cast(float, __builtin_bit_cast(unsigned, sacc) & sp);
      pw0 = (v4u){PKW(pB0, 0), PKW(pB0, 2), PKW(pB0, 4), PKW(pB0, 6)}; pw1 = (v4u){PKW(pB0, 8), PKW(pB0, 10), PKW(pB0, 12), PKW(pB0, 14)};
      pw2 = (v4u){PKW(pB1, 0), PKW(pB1, 2), PKW(pB1, 4), PKW(pB1, 6)}; pw3 = (v4u){PKW(pB1, 8), PKW(pB1, 10), PKW(pB1, 12), PKW(pB1, 14)};
      SBAR(); mb_pv(o, (int)(unsigned)(size_t)vp0 + sl_cur, PAF(0), PAF(1), PAF(2), PAF(3)); }
    l_reg = add32(l_reg);
    if (hi == 0) wsf[32 + r32] = l_reg; asm volatile("s_waitcnt lgkmcnt(0)" ::: "memory");
    float rli[16];
#pragma unroll
    for (int r = 0; r < 16; ++r) rli[r] = __builtin_amdgcn_rcpf(wsf[32 + crow(r, hi)]);
    bf16* Ow = O + (rowbase + q0 + wid * 32) * 512 + h * 64; LAS bf16* stg = (LAS bf16*)(shm + MB_OST) + wid * 2048;
#pragma unroll
    for (int r = 0; r < 16; ++r) { const int orow = crow(r, hi);
#pragma unroll
        for (int d0 = 0; d0 < 2; ++d0) stg[orow * 64 + d0 * 32 + r32] = (bf16)f2bf(o[d0][r] * rli[r]); }
    asm volatile("s_waitcnt lgkmcnt(0)" ::: "memory");
#pragma unroll
    for (int i = 0; i < 4; ++i) { const int row = i * 8 + (lane >> 3), ch = lane & 7; *(v4u*)(Ow + (size_t)row * 512 + ch * 8) = *(LAS const v4u*)(stg + row * 64 + ch * 8); }
    asm volatile("s_waitcnt lgkmcnt(0)\n\ts_barrier" ::: "memory");
#undef qrel
#undef MB_BLK
#undef MB_TJ
#undef MB_SEL
#undef DMA_K
#undef DMA_V
#undef RESC
#undef ROT
#undef PKW
#undef PAF
#undef VFR
#undef PIN
#undef MX3
#undef GAPA
#undef EX
#undef GAPB
#undef VRD
#undef KRD
#undef MFM
#undef STEP
#undef ENDW
}
__device__ __forceinline__ void moba_unit(const Frame& F, const bf16* P, const float* KM, bf16* O  , int b, int h, int qb) {
    LAS float* kml = (LAS float*)(F.lds + 86016);
    LAS unsigned* uni = (LAS unsigned*)(F.lds + 86016 + 2048);
    const int lane = F.lane, r32 = lane & 31, hi = lane >> 5;
    const int tl = 32 * F.wave + r32;
    const size_t row = (size_t)b * SEQ + 256 * qb + tl;
    bf16x8 qr[4];
#pragma unroll
    for (int d = 0; d < 4; ++d) qr[d] = *(const bf16x8*)(P + row * NP1 + C_DQ + h * 64 + d * 16 + hi * 8);
    __syncthreads();
    { const int blk = F.tid >> 6, p = F.tid & 63; kml[F.tid] = KM[((size_t)(b * 8 + blk) * 8 + h) * 64 + p]; if (F.tid == 0) uni[0] = 0u; }
    __syncthreads();
    unsigned mymask = 0u;
    if (qb > 0) {
        float gt[8];
        float qf[32];
#pragma unroll
        for (int d = 0; d < 4; ++d) { const v4u qw = __builtin_bit_cast(v4u, qr[d]);
            qf[8 * d + 0] = bflo(qw.x); qf[8 * d + 1] = bfhi(qw.x); qf[8 * d + 2] = bflo(qw.y); qf[8 * d + 3] = bfhi(qw.y); qf[8 * d + 4] = bflo(qw.z); qf[8 * d + 5] = bfhi(qw.z); qf[8 * d + 6] = bflo(qw.w); qf[8 * d + 7] = bfhi(qw.w); }
#pragma unroll
        for (int n = 0; n < 8; ++n) {
            f32x4 kv[8];
#pragma unroll
            for (int d = 0; d < 4; ++d) { const LAS f32x4* km = (const LAS f32x4*)(kml + n * 64 + d * 16 + hi * 8); kv[2 * d] = km[0]; kv[2 * d + 1] = km[1]; }
            SBAR();
            float a = 0.f;
#pragma unroll
            for (int d = 0; d < 4; ++d) a += qf[8 * d + 0] * kv[2 * d][0] + qf[8 * d + 1] * kv[2 * d][1] + qf[8 * d + 2] * kv[2 * d][2] + qf[8 * d + 3] * kv[2 * d][3]
                                           + qf[8 * d + 4] * kv[2 * d + 1][0] + qf[8 * d + 5] * kv[2 * d + 1][1] + qf[8 * d + 6] * kv[2 * d + 1][2] + qf[8 * d + 7] * kv[2 * d + 1][3];
            a = add32(a); gt[n] = a; }
#pragma unroll
        for (int n = 0; n < 8; ++n) { int rank = 0;
#pragma unroll
            for (int m = 0; m < 8; ++m) if (m != n) { const bool ahead = (m < n) ? (gt[m] >= gt[n]) : (gt[m] > gt[n]); rank += ((m < qb) & ahead) ? 1 : 0; }
            mymask |= ((n < qb) & (rank < 3)) ? (1u << n) : 0u; }
        atomicOr((unsigned*)uni, mymask);
    }
    __syncthreads();
    const unsigned um = (unsigned)__builtin_amdgcn_readfirstlane((int)uni[0]);
    VM_WAIT();
    moba_tiles(F, P, O, b, h, qb, qr, mymask, um);
}
__device__ __forceinline__ void phase_moba(const Frame& F, const bf16* P, const float* KM, bf16* O) {
    for (int un2 = 2 * F.bid; un2 < 512; un2 += 2 * F.G)
#pragma unroll 1
        for (int k = 0; k < 2; ++k) { const int un = un2 >> 1, qp = un & 3, h = (un >> 2) & 7, b = un >> 5; moba_unit(F, P, KM, O, b, h, k == 0 ? 7 - qp : qp); }
}

__device__ __forceinline__ unsigned ord_key(float x) { const unsigned u = __builtin_bit_cast(unsigned, x); return (u & 0x80000000u) ? ~u : (u | 0x80000000u); }
__device__ __forceinline__ float ord_val(unsigned k) { const unsigned u = (k & 0x80000000u) ? (k & 0x7fffffffu) : ~k; return __builtin_bit_cast(float, u); }
__device__ __forceinline__ void ce_desc(unsigned& a, unsigned& b) { const unsigned hi_ = a > b ? a : b, lo_ = a > b ? b : a; a = hi_; b = lo_; }
__device__ __forceinline__ void bitonic_merge16_desc(unsigned* a) {
#pragma unroll
    for (int j = 8; j > 0; j >>= 1)
#pragma unroll
        for (int i = 0; i < 16; ++i) if ((i & j) == 0) ce_desc(a[i], a[i | j]);
}
__device__ __forceinline__ void bitonic_sort16_desc(unsigned* a) {
    ce_desc(a[0], a[1]); ce_desc(a[2], a[3]); ce_desc(a[0], a[2]); ce_desc(a[1], a[3]); ce_desc(a[1], a[2]); ce_desc(a[4], a[5]); ce_desc(a[6], a[7]); ce_desc(a[4], a[6]); ce_desc(a[5], a[7]); ce_desc(a[5], a[6]); ce_desc(a[0], a[4]); ce_desc(a[2], a[6]); ce_desc(a[2], a[4]); ce_desc(a[1], a[5]); ce_desc(a[3], a[7]); ce_desc(a[3], a[5]); ce_desc(a[1], a[2]); ce_desc(a[3], a[4]); ce_desc(a[5], a[6]); ce_desc(a[8], a[9]); ce_desc(a[10], a[11]); ce_desc(a[8], a[10]); ce_desc(a[9], a[11]); ce_desc(a[9], a[10]); ce_desc(a[12], a[13]); ce_desc(a[14], a[15]); ce_desc(a[12], a[14]); ce_desc(a[13], a[15]); ce_desc(a[13], a[14]); ce_desc(a[8], a[12]); ce_desc(a[10], a[14]); ce_desc(a[10], a[12]); ce_desc(a[9], a[13]); ce_desc(a[11], a[15]); ce_desc(a[11], a[13]); ce_desc(a[9], a[10]); ce_desc(a[11], a[12]); ce_desc(a[13], a[14]); ce_desc(a[0], a[8]); ce_desc(a[4], a[12]); ce_desc(a[4], a[8]); ce_desc(a[2], a[10]); ce_desc(a[6], a[14]); ce_desc(a[6], a[10]); ce_desc(a[2], a[4]); ce_desc(a[6], a[8]); ce_desc(a[10], a[12]); ce_desc(a[1], a[9]); ce_desc(a[5], a[13]); ce_desc(a[5], a[9]); ce_desc(a[3], a[11]); ce_desc(a[7], a[15]); ce_desc(a[7], a[11]); ce_desc(a[3], a[5]); ce_desc(a[7], a[9]); ce_desc(a[11], a[13]); ce_desc(a[1], a[2]); ce_desc(a[3], a[4]); ce_desc(a[5], a[6]); ce_desc(a[7], a[8]); ce_desc(a[9], a[10]); ce_desc(a[11], a[12]); ce_desc(a[13], a[14]);
}
__device__ __forceinline__ void merge_top16(unsigned* a, const unsigned* b) {
#pragma unroll
    for (int i = 0; i < 16; ++i) a[i] = a[i] > b[15 - i] ? a[i] : b[15 - i];
    bitonic_merge16_desc(a);
}
constexpr int SK_STRIDE = 272;
__device__ __forceinline__ void peer_route_unit(const Frame& F, const bf16* Q2, const bf16* SUBK  , int* EIDX, float* EW, int tb, int h) {
    LAS unsigned char* skl = F.lds;
    LAS unsigned* slot = (LAS unsigned*)(F.lds + 36864) + F.tid;
    const int lane = F.lane, r32 = lane & 31, hi = lane >> 5;
    const size_t tok = (size_t)tb * 256 + F.wave * 32 + r32;
#pragma unroll 1
    for (int p = 0; p < 2; ++p) {
        __syncthreads();
        { v4u sk[4];
#pragma unroll
          for (int j = 0; j < 4; ++j) { const int i = F.tid + j * NTHR, ch = i & 15, rowi = i >> 4; sk[j] = *(const v4u*)(SUBK + ((size_t)h * 256 + p * 128 + rowi) * 128 + ch * 8); }
#pragma unroll
          for (int j = 0; j < 4; ++j) { const int i = F.tid + j * NTHR, ch = i & 15, rowi = i >> 4; *(LAS v4u*)(skl + rowi * SK_STRIDE + ch * 16) = sk[j]; } }
        __syncthreads();
        bf16x8 qf[8]; float ss = 0.f;
#pragma unroll
        for (int s = 0; s < 8; ++s) { qf[s] = *(const bf16x8*)(Q2 + tok * 2048 + h * 256 + p * 128 + s * 16 + hi * 8); const v4u w = __builtin_bit_cast(v4u, qf[s]);
            const float a0 = bflo(w.x), a1 = bfhi(w.x), a2 = bflo(w.y), a3 = bfhi(w.y), a4 = bflo(w.z), a5 = bfhi(w.z), a6 = bflo(w.w), a7 = bfhi(w.w);
            ss += (a0 * a0 + a1 * a1) + (a2 * a2 + a3 * a3) + (a4 * a4 + a5 * a5) + (a6 * a6 + a7 * a7); }
        ss = add32(ss);
        const float rn = 1.0f / sqrtf(ss * (1.0f / 128.0f) + NORM_EPS);
        unsigned key[64];
#pragma unroll
        for (int nb = 0; nb < 4; ++nb) { f32x16 acc;
#pragma unroll
            for (int r = 0; r < 16; ++r) acc[r] = 0.f;
#pragma unroll
            for (int sh = 0; sh < 2; ++sh) { bf16x8 sa[4];
#pragma unroll
                for (int s = 0; s < 4; ++s) sa[s] = *(LAS const bf16x8*)(skl + (nb * 32 + r32) * SK_STRIDE + (2 * (4 * sh + s) + hi) * 16);
                __builtin_amdgcn_sched_barrier(0);
#pragma unroll
                for (int s = 0; s < 4; ++s) acc = __builtin_amdgcn_mfma_f32_32x32x16_bf16(sa[s], qf[4 * sh + s], acc, 0, 0, 0); }
#pragma unroll
            for (int r = 0; r < 16; ++r) { const int n = nb * 32 + crow(r, hi); key[nb * 16 + r] = (ord_key(acc[r] * rn) & 0xffffff80u) | (unsigned)(127 - n); } }
#pragma unroll
        for (int blk = 0; blk < 4; ++blk) bitonic_sort16_desc(key + 16 * blk);
        merge_top16(key, key + 16); merge_top16(key + 32, key + 48); merge_top16(key, key + 32);
        { unsigned oth[16];
#pragma unroll
          for (int i = 0; i < 16; ++i) { unsigned r0, r1; swap32(key[i], r0, r1); oth[i] = hi ? r0 : r1; }
          merge_top16(key, oth); }
#pragma unroll
        for (int k = 0; k < 16; ++k) slot[(p * 16 + k) * 512] = key[k];
    }
    LDS_WAIT(); asm volatile("" ::: "memory");
    unsigned ck[64];
    { float v1[16], v2[16];
#pragma unroll
      for (int k = 0; k < 16; ++k) { v1[k] = ord_val(slot[k * 512] & 0xffffff80u); v2[k] = ord_val(slot[(16 + k) * 512] & 0xffffff80u); }
      int c = 0;
#pragma unroll
      for (int a = 0; a < 16; ++a)
#pragma unroll
          for (int bq = 0; bq < 16; ++bq) if ((a + 1) * (bq + 1) <= 16) { ck[c] = (ord_key(v1[a] + v2[bq]) & 0xffffff00u) | (unsigned)(255 - (16 * a + bq)); ++c; }
#pragma unroll
      for (int q = 50; q < 64; ++q) ck[q] = 0u; }
#pragma unroll
    for (int blk = 0; blk < 4; ++blk) bitonic_sort16_desc(ck + 16 * blk);
    merge_top16(ck, ck + 16); merge_top16(ck + 32, ck + 48); merge_top16(ck, ck + 32);
    float den = 0.f; const float mx = ord_val(ck[0] & 0xffffff00u);
#pragma unroll
    for (int k = 0; k < 16; ++k) { const unsigned m = ck[k];
        const int ci = 255 - (int)(m & 255u), a = ci >> 4, bq = ci & 15;
        const unsigned ka = slot[a * 512], kb = slot[(16 + bq) * 512];
        const int te = (127 - (int)(ka & 127u)) * 128 + (127 - (int)(kb & 127u));
        const float ek = __expf(ord_val(m & 0xffffff00u) - mx); den += ek;
        slot[(32 + k) * 512] = __builtin_bit_cast(unsigned, ek);
        if (hi == 0) EIDX[(tok * 8 + h) * 16 + k] = te; }
    LDS_WAIT(); asm volatile("" ::: "memory");
    if (hi == 0) { const float inv = 1.0f / den; float* ewp = EW + (tok * 8 + h) * 16;
#pragma unroll
        for (int q = 0; q < 4; ++q) *(f32x4*)(ewp + 4 * q) = (f32x4){__builtin_bit_cast(float, slot[(32 + 4 * q) * 512]), __builtin_bit_cast(float, slot[(33 + 4 * q) * 512]),
                                                                      __builtin_bit_cast(float, slot[(34 + 4 * q) * 512]), __builtin_bit_cast(float, slot[(35 + 4 * q) * 512])} * inv; }
}

__device__ __forceinline__ void phase_peer_route(const Frame& F, const bf16* Q2, const bf16* SUBK, int* EIDX, float* EW) {
    for (int un = F.bid; un < 64 * 8; un += F.G) peer_route_unit(F, Q2, SUBK, EIDX, EW, un >> 3, un & 7);
}

__device__ __forceinline__ void phase_peer_tables(const Frame& F, const float* U, const float* V, unsigned char* UT8, unsigned char* VT8, float* SU, float* SV) {
    const int gw = gwave(F), NGW = ngwave(F), lane = F.lane;
    for (int r = gw; r < 2 * 16384; r += NGW) {
        const int tab = r >> 14, e = r & 16383; const float* src = (tab ? V : U) + (size_t)e * DM + 16 * lane;
        f32x4 x[4]; float mx = 0.f;
#pragma unroll
        for (int q = 0; q < 4; ++q) { x[q] = *(const f32x4*)(src + 4 * q); mx = fmaxf(fmaxf(mx, fmaxf(fabsf(x[q][0]), fabsf(x[q][1]))), fmaxf(fabsf(x[q][2]), fabsf(x[q][3]))); }
#pragma unroll
        for (int o = 1; o < 32; o <<= 1) mx = fmaxf(mx, shx(mx, o, lane));
        mx = max32(mx);
        int ex = 0; (void)frexpf(mx, &ex);
        const int k = (mx > 0.f) ? (8 - ex) : 0;
        const float sc = __builtin_ldexpf(1.0f, k), inv = __builtin_ldexpf(1.0f, -k);
        v4u w; float rowscale = inv;
        if (tab) {
#pragma unroll
            for (int q = 0; q < 4; ++q) { unsigned p = 0u; p = __builtin_amdgcn_cvt_pk_fp8_f32(x[q][0] * sc, x[q][1] * sc, p, false); p = __builtin_amdgcn_cvt_pk_fp8_f32(x[q][2] * sc, x[q][3] * sc, p, true); w[q] = p; }
        } else {
            const float qs = mx > 0.f ? 127.0f / mx : 0.f; rowscale = mx > 0.f ? mx * (1.0f / 127.0f) : 0.f;
#pragma unroll
            for (int q = 0; q < 4; ++q) w[q] = ((unsigned)(int)rintf(x[q][0] * qs) & 0xffu) | (((unsigned)(int)rintf(x[q][1] * qs) & 0xffu) << 8) | (((unsigned)(int)rintf(x[q][2] * qs) & 0xffu) << 16) | (((unsigned)(int)rintf(x[q][3] * qs) & 0xffu) << 24);
        }
        *(v4u*)((tab ? VT8 : UT8) + ((size_t)(lane >> 3) * 16384 + e) * 128 + (lane & 7) * 16) = w;
        if (lane == 0) SU[2 * e + tab] = rowscale;
    }
}
typedef _Float16 h16x2 __attribute__((ext_vector_type(2)));
typedef __fp16 fp16x2_t __attribute__((ext_vector_type(2)));
__device__ __forceinline__ void phase_peer_u(const Frame& F, const unsigned char* H8, const float* HS, const unsigned char* UT8, const float* SU, const int* EIDX, float* PART) {
    const int lane = F.lane, g = lane >> 3, sub = lane & 7, b0 = lane & 1, b1 = (lane >> 1) & 1, b2 = (lane >> 2) & 1;
    const int s = F.bid & 7, wgq = F.bid >> 3, nq = F.G >> 3;
    LAS int* il = (LAS int*)(F.lds + F.wave * 8192);
    LAS float* pcl = (LAS float*)(F.lds + F.wave * 8192 + 4096);
    const unsigned char* ub = UT8 + (size_t)s * 16384 * 128 + sub * 16;
    v4u ni0, ni1, ni2, ni3, nh;
#define PU_META(bt) do { const int t0_ = (bt) * 8; const v4u* src = (const v4u*)(EIDX + (size_t)t0_ * 128) + lane; ni0 = src[0]; ni1 = src[64]; ni2 = src[128]; ni3 = src[192];     \
        nh = *(const v4u*)(H8 + (size_t)(t0_ + g) * DM + s * 128 + sub * 16); } while (0)
    { const int b0_ = wgq * 8 + F.wave; if (b0_ < TOK / 8) PU_META(b0_); }
    for (int batch = wgq * 8 + F.wave; batch < TOK / 8; batch += nq * 8) {
        const int t0 = batch * 8, t = t0 + g;
        { LAS v4u* dst = (LAS v4u*)il + lane; dst[0] = ni0; dst[64] = ni1; dst[128] = ni2; dst[192] = ni3; }
        const v4u h = nh;
        if (batch + nq * 8 < TOK / 8) PU_META(batch + nq * 8);
        LDS_WAIT(); asm volatile("" ::: "memory");
#define PU_LOAD(c, ua, su_) do { const v4u ia = *(LAS v4u*)(il + g * 128 + (c) * 8), ib = *(LAS v4u*)(il + g * 128 + (c) * 8 + 4); \
            ua[0] = *(const v4u*)(ub + (size_t)ia.x * 128); ua[1] = *(const v4u*)(ub + (size_t)ia.y * 128); ua[2] = *(const v4u*)(ub + (size_t)ia.z * 128); ua[3] = *(const v4u*)(ub + (size_t)ia.w * 128); \
            ua[4] = *(const v4u*)(ub + (size_t)ib.x * 128); ua[5] = *(const v4u*)(ub + (size_t)ib.y * 128); ua[6] = *(const v4u*)(ub + (size_t)ib.z * 128); ua[7] = *(const v4u*)(ub + (size_t)ib.w * 128); \
            su_ = 1.0f; } while (0)
#define PU_COMP(c, ua, su_) do { float a[8]; \
            _Pragma("unroll") for (int j = 0; j < 8; ++j) { int acc = __builtin_amdgcn_sdot4((int)ua[j].x, (int)h.x, 0, false); acc = __builtin_amdgcn_sdot4((int)ua[j].y, (int)h.y, acc, false); \
                acc = __builtin_amdgcn_sdot4((int)ua[j].z, (int)h.z, acc, false); acc = __builtin_amdgcn_sdot4((int)ua[j].w, (int)h.w, acc, false); a[j] = (float)acc; } \
            float bq[4], cc[2]; \
            _Pragma("unroll") for (int p = 0; p < 4; ++p) { const float keep = b0 ? a[2 * p + 1] : a[2 * p], send = b0 ? a[2 * p] : a[2 * p + 1]; bq[p] = keep + shx(send, 1, lane); } \
            _Pragma("unroll") for (int q = 0; q < 2; ++q) { const float keep = b1 ? bq[2 * q + 1] : bq[2 * q], send = b1 ? bq[2 * q] : bq[2 * q + 1]; cc[q] = keep + shx(send, 2, lane); } \
            { const float keep = b2 ? cc[1] : cc[0], send = b2 ? cc[0] : cc[1]; pcl[(c) * 64 + lane] = (keep + shx(send, 4, lane)) * su_; } } while (0)
        { v4u uA[8], uB[8]; float sA, sB;
          PU_LOAD(0, uA, sA);
#pragma unroll 1
          for (int c = 0; c < 16; c += 2) {
              PU_LOAD(c + 1, uB, sB);
              PU_COMP(c, uA, sA);
              if (c + 2 < 16) PU_LOAD(c + 2, uA, sA);
              PU_COMP(c + 1, uB, sB);
          } }
#undef PU_LOAD
#undef PU_COMP
        LDS_WAIT(); asm volatile("" ::: "memory");
        float* dst = PART + ((size_t)s * TOK + t) * 128 + sub;
#pragma unroll
        for (int c = 0; c < 16; ++c) dst[8 * c] = pcl[c * 64 + lane];
        LDS_WAIT(); asm volatile("" ::: "memory");
    }
#undef PU_META
}
__device__ __forceinline__ float gelu_as(float v) {
    const float av = fabsf(v), t = __builtin_amdgcn_rcpf(av * 0.2316418882f + 1.0f);
    float q = t * 0.5307027145f + (-0.7265760135f); q = q * t + 0.7107068705f; q = q * t + (-0.142248368f); q = q * t + 0.127414796f; q = q * t;
    const float m = v * (q * __builtin_amdgcn_exp2f((v * v) * (-0.72134752044f)));
    return v < 0.f ? m : v - m;
}
__device__ __forceinline__ void phase_peer_w(const Frame& F, const float* SV, const float* SU, const float* HS, const int* EIDX, const float* EW, const float* PART, v2u* COEF) {
    const int nth = F.G * NTHR;
    for (int i0 = F.bid * NTHR + F.tid; i0 < TOK * 128; i0 += 4 * nth) {
        float pv[4][8], ew[4]; int e[4];
#pragma unroll
        for (int u = 0; u < 4; ++u) { const int i = i0 + u * nth < TOK * 128 ? i0 + u * nth : i0;
#pragma unroll
            for (int sp = 0; sp < 8; ++sp) pv[u][sp] = PART[(size_t)sp * TOK * 128 + i];
            e[u] = EIDX[i]; ew[u] = EW[i]; }
        float sv[4], su[4], hs[4];
#pragma unroll
        for (int u = 0; u < 4; ++u) { const int i = i0 + u * nth < TOK * 128 ? i0 + u * nth : i0; const f32x2 sc2 = *(const f32x2*)(SU + 2 * e[u]); su[u] = sc2.x; sv[u] = sc2.y; hs[u] = HS[i >> 7]; }
#pragma unroll
        for (int u = 0; u < 4; ++u) { const int i = i0 + u * nth; float act = 0.f;
#pragma unroll
            for (int sp = 0; sp < 8; ++sp) act += pv[u][sp];
            const float c = ew[u] * gelu_as(act * (su[u] * hs[u])) * sv[u];
            if (i < TOK * 128) COEF[i] = (v2u){(unsigned)e[u], __builtin_bit_cast(unsigned, c)}; }
    }
}
__device__ __forceinline__ void phase_peer_v(const Frame& F, const unsigned char* VT8, const v2u* COEF, float* XB, const float* gate) {
    const int lane = F.lane, g = lane >> 3, sub = lane & 7;
    const int s = F.bid & 7, wgq = F.bid >> 3, nq = F.G >> 3;
    LAS v2u* wl = (LAS v2u*)(F.lds + F.wave * 8192);
    const unsigned char* vb = VT8 + (size_t)s * 16384 * 128 + sub * 16;
    v4u nc[8];
#define PV_META(bt) do { const v4u* src = (const v4u*)(COEF + (size_t)(bt) * 8 * 128) + lane; _Pragma("unroll") for (int q = 0; q < 8; ++q) nc[q] = src[64 * q]; } while (0)
    { const int b0_ = wgq * 8 + F.wave; if (b0_ < TOK / 8) PV_META(b0_); }
    for (int batch = wgq * 8 + F.wave; batch < TOK / 8; batch += nq * 8) {
        const int t0 = batch * 8, t = t0 + g;
        { LAS v4u* dst = (LAS v4u*)wl + lane;
#pragma unroll
          for (int q = 0; q < 8; ++q) dst[64 * q] = nc[q]; }
        if (batch + nq * 8 < TOK / 8) PV_META(batch + nq * 8);
        const int bb = t / SEQ; float* xr = XB + (size_t)t * DM + s * 128 + sub * 16; const float* gr = gate + (size_t)bb * 6144 + s * 128 + sub * 16;
        f32x4 xv[4], gv4[4];
#pragma unroll
        for (int q = 0; q < 4; ++q) { xv[q] = *(const f32x4*)(xr + 4 * q); gv4[q] = *(const f32x4*)(gr + 4 * q); }
        LDS_WAIT(); asm volatile("" ::: "memory");
        h16x2 o[8];
#pragma unroll
        for (int q = 0; q < 8; ++q) o[q] = (h16x2){(_Float16)0.f, (_Float16)0.f};
#define PV_LOAD(c, pr, va) do { \
            _Pragma("unroll") for (int q = 0; q < 4; ++q) pr[q] = *(LAS v4u*)(wl + g * 128 + (c) * 8 + 2 * q); \
            _Pragma("unroll") for (int q = 0; q < 4; ++q) { va[2 * q] = *(const v4u*)(vb + (size_t)pr[q].x * 128); va[2 * q + 1] = *(const v4u*)(vb + (size_t)pr[q].z * 128); } } while (0)
#define PV_COMP(pr, va) do { \
            _Pragma("unroll") for (int j = 0; j < 8; ++j) { const unsigned cb = (j & 1) ? pr[j >> 1].w : pr[j >> 1].y; \
                const float s2 = __builtin_bit_cast(float, cb & 0x7f800000u); const _Float16 mh = (_Float16)__builtin_bit_cast(float, (cb & 0x807fffffu) | 0x3f800000u); const h16x2 m2 = (h16x2){mh, mh}; \
                _Pragma("unroll") for (int q = 0; q < 4; ++q) { o[2 * q] = __builtin_elementwise_fma(__builtin_bit_cast(h16x2, __builtin_amdgcn_cvt_scalef32_pk_f16_fp8(va[j][q], s2, false)), m2, o[2 * q]); \
                    o[2 * q + 1] = __builtin_elementwise_fma(__builtin_bit_cast(h16x2, __builtin_amdgcn_cvt_scalef32_pk_f16_fp8(va[j][q], s2, true)), m2, o[2 * q + 1]); } } } while (0)
        { v4u pA[4], pB[4], vA[8], vB[8];
          PV_LOAD(0, pA, vA);
#pragma unroll 1
          for (int c = 0; c < 16; c += 2) {
              PV_LOAD(c + 1, pB, vB);
              PV_COMP(pA, vA);
              if (c + 2 < 16) PV_LOAD(c + 2, pA, vA);
              PV_COMP(pB, vB);
          } }
#undef PV_LOAD
#undef PV_COMP
#pragma unroll
        for (int q = 0; q < 4; ++q) *(f32x4*)(xr + 4 * q) = xv[q] + gv4[q] * (f32x4){(float)o[2 * q].x, (float)o[2 * q].y, (float)o[2 * q + 1].x, (float)o[2 * q + 1].y};
        LDS_WAIT(); asm volatile("" ::: "memory");
    }
#undef PV_META
}

constexpr int NPL = 12, NPHASE = 1 + DEPTH * NPL + 1;
constexpr int CW_BAR = 1024;
static_assert((CW_BAR + XCD_BAR_WORDS) * 4 <= (int)CTL_ZERO_BYTES, "barrier words inside the memset region");

__global__ void __launch_bounds__(NTHR, 2) hybrid_fwd(Args args) {
    extern __shared__ __attribute__((aligned(16))) unsigned char lds[];
    Frame F;
    F.lds = (LAS unsigned char*)lds; F.ldsg = lds;
    F.tid = threadIdx.x; F.lane = F.tid & 63; F.wave = __builtin_amdgcn_readfirstlane(F.tid >> 6);
    F.G = gridDim.x; F.bid = blockIdx.x; F.ws = args.ws;
    GAS unsigned char* wsg = (GAS unsigned char*)args.ws;
#define WSP ((unsigned char*)wsg)
    volatile LAS unsigned* MISC = (volatile LAS unsigned*)(F.lds + MISC_OFF);
    for (int u = F.tid; u < 64; u += NTHR) ((LAS unsigned*)(F.lds + MISC_OFF))[u] = 0u;
    __syncthreads();
    XcdBarrier bar; bar.bar = (unsigned*)(WSP + WS_CTL) + CW_BAR; bar.x = 0; bar.st = nullptr;
    const int lo = args.ph_lo, hi = args.ph_hi;
    if (hi - lo > 1) bar = xcd_barrier_post((unsigned*)(WSP + WS_CTL) + CW_BAR, MISC + 8);
#define IN(k) (lo <= (k) && (k) < hi)
#define SEAM(k) do { if (IN(k) && IN((k) + 1)) xcd_barrier(bar); } while (0)

    typedef __attribute__((address_space(4))) const Args* KArgs;
    KArgs ap = (KArgs)__builtin_amdgcn_kernarg_segment_ptr();
#define FRESH() asm volatile("" : "+s"(ap), "+s"(wsg)); Frame Fp = F; asm volatile("" : "+v"(Fp.tid)); Fp.lane = Fp.tid & 63; asm volatile("" : "+s"(Fp.wave), "+s"(Fp.bid), "+s"(Fp.G)); Fp.ws = WSP; LAS unsigned char* ring = Fp.lds; asm volatile("" : "+s"(ring)); Fp.lds = ring
#define INP(i) ((const float*)(GAS const float*)ap->in[i])
#define WIN_ ((bf16*)(WSP + WS_WIN))
#define WOUT_ ((bf16*)(WSP + WS_WOUT))
#define WOT_ ((bf16*)(WSP + WS_WO))
#define WQT_ ((bf16*)(WSP + WS_WQ))
#define W1T_ ((bf16*)(WSP + WS_W1T))
#define SUBK_ ((bf16*)(WSP + WS_SUBK))
#define W2T_ ((bf16*)(WSP + WS_SMALL + SM_W2T))
#define MOD_ ((float*)(WSP + WS_MOD))
#define COS_ ((const float*)(WSP + WS_COS))
#define SIN_ ((const float*)(WSP + WS_SIN))
#define KMEAN_ ((float*)(WSP + WS_SMALL + SM_KMEAN))
#define KCMP_ ((bf16*)(WSP + WS_SMALL + SM_KCMP))
#define VCMP_ ((bf16*)(WSP + WS_SMALL + SM_VCMP))
#define PBP_ ((float*)(WSP + WS_SMALL + SM_PBP))
#define EIDX_ ((int*)(WSP + WS_EIDX))
#define EW_ ((float*)(WSP + WS_EW))
#define HN_ ((bf16*)(WSP + WS_HN))
#define MIX_ ((bf16*)(WSP + WS_MIX))
#define PROJ_ ((bf16*)(WSP + WS_BIG))
#define GATES_ ((unsigned char*)(WSP + WS_GATES))
#define UT_ ((unsigned char*)(WSP + WS_BIG))
#define VT_ ((unsigned char*)(WSP + WS_BIG + 16 * MiB))
#define SU_ ((float*)(WSP + WS_BIG + 32 * MiB))
#define SV_ ((float*)(WSP + WS_BIG + 32 * MiB + 65536))
#define COEF_ ((v2u*)(WSP + WS_BIG + 33 * MiB))
#define H8_ ((unsigned char*)(WSP + WS_BIG + 128 * MiB))
#define HS_ ((float*)(WSP + WS_BIG + 144 * MiB))
#define Q2_ ((bf16*)(WSP + WS_BIG + 64 * MiB))
#define PART_ ((float*)(WSP + WS_BIG + 64 * MiB))
#define XB_ ((float*)(GAS float*)ap->out)
#define MODL_ (MOD_ + (size_t)l * 8 * 6144)
#define XIN_ ((l == 0) ? INP(I_X) : (const float*)XB_)

    if (IN(0)) { FRESH(); phase_prologue(Fp, ap); }
    SEAM(0);
#pragma unroll 1
    for (int l = 0; l < DEPTH; ++l) {
        const int p0 = 1 + l * NPL;
        if (IN(p0 + 0)) { FRESH(); phase_norm_mod(Fp, XIN_, INP(I_NMG) + l * DM, MODL_ + 0, MODL_ + 1024, HN_); }
        SEAM(p0 + 0);
        if (IN(p0 + 1)) { FRESH(); pg8::Gemm g{HN_, WIN_ + (size_t)l * NWIN * DM, TOK, NWIN, DM}; pg8::StaticOrder S; S.init(TOK, NWIN, Fp.G, Fp.bid);
            epi::EpiProjAll E{{PROJ_, COS_, SIN_}, {GATES_}}; pg8::gemm_phase<epi::EpiProjAll, pg8::StaticOrder, true, true>(ring, g, S, E, Fp.tid); }
        SEAM(p0 + 1);
        if (IN(p0 + 2)) {
            { FRESH(); phase_compress(Fp, PROJ_, W1T_ + (size_t)l * 2 * 128 * 2048, W2T_ + (size_t)l * 2 * 64 * 128, PBP_ + (size_t)l * 2 * 16 * 128, KCMP_, VCMP_); }
            { FRESH(); phase_kmean(Fp, PROJ_, KMEAN_); }
            { FRESH(); phase_mixer_a(Fp, PROJ_, INP(I_ACW) + (size_t)l * 3 * 512, MIX_); }
            __syncthreads();
            { FRESH(); phase_mixer_b(Fp, PROJ_, INP(I_BCW) + (size_t)l * 31 * 512, INP(I_BCB) + l * 512, INP(I_BLNG) + l * 512, INP(I_BLNB) + l * 512, MIX_ + (size_t)TOK * 512); }
            __syncthreads();
        }
        SEAM(p0 + 2);
        if (IN(p0 + 3)) { { FRESH(); phase_nsa(Fp, PROJ_, KCMP_, VCMP_, MIX_ + (size_t)2 * TOK * 512); __syncthreads(); }
                                   { FRESH(); phase_moba(Fp, PROJ_, KMEAN_, MIX_ + (size_t)3 * TOK * 512); __syncthreads(); } }
        SEAM(p0 + 3);
        if (IN(p0 + 4)) { FRESH(); pg8::Gemm g{MIX_, WOUT_ + (size_t)(l * 4) * DM * 512, 4 * TOK, 4 * DM, 512}; epi::MergeOrder S; S.init(Fp.G, Fp.bid);
            epi::EpiMergeAll E{HN_, GATES_}; pg8::gemm_phase<epi::EpiMergeAll, epi::MergeOrder, true, true>(ring, g, S, E, Fp.tid); }
        SEAM(p0 + 4);
        if (IN(p0 + 5)) { FRESH(); pg8::Gemm g{HN_, WOT_ + (size_t)l * DM * DM, TOK, DM, DM}; pg8::StaticOrder S; S.init(TOK, DM, Fp.G, Fp.bid);
            epi::EpiResid E{XIN_, XB_, MODL_ + 2048}; pg8::gemm_phase<epi::EpiResid, pg8::StaticOrder, true, true>(ring, g, S, E, Fp.tid); }
        SEAM(p0 + 5);
        if (IN(p0 + 6)) {
            { FRESH(); phase_norm_mod(Fp, XB_, INP(I_NFG) + l * DM, MODL_ + 3072, MODL_ + 4096, HN_, H8_, HS_); }
            { FRESH(); phase_peer_tables(Fp, INP(I_PU) + (size_t)l * 16384 * DM, INP(I_PV) + (size_t)l * 16384 * DM, UT_, VT_, SU_, SV_); }
        }
        SEAM(p0 + 6);
        if (IN(p0 + 7)) { FRESH(); pg8::Gemm g{HN_, WQT_ + (size_t)l * 2048 * DM, TOK, 2048, DM}; pg8::StaticOrder S; S.init(TOK, 2048, Fp.G, Fp.bid);
            epi::EpiStoreBf E{Q2_, 2048}; pg8::gemm_phase<epi::EpiStoreBf, pg8::StaticOrder, true, true>(ring, g, S, E, Fp.tid); }
        SEAM(p0 + 7);
        if (IN(p0 + 8)) { FRESH(); phase_peer_route(Fp, Q2_, SUBK_ + (size_t)l * 8 * 2 * 128 * 128, EIDX_, EW_); __syncthreads(); }
        SEAM(p0 + 8);
        if (IN(p0 + 9)) { FRESH(); phase_peer_u(Fp, H8_, HS_, UT_, SU_, EIDX_, PART_); }
        SEAM(p0 + 9);
        if (IN(p0 + 10)) { FRESH(); phase_peer_w(Fp, SV_, SU_, HS_, EIDX_, EW_, PART_, COEF_); }
        SEAM(p0 + 10);
        if (IN(p0 + 11)) { FRESH(); phase_peer_v(Fp, VT_, COEF_, XB_, MODL_ + 5120); }
        SEAM(p0 + 11);
    }
    if (IN(NPHASE - 1)) { FRESH(); phase_final_norm(Fp, XB_, INP(I_FNG), XB_); }
#undef IN
#undef SEAM
#undef WSP
}

extern "C" void kernel_launch(void* const* d_in, const int* in_sizes, int n_in, void* d_out, int out_size, void* d_ws, size_t ws_size, hipStream_t stream) {
    static int grid = 0;
    if (grid == 0) {
        if (n_in != 26 || in_sizes[0] != TOK * DM || out_size != TOK * DM || ws_size < WS_END) {
            fprintf(stderr, "kernel_launch: unexpected problem (n_in %d, in0 %d, out %d, WSP %zu); nothing launched\n", n_in, n_in > 0 ? in_sizes[0] : -1, out_size, ws_size); grid = -1; return; }
        int dev = 0, cus = 0, per_cu = 0;
        if (hipGetDevice(&dev) != hipSuccess || hipDeviceGetAttribute(&cus, hipDeviceAttributeMultiprocessorCount, dev) != hipSuccess) { grid = -1; return; }
        if (hipFuncSetAttribute((const void*)hybrid_fwd, hipFuncAttributeMaxDynamicSharedMemorySize, LDS_BYTES) != hipSuccess) { fprintf(stderr, "kernel_launch: hipFuncSetAttribute failed\n"); grid = -1; return; }
        if (hipOccupancyMaxActiveBlocksPerMultiprocessor(&per_cu, (const void*)hybrid_fwd, NTHR, LDS_BYTES) != hipSuccess || per_cu < 1)
            fprintf(stderr, "kernel_launch: note: occupancy query reports %d workgroups per CU\n", per_cu);
        (void)hipGetLastError();
        grid = cus;
    }
    if (grid < 0) return;
    if (hipMemsetAsync((char*)d_ws + WS_CTL, 0, CTL_ZERO_BYTES, stream) != hipSuccess) return;
    Args a{};
    for (int i = 0; i < 26; ++i) a.in[i] = d_in[i];
    a.out = (float*)d_out; a.ws = (unsigned char*)d_ws;
#if MK_PER_PHASE
    for (int p = 0; p < NPHASE; ++p) { a.ph_lo = p; a.ph_hi = p + 1; hipLaunchKernelGGL(hybrid_fwd, dim3(grid), dim3(NTHR), LDS_BYTES, stream, a); }
#else
    a.ph_lo = 0; a.ph_hi = NPHASE; hipLaunchKernelGGL(hybrid_fwd, dim3(grid), dim3(NTHR), LDS_BYTES, stream, a);
#endif
    const hipError_t le = hipPeekAtLastError();
    if (le != hipSuccess) fprintf(stderr, "kernel_launch: launch failed: %s\n", hipGetErrorName(le));
}
```

```cpp
#include <hip/hip_runtime.h>
#include <hip/hip_bf16.h>
#include <cstdio>
#include <cstdint>
#include <cmath>

#ifndef MK_PER_PHASE
#define MK_PER_PHASE 0
#endif

#define GAS __attribute__((address_space(1)))
#define LAS __attribute__((address_space(3)))
typedef unsigned short bf16;
typedef unsigned v4u __attribute__((ext_vector_type(4)));
typedef unsigned v2u __attribute__((ext_vector_type(2)));
typedef float f32x4 __attribute__((ext_vector_type(4)));
typedef float f32x2 __attribute__((ext_vector_type(2)));
typedef float f32x16 __attribute__((ext_vector_type(16)));
typedef short bf16x8 __attribute__((ext_vector_type(8)));
typedef short s16x4 __attribute__((ext_vector_type(4)));
typedef __bf16 bf16x2_t __attribute__((ext_vector_type(2)));

constexpr int BATCH = 8, SEQ = 2048, DM = 1024, DEPTH = 2, TOK = BATCH * SEQ;
constexpr int NP1 = 5632;
constexpr int NGT = 4096;
constexpr int NWIN = NP1 + NGT;
constexpr int C_AB = 0, C_AC = 512, C_AX = 1024, C_BA = 1536, C_BG = 2048, C_CQ = 2560, C_KC = 3072, C_VC = 3200, C_KS = 3328, C_VS = 3456, C_KW = 3584, C_VW = 3712,
              C_DQ = 3840, C_DK = 4352, C_DV = 4864, C_CG = 5376;
constexpr float NORM_EPS = 1e-6f;
constexpr float QSCALE = 0.125f * 1.4426950408889634f;

constexpr size_t MiB = 1u << 20;
constexpr size_t WS_CTL = 0, CTL_ZERO_BYTES = 64 * 1024;
constexpr size_t WS_MOD = 1 * MiB;
constexpr size_t WS_COS = 2 * MiB, WS_SIN = 4 * MiB;
constexpr size_t WS_SMALL = 6 * MiB;
constexpr size_t SM_KMEAN = 704 * 1024;
constexpr size_t SM_KCMP = 64 * 1024;
constexpr size_t SM_VCMP = 320 * 1024;
constexpr size_t SM_PBP = 576 * 1024;
constexpr size_t SM_W2T = 640 * 1024;
constexpr size_t WS_EIDX = 8 * MiB;
constexpr size_t WS_EW = 16 * MiB;
constexpr size_t WS_WIN = 24 * MiB;
constexpr size_t WS_WOUT = 62 * MiB;
constexpr size_t WS_WO = 70 * MiB;
constexpr size_t WS_WQ = 74 * MiB;
constexpr size_t WS_W1T = 82 * MiB;
constexpr size_t WS_SUBK = 84 * MiB;
constexpr size_t WS_HN = 86 * MiB;
constexpr size_t WS_MIX = 118 * MiB;
constexpr size_t WS_BIG = 182 * MiB;
constexpr size_t WS_GATES = 358 * MiB;
constexpr size_t WS_END = 486 * MiB;

constexpr int LDS_BYTES = 147456;
constexpr int RING_BYTES = 131072;
constexpr int MISC_OFF = LDS_BYTES - 256;

#define RLX_AGENT __ATOMIC_RELAXED, __HIP_MEMORY_SCOPE_AGENT
#define LDS_WAIT() asm volatile("s_waitcnt lgkmcnt(0)" ::: "memory")
#define VM_WAIT() asm volatile("s_waitcnt vmcnt(0)" ::: "memory")
__device__ __forceinline__ unsigned f2bf(float f) { unsigned u = __builtin_bit_cast(unsigned, f); return (u + 0x7fffu + ((u >> 16) & 1u)) >> 16; }
__device__ __forceinline__ float bf2f(unsigned h) { return __builtin_bit_cast(float, h << 16); }
__device__ __forceinline__ unsigned pk2(float lo, float hi) { f32x2 v = {lo, hi}; bf16x2_t b = __builtin_convertvector(v, bf16x2_t); return __builtin_bit_cast(unsigned, b); }
__device__ __forceinline__ float bflo(unsigned w) { return __builtin_bit_cast(float, w << 16); }
__device__ __forceinline__ float bfhi(unsigned w) { return __builtin_bit_cast(float, w & 0xffff0000u); }
__device__ __forceinline__ float sigmoidf_(float x) { return __builtin_amdgcn_rcpf(1.0f + __builtin_amdgcn_exp2f(x * -1.4426950408889634f)); }
__device__ __forceinline__ float gelu_erf(float x) { return 0.5f * x * (1.0f + erff(x * 0.70710678118654752f)); }
__device__ __forceinline__ float shx(float v, int m, int lane) { return __builtin_bit_cast(float, __builtin_amdgcn_ds_bpermute((lane ^ m) << 2, __builtin_bit_cast(int, v))); }
__device__ __forceinline__ unsigned shxu(unsigned v, int m, int lane) { return (unsigned)__builtin_amdgcn_ds_bpermute((lane ^ m) << 2, (int)v); }
__device__ __forceinline__ void swap32(unsigned v, unsigned& r0, unsigned& r1) { unsigned b = v; asm volatile("" : "+v"(b)); auto r = __builtin_amdgcn_permlane32_swap(v, b, false, false); r0 = r[0]; r1 = r[1]; }
__device__ __forceinline__ float other32(float v, int hi) { unsigned r0, r1; swap32(__builtin_bit_cast(unsigned, v), r0, r1); return __builtin_bit_cast(float, hi ? r0 : r1); }
__device__ __forceinline__ float add32(float v) { unsigned r0, r1; swap32(__builtin_bit_cast(unsigned, v), r0, r1); return __builtin_bit_cast(float, r0) + __builtin_bit_cast(float, r1); }
__device__ __forceinline__ float max32(float v) { unsigned r0, r1; swap32(__builtin_bit_cast(unsigned, v), r0, r1); return fmaxf(__builtin_bit_cast(float, r0), __builtin_bit_cast(float, r1)); }
__device__ __forceinline__ unsigned umax32(unsigned v) { unsigned r0, r1; swap32(v, r0, r1); return r0 > r1 ? r0 : r1; }
__device__ __forceinline__ float wave_sum(float v, int lane) {
#pragma unroll
    for (int o = 1; o < 32; o <<= 1) v += shx(v, o, lane);
    return add32(v);
}
namespace pg8 {
#define PG8_LAS __attribute__((address_space(3)))
typedef unsigned short bf16_t;
typedef short bf16x8 __attribute__((ext_vector_type(8)));
typedef float f32x4 __attribute__((ext_vector_type(4)));
typedef unsigned u32x4 __attribute__((ext_vector_type(4)));
constexpr int BM = 256, BK = 64, HALF = 128, HTB = HALF * BK * 2  , STAGE_BYTES = 8 * HTB, NXCD = 8, WGM = 4;

__host__ __device__ __forceinline__ int lds_byte(int r, int c) { const int st = (r >> 4) * 2 + (c >> 5), rr = r & 15, cc = c & 31, ob = rr * 64 + cc * 2; return st * 1024 + (ob ^ (((ob >> 9) & 1) << 5)); }
__host__ __device__ __forceinline__ void stage_rc(int b, int& R, int& C) { const int st = b / 1024, sb = b % 1024, swz = sb ^ (((sb >> 9) & 1) << 5); R = (st >> 1) * 16 + swz / 64; C = (st & 1) * 32 + (swz % 64) / 2; }
__host__ __device__ __forceinline__ int perm32(int rho) { const int n = rho >> 4, i = rho & 15; return 8 * (i >> 2) + 4 * n + (i & 3); }

struct Unit { int pm, pn; };
struct Gemm { const bf16_t* A; const bf16_t* Bt; int M, N, K; };

struct StaticOrder {
    int nM, nN, nwg, G, c;
    __host__ __device__ void init(int M, int N, int G_, int c_) { nM = M / BM; nN = N / BM; nwg = nM * nN; G = G_; c = c_; }
    __host__ __device__ bool next(int i, Unit& u) const {
        const long L = (long)i * G + c; if (L >= nwg) return false;
        int wgid = (int)L; { const int q = nwg / NXCD, r = nwg % NXCD, xcd = wgid % NXCD, off = wgid / NXCD; wgid = (xcd < r ? xcd * (q + 1) : r * (q + 1) + (xcd - r) * q) + off; }
        const int nig = WGM * nN, gid = wgid / nig, fm = gid * WGM, gsz = (nM - fm) < WGM ? (nM - fm) : WGM;
        u.pm = fm + ((wgid % nig) % gsz); u.pn = (wgid % nig) / gsz; return true;
    }
    __device__ __forceinline__ void a_ready(const Unit&) const {}
    __device__ __forceinline__ void done(const Unit&) const {}
};

__device__ __forceinline__ unsigned cvt_pk_bf16(float lo, float hi) { unsigned r; asm volatile("v_cvt_pk_bf16_f32 %0, %1, %2" : "=v"(r) : "v"(lo), "v"(hi)); return r; }
typedef float f32x2 __attribute__((ext_vector_type(2)));
template <class Epi, class Sched, bool ALIGN_EPI = false, bool SP2 = false>
__device__ __forceinline__ void gemm_phase(PG8_LAS unsigned char* lds, const Gemm g, const Sched& S, const Epi& E, const int tid) {
    const int wid = __builtin_amdgcn_readfirstlane(tid >> 6), lane = tid & 63, wr = wid >> 2, wc = wid & 3, fr = lane & 15, fq = lane >> 4;
    const int K = g.K, nt = K / BK;
    unsigned voffA[2], voffB[2];
#pragma unroll
    for (int i = 0; i < 2; ++i) { int R, C; stage_rc(tid * 16 + i * 8192, R, C); const int Rb = Epi::PERM ? ((R & ~31) + perm32(R & 31)) : R;
        voffA[i] = (unsigned)(R * K + C) * 2u; voffB[i] = (unsigned)(Rb * K + C) * 2u; }
    const size_t kstep = (size_t)(BK * 2);
    const size_t hstep = (size_t)HALF * K * 2;
    const size_t tstep = 2 * hstep;
    const unsigned ldsw = (unsigned)wid * 1024u;
    const int aoff = lds_byte(wr * 64 + fr, fq * 8), boff = lds_byte(wc * 32 + fr, fq * 8);
#define PG8_SA(b, h) (((b) * 2 + (h)) * HTB)
#define PG8_SB(b, h) ((4 + (b) * 2 + (h)) * HTB)
#define PG8_STAGE(bufoff, gbase, voff) do { _Pragma("unroll") for (int _i = 0; _i < 2; ++_i) \
        __builtin_amdgcn_global_load_lds((const unsigned*)((const char*)(gbase) + (voff)[_i]), (PG8_LAS unsigned*)(lds + (bufoff) + ldsw + _i * 8192), 16, 0, 0); } while (0)
#define PG8_LDA(dst, b, h) do { _Pragma("unroll") for (int m = 0; m < 4; ++m) _Pragma("unroll") for (int k = 0; k < 2; ++k) dst[m][k] = *(const PG8_LAS bf16x8*)(lds + PG8_SA(b, h) + aoff + m * 2048 + k * 1024); } while (0)
#define PG8_LDB(dst, b, h) do { _Pragma("unroll") for (int n = 0; n < 2; ++n) _Pragma("unroll") for (int k = 0; k < 2; ++k) dst[n][k] = *(const PG8_LAS bf16x8*)(lds + PG8_SB(b, h) + boff + n * 2048 + k * 1024); } while (0)
#define PG8_MMA(ai, bj, At, Bt) do { __builtin_amdgcn_s_setprio(1); _Pragma("unroll") for (int m = 0; m < 4; ++m) _Pragma("unroll") for (int n = 0; n < 2; ++n) _Pragma("unroll") for (int k = 0; k < 2; ++k) \
        acc[ai][bj][m][n] = __builtin_amdgcn_mfma_f32_16x16x32_bf16(Bt[n][k], At[m][k], acc[ai][bj][m][n], 0, 0, 0); __builtin_amdgcn_s_setprio(0); } while (0)
#define PG8_WAIT_V(n) asm volatile("s_waitcnt vmcnt(" #n ")" ::: "memory")
#define PG8_WAIT_L(n) asm volatile("s_waitcnt lgkmcnt(" #n ")" ::: "memory")
#define PG8_BAR __builtin_amdgcn_s_barrier()
#define PG8_SCHED __builtin_amdgcn_sched_barrier(0)
    Unit cur, nxt; int ui = 0;
    if (!S.next(0, cur)) return;
    f32x4 acc[2][2][4][2];
#pragma unroll
    for (int a = 0; a < 2; ++a)
#pragma unroll
        for (int b = 0; b < 2; ++b)
#pragma unroll
            for (int m = 0; m < 4; ++m)
#pragma unroll
                for (int n = 0; n < 2; ++n) acc[a][b][m][n] = (f32x4){0.f, 0.f, 0.f, 0.f};
    bf16x8 At[4][2], B0[2][2], B1[2][2];
    const char* cA = (const char*)g.A + (size_t)cur.pm * tstep; const char* cB = (const char*)g.Bt + (size_t)cur.pn * tstep;
    S.a_ready(cur);
    if constexpr (SP2) {
        PG8_STAGE(PG8_SB(0, 0), cB, voffB); PG8_STAGE(PG8_SB(0, 1), cB + hstep, voffB); PG8_STAGE(PG8_SA(0, 0), cA, voffA); PG8_STAGE(PG8_SA(0, 1), cA + hstep, voffA);
        if (wr == 1) PG8_BAR;
        PG8_WAIT_V(2); PG8_BAR;
        PG8_STAGE(PG8_SB(1, 0), cB + kstep, voffB); PG8_STAGE(PG8_SA(1, 0), cA + kstep, voffA); PG8_STAGE(PG8_SB(1, 1), cB + hstep + kstep, voffB);
        PG8_WAIT_V(6); PG8_BAR;
    } else {
        PG8_STAGE(PG8_SB(0, 0), cB, voffB); PG8_STAGE(PG8_SA(0, 0), cA, voffA); PG8_STAGE(PG8_SB(0, 1), cB + hstep, voffB); PG8_STAGE(PG8_SA(0, 1), cA + hstep, voffA);
        if (wr == 1) PG8_BAR;
        PG8_WAIT_V(4); PG8_BAR;
        PG8_STAGE(PG8_SB(1, 0), cB + kstep, voffB); PG8_STAGE(PG8_SA(1, 0), cA + kstep, voffA); PG8_STAGE(PG8_SB(1, 1), cB + hstep + kstep, voffB);
        PG8_WAIT_V(6); PG8_BAR;
    }
    for (;;) {
        const bool has_next = S.next(ui + 1, nxt);
        const char* nA = has_next ? (const char*)g.A + (size_t)nxt.pm * tstep : cA; const char* nB = has_next ? (const char*)g.Bt + (size_t)nxt.pn * tstep : cB;
        for (int t = 0; t < nt; t += 2) {
            const bool last = (t == nt - 2);
            const char* a1 = cA + (size_t)(t + 1) * kstep;
            const char* a2 = last ? nA : cA + (size_t)(t + 2) * kstep; const char* b2 = last ? nB : cB + (size_t)(t + 2) * kstep;
            const char* a3 = a2 + kstep; const char* b3 = b2 + kstep;
            if (last && has_next) S.a_ready(nxt);
            if constexpr (SP2) {
            PG8_LDB(B0, 0, 0); PG8_LDB(B1, 0, 1); PG8_SCHED; PG8_LDA(At, 0, 0); PG8_STAGE(PG8_SA(1, 1), a1 + hstep, voffA);
            PG8_WAIT_V(8); PG8_WAIT_L(0); PG8_BAR; PG8_MMA(0, 0, At, B0); PG8_MMA(0, 1, At, B1); PG8_BAR; PG8_SCHED;
            PG8_LDA(At, 0, 1); PG8_STAGE(PG8_SB(0, 0), b2, voffB); PG8_STAGE(PG8_SB(0, 1), b2 + hstep, voffB); PG8_STAGE(PG8_SA(0, 0), a2, voffA);
            PG8_WAIT_V(8); PG8_WAIT_L(0); PG8_BAR; PG8_MMA(1, 0, At, B0); PG8_MMA(1, 1, At, B1); PG8_BAR; PG8_SCHED;
            PG8_LDB(B0, 1, 0); PG8_LDB(B1, 1, 1); PG8_SCHED; PG8_LDA(At, 1, 0); PG8_STAGE(PG8_SA(0, 1), a2 + hstep, voffA);
            PG8_WAIT_V(8); PG8_WAIT_L(0); PG8_BAR; PG8_MMA(0, 0, At, B0); PG8_MMA(0, 1, At, B1); PG8_BAR; PG8_SCHED;
            PG8_LDA(At, 1, 1); PG8_STAGE(PG8_SB(1, 0), b3, voffB); PG8_STAGE(PG8_SB(1, 1), b3 + hstep, voffB); PG8_STAGE(PG8_SA(1, 0), a3, voffA);
            PG8_WAIT_V(8); PG8_WAIT_L(0); PG8_BAR; PG8_MMA(1, 0, At, B0); PG8_MMA(1, 1, At, B1); PG8_BAR; PG8_SCHED;
            } else {
            PG8_LDB(B0, 0, 0); PG8_SCHED; PG8_LDA(At, 0, 0); PG8_STAGE(PG8_SA(1, 1), a1 + hstep, voffA);
            PG8_WAIT_L(8); PG8_BAR; PG8_WAIT_L(0); PG8_MMA(0, 0, At, B0); PG8_BAR; PG8_SCHED;
            PG8_LDB(B1, 0, 1); PG8_STAGE(PG8_SB(0, 0), b2, voffB);
            PG8_BAR; PG8_WAIT_L(0); PG8_MMA(0, 1, At, B1); PG8_BAR;
            PG8_LDA(At, 0, 1); PG8_STAGE(PG8_SA(0, 0), a2, voffA);
            PG8_BAR; PG8_WAIT_L(0); PG8_MMA(1, 0, At, B0); PG8_BAR; PG8_SCHED;
            PG8_STAGE(PG8_SB(0, 1), b2 + hstep, voffB);
            PG8_WAIT_V(6); PG8_BAR; PG8_MMA(1, 1, At, B1); PG8_BAR;
            PG8_LDB(B0, 1, 0); PG8_SCHED; PG8_LDA(At, 1, 0); PG8_STAGE(PG8_SA(0, 1), a2 + hstep, voffA);
            PG8_WAIT_L(8); PG8_BAR; PG8_WAIT_L(0); PG8_MMA(0, 0, At, B0); PG8_BAR; PG8_SCHED;
            PG8_LDB(B1, 1, 1); PG8_STAGE(PG8_SB(1, 0), b3, voffB);
            PG8_BAR; PG8_WAIT_L(0); PG8_MMA(0, 1, At, B1); PG8_BAR;
            PG8_LDA(At, 1, 1); PG8_STAGE(PG8_SA(1, 0), a3, voffA);
            PG8_BAR; PG8_WAIT_L(0); PG8_MMA(1, 0, At, B0); PG8_BAR; PG8_SCHED;
            PG8_STAGE(PG8_SB(1, 1), b3 + hstep, voffB);
            PG8_WAIT_V(6); PG8_BAR; PG8_MMA(1, 1, At, B1); PG8_BAR;
            }
        }
        if constexpr (ALIGN_EPI) { if (wr == 0) PG8_BAR; }
        if constexpr (Epi::KEEP_ACC) { E.inplace(acc, cur, wr, wc, fr, fq); S.done(cur); }
        else if constexpr (!Epi::AFTER_DRAIN) { E(acc, cur, wr, wc, fr, fq); S.done(cur); }
        if (!has_next) break;
        if constexpr (!Epi::KEEP_ACC)
#pragma unroll
        for (int a = 0; a < 2; ++a)
#pragma unroll
            for (int b = 0; b < 2; ++b)
#pragma unroll
                for (int m = 0; m < 4; ++m)
#pragma unroll
                    for (int n = 0; n < 2; ++n) acc[a][b][m][n] = (f32x4){0.f, 0.f, 0.f, 0.f};
        cur = nxt; cA = nA; cB = nB; ++ui;
        if constexpr (ALIGN_EPI) { if (wr == 1) PG8_BAR; }
    }
    PG8_WAIT_V(0);
    if constexpr (!ALIGN_EPI) { if (wr == 0) PG8_BAR; }
    PG8_BAR;
    if constexpr (Epi::AFTER_DRAIN) {
        const int wid2 = wid; unsigned z0 = 0u; asm volatile("" : "+v"(z0)); const int lane2 = (int)__builtin_amdgcn_mbcnt_hi(~0u, __builtin_amdgcn_mbcnt_lo(~0u, z0));
        E.fused(acc, cur, wid2 >> 2, wid2 & 3, lane2 & 15, lane2 >> 4, lds, wid2, lane2); S.done(cur); }
#undef PG8_SA
#undef PG8_SB
#undef PG8_STAGE
#undef PG8_LDA
#undef PG8_LDB
#undef PG8_MMA
#undef PG8_WAIT_V
#undef PG8_WAIT_L
#undef PG8_BAR
#undef PG8_SCHED
}
}
#define XB_TMO      128
#define XB_XCNT(j)  (256  + 64 * (j))
#define XB_XSUB(j)  (1280 + 64 * (j))
#define XB_XGEN(j)  (2304 + 64 * (j))
#define XB_TOP      3328
#define XB_TOPGEN   3392
#define XB_FLAG     3408
#define XCD_BAR_WORDS 3456
#define XB_SPIN_CAP (1u << 25)

__device__ __forceinline__ unsigned xb_ld(unsigned* p)              { return __hip_atomic_load(p, __ATOMIC_RELAXED, __HIP_MEMORY_SCOPE_AGENT); }
__device__ __forceinline__ unsigned xb_add(unsigned* p, unsigned v) { return __hip_atomic_fetch_add(p, v, __ATOMIC_RELAXED, __HIP_MEMORY_SCOPE_AGENT); }
__device__ __forceinline__ unsigned xb_xcc_id() { return (unsigned)__builtin_amdgcn_s_getreg((3 << 11) | 20) & 0xFu; }
#define XB_SPIN(cond, bar) do { unsigned _sp = 0; while (cond) { __builtin_amdgcn_s_sleep(1); \
    if ((++_sp & 255u) == 0u) { if (xb_ld(&(bar)[XB_TMO])) break; if (_sp > XB_SPIN_CAP) { atomicAdd(&(bar)[XB_TMO], 1u); break; } } } } while (0)

struct XcdBarrier {
    unsigned* bar; unsigned x;
    volatile LAS unsigned* st;
};

__device__ __forceinline__ XcdBarrier xcd_barrier_post(unsigned* bar, volatile LAS unsigned* st) {
    XcdBarrier b; b.bar = bar; b.x = xb_xcc_id(); b.st = st;
    if (threadIdx.x == 0) (void)xb_add(&bar[XB_XCNT(b.x)], 1u);
    return b;
}
__device__ __forceinline__ void xcd_barrier_complete(unsigned* bar, unsigned x, unsigned& nloc, unsigned& nx, unsigned& xmask) {
    const unsigned G = gridDim.x * gridDim.y * gridDim.z;
    unsigned sum, cnt, mine, sp = 0u;
    for (;;) {
        sum = 0u; cnt = 0u; mine = 0u; xmask = 0u;
        unsigned cv[16];
        { unsigned* p0 = &bar[XB_XCNT(0)]; unsigned* p1 = &bar[XB_XCNT(8)];
          asm volatile("global_load_dword %0, %8, off sc1\n\tglobal_load_dword %1, %8, off offset:256 sc1\n\tglobal_load_dword %2, %8, off offset:512 sc1\n\tglobal_load_dword %3, %8, off offset:768 sc1\n\t"
                       "global_load_dword %4, %8, off offset:1024 sc1\n\tglobal_load_dword %5, %8, off offset:1280 sc1\n\tglobal_load_dword %6, %8, off offset:1536 sc1\n\tglobal_load_dword %7, %8, off offset:1792 sc1"
                       : "=&v"(cv[0]), "=&v"(cv[1]), "=&v"(cv[2]), "=&v"(cv[3]), "=&v"(cv[4]), "=&v"(cv[5]), "=&v"(cv[6]), "=&v"(cv[7]) : "v"(p0) : "memory");
          asm volatile("global_load_dword %0, %8, off sc1\n\tglobal_load_dword %1, %8, off offset:256 sc1\n\tglobal_load_dword %2, %8, off offset:512 sc1\n\tglobal_load_dword %3, %8, off offset:768 sc1\n\t"
                       "global_load_dword %4, %8, off offset:1024 sc1\n\tglobal_load_dword %5, %8, off offset:1280 sc1\n\tglobal_load_dword %6, %8, off offset:1536 sc1\n\tglobal_load_dword %7, %8, off offset:1792 sc1\n\ts_waitcnt vmcnt(0)"
                       : "=&v"(cv[8]), "=&v"(cv[9]), "=&v"(cv[10]), "=&v"(cv[11]), "=&v"(cv[12]), "=&v"(cv[13]), "=&v"(cv[14]), "=&v"(cv[15]) : "v"(p1) : "memory");
          asm volatile("" : "+v"(cv[0]), "+v"(cv[1]), "+v"(cv[2]), "+v"(cv[3]), "+v"(cv[4]), "+v"(cv[5]), "+v"(cv[6]), "+v"(cv[7])); }
#pragma unroll
        for (unsigned j = 0; j < 16; ++j) { const unsigned c = cv[j]; sum += c; cnt += (c > 0u) ? 1u : 0u; xmask |= (c > 0u) ? (1u << j) : 0u; mine = (j == x) ? c : mine; }
        if (sum == G) break;
        __builtin_amdgcn_s_sleep(1);
        if ((++sp & 255u) == 0u) { if (xb_ld(&bar[XB_TMO])) break; if (sp > XB_SPIN_CAP) { atomicAdd(&bar[XB_TMO], 1u); break; } }
    }
    nloc = mine > 0u ? mine : 1u; nx = cnt > 0u ? cnt : 1u;
}

__device__ __forceinline__ bool xb_flags_pending(unsigned* bar, unsigned xmask, unsigned target) {
    typedef unsigned xb_v4 __attribute__((ext_vector_type(4)));
    xb_v4 f0, f1, f2, f3; unsigned* p = &bar[XB_FLAG];
    asm volatile("global_load_dwordx4 %0, %4, off sc1\n\tglobal_load_dwordx4 %1, %4, off offset:16 sc1\n\tglobal_load_dwordx4 %2, %4, off offset:32 sc1\n\tglobal_load_dwordx4 %3, %4, off offset:48 sc1\n\ts_waitcnt vmcnt(0)"
                 : "=&v"(f0), "=&v"(f1), "=&v"(f2), "=&v"(f3) : "v"(p) : "memory");
    asm volatile("" : "+v"(f0), "+v"(f1), "+v"(f2), "+v"(f3));
    unsigned pend = 0u;
#pragma unroll
    for (int e = 0; e < 4; ++e) { pend |= (f0[e] < target) ? (1u << e) : 0u; pend |= (f1[e] < target) ? (16u << e) : 0u; pend |= (f2[e] < target) ? (256u << e) : 0u; pend |= (f3[e] < target) ? (4096u << e) : 0u; }
    return (pend & xmask) != 0u;
}
__device__ __forceinline__ void xcd_barrier(const XcdBarrier& b) {
    asm volatile("s_waitcnt vmcnt(0)" ::: "memory");
    __syncthreads();
    if (threadIdx.x == 0) {
        unsigned* bar = b.bar;
        __builtin_amdgcn_s_waitcnt(0);
        unsigned nloc = b.st[0], nx = b.st[1], xmask = b.st[3];
        if (nloc == 0u) { xcd_barrier_complete(bar, b.x, nloc, nx, xmask); b.st[0] = nloc; b.st[1] = nx; b.st[3] = xmask; }
        const unsigned round = b.st[2];
        const unsigned old = xb_add(&bar[XB_XSUB(b.x)], 1u);
        const unsigned gen = old / nloc;
        if (old + 1u == (gen + 1u) * nloc) {
            __builtin_amdgcn_fence(__ATOMIC_RELEASE, "agent");
            asm volatile("s_waitcnt vmcnt(0)" ::: "memory");
            __hip_atomic_store(&bar[XB_FLAG + b.x], round + 1u, __ATOMIC_RELAXED, __HIP_MEMORY_SCOPE_AGENT);
        }
        XB_SPIN(xb_flags_pending(bar, xmask, round + 1u), bar);
        __builtin_amdgcn_fence(__ATOMIC_ACQUIRE, "agent");
        asm volatile("s_waitcnt vmcnt(0)" ::: "memory");
        b.st[2] = round + 1u;
    }
    __syncthreads();
}

namespace epi {
using pg8::Unit; using pg8::BM; using pg8::HALF;
typedef const pg8::f32x4 (&AccRef)[2][2][4][2];

struct EpiProj1 {
    static constexpr bool PERM = true, AFTER_DRAIN = false, KEEP_ACC = false;
    bf16* O; const float* cosT; const float* sinT;
    __device__ __forceinline__ void operator()(AccRef acc, const Unit& u, int wr, int wc, int fr, int fq) const {
        const int row0 = u.pm * BM + wr * 64 + fr, colw = u.pn * BM + wc * 32;
#pragma unroll
        for (int bj = 0; bj < 2; ++bj) {
            const int hb = (colw + bj * HALF) >> 6;
            const bool rope = (hb >= 40 && hb < 50) || (hb >= 52 && hb < 54) || (hb >= 56 && hb < 58) || (hb >= 60 && hb < 76);
            const bool isq = (hb >= 40 && hb < 48) || (hb >= 60 && hb < 68);
            const float qs = isq ? QSCALE : 1.0f;
            const int jw = (wc & 1) * 16 + fq * 4;
#pragma unroll
            for (int ai = 0; ai < 2; ++ai)
#pragma unroll
                for (int m = 0; m < 4; ++m) {
                    const int row = row0 + ai * HALF + m * 16;
                    pg8::f32x4 v0 = acc[ai][bj][m][0], v1 = acc[ai][bj][m][1];
                    if (rope) {
                        const pg8::f32x4 c = *(const pg8::f32x4*)(cosT + (size_t)row * 32 + jw), s = *(const pg8::f32x4*)(sinT + (size_t)row * 32 + jw);
                        const float a0 = v0[0] * c[0] - v0[1] * s[0], a1 = v0[1] * c[0] + v0[0] * s[0], a2 = v0[2] * c[1] - v0[3] * s[1], a3 = v0[3] * c[1] + v0[2] * s[1];
                        const float b0 = v1[0] * c[2] - v1[1] * s[2], b1 = v1[1] * c[2] + v1[0] * s[2], b2 = v1[2] * c[3] - v1[3] * s[3], b3 = v1[3] * c[3] + v1[2] * s[3];
                        v0 = (pg8::f32x4){a0, a1, a2, a3} * qs; v1 = (pg8::f32x4){b0, b1, b2, b3} * qs;
                    }
                    v4u w; w.x = pk2(v0[0], v0[1]); w.y = pk2(v0[2], v0[3]); w.z = pk2(v1[0], v1[1]); w.w = pk2(v1[2], v1[3]);
                    *(v4u*)(O + (size_t)row * NP1 + colw + bj * HALF + 8 * fq) = w;
                }
        }
    }
};
struct EpiStoreBf {
    static constexpr bool PERM = true, AFTER_DRAIN = false, KEEP_ACC = false;
    bf16* O; int ldc;
    __device__ __forceinline__ void operator()(AccRef acc, const Unit& u, int wr, int wc, int fr, int fq) const {
        const int row0 = u.pm * BM + wr * 64 + fr, col0 = u.pn * BM + wc * 32 + 8 * fq;
#pragma unroll
        for (int ai = 0; ai < 2; ++ai)
#pragma unroll
            for (int m = 0; m < 4; ++m) { bf16* rowp = O + (size_t)(row0 + ai * HALF + m * 16) * ldc + col0;
#pragma unroll
                for (int bj = 0; bj < 2; ++bj) { const pg8::f32x4 v0 = acc[ai][bj][m][0], v1 = acc[ai][bj][m][1];
                    v4u w; w.x = pk2(v0[0], v0[1]); w.y = pk2(v0[2], v0[3]); w.z = pk2(v1[0], v1[1]); w.w = pk2(v1[2], v1[3]); *(v4u*)(rowp + bj * HALF) = w; } }
    }
};
__device__ __forceinline__ float gate_enc(float a) { return __builtin_fmaf(-2.0f, __builtin_amdgcn_rcpf(1.0f + __builtin_amdgcn_exp2f(a)), 1.0f); }

struct EpiGates {
    static constexpr bool PERM = true, AFTER_DRAIN = false, KEEP_ACC = false;
    unsigned char* O;
    __device__ __forceinline__ void operator()(AccRef acc, const Unit& u, int wr, int wc, int fr, int fq) const {
        const int row0 = u.pm * BM + wr * 64 + fr, col0 = u.pn * BM + wc * 32 + 8 * fq;
#pragma unroll
        for (int ai = 0; ai < 2; ++ai)
#pragma unroll
            for (int m = 0; m < 4; ++m) { unsigned char* rowp = O + (size_t)(row0 + ai * HALF + m * 16) * NGT + col0;
#pragma unroll
                for (int bj = 0; bj < 2; ++bj) { const pg8::f32x4 v0 = acc[ai][bj][m][0], v1 = acc[ai][bj][m][1];
                    v2u w; unsigned p = 0u; p = __builtin_amdgcn_cvt_pk_fp8_f32(gate_enc(v0[0]), gate_enc(v0[1]), p, false); p = __builtin_amdgcn_cvt_pk_fp8_f32(gate_enc(v0[2]), gate_enc(v0[3]), p, true); w.x = p;
                    p = 0u; p = __builtin_amdgcn_cvt_pk_fp8_f32(gate_enc(v1[0]), gate_enc(v1[1]), p, false); p = __builtin_amdgcn_cvt_pk_fp8_f32(gate_enc(v1[2]), gate_enc(v1[3]), p, true); w.y = p;
                    *(v2u*)(rowp + bj * HALF) = w; } }
    }
};
struct EpiMerge {
    static constexpr bool PERM = true, AFTER_DRAIN = false, KEEP_ACC = false;
    bf16* O; const unsigned char* G; int seg;
    __device__ __forceinline__ void operator()(AccRef acc, const Unit& u, int wr, int wc, int fr, int fq) const {
        const int row0 = u.pm * BM + wr * 64 + fr, col0 = u.pn * BM + wc * 32 + 8 * fq;
#pragma unroll
        for (int ai = 0; ai < 2; ++ai)
#pragma unroll
            for (int m = 0; m < 4; ++m) { const size_t row = (size_t)(row0 + ai * HALF + m * 16); bf16* rowp = O + row * DM + col0; const unsigned char* gp = G + row * NGT + seg * DM + col0;
#pragma unroll
                for (int bj = 0; bj < 2; ++bj) { pg8::f32x4 v0 = acc[ai][bj][m][0], v1 = acc[ai][bj][m][1];
                    const v2u g = *(const v2u*)(gp + bj * HALF);
                    const f32x2 g0 = __builtin_amdgcn_cvt_pk_f32_fp8(g.x, false), g1 = __builtin_amdgcn_cvt_pk_f32_fp8(g.x, true), g2 = __builtin_amdgcn_cvt_pk_f32_fp8(g.y, false), g3 = __builtin_amdgcn_cvt_pk_f32_fp8(g.y, true);
                    v0[0] *= 0.5f * g0.x + 0.5f; v0[1] *= 0.5f * g0.y + 0.5f; v0[2] *= 0.5f * g1.x + 0.5f; v0[3] *= 0.5f * g1.y + 0.5f;
                    v1[0] *= 0.5f * g2.x + 0.5f; v1[1] *= 0.5f * g2.y + 0.5f; v1[2] *= 0.5f * g3.x + 0.5f; v1[3] *= 0.5f * g3.y + 0.5f;
                    if (seg != 0) { const v4u o = *(const v4u*)(rowp + bj * HALF); v0[0] += bflo(o.x); v0[1] += bfhi(o.x); v0[2] += bflo(o.y); v0[3] += bfhi(o.y); v1[0] += bflo(o.z); v1[1] += bfhi(o.z); v1[2] += bflo(o.w); v1[3] += bfhi(o.w); }
                    v4u w; w.x = pk2(v0[0], v0[1]); w.y = pk2(v0[2], v0[3]); w.z = pk2(v1[0], v1[1]); w.w = pk2(v1[2], v1[3]); *(v4u*)(rowp + bj * HALF) = w; } }
    }
};
struct EpiResid {
    static constexpr bool PERM = false, AFTER_DRAIN = false, KEEP_ACC = false;
    const float* XI; float* XO; const float* gate;
    __device__ __forceinline__ void operator()(AccRef acc, const Unit& u, int wr, int wc, int fr, int fq) const {
        const int row0 = u.pm * BM + wr * 64 + fr, col0 = u.pn * BM + wc * 32 + 4 * fq;
        const float* gb = gate + (size_t)((u.pm * BM) / SEQ) * 6144 + col0;
        pg8::f32x4 gv[2][2];
#pragma unroll
        for (int bj = 0; bj < 2; ++bj)
#pragma unroll
            for (int n = 0; n < 2; ++n) gv[bj][n] = *(const pg8::f32x4*)(gb + bj * HALF + n * 16);
#pragma unroll
        for (int ai = 0; ai < 2; ++ai) { pg8::f32x4 xi[4][2][2];
#pragma unroll
            for (int m = 0; m < 4; ++m) { const size_t off = (size_t)(row0 + ai * HALF + m * 16) * DM + col0;
#pragma unroll
                for (int bj = 0; bj < 2; ++bj)
#pragma unroll
                    for (int n = 0; n < 2; ++n) xi[m][bj][n] = *(const pg8::f32x4*)(XI + off + bj * HALF + n * 16); }
            __builtin_amdgcn_sched_barrier(0);
#pragma unroll
            for (int m = 0; m < 4; ++m) { const size_t off = (size_t)(row0 + ai * HALF + m * 16) * DM + col0;
#pragma unroll
                for (int bj = 0; bj < 2; ++bj)
#pragma unroll
                    for (int n = 0; n < 2; ++n) *(pg8::f32x4*)(XO + off + bj * HALF + n * 16) = xi[m][bj][n] + gv[bj][n] * acc[ai][bj][m][n]; } }
    }
};

struct PanelRms {
    float* xbuf;
    unsigned* cnt;
    unsigned* tmo;
    __device__ __forceinline__ bool run(const pg8::f32x4 (&v)[2][2][4][2], const Unit& u, int wr, int wc, int fr, int fq, PG8_LAS unsigned char* lds, int wid, int lane) const {
        PG8_LAS float* P = (PG8_LAS float*)lds;
        PG8_LAS float* S = (PG8_LAS float*)(lds + 8192);
        PG8_LAS unsigned* flag = (PG8_LAS unsigned*)(lds + 8192 + 2048);
        float sq[2][4];
#pragma unroll
        for (int ai = 0; ai < 2; ++ai)
#pragma unroll
            for (int m = 0; m < 4; ++m) { float q = 0.f;
#pragma unroll
                for (int bj = 0; bj < 2; ++bj)
#pragma unroll
                    for (int n = 0; n < 2; ++n) { const pg8::f32x4 x = v[ai][bj][m][n]; q += (x[0] * x[0] + x[1] * x[1]) + (x[2] * x[2] + x[3] * x[3]); }
                sq[ai][m] = q; }
#pragma unroll
        for (int o = 16; o <= 32; o <<= 1) { float t[2][4];
#pragma unroll
            for (int ai = 0; ai < 2; ++ai)
#pragma unroll
                for (int m = 0; m < 4; ++m) t[ai][m] = shx(sq[ai][m], o, lane);
#pragma unroll
            for (int ai = 0; ai < 2; ++ai)
#pragma unroll
                for (int m = 0; m < 4; ++m) sq[ai][m] += t[ai][m]; }
        if (fq == 0) {
#pragma unroll
            for (int ai = 0; ai < 2; ++ai)
#pragma unroll
                for (int m = 0; m < 4; ++m) P[(ai * HALF + wr * 64 + m * 16 + fr) * 4 + wc] = sq[ai][m]; }
        asm volatile("s_waitcnt lgkmcnt(0)" ::: "memory"); __builtin_amdgcn_s_barrier(); asm volatile("" ::: "memory");
        const int row = wid * 32 + (lane & 31);
        if (lane < 32) { const float tot = (P[row * 4 + 0] + P[row * 4 + 1]) + (P[row * 4 + 2] + P[row * 4 + 3]);
            __hip_atomic_store((unsigned*)xbuf + ((size_t)(u.pm * BM + row) * 4 + u.pn), __builtin_bit_cast(unsigned, tot), __ATOMIC_RELAXED, __HIP_MEMORY_SCOPE_AGENT); }
        asm volatile("s_waitcnt vmcnt(0)" ::: "memory");
        if (lane == 0) __hip_atomic_fetch_add(cnt + 64 * u.pm, 1u, __ATOMIC_RELAXED, __HIP_MEMORY_SCOPE_AGENT);
        if (wid == 0) { bool dead = false; unsigned sp = 0u;
            for (;;) {
                if ((unsigned)__builtin_amdgcn_readfirstlane((int)__hip_atomic_load(cnt + 64 * u.pm, __ATOMIC_RELAXED, __HIP_MEMORY_SCOPE_AGENT)) >= 32u) break;
                if (++sp > (1u << 18) || ((sp & 255u) == 0u && __hip_atomic_load(tmo, __ATOMIC_RELAXED, __HIP_MEMORY_SCOPE_AGENT) != 0u)) { if (lane == 0) __hip_atomic_store(tmo, 1u, __ATOMIC_RELAXED, __HIP_MEMORY_SCOPE_AGENT); dead = true; break; }
                __builtin_amdgcn_s_sleep(2);
            }
            __builtin_amdgcn_fence(__ATOMIC_ACQUIRE, "agent");
            if (lane == 0) flag[0] = dead ? 1u : 0u; }
        asm volatile("s_waitcnt vmcnt(0) lgkmcnt(0)" ::: "memory"); __builtin_amdgcn_s_barrier(); asm volatile("" ::: "memory");
        const bool bad = flag[0] != 0u;
        if (lane < 32) { const unsigned* slot = (const unsigned*)xbuf + (size_t)(u.pm * BM + row) * 4; float q = 0.f;
#pragma unroll
            for (int t = 0; t < 4; ++t) q += __builtin_bit_cast(float, __hip_atomic_load(slot + t, __ATOMIC_RELAXED, __HIP_MEMORY_SCOPE_AGENT));
            S[row] = 1.0f / sqrtf(q * (1.0f / DM) + NORM_EPS); }
        asm volatile("s_waitcnt lgkmcnt(0)" ::: "memory"); __builtin_amdgcn_s_barrier(); asm volatile("" ::: "memory");
        return bad;
    }
};
struct EpiResidNorm {
    static constexpr bool PERM = true, AFTER_DRAIN = true, KEEP_ACC = false;
    const float* XI; float* XO; const float* gate;
    const float* g; const float* sh; const float* sc; bf16* HN;
    PanelRms st;
    __device__ __forceinline__ void operator()(AccRef, const Unit&, int, int, int, int) const {}
    __device__ __forceinline__ void fused(pg8::f32x4 (&acc)[2][2][4][2], const Unit& u, int wr, int wc, int fr, int fq, PG8_LAS unsigned char* lds, int wid, int lane) const {
        const int row0 = u.pm * BM + wr * 64 + fr, col0 = u.pn * BM + wc * 32 + 8 * fq, bidx = (u.pm * BM) / SEQ;
        { const float* gb = gate + (size_t)bidx * 6144 + col0; pg8::f32x4 gv[2][2];
#pragma unroll
          for (int bj = 0; bj < 2; ++bj)
#pragma unroll
              for (int n = 0; n < 2; ++n) gv[bj][n] = *(const pg8::f32x4*)(gb + bj * HALF + n * 4);
#pragma unroll
          for (int ai = 0; ai < 2; ++ai) { pg8::f32x4 xi[4][2][2];
#pragma unroll
              for (int m = 0; m < 4; ++m) { const size_t off = (size_t)(row0 + ai * HALF + m * 16) * DM + col0;
#pragma unroll
                  for (int bj = 0; bj < 2; ++bj)
#pragma unroll
                      for (int n = 0; n < 2; ++n) xi[m][bj][n] = *(const pg8::f32x4*)(XI + off + bj * HALF + n * 4); }
              __builtin_amdgcn_sched_barrier(0);
#pragma unroll
              for (int m = 0; m < 4; ++m) { const size_t off = (size_t)(row0 + ai * HALF + m * 16) * DM + col0;
#pragma unroll
                  for (int bj = 0; bj < 2; ++bj)
#pragma unroll
                      for (int n = 0; n < 2; ++n) { const pg8::f32x4 x = xi[m][bj][n] + gv[bj][n] * acc[ai][bj][m][n]; acc[ai][bj][m][n] = x; *(pg8::f32x4*)(XO + off + bj * HALF + n * 4) = x; } } } }
        const bool bad = st.run(acc, u, wr, wc, fr, fq, lds, wid, lane);
        const PG8_LAS float* S = (const PG8_LAS float*)(lds + 8192);
        const float qnan = __builtin_nanf("");
#pragma unroll
        for (int bj = 0; bj < 2; ++bj) { const int c = col0 + bj * HALF;
            pg8::f32x4 mul[2], shv[2];
#pragma unroll
            for (int n = 0; n < 2; ++n) { mul[n] = *(const pg8::f32x4*)(g + c + 4 * n) * (*(const pg8::f32x4*)(sc + (size_t)bidx * 6144 + c + 4 * n) + 1.0f); shv[n] = *(const pg8::f32x4*)(sh + (size_t)bidx * 6144 + c + 4 * n); }
#pragma unroll
            for (int ai = 0; ai < 2; ++ai)
#pragma unroll
                for (int m = 0; m < 4; ++m) { const int r = ai * HALF + wr * 64 + m * 16 + fr; const float rs = bad ? qnan : S[r];
                    const pg8::f32x4 y0 = acc[ai][bj][m][0] * rs * mul[0] + shv[0], y1 = acc[ai][bj][m][1] * rs * mul[1] + shv[1];
                    *(v4u*)(HN + (size_t)(u.pm * BM + r) * DM + c) = (v4u){pk2(y0[0], y0[1]), pk2(y0[2], y0[3]), pk2(y1[0], y1[1]), pk2(y1[2], y1[3])}; } }
    }
};
struct EpiProjAll {
    static constexpr bool PERM = true, AFTER_DRAIN = false, KEEP_ACC = false;
    static_assert(true, ""); EpiProj1 P; EpiGates G;
    __device__ __forceinline__ void operator()(AccRef acc, const Unit& u, int wr, int wc, int fr, int fq) const {
        if (u.pn < NP1 / BM) P(acc, u, wr, wc, fr, fq);
        else { Unit v = u; v.pn -= NP1 / BM; G(acc, v, wr, wc, fr, fq); }
    }
};
__device__ __forceinline__ void gates8w(const v2u w, float (&g)[8]) {
    const f32x2 a = __builtin_amdgcn_cvt_pk_f32_fp8(w.x, false), b = __builtin_amdgcn_cvt_pk_f32_fp8(w.x, true), c = __builtin_amdgcn_cvt_pk_f32_fp8(w.y, false), d = __builtin_amdgcn_cvt_pk_f32_fp8(w.y, true);
    g[0] = fmaxf(0.5f * a.x + 0.5f, 0x1p-10f); g[1] = fmaxf(0.5f * a.y + 0.5f, 0x1p-10f); g[2] = fmaxf(0.5f * b.x + 0.5f, 0x1p-10f); g[3] = fmaxf(0.5f * b.y + 0.5f, 0x1p-10f);
    g[4] = fmaxf(0.5f * c.x + 0.5f, 0x1p-10f); g[5] = fmaxf(0.5f * c.y + 0.5f, 0x1p-10f); g[6] = fmaxf(0.5f * d.x + 0.5f, 0x1p-10f); g[7] = fmaxf(0.5f * d.y + 0.5f, 0x1p-10f);
}
__device__ __forceinline__ void gates8(const unsigned char* p, float (&g)[8]) { gates8w(*(const v2u*)p, g); }
struct EpiMergeAll {
    static constexpr bool PERM = true, AFTER_DRAIN = false, KEEP_ACC = true;
    bf16* O; const unsigned char* G;
    __device__ __forceinline__ void operator()(AccRef, const Unit&, int, int, int, int) const {}
    __device__ __forceinline__ void inplace(pg8::f32x4 (&acc)[2][2][4][2], const Unit& u, int wr, int wc, int fr, int fq) const {
        const int seg = u.pm >> 6, pm = u.pm & 63, pn = u.pn & 3;
        const int row0 = pm * BM + wr * 64 + fr, col0 = pn * BM + wc * 32 + 8 * fq;
#pragma unroll
        for (int ai = 0; ai < 2; ++ai) {
            v2u gcw[4][2], gnw[4][2];
#pragma unroll
            for (int m = 0; m < 4; ++m) { const unsigned char* gp = G + (size_t)(row0 + ai * HALF + m * 16) * NGT + seg * DM + col0;
#pragma unroll
                for (int bj = 0; bj < 2; ++bj) { gcw[m][bj] = *(const v2u*)(gp + bj * HALF); gnw[m][bj] = seg < 3 ? *(const v2u*)(gp + DM + bj * HALF) : (v2u){0u, 0u}; } }
            __builtin_amdgcn_sched_barrier(0);
#pragma unroll
            for (int m = 0; m < 4; ++m) { const size_t row = (size_t)(row0 + ai * HALF + m * 16);
#pragma unroll
                for (int bj = 0; bj < 2; ++bj) { float gc[8]; gates8w(gcw[m][bj], gc);
                    pg8::f32x4& v0 = acc[ai][bj][m][0]; pg8::f32x4& v1 = acc[ai][bj][m][1];
                    if (seg < 3) { float gn[8]; gates8w(gnw[m][bj], gn);
#pragma unroll
                        for (int e = 0; e < 4; ++e) { v0[e] *= gc[e] * __builtin_amdgcn_rcpf(gn[e]); v1[e] *= gc[4 + e] * __builtin_amdgcn_rcpf(gn[4 + e]); } }
                    else {
#pragma unroll
                        for (int e = 0; e < 4; ++e) { v0[e] *= gc[e]; v1[e] *= gc[4 + e]; }
                        v4u w; w.x = pk2(v0[0], v0[1]); w.y = pk2(v0[2], v0[3]); w.z = pk2(v1[0], v1[1]); w.w = pk2(v1[2], v1[3]); *(v4u*)(O + row * DM + col0 + bj * HALF) = w;
                        v0 = (pg8::f32x4){0.f, 0.f, 0.f, 0.f}; v1 = (pg8::f32x4){0.f, 0.f, 0.f, 0.f}; } } } }
    }
};
struct MergeOrder {
    pg8::StaticOrder S;
    __device__ void init(int G_, int c_) { S.init(TOK, DM, G_, c_); }
    __device__ bool next(int i, Unit& u) const { Unit b; if (!S.next(i >> 2, b)) return false; const int seg = i & 3; u.pm = seg * 64 + b.pm; u.pn = seg * 4 + b.pn; return true; }
    __device__ __forceinline__ void a_ready(const Unit&) const {}
    __device__ __forceinline__ void done(const Unit&) const {}
};
}

#ifndef SBAR
#define SBAR() __builtin_amdgcn_sched_barrier(0)
#endif
constexpr int NWAVES = 8, NTHR = 512;
struct Args { const void* in[26]; float* out; unsigned char* ws; int ph_lo, ph_hi; };
enum InIdx { I_X = 0, I_C, I_POS, I_MODW, I_MODB, I_NMG, I_NFG, I_WIN, I_ACW, I_AOUT, I_BCW, I_BCB, I_BLNG, I_BLNB, I_BOUT, I_CPOS, I_CW1, I_CW2, I_COUT, I_DOUT, I_WO, I_PWQ, I_PSUB, I_PU, I_PV, I_FNG };

struct Frame {
    LAS unsigned char* lds; unsigned char* ldsg;
    int tid, lane, wave, G, bid;
    unsigned char* ws;
};
__device__ __forceinline__ int gwave(const Frame& F) { return F.bid * NWAVES + F.wave; }
__device__ __forceinline__ int ngwave(const Frame& F) { return F.G * NWAVES; }

__device__ __forceinline__ int rope_pos_of_dim(int d) { return d < 32 ? 2 * d : 2 * (d - 32) + 1; }
__device__ __forceinline__ int rope_dim_of_pos(int p) { return (p >> 1) + 32 * (p & 1); }
__device__ __forceinline__ int win_row_of_col(int n) {
    if (n < 2560) return n;
    if (n < 3072) { const int c = n - 2560; return C_CQ + (c & ~63) + rope_pos_of_dim(c & 63); }
    if (n < 3200) { const int c = n - 3072; return C_KC + (c & ~63) + rope_pos_of_dim(c & 63); }
    if (n < 3328) return C_VC + (n - 3200);
    if (n < 3456) { const int c = n - 3328; return C_KS + (c & ~63) + rope_pos_of_dim(c & 63); }
    if (n < 3584) return C_VS + (n - 3456);
    if (n < 3712) { const int c = n - 3584; return C_KW + (c & ~63) + rope_pos_of_dim(c & 63); }
    if (n < 3840) return C_VW + (n - 3712);
    if (n < 3864) return C_CG + (n - 3840);
    if (n < 4376) { const int c = n - 3864; return C_DQ + (c & ~63) + rope_pos_of_dim(c & 63); }
    if (n < 4888) { const int c = n - 4376; return C_DK + (c & ~63) + rope_pos_of_dim(c & 63); }
    if (n < 5400) return C_DV + (n - 4888);
    return NP1 + (n - 5400);
}
constexpr int TR_SCR = 17408;
template <int MODE, bool KPERM>
__device__ __forceinline__ void transpose_item(const float* W, int K, int N, bf16* WT, LAS float* scr, int item, int lane) {
    const int nblk = (N + 63) / 64, kb = item / nblk, nb = item % nblk, k0 = 64 * kb, n0 = 64 * nb;
    const int nq = (lane & 15) * 4; const bool nok = n0 + nq < N;
    f32x4 tv[16];
#pragma unroll
    for (int i = 0; i < 16; ++i) { const int kk = 4 * i + (lane >> 4); tv[i] = nok ? *(const f32x4*)(W + (size_t)(k0 + kk) * N + n0 + nq) : (f32x4){0.f, 0.f, 0.f, 0.f}; }
    SBAR();
#pragma unroll
    for (int i = 0; i < 16; ++i) { const int kk = 4 * i + (lane >> 4); const f32x4 v = tv[i];
        LAS float* d = scr + kk * 65 + nq; d[0] = v[0]; d[1] = v[1]; d[2] = v[2]; d[3] = v[3]; }
    LDS_WAIT(); asm volatile("" ::: "memory");
    const int c = lane & 7;
#pragma unroll
    for (int j = 0; j < 8; ++j) { const int n = (lane >> 3) + 8 * j;
        const int row = (MODE == 1) ? win_row_of_col(n0 + n < N ? n0 + n : 0) : (n0 + n);
        const float wsc = (MODE == 1 && row >= NP1) ? 1.4426950408889634f : 1.0f;
        float s[8];
#pragma unroll
        for (int e = 0; e < 8; ++e) { const int p = 8 * c + e; const int ks = KPERM ? rope_dim_of_pos(p) : p; s[e] = scr[ks * 65 + n] * wsc; }
        v4u o; o.x = pk2(s[0], s[1]); o.y = pk2(s[2], s[3]); o.z = pk2(s[4], s[5]); o.w = pk2(s[6], s[7]);
        if (n0 + n < N) *(v4u*)(WT + (size_t)row * K + k0 + 8 * c) = o; }
    LDS_WAIT(); asm volatile("" ::: "memory");
}
template <int MODE, bool KPERM>
__device__ __forceinline__ void transpose_matrix(const Frame& F, const float* W, int K, int N, bf16* WT, int& base) {
    LAS float* scr = (LAS float*)(F.lds + F.wave * TR_SCR);
    const int nitems = (K / 64) * ((N + 63) / 64), gw = gwave(F), NGW = ngwave(F);
    int first = (gw - base % NGW + NGW) % NGW;
    for (int it = first; it < nitems; it += NGW) transpose_item<MODE, KPERM>(W, K, N, WT, scr, it, F.lane);
    base += nitems;
}
__device__ __forceinline__ void convert_copy(const Frame& F, const float* src, bf16* dst, size_t n) {
    const size_t nth = (size_t)F.G * NTHR, t0 = (size_t)F.bid * NTHR + F.tid;
    for (size_t i = t0; i < n / 8; i += nth) { const f32x4 a = *(const f32x4*)(src + i * 8), b = *(const f32x4*)(src + i * 8 + 4);
        v4u o; o.x = pk2(a[0], a[1]); o.y = pk2(a[2], a[3]); o.z = pk2(b[0], b[1]); o.w = pk2(b[2], b[3]); *(v4u*)(dst + i * 8) = o; }
}

typedef __attribute__((address_space(4))) const Args* KArgsP;
__device__ __forceinline__ void phase_prologue(const Frame& F, KArgsP Ap) {
    unsigned char* ws = F.ws;
    int base = 0;
    for (int l = 0; l < DEPTH; ++l) {
        transpose_matrix<1, false>(F, (const float*)(GAS const void*)Ap->in[I_WIN] + (size_t)l * DM * 9496, DM, 9496, (bf16*)(ws + WS_WIN) + (size_t)l * NWIN * DM, base);
        transpose_matrix<0, false>(F, (const float*)(GAS const void*)Ap->in[I_AOUT] + (size_t)l * 512 * DM, 512, DM, (bf16*)(ws + WS_WOUT) + (size_t)(l * 4 + 0) * DM * 512, base);
        transpose_matrix<0, false>(F, (const float*)(GAS const void*)Ap->in[I_BOUT] + (size_t)l * 512 * DM, 512, DM, (bf16*)(ws + WS_WOUT) + (size_t)(l * 4 + 1) * DM * 512, base);
        transpose_matrix<0, false>(F, (const float*)(GAS const void*)Ap->in[I_COUT] + (size_t)l * 512 * DM, 512, DM, (bf16*)(ws + WS_WOUT) + (size_t)(l * 4 + 2) * DM * 512, base);
        transpose_matrix<0, false>(F, (const float*)(GAS const void*)Ap->in[I_DOUT] + (size_t)l * 512 * DM, 512, DM, (bf16*)(ws + WS_WOUT) + (size_t)(l * 4 + 3) * DM * 512, base);
        transpose_matrix<0, false>(F, (const float*)(GAS const void*)Ap->in[I_WO] + (size_t)l * DM * DM, DM, DM, (bf16*)(ws + WS_WO) + (size_t)l * DM * DM, base);
        transpose_matrix<0, false>(F, (const float*)(GAS const void*)Ap->in[I_PWQ] + (size_t)l * DM * 2048, DM, 2048, (bf16*)(ws + WS_WQ) + (size_t)l * 2048 * DM, base);
        transpose_matrix<0, true>(F, (const float*)(GAS const void*)Ap->in[I_CW1] + (size_t)(l * 2 + 0) * 2048 * 128, 2048, 128, (bf16*)(ws + WS_W1T) + (size_t)(l * 2 + 0) * 128 * 2048, base);
        transpose_matrix<0, false>(F, (const float*)(GAS const void*)Ap->in[I_CW1] + (size_t)(l * 2 + 1) * 2048 * 128, 2048, 128, (bf16*)(ws + WS_W1T) + (size_t)(l * 2 + 1) * 128 * 2048, base);
    }
    convert_copy(F, (const float*)(GAS const void*)Ap->in[I_PSUB], (bf16*)(ws + WS_SUBK), (size_t)DEPTH * 8 * 2 * 128 * 128);
    const int gt = F.bid * NTHR + F.tid, NGT_ = F.G * NTHR;
    { const float* w2 = (const float*)(GAS const void*)Ap->in[I_CW2]; bf16* w2t = (bf16*)(ws + WS_SMALL + SM_W2T);
      for (int i = gt; i < DEPTH * 2 * 64 * 128; i += NGT_) { const int k = i & 127, n = (i >> 7) & 63, lw = i >> 13; w2t[i] = (bf16)f2bf(w2[((size_t)lw * 128 + k) * 64 + n]); } }
    { const int* pos = (const int*)(GAS const void*)Ap->in[I_POS]; float* ct = (float*)(ws + WS_COS); float* st = (float*)(ws + WS_SIN);
      for (int i = gt; i < TOK * 32; i += NGT_) { const int t = i >> 5, j = i & 31;
          const float inv = 1.0f / powf(10000.0f, (float)(2 * j) / 64.0f); const float ang = (float)pos[t] * inv;
          ct[i] = (float)cos((double)ang); st[i] = (float)sin((double)ang); } }
    { const float* w1 = (const float*)(GAS const void*)Ap->in[I_CW1]; const float* cp = (const float*)(GAS const void*)Ap->in[I_CPOS]; float* pbp = (float*)(ws + WS_SMALL + SM_PBP);
      for (int i = gt; i < DEPTH * 2 * 16 * 128; i += NGT_) { const int n = i & 127, kc = (i >> 7) & 15, lw = i >> 11; float s = 0.f;
#pragma unroll 32
          for (int k = kc * 128; k < kc * 128 + 128; ++k) s += cp[(size_t)lw * 2048 + k] * w1[((size_t)lw * 2048 + k) * 128 + n];
          pbp[i] = s; } }
    __syncthreads();
    { LAS float* cond = (LAS float*)(F.lds);
      LAS float* red = (LAS float*)(F.lds + 32768);
      const float* c = (const float*)(GAS const void*)Ap->in[I_C];
      for (int i = F.tid; i < 8 * 1024; i += NTHR) { const float v = c[i]; cond[i] = v / (1.0f + __expf(-v)); }
      __syncthreads();
      for (int un = F.bid; un < DEPTH * 96; un += F.G) { const int l = un / 96, n0 = (un % 96) * 64;
          const float* mw = (const float*)(GAS const void*)Ap->in[I_MODW] + (size_t)l * DM * 6144 + n0 + F.lane;
          float acc[8];
#pragma unroll
          for (int b = 0; b < 8; ++b) acc[b] = 0.f;
#pragma unroll 32
          for (int k = F.wave * 128; k < F.wave * 128 + 128; ++k) { const float w = mw[(size_t)k * 6144];
#pragma unroll
              for (int b = 0; b < 8; ++b) acc[b] += cond[b * 1024 + k] * w; }
#pragma unroll
          for (int b = 0; b < 8; ++b) red[(F.wave * 8 + b) * 64 + F.lane] = acc[b];
          __syncthreads();
          { const int b = F.tid >> 6, n = F.tid & 63; float s = 0.f;
#pragma unroll
            for (int w = 0; w < 8; ++w) s += red[(w * 8 + b) * 64 + n];
            ((float*)(ws + WS_MOD))[((size_t)l * 8 + b) * 6144 + n0 + n] = s + ((const float*)(GAS const void*)Ap->in[I_MODB])[(size_t)l * 6144 + n0 + n]; }
          __syncthreads(); }
    }
}

__device__ __forceinline__ void phase_norm_mod(const Frame& F, const float* X, const float* g, const float* sh, const float* sc, bf16* O, unsigned char* O8 = nullptr, float* OS = nullptr) {
    const int gw = gwave(F), NGW = ngwave(F);
    f32x4 gv[4];
#pragma unroll
    for (int j = 0; j < 4; ++j) gv[j] = *(const f32x4*)(g + 4 * F.lane + 256 * j);
    for (int row0 = gw; row0 < TOK; row0 += 2 * NGW) {
        f32x4 v[2][4], scv[2][4], shv[2][4]; float s[2];
#pragma unroll
        for (int u = 0; u < 2; ++u) { const int row = row0 + u * NGW, b = row / SEQ; const float* xr = X + (size_t)row * DM + 4 * F.lane;
#pragma unroll
            for (int j = 0; j < 4; ++j) { v[u][j] = *(const f32x4*)(xr + 256 * j); scv[u][j] = *(const f32x4*)(sc + (size_t)b * 6144 + 4 * F.lane + 256 * j); shv[u][j] = *(const f32x4*)(sh + (size_t)b * 6144 + 4 * F.lane + 256 * j); } }
#pragma unroll
        for (int u = 0; u < 2; ++u) { s[u] = 0.f;
#pragma unroll
            for (int j = 0; j < 4; ++j) s[u] += (v[u][j][0] * v[u][j][0] + v[u][j][1] * v[u][j][1]) + (v[u][j][2] * v[u][j][2] + v[u][j][3] * v[u][j][3]); }
        float r[2];
#pragma unroll
        for (int u = 0; u < 2; ++u) r[u] = 1.0f / sqrtf(wave_sum(s[u], F.lane) * (1.0f / DM) + NORM_EPS);
        float mx[2] = {0.f, 0.f};
#pragma unroll
        for (int u = 0; u < 2; ++u) { const int row = row0 + u * NGW; bf16* orow = O + (size_t)row * DM + 4 * F.lane;
#pragma unroll
            for (int j = 0; j < 4; ++j) { const f32x4 y = v[u][j] * r[u] * gv[j] * (scv[u][j] + 1.0f) + shv[u][j]; v2u w; w.x = pk2(y[0], y[1]); w.y = pk2(y[2], y[3]); *(v2u*)(orow + 256 * j) = w; v[u][j] = y;
                mx[u] = fmaxf(fmaxf(mx[u], fmaxf(fabsf(y[0]), fabsf(y[1]))), fmaxf(fabsf(y[2]), fabsf(y[3]))); } }
        if (O8) {
#pragma unroll
            for (int o = 1; o < 32; o <<= 1) { mx[0] = fmaxf(mx[0], shx(mx[0], o, F.lane)); mx[1] = fmaxf(mx[1], shx(mx[1], o, F.lane)); }
#pragma unroll
            for (int u = 0; u < 2; ++u) { const int row = row0 + u * NGW; const float m = max32(mx[u]);
                const float qs = m > 0.f ? 127.0f / m : 0.f;
#pragma unroll
                for (int j = 0; j < 4; ++j) *(unsigned*)(O8 + (size_t)row * DM + 4 * F.lane + 256 * j) =
                    ((unsigned)(int)rintf(v[u][j][0] * qs) & 0xffu) | (((unsigned)(int)rintf(v[u][j][1] * qs) & 0xffu) << 8) | (((unsigned)(int)rintf(v[u][j][2] * qs) & 0xffu) << 16) | (((unsigned)(int)rintf(v[u][j][3] * qs) & 0xffu) << 24);
                if (F.lane == 0) OS[row] = m * (1.0f / 127.0f); }
        }
    }
}
__device__ __forceinline__ void phase_final_norm(const Frame& F, const float* X, const float* g, float* O) {
    const int gw = gwave(F), NGW = ngwave(F);
    f32x4 gv[4];
#pragma unroll
    for (int j = 0; j < 4; ++j) gv[j] = *(const f32x4*)(g + 4 * F.lane + 256 * j);
    for (int row0 = gw; row0 < TOK; row0 += 2 * NGW) {
        f32x4 v[2][4]; float s[2];
#pragma unroll
        for (int u = 0; u < 2; ++u) { const float* xr = X + (size_t)(row0 + u * NGW) * DM + 4 * F.lane;
#pragma unroll
            for (int j = 0; j < 4; ++j) v[u][j] = *(const f32x4*)(xr + 256 * j); }
#pragma unroll
        for (int u = 0; u < 2; ++u) { s[u] = 0.f;
#pragma unroll
            for (int j = 0; j < 4; ++j) s[u] += (v[u][j][0] * v[u][j][0] + v[u][j][1] * v[u][j][1]) + (v[u][j][2] * v[u][j][2] + v[u][j][3] * v[u][j][3]); }
#pragma unroll
        for (int u = 0; u < 2; ++u) { const float r = 1.0f / sqrtf(wave_sum(s[u], F.lane) * (1.0f / DM) + NORM_EPS);
            float* orow = O + (size_t)(row0 + u * NGW) * DM + 4 * F.lane;
#pragma unroll
            for (int j = 0; j < 4; ++j) *(f32x4*)(orow + 256 * j) = v[u][j] * r * gv[j]; }
    }
}

__device__ __forceinline__ void phase_mixer_a(const Frame& F, const bf16* P, const float* cw  , bf16* O  ) {
    const int nth = F.G * NTHR, gt = F.bid * NTHR + F.tid;
    for (int it = gt; it < (TOK / 8) * 64; it += nth) {
        const int cg = it & 63, tb = it >> 6, c0 = cg * 8, t0 = tb * 8, s0 = t0 % SEQ;
        v4u acv[10], axv[10], abv[8];
#pragma unroll
        for (int j = 0; j < 10; ++j) { const int tr = t0 - 2 + j; const bf16* r = P + (size_t)(tr > 0 ? tr : 0) * NP1; acv[j] = *(const v4u*)(r + C_AC + c0); axv[j] = *(const v4u*)(r + C_AX + c0); }
#pragma unroll
        for (int j = 0; j < 8; ++j) abv[j] = *(const v4u*)(P + (size_t)(t0 + j) * NP1 + C_AB + c0);
        float w0[8], w1[8], w2[8];
#pragma unroll
        for (int e = 0; e < 8; ++e) { w0[e] = cw[c0 + e]; w1[e] = cw[512 + c0 + e]; w2[e] = cw[1024 + c0 + e]; }
        float pm2[8], pm1[8];
#pragma unroll
        for (int j = 0; j < 2; ++j) { const v4u ac = acv[j], ax = axv[j]; const float z = (s0 - 2 + j >= 0) ? 1.0f : 0.0f;
            float pr[8]; pr[0] = bflo(ac.x) * bflo(ax.x); pr[1] = bfhi(ac.x) * bfhi(ax.x); pr[2] = bflo(ac.y) * bflo(ax.y); pr[3] = bfhi(ac.y) * bfhi(ax.y);
            pr[4] = bflo(ac.z) * bflo(ax.z); pr[5] = bfhi(ac.z) * bfhi(ax.z); pr[6] = bflo(ac.w) * bflo(ax.w); pr[7] = bfhi(ac.w) * bfhi(ax.w);
#pragma unroll
            for (int e = 0; e < 8; ++e) { if (j == 0) pm2[e] = pr[e] * z; else pm1[e] = pr[e] * z; } }
#pragma unroll
        for (int tt = 0; tt < 8; ++tt) {
            const v4u ac = acv[tt + 2], ax = axv[tt + 2], ab = abv[tt];
            float pr[8], bb[8], y[8];
            pr[0] = bflo(ac.x) * bflo(ax.x); pr[1] = bfhi(ac.x) * bfhi(ax.x); pr[2] = bflo(ac.y) * bflo(ax.y); pr[3] = bfhi(ac.y) * bfhi(ax.y);
            pr[4] = bflo(ac.z) * bflo(ax.z); pr[5] = bfhi(ac.z) * bfhi(ax.z); pr[6] = bflo(ac.w) * bflo(ax.w); pr[7] = bfhi(ac.w) * bfhi(ax.w);
            bb[0] = bflo(ab.x); bb[1] = bfhi(ab.x); bb[2] = bflo(ab.y); bb[3] = bfhi(ab.y); bb[4] = bflo(ab.z); bb[5] = bfhi(ab.z); bb[6] = bflo(ab.w); bb[7] = bfhi(ab.w);
#pragma unroll
            for (int e = 0; e < 8; ++e) { y[e] = bb[e] * (w0[e] * pm2[e] + w1[e] * pm1[e] + w2[e] * pr[e]); pm2[e] = pm1[e]; pm1[e] = pr[e]; }
            v4u o; o.x = pk2(y[0], y[1]); o.y = pk2(y[2], y[3]); o.z = pk2(y[4], y[5]); o.w = pk2(y[6], y[7]);
            *(v4u*)(O + (size_t)(t0 + tt) * 512 + c0) = o; }
    }
}

__device__ __forceinline__ void phase_mixer_b(const Frame& F, const bf16* P, const float* cw  , const float* cb, const float* lg, const float* lb, bf16* O) {
    LAS float* U = (LAS float*)F.lds;
    for (int un = F.bid; un < TOK / 32; un += F.G) {
        const int t0 = un * 32, s0 = t0 % SEQ;
        __syncthreads();
        { v4u av[8], gv[8];
#pragma unroll
          for (int j = 0; j < 8; ++j) { const int i = F.tid + j * NTHR, r = (i >> 6) < 61 ? (i >> 6) : 61, c0 = (i & 63) * 8; const int tr = t0 - 30 + r;
              const bf16* row = P + (size_t)(tr > 0 ? tr : 0) * NP1; av[j] = *(const v4u*)(row + C_BA + c0); gv[j] = *(const v4u*)(row + C_BG + c0); }
#pragma unroll
          for (int j = 0; j < 8; ++j) { const int i = F.tid + j * NTHR, r = i >> 6, c0 = (i & 63) * 8;
              if (i < 62 * 64) { const v4u a = av[j], g = gv[j]; const float z = (s0 - 30 + r >= 0) ? 1.0f : 0.0f; float u[8];
                  u[0] = bflo(a.x) * sigmoidf_(bflo(g.x)); u[1] = bfhi(a.x) * sigmoidf_(bfhi(g.x)); u[2] = bflo(a.y) * sigmoidf_(bflo(g.y)); u[3] = bfhi(a.y) * sigmoidf_(bfhi(g.y));
                  u[4] = bflo(a.z) * sigmoidf_(bflo(g.z)); u[5] = bfhi(a.z) * sigmoidf_(bfhi(g.z)); u[6] = bflo(a.w) * sigmoidf_(bflo(g.w)); u[7] = bfhi(a.w) * sigmoidf_(bfhi(g.w));
                  *(LAS f32x4*)(U + r * 512 + c0) = (f32x4){u[0], u[1], u[2], u[3]} * z; *(LAS f32x4*)(U + r * 512 + c0 + 4) = (f32x4){u[4], u[5], u[6], u[7]} * z; } } }
        __syncthreads();
        const int c0 = F.lane * 8;
        float acc[4][8];
#pragma unroll
        for (int q = 0; q < 4; ++q)
#pragma unroll
            for (int e = 0; e < 8; ++e) acc[q][e] = cb[c0 + e];
        LAS const float* Uw = U + (4 * F.wave) * 512 + c0;
        f32x4 wina[4], winb[4];
#pragma unroll
        for (int j = 0; j < 3; ++j) { wina[j] = *(LAS const f32x4*)(Uw + j * 512); winb[j] = *(LAS const f32x4*)(Uw + j * 512 + 4); }
        struct WG4 { f32x4 a[4], b[4]; };
#define MIXB_LOADW(W, kg) do { _Pragma("unroll") for (int j = 0; j < 4; ++j) { const int k_ = 4 * (kg) + j, kc_ = k_ < 31 ? k_ : 30; const float zz_ = k_ < 31 ? 1.0f : 0.0f; \
            W.a[j] = *(const f32x4*)(cw + kc_ * 512 + c0) * zz_; W.b[j] = *(const f32x4*)(cw + kc_ * 512 + c0 + 4) * zz_; } } while (0)
#define MIXB_GROUP(W, kg) do { _Pragma("unroll") for (int j = 0; j < 4; ++j) { const int k_ = 4 * (kg) + j; const int rn_ = (4 * F.wave + k_ + 3) < 62 ? (k_ + 3) : (61 - 4 * F.wave); \
            wina[(j + 3) & 3] = *(LAS const f32x4*)(Uw + rn_ * 512); winb[(j + 3) & 3] = *(LAS const f32x4*)(Uw + rn_ * 512 + 4); \
            _Pragma("unroll") for (int q = 0; q < 4; ++q) { const f32x4 ua = wina[(j + q) & 3], ub = winb[(j + q) & 3]; \
                acc[q][0] += W.a[j][0] * ua[0]; acc[q][1] += W.a[j][1] * ua[1]; acc[q][2] += W.a[j][2] * ua[2]; acc[q][3] += W.a[j][3] * ua[3]; \
                acc[q][4] += W.b[j][0] * ub[0]; acc[q][5] += W.b[j][1] * ub[1]; acc[q][6] += W.b[j][2] * ub[2]; acc[q][7] += W.b[j][3] * ub[3]; } } } while (0)
        { WG4 wA, wB; MIXB_LOADW(wA, 0);
#pragma unroll 1
          for (int kg = 0; kg < 8; kg += 2) {
              MIXB_LOADW(wB, kg + 1);
              MIXB_GROUP(wA, kg);
              if (kg + 2 < 8) MIXB_LOADW(wA, kg + 2);
              MIXB_GROUP(wB, kg + 1);
          } }
#undef MIXB_LOADW
#undef MIXB_GROUP
        const f32x4 ga = *(const f32x4*)(lg + c0), gb = *(const f32x4*)(lg + c0 + 4), ba = *(const f32x4*)(lb + c0), bb = *(const f32x4*)(lb + c0 + 4);
        float s4[4], v4[4];
#pragma unroll
        for (int q = 0; q < 4; ++q) { float s = 0.f;
#pragma unroll
            for (int e = 0; e < 8; ++e) s += acc[q][e];
            s4[q] = s; }
#pragma unroll
        for (int o = 1; o < 32; o <<= 1) { float t[4];
#pragma unroll
            for (int q = 0; q < 4; ++q) t[q] = shx(s4[q], o, F.lane);
#pragma unroll
            for (int q = 0; q < 4; ++q) s4[q] += t[q]; }
#pragma unroll
        for (int q = 0; q < 4; ++q) { const float mu = add32(s4[q]) * (1.0f / 512.0f); float v = 0.f;
#pragma unroll
            for (int e = 0; e < 8; ++e) { acc[q][e] -= mu; v += acc[q][e] * acc[q][e]; }
            v4[q] = v; }
#pragma unroll
        for (int o = 1; o < 32; o <<= 1) { float t[4];
#pragma unroll
            for (int q = 0; q < 4; ++q) t[q] = shx(v4[q], o, F.lane);
#pragma unroll
            for (int q = 0; q < 4; ++q) v4[q] += t[q]; }
#pragma unroll
        for (int q = 0; q < 4; ++q) {
            const float rs = 1.0f / sqrtf(add32(v4[q]) * (1.0f / 512.0f) + NORM_EPS);
            float y[8];
#pragma unroll
            for (int e = 0; e < 8; ++e) { const float gg = e < 4 ? ga[e] : gb[e - 4], bv = e < 4 ? ba[e] : bb[e - 4]; const float z = acc[q][e] * rs * gg + bv; y[e] = z * sigmoidf_(z); }
            v4u o; o.x = pk2(y[0], y[1]); o.y = pk2(y[2], y[3]); o.z = pk2(y[4], y[5]); o.w = pk2(y[6], y[7]);
            *(v4u*)(O + (size_t)(t0 + 4 * F.wave + q) * 512 + c0) = o; }
    }
}

__device__ __forceinline__ void phase_compress(const Frame& F, const bf16* P, const bf16* W1T  , const bf16* W2T  , const float* PBP  ,
                                               bf16* KC, bf16* VC  ) {
    LAS float* PART = (LAS float*)F.lds;
    LAS bf16* H1 = (LAS bf16*)(F.lds + 69632);
    const int lane = F.lane, r16 = lane & 15, q4 = lane >> 4, w = F.wave;
    for (int un = F.bid; un < 2 * 8 * 2 * 8; un += F.G) {
        const int nb = un & 7, g = (un >> 3) & 1, b = (un >> 4) & 7, which = un >> 7;
        const int n = nb * 16 + r16; const int nn = n < 127 ? n : 126;
        const int col0 = (which == 0 ? C_KC : C_VC) + g * 64;
        const bf16* arow = P + ((size_t)b * SEQ + nn * 16) * NP1 + col0;
        const bf16* w1 = W1T + (size_t)which * 128 * 2048;
        f32x4 acc[8];
#pragma unroll
        for (int j = 0; j < 8; ++j) acc[j] = (f32x4){0.f, 0.f, 0.f, 0.f};
#pragma unroll
        for (int half = 0; half < 2; ++half) {
            bf16x8 a[4], bb[4][8];
#pragma unroll
            for (int s4 = 0; s4 < 4; ++s4) { const int k = w * 256 + (half * 4 + s4) * 32 + q4 * 8;
                a[s4] = *(const bf16x8*)(arow + (size_t)(k >> 6) * NP1 + (k & 63));
#pragma unroll
                for (int j = 0; j < 8; ++j) bb[s4][j] = *(const bf16x8*)(w1 + (size_t)(j * 16 + r16) * 2048 + k); }
            SBAR();
#pragma unroll
            for (int s4 = 0; s4 < 4; ++s4)
#pragma unroll
                for (int j = 0; j < 8; ++j) acc[j] = __builtin_amdgcn_mfma_f32_16x16x32_bf16(a[s4], bb[s4][j], acc[j], 0, 0, 0);
        }
        __syncthreads();
#pragma unroll
        for (int j = 0; j < 8; ++j)
#pragma unroll
            for (int i = 0; i < 4; ++i) PART[(w * 16 + 4 * q4 + i) * 132 + j * 16 + r16] = acc[j][i];
        __syncthreads();
        {
            const int row = F.tid >> 5, c4 = (F.tid & 31) * 4;
            f32x4 sacc = (f32x4){0.f, 0.f, 0.f, 0.f};
#pragma unroll
            for (int ww = 0; ww < 8; ++ww) sacc += *(LAS f32x4*)(PART + (ww * 16 + row) * 132 + c4);
#pragma unroll
            for (int kc = 0; kc < 16; ++kc) sacc += *(const f32x4*)(PBP + ((size_t)which * 16 + kc) * 128 + c4);
            v2u o; o.x = pk2(gelu_erf(sacc[0]), gelu_erf(sacc[1])); o.y = pk2(gelu_erf(sacc[2]), gelu_erf(sacc[3]));
            *(LAS v2u*)(H1 + row * 136 + c4) = o;
        }
        __syncthreads();
        if (w < 4) {
            f32x4 o = (f32x4){0.f, 0.f, 0.f, 0.f};
            const bf16* w2 = W2T + (size_t)which * 64 * 128;
#pragma unroll
            for (int ks = 0; ks < 4; ++ks) { const bf16x8 a = *(LAS bf16x8*)(H1 + r16 * 136 + ks * 32 + q4 * 8);
                const bf16x8 bb = *(const bf16x8*)(w2 + (size_t)(w * 16 + r16) * 128 + ks * 32 + q4 * 8);
                o = __builtin_amdgcn_mfma_f32_16x16x32_bf16(a, bb, o, 0, 0, 0); }
            bf16* out = (which == 0 ? KC : VC) + ((size_t)(b * 2 + g) * 128) * 64;
#pragma unroll
            for (int i = 0; i < 4; ++i) { const int row = nb * 16 + 4 * q4 + i; out[(size_t)row * 64 + w * 16 + r16] = row < 127 ? (bf16)f2bf(o[i]) : (bf16)0; }
        }
    }
    __syncthreads();
}
__device__ __forceinline__ void phase_kmean(const Frame& F, const bf16* P, float* KM) {
    const int gw = gwave(F), NGW = ngwave(F), lane = F.lane, rs = lane >> 3, ch = lane & 7;
    for (int un = gw; un < 8 * 8 * 8; un += NGW) { const int h = un & 7, blk = (un >> 3) & 7, b = un >> 6;
        const bf16* base = P + ((size_t)b * SEQ + blk * 256) * NP1 + C_DK + h * 64 + ch * 8;
        float s[8];
#pragma unroll
        for (int e = 0; e < 8; ++e) s[e] = 0.f;
#pragma unroll
        for (int hb = 0; hb < 2; ++hb) { v4u vv[16];
#pragma unroll
            for (int i = 0; i < 16; ++i) vv[i] = *(const v4u*)(base + (size_t)((hb * 16 + i) * 8 + rs) * NP1);
            SBAR();
#pragma unroll
            for (int i = 0; i < 16; ++i) { const v4u v = vv[i];
                s[0] += bflo(v.x); s[1] += bfhi(v.x); s[2] += bflo(v.y); s[3] += bfhi(v.y); s[4] += bflo(v.z); s[5] += bfhi(v.z); s[6] += bflo(v.w); s[7] += bfhi(v.w); } }
#pragma unroll
        for (int e = 0; e < 8; ++e) { s[e] += shx(s[e], 8, lane); s[e] += shx(s[e], 16, lane); s[e] = add32(s[e]); }
        if (rs == 0) { float* o = KM + ((size_t)(b * 8 + blk) * 8 + h) * 64 + ch * 8;
            *(f32x4*)o = (f32x4){s[0], s[1], s[2], s[3]} * (1.0f / 256.0f); *(f32x4*)(o + 4) = (f32x4){s[4], s[5], s[6], s[7]} * (1.0f / 256.0f); }
    }
}

constexpr int KT_STRIDE = 144, VT_STRIDE = 192, KT_BYTES = 64 * KT_STRIDE, VT_BYTES = 64 * VT_STRIDE, KV_BUF = KT_BYTES + VT_BYTES;
__device__ __forceinline__ int crow(int r, int hi) { return (r & 3) + 8 * (r >> 2) + 4 * hi; }
struct AttnState { float m, l; f32x16 o0, o1; };
__device__ __forceinline__ void attn_reset(AttnState& st) { st.m = -1e30f; st.l = 0.f;
#pragma unroll
    for (int r = 0; r < 16; ++r) { st.o0[r] = 0.f; st.o1[r] = 0.f; } }
__device__ __forceinline__ s16x4 vtr(LAS const unsigned char* p) { return __builtin_bit_cast(s16x4, __builtin_amdgcn_ds_read_tr16_b64_v4i16((LAS s16x4*)p)); }

__device__ __forceinline__ void attn_scores(LAS const unsigned char* Kt, const bf16x8 (&qr)[4], f32x16& p0, f32x16& p1, int lane) {
    const int r32 = lane & 31, hi = lane >> 5;
#pragma unroll
    for (int r = 0; r < 16; ++r) { p0[r] = 0.f; p1[r] = 0.f; }
    bf16x8 ka[8];
#pragma unroll
    for (int s = 0; s < 4; ++s) { ka[2 * s] = *(LAS const bf16x8*)(Kt + r32 * KT_STRIDE + (2 * s + hi) * 16); ka[2 * s + 1] = *(LAS const bf16x8*)(Kt + (32 + r32) * KT_STRIDE + (2 * s + hi) * 16); }
    SBAR();
#pragma unroll
    for (int s = 0; s < 4; ++s) {
        p0 = __builtin_amdgcn_mfma_f32_32x32x16_bf16(ka[2 * s], qr[s], p0, 0, 0, 0);
        p1 = __builtin_amdgcn_mfma_f32_32x32x16_bf16(ka[2 * s + 1], qr[s], p1, 0, 0, 0);
    }
    SBAR();
}
struct VFrags { s16x4 lo[8], hh[8]; };
__device__ __forceinline__ void attn_vread(LAS const unsigned char* Vt, VFrags& vf, int lane) {
    const int hi = lane >> 5;
    LAS const unsigned char* vb = Vt + (4 * hi + ((lane & 15) >> 2)) * VT_STRIDE + (((lane >> 4) & 1) * 16 + 4 * (lane & 3)) * 2;
#pragma unroll
    for (int s = 0; s < 4; ++s)
#pragma unroll
        for (int db = 0; db < 2; ++db) { vf.lo[2 * s + db] = vtr(vb + (16 * s) * VT_STRIDE + db * 64); vf.hh[2 * s + db] = vtr(vb + (16 * s + 8) * VT_STRIDE + db * 64); }
    SBAR();
}
__device__ __forceinline__ void attn_pv(const VFrags& vf, const f32x16& e0, const f32x16& e1, f32x16& o0, f32x16& o1) {
    SBAR();
#pragma unroll
    for (int s = 0; s < 4; ++s) {
        v4u pw;
        if (s < 2) { pw.x = pk2(e0[8 * s + 0], e0[8 * s + 1]); pw.y = pk2(e0[8 * s + 2], e0[8 * s + 3]); pw.z = pk2(e0[8 * s + 4], e0[8 * s + 5]); pw.w = pk2(e0[8 * s + 6], e0[8 * s + 7]); }
        else { const int t = s - 2; pw.x = pk2(e1[8 * t + 0], e1[8 * t + 1]); pw.y = pk2(e1[8 * t + 2], e1[8 * t + 3]); pw.z = pk2(e1[8 * t + 4], e1[8 * t + 5]); pw.w = pk2(e1[8 * t + 6], e1[8 * t + 7]); }
        const bf16x8 pb = __builtin_bit_cast(bf16x8, pw);
#pragma unroll
        for (int db = 0; db < 2; ++db) {
            const s16x4 lo = vf.lo[2 * s + db], hh = vf.hh[2 * s + db];
            const bf16x8 a = (bf16x8){lo[0], lo[1], lo[2], lo[3], hh[0], hh[1], hh[2], hh[3]};
            if (db == 0) o0 = __builtin_amdgcn_mfma_f32_32x32x16_bf16(a, pb, o0, 0, 0, 0); else o1 = __builtin_amdgcn_mfma_f32_32x32x16_bf16(a, pb, o1, 0, 0, 0);
        }
    }
}
__device__ __forceinline__ float max3f(float a, float b, float c) { float r; asm("v_max3_f32 %0, %1, %2, %3" : "=v"(r) : "v"(a), "v"(b), "v"(c)); return r; }
__device__ __forceinline__ float mask_score(float v, int a, int b, int c) {
    const unsigned sg = (unsigned)(((a + c) | (b - c)) >> 31);
    return __builtin_bit_cast(float, (__builtin_bit_cast(unsigned, v) & ~sg) | (0xf149f2cau & sg));
}
__device__ __forceinline__ void attn_tile(LAS const unsigned char* Kt, LAS const unsigned char* Vt, const bf16x8 (&qr)[4], AttnState& st, int kmin, int kmax, int lane) {
    const int hi = lane >> 5;
    f32x16 p0, p1; attn_scores(Kt, qr, p0, p1, lane);
    VFrags vf; attn_vread(Vt, vf, lane);
    const bool none = kmax < kmin;
    if (!__all((kmin <= 0 && kmax >= 63) || none)) {
        const int a = 4 * hi - kmin, b = kmax - 4 * hi;
#pragma unroll
        for (int r = 0; r < 16; ++r) { const int c = (r & 3) + 8 * (r >> 2); p0[r] = mask_score(p0[r], a, b, c); p1[r] = mask_score(p1[r], a, b, c + 32); }
    }
    asm volatile("s_nop 15\n\ts_nop 7" : "+v"(p0), "+v"(p1));
    float mx = max3f(p0[0], p0[1], p1[0]), mx2 = max3f(p0[2], p0[3], p1[1]);
    mx = max3f(mx, p1[2], p1[3]);
#pragma unroll
    for (int r = 4; r < 16; r += 4) { mx = max3f(mx, p0[r], p0[r + 1]); mx2 = max3f(mx2, p0[r + 2], p0[r + 3]); mx = max3f(mx, p1[r], p1[r + 1]); mx2 = max3f(mx2, p1[r + 2], p1[r + 3]); }
    mx = max3f(mx, mx2, mx2);
    mx = max32(mx);
    mx = none ? -1e30f : mx;
    const bool up = mx > st.m + 8.0f;
    { const float mn = up ? mx : st.m, alpha = __builtin_amdgcn_exp2f(st.m - fmaxf(mn, -1e29f));
        st.m = mn; st.l *= alpha;
        const unsigned long long upm = __ballot(up);
#define RESC16(O) asm volatile("s_cmp_eq_u64 %[c], 0\n\ts_cbranch_scc1 .Lrs%=\n\t" \
            "v_mul_f32 %0, %0, %[a]\n\tv_mul_f32 %1, %1, %[a]\n\tv_mul_f32 %2, %2, %[a]\n\tv_mul_f32 %3, %3, %[a]\n\tv_mul_f32 %4, %4, %[a]\n\tv_mul_f32 %5, %5, %[a]\n\tv_mul_f32 %6, %6, %[a]\n\tv_mul_f32 %7, %7, %[a]\n\t" \
            "v_mul_f32 %8, %8, %[a]\n\tv_mul_f32 %9, %9, %[a]\n\tv_mul_f32 %10, %10, %[a]\n\tv_mul_f32 %11, %11, %[a]\n\tv_mul_f32 %12, %12, %[a]\n\tv_mul_f32 %13, %13, %[a]\n\tv_mul_f32 %14, %14, %[a]\n\tv_mul_f32 %15, %15, %[a]\n" \
            ".Lrs%=:" : "+v"(O[0]), "+v"(O[1]), "+v"(O[2]), "+v"(O[3]), "+v"(O[4]), "+v"(O[5]), "+v"(O[6]), "+v"(O[7]), "+v"(O[8]), "+v"(O[9]), "+v"(O[10]), "+v"(O[11]), "+v"(O[12]), "+v"(O[13]), "+v"(O[14]), "+v"(O[15]) \
            : [a] "v"(alpha), [c] "s"(upm) : "scc")
        RESC16(st.o0); RESC16(st.o1);
#undef RESC16
    }
    const float me = none ? 1e30f : fmaxf(st.m, -1e29f);
    float rs = 0.f;
#pragma unroll
    for (int r = 0; r < 16; ++r) { p0[r] = __builtin_amdgcn_exp2f(p0[r] - me); p1[r] = __builtin_amdgcn_exp2f(p1[r] - me); }
#pragma unroll
    for (int r = 0; r < 16; ++r) { rs += p0[r]; rs += p1[r]; }
    st.l += rs;
    attn_pv(vf, p0, p1, st.o0, st.o1);
}
struct KVRegs { v4u k, v; };
__device__ __forceinline__ void kv_load(KVRegs& r, const bf16* Kg, const bf16* Vg, size_t ld, int tid) {
    const int key = tid >> 3, ch = tid & 7;
    r.k = *(const v4u*)(Kg + (size_t)key * ld + ch * 8); r.v = *(const v4u*)(Vg + (size_t)key * ld + ch * 8);
}
__device__ __forceinline__ void kv_store(const KVRegs& r, LAS unsigned char* buf, int tid) {
    const int key = tid >> 3, ch = tid & 7;
    *(LAS v4u*)(buf + key * KT_STRIDE + ch * 16) = r.k; *(LAS v4u*)(buf + KT_BYTES + key * VT_STRIDE + ch * 16) = r.v;
}

__device__ __forceinline__ float attn_inv_l(const AttnState& st) { const float l = add32(st.l); return 1.0f / fmaxf(l, 1e-30f); }

#define ATTN_STREAM(Kg, Vg, ld, j0, j1, SKIP, RANGE) do { \
    int jn_ = (j0); while (jn_ < (j1) && (SKIP(jn_))) ++jn_; \
    if (jn_ < (j1)) { KVRegs kv_; kv_load(kv_, (Kg) + (size_t)jn_ * 64 * (ld), (Vg) + (size_t)jn_ * 64 * (ld), (ld), F.tid); \
        __syncthreads(); kv_store(kv_, ring, F.tid); int cur_ = 0; \
        for (;;) { const int j_ = jn_; ++jn_; while (jn_ < (j1) && (SKIP(jn_))) ++jn_; const bool more_ = jn_ < (j1); \
            if (more_) kv_load(kv_, (Kg) + (size_t)jn_ * 64 * (ld), (Vg) + (size_t)jn_ * 64 * (ld), (ld), F.tid); \
            __syncthreads(); \
            { int kmin_, kmax_; RANGE(j_, kmin_, kmax_); \
              if (__any(kmax_ >= kmin_)) attn_tile(ring + cur_ * KV_BUF, ring + cur_ * KV_BUF + KT_BYTES, qr, st, kmin_, kmax_, F.lane); } \
            if (!more_) break; \
            kv_store(kv_, ring + (cur_ ^ 1) * KV_BUF, F.tid); cur_ ^= 1; } } } while (0)

__device__ __forceinline__ void nsa_unit(const Frame& F, const bf16* P, const bf16* KC, const bf16* VC, bf16* O  , int b, int g, int i) {
    LAS unsigned char* ring = F.lds;
    LAS float* impb = (LAS float*)(F.lds + 2 * KV_BUF);
    LAS unsigned* selm = (LAS unsigned*)(F.lds + 2 * KV_BUF + 33792);
    LAS float* stash = (LAS float*)(F.lds + 2 * KV_BUF + 33792 + 256) + F.tid;
    const int lane = F.lane, r32 = lane & 31, hi = lane >> 5, hr = F.wave & 3, th = F.wave >> 2;
    const int tl = 32 * th + r32;
    const int s = 64 * i + tl;
    const size_t row = (size_t)b * SEQ + s;
    const int head = g * 4 + hr;
    bf16x8 qr[4];
#pragma unroll
    for (int d = 0; d < 4; ++d) qr[d] = *(const bf16x8*)(P + row * NP1 + C_CQ + head * 64 + d * 16 + hi * 8);
    const float g0 = sigmoidf_(bf2f(P[row * NP1 + C_CG + head])), g1 = sigmoidf_(bf2f(P[row * NP1 + C_CG + 8 + head])), g2 = sigmoidf_(bf2f(P[row * NP1 + C_CG + 16 + head]));
    AttnState st;
    {
        const bf16* Kg = KC + (size_t)(b * 2 + g) * 128 * 64; const bf16* Vg = VC + (size_t)(b * 2 + g) * 128 * 64;
        const int nmax = (s >= 31) ? ((s - 31) >> 4) : -1;
        { KVRegs kv0, kv1; kv_load(kv0, Kg, Vg, 64, F.tid); kv_load(kv1, Kg + 64 * 64, Vg + 64 * 64, 64, F.tid);
          __syncthreads();
          kv_store(kv0, ring, F.tid); kv_store(kv1, ring + KV_BUF, F.tid); }
        __syncthreads();
        attn_reset(st);
        attn_tile(ring, ring + KT_BYTES, qr, st, 0, nmax < 63 ? nmax : 63, lane);
        attn_tile(ring + KV_BUF, ring + KV_BUF + KT_BYTES, qr, st, 0, nmax - 64 < 63 ? nmax - 64 : 63, lane);
        const float inv = attn_inv_l(st);
        { const float sc = g0 * inv;
#pragma unroll
          for (int r = 0; r < 16; ++r) { stash[r * 512] = st.o0[r] * sc; stash[(16 + r) * 512] = st.o1[r] * sc; } }
        if (i >= 16) {
            float xprev = 0.f; const float mfin = st.m;
#define NSA_IMP(U, ACC, GQ) do { const float G_ = ((ACC[4 * (GQ)] + ACC[4 * (GQ) + 1]) + (ACC[4 * (GQ) + 2] + ACC[4 * (GQ) + 3])), L_ = ACC[4 * (GQ) + 3]; \
                const float x_ = other32(L_, hi); impb[(hr * 64 + tl) * 33 + 2 * (U) + hi] = G_ + (hi ? x_ : xprev); xprev = x_; } while (0)
#pragma unroll
            for (int tile = 0; tile < 2; ++tile) {
                f32x16 a0, a1; attn_scores(ring + tile * KV_BUF, qr, a0, a1, lane);
#pragma unroll
                for (int r = 0; r < 16; ++r) { const int c = (r & 3) + 8 * (r >> 2);
                    a0[r] = __builtin_amdgcn_exp2f(mask_score(a0[r], 4 * hi, nmax - 64 * tile - 4 * hi, c) - mfin) * inv; a1[r] = __builtin_amdgcn_exp2f(mask_score(a1[r], 4 * hi, nmax - 64 * tile - 4 * hi, c + 32) - mfin) * inv; }
                NSA_IMP(8 * tile + 0, a0, 0); NSA_IMP(8 * tile + 1, a0, 1); NSA_IMP(8 * tile + 2, a0, 2); NSA_IMP(8 * tile + 3, a0, 3);
                NSA_IMP(8 * tile + 4, a1, 0); NSA_IMP(8 * tile + 5, a1, 1); NSA_IMP(8 * tile + 6, a1, 2); NSA_IMP(8 * tile + 7, a1, 3);
            }
#undef NSA_IMP
        }
    }
    __syncthreads();
    unsigned mymask;
    if (i < 16) mymask = (2u << i) - 1u;
    else {
        { const int tk = F.tid >> 3, js = F.tid & 7; unsigned bits = 0u;
          float v[4];
#pragma unroll
          for (int e = 0; e < 4; ++e) { const int j = js * 4 + e; v[e] = (impb[(0 * 64 + tk) * 33 + j] + impb[(1 * 64 + tk) * 33 + j]) + (impb[(2 * 64 + tk) * 33 + j] + impb[(3 * 64 + tk) * 33 + j]); }
          int rank[4] = {0, 0, 0, 0};
          for (int jj = 1; jj <= i - 2; ++jj) { const float o = (impb[(0 * 64 + tk) * 33 + jj] + impb[(1 * 64 + tk) * 33 + jj]) + (impb[(2 * 64 + tk) * 33 + jj] + impb[(3 * 64 + tk) * 33 + jj]);
#pragma unroll
              for (int e = 0; e < 4; ++e) { const int j = js * 4 + e; rank[e] += (o > v[e] || (o == v[e] && jj < j)) ? 1 : 0; } }
#pragma unroll
          for (int e = 0; e < 4; ++e) { const int j = js * 4 + e; const bool forced = (j == 0) || (j == i) || (j == i - 1); const bool cand = (j >= 1) && (j <= i - 2);
              if (forced || (cand && rank[e] < 13)) bits |= 1u << j; }
          bits |= shxu(bits, 1, F.lane); bits |= shxu(bits, 2, F.lane); bits |= shxu(bits, 4, F.lane);
          if (js == 0) selm[tk] = bits; }
        __syncthreads();
        mymask = selm[tl];
    }
    {
        attn_reset(st);
        const bf16* Kg = P + (size_t)b * SEQ * NP1 + C_KS + g * 64; const bf16* Vg = P + (size_t)b * SEQ * NP1 + C_VS + g * 64;
#define NSA_SKIP(j) (false)
#define NSA_RANGE(j, kmin, kmax) do { kmin = 0; kmax = ((mymask >> (j)) & 1u) ? ((j) == i ? tl : 63) : -1; } while (0)
        ATTN_STREAM(Kg, Vg, (size_t)NP1, 0, i + 1, NSA_SKIP, NSA_RANGE);
#undef NSA_RANGE
        const float sc = g1 * attn_inv_l(st);
#pragma unroll
        for (int r = 0; r < 16; ++r) { stash[r * 512] += st.o0[r] * sc; stash[(16 + r) * 512] += st.o1[r] * sc; }
    }
    {
        attn_reset(st);
        const bf16* Kg = P + (size_t)b * SEQ * NP1 + C_KW + g * 64; const bf16* Vg = P + (size_t)b * SEQ * NP1 + C_VW + g * 64;
        const int jlo = i >= 8 ? i - 8 : 0; f32x16 out0, out1;
#define NSA_RANGE(j, kmin, kmax) do { const int d_ = 64 * (i - (j)) + tl; kmin = d_ - 511 > 0 ? d_ - 511 : 0; kmax = d_ < 63 ? d_ : 63; } while (0)
        ATTN_STREAM(Kg, Vg, (size_t)NP1, jlo, i + 1, NSA_SKIP, NSA_RANGE);
#undef NSA_RANGE
#undef NSA_SKIP
        const float sc = g2 * attn_inv_l(st);
#pragma unroll
        for (int r = 0; r < 16; ++r) { out0[r] = stash[r * 512] + st.o0[r] * sc; out1[r] = stash[(16 + r) * 512] + st.o1[r] * sc; }
        bf16* orow = O + row * 512 + head * 64;
#pragma unroll
        for (int gq = 0; gq < 4; ++gq) {
            v2u w0; w0.x = pk2(out0[4 * gq], out0[4 * gq + 1]); w0.y = pk2(out0[4 * gq + 2], out0[4 * gq + 3]); *(v2u*)(orow + 8 * gq + 4 * hi) = w0;
            v2u w1; w1.x = pk2(out1[4 * gq], out1[4 * gq + 1]); w1.y = pk2(out1[4 * gq + 2], out1[4 * gq + 3]); *(v2u*)(orow + 32 + 8 * gq + 4 * hi) = w1; }
    }
}
__device__ __forceinline__ void phase_nsa(const Frame& F, const bf16* P, const bf16* KC, const bf16* VC, bf16* O) {
    for (int un2 = 2 * F.bid; un2 < 512; un2 += 2 * F.G)
#pragma unroll 1
        for (int k = 0; k < 2; ++k) { const int u0 = un2 >> 1, un = (F.G == 256) ? ((u0 & 7) * 32 + (u0 >> 3)) : u0, ip = un & 15, g = (un >> 4) & 1, b = un >> 5;
            nsa_unit(F, P, KC, VC, O, b, g, k == 0 ? 31 - ip : ip); }
}

constexpr int MB_SLOTB = 8192, MB_K = 0, MB_V = 3 * MB_SLOTB, MB_WS = 6 * MB_SLOTB, MB_OST = MB_WS + 8 * 256, MB_END = MB_OST + 8 * 4096;
__device__ __forceinline__ void mb_glds16(const void* sbase, unsigned voff, unsigned lds_dst) { unsigned keep;
    asm volatile("s_mov_b32 %0, m0\n\ts_mov_b32 m0, %3\n\ts_nop 0\n\tglobal_load_lds_dwordx4 %1, %2\n\ts_mov_b32 m0, %0" : "=&s"(keep) : "v"(voff), "s"(sbase), "s"(lds_dst) : "memory"); }
__device__ __forceinline__ void mb_kload2(bf16x8* kf, LAS const unsigned char* kp, int j) { kf[2 * j] = *(LAS const bf16x8*)(kp + j * 2048); kf[2 * j + 1] = *(LAS const bf16x8*)(kp + j * 2048 + 512); }
__device__ __forceinline__ void mb_kload2x(bf16x8* kf, LAS const unsigned char* kp, int j, int ka16) { const int o = (32 * j) ^ ka16; kf[2 * j] = *(LAS const bf16x8*)(kp + o); kf[2 * j + 1] = *(LAS const bf16x8*)(kp + 4096 + o); }
__device__ __forceinline__ void mb_cmask(f32x16& p0, f32x16& p1, int jb, int qrel, int hi) {
    const int kb = 64 * jb + 4 * hi;
#pragma unroll
    for (int r = 0; r < 16; ++r) { const int kv = kb + (r & 3) + 8 * (r >> 2); if (kv > qrel) p0[r] = -INFINITY; if (kv + 32 > qrel) p1[r] = -INFINITY; }
}
__device__ __forceinline__ void mb_pv(f32x16* o, int vb, bf16x8 pa0, bf16x8 pa1, bf16x8 pa2, bf16x8 pa3) {
#pragma unroll
    for (int d0 = 0; d0 < 2; ++d0) { s16x4 lo[4], hh[4];
#pragma unroll
        for (int ks = 0; ks < 4; ++ks) {
            asm volatile("ds_read_b64_tr_b16 %0, %1 offset:%c2" : "=&v"(lo[ks]) : "v"(vb), "i"(d0 * 4096 + ks * 1024) : "memory");
            asm volatile("ds_read_b64_tr_b16 %0, %1 offset:%c2" : "=&v"(hh[ks]) : "v"(vb), "i"(d0 * 4096 + ks * 1024 + 512) : "memory"); }
        asm volatile("s_waitcnt lgkmcnt(0)" ::: "memory"); SBAR();
#define MB_PK(k) (bf16x8){lo[k][0], lo[k][1], lo[k][2], lo[k][3], hh[k][0], hh[k][1], hh[k][2], hh[k][3]}
        o[d0] = __builtin_amdgcn_mfma_f32_32x32x16_bf16(pa0, MB_PK(0), o[d0], 0, 0, 0);
        o[d0] = __builtin_amdgcn_mfma_f32_32x32x16_bf16(pa1, MB_PK(1), o[d0], 0, 0, 0);
        o[d0] = __builtin_amdgcn_mfma_f32_32x32x16_bf16(pa2, MB_PK(2), o[d0], 0, 0, 0);
        o[d0] = __builtin_amdgcn_mfma_f32_32x32x16_bf16(pa3, MB_PK(3), o[d0], 0, 0, 0);
#undef MB_PK
    }
}
#define MB_WAIT_BAR(N) asm volatile("s_waitcnt vmcnt(" #N ") lgkmcnt(0)\n\ts_barrier" ::: "memory")
__device__ __forceinline__ void moba_tiles(const Frame& F, const bf16* P, bf16* O, int b, int h, int qb, const bf16x8 (&qr)[4], const unsigned mymask, const unsigned um) {
    const int lane = F.lane, r32 = lane & 31, hi = lane >> 5, wid = F.wave;
    LAS unsigned char* shm = F.lds;
    const unsigned lds0 = (unsigned)(size_t)shm;
    LAS float* wsf = (LAS float*)(shm + MB_WS) + wid * 64;
    const size_t rowbase = (size_t)b * SEQ; const int q0 = qb * 256;
    const bf16* Kh = P + rowbase * NP1 + C_DK + h * 64; const bf16* Vh = P + rowbase * NP1 + C_DV + h * 64;
    const bf16* ksrc = Kh + (size_t)(8 * wid) * NP1; const unsigned koff = (unsigned)(lane >> 3) * (NP1 * 2) + (unsigned)((lane & 7) ^ ((4 * wid + (lane >> 4)) & 7)) * 16;
    const bf16* vsrc = Vh + (size_t)(16 * (wid & 3)) * NP1 + (wid >> 2) * 32; const unsigned voff = (unsigned)(lane >> 2) * (NP1 * 2) + (lane & 3) * 16;
    const unsigned kdst = lds0 + MB_K + wid * 1024, vdst = lds0 + MB_V + wid * 1024;
    const int np = __builtin_popcount(um); unsigned bl = 0u;
    { int k = 0;
#pragma unroll
      for (int n = 0; n < 8; ++n) if ((um >> n) & 1u) { bl |= (unsigned)n << (4 * k); ++k; } }
    const int NT = 4 * np + 4;
#define MB_BLK(t) ((bl >> (4 * (((t) - 1) >> 2))) & 15u)
#define MB_TJ(t) ((t) == 0 ? 4 * qb : ((t) <= 4 * np ? 4 * (int)MB_BLK(t) + (((t) - 1) & 3) : 4 * qb + (t) - 4 * np))
#define MB_SEL(t) (((t) == 0 || (t) > 4 * np) ? 0xffffffffu : (0u - ((mymask >> MB_BLK(t)) & 1u)))
#define DMA_K(t, slot) mb_glds16(ksrc + (size_t)MB_TJ(t) * 64 * NP1, koff, (unsigned)__builtin_amdgcn_readfirstlane(kdst + (slot)))
#define DMA_V(t, slot) mb_glds16(vsrc + (size_t)MB_TJ(t) * 64 * NP1, voff, (unsigned)__builtin_amdgcn_readfirstlane(vdst + (slot)))
    bf16x8 kf[8];
    LAS const unsigned char* kp0 = shm + MB_K + r32 * 128; const int ka16 = (hi ^ ((r32 >> 1) & 7)) << 4;
    LAS const unsigned char* vp0 = shm + MB_V + ((lane >> 4) & 1) * 32 + (lane & 3) * 8 + (4 * hi + ((lane & 15) >> 2)) * 64;
    DMA_K(0, 0); DMA_V(0, 0); DMA_K(1, MB_SLOTB);
    float mhat = 0.f, l_reg = 0.f; f32x16 o[2]; o[0] = f32x16{}; o[1] = f32x16{}; const f32x16 negm = f32x16{};
#define qrel (wid * 32 + (F.lane & 31))
    bool resc = false; unsigned sp = 0xffffffffu;
#define RESC() do { if (resc) { asm volatile("s_waitcnt lgkmcnt(0)" ::: "memory"); \
        _Pragma("unroll") for (int d_ = 0; d_ < 2; ++d_) _Pragma("unroll") for (int r = 0; r < 16; ++r) o[d_][r] *= wsf[crow(r, hi)]; } } while (0)
    f32x16 pA0, pA1, pB0, pB1;
    int sl_prev = 0, sl_cur = 0, sl_next = MB_SLOTB;
#define ROT() do { sl_prev = sl_cur; sl_cur = sl_next; sl_next = (sl_next == 2 * MB_SLOTB) ? 0 : sl_next + MB_SLOTB; } while (0)
    DMA_K(2, 2 * MB_SLOTB);
    MB_WAIT_BAR(3);
    { mb_kload2x(kf, kp0, 0, ka16); mb_kload2x(kf, kp0, 1, ka16); mb_kload2x(kf, kp0, 2, ka16); mb_kload2x(kf, kp0, 3, ka16);
      pA0 = __builtin_amdgcn_mfma_f32_32x32x16_bf16(kf[0], qr[0], negm, 0, 0, 0); pA1 = __builtin_amdgcn_mfma_f32_32x32x16_bf16(kf[1], qr[0], negm, 0, 0, 0);
#pragma unroll
      for (int d0 = 1; d0 < 4; ++d0) { pA0 = __builtin_amdgcn_mfma_f32_32x32x16_bf16(kf[2 * d0], qr[d0], pA0, 0, 0, 0); pA1 = __builtin_amdgcn_mfma_f32_32x32x16_bf16(kf[2 * d0 + 1], qr[d0], pA1, 0, 0, 0); } }
    mb_cmask(pA0, pA1, 0, qrel, hi);
    { float a = fmaxf(fmaxf(pA0[0], pA0[1]), pA1[0]);
#pragma unroll
      for (int r = 1; r < 16; ++r) a = fmaxf(a, r == 1 ? pA1[1] : fmaxf(pA0[r], pA1[r]));
      const float rm = max32(a); mhat = rm;
#pragma unroll
      for (int r = 0; r < 16; ++r) { pA0[r] = __builtin_amdgcn_exp2f(pA0[r] - rm); pA1[r] = __builtin_amdgcn_exp2f(pA1[r] - rm); }
    }
    MB_WAIT_BAR(0);
    DMA_K(3, 0); DMA_V(1, MB_SLOTB);
    ROT();
    mb_kload2x(kf, kp0 + sl_cur, 0, ka16); mb_kload2x(kf, kp0 + sl_cur, 1, ka16); mb_kload2x(kf, kp0 + sl_cur, 2, ka16); mb_kload2x(kf, kp0 + sl_cur, 3, ka16);
    MB_WAIT_BAR(2);
    s16x4 vlo[8], vhi[8]; v4u pw0, pw1, pw2, pw3;
#define PKW(P_, B_) (pk2(P_[B_], P_[B_ + 1]) & sp)
#define PAF(k) __builtin_bit_cast(bf16x8, pw##k)
#define VFR(i) (bf16x8){vlo[i][0], vlo[i][1], vlo[i][2], vlo[i][3], vhi[i][0], vhi[i][1], vhi[i][2], vhi[i][3]}
#define PIN(x) asm volatile("" : "+v"(x))
#define MX3(a_, b_, c_) __builtin_fmaxf(__builtin_fmaxf((a_), (b_)), (c_))
#define GAPA(MF, A0, A1, A2, A3, W0, W1, PW) do { MF; sacc += A0; sacc += A1; sacc += A2; sacc += A3; PIN(sacc); W0; W1; PIN(PW); SBAR(); } while (0)
#define EX(v_) __builtin_amdgcn_exp2f((v_) - mhat)
#define GAPB(MF, X, B_) do { MF; X[B_] = EX(X[B_]); X[B_ + 1] = EX(X[B_ + 1]); X[B_ + 2] = EX(X[B_ + 2]); X[B_ + 3] = EX(X[B_ + 3]); PIN(X); SBAR(); } while (0)
#define VRD(i) do { vlo[i] = vtr(vp_ + (((i) >> 2) * 4096 + ((i) & 3) * 1024)); vhi[i] = vtr(vp_ + (((i) >> 2) * 4096 + ((i) & 3) * 1024 + 512)); } while (0)
#define KRD(G, j) do { if (G) { mb_kload2x(kf, kp0 + sl_next, j, ka16); SBAR(); } } while (0)
#define MFM(a_, b_, c_) __builtin_amdgcn_mfma_f32_32x32x16_bf16(a_, b_, c_, 0, 0, 0)
#define STEP(C0, C1, P0, P1, t, GK, GV, GL, MASK) do { SBAR(); \
    LAS const unsigned char* vp_ = vp0 + sl_prev; \
    VRD(0); SBAR(); float sacc = (P0[0] + P0[1]); \
    GAPA(C0 = MFM(kf[0], qr[0], negm), P0[2], P0[3], P0[4], P0[5],     pw0[0] = PKW(P0, 0),  pw0[1] = PKW(P0, 2),  pw0); \
    VRD(4); SBAR(); GAPA(C1 = MFM(kf[1], qr[0], negm), P0[6], P0[7], P0[8], P0[9],     pw0[2] = PKW(P0, 4),  pw0[3] = PKW(P0, 6),  pw0); \
    VRD(1); SBAR(); GAPA(C0 = MFM(kf[2], qr[1], C0),   P0[10], P0[11], P0[12], P0[13], pw1[0] = PKW(P0, 8),  pw1[1] = PKW(P0, 10), pw1); \
    VRD(5); SBAR(); GAPA(C1 = MFM(kf[3], qr[1], C1),   P0[14], P0[15], P1[0], P1[1],   pw1[2] = PKW(P0, 12), pw1[3] = PKW(P0, 14), pw1); \
    VRD(2); SBAR(); GAPA(C0 = MFM(kf[4], qr[2], C0),   P1[2], P1[3], P1[4], P1[5],     pw2[0] = PKW(P1, 0),  pw2[1] = PKW(P1, 2),  pw2); \
    VRD(6); SBAR(); GAPA(C1 = MFM(kf[5], qr[2], C1),   P1[6], P1[7], P1[8], P1[9],     pw2[2] = PKW(P1, 4),  pw2[3] = PKW(P1, 6),  pw2); \
    VRD(3); SBAR(); GAPA(C0 = MFM(kf[6], qr[3], C0),   P1[10], P1[11], P1[12], P1[13], pw3[0] = PKW(P1, 8),  pw3[1] = PKW(P1, 10), pw3); \
    VRD(7); SBAR(); GAPA(C1 = MFM(kf[7], qr[3], C1),   P1[14], P1[15], 0.f, 0.f,       pw3[2] = PKW(P1, 12), pw3[3] = PKW(P1, 14), pw3); \
    l_reg += __builtin_bit_cast(float, __builtin_bit_cast(unsigned, sacc) & sp); \
    if (GK) { DMA_K((t) + 3, sl_cur); } if (GV) { DMA_V((t) + 1, sl_next); } \
    if (MASK) { if ((t) >= NT - 3) mb_cmask(C0, C1, (t) - (NT - 4), qrel, hi); } \
    const unsigned sc_ = MB_SEL(t); \
    { float a = MX3(C0[0], C0[1], C1[0]), b_ = MX3(C0[2], C0[3], C1[1]); a = MX3(a, C1[2], C1[3]); \
      _Pragma("unroll") for (int r = 4; r < 16; r += 4) { a = MX3(a, C0[r], C0[r + 1]); b_ = MX3(b_, C0[r + 2], C0[r + 3]); a = MX3(a, C1[r], C1[r + 1]); b_ = MX3(b_, C1[r + 2], C1[r + 3]); } \
      float rm = max32(__builtin_fmaxf(a, b_)) - mhat; rm = sc_ ? rm : -INFINITY;        \
      resc = false; \
      if (__builtin_expect(__any(rm > 8.0f), 0)) { const float dl = __builtin_fmaxf(rm, 0.f); mhat += dl; \
        const float f = __builtin_amdgcn_exp2f(-dl); l_reg *= f; if (hi == 0) wsf[r32] = f; resc = true; } } \
    SBAR(); sp = sc_; \
    GAPB(o[0] = MFM(PAF(0), VFR(0), o[0]), C0, 0); \
    GAPB(o[1] = MFM(PAF(0), VFR(4), o[1]), C0, 4); \
    KRD(GL, 0); GAPB(o[0] = MFM(PAF(1), VFR(1), o[0]), C0, 8); \
    KRD(GL, 1); GAPB(o[1] = MFM(PAF(1), VFR(5), o[1]), C0, 12); \
    KRD(GL, 2); GAPB(o[0] = MFM(PAF(2), VFR(2), o[0]), C1, 0); \
    KRD(GL, 3); GAPB(o[1] = MFM(PAF(2), VFR(6), o[1]), C1, 4); \
    GAPB(o[0] = MFM(PAF(3), VFR(3), o[0]), C1, 8); \
    GAPB(o[1] = MFM(PAF(3), VFR(7), o[1]), C1, 12); \
    } while (0)
    int t = 1;
    for (; t + 5 < NT; t += 2) {
        STEP(pB0, pB1, pA0, pA1, t, true, true, true, false);     MB_WAIT_BAR(2); RESC(); ROT();
        STEP(pA0, pA1, pB0, pB1, t + 1, true, true, true, false); MB_WAIT_BAR(2); RESC(); ROT();
    }
#define ENDW(tt) do { if ((tt) + 3 < NT) { MB_WAIT_BAR(2); } else if ((tt) + 2 < NT) { MB_WAIT_BAR(1); } else { MB_WAIT_BAR(0); } } while (0)
    for (; t + 1 < NT; t += 2) {
        STEP(pB0, pB1, pA0, pA1, t, (t + 3 < NT), (t + 1 < NT), (t + 1 < NT), true);         ENDW(t);     RESC(); ROT();
        STEP(pA0, pA1, pB0, pB1, t + 1, (t + 4 < NT), (t + 2 < NT), (t + 2 < NT), true);     ENDW(t + 1); RESC(); ROT();
    }
    STEP(pB0, pB1, pA0, pA1, NT - 1, false, false, false, true); RESC();
    { float sacc = pB0[0] + pB0[1];
#pragma unroll
      for (int r = 2; r < 16; ++r) sacc += pB0[r];
#pragma unroll
      for (int r = 0; r < 16; ++r) sacc += pB1[r];
      l_reg += __builtin_bit_cast(float, __builtin_bit_cast(unsigned, sacc) & sp);
      pw0 = (v4u){PKW(pB0, 0), PKW(pB0, 2), PKW(pB0, 4), PKW(pB0, 6)}; pw1 = (v4u){PKW(pB0, 8), PKW(pB0, 10), PKW(pB0, 12), PKW(pB0, 14)};
      pw2 = (v4u){PKW(pB1, 0), PKW(pB1, 2), PKW(pB1, 4), PKW(pB1, 6)}; pw3 = (v4u){PKW(pB1, 8), PKW(pB1, 10), PKW(pB1, 12), PKW(pB1, 14)};
      SBAR(); mb_pv(o, (int)(unsigned)(size_t)vp0 + sl_cur, PAF(0), PAF(1), PAF(2), PAF(3)); }
    l_reg = add32(l_reg);
    if (hi == 0) wsf[32 + r32] = l_reg; asm volatile("s_waitcnt lgkmcnt(0)" ::: "memory");
    float rli[16];
#pragma unroll
    for (int r = 0; r < 16; ++r) rli[r] = __builtin_amdgcn_rcpf(wsf[32 + crow(r, hi)]);
    bf16* Ow = O + (rowbase + q0 + wid * 32) * 512 + h * 64; LAS bf16* stg = (LAS bf16*)(shm + MB_OST) + wid * 2048;
#pragma unroll
    for (int r = 0; r < 16; ++r) { const int orow = crow(r, hi);
#pragma unroll
        for (int d0 = 0; d0 < 2; ++d0) stg[orow * 64 + d0 * 32 + r32] = (bf16)f2bf(o[d0][r] * rli[r]); }
    asm volatile("s_waitcnt lgkmcnt(0)" ::: "memory");
#pragma unroll
    for (int i = 0; i < 4; ++i) { const int row = i * 8 + (lane >> 3), ch = lane & 7; *(v4u*)(Ow + (size_t)row * 512 + ch * 8) = *(LAS const v4u*)(stg + row * 64 + ch * 8); }
    asm volatile("s_waitcnt lgkmcnt(0)\n\ts_barrier" ::: "memory");
#undef qrel
#undef MB_BLK
#undef MB_TJ
#undef MB_SEL
#undef DMA_K
#undef DMA_V
#undef RESC
#undef ROT
#undef PKW
#undef PAF
#undef VFR
#undef PIN
#undef MX3
#undef GAPA
#undef EX
#undef GAPB
#undef VRD
#undef KRD
#undef MFM
#undef STEP
#undef ENDW
}
__device__ __forceinline__ void moba_unit(const Frame& F, const bf16* P, const float* KM, bf16* O  , int b, int h, int qb) {
    LAS float* kml = (LAS float*)(F.lds + 86016);
    LAS unsigned* uni = (LAS unsigned*)(F.lds + 86016 + 2048);
    const int lane = F.lane, r32 = lane & 31, hi = lane >> 5;
    const int tl = 32 * F.wave + r32;
    const size_t row = (size_t)b * SEQ + 256 * qb + tl;
    bf16x8 qr[4];
#pragma unroll
    for (int d = 0; d < 4; ++d) qr[d] = *(const bf16x8*)(P + row * NP1 + C_DQ + h * 64 + d * 16 + hi * 8);
    __syncthreads();
    { const int blk = F.tid >> 6, p = F.tid & 63; kml[F.tid] = KM[((size_t)(b * 8 + blk) * 8 + h) * 64 + p]; if (F.tid == 0) uni[0] = 0u; }
    __syncthreads();
    unsigned mymask = 0u;
    if (qb > 0) {
        float gt[8];
        float qf[32];
#pragma unroll
        for (int d = 0; d < 4; ++d) { const v4u qw = __builtin_bit_cast(v4u, qr[d]);
            qf[8 * d + 0] = bflo(qw.x); qf[8 * d + 1] = bfhi(qw.x); qf[8 * d + 2] = bflo(qw.y); qf[8 * d + 3] = bfhi(qw.y); qf[8 * d + 4] = bflo(qw.z); qf[8 * d + 5] = bfhi(qw.z); qf[8 * d + 6] = bflo(qw.w); qf[8 * d + 7] = bfhi(qw.w); }
#pragma unroll
        for (int n = 0; n < 8; ++n) {
            f32x4 kv[8];
#pragma unroll
            for (int d = 0; d < 4; ++d) { const LAS f32x4* km = (const LAS f32x4*)(kml + n * 64 + d * 16 + hi * 8); kv[2 * d] = km[0]; kv[2 * d + 1] = km[1]; }
            SBAR();
            float a = 0.f;
#pragma unroll
            for (int d = 0; d < 4; ++d) a += qf[8 * d + 0] * kv[2 * d][0] + qf[8 * d + 1] * kv[2 * d][1] + qf[8 * d + 2] * kv[2 * d][2] + qf[8 * d + 3] * kv[2 * d][3]
                                           + qf[8 * d + 4] * kv[2 * d + 1][0] + qf[8 * d + 5] * kv[2 * d + 1][1] + qf[8 * d + 6] * kv[2 * d + 1][2] + qf[8 * d + 7] * kv[2 * d + 1][3];
            a = add32(a); gt[n] = a; }
#pragma unroll
        for (int n = 0; n < 8; ++n) { int rank = 0;
#pragma unroll
            for (int m = 0; m < 8; ++m) if (m != n) { const bool ahead = (m < n) ? (gt[m] >= gt[n]) : (gt[m] > gt[n]); rank += ((m < qb) & ahead) ? 1 : 0; }
            mymask |= ((n < qb) & (rank < 3)) ? (1u << n) : 0u; }
        atomicOr((unsigned*)uni, mymask);
    }
    __syncthreads();
    const unsigned um = (unsigned)__builtin_amdgcn_readfirstlane((int)uni[0]);
    VM_WAIT();
    moba_tiles(F, P, O, b, h, qb, qr, mymask, um);
}
__device__ __forceinline__ void phase_moba(const Frame& F, const bf16* P, const float* KM, bf16* O) {
    for (int un2 = 2 * F.bid; un2 < 512; un2 += 2 * F.G)
#pragma unroll 1
        for (int k = 0; k < 2; ++k) { const int u0 = un2 >> 1, un = (F.G == 256) ? ((u0 & 7) * 32 + (u0 >> 3)) : u0, qp = un & 3, h = (un >> 2) & 7, b = un >> 5; moba_unit(F, P, KM, O, b, h, k == 0 ? 7 - qp : qp); }
}

__device__ __forceinline__ unsigned ord_key(float x) { const unsigned u = __builtin_bit_cast(unsigned, x); const unsigned m = (unsigned)((int)u >> 31); return u ^ (m | 0x80000000u); }
__device__ __forceinline__ float ord_val(unsigned k) { const unsigned m = (unsigned)((int)k >> 31); return __builtin_bit_cast(float, k ^ (~m | 0x80000000u)); }
__device__ __forceinline__ void ce_desc(unsigned& a, unsigned& b) { const unsigned hi_ = a > b ? a : b, lo_ = a > b ? b : a; a = hi_; b = lo_; }
__device__ __forceinline__ void bitonic_merge16_desc(unsigned* a) {
#pragma unroll
    for (int j = 8; j > 0; j >>= 1)
#pragma unroll
        for (int i = 0; i < 16; ++i) if ((i & j) == 0) ce_desc(a[i], a[i | j]);
}
__device__ __forceinline__ void bitonic_sort16_desc(unsigned* a) {
    ce_desc(a[0], a[1]); ce_desc(a[2], a[3]); ce_desc(a[0], a[2]); ce_desc(a[1], a[3]); ce_desc(a[1], a[2]); ce_desc(a[4], a[5]); ce_desc(a[6], a[7]); ce_desc(a[4], a[6]); ce_desc(a[5], a[7]); ce_desc(a[5], a[6]); ce_desc(a[0], a[4]); ce_desc(a[2], a[6]); ce_desc(a[2], a[4]); ce_desc(a[1], a[5]); ce_desc(a[3], a[7]); ce_desc(a[3], a[5]); ce_desc(a[1], a[2]); ce_desc(a[3], a[4]); ce_desc(a[5], a[6]); ce_desc(a[8], a[9]); ce_desc(a[10], a[11]); ce_desc(a[8], a[10]); ce_desc(a[9], a[11]); ce_desc(a[9], a[10]); ce_desc(a[12], a[13]); ce_desc(a[14], a[15]); ce_desc(a[12], a[14]); ce_desc(a[13], a[15]); ce_desc(a[13], a[14]); ce_desc(a[8], a[12]); ce_desc(a[10], a[14]); ce_desc(a[10], a[12]); ce_desc(a[9], a[13]); ce_desc(a[11], a[15]); ce_desc(a[11], a[13]); ce_desc(a[9], a[10]); ce_desc(a[11], a[12]); ce_desc(a[13], a[14]); ce_desc(a[0], a[8]); ce_desc(a[4], a[12]); ce_desc(a[4], a[8]); ce_desc(a[2], a[10]); ce_desc(a[6], a[14]); ce_desc(a[6], a[10]); ce_desc(a[2], a[4]); ce_desc(a[6], a[8]); ce_desc(a[10], a[12]); ce_desc(a[1], a[9]); ce_desc(a[5], a[13]); ce_desc(a[5], a[9]); ce_desc(a[3], a[11]); ce_desc(a[7], a[15]); ce_desc(a[7], a[11]); ce_desc(a[3], a[5]); ce_desc(a[7], a[9]); ce_desc(a[11], a[13]); ce_desc(a[1], a[2]); ce_desc(a[3], a[4]); ce_desc(a[5], a[6]); ce_desc(a[7], a[8]); ce_desc(a[9], a[10]); ce_desc(a[11], a[12]); ce_desc(a[13], a[14]);
}
__device__ __forceinline__ void merge_top16(unsigned* a, const unsigned* b) {
#pragma unroll
    for (int i = 0; i < 16; ++i) a[i] = a[i] > b[15 - i] ? a[i] : b[15 - i];
    bitonic_merge16_desc(a);
}
constexpr int SK_STRIDE = 272;
__device__ __forceinline__ void peer_route_unit(const Frame& F, const bf16* Q2, const bf16* SUBK  , int* EIDX, float* EW, int tb, int h) {
    LAS unsigned char* skl = F.lds;
    LAS unsigned* slot = (LAS unsigned*)(F.lds + 36864) + F.tid;
    const int lane = F.lane, r32 = lane & 31, hi = lane >> 5;
    const size_t tok = (size_t)tb * 256 + F.wave * 32 + r32;
    float rn0 = 0.f, rn1 = 0.f;
#pragma unroll 1
    for (int p = 0; p < 2; ++p) {
        __syncthreads();
        { v4u sk[4];
#pragma unroll
          for (int j = 0; j < 4; ++j) { const int i = F.tid + j * NTHR, ch = i & 15, rowi = i >> 4; sk[j] = *(const v4u*)(SUBK + ((size_t)h * 256 + p * 128 + rowi) * 128 + ch * 8); }
#pragma unroll
          for (int j = 0; j < 4; ++j) { const int i = F.tid + j * NTHR, ch = i & 15, rowi = i >> 4; *(LAS v4u*)(skl + rowi * SK_STRIDE + ch * 16) = sk[j]; } }
        __syncthreads();
        bf16x8 qf[8]; float ss = 0.f;
#pragma unroll
        for (int s = 0; s < 8; ++s) { qf[s] = *(const bf16x8*)(Q2 + tok * 2048 + h * 256 + p * 128 + s * 16 + hi * 8); const v4u w = __builtin_bit_cast(v4u, qf[s]);
            const float a0 = bflo(w.x), a1 = bfhi(w.x), a2 = bflo(w.y), a3 = bfhi(w.y), a4 = bflo(w.z), a5 = bfhi(w.z), a6 = bflo(w.w), a7 = bfhi(w.w);
            ss += (a0 * a0 + a1 * a1) + (a2 * a2 + a3 * a3) + (a4 * a4 + a5 * a5) + (a6 * a6 + a7 * a7); }
        ss = add32(ss);
        const float rn = 1.0f / sqrtf(ss * (1.0f / 128.0f) + NORM_EPS); if (p == 0) rn0 = rn; else rn1 = rn;
        unsigned key[64];
#pragma unroll
        for (int nb = 0; nb < 4; ++nb) { f32x16 acc;
#pragma unroll
            for (int r = 0; r < 16; ++r) acc[r] = 0.f;
#pragma unroll
            for (int sh = 0; sh < 2; ++sh) { bf16x8 sa[4];
#pragma unroll
                for (int s = 0; s < 4; ++s) sa[s] = *(LAS const bf16x8*)(skl + (nb * 32 + r32) * SK_STRIDE + (2 * (4 * sh + s) + hi) * 16);
                __builtin_amdgcn_sched_barrier(0);
#pragma unroll
                for (int s = 0; s < 4; ++s) acc = __builtin_amdgcn_mfma_f32_32x32x16_bf16(sa[s], qf[4 * sh + s], acc, 0, 0, 0); }
#pragma unroll
            for (int r = 0; r < 16; ++r) { const int n0 = nb * 32 + (r & 3) + 8 * (r >> 2); key[nb * 16 + r] = (ord_key(acc[r]) & 0xffffff80u) | (unsigned)(127 - n0); } }
#pragma unroll
        for (int blk = 0; blk < 4; ++blk) bitonic_sort16_desc(key + 16 * blk);
        merge_top16(key, key + 16); merge_top16(key + 32, key + 48); merge_top16(key, key + 32);
        { unsigned oth[16];
#pragma unroll
          for (int i = 0; i < 16; ++i) { key[i] ^= (unsigned)(hi << 2); unsigned r0, r1; swap32(key[i], r0, r1); oth[i] = hi ? r0 : r1; }
          merge_top16(key, oth); }
#pragma unroll
        for (int k = 0; k < 16; ++k) slot[(p * 16 + k) * 512] = key[k];
    }
    LDS_WAIT(); asm volatile("" ::: "memory");
    unsigned ck[32];
    { float v1[16], v2[16];
#pragma unroll
      for (int k = 0; k < 16; ++k) { v1[k] = ord_val(slot[k * 512] & 0xffffff80u) * rn0; v2[k] = ord_val(slot[(16 + k) * 512] & 0xffffff80u) * rn1; }
      ck[0] = (ord_key((hi ? v1[0] : v1[0]) + (hi ? v2[1] : v2[0])) & 0xffffff00u) | (hi ? 254u : 255u);
      ck[1] = (ord_key((hi ? v1[0] : v1[0]) + (hi ? v2[3] : v2[2])) & 0xffffff00u) | (hi ? 252u : 253u);
      ck[2] = (ord_key((hi ? v1[0] : v1[0]) + (hi ? v2[5] : v2[4])) & 0xffffff00u) | (hi ? 250u : 251u);
      ck[3] = (ord_key((hi ? v1[0] : v1[0]) + (hi ? v2[7] : v2[6])) & 0xffffff00u) | (hi ? 248u : 249u);
      ck[4] = (ord_key((hi ? v1[0] : v1[0]) + (hi ? v2[9] : v2[8])) & 0xffffff00u) | (hi ? 246u : 247u);
      ck[5] = (ord_key((hi ? v1[0] : v1[0]) + (hi ? v2[11] : v2[10])) & 0xffffff00u) | (hi ? 244u : 245u);
      ck[6] = (ord_key((hi ? v1[0] : v1[0]) + (hi ? v2[13] : v2[12])) & 0xffffff00u) | (hi ? 242u : 243u);
      ck[7] = (ord_key((hi ? v1[0] : v1[0]) + (hi ? v2[15] : v2[14])) & 0xffffff00u) | (hi ? 240u : 241u);
      ck[8] = (ord_key((hi ? v1[1] : v1[1]) + (hi ? v2[1] : v2[0])) & 0xffffff00u) | (hi ? 238u : 239u);
      ck[9] = (ord_key((hi ? v1[1] : v1[1]) + (hi ? v2[3] : v2[2])) & 0xffffff00u) | (hi ? 236u : 237u);
      ck[10] = (ord_key((hi ? v1[1] : v1[1]) + (hi ? v2[5] : v2[4])) & 0xffffff00u) | (hi ? 234u : 235u);
      ck[11] = (ord_key((hi ? v1[1] : v1[1]) + (hi ? v2[7] : v2[6])) & 0xffffff00u) | (hi ? 232u : 233u);
      ck[12] = (ord_key((hi ? v1[2] : v1[2]) + (hi ? v2[1] : v2[0])) & 0xffffff00u) | (hi ? 222u : 223u);
      ck[13] = (ord_key((hi ? v1[2] : v1[2]) + (hi ? v2[3] : v2[2])) & 0xffffff00u) | (hi ? 220u : 221u);
      ck[14] = (ord_key((hi ? v1[3] : v1[2]) + (hi ? v2[0] : v2[4])) & 0xffffff00u) | (hi ? 207u : 219u);
      ck[15] = (ord_key((hi ? v1[3] : v1[3]) + (hi ? v2[2] : v2[1])) & 0xffffff00u) | (hi ? 205u : 206u);
      ck[16] = (ord_key((hi ? v1[4] : v1[3]) + (hi ? v2[0] : v2[3])) & 0xffffff00u) | (hi ? 191u : 204u);
      ck[17] = (ord_key((hi ? v1[4] : v1[4]) + (hi ? v2[2] : v2[1])) & 0xffffff00u) | (hi ? 189u : 190u);
      ck[18] = (ord_key((hi ? v1[5] : v1[5]) + (hi ? v2[1] : v2[0])) & 0xffffff00u) | (hi ? 174u : 175u);
      ck[19] = (ord_key((hi ? v1[6] : v1[6]) + (hi ? v2[1] : v2[0])) & 0xffffff00u) | (hi ? 158u : 159u);
      ck[20] = (ord_key((hi ? v1[7] : v1[7]) + (hi ? v2[1] : v2[0])) & 0xffffff00u) | (hi ? 142u : 143u);
      ck[21] = (ord_key((hi ? v1[9] : v1[8]) + (hi ? v2[0] : v2[0])) & 0xffffff00u) | (hi ? 111u : 127u);
      ck[22] = (ord_key((hi ? v1[11] : v1[10]) + (hi ? v2[0] : v2[0])) & 0xffffff00u) | (hi ? 79u : 95u);
      ck[23] = (ord_key((hi ? v1[13] : v1[12]) + (hi ? v2[0] : v2[0])) & 0xffffff00u) | (hi ? 47u : 63u);
      ck[24] = (ord_key((hi ? v1[15] : v1[14]) + (hi ? v2[0] : v2[0])) & 0xffffff00u) | (hi ? 15u : 31u);
#pragma unroll
      for (int q = 25; q < 32; ++q) ck[q] = 0u; }
    bitonic_sort16_desc(ck); bitonic_sort16_desc(ck + 16);
    merge_top16(ck, ck + 16);
    { unsigned oth[16];
#pragma unroll
      for (int i = 0; i < 16; ++i) { unsigned r0, r1; swap32(ck[i], r0, r1); oth[i] = hi ? r0 : r1; }
      merge_top16(ck, oth); }
    const float mx = ord_val(ck[0] & 0xffffff00u);
    float ek[8], den = 0.f; unsigned te[8];
#pragma unroll
    for (int j = 0; j < 8; ++j) { const unsigned m = hi ? ck[8 + j] : ck[j];
        const int ci = 255 - (int)(m & 255u), a = ci >> 4, bq = ci & 15;
        const unsigned ka = slot[a * 512], kb = slot[(16 + bq) * 512];
        te[j] = (unsigned)((127 - (int)(ka & 127u)) * 128 + (127 - (int)(kb & 127u)));
        ek[j] = __expf(ord_val(m & 0xffffff00u) - mx); den += ek[j]; }
    const float inv = 1.0f / add32(den);
    { v4u* ep = (v4u*)(EIDX + (tok * 8 + h) * 16 + 8 * hi); ep[0] = (v4u){te[0], te[1], te[2], te[3]}; ep[1] = (v4u){te[4], te[5], te[6], te[7]};
      f32x4* wp = (f32x4*)(EW + (tok * 8 + h) * 16 + 8 * hi); wp[0] = (f32x4){ek[0], ek[1], ek[2], ek[3]} * inv; wp[1] = (f32x4){ek[4], ek[5], ek[6], ek[7]} * inv; }
}

__device__ __forceinline__ void phase_peer_route(const Frame& F, const bf16* Q2, const bf16* SUBK, int* EIDX, float* EW) {
    for (int un = F.bid; un < 64 * 8; un += F.G) peer_route_unit(F, Q2, SUBK, EIDX, EW, un >> 3, un & 7);
}

__device__ __forceinline__ void phase_peer_tables(const Frame& F, const float* U, const float* V, unsigned char* UT8, unsigned char* VT8, float* SU, float* SV, int r_lo, int r_hi, int gw, int NGW) {
    const int lane = F.lane;
    for (int r4 = r_lo + gw; r4 < r_hi; r4 += 4 * NGW) {
      f32x4 xx[4][4];
#pragma unroll
      for (int j = 0; j < 4; ++j) { const int rr = r4 + j * NGW, r = rr < r_hi ? rr : r4; const int tab = r >> 14, e = r & 16383; const float* src = (tab ? V : U) + (size_t)e * DM + 16 * lane;
#pragma unroll
          for (int q = 0; q < 4; ++q) xx[j][q] = *(const f32x4*)(src + 4 * q); }
      SBAR();
#pragma unroll
      for (int j = 0; j < 4; ++j) {
        const int rr = r4 + j * NGW, r = rr < r_hi ? rr : r4;
        const int tab = r >> 14, e = r & 16383;
        f32x4 x[4]; float mx = 0.f;
#pragma unroll
        for (int q = 0; q < 4; ++q) { x[q] = xx[j][q]; mx = fmaxf(fmaxf(mx, fmaxf(fabsf(x[q][0]), fabsf(x[q][1]))), fmaxf(fabsf(x[q][2]), fabsf(x[q][3]))); }
#pragma unroll
        for (int o = 1; o < 32; o <<= 1) mx = fmaxf(mx, shx(mx, o, lane));
        mx = max32(mx);
        int ex = 0; (void)frexpf(mx, &ex);
        const int k = (mx > 0.f) ? (8 - ex) : 0;
        const float sc = __builtin_ldexpf(1.0f, k), inv = __builtin_ldexpf(1.0f, -k);
        v4u w; float rowscale = inv;
        if (tab) {
#pragma unroll
            for (int q = 0; q < 4; ++q) { unsigned p = 0u; p = __builtin_amdgcn_cvt_pk_fp8_f32(x[q][0] * sc, x[q][1] * sc, p, false); p = __builtin_amdgcn_cvt_pk_fp8_f32(x[q][2] * sc, x[q][3] * sc, p, true); w[q] = p; }
        } else {
            const float qs = mx > 0.f ? 127.0f / mx : 0.f; rowscale = mx > 0.f ? mx * (1.0f / 127.0f) : 0.f;
#pragma unroll
            for (int q = 0; q < 4; ++q) w[q] = ((unsigned)(int)rintf(x[q][0] * qs) & 0xffu) | (((unsigned)(int)rintf(x[q][1] * qs) & 0xffu) << 8) | (((unsigned)(int)rintf(x[q][2] * qs) & 0xffu) << 16) | (((unsigned)(int)rintf(x[q][3] * qs) & 0xffu) << 24);
        }
        if (tab == 0) *(v4u*)(UT8 + ((size_t)(lane >> 3) * 16384 + e) * 128 + (lane & 7) * 16) = w;
        else { unsigned char* vrow = VT8 + ((size_t)(lane >> 3) * 16384 + e) * 128 + 64 * (lane & 1) + 4 * ((lane & 7) >> 1);
#pragma unroll
            for (int jj = 0; jj < 4; ++jj) *(unsigned*)(vrow + 16 * jj) = w[jj]; }
        if (lane == 0) SU[2 * e + tab] = rowscale;
      }
    }
}
typedef _Float16 h16x2 __attribute__((ext_vector_type(2)));
typedef __fp16 fp16x2_t __attribute__((ext_vector_type(2)));
__device__ __forceinline__ void phase_peer_u(const Frame& F, const bf16* HNB, const unsigned char* UT8, const float* SU, const int* EIDX, float* PART) {
    const int lane = F.lane, g = lane >> 3, sub = lane & 7, b0 = lane & 1, b1 = (lane >> 1) & 1, b2 = (lane >> 2) & 1;
    const int s = F.bid & 7, wgq = F.bid >> 3, nq = F.G >> 3;
    LAS int* il = (LAS int*)(F.lds + F.wave * 8192);
    LAS float* pcl = (LAS float*)(F.lds + F.wave * 8192 + 4096);
    const unsigned char* ub = UT8 + (size_t)s * 16384 * 128 + sub * 16;
    v4u ni0, ni1, ni2, ni3, nh0, nh1;
#define PU_META(bt) do { const int t0_ = (bt) * 8; const v4u* src = (const v4u*)(EIDX + (size_t)t0_ * 128) + lane; ni0 = src[0]; ni1 = src[64]; ni2 = src[128]; ni3 = src[192];     \
        { const v4u* hp = (const v4u*)(HNB + (size_t)(t0_ + g) * DM + s * 128 + sub * 16); nh0 = hp[0]; nh1 = hp[1]; } } while (0)
    { const int b0_ = wgq * 8 + F.wave; if (b0_ < TOK / 8) PU_META(b0_); }
    for (int batch = wgq * 8 + F.wave; batch < TOK / 8; batch += nq * 8) {
        const int t0 = batch * 8, t = t0 + g;
        { LAS v4u* dst = (LAS v4u*)il + lane; dst[0] = ni0; dst[64] = ni1; dst[128] = ni2; dst[192] = ni3; }
        v4u h; float hsl;
        { const unsigned wd[8] = {nh0.x, nh0.y, nh0.z, nh0.w, nh1.x, nh1.y, nh1.z, nh1.w}; float hv[16]; float mx = 0.f;
#pragma unroll
          for (int e = 0; e < 8; ++e) { hv[2 * e] = bflo(wd[e]); hv[2 * e + 1] = bfhi(wd[e]); mx = fmaxf(mx, fmaxf(fabsf(hv[2 * e]), fabsf(hv[2 * e + 1]))); }
          mx = fmaxf(mx, shx(mx, 1, lane)); mx = fmaxf(mx, shx(mx, 2, lane)); mx = fmaxf(mx, shx(mx, 4, lane));
          const float qs = mx > 0.f ? 127.0f / mx : 0.f; hsl = mx * (1.0f / 127.0f);
#pragma unroll
          for (int q = 0; q < 4; ++q) h[q] = ((unsigned)(int)rintf(hv[4 * q] * qs) & 0xffu) | (((unsigned)(int)rintf(hv[4 * q + 1] * qs) & 0xffu) << 8) | (((unsigned)(int)rintf(hv[4 * q + 2] * qs) & 0xffu) << 16) | (((unsigned)(int)rintf(hv[4 * q + 3] * qs) & 0xffu) << 24); }
        if (batch + nq * 8 < TOK / 8) PU_META(batch + nq * 8);
        LDS_WAIT(); asm volatile("" ::: "memory");
#define PU_LOAD(c, ua, su_) do { const v4u ia = *(LAS v4u*)(il + g * 128 + (c) * 8), ib = *(LAS v4u*)(il + g * 128 + (c) * 8 + 4); \
            ua[0] = *(const v4u*)(ub + (size_t)ia.x * 128); ua[1] = *(const v4u*)(ub + (size_t)ia.y * 128); ua[2] = *(const v4u*)(ub + (size_t)ia.z * 128); ua[3] = *(const v4u*)(ub + (size_t)ia.w * 128); \
            ua[4] = *(const v4u*)(ub + (size_t)ib.x * 128); ua[5] = *(const v4u*)(ub + (size_t)ib.y * 128); ua[6] = *(const v4u*)(ub + (size_t)ib.z * 128); ua[7] = *(const v4u*)(ub + (size_t)ib.w * 128); \
            su_ = hsl; } while (0)
#define PU_COMP(c, ua, su_) do { float a[8]; \
            _Pragma("unroll") for (int j = 0; j < 8; ++j) { int acc = __builtin_amdgcn_sdot4((int)ua[j].x, (int)h.x, 0, false); acc = __builtin_amdgcn_sdot4((int)ua[j].y, (int)h.y, acc, false); \
                acc = __builtin_amdgcn_sdot4((int)ua[j].z, (int)h.z, acc, false); acc = __builtin_amdgcn_sdot4((int)ua[j].w, (int)h.w, acc, false); a[j] = (float)acc; } \
            float bq[4], cc[2]; \
            _Pragma("unroll") for (int p = 0; p < 4; ++p) { const float keep = b0 ? a[2 * p + 1] : a[2 * p], send = b0 ? a[2 * p] : a[2 * p + 1]; bq[p] = keep + shx(send, 1, lane); } \
            _Pragma("unroll") for (int q = 0; q < 2; ++q) { const float keep = b1 ? bq[2 * q + 1] : bq[2 * q], send = b1 ? bq[2 * q] : bq[2 * q + 1]; cc[q] = keep + shx(send, 2, lane); } \
            { const float keep = b2 ? cc[1] : cc[0], send = b2 ? cc[0] : cc[1]; pcl[(c) * 64 + lane] = (keep + shx(send, 4, lane)) * su_; } } while (0)
        { v4u uA[8], uB[8]; float sA, sB;
          PU_LOAD(0, uA, sA);
#pragma unroll 1
          for (int c = 0; c < 16; c += 2) {
              PU_LOAD(c + 1, uB, sB);
              PU_COMP(c, uA, sA);
              if (c + 2 < 16) PU_LOAD(c + 2, uA, sA);
              PU_COMP(c + 1, uB, sB);
          } }
#undef PU_LOAD
#undef PU_COMP
        LDS_WAIT(); asm volatile("" ::: "memory");
        float* dst = PART + ((size_t)s * TOK + t) * 128 + sub;
#pragma unroll
        for (int c = 0; c < 16; ++c) dst[8 * c] = pcl[c * 64 + lane];
        LDS_WAIT(); asm volatile("" ::: "memory");
    }
#undef PU_META
}
__device__ __forceinline__ float gelu_as(float v) {
    const float av = fabsf(v), t = __builtin_amdgcn_rcpf(av * 0.2316418882f + 1.0f);
    float q = t * 0.5307027145f + (-0.7265760135f); q = q * t + 0.7107068705f; q = q * t + (-0.142248368f); q = q * t + 0.127414796f; q = q * t;
    const float m = v * (q * __builtin_amdgcn_exp2f((v * v) * (-0.72134752044f)));
    return v < 0.f ? m : v - m;
}
__device__ __forceinline__ void phase_peer_w(const Frame& F, const float* SV, const float* SU, const int* EIDX, const float* EW, const float* PART, v2u* COEF) {
    const int nth = F.G * NTHR;
    for (int i0 = F.bid * NTHR + F.tid; i0 < TOK * 128; i0 += 4 * nth) {
        float pv[4][8], ew[4]; int e[4];
#pragma unroll
        for (int u = 0; u < 4; ++u) { const int i = i0 + u * nth < TOK * 128 ? i0 + u * nth : i0;
#pragma unroll
            for (int sp = 0; sp < 8; ++sp) pv[u][sp] = PART[(size_t)sp * TOK * 128 + i];
            e[u] = EIDX[i]; ew[u] = EW[i]; }
        float sv[4], su[4];
#pragma unroll
        for (int u = 0; u < 4; ++u) { const int i = i0 + u * nth < TOK * 128 ? i0 + u * nth : i0; const f32x2 sc2 = *(const f32x2*)(SU + 2 * e[u]); su[u] = sc2.x; sv[u] = sc2.y; }
#pragma unroll
        for (int u = 0; u < 4; ++u) { const int i = i0 + u * nth; float act = 0.f;
#pragma unroll
            for (int sp = 0; sp < 8; ++sp) act += pv[u][sp];
            const float c = ew[u] * gelu_as(act * su[u]) * sv[u];
            const unsigned cbits = __builtin_bit_cast(unsigned, c); const _Float16 mh = (_Float16)__builtin_bit_cast(float, (cbits & 0x807fffffu) | 0x3f800000u);
            if (i < TOK * 128) COEF[i] = (v2u){(unsigned)e[u] | ((unsigned)__builtin_bit_cast(unsigned short, mh) << 16), cbits & 0x7f800000u}; }
    }
}
__device__ __forceinline__ void phase_peer_v(const Frame& F, const unsigned char* VT8, const v2u* COEF, float* XB, const float* gate) {
    const int lane = F.lane, g = lane >> 3, sub = lane & 7;
    const int s = F.bid & 7, wgq = F.bid >> 3, nq = F.G >> 3;
    LAS v2u* wl = (LAS v2u*)(F.lds + F.wave * 8192);
    const unsigned char* vb = VT8 + (size_t)s * 16384 * 128 + sub * 16;
    v4u nc[8];
#define PV_META(bt) do { const v4u* src = (const v4u*)(COEF + (size_t)(bt) * 8 * 128) + lane; _Pragma("unroll") for (int q = 0; q < 8; ++q) nc[q] = src[64 * q]; } while (0)
    { const int b0_ = wgq * 8 + F.wave; if (b0_ < TOK / 8) PV_META(b0_); }
    for (int batch = wgq * 8 + F.wave; batch < TOK / 8; batch += nq * 8) {
        const int t0 = batch * 8, t = t0 + g;
        { LAS v4u* dst = (LAS v4u*)wl + lane;
#pragma unroll
          for (int q = 0; q < 8; ++q) dst[64 * q] = nc[q]; }
        if (batch + nq * 8 < TOK / 8) PV_META(batch + nq * 8);
        const int bb = t / SEQ; float* xr = XB + (size_t)t * DM + s * 128 + sub * 4; const float* gr = gate + (size_t)bb * 6144 + s * 128 + sub * 4;
        f32x4 xv[4], gv4[4];
#pragma unroll
        for (int q = 0; q < 4; ++q) { xv[q] = *(const f32x4*)(xr + 32 * q); gv4[q] = *(const f32x4*)(gr + 32 * q); }
        LDS_WAIT(); asm volatile("" ::: "memory");
        h16x2 o[8];
#pragma unroll
        for (int q = 0; q < 8; ++q) o[q] = (h16x2){(_Float16)0.f, (_Float16)0.f};
#define PV_LOAD(c, pr, va) do { \
            _Pragma("unroll") for (int q = 0; q < 4; ++q) pr[q] = *(LAS v4u*)(wl + g * 128 + (c) * 8 + 2 * q); \
            _Pragma("unroll") for (int q = 0; q < 4; ++q) { va[2 * q] = *(const v4u*)(vb + (size_t)(pr[q].x & 0xffffu) * 128); va[2 * q + 1] = *(const v4u*)(vb + (size_t)(pr[q].z & 0xffffu) * 128); } } while (0)
#define PV_COMP(pr, va) do { \
            _Pragma("unroll") for (int j = 0; j < 8; ++j) { const unsigned w0 = (j & 1) ? pr[j >> 1].z : pr[j >> 1].x; \
                const float s2 = __builtin_bit_cast(float, (j & 1) ? pr[j >> 1].w : pr[j >> 1].y); const h16x2 m2 = __builtin_bit_cast(h16x2, __builtin_amdgcn_perm(w0, w0, 0x07060706u)); \
                _Pragma("unroll") for (int q = 0; q < 4; ++q) { o[2 * q] = __builtin_elementwise_fma(__builtin_bit_cast(h16x2, __builtin_amdgcn_cvt_scalef32_pk_f16_fp8(va[j][q], s2, false)), m2, o[2 * q]); \
                    o[2 * q + 1] = __builtin_elementwise_fma(__builtin_bit_cast(h16x2, __builtin_amdgcn_cvt_scalef32_pk_f16_fp8(va[j][q], s2, true)), m2, o[2 * q + 1]); } } } while (0)
        { v4u pA[4], pB[4], vA[8], vB[8];
          PV_LOAD(0, pA, vA);
#pragma unroll 1
          for (int c = 0; c < 16; c += 2) {
              PV_LOAD(c + 1, pB, vB);
              PV_COMP(pA, vA);
              if (c + 2 < 16) PV_LOAD(c + 2, pA, vA);
              PV_COMP(pB, vB);
          } }
#undef PV_LOAD
#undef PV_COMP
#pragma unroll
        for (int q = 0; q < 4; ++q) *(f32x4*)(xr + 32 * q) = xv[q] + gv4[q] * (f32x4){(float)o[2 * q].x, (float)o[2 * q].y, (float)o[2 * q + 1].x, (float)o[2 * q + 1].y};
        LDS_WAIT(); asm volatile("" ::: "memory");
    }
#undef PV_META
}

constexpr int NPL = 12, NPHASE = 1 + DEPTH * NPL + 1;
constexpr int CW_BAR = 1024;
static_assert((CW_BAR + XCD_BAR_WORDS) * 4 <= (int)CTL_ZERO_BYTES, "barrier words inside the memset region");

__global__ void __launch_bounds__(NTHR, 2) hybrid_fwd(Args args) {
    extern __shared__ __attribute__((aligned(16))) unsigned char lds[];
    Frame F;
    F.lds = (LAS unsigned char*)lds; F.ldsg = lds;
    F.tid = threadIdx.x; F.lane = F.tid & 63; F.wave = __builtin_amdgcn_readfirstlane(F.tid >> 6);
    F.G = gridDim.x; F.bid = blockIdx.x; F.ws = args.ws;
    GAS unsigned char* wsg = (GAS unsigned char*)args.ws;
#define WSP ((unsigned char*)wsg)
    volatile LAS unsigned* MISC = (volatile LAS unsigned*)(F.lds + MISC_OFF);
    for (int u = F.tid; u < 64; u += NTHR) ((LAS unsigned*)(F.lds + MISC_OFF))[u] = 0u;
    __syncthreads();
    XcdBarrier bar; bar.bar = (unsigned*)(WSP + WS_CTL) + CW_BAR; bar.x = 0; bar.st = nullptr;
    const int lo = args.ph_lo, hi = args.ph_hi;
    if (hi - lo > 1) bar = xcd_barrier_post((unsigned*)(WSP + WS_CTL) + CW_BAR, MISC + 8);
#define IN(k) (lo <= (k) && (k) < hi)
#define SEAM(k) do { if (IN(k) && IN((k) + 1)) xcd_barrier(bar); } while (0)

    typedef __attribute__((address_space(4))) const Args* KArgs;
    KArgs ap = (KArgs)__builtin_amdgcn_kernarg_segment_ptr();
#define FRESH() asm volatile("" : "+s"(ap), "+s"(wsg)); Frame Fp = F; asm volatile("" : "+v"(Fp.tid)); Fp.lane = Fp.tid & 63; asm volatile("" : "+s"(Fp.wave), "+s"(Fp.bid), "+s"(Fp.G)); Fp.ws = WSP; LAS unsigned char* ring = Fp.lds; asm volatile("" : "+s"(ring)); Fp.lds = ring
#define INP(i) ((const float*)(GAS const float*)ap->in[i])
#define WIN_ ((bf16*)(WSP + WS_WIN))
#define WOUT_ ((bf16*)(WSP + WS_WOUT))
#define WOT_ ((bf16*)(WSP + WS_WO))
#define WQT_ ((bf16*)(WSP + WS_WQ))
#define W1T_ ((bf16*)(WSP + WS_W1T))
#define SUBK_ ((bf16*)(WSP + WS_SUBK))
#define W2T_ ((bf16*)(WSP + WS_SMALL + SM_W2T))
#define MOD_ ((float*)(WSP + WS_MOD))
#define COS_ ((const float*)(WSP + WS_COS))
#define SIN_ ((const float*)(WSP + WS_SIN))
#define KMEAN_ ((float*)(WSP + WS_SMALL + SM_KMEAN))
#define KCMP_ ((bf16*)(WSP + WS_SMALL + SM_KCMP))
#define VCMP_ ((bf16*)(WSP + WS_SMALL + SM_VCMP))
#define PBP_ ((float*)(WSP + WS_SMALL + SM_PBP))
#define EIDX_ ((int*)(WSP + WS_EIDX))
#define EW_ ((float*)(WSP + WS_EW))
#define HN_ ((bf16*)(WSP + WS_HN))
#define MIX_ ((bf16*)(WSP + WS_MIX))
#define PROJ_ ((bf16*)(WSP + WS_BIG))
#define GATES_ ((unsigned char*)(WSP + WS_GATES))
#define UT_ ((unsigned char*)(WSP + WS_GATES + 64 * MiB))
#define VT_ ((unsigned char*)(WSP + WS_BIG + 16 * MiB))
#define SU_ ((float*)(WSP + WS_MOD + 512 * 1024))
#define SV_ ((float*)(WSP + WS_MOD + 512 * 1024))
#define COEF_ ((v2u*)(WSP + WS_BIG + 33 * MiB))
#define H8_ ((unsigned char*)(WSP + WS_BIG + 128 * MiB))
#define HS_ ((float*)(WSP + WS_BIG + 144 * MiB))
#define Q2_ ((bf16*)(WSP + WS_BIG + 64 * MiB))
#define PART_ ((float*)(WSP + WS_BIG + 64 * MiB))
#define XB_ ((float*)(GAS float*)ap->out)
#define MODL_ (MOD_ + (size_t)l * 8 * 6144)
#define XIN_ ((l == 0) ? INP(I_X) : (const float*)XB_)

    if (IN(0)) { FRESH(); phase_prologue(Fp, ap); }
    SEAM(0);
#pragma unroll 1
    for (int l = 0; l < DEPTH; ++l) {
        const int p0 = 1 + l * NPL;
        if (IN(p0 + 0)) { FRESH(); phase_norm_mod(Fp, XIN_, INP(I_NMG) + l * DM, MODL_ + 0, MODL_ + 1024, HN_); }
        SEAM(p0 + 0);
        if (IN(p0 + 1)) { FRESH(); pg8::Gemm g{HN_, WIN_ + (size_t)l * NWIN * DM, TOK, NWIN, DM}; pg8::StaticOrder S; S.init(TOK, NWIN, Fp.G, Fp.bid);
            if (Fp.G == 256 && Fp.bid >= 128) { phase_peer_tables(Fp, INP(I_PU) + (size_t)l * 16384 * DM, INP(I_PV) + (size_t)l * 16384 * DM, UT_, VT_, SU_, SV_, 0, 16384, (Fp.bid - 128) * NWAVES + Fp.wave, 128 * NWAVES); __syncthreads(); }
            epi::EpiProjAll E{{PROJ_, COS_, SIN_}, {GATES_}}; pg8::gemm_phase<epi::EpiProjAll, pg8::StaticOrder, true, true>(ring, g, S, E, Fp.tid); }
        SEAM(p0 + 1);
        if (IN(p0 + 2)) {
            const bool bfirst = ((F.bid >> 3) & 1) != 0;
            if (bfirst) { { FRESH(); phase_mixer_b(Fp, PROJ_, INP(I_BCW) + (size_t)l * 31 * 512, INP(I_BCB) + l * 512, INP(I_BLNG) + l * 512, INP(I_BLNB) + l * 512, MIX_ + (size_t)TOK * 512); } __syncthreads(); }
            { FRESH(); phase_compress(Fp, PROJ_, W1T_ + (size_t)l * 2 * 128 * 2048, W2T_ + (size_t)l * 2 * 64 * 128, PBP_ + (size_t)l * 2 * 16 * 128, KCMP_, VCMP_); }
            { FRESH(); phase_kmean(Fp, PROJ_, KMEAN_); }
            { FRESH(); phase_mixer_a(Fp, PROJ_, INP(I_ACW) + (size_t)l * 3 * 512, MIX_); }
            __syncthreads();
            if (!(((F.bid >> 3) & 1) != 0)) { { FRESH(); phase_mixer_b(Fp, PROJ_, INP(I_BCW) + (size_t)l * 31 * 512, INP(I_BCB) + l * 512, INP(I_BLNG) + l * 512, INP(I_BLNB) + l * 512, MIX_ + (size_t)TOK * 512); } __syncthreads(); }
        }
        SEAM(p0 + 2);
        if (IN(p0 + 3)) { { FRESH(); phase_nsa(Fp, PROJ_, KCMP_, VCMP_, MIX_ + (size_t)2 * TOK * 512); __syncthreads(); }
                                   { FRESH(); phase_moba(Fp, PROJ_, KMEAN_, MIX_ + (size_t)3 * TOK * 512); __syncthreads(); } }
        SEAM(p0 + 3);
        if (IN(p0 + 4) && ((F.bid >> 3) & 1) != 0) { FRESH(); phase_peer_tables(Fp, INP(I_PU) + (size_t)l * 16384 * DM, INP(I_PV) + (size_t)l * 16384 * DM, UT_, VT_, SU_, SV_, 16384, 32768, gwave(Fp), ngwave(Fp)); __syncthreads(); }
        if (IN(p0 + 4)) { FRESH(); pg8::Gemm g{MIX_, WOUT_ + (size_t)(l * 4) * DM * 512, 4 * TOK, 4 * DM, 512}; epi::MergeOrder S; S.init(Fp.G, Fp.bid);
            epi::EpiMergeAll E{HN_, GATES_}; pg8::gemm_phase<epi::EpiMergeAll, epi::MergeOrder, true, true>(ring, g, S, E, Fp.tid); }
        if (IN(p0 + 4) && ((F.bid >> 3) & 1) == 0) { FRESH(); phase_peer_tables(Fp, INP(I_PU) + (size_t)l * 16384 * DM, INP(I_PV) + (size_t)l * 16384 * DM, UT_, VT_, SU_, SV_, 16384, 32768, gwave(Fp), ngwave(Fp)); }
        SEAM(p0 + 4);
        if (IN(p0 + 5)) { FRESH(); pg8::Gemm g{HN_, WOT_ + (size_t)l * DM * DM, TOK, DM, DM}; pg8::StaticOrder S; S.init(TOK, DM, Fp.G, Fp.bid);
            epi::PanelRms st{(float*)(WSP + WS_SMALL + 1 * MiB) + (size_t)l * TOK * 4, (unsigned*)(WSP + WS_CTL + 32768) + (size_t)l * 64 * 64, (unsigned*)(WSP + WS_CTL + 20480)};
            epi::EpiResidNorm E{XIN_, XB_, MODL_ + 2048, INP(I_NFG) + l * DM, MODL_ + 3072, MODL_ + 4096, HN_, st};
            pg8::gemm_phase<epi::EpiResidNorm, pg8::StaticOrder, true, true>(ring, g, S, E, Fp.tid); }
        SEAM(p0 + 5);
        if (IN(p0 + 7)) { FRESH(); pg8::Gemm g{HN_, WQT_ + (size_t)l * 2048 * DM, TOK, 2048, DM}; pg8::StaticOrder S; S.init(TOK, 2048, Fp.G, Fp.bid);
            epi::EpiStoreBf E{Q2_, 2048}; pg8::gemm_phase<epi::EpiStoreBf, pg8::StaticOrder, true, true>(ring, g, S, E, Fp.tid); }
        SEAM(p0 + 7);
        if (IN(p0 + 8)) { FRESH(); phase_peer_route(Fp, Q2_, SUBK_ + (size_t)l * 8 * 2 * 128 * 128, EIDX_, EW_); __syncthreads(); }
        SEAM(p0 + 8);
        if (IN(p0 + 9)) { FRESH(); phase_peer_u(Fp, HN_, UT_, SU_, EIDX_, PART_); }
        SEAM(p0 + 9);
        if (IN(p0 + 10)) { FRESH(); phase_peer_w(Fp, SV_, SU_, EIDX_, EW_, PART_, COEF_); }
        SEAM(p0 + 10);
        if (IN(p0 + 11)) { FRESH(); phase_peer_v(Fp, VT_, COEF_, XB_, MODL_ + 5120); }
        SEAM(p0 + 11);
    }
    if (IN(NPHASE - 1)) { FRESH(); phase_final_norm(Fp, XB_, INP(I_FNG), XB_); }
#undef IN
#undef SEAM
#undef WSP
}

extern "C" void kernel_launch(void* const* d_in, const int* in_sizes, int n_in, void* d_out, int out_size, void* d_ws, size_t ws_size, hipStream_t stream) {
    static int grid = 0;
    if (grid == 0) {
        if (n_in != 26 || in_sizes[0] != TOK * DM || out_size != TOK * DM || ws_size < WS_END) {
            fprintf(stderr, "kernel_launch: unexpected problem (n_in %d, in0 %d, out %d, WSP %zu); nothing launched\n", n_in, n_in > 0 ? in_sizes[0] : -1, out_size, ws_size); grid = -1; return; }
        int dev = 0, cus = 0, per_cu = 0;
        if (hipGetDevice(&dev) != hipSuccess || hipDeviceGetAttribute(&cus, hipDeviceAttributeMultiprocessorCount, dev) != hipSuccess) { grid = -1; return; }
        if (hipFuncSetAttribute((const void*)hybrid_fwd, hipFuncAttributeMaxDynamicSharedMemorySize, LDS_BYTES) != hipSuccess) { fprintf(stderr, "kernel_launch: hipFuncSetAttribute failed\n"); grid = -1; return; }
        if (hipOccupancyMaxActiveBlocksPerMultiprocessor(&per_cu, (const void*)hybrid_fwd, NTHR, LDS_BYTES) != hipSuccess || per_cu < 1)
            fprintf(stderr, "kernel_launch: note: occupancy query reports %d workgroups per CU\n", per_cu);
        (void)hipGetLastError();
        if (cus != 256) { fprintf(stderr, "kernel_launch: this kernel is laid out for the 256-CU MI355X (one workgroup per CU; found %d CUs); nothing launched\n", cus); grid = -1; return; }
        grid = cus;
    }
    if (grid < 0) return;
    if (hipMemsetAsync((char*)d_ws + WS_CTL, 0, CTL_ZERO_BYTES, stream) != hipSuccess) return;
    Args a{};
    for (int i = 0; i < 26; ++i) a.in[i] = d_in[i];
    a.out = (float*)d_out; a.ws = (unsigned char*)d_ws;
#if MK_PER_PHASE
    for (int p = 0; p < NPHASE; ++p) { a.ph_lo = p; a.ph_hi = p + 1; hipLaunchKernelGGL(hybrid_fwd, dim3(grid), dim3(NTHR), LDS_BYTES, stream, a); }
#else
    a.ph_lo = 0; a.ph_hi = NPHASE; hipLaunchKernelGGL(hybrid_fwd, dim3(grid), dim3(NTHR), LDS_BYTES, stream, a);
#endif
    const hipError_t le = hipPeekAtLastError();
    if (le != hipSuccess) fprintf(stderr, "kernel_launch: launch failed: %s\n", hipGetErrorName(le));
}
```
